# Optimizing an MI355X kernel written in HIP

```python
import math
import jax, jax.numpy as jnp
from jax import lax
import numpy as np


D_MODEL = 1024
BATCH = 8
SEQ = 4096
DEPTH = 2

LRU_WIDTH = 1024
LRU_BLOCKS = 8
LRU_C = 8.0
CONV_WIDTH = 4
ML_HEADS = 4
ML_DQK = 64
ML_DV = 128
GD_HEADS = 8
GD_DK = 64
GD_DV = 64
CHUNK = 64
N_EXPERTS = 32
TOP_K = 4
D_FF = 1024
SWIGLU_LIMIT = 7.0
SWIGLU_ALPHA = 1.702
MOE_BLOCK = 256
N_BRANCH = 3
DN_ALPHA = (2.0 * DEPTH) ** 0.25
DN_BETA = (8.0 * DEPTH) ** -0.25
LN_EPS = 1e-5
RMS_EPS = 1e-6

ML_QK_W = ML_HEADS * ML_DQK
ML_V_W = ML_HEADS * ML_DV
GD_K_W = GD_HEADS * GD_DK
GD_V_W = GD_HEADS * GD_DV
IN_SPLITS = (LRU_WIDTH, LRU_WIDTH, ML_QK_W, ML_QK_W, ML_V_W, ML_HEADS, ML_HEADS, ML_V_W,
             GD_K_W, GD_K_W, GD_V_W, GD_HEADS, GD_HEADS, GD_V_W, N_BRANCH * D_MODEL)
D_IN = sum(IN_SPLITS)
SPLIT_POINTS = [int(c) for c in np.cumsum(IN_SPLITS)[:-1]]

kernel_name = 'hybrid_lru_mlstm_gdn_moe_deepnorm'


def layer_norm(x, g, b):
    xf = x.astype(jnp.float32)
    mu = jnp.mean(xf, -1, keepdims=True)
    xc = xf - mu
    var = jnp.mean(xc * xc, -1, keepdims=True)
    return (xc * lax.rsqrt(var + LN_EPS) * g + b).astype(x.dtype)


def rms_norm(x, g):
    xf = x.astype(jnp.float32)
    return xf * lax.rsqrt(jnp.mean(xf * xf, -1, keepdims=True) + RMS_EPS) * g


def l2_norm(x):
    xf = x.astype(jnp.float32)
    return xf * lax.rsqrt(jnp.sum(xf * xf, -1, keepdims=True) + RMS_EPS)


def causal_conv(x, w):
    S = x.shape[1]
    W = w.shape[0]
    xp = jnp.pad(x, ((0, 0), (W - 1, 0), (0, 0)))
    y = xp[:, W - 1:W - 1 + S] * w[W - 1]
    for j in range(W - 1):
        y = y + xp[:, j:j + S] * w[j]
    return y


def to_chunks(t):
    B, S, H = t.shape[:3]
    t = t.reshape((B, S // CHUNK, CHUNK, H) + t.shape[3:])
    return jnp.moveaxis(t, 3, 1)


def from_chunks(t):
    B, H, NC, L, d = t.shape
    return jnp.moveaxis(t, 1, 3).reshape(B, NC * L, H, d)


def rg_lru(x, wa, ba, wx, bx, lam):
    B, S, W = x.shape
    xf = x.astype(jnp.float32)
    xb = xf.reshape(B, S, LRU_BLOCKS, W // LRU_BLOCKS)
    r = jax.nn.sigmoid(jnp.einsum('bshi,hij->bshj', xb, wa.astype(jnp.float32)) + ba).reshape(B, S, W)
    ig = jax.nn.sigmoid(jnp.einsum('bshi,hij->bshj', xb, wx.astype(jnp.float32)) + bx).reshape(B, S, W)
    log_a = -LRU_C * r * jax.nn.softplus(-lam.astype(jnp.float32))
    a = jnp.exp(log_a)
    u = jnp.sqrt(-jnp.expm1(2.0 * log_a)) * (ig * xf)
    _, h = lax.associative_scan(lambda e1, e2: (e1[0] * e2[0], e2[0] * e1[1] + e2[1]), (a, u), axis=1)
    return h


def mlstm_chunkwise(q, k, v, i_pre, f_pre):
    f32 = jnp.float32
    q = to_chunks(q.astype(f32)) * (q.shape[-1] ** -0.5)
    k = to_chunks(k.astype(f32))
    v = to_chunks(v.astype(f32))
    ig = to_chunks(i_pre.astype(f32))
    logf = to_chunks(jax.nn.log_sigmoid(f_pre.astype(f32)))
    Bn, H, NC, L, dqk = q.shape
    dv = v.shape[-1]
    b = jnp.cumsum(logf, axis=-1)
    b_last = b[..., -1]
    g_end = b_last[..., None] - b + ig

    def step(carry, inp):
        C, n, m = carry
        bl, ge, kc, vc = inp
        m_new = jnp.maximum(bl + m, jnp.max(ge, axis=-1))
        decay = jnp.exp(bl + m - m_new)
        w = jnp.exp(ge - m_new[..., None])
        C_new = decay[..., None, None] * C + jnp.einsum('bhl,bhld,bhle->bhde', w, kc, vc)
        n_new = decay[..., None] * n + jnp.einsum('bhl,bhld->bhd', w, kc)
        return (C_new, n_new, m_new), (C, n, m)

    init = (jnp.zeros((Bn, H, dqk, dv), f32), jnp.zeros((Bn, H, dqk), f32), jnp.zeros((Bn, H), f32))
    xs = tuple(jnp.moveaxis(t, 2, 0) for t in (b_last, g_end, k, v))
    _, (C_prev, n_prev, m_prev) = lax.scan(step, init, xs)
    C_prev = jnp.moveaxis(C_prev, 0, 2)
    n_prev = jnp.moveaxis(n_prev, 0, 2)
    m_prev = jnp.moveaxis(m_prev, 0, 2)

    causal = jnp.tril(jnp.ones((L, L), bool))
    D = jnp.where(causal, b[..., :, None] - b[..., None, :] + ig[..., None, :], -jnp.inf)
    inter = b + m_prev[..., None]
    m_t = jnp.maximum(inter, jnp.max(D, axis=-1))
    Dw = jnp.exp(D - m_t[..., None])
    iw = jnp.exp(inter - m_t)
    s = jnp.einsum('bhcld,bhcsd->bhcls', q, k) * Dw
    num = jnp.einsum('bhcls,bhcse->bhcle', s, v) + iw[..., None] * jnp.einsum('bhcld,bhcde->bhcle', q, C_prev)
    den = jnp.sum(s, axis=-1) + iw * jnp.einsum('bhcld,bhcd->bhcl', q, n_prev)
    h = num / jnp.maximum(jnp.abs(den), jnp.exp(-m_t))[..., None]
    return from_chunks(h)


def gated_delta_chunked(q, k, v, g, beta):
    f32 = jnp.float32
    q = to_chunks(q.astype(f32)) * (q.shape[-1] ** -0.5)
    k = to_chunks(k.astype(f32))
    v = to_chunks(v.astype(f32))
    g = to_chunks(g.astype(f32))
    beta = to_chunks(beta.astype(f32))
    Bn, H, NC, L, dk = q.shape
    dv = v.shape[-1]
    gc = jnp.cumsum(g, axis=-1)
    causal = jnp.tril(jnp.ones((L, L), bool))
    strict = jnp.tril(jnp.ones((L, L), bool), k=-1)
    gam = jnp.exp(jnp.where(causal, gc[..., :, None] - gc[..., None, :], -jnp.inf))
    a_mat = jnp.where(strict, beta[..., :, None] * gam * jnp.einsum('bhcld,bhcsd->bhcls', k, k), 0.0)
    eye = jnp.eye(L, dtype=f32)
    rhs = jnp.concatenate([beta[..., None] * v, (beta * jnp.exp(gc))[..., None] * k], axis=-1)
    sol = lax.linalg.triangular_solve(eye + a_mat, rhs, left_side=True, lower=True, unit_diagonal=True)
    u, w = sol[..., :dv], sol[..., dv:]
    p = gam * jnp.einsum('bhcld,bhcsd->bhcls', q, k)
    qg = q * jnp.exp(gc)[..., None]
    kd = k * jnp.exp(gc[..., -1:] - gc)[..., None]
    gl = jnp.exp(gc[..., -1])

    def step(S, inp):
        qg_c, p_c, u_c, w_c, kd_c, gl_c = inp
        delta = u_c - jnp.einsum('bhld,bhde->bhle', w_c, S)
        o = jnp.einsum('bhld,bhde->bhle', qg_c, S) + jnp.einsum('bhls,bhse->bhle', p_c, delta)
        S_new = gl_c[..., None, None] * S + jnp.einsum('bhld,bhle->bhde', kd_c, delta)
        return S_new, o

    xs = tuple(jnp.moveaxis(t, 2, 0) for t in (qg, p, u, w, kd, gl))
    _, o = lax.scan(step, jnp.zeros((Bn, H, dk, dv), f32), xs)
    return from_chunks(jnp.moveaxis(o, 0, 2))


def token_mixers(x, w_in, lru_conv_w, lru_conv_b, lru_wa, lru_ba, lru_wx, lru_bx, lru_lambda,
                 ml_i_bias, ml_f_bias, ml_norm_g, gd_conv_w, gd_a_log, gd_dt_bias, gd_norm_g,
                 w_br_lru, w_br_ml, w_br_gd, w_out):
    B, S, _ = x.shape
    f32 = jnp.float32
    proj = x @ w_in
    (lru_x, lru_y, ml_q, ml_k, ml_v, ml_i, ml_f, ml_o,
     gd_q, gd_k, gd_v, gd_a, gd_b, gd_z, gate_pre) = jnp.split(proj, SPLIT_POINTS, axis=-1)

    xa = causal_conv(lru_x, lru_conv_w) + lru_conv_b
    ha = rg_lru(xa, lru_wa, lru_ba, lru_wx, lru_bx, lru_lambda) * jax.nn.gelu(lru_y.astype(f32))
    br_a = ha.astype(x.dtype) @ w_br_lru

    hb = mlstm_chunkwise(ml_q.reshape(B, S, ML_HEADS, ML_DQK), ml_k.reshape(B, S, ML_HEADS, ML_DQK),
                         ml_v.reshape(B, S, ML_HEADS, ML_DV), ml_i + ml_i_bias, ml_f + ml_f_bias)
    hb = rms_norm(hb, ml_norm_g) * jax.nn.sigmoid(ml_o.astype(f32)).reshape(B, S, ML_HEADS, ML_DV)
    br_b = hb.reshape(B, S, ML_V_W).astype(x.dtype) @ w_br_ml

    qkv = jax.nn.silu(causal_conv(jnp.concatenate([gd_q, gd_k, gd_v], axis=-1), gd_conv_w))
    q, k, v = jnp.split(qkv, [GD_K_W, 2 * GD_K_W], axis=-1)
    q = l2_norm(q.reshape(B, S, GD_HEADS, GD_DK))
    k = l2_norm(k.reshape(B, S, GD_HEADS, GD_DK))
    g = -jnp.exp(gd_a_log) * jax.nn.softplus(gd_a.astype(f32) + gd_dt_bias)
    beta = jax.nn.sigmoid(gd_b.astype(f32))
    hc = gated_delta_chunked(q, k, v.reshape(B, S, GD_HEADS, GD_DV), g, beta)
    hc = rms_norm(hc, gd_norm_g) * jax.nn.silu(gd_z.astype(f32)).reshape(B, S, GD_HEADS, GD_DV)
    br_c = hc.reshape(B, S, GD_V_W).astype(x.dtype) @ w_br_gd

    gates = jax.nn.sigmoid(gate_pre.astype(f32)).reshape(B, S, N_BRANCH, D_MODEL)
    merged = gates[..., 0, :] * br_a + gates[..., 1, :] * br_b + gates[..., 2, :] * br_c
    return (merged.astype(x.dtype) @ w_out).astype(x.dtype)


def moe_ffn(x, router_w, router_b, w1, b1, w2, b2):
    B, S, D = x.shape
    T = B * S
    A = T * TOP_K
    xf = x.reshape(T, D)
    logits = (xf @ router_w + router_b).astype(jnp.float32)
    top_val, top_idx = lax.top_k(logits, TOP_K)
    gate = jax.nn.softmax(top_val, axis=-1)
    flat_e = top_idx.reshape(A)
    flat_tok = jnp.repeat(jnp.arange(T, dtype=jnp.int32), TOP_K)
    flat_w = gate.reshape(A)
    order = jnp.argsort(flat_e)
    sorted_e = flat_e[order]
    counts = jnp.bincount(flat_e, length=N_EXPERTS)
    padded = ((counts + MOE_BLOCK - 1) // MOE_BLOCK) * MOE_BLOCK
    pad_end = jnp.cumsum(padded)
    pad_start = pad_end - padded
    start = jnp.cumsum(counts) - counts
    dest = pad_start[sorted_e] + (jnp.arange(A, dtype=jnp.int32) - start[sorted_e])
    n_blocks = -(-A // MOE_BLOCK) + N_EXPERTS
    P = n_blocks * MOE_BLOCK
    tok_buf = jnp.full((P,), T, jnp.int32).at[dest].set(flat_tok[order])
    w_buf = jnp.zeros((P,), jnp.float32).at[dest].set(flat_w[order])
    block_e = jnp.clip(jnp.searchsorted(pad_end, jnp.arange(n_blocks) * MOE_BLOCK, side='right'), 0, N_EXPERTS - 1)
    x_pad = jnp.concatenate([xf, jnp.zeros((1, D), xf.dtype)], axis=0)

    def expert_block(args):
        tok, e = args
        hdn = x_pad[tok] @ w1[e] + b1[e]
        glu, lin = hdn[:, :D_FF], hdn[:, D_FF:]
        glu = jnp.minimum(glu, SWIGLU_LIMIT)
        lin = jnp.clip(lin, -SWIGLU_LIMIT, SWIGLU_LIMIT)
        act = glu * jax.nn.sigmoid(SWIGLU_ALPHA * glu) * (lin + 1.0)
        return act @ w2[e] + b2[e]

    y = lax.map(expert_block, (tok_buf.reshape(n_blocks, MOE_BLOCK), block_e)).reshape(P, D)
    y = y * w_buf[:, None].astype(y.dtype)
    out = jnp.zeros((T + 1, D), y.dtype).at[tok_buf].add(y)[:T]
    return out.reshape(B, S, D).astype(x.dtype)


def setup_inputs(seed: int = 0) -> dict:
    key = jax.random.key(seed)
    ks = iter(jax.random.split(key, 40))
    f32 = jnp.float32

    def nrm(shape, scale):
        return scale * jax.random.normal(next(ks), shape, f32)

    def unif(shape, lo, hi):
        return jax.random.uniform(next(ks), shape, f32, lo, hi)

    Lr = DEPTH
    bw = LRU_WIDTH // LRU_BLOCKS
    gd_ch = 2 * GD_K_W + GD_V_W
    a_base = unif((Lr, LRU_WIDTH), 0.9, 0.999) ** (1.0 / LRU_C)
    dt = jnp.exp(unif((Lr, GD_HEADS), math.log(1e-3), math.log(0.1)))
    return {
        'x': nrm((BATCH, SEQ, D_MODEL), 1.0),
        'w_in': nrm((Lr, D_MODEL, D_IN), D_MODEL ** -0.5),
        'lru_conv_w': nrm((Lr, CONV_WIDTH, LRU_WIDTH), CONV_WIDTH ** -0.5),
        'lru_conv_b': nrm((Lr, LRU_WIDTH), 0.02),
        'lru_wa': nrm((Lr, LRU_BLOCKS, bw, bw), bw ** -0.5),
        'lru_ba': nrm((Lr, LRU_BLOCKS, bw), 0.02),
        'lru_wx': nrm((Lr, LRU_BLOCKS, bw, bw), bw ** -0.5),
        'lru_bx': nrm((Lr, LRU_BLOCKS, bw), 0.02),
        'lru_lambda': jnp.log(a_base) - jnp.log1p(-a_base),
        'ml_i_bias': -2.0 + nrm((Lr, ML_HEADS), 0.1),
        'ml_f_bias': jnp.linspace(3.0, 6.0, ML_HEADS)[None, :] + nrm((Lr, ML_HEADS), 0.1),
        'ml_norm_g': 1.0 + nrm((Lr, ML_HEADS, ML_DV), 0.02),
        'gd_conv_w': nrm((Lr, CONV_WIDTH, gd_ch), CONV_WIDTH ** -0.5),
        'gd_a_log': jnp.log(unif((Lr, GD_HEADS), 1.0, 16.0)),
        'gd_dt_bias': dt + jnp.log(-jnp.expm1(-dt)),
        'gd_norm_g': 1.0 + nrm((Lr, GD_DV), 0.02),
        'w_br_lru': nrm((Lr, LRU_WIDTH, D_MODEL), DN_BETA * LRU_WIDTH ** -0.5),
        'w_br_ml': nrm((Lr, ML_V_W, D_MODEL), DN_BETA * ML_V_W ** -0.5),
        'w_br_gd': nrm((Lr, GD_V_W, D_MODEL), DN_BETA * GD_V_W ** -0.5),
        'w_out': nrm((Lr, D_MODEL, D_MODEL), DN_BETA * D_MODEL ** -0.5),
        'ln1_g': 1.0 + nrm((Lr, D_MODEL), 0.02),
        'ln1_b': nrm((Lr, D_MODEL), 0.02),
        'router_w': nrm((Lr, D_MODEL, N_EXPERTS), D_MODEL ** -0.5),
        'router_b': nrm((Lr, N_EXPERTS), 0.01),
        'exp_w1': nrm((Lr, N_EXPERTS, D_MODEL, 2 * D_FF), D_MODEL ** -0.5),
        'exp_b1': nrm((Lr, N_EXPERTS, 2 * D_FF), 0.02),
        'exp_w2': nrm((Lr, N_EXPERTS, D_FF, D_MODEL), DN_BETA * D_FF ** -0.5),
        'exp_b2': nrm((Lr, N_EXPERTS, D_MODEL), 0.02),
        'ln2_g': 1.0 + nrm((Lr, D_MODEL), 0.02),
        'ln2_b': nrm((Lr, D_MODEL), 0.02),
    }


def reference(x, w_in, lru_conv_w, lru_conv_b, lru_wa, lru_ba, lru_wx, lru_bx, lru_lambda,
              ml_i_bias, ml_f_bias, ml_norm_g, gd_conv_w, gd_a_log, gd_dt_bias, gd_norm_g,
              w_br_lru, w_br_ml, w_br_gd, w_out, ln1_g, ln1_b, router_w, router_b,
              exp_w1, exp_b1, exp_w2, exp_b2, ln2_g, ln2_b):
    for l in range(DEPTH):
        y = token_mixers(x, w_in[l], lru_conv_w[l], lru_conv_b[l], lru_wa[l], lru_ba[l], lru_wx[l],
                         lru_bx[l], lru_lambda[l], ml_i_bias[l], ml_f_bias[l], ml_norm_g[l],
                         gd_conv_w[l], gd_a_log[l], gd_dt_bias[l], gd_norm_g[l],
                         w_br_lru[l], w_br_ml[l], w_br_gd[l], w_out[l])
        x = layer_norm(DN_ALPHA * x + y, ln1_g[l], ln1_b[l])
        y = moe_ffn(x, router_w[l], router_b[l], exp_w1[l], exp_b1[l], exp_w2[l], exp_b2[l])
        x = layer_norm(DN_ALPHA * x + y, ln2_g[l], ln2_b[l])
    return x
```

```cpp
#include <hip/hip_runtime.h>
#include <cstdio>
#include <cstdint>

#define LAS __attribute__((address_space(3)))
#define GAS __attribute__((address_space(1)))
typedef unsigned short bf16_t;
typedef short bf16x8 __attribute__((ext_vector_type(8)));
typedef float f32x4 __attribute__((ext_vector_type(4)));
typedef float f32x2 __attribute__((ext_vector_type(2)));
typedef unsigned u32x4 __attribute__((ext_vector_type(4)));
typedef unsigned u32x2 __attribute__((ext_vector_type(2)));

constexpr int T_ = 32768, D_ = 1024, SEQ_ = 4096, NBATCH = 8, DEPTH_ = 2;
constexpr int DIN = 8728, NPROJ = 8704, NINP = 8960;
constexpr int NE = 32, DFF = 1024;
constexpr int PMAX = 139264;
constexpr int NCHUNK = 256, CHTOK = 128;
constexpr float DN_ALPHA = 1.41421356237309515f;
constexpr float LN_EPS = 1e-5f, RMS_EPS = 1e-6f;
constexpr int PC_LRUX = 0, PC_LRUY = 1024, PC_MLQ = 2048, PC_MLK = 2304, PC_MLV = 2560, PC_MLO = 3072, PC_GDQ = 3584, PC_GDK = 4096, PC_GDV = 4608, PC_GDZ = 5120, PC_GATE = 5632;

constexpr size_t MiB = 1u << 20;
constexpr size_t WS_CTL = 0, CTL_ZERO_BYTES = 64 * 1024;
constexpr size_t WS_HIST = 256 * 1024;
constexpr size_t WS_META = 320 * 1024;
constexpr size_t WS_W = 1 * MiB;
constexpr size_t WL_IN = 0, WL_BR = 18 * MiB, WL_OUT = 22 * MiB, WL_W1 = 24 * MiB, WL_W2 = 152 * MiB, WL_G = 216 * MiB, WL_STRIDE = 217 * MiB;
constexpr size_t WS_XB = 436 * MiB;
constexpr size_t WS_GSM = 501 * MiB;
constexpr size_t WS_MB = 505 * MiB;
constexpr size_t WS_V = 569 * MiB;
constexpr size_t WS_X1 = 697 * MiB;
constexpr size_t WS_X1B = 825 * MiB;
constexpr size_t WS_X2 = 890 * MiB;
constexpr size_t WS_TKE = 1018 * MiB;
constexpr size_t WS_TKW = WS_TKE + 512 * 1024;
constexpr size_t WS_SLOT = 1019 * MiB;
constexpr size_t WS_WBUF = 1020 * MiB;
constexpr size_t WS_OV = 1024 * MiB;
constexpr size_t OV_PROJ = 0, OV_H = 544 * MiB, OV_MF = 672 * MiB;
constexpr size_t OV_XS = 0, OV_ACT = 272 * MiB, OV_YS = 544 * MiB;
constexpr size_t WS_END = WS_OV + 816 * MiB;

constexpr int CW_BAR = 1024;

constexpr int RING_BYTES = 131072;
constexpr int MISC_OFF = RING_BYTES;
constexpr int LDS_BYTES = 147456;
constexpr int NWAVES = 8;

#define LDS_WAIT() asm volatile("s_waitcnt lgkmcnt(0)" ::: "memory")
#define VM_WAIT() asm volatile("s_waitcnt vmcnt(0)" ::: "memory")

__device__ __forceinline__ unsigned f2bf(float f) { unsigned u = __builtin_bit_cast(unsigned, f); return (u + 0x7fffu + ((u >> 16) & 1u)) >> 16; }
__device__ __forceinline__ unsigned pk2(float lo, float hi) { return f2bf(lo) | (f2bf(hi) << 16); }
__device__ __forceinline__ float bf2f(unsigned short b) { return __builtin_bit_cast(float, (unsigned)b << 16); }
__device__ __forceinline__ float bflo(unsigned w) { return __builtin_bit_cast(float, w << 16); }
__device__ __forceinline__ float bfhi(unsigned w) { return __builtin_bit_cast(float, w & 0xffff0000u); }
__device__ __forceinline__ float wave_sum(float v) {
#pragma unroll
    for (int o = 1; o < 64; o <<= 1) v += __shfl_xor(v, o);
    return v;
}
__device__ __forceinline__ float wave_max(float v) {
#pragma unroll
    for (int o = 1; o < 64; o <<= 1) v = fmaxf(v, __shfl_xor(v, o));
    return v;
}
__device__ __forceinline__ float sigmoid_f(float x) { return 1.f / (1.f + __expf(-x)); }
__device__ __forceinline__ float silu_f(float x) { return x / (1.f + __expf(-x)); }
__device__ __forceinline__ float softplus_f(float x) { return x > 20.f ? x : log1pf(expf(x)); }
__device__ __forceinline__ float gelu_tanh_f(float x) { const float u = 0.7978845608028654f * (x + 0.044715f * x * x * x); return 0.5f * x * (1.f + tanhf(u)); }
namespace pg8 {
#define PG8_LAS __attribute__((address_space(3)))
constexpr int BM = 256, BK = 64, HALF = 128, HTB = HALF * BK * 2  , STAGE_BYTES = 8 * HTB, NXCD = 8, WGM = 8;

__host__ __device__ __forceinline__ int lds_byte(int r, int c) { const int st = (r >> 4) * 2 + (c >> 5), rr = r & 15, cc = c & 31, ob = rr * 64 + cc * 2; return st * 1024 + (ob ^ (((ob >> 9) & 1) << 5)); }
__host__ __device__ __forceinline__ void stage_rc(int b, int& R, int& C) { const int st = b / 1024, sb = b % 1024, swz = sb ^ (((sb >> 9) & 1) << 5); R = (st >> 1) * 16 + swz / 64; C = (st & 1) * 32 + (swz % 64) / 2; }
__host__ __device__ __forceinline__ int perm32(int rho) { const int n = rho >> 4, i = rho & 15; return 8 * (i >> 2) + 4 * n + (i & 3); }

struct Unit { int pm, pn; };
struct Gemm { const bf16_t* A; const bf16_t* Bt; int lda, ldb, K; };

struct StaticOrder {
    int nM, nN, nwg, G, c;
    __host__ __device__ void init(int M, int N, int G_, int c_) { nM = M / BM; nN = N / BM; nwg = nM * nN; G = G_; c = c_; }
    __host__ __device__ bool next(int i, Unit& u) const {
        const long L = (long)i * G + c; if (L >= nwg) return false;
        int wgid = (int)L; { const int q = nwg / NXCD, r = nwg % NXCD, xcd = wgid % NXCD, off = wgid / NXCD; wgid = (xcd < r ? xcd * (q + 1) : r * (q + 1) + (xcd - r) * q) + off; }
        const int nig = WGM * nN, gid = wgid / nig, fm = gid * WGM, gsz = (nM - fm) < WGM ? (nM - fm) : WGM;
        u.pm = fm + ((wgid % nig) % gsz); u.pn = (wgid % nig) / gsz; return true;
    }
    __device__ __forceinline__ void a_ready(const Unit&) const {}
    __device__ __forceinline__ void done(const Unit&) const {}
};

__device__ __forceinline__ unsigned cvt_pk_bf16(float lo, float hi) { unsigned r; asm volatile("v_cvt_pk_bf16_f32 %0, %1, %2" : "=v"(r) : "v"(lo), "v"(hi)); return r; }

template <class Epi, class Sched, bool ALIGN_EPI = false, bool SP2 = false>
__device__ __forceinline__ void gemm_phase(PG8_LAS unsigned char* lds, const Gemm g, const Sched& S, const Epi& E) {
    int tid_ = threadIdx.x; asm volatile("" : "+v"(tid_));
    const int tid = tid_, wid = __builtin_amdgcn_readfirstlane(tid >> 6), lane = tid & 63, wr = wid >> 2, wc = wid & 3, fr = lane & 15, fq = lane >> 4;
    const int K = g.K, nt = K / BK;
    unsigned voffA[2], voffB[2];
#pragma unroll
    for (int i = 0; i < 2; ++i) { int R, C; stage_rc(tid * 16 + i * 8192, R, C); const int Rb = Epi::PERM ? ((R & ~31) + perm32(R & 31)) : R;
        voffA[i] = (unsigned)(R * g.lda + C) * 2u; voffB[i] = (unsigned)(Rb * g.ldb + C) * 2u; }
    const size_t kstep = (size_t)(BK * 2);
    const size_t hstepA = (size_t)HALF * g.lda * 2, hstepB = (size_t)HALF * g.ldb * 2;
    const size_t tstepA = 2 * hstepA, tstepB = 2 * hstepB;
    const unsigned ldsw = (unsigned)wid * 1024u;
    const int aoff = lds_byte(wr * 64 + fr, fq * 8), boff = lds_byte(wc * 32 + fr, fq * 8);
#define PG8_SA(b, h) (((b) * 2 + (h)) * HTB)
#define PG8_SB(b, h) ((4 + (b) * 2 + (h)) * HTB)
#define PG8_STAGE(bufoff, gbase, voff) do { _Pragma("unroll") for (int _i = 0; _i < 2; ++_i) \
        __builtin_amdgcn_global_load_lds((const unsigned*)((const char*)(gbase) + (voff)[_i]), (PG8_LAS unsigned*)(lds + (bufoff) + ldsw + _i * 8192), 16, 0, 0); } while (0)
#define PG8_LDA(dst, b, h) do { _Pragma("unroll") for (int m = 0; m < 4; ++m) _Pragma("unroll") for (int k = 0; k < 2; ++k) dst[m][k] = *(const PG8_LAS bf16x8*)(lds + PG8_SA(b, h) + aoff + m * 2048 + k * 1024); } while (0)
#define PG8_LDB(dst, b, h) do { _Pragma("unroll") for (int n = 0; n < 2; ++n) _Pragma("unroll") for (int k = 0; k < 2; ++k) dst[n][k] = *(const PG8_LAS bf16x8*)(lds + PG8_SB(b, h) + boff + n * 2048 + k * 1024); } while (0)
#define PG8_MMA(ai, bj, At, Bt) do { __builtin_amdgcn_s_setprio(1); _Pragma("unroll") for (int m = 0; m < 4; ++m) _Pragma("unroll") for (int n = 0; n < 2; ++n) _Pragma("unroll") for (int k = 0; k < 2; ++k) \
        acc[ai][bj][m][n] = __builtin_amdgcn_mfma_f32_16x16x32_bf16(Bt[n][k], At[m][k], acc[ai][bj][m][n], 0, 0, 0); __builtin_amdgcn_s_setprio(0); } while (0)
#define PG8_WAIT_V(n) asm volatile("s_waitcnt vmcnt(" #n ")" ::: "memory")
#define PG8_WAIT_L(n) asm volatile("s_waitcnt lgkmcnt(" #n ")" ::: "memory")
#define PG8_BAR __builtin_amdgcn_s_barrier()
#define PG8_SCHED __builtin_amdgcn_sched_barrier(0)
    Unit cur, nxt; int ui = 0;
    if (!S.next(0, cur)) return;
    f32x4 acc[2][2][4][2];
#pragma unroll
    for (int a = 0; a < 2; ++a)
#pragma unroll
        for (int b = 0; b < 2; ++b)
#pragma unroll
            for (int m = 0; m < 4; ++m)
#pragma unroll
                for (int n = 0; n < 2; ++n) acc[a][b][m][n] = (f32x4){0.f, 0.f, 0.f, 0.f};
    bf16x8 At[4][2], B0[2][2], B1[2][2];
    const char* cA = (const char*)g.A + (size_t)cur.pm * tstepA; const char* cB = (const char*)g.Bt + (size_t)cur.pn * tstepB;
    S.a_ready(cur);
    if constexpr (SP2) {
        PG8_STAGE(PG8_SB(0, 0), cB, voffB); PG8_STAGE(PG8_SB(0, 1), cB + hstepB, voffB); PG8_STAGE(PG8_SA(0, 0), cA, voffA); PG8_STAGE(PG8_SA(0, 1), cA + hstepA, voffA);
        if (wr == 1) PG8_BAR;
        PG8_WAIT_V(2); PG8_BAR;
        PG8_STAGE(PG8_SB(1, 0), cB + kstep, voffB); PG8_STAGE(PG8_SA(1, 0), cA + kstep, voffA); PG8_STAGE(PG8_SB(1, 1), cB + hstepB + kstep, voffB);
        PG8_WAIT_V(6); PG8_BAR;
    } else {
        PG8_STAGE(PG8_SB(0, 0), cB, voffB); PG8_STAGE(PG8_SA(0, 0), cA, voffA); PG8_STAGE(PG8_SB(0, 1), cB + hstepB, voffB); PG8_STAGE(PG8_SA(0, 1), cA + hstepA, voffA);
        if (wr == 1) PG8_BAR;
        PG8_WAIT_V(4); PG8_BAR;
        PG8_STAGE(PG8_SB(1, 0), cB + kstep, voffB); PG8_STAGE(PG8_SA(1, 0), cA + kstep, voffA); PG8_STAGE(PG8_SB(1, 1), cB + hstepB + kstep, voffB);
        PG8_WAIT_V(6); PG8_BAR;
    }
    for (;;) {
        const bool has_next = S.next(ui + 1, nxt);
        const char* nA = has_next ? (const char*)g.A + (size_t)nxt.pm * tstepA : cA; const char* nB = has_next ? (const char*)g.Bt + (size_t)nxt.pn * tstepB : cB;
        for (int t = 0; t < nt; t += 2) {
            const bool last = (t == nt - 2);
            const char* a1 = cA + (size_t)(t + 1) * kstep;
            const char* a2 = last ? nA : cA + (size_t)(t + 2) * kstep; const char* b2 = last ? nB : cB + (size_t)(t + 2) * kstep;
            const char* a3 = a2 + kstep; const char* b3 = b2 + kstep;
            if (last && has_next) S.a_ready(nxt);
            if constexpr (SP2) {
            PG8_LDB(B0, 0, 0); PG8_LDB(B1, 0, 1); PG8_SCHED; PG8_LDA(At, 0, 0); PG8_STAGE(PG8_SA(1, 1), a1 + hstepA, voffA);
            PG8_WAIT_V(8); PG8_WAIT_L(0); PG8_BAR; PG8_MMA(0, 0, At, B0); PG8_MMA(0, 1, At, B1); PG8_BAR; PG8_SCHED;
            PG8_LDA(At, 0, 1); PG8_STAGE(PG8_SB(0, 0), b2, voffB); PG8_STAGE(PG8_SB(0, 1), b2 + hstepB, voffB); PG8_STAGE(PG8_SA(0, 0), a2, voffA);
            PG8_WAIT_V(8); PG8_WAIT_L(0); PG8_BAR; PG8_MMA(1, 0, At, B0); PG8_MMA(1, 1, At, B1); PG8_BAR; PG8_SCHED;
            PG8_LDB(B0, 1, 0); PG8_LDB(B1, 1, 1); PG8_SCHED; PG8_LDA(At, 1, 0); PG8_STAGE(PG8_SA(0, 1), a2 + hstepA, voffA);
            PG8_WAIT_V(8); PG8_WAIT_L(0); PG8_BAR; PG8_MMA(0, 0, At, B0); PG8_MMA(0, 1, At, B1); PG8_BAR; PG8_SCHED;
            PG8_LDA(At, 1, 1); PG8_STAGE(PG8_SB(1, 0), b3, voffB); PG8_STAGE(PG8_SB(1, 1), b3 + hstepB, voffB); PG8_STAGE(PG8_SA(1, 0), a3, voffA);
            PG8_WAIT_V(8); PG8_WAIT_L(0); PG8_BAR; PG8_MMA(1, 0, At, B0); PG8_MMA(1, 1, At, B1); PG8_BAR; PG8_SCHED;
            } else {
            PG8_LDB(B0, 0, 0); PG8_SCHED; PG8_LDA(At, 0, 0); PG8_STAGE(PG8_SA(1, 1), a1 + hstepA, voffA);
            PG8_WAIT_L(8); PG8_BAR; PG8_WAIT_L(0); PG8_MMA(0, 0, At, B0); PG8_BAR; PG8_SCHED;
            PG8_LDB(B1, 0, 1); PG8_STAGE(PG8_SB(0, 0), b2, voffB);
            PG8_BAR; PG8_WAIT_L(0); PG8_MMA(0, 1, At, B1); PG8_BAR;
            PG8_LDA(At, 0, 1); PG8_STAGE(PG8_SA(0, 0), a2, voffA);
            PG8_BAR; PG8_WAIT_L(0); PG8_MMA(1, 0, At, B0); PG8_BAR; PG8_SCHED;
            PG8_STAGE(PG8_SB(0, 1), b2 + hstepB, voffB);
            PG8_WAIT_V(6); PG8_BAR; PG8_MMA(1, 1, At, B1); PG8_BAR;
            PG8_LDB(B0, 1, 0); PG8_SCHED; PG8_LDA(At, 1, 0); PG8_STAGE(PG8_SA(0, 1), a2 + hstepA, voffA);
            PG8_WAIT_L(8); PG8_BAR; PG8_WAIT_L(0); PG8_MMA(0, 0, At, B0); PG8_BAR; PG8_SCHED;
            PG8_LDB(B1, 1, 1); PG8_STAGE(PG8_SB(1, 0), b3, voffB);
            PG8_BAR; PG8_WAIT_L(0); PG8_MMA(0, 1, At, B1); PG8_BAR;
            PG8_LDA(At, 1, 1); PG8_STAGE(PG8_SA(1, 0), a3, voffA);
            PG8_BAR; PG8_WAIT_L(0); PG8_MMA(1, 0, At, B0); PG8_BAR; PG8_SCHED;
            PG8_STAGE(PG8_SB(1, 1), b3 + hstepB, voffB);
            PG8_WAIT_V(6); PG8_BAR; PG8_MMA(1, 1, At, B1); PG8_BAR;
            }
        }
        if constexpr (ALIGN_EPI) { if (wr == 0) PG8_BAR; }
        E(acc, cur, wr, wc, fr, fq); S.done(cur);
        if (!has_next) break;
#pragma unroll
        for (int a = 0; a < 2; ++a)
#pragma unroll
            for (int b = 0; b < 2; ++b)
#pragma unroll
                for (int m = 0; m < 4; ++m)
#pragma unroll
                    for (int n = 0; n < 2; ++n) acc[a][b][m][n] = (f32x4){0.f, 0.f, 0.f, 0.f};
        cur = nxt; cA = nA; cB = nB; ++ui;
        if constexpr (ALIGN_EPI) { if (wr == 1) PG8_BAR; }
    }
    PG8_WAIT_V(0);
    if constexpr (!ALIGN_EPI) { if (wr == 0) PG8_BAR; }
    PG8_BAR;
#undef PG8_SA
#undef PG8_SB
#undef PG8_STAGE
#undef PG8_LDA
#undef PG8_LDB
#undef PG8_MMA
#undef PG8_WAIT_V
#undef PG8_WAIT_L
#undef PG8_BAR
#undef PG8_SCHED
}
}
#define XB_TMO      128
#define XB_XCNT(j)  (256  + 64 * (j))
#define XB_XSUB(j)  (1280 + 64 * (j))
#define XB_XGEN(j)  (2304 + 64 * (j))
#define XB_TOP      3328
#define XB_TOPGEN   3392
#define XCD_BAR_WORDS 3456
#define XB_SPIN_CAP (1u << 18)

__device__ __forceinline__ unsigned xb_ld(unsigned* p)              { return __hip_atomic_load(p, __ATOMIC_RELAXED, __HIP_MEMORY_SCOPE_AGENT); }
__device__ __forceinline__ unsigned xb_add(unsigned* p, unsigned v) { return __hip_atomic_fetch_add(p, v, __ATOMIC_RELAXED, __HIP_MEMORY_SCOPE_AGENT); }
__device__ __forceinline__ unsigned xb_xcc_id() { return (unsigned)__builtin_amdgcn_s_getreg((3 << 11) | 20) & 0xFu; }
#define XB_SPIN(cond, bar) do { unsigned _sp = 0; while (cond) { __builtin_amdgcn_s_sleep(1); \
    if ((++_sp & 255u) == 0u) { if (xb_ld(&(bar)[XB_TMO])) break; if (_sp > XB_SPIN_CAP) { atomicAdd(&(bar)[XB_TMO], 1u); break; } } } } while (0)

struct XcdBarrier {
    unsigned* bar; unsigned x;
    volatile LAS unsigned* st;
};

__device__ __forceinline__ XcdBarrier xcd_barrier_post(unsigned* bar, volatile LAS unsigned* st) {
    XcdBarrier b; b.bar = bar; b.x = xb_xcc_id(); b.st = st;
    if (threadIdx.x == 0) (void)xb_add(&bar[XB_XCNT(b.x)], 1u);
    return b;
}
__device__ __forceinline__ void xcd_barrier_complete(unsigned* bar, unsigned x, unsigned& nloc, unsigned& nx) {
    const unsigned G = gridDim.x * gridDim.y * gridDim.z;
    unsigned sum, cnt, mine, sp = 0u;
    for (;;) {
        sum = 0u; cnt = 0u; mine = 0u;
#pragma unroll
        for (unsigned j = 0; j < 16; ++j) { const unsigned c = xb_ld(&bar[XB_XCNT(j)]); sum += c; cnt += (c > 0u) ? 1u : 0u; mine = (j == x) ? c : mine; }
        if (sum == G) break;
        __builtin_amdgcn_s_sleep(1);
        if ((++sp & 255u) == 0u) { if (xb_ld(&bar[XB_TMO])) break; if (sp > XB_SPIN_CAP) { atomicAdd(&bar[XB_TMO], 1u); break; } }
    }
    nloc = mine > 0u ? mine : 1u; nx = cnt > 0u ? cnt : 1u;
}

__device__ __forceinline__ void xcd_barrier(const XcdBarrier& b) {
    asm volatile("s_waitcnt vmcnt(0)" ::: "memory");
    __syncthreads();
    if (threadIdx.x == 0) {
        unsigned* bar = b.bar;
        __builtin_amdgcn_s_waitcnt(0);
        unsigned nloc = b.st[0], nx = b.st[1];
        if (nloc == 0u) { xcd_barrier_complete(bar, b.x, nloc, nx); b.st[0] = nloc; b.st[1] = nx; }
        const unsigned old = xb_add(&bar[XB_XSUB(b.x)], 1u);
        const unsigned gen = old / nloc;
        if (old + 1u == (gen + 1u) * nloc) {
            __builtin_amdgcn_fence(__ATOMIC_RELEASE, "agent");
            asm volatile("s_waitcnt vmcnt(0)" ::: "memory");
            const unsigned og = xb_add(&bar[XB_TOP], 1u);
            const unsigned tg = og / nx;
            if (og + 1u == (tg + 1u) * nx) xb_add(&bar[XB_TOPGEN], 1u);
            else XB_SPIN(xb_ld(&bar[XB_TOPGEN]) == tg, bar);
            __builtin_amdgcn_fence(__ATOMIC_ACQUIRE, "agent");
            xb_add(&bar[XB_XGEN(b.x)], 1u);
            asm volatile("s_waitcnt vmcnt(0)" ::: "memory");
        } else {
            XB_SPIN(xb_ld(&bar[XB_XGEN(b.x)]) == gen, bar);
            __builtin_amdgcn_fence(__ATOMIC_ACQUIRE, "agent");
            asm volatile("s_waitcnt vmcnt(0)" ::: "memory");
        }
    }
    __syncthreads();
}
namespace pg8 {
struct EpiProj {
    static constexpr bool PERM = true;
    bf16_t* proj; float* gsm;
    __device__ __forceinline__ void operator()(const f32x4 (&acc)[2][2][4][2], const Unit& u, int wr, int wc, int fr, int fq) const {
        const int row0 = u.pm * BM + wr * 64 + fr;
        if (u.pn < 34) {
            const int col0 = u.pn * BM + wc * 32 + 8 * fq;
#pragma unroll
            for (int ai = 0; ai < 2; ++ai)
#pragma unroll
                for (int m = 0; m < 4; ++m) { bf16_t* rowp = proj + (size_t)(row0 + ai * HALF + m * 16) * NPROJ + col0;
#pragma unroll
                    for (int bj = 0; bj < 2; ++bj) { const f32x4 v0 = acc[ai][bj][m][0], v1 = acc[ai][bj][m][1];
                        u32x4 w; w.x = cvt_pk_bf16(v0[0], v0[1]); w.y = cvt_pk_bf16(v0[2], v0[3]); w.z = cvt_pk_bf16(v1[0], v1[1]); w.w = cvt_pk_bf16(v1[2], v1[3]);
                        *(u32x4*)(rowp + bj * HALF) = w; } }
        } else if (wc == 0 && fq < 3) {
#pragma unroll
            for (int ai = 0; ai < 2; ++ai)
#pragma unroll
                for (int m = 0; m < 4; ++m) { float* rowp = gsm + (size_t)(row0 + ai * HALF + m * 16) * 32 + 8 * fq;
                    *(f32x4*)(rowp) = acc[ai][0][m][0]; *(f32x4*)(rowp + 4) = acc[ai][0][m][1]; }
        }
    }
};
template <int STAGE> struct EpiMerge {
    static constexpr bool PERM = true;
    const bf16_t* proj; float* mf; bf16_t* mb;
    __device__ __forceinline__ void operator()(const f32x4 (&acc)[2][2][4][2], const Unit& u, int wr, int wc, int fr, int fq) const {
        const int row0 = u.pm * BM + wr * 64 + fr, col0 = u.pn * BM + wc * 32 + 8 * fq;
#pragma unroll
        for (int ai = 0; ai < 2; ++ai)
#pragma unroll
            for (int m = 0; m < 4; ++m) { const size_t row = (size_t)(row0 + ai * HALF + m * 16);
#pragma unroll
                for (int bj = 0; bj < 2; ++bj) { const int col = col0 + bj * HALF;
                    const u32x4 gw = *(const u32x4*)(proj + row * NPROJ + PC_GATE + STAGE * 1024 + col);
                    f32x4 g0, g1;
                    g0[0] = sigmoid_f(bflo(gw.x)); g0[1] = sigmoid_f(bfhi(gw.x)); g0[2] = sigmoid_f(bflo(gw.y)); g0[3] = sigmoid_f(bfhi(gw.y));
                    g1[0] = sigmoid_f(bflo(gw.z)); g1[1] = sigmoid_f(bfhi(gw.z)); g1[2] = sigmoid_f(bflo(gw.w)); g1[3] = sigmoid_f(bfhi(gw.w));
                    f32x4 v0 = acc[ai][bj][m][0] * g0, v1 = acc[ai][bj][m][1] * g1;
                    float* mp = mf + row * 1024 + col;
                    if (STAGE > 0) { v0 += *(const f32x4*)(mp); v1 += *(const f32x4*)(mp + 4); }
                    if (STAGE < 2) { *(f32x4*)(mp) = v0; *(f32x4*)(mp + 4) = v1; }
                    else { u32x4 w; w.x = cvt_pk_bf16(v0[0], v0[1]); w.y = cvt_pk_bf16(v0[2], v0[3]); w.z = cvt_pk_bf16(v1[0], v1[1]); w.w = cvt_pk_bf16(v1[2], v1[3]);
                        *(u32x4*)(mb + row * 1024 + col) = w; } } }
    }
};
struct EpiWout {
    static constexpr bool PERM = false;
    const float* x; float* v;
    __device__ __forceinline__ void operator()(const f32x4 (&acc)[2][2][4][2], const Unit& u, int wr, int wc, int fr, int fq) const {
        const int row0 = u.pm * BM + wr * 64 + fr, col0 = u.pn * BM + wc * 32 + 4 * fq;
#pragma unroll
        for (int ai = 0; ai < 2; ++ai)
#pragma unroll
            for (int m = 0; m < 4; ++m) { const size_t off = (size_t)(row0 + ai * HALF + m * 16) * 1024 + col0;
#pragma unroll
                for (int bj = 0; bj < 2; ++bj)
#pragma unroll
                    for (int n = 0; n < 2; ++n) { const f32x4 xv = *(const f32x4*)(x + off + bj * HALF + n * 16);
                        *(f32x4*)(v + off + bj * HALF + n * 16) = xv * DN_ALPHA + acc[ai][bj][m][n]; } }
    }
};
struct EpiMoe1 {
    static constexpr bool PERM = true;
    bf16_t* act; const float* b1;
    __device__ __forceinline__ void operator()(const f32x4 (&acc)[2][2][4][2], const Unit& u, int wr, int wc, int fr, int fq) const {
        const int e = u.pn >> 3, tl = u.pn & 7;
        const int row0 = u.pm * BM + wr * 64 + fr, col0 = tl * 128 + wc * 32 + 8 * fq;
        const float* bp = b1 + (size_t)e * 2048 + col0;
        const f32x4 bg0 = *(const f32x4*)(bp), bg1 = *(const f32x4*)(bp + 4), bl0 = *(const f32x4*)(bp + 1024), bl1 = *(const f32x4*)(bp + 1028);
#pragma unroll
        for (int ai = 0; ai < 2; ++ai)
#pragma unroll
            for (int m = 0; m < 4; ++m) { bf16_t* rowp = act + (size_t)(row0 + ai * HALF + m * 16) * 1024 + col0;
                f32x4 o[2];
#pragma unroll
                for (int n = 0; n < 2; ++n) { const f32x4 gg = acc[ai][0][m][n] + (n ? bg1 : bg0), ll = acc[ai][1][m][n] + (n ? bl1 : bl0);
#pragma unroll
                    for (int q = 0; q < 4; ++q) { const float gv = fminf(gg[q], 7.0f), lv = fminf(fmaxf(ll[q], -7.0f), 7.0f);
                        o[n][q] = gv * sigmoid_f(1.702f * gv) * (lv + 1.0f); } }
                u32x4 w; w.x = cvt_pk_bf16(o[0][0], o[0][1]); w.y = cvt_pk_bf16(o[0][2], o[0][3]); w.z = cvt_pk_bf16(o[1][0], o[1][1]); w.w = cvt_pk_bf16(o[1][2], o[1][3]);
                *(u32x4*)(rowp) = w; }
    }
};
struct EpiMoe2 {
    static constexpr bool PERM = true;
    bf16_t* ys; const float* b2; const float* wbuf;
    __device__ __forceinline__ void operator()(const f32x4 (&acc)[2][2][4][2], const Unit& u, int wr, int wc, int fr, int fq) const {
        const int e = u.pn >> 2, tl = u.pn & 3;
        const int row0 = u.pm * BM + wr * 64 + fr, col0 = tl * 256 + wc * 32 + 8 * fq;
        const float* bp = b2 + (size_t)e * 1024 + col0;
        f32x4 bv[2][2];
#pragma unroll
        for (int bj = 0; bj < 2; ++bj) { bv[bj][0] = *(const f32x4*)(bp + bj * HALF); bv[bj][1] = *(const f32x4*)(bp + bj * HALF + 4); }
#pragma unroll
        for (int ai = 0; ai < 2; ++ai)
#pragma unroll
            for (int m = 0; m < 4; ++m) { const int row = row0 + ai * HALF + m * 16; const float ww = wbuf[row]; bf16_t* rowp = ys + (size_t)row * 1024 + col0;
#pragma unroll
                for (int bj = 0; bj < 2; ++bj) { const f32x4 v0 = (acc[ai][bj][m][0] + bv[bj][0]) * ww, v1 = (acc[ai][bj][m][1] + bv[bj][1]) * ww;
                    u32x4 w; w.x = cvt_pk_bf16(v0[0], v0[1]); w.y = cvt_pk_bf16(v0[2], v0[3]); w.z = cvt_pk_bf16(v1[0], v1[1]); w.w = cvt_pk_bf16(v1[2], v1[3]);
                    *(u32x4*)(rowp + bj * HALF) = w; } }
    }
};
struct MoeOrder {
    int nN, G, c, total; const LAS int* blk_e;
    __device__ __forceinline__ bool next(int i, Unit& u) const {
        const long L = (long)i * G + c; if (L >= total) return false;
        const int rb = (int)(L / nN), tl = (int)(L % nN); u.pm = rb; u.pn = blk_e[rb] * nN + tl; return true;
    }
    __device__ __forceinline__ void a_ready(const Unit&) const {}
    __device__ __forceinline__ void done(const Unit&) const {}
};
}
struct Args { const float* in[30]; float* out; unsigned char* ws; int ph_lo, ph_hi, li, pad; };
enum { I_X = 0, I_WIN, I_LCW, I_LCB, I_LWA, I_LBA, I_LWX, I_LBX, I_LLAM, I_MIB, I_MFB, I_MNG, I_GCW, I_GAL, I_GDT, I_GNG, I_WBA, I_WBB, I_WBC, I_WOUT, I_LN1G, I_LN1B, I_RW, I_RB, I_W1, I_B1, I_W2, I_B2, I_LN2G, I_LN2B };

template <int MODE> __device__ __forceinline__ int col_map(int n) {
    if (MODE == 1) {
        if (n < 3072) return n;
        if (n < 3076) return 8704 + (n - 3072);
        if (n < 3080) return 8708 + (n - 3076);
        if (n < 5128) return n - 8;
        if (n < 5136) return 8712 + (n - 5128);
        if (n < 5144) return 8720 + (n - 5136);
        return n - 24;
    } else if (MODE == 2) {
        if (n < 1024) return (n >> 7) * 256 + (n & 127);
        const int q = n - 1024; return (q >> 7) * 256 + 128 + (q & 127);
    }
    return n;
}
template <int MODE> __device__ __forceinline__ void transpose_item(const float* W, int N, bf16_t* WT, int ldk, int koff, LAS float* scr, int kb, int nb, int lane) {
    const int k0 = 64 * kb, n0 = 32 * nb; const int nsrc = n0 + (lane & 31);
#pragma unroll 8
    for (int i = 0; i < 32; ++i) { const int kk = 2 * i + (lane >> 5); scr[kk * 33 + (lane & 31)] = (nsrc < N) ? W[(size_t)(k0 + kk) * N + nsrc] : 0.f; }
    LDS_WAIT(); asm volatile("" ::: "memory");
    const int c = lane & 7;
#pragma unroll
    for (int j = 0; j < 4; ++j) { const int nl = (lane >> 3) + 8 * j, n = n0 + nl; const LAS float* s = scr + (8 * c) * 33 + nl;
        u32x4 o; o.x = pk2(s[0 * 33], s[1 * 33]); o.y = pk2(s[2 * 33], s[3 * 33]); o.z = pk2(s[4 * 33], s[5 * 33]); o.w = pk2(s[6 * 33], s[7 * 33]);
        if (n < N) *(u32x4*)(WT + (size_t)col_map<MODE>(n) * ldk + koff + k0 + 8 * c) = o; }
    LDS_WAIT(); asm volatile("" ::: "memory");
}
constexpr int IT_IN = 16 * 273, IT_BRA = 16 * 32, IT_BRB = 8 * 32, IT_BRC = 8 * 32, IT_OUT = 16 * 32, IT_W1 = 32 * 16 * 64, IT_W2 = 32 * 16 * 32;
constexpr int IT_LAYER = IT_IN + IT_BRA + IT_BRB + IT_BRC + IT_OUT + IT_W1 + IT_W2;
__device__ __forceinline__ void p0_convert(const Args& a, LAS unsigned char* lds, int G) {
    int tid_ = threadIdx.x; asm volatile("" : "+v"(tid_)); const int tid = tid_, lane = tid & 63, wave = tid >> 6;
    LAS float* scr = (LAS float*)(lds + wave * 16384);
    const int gw = blockIdx.x * NWAVES + wave, NGW = G * NWAVES;
    for (int it = gw; it < 2 * IT_LAYER; it += NGW) {
        const int l = it / IT_LAYER; int r = it - l * IT_LAYER;
        unsigned char* wl = a.ws + WS_W + (size_t)l * WL_STRIDE;
        if (r < IT_IN) { transpose_item<1>(a.in[I_WIN] + (size_t)l * 1024 * DIN, DIN, (bf16_t*)(wl + WL_IN), 1024, 0, scr, r / 273, r % 273, lane); continue; } r -= IT_IN;
        if (r < IT_BRA) { transpose_item<0>(a.in[I_WBA] + (size_t)l * 1024 * 1024, 1024, (bf16_t*)(wl + WL_BR), 2048, 0, scr, r / 32, r % 32, lane); continue; } r -= IT_BRA;
        if (r < IT_BRB) { transpose_item<0>(a.in[I_WBB] + (size_t)l * 512 * 1024, 1024, (bf16_t*)(wl + WL_BR), 2048, 1024, scr, r / 32, r % 32, lane); continue; } r -= IT_BRB;
        if (r < IT_BRC) { transpose_item<0>(a.in[I_WBC] + (size_t)l * 512 * 1024, 1024, (bf16_t*)(wl + WL_BR), 2048, 1536, scr, r / 32, r % 32, lane); continue; } r -= IT_BRC;
        if (r < IT_OUT) { transpose_item<0>(a.in[I_WOUT] + (size_t)l * 1024 * 1024, 1024, (bf16_t*)(wl + WL_OUT), 1024, 0, scr, r / 32, r % 32, lane); continue; } r -= IT_OUT;
        if (r < IT_W1) { const int e = r / 1024, q = r % 1024;
            transpose_item<2>(a.in[I_W1] + ((size_t)l * NE + e) * 1024 * 2048, 2048, (bf16_t*)(wl + WL_W1) + (size_t)e * 2048 * 1024, 1024, 0, scr, q / 64, q % 64, lane); continue; } r -= IT_W1;
        { const int e = r / 512, q = r % 512;
            transpose_item<0>(a.in[I_W2] + ((size_t)l * NE + e) * 1024 * 1024, 1024, (bf16_t*)(wl + WL_W2) + (size_t)e * 1024 * 1024, 1024, 0, scr, q / 32, q % 32, lane); }
    }
    const size_t gt = (size_t)blockIdx.x * 512 + tid, GT = (size_t)G * 512;
    for (size_t i = gt; i < (size_t)2 * 232 * 128; i += GT) { const int l = (int)(i / (232 * 128)); const size_t q = i % (232 * 128);
        *(u32x4*)(a.ws + WS_W + (size_t)l * WL_STRIDE + WL_IN + ((size_t)8728 * 1024) * 2 + q * 16) = (u32x4){0u, 0u, 0u, 0u}; }
    const float* x = a.in[I_X]; bf16_t* xb = (bf16_t*)(a.ws + WS_XB);
    for (size_t i = gt; i < (size_t)T_ * D_ / 8; i += GT) { const f32x4 v0 = *(const f32x4*)(x + i * 8), v1 = *(const f32x4*)(x + i * 8 + 4);
        u32x4 w; w.x = pk2(v0[0], v0[1]); w.y = pk2(v0[2], v0[3]); w.z = pk2(v1[0], v1[1]); w.w = pk2(v1[2], v1[3]); *(u32x4*)(xb + i * 8) = w; }
}

constexpr int TB = 32;
__device__ __forceinline__ void lru_naive(const Args& a, int l, int u, LAS unsigned char* lds, const bf16_t* proj, bf16_t* H) {
    int tid_ = threadIdx.x; asm volatile("" : "+v"(tid_)); const int tid = tid_, b = u >> 3, h = u & 7, c = tid >> 2, p = tid & 3, chg = h * 128 + c;
    const float* wa = a.in[I_LWA] + ((size_t)l * 8 + h) * 128 * 128; const float* wx = a.in[I_LWX] + ((size_t)l * 8 + h) * 128 * 128;
    float wra[32], wrx[32];
#pragma unroll
    for (int i = 0; i < 32; ++i) { wra[i] = wa[(p * 32 + i) * 128 + c]; wrx[i] = wx[(p * 32 + i) * 128 + c]; }
    const float ba = a.in[I_LBA][l * 1024 + chg], bx = a.in[I_LBX][l * 1024 + chg];
    const float sp = softplus_f(-a.in[I_LLAM][l * 1024 + chg]);
    const float* cw = a.in[I_LCW] + (size_t)l * 4 * 1024 + chg; const float cw0 = cw[0], cw1 = cw[1024], cw2 = cw[2048], cw3 = cw[3072], cb = a.in[I_LCB][l * 1024 + chg];
    LAS bf16_t* xs = (LAS bf16_t*)(lds);
    LAS bf16_t* ys = (LAS bf16_t*)(lds + 8192);
    LAS float* xa_s = (LAS float*)(lds + 16384);
    const int srow = tid >> 4, scol = (tid & 15) * 8;
    const size_t tok0 = (size_t)b * SEQ_;
    u32x4 px = *(const u32x4*)(proj + (tok0 + srow) * NPROJ + PC_LRUX + h * 128 + scol);
    u32x4 py = *(const u32x4*)(proj + (tok0 + srow) * NPROJ + PC_LRUY + h * 128 + scol);
    float hs = 0.f, x1 = 0.f, x2 = 0.f, x3 = 0.f;
    for (int blk = 0; blk < SEQ_ / TB; ++blk) {
        __syncthreads();
        *(LAS u32x4*)(xs + srow * 128 + scol) = px; *(LAS u32x4*)(ys + srow * 128 + scol) = py;
        __syncthreads();
        if (blk + 1 < SEQ_ / TB) { const size_t tk = tok0 + (size_t)(blk + 1) * TB + srow;
            px = *(const u32x4*)(proj + tk * NPROJ + PC_LRUX + h * 128 + scol); py = *(const u32x4*)(proj + tk * NPROJ + PC_LRUY + h * 128 + scol); }
        for (int s = 0; s < TB; ++s) {
            const float xraw = bf2f(xs[s * 128 + c]);
            const float xa = cw0 * x3 + cw1 * x2 + cw2 * x1 + cw3 * xraw + cb;
            x3 = x2; x2 = x1; x1 = xraw;
            LAS float* xb_ = xa_s + (s & 1) * 128;
            if (p == 0) xb_[c] = xa;
            __syncthreads();
            float sa = 0.f, sx = 0.f;
#pragma unroll
            for (int i4 = 0; i4 < 8; ++i4) { const f32x4 xv = *(const LAS f32x4*)(xb_ + p * 32 + i4 * 4);
#pragma unroll
                for (int q = 0; q < 4; ++q) { sa += xv[q] * wra[i4 * 4 + q]; sx += xv[q] * wrx[i4 * 4 + q]; } }
            sa += __shfl_xor(sa, 1); sa += __shfl_xor(sa, 2); sx += __shfl_xor(sx, 1); sx += __shfl_xor(sx, 2);
            const float r = 1.f / (1.f + expf(-(sa + ba))), ig = 1.f / (1.f + expf(-(sx + bx)));
            const float log_a = -8.0f * r * sp, av = expf(log_a), mult = sqrtf(-expm1f(2.0f * log_a));
            hs = av * hs + mult * (ig * xa);
            if (p == 0) { const float y = bf2f(ys[s * 128 + c]);
                H[(tok0 + (size_t)blk * TB + s) * 2048 + chg] = (bf16_t)f2bf(hs * gelu_tanh_f(y)); }
        }
    }
}
__device__ __forceinline__ void mlstm_naive(const Args& a, int l, int u, LAS unsigned char* lds, const bf16_t* proj, const float* gsm, bf16_t* H) {
    int tid_ = threadIdx.x; asm volatile("" : "+v"(tid_)); const int tid = tid_, lane = tid & 63, wave = tid >> 6, b = u >> 2, hd = u & 3, j = tid & 127;
    LAS float* qs = (LAS float*)(lds);
    LAS float* ks = (LAS float*)(lds + 8192);
    LAS float* vs = (LAS float*)(lds + 16384);
    LAS float* os = (LAS float*)(lds + 32768);
    LAS float* gi = (LAS float*)(lds + 49152);
    LAS float* gf = (LAS float*)(lds + 49152 + 128);
    LAS float* red = (LAS float*)(lds + 49152 + 256);
    const float ib = a.in[I_MIB][l * 4 + hd], fb = a.in[I_MFB][l * 4 + hd], gn = a.in[I_MNG][(size_t)l * 512 + hd * 128 + j];
    const size_t tok0 = (size_t)b * SEQ_;
    const int qa_row = (tid & 255) >> 3, qa_c8 = (tid & 7) * 8; const int qa_col = (tid < 256 ? PC_MLQ : PC_MLK) + hd * 64 + qa_c8;
    const int vb_row = tid >> 4, vb_c8 = (tid & 15) * 8;
    u32x4 pa, pb, pc; float pg = 0.f;
#define ML_ISSUE(blk_) do { const size_t t0 = tok0 + (size_t)(blk_) * TB; \
        pa = *(const u32x4*)(proj + (t0 + qa_row) * NPROJ + qa_col); \
        pb = *(const u32x4*)(proj + (t0 + vb_row) * NPROJ + PC_MLV + hd * 128 + vb_c8); \
        pc = *(const u32x4*)(proj + (t0 + vb_row) * NPROJ + PC_MLO + hd * 128 + vb_c8); \
        if (tid < 64) pg = gsm[(t0 + (tid & 31)) * 32 + (tid < 32 ? 0 : 4) + hd]; } while (0)
    ML_ISSUE(0);
    float C[64], n[64];
#pragma unroll
    for (int r = 0; r < 64; ++r) { C[r] = 0.f; n[r] = 0.f; }
    for (int blk = 0; blk < SEQ_ / TB; ++blk) {
        __syncthreads();
        { LAS float* d = (tid < 256 ? qs : ks) + qa_row * 64 + qa_c8;
          *(LAS f32x4*)(d) = (f32x4){bflo(pa.x), bfhi(pa.x), bflo(pa.y), bfhi(pa.y)}; *(LAS f32x4*)(d + 4) = (f32x4){bflo(pa.z), bfhi(pa.z), bflo(pa.w), bfhi(pa.w)};
          LAS float* dv = vs + vb_row * 128 + vb_c8;
          *(LAS f32x4*)(dv) = (f32x4){bflo(pb.x), bfhi(pb.x), bflo(pb.y), bfhi(pb.y)}; *(LAS f32x4*)(dv + 4) = (f32x4){bflo(pb.z), bfhi(pb.z), bflo(pb.w), bfhi(pb.w)};
          LAS float* dz = os + vb_row * 128 + vb_c8;
          *(LAS f32x4*)(dz) = (f32x4){bflo(pc.x), bfhi(pc.x), bflo(pc.y), bfhi(pc.y)}; *(LAS f32x4*)(dz + 4) = (f32x4){bflo(pc.z), bfhi(pc.z), bflo(pc.w), bfhi(pc.w)};
          if (tid < 32) gi[tid] = pg; else if (tid < 64) gf[tid - 32] = pg; }
        __syncthreads();
        if (blk + 1 < SEQ_ / TB) ML_ISSUE(blk + 1);
        for (int s = 0; s < TB; ++s) {
            float hj = 0.f;
            if (tid < 128) {
                const float f = 1.f / (1.f + expf(-(gf[s] + fb))), ie = expf(gi[s] + ib);
                const float vj = vs[s * 128 + j];
                float num = 0.f, den = 0.f;
#pragma unroll
                for (int r4 = 0; r4 < 16; ++r4) { const f32x4 kk = *(const LAS f32x4*)(ks + s * 64 + r4 * 4), qq = *(const LAS f32x4*)(qs + s * 64 + r4 * 4);
#pragma unroll
                    for (int q = 0; q < 4; ++q) { const int r = r4 * 4 + q; const float ik = ie * kk[q];
                        C[r] = f * C[r] + ik * vj; n[r] = f * n[r] + ik; num += qq[q] * C[r]; den += qq[q] * n[r]; } }
                num *= 0.125f; den *= 0.125f;
                hj = num / fmaxf(fabsf(den), 1.0f);
                const float ss = wave_sum(hj * hj);
                if (lane == 0) red[(s & 1) * 2 + wave] = ss;
            }
            __syncthreads();
            if (tid < 128) {
                const float tot = red[(s & 1) * 2] + red[(s & 1) * 2 + 1];
                const float o = hj * rsqrtf(tot * (1.0f / 128.0f) + RMS_EPS) * gn * sigmoid_f(os[s * 128 + j]);
                H[(tok0 + (size_t)blk * TB + s) * 2048 + 1024 + hd * 128 + j] = (bf16_t)f2bf(o);
            }
        }
    }
}
__device__ __forceinline__ void gdn_naive(const Args& a, int l, int u, LAS unsigned char* lds, const bf16_t* proj, const float* gsm, bf16_t* H) {
    int tid_ = threadIdx.x; asm volatile("" : "+v"(tid_)); const int tid = tid_, lane = tid & 63, b = u >> 3, hd = u & 7;
    LAS float* rq = (LAS float*)(lds);
    LAS float* rk = (LAS float*)(lds + 9216);
    LAS float* rv = (LAS float*)(lds + 18432);
    LAS float* zs = (LAS float*)(lds + 27648);
    LAS float* ga = (LAS float*)(lds + 27648 + 8192);
    LAS float* gb = ga + TB;
    const float* cw = a.in[I_GCW] + (size_t)l * 4 * 1536;
    float cq[4], ck[4], cv[4];
#pragma unroll
    for (int i = 0; i < 4; ++i) { cq[i] = cw[i * 1536 + hd * 64 + lane]; ck[i] = cw[i * 1536 + 512 + hd * 64 + lane]; cv[i] = cw[i * 1536 + 1024 + hd * 64 + lane]; }
    const float nexpA = -expf(a.in[I_GAL][l * 8 + hd]), dtb = a.in[I_GDT][l * 8 + hd], gn = a.in[I_GNG][l * 64 + lane];
    const size_t tok0 = (size_t)b * SEQ_;
    u32x4 pp[3]; float pg = 0.f;
#define GD_ISSUE(blk_) do { const int tl0 = (blk_) * TB; \
        _Pragma("unroll") for (int i = 0; i < 3; ++i) { const int pid = tid + 512 * i; pp[i] = (u32x4){0u, 0u, 0u, 0u}; \
            if (pid < 840) { const int arr = pid / 280, rem = pid % 280, row = rem >> 3, c8 = (rem & 7) * 8; const int tl = tl0 - 3 + row; \
                if (tl >= 0) pp[i] = *(const u32x4*)(proj + (tok0 + tl) * NPROJ + (arr == 0 ? PC_GDQ : (arr == 1 ? PC_GDK : PC_GDV)) + hd * 64 + c8); } \
            else if (pid < 1096) { const int zp = pid - 840, row = zp >> 3, c8 = (zp & 7) * 8; \
                pp[i] = *(const u32x4*)(proj + (tok0 + tl0 + row) * NPROJ + PC_GDZ + hd * 64 + c8); } } \
        if (tid < 64) pg = gsm[(tok0 + tl0 + (tid & 31)) * 32 + (tid < 32 ? 8 : 16) + hd]; } while (0)
    GD_ISSUE(0);
    float S[64];
#pragma unroll
    for (int i = 0; i < 64; ++i) S[i] = 0.f;
    for (int blk = 0; blk < SEQ_ / TB; ++blk) {
        __syncthreads();
#pragma unroll
        for (int i = 0; i < 3; ++i) { const int pid = tid + 512 * i; LAS float* d = nullptr;
            if (pid < 840) { const int arr = pid / 280, rem = pid % 280, row = rem >> 3, c8 = (rem & 7) * 8; d = (arr == 0 ? rq : (arr == 1 ? rk : rv)) + row * 64 + c8; }
            else if (pid < 1096) { const int zp = pid - 840, row = zp >> 3, c8 = (zp & 7) * 8; d = zs + row * 64 + c8; }
            if (pid < 1096) { const u32x4 w = pp[i];
                *(LAS f32x4*)(d) = (f32x4){bflo(w.x), bfhi(w.x), bflo(w.y), bfhi(w.y)}; *(LAS f32x4*)(d + 4) = (f32x4){bflo(w.z), bfhi(w.z), bflo(w.w), bfhi(w.w)}; } }
        if (tid < 32) ga[tid] = pg; else if (tid < 64) gb[tid - 32] = pg;
        __syncthreads();
        if (blk + 1 < SEQ_ / TB) GD_ISSUE(blk + 1);
        if (tid < 64) {
            for (int s = 0; s < TB; ++s) {
                float qv = 0.f, kv = 0.f, vv = 0.f;
#pragma unroll
                for (int i = 0; i < 4; ++i) { qv += cq[i] * rq[(s + i) * 64 + lane]; kv += ck[i] * rk[(s + i) * 64 + lane]; vv += cv[i] * rv[(s + i) * 64 + lane]; }
                qv = silu_f(qv); kv = silu_f(kv); vv = silu_f(vv);
                const float qn = qv * rsqrtf(wave_sum(qv * qv) + RMS_EPS) * 0.125f;
                const float kn = kv * rsqrtf(wave_sum(kv * kv) + RMS_EPS);
                const float g = nexpA * softplus_f(ga[s] + dtb), alpha = expf(g), beta = 1.f / (1.f + expf(-gb[s]));
                float kS = 0.f;
#pragma unroll
                for (int i = 0; i < 64; ++i) kS += __builtin_bit_cast(float, __builtin_amdgcn_readlane(__builtin_bit_cast(int, kn), i)) * S[i];
                const float dl = beta * (vv - alpha * kS);
                float o = 0.f;
#pragma unroll
                for (int i = 0; i < 64; ++i) { const float ki = __builtin_bit_cast(float, __builtin_amdgcn_readlane(__builtin_bit_cast(int, kn), i));
                    const float qi = __builtin_bit_cast(float, __builtin_amdgcn_readlane(__builtin_bit_cast(int, qn), i));
                    S[i] = alpha * S[i] + ki * dl; o += qi * S[i]; }
                const float ms = wave_sum(o * o) * (1.0f / 64.0f);
                const float out = o * rsqrtf(ms + RMS_EPS) * gn * silu_f(zs[s * 64 + lane]);
                H[(tok0 + (size_t)blk * TB + s) * 2048 + 1536 + hd * 64 + lane] = (bf16_t)f2bf(out);
            }
        }
    }
}

__device__ __forceinline__ void p5_ln1_router(const Args& a, int l, LAS unsigned char* lds, int G) {
    int tid_ = threadIdx.x; asm volatile("" : "+v"(tid_)); const int tid = tid_, lane = tid & 63, wave = tid >> 6;
    LAS float* rwT = (LAS float*)lds;
    LAS int* hist = (LAS int*)(lds + MISC_OFF);
    const float* rw = a.in[I_RW] + (size_t)l * 1024 * 32;
    for (int idx = tid; idx < 32768; idx += 512) { const int e = idx >> 10, i = idx & 1023; rwT[idx] = rw[i * 32 + e]; }
    const float* v = (const float*)(a.ws + WS_V); float* x1 = (float*)(a.ws + WS_X1); bf16_t* x1b = (bf16_t*)(a.ws + WS_X1B);
    int* tke = (int*)(a.ws + WS_TKE); float* tkw = (float*)(a.ws + WS_TKW); int* ghist = (int*)(a.ws + WS_HIST);
    f32x4 gg[4], bb[4];
#pragma unroll
    for (int j = 0; j < 4; ++j) { gg[j] = *(const f32x4*)(a.in[I_LN1G] + l * 1024 + 4 * lane + 256 * j); bb[j] = *(const f32x4*)(a.in[I_LN1B] + l * 1024 + 4 * lane + 256 * j); }
    const float rbias = lane < 32 ? a.in[I_RB][l * 32 + lane] : 0.f;
    for (int ch = blockIdx.x; ch < NCHUNK; ch += G) {
        __syncthreads();
        if (tid < 32) hist[tid] = 0;
        __syncthreads();
        for (int tt = 0; tt < 16; ++tt) {
            const size_t t = (size_t)ch * CHTOK + wave * 16 + tt;
            f32x4 xv[4]; float s = 0.f;
#pragma unroll
            for (int j = 0; j < 4; ++j) { xv[j] = *(const f32x4*)(v + t * 1024 + 4 * lane + 256 * j); s += (xv[j][0] + xv[j][1]) + (xv[j][2] + xv[j][3]); }
            const float mean = wave_sum(s) * (1.0f / 1024.0f); float s2 = 0.f;
#pragma unroll
            for (int j = 0; j < 4; ++j) { xv[j] = xv[j] - mean; s2 += (xv[j][0] * xv[j][0] + xv[j][1] * xv[j][1]) + (xv[j][2] * xv[j][2] + xv[j][3] * xv[j][3]); }
            const float rstd = rsqrtf(wave_sum(s2) * (1.0f / 1024.0f) + LN_EPS);
#pragma unroll
            for (int j = 0; j < 4; ++j) { xv[j] = xv[j] * rstd * gg[j] + bb[j];
                *(f32x4*)(x1 + t * 1024 + 4 * lane + 256 * j) = xv[j];
                u32x2 w; w.x = pk2(xv[j][0], xv[j][1]); w.y = pk2(xv[j][2], xv[j][3]); *(u32x2*)(x1b + t * 1024 + 4 * lane + 256 * j) = w; }
            float lg = 0.f;
#pragma unroll
            for (int e = 0; e < 32; ++e) { float pe = 0.f;
#pragma unroll
                for (int j = 0; j < 4; ++j) { const f32x4 w = *(const LAS f32x4*)(rwT + e * 1024 + 4 * lane + 256 * j); pe += (xv[j][0] * w[0] + xv[j][1] * w[1]) + (xv[j][2] * w[2] + xv[j][3] * w[3]); }
                pe = wave_sum(pe); if (lane == e) lg = pe; }
            float val = lane < 32 ? lg + rbias : -INFINITY;
            float tv[4]; int ti[4];
#pragma unroll
            for (int k = 0; k < 4; ++k) { const float m = wave_max(val); const unsigned long long bal = __ballot(val == m); const int idx = __ffsll((long long)bal) - 1;
                tv[k] = m; ti[k] = idx; if (lane == idx) val = -INFINITY; }
            const float e1 = expf(tv[1] - tv[0]), e2 = expf(tv[2] - tv[0]), e3 = expf(tv[3] - tv[0]); const float inv = 1.0f / (1.0f + e1 + e2 + e3);
            if (lane < 4) { const int ei = lane == 0 ? ti[0] : (lane == 1 ? ti[1] : (lane == 2 ? ti[2] : ti[3]));
                const float wi = (lane == 0 ? 1.0f : (lane == 1 ? e1 : (lane == 2 ? e2 : e3))) * inv;
                tke[t * 4 + lane] = ei; tkw[t * 4 + lane] = wi; __hip_atomic_fetch_add(&hist[ei], 1, __ATOMIC_RELAXED, __HIP_MEMORY_SCOPE_WORKGROUP); }
        }
        __syncthreads();
        if (tid < 32) ghist[ch * 32 + tid] = hist[tid];
    }
}

__device__ __forceinline__ void p6_slots(const Args& a, LAS unsigned char* lds, int G) {
    int tid_ = threadIdx.x; asm volatile("" : "+v"(tid_)); const int tid = tid_, lane = tid & 63, wave = tid >> 6;
    LAS int* hs = (LAS int*)lds;
    LAS int* cnt = (LAS int*)(lds + 32768);
    LAS int* bst = (LAS int*)(lds + 32768 + 256);
    LAS int* te = (LAS int*)(lds + 36864);
    LAS int* sl = (LAS int*)(lds + 36864 + 2048);
    const int* ghist = (const int*)(a.ws + WS_HIST);
    for (int i = tid; i < NCHUNK * 32; i += 512) hs[i] = ghist[i];
    __syncthreads();
    if (tid < 32) { int run = 0; for (int ch = 0; ch < NCHUNK; ++ch) { const int c = hs[ch * 32 + tid]; hs[ch * 32 + tid] = run; run += c; } cnt[tid] = run; }
    __syncthreads();
    if (tid == 0) { int bs = 0; for (int e = 0; e < 32; ++e) { bst[e] = bs; bs += (cnt[e] + 255) >> 8; } bst[32] = bs; }
    __syncthreads();
    if (blockIdx.x == 0 && tid <= 32) ((int*)(a.ws + WS_META))[tid] = bst[tid];
    const int* tke = (const int*)(a.ws + WS_TKE); const float* tkw = (const float*)(a.ws + WS_TKW);
    int* slot = (int*)(a.ws + WS_SLOT); float* wbuf = (float*)(a.ws + WS_WBUF);
    const bf16_t* x1b = (const bf16_t*)(a.ws + WS_X1B); bf16_t* xs = (bf16_t*)(a.ws + WS_OV + OV_XS);
    for (int ch = blockIdx.x; ch < NCHUNK; ch += G) {
        __syncthreads();
        te[tid] = tke[(size_t)ch * 512 + tid];
        __syncthreads();
        if (tid < 32) { int rank = bst[tid] * 256 + hs[ch * 32 + tid]; for (int p = 0; p < 512; ++p) if (te[p] == tid) sl[p] = rank++; }
        __syncthreads();
        { const size_t pi = (size_t)ch * 512 + tid; const int s_ = sl[tid]; slot[pi] = s_; wbuf[s_] = tkw[pi]; }
        for (int tt = 0; tt < 16; ++tt) { const int tl = wave * 16 + tt; const size_t t = (size_t)ch * CHTOK + tl;
            const u32x4 r0 = *(const u32x4*)(x1b + t * 1024 + lane * 8), r1 = *(const u32x4*)(x1b + t * 1024 + 512 + lane * 8);
#pragma unroll
            for (int k = 0; k < 4; ++k) { const size_t s_ = (size_t)sl[tl * 4 + k]; *(u32x4*)(xs + s_ * 1024 + lane * 8) = r0; *(u32x4*)(xs + s_ * 1024 + 512 + lane * 8) = r1; } }
    }
}
__device__ __forceinline__ int moe_table(const Args& a, LAS unsigned char* lds) {
    int tid_ = threadIdx.x; asm volatile("" : "+v"(tid_)); const int tid = tid_;
    LAS int* bst = (LAS int*)(lds + MISC_OFF);
    LAS int* blk_e = (LAS int*)(lds + MISC_OFF + 256);
    __syncthreads();
    if (tid <= 32) bst[tid] = ((const int*)(a.ws + WS_META))[tid];
    __syncthreads();
    const int nb = bst[32];
    for (int rb = tid; rb < nb; rb += 512) { int e = 0; while (e < 31 && rb >= bst[e + 1]) ++e; blk_e[rb] = e; }
    __syncthreads();
    return nb;
}

__device__ __forceinline__ void p9_combine_ln2(const Args& a, int l, float* xout, int G) {
    int tid_ = threadIdx.x; asm volatile("" : "+v"(tid_)); const int tid = tid_, lane = tid & 63, wave = tid >> 6;
    const float* x1 = (const float*)(a.ws + WS_X1); const int* slot = (const int*)(a.ws + WS_SLOT);
    const bf16_t* ys = (const bf16_t*)(a.ws + WS_OV + OV_YS); bf16_t* xb = (bf16_t*)(a.ws + WS_XB);
    f32x4 gg[4], bb[4];
#pragma unroll
    for (int j = 0; j < 4; ++j) { gg[j] = *(const f32x4*)(a.in[I_LN2G] + l * 1024 + 4 * lane + 256 * j); bb[j] = *(const f32x4*)(a.in[I_LN2B] + l * 1024 + 4 * lane + 256 * j); }
    for (size_t t = (size_t)blockIdx.x * NWAVES + wave; t < (size_t)T_; t += (size_t)G * NWAVES) {
        int sk[4];
#pragma unroll
        for (int k = 0; k < 4; ++k) sk[k] = slot[t * 4 + k];
        f32x4 xv[4]; float s = 0.f;
#pragma unroll
        for (int j = 0; j < 4; ++j) { xv[j] = *(const f32x4*)(x1 + t * 1024 + 4 * lane + 256 * j) * DN_ALPHA;
            f32x4 ya = (f32x4){0.f, 0.f, 0.f, 0.f};
#pragma unroll
            for (int k = 0; k < 4; ++k) { const u32x2 w = *(const u32x2*)(ys + (size_t)sk[k] * 1024 + 4 * lane + 256 * j);
                ya[0] += bflo(w.x); ya[1] += bfhi(w.x); ya[2] += bflo(w.y); ya[3] += bfhi(w.y); }
            xv[j] += ya; s += (xv[j][0] + xv[j][1]) + (xv[j][2] + xv[j][3]); }
        const float mean = wave_sum(s) * (1.0f / 1024.0f); float s2 = 0.f;
#pragma unroll
        for (int j = 0; j < 4; ++j) { xv[j] = xv[j] - mean; s2 += (xv[j][0] * xv[j][0] + xv[j][1] * xv[j][1]) + (xv[j][2] * xv[j][2] + xv[j][3] * xv[j][3]); }
        const float rstd = rsqrtf(wave_sum(s2) * (1.0f / 1024.0f) + LN_EPS);
#pragma unroll
        for (int j = 0; j < 4; ++j) { xv[j] = xv[j] * rstd * gg[j] + bb[j];
            *(f32x4*)(xout + t * 1024 + 4 * lane + 256 * j) = xv[j];
            u32x2 w; w.x = pk2(xv[j][0], xv[j][1]); w.y = pk2(xv[j][2], xv[j][3]); *(u32x2*)(xb + t * 1024 + 4 * lane + 256 * j) = w; }
    }
}
constexpr int NPH = 1 + 9 * DEPTH_;
#ifndef MK_N_LAUNCHES
#define MK_N_LAUNCHES NPH
#endif
#ifndef PG8_SP2
#define PG8_SP2 true
#endif
#ifndef PG8_ALIGN
#define PG8_ALIGN true
#endif
__global__ void __launch_bounds__(NWAVES * 64, 2) fwd(Args a) {
    extern __shared__ __attribute__((aligned(16))) unsigned char lds_raw[];
    LAS unsigned char* lds = (LAS unsigned char*)lds_raw;
    const int tid = threadIdx.x, G = gridDim.x;
    const int vcu = (G % 8 == 0) ? ((int)blockIdx.x % 8) * (G / 8) + (int)blockIdx.x / 8 : (int)blockIdx.x;
    for (int u = tid; u < (LDS_BYTES - MISC_OFF) / 4; u += NWAVES * 64) ((LAS unsigned*)(lds + MISC_OFF))[u] = 0u;
    __syncthreads();
    const int lo = a.ph_lo, hi = a.ph_hi;
    unsigned* barw = (unsigned*)(a.ws + WS_CTL) + CW_BAR + a.li * XCD_BAR_WORDS;
    XcdBarrier bar; bar.bar = barw; bar.x = 0; bar.st = nullptr;
    if (hi - lo > 1) bar = xcd_barrier_post(barw, (volatile LAS unsigned*)(lds + LDS_BYTES - 16));
#define IN(k) (lo <= (k) && (k) < hi)
#define SEAM(k) do { if (IN(k) && IN((k) + 1)) xcd_barrier(bar); } while (0)
    unsigned char* ws = a.ws;
    bf16_t* xb = (bf16_t*)(ws + WS_XB); float* gsm = (float*)(ws + WS_GSM); bf16_t* mb = (bf16_t*)(ws + WS_MB);
    float* vbuf = (float*)(ws + WS_V); bf16_t* x1b = (bf16_t*)(ws + WS_X1B); float* x2 = (float*)(ws + WS_X2);
    bf16_t* proj = (bf16_t*)(ws + WS_OV + OV_PROJ); bf16_t* Hb = (bf16_t*)(ws + WS_OV + OV_H); float* mf = (float*)(ws + WS_OV + OV_MF);
    bf16_t* xs = (bf16_t*)(ws + WS_OV + OV_XS); bf16_t* act = (bf16_t*)(ws + WS_OV + OV_ACT); bf16_t* ysb = (bf16_t*)(ws + WS_OV + OV_YS);

    if (IN(0)) p0_convert(a, lds, G);
    SEAM(0);

    for (int l = 0; l < DEPTH_; ++l) {
        const int pb = 1 + 9 * l;
        unsigned char* wl = ws + WS_W + (size_t)l * WL_STRIDE;
        const float* xin = l == 0 ? a.in[I_X] : x2; float* xout = (l == DEPTH_ - 1) ? a.out : x2;

        if (IN(pb + 0)) {
            pg8::Gemm g{xb, (const bf16_t*)(wl + WL_IN), 1024, 1024, 1024}; pg8::StaticOrder S; S.init(T_, NINP, G, (int)blockIdx.x);
            pg8::EpiProj E{proj, gsm};
            pg8::gemm_phase<pg8::EpiProj, pg8::StaticOrder, PG8_ALIGN, PG8_SP2>(lds, g, S, E);
        }
        SEAM(pb + 0);

        if (IN(pb + 1)) {
            for (int u = (int)blockIdx.x; u < 160; u += G) {
                if (u < 64) lru_naive(a, l, u, lds, proj, Hb);
                else if (u < 96) mlstm_naive(a, l, u - 64, lds, proj, gsm, Hb);
                else gdn_naive(a, l, u - 96, lds, proj, gsm, Hb);
                __syncthreads();
            }
        }
        SEAM(pb + 1);

        if (IN(pb + 2)) {
            pg8::StaticOrder S; S.init(T_, 1024, G, (int)blockIdx.x);
            { pg8::Gemm g{Hb, (const bf16_t*)(wl + WL_BR), 2048, 2048, 1024}; pg8::EpiMerge<0> E{proj, mf, mb};
              pg8::gemm_phase<pg8::EpiMerge<0>, pg8::StaticOrder, PG8_ALIGN, PG8_SP2>(lds, g, S, E); }
            { pg8::Gemm g{Hb + 1024, (const bf16_t*)(wl + WL_BR) + 1024, 2048, 2048, 512}; pg8::EpiMerge<1> E{proj, mf, mb};
              pg8::gemm_phase<pg8::EpiMerge<1>, pg8::StaticOrder, PG8_ALIGN, PG8_SP2>(lds, g, S, E); }
            { pg8::Gemm g{Hb + 1536, (const bf16_t*)(wl + WL_BR) + 1536, 2048, 2048, 512}; pg8::EpiMerge<2> E{proj, mf, mb};
              pg8::gemm_phase<pg8::EpiMerge<2>, pg8::StaticOrder, PG8_ALIGN, PG8_SP2>(lds, g, S, E); }
        }
        SEAM(pb + 2);

        if (IN(pb + 3)) {
            pg8::Gemm g{mb, (const bf16_t*)(wl + WL_OUT), 1024, 1024, 1024}; pg8::StaticOrder S; S.init(T_, 1024, G, (int)blockIdx.x);
            pg8::EpiWout E{xin, vbuf};
            pg8::gemm_phase<pg8::EpiWout, pg8::StaticOrder, PG8_ALIGN, PG8_SP2>(lds, g, S, E);
        }
        SEAM(pb + 3);

        if (IN(pb + 4)) p5_ln1_router(a, l, lds, G);
        SEAM(pb + 4);

        if (IN(pb + 5)) p6_slots(a, lds, G);
        SEAM(pb + 5);

        if (IN(pb + 6)) {
            const int nb = moe_table(a, lds);
            pg8::MoeOrder S{8, G, vcu, nb * 8, (const LAS int*)(lds + MISC_OFF + 256)};
            pg8::Gemm g{xs, (const bf16_t*)(wl + WL_W1), 1024, 1024, 1024};
            pg8::EpiMoe1 E{act, a.in[I_B1] + (size_t)l * NE * 2048};
            pg8::gemm_phase<pg8::EpiMoe1, pg8::MoeOrder, PG8_ALIGN, PG8_SP2>(lds, g, S, E);
        }
        SEAM(pb + 6);

        if (IN(pb + 7)) {
            const int nb = moe_table(a, lds);
            pg8::MoeOrder S{4, G, vcu, nb * 4, (const LAS int*)(lds + MISC_OFF + 256)};
            pg8::Gemm g{act, (const bf16_t*)(wl + WL_W2), 1024, 1024, 1024};
            pg8::EpiMoe2 E{ysb, a.in[I_B2] + (size_t)l * NE * 1024, (const float*)(ws + WS_WBUF)};
            pg8::gemm_phase<pg8::EpiMoe2, pg8::MoeOrder, PG8_ALIGN, PG8_SP2>(lds, g, S, E);
        }
        SEAM(pb + 7);

        if (IN(pb + 8)) p9_combine_ln2(a, l, xout, G);
        SEAM(pb + 8);
    }
#undef IN
#undef SEAM
}

extern "C" void kernel_launch(void* const* d_in, const int* in_sizes, int n_in, void* d_out, int out_size, void* d_ws, size_t ws_size, hipStream_t stream) {
    static int grid = 0;
    if (grid == 0) {
        if (n_in != 30 || in_sizes[0] != T_ * D_ || out_size != T_ * D_ || ws_size < WS_END) {
            fprintf(stderr, "kernel_launch: unexpected shapes: n_in %d in0 %d out %d ws %zu (need %zu); nothing launched\n", n_in, n_in > 0 ? in_sizes[0] : -1, out_size, ws_size, (size_t)WS_END); grid = -1; return; }
        int dev = 0, cus = 0;
        if (hipGetDevice(&dev) != hipSuccess || hipDeviceGetAttribute(&cus, hipDeviceAttributeMultiprocessorCount, dev) != hipSuccess) { grid = -1; return; }
        if (hipFuncSetAttribute((const void*)fwd, hipFuncAttributeMaxDynamicSharedMemorySize, LDS_BYTES) != hipSuccess) { fprintf(stderr, "kernel_launch: hipFuncSetAttribute failed\n"); grid = -1; return; }
        int per_cu = 0; (void)hipOccupancyMaxActiveBlocksPerMultiprocessor(&per_cu, (const void*)fwd, NWAVES * 64, LDS_BYTES); (void)hipGetLastError();
        if (per_cu < 1) fprintf(stderr, "kernel_launch: occupancy query reports %d blocks per CU\n", per_cu);
        grid = cus;
    }
    if (grid < 0) return;
    (void)hipMemsetAsync((char*)d_ws + WS_CTL, 0, CTL_ZERO_BYTES, stream);
    Args a{};
    for (int i = 0; i < 30; ++i) a.in[i] = (const float*)d_in[i];
    a.out = (float*)d_out; a.ws = (unsigned char*)d_ws;
    constexpr int NL = MK_N_LAUNCHES; static_assert(NL == NPH || NL <= 4, "barrier regions");
    for (int li = 0; li < NL; ++li) {
        a.ph_lo = (int)((long)NPH * li / NL); a.ph_hi = (int)((long)NPH * (li + 1) / NL); a.li = (NL <= 4) ? li : 0;
        hipLaunchKernelGGL(fwd, dim3(grid), dim3(NWAVES * 64), LDS_BYTES, stream, a);
        const hipError_t le = hipPeekAtLastError();
        if (le != hipSuccess) { fprintf(stderr, "kernel_launch: launch %d failed: %s\n", li, hipGetErrorName(le)); break; }
    }
}
```

```cpp
#include <hip/hip_runtime.h>
#include <cstdio>
#include <cstdint>

#define LAS __attribute__((address_space(3)))
#define GAS __attribute__((address_space(1)))
typedef unsigned short bf16_t;
typedef short bf16x8 __attribute__((ext_vector_type(8)));
typedef float f32x4 __attribute__((ext_vector_type(4)));
typedef float f32x2 __attribute__((ext_vector_type(2)));
typedef unsigned u32x4 __attribute__((ext_vector_type(4)));
typedef unsigned u32x2 __attribute__((ext_vector_type(2)));

constexpr int T_ = 32768, D_ = 1024, SEQ_ = 4096, NBATCH = 8, DEPTH_ = 2;
constexpr int DIN = 8728, NPROJ = 8704, NINP = 8960;
constexpr int NE = 32, DFF = 1024;
constexpr int PMAX = 139264;
constexpr int NCHUNK = 256, CHTOK = 128;
constexpr float DN_ALPHA = 1.41421356237309515f;
constexpr float LN_EPS = 1e-5f, RMS_EPS = 1e-6f;
constexpr int PC_LRUX = 0, PC_LRUY = 1024, PC_MLQ = 2048, PC_MLK = 2304, PC_MLV = 2560, PC_MLO = 3072, PC_GDQ = 3584, PC_GDK = 4096, PC_GDV = 4608, PC_GDZ = 5120, PC_GATE = 5632;

constexpr size_t MiB = 1u << 20;
constexpr size_t WS_CTL = 0, CTL_ZERO_BYTES = 64 * 1024;
constexpr size_t WS_HIST = 256 * 1024;
constexpr size_t WS_META = 320 * 1024;
constexpr size_t WS_W = 1 * MiB;
constexpr size_t WL_IN = 0, WL_BR = 18 * MiB, WL_OUT = 22 * MiB, WL_W1 = 24 * MiB, WL_W2 = 152 * MiB, WL_G = 216 * MiB, WL_STRIDE = 217 * MiB;
constexpr size_t WS_XB = 436 * MiB;
constexpr size_t WS_GSM = 501 * MiB;
constexpr size_t WS_MB = 505 * MiB;
constexpr size_t WS_V = 569 * MiB;
constexpr size_t WS_X1 = 697 * MiB;
constexpr size_t WS_X1B = 825 * MiB;
constexpr size_t WS_X2 = 890 * MiB;
constexpr size_t WS_TKE = 1018 * MiB;
constexpr size_t WS_TKW = WS_TKE + 512 * 1024;
constexpr size_t WS_SLOT = 1019 * MiB;
constexpr size_t WS_WBUF = 1020 * MiB;
constexpr size_t WS_OV = 1024 * MiB;
constexpr size_t OV_PROJ = 0, OV_H = 544 * MiB, OV_MF = 672 * MiB;
constexpr size_t OV_XS = 0, OV_ACT = 272 * MiB, OV_YS = 544 * MiB;
constexpr size_t WS_END = WS_OV + 816 * MiB;

constexpr int CW_BAR = 1024;

constexpr int RING_BYTES = 131072;
constexpr int MISC_OFF = RING_BYTES;
constexpr int LDS_BYTES = 147456;
constexpr int NWAVES = 8;

#define LDS_WAIT() asm volatile("s_waitcnt lgkmcnt(0)" ::: "memory")
#define VM_WAIT() asm volatile("s_waitcnt vmcnt(0)" ::: "memory")

__device__ __forceinline__ unsigned f2bf(float f) { unsigned u = __builtin_bit_cast(unsigned, f); return (u + 0x7fffu + ((u >> 16) & 1u)) >> 16; }
__device__ __forceinline__ unsigned pk2(float lo, float hi) { return f2bf(lo) | (f2bf(hi) << 16); }
__device__ __forceinline__ float bf2f(unsigned short b) { return __builtin_bit_cast(float, (unsigned)b << 16); }
__device__ __forceinline__ float bflo(unsigned w) { return __builtin_bit_cast(float, w << 16); }
__device__ __forceinline__ float bfhi(unsigned w) { return __builtin_bit_cast(float, w & 0xffff0000u); }
__device__ __forceinline__ float wave_sum(float v) {
#pragma unroll
    for (int o = 1; o < 64; o <<= 1) v += __shfl_xor(v, o);
    return v;
}
__device__ __forceinline__ float wave_max(float v) {
#pragma unroll
    for (int o = 1; o < 64; o <<= 1) v = fmaxf(v, __shfl_xor(v, o));
    return v;
}
__device__ __forceinline__ float sigmoid_f(float x) { return 1.f / (1.f + __expf(-x)); }
__device__ __forceinline__ float silu_f(float x) { return x / (1.f + __expf(-x)); }
__device__ __forceinline__ float softplus_f(float x) { return x > 20.f ? x : log1pf(expf(x)); }
__device__ __forceinline__ float gelu_tanh_f(float x) { const float u = 0.7978845608028654f * (x + 0.044715f * x * x * x); return 0.5f * x * (1.f + tanhf(u)); }
namespace pg8 {
#define PG8_LAS __attribute__((address_space(3)))
constexpr int BM = 256, BK = 64, HALF = 128, HTB = HALF * BK * 2  , STAGE_BYTES = 8 * HTB, NXCD = 8, WGM = 8;

__host__ __device__ __forceinline__ int lds_byte(int r, int c) { const int st = (r >> 4) * 2 + (c >> 5), rr = r & 15, cc = c & 31, ob = rr * 64 + cc * 2; return st * 1024 + (ob ^ (((ob >> 9) & 1) << 5)); }
__host__ __device__ __forceinline__ void stage_rc(int b, int& R, int& C) { const int st = b / 1024, sb = b % 1024, swz = sb ^ (((sb >> 9) & 1) << 5); R = (st >> 1) * 16 + swz / 64; C = (st & 1) * 32 + (swz % 64) / 2; }
__host__ __device__ __forceinline__ int perm32(int rho) { const int n = rho >> 4, i = rho & 15; return 8 * (i >> 2) + 4 * n + (i & 3); }

struct Unit { int pm, pn; };
struct Gemm { const bf16_t* A; const bf16_t* Bt; int lda, ldb, K; };

struct StaticOrder {
    int nM, nN, nwg, G, c;
    __host__ __device__ void init(int M, int N, int G_, int c_) { nM = M / BM; nN = N / BM; nwg = nM * nN; G = G_; c = c_; }
    __host__ __device__ bool next(int i, Unit& u) const {
        const long L = (long)i * G + c; if (L >= nwg) return false;
        int wgid = (int)L; { const int q = nwg / NXCD, r = nwg % NXCD, xcd = wgid % NXCD, off = wgid / NXCD; wgid = (xcd < r ? xcd * (q + 1) : r * (q + 1) + (xcd - r) * q) + off; }
        const int nig = WGM * nN, gid = wgid / nig, fm = gid * WGM, gsz = (nM - fm) < WGM ? (nM - fm) : WGM;
        u.pm = fm + ((wgid % nig) % gsz); u.pn = (wgid % nig) / gsz; return true;
    }
    __device__ __forceinline__ void a_ready(const Unit&) const {}
    __device__ __forceinline__ void done(const Unit&) const {}
};

__device__ __forceinline__ unsigned cvt_pk_bf16(float lo, float hi) { unsigned r; asm volatile("v_cvt_pk_bf16_f32 %0, %1, %2" : "=v"(r) : "v"(lo), "v"(hi)); return r; }

template <class Epi, class Sched, bool ALIGN_EPI = false, bool SP2 = false>
__device__ __forceinline__ void gemm_phase(PG8_LAS unsigned char* lds, const Gemm g, const Sched& S, const Epi& E) {
    int tid_ = threadIdx.x; asm volatile("" : "+v"(tid_));
    const int tid = tid_, wid = __builtin_amdgcn_readfirstlane(tid >> 6), lane = tid & 63, wr = wid >> 2, wc = wid & 3, fr = lane & 15, fq = lane >> 4;
    const int K = g.K, nt = K / BK;
    unsigned voffA[2], voffB[2];
#pragma unroll
    for (int i = 0; i < 2; ++i) { int R, C; stage_rc(tid * 16 + i * 8192, R, C); const int Rb = Epi::PERM ? ((R & ~31) + perm32(R & 31)) : R;
        voffA[i] = (unsigned)(R * g.lda + C) * 2u; voffB[i] = (unsigned)(Rb * g.ldb + C) * 2u; }
    const size_t kstep = (size_t)(BK * 2);
    const size_t hstepA = (size_t)HALF * g.lda * 2, hstepB = (size_t)HALF * g.ldb * 2;
    const size_t tstepA = 2 * hstepA, tstepB = 2 * hstepB;
    const unsigned ldsw = (unsigned)wid * 1024u;
    const int aoff = lds_byte(wr * 64 + fr, fq * 8), boff = lds_byte(wc * 32 + fr, fq * 8);
#define PG8_SA(b, h) (((b) * 2 + (h)) * HTB)
#define PG8_SB(b, h) ((4 + (b) * 2 + (h)) * HTB)
#define PG8_STAGE(bufoff, gbase, voff) do { _Pragma("unroll") for (int _i = 0; _i < 2; ++_i) \
        __builtin_amdgcn_global_load_lds((const unsigned*)((const char*)(gbase) + (voff)[_i]), (PG8_LAS unsigned*)(lds + (bufoff) + ldsw + _i * 8192), 16, 0, 0); } while (0)
#define PG8_LDA(dst, b, h) do { _Pragma("unroll") for (int m = 0; m < 4; ++m) _Pragma("unroll") for (int k = 0; k < 2; ++k) dst[m][k] = *(const PG8_LAS bf16x8*)(lds + PG8_SA(b, h) + aoff + m * 2048 + k * 1024); } while (0)
#define PG8_LDB(dst, b, h) do { _Pragma("unroll") for (int n = 0; n < 2; ++n) _Pragma("unroll") for (int k = 0; k < 2; ++k) dst[n][k] = *(const PG8_LAS bf16x8*)(lds + PG8_SB(b, h) + boff + n * 2048 + k * 1024); } while (0)
#define PG8_MMA(ai, bj, At, Bt) do { __builtin_amdgcn_s_setprio(1); _Pragma("unroll") for (int m = 0; m < 4; ++m) _Pragma("unroll") for (int n = 0; n < 2; ++n) _Pragma("unroll") for (int k = 0; k < 2; ++k) \
        acc[ai][bj][m][n] = __builtin_amdgcn_mfma_f32_16x16x32_bf16(Bt[n][k], At[m][k], acc[ai][bj][m][n], 0, 0, 0); __builtin_amdgcn_s_setprio(0); } while (0)
#define PG8_WAIT_V(n) asm volatile("s_waitcnt vmcnt(" #n ")" ::: "memory")
#define PG8_WAIT_L(n) asm volatile("s_waitcnt lgkmcnt(" #n ")" ::: "memory")
#define PG8_BAR __builtin_amdgcn_s_barrier()
#define PG8_SCHED __builtin_amdgcn_sched_barrier(0)
    Unit cur, nxt; int ui = 0;
    if (!S.next(0, cur)) return;
    f32x4 acc[2][2][4][2];
#pragma unroll
    for (int a = 0; a < 2; ++a)
#pragma unroll
        for (int b = 0; b < 2; ++b)
#pragma unroll
            for (int m = 0; m < 4; ++m)
#pragma unroll
                for (int n = 0; n < 2; ++n) acc[a][b][m][n] = (f32x4){0.f, 0.f, 0.f, 0.f};
    bf16x8 At[4][2], B0[2][2], B1[2][2];
    const char* cA = (const char*)g.A + (size_t)cur.pm * tstepA; const char* cB = (const char*)g.Bt + (size_t)cur.pn * tstepB;
    S.a_ready(cur);
    if constexpr (SP2) {
        PG8_STAGE(PG8_SB(0, 0), cB, voffB); PG8_STAGE(PG8_SB(0, 1), cB + hstepB, voffB); PG8_STAGE(PG8_SA(0, 0), cA, voffA); PG8_STAGE(PG8_SA(0, 1), cA + hstepA, voffA);
        if (wr == 1) PG8_BAR;
        PG8_WAIT_V(2); PG8_BAR;
        PG8_STAGE(PG8_SB(1, 0), cB + kstep, voffB); PG8_STAGE(PG8_SA(1, 0), cA + kstep, voffA); PG8_STAGE(PG8_SB(1, 1), cB + hstepB + kstep, voffB);
        PG8_WAIT_V(6); PG8_BAR;
    } else {
        PG8_STAGE(PG8_SB(0, 0), cB, voffB); PG8_STAGE(PG8_SA(0, 0), cA, voffA); PG8_STAGE(PG8_SB(0, 1), cB + hstepB, voffB); PG8_STAGE(PG8_SA(0, 1), cA + hstepA, voffA);
        if (wr == 1) PG8_BAR;
        PG8_WAIT_V(4); PG8_BAR;
        PG8_STAGE(PG8_SB(1, 0), cB + kstep, voffB); PG8_STAGE(PG8_SA(1, 0), cA + kstep, voffA); PG8_STAGE(PG8_SB(1, 1), cB + hstepB + kstep, voffB);
        PG8_WAIT_V(6); PG8_BAR;
    }
    for (;;) {
        const bool has_next = S.next(ui + 1, nxt);
        const char* nA = has_next ? (const char*)g.A + (size_t)nxt.pm * tstepA : cA; const char* nB = has_next ? (const char*)g.Bt + (size_t)nxt.pn * tstepB : cB;
        for (int t = 0; t < nt; t += 2) {
            const bool last = (t == nt - 2);
            const char* a1 = cA + (size_t)(t + 1) * kstep;
            const char* a2 = last ? nA : cA + (size_t)(t + 2) * kstep; const char* b2 = last ? nB : cB + (size_t)(t + 2) * kstep;
            const char* a3 = a2 + kstep; const char* b3 = b2 + kstep;
            if (last && has_next) S.a_ready(nxt);
            if constexpr (SP2) {
            PG8_LDB(B0, 0, 0); PG8_LDB(B1, 0, 1); PG8_SCHED; PG8_LDA(At, 0, 0); PG8_STAGE(PG8_SA(1, 1), a1 + hstepA, voffA);
            PG8_WAIT_V(8); PG8_WAIT_L(0); PG8_BAR; PG8_MMA(0, 0, At, B0); PG8_MMA(0, 1, At, B1); PG8_BAR; PG8_SCHED;
            PG8_LDA(At, 0, 1); PG8_STAGE(PG8_SB(0, 0), b2, voffB); PG8_STAGE(PG8_SB(0, 1), b2 + hstepB, voffB); PG8_STAGE(PG8_SA(0, 0), a2, voffA);
            PG8_WAIT_V(8); PG8_WAIT_L(0); PG8_BAR; PG8_MMA(1, 0, At, B0); PG8_MMA(1, 1, At, B1); PG8_BAR; PG8_SCHED;
            PG8_LDB(B0, 1, 0); PG8_LDB(B1, 1, 1); PG8_SCHED; PG8_LDA(At, 1, 0); PG8_STAGE(PG8_SA(0, 1), a2 + hstepA, voffA);
            PG8_WAIT_V(8); PG8_WAIT_L(0); PG8_BAR; PG8_MMA(0, 0, At, B0); PG8_MMA(0, 1, At, B1); PG8_BAR; PG8_SCHED;
            PG8_LDA(At, 1, 1); PG8_STAGE(PG8_SB(1, 0), b3, voffB); PG8_STAGE(PG8_SB(1, 1), b3 + hstepB, voffB); PG8_STAGE(PG8_SA(1, 0), a3, voffA);
            PG8_WAIT_V(8); PG8_WAIT_L(0); PG8_BAR; PG8_MMA(1, 0, At, B0); PG8_MMA(1, 1, At, B1); PG8_BAR; PG8_SCHED;
            } else {
            PG8_LDB(B0, 0, 0); PG8_SCHED; PG8_LDA(At, 0, 0); PG8_STAGE(PG8_SA(1, 1), a1 + hstepA, voffA);
            PG8_WAIT_L(8); PG8_BAR; PG8_WAIT_L(0); PG8_MMA(0, 0, At, B0); PG8_BAR; PG8_SCHED;
            PG8_LDB(B1, 0, 1); PG8_STAGE(PG8_SB(0, 0), b2, voffB);
            PG8_BAR; PG8_WAIT_L(0); PG8_MMA(0, 1, At, B1); PG8_BAR;
            PG8_LDA(At, 0, 1); PG8_STAGE(PG8_SA(0, 0), a2, voffA);
            PG8_BAR; PG8_WAIT_L(0); PG8_MMA(1, 0, At, B0); PG8_BAR; PG8_SCHED;
            PG8_STAGE(PG8_SB(0, 1), b2 + hstepB, voffB);
            PG8_WAIT_V(6); PG8_BAR; PG8_MMA(1, 1, At, B1); PG8_BAR;
            PG8_LDB(B0, 1, 0); PG8_SCHED; PG8_LDA(At, 1, 0); PG8_STAGE(PG8_SA(0, 1), a2 + hstepA, voffA);
            PG8_WAIT_L(8); PG8_BAR; PG8_WAIT_L(0); PG8_MMA(0, 0, At, B0); PG8_BAR; PG8_SCHED;
            PG8_LDB(B1, 1, 1); PG8_STAGE(PG8_SB(1, 0), b3, voffB);
            PG8_BAR; PG8_WAIT_L(0); PG8_MMA(0, 1, At, B1); PG8_BAR;
            PG8_LDA(At, 1, 1); PG8_STAGE(PG8_SA(1, 0), a3, voffA);
            PG8_BAR; PG8_WAIT_L(0); PG8_MMA(1, 0, At, B0); PG8_BAR; PG8_SCHED;
            PG8_STAGE(PG8_SB(1, 1), b3 + hstepB, voffB);
            PG8_WAIT_V(6); PG8_BAR; PG8_MMA(1, 1, At, B1); PG8_BAR;
            }
        }
        if constexpr (ALIGN_EPI) { if (wr == 0) PG8_BAR; }
        E(acc, cur, wr, wc, fr, fq); S.done(cur);
        if (!has_next) break;
#pragma unroll
        for (int a = 0; a < 2; ++a)
#pragma unroll
            for (int b = 0; b < 2; ++b)
#pragma unroll
                for (int m = 0; m < 4; ++m)
#pragma unroll
                    for (int n = 0; n < 2; ++n) acc[a][b][m][n] = (f32x4){0.f, 0.f, 0.f, 0.f};
        cur = nxt; cA = nA; cB = nB; ++ui;
        if constexpr (ALIGN_EPI) { if (wr == 1) PG8_BAR; }
    }
    PG8_WAIT_V(0);
    if constexpr (!ALIGN_EPI) { if (wr == 0) PG8_BAR; }
    PG8_BAR;
#undef PG8_SA
#undef PG8_SB
#undef PG8_STAGE
#undef PG8_LDA
#undef PG8_LDB
#undef PG8_MMA
#undef PG8_WAIT_V
#undef PG8_WAIT_L
#undef PG8_BAR
#undef PG8_SCHED
}
}
#define XB_TMO      128
#define XB_XCNT(j)  (256  + 64 * (j))
#define XB_XSUB(j)  (1280 + 64 * (j))
#define XB_XGEN(j)  (2304 + 64 * (j))
#define XB_TOP      3328
#define XB_TOPGEN   3392
#define XCD_BAR_WORDS 3456
#define XB_SPIN_CAP (1u << 18)

__device__ __forceinline__ unsigned xb_ld(unsigned* p)              { return __hip_atomic_load(p, __ATOMIC_RELAXED, __HIP_MEMORY_SCOPE_AGENT); }
__device__ __forceinline__ unsigned xb_add(unsigned* p, unsigned v) { return __hip_atomic_fetch_add(p, v, __ATOMIC_RELAXED, __HIP_MEMORY_SCOPE_AGENT); }
__device__ __forceinline__ unsigned xb_xcc_id() { return (unsigned)__builtin_amdgcn_s_getreg((3 << 11) | 20) & 0xFu; }
#define XB_SPIN(cond, bar) do { unsigned _sp = 0; while (cond) { __builtin_amdgcn_s_sleep(1); \
    if ((++_sp & 255u) == 0u) { if (xb_ld(&(bar)[XB_TMO])) break; if (_sp > XB_SPIN_CAP) { atomicAdd(&(bar)[XB_TMO], 1u); break; } } } } while (0)

struct XcdBarrier {
    unsigned* bar; unsigned x;
    volatile LAS unsigned* st;
};

__device__ __forceinline__ XcdBarrier xcd_barrier_post(unsigned* bar, volatile LAS unsigned* st) {
    XcdBarrier b; b.bar = bar; b.x = xb_xcc_id(); b.st = st;
    if (threadIdx.x == 0) (void)xb_add(&bar[XB_XCNT(b.x)], 1u);
    return b;
}
__device__ __forceinline__ void xcd_barrier_complete(unsigned* bar, unsigned x, unsigned& nloc, unsigned& nx) {
    const unsigned G = gridDim.x * gridDim.y * gridDim.z;
    unsigned sum, cnt, mine, sp = 0u;
    for (;;) {
        sum = 0u; cnt = 0u; mine = 0u;
#pragma unroll
        for (unsigned j = 0; j < 16; ++j) { const unsigned c = xb_ld(&bar[XB_XCNT(j)]); sum += c; cnt += (c > 0u) ? 1u : 0u; mine = (j == x) ? c : mine; }
        if (sum == G) break;
        __builtin_amdgcn_s_sleep(1);
        if ((++sp & 255u) == 0u) { if (xb_ld(&bar[XB_TMO])) break; if (sp > XB_SPIN_CAP) { atomicAdd(&bar[XB_TMO], 1u); break; } }
    }
    nloc = mine > 0u ? mine : 1u; nx = cnt > 0u ? cnt : 1u;
}

__device__ __forceinline__ void xcd_barrier(const XcdBarrier& b) {
    asm volatile("s_waitcnt vmcnt(0)" ::: "memory");
    __syncthreads();
    if (threadIdx.x == 0) {
        unsigned* bar = b.bar;
        __builtin_amdgcn_s_waitcnt(0);
        unsigned nloc = b.st[0], nx = b.st[1];
        if (nloc == 0u) { xcd_barrier_complete(bar, b.x, nloc, nx); b.st[0] = nloc; b.st[1] = nx; }
        const unsigned old = xb_add(&bar[XB_XSUB(b.x)], 1u);
        const unsigned gen = old / nloc;
        if (old + 1u == (gen + 1u) * nloc) {
            __builtin_amdgcn_fence(__ATOMIC_RELEASE, "agent");
            asm volatile("s_waitcnt vmcnt(0)" ::: "memory");
            const unsigned og = xb_add(&bar[XB_TOP], 1u);
            const unsigned tg = og / nx;
            if (og + 1u == (tg + 1u) * nx) xb_add(&bar[XB_TOPGEN], 1u);
            else XB_SPIN(xb_ld(&bar[XB_TOPGEN]) == tg, bar);
            __builtin_amdgcn_fence(__ATOMIC_ACQUIRE, "agent");
            xb_add(&bar[XB_XGEN(b.x)], 1u);
            asm volatile("s_waitcnt vmcnt(0)" ::: "memory");
        } else {
            XB_SPIN(xb_ld(&bar[XB_XGEN(b.x)]) == gen, bar);
            __builtin_amdgcn_fence(__ATOMIC_ACQUIRE, "agent");
            asm volatile("s_waitcnt vmcnt(0)" ::: "memory");
        }
    }
    __syncthreads();
}
namespace pg8 {
struct EpiProj {
    static constexpr bool PERM = true;
    bf16_t* proj; float* gsm;
    __device__ __forceinline__ void operator()(const f32x4 (&acc)[2][2][4][2], const Unit& u, int wr, int wc, int fr, int fq) const {
        const int row0 = u.pm * BM + wr * 64 + fr;
        if (u.pn < 34) {
            const int col0 = u.pn * BM + wc * 32 + 8 * fq;
#pragma unroll
            for (int ai = 0; ai < 2; ++ai)
#pragma unroll
                for (int m = 0; m < 4; ++m) { bf16_t* rowp = proj + (size_t)(row0 + ai * HALF + m * 16) * NPROJ + col0;
#pragma unroll
                    for (int bj = 0; bj < 2; ++bj) { const f32x4 v0 = acc[ai][bj][m][0], v1 = acc[ai][bj][m][1];
                        u32x4 w; w.x = cvt_pk_bf16(v0[0], v0[1]); w.y = cvt_pk_bf16(v0[2], v0[3]); w.z = cvt_pk_bf16(v1[0], v1[1]); w.w = cvt_pk_bf16(v1[2], v1[3]);
                        *(u32x4*)(rowp + bj * HALF) = w; } }
        } else if (wc == 0 && fq < 3) {
#pragma unroll
            for (int ai = 0; ai < 2; ++ai)
#pragma unroll
                for (int m = 0; m < 4; ++m) { float* rowp = gsm + (size_t)(row0 + ai * HALF + m * 16) * 32 + 8 * fq;
                    *(f32x4*)(rowp) = acc[ai][0][m][0]; *(f32x4*)(rowp + 4) = acc[ai][0][m][1]; }
        }
    }
};
template <int STAGE> struct EpiMerge {
    static constexpr bool PERM = true;
    const bf16_t* proj; float* mf; bf16_t* mb;
    __device__ __forceinline__ void operator()(const f32x4 (&acc)[2][2][4][2], const Unit& u, int wr, int wc, int fr, int fq) const {
        const int row0 = u.pm * BM + wr * 64 + fr, col0 = u.pn * BM + wc * 32 + 8 * fq;
#pragma unroll
        for (int ai = 0; ai < 2; ++ai)
#pragma unroll
            for (int m = 0; m < 4; ++m) { const size_t row = (size_t)(row0 + ai * HALF + m * 16);
#pragma unroll
                for (int bj = 0; bj < 2; ++bj) { const int col = col0 + bj * HALF;
                    const u32x4 gw = *(const u32x4*)(proj + row * NPROJ + PC_GATE + STAGE * 1024 + col);
                    f32x4 g0, g1;
                    g0[0] = sigmoid_f(bflo(gw.x)); g0[1] = sigmoid_f(bfhi(gw.x)); g0[2] = sigmoid_f(bflo(gw.y)); g0[3] = sigmoid_f(bfhi(gw.y));
                    g1[0] = sigmoid_f(bflo(gw.z)); g1[1] = sigmoid_f(bfhi(gw.z)); g1[2] = sigmoid_f(bflo(gw.w)); g1[3] = sigmoid_f(bfhi(gw.w));
                    f32x4 v0 = acc[ai][bj][m][0] * g0, v1 = acc[ai][bj][m][1] * g1;
                    float* mp = mf + row * 1024 + col;
                    if (STAGE > 0) { v0 += *(const f32x4*)(mp); v1 += *(const f32x4*)(mp + 4); }
                    if (STAGE < 2) { *(f32x4*)(mp) = v0; *(f32x4*)(mp + 4) = v1; }
                    else { u32x4 w; w.x = cvt_pk_bf16(v0[0], v0[1]); w.y = cvt_pk_bf16(v0[2], v0[3]); w.z = cvt_pk_bf16(v1[0], v1[1]); w.w = cvt_pk_bf16(v1[2], v1[3]);
                        *(u32x4*)(mb + row * 1024 + col) = w; } } }
    }
};
struct EpiWout {
    static constexpr bool PERM = false;
    const float* x; float* v;
    __device__ __forceinline__ void operator()(const f32x4 (&acc)[2][2][4][2], const Unit& u, int wr, int wc, int fr, int fq) const {
        const int row0 = u.pm * BM + wr * 64 + fr, col0 = u.pn * BM + wc * 32 + 4 * fq;
#pragma unroll
        for (int ai = 0; ai < 2; ++ai)
#pragma unroll
            for (int m = 0; m < 4; ++m) { const size_t off = (size_t)(row0 + ai * HALF + m * 16) * 1024 + col0;
#pragma unroll
                for (int bj = 0; bj < 2; ++bj)
#pragma unroll
                    for (int n = 0; n < 2; ++n) { const f32x4 xv = *(const f32x4*)(x + off + bj * HALF + n * 16);
                        *(f32x4*)(v + off + bj * HALF + n * 16) = xv * DN_ALPHA + acc[ai][bj][m][n]; } }
    }
};
struct EpiMoe1 {
    static constexpr bool PERM = true;
    bf16_t* act; const float* b1;
    __device__ __forceinline__ void operator()(const f32x4 (&acc)[2][2][4][2], const Unit& u, int wr, int wc, int fr, int fq) const {
        const int e = u.pn >> 3, tl = u.pn & 7;
        const int row0 = u.pm * BM + wr * 64 + fr, col0 = tl * 128 + wc * 32 + 8 * fq;
        const float* bp = b1 + (size_t)e * 2048 + col0;
        const f32x4 bg0 = *(const f32x4*)(bp), bg1 = *(const f32x4*)(bp + 4), bl0 = *(const f32x4*)(bp + 1024), bl1 = *(const f32x4*)(bp + 1028);
#pragma unroll
        for (int ai = 0; ai < 2; ++ai)
#pragma unroll
            for (int m = 0; m < 4; ++m) { bf16_t* rowp = act + (size_t)(row0 + ai * HALF + m * 16) * 1024 + col0;
                f32x4 o[2];
#pragma unroll
                for (int n = 0; n < 2; ++n) { const f32x4 gg = acc[ai][0][m][n] + (n ? bg1 : bg0), ll = acc[ai][1][m][n] + (n ? bl1 : bl0);
#pragma unroll
                    for (int q = 0; q < 4; ++q) { const float gv = fminf(gg[q], 7.0f), lv = fminf(fmaxf(ll[q], -7.0f), 7.0f);
                        o[n][q] = gv * sigmoid_f(1.702f * gv) * (lv + 1.0f); } }
                u32x4 w; w.x = cvt_pk_bf16(o[0][0], o[0][1]); w.y = cvt_pk_bf16(o[0][2], o[0][3]); w.z = cvt_pk_bf16(o[1][0], o[1][1]); w.w = cvt_pk_bf16(o[1][2], o[1][3]);
                *(u32x4*)(rowp) = w; }
    }
};
struct EpiMoe2 {
    static constexpr bool PERM = true;
    bf16_t* ys; const float* b2; const float* wbuf;
    __device__ __forceinline__ void operator()(const f32x4 (&acc)[2][2][4][2], const Unit& u, int wr, int wc, int fr, int fq) const {
        const int e = u.pn >> 2, tl = u.pn & 3;
        const int row0 = u.pm * BM + wr * 64 + fr, col0 = tl * 256 + wc * 32 + 8 * fq;
        const float* bp = b2 + (size_t)e * 1024 + col0;
        f32x4 bv[2][2];
#pragma unroll
        for (int bj = 0; bj < 2; ++bj) { bv[bj][0] = *(const f32x4*)(bp + bj * HALF); bv[bj][1] = *(const f32x4*)(bp + bj * HALF + 4); }
#pragma unroll
        for (int ai = 0; ai < 2; ++ai)
#pragma unroll
            for (int m = 0; m < 4; ++m) { const int row = row0 + ai * HALF + m * 16; const float ww = wbuf[row]; bf16_t* rowp = ys + (size_t)row * 1024 + col0;
#pragma unroll
                for (int bj = 0; bj < 2; ++bj) { const f32x4 v0 = (acc[ai][bj][m][0] + bv[bj][0]) * ww, v1 = (acc[ai][bj][m][1] + bv[bj][1]) * ww;
                    u32x4 w; w.x = cvt_pk_bf16(v0[0], v0[1]); w.y = cvt_pk_bf16(v0[2], v0[3]); w.z = cvt_pk_bf16(v1[0], v1[1]); w.w = cvt_pk_bf16(v1[2], v1[3]);
                    *(u32x4*)(rowp + bj * HALF) = w; } }
    }
};
struct MoeOrder {
    int nN, G, c, total; const LAS int* blk_e;
    __device__ __forceinline__ bool next(int i, Unit& u) const {
        const long L = (long)i * G + c; if (L >= total) return false;
        const int rb = (int)(L / nN), tl = (int)(L % nN); u.pm = rb; u.pn = blk_e[rb] * nN + tl; return true;
    }
    __device__ __forceinline__ void a_ready(const Unit&) const {}
    __device__ __forceinline__ void done(const Unit&) const {}
};
}
struct Args { const float* in[30]; float* out; unsigned char* ws; int ph_lo, ph_hi, li, pad; };
enum { I_X = 0, I_WIN, I_LCW, I_LCB, I_LWA, I_LBA, I_LWX, I_LBX, I_LLAM, I_MIB, I_MFB, I_MNG, I_GCW, I_GAL, I_GDT, I_GNG, I_WBA, I_WBB, I_WBC, I_WOUT, I_LN1G, I_LN1B, I_RW, I_RB, I_W1, I_B1, I_W2, I_B2, I_LN2G, I_LN2B };

template <int MODE> __device__ __forceinline__ int col_map(int n) {
    if (MODE == 1) {
        if (n < 3072) return n;
        if (n < 3076) return 8704 + (n - 3072);
        if (n < 3080) return 8708 + (n - 3076);
        if (n < 5128) return n - 8;
        if (n < 5136) return 8712 + (n - 5128);
        if (n < 5144) return 8720 + (n - 5136);
        return n - 24;
    } else if (MODE == 2) {
        if (n < 1024) return (n >> 7) * 256 + (n & 127);
        const int q = n - 1024; return (q >> 7) * 256 + 128 + (q & 127);
    }
    return n;
}
template <int MODE> __device__ __forceinline__ void transpose_item(const float* W, int N, bf16_t* WT, int ldk, int koff, LAS float* scr, int kb, int nb, int lane) {
    const int k0 = 64 * kb, n0 = 32 * nb; const int nsrc = n0 + (lane & 31);
#pragma unroll 8
    for (int i = 0; i < 32; ++i) { const int kk = 2 * i + (lane >> 5); scr[kk * 33 + (lane & 31)] = (nsrc < N) ? W[(size_t)(k0 + kk) * N + nsrc] : 0.f; }
    LDS_WAIT(); asm volatile("" ::: "memory");
    const int c = lane & 7;
#pragma unroll
    for (int j = 0; j < 4; ++j) { const int nl = (lane >> 3) + 8 * j, n = n0 + nl; const LAS float* s = scr + (8 * c) * 33 + nl;
        u32x4 o; o.x = pk2(s[0 * 33], s[1 * 33]); o.y = pk2(s[2 * 33], s[3 * 33]); o.z = pk2(s[4 * 33], s[5 * 33]); o.w = pk2(s[6 * 33], s[7 * 33]);
        if (n < N) *(u32x4*)(WT + (size_t)col_map<MODE>(n) * ldk + koff + k0 + 8 * c) = o; }
    LDS_WAIT(); asm volatile("" ::: "memory");
}
constexpr int IT_IN = 16 * 273, IT_BRA = 16 * 32, IT_BRB = 8 * 32, IT_BRC = 8 * 32, IT_OUT = 16 * 32, IT_W1 = 32 * 16 * 64, IT_W2 = 32 * 16 * 32;
constexpr int IT_LAYER = IT_IN + IT_BRA + IT_BRB + IT_BRC + IT_OUT + IT_W1 + IT_W2;
__device__ __forceinline__ void p0_convert(const Args& a, LAS unsigned char* lds, int G) {
    int tid_ = threadIdx.x; asm volatile("" : "+v"(tid_)); const int tid = tid_, lane = tid & 63, wave = tid >> 6;
    LAS float* scr = (LAS float*)(lds + wave * 16384);
    const int gw = blockIdx.x * NWAVES + wave, NGW = G * NWAVES;
    for (int it = gw; it < 2 * IT_LAYER; it += NGW) {
        const int l = it / IT_LAYER; int r = it - l * IT_LAYER;
        unsigned char* wl = a.ws + WS_W + (size_t)l * WL_STRIDE;
        if (r < IT_IN) { transpose_item<1>(a.in[I_WIN] + (size_t)l * 1024 * DIN, DIN, (bf16_t*)(wl + WL_IN), 1024, 0, scr, r / 273, r % 273, lane); continue; } r -= IT_IN;
        if (r < IT_BRA) { transpose_item<0>(a.in[I_WBA] + (size_t)l * 1024 * 1024, 1024, (bf16_t*)(wl + WL_BR), 2048, 0, scr, r / 32, r % 32, lane); continue; } r -= IT_BRA;
        if (r < IT_BRB) { transpose_item<0>(a.in[I_WBB] + (size_t)l * 512 * 1024, 1024, (bf16_t*)(wl + WL_BR), 2048, 1024, scr, r / 32, r % 32, lane); continue; } r -= IT_BRB;
        if (r < IT_BRC) { transpose_item<0>(a.in[I_WBC] + (size_t)l * 512 * 1024, 1024, (bf16_t*)(wl + WL_BR), 2048, 1536, scr, r / 32, r % 32, lane); continue; } r -= IT_BRC;
        if (r < IT_OUT) { transpose_item<0>(a.in[I_WOUT] + (size_t)l * 1024 * 1024, 1024, (bf16_t*)(wl + WL_OUT), 1024, 0, scr, r / 32, r % 32, lane); continue; } r -= IT_OUT;
        if (r < IT_W1) { const int e = r / 1024, q = r % 1024;
            transpose_item<2>(a.in[I_W1] + ((size_t)l * NE + e) * 1024 * 2048, 2048, (bf16_t*)(wl + WL_W1) + (size_t)e * 2048 * 1024, 1024, 0, scr, q / 64, q % 64, lane); continue; } r -= IT_W1;
        { const int e = r / 512, q = r % 512;
            transpose_item<0>(a.in[I_W2] + ((size_t)l * NE + e) * 1024 * 1024, 1024, (bf16_t*)(wl + WL_W2) + (size_t)e * 1024 * 1024, 1024, 0, scr, q / 32, q % 32, lane); }
    }
    const size_t gt = (size_t)blockIdx.x * 512 + tid, GT = (size_t)G * 512;
    for (size_t i = gt; i < (size_t)2 * 232 * 128; i += GT) { const int l = (int)(i / (232 * 128)); const size_t q = i % (232 * 128);
        *(u32x4*)(a.ws + WS_W + (size_t)l * WL_STRIDE + WL_IN + ((size_t)8728 * 1024) * 2 + q * 16) = (u32x4){0u, 0u, 0u, 0u}; }
    const float* x = a.in[I_X]; bf16_t* xb = (bf16_t*)(a.ws + WS_XB);
    for (size_t i = gt; i < (size_t)T_ * D_ / 8; i += GT) { const f32x4 v0 = *(const f32x4*)(x + i * 8), v1 = *(const f32x4*)(x + i * 8 + 4);
        u32x4 w; w.x = pk2(v0[0], v0[1]); w.y = pk2(v0[2], v0[3]); w.z = pk2(v1[0], v1[1]); w.w = pk2(v1[2], v1[3]); *(u32x4*)(xb + i * 8) = w; }
}

constexpr int TB = 32;
__device__ __forceinline__ void lru_naive(const Args& a, int l, int u, LAS unsigned char* lds, const bf16_t* proj, bf16_t* H) {
    int tid_ = threadIdx.x; asm volatile("" : "+v"(tid_)); const int tid = tid_, b = u >> 3, h = u & 7, c = tid >> 2, p = tid & 3, chg = h * 128 + c;
    const float* wa = a.in[I_LWA] + ((size_t)l * 8 + h) * 128 * 128; const float* wx = a.in[I_LWX] + ((size_t)l * 8 + h) * 128 * 128;
    float wra[32], wrx[32];
#pragma unroll
    for (int i = 0; i < 32; ++i) { wra[i] = wa[(p * 32 + i) * 128 + c]; wrx[i] = wx[(p * 32 + i) * 128 + c]; }
    const float ba = a.in[I_LBA][l * 1024 + chg], bx = a.in[I_LBX][l * 1024 + chg];
    const float sp = softplus_f(-a.in[I_LLAM][l * 1024 + chg]);
    const float* cw = a.in[I_LCW] + (size_t)l * 4 * 1024 + chg; const float cw0 = cw[0], cw1 = cw[1024], cw2 = cw[2048], cw3 = cw[3072], cb = a.in[I_LCB][l * 1024 + chg];
    LAS bf16_t* xs = (LAS bf16_t*)(lds);
    LAS bf16_t* ys = (LAS bf16_t*)(lds + 8192);
    LAS float* xa_s = (LAS float*)(lds + 16384);
    const int srow = tid >> 4, scol = (tid & 15) * 8;
    const size_t tok0 = (size_t)b * SEQ_;
    u32x4 px = *(const u32x4*)(proj + (tok0 + srow) * NPROJ + PC_LRUX + h * 128 + scol);
    u32x4 py = *(const u32x4*)(proj + (tok0 + srow) * NPROJ + PC_LRUY + h * 128 + scol);
    float hs = 0.f, x1 = 0.f, x2 = 0.f, x3 = 0.f;
    for (int blk = 0; blk < SEQ_ / TB; ++blk) {
        __syncthreads();
        *(LAS u32x4*)(xs + srow * 128 + scol) = px; *(LAS u32x4*)(ys + srow * 128 + scol) = py;
        __syncthreads();
        if (blk + 1 < SEQ_ / TB) { const size_t tk = tok0 + (size_t)(blk + 1) * TB + srow;
            px = *(const u32x4*)(proj + tk * NPROJ + PC_LRUX + h * 128 + scol); py = *(const u32x4*)(proj + tk * NPROJ + PC_LRUY + h * 128 + scol); }
        for (int s = 0; s < TB; ++s) {
            const float xraw = bf2f(xs[s * 128 + c]);
            const float xa = cw0 * x3 + cw1 * x2 + cw2 * x1 + cw3 * xraw + cb;
            x3 = x2; x2 = x1; x1 = xraw;
            LAS float* xb_ = xa_s + (s & 1) * 128;
            if (p == 0) xb_[c] = xa;
            __syncthreads();
            float sa = 0.f, sx = 0.f;
#pragma unroll
            for (int i4 = 0; i4 < 8; ++i4) { const f32x4 xv = *(const LAS f32x4*)(xb_ + p * 32 + i4 * 4);
#pragma unroll
                for (int q = 0; q < 4; ++q) { sa += xv[q] * wra[i4 * 4 + q]; sx += xv[q] * wrx[i4 * 4 + q]; } }
            sa += __shfl_xor(sa, 1); sa += __shfl_xor(sa, 2); sx += __shfl_xor(sx, 1); sx += __shfl_xor(sx, 2);
            const float r = 1.f / (1.f + expf(-(sa + ba))), ig = 1.f / (1.f + expf(-(sx + bx)));
            const float log_a = -8.0f * r * sp, av = expf(log_a), mult = sqrtf(-expm1f(2.0f * log_a));
            hs = av * hs + mult * (ig * xa);
            if (p == 0) { const float y = bf2f(ys[s * 128 + c]);
                H[(tok0 + (size_t)blk * TB + s) * 2048 + chg] = (bf16_t)f2bf(hs * gelu_tanh_f(y)); }
        }
    }
}
__device__ __forceinline__ void mlstm_naive(const Args& a, int l, int u, LAS unsigned char* lds, const bf16_t* proj, const float* gsm, bf16_t* H) {
    int tid_ = threadIdx.x; asm volatile("" : "+v"(tid_)); const int tid = tid_, lane = tid & 63, wave = tid >> 6, b = u >> 2, hd = u & 3, j = tid & 127;
    LAS float* qs = (LAS float*)(lds);
    LAS float* ks = (LAS float*)(lds + 8192);
    LAS float* vs = (LAS float*)(lds + 16384);
    LAS float* os = (LAS float*)(lds + 32768);
    LAS float* gi = (LAS float*)(lds + 49152);
    LAS float* gf = (LAS float*)(lds + 49152 + 128);
    LAS float* red = (LAS float*)(lds + 49152 + 256);
    const float ib = a.in[I_MIB][l * 4 + hd], fb = a.in[I_MFB][l * 4 + hd], gn = a.in[I_MNG][(size_t)l * 512 + hd * 128 + j];
    const size_t tok0 = (size_t)b * SEQ_;
    const int qa_row = (tid & 255) >> 3, qa_c8 = (tid & 7) * 8; const int qa_col = (tid < 256 ? PC_MLQ : PC_MLK) + hd * 64 + qa_c8;
    const int vb_row = tid >> 4, vb_c8 = (tid & 15) * 8;
    u32x4 pa, pb, pc; float pg = 0.f;
#define ML_ISSUE(blk_) do { const size_t t0 = tok0 + (size_t)(blk_) * TB; \
        pa = *(const u32x4*)(proj + (t0 + qa_row) * NPROJ + qa_col); \
        pb = *(const u32x4*)(proj + (t0 + vb_row) * NPROJ + PC_MLV + hd * 128 + vb_c8); \
        pc = *(const u32x4*)(proj + (t0 + vb_row) * NPROJ + PC_MLO + hd * 128 + vb_c8); \
        if (tid < 64) pg = gsm[(t0 + (tid & 31)) * 32 + (tid < 32 ? 0 : 4) + hd]; } while (0)
    ML_ISSUE(0);
    float C[64], n[64];
#pragma unroll
    for (int r = 0; r < 64; ++r) { C[r] = 0.f; n[r] = 0.f; }
    for (int blk = 0; blk < SEQ_ / TB; ++blk) {
        __syncthreads();
        { LAS float* d = (tid < 256 ? qs : ks) + qa_row * 64 + qa_c8;
          *(LAS f32x4*)(d) = (f32x4){bflo(pa.x), bfhi(pa.x), bflo(pa.y), bfhi(pa.y)}; *(LAS f32x4*)(d + 4) = (f32x4){bflo(pa.z), bfhi(pa.z), bflo(pa.w), bfhi(pa.w)};
          LAS float* dv = vs + vb_row * 128 + vb_c8;
          *(LAS f32x4*)(dv) = (f32x4){bflo(pb.x), bfhi(pb.x), bflo(pb.y), bfhi(pb.y)}; *(LAS f32x4*)(dv + 4) = (f32x4){bflo(pb.z), bfhi(pb.z), bflo(pb.w), bfhi(pb.w)};
          LAS float* dz = os + vb_row * 128 + vb_c8;
          *(LAS f32x4*)(dz) = (f32x4){bflo(pc.x), bfhi(pc.x), bflo(pc.y), bfhi(pc.y)}; *(LAS f32x4*)(dz + 4) = (f32x4){bflo(pc.z), bfhi(pc.z), bflo(pc.w), bfhi(pc.w)};
          if (tid < 32) gi[tid] = pg; else if (tid < 64) gf[tid - 32] = pg; }
        __syncthreads();
        if (blk + 1 < SEQ_ / TB) ML_ISSUE(blk + 1);
        for (int s = 0; s < TB; ++s) {
            float hj = 0.f;
            if (tid < 128) {
                const float f = 1.f / (1.f + expf(-(gf[s] + fb))), ie = expf(gi[s] + ib);
                const float vj = vs[s * 128 + j];
                float num = 0.f, den = 0.f;
#pragma unroll
                for (int r4 = 0; r4 < 16; ++r4) { const f32x4 kk = *(const LAS f32x4*)(ks + s * 64 + r4 * 4), qq = *(const LAS f32x4*)(qs + s * 64 + r4 * 4);
#pragma unroll
                    for (int q = 0; q < 4; ++q) { const int r = r4 * 4 + q; const float ik = ie * kk[q];
                        C[r] = f * C[r] + ik * vj; n[r] = f * n[r] + ik; num += qq[q] * C[r]; den += qq[q] * n[r]; } }
                num *= 0.125f; den *= 0.125f;
                hj = num / fmaxf(fabsf(den), 1.0f);
                const float ss = wave_sum(hj * hj);
                if (lane == 0) red[(s & 1) * 2 + wave] = ss;
            }
            __syncthreads();
            if (tid < 128) {
                const float tot = red[(s & 1) * 2] + red[(s & 1) * 2 + 1];
                const float o = hj * rsqrtf(tot * (1.0f / 128.0f) + RMS_EPS) * gn * sigmoid_f(os[s * 128 + j]);
                H[(tok0 + (size_t)blk * TB + s) * 2048 + 1024 + hd * 128 + j] = (bf16_t)f2bf(o);
            }
        }
    }
}
__device__ __forceinline__ void gdn_naive(const Args& a, int l, int u, LAS unsigned char* lds, const bf16_t* proj, const float* gsm, bf16_t* H) {
    int tid_ = threadIdx.x; asm volatile("" : "+v"(tid_)); const int tid = tid_, lane = tid & 63, b = u >> 3, hd = u & 7;
    LAS float* rq = (LAS float*)(lds);
    LAS float* rk = (LAS float*)(lds + 9216);
    LAS float* rv = (LAS float*)(lds + 18432);
    LAS float* zs = (LAS float*)(lds + 27648);
    LAS float* ga = (LAS float*)(lds + 27648 + 8192);
    LAS float* gb = ga + TB;
    const float* cw = a.in[I_GCW] + (size_t)l * 4 * 1536;
    float cq[4], ck[4], cv[4];
#pragma unroll
    for (int i = 0; i < 4; ++i) { cq[i] = cw[i * 1536 + hd * 64 + lane]; ck[i] = cw[i * 1536 + 512 + hd * 64 + lane]; cv[i] = cw[i * 1536 + 1024 + hd * 64 + lane]; }
    const float nexpA = -expf(a.in[I_GAL][l * 8 + hd]), dtb = a.in[I_GDT][l * 8 + hd], gn = a.in[I_GNG][l * 64 + lane];
    const size_t tok0 = (size_t)b * SEQ_;
    u32x4 pp[3]; float pg = 0.f;
#define GD_ISSUE(blk_) do { const int tl0 = (blk_) * TB; \
        _Pragma("unroll") for (int i = 0; i < 3; ++i) { const int pid = tid + 512 * i; pp[i] = (u32x4){0u, 0u, 0u, 0u}; \
            if (pid < 840) { const int arr = pid / 280, rem = pid % 280, row = rem >> 3, c8 = (rem & 7) * 8; const int tl = tl0 - 3 + row; \
                if (tl >= 0) pp[i] = *(const u32x4*)(proj + (tok0 + tl) * NPROJ + (arr == 0 ? PC_GDQ : (arr == 1 ? PC_GDK : PC_GDV)) + hd * 64 + c8); } \
            else if (pid < 1096) { const int zp = pid - 840, row = zp >> 3, c8 = (zp & 7) * 8; \
                pp[i] = *(const u32x4*)(proj + (tok0 + tl0 + row) * NPROJ + PC_GDZ + hd * 64 + c8); } } \
        if (tid < 64) pg = gsm[(tok0 + tl0 + (tid & 31)) * 32 + (tid < 32 ? 8 : 16) + hd]; } while (0)
    GD_ISSUE(0);
    float S[64];
#pragma unroll
    for (int i = 0; i < 64; ++i) S[i] = 0.f;
    for (int blk = 0; blk < SEQ_ / TB; ++blk) {
        __syncthreads();
#pragma unroll
        for (int i = 0; i < 3; ++i) { const int pid = tid + 512 * i; LAS float* d = nullptr;
            if (pid < 840) { const int arr = pid / 280, rem = pid % 280, row = rem >> 3, c8 = (rem & 7) * 8; d = (arr == 0 ? rq : (arr == 1 ? rk : rv)) + row * 64 + c8; }
            else if (pid < 1096) { const int zp = pid - 840, row = zp >> 3, c8 = (zp & 7) * 8; d = zs + row * 64 + c8; }
            if (pid < 1096) { const u32x4 w = pp[i];
                *(LAS f32x4*)(d) = (f32x4){bflo(w.x), bfhi(w.x), bflo(w.y), bfhi(w.y)}; *(LAS f32x4*)(d + 4) = (f32x4){bflo(w.z), bfhi(w.z), bflo(w.w), bfhi(w.w)}; } }
        if (tid < 32) ga[tid] = pg; else if (tid < 64) gb[tid - 32] = pg;
        __syncthreads();
        if (blk + 1 < SEQ_ / TB) GD_ISSUE(blk + 1);
        if (tid < 64) {
            for (int s = 0; s < TB; ++s) {
                float qv = 0.f, kv = 0.f, vv = 0.f;
#pragma unroll
                for (int i = 0; i < 4; ++i) { qv += cq[i] * rq[(s + i) * 64 + lane]; kv += ck[i] * rk[(s + i) * 64 + lane]; vv += cv[i] * rv[(s + i) * 64 + lane]; }
                qv = silu_f(qv); kv = silu_f(kv); vv = silu_f(vv);
                const float qn = qv * rsqrtf(wave_sum(qv * qv) + RMS_EPS) * 0.125f;
                const float kn = kv * rsqrtf(wave_sum(kv * kv) + RMS_EPS);
                const float g = nexpA * softplus_f(ga[s] + dtb), alpha = expf(g), beta = 1.f / (1.f + expf(-gb[s]));
                float kS = 0.f;
#pragma unroll
                for (int i = 0; i < 64; ++i) kS += __builtin_bit_cast(float, __builtin_amdgcn_readlane(__builtin_bit_cast(int, kn), i)) * S[i];
                const float dl = beta * (vv - alpha * kS);
                float o = 0.f;
#pragma unroll
                for (int i = 0; i < 64; ++i) { const float ki = __builtin_bit_cast(float, __builtin_amdgcn_readlane(__builtin_bit_cast(int, kn), i));
                    const float qi = __builtin_bit_cast(float, __builtin_amdgcn_readlane(__builtin_bit_cast(int, qn), i));
                    S[i] = alpha * S[i] + ki * dl; o += qi * S[i]; }
                const float ms = wave_sum(o * o) * (1.0f / 64.0f);
                const float out = o * rsqrtf(ms + RMS_EPS) * gn * silu_f(zs[s * 64 + lane]);
                H[(tok0 + (size_t)blk * TB + s) * 2048 + 1536 + hd * 64 + lane] = (bf16_t)f2bf(out);
            }
        }
    }
}

__device__ __forceinline__ void p5_ln1_router(const Args& a, int l, LAS unsigned char* lds, int G) {
    int tid_ = threadIdx.x; asm volatile("" : "+v"(tid_)); const int tid = tid_, lane = tid & 63, wave = tid >> 6;
    LAS float* rwT = (LAS float*)lds;
    LAS int* hist = (LAS int*)(lds + MISC_OFF);
    const float* rw = a.in[I_RW] + (size_t)l * 1024 * 32;
    for (int idx = tid; idx < 32768; idx += 512) { const int e = idx >> 10, i = idx & 1023; rwT[idx] = rw[i * 32 + e]; }
    const float* v = (const float*)(a.ws + WS_V); float* x1 = (float*)(a.ws + WS_X1); bf16_t* x1b = (bf16_t*)(a.ws + WS_X1B);
    int* tke = (int*)(a.ws + WS_TKE); float* tkw = (float*)(a.ws + WS_TKW); int* ghist = (int*)(a.ws + WS_HIST);
    f32x4 gg[4], bb[4];
#pragma unroll
    for (int j = 0; j < 4; ++j) { gg[j] = *(const f32x4*)(a.in[I_LN1G] + l * 1024 + 4 * lane + 256 * j); bb[j] = *(const f32x4*)(a.in[I_LN1B] + l * 1024 + 4 * lane + 256 * j); }
    const float rbias = lane < 32 ? a.in[I_RB][l * 32 + lane] : 0.f;
    for (int ch = blockIdx.x; ch < NCHUNK; ch += G) {
        __syncthreads();
        if (tid < 32) hist[tid] = 0;
        __syncthreads();
        for (int tt = 0; tt < 16; ++tt) {
            const size_t t = (size_t)ch * CHTOK + wave * 16 + tt;
            f32x4 xv[4]; float s = 0.f;
#pragma unroll
            for (int j = 0; j < 4; ++j) { xv[j] = *(const f32x4*)(v + t * 1024 + 4 * lane + 256 * j); s += (xv[j][0] + xv[j][1]) + (xv[j][2] + xv[j][3]); }
            const float mean = wave_sum(s) * (1.0f / 1024.0f); float s2 = 0.f;
#pragma unroll
            for (int j = 0; j < 4; ++j) { xv[j] = xv[j] - mean; s2 += (xv[j][0] * xv[j][0] + xv[j][1] * xv[j][1]) + (xv[j][2] * xv[j][2] + xv[j][3] * xv[j][3]); }
            const float rstd = rsqrtf(wave_sum(s2) * (1.0f / 1024.0f) + LN_EPS);
#pragma unroll
            for (int j = 0; j < 4; ++j) { xv[j] = xv[j] * rstd * gg[j] + bb[j];
                *(f32x4*)(x1 + t * 1024 + 4 * lane + 256 * j) = xv[j];
                u32x2 w; w.x = pk2(xv[j][0], xv[j][1]); w.y = pk2(xv[j][2], xv[j][3]); *(u32x2*)(x1b + t * 1024 + 4 * lane + 256 * j) = w; }
            float lg = 0.f;
#pragma unroll
            for (int e = 0; e < 32; ++e) { float pe = 0.f;
#pragma unroll
                for (int j = 0; j < 4; ++j) { const f32x4 w = *(const LAS f32x4*)(rwT + e * 1024 + 4 * lane + 256 * j); pe += (xv[j][0] * w[0] + xv[j][1] * w[1]) + (xv[j][2] * w[2] + xv[j][3] * w[3]); }
                pe = wave_sum(pe); if (lane == e) lg = pe; }
            float val = lane < 32 ? lg + rbias : -INFINITY;
            float tv[4]; int ti[4];
#pragma unroll
            for (int k = 0; k < 4; ++k) { const float m = wave_max(val); const unsigned long long bal = __ballot(val == m); const int idx = __ffsll((long long)bal) - 1;
                tv[k] = m; ti[k] = idx; if (lane == idx) val = -INFINITY; }
            const float e1 = expf(tv[1] - tv[0]), e2 = expf(tv[2] - tv[0]), e3 = expf(tv[3] - tv[0]); const float inv = 1.0f / (1.0f + e1 + e2 + e3);
            if (lane < 4) { const int ei = lane == 0 ? ti[0] : (lane == 1 ? ti[1] : (lane == 2 ? ti[2] : ti[3]));
                const float wi = (lane == 0 ? 1.0f : (lane == 1 ? e1 : (lane == 2 ? e2 : e3))) * inv;
                tke[t * 4 + lane] = ei; tkw[t * 4 + lane] = wi; __hip_atomic_fetch_add(&hist[ei], 1, __ATOMIC_RELAXED, __HIP_MEMORY_SCOPE_WORKGROUP); }
        }
        __syncthreads();
        if (tid < 32) ghist[ch * 32 + tid] = hist[tid];
    }
}

__device__ __forceinline__ void p6_slots(const Args& a, LAS unsigned char* lds, int G) {
    int tid_ = threadIdx.x; asm volatile("" : "+v"(tid_)); const int tid = tid_, lane = tid & 63, wave = tid >> 6;
    LAS int* hs = (LAS int*)lds;
    LAS int* cnt = (LAS int*)(lds + 32768);
    LAS int* bst = (LAS int*)(lds + 32768 + 256);
    LAS int* te = (LAS int*)(lds + 36864);
    LAS int* sl = (LAS int*)(lds + 36864 + 2048);
    const int* ghist = (const int*)(a.ws + WS_HIST);
    for (int i = tid; i < NCHUNK * 32; i += 512) hs[i] = ghist[i];
    __syncthreads();
    if (tid < 32) { int run = 0; for (int ch = 0; ch < NCHUNK; ++ch) { const int c = hs[ch * 32 + tid]; hs[ch * 32 + tid] = run; run += c; } cnt[tid] = run; }
    __syncthreads();
    if (tid == 0) { int bs = 0; for (int e = 0; e < 32; ++e) { bst[e] = bs; bs += (cnt[e] + 255) >> 8; } bst[32] = bs; }
    __syncthreads();
    if (blockIdx.x == 0 && tid <= 32) ((int*)(a.ws + WS_META))[tid] = bst[tid];
    const int* tke = (const int*)(a.ws + WS_TKE); const float* tkw = (const float*)(a.ws + WS_TKW);
    int* slot = (int*)(a.ws + WS_SLOT); float* wbuf = (float*)(a.ws + WS_WBUF);
    const bf16_t* x1b = (const bf16_t*)(a.ws + WS_X1B); bf16_t* xs = (bf16_t*)(a.ws + WS_OV + OV_XS);
    for (int ch = blockIdx.x; ch < NCHUNK; ch += G) {
        __syncthreads();
        te[tid] = tke[(size_t)ch * 512 + tid];
        __syncthreads();
        if (tid < 32) { int rank = bst[tid] * 256 + hs[ch * 32 + tid]; for (int p = 0; p < 512; ++p) if (te[p] == tid) sl[p] = rank++; }
        __syncthreads();
        { const size_t pi = (size_t)ch * 512 + tid; const int s_ = sl[tid]; slot[pi] = s_; wbuf[s_] = tkw[pi]; }
        for (int tt = 0; tt < 16; ++tt) { const int tl = wave * 16 + tt; const size_t t = (size_t)ch * CHTOK + tl;
            const u32x4 r0 = *(const u32x4*)(x1b + t * 1024 + lane * 8), r1 = *(const u32x4*)(x1b + t * 1024 + 512 + lane * 8);
#pragma unroll
            for (int k = 0; k < 4; ++k) { const size_t s_ = (size_t)sl[tl * 4 + k]; *(u32x4*)(xs + s_ * 1024 + lane * 8) = r0; *(u32x4*)(xs + s_ * 1024 + 512 + lane * 8) = r1; } }
    }
}
__device__ __forceinline__ int moe_table(const Args& a, LAS unsigned char* lds) {
    int tid_ = threadIdx.x; asm volatile("" : "+v"(tid_)); const int tid = tid_;
    LAS int* bst = (LAS int*)(lds + MISC_OFF);
    LAS int* blk_e = (LAS int*)(lds + MISC_OFF + 256);
    __syncthreads();
    if (tid <= 32) bst[tid] = ((const int*)(a.ws + WS_META))[tid];
    __syncthreads();
    const int nb = bst[32];
    for (int rb = tid; rb < nb; rb += 512) { int e = 0; while (e < 31 && rb >= bst[e + 1]) ++e; blk_e[rb] = e; }
    __syncthreads();
    return nb;
}

__device__ __forceinline__ void p9_combine_ln2(const Args& a, int l, float* xout, int G) {
    int tid_ = threadIdx.x; asm volatile("" : "+v"(tid_)); const int tid = tid_, lane = tid & 63, wave = tid >> 6;
    const float* x1 = (const float*)(a.ws + WS_X1); const int* slot = (const int*)(a.ws + WS_SLOT);
    const bf16_t* ys = (const bf16_t*)(a.ws + WS_OV + OV_YS); bf16_t* xb = (bf16_t*)(a.ws + WS_XB);
    f32x4 gg[4], bb[4];
#pragma unroll
    for (int j = 0; j < 4; ++j) { gg[j] = *(const f32x4*)(a.in[I_LN2G] + l * 1024 + 4 * lane + 256 * j); bb[j] = *(const f32x4*)(a.in[I_LN2B] + l * 1024 + 4 * lane + 256 * j); }
    for (size_t t = (size_t)blockIdx.x * NWAVES + wave; t < (size_t)T_; t += (size_t)G * NWAVES) {
        int sk[4];
#pragma unroll
        for (int k = 0; k < 4; ++k) sk[k] = slot[t * 4 + k];
        f32x4 xv[4]; float s = 0.f;
#pragma unroll
        for (int j = 0; j < 4; ++j) { xv[j] = *(const f32x4*)(x1 + t * 1024 + 4 * lane + 256 * j) * DN_ALPHA;
            f32x4 ya = (f32x4){0.f, 0.f, 0.f, 0.f};
#pragma unroll
            for (int k = 0; k < 4; ++k) { const u32x2 w = *(const u32x2*)(ys + (size_t)sk[k] * 1024 + 4 * lane + 256 * j);
                ya[0] += bflo(w.x); ya[1] += bfhi(w.x); ya[2] += bflo(w.y); ya[3] += bfhi(w.y); }
            xv[j] += ya; s += (xv[j][0] + xv[j][1]) + (xv[j][2] + xv[j][3]); }
        const float mean = wave_sum(s) * (1.0f / 1024.0f); float s2 = 0.f;
#pragma unroll
        for (int j = 0; j < 4; ++j) { xv[j] = xv[j] - mean; s2 += (xv[j][0] * xv[j][0] + xv[j][1] * xv[j][1]) + (xv[j][2] * xv[j][2] + xv[j][3] * xv[j][3]); }
        const float rstd = rsqrtf(wave_sum(s2) * (1.0f / 1024.0f) + LN_EPS);
#pragma unroll
        for (int j = 0; j < 4; ++j) { xv[j] = xv[j] * rstd * gg[j] + bb[j];
            *(f32x4*)(xout + t * 1024 + 4 * lane + 256 * j) = xv[j];
            u32x2 w; w.x = pk2(xv[j][0], xv[j][1]); w.y = pk2(xv[j][2], xv[j][3]); *(u32x2*)(xb + t * 1024 + 4 * lane + 256 * j) = w; }
    }
}
constexpr int NPH = 1 + 9 * DEPTH_;
#ifndef MK_N_LAUNCHES
#define MK_N_LAUNCHES 1
#endif
#ifndef PG8_SP2
#define PG8_SP2 true
#endif
#ifndef PG8_ALIGN
#define PG8_ALIGN true
#endif
__global__ void __launch_bounds__(NWAVES * 64, 2) fwd(Args a) {
    extern __shared__ __attribute__((aligned(16))) unsigned char lds_raw[];
    LAS unsigned char* lds = (LAS unsigned char*)lds_raw;
    const int tid = threadIdx.x, G = gridDim.x;
    const int vcu = (G % 8 == 0) ? ((int)blockIdx.x % 8) * (G / 8) + (int)blockIdx.x / 8 : (int)blockIdx.x;
    for (int u = tid; u < (LDS_BYTES - MISC_OFF) / 4; u += NWAVES * 64) ((LAS unsigned*)(lds + MISC_OFF))[u] = 0u;
    __syncthreads();
    const int lo = a.ph_lo, hi = a.ph_hi;
    unsigned* barw = (unsigned*)(a.ws + WS_CTL) + CW_BAR + a.li * XCD_BAR_WORDS;
    XcdBarrier bar; bar.bar = barw; bar.x = 0; bar.st = nullptr;
    if (hi - lo > 1) bar = xcd_barrier_post(barw, (volatile LAS unsigned*)(lds + LDS_BYTES - 16));
#define IN(k) (lo <= (k) && (k) < hi)
#define SEAM(k) do { if (IN(k) && IN((k) + 1)) xcd_barrier(bar); } while (0)
    unsigned char* ws = a.ws;
    bf16_t* xb = (bf16_t*)(ws + WS_XB); float* gsm = (float*)(ws + WS_GSM); bf16_t* mb = (bf16_t*)(ws + WS_MB);
    float* vbuf = (float*)(ws + WS_V); bf16_t* x1b = (bf16_t*)(ws + WS_X1B); float* x2 = (float*)(ws + WS_X2);
    bf16_t* proj = (bf16_t*)(ws + WS_OV + OV_PROJ); bf16_t* Hb = (bf16_t*)(ws + WS_OV + OV_H); float* mf = (float*)(ws + WS_OV + OV_MF);
    bf16_t* xs = (bf16_t*)(ws + WS_OV + OV_XS); bf16_t* act = (bf16_t*)(ws + WS_OV + OV_ACT); bf16_t* ysb = (bf16_t*)(ws + WS_OV + OV_YS);

    if (IN(0)) p0_convert(a, lds, G);
    SEAM(0);

    for (int l = 0; l < DEPTH_; ++l) {
        const int pb = 1 + 9 * l;
        unsigned char* wl = ws + WS_W + (size_t)l * WL_STRIDE;
        const float* xin = l == 0 ? a.in[I_X] : x2; float* xout = (l == DEPTH_ - 1) ? a.out : x2;

        if (IN(pb + 0)) {
            pg8::Gemm g{xb, (const bf16_t*)(wl + WL_IN), 1024, 1024, 1024}; pg8::StaticOrder S; S.init(T_, NINP, G, (int)blockIdx.x);
            pg8::EpiProj E{proj, gsm};
            pg8::gemm_phase<pg8::EpiProj, pg8::StaticOrder, PG8_ALIGN, PG8_SP2>(lds, g, S, E);
        }
        SEAM(pb + 0);

        if (IN(pb + 1)) {
            for (int u = (int)blockIdx.x; u < 160; u += G) {
                if (u < 64) lru_naive(a, l, u, lds, proj, Hb);
                else if (u < 96) mlstm_naive(a, l, u - 64, lds, proj, gsm, Hb);
                else gdn_naive(a, l, u - 96, lds, proj, gsm, Hb);
                __syncthreads();
            }
        }
        SEAM(pb + 1);

        if (IN(pb + 2)) {
            pg8::StaticOrder S; S.init(T_, 1024, G, (int)blockIdx.x);
            { pg8::Gemm g{Hb, (const bf16_t*)(wl + WL_BR), 2048, 2048, 1024}; pg8::EpiMerge<0> E{proj, mf, mb};
              pg8::gemm_phase<pg8::EpiMerge<0>, pg8::StaticOrder, PG8_ALIGN, PG8_SP2>(lds, g, S, E); }
            { pg8::Gemm g{Hb + 1024, (const bf16_t*)(wl + WL_BR) + 1024, 2048, 2048, 512}; pg8::EpiMerge<1> E{proj, mf, mb};
              pg8::gemm_phase<pg8::EpiMerge<1>, pg8::StaticOrder, PG8_ALIGN, PG8_SP2>(lds, g, S, E); }
            { pg8::Gemm g{Hb + 1536, (const bf16_t*)(wl + WL_BR) + 1536, 2048, 2048, 512}; pg8::EpiMerge<2> E{proj, mf, mb};
              pg8::gemm_phase<pg8::EpiMerge<2>, pg8::StaticOrder, PG8_ALIGN, PG8_SP2>(lds, g, S, E); }
        }
        SEAM(pb + 2);

        if (IN(pb + 3)) {
            pg8::Gemm g{mb, (const bf16_t*)(wl + WL_OUT), 1024, 1024, 1024}; pg8::StaticOrder S; S.init(T_, 1024, G, (int)blockIdx.x);
            pg8::EpiWout E{xin, vbuf};
            pg8::gemm_phase<pg8::EpiWout, pg8::StaticOrder, PG8_ALIGN, PG8_SP2>(lds, g, S, E);
        }
        SEAM(pb + 3);

        if (IN(pb + 4)) p5_ln1_router(a, l, lds, G);
        SEAM(pb + 4);

        if (IN(pb + 5)) p6_slots(a, lds, G);
        SEAM(pb + 5);

        if (IN(pb + 6)) {
            const int nb = moe_table(a, lds);
            pg8::MoeOrder S{8, G, vcu, nb * 8, (const LAS int*)(lds + MISC_OFF + 256)};
            pg8::Gemm g{xs, (const bf16_t*)(wl + WL_W1), 1024, 1024, 1024};
            pg8::EpiMoe1 E{act, a.in[I_B1] + (size_t)l * NE * 2048};
            pg8::gemm_phase<pg8::EpiMoe1, pg8::MoeOrder, PG8_ALIGN, PG8_SP2>(lds, g, S, E);
        }
        SEAM(pb + 6);

        if (IN(pb + 7)) {
            const int nb = moe_table(a, lds);
            pg8::MoeOrder S{4, G, vcu, nb * 4, (const LAS int*)(lds + MISC_OFF + 256)};
            pg8::Gemm g{act, (const bf16_t*)(wl + WL_W2), 1024, 1024, 1024};
            pg8::EpiMoe2 E{ysb, a.in[I_B2] + (size_t)l * NE * 1024, (const float*)(ws + WS_WBUF)};
            pg8::gemm_phase<pg8::EpiMoe2, pg8::MoeOrder, PG8_ALIGN, PG8_SP2>(lds, g, S, E);
        }
        SEAM(pb + 7);

        if (IN(pb + 8)) p9_combine_ln2(a, l, xout, G);
        SEAM(pb + 8);
    }
#undef IN
#undef SEAM
}

extern "C" void kernel_launch(void* const* d_in, const int* in_sizes, int n_in, void* d_out, int out_size, void* d_ws, size_t ws_size, hipStream_t stream) {
    static int grid = 0;
    if (grid == 0) {
        if (n_in != 30 || in_sizes[0] != T_ * D_ || out_size != T_ * D_ || ws_size < WS_END) {
            fprintf(stderr, "kernel_launch: unexpected shapes: n_in %d in0 %d out %d ws %zu (need %zu); nothing launched\n", n_in, n_in > 0 ? in_sizes[0] : -1, out_size, ws_size, (size_t)WS_END); grid = -1; return; }
        int dev = 0, cus = 0;
        if (hipGetDevice(&dev) != hipSuccess || hipDeviceGetAttribute(&cus, hipDeviceAttributeMultiprocessorCount, dev) != hipSuccess) { grid = -1; return; }
        if (hipFuncSetAttribute((const void*)fwd, hipFuncAttributeMaxDynamicSharedMemorySize, LDS_BYTES) != hipSuccess) { fprintf(stderr, "kernel_launch: hipFuncSetAttribute failed\n"); grid = -1; return; }
        int per_cu = 0; (void)hipOccupancyMaxActiveBlocksPerMultiprocessor(&per_cu, (const void*)fwd, NWAVES * 64, LDS_BYTES); (void)hipGetLastError();
        if (per_cu < 1) fprintf(stderr, "kernel_launch: occupancy query reports %d blocks per CU\n", per_cu);
        grid = cus;
    }
    if (grid < 0) return;
    (void)hipMemsetAsync((char*)d_ws + WS_CTL, 0, CTL_ZERO_BYTES, stream);
    Args a{};
    for (int i = 0; i < 30; ++i) a.in[i] = (const float*)d_in[i];
    a.out = (float*)d_out; a.ws = (unsigned char*)d_ws;
    constexpr int NL = MK_N_LAUNCHES; static_assert(NL == NPH || NL <= 4, "barrier regions");
    for (int li = 0; li < NL; ++li) {
        a.ph_lo = (int)((long)NPH * li / NL); a.ph_hi = (int)((long)NPH * (li + 1) / NL); a.li = (NL <= 4) ? li : 0;
        hipLaunchKernelGGL(fwd, dim3(grid), dim3(NWAVES * 64), LDS_BYTES, stream, a);
        const hipError_t le = hipPeekAtLastError();
        if (le != hipSuccess) { fprintf(stderr, "kernel_launch: launch %d failed: %s\n", li, hipGetErrorName(le)); break; }
    }
}
```

```cpp
#include <hip/hip_runtime.h>
#include <cstdio>
#include <cstdint>

#define LAS __attribute__((address_space(3)))
#define GAS __attribute__((address_space(1)))
typedef unsigned short bf16_t;
typedef short bf16x8 __attribute__((ext_vector_type(8)));
typedef float f32x4 __attribute__((ext_vector_type(4)));
typedef float f32x2 __attribute__((ext_vector_type(2)));
typedef unsigned u32x4 __attribute__((ext_vector_type(4)));
typedef unsigned u32x2 __attribute__((ext_vector_type(2)));

constexpr int T_ = 32768, D_ = 1024, SEQ_ = 4096, NBATCH = 8, DEPTH_ = 2;
constexpr int DIN = 8728, NPROJ = 8704, NINP = 8960;
constexpr int NE = 32, DFF = 1024;
constexpr int PMAX = 139264;
constexpr int NCHUNK = 256, CHTOK = 128;
constexpr float DN_ALPHA = 1.41421356237309515f;
constexpr float LN_EPS = 1e-5f, RMS_EPS = 1e-6f;
constexpr int PC_LRUX = 0, PC_LRUY = 1024, PC_MLQ = 2048, PC_MLK = 2304, PC_MLV = 2560, PC_MLO = 3072, PC_GDQ = 3584, PC_GDK = 4096, PC_GDV = 4608, PC_GDZ = 5120, PC_GATE = 5632;

constexpr size_t MiB = 1u << 20;
constexpr size_t WS_CTL = 0, CTL_ZERO_BYTES = 64 * 1024;
constexpr size_t WS_HIST = 256 * 1024;
constexpr size_t WS_META = 320 * 1024;
constexpr size_t WS_W = 1 * MiB;
constexpr size_t WL_IN = 0, WL_BR = 18 * MiB, WL_OUT = 22 * MiB, WL_W1 = 24 * MiB, WL_W2 = 152 * MiB, WL_G = 216 * MiB, WL_STRIDE = 217 * MiB;
constexpr size_t WS_XB = 436 * MiB;
constexpr size_t WS_GSM = 501 * MiB;
constexpr size_t WS_MB = 505 * MiB;
constexpr size_t WS_V = 569 * MiB;
constexpr size_t WS_X1 = 697 * MiB;
constexpr size_t WS_X1B = 825 * MiB;
constexpr size_t WS_X2 = 890 * MiB;
constexpr size_t WS_TKE = 1018 * MiB;
constexpr size_t WS_TKW = WS_TKE + 512 * 1024;
constexpr size_t WS_SLOT = 1019 * MiB;
constexpr size_t WS_WBUF = 1020 * MiB;
constexpr size_t WS_OV = 1024 * MiB;
constexpr size_t OV_PROJ = 0, OV_H = 544 * MiB, OV_MF = 672 * MiB;
constexpr size_t OV_XS = 0, OV_ACT = 272 * MiB, OV_YS = 544 * MiB;
constexpr size_t WS_MXS = WS_OV + 816 * MiB;
constexpr size_t WS_END = WS_MXS + 104 * MiB;

constexpr int CW_BAR = 1024;

constexpr int RING_BYTES = 131072;
constexpr int MISC_OFF = RING_BYTES;
constexpr int LDS_BYTES = 147456;
constexpr int NWAVES = 8;

#define LDS_WAIT() asm volatile("s_waitcnt lgkmcnt(0)" ::: "memory")
#define VM_WAIT() asm volatile("s_waitcnt vmcnt(0)" ::: "memory")

__device__ __forceinline__ unsigned f2bf(float f) { unsigned u = __builtin_bit_cast(unsigned, f); return (u + 0x7fffu + ((u >> 16) & 1u)) >> 16; }
__device__ __forceinline__ unsigned pk2(float lo, float hi) { return f2bf(lo) | (f2bf(hi) << 16); }
__device__ __forceinline__ float bf2f(unsigned short b) { return __builtin_bit_cast(float, (unsigned)b << 16); }
__device__ __forceinline__ float bflo(unsigned w) { return __builtin_bit_cast(float, w << 16); }
__device__ __forceinline__ float bfhi(unsigned w) { return __builtin_bit_cast(float, w & 0xffff0000u); }
__device__ __forceinline__ float wave_sum(float v) {
#pragma unroll
    for (int o = 1; o < 64; o <<= 1) v += __shfl_xor(v, o);
    return v;
}
__device__ __forceinline__ float wave_max(float v) {
#pragma unroll
    for (int o = 1; o < 64; o <<= 1) v = fmaxf(v, __shfl_xor(v, o));
    return v;
}
__device__ __forceinline__ float sigmoid_f(float x) { return 1.f / (1.f + __expf(-x)); }
__device__ __forceinline__ float silu_f(float x) { return x / (1.f + __expf(-x)); }
__device__ __forceinline__ float softplus_f(float x) { return x > 20.f ? x : log1pf(expf(x)); }
__device__ __forceinline__ float gelu_tanh_f(float x) { const float u = 0.7978845608028654f * (x + 0.044715f * x * x * x); return 0.5f * x * (1.f + tanhf(u)); }
namespace pg8 {
#define PG8_LAS __attribute__((address_space(3)))
constexpr int BM = 256, BK = 64, HALF = 128, HTB = HALF * BK * 2  , STAGE_BYTES = 8 * HTB, NXCD = 8, WGM = 8;

__host__ __device__ __forceinline__ int lds_byte(int r, int c) { const int st = (r >> 4) * 2 + (c >> 5), rr = r & 15, cc = c & 31, ob = rr * 64 + cc * 2; return st * 1024 + (ob ^ (((ob >> 9) & 1) << 5)); }
__host__ __device__ __forceinline__ void stage_rc(int b, int& R, int& C) { const int st = b / 1024, sb = b % 1024, swz = sb ^ (((sb >> 9) & 1) << 5); R = (st >> 1) * 16 + swz / 64; C = (st & 1) * 32 + (swz % 64) / 2; }
__host__ __device__ __forceinline__ int perm32(int rho) { const int n = rho >> 4, i = rho & 15; return 8 * (i >> 2) + 4 * n + (i & 3); }

struct Unit { int pm, pn; };
struct Gemm { const bf16_t* A; const bf16_t* Bt; int lda, ldb, K; };

struct StaticOrder {
    int nM, nN, nwg, G, c;
    __host__ __device__ void init(int M, int N, int G_, int c_) { nM = M / BM; nN = N / BM; nwg = nM * nN; G = G_; c = c_; }
    __host__ __device__ bool next(int i, Unit& u) const {
        const long L = (long)i * G + c; if (L >= nwg) return false;
        int wgid = (int)L; { const int q = nwg / NXCD, r = nwg % NXCD, xcd = wgid % NXCD, off = wgid / NXCD; wgid = (xcd < r ? xcd * (q + 1) : r * (q + 1) + (xcd - r) * q) + off; }
        const int nig = WGM * nN, gid = wgid / nig, fm = gid * WGM, gsz = (nM - fm) < WGM ? (nM - fm) : WGM;
        u.pm = fm + ((wgid % nig) % gsz); u.pn = (wgid % nig) / gsz; return true;
    }
    __device__ __forceinline__ void a_ready(const Unit&) const {}
    __device__ __forceinline__ void done(const Unit&) const {}
};

__device__ __forceinline__ unsigned cvt_pk_bf16(float lo, float hi) { unsigned r; asm volatile("v_cvt_pk_bf16_f32 %0, %1, %2" : "=v"(r) : "v"(lo), "v"(hi)); return r; }

template <class Epi, class Sched, bool ALIGN_EPI = false, bool SP2 = false>
__device__ __forceinline__ void gemm_phase(PG8_LAS unsigned char* lds, const Gemm g, const Sched& S, const Epi& E) {
    int tid_ = threadIdx.x; asm volatile("" : "+v"(tid_));
    const int tid = tid_, wid = __builtin_amdgcn_readfirstlane(tid >> 6), lane = tid & 63, wr = wid >> 2, wc = wid & 3, fr = lane & 15, fq = lane >> 4;
    const int K = g.K, nt = K / BK;
    unsigned voffA[2], voffB[2];
#pragma unroll
    for (int i = 0; i < 2; ++i) { int R, C; stage_rc(tid * 16 + i * 8192, R, C); const int Rb = Epi::PERM ? ((R & ~31) + perm32(R & 31)) : R;
        voffA[i] = (unsigned)(R * g.lda + C) * 2u; voffB[i] = (unsigned)(Rb * g.ldb + C) * 2u; }
    const size_t kstep = (size_t)(BK * 2);
    const size_t hstepA = (size_t)HALF * g.lda * 2, hstepB = (size_t)HALF * g.ldb * 2;
    const size_t tstepA = 2 * hstepA, tstepB = 2 * hstepB;
    const unsigned ldsw = (unsigned)wid * 1024u;
    const int aoff = lds_byte(wr * 64 + fr, fq * 8), boff = lds_byte(wc * 32 + fr, fq * 8);
#define PG8_SA(b, h) (((b) * 2 + (h)) * HTB)
#define PG8_SB(b, h) ((4 + (b) * 2 + (h)) * HTB)
#define PG8_STAGE(bufoff, gbase, voff) do { _Pragma("unroll") for (int _i = 0; _i < 2; ++_i) \
        __builtin_amdgcn_global_load_lds((const unsigned*)((const char*)(gbase) + (voff)[_i]), (PG8_LAS unsigned*)(lds + (bufoff) + ldsw + _i * 8192), 16, 0, 0); } while (0)
#define PG8_LDA(dst, b, h) do { _Pragma("unroll") for (int m = 0; m < 4; ++m) _Pragma("unroll") for (int k = 0; k < 2; ++k) dst[m][k] = *(const PG8_LAS bf16x8*)(lds + PG8_SA(b, h) + aoff + m * 2048 + k * 1024); } while (0)
#define PG8_LDB(dst, b, h) do { _Pragma("unroll") for (int n = 0; n < 2; ++n) _Pragma("unroll") for (int k = 0; k < 2; ++k) dst[n][k] = *(const PG8_LAS bf16x8*)(lds + PG8_SB(b, h) + boff + n * 2048 + k * 1024); } while (0)
#define PG8_MMA(ai, bj, At, Bt) do { __builtin_amdgcn_s_setprio(1); _Pragma("unroll") for (int m = 0; m < 4; ++m) _Pragma("unroll") for (int n = 0; n < 2; ++n) _Pragma("unroll") for (int k = 0; k < 2; ++k) \
        acc[ai][bj][m][n] = __builtin_amdgcn_mfma_f32_16x16x32_bf16(Bt[n][k], At[m][k], acc[ai][bj][m][n], 0, 0, 0); __builtin_amdgcn_s_setprio(0); } while (0)
#define PG8_WAIT_V(n) asm volatile("s_waitcnt vmcnt(" #n ")" ::: "memory")
#define PG8_WAIT_L(n) asm volatile("s_waitcnt lgkmcnt(" #n ")" ::: "memory")
#define PG8_BAR __builtin_amdgcn_s_barrier()
#define PG8_SCHED __builtin_amdgcn_sched_barrier(0)
    Unit cur, nxt; int ui = 0;
    if (!S.next(0, cur)) return;
    f32x4 acc[2][2][4][2];
#pragma unroll
    for (int a = 0; a < 2; ++a)
#pragma unroll
        for (int b = 0; b < 2; ++b)
#pragma unroll
            for (int m = 0; m < 4; ++m)
#pragma unroll
                for (int n = 0; n < 2; ++n) acc[a][b][m][n] = (f32x4){0.f, 0.f, 0.f, 0.f};
    bf16x8 At[4][2], B0[2][2], B1[2][2];
    const char* cA = (const char*)g.A + (size_t)cur.pm * tstepA; const char* cB = (const char*)g.Bt + (size_t)cur.pn * tstepB;
    S.a_ready(cur);
    if constexpr (SP2) {
        PG8_STAGE(PG8_SB(0, 0), cB, voffB); PG8_STAGE(PG8_SB(0, 1), cB + hstepB, voffB); PG8_STAGE(PG8_SA(0, 0), cA, voffA); PG8_STAGE(PG8_SA(0, 1), cA + hstepA, voffA);
        if (wr == 1) PG8_BAR;
        PG8_WAIT_V(2); PG8_BAR;
        PG8_STAGE(PG8_SB(1, 0), cB + kstep, voffB); PG8_STAGE(PG8_SA(1, 0), cA + kstep, voffA); PG8_STAGE(PG8_SB(1, 1), cB + hstepB + kstep, voffB);
        PG8_WAIT_V(6); PG8_BAR;
    } else {
        PG8_STAGE(PG8_SB(0, 0), cB, voffB); PG8_STAGE(PG8_SA(0, 0), cA, voffA); PG8_STAGE(PG8_SB(0, 1), cB + hstepB, voffB); PG8_STAGE(PG8_SA(0, 1), cA + hstepA, voffA);
        if (wr == 1) PG8_BAR;
        PG8_WAIT_V(4); PG8_BAR;
        PG8_STAGE(PG8_SB(1, 0), cB + kstep, voffB); PG8_STAGE(PG8_SA(1, 0), cA + kstep, voffA); PG8_STAGE(PG8_SB(1, 1), cB + hstepB + kstep, voffB);
        PG8_WAIT_V(6); PG8_BAR;
    }
    for (;;) {
        const bool has_next = S.next(ui + 1, nxt);
        const char* nA = has_next ? (const char*)g.A + (size_t)nxt.pm * tstepA : cA; const char* nB = has_next ? (const char*)g.Bt + (size_t)nxt.pn * tstepB : cB;
        for (int t = 0; t < nt; t += 2) {
            const bool last = (t == nt - 2);
            const char* a1 = cA + (size_t)(t + 1) * kstep;
            const char* a2 = last ? nA : cA + (size_t)(t + 2) * kstep; const char* b2 = last ? nB : cB + (size_t)(t + 2) * kstep;
            const char* a3 = a2 + kstep; const char* b3 = b2 + kstep;
            if (last && has_next) S.a_ready(nxt);
            if constexpr (SP2) {
            PG8_LDB(B0, 0, 0); PG8_LDB(B1, 0, 1); PG8_SCHED; PG8_LDA(At, 0, 0); PG8_STAGE(PG8_SA(1, 1), a1 + hstepA, voffA);
            PG8_WAIT_V(8); PG8_WAIT_L(0); PG8_BAR; PG8_MMA(0, 0, At, B0); PG8_MMA(0, 1, At, B1); PG8_BAR; PG8_SCHED;
            PG8_LDA(At, 0, 1); PG8_STAGE(PG8_SB(0, 0), b2, voffB); PG8_STAGE(PG8_SB(0, 1), b2 + hstepB, voffB); PG8_STAGE(PG8_SA(0, 0), a2, voffA);
            PG8_WAIT_V(8); PG8_WAIT_L(0); PG8_BAR; PG8_MMA(1, 0, At, B0); PG8_MMA(1, 1, At, B1); PG8_BAR; PG8_SCHED;
            PG8_LDB(B0, 1, 0); PG8_LDB(B1, 1, 1); PG8_SCHED; PG8_LDA(At, 1, 0); PG8_STAGE(PG8_SA(0, 1), a2 + hstepA, voffA);
            PG8_WAIT_V(8); PG8_WAIT_L(0); PG8_BAR; PG8_MMA(0, 0, At, B0); PG8_MMA(0, 1, At, B1); PG8_BAR; PG8_SCHED;
            PG8_LDA(At, 1, 1); PG8_STAGE(PG8_SB(1, 0), b3, voffB); PG8_STAGE(PG8_SB(1, 1), b3 + hstepB, voffB); PG8_STAGE(PG8_SA(1, 0), a3, voffA);
            PG8_WAIT_V(8); PG8_WAIT_L(0); PG8_BAR; PG8_MMA(1, 0, At, B0); PG8_MMA(1, 1, At, B1); PG8_BAR; PG8_SCHED;
            } else {
            PG8_LDB(B0, 0, 0); PG8_SCHED; PG8_LDA(At, 0, 0); PG8_STAGE(PG8_SA(1, 1), a1 + hstepA, voffA);
            PG8_WAIT_L(8); PG8_BAR; PG8_WAIT_L(0); PG8_MMA(0, 0, At, B0); PG8_BAR; PG8_SCHED;
            PG8_LDB(B1, 0, 1); PG8_STAGE(PG8_SB(0, 0), b2, voffB);
            PG8_BAR; PG8_WAIT_L(0); PG8_MMA(0, 1, At, B1); PG8_BAR;
            PG8_LDA(At, 0, 1); PG8_STAGE(PG8_SA(0, 0), a2, voffA);
            PG8_BAR; PG8_WAIT_L(0); PG8_MMA(1, 0, At, B0); PG8_BAR; PG8_SCHED;
            PG8_STAGE(PG8_SB(0, 1), b2 + hstepB, voffB);
            PG8_WAIT_V(6); PG8_BAR; PG8_MMA(1, 1, At, B1); PG8_BAR;
            PG8_LDB(B0, 1, 0); PG8_SCHED; PG8_LDA(At, 1, 0); PG8_STAGE(PG8_SA(0, 1), a2 + hstepA, voffA);
            PG8_WAIT_L(8); PG8_BAR; PG8_WAIT_L(0); PG8_MMA(0, 0, At, B0); PG8_BAR; PG8_SCHED;
            PG8_LDB(B1, 1, 1); PG8_STAGE(PG8_SB(1, 0), b3, voffB);
            PG8_BAR; PG8_WAIT_L(0); PG8_MMA(0, 1, At, B1); PG8_BAR;
            PG8_LDA(At, 1, 1); PG8_STAGE(PG8_SA(1, 0), a3, voffA);
            PG8_BAR; PG8_WAIT_L(0); PG8_MMA(1, 0, At, B0); PG8_BAR; PG8_SCHED;
            PG8_STAGE(PG8_SB(1, 1), b3 + hstepB, voffB);
            PG8_WAIT_V(6); PG8_BAR; PG8_MMA(1, 1, At, B1); PG8_BAR;
            }
        }
        if constexpr (ALIGN_EPI) { if (wr == 0) PG8_BAR; }
        E(acc, cur, wr, wc, fr, fq); S.done(cur);
        if (!has_next) break;
#pragma unroll
        for (int a = 0; a < 2; ++a)
#pragma unroll
            for (int b = 0; b < 2; ++b)
#pragma unroll
                for (int m = 0; m < 4; ++m)
#pragma unroll
                    for (int n = 0; n < 2; ++n) acc[a][b][m][n] = (f32x4){0.f, 0.f, 0.f, 0.f};
        cur = nxt; cA = nA; cB = nB; ++ui;
        if constexpr (ALIGN_EPI) { if (wr == 1) PG8_BAR; }
    }
    PG8_WAIT_V(0);
    if constexpr (!ALIGN_EPI) { if (wr == 0) PG8_BAR; }
    PG8_BAR;
#undef PG8_SA
#undef PG8_SB
#undef PG8_STAGE
#undef PG8_LDA
#undef PG8_LDB
#undef PG8_MMA
#undef PG8_WAIT_V
#undef PG8_WAIT_L
#undef PG8_BAR
#undef PG8_SCHED
}
}
#define XB_TMO      128
#define XB_XCNT(j)  (256  + 64 * (j))
#define XB_XSUB(j)  (1280 + 64 * (j))
#define XB_XGEN(j)  (2304 + 64 * (j))
#define XB_TOP      3328
#define XB_TOPGEN   3392
#define XCD_BAR_WORDS 3456
#define XB_SPIN_CAP (1u << 18)

__device__ __forceinline__ unsigned xb_ld(unsigned* p)              { return __hip_atomic_load(p, __ATOMIC_RELAXED, __HIP_MEMORY_SCOPE_AGENT); }
__device__ __forceinline__ unsigned xb_add(unsigned* p, unsigned v) { return __hip_atomic_fetch_add(p, v, __ATOMIC_RELAXED, __HIP_MEMORY_SCOPE_AGENT); }
__device__ __forceinline__ unsigned xb_xcc_id() { return (unsigned)__builtin_amdgcn_s_getreg((3 << 11) | 20) & 0xFu; }
#define XB_SPIN(cond, bar) do { unsigned _sp = 0; while (cond) { __builtin_amdgcn_s_sleep(1); \
    if ((++_sp & 255u) == 0u) { if (xb_ld(&(bar)[XB_TMO])) break; if (_sp > XB_SPIN_CAP) { atomicAdd(&(bar)[XB_TMO], 1u); break; } } } } while (0)

struct XcdBarrier {
    unsigned* bar; unsigned x;
    volatile LAS unsigned* st;
};

__device__ __forceinline__ XcdBarrier xcd_barrier_post(unsigned* bar, volatile LAS unsigned* st) {
    XcdBarrier b; b.bar = bar; b.x = xb_xcc_id(); b.st = st;
    if (threadIdx.x == 0) (void)xb_add(&bar[XB_XCNT(b.x)], 1u);
    return b;
}
__device__ __forceinline__ void xcd_barrier_complete(unsigned* bar, unsigned x, unsigned& nloc, unsigned& nx) {
    const unsigned G = gridDim.x * gridDim.y * gridDim.z;
    unsigned sum, cnt, mine, sp = 0u;
    for (;;) {
        sum = 0u; cnt = 0u; mine = 0u;
#pragma unroll
        for (unsigned j = 0; j < 16; ++j) { const unsigned c = xb_ld(&bar[XB_XCNT(j)]); sum += c; cnt += (c > 0u) ? 1u : 0u; mine = (j == x) ? c : mine; }
        if (sum == G) break;
        __builtin_amdgcn_s_sleep(1);
        if ((++sp & 255u) == 0u) { if (xb_ld(&bar[XB_TMO])) break; if (sp > XB_SPIN_CAP) { atomicAdd(&bar[XB_TMO], 1u); break; } }
    }
    nloc = mine > 0u ? mine : 1u; nx = cnt > 0u ? cnt : 1u;
}

__device__ __forceinline__ void xcd_barrier(const XcdBarrier& b) {
    asm volatile("s_waitcnt vmcnt(0)" ::: "memory");
    __syncthreads();
    if (threadIdx.x == 0) {
        unsigned* bar = b.bar;
        __builtin_amdgcn_s_waitcnt(0);
        unsigned nloc = b.st[0], nx = b.st[1];
        if (nloc == 0u) { xcd_barrier_complete(bar, b.x, nloc, nx); b.st[0] = nloc; b.st[1] = nx; }
        const unsigned old = xb_add(&bar[XB_XSUB(b.x)], 1u);
        const unsigned gen = old / nloc;
        if (old + 1u == (gen + 1u) * nloc) {
            __builtin_amdgcn_fence(__ATOMIC_RELEASE, "agent");
            asm volatile("s_waitcnt vmcnt(0)" ::: "memory");
            const unsigned og = xb_add(&bar[XB_TOP], 1u);
            const unsigned tg = og / nx;
            if (og + 1u == (tg + 1u) * nx) xb_add(&bar[XB_TOPGEN], 1u);
            else XB_SPIN(xb_ld(&bar[XB_TOPGEN]) == tg, bar);
            __builtin_amdgcn_fence(__ATOMIC_ACQUIRE, "agent");
            xb_add(&bar[XB_XGEN(b.x)], 1u);
            asm volatile("s_waitcnt vmcnt(0)" ::: "memory");
        } else {
            XB_SPIN(xb_ld(&bar[XB_XGEN(b.x)]) == gen, bar);
            __builtin_amdgcn_fence(__ATOMIC_ACQUIRE, "agent");
            asm volatile("s_waitcnt vmcnt(0)" ::: "memory");
        }
    }
    __syncthreads();
}
namespace pg8 {
struct EpiProj {
    static constexpr bool PERM = true;
    bf16_t* proj; float* gsm;
    __device__ __forceinline__ void operator()(const f32x4 (&acc)[2][2][4][2], const Unit& u, int wr, int wc, int fr, int fq) const {
        const int row0 = u.pm * BM + wr * 64 + fr;
        if (u.pn < 34) {
            const int col0 = u.pn * BM + wc * 32 + 8 * fq;
#pragma unroll
            for (int ai = 0; ai < 2; ++ai)
#pragma unroll
                for (int m = 0; m < 4; ++m) { bf16_t* rowp = proj + (size_t)(row0 + ai * HALF + m * 16) * NPROJ + col0;
#pragma unroll
                    for (int bj = 0; bj < 2; ++bj) { const f32x4 v0 = acc[ai][bj][m][0], v1 = acc[ai][bj][m][1];
                        u32x4 w; w.x = cvt_pk_bf16(v0[0], v0[1]); w.y = cvt_pk_bf16(v0[2], v0[3]); w.z = cvt_pk_bf16(v1[0], v1[1]); w.w = cvt_pk_bf16(v1[2], v1[3]);
                        *(u32x4*)(rowp + bj * HALF) = w; } }
        } else if (wc == 0 && fq < 3) {
#pragma unroll
            for (int ai = 0; ai < 2; ++ai)
#pragma unroll
                for (int m = 0; m < 4; ++m) { float* rowp = gsm + (size_t)(row0 + ai * HALF + m * 16) * 32 + 8 * fq;
                    *(f32x4*)(rowp) = acc[ai][0][m][0]; *(f32x4*)(rowp + 4) = acc[ai][0][m][1]; }
        }
    }
};
template <int STAGE> struct EpiMerge {
    static constexpr bool PERM = true;
    const bf16_t* proj; float* mf; bf16_t* mb;
    __device__ __forceinline__ void operator()(const f32x4 (&acc)[2][2][4][2], const Unit& u, int wr, int wc, int fr, int fq) const {
        const int row0 = u.pm * BM + wr * 64 + fr, col0 = u.pn * BM + wc * 32 + 8 * fq;
#pragma unroll
        for (int ai = 0; ai < 2; ++ai)
#pragma unroll
            for (int m = 0; m < 4; ++m) { const size_t row = (size_t)(row0 + ai * HALF + m * 16);
#pragma unroll
                for (int bj = 0; bj < 2; ++bj) { const int col = col0 + bj * HALF;
                    const u32x4 gw = *(const u32x4*)(proj + row * NPROJ + PC_GATE + STAGE * 1024 + col);
                    f32x4 g0, g1;
                    g0[0] = sigmoid_f(bflo(gw.x)); g0[1] = sigmoid_f(bfhi(gw.x)); g0[2] = sigmoid_f(bflo(gw.y)); g0[3] = sigmoid_f(bfhi(gw.y));
                    g1[0] = sigmoid_f(bflo(gw.z)); g1[1] = sigmoid_f(bfhi(gw.z)); g1[2] = sigmoid_f(bflo(gw.w)); g1[3] = sigmoid_f(bfhi(gw.w));
                    f32x4 v0 = acc[ai][bj][m][0] * g0, v1 = acc[ai][bj][m][1] * g1;
                    float* mp = mf + row * 1024 + col;
                    if (STAGE > 0) { v0 += *(const f32x4*)(mp); v1 += *(const f32x4*)(mp + 4); }
                    if (STAGE < 2) { *(f32x4*)(mp) = v0; *(f32x4*)(mp + 4) = v1; }
                    else { u32x4 w; w.x = cvt_pk_bf16(v0[0], v0[1]); w.y = cvt_pk_bf16(v0[2], v0[3]); w.z = cvt_pk_bf16(v1[0], v1[1]); w.w = cvt_pk_bf16(v1[2], v1[3]);
                        *(u32x4*)(mb + row * 1024 + col) = w; } }
                asm volatile("" ::: "memory"); }
    }
};
struct EpiWout {
    static constexpr bool PERM = false;
    const float* x; float* v;
    __device__ __forceinline__ void operator()(const f32x4 (&acc)[2][2][4][2], const Unit& u, int wr, int wc, int fr, int fq) const {
        const int row0 = u.pm * BM + wr * 64 + fr, col0 = u.pn * BM + wc * 32 + 4 * fq;
#pragma unroll
        for (int ai = 0; ai < 2; ++ai)
#pragma unroll
            for (int m = 0; m < 4; ++m) { const size_t off = (size_t)(row0 + ai * HALF + m * 16) * 1024 + col0;
#pragma unroll
                for (int bj = 0; bj < 2; ++bj)
#pragma unroll
                    for (int n = 0; n < 2; ++n) { const f32x4 xv = *(const f32x4*)(x + off + bj * HALF + n * 16);
                        *(f32x4*)(v + off + bj * HALF + n * 16) = xv * DN_ALPHA + acc[ai][bj][m][n]; }
                asm volatile("" ::: "memory"); }
    }
};
struct EpiMoe1 {
    static constexpr bool PERM = true;
    bf16_t* act; const float* b1;
    __device__ __forceinline__ void operator()(const f32x4 (&acc)[2][2][4][2], const Unit& u, int wr, int wc, int fr, int fq) const {
        const int e = u.pn >> 3, tl = u.pn & 7;
        const int row0 = u.pm * BM + wr * 64 + fr, col0 = tl * 128 + wc * 32 + 8 * fq;
        const float* bp = b1 + (size_t)e * 2048 + col0;
        const f32x4 bg0 = *(const f32x4*)(bp), bg1 = *(const f32x4*)(bp + 4), bl0 = *(const f32x4*)(bp + 1024), bl1 = *(const f32x4*)(bp + 1028);
#pragma unroll
        for (int ai = 0; ai < 2; ++ai)
#pragma unroll
            for (int m = 0; m < 4; ++m) { bf16_t* rowp = act + (size_t)(row0 + ai * HALF + m * 16) * 1024 + col0;
                f32x4 o[2];
#pragma unroll
                for (int n = 0; n < 2; ++n) { const f32x4 gg = acc[ai][0][m][n] + (n ? bg1 : bg0), ll = acc[ai][1][m][n] + (n ? bl1 : bl0);
#pragma unroll
                    for (int q = 0; q < 4; ++q) { const float gv = fminf(gg[q], 7.0f), lv = fminf(fmaxf(ll[q], -7.0f), 7.0f);
                        o[n][q] = gv * sigmoid_f(1.702f * gv) * (lv + 1.0f); } }
                u32x4 w; w.x = cvt_pk_bf16(o[0][0], o[0][1]); w.y = cvt_pk_bf16(o[0][2], o[0][3]); w.z = cvt_pk_bf16(o[1][0], o[1][1]); w.w = cvt_pk_bf16(o[1][2], o[1][3]);
                *(u32x4*)(rowp) = w; }
    }
};
struct EpiMoe2 {
    static constexpr bool PERM = true;
    bf16_t* ys; const float* b2; const float* wbuf;
    __device__ __forceinline__ void operator()(const f32x4 (&acc)[2][2][4][2], const Unit& u, int wr, int wc, int fr, int fq) const {
        const int e = u.pn >> 2, tl = u.pn & 3;
        const int row0 = u.pm * BM + wr * 64 + fr, col0 = tl * 256 + wc * 32 + 8 * fq;
        const float* bp = b2 + (size_t)e * 1024 + col0;
        f32x4 bv[2][2];
#pragma unroll
        for (int bj = 0; bj < 2; ++bj) { bv[bj][0] = *(const f32x4*)(bp + bj * HALF); bv[bj][1] = *(const f32x4*)(bp + bj * HALF + 4); }
#pragma unroll
        for (int ai = 0; ai < 2; ++ai)
#pragma unroll
            for (int m = 0; m < 4; ++m) { const int row = row0 + ai * HALF + m * 16; const float ww = wbuf[row]; bf16_t* rowp = ys + (size_t)row * 1024 + col0;
#pragma unroll
                for (int bj = 0; bj < 2; ++bj) { const f32x4 v0 = (acc[ai][bj][m][0] + bv[bj][0]) * ww, v1 = (acc[ai][bj][m][1] + bv[bj][1]) * ww;
                    u32x4 w; w.x = cvt_pk_bf16(v0[0], v0[1]); w.y = cvt_pk_bf16(v0[2], v0[3]); w.z = cvt_pk_bf16(v1[0], v1[1]); w.w = cvt_pk_bf16(v1[2], v1[3]);
                    *(u32x4*)(rowp + bj * HALF) = w; } }
    }
};
struct MoeOrder {
    int nN, G, c, total; const LAS int* blk_e;
    __device__ __forceinline__ bool next(int i, Unit& u) const {
        const long L = (long)i * G + c; if (L >= total) return false;
        const int rb = (int)(L / nN), tl = (int)(L % nN); u.pm = rb; u.pn = blk_e[rb] * nN + tl; return true;
    }
    __device__ __forceinline__ void a_ready(const Unit&) const {}
    __device__ __forceinline__ void done(const Unit&) const {}
};
}
struct Args { const float* in[30]; float* out; unsigned char* ws; int ph_lo, ph_hi, li, pad; };
typedef const __attribute__((address_space(4))) Args* ArgsP;
enum { I_X = 0, I_WIN, I_LCW, I_LCB, I_LWA, I_LBA, I_LWX, I_LBX, I_LLAM, I_MIB, I_MFB, I_MNG, I_GCW, I_GAL, I_GDT, I_GNG, I_WBA, I_WBB, I_WBC, I_WOUT, I_LN1G, I_LN1B, I_RW, I_RB, I_W1, I_B1, I_W2, I_B2, I_LN2G, I_LN2B };

template <int MODE> __device__ __forceinline__ int col_map(int n) {
    if (MODE == 1) {
        if (n < 3072) return n;
        if (n < 3076) return 8704 + (n - 3072);
        if (n < 3080) return 8708 + (n - 3076);
        if (n < 5128) return n - 8;
        if (n < 5136) return 8712 + (n - 5128);
        if (n < 5144) return 8720 + (n - 5136);
        return n - 24;
    } else if (MODE == 2) {
        if (n < 1024) return (n >> 7) * 256 + (n & 127);
        const int q = n - 1024; return (q >> 7) * 256 + 128 + (q & 127);
    }
    return n;
}
template <int MODE> __device__ __forceinline__ void transpose_item(const float* W, int N, bf16_t* WT, int ldk, int koff, LAS float* scr, int kb, int nb, int lane) {
    const int k0 = 64 * kb, n0 = 32 * nb; const int nsrc = n0 + (lane & 31);
#pragma unroll 8
    for (int i = 0; i < 32; ++i) { const int kk = 2 * i + (lane >> 5); scr[kk * 33 + (lane & 31)] = (nsrc < N) ? W[(size_t)(k0 + kk) * N + nsrc] : 0.f; }
    LDS_WAIT(); asm volatile("" ::: "memory");
    const int c = lane & 7;
#pragma unroll
    for (int j = 0; j < 4; ++j) { const int nl = (lane >> 3) + 8 * j, n = n0 + nl; const LAS float* s = scr + (8 * c) * 33 + nl;
        u32x4 o; o.x = pk2(s[0 * 33], s[1 * 33]); o.y = pk2(s[2 * 33], s[3 * 33]); o.z = pk2(s[4 * 33], s[5 * 33]); o.w = pk2(s[6 * 33], s[7 * 33]);
        if (n < N) *(u32x4*)(WT + (size_t)col_map<MODE>(n) * ldk + koff + k0 + 8 * c) = o; }
    LDS_WAIT(); asm volatile("" ::: "memory");
}
constexpr int IT_IN = 16 * 273, IT_BRA = 16 * 32, IT_BRB = 8 * 32, IT_BRC = 8 * 32, IT_OUT = 16 * 32, IT_W1 = 32 * 16 * 64, IT_W2 = 32 * 16 * 32;
constexpr int IT_G = 8 * 2 * 8;
constexpr int IT_LAYER = IT_IN + IT_BRA + IT_BRB + IT_BRC + IT_OUT + IT_W1 + IT_W2 + IT_G;
__device__ __forceinline__ void p0_convert(ArgsP a, LAS unsigned char* lds, int G) {
    int tid_ = threadIdx.x; asm volatile("" : "+v"(tid_)); const int tid = tid_, lane = tid & 63, wave = tid >> 6;
    LAS float* scr = (LAS float*)(lds + wave * 16384);
    const int gw = blockIdx.x * NWAVES + wave, NGW = G * NWAVES;
    for (int it = gw; it < 2 * IT_LAYER; it += NGW) {
        const int l = it / IT_LAYER; int r = it - l * IT_LAYER;
        unsigned char* wl = a->ws + WS_W + (size_t)l * WL_STRIDE;
        if (r < IT_IN) { transpose_item<1>(a->in[I_WIN] + (size_t)l * 1024 * DIN, DIN, (bf16_t*)(wl + WL_IN), 1024, 0, scr, r / 273, r % 273, lane); continue; } r -= IT_IN;
        if (r < IT_BRA) { transpose_item<0>(a->in[I_WBA] + (size_t)l * 1024 * 1024, 1024, (bf16_t*)(wl + WL_BR), 2048, 0, scr, r / 32, r % 32, lane); continue; } r -= IT_BRA;
        if (r < IT_BRB) { transpose_item<0>(a->in[I_WBB] + (size_t)l * 512 * 1024, 1024, (bf16_t*)(wl + WL_BR), 2048, 1024, scr, r / 32, r % 32, lane); continue; } r -= IT_BRB;
        if (r < IT_BRC) { transpose_item<0>(a->in[I_WBC] + (size_t)l * 512 * 1024, 1024, (bf16_t*)(wl + WL_BR), 2048, 1536, scr, r / 32, r % 32, lane); continue; } r -= IT_BRC;
        if (r < IT_OUT) { transpose_item<0>(a->in[I_WOUT] + (size_t)l * 1024 * 1024, 1024, (bf16_t*)(wl + WL_OUT), 1024, 0, scr, r / 32, r % 32, lane); continue; } r -= IT_OUT;
        if (r < IT_W1) { const int e = r / 1024, q = r % 1024;
            transpose_item<2>(a->in[I_W1] + ((size_t)l * NE + e) * 1024 * 2048, 2048, (bf16_t*)(wl + WL_W1) + (size_t)e * 2048 * 1024, 1024, 0, scr, q / 64, q % 64, lane); continue; } r -= IT_W1;
        if (r < IT_W2) { const int e = r / 512, q = r % 512;
            transpose_item<0>(a->in[I_W2] + ((size_t)l * NE + e) * 1024 * 1024, 1024, (bf16_t*)(wl + WL_W2) + (size_t)e * 1024 * 1024, 1024, 0, scr, q / 32, q % 32, lane); continue; } r -= IT_W2;
        { const int h = r >> 4, gate = (r >> 3) & 1, q = r & 7;
            transpose_item<0>(a->in[gate ? I_LWX : I_LWA] + ((size_t)l * 8 + h) * 128 * 128, 128, (bf16_t*)(wl + WL_G) + (size_t)(h * 256 + gate * 128) * 128, 128, 0, scr, q >> 2, q & 3, lane); }
    }
    const size_t gt = (size_t)blockIdx.x * 512 + tid, GT = (size_t)G * 512;
    for (size_t i = gt; i < (size_t)2 * 232 * 128; i += GT) { const int l = (int)(i / (232 * 128)); const size_t q = i % (232 * 128);
        *(u32x4*)(a->ws + WS_W + (size_t)l * WL_STRIDE + WL_IN + ((size_t)8728 * 1024) * 2 + q * 16) = (u32x4){0u, 0u, 0u, 0u}; }
    const float* x = a->in[I_X]; bf16_t* xb = (bf16_t*)(a->ws + WS_XB);
    for (size_t i = gt; i < (size_t)T_ * D_ / 8; i += GT) { const f32x4 v0 = *(const f32x4*)(x + i * 8), v1 = *(const f32x4*)(x + i * 8 + 4);
        u32x4 w; w.x = pk2(v0[0], v0[1]); w.y = pk2(v0[2], v0[3]); w.z = pk2(v1[0], v1[1]); w.w = pk2(v1[2], v1[3]); *(u32x4*)(xb + i * 8) = w; }
}

constexpr int TB = 32;
__device__ __forceinline__ void lru_naive(ArgsP a, int l, int u, LAS unsigned char* lds, const bf16_t* proj, bf16_t* H) {
    int tid_ = threadIdx.x; asm volatile("" : "+v"(tid_)); const int tid = tid_, b = u >> 3, h = u & 7, c = tid >> 2, p = tid & 3, chg = h * 128 + c;
    const float* wa = a->in[I_LWA] + ((size_t)l * 8 + h) * 128 * 128; const float* wx = a->in[I_LWX] + ((size_t)l * 8 + h) * 128 * 128;
    float wra[32], wrx[32];
#pragma unroll
    for (int i = 0; i < 32; ++i) { wra[i] = wa[(p * 32 + i) * 128 + c]; wrx[i] = wx[(p * 32 + i) * 128 + c]; }
    const float ba = a->in[I_LBA][l * 1024 + chg], bx = a->in[I_LBX][l * 1024 + chg];
    const float sp = softplus_f(-a->in[I_LLAM][l * 1024 + chg]);
    const float* cw = a->in[I_LCW] + (size_t)l * 4 * 1024 + chg; const float cw0 = cw[0], cw1 = cw[1024], cw2 = cw[2048], cw3 = cw[3072], cb = a->in[I_LCB][l * 1024 + chg];
    LAS bf16_t* xs = (LAS bf16_t*)(lds);
    LAS bf16_t* ys = (LAS bf16_t*)(lds + 8192);
    LAS float* xa_s = (LAS float*)(lds + 16384);
    const int srow = tid >> 4, scol = (tid & 15) * 8;
    const size_t tok0 = (size_t)b * SEQ_;
    u32x4 px = *(const u32x4*)(proj + (tok0 + srow) * NPROJ + PC_LRUX + h * 128 + scol);
    u32x4 py = *(const u32x4*)(proj + (tok0 + srow) * NPROJ + PC_LRUY + h * 128 + scol);
    float hs = 0.f, x1 = 0.f, x2 = 0.f, x3 = 0.f;
    for (int blk = 0; blk < SEQ_ / TB; ++blk) {
        __syncthreads();
        *(LAS u32x4*)(xs + srow * 128 + scol) = px; *(LAS u32x4*)(ys + srow * 128 + scol) = py;
        __syncthreads();
        if (blk + 1 < SEQ_ / TB) { const size_t tk = tok0 + (size_t)(blk + 1) * TB + srow;
            px = *(const u32x4*)(proj + tk * NPROJ + PC_LRUX + h * 128 + scol); py = *(const u32x4*)(proj + tk * NPROJ + PC_LRUY + h * 128 + scol); }
        for (int s = 0; s < TB; ++s) {
            const float xraw = bf2f(xs[s * 128 + c]);
            const float xa = cw0 * x3 + cw1 * x2 + cw2 * x1 + cw3 * xraw + cb;
            x3 = x2; x2 = x1; x1 = xraw;
            LAS float* xb_ = xa_s + (s & 1) * 128;
            if (p == 0) xb_[c] = xa;
            __syncthreads();
            float sa = 0.f, sx = 0.f;
#pragma unroll
            for (int i4 = 0; i4 < 8; ++i4) { const f32x4 xv = *(const LAS f32x4*)(xb_ + p * 32 + i4 * 4);
#pragma unroll
                for (int q = 0; q < 4; ++q) { sa += xv[q] * wra[i4 * 4 + q]; sx += xv[q] * wrx[i4 * 4 + q]; } }
            sa += __shfl_xor(sa, 1); sa += __shfl_xor(sa, 2); sx += __shfl_xor(sx, 1); sx += __shfl_xor(sx, 2);
            const float r = 1.f / (1.f + expf(-(sa + ba))), ig = 1.f / (1.f + expf(-(sx + bx)));
            const float log_a = -8.0f * r * sp, av = expf(log_a), mult = sqrtf(-expm1f(2.0f * log_a));
            hs = av * hs + mult * (ig * xa);
            if (p == 0) { const float y = bf2f(ys[s * 128 + c]);
                H[(tok0 + (size_t)blk * TB + s) * 2048 + chg] = (bf16_t)f2bf(hs * gelu_tanh_f(y)); }
        }
    }
}
__device__ __forceinline__ void mlstm_naive(ArgsP a, int l, int u, LAS unsigned char* lds, const bf16_t* proj, const float* gsm, bf16_t* H) {
    int tid_ = threadIdx.x; asm volatile("" : "+v"(tid_)); const int tid = tid_, lane = tid & 63, wave = tid >> 6, b = u >> 2, hd = u & 3, j = tid & 127;
    LAS float* qs = (LAS float*)(lds);
    LAS float* ks = (LAS float*)(lds + 8192);
    LAS float* vs = (LAS float*)(lds + 16384);
    LAS float* os = (LAS float*)(lds + 32768);
    LAS float* gi = (LAS float*)(lds + 49152);
    LAS float* gf = (LAS float*)(lds + 49152 + 128);
    LAS float* red = (LAS float*)(lds + 49152 + 256);
    const float ib = a->in[I_MIB][l * 4 + hd], fb = a->in[I_MFB][l * 4 + hd], gn = a->in[I_MNG][(size_t)l * 512 + hd * 128 + j];
    const size_t tok0 = (size_t)b * SEQ_;
    const int qa_row = (tid & 255) >> 3, qa_c8 = (tid & 7) * 8; const int qa_col = (tid < 256 ? PC_MLQ : PC_MLK) + hd * 64 + qa_c8;
    const int vb_row = tid >> 4, vb_c8 = (tid & 15) * 8;
    u32x4 pa, pb, pc; float pg = 0.f;
#define ML_ISSUE(blk_) do { const size_t t0 = tok0 + (size_t)(blk_) * TB; \
        pa = *(const u32x4*)(proj + (t0 + qa_row) * NPROJ + qa_col); \
        pb = *(const u32x4*)(proj + (t0 + vb_row) * NPROJ + PC_MLV + hd * 128 + vb_c8); \
        pc = *(const u32x4*)(proj + (t0 + vb_row) * NPROJ + PC_MLO + hd * 128 + vb_c8); \
        if (tid < 64) pg = gsm[(t0 + (tid & 31)) * 32 + (tid < 32 ? 0 : 4) + hd]; } while (0)
    ML_ISSUE(0);
    float C[64], n[64];
#pragma unroll
    for (int r = 0; r < 64; ++r) { C[r] = 0.f; n[r] = 0.f; }
    for (int blk = 0; blk < SEQ_ / TB; ++blk) {
        __syncthreads();
        { LAS float* d = (tid < 256 ? qs : ks) + qa_row * 64 + qa_c8;
          *(LAS f32x4*)(d) = (f32x4){bflo(pa.x), bfhi(pa.x), bflo(pa.y), bfhi(pa.y)}; *(LAS f32x4*)(d + 4) = (f32x4){bflo(pa.z), bfhi(pa.z), bflo(pa.w), bfhi(pa.w)};
          LAS float* dv = vs + vb_row * 128 + vb_c8;
          *(LAS f32x4*)(dv) = (f32x4){bflo(pb.x), bfhi(pb.x), bflo(pb.y), bfhi(pb.y)}; *(LAS f32x4*)(dv + 4) = (f32x4){bflo(pb.z), bfhi(pb.z), bflo(pb.w), bfhi(pb.w)};
          LAS float* dz = os + vb_row * 128 + vb_c8;
          *(LAS f32x4*)(dz) = (f32x4){bflo(pc.x), bfhi(pc.x), bflo(pc.y), bfhi(pc.y)}; *(LAS f32x4*)(dz + 4) = (f32x4){bflo(pc.z), bfhi(pc.z), bflo(pc.w), bfhi(pc.w)};
          if (tid < 32) gi[tid] = pg; else if (tid < 64) gf[tid - 32] = pg; }
        __syncthreads();
        if (blk + 1 < SEQ_ / TB) ML_ISSUE(blk + 1);
        for (int s = 0; s < TB; ++s) {
            float hj = 0.f;
            if (tid < 128) {
                const float f = 1.f / (1.f + expf(-(gf[s] + fb))), ie = expf(gi[s] + ib);
                const float vj = vs[s * 128 + j];
                float num = 0.f, den = 0.f;
#pragma unroll
                for (int r4 = 0; r4 < 16; ++r4) { const f32x4 kk = *(const LAS f32x4*)(ks + s * 64 + r4 * 4), qq = *(const LAS f32x4*)(qs + s * 64 + r4 * 4);
#pragma unroll
                    for (int q = 0; q < 4; ++q) { const int r = r4 * 4 + q; const float ik = ie * kk[q];
                        C[r] = f * C[r] + ik * vj; n[r] = f * n[r] + ik; num += qq[q] * C[r]; den += qq[q] * n[r]; } }
                num *= 0.125f; den *= 0.125f;
                hj = num / fmaxf(fabsf(den), 1.0f);
                const float ss = wave_sum(hj * hj);
                if (lane == 0) red[(s & 1) * 2 + wave] = ss;
            }
            __syncthreads();
            if (tid < 128) {
                const float tot = red[(s & 1) * 2] + red[(s & 1) * 2 + 1];
                const float o = hj * rsqrtf(tot * (1.0f / 128.0f) + RMS_EPS) * gn * sigmoid_f(os[s * 128 + j]);
                H[(tok0 + (size_t)blk * TB + s) * 2048 + 1024 + hd * 128 + j] = (bf16_t)f2bf(o);
            }
        }
    }
}
__device__ __forceinline__ void gdn_naive(ArgsP a, int l, int u, LAS unsigned char* lds, const bf16_t* proj, const float* gsm, bf16_t* H) {
    int tid_ = threadIdx.x; asm volatile("" : "+v"(tid_)); const int tid = tid_, lane = tid & 63, b = u >> 3, hd = u & 7;
    LAS float* rq = (LAS float*)(lds);
    LAS float* rk = (LAS float*)(lds + 9216);
    LAS float* rv = (LAS float*)(lds + 18432);
    LAS float* zs = (LAS float*)(lds + 27648);
    LAS float* ga = (LAS float*)(lds + 27648 + 8192);
    LAS float* gb = ga + TB;
    const float* cw = a->in[I_GCW] + (size_t)l * 4 * 1536;
    float cq[4], ck[4], cv[4];
#pragma unroll
    for (int i = 0; i < 4; ++i) { cq[i] = cw[i * 1536 + hd * 64 + lane]; ck[i] = cw[i * 1536 + 512 + hd * 64 + lane]; cv[i] = cw[i * 1536 + 1024 + hd * 64 + lane]; }
    const float nexpA = -expf(a->in[I_GAL][l * 8 + hd]), dtb = a->in[I_GDT][l * 8 + hd], gn = a->in[I_GNG][l * 64 + lane];
    const size_t tok0 = (size_t)b * SEQ_;
    u32x4 pp[3]; float pg = 0.f;
#define GD_ISSUE(blk_) do { const int tl0 = (blk_) * TB; \
        _Pragma("unroll") for (int i = 0; i < 3; ++i) { const int pid = tid + 512 * i; pp[i] = (u32x4){0u, 0u, 0u, 0u}; \
            if (pid < 840) { const int arr = pid / 280, rem = pid % 280, row = rem >> 3, c8 = (rem & 7) * 8; const int tl = tl0 - 3 + row; \
                if (tl >= 0) pp[i] = *(const u32x4*)(proj + (tok0 + tl) * NPROJ + (arr == 0 ? PC_GDQ : (arr == 1 ? PC_GDK : PC_GDV)) + hd * 64 + c8); } \
            else if (pid < 1096) { const int zp = pid - 840, row = zp >> 3, c8 = (zp & 7) * 8; \
                pp[i] = *(const u32x4*)(proj + (tok0 + tl0 + row) * NPROJ + PC_GDZ + hd * 64 + c8); } } \
        if (tid < 64) pg = gsm[(tok0 + tl0 + (tid & 31)) * 32 + (tid < 32 ? 8 : 16) + hd]; } while (0)
    GD_ISSUE(0);
    float S[64];
#pragma unroll
    for (int i = 0; i < 64; ++i) S[i] = 0.f;
    for (int blk = 0; blk < SEQ_ / TB; ++blk) {
        __syncthreads();
#pragma unroll
        for (int i = 0; i < 3; ++i) { const int pid = tid + 512 * i; LAS float* d = nullptr;
            if (pid < 840) { const int arr = pid / 280, rem = pid % 280, row = rem >> 3, c8 = (rem & 7) * 8; d = (arr == 0 ? rq : (arr == 1 ? rk : rv)) + row * 64 + c8; }
            else if (pid < 1096) { const int zp = pid - 840, row = zp >> 3, c8 = (zp & 7) * 8; d = zs + row * 64 + c8; }
            if (pid < 1096) { const u32x4 w = pp[i];
                *(LAS f32x4*)(d) = (f32x4){bflo(w.x), bfhi(w.x), bflo(w.y), bfhi(w.y)}; *(LAS f32x4*)(d + 4) = (f32x4){bflo(w.z), bfhi(w.z), bflo(w.w), bfhi(w.w)}; } }
        if (tid < 32) ga[tid] = pg; else if (tid < 64) gb[tid - 32] = pg;
        __syncthreads();
        if (blk + 1 < SEQ_ / TB) GD_ISSUE(blk + 1);
        if (tid < 64) {
            for (int s = 0; s < TB; ++s) {
                float qv = 0.f, kv = 0.f, vv = 0.f;
#pragma unroll
                for (int i = 0; i < 4; ++i) { qv += cq[i] * rq[(s + i) * 64 + lane]; kv += ck[i] * rk[(s + i) * 64 + lane]; vv += cv[i] * rv[(s + i) * 64 + lane]; }
                qv = silu_f(qv); kv = silu_f(kv); vv = silu_f(vv);
                const float qn = qv * rsqrtf(wave_sum(qv * qv) + RMS_EPS) * 0.125f;
                const float kn = kv * rsqrtf(wave_sum(kv * kv) + RMS_EPS);
                const float g = nexpA * softplus_f(ga[s] + dtb), alpha = expf(g), beta = 1.f / (1.f + expf(-gb[s]));
                float kS = 0.f;
#pragma unroll
                for (int i = 0; i < 64; ++i) kS += __builtin_bit_cast(float, __builtin_amdgcn_readlane(__builtin_bit_cast(int, kn), i)) * S[i];
                const float dl = beta * (vv - alpha * kS);
                float o = 0.f;
#pragma unroll
                for (int i = 0; i < 64; ++i) { const float ki = __builtin_bit_cast(float, __builtin_amdgcn_readlane(__builtin_bit_cast(int, kn), i));
                    const float qi = __builtin_bit_cast(float, __builtin_amdgcn_readlane(__builtin_bit_cast(int, qn), i));
                    S[i] = alpha * S[i] + ki * dl; o += qi * S[i]; }
                const float ms = wave_sum(o * o) * (1.0f / 64.0f);
                const float out = o * rsqrtf(ms + RMS_EPS) * gn * silu_f(zs[s * 64 + lane]);
                H[(tok0 + (size_t)blk * TB + s) * 2048 + 1536 + hd * 64 + lane] = (bf16_t)f2bf(out);
            }
        }
    }
}

__device__ __forceinline__ void p5_ln1_router(ArgsP a, int l, LAS unsigned char* lds, int G) {
    int tid_ = threadIdx.x; asm volatile("" : "+v"(tid_)); const int tid = tid_, lane = tid & 63, wave = tid >> 6;
    LAS float* rwT = (LAS float*)lds;
    LAS int* hist = (LAS int*)(lds + MISC_OFF);
    const float* rw = a->in[I_RW] + (size_t)l * 1024 * 32;
    for (int idx = tid; idx < 32768; idx += 512) { const int e = idx >> 10, i = idx & 1023; rwT[idx] = rw[i * 32 + e]; }
    const float* v = (const float*)(a->ws + WS_V); float* x1 = (float*)(a->ws + WS_X1); bf16_t* x1b = (bf16_t*)(a->ws + WS_X1B);
    int* tke = (int*)(a->ws + WS_TKE); float* tkw = (float*)(a->ws + WS_TKW); int* ghist = (int*)(a->ws + WS_HIST);
    f32x4 gg[4], bb[4];
#pragma unroll
    for (int j = 0; j < 4; ++j) { gg[j] = *(const f32x4*)(a->in[I_LN1G] + l * 1024 + 4 * lane + 256 * j); bb[j] = *(const f32x4*)(a->in[I_LN1B] + l * 1024 + 4 * lane + 256 * j); }
    const float rbias = lane < 32 ? a->in[I_RB][l * 32 + lane] : 0.f;
    for (int ch = blockIdx.x; ch < NCHUNK; ch += G) {
        __syncthreads();
        if (tid < 32) hist[tid] = 0;
        __syncthreads();
        for (int tt = 0; tt < 16; ++tt) {
            const size_t t = (size_t)ch * CHTOK + wave * 16 + tt;
            f32x4 xv[4]; float s = 0.f;
#pragma unroll
            for (int j = 0; j < 4; ++j) { xv[j] = *(const f32x4*)(v + t * 1024 + 4 * lane + 256 * j); s += (xv[j][0] + xv[j][1]) + (xv[j][2] + xv[j][3]); }
            const float mean = wave_sum(s) * (1.0f / 1024.0f); float s2 = 0.f;
#pragma unroll
            for (int j = 0; j < 4; ++j) { xv[j] = xv[j] - mean; s2 += (xv[j][0] * xv[j][0] + xv[j][1] * xv[j][1]) + (xv[j][2] * xv[j][2] + xv[j][3] * xv[j][3]); }
            const float rstd = rsqrtf(wave_sum(s2) * (1.0f / 1024.0f) + LN_EPS);
#pragma unroll
            for (int j = 0; j < 4; ++j) { xv[j] = xv[j] * rstd * gg[j] + bb[j];
                *(f32x4*)(x1 + t * 1024 + 4 * lane + 256 * j) = xv[j];
                u32x2 w; w.x = pk2(xv[j][0], xv[j][1]); w.y = pk2(xv[j][2], xv[j][3]); *(u32x2*)(x1b + t * 1024 + 4 * lane + 256 * j) = w; }
            float lg = 0.f;
#pragma unroll
            for (int e = 0; e < 32; ++e) { float pe = 0.f;
#pragma unroll
                for (int j = 0; j < 4; ++j) { const f32x4 w = *(const LAS f32x4*)(rwT + e * 1024 + 4 * lane + 256 * j); pe += (xv[j][0] * w[0] + xv[j][1] * w[1]) + (xv[j][2] * w[2] + xv[j][3] * w[3]); }
                pe = wave_sum(pe); if (lane == e) lg = pe; }
            float val = lane < 32 ? lg + rbias : -INFINITY;
            float tv[4]; int ti[4];
#pragma unroll
            for (int k = 0; k < 4; ++k) { const float m = wave_max(val); const unsigned long long bal = __ballot(val == m); const int idx = __ffsll((long long)bal) - 1;
                tv[k] = m; ti[k] = idx; if (lane == idx) val = -INFINITY; }
            const float e1 = expf(tv[1] - tv[0]), e2 = expf(tv[2] - tv[0]), e3 = expf(tv[3] - tv[0]); const float inv = 1.0f / (1.0f + e1 + e2 + e3);
            if (lane < 4) { const int ei = lane == 0 ? ti[0] : (lane == 1 ? ti[1] : (lane == 2 ? ti[2] : ti[3]));
                const float wi = (lane == 0 ? 1.0f : (lane == 1 ? e1 : (lane == 2 ? e2 : e3))) * inv;
                tke[t * 4 + lane] = ei; tkw[t * 4 + lane] = wi; __hip_atomic_fetch_add(&hist[ei], 1, __ATOMIC_RELAXED, __HIP_MEMORY_SCOPE_WORKGROUP); }
        }
        __syncthreads();
        if (tid < 32) ghist[ch * 32 + tid] = hist[tid];
    }
}

__device__ __forceinline__ void p6_slots(ArgsP a, LAS unsigned char* lds, int G) {
    int tid_ = threadIdx.x; asm volatile("" : "+v"(tid_)); const int tid = tid_, lane = tid & 63, wave = tid >> 6;
    LAS int* hs = (LAS int*)lds;
    LAS int* cnt = (LAS int*)(lds + 32768);
    LAS int* bst = (LAS int*)(lds + 32768 + 256);
    LAS int* te = (LAS int*)(lds + 36864);
    LAS int* sl = (LAS int*)(lds + 36864 + 2048);
    const int* ghist = (const int*)(a->ws + WS_HIST);
    for (int i = tid; i < NCHUNK * 32; i += 512) hs[i] = ghist[i];
    __syncthreads();
    if (tid < 32) { int run = 0; for (int ch = 0; ch < NCHUNK; ++ch) { const int c = hs[ch * 32 + tid]; hs[ch * 32 + tid] = run; run += c; } cnt[tid] = run; }
    __syncthreads();
    if (tid == 0) { int bs = 0; for (int e = 0; e < 32; ++e) { bst[e] = bs; bs += (cnt[e] + 255) >> 8; } bst[32] = bs; }
    __syncthreads();
    if (blockIdx.x == 0 && tid <= 32) ((int*)(a->ws + WS_META))[tid] = bst[tid];
    const int* tke = (const int*)(a->ws + WS_TKE); const float* tkw = (const float*)(a->ws + WS_TKW);
    int* slot = (int*)(a->ws + WS_SLOT); float* wbuf = (float*)(a->ws + WS_WBUF);
    const bf16_t* x1b = (const bf16_t*)(a->ws + WS_X1B); bf16_t* xs = (bf16_t*)(a->ws + WS_OV + OV_XS);
    for (int ch = blockIdx.x; ch < NCHUNK; ch += G) {
        __syncthreads();
        te[tid] = tke[(size_t)ch * 512 + tid];
        __syncthreads();
        if (tid < 32) { int rank = bst[tid] * 256 + hs[ch * 32 + tid]; for (int p = 0; p < 512; ++p) if (te[p] == tid) sl[p] = rank++; }
        __syncthreads();
        { const size_t pi = (size_t)ch * 512 + tid; const int s_ = sl[tid]; slot[pi] = s_; wbuf[s_] = tkw[pi]; }
        for (int tt = 0; tt < 16; ++tt) { const int tl = wave * 16 + tt; const size_t t = (size_t)ch * CHTOK + tl;
            const u32x4 r0 = *(const u32x4*)(x1b + t * 1024 + lane * 8), r1 = *(const u32x4*)(x1b + t * 1024 + 512 + lane * 8);
#pragma unroll
            for (int k = 0; k < 4; ++k) { const size_t s_ = (size_t)sl[tl * 4 + k]; *(u32x4*)(xs + s_ * 1024 + lane * 8) = r0; *(u32x4*)(xs + s_ * 1024 + 512 + lane * 8) = r1; } }
    }
}
__device__ __forceinline__ int moe_table(ArgsP a, LAS unsigned char* lds) {
    int tid_ = threadIdx.x; asm volatile("" : "+v"(tid_)); const int tid = tid_;
    LAS int* bst = (LAS int*)(lds + MISC_OFF);
    LAS int* blk_e = (LAS int*)(lds + MISC_OFF + 256);
    __syncthreads();
    if (tid <= 32) bst[tid] = ((const int*)(a->ws + WS_META))[tid];
    __syncthreads();
    const int nb = bst[32];
    for (int rb = tid; rb < nb; rb += 512) { int e = 0; while (e < 31 && rb >= bst[e + 1]) ++e; blk_e[rb] = e; }
    __syncthreads();
    return nb;
}

__device__ __forceinline__ void p9_combine_ln2(ArgsP a, int l, float* xout, int G) {
    int tid_ = threadIdx.x; asm volatile("" : "+v"(tid_)); const int tid = tid_, lane = tid & 63, wave = tid >> 6;
    const float* x1 = (const float*)(a->ws + WS_X1); const int* slot = (const int*)(a->ws + WS_SLOT);
    const bf16_t* ys = (const bf16_t*)(a->ws + WS_OV + OV_YS); bf16_t* xb = (bf16_t*)(a->ws + WS_XB);
    f32x4 gg[4], bb[4];
#pragma unroll
    for (int j = 0; j < 4; ++j) { gg[j] = *(const f32x4*)(a->in[I_LN2G] + l * 1024 + 4 * lane + 256 * j); bb[j] = *(const f32x4*)(a->in[I_LN2B] + l * 1024 + 4 * lane + 256 * j); }
    for (size_t t = (size_t)blockIdx.x * NWAVES + wave; t < (size_t)T_; t += (size_t)G * NWAVES) {
        int sk[4];
#pragma unroll
        for (int k = 0; k < 4; ++k) sk[k] = slot[t * 4 + k];
        f32x4 xv[4]; float s = 0.f;
#pragma unroll
        for (int j = 0; j < 4; ++j) { xv[j] = *(const f32x4*)(x1 + t * 1024 + 4 * lane + 256 * j) * DN_ALPHA;
            f32x4 ya = (f32x4){0.f, 0.f, 0.f, 0.f};
#pragma unroll
            for (int k = 0; k < 4; ++k) { const u32x2 w = *(const u32x2*)(ys + (size_t)sk[k] * 1024 + 4 * lane + 256 * j);
                ya[0] += bflo(w.x); ya[1] += bfhi(w.x); ya[2] += bflo(w.y); ya[3] += bfhi(w.y); }
            xv[j] += ya; s += (xv[j][0] + xv[j][1]) + (xv[j][2] + xv[j][3]); }
        const float mean = wave_sum(s) * (1.0f / 1024.0f); float s2 = 0.f;
#pragma unroll
        for (int j = 0; j < 4; ++j) { xv[j] = xv[j] - mean; s2 += (xv[j][0] * xv[j][0] + xv[j][1] * xv[j][1]) + (xv[j][2] * xv[j][2] + xv[j][3] * xv[j][3]); }
        const float rstd = rsqrtf(wave_sum(s2) * (1.0f / 1024.0f) + LN_EPS);
#pragma unroll
        for (int j = 0; j < 4; ++j) { xv[j] = xv[j] * rstd * gg[j] + bb[j];
            *(f32x4*)(xout + t * 1024 + 4 * lane + 256 * j) = xv[j];
            u32x2 w; w.x = pk2(xv[j][0], xv[j][1]); w.y = pk2(xv[j][2], xv[j][3]); *(u32x2*)(xb + t * 1024 + 4 * lane + 256 * j) = w; }
    }
}
typedef float f32x4_t __attribute__((ext_vector_type(4)));
constexpr size_t MX_LRU_PH = 0, MX_LRU_CARRY = 4 * MiB;
template <int MODE> __device__ __forceinline__ void lru_fast(ArgsP a, int l, int b, int h, int c_lo, int c_hi, LAS unsigned char* lds, const bf16_t* proj, bf16_t* H, unsigned char* mxs) {
    int tid_ = threadIdx.x; asm volatile("" : "+v"(tid_)); const int tid = tid_, lane = tid & 63, wave = __builtin_amdgcn_readfirstlane(tid >> 6), fr = lane & 15, g = lane >> 4;
    LAS bf16_t* raw = (LAS bf16_t*)(lds);
    LAS bf16_t* xa = (LAS bf16_t*)(lds + 17408);
    LAS bf16_t* ysb = (LAS bf16_t*)(lds + 34816);
    LAS bf16_t* outb = (LAS bf16_t*)(lds + 51200);
    float* PH = (float*)(mxs + MX_LRU_PH); const float* carry = (const float*)(mxs + MX_LRU_CARRY);
    const int ch = 16 * wave + fr, chg = h * 128 + ch;
    const bf16_t* wg = (const bf16_t*)(a->ws + WS_W + (size_t)l * WL_STRIDE + WL_G) + (size_t)h * 256 * 128;
    bf16x8 bra[4], brx[4];
#pragma unroll
    for (int ks = 0; ks < 4; ++ks) { bra[ks] = *(const bf16x8*)(wg + (size_t)(ch) * 128 + 32 * ks + 8 * g); brx[ks] = *(const bf16x8*)(wg + (size_t)(128 + ch) * 128 + 32 * ks + 8 * g); }
    const float ba = a->in[I_LBA][l * 1024 + chg], bx = a->in[I_LBX][l * 1024 + chg], sp = softplus_f(-a->in[I_LLAM][l * 1024 + chg]);
    const int ci = tid & 127;
    const float* cw = a->in[I_LCW] + (size_t)l * 4 * 1024 + h * 128 + ci; const float cw0 = cw[0], cw1 = cw[1024], cw2 = cw[2048], cw3 = cw[3072], cb = a->in[I_LCB][l * 1024 + h * 128 + ci];
    for (int c = c_lo; c < c_hi; ++c) {
        const size_t tok0 = (size_t)b * SEQ_ + (size_t)c * 64;
        __syncthreads();
#pragma unroll
        for (int i = 0; i < 3; ++i) { const int pid = tid + 512 * i;
            if (pid < 67 * 16) { const int row = pid >> 4, c8 = (pid & 15) * 8; const int tl = c * 64 - 3 + row; u32x4 v = (u32x4){0u, 0u, 0u, 0u};
                if (tl >= 0) v = *(const u32x4*)(proj + ((size_t)b * SEQ_ + tl) * NPROJ + PC_LRUX + h * 128 + c8);
                *(LAS u32x4*)(raw + row * 128 + c8) = v; } }
        if (MODE == 1) {
#pragma unroll
            for (int i = 0; i < 2; ++i) { const int pid = tid + 512 * i; const int row = pid >> 4, c8 = (pid & 15) * 8;
                *(LAS u32x4*)(ysb + row * 128 + c8) = *(const u32x4*)(proj + (tok0 + row) * NPROJ + PC_LRUY + h * 128 + c8); } }
        __syncthreads();
#pragma unroll
        for (int k = 0; k < 16; ++k) { const int t = (tid >> 7) + 4 * k;
            const float v = cw0 * bf2f(raw[t * 128 + ci]) + cw1 * bf2f(raw[(t + 1) * 128 + ci]) + cw2 * bf2f(raw[(t + 2) * 128 + ci]) + cw3 * bf2f(raw[(t + 3) * 128 + ci]) + cb;
            xa[t * 136 + ci] = (bf16_t)f2bf(v); }
        __syncthreads();
        f32x4_t ar[4], ax[4];
#pragma unroll
        for (int tt = 0; tt < 4; ++tt) { ar[tt] = (f32x4_t){0.f, 0.f, 0.f, 0.f}; ax[tt] = (f32x4_t){0.f, 0.f, 0.f, 0.f}; }
#pragma unroll
        for (int tt = 0; tt < 4; ++tt)
#pragma unroll
            for (int ks = 0; ks < 4; ++ks) { const bf16x8 af = *(const LAS bf16x8*)(xa + (16 * tt + fr) * 136 + 32 * ks + 8 * g);
                ar[tt] = __builtin_amdgcn_mfma_f32_16x16x32_bf16(af, bra[ks], ar[tt], 0, 0, 0);
                ax[tt] = __builtin_amdgcn_mfma_f32_16x16x32_bf16(af, brx[ks], ax[tt], 0, 0, 0); }
        float hin = 0.f, ptot = 1.f;
        if (MODE == 1) hin = carry[((size_t)b * 64 + c) * 1024 + chg];
#pragma unroll
        for (int tt = 0; tt < 4; ++tt) {
            float av[4], uv[4];
#pragma unroll
            for (int r = 0; r < 4; ++r) { const int t = 16 * tt + 4 * g + r;
                const float rg = 1.f / (1.f + expf(-(ar[tt][r] + ba))), ig = 1.f / (1.f + expf(-(ax[tt][r] + bx)));
                const float log_a = -8.0f * rg * sp; av[r] = expf(log_a); uv[r] = sqrtf(-expm1f(2.0f * log_a)) * (ig * bf2f(xa[t * 136 + ch])); }
            float A = 1.f, B = 0.f;
#pragma unroll
            for (int r = 0; r < 4; ++r) { B = av[r] * B + uv[r]; A *= av[r]; }
            { const float A1 = __shfl_up(A, 16), B1 = __shfl_up(B, 16); if (g >= 1) { B = A * B1 + B; A = A * A1; } }
            { const float A2 = __shfl_up(A, 32), B2 = __shfl_up(B, 32); if (g >= 2) { B = A * B2 + B; A = A * A2; } }
            float Ae = __shfl_up(A, 16), Be = __shfl_up(B, 16); if (g == 0) { Ae = 1.f; Be = 0.f; }
            float hcur = Ae * hin + Be;
            if (MODE == 1) {
#pragma unroll
                for (int r = 0; r < 4; ++r) { const int t = 16 * tt + 4 * g + r; hcur = av[r] * hcur + uv[r];
                    outb[t * 128 + ch] = (bf16_t)f2bf(hcur * gelu_tanh_f(bf2f(ysb[t * 128 + ch]))); }
            }
            const float hend = A * hin + B;
            hin = __shfl(hend, fr + 48); ptot *= __shfl(A, fr + 48);
        }
        if (MODE == 0) { if (g == 0) { PH[(((size_t)b * 64 + c) * 2 + 0) * 1024 + chg] = ptot; PH[(((size_t)b * 64 + c) * 2 + 1) * 1024 + chg] = hin; } }
        else {
            __syncthreads();
#pragma unroll
            for (int i = 0; i < 2; ++i) { const int pid = tid + 512 * i; const int row = pid >> 4, c8 = (pid & 15) * 8;
                *(u32x4*)(H + (tok0 + row) * 2048 + h * 128 + c8) = *(const LAS u32x4*)(outb + row * 128 + c8); }
        }
    }
}
__device__ __forceinline__ void lru_carry(unsigned char* mxs, int G) {
    const float* PH = (const float*)(mxs + MX_LRU_PH); float* carry = (float*)(mxs + MX_LRU_CARRY);
    int tid_ = threadIdx.x; asm volatile("" : "+v"(tid_));
    for (int gid = blockIdx.x * 512 + tid_; gid < NBATCH * 1024; gid += G * 512) { const int b = gid >> 10, chg = gid & 1023; float hc = 0.f;
#pragma unroll 8
        for (int c = 0; c < 64; ++c) { const size_t o = ((size_t)b * 64 + c); carry[o * 1024 + chg] = hc; hc = PH[(o * 2) * 1024 + chg] * hc + PH[(o * 2 + 1) * 1024 + chg]; } }
}
typedef float f32x16 __attribute__((ext_vector_type(16)));
typedef short bf16x4 __attribute__((ext_vector_type(4)));
constexpr size_t MXB_ML_U = 0;
constexpr size_t MXB_ML_CP = 64 * MiB;
constexpr size_t MXS_ML_NU = 6 * MiB, MXS_ML_NP = 6 * MiB + 512 * 1024, MXS_ML_SC = 7 * MiB;

__device__ __forceinline__ float wave_incl_sum(float v, int lane) {
#pragma unroll
    for (int o = 1; o < 64; o <<= 1) { const float t = __shfl_up(v, o); if (lane >= o) v += t; }
    return v;
}
__device__ __forceinline__ float wave_incl_max(float v, int lane) {
#pragma unroll
    for (int o = 1; o < 64; o <<= 1) { const float t = __shfl_up(v, o); if (lane >= o) v = fmaxf(v, t); }
    return v;
}
__device__ __forceinline__ bf16x8 pack8(float a0, float a1, float a2, float a3, float a4, float a5, float a6, float a7) {
    u32x4 w; w.x = pg8::cvt_pk_bf16(a0, a1); w.y = pg8::cvt_pk_bf16(a2, a3); w.z = pg8::cvt_pk_bf16(a4, a5); w.w = pg8::cvt_pk_bf16(a6, a7); return __builtin_bit_cast(bf16x8, w);
}
__device__ __forceinline__ bf16x8 ld_perm(const LAS bf16_t* p) {
    const u32x2 lo = *(const LAS u32x2*)(p), hi = *(const LAS u32x2*)(p + 8); u32x4 w; w.x = lo.x; w.y = lo.y; w.z = hi.x; w.w = hi.y; return __builtin_bit_cast(bf16x8, w);
}

__device__ __forceinline__ void mlstm_passA(ArgsP a, int l, LAS unsigned char* lds, const bf16_t* proj, const float* gsm, unsigned char* mxb, unsigned char* mxs, int G) {
    int tid_ = threadIdx.x; asm volatile("" : "+v"(tid_)); const int tid = tid_, lane = tid & 63, wave = __builtin_amdgcn_readfirstlane(tid >> 6), r = lane & 31, hh = lane >> 5;
    LAS bf16_t* kwT = (LAS bf16_t*)(lds);
    LAS bf16_t* vT = (LAS bf16_t*)(lds + 9216);
    LAS float* wts = (LAS float*)(lds + 27648);
    float* NU = (float*)(mxs + MXS_ML_NU); float* SC = (float*)(mxs + MXS_ML_SC);
    for (int uid = blockIdx.x; uid < 2048; uid += G) {
        const int c = uid & 63, hd = (uid >> 6) & 3, b = uid >> 8; const size_t tok0 = (size_t)b * SEQ_ + (size_t)c * 64;
        const float ib = a->in[I_MIB][l * 4 + hd], fb = a->in[I_MFB][l * 4 + hd];
        __syncthreads();
        if (wave == 0) {
            const float fpre = gsm[(tok0 + lane) * 32 + 4 + hd] + fb, ipre = gsm[(tok0 + lane) * 32 + hd] + ib;
            const float logf = -softplus_f(-fpre); const float bc = wave_incl_sum(logf, lane); const float bl = __shfl(bc, 63);
            const float ge = bl - bc + ipre; const float mloc = wave_max(ge);
            wts[lane] = expf(ge - mloc);
            if (lane == 0) { SC[(size_t)uid * 4 + 0] = bl; SC[(size_t)uid * 4 + 1] = mloc; }
        }
        const u32x4 kp = *(const u32x4*)(proj + (tok0 + lane) * NPROJ + PC_MLK + hd * 64 + wave * 8);
        const u32x4 vp0 = *(const u32x4*)(proj + (tok0 + lane) * NPROJ + PC_MLV + hd * 128 + wave * 8);
        const u32x4 vp1 = *(const u32x4*)(proj + (tok0 + lane) * NPROJ + PC_MLV + hd * 128 + 64 + wave * 8);
        __syncthreads();
        { const float w = wts[lane]; const unsigned kw[4] = {kp.x, kp.y, kp.z, kp.w};
#pragma unroll
          for (int j = 0; j < 4; ++j) { kwT[(wave * 8 + 2 * j) * 72 + lane] = (bf16_t)f2bf(w * bflo(kw[j])); kwT[(wave * 8 + 2 * j + 1) * 72 + lane] = (bf16_t)f2bf(w * bfhi(kw[j])); }
          const unsigned v0[4] = {vp0.x, vp0.y, vp0.z, vp0.w}, v1[4] = {vp1.x, vp1.y, vp1.z, vp1.w};
#pragma unroll
          for (int j = 0; j < 4; ++j) { vT[(wave * 8 + 2 * j) * 72 + lane] = (bf16_t)(v0[j] & 0xffffu); vT[(wave * 8 + 2 * j + 1) * 72 + lane] = (bf16_t)(v0[j] >> 16);
              vT[(64 + wave * 8 + 2 * j) * 72 + lane] = (bf16_t)(v1[j] & 0xffffu); vT[(64 + wave * 8 + 2 * j + 1) * 72 + lane] = (bf16_t)(v1[j] >> 16); } }
        __syncthreads();
        const int dI = wave >> 2, eJ = wave & 3;
        f32x16 acc;
#pragma unroll
        for (int i = 0; i < 16; ++i) acc[i] = 0.f;
#pragma unroll
        for (int ks = 0; ks < 4; ++ks) { const bf16x8 af = *(const LAS bf16x8*)(kwT + (32 * dI + r) * 72 + 16 * ks + 8 * hh), bf = *(const LAS bf16x8*)(vT + (32 * eJ + r) * 72 + 16 * ks + 8 * hh);
            acc = __builtin_amdgcn_mfma_f32_32x32x16_bf16(af, bf, acc, 0, 0, 0); }
        float* ud = (float*)(mxb + MXB_ML_U) + ((size_t)uid * 8 + wave) * 1024;
#pragma unroll
        for (int q = 0; q < 4; ++q) *(f32x4*)(ud + (q * 64 + lane) * 4) = (f32x4){acc[4 * q], acc[4 * q + 1], acc[4 * q + 2], acc[4 * q + 3]};
        if (tid < 64) { float s = 0.f;
#pragma unroll 8
            for (int t = 0; t < 64; ++t) s += bf2f(kwT[tid * 72 + t]);
            NU[(size_t)uid * 64 + tid] = s; }
    }
}
__device__ __forceinline__ void mlstm_passB(unsigned char* mxb, unsigned char* mxs, int G) {
    int tid_ = threadIdx.x; asm volatile("" : "+v"(tid_)); const int tid = tid_;
    const float* NU = (const float*)(mxs + MXS_ML_NU); float* NP = (float*)(mxs + MXS_ML_NP); float* SC = (float*)(mxs + MXS_ML_SC);
    for (int wu = blockIdx.x; wu < 256; wu += G) {
        const int chain = wu >> 3, tile = wu & 7;
        if (tid < 128) {
            const int lane = tid & 63, s = tid >> 6;
            float st[8]; float m = 0.f;
#pragma unroll
            for (int i = 0; i < 8; ++i) st[i] = 0.f;
#pragma unroll 4
            for (int c = 0; c < 64; ++c) { const size_t uid = (size_t)chain * 64 + c;
                const float* ud = (const float*)(mxb + MXB_ML_U) + (uid * 8 + tile) * 1024;
                const f32x4 u0 = *(const f32x4*)(ud + ((2 * s) * 64 + lane) * 4), u1 = *(const f32x4*)(ud + ((2 * s + 1) * 64 + lane) * 4);
                const float bl = SC[uid * 4 + 0], mloc = SC[uid * 4 + 1];
                *(bf16x8*)((bf16_t*)(mxb + MXB_ML_CP) + (uid * 8 + tile) * 1024 + (s * 64 + lane) * 8) = pack8(st[0], st[1], st[2], st[3], st[4], st[5], st[6], st[7]);
                if (tile == 0 && tid == 0) SC[uid * 4 + 2] = m;
                const float mn = fmaxf(bl + m, mloc), dec = expf(bl + m - mn), sc = expf(mloc - mn); m = mn;
#pragma unroll
                for (int i = 0; i < 4; ++i) { st[i] = dec * st[i] + sc * u0[i]; st[4 + i] = dec * st[4 + i] + sc * u1[i]; } }
        } else if (tile == 0 && tid < 192) {
            const int d = tid - 128; float n = 0.f, m = 0.f;
#pragma unroll 4
            for (int c = 0; c < 64; ++c) { const size_t uid = (size_t)chain * 64 + c; const float bl = SC[uid * 4 + 0], mloc = SC[uid * 4 + 1]; const float nu = NU[uid * 64 + d];
                NP[uid * 64 + d] = n; const float mn = fmaxf(bl + m, mloc), dec = expf(bl + m - mn), sc = expf(mloc - mn); m = mn; n = dec * n + sc * nu; }
        }
    }
}
__device__ __forceinline__ void mlstm_passC(ArgsP a, int l, LAS unsigned char* lds, const bf16_t* proj, const float* gsm, bf16_t* H, unsigned char* mxb, unsigned char* mxs, int first, int stride) {
    int tid_ = threadIdx.x; asm volatile("" : "+v"(tid_)); const int tid = tid_, lane = tid & 63, wave = __builtin_amdgcn_readfirstlane(tid >> 6), r = lane & 31, hh = lane >> 5;
    LAS bf16_t* qb = (LAS bf16_t*)(lds);
    LAS bf16_t* kb = (LAS bf16_t*)(lds + 9216);
    LAS bf16_t* vT = (LAS bf16_t*)(lds + 18432);
    LAS bf16_t* ob = (LAS bf16_t*)(lds + 36864);
    LAS bf16_t* outb = (LAS bf16_t*)(lds + 54272);
    LAS float* tb_rt = (LAS float*)(lds + 70656);
    LAS float* tb_ct = tb_rt + 64;
    LAS float* tb_iw = tb_rt + 128;
    LAS float* tb_em = tb_rt + 192;
    LAS float* tb_np = tb_rt + 256;
    LAS float* ssq = tb_rt + 320;
    const float* NP = (const float*)(mxs + MXS_ML_NP); const float* SC = (const float*)(mxs + MXS_ML_SC);
    for (int uid = first; uid < 2048; uid += stride) {
        const int c = uid & 63, hd = (uid >> 6) & 3, b = uid >> 8; const size_t tok0 = (size_t)b * SEQ_ + (size_t)c * 64;
        __syncthreads();
        if (wave == 0) {
            const float ib = a->in[I_MIB][l * 4 + hd], fb = a->in[I_MFB][l * 4 + hd];
            const float fpre = gsm[(tok0 + lane) * 32 + 4 + hd] + fb, ipre = gsm[(tok0 + lane) * 32 + hd] + ib;
            const float logf = -softplus_f(-fpre); const float bc = wave_incl_sum(logf, lane);
            const float rt = ipre - bc; const float cmx = wave_incl_max(rt, lane); const float mprev = SC[(size_t)uid * 4 + 2];
            const float mt = bc + fmaxf(mprev, cmx);
            tb_rt[lane] = rt; tb_ct[lane] = bc - mt; tb_iw[lane] = expf(bc + mprev - mt); tb_em[lane] = expf(-mt); tb_np[lane] = NP[(size_t)uid * 64 + lane];
        }
        { const int row = tid >> 3, c8 = (tid & 7) * 8;
          *(LAS u32x4*)(qb + row * 72 + c8) = *(const u32x4*)(proj + (tok0 + row) * NPROJ + PC_MLQ + hd * 64 + c8);
          *(LAS u32x4*)(kb + row * 72 + c8) = *(const u32x4*)(proj + (tok0 + row) * NPROJ + PC_MLK + hd * 64 + c8);
#pragma unroll
          for (int i = 0; i < 2; ++i) { const int pid = tid + 512 * i; const int orow = pid >> 4, oc8 = (pid & 15) * 8;
              *(LAS u32x4*)(ob + orow * 136 + oc8) = *(const u32x4*)(proj + (tok0 + orow) * NPROJ + PC_MLO + hd * 128 + oc8); }
          const u32x4 vp0 = *(const u32x4*)(proj + (tok0 + lane) * NPROJ + PC_MLV + hd * 128 + wave * 8);
          const u32x4 vp1 = *(const u32x4*)(proj + (tok0 + lane) * NPROJ + PC_MLV + hd * 128 + 64 + wave * 8);
          const unsigned v0[4] = {vp0.x, vp0.y, vp0.z, vp0.w}, v1[4] = {vp1.x, vp1.y, vp1.z, vp1.w};
#pragma unroll
          for (int j = 0; j < 4; ++j) { vT[(wave * 8 + 2 * j) * 72 + lane] = (bf16_t)(v0[j] & 0xffffu); vT[(wave * 8 + 2 * j + 1) * 72 + lane] = (bf16_t)(v0[j] >> 16);
              vT[(64 + wave * 8 + 2 * j) * 72 + lane] = (bf16_t)(v1[j] & 0xffffu); vT[(64 + wave * 8 + 2 * j + 1) * 72 + lane] = (bf16_t)(v1[j] >> 16); } }
        __syncthreads();
        const int eI = wave >> 1, tJ = wave & 1; const int t = 32 * tJ + r;
        f32x16 as[2];
#pragma unroll
        for (int sI = 0; sI < 2; ++sI) {
#pragma unroll
            for (int i = 0; i < 16; ++i) as[sI][i] = 0.f;
#pragma unroll
            for (int ks = 0; ks < 4; ++ks) { const bf16x8 af = *(const LAS bf16x8*)(kb + (32 * sI + r) * 72 + 16 * ks + 8 * hh), bf = *(const LAS bf16x8*)(qb + t * 72 + 16 * ks + 8 * hh);
                as[sI] = __builtin_amdgcn_mfma_f32_32x32x16_bf16(af, bf, as[sI], 0, 0, 0); } }
        const float ctt = tb_ct[t], iwt = tb_iw[t] * 0.125f, emt = tb_em[t];
        float dsum = 0.f;
#pragma unroll
        for (int sI = 0; sI < 2; ++sI)
#pragma unroll
            for (int q = 0; q < 4; ++q) { const int s0 = 32 * sI + 8 * q + 4 * hh; const f32x4 rt4 = *(const LAS f32x4*)(tb_rt + s0);
#pragma unroll
                for (int i = 0; i < 4; ++i) { const float wv = (s0 + i <= t) ? as[sI][4 * q + i] * 0.125f * __expf(ctt + rt4[i]) : 0.f; as[sI][4 * q + i] = wv; dsum += wv; } }
        float qn = 0.f;
#pragma unroll
        for (int j = 0; j < 4; ++j) { const u32x4 qw = *(const LAS u32x4*)(qb + t * 72 + 32 * hh + 8 * j); const f32x4 n0 = *(const LAS f32x4*)(tb_np + 32 * hh + 8 * j), n1 = *(const LAS f32x4*)(tb_np + 32 * hh + 8 * j + 4);
            qn += bflo(qw.x) * n0[0] + bfhi(qw.x) * n0[1] + bflo(qw.y) * n0[2] + bfhi(qw.y) * n0[3] + bflo(qw.z) * n1[0] + bfhi(qw.z) * n1[1] + bflo(qw.w) * n1[2] + bfhi(qw.w) * n1[3]; }
        float den = dsum + iwt * qn; den += __shfl_xor(den, 32);
        f32x16 an;
#pragma unroll
        for (int i = 0; i < 16; ++i) an[i] = 0.f;
#pragma unroll
        for (int sI = 0; sI < 2; ++sI)
#pragma unroll
            for (int s2 = 0; s2 < 2; ++s2) { const bf16x8 af = ld_perm(vT + (32 * eI + r) * 72 + 32 * sI + 16 * s2 + 4 * hh);
                const bf16x8 bf = pack8(as[sI][8 * s2], as[sI][8 * s2 + 1], as[sI][8 * s2 + 2], as[sI][8 * s2 + 3], as[sI][8 * s2 + 4], as[sI][8 * s2 + 5], as[sI][8 * s2 + 6], as[sI][8 * s2 + 7]);
                an = __builtin_amdgcn_mfma_f32_32x32x16_bf16(af, bf, an, 0, 0, 0); }
        const bf16_t* cpd = (const bf16_t*)(mxb + MXB_ML_CP) + (size_t)uid * 8 * 1024;
#pragma unroll
        for (int dI = 0; dI < 2; ++dI)
#pragma unroll
            for (int s2 = 0; s2 < 2; ++s2) { const bf16x8 af = *(const bf16x8*)(cpd + (size_t)(dI * 4 + eI) * 1024 + (s2 * 64 + lane) * 8);
                const u32x4 qw = __builtin_bit_cast(u32x4, ld_perm(qb + t * 72 + 32 * dI + 16 * s2 + 4 * hh));
                const bf16x8 bf = pack8(bflo(qw.x) * iwt, bfhi(qw.x) * iwt, bflo(qw.y) * iwt, bfhi(qw.y) * iwt, bflo(qw.z) * iwt, bfhi(qw.z) * iwt, bflo(qw.w) * iwt, bfhi(qw.w) * iwt);
                an = __builtin_amdgcn_mfma_f32_32x32x16_bf16(af, bf, an, 0, 0, 0); }
        const float dinv = 1.0f / fmaxf(fabsf(den), emt);
        float sq = 0.f;
#pragma unroll
        for (int i = 0; i < 16; ++i) { an[i] *= dinv; sq += an[i] * an[i]; }
        sq += __shfl_xor(sq, 32);
        if (hh == 0) ssq[eI * 64 + t] = sq;
        __syncthreads();
        const float tot = ssq[t] + ssq[64 + t] + ssq[128 + t] + ssq[192 + t];
        const float rinv = rsqrtf(tot * (1.0f / 128.0f) + RMS_EPS);
        const float* gn = a->in[I_MNG] + (size_t)l * 512 + hd * 128;
#pragma unroll
        for (int q = 0; q < 4; ++q) { const int e0 = 32 * eI + 8 * q + 4 * hh; const f32x4 g4 = *(const f32x4*)(gn + e0); const u32x2 ow = *(const LAS u32x2*)(ob + t * 136 + e0);
            const float o0 = an[4 * q] * rinv * g4[0] * sigmoid_f(bflo(ow.x)), o1 = an[4 * q + 1] * rinv * g4[1] * sigmoid_f(bfhi(ow.x));
            const float o2 = an[4 * q + 2] * rinv * g4[2] * sigmoid_f(bflo(ow.y)), o3 = an[4 * q + 3] * rinv * g4[3] * sigmoid_f(bfhi(ow.y));
            u32x2 pw; pw.x = pg8::cvt_pk_bf16(o0, o1); pw.y = pg8::cvt_pk_bf16(o2, o3); *(LAS u32x2*)(outb + t * 128 + e0) = pw; }
        __syncthreads();
#pragma unroll
        for (int i = 0; i < 2; ++i) { const int pid = tid + 512 * i; const int row = pid >> 4, c8 = (pid & 15) * 8;
            *(u32x4*)(H + (tok0 + row) * 2048 + 1024 + hd * 128 + c8) = *(const LAS u32x4*)(outb + row * 128 + c8); }
    }
}
constexpr size_t MXB_GD_ND = 96 * MiB, MXB_GD_OD = 160 * MiB, MXB_GD_T = 224 * MiB;
constexpr size_t MXT_GD_XD = 8 * MiB, MXT_GD_QD = 40 * MiB, MXT_GD_SD = 72 * MiB;
constexpr size_t MXS_GD_GL = 7 * MiB + 64 * 1024;

__device__ __forceinline__ void conv_silu8(const u32x4 (&rw)[4], const float* cw, float (&o)[8]) {
#pragma unroll
    for (int j = 0; j < 8; ++j) o[j] = 0.f;
#pragma unroll
    for (int i = 0; i < 4; ++i) { const f32x4 w0 = *(const f32x4*)(cw + i * 1536), w1 = *(const f32x4*)(cw + i * 1536 + 4); const unsigned x[4] = {rw[i].x, rw[i].y, rw[i].z, rw[i].w};
        o[0] += w0[0] * bflo(x[0]); o[1] += w0[1] * bfhi(x[0]); o[2] += w0[2] * bflo(x[1]); o[3] += w0[3] * bfhi(x[1]);
        o[4] += w1[0] * bflo(x[2]); o[5] += w1[1] * bfhi(x[2]); o[6] += w1[2] * bflo(x[3]); o[7] += w1[3] * bfhi(x[3]); }
#pragma unroll
    for (int j = 0; j < 8; ++j) o[j] = silu_f(o[j]);
}
__device__ __forceinline__ void load_rows4(const bf16_t* proj, int b, int tl, int col, u32x4 (&rw)[4]) {
#pragma unroll
    for (int i = 0; i < 4; ++i) { const int tt = tl - 3 + i; rw[i] = (u32x4){0u, 0u, 0u, 0u}; if (tt >= 0) rw[i] = *(const u32x4*)(proj + ((size_t)b * SEQ_ + tt) * NPROJ + col); }
}

__device__ __forceinline__ void gdn_passA1(ArgsP a, int l, LAS unsigned char* lds, const bf16_t* proj, const float* gsm, unsigned char* mxb, int G) {
    int tid_ = threadIdx.x; asm volatile("" : "+v"(tid_)); const int tid = tid_, lane = tid & 63, wave = __builtin_amdgcn_readfirstlane(tid >> 6), r = lane & 31, hh = lane >> 5;
    LAS unsigned char* wl = lds + wave * 16384;
    LAS bf16_t* kb = (LAS bf16_t*)wl;
    LAS float* am = (LAS float*)wl;
    LAS float* tb = (LAS float*)(lds + MISC_OFF + 1024 + wave * 512);
    const float* cwk = a->in[I_GCW] + (size_t)l * 4 * 1536 + 512;
    for (int uid = blockIdx.x * NWAVES + wave; uid < 4096; uid += G * NWAVES) {
        const int c = uid & 63, hd = (uid >> 6) & 7, b = uid >> 9; const int tl = c * 64 + lane; const size_t tok = (size_t)b * SEQ_ + tl;
        float ss = 0.f;
#pragma unroll 2
        for (int p = 0; p < 8; ++p) { u32x4 rw[4]; load_rows4(proj, b, tl, PC_GDK + hd * 64 + 8 * p, rw); float o[8]; conv_silu8(rw, cwk + hd * 64 + 8 * p, o);
#pragma unroll
            for (int j = 0; j < 8; ++j) ss += o[j] * o[j];
            *(LAS bf16x8*)(kb + lane * 72 + 8 * p) = pack8(o[0], o[1], o[2], o[3], o[4], o[5], o[6], o[7]); }
        const float rn = rsqrtf(ss + RMS_EPS);
        const float gg = -expf(a->in[I_GAL][l * 8 + hd]) * softplus_f(gsm[tok * 32 + 8 + hd] + a->in[I_GDT][l * 8 + hd]);
        const float gc = wave_incl_sum(gg, lane), beta = 1.f / (1.f + expf(-gsm[tok * 32 + 16 + hd]));
        tb[lane] = gc; tb[64 + lane] = beta * rn;
        LDS_WAIT(); asm volatile("" ::: "memory");
        bf16x8 kf[2][4];
#pragma unroll
        for (int I = 0; I < 2; ++I)
#pragma unroll
            for (int ks = 0; ks < 4; ++ks) kf[I][ks] = *(const LAS bf16x8*)(kb + (32 * I + r) * 72 + 16 * ks + 8 * hh);
        LDS_WAIT(); asm volatile("" ::: "memory");
#pragma unroll
        for (int I = 0; I < 2; ++I)
#pragma unroll
            for (int J = 0; J < 2; ++J) { f32x16 acc;
#pragma unroll
                for (int i = 0; i < 16; ++i) acc[i] = 0.f;
#pragma unroll
                for (int ks = 0; ks < 4; ++ks) acc = __builtin_amdgcn_mfma_f32_32x32x16_bf16(kf[I][ks], kf[J][ks], acc, 0, 0, 0);
                const int s = 32 * J + r; const float gcs = __shfl(gc, s), rns = __shfl(rn, s);
#pragma unroll
                for (int q = 0; q < 4; ++q) { const int t0 = 32 * I + 8 * q + 4 * hh; const f32x4 gct = *(const LAS f32x4*)(tb + t0), brt = *(const LAS f32x4*)(tb + 64 + t0);
#pragma unroll
                    for (int i = 0; i < 4; ++i) { const float v = (s < t0 + i) ? acc[4 * q + i] * brt[i] * rns * __expf(gct[i] - gcs) : 0.f; am[(t0 + i) * 64 + s] = v; } } }
        LDS_WAIT(); asm volatile("" ::: "memory");
        float Tc[64];
#pragma unroll
        for (int i = 0; i < 64; ++i) { float acc = (i == lane) ? 1.f : 0.f;
#pragma unroll
            for (int j4 = 0; j4 < (i + 3) / 4; ++j4) { const f32x4 av = *(const LAS f32x4*)(am + i * 64 + 4 * j4);
#pragma unroll
                for (int jj = 0; jj < 4; ++jj) if (4 * j4 + jj < i) acc -= av[jj] * Tc[4 * j4 + jj]; }
            Tc[i] = acc; }
        bf16_t* Tg = (bf16_t*)(mxb + MXB_GD_T) + (size_t)uid * 4096;
#pragma unroll
        for (int i = 0; i < 64; ++i) Tg[i * 64 + lane] = (bf16_t)f2bf(Tc[i]);
    }
}

__device__ __forceinline__ void gdn_passA2(ArgsP a, int l, LAS unsigned char* lds, const bf16_t* proj, const float* gsm, unsigned char* mxb, unsigned char* mxt, unsigned char* mxs, int G) {
    int tid_ = threadIdx.x; asm volatile("" : "+v"(tid_)); const int tid = tid_, lane = tid & 63, wave = __builtin_amdgcn_readfirstlane(tid >> 6), r = lane & 31, hh = lane >> 5;
    LAS bf16_t* qb = (LAS bf16_t*)(lds);
    LAS bf16_t* kb = (LAS bf16_t*)(lds + 9216);
    LAS bf16_t* bvT = (LAS bf16_t*)(lds + 18432);
    LAS bf16_t* bkT = (LAS bf16_t*)(lds + 27648);
    LAS bf16_t* Tm = (LAS bf16_t*)(lds + 36864);
    LAS bf16_t* wT = (LAS bf16_t*)(lds + 46080);
    LAS bf16_t* uT = (LAS bf16_t*)(lds + 55296);
    LAS bf16_t* kdT = (LAS bf16_t*)(lds + 64512);
    LAS float* tb_gc = (LAS float*)(lds + 73728);
    LAS float* tb_beta = tb_gc + 64;
    LAS float* ssq = tb_gc + 128;
    const float* cw = a->in[I_GCW] + (size_t)l * 4 * 1536;
    float* GL = (float*)(mxs + MXS_GD_GL);
    for (int uid = blockIdx.x; uid < 4096; uid += G) {
        const int c = uid & 63, hd = (uid >> 6) & 7, b = uid >> 9; const int tl = c * 64 + lane; const size_t tok = (size_t)b * SEQ_ + tl;
        __syncthreads();
        if (wave == 0) {
            const float gg = -expf(a->in[I_GAL][l * 8 + hd]) * softplus_f(gsm[tok * 32 + 8 + hd] + a->in[I_GDT][l * 8 + hd]);
            const float gc = wave_incl_sum(gg, lane); tb_gc[lane] = gc; tb_beta[lane] = 1.f / (1.f + expf(-gsm[tok * 32 + 16 + hd]));
            if (lane == 63) GL[uid] = expf(gc);
        }
        float qo[8], ko[8], vo[8];
        { u32x4 rw[4]; load_rows4(proj, b, tl, PC_GDQ + hd * 64 + 8 * wave, rw); conv_silu8(rw, cw + hd * 64 + 8 * wave, qo); }
        { u32x4 rw[4]; load_rows4(proj, b, tl, PC_GDK + hd * 64 + 8 * wave, rw); conv_silu8(rw, cw + 512 + hd * 64 + 8 * wave, ko); }
        { u32x4 rw[4]; load_rows4(proj, b, tl, PC_GDV + hd * 64 + 8 * wave, rw); conv_silu8(rw, cw + 1024 + hd * 64 + 8 * wave, vo); }
        { float sq = 0.f, sk = 0.f;
#pragma unroll
          for (int j = 0; j < 8; ++j) { sq += qo[j] * qo[j]; sk += ko[j] * ko[j]; }
          ssq[wave * 64 + lane] = sq; ssq[512 + wave * 64 + lane] = sk; }
        *(LAS u32x4*)(Tm + (tid >> 3) * 72 + (tid & 7) * 8) = *(const u32x4*)((const bf16_t*)(mxb + MXB_GD_T) + (size_t)uid * 4096 + (tid >> 3) * 64 + (tid & 7) * 8);
        __syncthreads();
        { float sq = 0.f, sk = 0.f;
#pragma unroll
          for (int w = 0; w < 8; ++w) { sq += ssq[w * 64 + lane]; sk += ssq[512 + w * 64 + lane]; }
          const float rq = rsqrtf(sq + RMS_EPS) * 0.125f, rk = rsqrtf(sk + RMS_EPS);
          const float gc = tb_gc[lane], beta = tb_beta[lane], gl_ = tb_gc[63];
          const float e1 = beta * __expf(gc), e2 = __expf(gl_ - gc);
#pragma unroll
          for (int j = 0; j < 8; ++j) { qo[j] *= rq; ko[j] *= rk; }
          *(LAS bf16x8*)(qb + lane * 72 + 8 * wave) = pack8(qo[0], qo[1], qo[2], qo[3], qo[4], qo[5], qo[6], qo[7]);
          *(LAS bf16x8*)(kb + lane * 72 + 8 * wave) = pack8(ko[0], ko[1], ko[2], ko[3], ko[4], ko[5], ko[6], ko[7]);
#pragma unroll
          for (int j = 0; j < 8; ++j) { const int d = 8 * wave + j;
              bvT[d * 72 + lane] = (bf16_t)f2bf(beta * vo[j]); bkT[d * 72 + lane] = (bf16_t)f2bf(e1 * ko[j]); kdT[d * 72 + lane] = (bf16_t)f2bf(e2 * ko[j]); } }
        __syncthreads();
        { const int mat = wave >> 2, I = (wave >> 1) & 1, J = wave & 1; const LAS bf16_t* Am = mat ? bkT : bvT; LAS bf16_t* Om = mat ? wT : uT;
          f32x16 acc;
#pragma unroll
          for (int i = 0; i < 16; ++i) acc[i] = 0.f;
#pragma unroll
          for (int ks = 0; ks < 4; ++ks) { const bf16x8 af = *(const LAS bf16x8*)(Am + (32 * I + r) * 72 + 16 * ks + 8 * hh), bf = *(const LAS bf16x8*)(Tm + (32 * J + r) * 72 + 16 * ks + 8 * hh);
              acc = __builtin_amdgcn_mfma_f32_32x32x16_bf16(af, bf, acc, 0, 0, 0); }
#pragma unroll
          for (int q = 0; q < 4; ++q)
#pragma unroll
              for (int i = 0; i < 4; ++i) Om[(32 * I + 8 * q + 4 * hh + i) * 72 + 32 * J + r] = (bf16_t)f2bf(acc[4 * q + i]); }
        __syncthreads();
        if (wave < 4) {
            const int I = (wave >> 1) & 1, J = wave & 1;
            f32x16 ax, an;
#pragma unroll
            for (int i = 0; i < 16; ++i) { ax[i] = 0.f; an[i] = 0.f; }
#pragma unroll
            for (int ks = 0; ks < 4; ++ks) { const bf16x8 wf = *(const LAS bf16x8*)(wT + (32 * I + r) * 72 + 16 * ks + 8 * hh), kdf_b = *(const LAS bf16x8*)(kdT + (32 * J + r) * 72 + 16 * ks + 8 * hh);
                ax = __builtin_amdgcn_mfma_f32_32x32x16_bf16(wf, kdf_b, ax, 0, 0, 0);
                const bf16x8 kdf_a = *(const LAS bf16x8*)(kdT + (32 * I + r) * 72 + 16 * ks + 8 * hh), uf = *(const LAS bf16x8*)(uT + (32 * J + r) * 72 + 16 * ks + 8 * hh);
                an = __builtin_amdgcn_mfma_f32_32x32x16_bf16(kdf_a, uf, an, 0, 0, 0); }
            bf16_t* xd = (bf16_t*)(mxt + MXT_GD_XD) + (size_t)uid * 4096 + (size_t)(I * 2 + J) * 1024;
#pragma unroll
            for (int s2 = 0; s2 < 2; ++s2) *(bf16x8*)(xd + (s2 * 64 + lane) * 8) = pack8(-ax[8 * s2], -ax[8 * s2 + 1], -ax[8 * s2 + 2], -ax[8 * s2 + 3], -ax[8 * s2 + 4], -ax[8 * s2 + 5], -ax[8 * s2 + 6], -ax[8 * s2 + 7]);
            float* nd = (float*)(mxb + MXB_GD_ND) + (size_t)uid * 4096 + (size_t)(I * 2 + J) * 1024;
#pragma unroll
            for (int q = 0; q < 4; ++q) *(f32x4*)(nd + (q * 64 + lane) * 4) = (f32x4){an[4 * q], an[4 * q + 1], an[4 * q + 2], an[4 * q + 3]};
        } else {
            const int I = (wave >> 1) & 1, tJ = wave & 1; const int t = 32 * tJ + r; const float gct = tb_gc[t];
            bf16x8 pf[2][2];
#pragma unroll
            for (int sI = 0; sI < 2; ++sI) { f32x16 ap;
#pragma unroll
                for (int i = 0; i < 16; ++i) ap[i] = 0.f;
#pragma unroll
                for (int ks = 0; ks < 4; ++ks) { const bf16x8 af = *(const LAS bf16x8*)(kb + (32 * sI + r) * 72 + 16 * ks + 8 * hh), bf = *(const LAS bf16x8*)(qb + t * 72 + 16 * ks + 8 * hh);
                    ap = __builtin_amdgcn_mfma_f32_32x32x16_bf16(af, bf, ap, 0, 0, 0); }
#pragma unroll
                for (int q = 0; q < 4; ++q) { const int s0 = 32 * sI + 8 * q + 4 * hh; const f32x4 gcs = *(const LAS f32x4*)(tb_gc + s0);
#pragma unroll
                    for (int i = 0; i < 4; ++i) ap[4 * q + i] = (s0 + i <= t) ? ap[4 * q + i] * __expf(gct - gcs[i]) : 0.f; }
#pragma unroll
                for (int s2 = 0; s2 < 2; ++s2) pf[sI][s2] = pack8(ap[8 * s2], ap[8 * s2 + 1], ap[8 * s2 + 2], ap[8 * s2 + 3], ap[8 * s2 + 4], ap[8 * s2 + 5], ap[8 * s2 + 6], ap[8 * s2 + 7]); }
            f32x16 aq, ao;
#pragma unroll
            for (int i = 0; i < 16; ++i) { aq[i] = 0.f; ao[i] = 0.f; }
#pragma unroll
            for (int sI = 0; sI < 2; ++sI)
#pragma unroll
                for (int s2 = 0; s2 < 2; ++s2) { const bf16x8 wf = ld_perm(wT + (32 * I + r) * 72 + 32 * sI + 16 * s2 + 4 * hh), uf = ld_perm(uT + (32 * I + r) * 72 + 32 * sI + 16 * s2 + 4 * hh);
                    aq = __builtin_amdgcn_mfma_f32_32x32x16_bf16(wf, pf[sI][s2], aq, 0, 0, 0); ao = __builtin_amdgcn_mfma_f32_32x32x16_bf16(uf, pf[sI][s2], ao, 0, 0, 0); }
            const float egt = __expf(gct);
#pragma unroll
            for (int q = 0; q < 4; ++q) { const int d0 = 32 * I + 8 * q + 4 * hh; const u32x2 qw = *(const LAS u32x2*)(qb + t * 72 + d0);
                aq[4 * q] = bflo(qw.x) * egt - aq[4 * q]; aq[4 * q + 1] = bfhi(qw.x) * egt - aq[4 * q + 1]; aq[4 * q + 2] = bflo(qw.y) * egt - aq[4 * q + 2]; aq[4 * q + 3] = bfhi(qw.y) * egt - aq[4 * q + 3]; }
            bf16_t* qd = (bf16_t*)(mxt + MXT_GD_QD) + (size_t)uid * 4096 + (size_t)(I * 2 + tJ) * 1024;
#pragma unroll
            for (int s2 = 0; s2 < 2; ++s2) *(bf16x8*)(qd + (s2 * 64 + lane) * 8) = pack8(aq[8 * s2], aq[8 * s2 + 1], aq[8 * s2 + 2], aq[8 * s2 + 3], aq[8 * s2 + 4], aq[8 * s2 + 5], aq[8 * s2 + 6], aq[8 * s2 + 7]);
            float* od = (float*)(mxb + MXB_GD_OD) + (size_t)uid * 4096 + (size_t)(I * 2 + tJ) * 1024;
#pragma unroll
            for (int q = 0; q < 4; ++q) *(f32x4*)(od + (q * 64 + lane) * 4) = (f32x4){ao[4 * q], ao[4 * q + 1], ao[4 * q + 2], ao[4 * q + 3]};
        }
    }
}

__device__ __forceinline__ void gdn_passB(unsigned char* mxb, unsigned char* mxt, unsigned char* mxs, int nB) {
    int tid_ = threadIdx.x; asm volatile("" : "+v"(tid_)); const int tid = tid_, lane = tid & 63, wave = __builtin_amdgcn_readfirstlane(tid >> 6);
    const float* GL = (const float*)(mxs + MXS_GD_GL);
    if (wave >= 2) return;
    const int eJ = wave;
    for (int chain = blockIdx.x; chain < 64; chain += nB) {
        f32x16 S[2];
#pragma unroll
        for (int i = 0; i < 16; ++i) { S[0][i] = 0.f; S[1][i] = 0.f; }
        bf16x8 xn[2][2][2]; f32x4 nq[2][4]; float gln;
#define GDB_LOAD(c_) do { const size_t u_ = (size_t)chain * 64 + (c_); const bf16_t* xd_ = (const bf16_t*)(mxt + MXT_GD_XD) + u_ * 4096; const float* nd_ = (const float*)(mxb + MXB_GD_ND) + u_ * 4096; \
        _Pragma("unroll") for (int I = 0; I < 2; ++I) _Pragma("unroll") for (int J = 0; J < 2; ++J) _Pragma("unroll") for (int s2 = 0; s2 < 2; ++s2) xn[I][J][s2] = *(const bf16x8*)(xd_ + (size_t)(I * 2 + J) * 1024 + (s2 * 64 + lane) * 8); \
        _Pragma("unroll") for (int J = 0; J < 2; ++J) _Pragma("unroll") for (int q = 0; q < 4; ++q) nq[J][q] = *(const f32x4*)(nd_ + (size_t)(J * 2 + eJ) * 1024 + (q * 64 + lane) * 4); \
        gln = GL[u_]; } while (0)
        GDB_LOAD(0);
        for (int c = 0; c < 64; ++c) { const size_t uid = (size_t)chain * 64 + c;
            bf16x8 xf[2][2][2]; f32x16 nn[2]; const float gl = gln;
#pragma unroll
            for (int I = 0; I < 2; ++I)
#pragma unroll
                for (int J = 0; J < 2; ++J)
#pragma unroll
                    for (int s2 = 0; s2 < 2; ++s2) xf[I][J][s2] = xn[I][J][s2];
#pragma unroll
            for (int J = 0; J < 2; ++J)
#pragma unroll
                for (int q = 0; q < 4; ++q) { nn[J][4 * q] = nq[J][q][0]; nn[J][4 * q + 1] = nq[J][q][1]; nn[J][4 * q + 2] = nq[J][q][2]; nn[J][4 * q + 3] = nq[J][q][3]; }
            if (c + 1 < 64) GDB_LOAD(c + 1);
            bf16x8 sh[2][2], sl[2][2];
            bf16_t* sd = (bf16_t*)(mxt + MXT_GD_SD) + uid * 4096;
#pragma unroll
            for (int I = 0; I < 2; ++I)
#pragma unroll
                for (int s2 = 0; s2 < 2; ++s2) { float hi[8], lo[8];
#pragma unroll
                    for (int j = 0; j < 8; ++j) { const float v = S[I][8 * s2 + j]; hi[j] = bf2f((unsigned short)f2bf(v)); lo[j] = v - hi[j]; }
                    sh[I][s2] = pack8(hi[0], hi[1], hi[2], hi[3], hi[4], hi[5], hi[6], hi[7]); sl[I][s2] = pack8(lo[0], lo[1], lo[2], lo[3], lo[4], lo[5], lo[6], lo[7]);
                    *(bf16x8*)(sd + (size_t)(I * 2 + eJ) * 1024 + (s2 * 64 + lane) * 8) = sh[I][s2]; }
#pragma unroll
            for (int J = 0; J < 2; ++J) { f32x16 acc = nn[J];
#pragma unroll
                for (int I = 0; I < 2; ++I)
#pragma unroll
                    for (int s2 = 0; s2 < 2; ++s2) { acc = __builtin_amdgcn_mfma_f32_32x32x16_bf16(xf[I][J][s2], sh[I][s2], acc, 0, 0, 0); acc = __builtin_amdgcn_mfma_f32_32x32x16_bf16(xf[I][J][s2], sl[I][s2], acc, 0, 0, 0); }
                nn[J] = acc; }
#pragma unroll
            for (int J = 0; J < 2; ++J)
#pragma unroll
                for (int i = 0; i < 16; ++i) S[J][i] = gl * S[J][i] + nn[J][i];
        }
    }
}

__device__ __forceinline__ void gdn_passC(ArgsP a, int l, LAS unsigned char* lds, const bf16_t* proj, bf16_t* H, unsigned char* mxb, unsigned char* mxt, int G) {
    int tid_ = threadIdx.x; asm volatile("" : "+v"(tid_)); const int tid = tid_, lane = tid & 63, wave = __builtin_amdgcn_readfirstlane(tid >> 6), r = lane & 31, hh = lane >> 5;
    LAS bf16_t* ob = (LAS bf16_t*)(lds + wave * 8192);
    const float* gn = a->in[I_GNG] + l * 64;
    for (int wu = blockIdx.x * NWAVES + wave; wu < 8192; wu += G * NWAVES) {
        const int uid = wu >> 1, tJ = wu & 1; const int c = uid & 63, hd = (uid >> 6) & 7, b = uid >> 9; const size_t tok0 = (size_t)b * SEQ_ + (size_t)c * 64;
        const bf16_t* sd = (const bf16_t*)(mxt + MXT_GD_SD) + (size_t)uid * 4096; const bf16_t* qd = (const bf16_t*)(mxt + MXT_GD_QD) + (size_t)uid * 4096; const float* od = (const float*)(mxb + MXB_GD_OD) + (size_t)uid * 4096;
        f32x16 ao[2];
#pragma unroll
        for (int eI = 0; eI < 2; ++eI)
#pragma unroll
            for (int q = 0; q < 4; ++q) { const f32x4 v = *(const f32x4*)(od + (size_t)(eI * 2 + tJ) * 1024 + (q * 64 + lane) * 4); ao[eI][4 * q] = v[0]; ao[eI][4 * q + 1] = v[1]; ao[eI][4 * q + 2] = v[2]; ao[eI][4 * q + 3] = v[3]; }
#pragma unroll
        for (int dI = 0; dI < 2; ++dI)
#pragma unroll
            for (int s2 = 0; s2 < 2; ++s2) { const bf16x8 qf = *(const bf16x8*)(qd + (size_t)(dI * 2 + tJ) * 1024 + (s2 * 64 + lane) * 8);
#pragma unroll
                for (int eI = 0; eI < 2; ++eI) { const bf16x8 sf = *(const bf16x8*)(sd + (size_t)(dI * 2 + eI) * 1024 + (s2 * 64 + lane) * 8);
                    ao[eI] = __builtin_amdgcn_mfma_f32_32x32x16_bf16(sf, qf, ao[eI], 0, 0, 0); } }
        float sq = 0.f;
#pragma unroll
        for (int eI = 0; eI < 2; ++eI)
#pragma unroll
            for (int i = 0; i < 16; ++i) sq += ao[eI][i] * ao[eI][i];
        sq += __shfl_xor(sq, 32);
        const float rinv = rsqrtf(sq * (1.0f / 64.0f) + RMS_EPS);
        const size_t tok = tok0 + 32 * tJ + r;
#pragma unroll
        for (int eI = 0; eI < 2; ++eI)
#pragma unroll
            for (int q = 0; q < 4; ++q) { const int e0 = 32 * eI + 8 * q + 4 * hh; const f32x4 g4 = *(const f32x4*)(gn + e0); const u32x2 zw = *(const u32x2*)(proj + tok * NPROJ + PC_GDZ + hd * 64 + e0);
                u32x2 pw; pw.x = pg8::cvt_pk_bf16(ao[eI][4 * q] * rinv * g4[0] * silu_f(bflo(zw.x)), ao[eI][4 * q + 1] * rinv * g4[1] * silu_f(bfhi(zw.x)));
                pw.y = pg8::cvt_pk_bf16(ao[eI][4 * q + 2] * rinv * g4[2] * silu_f(bflo(zw.y)), ao[eI][4 * q + 3] * rinv * g4[3] * silu_f(bfhi(zw.y)));
                *(LAS u32x2*)(ob + r * 64 + e0) = pw; }
        LDS_WAIT(); asm volatile("" ::: "memory");
#pragma unroll
        for (int it = 0; it < 4; ++it) { const int row = it * 8 + (lane >> 3), c8 = (lane & 7) * 8;
            *(u32x4*)(H + (tok0 + 32 * tJ + row) * 2048 + 1536 + hd * 64 + c8) = *(const LAS u32x4*)(ob + row * 64 + c8); }
        LDS_WAIT(); asm volatile("" ::: "memory");
    }
}
constexpr int PPL = 12;
constexpr int NPH = 1 + PPL * DEPTH_;
#ifndef MK_N_LAUNCHES
#define MK_N_LAUNCHES 1
#endif
#ifndef PG8_SP2
#define PG8_SP2 true
#endif
#ifndef PG8_ALIGN
#define PG8_ALIGN true
#endif
__global__ void __launch_bounds__(NWAVES * 64, 2) fwd(Args a_unused) {
    ArgsP kargs = (ArgsP)__builtin_amdgcn_kernarg_segment_ptr();
#define FRESH(a) ArgsP a = kargs; asm volatile("" : "+s"(a))
    extern __shared__ __attribute__((aligned(16))) unsigned char lds_raw[];
    LAS unsigned char* lds = (LAS unsigned char*)lds_raw;
    const int tid = threadIdx.x, G = gridDim.x;
    const int vcu = (G % 8 == 0) ? ((int)blockIdx.x % 8) * (G / 8) + (int)blockIdx.x / 8 : (int)blockIdx.x;
    for (int u = tid; u < (LDS_BYTES - MISC_OFF) / 4; u += NWAVES * 64) ((LAS unsigned*)(lds + MISC_OFF))[u] = 0u;
    __syncthreads();
    const int lo = kargs->ph_lo, hi = kargs->ph_hi;
    unsigned* barw = (unsigned*)(kargs->ws + WS_CTL) + CW_BAR + kargs->li * XCD_BAR_WORDS;
    XcdBarrier bar; bar.bar = barw; bar.x = 0; bar.st = nullptr;
    if (hi - lo > 1) bar = xcd_barrier_post(barw, (volatile LAS unsigned*)(lds + LDS_BYTES - 16));
#define IN(k) (lo <= (k) && (k) < hi)
#define SEAM(k) do { if (IN(k) && IN((k) + 1)) xcd_barrier(bar); } while (0)
    if (IN(0)) { FRESH(a); p0_convert(a, lds, G); }
    SEAM(0);

    for (int l = 0; l < DEPTH_; ++l) {
        const int pb = 1 + PPL * l;
#define WSP(T_, off) ((T_*)(a->ws + (off)))
#define WL_(off) (a->ws + WS_W + (size_t)l * WL_STRIDE + (off))
        if (IN(pb + 0)) { FRESH(a);
            pg8::Gemm g{WSP(const bf16_t, WS_XB), (const bf16_t*)WL_(WL_IN), 1024, 1024, 1024}; pg8::StaticOrder S; S.init(T_, NINP, G, (int)blockIdx.x);
            pg8::EpiProj E{WSP(bf16_t, WS_OV + OV_PROJ), WSP(float, WS_GSM)};
            pg8::gemm_phase<pg8::EpiProj, pg8::StaticOrder, PG8_ALIGN, PG8_SP2>(lds, g, S, E);
        }
        SEAM(pb + 0);

        if (IN(pb + 1)) { FRESH(a);
            const bf16_t* proj = WSP(const bf16_t, WS_OV + OV_PROJ); bf16_t* Hb = WSP(bf16_t, WS_OV + OV_H); const float* gsm = WSP(const float, WS_GSM);
            for (int u = (int)blockIdx.x; u < 256; u += G) lru_fast<0>(a, l, u >> 5, (u >> 2) & 7, (u & 3) * 16, (u & 3) * 16 + 16, lds, proj, Hb, a->ws + WS_MXS);
            mlstm_passA(a, l, lds, proj, gsm, a->ws + WS_V, a->ws + WS_MXS, G);
            __syncthreads();
            gdn_passA1(a, l, lds, proj, gsm, a->ws + WS_V, G);
        }
        SEAM(pb + 1);
        if (IN(pb + 2)) { FRESH(a);
            const bf16_t* proj = WSP(const bf16_t, WS_OV + OV_PROJ); const float* gsm = WSP(const float, WS_GSM);
            lru_carry(a->ws + WS_MXS, G); mlstm_passB(a->ws + WS_V, a->ws + WS_MXS, G); gdn_passA2(a, l, lds, proj, gsm, a->ws + WS_V, a->ws + WS_MXS, a->ws + WS_MXS, G); }
        SEAM(pb + 2);
        if (IN(pb + 3)) { FRESH(a);
            const bf16_t* proj = WSP(const bf16_t, WS_OV + OV_PROJ); bf16_t* Hb = WSP(bf16_t, WS_OV + OV_H); const float* gsm = WSP(const float, WS_GSM);
            const int nB = G >= 128 ? 64 : 0;
            if ((int)blockIdx.x < nB) gdn_passB(a->ws + WS_V, a->ws + WS_MXS, a->ws + WS_MXS, nB);
            else {
                if (nB == 0) { gdn_passB(a->ws + WS_V, a->ws + WS_MXS, a->ws + WS_MXS, G); __syncthreads(); }
                for (int u = (int)blockIdx.x - nB; u < 256; u += G - nB) lru_fast<1>(a, l, u >> 5, (u >> 2) & 7, (u & 3) * 16, (u & 3) * 16 + 16, lds, proj, Hb, a->ws + WS_MXS);
                mlstm_passC(a, l, lds, proj, gsm, Hb, a->ws + WS_V, a->ws + WS_MXS, (int)blockIdx.x - nB, G - nB);
            }
        }
        SEAM(pb + 3);
        if (IN(pb + 4)) { FRESH(a); gdn_passC(a, l, lds, WSP(const bf16_t, WS_OV + OV_PROJ), WSP(bf16_t, WS_OV + OV_H), a->ws + WS_V, a->ws + WS_MXS, G); }
        SEAM(pb + 4);

        if (IN(pb + 5)) { FRESH(a);
            const bf16_t* proj = WSP(const bf16_t, WS_OV + OV_PROJ); const bf16_t* Hb = WSP(const bf16_t, WS_OV + OV_H); float* mf = WSP(float, WS_OV + OV_MF); bf16_t* mb = WSP(bf16_t, WS_MB);
            const bf16_t* wbr = (const bf16_t*)WL_(WL_BR);
            pg8::StaticOrder S; S.init(T_, 1024, G, (int)blockIdx.x);
            { pg8::Gemm g{Hb, wbr, 2048, 2048, 1024}; pg8::EpiMerge<0> E{proj, mf, mb};
              pg8::gemm_phase<pg8::EpiMerge<0>, pg8::StaticOrder, PG8_ALIGN, PG8_SP2>(lds, g, S, E); }
            { pg8::Gemm g{Hb + 1024, wbr + 1024, 2048, 2048, 512}; pg8::EpiMerge<1> E{proj, mf, mb};
              pg8::gemm_phase<pg8::EpiMerge<1>, pg8::StaticOrder, PG8_ALIGN, PG8_SP2>(lds, g, S, E); }
            { pg8::Gemm g{Hb + 1536, wbr + 1536, 2048, 2048, 512}; pg8::EpiMerge<2> E{proj, mf, mb};
              pg8::gemm_phase<pg8::EpiMerge<2>, pg8::StaticOrder, PG8_ALIGN, PG8_SP2>(lds, g, S, E); }
        }
        SEAM(pb + 5);

        if (IN(pb + 6)) { FRESH(a);
            const float* xin = l == 0 ? a->in[I_X] : WSP(const float, WS_X2);
            pg8::Gemm g{WSP(const bf16_t, WS_MB), (const bf16_t*)WL_(WL_OUT), 1024, 1024, 1024}; pg8::StaticOrder S; S.init(T_, 1024, G, (int)blockIdx.x);
            pg8::EpiWout E{xin, WSP(float, WS_V)};
            pg8::gemm_phase<pg8::EpiWout, pg8::StaticOrder, PG8_ALIGN, PG8_SP2>(lds, g, S, E);
        }
        SEAM(pb + 6);

        if (IN(pb + 7)) { FRESH(a); p5_ln1_router(a, l, lds, G); }
        SEAM(pb + 7);

        if (IN(pb + 8)) { FRESH(a); p6_slots(a, lds, G); }
        SEAM(pb + 8);

        if (IN(pb + 9)) { FRESH(a);
            const int nb = moe_table(a, lds);
            pg8::MoeOrder S{8, G, vcu, nb * 8, (const LAS int*)(lds + MISC_OFF + 256)};
            pg8::Gemm g{WSP(const bf16_t, WS_OV + OV_XS), (const bf16_t*)WL_(WL_W1), 1024, 1024, 1024};
            pg8::EpiMoe1 E{WSP(bf16_t, WS_OV + OV_ACT), a->in[I_B1] + (size_t)l * NE * 2048};
            pg8::gemm_phase<pg8::EpiMoe1, pg8::MoeOrder, PG8_ALIGN, PG8_SP2>(lds, g, S, E);
        }
        SEAM(pb + 9);

        if (IN(pb + 10)) { FRESH(a);
            const int nb = moe_table(a, lds);
            pg8::MoeOrder S{4, G, vcu, nb * 4, (const LAS int*)(lds + MISC_OFF + 256)};
            pg8::Gemm g{WSP(const bf16_t, WS_OV + OV_ACT), (const bf16_t*)WL_(WL_W2), 1024, 1024, 1024};
            pg8::EpiMoe2 E{WSP(bf16_t, WS_OV + OV_YS), a->in[I_B2] + (size_t)l * NE * 1024, WSP(const float, WS_WBUF)};
            pg8::gemm_phase<pg8::EpiMoe2, pg8::MoeOrder, PG8_ALIGN, PG8_SP2>(lds, g, S, E);
        }
        SEAM(pb + 10);

        if (IN(pb + 11)) { FRESH(a); p9_combine_ln2(a, l, (l == DEPTH_ - 1) ? a->out : WSP(float, WS_X2), G); }
        SEAM(pb + 11);
    }
#undef WSP
#undef WL_
#undef IN
#undef SEAM
}

extern "C" void kernel_launch(void* const* d_in, const int* in_sizes, int n_in, void* d_out, int out_size, void* d_ws, size_t ws_size, hipStream_t stream) {
    static int grid = 0;
    if (grid == 0) {
        if (n_in != 30 || in_sizes[0] != T_ * D_ || out_size != T_ * D_ || ws_size < WS_END) {
            fprintf(stderr, "kernel_launch: unexpected shapes: n_in %d in0 %d out %d ws %zu (need %zu); nothing launched\n", n_in, n_in > 0 ? in_sizes[0] : -1, out_size, ws_size, (size_t)WS_END); grid = -1; return; }
        int dev = 0, cus = 0;
        if (hipGetDevice(&dev) != hipSuccess || hipDeviceGetAttribute(&cus, hipDeviceAttributeMultiprocessorCount, dev) != hipSuccess) { grid = -1; return; }
        if (hipFuncSetAttribute((const void*)fwd, hipFuncAttributeMaxDynamicSharedMemorySize, LDS_BYTES) != hipSuccess) { fprintf(stderr, "kernel_launch: hipFuncSetAttribute failed\n"); grid = -1; return; }
        int per_cu = 0; (void)hipOccupancyMaxActiveBlocksPerMultiprocessor(&per_cu, (const void*)fwd, NWAVES * 64, LDS_BYTES); (void)hipGetLastError();
        if (per_cu < 1) fprintf(stderr, "kernel_launch: occupancy query reports %d blocks per CU\n", per_cu);
        grid = cus;
    }
    if (grid < 0) return;
    (void)hipMemsetAsync((char*)d_ws + WS_CTL, 0, CTL_ZERO_BYTES, stream);
    Args a{};
    for (int i = 0; i < 30; ++i) a.in[i] = (const float*)d_in[i];
    a.out = (float*)d_out; a.ws = (unsigned char*)d_ws;
    constexpr int NL = MK_N_LAUNCHES; static_assert(NL == NPH || NL <= 4, "barrier regions");
    for (int li = 0; li < NL; ++li) {
        a.ph_lo = (int)((long)NPH * li / NL); a.ph_hi = (int)((long)NPH * (li + 1) / NL); a.li = (NL <= 4) ? li : 0;
        hipLaunchKernelGGL(fwd, dim3(grid), dim3(NWAVES * 64), LDS_BYTES, stream, a);
        const hipError_t le = hipPeekAtLastError();
        if (le != hipSuccess) { fprintf(stderr, "kernel_launch: launch %d failed: %s\n", li, hipGetErrorName(le)); break; }
    }
}
```

```cpp
#include <hip/hip_runtime.h>
#include <cstdio>
#include <cstdint>

#define LAS __attribute__((address_space(3)))
#define GAS __attribute__((address_space(1)))
typedef unsigned short bf16_t;
typedef short bf16x8 __attribute__((ext_vector_type(8)));
typedef float f32x4 __attribute__((ext_vector_type(4)));
typedef float f32x2 __attribute__((ext_vector_type(2)));
typedef unsigned u32x4 __attribute__((ext_vector_type(4)));
typedef unsigned u32x2 __attribute__((ext_vector_type(2)));

constexpr int T_ = 32768, D_ = 1024, SEQ_ = 4096, NBATCH = 8, DEPTH_ = 2;
constexpr int DIN = 8728, NPROJ = 8704, NINP = 8960;
constexpr int NE = 32, DFF = 1024;
constexpr int PMAX = 139264;
constexpr int NCHUNK = 256, CHTOK = 128;
constexpr float DN_ALPHA = 1.41421356237309515f;
constexpr float LN_EPS = 1e-5f, RMS_EPS = 1e-6f;
constexpr int PC_LRUX = 0, PC_LRUY = 1024, PC_MLQ = 2048, PC_MLK = 2304, PC_MLV = 2560, PC_MLO = 3072, PC_GDQ = 3584, PC_GDK = 4096, PC_GDV = 4608, PC_GDZ = 5120, PC_GATE = 5632;

constexpr size_t MiB = 1u << 20;
constexpr size_t WS_CTL = 0, CTL_ZERO_BYTES = 64 * 1024;
constexpr size_t WS_HIST = 256 * 1024;
constexpr size_t WS_META = 320 * 1024;
constexpr size_t WS_RWB = 384 * 1024;
constexpr size_t WS_W = 1 * MiB;
constexpr size_t WL_IN = 0, WL_BR = 18 * MiB, WL_OUT = 22 * MiB, WL_W1 = 24 * MiB, WL_W2 = 152 * MiB, WL_G = 216 * MiB, WL_STRIDE = 217 * MiB;
constexpr size_t WS_XB = 436 * MiB;
constexpr size_t WS_GSM = 501 * MiB;
constexpr size_t WS_MB = 505 * MiB;
constexpr size_t WS_V = 569 * MiB;
constexpr size_t WS_X1 = 697 * MiB;
constexpr size_t WS_X1B = 825 * MiB;
constexpr size_t WS_X2 = 890 * MiB;
constexpr size_t WS_TKE = 1018 * MiB;
constexpr size_t WS_TKW = WS_TKE + 512 * 1024;
constexpr size_t WS_SLOT = 1019 * MiB;
constexpr size_t WS_WBUF = 1020 * MiB;
constexpr size_t WS_OV = 1024 * MiB;
constexpr size_t OV_PROJ = 0, OV_H = 544 * MiB, OV_MF = 672 * MiB;
constexpr size_t OV_XS = 0, OV_ACT = 272 * MiB, OV_YS = 544 * MiB;
constexpr size_t WS_MXS = WS_OV + 816 * MiB;
constexpr size_t WS_END = WS_MXS + 104 * MiB;

constexpr int CW_BAR = 1024;

constexpr int RING_BYTES = 131072;
constexpr int MISC_OFF = RING_BYTES;
constexpr int LDS_BYTES = 147456;
constexpr int NWAVES = 8;

#define LDS_WAIT() asm volatile("s_waitcnt lgkmcnt(0)" ::: "memory")
#define VM_WAIT() asm volatile("s_waitcnt vmcnt(0)" ::: "memory")

__device__ __forceinline__ unsigned f2bf(float f) { unsigned u = __builtin_bit_cast(unsigned, f); return (u + 0x7fffu + ((u >> 16) & 1u)) >> 16; }
__device__ __forceinline__ unsigned pk2(float lo, float hi) { return f2bf(lo) | (f2bf(hi) << 16); }
__device__ __forceinline__ float bf2f(unsigned short b) { return __builtin_bit_cast(float, (unsigned)b << 16); }
__device__ __forceinline__ float bflo(unsigned w) { return __builtin_bit_cast(float, w << 16); }
__device__ __forceinline__ float bfhi(unsigned w) { return __builtin_bit_cast(float, w & 0xffff0000u); }
__device__ __forceinline__ float wave_sum(float v) {
#pragma unroll
    for (int o = 1; o < 64; o <<= 1) v += __shfl_xor(v, o);
    return v;
}
__device__ __forceinline__ float wave_max(float v) {
#pragma unroll
    for (int o = 1; o < 64; o <<= 1) v = fmaxf(v, __shfl_xor(v, o));
    return v;
}
__device__ __forceinline__ float sigmoid_f(float x) { return __builtin_amdgcn_rcpf(1.f + __expf(-x)); }
__device__ __forceinline__ float silu_f(float x) { return x * __builtin_amdgcn_rcpf(1.f + __expf(-x)); }
__device__ __forceinline__ float neg_expm1_f(float t) {
    const float p = -t * (1.f + t * 0.5f * (1.f + t * (1.f / 3.f) * (1.f + t * 0.25f * (1.f + t * 0.2f * (1.f + t * (1.f / 6.f) * (1.f + t * (1.f / 7.f)))))));
    return t > -0.3f ? p : 1.f - __expf(t);
}
__device__ __forceinline__ float softplus_f(float x) { return x > 20.f ? x : log1pf(expf(x)); }
__device__ __forceinline__ float gelu_tanh_f(float x) { const float u = 0.7978845608028654f * (x + 0.044715f * x * x * x); return x * __builtin_amdgcn_rcpf(1.f + __expf(-2.f * u)); }
namespace pg8 {
#define PG8_LAS __attribute__((address_space(3)))
constexpr int BM = 256, BK = 64, HALF = 128, HTB = HALF * BK * 2  , STAGE_BYTES = 8 * HTB, NXCD = 8, WGM = 8;

__host__ __device__ __forceinline__ int lds_byte(int r, int c) { const int st = (r >> 4) * 2 + (c >> 5), rr = r & 15, cc = c & 31, ob = rr * 64 + cc * 2; return st * 1024 + (ob ^ (((ob >> 9) & 1) << 5)); }
__host__ __device__ __forceinline__ void stage_rc(int b, int& R, int& C) { const int st = b / 1024, sb = b % 1024, swz = sb ^ (((sb >> 9) & 1) << 5); R = (st >> 1) * 16 + swz / 64; C = (st & 1) * 32 + (swz % 64) / 2; }
__host__ __device__ __forceinline__ int perm32(int rho) { const int n = rho >> 4, i = rho & 15; return 8 * (i >> 2) + 4 * n + (i & 3); }

struct Unit { int pm, pn; };
struct Gemm { const bf16_t* A; const bf16_t* Bt; int lda, ldb, K; };

struct StaticOrder {
    int nM, nN, nwg, G, c;
    __host__ __device__ void init(int M, int N, int G_, int c_) { nM = M / BM; nN = N / BM; nwg = nM * nN; G = G_; c = c_; }
    __host__ __device__ bool next(int i, Unit& u) const {
        const long L = (long)i * G + c; if (L >= nwg) return false;
        int wgid = (int)L; { const int q = nwg / NXCD, r = nwg % NXCD, xcd = wgid % NXCD, off = wgid / NXCD; wgid = (xcd < r ? xcd * (q + 1) : r * (q + 1) + (xcd - r) * q) + off; }
        const int nig = WGM * nN, gid = wgid / nig, fm = gid * WGM, gsz = (nM - fm) < WGM ? (nM - fm) : WGM;
        u.pm = fm + ((wgid % nig) % gsz); u.pn = (wgid % nig) / gsz; return true;
    }
    __device__ __forceinline__ void a_ready(const Unit&) const {}
    __device__ __forceinline__ void done(const Unit&) const {}
};

__device__ __forceinline__ unsigned cvt_pk_bf16(float lo, float hi) { unsigned r; asm volatile("v_cvt_pk_bf16_f32 %0, %1, %2" : "=v"(r) : "v"(lo), "v"(hi)); return r; }

template <class Epi, class Sched, bool ALIGN_EPI = false, bool SP2 = false>
__device__ __forceinline__ void gemm_phase(PG8_LAS unsigned char* lds, const Gemm g, const Sched& S, const Epi& E) {
    int tid_ = threadIdx.x; asm volatile("" : "+v"(tid_));
    const int tid = tid_, wid = __builtin_amdgcn_readfirstlane(tid >> 6), lane = tid & 63, wr = wid >> 2, wc = wid & 3, fr = lane & 15, fq = lane >> 4;
    const int K = g.K, nt = K / BK;
    unsigned voffA[2], voffB[2];
#pragma unroll
    for (int i = 0; i < 2; ++i) { int R, C; stage_rc(tid * 16 + i * 8192, R, C); const int Rb = Epi::PERM ? ((R & ~31) + perm32(R & 31)) : R;
        voffA[i] = (unsigned)(R * g.lda + C) * 2u; voffB[i] = (unsigned)(Rb * g.ldb + C) * 2u; }
    const size_t kstep = (size_t)(BK * 2);
    const size_t hstepA = (size_t)HALF * g.lda * 2, hstepB = (size_t)HALF * g.ldb * 2;
    const size_t tstepA = 2 * hstepA, tstepB = 2 * hstepB;
    const unsigned ldsw = (unsigned)wid * 1024u;
    const int aoff = lds_byte(wr * 64 + fr, fq * 8), boff = lds_byte(wc * 32 + fr, fq * 8);
#define PG8_SA(b, h) (((b) * 2 + (h)) * HTB)
#define PG8_SB(b, h) ((4 + (b) * 2 + (h)) * HTB)
#define PG8_STAGE(bufoff, gbase, voff) do { _Pragma("unroll") for (int _i = 0; _i < 2; ++_i) \
        __builtin_amdgcn_global_load_lds((const unsigned*)((const char*)(gbase) + (voff)[_i]), (PG8_LAS unsigned*)(lds + (bufoff) + ldsw + _i * 8192), 16, 0, 0); } while (0)
#define PG8_LDA(dst, b, h) do { _Pragma("unroll") for (int m = 0; m < 4; ++m) _Pragma("unroll") for (int k = 0; k < 2; ++k) dst[m][k] = *(const PG8_LAS bf16x8*)(lds + PG8_SA(b, h) + aoff + m * 2048 + k * 1024); } while (0)
#define PG8_LDB(dst, b, h) do { _Pragma("unroll") for (int n = 0; n < 2; ++n) _Pragma("unroll") for (int k = 0; k < 2; ++k) dst[n][k] = *(const PG8_LAS bf16x8*)(lds + PG8_SB(b, h) + boff + n * 2048 + k * 1024); } while (0)
#define PG8_MMA(ai, bj, At, Bt) do { __builtin_amdgcn_s_setprio(1); _Pragma("unroll") for (int m = 0; m < 4; ++m) _Pragma("unroll") for (int n = 0; n < 2; ++n) _Pragma("unroll") for (int k = 0; k < 2; ++k) \
        acc[ai][bj][m][n] = __builtin_amdgcn_mfma_f32_16x16x32_bf16(Bt[n][k], At[m][k], acc[ai][bj][m][n], 0, 0, 0); __builtin_amdgcn_s_setprio(0); } while (0)
#define PG8_WAIT_V(n) asm volatile("s_waitcnt vmcnt(" #n ")" ::: "memory")
#define PG8_WAIT_L(n) asm volatile("s_waitcnt lgkmcnt(" #n ")" ::: "memory")
#define PG8_BAR __builtin_amdgcn_s_barrier()
#define PG8_SCHED __builtin_amdgcn_sched_barrier(0)
    Unit cur, nxt; int ui = 0;
    if (!S.next(0, cur)) return;
    f32x4 acc[2][2][4][2];
#pragma unroll
    for (int a = 0; a < 2; ++a)
#pragma unroll
        for (int b = 0; b < 2; ++b)
#pragma unroll
            for (int m = 0; m < 4; ++m)
#pragma unroll
                for (int n = 0; n < 2; ++n) acc[a][b][m][n] = (f32x4){0.f, 0.f, 0.f, 0.f};
    bf16x8 At[4][2], B0[2][2], B1[2][2];
    const char* cA = (const char*)g.A + (size_t)cur.pm * tstepA; const char* cB = (const char*)g.Bt + (size_t)cur.pn * tstepB;
    S.a_ready(cur);
    if constexpr (SP2) {
        PG8_STAGE(PG8_SB(0, 0), cB, voffB); PG8_STAGE(PG8_SB(0, 1), cB + hstepB, voffB); PG8_STAGE(PG8_SA(0, 0), cA, voffA); PG8_STAGE(PG8_SA(0, 1), cA + hstepA, voffA);
        if (wr == 1) PG8_BAR;
        PG8_WAIT_V(2); PG8_BAR;
        PG8_STAGE(PG8_SB(1, 0), cB + kstep, voffB); PG8_STAGE(PG8_SA(1, 0), cA + kstep, voffA); PG8_STAGE(PG8_SB(1, 1), cB + hstepB + kstep, voffB);
        PG8_WAIT_V(6); PG8_BAR;
    } else {
        PG8_STAGE(PG8_SB(0, 0), cB, voffB); PG8_STAGE(PG8_SA(0, 0), cA, voffA); PG8_STAGE(PG8_SB(0, 1), cB + hstepB, voffB); PG8_STAGE(PG8_SA(0, 1), cA + hstepA, voffA);
        if (wr == 1) PG8_BAR;
        PG8_WAIT_V(4); PG8_BAR;
        PG8_STAGE(PG8_SB(1, 0), cB + kstep, voffB); PG8_STAGE(PG8_SA(1, 0), cA + kstep, voffA); PG8_STAGE(PG8_SB(1, 1), cB + hstepB + kstep, voffB);
        PG8_WAIT_V(6); PG8_BAR;
    }
    for (;;) {
        const bool has_next = S.next(ui + 1, nxt);
        const char* nA = has_next ? (const char*)g.A + (size_t)nxt.pm * tstepA : cA; const char* nB = has_next ? (const char*)g.Bt + (size_t)nxt.pn * tstepB : cB;
        for (int t = 0; t < nt; t += 2) {
            const bool last = (t == nt - 2);
            const char* a1 = cA + (size_t)(t + 1) * kstep;
            const char* a2 = last ? nA : cA + (size_t)(t + 2) * kstep; const char* b2 = last ? nB : cB + (size_t)(t + 2) * kstep;
            const char* a3 = a2 + kstep; const char* b3 = b2 + kstep;
            if (last && has_next) S.a_ready(nxt);
            if constexpr (SP2) {
            PG8_LDB(B0, 0, 0); PG8_LDB(B1, 0, 1); PG8_SCHED; PG8_LDA(At, 0, 0); PG8_STAGE(PG8_SA(1, 1), a1 + hstepA, voffA);
            PG8_WAIT_V(8); PG8_WAIT_L(0); PG8_BAR; PG8_MMA(0, 0, At, B0); PG8_MMA(0, 1, At, B1); PG8_BAR; PG8_SCHED;
            PG8_LDA(At, 0, 1); PG8_STAGE(PG8_SB(0, 0), b2, voffB); PG8_STAGE(PG8_SB(0, 1), b2 + hstepB, voffB); PG8_STAGE(PG8_SA(0, 0), a2, voffA);
            PG8_WAIT_V(8); PG8_WAIT_L(0); PG8_BAR; PG8_MMA(1, 0, At, B0); PG8_MMA(1, 1, At, B1); PG8_BAR; PG8_SCHED;
            PG8_LDB(B0, 1, 0); PG8_LDB(B1, 1, 1); PG8_SCHED; PG8_LDA(At, 1, 0); PG8_STAGE(PG8_SA(0, 1), a2 + hstepA, voffA);
            PG8_WAIT_V(8); PG8_WAIT_L(0); PG8_BAR; PG8_MMA(0, 0, At, B0); PG8_MMA(0, 1, At, B1); PG8_BAR; PG8_SCHED;
            PG8_LDA(At, 1, 1); PG8_STAGE(PG8_SB(1, 0), b3, voffB); PG8_STAGE(PG8_SB(1, 1), b3 + hstepB, voffB); PG8_STAGE(PG8_SA(1, 0), a3, voffA);
            PG8_WAIT_V(8); PG8_WAIT_L(0); PG8_BAR; PG8_MMA(1, 0, At, B0); PG8_MMA(1, 1, At, B1); PG8_BAR; PG8_SCHED;
            } else {
            PG8_LDB(B0, 0, 0); PG8_SCHED; PG8_LDA(At, 0, 0); PG8_STAGE(PG8_SA(1, 1), a1 + hstepA, voffA);
            PG8_WAIT_L(8); PG8_BAR; PG8_WAIT_L(0); PG8_MMA(0, 0, At, B0); PG8_BAR; PG8_SCHED;
            PG8_LDB(B1, 0, 1); PG8_STAGE(PG8_SB(0, 0), b2, voffB);
            PG8_BAR; PG8_WAIT_L(0); PG8_MMA(0, 1, At, B1); PG8_BAR;
            PG8_LDA(At, 0, 1); PG8_STAGE(PG8_SA(0, 0), a2, voffA);
            PG8_BAR; PG8_WAIT_L(0); PG8_MMA(1, 0, At, B0); PG8_BAR; PG8_SCHED;
            PG8_STAGE(PG8_SB(0, 1), b2 + hstepB, voffB);
            PG8_WAIT_V(6); PG8_BAR; PG8_MMA(1, 1, At, B1); PG8_BAR;
            PG8_LDB(B0, 1, 0); PG8_SCHED; PG8_LDA(At, 1, 0); PG8_STAGE(PG8_SA(0, 1), a2 + hstepA, voffA);
            PG8_WAIT_L(8); PG8_BAR; PG8_WAIT_L(0); PG8_MMA(0, 0, At, B0); PG8_BAR; PG8_SCHED;
            PG8_LDB(B1, 1, 1); PG8_STAGE(PG8_SB(1, 0), b3, voffB);
            PG8_BAR; PG8_WAIT_L(0); PG8_MMA(0, 1, At, B1); PG8_BAR;
            PG8_LDA(At, 1, 1); PG8_STAGE(PG8_SA(1, 0), a3, voffA);
            PG8_BAR; PG8_WAIT_L(0); PG8_MMA(1, 0, At, B0); PG8_BAR; PG8_SCHED;
            PG8_STAGE(PG8_SB(1, 1), b3 + hstepB, voffB);
            PG8_WAIT_V(6); PG8_BAR; PG8_MMA(1, 1, At, B1); PG8_BAR;
            }
        }
        if constexpr (ALIGN_EPI) { if (wr == 0) PG8_BAR; }
        E(acc, cur, wr, wc, fr, fq); S.done(cur);
        if (!has_next) break;
#pragma unroll
        for (int a = 0; a < 2; ++a)
#pragma unroll
            for (int b = 0; b < 2; ++b)
#pragma unroll
                for (int m = 0; m < 4; ++m)
#pragma unroll
                    for (int n = 0; n < 2; ++n) acc[a][b][m][n] = (f32x4){0.f, 0.f, 0.f, 0.f};
        cur = nxt; cA = nA; cB = nB; ++ui;
        if constexpr (ALIGN_EPI) { if (wr == 1) PG8_BAR; }
    }
    PG8_WAIT_V(0);
    if constexpr (!ALIGN_EPI) { if (wr == 0) PG8_BAR; }
    PG8_BAR;
#undef PG8_SA
#undef PG8_SB
#undef PG8_STAGE
#undef PG8_LDA
#undef PG8_LDB
#undef PG8_MMA
#undef PG8_WAIT_V
#undef PG8_WAIT_L
#undef PG8_BAR
#undef PG8_SCHED
}
}
#define XB_TMO      128
#define XB_XCNT(j)  (256  + 64 * (j))
#define XB_XSUB(j)  (1280 + 64 * (j))
#define XB_XGEN(j)  (2304 + 64 * (j))
#define XB_TOP      3328
#define XB_TOPGEN   3392
#define XCD_BAR_WORDS 3456
#define XB_SPIN_CAP (1u << 18)

__device__ __forceinline__ unsigned xb_ld(unsigned* p)              { return __hip_atomic_load(p, __ATOMIC_RELAXED, __HIP_MEMORY_SCOPE_AGENT); }
__device__ __forceinline__ unsigned xb_add(unsigned* p, unsigned v) { return __hip_atomic_fetch_add(p, v, __ATOMIC_RELAXED, __HIP_MEMORY_SCOPE_AGENT); }
__device__ __forceinline__ unsigned xb_xcc_id() { return (unsigned)__builtin_amdgcn_s_getreg((3 << 11) | 20) & 0xFu; }
#define XB_SPIN(cond, bar) do { unsigned _sp = 0; while (cond) { __builtin_amdgcn_s_sleep(1); \
    if ((++_sp & 255u) == 0u) { if (xb_ld(&(bar)[XB_TMO])) break; if (_sp > XB_SPIN_CAP) { atomicAdd(&(bar)[XB_TMO], 1u); break; } } } } while (0)

struct XcdBarrier {
    unsigned* bar; unsigned x;
    volatile LAS unsigned* st;
};

__device__ __forceinline__ XcdBarrier xcd_barrier_post(unsigned* bar, volatile LAS unsigned* st) {
    XcdBarrier b; b.bar = bar; b.x = xb_xcc_id(); b.st = st;
    if (threadIdx.x == 0) (void)xb_add(&bar[XB_XCNT(b.x)], 1u);
    return b;
}
__device__ __forceinline__ void xcd_barrier_complete(unsigned* bar, unsigned x, unsigned& nloc, unsigned& nx) {
    const unsigned G = gridDim.x * gridDim.y * gridDim.z;
    unsigned sum, cnt, mine, sp = 0u;
    for (;;) {
        sum = 0u; cnt = 0u; mine = 0u;
#pragma unroll
        for (unsigned j = 0; j < 16; ++j) { const unsigned c = xb_ld(&bar[XB_XCNT(j)]); sum += c; cnt += (c > 0u) ? 1u : 0u; mine = (j == x) ? c : mine; }
        if (sum == G) break;
        __builtin_amdgcn_s_sleep(1);
        if ((++sp & 255u) == 0u) { if (xb_ld(&bar[XB_TMO])) break; if (sp > XB_SPIN_CAP) { atomicAdd(&bar[XB_TMO], 1u); break; } }
    }
    nloc = mine > 0u ? mine : 1u; nx = cnt > 0u ? cnt : 1u;
}

__device__ __forceinline__ void xcd_barrier(const XcdBarrier& b) {
    asm volatile("s_waitcnt vmcnt(0)" ::: "memory");
    __syncthreads();
    if (threadIdx.x == 0) {
        unsigned* bar = b.bar;
        __builtin_amdgcn_s_waitcnt(0);
        unsigned nloc = b.st[0], nx = b.st[1];
        if (nloc == 0u) { xcd_barrier_complete(bar, b.x, nloc, nx); b.st[0] = nloc; b.st[1] = nx; }
        const unsigned old = xb_add(&bar[XB_XSUB(b.x)], 1u);
        const unsigned gen = old / nloc;
        if (old + 1u == (gen + 1u) * nloc) {
            __builtin_amdgcn_fence(__ATOMIC_RELEASE, "agent");
            asm volatile("s_waitcnt vmcnt(0)" ::: "memory");
            const unsigned og = xb_add(&bar[XB_TOP], 1u);
            const unsigned tg = og / nx;
            if (og + 1u == (tg + 1u) * nx) xb_add(&bar[XB_TOPGEN], 1u);
            else XB_SPIN(xb_ld(&bar[XB_TOPGEN]) == tg, bar);
            __builtin_amdgcn_fence(__ATOMIC_ACQUIRE, "agent");
            xb_add(&bar[XB_XGEN(b.x)], 1u);
            asm volatile("s_waitcnt vmcnt(0)" ::: "memory");
        } else {
            XB_SPIN(xb_ld(&bar[XB_XGEN(b.x)]) == gen, bar);
            __builtin_amdgcn_fence(__ATOMIC_ACQUIRE, "agent");
            asm volatile("s_waitcnt vmcnt(0)" ::: "memory");
        }
    }
    __syncthreads();
}
namespace pg8 {
struct EpiProj {
    static constexpr bool PERM = true;
    bf16_t* proj; float* gsm;
    __device__ __forceinline__ void operator()(const f32x4 (&acc)[2][2][4][2], const Unit& u, int wr, int wc, int fr, int fq) const {
        const int row0 = u.pm * BM + wr * 64 + fr;
        if (u.pn < 34) {
            const int col0 = u.pn * BM + wc * 32 + 8 * fq;
#pragma unroll
            for (int ai = 0; ai < 2; ++ai)
#pragma unroll
                for (int m = 0; m < 4; ++m) { bf16_t* rowp = proj + (size_t)(row0 + ai * HALF + m * 16) * NPROJ + col0;
#pragma unroll
                    for (int bj = 0; bj < 2; ++bj) { const f32x4 v0 = acc[ai][bj][m][0], v1 = acc[ai][bj][m][1];
                        u32x4 w; w.x = cvt_pk_bf16(v0[0], v0[1]); w.y = cvt_pk_bf16(v0[2], v0[3]); w.z = cvt_pk_bf16(v1[0], v1[1]); w.w = cvt_pk_bf16(v1[2], v1[3]);
                        *(u32x4*)(rowp + bj * HALF) = w; } }
        } else if (wc == 0 && fq < 3) {
#pragma unroll
            for (int ai = 0; ai < 2; ++ai)
#pragma unroll
                for (int m = 0; m < 4; ++m) { float* rowp = gsm + (size_t)(row0 + ai * HALF + m * 16) * 32 + 8 * fq;
                    *(f32x4*)(rowp) = acc[ai][0][m][0]; *(f32x4*)(rowp + 4) = acc[ai][0][m][1]; }
        }
    }
};
template <int STAGE> struct EpiMerge {
    static constexpr bool PERM = true;
    const bf16_t* proj; float* mf; bf16_t* mb;
    __device__ __forceinline__ void operator()(const f32x4 (&acc)[2][2][4][2], const Unit& u, int wr, int wc, int fr, int fq) const {
        const int row0 = u.pm * BM + wr * 64 + fr, col0 = u.pn * BM + wc * 32 + 8 * fq;
#pragma unroll
        for (int ai = 0; ai < 2; ++ai)
#pragma unroll
            for (int m = 0; m < 4; ++m) { const size_t row = (size_t)(row0 + ai * HALF + m * 16);
#pragma unroll
                for (int bj = 0; bj < 2; ++bj) { const int col = col0 + bj * HALF;
                    const u32x4 gw = *(const u32x4*)(proj + row * NPROJ + PC_GATE + STAGE * 1024 + col);
                    f32x4 g0, g1;
                    g0[0] = sigmoid_f(bflo(gw.x)); g0[1] = sigmoid_f(bfhi(gw.x)); g0[2] = sigmoid_f(bflo(gw.y)); g0[3] = sigmoid_f(bfhi(gw.y));
                    g1[0] = sigmoid_f(bflo(gw.z)); g1[1] = sigmoid_f(bfhi(gw.z)); g1[2] = sigmoid_f(bflo(gw.w)); g1[3] = sigmoid_f(bfhi(gw.w));
                    f32x4 v0 = acc[ai][bj][m][0] * g0, v1 = acc[ai][bj][m][1] * g1;
                    float* mp = mf + row * 1024 + col;
                    if (STAGE > 0) { v0 += *(const f32x4*)(mp); v1 += *(const f32x4*)(mp + 4); }
                    if (STAGE < 2) { *(f32x4*)(mp) = v0; *(f32x4*)(mp + 4) = v1; }
                    else { u32x4 w; w.x = cvt_pk_bf16(v0[0], v0[1]); w.y = cvt_pk_bf16(v0[2], v0[3]); w.z = cvt_pk_bf16(v1[0], v1[1]); w.w = cvt_pk_bf16(v1[2], v1[3]);
                        *(u32x4*)(mb + row * 1024 + col) = w; } }
                asm volatile("" ::: "memory"); }
    }
};
struct EpiWout {
    static constexpr bool PERM = false;
    const float* x; float* v;
    __device__ __forceinline__ void operator()(const f32x4 (&acc)[2][2][4][2], const Unit& u, int wr, int wc, int fr, int fq) const {
        const int row0 = u.pm * BM + wr * 64 + fr, col0 = u.pn * BM + wc * 32 + 4 * fq;
#pragma unroll
        for (int ai = 0; ai < 2; ++ai)
#pragma unroll
            for (int m = 0; m < 4; ++m) { const size_t off = (size_t)(row0 + ai * HALF + m * 16) * 1024 + col0;
#pragma unroll
                for (int bj = 0; bj < 2; ++bj)
#pragma unroll
                    for (int n = 0; n < 2; ++n) { const f32x4 xv = *(const f32x4*)(x + off + bj * HALF + n * 16);
                        *(f32x4*)(v + off + bj * HALF + n * 16) = xv * DN_ALPHA + acc[ai][bj][m][n]; }
                asm volatile("" ::: "memory"); }
    }
};
struct EpiMoe1 {
    static constexpr bool PERM = true;
    bf16_t* act; const float* b1;
    __device__ __forceinline__ void operator()(const f32x4 (&acc)[2][2][4][2], const Unit& u, int wr, int wc, int fr, int fq) const {
        const int e = u.pn >> 3, tl = u.pn & 7;
        const int row0 = u.pm * BM + wr * 64 + fr, col0 = tl * 128 + wc * 32 + 8 * fq;
        const float* bp = b1 + (size_t)e * 2048 + col0;
        const f32x4 bg0 = *(const f32x4*)(bp), bg1 = *(const f32x4*)(bp + 4), bl0 = *(const f32x4*)(bp + 1024), bl1 = *(const f32x4*)(bp + 1028);
#pragma unroll
        for (int ai = 0; ai < 2; ++ai)
#pragma unroll
            for (int m = 0; m < 4; ++m) { bf16_t* rowp = act + (size_t)(row0 + ai * HALF + m * 16) * 1024 + col0;
                f32x4 o[2];
#pragma unroll
                for (int n = 0; n < 2; ++n) { const f32x4 gg = acc[ai][0][m][n] + (n ? bg1 : bg0), ll = acc[ai][1][m][n] + (n ? bl1 : bl0);
#pragma unroll
                    for (int q = 0; q < 4; ++q) { const float gv = fminf(gg[q], 7.0f), lv = fminf(fmaxf(ll[q], -7.0f), 7.0f);
                        o[n][q] = gv * sigmoid_f(1.702f * gv) * (lv + 1.0f); } }
                u32x4 w; w.x = cvt_pk_bf16(o[0][0], o[0][1]); w.y = cvt_pk_bf16(o[0][2], o[0][3]); w.z = cvt_pk_bf16(o[1][0], o[1][1]); w.w = cvt_pk_bf16(o[1][2], o[1][3]);
                *(u32x4*)(rowp) = w; }
    }
};
struct EpiMoe2 {
    static constexpr bool PERM = true;
    bf16_t* ys; const float* b2; const float* wbuf;
    __device__ __forceinline__ void operator()(const f32x4 (&acc)[2][2][4][2], const Unit& u, int wr, int wc, int fr, int fq) const {
        const int e = u.pn >> 2, tl = u.pn & 3;
        const int row0 = u.pm * BM + wr * 64 + fr, col0 = tl * 256 + wc * 32 + 8 * fq;
        const float* bp = b2 + (size_t)e * 1024 + col0;
        f32x4 bv[2][2];
#pragma unroll
        for (int bj = 0; bj < 2; ++bj) { bv[bj][0] = *(const f32x4*)(bp + bj * HALF); bv[bj][1] = *(const f32x4*)(bp + bj * HALF + 4); }
#pragma unroll
        for (int ai = 0; ai < 2; ++ai)
#pragma unroll
            for (int m = 0; m < 4; ++m) { const int row = row0 + ai * HALF + m * 16; const float ww = wbuf[row]; bf16_t* rowp = ys + (size_t)row * 1024 + col0;
#pragma unroll
                for (int bj = 0; bj < 2; ++bj) { const f32x4 v0 = (acc[ai][bj][m][0] + bv[bj][0]) * ww, v1 = (acc[ai][bj][m][1] + bv[bj][1]) * ww;
                    u32x4 w; w.x = cvt_pk_bf16(v0[0], v0[1]); w.y = cvt_pk_bf16(v0[2], v0[3]); w.z = cvt_pk_bf16(v1[0], v1[1]); w.w = cvt_pk_bf16(v1[2], v1[3]);
                    *(u32x4*)(rowp + bj * HALF) = w; } }
    }
};
struct MoeOrder {
    int nN, G, c, total; const LAS int* blk_e;
    __device__ __forceinline__ bool next(int i, Unit& u) const {
        const long L = (long)i * G + c; if (L >= total) return false;
        const int rb = (int)(L / nN), tl = (int)(L % nN); u.pm = rb; u.pn = blk_e[rb] * nN + tl; return true;
    }
    __device__ __forceinline__ void a_ready(const Unit&) const {}
    __device__ __forceinline__ void done(const Unit&) const {}
};
}
struct Args { const float* in[30]; float* out; unsigned char* ws; int ph_lo, ph_hi, li, pad; };
typedef const __attribute__((address_space(4))) Args* ArgsP;
enum { I_X = 0, I_WIN, I_LCW, I_LCB, I_LWA, I_LBA, I_LWX, I_LBX, I_LLAM, I_MIB, I_MFB, I_MNG, I_GCW, I_GAL, I_GDT, I_GNG, I_WBA, I_WBB, I_WBC, I_WOUT, I_LN1G, I_LN1B, I_RW, I_RB, I_W1, I_B1, I_W2, I_B2, I_LN2G, I_LN2B };

template <int MODE> __device__ __forceinline__ int col_map(int n) {
    if (MODE == 1) {
        if (n < 3072) return n;
        if (n < 3076) return 8704 + (n - 3072);
        if (n < 3080) return 8708 + (n - 3076);
        if (n < 5128) return n - 8;
        if (n < 5136) return 8712 + (n - 5128);
        if (n < 5144) return 8720 + (n - 5136);
        return n - 24;
    } else if (MODE == 2) {
        if (n < 1024) return (n >> 7) * 256 + (n & 127);
        const int q = n - 1024; return (q >> 7) * 256 + 128 + (q & 127);
    }
    return n;
}
template <int MODE> __device__ __forceinline__ void transpose_item(const float* W, int N, bf16_t* WT, int ldk, int koff, LAS float* scr, int kb, int nb, int lane) {
    const int k0 = 64 * kb, n0 = 32 * nb; const int nsrc = n0 + (lane & 31);
#pragma unroll 8
    for (int i = 0; i < 32; ++i) { const int kk = 2 * i + (lane >> 5); scr[kk * 33 + (lane & 31)] = (nsrc < N) ? W[(size_t)(k0 + kk) * N + nsrc] : 0.f; }
    LDS_WAIT(); asm volatile("" ::: "memory");
    const int c = lane & 7;
#pragma unroll
    for (int j = 0; j < 4; ++j) { const int nl = (lane >> 3) + 8 * j, n = n0 + nl; const LAS float* s = scr + (8 * c) * 33 + nl;
        u32x4 o; o.x = pk2(s[0 * 33], s[1 * 33]); o.y = pk2(s[2 * 33], s[3 * 33]); o.z = pk2(s[4 * 33], s[5 * 33]); o.w = pk2(s[6 * 33], s[7 * 33]);
        if (n < N) *(u32x4*)(WT + (size_t)col_map<MODE>(n) * ldk + koff + k0 + 8 * c) = o; }
    LDS_WAIT(); asm volatile("" ::: "memory");
}
constexpr int IT_IN = 16 * 273, IT_BRA = 16 * 32, IT_BRB = 8 * 32, IT_BRC = 8 * 32, IT_OUT = 16 * 32, IT_W1 = 32 * 16 * 64, IT_W2 = 32 * 16 * 32;
constexpr int IT_G = 8 * 2 * 8;
constexpr int IT_LAYER = IT_IN + IT_BRA + IT_BRB + IT_BRC + IT_OUT + IT_W1 + IT_W2 + IT_G;
__device__ __forceinline__ void p0_convert(ArgsP a, LAS unsigned char* lds, int G) {
    int tid_ = threadIdx.x; asm volatile("" : "+v"(tid_)); const int tid = tid_, lane = tid & 63, wave = tid >> 6;
    LAS float* scr = (LAS float*)(lds + wave * 16384);
    const int gw = blockIdx.x * NWAVES + wave, NGW = G * NWAVES;
    for (int it = gw; it < 2 * IT_LAYER; it += NGW) {
        const int l = it / IT_LAYER; int r = it - l * IT_LAYER;
        unsigned char* wl = a->ws + WS_W + (size_t)l * WL_STRIDE;
        if (r < IT_IN) { transpose_item<1>(a->in[I_WIN] + (size_t)l * 1024 * DIN, DIN, (bf16_t*)(wl + WL_IN), 1024, 0, scr, r / 273, r % 273, lane); continue; } r -= IT_IN;
        if (r < IT_BRA) { transpose_item<0>(a->in[I_WBA] + (size_t)l * 1024 * 1024, 1024, (bf16_t*)(wl + WL_BR), 2048, 0, scr, r / 32, r % 32, lane); continue; } r -= IT_BRA;
        if (r < IT_BRB) { transpose_item<0>(a->in[I_WBB] + (size_t)l * 512 * 1024, 1024, (bf16_t*)(wl + WL_BR), 2048, 1024, scr, r / 32, r % 32, lane); continue; } r -= IT_BRB;
        if (r < IT_BRC) { transpose_item<0>(a->in[I_WBC] + (size_t)l * 512 * 1024, 1024, (bf16_t*)(wl + WL_BR), 2048, 1536, scr, r / 32, r % 32, lane); continue; } r -= IT_BRC;
        if (r < IT_OUT) { transpose_item<0>(a->in[I_WOUT] + (size_t)l * 1024 * 1024, 1024, (bf16_t*)(wl + WL_OUT), 1024, 0, scr, r / 32, r % 32, lane); continue; } r -= IT_OUT;
        if (r < IT_W1) { const int e = r / 1024, q = r % 1024;
            transpose_item<2>(a->in[I_W1] + ((size_t)l * NE + e) * 1024 * 2048, 2048, (bf16_t*)(wl + WL_W1) + (size_t)e * 2048 * 1024, 1024, 0, scr, q / 64, q % 64, lane); continue; } r -= IT_W1;
        if (r < IT_W2) { const int e = r / 512, q = r % 512;
            transpose_item<0>(a->in[I_W2] + ((size_t)l * NE + e) * 1024 * 1024, 1024, (bf16_t*)(wl + WL_W2) + (size_t)e * 1024 * 1024, 1024, 0, scr, q / 32, q % 32, lane); continue; } r -= IT_W2;
        { const int h = r >> 4, gate = (r >> 3) & 1, q = r & 7;
            transpose_item<0>(a->in[gate ? I_LWX : I_LWA] + ((size_t)l * 8 + h) * 128 * 128, 128, (bf16_t*)(wl + WL_G) + (size_t)(h * 256 + gate * 128) * 128, 128, 0, scr, q >> 2, q & 3, lane); }
    }
    const size_t gt = (size_t)blockIdx.x * 512 + tid, GT = (size_t)G * 512;
    for (size_t i = gt; i < (size_t)2 * 232 * 128; i += GT) { const int l = (int)(i / (232 * 128)); const size_t q = i % (232 * 128);
        *(u32x4*)(a->ws + WS_W + (size_t)l * WL_STRIDE + WL_IN + ((size_t)8728 * 1024) * 2 + q * 16) = (u32x4){0u, 0u, 0u, 0u}; }
    for (size_t i = gt; i < (size_t)2 * 32 * 1024; i += GT) { const int l = (int)(i >> 15), k = (int)((i >> 5) & 1023), e = (int)(i & 31); const float w = a->in[I_RW][i];
        const unsigned hb = f2bf(w); const float lo = w - bf2f((unsigned short)hb); bf16_t* dst = (bf16_t*)(a->ws + WS_RWB) + (size_t)l * 2 * 32 * 1024;
        dst[(size_t)e * 1024 + k] = (bf16_t)hb; dst[(size_t)(32 + e) * 1024 + k] = (bf16_t)f2bf(lo); }
    const float* x = a->in[I_X]; bf16_t* xb = (bf16_t*)(a->ws + WS_XB);
    for (size_t i = gt; i < (size_t)T_ * D_ / 8; i += GT) { const f32x4 v0 = *(const f32x4*)(x + i * 8), v1 = *(const f32x4*)(x + i * 8 + 4);
        u32x4 w; w.x = pk2(v0[0], v0[1]); w.y = pk2(v0[2], v0[3]); w.z = pk2(v1[0], v1[1]); w.w = pk2(v1[2], v1[3]); *(u32x4*)(xb + i * 8) = w; }
}

constexpr int TB = 32;
__device__ __forceinline__ void lru_naive(ArgsP a, int l, int u, LAS unsigned char* lds, const bf16_t* proj, bf16_t* H) {
    int tid_ = threadIdx.x; asm volatile("" : "+v"(tid_)); const int tid = tid_, b = u >> 3, h = u & 7, c = tid >> 2, p = tid & 3, chg = h * 128 + c;
    const float* wa = a->in[I_LWA] + ((size_t)l * 8 + h) * 128 * 128; const float* wx = a->in[I_LWX] + ((size_t)l * 8 + h) * 128 * 128;
    float wra[32], wrx[32];
#pragma unroll
    for (int i = 0; i < 32; ++i) { wra[i] = wa[(p * 32 + i) * 128 + c]; wrx[i] = wx[(p * 32 + i) * 128 + c]; }
    const float ba = a->in[I_LBA][l * 1024 + chg], bx = a->in[I_LBX][l * 1024 + chg];
    const float sp = softplus_f(-a->in[I_LLAM][l * 1024 + chg]);
    const float* cw = a->in[I_LCW] + (size_t)l * 4 * 1024 + chg; const float cw0 = cw[0], cw1 = cw[1024], cw2 = cw[2048], cw3 = cw[3072], cb = a->in[I_LCB][l * 1024 + chg];
    LAS bf16_t* xs = (LAS bf16_t*)(lds);
    LAS bf16_t* ys = (LAS bf16_t*)(lds + 8192);
    LAS float* xa_s = (LAS float*)(lds + 16384);
    const int srow = tid >> 4, scol = (tid & 15) * 8;
    const size_t tok0 = (size_t)b * SEQ_;
    u32x4 px = *(const u32x4*)(proj + (tok0 + srow) * NPROJ + PC_LRUX + h * 128 + scol);
    u32x4 py = *(const u32x4*)(proj + (tok0 + srow) * NPROJ + PC_LRUY + h * 128 + scol);
    float hs = 0.f, x1 = 0.f, x2 = 0.f, x3 = 0.f;
    for (int blk = 0; blk < SEQ_ / TB; ++blk) {
        __syncthreads();
        *(LAS u32x4*)(xs + srow * 128 + scol) = px; *(LAS u32x4*)(ys + srow * 128 + scol) = py;
        __syncthreads();
        if (blk + 1 < SEQ_ / TB) { const size_t tk = tok0 + (size_t)(blk + 1) * TB + srow;
            px = *(const u32x4*)(proj + tk * NPROJ + PC_LRUX + h * 128 + scol); py = *(const u32x4*)(proj + tk * NPROJ + PC_LRUY + h * 128 + scol); }
        for (int s = 0; s < TB; ++s) {
            const float xraw = bf2f(xs[s * 128 + c]);
            const float xa = cw0 * x3 + cw1 * x2 + cw2 * x1 + cw3 * xraw + cb;
            x3 = x2; x2 = x1; x1 = xraw;
            LAS float* xb_ = xa_s + (s & 1) * 128;
            if (p == 0) xb_[c] = xa;
            __syncthreads();
            float sa = 0.f, sx = 0.f;
#pragma unroll
            for (int i4 = 0; i4 < 8; ++i4) { const f32x4 xv = *(const LAS f32x4*)(xb_ + p * 32 + i4 * 4);
#pragma unroll
                for (int q = 0; q < 4; ++q) { sa += xv[q] * wra[i4 * 4 + q]; sx += xv[q] * wrx[i4 * 4 + q]; } }
            sa += __shfl_xor(sa, 1); sa += __shfl_xor(sa, 2); sx += __shfl_xor(sx, 1); sx += __shfl_xor(sx, 2);
            const float r = 1.f / (1.f + expf(-(sa + ba))), ig = 1.f / (1.f + expf(-(sx + bx)));
            const float log_a = -8.0f * r * sp, av = expf(log_a), mult = sqrtf(-expm1f(2.0f * log_a));
            hs = av * hs + mult * (ig * xa);
            if (p == 0) { const float y = bf2f(ys[s * 128 + c]);
                H[(tok0 + (size_t)blk * TB + s) * 2048 + chg] = (bf16_t)f2bf(hs * gelu_tanh_f(y)); }
        }
    }
}
__device__ __forceinline__ void mlstm_naive(ArgsP a, int l, int u, LAS unsigned char* lds, const bf16_t* proj, const float* gsm, bf16_t* H) {
    int tid_ = threadIdx.x; asm volatile("" : "+v"(tid_)); const int tid = tid_, lane = tid & 63, wave = tid >> 6, b = u >> 2, hd = u & 3, j = tid & 127;
    LAS float* qs = (LAS float*)(lds);
    LAS float* ks = (LAS float*)(lds + 8192);
    LAS float* vs = (LAS float*)(lds + 16384);
    LAS float* os = (LAS float*)(lds + 32768);
    LAS float* gi = (LAS float*)(lds + 49152);
    LAS float* gf = (LAS float*)(lds + 49152 + 128);
    LAS float* red = (LAS float*)(lds + 49152 + 256);
    const float ib = a->in[I_MIB][l * 4 + hd], fb = a->in[I_MFB][l * 4 + hd], gn = a->in[I_MNG][(size_t)l * 512 + hd * 128 + j];
    const size_t tok0 = (size_t)b * SEQ_;
    const int qa_row = (tid & 255) >> 3, qa_c8 = (tid & 7) * 8; const int qa_col = (tid < 256 ? PC_MLQ : PC_MLK) + hd * 64 + qa_c8;
    const int vb_row = tid >> 4, vb_c8 = (tid & 15) * 8;
    u32x4 pa, pb, pc; float pg = 0.f;
#define ML_ISSUE(blk_) do { const size_t t0 = tok0 + (size_t)(blk_) * TB; \
        pa = *(const u32x4*)(proj + (t0 + qa_row) * NPROJ + qa_col); \
        pb = *(const u32x4*)(proj + (t0 + vb_row) * NPROJ + PC_MLV + hd * 128 + vb_c8); \
        pc = *(const u32x4*)(proj + (t0 + vb_row) * NPROJ + PC_MLO + hd * 128 + vb_c8); \
        if (tid < 64) pg = gsm[(t0 + (tid & 31)) * 32 + (tid < 32 ? 0 : 4) + hd]; } while (0)
    ML_ISSUE(0);
    float C[64], n[64];
#pragma unroll
    for (int r = 0; r < 64; ++r) { C[r] = 0.f; n[r] = 0.f; }
    for (int blk = 0; blk < SEQ_ / TB; ++blk) {
        __syncthreads();
        { LAS float* d = (tid < 256 ? qs : ks) + qa_row * 64 + qa_c8;
          *(LAS f32x4*)(d) = (f32x4){bflo(pa.x), bfhi(pa.x), bflo(pa.y), bfhi(pa.y)}; *(LAS f32x4*)(d + 4) = (f32x4){bflo(pa.z), bfhi(pa.z), bflo(pa.w), bfhi(pa.w)};
          LAS float* dv = vs + vb_row * 128 + vb_c8;
          *(LAS f32x4*)(dv) = (f32x4){bflo(pb.x), bfhi(pb.x), bflo(pb.y), bfhi(pb.y)}; *(LAS f32x4*)(dv + 4) = (f32x4){bflo(pb.z), bfhi(pb.z), bflo(pb.w), bfhi(pb.w)};
          LAS float* dz = os + vb_row * 128 + vb_c8;
          *(LAS f32x4*)(dz) = (f32x4){bflo(pc.x), bfhi(pc.x), bflo(pc.y), bfhi(pc.y)}; *(LAS f32x4*)(dz + 4) = (f32x4){bflo(pc.z), bfhi(pc.z), bflo(pc.w), bfhi(pc.w)};
          if (tid < 32) gi[tid] = pg; else if (tid < 64) gf[tid - 32] = pg; }
        __syncthreads();
        if (blk + 1 < SEQ_ / TB) ML_ISSUE(blk + 1);
        for (int s = 0; s < TB; ++s) {
            float hj = 0.f;
            if (tid < 128) {
                const float f = 1.f / (1.f + expf(-(gf[s] + fb))), ie = expf(gi[s] + ib);
                const float vj = vs[s * 128 + j];
                float num = 0.f, den = 0.f;
#pragma unroll
                for (int r4 = 0; r4 < 16; ++r4) { const f32x4 kk = *(const LAS f32x4*)(ks + s * 64 + r4 * 4), qq = *(const LAS f32x4*)(qs + s * 64 + r4 * 4);
#pragma unroll
                    for (int q = 0; q < 4; ++q) { const int r = r4 * 4 + q; const float ik = ie * kk[q];
                        C[r] = f * C[r] + ik * vj; n[r] = f * n[r] + ik; num += qq[q] * C[r]; den += qq[q] * n[r]; } }
                num *= 0.125f; den *= 0.125f;
                hj = num / fmaxf(fabsf(den), 1.0f);
                const float ss = wave_sum(hj * hj);
                if (lane == 0) red[(s & 1) * 2 + wave] = ss;
            }
            __syncthreads();
            if (tid < 128) {
                const float tot = red[(s & 1) * 2] + red[(s & 1) * 2 + 1];
                const float o = hj * rsqrtf(tot * (1.0f / 128.0f) + RMS_EPS) * gn * sigmoid_f(os[s * 128 + j]);
                H[(tok0 + (size_t)blk * TB + s) * 2048 + 1024 + hd * 128 + j] = (bf16_t)f2bf(o);
            }
        }
    }
}
__device__ __forceinline__ void gdn_naive(ArgsP a, int l, int u, LAS unsigned char* lds, const bf16_t* proj, const float* gsm, bf16_t* H) {
    int tid_ = threadIdx.x; asm volatile("" : "+v"(tid_)); const int tid = tid_, lane = tid & 63, b = u >> 3, hd = u & 7;
    LAS float* rq = (LAS float*)(lds);
    LAS float* rk = (LAS float*)(lds + 9216);
    LAS float* rv = (LAS float*)(lds + 18432);
    LAS float* zs = (LAS float*)(lds + 27648);
    LAS float* ga = (LAS float*)(lds + 27648 + 8192);
    LAS float* gb = ga + TB;
    const float* cw = a->in[I_GCW] + (size_t)l * 4 * 1536;
    float cq[4], ck[4], cv[4];
#pragma unroll
    for (int i = 0; i < 4; ++i) { cq[i] = cw[i * 1536 + hd * 64 + lane]; ck[i] = cw[i * 1536 + 512 + hd * 64 + lane]; cv[i] = cw[i * 1536 + 1024 + hd * 64 + lane]; }
    const float nexpA = -expf(a->in[I_GAL][l * 8 + hd]), dtb = a->in[I_GDT][l * 8 + hd], gn = a->in[I_GNG][l * 64 + lane];
    const size_t tok0 = (size_t)b * SEQ_;
    u32x4 pp[3]; float pg = 0.f;
#define GD_ISSUE(blk_) do { const int tl0 = (blk_) * TB; \
        _Pragma("unroll") for (int i = 0; i < 3; ++i) { const int pid = tid + 512 * i; pp[i] = (u32x4){0u, 0u, 0u, 0u}; \
            if (pid < 840) { const int arr = pid / 280, rem = pid % 280, row = rem >> 3, c8 = (rem & 7) * 8; const int tl = tl0 - 3 + row; \
                if (tl >= 0) pp[i] = *(const u32x4*)(proj + (tok0 + tl) * NPROJ + (arr == 0 ? PC_GDQ : (arr == 1 ? PC_GDK : PC_GDV)) + hd * 64 + c8); } \
            else if (pid < 1096) { const int zp = pid - 840, row = zp >> 3, c8 = (zp & 7) * 8; \
                pp[i] = *(const u32x4*)(proj + (tok0 + tl0 + row) * NPROJ + PC_GDZ + hd * 64 + c8); } } \
        if (tid < 64) pg = gsm[(tok0 + tl0 + (tid & 31)) * 32 + (tid < 32 ? 8 : 16) + hd]; } while (0)
    GD_ISSUE(0);
    float S[64];
#pragma unroll
    for (int i = 0; i < 64; ++i) S[i] = 0.f;
    for (int blk = 0; blk < SEQ_ / TB; ++blk) {
        __syncthreads();
#pragma unroll
        for (int i = 0; i < 3; ++i) { const int pid = tid + 512 * i; LAS float* d = nullptr;
            if (pid < 840) { const int arr = pid / 280, rem = pid % 280, row = rem >> 3, c8 = (rem & 7) * 8; d = (arr == 0 ? rq : (arr == 1 ? rk : rv)) + row * 64 + c8; }
            else if (pid < 1096) { const int zp = pid - 840, row = zp >> 3, c8 = (zp & 7) * 8; d = zs + row * 64 + c8; }
            if (pid < 1096) { const u32x4 w = pp[i];
                *(LAS f32x4*)(d) = (f32x4){bflo(w.x), bfhi(w.x), bflo(w.y), bfhi(w.y)}; *(LAS f32x4*)(d + 4) = (f32x4){bflo(w.z), bfhi(w.z), bflo(w.w), bfhi(w.w)}; } }
        if (tid < 32) ga[tid] = pg; else if (tid < 64) gb[tid - 32] = pg;
        __syncthreads();
        if (blk + 1 < SEQ_ / TB) GD_ISSUE(blk + 1);
        if (tid < 64) {
            for (int s = 0; s < TB; ++s) {
                float qv = 0.f, kv = 0.f, vv = 0.f;
#pragma unroll
                for (int i = 0; i < 4; ++i) { qv += cq[i] * rq[(s + i) * 64 + lane]; kv += ck[i] * rk[(s + i) * 64 + lane]; vv += cv[i] * rv[(s + i) * 64 + lane]; }
                qv = silu_f(qv); kv = silu_f(kv); vv = silu_f(vv);
                const float qn = qv * rsqrtf(wave_sum(qv * qv) + RMS_EPS) * 0.125f;
                const float kn = kv * rsqrtf(wave_sum(kv * kv) + RMS_EPS);
                const float g = nexpA * softplus_f(ga[s] + dtb), alpha = expf(g), beta = 1.f / (1.f + expf(-gb[s]));
                float kS = 0.f;
#pragma unroll
                for (int i = 0; i < 64; ++i) kS += __builtin_bit_cast(float, __builtin_amdgcn_readlane(__builtin_bit_cast(int, kn), i)) * S[i];
                const float dl = beta * (vv - alpha * kS);
                float o = 0.f;
#pragma unroll
                for (int i = 0; i < 64; ++i) { const float ki = __builtin_bit_cast(float, __builtin_amdgcn_readlane(__builtin_bit_cast(int, kn), i));
                    const float qi = __builtin_bit_cast(float, __builtin_amdgcn_readlane(__builtin_bit_cast(int, qn), i));
                    S[i] = alpha * S[i] + ki * dl; o += qi * S[i]; }
                const float ms = wave_sum(o * o) * (1.0f / 64.0f);
                const float out = o * rsqrtf(ms + RMS_EPS) * gn * silu_f(zs[s * 64 + lane]);
                H[(tok0 + (size_t)blk * TB + s) * 2048 + 1536 + hd * 64 + lane] = (bf16_t)f2bf(out);
            }
        }
    }
}

constexpr int RW_PITCH = 1032;
__device__ __forceinline__ unsigned f2key(float v, int e) { unsigned u = __builtin_bit_cast(unsigned, v); u = (u & 0x80000000u) ? ~u : (u | 0x80000000u); return (u & ~31u) | (unsigned)(31 - e); }
__device__ __forceinline__ float key2f(unsigned k) { const unsigned u = k & ~31u; return __builtin_bit_cast(float, (u & 0x80000000u) ? (u ^ 0x80000000u) : ~u); }
__device__ __forceinline__ void p5_ln1_router(ArgsP a, int l, LAS unsigned char* lds, int G) {
    int tid_ = threadIdx.x; asm volatile("" : "+v"(tid_)); const int tid = tid_, lane = tid & 63, wave = tid >> 6, tk = lane & 15, g = lane >> 4;
    LAS bf16_t* whi = (LAS bf16_t*)lds;
    LAS bf16_t* wlo = (LAS bf16_t*)(lds + 32 * RW_PITCH * 2);
    LAS int* hist = (LAS int*)(lds + 2 * 32 * RW_PITCH * 2);
    { const bf16_t* src = (const bf16_t*)(a->ws + WS_RWB) + (size_t)l * 2 * 32 * 1024;
      for (int p = tid; p < 2 * 32 * 128; p += 512) { const int arr = p >> 12, e = (p >> 7) & 31, c8 = (p & 127) * 8;
          *(LAS u32x4*)((arr ? wlo : whi) + e * RW_PITCH + c8) = *(const u32x4*)(src + ((size_t)arr * 32 + e) * 1024 + c8); } }
    const float* v = (const float*)(a->ws + WS_V); float* x1 = (float*)(a->ws + WS_X1); bf16_t* x1b = (bf16_t*)(a->ws + WS_X1B);
    int* tke = (int*)(a->ws + WS_TKE); float* tkw = (float*)(a->ws + WS_TKW); int* ghist = (int*)(a->ws + WS_HIST);
    const float* lng = a->in[I_LN1G] + l * 1024; const float* lnb = a->in[I_LN1B] + l * 1024;
    const float rb0 = a->in[I_RB][l * 32 + tk], rb1 = a->in[I_RB][l * 32 + 16 + tk];
    for (int ch = blockIdx.x; ch < NCHUNK; ch += G) {
        __syncthreads();
        if (tid < 32) hist[tid] = 0;
        __syncthreads();
        const size_t t = (size_t)ch * CHTOK + wave * 16 + tk;
        const float* vr = v + t * 1024 + 8 * g;
        float s = 0.f, s2 = 0.f;
#pragma unroll 8
        for (int ks = 0; ks < 32; ++ks) { const f32x4 p0 = *(const f32x4*)(vr + 32 * ks), p1 = *(const f32x4*)(vr + 32 * ks + 4);
            s += (p0[0] + p0[1]) + (p0[2] + p0[3]) + (p1[0] + p1[1]) + (p1[2] + p1[3]);
            s2 += (p0[0] * p0[0] + p0[1] * p0[1]) + (p0[2] * p0[2] + p0[3] * p0[3]) + (p1[0] * p1[0] + p1[1] * p1[1]) + (p1[2] * p1[2] + p1[3] * p1[3]); }
        s += __shfl_xor(s, 16); s += __shfl_xor(s, 32); s2 += __shfl_xor(s2, 16); s2 += __shfl_xor(s2, 32);
        const float mean = s * (1.0f / 1024.0f); const float rstd = rsqrtf(fmaxf(s2 * (1.0f / 1024.0f) - mean * mean, 0.f) + LN_EPS);
        f32x4 acc0 = (f32x4){0.f, 0.f, 0.f, 0.f}, acc1 = (f32x4){0.f, 0.f, 0.f, 0.f};
#pragma unroll 2
        for (int ks = 0; ks < 32; ++ks) { const int k0 = 32 * ks + 8 * g;
            const f32x4 p0 = *(const f32x4*)(vr + 32 * ks), p1 = *(const f32x4*)(vr + 32 * ks + 4);
            const f32x4 g0 = *(const f32x4*)(lng + k0), g1 = *(const f32x4*)(lng + k0 + 4), b0 = *(const f32x4*)(lnb + k0), b1 = *(const f32x4*)(lnb + k0 + 4);
            const f32x4 y0 = (p0 - mean) * rstd * g0 + b0, y1 = (p1 - mean) * rstd * g1 + b1;
            *(f32x4*)(x1 + t * 1024 + k0) = y0; *(f32x4*)(x1 + t * 1024 + k0 + 4) = y1;
            u32x4 hw; hw.x = pg8::cvt_pk_bf16(y0[0], y0[1]); hw.y = pg8::cvt_pk_bf16(y0[2], y0[3]); hw.z = pg8::cvt_pk_bf16(y1[0], y1[1]); hw.w = pg8::cvt_pk_bf16(y1[2], y1[3]);
            *(u32x4*)(x1b + t * 1024 + k0) = hw;
            u32x4 lw; lw.x = pg8::cvt_pk_bf16(y0[0] - bflo(hw.x), y0[1] - bfhi(hw.x)); lw.y = pg8::cvt_pk_bf16(y0[2] - bflo(hw.y), y0[3] - bfhi(hw.y));
            lw.z = pg8::cvt_pk_bf16(y1[0] - bflo(hw.z), y1[1] - bfhi(hw.z)); lw.w = pg8::cvt_pk_bf16(y1[2] - bflo(hw.w), y1[3] - bfhi(hw.w));
            const bf16x8 ah = __builtin_bit_cast(bf16x8, hw), al = __builtin_bit_cast(bf16x8, lw);
            const bf16x8 wh0 = *(const LAS bf16x8*)(whi + tk * RW_PITCH + k0), wh1 = *(const LAS bf16x8*)(whi + (16 + tk) * RW_PITCH + k0);
            const bf16x8 wl0 = *(const LAS bf16x8*)(wlo + tk * RW_PITCH + k0), wl1 = *(const LAS bf16x8*)(wlo + (16 + tk) * RW_PITCH + k0);
            acc0 = __builtin_amdgcn_mfma_f32_16x16x32_bf16(ah, wh0, acc0, 0, 0, 0); acc1 = __builtin_amdgcn_mfma_f32_16x16x32_bf16(ah, wh1, acc1, 0, 0, 0);
            acc0 = __builtin_amdgcn_mfma_f32_16x16x32_bf16(ah, wl0, acc0, 0, 0, 0); acc1 = __builtin_amdgcn_mfma_f32_16x16x32_bf16(ah, wl1, acc1, 0, 0, 0);
            acc0 = __builtin_amdgcn_mfma_f32_16x16x32_bf16(al, wh0, acc0, 0, 0, 0); acc1 = __builtin_amdgcn_mfma_f32_16x16x32_bf16(al, wh1, acc1, 0, 0, 0); }
#pragma unroll
        for (int r = 0; r < 4; ++r) {
            unsigned k0 = f2key(acc0[r] + rb0, tk), k1 = f2key(acc1[r] + rb1, 16 + tk);
            float tv[4]; int te[4];
#pragma unroll
            for (int k = 0; k < 4; ++k) { unsigned m = k0 > k1 ? k0 : k1;
#pragma unroll
                for (int o = 1; o < 16; o <<= 1) { const unsigned q = (unsigned)__shfl_xor((int)m, o); m = q > m ? q : m; }
                const int e = 31 - (int)(m & 31u); tv[k] = key2f(m); te[k] = e;
                if (e == tk) k0 = 0u; if (e == 16 + tk) k1 = 0u; }
            const float e1 = __expf(tv[1] - tv[0]), e2 = __expf(tv[2] - tv[0]), e3 = __expf(tv[3] - tv[0]); const float inv = 1.0f / (1.0f + e1 + e2 + e3);
            if (tk < 4) { const size_t tt = (size_t)ch * CHTOK + wave * 16 + 4 * g + r;
                const int ei = tk == 0 ? te[0] : (tk == 1 ? te[1] : (tk == 2 ? te[2] : te[3]));
                const float wi = (tk == 0 ? 1.0f : (tk == 1 ? e1 : (tk == 2 ? e2 : e3))) * inv;
                tke[tt * 4 + tk] = ei; tkw[tt * 4 + tk] = wi; __hip_atomic_fetch_add(&hist[ei], 1, __ATOMIC_RELAXED, __HIP_MEMORY_SCOPE_WORKGROUP); }
        }
        __syncthreads();
        if (tid < 32) ghist[ch * 32 + tid] = hist[tid];
    }
}

__device__ __forceinline__ void p6_slots(ArgsP a, LAS unsigned char* lds, int G) {
    int tid_ = threadIdx.x; asm volatile("" : "+v"(tid_)); const int tid = tid_, lane = tid & 63, wave = tid >> 6;
    LAS int* hs = (LAS int*)lds;
    LAS int* cnt = (LAS int*)(lds + 32768);
    LAS int* bst = (LAS int*)(lds + 32768 + 256);
    LAS int* te = (LAS int*)(lds + 36864);
    LAS int* sl = (LAS int*)(lds + 36864 + 2048);
    const int* ghist = (const int*)(a->ws + WS_HIST);
    for (int i = tid; i < NCHUNK * 32; i += 512) hs[i] = ghist[i];
    __syncthreads();
    if (tid < 32) { int run = 0; for (int ch = 0; ch < NCHUNK; ++ch) { const int c = hs[ch * 32 + tid]; hs[ch * 32 + tid] = run; run += c; } cnt[tid] = run; }
    __syncthreads();
    if (tid == 0) { int bs = 0; for (int e = 0; e < 32; ++e) { bst[e] = bs; bs += (cnt[e] + 255) >> 8; } bst[32] = bs; }
    __syncthreads();
    if (blockIdx.x == 0 && tid <= 32) ((int*)(a->ws + WS_META))[tid] = bst[tid];
    const int* tke = (const int*)(a->ws + WS_TKE); const float* tkw = (const float*)(a->ws + WS_TKW);
    int* slot = (int*)(a->ws + WS_SLOT); float* wbuf = (float*)(a->ws + WS_WBUF);
    const bf16_t* x1b = (const bf16_t*)(a->ws + WS_X1B); bf16_t* xs = (bf16_t*)(a->ws + WS_OV + OV_XS);
    for (int ch = blockIdx.x; ch < NCHUNK; ch += G) {
        __syncthreads();
        te[tid] = tke[(size_t)ch * 512 + tid];
        __syncthreads();
        if (tid < 32) { int rank = bst[tid] * 256 + hs[ch * 32 + tid]; for (int p = 0; p < 512; ++p) if (te[p] == tid) sl[p] = rank++; }
        __syncthreads();
        { const size_t pi = (size_t)ch * 512 + tid; const int s_ = sl[tid]; slot[pi] = s_; wbuf[s_] = tkw[pi]; }
        for (int tt = 0; tt < 16; ++tt) { const int tl = wave * 16 + tt; const size_t t = (size_t)ch * CHTOK + tl;
            const u32x4 r0 = *(const u32x4*)(x1b + t * 1024 + lane * 8), r1 = *(const u32x4*)(x1b + t * 1024 + 512 + lane * 8);
#pragma unroll
            for (int k = 0; k < 4; ++k) { const size_t s_ = (size_t)sl[tl * 4 + k]; *(u32x4*)(xs + s_ * 1024 + lane * 8) = r0; *(u32x4*)(xs + s_ * 1024 + 512 + lane * 8) = r1; } }
    }
}
__device__ __forceinline__ int moe_table(ArgsP a, LAS unsigned char* lds) {
    int tid_ = threadIdx.x; asm volatile("" : "+v"(tid_)); const int tid = tid_;
    LAS int* bst = (LAS int*)(lds + MISC_OFF);
    LAS int* blk_e = (LAS int*)(lds + MISC_OFF + 256);
    __syncthreads();
    if (tid <= 32) bst[tid] = ((const int*)(a->ws + WS_META))[tid];
    __syncthreads();
    const int nb = bst[32];
    for (int rb = tid; rb < nb; rb += 512) { int e = 0; while (e < 31 && rb >= bst[e + 1]) ++e; blk_e[rb] = e; }
    __syncthreads();
    return nb;
}

__device__ __forceinline__ void p9_combine_ln2(ArgsP a, int l, float* xout, int G) {
    int tid_ = threadIdx.x; asm volatile("" : "+v"(tid_)); const int tid = tid_, lane = tid & 63, wave = tid >> 6;
    const float* x1 = (const float*)(a->ws + WS_X1); const int* slot = (const int*)(a->ws + WS_SLOT);
    const bf16_t* ys = (const bf16_t*)(a->ws + WS_OV + OV_YS); bf16_t* xb = (bf16_t*)(a->ws + WS_XB);
    f32x4 gg[4], bb[4];
#pragma unroll
    for (int j = 0; j < 4; ++j) { gg[j] = *(const f32x4*)(a->in[I_LN2G] + l * 1024 + 4 * lane + 256 * j); bb[j] = *(const f32x4*)(a->in[I_LN2B] + l * 1024 + 4 * lane + 256 * j); }
    for (size_t t = (size_t)blockIdx.x * NWAVES + wave; t < (size_t)T_; t += (size_t)G * NWAVES) {
        int sk[4];
#pragma unroll
        for (int k = 0; k < 4; ++k) sk[k] = slot[t * 4 + k];
        f32x4 xv[4]; float s = 0.f;
#pragma unroll
        for (int j = 0; j < 4; ++j) { xv[j] = *(const f32x4*)(x1 + t * 1024 + 4 * lane + 256 * j) * DN_ALPHA;
            f32x4 ya = (f32x4){0.f, 0.f, 0.f, 0.f};
#pragma unroll
            for (int k = 0; k < 4; ++k) { const u32x2 w = *(const u32x2*)(ys + (size_t)sk[k] * 1024 + 4 * lane + 256 * j);
                ya[0] += bflo(w.x); ya[1] += bfhi(w.x); ya[2] += bflo(w.y); ya[3] += bfhi(w.y); }
            xv[j] += ya; s += (xv[j][0] + xv[j][1]) + (xv[j][2] + xv[j][3]); }
        const float mean = wave_sum(s) * (1.0f / 1024.0f); float s2 = 0.f;
#pragma unroll
        for (int j = 0; j < 4; ++j) { xv[j] = xv[j] - mean; s2 += (xv[j][0] * xv[j][0] + xv[j][1] * xv[j][1]) + (xv[j][2] * xv[j][2] + xv[j][3] * xv[j][3]); }
        const float rstd = rsqrtf(wave_sum(s2) * (1.0f / 1024.0f) + LN_EPS);
#pragma unroll
        for (int j = 0; j < 4; ++j) { xv[j] = xv[j] * rstd * gg[j] + bb[j];
            *(f32x4*)(xout + t * 1024 + 4 * lane + 256 * j) = xv[j];
            u32x2 w; w.x = pk2(xv[j][0], xv[j][1]); w.y = pk2(xv[j][2], xv[j][3]); *(u32x2*)(xb + t * 1024 + 4 * lane + 256 * j) = w; }
    }
}
typedef float f32x4_t __attribute__((ext_vector_type(4)));
constexpr size_t MX_LRU_PH = 0, MX_LRU_CARRY = 4 * MiB;
template <int MODE> __device__ __forceinline__ void lru_fast(ArgsP a, int l, int b, int h, int c_lo, int c_hi, LAS unsigned char* lds, const bf16_t* proj, bf16_t* H, unsigned char* mxs) {
    int tid_ = threadIdx.x; asm volatile("" : "+v"(tid_)); const int tid = tid_, lane = tid & 63, wave = __builtin_amdgcn_readfirstlane(tid >> 6), fr = lane & 15, g = lane >> 4;
    LAS bf16_t* xa = (LAS bf16_t*)(lds);
    LAS bf16_t* ysb = (LAS bf16_t*)(lds + 17408);
    LAS bf16_t* outb = (LAS bf16_t*)(lds + 33792);
    float* PH = (float*)(mxs + MX_LRU_PH); const float* carry = (const float*)(mxs + MX_LRU_CARRY);
    const int ch = 16 * wave + fr, chg = h * 128 + ch;
    const bf16_t* wg = (const bf16_t*)(a->ws + WS_W + (size_t)l * WL_STRIDE + WL_G) + (size_t)h * 256 * 128;
    bf16x8 bra[4], brx[4];
#pragma unroll
    for (int ks = 0; ks < 4; ++ks) { bra[ks] = *(const bf16x8*)(wg + (size_t)(ch) * 128 + 32 * ks + 8 * g); brx[ks] = *(const bf16x8*)(wg + (size_t)(128 + ch) * 128 + 32 * ks + 8 * g); }
    const float ba = a->in[I_LBA][l * 1024 + chg], bx = a->in[I_LBX][l * 1024 + chg], sp = softplus_f(-a->in[I_LLAM][l * 1024 + chg]);
    const int cg = tid & 15, t0i = tid >> 4;
    float cwv[4][8], cbv[8];
    { const float* cw = a->in[I_LCW] + (size_t)l * 4 * 1024 + h * 128 + 8 * cg;
#pragma unroll
      for (int j = 0; j < 4; ++j) { const f32x4 w0 = *(const f32x4*)(cw + j * 1024), w1 = *(const f32x4*)(cw + j * 1024 + 4);
          cwv[j][0] = w0[0]; cwv[j][1] = w0[1]; cwv[j][2] = w0[2]; cwv[j][3] = w0[3]; cwv[j][4] = w1[0]; cwv[j][5] = w1[1]; cwv[j][6] = w1[2]; cwv[j][7] = w1[3]; }
      const float* cbp = a->in[I_LCB] + l * 1024 + h * 128 + 8 * cg; const f32x4 b0 = *(const f32x4*)(cbp), b1 = *(const f32x4*)(cbp + 4);
      cbv[0] = b0[0]; cbv[1] = b0[1]; cbv[2] = b0[2]; cbv[3] = b0[3]; cbv[4] = b1[0]; cbv[5] = b1[1]; cbv[6] = b1[2]; cbv[7] = b1[3]; }
    u32x4 pr[2][4], py[2];
#define LRU_ISSUE(c_) do { _Pragma("unroll") for (int i = 0; i < 2; ++i) { const int tl = (c_) * 64 + t0i + 32 * i; \
        _Pragma("unroll") for (int j = 0; j < 4; ++j) { const int tt_ = tl - 3 + j; pr[i][j] = (u32x4){0u, 0u, 0u, 0u}; \
            if (tt_ >= 0) pr[i][j] = *(const u32x4*)(proj + ((size_t)b * SEQ_ + tt_) * NPROJ + PC_LRUX + h * 128 + 8 * cg); } \
        if (MODE == 1) py[i] = *(const u32x4*)(proj + ((size_t)b * SEQ_ + tl) * NPROJ + PC_LRUY + h * 128 + 8 * cg); } } while (0)
    LRU_ISSUE(c_lo);
    for (int c = c_lo; c < c_hi; ++c) {
        const size_t tok0 = (size_t)b * SEQ_ + (size_t)c * 64;
        __syncthreads();
#pragma unroll
        for (int i = 0; i < 2; ++i) { float o[8];
#pragma unroll
            for (int q = 0; q < 8; ++q) o[q] = cbv[q];
#pragma unroll
            for (int j = 0; j < 4; ++j) { const unsigned x[4] = {pr[i][j].x, pr[i][j].y, pr[i][j].z, pr[i][j].w};
#pragma unroll
                for (int q = 0; q < 4; ++q) { o[2 * q] += cwv[j][2 * q] * bflo(x[q]); o[2 * q + 1] += cwv[j][2 * q + 1] * bfhi(x[q]); } }
            u32x4 w; w.x = pg8::cvt_pk_bf16(o[0], o[1]); w.y = pg8::cvt_pk_bf16(o[2], o[3]); w.z = pg8::cvt_pk_bf16(o[4], o[5]); w.w = pg8::cvt_pk_bf16(o[6], o[7]);
            *(LAS u32x4*)(xa + (t0i + 32 * i) * 136 + 8 * cg) = w;
            if (MODE == 1) *(LAS u32x4*)(ysb + (t0i + 32 * i) * 128 + 8 * cg) = py[i]; }
        if (c + 1 < c_hi) LRU_ISSUE(c + 1);
        __syncthreads();
        f32x4_t ar[4], ax[4];
#pragma unroll
        for (int tt = 0; tt < 4; ++tt) { ar[tt] = (f32x4_t){0.f, 0.f, 0.f, 0.f}; ax[tt] = (f32x4_t){0.f, 0.f, 0.f, 0.f}; }
#pragma unroll
        for (int tt = 0; tt < 4; ++tt)
#pragma unroll
            for (int ks = 0; ks < 4; ++ks) { const bf16x8 af = *(const LAS bf16x8*)(xa + (16 * tt + fr) * 136 + 32 * ks + 8 * g);
                ar[tt] = __builtin_amdgcn_mfma_f32_16x16x32_bf16(af, bra[ks], ar[tt], 0, 0, 0);
                ax[tt] = __builtin_amdgcn_mfma_f32_16x16x32_bf16(af, brx[ks], ax[tt], 0, 0, 0); }
        float av[4][4], uv[4][4], Ai[4], Bi[4];
#pragma unroll
        for (int tt = 0; tt < 4; ++tt) { float A = 1.f, B = 0.f;
#pragma unroll
            for (int r = 0; r < 4; ++r) { const int t = 16 * tt + 4 * g + r;
                const float rg = sigmoid_f(ar[tt][r] + ba), ig = sigmoid_f(ax[tt][r] + bx);
                const float log_a = -8.0f * rg * sp; av[tt][r] = __expf(log_a); uv[tt][r] = __builtin_amdgcn_sqrtf(neg_expm1_f(2.0f * log_a)) * (ig * bf2f(xa[t * 136 + ch]));
                B = av[tt][r] * B + uv[tt][r]; A *= av[tt][r]; }
            Ai[tt] = A; Bi[tt] = B; }
#pragma unroll
        for (int tt = 0; tt < 4; ++tt) { const float A1 = __shfl_up(Ai[tt], 16), B1 = __shfl_up(Bi[tt], 16); if (g >= 1) { Bi[tt] = Ai[tt] * B1 + Bi[tt]; Ai[tt] = Ai[tt] * A1; } }
#pragma unroll
        for (int tt = 0; tt < 4; ++tt) { const float A2 = __shfl_up(Ai[tt], 32), B2 = __shfl_up(Bi[tt], 32); if (g >= 2) { Bi[tt] = Ai[tt] * B2 + Bi[tt]; Ai[tt] = Ai[tt] * A2; } }
        float Ae[4], Be[4], At[4], Bt[4];
#pragma unroll
        for (int tt = 0; tt < 4; ++tt) { Ae[tt] = __shfl_up(Ai[tt], 16); Be[tt] = __shfl_up(Bi[tt], 16); if (g == 0) { Ae[tt] = 1.f; Be[tt] = 0.f; }
            At[tt] = __shfl(Ai[tt], fr + 48); Bt[tt] = __shfl(Bi[tt], fr + 48); }
        float hin = 0.f, ptot = 1.f;
        if (MODE == 1) hin = carry[((size_t)b * 64 + c) * 1024 + chg];
#pragma unroll
        for (int tt = 0; tt < 4; ++tt) {
            if (MODE == 1) { float hcur = Ae[tt] * hin + Be[tt];
#pragma unroll
                for (int r = 0; r < 4; ++r) { const int t = 16 * tt + 4 * g + r; hcur = av[tt][r] * hcur + uv[tt][r];
                    outb[t * 128 + ch] = (bf16_t)f2bf(hcur * gelu_tanh_f(bf2f(ysb[t * 128 + ch]))); } }
            hin = At[tt] * hin + Bt[tt]; ptot *= At[tt]; }
        if (MODE == 0) { if (g == 0) { PH[(((size_t)b * 64 + c) * 2 + 0) * 1024 + chg] = ptot; PH[(((size_t)b * 64 + c) * 2 + 1) * 1024 + chg] = hin; } }
        else {
            __syncthreads();
#pragma unroll
            for (int i = 0; i < 2; ++i) { const int pid = tid + 512 * i; const int row = pid >> 4, c8 = (pid & 15) * 8;
                *(u32x4*)(H + (tok0 + row) * 2048 + h * 128 + c8) = *(const LAS u32x4*)(outb + row * 128 + c8); }
        }
    }
#undef LRU_ISSUE
}
__device__ __forceinline__ void lru_carry(unsigned char* mxs, int G) {
    const float* PH = (const float*)(mxs + MX_LRU_PH); float* carry = (float*)(mxs + MX_LRU_CARRY);
    int tid_ = threadIdx.x; asm volatile("" : "+v"(tid_));
    for (int gid = blockIdx.x * 512 + tid_; gid < NBATCH * 1024; gid += G * 512) { const int b = gid >> 10, chg = gid & 1023; float hc = 0.f;
#pragma unroll 8
        for (int c = 0; c < 64; ++c) { const size_t o = ((size_t)b * 64 + c); carry[o * 1024 + chg] = hc; hc = PH[(o * 2) * 1024 + chg] * hc + PH[(o * 2 + 1) * 1024 + chg]; } }
}
typedef float f32x16 __attribute__((ext_vector_type(16)));
typedef short bf16x4 __attribute__((ext_vector_type(4)));
constexpr size_t MXB_ML_U = 0;
constexpr size_t MXB_ML_CP = 64 * MiB;
constexpr size_t MXS_ML_NU = 6 * MiB, MXS_ML_NP = 6 * MiB + 512 * 1024, MXS_ML_SC = 7 * MiB;

__device__ __forceinline__ float wave_incl_sum(float v, int lane) {
#pragma unroll
    for (int o = 1; o < 64; o <<= 1) { const float t = __shfl_up(v, o); if (lane >= o) v += t; }
    return v;
}
__device__ __forceinline__ float wave_incl_max(float v, int lane) {
#pragma unroll
    for (int o = 1; o < 64; o <<= 1) { const float t = __shfl_up(v, o); if (lane >= o) v = fmaxf(v, t); }
    return v;
}
__device__ __forceinline__ bf16x8 pack8(float a0, float a1, float a2, float a3, float a4, float a5, float a6, float a7) {
    u32x4 w; w.x = pg8::cvt_pk_bf16(a0, a1); w.y = pg8::cvt_pk_bf16(a2, a3); w.z = pg8::cvt_pk_bf16(a4, a5); w.w = pg8::cvt_pk_bf16(a6, a7); return __builtin_bit_cast(bf16x8, w);
}
__device__ __forceinline__ bf16x8 ld_perm(const LAS bf16_t* p) {
    const u32x2 lo = *(const LAS u32x2*)(p), hi = *(const LAS u32x2*)(p + 8); u32x4 w; w.x = lo.x; w.y = lo.y; w.z = hi.x; w.w = hi.y; return __builtin_bit_cast(bf16x8, w);
}

__device__ __forceinline__ void mlstm_passA(ArgsP a, int l, LAS unsigned char* lds, const bf16_t* proj, const float* gsm, unsigned char* mxb, unsigned char* mxs, int G) {
    int tid_ = threadIdx.x; asm volatile("" : "+v"(tid_)); const int tid = tid_, lane = tid & 63, wave = __builtin_amdgcn_readfirstlane(tid >> 6), r = lane & 31, hh = lane >> 5;
    LAS bf16_t* kwT = (LAS bf16_t*)(lds);
    LAS bf16_t* vT = (LAS bf16_t*)(lds + 9216);
    LAS float* wts = (LAS float*)(lds + 27648);
    float* NU = (float*)(mxs + MXS_ML_NU); float* SC = (float*)(mxs + MXS_ML_SC);
    for (int uid = blockIdx.x; uid < 2048; uid += G) {
        const int c = uid & 63, hd = (uid >> 6) & 3, b = uid >> 8; const size_t tok0 = (size_t)b * SEQ_ + (size_t)c * 64;
        const float ib = a->in[I_MIB][l * 4 + hd], fb = a->in[I_MFB][l * 4 + hd];
        __syncthreads();
        if (wave == 0) {
            const float fpre = gsm[(tok0 + lane) * 32 + 4 + hd] + fb, ipre = gsm[(tok0 + lane) * 32 + hd] + ib;
            const float logf = -softplus_f(-fpre); const float bc = wave_incl_sum(logf, lane); const float bl = __shfl(bc, 63);
            const float ge = bl - bc + ipre; const float mloc = wave_max(ge);
            wts[lane] = expf(ge - mloc);
            if (lane == 0) { SC[(size_t)uid * 4 + 0] = bl; SC[(size_t)uid * 4 + 1] = mloc; }
        }
        const u32x4 kp = *(const u32x4*)(proj + (tok0 + lane) * NPROJ + PC_MLK + hd * 64 + wave * 8);
        const u32x4 vp0 = *(const u32x4*)(proj + (tok0 + lane) * NPROJ + PC_MLV + hd * 128 + wave * 8);
        const u32x4 vp1 = *(const u32x4*)(proj + (tok0 + lane) * NPROJ + PC_MLV + hd * 128 + 64 + wave * 8);
        __syncthreads();
        { const float w = wts[lane]; const unsigned kw[4] = {kp.x, kp.y, kp.z, kp.w};
#pragma unroll
          for (int j = 0; j < 4; ++j) { kwT[(wave * 8 + 2 * j) * 72 + lane] = (bf16_t)f2bf(w * bflo(kw[j])); kwT[(wave * 8 + 2 * j + 1) * 72 + lane] = (bf16_t)f2bf(w * bfhi(kw[j])); }
          const unsigned v0[4] = {vp0.x, vp0.y, vp0.z, vp0.w}, v1[4] = {vp1.x, vp1.y, vp1.z, vp1.w};
#pragma unroll
          for (int j = 0; j < 4; ++j) { vT[(wave * 8 + 2 * j) * 72 + lane] = (bf16_t)(v0[j] & 0xffffu); vT[(wave * 8 + 2 * j + 1) * 72 + lane] = (bf16_t)(v0[j] >> 16);
              vT[(64 + wave * 8 + 2 * j) * 72 + lane] = (bf16_t)(v1[j] & 0xffffu); vT[(64 + wave * 8 + 2 * j + 1) * 72 + lane] = (bf16_t)(v1[j] >> 16); } }
        __syncthreads();
        const int dI = wave >> 2, eJ = wave & 3;
        f32x16 acc;
#pragma unroll
        for (int i = 0; i < 16; ++i) acc[i] = 0.f;
#pragma unroll
        for (int ks = 0; ks < 4; ++ks) { const bf16x8 af = *(const LAS bf16x8*)(kwT + (32 * dI + r) * 72 + 16 * ks + 8 * hh), bf = *(const LAS bf16x8*)(vT + (32 * eJ + r) * 72 + 16 * ks + 8 * hh);
            acc = __builtin_amdgcn_mfma_f32_32x32x16_bf16(af, bf, acc, 0, 0, 0); }
        float* ud = (float*)(mxb + MXB_ML_U) + ((size_t)uid * 8 + wave) * 1024;
#pragma unroll
        for (int q = 0; q < 4; ++q) *(f32x4*)(ud + (q * 64 + lane) * 4) = (f32x4){acc[4 * q], acc[4 * q + 1], acc[4 * q + 2], acc[4 * q + 3]};
        if (tid < 64) { float s = 0.f;
#pragma unroll 8
            for (int t = 0; t < 64; ++t) s += bf2f(kwT[tid * 72 + t]);
            NU[(size_t)uid * 64 + tid] = s; }
    }
}
__device__ __forceinline__ void mlstm_passB(unsigned char* mxb, unsigned char* mxs, int G) {
    int tid_ = threadIdx.x; asm volatile("" : "+v"(tid_)); const int tid = tid_;
    const float* NU = (const float*)(mxs + MXS_ML_NU); float* NP = (float*)(mxs + MXS_ML_NP); float* SC = (float*)(mxs + MXS_ML_SC);
    for (int wu = blockIdx.x; wu < 256; wu += G) {
        const int chain = wu >> 3, tile = wu & 7;
        if (tid < 128) {
            const int lane = tid & 63, s = tid >> 6;
            float st[8]; float m = 0.f;
#pragma unroll
            for (int i = 0; i < 8; ++i) st[i] = 0.f;
#pragma unroll 4
            for (int c = 0; c < 64; ++c) { const size_t uid = (size_t)chain * 64 + c;
                const float* ud = (const float*)(mxb + MXB_ML_U) + (uid * 8 + tile) * 1024;
                const f32x4 u0 = *(const f32x4*)(ud + ((2 * s) * 64 + lane) * 4), u1 = *(const f32x4*)(ud + ((2 * s + 1) * 64 + lane) * 4);
                const float bl = SC[uid * 4 + 0], mloc = SC[uid * 4 + 1];
                *(bf16x8*)((bf16_t*)(mxb + MXB_ML_CP) + (uid * 8 + tile) * 1024 + (s * 64 + lane) * 8) = pack8(st[0], st[1], st[2], st[3], st[4], st[5], st[6], st[7]);
                if (tile == 0 && tid == 0) SC[uid * 4 + 2] = m;
                const float mn = fmaxf(bl + m, mloc), dec = expf(bl + m - mn), sc = expf(mloc - mn); m = mn;
#pragma unroll
                for (int i = 0; i < 4; ++i) { st[i] = dec * st[i] + sc * u0[i]; st[4 + i] = dec * st[4 + i] + sc * u1[i]; } }
        } else if (tile == 0 && tid < 192) {
            const int d = tid - 128; float n = 0.f, m = 0.f;
#pragma unroll 4
            for (int c = 0; c < 64; ++c) { const size_t uid = (size_t)chain * 64 + c; const float bl = SC[uid * 4 + 0], mloc = SC[uid * 4 + 1]; const float nu = NU[uid * 64 + d];
                NP[uid * 64 + d] = n; const float mn = fmaxf(bl + m, mloc), dec = expf(bl + m - mn), sc = expf(mloc - mn); m = mn; n = dec * n + sc * nu; }
        }
    }
}
__device__ __forceinline__ void mlstm_passC(ArgsP a, int l, LAS unsigned char* lds, const bf16_t* proj, const float* gsm, bf16_t* H, unsigned char* mxb, unsigned char* mxs, int first, int stride) {
    int tid_ = threadIdx.x; asm volatile("" : "+v"(tid_)); const int tid = tid_, lane = tid & 63, wave = __builtin_amdgcn_readfirstlane(tid >> 6), r = lane & 31, hh = lane >> 5;
    LAS bf16_t* qb = (LAS bf16_t*)(lds);
    LAS bf16_t* kb = (LAS bf16_t*)(lds + 9216);
    LAS bf16_t* vT = (LAS bf16_t*)(lds + 18432);
    LAS bf16_t* ob = (LAS bf16_t*)(lds + 36864);
    LAS bf16_t* outb = (LAS bf16_t*)(lds + 54272);
    LAS float* tb_rt = (LAS float*)(lds + 70656);
    LAS float* tb_ct = tb_rt + 64;
    LAS float* tb_iw = tb_rt + 128;
    LAS float* tb_em = tb_rt + 192;
    LAS float* tb_np = tb_rt + 256;
    LAS float* ssq = tb_rt + 320;
    const float* NP = (const float*)(mxs + MXS_ML_NP); const float* SC = (const float*)(mxs + MXS_ML_SC);
    for (int uid = first; uid < 2048; uid += stride) {
        const int c = uid & 63, hd = (uid >> 6) & 3, b = uid >> 8; const size_t tok0 = (size_t)b * SEQ_ + (size_t)c * 64;
        __syncthreads();
        if (wave == 0) {
            const float ib = a->in[I_MIB][l * 4 + hd], fb = a->in[I_MFB][l * 4 + hd];
            const float fpre = gsm[(tok0 + lane) * 32 + 4 + hd] + fb, ipre = gsm[(tok0 + lane) * 32 + hd] + ib;
            const float logf = -softplus_f(-fpre); const float bc = wave_incl_sum(logf, lane);
            const float rt = ipre - bc; const float cmx = wave_incl_max(rt, lane); const float mprev = SC[(size_t)uid * 4 + 2];
            const float mt = bc + fmaxf(mprev, cmx);
            tb_rt[lane] = rt; tb_ct[lane] = bc - mt; tb_iw[lane] = expf(bc + mprev - mt); tb_em[lane] = expf(-mt); tb_np[lane] = NP[(size_t)uid * 64 + lane];
        }
        { const int row = tid >> 3, c8 = (tid & 7) * 8;
          *(LAS u32x4*)(qb + row * 72 + c8) = *(const u32x4*)(proj + (tok0 + row) * NPROJ + PC_MLQ + hd * 64 + c8);
          *(LAS u32x4*)(kb + row * 72 + c8) = *(const u32x4*)(proj + (tok0 + row) * NPROJ + PC_MLK + hd * 64 + c8);
#pragma unroll
          for (int i = 0; i < 2; ++i) { const int pid = tid + 512 * i; const int orow = pid >> 4, oc8 = (pid & 15) * 8;
              *(LAS u32x4*)(ob + orow * 136 + oc8) = *(const u32x4*)(proj + (tok0 + orow) * NPROJ + PC_MLO + hd * 128 + oc8); }
          const u32x4 vp0 = *(const u32x4*)(proj + (tok0 + lane) * NPROJ + PC_MLV + hd * 128 + wave * 8);
          const u32x4 vp1 = *(const u32x4*)(proj + (tok0 + lane) * NPROJ + PC_MLV + hd * 128 + 64 + wave * 8);
          const unsigned v0[4] = {vp0.x, vp0.y, vp0.z, vp0.w}, v1[4] = {vp1.x, vp1.y, vp1.z, vp1.w};
#pragma unroll
          for (int j = 0; j < 4; ++j) { vT[(wave * 8 + 2 * j) * 72 + lane] = (bf16_t)(v0[j] & 0xffffu); vT[(wave * 8 + 2 * j + 1) * 72 + lane] = (bf16_t)(v0[j] >> 16);
              vT[(64 + wave * 8 + 2 * j) * 72 + lane] = (bf16_t)(v1[j] & 0xffffu); vT[(64 + wave * 8 + 2 * j + 1) * 72 + lane] = (bf16_t)(v1[j] >> 16); } }
        __syncthreads();
        const int eI = wave >> 1, tJ = wave & 1; const int t = 32 * tJ + r;
        f32x16 as[2];
#pragma unroll
        for (int sI = 0; sI < 2; ++sI) {
#pragma unroll
            for (int i = 0; i < 16; ++i) as[sI][i] = 0.f;
#pragma unroll
            for (int ks = 0; ks < 4; ++ks) { const bf16x8 af = *(const LAS bf16x8*)(kb + (32 * sI + r) * 72 + 16 * ks + 8 * hh), bf = *(const LAS bf16x8*)(qb + t * 72 + 16 * ks + 8 * hh);
                as[sI] = __builtin_amdgcn_mfma_f32_32x32x16_bf16(af, bf, as[sI], 0, 0, 0); } }
        const float ctt = tb_ct[t], iwt = tb_iw[t] * 0.125f, emt = tb_em[t];
        float dsum = 0.f;
#pragma unroll
        for (int sI = 0; sI < 2; ++sI)
#pragma unroll
            for (int q = 0; q < 4; ++q) { const int s0 = 32 * sI + 8 * q + 4 * hh; const f32x4 rt4 = *(const LAS f32x4*)(tb_rt + s0);
#pragma unroll
                for (int i = 0; i < 4; ++i) { const float wv = (s0 + i <= t) ? as[sI][4 * q + i] * 0.125f * __expf(ctt + rt4[i]) : 0.f; as[sI][4 * q + i] = wv; dsum += wv; } }
        float qn = 0.f;
#pragma unroll
        for (int j = 0; j < 4; ++j) { const u32x4 qw = *(const LAS u32x4*)(qb + t * 72 + 32 * hh + 8 * j); const f32x4 n0 = *(const LAS f32x4*)(tb_np + 32 * hh + 8 * j), n1 = *(const LAS f32x4*)(tb_np + 32 * hh + 8 * j + 4);
            qn += bflo(qw.x) * n0[0] + bfhi(qw.x) * n0[1] + bflo(qw.y) * n0[2] + bfhi(qw.y) * n0[3] + bflo(qw.z) * n1[0] + bfhi(qw.z) * n1[1] + bflo(qw.w) * n1[2] + bfhi(qw.w) * n1[3]; }
        float den = dsum + iwt * qn; den += __shfl_xor(den, 32);
        f32x16 an;
#pragma unroll
        for (int i = 0; i < 16; ++i) an[i] = 0.f;
#pragma unroll
        for (int sI = 0; sI < 2; ++sI)
#pragma unroll
            for (int s2 = 0; s2 < 2; ++s2) { const bf16x8 af = ld_perm(vT + (32 * eI + r) * 72 + 32 * sI + 16 * s2 + 4 * hh);
                const bf16x8 bf = pack8(as[sI][8 * s2], as[sI][8 * s2 + 1], as[sI][8 * s2 + 2], as[sI][8 * s2 + 3], as[sI][8 * s2 + 4], as[sI][8 * s2 + 5], as[sI][8 * s2 + 6], as[sI][8 * s2 + 7]);
                an = __builtin_amdgcn_mfma_f32_32x32x16_bf16(af, bf, an, 0, 0, 0); }
        const bf16_t* cpd = (const bf16_t*)(mxb + MXB_ML_CP) + (size_t)uid * 8 * 1024;
#pragma unroll
        for (int dI = 0; dI < 2; ++dI)
#pragma unroll
            for (int s2 = 0; s2 < 2; ++s2) { const bf16x8 af = *(const bf16x8*)(cpd + (size_t)(dI * 4 + eI) * 1024 + (s2 * 64 + lane) * 8);
                const u32x4 qw = __builtin_bit_cast(u32x4, ld_perm(qb + t * 72 + 32 * dI + 16 * s2 + 4 * hh));
                const bf16x8 bf = pack8(bflo(qw.x) * iwt, bfhi(qw.x) * iwt, bflo(qw.y) * iwt, bfhi(qw.y) * iwt, bflo(qw.z) * iwt, bfhi(qw.z) * iwt, bflo(qw.w) * iwt, bfhi(qw.w) * iwt);
                an = __builtin_amdgcn_mfma_f32_32x32x16_bf16(af, bf, an, 0, 0, 0); }
        const float dinv = 1.0f / fmaxf(fabsf(den), emt);
        float sq = 0.f;
#pragma unroll
        for (int i = 0; i < 16; ++i) { an[i] *= dinv; sq += an[i] * an[i]; }
        sq += __shfl_xor(sq, 32);
        if (hh == 0) ssq[eI * 64 + t] = sq;
        __syncthreads();
        const float tot = ssq[t] + ssq[64 + t] + ssq[128 + t] + ssq[192 + t];
        const float rinv = rsqrtf(tot * (1.0f / 128.0f) + RMS_EPS);
        const float* gn = a->in[I_MNG] + (size_t)l * 512 + hd * 128;
#pragma unroll
        for (int q = 0; q < 4; ++q) { const int e0 = 32 * eI + 8 * q + 4 * hh; const f32x4 g4 = *(const f32x4*)(gn + e0); const u32x2 ow = *(const LAS u32x2*)(ob + t * 136 + e0);
            const float o0 = an[4 * q] * rinv * g4[0] * sigmoid_f(bflo(ow.x)), o1 = an[4 * q + 1] * rinv * g4[1] * sigmoid_f(bfhi(ow.x));
            const float o2 = an[4 * q + 2] * rinv * g4[2] * sigmoid_f(bflo(ow.y)), o3 = an[4 * q + 3] * rinv * g4[3] * sigmoid_f(bfhi(ow.y));
            u32x2 pw; pw.x = pg8::cvt_pk_bf16(o0, o1); pw.y = pg8::cvt_pk_bf16(o2, o3); *(LAS u32x2*)(outb + t * 128 + e0) = pw; }
        __syncthreads();
#pragma unroll
        for (int i = 0; i < 2; ++i) { const int pid = tid + 512 * i; const int row = pid >> 4, c8 = (pid & 15) * 8;
            *(u32x4*)(H + (tok0 + row) * 2048 + 1024 + hd * 128 + c8) = *(const LAS u32x4*)(outb + row * 128 + c8); }
    }
}
constexpr size_t MXB_GD_ND = 96 * MiB, MXB_GD_OD = 160 * MiB, MXB_GD_T = 224 * MiB;
constexpr size_t MXT_GD_XD = 8 * MiB, MXT_GD_QD = 40 * MiB, MXT_GD_SD = 72 * MiB;
constexpr size_t MXS_GD_GL = 7 * MiB + 64 * 1024;

__device__ __forceinline__ void conv_silu8(const u32x4 (&rw)[4], const float* cw, float (&o)[8]) {
#pragma unroll
    for (int j = 0; j < 8; ++j) o[j] = 0.f;
#pragma unroll
    for (int i = 0; i < 4; ++i) { const f32x4 w0 = *(const f32x4*)(cw + i * 1536), w1 = *(const f32x4*)(cw + i * 1536 + 4); const unsigned x[4] = {rw[i].x, rw[i].y, rw[i].z, rw[i].w};
        o[0] += w0[0] * bflo(x[0]); o[1] += w0[1] * bfhi(x[0]); o[2] += w0[2] * bflo(x[1]); o[3] += w0[3] * bfhi(x[1]);
        o[4] += w1[0] * bflo(x[2]); o[5] += w1[1] * bfhi(x[2]); o[6] += w1[2] * bflo(x[3]); o[7] += w1[3] * bfhi(x[3]); }
#pragma unroll
    for (int j = 0; j < 8; ++j) o[j] = silu_f(o[j]);
}
__device__ __forceinline__ void load_rows4(const bf16_t* proj, int b, int tl, int col, u32x4 (&rw)[4]) {
#pragma unroll
    for (int i = 0; i < 4; ++i) { const int tt = tl - 3 + i; rw[i] = (u32x4){0u, 0u, 0u, 0u}; if (tt >= 0) rw[i] = *(const u32x4*)(proj + ((size_t)b * SEQ_ + tt) * NPROJ + col); }
}

__device__ __forceinline__ void gdn_passA1(ArgsP a, int l, LAS unsigned char* lds, const bf16_t* proj, const float* gsm, unsigned char* mxb, int G) {
    int tid_ = threadIdx.x; asm volatile("" : "+v"(tid_)); const int tid = tid_, lane = tid & 63, wave = __builtin_amdgcn_readfirstlane(tid >> 6), r = lane & 31, hh = lane >> 5;
    LAS unsigned char* wl = lds + wave * 16384;
    LAS bf16_t* kb = (LAS bf16_t*)wl;
    LAS float* am = (LAS float*)wl;
    LAS float* tb = (LAS float*)(lds + MISC_OFF + 1024 + wave * 512);
    const float* cwk = a->in[I_GCW] + (size_t)l * 4 * 1536 + 512;
    for (int uid = blockIdx.x * NWAVES + wave; uid < 4096; uid += G * NWAVES) {
        const int c = uid & 63, hd = (uid >> 6) & 7, b = uid >> 9; const int tl = c * 64 + lane; const size_t tok = (size_t)b * SEQ_ + tl;
        float ss = 0.f;
#pragma unroll 2
        for (int p = 0; p < 8; ++p) { u32x4 rw[4]; load_rows4(proj, b, tl, PC_GDK + hd * 64 + 8 * p, rw); float o[8]; conv_silu8(rw, cwk + hd * 64 + 8 * p, o);
#pragma unroll
            for (int j = 0; j < 8; ++j) ss += o[j] * o[j];
            *(LAS bf16x8*)(kb + lane * 72 + 8 * p) = pack8(o[0], o[1], o[2], o[3], o[4], o[5], o[6], o[7]); }
        const float rn = rsqrtf(ss + RMS_EPS);
        const float gg = -expf(a->in[I_GAL][l * 8 + hd]) * softplus_f(gsm[tok * 32 + 8 + hd] + a->in[I_GDT][l * 8 + hd]);
        const float gc = wave_incl_sum(gg, lane), beta = 1.f / (1.f + expf(-gsm[tok * 32 + 16 + hd]));
        tb[lane] = gc; tb[64 + lane] = beta * rn;
        LDS_WAIT(); asm volatile("" ::: "memory");
        bf16x8 kf[2][4];
#pragma unroll
        for (int I = 0; I < 2; ++I)
#pragma unroll
            for (int ks = 0; ks < 4; ++ks) kf[I][ks] = *(const LAS bf16x8*)(kb + (32 * I + r) * 72 + 16 * ks + 8 * hh);
        LDS_WAIT(); asm volatile("" ::: "memory");
#pragma unroll
        for (int I = 0; I < 2; ++I)
#pragma unroll
            for (int J = 0; J < 2; ++J) { f32x16 acc;
#pragma unroll
                for (int i = 0; i < 16; ++i) acc[i] = 0.f;
#pragma unroll
                for (int ks = 0; ks < 4; ++ks) acc = __builtin_amdgcn_mfma_f32_32x32x16_bf16(kf[I][ks], kf[J][ks], acc, 0, 0, 0);
                const int s = 32 * J + r; const float gcs = __shfl(gc, s), rns = __shfl(rn, s);
#pragma unroll
                for (int q = 0; q < 4; ++q) { const int t0 = 32 * I + 8 * q + 4 * hh; const f32x4 gct = *(const LAS f32x4*)(tb + t0), brt = *(const LAS f32x4*)(tb + 64 + t0);
#pragma unroll
                    for (int i = 0; i < 4; ++i) { const float v = (s < t0 + i) ? acc[4 * q + i] * brt[i] * rns * __expf(gct[i] - gcs) : 0.f; am[(t0 + i) * 64 + s] = v; } } }
        LDS_WAIT(); asm volatile("" ::: "memory");
        float Tc[64];
#pragma unroll
        for (int i = 0; i < 64; ++i) { float acc = (i == lane) ? 1.f : 0.f;
#pragma unroll
            for (int j4 = 0; j4 < (i + 3) / 4; ++j4) { const f32x4 av = *(const LAS f32x4*)(am + i * 64 + 4 * j4);
#pragma unroll
                for (int jj = 0; jj < 4; ++jj) if (4 * j4 + jj < i) acc -= av[jj] * Tc[4 * j4 + jj]; }
            Tc[i] = acc; }
        bf16_t* Tg = (bf16_t*)(mxb + MXB_GD_T) + (size_t)uid * 4096;
#pragma unroll
        for (int i = 0; i < 64; ++i) Tg[i * 64 + lane] = (bf16_t)f2bf(Tc[i]);
    }
}

__device__ __forceinline__ void gdn_passA2(ArgsP a, int l, LAS unsigned char* lds, const bf16_t* proj, const float* gsm, unsigned char* mxb, unsigned char* mxt, unsigned char* mxs, int G) {
    int tid_ = threadIdx.x; asm volatile("" : "+v"(tid_)); const int tid = tid_, lane = tid & 63, wave = __builtin_amdgcn_readfirstlane(tid >> 6), r = lane & 31, hh = lane >> 5;
    LAS bf16_t* qb = (LAS bf16_t*)(lds);
    LAS bf16_t* kb = (LAS bf16_t*)(lds + 9216);
    LAS bf16_t* bvT = (LAS bf16_t*)(lds + 18432);
    LAS bf16_t* bkT = (LAS bf16_t*)(lds + 27648);
    LAS bf16_t* Tm = (LAS bf16_t*)(lds + 36864);
    LAS bf16_t* wT = (LAS bf16_t*)(lds + 46080);
    LAS bf16_t* uT = (LAS bf16_t*)(lds + 55296);
    LAS bf16_t* kdT = (LAS bf16_t*)(lds + 64512);
    LAS float* tb_gc = (LAS float*)(lds + 73728);
    LAS float* tb_beta = tb_gc + 64;
    LAS float* ssq = tb_gc + 128;
    const float* cw = a->in[I_GCW] + (size_t)l * 4 * 1536;
    float* GL = (float*)(mxs + MXS_GD_GL);
    for (int uid = blockIdx.x; uid < 4096; uid += G) {
        const int c = uid & 63, hd = (uid >> 6) & 7, b = uid >> 9; const int tl = c * 64 + lane; const size_t tok = (size_t)b * SEQ_ + tl;
        __syncthreads();
        if (wave == 0) {
            const float gg = -expf(a->in[I_GAL][l * 8 + hd]) * softplus_f(gsm[tok * 32 + 8 + hd] + a->in[I_GDT][l * 8 + hd]);
            const float gc = wave_incl_sum(gg, lane); tb_gc[lane] = gc; tb_beta[lane] = 1.f / (1.f + expf(-gsm[tok * 32 + 16 + hd]));
            if (lane == 63) GL[uid] = expf(gc);
        }
        float qo[8], ko[8], vo[8];
        { u32x4 rw[4]; load_rows4(proj, b, tl, PC_GDQ + hd * 64 + 8 * wave, rw); conv_silu8(rw, cw + hd * 64 + 8 * wave, qo); }
        { u32x4 rw[4]; load_rows4(proj, b, tl, PC_GDK + hd * 64 + 8 * wave, rw); conv_silu8(rw, cw + 512 + hd * 64 + 8 * wave, ko); }
        { u32x4 rw[4]; load_rows4(proj, b, tl, PC_GDV + hd * 64 + 8 * wave, rw); conv_silu8(rw, cw + 1024 + hd * 64 + 8 * wave, vo); }
        { float sq = 0.f, sk = 0.f;
#pragma unroll
          for (int j = 0; j < 8; ++j) { sq += qo[j] * qo[j]; sk += ko[j] * ko[j]; }
          ssq[wave * 64 + lane] = sq; ssq[512 + wave * 64 + lane] = sk; }
        *(LAS u32x4*)(Tm + (tid >> 3) * 72 + (tid & 7) * 8) = *(const u32x4*)((const bf16_t*)(mxb + MXB_GD_T) + (size_t)uid * 4096 + (tid >> 3) * 64 + (tid & 7) * 8);
        __syncthreads();
        { float sq = 0.f, sk = 0.f;
#pragma unroll
          for (int w = 0; w < 8; ++w) { sq += ssq[w * 64 + lane]; sk += ssq[512 + w * 64 + lane]; }
          const float rq = rsqrtf(sq + RMS_EPS) * 0.125f, rk = rsqrtf(sk + RMS_EPS);
          const float gc = tb_gc[lane], beta = tb_beta[lane], gl_ = tb_gc[63];
          const float e1 = beta * __expf(gc), e2 = __expf(gl_ - gc);
#pragma unroll
          for (int j = 0; j < 8; ++j) { qo[j] *= rq; ko[j] *= rk; }
          *(LAS bf16x8*)(qb + lane * 72 + 8 * wave) = pack8(qo[0], qo[1], qo[2], qo[3], qo[4], qo[5], qo[6], qo[7]);
          *(LAS bf16x8*)(kb + lane * 72 + 8 * wave) = pack8(ko[0], ko[1], ko[2], ko[3], ko[4], ko[5], ko[6], ko[7]);
#pragma unroll
          for (int j = 0; j < 8; ++j) { const int d = 8 * wave + j;
              bvT[d * 72 + lane] = (bf16_t)f2bf(beta * vo[j]); bkT[d * 72 + lane] = (bf16_t)f2bf(e1 * ko[j]); kdT[d * 72 + lane] = (bf16_t)f2bf(e2 * ko[j]); } }
        __syncthreads();
        { const int mat = wave >> 2, I = (wave >> 1) & 1, J = wave & 1; const LAS bf16_t* Am = mat ? bkT : bvT; LAS bf16_t* Om = mat ? wT : uT;
          f32x16 acc;
#pragma unroll
          for (int i = 0; i < 16; ++i) acc[i] = 0.f;
#pragma unroll
          for (int ks = 0; ks < 4; ++ks) { const bf16x8 af = *(const LAS bf16x8*)(Am + (32 * I + r) * 72 + 16 * ks + 8 * hh), bf = *(const LAS bf16x8*)(Tm + (32 * J + r) * 72 + 16 * ks + 8 * hh);
              acc = __builtin_amdgcn_mfma_f32_32x32x16_bf16(af, bf, acc, 0, 0, 0); }
#pragma unroll
          for (int q = 0; q < 4; ++q)
#pragma unroll
              for (int i = 0; i < 4; ++i) Om[(32 * I + 8 * q + 4 * hh + i) * 72 + 32 * J + r] = (bf16_t)f2bf(acc[4 * q + i]); }
        __syncthreads();
        if (wave < 4) {
            const int I = (wave >> 1) & 1, J = wave & 1;
            f32x16 ax, an;
#pragma unroll
            for (int i = 0; i < 16; ++i) { ax[i] = 0.f; an[i] = 0.f; }
#pragma unroll
            for (int ks = 0; ks < 4; ++ks) { const bf16x8 wf = *(const LAS bf16x8*)(wT + (32 * I + r) * 72 + 16 * ks + 8 * hh), kdf_b = *(const LAS bf16x8*)(kdT + (32 * J + r) * 72 + 16 * ks + 8 * hh);
                ax = __builtin_amdgcn_mfma_f32_32x32x16_bf16(wf, kdf_b, ax, 0, 0, 0);
                const bf16x8 kdf_a = *(const LAS bf16x8*)(kdT + (32 * I + r) * 72 + 16 * ks + 8 * hh), uf = *(const LAS bf16x8*)(uT + (32 * J + r) * 72 + 16 * ks + 8 * hh);
                an = __builtin_amdgcn_mfma_f32_32x32x16_bf16(kdf_a, uf, an, 0, 0, 0); }
            bf16_t* xd = (bf16_t*)(mxt + MXT_GD_XD) + (size_t)uid * 4096 + (size_t)(I * 2 + J) * 1024;
#pragma unroll
            for (int s2 = 0; s2 < 2; ++s2) *(bf16x8*)(xd + (s2 * 64 + lane) * 8) = pack8(-ax[8 * s2], -ax[8 * s2 + 1], -ax[8 * s2 + 2], -ax[8 * s2 + 3], -ax[8 * s2 + 4], -ax[8 * s2 + 5], -ax[8 * s2 + 6], -ax[8 * s2 + 7]);
            float* nd = (float*)(mxb + MXB_GD_ND) + (size_t)uid * 4096 + (size_t)(I * 2 + J) * 1024;
#pragma unroll
            for (int q = 0; q < 4; ++q) *(f32x4*)(nd + (q * 64 + lane) * 4) = (f32x4){an[4 * q], an[4 * q + 1], an[4 * q + 2], an[4 * q + 3]};
        } else {
            const int I = (wave >> 1) & 1, tJ = wave & 1; const int t = 32 * tJ + r; const float gct = tb_gc[t];
            bf16x8 pf[2][2];
#pragma unroll
            for (int sI = 0; sI < 2; ++sI) { f32x16 ap;
#pragma unroll
                for (int i = 0; i < 16; ++i) ap[i] = 0.f;
#pragma unroll
                for (int ks = 0; ks < 4; ++ks) { const bf16x8 af = *(const LAS bf16x8*)(kb + (32 * sI + r) * 72 + 16 * ks + 8 * hh), bf = *(const LAS bf16x8*)(qb + t * 72 + 16 * ks + 8 * hh);
                    ap = __builtin_amdgcn_mfma_f32_32x32x16_bf16(af, bf, ap, 0, 0, 0); }
#pragma unroll
                for (int q = 0; q < 4; ++q) { const int s0 = 32 * sI + 8 * q + 4 * hh; const f32x4 gcs = *(const LAS f32x4*)(tb_gc + s0);
#pragma unroll
                    for (int i = 0; i < 4; ++i) ap[4 * q + i] = (s0 + i <= t) ? ap[4 * q + i] * __expf(gct - gcs[i]) : 0.f; }
#pragma unroll
                for (int s2 = 0; s2 < 2; ++s2) pf[sI][s2] = pack8(ap[8 * s2], ap[8 * s2 + 1], ap[8 * s2 + 2], ap[8 * s2 + 3], ap[8 * s2 + 4], ap[8 * s2 + 5], ap[8 * s2 + 6], ap[8 * s2 + 7]); }
            f32x16 aq, ao;
#pragma unroll
            for (int i = 0; i < 16; ++i) { aq[i] = 0.f; ao[i] = 0.f; }
#pragma unroll
            for (int sI = 0; sI < 2; ++sI)
#pragma unroll
                for (int s2 = 0; s2 < 2; ++s2) { const bf16x8 wf = ld_perm(wT + (32 * I + r) * 72 + 32 * sI + 16 * s2 + 4 * hh), uf = ld_perm(uT + (32 * I + r) * 72 + 32 * sI + 16 * s2 + 4 * hh);
                    aq = __builtin_amdgcn_mfma_f32_32x32x16_bf16(wf, pf[sI][s2], aq, 0, 0, 0); ao = __builtin_amdgcn_mfma_f32_32x32x16_bf16(uf, pf[sI][s2], ao, 0, 0, 0); }
            const float egt = __expf(gct);
#pragma unroll
            for (int q = 0; q < 4; ++q) { const int d0 = 32 * I + 8 * q + 4 * hh; const u32x2 qw = *(const LAS u32x2*)(qb + t * 72 + d0);
                aq[4 * q] = bflo(qw.x) * egt - aq[4 * q]; aq[4 * q + 1] = bfhi(qw.x) * egt - aq[4 * q + 1]; aq[4 * q + 2] = bflo(qw.y) * egt - aq[4 * q + 2]; aq[4 * q + 3] = bfhi(qw.y) * egt - aq[4 * q + 3]; }
            bf16_t* qd = (bf16_t*)(mxt + MXT_GD_QD) + (size_t)uid * 4096 + (size_t)(I * 2 + tJ) * 1024;
#pragma unroll
            for (int s2 = 0; s2 < 2; ++s2) *(bf16x8*)(qd + (s2 * 64 + lane) * 8) = pack8(aq[8 * s2], aq[8 * s2 + 1], aq[8 * s2 + 2], aq[8 * s2 + 3], aq[8 * s2 + 4], aq[8 * s2 + 5], aq[8 * s2 + 6], aq[8 * s2 + 7]);
            float* od = (float*)(mxb + MXB_GD_OD) + (size_t)uid * 4096 + (size_t)(I * 2 + tJ) * 1024;
#pragma unroll
            for (int q = 0; q < 4; ++q) *(f32x4*)(od + (q * 64 + lane) * 4) = (f32x4){ao[4 * q], ao[4 * q + 1], ao[4 * q + 2], ao[4 * q + 3]};
        }
    }
}

__device__ __forceinline__ void gdn_passB(unsigned char* mxb, unsigned char* mxt, unsigned char* mxs, int nB) {
    int tid_ = threadIdx.x; asm volatile("" : "+v"(tid_)); const int tid = tid_, lane = tid & 63, wave = __builtin_amdgcn_readfirstlane(tid >> 6);
    const float* GL = (const float*)(mxs + MXS_GD_GL);
    if (wave >= 2) return;
    const int eJ = wave;
    for (int chain = blockIdx.x; chain < 64; chain += nB) {
        f32x16 S[2];
#pragma unroll
        for (int i = 0; i < 16; ++i) { S[0][i] = 0.f; S[1][i] = 0.f; }
        bf16x8 xn[2][2][2]; f32x4 nq[2][4]; float gln;
#define GDB_LOAD(c_) do { const size_t u_ = (size_t)chain * 64 + (c_); const bf16_t* xd_ = (const bf16_t*)(mxt + MXT_GD_XD) + u_ * 4096; const float* nd_ = (const float*)(mxb + MXB_GD_ND) + u_ * 4096; \
        _Pragma("unroll") for (int I = 0; I < 2; ++I) _Pragma("unroll") for (int J = 0; J < 2; ++J) _Pragma("unroll") for (int s2 = 0; s2 < 2; ++s2) xn[I][J][s2] = *(const bf16x8*)(xd_ + (size_t)(I * 2 + J) * 1024 + (s2 * 64 + lane) * 8); \
        _Pragma("unroll") for (int J = 0; J < 2; ++J) _Pragma("unroll") for (int q = 0; q < 4; ++q) nq[J][q] = *(const f32x4*)(nd_ + (size_t)(J * 2 + eJ) * 1024 + (q * 64 + lane) * 4); \
        gln = GL[u_]; } while (0)
        GDB_LOAD(0);
        for (int c = 0; c < 64; ++c) { const size_t uid = (size_t)chain * 64 + c;
            bf16x8 xf[2][2][2]; f32x16 nn[2]; const float gl = gln;
#pragma unroll
            for (int I = 0; I < 2; ++I)
#pragma unroll
                for (int J = 0; J < 2; ++J)
#pragma unroll
                    for (int s2 = 0; s2 < 2; ++s2) xf[I][J][s2] = xn[I][J][s2];
#pragma unroll
            for (int J = 0; J < 2; ++J)
#pragma unroll
                for (int q = 0; q < 4; ++q) { nn[J][4 * q] = nq[J][q][0]; nn[J][4 * q + 1] = nq[J][q][1]; nn[J][4 * q + 2] = nq[J][q][2]; nn[J][4 * q + 3] = nq[J][q][3]; }
            if (c + 1 < 64) GDB_LOAD(c + 1);
            bf16x8 sh[2][2], sl[2][2];
            bf16_t* sd = (bf16_t*)(mxt + MXT_GD_SD) + uid * 4096;
#pragma unroll
            for (int I = 0; I < 2; ++I)
#pragma unroll
                for (int s2 = 0; s2 < 2; ++s2) { float hi[8], lo[8];
#pragma unroll
                    for (int j = 0; j < 8; ++j) { const float v = S[I][8 * s2 + j]; hi[j] = bf2f((unsigned short)f2bf(v)); lo[j] = v - hi[j]; }
                    sh[I][s2] = pack8(hi[0], hi[1], hi[2], hi[3], hi[4], hi[5], hi[6], hi[7]); sl[I][s2] = pack8(lo[0], lo[1], lo[2], lo[3], lo[4], lo[5], lo[6], lo[7]);
                    *(bf16x8*)(sd + (size_t)(I * 2 + eJ) * 1024 + (s2 * 64 + lane) * 8) = sh[I][s2]; }
#pragma unroll
            for (int J = 0; J < 2; ++J) { f32x16 acc = nn[J];
#pragma unroll
                for (int I = 0; I < 2; ++I)
#pragma unroll
                    for (int s2 = 0; s2 < 2; ++s2) { acc = __builtin_amdgcn_mfma_f32_32x32x16_bf16(xf[I][J][s2], sh[I][s2], acc, 0, 0, 0); acc = __builtin_amdgcn_mfma_f32_32x32x16_bf16(xf[I][J][s2], sl[I][s2], acc, 0, 0, 0); }
                nn[J] = acc; }
#pragma unroll
            for (int J = 0; J < 2; ++J)
#pragma unroll
                for (int i = 0; i < 16; ++i) S[J][i] = gl * S[J][i] + nn[J][i];
        }
    }
}

__device__ __forceinline__ void gdn_passC(ArgsP a, int l, LAS unsigned char* lds, const bf16_t* proj, bf16_t* H, unsigned char* mxb, unsigned char* mxt, int G) {
    int tid_ = threadIdx.x; asm volatile("" : "+v"(tid_)); const int tid = tid_, lane = tid & 63, wave = __builtin_amdgcn_readfirstlane(tid >> 6), r = lane & 31, hh = lane >> 5;
    LAS bf16_t* ob = (LAS bf16_t*)(lds + wave * 8192);
    const float* gn = a->in[I_GNG] + l * 64;
    for (int wu = blockIdx.x * NWAVES + wave; wu < 8192; wu += G * NWAVES) {
        const int uid = wu >> 1, tJ = wu & 1; const int c = uid & 63, hd = (uid >> 6) & 7, b = uid >> 9; const size_t tok0 = (size_t)b * SEQ_ + (size_t)c * 64;
        const bf16_t* sd = (const bf16_t*)(mxt + MXT_GD_SD) + (size_t)uid * 4096; const bf16_t* qd = (const bf16_t*)(mxt + MXT_GD_QD) + (size_t)uid * 4096; const float* od = (const float*)(mxb + MXB_GD_OD) + (size_t)uid * 4096;
        f32x16 ao[2];
#pragma unroll
        for (int eI = 0; eI < 2; ++eI)
#pragma unroll
            for (int q = 0; q < 4; ++q) { const f32x4 v = *(const f32x4*)(od + (size_t)(eI * 2 + tJ) * 1024 + (q * 64 + lane) * 4); ao[eI][4 * q] = v[0]; ao[eI][4 * q + 1] = v[1]; ao[eI][4 * q + 2] = v[2]; ao[eI][4 * q + 3] = v[3]; }
#pragma unroll
        for (int dI = 0; dI < 2; ++dI)
#pragma unroll
            for (int s2 = 0; s2 < 2; ++s2) { const bf16x8 qf = *(const bf16x8*)(qd + (size_t)(dI * 2 + tJ) * 1024 + (s2 * 64 + lane) * 8);
#pragma unroll
                for (int eI = 0; eI < 2; ++eI) { const bf16x8 sf = *(const bf16x8*)(sd + (size_t)(dI * 2 + eI) * 1024 + (s2 * 64 + lane) * 8);
                    ao[eI] = __builtin_amdgcn_mfma_f32_32x32x16_bf16(sf, qf, ao[eI], 0, 0, 0); } }
        float sq = 0.f;
#pragma unroll
        for (int eI = 0; eI < 2; ++eI)
#pragma unroll
            for (int i = 0; i < 16; ++i) sq += ao[eI][i] * ao[eI][i];
        sq += __shfl_xor(sq, 32);
        const float rinv = rsqrtf(sq * (1.0f / 64.0f) + RMS_EPS);
        const size_t tok = tok0 + 32 * tJ + r;
#pragma unroll
        for (int eI = 0; eI < 2; ++eI)
#pragma unroll
            for (int q = 0; q < 4; ++q) { const int e0 = 32 * eI + 8 * q + 4 * hh; const f32x4 g4 = *(const f32x4*)(gn + e0); const u32x2 zw = *(const u32x2*)(proj + tok * NPROJ + PC_GDZ + hd * 64 + e0);
                u32x2 pw; pw.x = pg8::cvt_pk_bf16(ao[eI][4 * q] * rinv * g4[0] * silu_f(bflo(zw.x)), ao[eI][4 * q + 1] * rinv * g4[1] * silu_f(bfhi(zw.x)));
                pw.y = pg8::cvt_pk_bf16(ao[eI][4 * q + 2] * rinv * g4[2] * silu_f(bflo(zw.y)), ao[eI][4 * q + 3] * rinv * g4[3] * silu_f(bfhi(zw.y)));
                *(LAS u32x2*)(ob + r * 64 + e0) = pw; }
        LDS_WAIT(); asm volatile("" ::: "memory");
#pragma unroll
        for (int it = 0; it < 4; ++it) { const int row = it * 8 + (lane >> 3), c8 = (lane & 7) * 8;
            *(u32x4*)(H + (tok0 + 32 * tJ + row) * 2048 + 1536 + hd * 64 + c8) = *(const LAS u32x4*)(ob + row * 64 + c8); }
        LDS_WAIT(); asm volatile("" ::: "memory");
    }
}
constexpr int PPL = 12;
constexpr int NPH = 1 + PPL * DEPTH_;
#ifndef MK_N_LAUNCHES
#define MK_N_LAUNCHES 1
#endif
#ifndef PROBE_PH
#define PROBE_PH -2
#endif
#define REPS(k) ((PROBE_PH) == (k) ? 2 : 1)
#ifndef PG8_SP2
#define PG8_SP2 true
#endif
#ifndef PG8_ALIGN
#define PG8_ALIGN true
#endif
__global__ void __launch_bounds__(NWAVES * 64, 2) fwd(Args a_unused) {
    ArgsP kargs = (ArgsP)__builtin_amdgcn_kernarg_segment_ptr();
#define FRESH(a) ArgsP a = kargs; asm volatile("" : "+s"(a))
    extern __shared__ __attribute__((aligned(16))) unsigned char lds_raw[];
    LAS unsigned char* lds = (LAS unsigned char*)lds_raw;
    const int tid = threadIdx.x, G = gridDim.x;
    const int vcu = (G % 8 == 0) ? ((int)blockIdx.x % 8) * (G / 8) + (int)blockIdx.x / 8 : (int)blockIdx.x;
    for (int u = tid; u < (LDS_BYTES - MISC_OFF) / 4; u += NWAVES * 64) ((LAS unsigned*)(lds + MISC_OFF))[u] = 0u;
    __syncthreads();
    const int lo = kargs->ph_lo, hi = kargs->ph_hi;
    unsigned* barw = (unsigned*)(kargs->ws + WS_CTL) + CW_BAR + kargs->li * XCD_BAR_WORDS;
    XcdBarrier bar; bar.bar = barw; bar.x = 0; bar.st = nullptr;
    if (hi - lo > 1) bar = xcd_barrier_post(barw, (volatile LAS unsigned*)(lds + LDS_BYTES - 16));
#define IN(k) (lo <= (k) && (k) < hi)
#define SEAM(k) do { if (IN(k) && IN((k) + 1)) xcd_barrier(bar); } while (0)
    if (IN(0)) for (int rep = 0; rep < REPS(-1); ++rep) { FRESH(a); p0_convert(a, lds, G); }
    SEAM(0);

    for (int l = 0; l < DEPTH_; ++l) {
        const int pb = 1 + PPL * l;
#define WSP(T_, off) ((T_*)(a->ws + (off)))
#define WL_(off) (a->ws + WS_W + (size_t)l * WL_STRIDE + (off))
        if (IN(pb + 0)) for (int rep = 0; rep < REPS(0); ++rep) { FRESH(a);
            pg8::Gemm g{WSP(const bf16_t, WS_XB), (const bf16_t*)WL_(WL_IN), 1024, 1024, 1024}; pg8::StaticOrder S; S.init(T_, NINP, G, (int)blockIdx.x);
            pg8::EpiProj E{WSP(bf16_t, WS_OV + OV_PROJ), WSP(float, WS_GSM)};
            pg8::gemm_phase<pg8::EpiProj, pg8::StaticOrder, PG8_ALIGN, PG8_SP2>(lds, g, S, E);
        }
        SEAM(pb + 0);

        if (IN(pb + 1)) for (int rep = 0; rep < REPS(1); ++rep) { FRESH(a);
            const bf16_t* proj = WSP(const bf16_t, WS_OV + OV_PROJ); bf16_t* Hb = WSP(bf16_t, WS_OV + OV_H); const float* gsm = WSP(const float, WS_GSM);
            for (int r2 = 0; r2 < REPS(11); ++r2) for (int u = (int)blockIdx.x; u < 256; u += G) lru_fast<0>(a, l, u >> 5, (u >> 2) & 7, (u & 3) * 16, (u & 3) * 16 + 16, lds, proj, Hb, a->ws + WS_MXS);
            for (int r2 = 0; r2 < REPS(12); ++r2) mlstm_passA(a, l, lds, proj, gsm, a->ws + WS_V, a->ws + WS_MXS, G);
            __syncthreads();
            for (int r2 = 0; r2 < REPS(13); ++r2) gdn_passA1(a, l, lds, proj, gsm, a->ws + WS_V, G);
        }
        SEAM(pb + 1);
        if (IN(pb + 2)) for (int rep = 0; rep < REPS(2); ++rep) { FRESH(a);
            const bf16_t* proj = WSP(const bf16_t, WS_OV + OV_PROJ); const float* gsm = WSP(const float, WS_GSM);
            for (int r2 = 0; r2 < REPS(21); ++r2) lru_carry(a->ws + WS_MXS, G); for (int r2 = 0; r2 < REPS(22); ++r2) mlstm_passB(a->ws + WS_V, a->ws + WS_MXS, G); for (int r2 = 0; r2 < REPS(23); ++r2) gdn_passA2(a, l, lds, proj, gsm, a->ws + WS_V, a->ws + WS_MXS, a->ws + WS_MXS, G); }
        SEAM(pb + 2);
        if (IN(pb + 3)) for (int rep = 0; rep < REPS(3); ++rep) { FRESH(a);
            const bf16_t* proj = WSP(const bf16_t, WS_OV + OV_PROJ); bf16_t* Hb = WSP(bf16_t, WS_OV + OV_H); const float* gsm = WSP(const float, WS_GSM);
            const int nB = G >= 128 ? 64 : 0;
            if ((int)blockIdx.x < nB) { for (int r2 = 0; r2 < REPS(31); ++r2) gdn_passB(a->ws + WS_V, a->ws + WS_MXS, a->ws + WS_MXS, nB); }
            else {
                if (nB == 0) { gdn_passB(a->ws + WS_V, a->ws + WS_MXS, a->ws + WS_MXS, G); __syncthreads(); }
                for (int r2 = 0; r2 < REPS(32); ++r2) for (int u = (int)blockIdx.x - nB; u < 256; u += G - nB) lru_fast<1>(a, l, u >> 5, (u >> 2) & 7, (u & 3) * 16, (u & 3) * 16 + 16, lds, proj, Hb, a->ws + WS_MXS);
                for (int r2 = 0; r2 < REPS(33); ++r2) mlstm_passC(a, l, lds, proj, gsm, Hb, a->ws + WS_V, a->ws + WS_MXS, (int)blockIdx.x - nB, G - nB);
            }
        }
        SEAM(pb + 3);
        if (IN(pb + 4)) for (int rep = 0; rep < REPS(4); ++rep) { FRESH(a); gdn_passC(a, l, lds, WSP(const bf16_t, WS_OV + OV_PROJ), WSP(bf16_t, WS_OV + OV_H), a->ws + WS_V, a->ws + WS_MXS, G); }
        SEAM(pb + 4);

        if (IN(pb + 5)) for (int rep = 0; rep < REPS(5); ++rep) { FRESH(a);
            const bf16_t* proj = WSP(const bf16_t, WS_OV + OV_PROJ); const bf16_t* Hb = WSP(const bf16_t, WS_OV + OV_H); float* mf = WSP(float, WS_OV + OV_MF); bf16_t* mb = WSP(bf16_t, WS_MB);
            const bf16_t* wbr = (const bf16_t*)WL_(WL_BR);
            pg8::StaticOrder S; S.init(T_, 1024, G, (int)blockIdx.x);
            { pg8::Gemm g{Hb, wbr, 2048, 2048, 1024}; pg8::EpiMerge<0> E{proj, mf, mb};
              pg8::gemm_phase<pg8::EpiMerge<0>, pg8::StaticOrder, PG8_ALIGN, PG8_SP2>(lds, g, S, E); }
            { pg8::Gemm g{Hb + 1024, wbr + 1024, 2048, 2048, 512}; pg8::EpiMerge<1> E{proj, mf, mb};
              pg8::gemm_phase<pg8::EpiMerge<1>, pg8::StaticOrder, PG8_ALIGN, PG8_SP2>(lds, g, S, E); }
            { pg8::Gemm g{Hb + 1536, wbr + 1536, 2048, 2048, 512}; pg8::EpiMerge<2> E{proj, mf, mb};
              pg8::gemm_phase<pg8::EpiMerge<2>, pg8::StaticOrder, PG8_ALIGN, PG8_SP2>(lds, g, S, E); }
        }
        SEAM(pb + 5);

        if (IN(pb + 6)) for (int rep = 0; rep < REPS(6); ++rep) { FRESH(a);
            const float* xin = l == 0 ? a->in[I_X] : WSP(const float, WS_X2);
            pg8::Gemm g{WSP(const bf16_t, WS_MB), (const bf16_t*)WL_(WL_OUT), 1024, 1024, 1024}; pg8::StaticOrder S; S.init(T_, 1024, G, (int)blockIdx.x);
            pg8::EpiWout E{xin, WSP(float, WS_V)};
            pg8::gemm_phase<pg8::EpiWout, pg8::StaticOrder, PG8_ALIGN, PG8_SP2>(lds, g, S, E);
        }
        SEAM(pb + 6);

        if (IN(pb + 7)) for (int rep = 0; rep < REPS(7); ++rep) { FRESH(a); p5_ln1_router(a, l, lds, G); }
        SEAM(pb + 7);

        if (IN(pb + 8)) for (int rep = 0; rep < REPS(8); ++rep) { FRESH(a); p6_slots(a, lds, G); }
        SEAM(pb + 8);

        if (IN(pb + 9)) for (int rep = 0; rep < REPS(9); ++rep) { FRESH(a);
            const int nb = moe_table(a, lds);
            pg8::MoeOrder S{8, G, vcu, nb * 8, (const LAS int*)(lds + MISC_OFF + 256)};
            pg8::Gemm g{WSP(const bf16_t, WS_OV + OV_XS), (const bf16_t*)WL_(WL_W1), 1024, 1024, 1024};
            pg8::EpiMoe1 E{WSP(bf16_t, WS_OV + OV_ACT), a->in[I_B1] + (size_t)l * NE * 2048};
            pg8::gemm_phase<pg8::EpiMoe1, pg8::MoeOrder, PG8_ALIGN, PG8_SP2>(lds, g, S, E);
        }
        SEAM(pb + 9);

        if (IN(pb + 10)) for (int rep = 0; rep < REPS(10); ++rep) { FRESH(a);
            const int nb = moe_table(a, lds);
            pg8::MoeOrder S{4, G, vcu, nb * 4, (const LAS int*)(lds + MISC_OFF + 256)};
            pg8::Gemm g{WSP(const bf16_t, WS_OV + OV_ACT), (const bf16_t*)WL_(WL_W2), 1024, 1024, 1024};
            pg8::EpiMoe2 E{WSP(bf16_t, WS_OV + OV_YS), a->in[I_B2] + (size_t)l * NE * 1024, WSP(const float, WS_WBUF)};
            pg8::gemm_phase<pg8::EpiMoe2, pg8::MoeOrder, PG8_ALIGN, PG8_SP2>(lds, g, S, E);
        }
        SEAM(pb + 10);

        if (IN(pb + 11)) for (int rep = 0; rep < REPS(11); ++rep) { FRESH(a); p9_combine_ln2(a, l, (l == DEPTH_ - 1) ? a->out : WSP(float, WS_X2), G); }
        SEAM(pb + 11);
    }
#undef WSP
#undef WL_
#undef IN
#undef SEAM
}

extern "C" void kernel_launch(void* const* d_in, const int* in_sizes, int n_in, void* d_out, int out_size, void* d_ws, size_t ws_size, hipStream_t stream) {
    static int grid = 0;
    if (grid == 0) {
        if (n_in != 30 || in_sizes[0] != T_ * D_ || out_size != T_ * D_ || ws_size < WS_END) {
            fprintf(stderr, "kernel_launch: unexpected shapes: n_in %d in0 %d out %d ws %zu (need %zu); nothing launched\n", n_in, n_in > 0 ? in_sizes[0] : -1, out_size, ws_size, (size_t)WS_END); grid = -1; return; }
        int dev = 0, cus = 0;
        if (hipGetDevice(&dev) != hipSuccess || hipDeviceGetAttribute(&cus, hipDeviceAttributeMultiprocessorCount, dev) != hipSuccess) { grid = -1; return; }
        if (hipFuncSetAttribute((const void*)fwd, hipFuncAttributeMaxDynamicSharedMemorySize, LDS_BYTES) != hipSuccess) { fprintf(stderr, "kernel_launch: hipFuncSetAttribute failed\n"); grid = -1; return; }
        int per_cu = 0; (void)hipOccupancyMaxActiveBlocksPerMultiprocessor(&per_cu, (const void*)fwd, NWAVES * 64, LDS_BYTES); (void)hipGetLastError();
        if (per_cu < 1) fprintf(stderr, "kernel_launch: occupancy query reports %d blocks per CU\n", per_cu);
        grid = cus;
    }
    if (grid < 0) return;
    (void)hipMemsetAsync((char*)d_ws + WS_CTL, 0, CTL_ZERO_BYTES, stream);
    Args a{};
    for (int i = 0; i < 30; ++i) a.in[i] = (const float*)d_in[i];
    a.out = (float*)d_out; a.ws = (unsigned char*)d_ws;
    constexpr int NL = MK_N_LAUNCHES; static_assert(NL == NPH || NL <= 4, "barrier regions");
    for (int li = 0; li < NL; ++li) {
        a.ph_lo = (int)((long)NPH * li / NL); a.ph_hi = (int)((long)NPH * (li + 1) / NL); a.li = (NL <= 4) ? li : 0;
        hipLaunchKernelGGL(fwd, dim3(grid), dim3(NWAVES * 64), LDS_BYTES, stream, a);
        const hipError_t le = hipPeekAtLastError();
        if (le != hipSuccess) { fprintf(stderr, "kernel_launch: launch %d failed: %s\n", li, hipGetErrorName(le)); break; }
    }
}
```

```cpp
#include <hip/hip_runtime.h>
#include <cstdio>
#include <cstdint>

#define LAS __attribute__((address_space(3)))
#define GAS __attribute__((address_space(1)))
typedef unsigned short bf16_t;
typedef short bf16x8 __attribute__((ext_vector_type(8)));
typedef float f32x4 __attribute__((ext_vector_type(4)));
typedef float f32x2 __attribute__((ext_vector_type(2)));
typedef unsigned u32x4 __attribute__((ext_vector_type(4)));
typedef unsigned u32x2 __attribute__((ext_vector_type(2)));

constexpr int T_ = 32768, D_ = 1024, SEQ_ = 4096, NBATCH = 8, DEPTH_ = 2;
constexpr int DIN = 8728, NPROJ = 5632, NINP = 8960;
constexpr int NE = 32, DFF = 1024;
constexpr int PMAX = 139264;
constexpr int NCHUNK = 256, CHTOK = 128;
constexpr float DN_ALPHA = 1.41421356237309515f;
constexpr float LN_EPS = 1e-5f, RMS_EPS = 1e-6f;
constexpr int PC_LRUX = 0, PC_LRUY = 1024, PC_MLQ = 2048, PC_MLK = 2304, PC_MLV = 2560, PC_MLO = 3072, PC_GDQ = 3584, PC_GDK = 4096, PC_GDV = 4608, PC_GDZ = 5120, PC_GATE = 5632;

constexpr size_t MiB = 1u << 20;
constexpr size_t WS_CTL = 0, CTL_ZERO_BYTES = 64 * 1024;
constexpr size_t WS_HIST = 256 * 1024;
constexpr size_t WS_META = 320 * 1024;
constexpr size_t WS_RWB = 384 * 1024;
constexpr size_t WS_W = 1 * MiB;
constexpr size_t WL_IN = 0, WL_BR = 18 * MiB, WL_OUT = 22 * MiB, WL_W1 = 24 * MiB, WL_W2 = 152 * MiB, WL_G = 216 * MiB, WL_STRIDE = 217 * MiB;
constexpr size_t WS_XB = 436 * MiB;
constexpr size_t WS_GSM = 501 * MiB;
constexpr size_t WS_MB = 505 * MiB;
constexpr size_t WS_V = 569 * MiB;
constexpr size_t WS_X1 = 697 * MiB;
constexpr size_t WS_X1B = 825 * MiB;
constexpr size_t WS_X2 = 890 * MiB;
constexpr size_t WS_TKE = 1018 * MiB;
constexpr size_t WS_TKW = WS_TKE + 512 * 1024;
constexpr size_t WS_SLOT = 1019 * MiB;
constexpr size_t WS_WBUF = 1020 * MiB;
constexpr size_t WS_OV = 1024 * MiB;
constexpr size_t OV_PROJ = 0, OV_GD = 352 * MiB, OV_H = 544 * MiB;
constexpr size_t OV_XS = 0, OV_ACT = 272 * MiB, OV_YS = 544 * MiB;
constexpr size_t WS_MXS = WS_OV + 816 * MiB;
constexpr size_t WS_END = WS_MXS + 104 * MiB;

constexpr int CW_BAR = 1024;

constexpr int RING_BYTES = 131072;
constexpr int MISC_OFF = RING_BYTES;
constexpr int LDS_BYTES = 147456;
constexpr int NWAVES = 8;

#define LDS_WAIT() asm volatile("s_waitcnt lgkmcnt(0)" ::: "memory")
#define VM_WAIT() asm volatile("s_waitcnt vmcnt(0)" ::: "memory")

__device__ __forceinline__ unsigned f2bf(float f) { unsigned u = __builtin_bit_cast(unsigned, f); return (u + 0x7fffu + ((u >> 16) & 1u)) >> 16; }
__device__ __forceinline__ unsigned pk2(float lo, float hi) { return f2bf(lo) | (f2bf(hi) << 16); }
__device__ __forceinline__ float bf2f(unsigned short b) { return __builtin_bit_cast(float, (unsigned)b << 16); }
__device__ __forceinline__ float bflo(unsigned w) { return __builtin_bit_cast(float, w << 16); }
__device__ __forceinline__ float bfhi(unsigned w) { return __builtin_bit_cast(float, w & 0xffff0000u); }
__device__ __forceinline__ float wave_sum(float v) {
#pragma unroll
    for (int o = 1; o < 64; o <<= 1) v += __shfl_xor(v, o);
    return v;
}
__device__ __forceinline__ float wave_max(float v) {
#pragma unroll
    for (int o = 1; o < 64; o <<= 1) v = fmaxf(v, __shfl_xor(v, o));
    return v;
}
__device__ __forceinline__ float sigmoid_f(float x) { return __builtin_amdgcn_rcpf(1.f + __expf(-x)); }
__device__ __forceinline__ float silu_f(float x) { return x * __builtin_amdgcn_rcpf(1.f + __expf(-x)); }
__device__ __forceinline__ float neg_expm1_f(float t) {
    const float p = -t * (1.f + t * 0.5f * (1.f + t * (1.f / 3.f) * (1.f + t * 0.25f * (1.f + t * 0.2f * (1.f + t * (1.f / 6.f) * (1.f + t * (1.f / 7.f)))))));
    return t > -0.3f ? p : 1.f - __expf(t);
}
__device__ __forceinline__ float log1p_f(float e) { return e < 0.01f ? e * (1.f - e * (0.5f - e * ((1.f / 3.f) - 0.25f * e))) : __logf(1.f + e); }
__device__ __forceinline__ float softplus_f(float x) { return fmaxf(x, 0.f) + log1p_f(__expf(-fabsf(x))); }
__device__ __forceinline__ float gelu_tanh_f(float x) { const float u = 0.7978845608028654f * (x + 0.044715f * x * x * x); return x * __builtin_amdgcn_rcpf(1.f + __expf(-2.f * u)); }
namespace pg8 {
#define PG8_LAS __attribute__((address_space(3)))
constexpr int BM = 256, BK = 64, HALF = 128, HTB = HALF * BK * 2  , STAGE_BYTES = 8 * HTB, NXCD = 8, WGM = 8;

__host__ __device__ __forceinline__ int lds_byte(int r, int c) { const int st = (r >> 4) * 2 + (c >> 5), rr = r & 15, cc = c & 31, ob = rr * 64 + cc * 2; return st * 1024 + (ob ^ (((ob >> 9) & 1) << 5)); }
__host__ __device__ __forceinline__ void stage_rc(int b, int& R, int& C) { const int st = b / 1024, sb = b % 1024, swz = sb ^ (((sb >> 9) & 1) << 5); R = (st >> 1) * 16 + swz / 64; C = (st & 1) * 32 + (swz % 64) / 2; }
__host__ __device__ __forceinline__ int perm32(int rho) { const int n = rho >> 4, i = rho & 15; return 8 * (i >> 2) + 4 * n + (i & 3); }

struct Unit { int pm, pn; };
struct Gemm { const bf16_t* A; const bf16_t* Bt; int lda, ldb, K; };

struct StaticOrder {
    int nM, nN, nwg, G, c;
    __host__ __device__ void init(int M, int N, int G_, int c_) { nM = M / BM; nN = N / BM; nwg = nM * nN; G = G_; c = c_; }
    __host__ __device__ bool next(int i, Unit& u) const {
        const long L = (long)i * G + c; if (L >= nwg) return false;
        int wgid = (int)L; { const int q = nwg / NXCD, r = nwg % NXCD, xcd = wgid % NXCD, off = wgid / NXCD; wgid = (xcd < r ? xcd * (q + 1) : r * (q + 1) + (xcd - r) * q) + off; }
        const int nig = WGM * nN, gid = wgid / nig, fm = gid * WGM, gsz = (nM - fm) < WGM ? (nM - fm) : WGM;
        u.pm = fm + ((wgid % nig) % gsz); u.pn = (wgid % nig) / gsz; return true;
    }
    __device__ __forceinline__ void a_ready(const Unit&) const {}
    __device__ __forceinline__ void done(const Unit&) const {}
};

__device__ __forceinline__ unsigned cvt_pk_bf16(float lo, float hi) { unsigned r; asm volatile("v_cvt_pk_bf16_f32 %0, %1, %2" : "=v"(r) : "v"(lo), "v"(hi)); return r; }

template <class Epi, class Sched, bool ALIGN_EPI = false, bool SP2 = false>
__device__ __forceinline__ void gemm_phase(PG8_LAS unsigned char* lds, const Gemm g, const Sched& S, const Epi& E) {
    int tid_ = threadIdx.x; asm volatile("" : "+v"(tid_));
    const int tid = tid_, wid = __builtin_amdgcn_readfirstlane(tid >> 6), lane = tid & 63, wr = wid >> 2, wc = wid & 3, fr = lane & 15, fq = lane >> 4;
    const int K = g.K, nt = K / BK;
    unsigned voffA[2], voffB[2];
#pragma unroll
    for (int i = 0; i < 2; ++i) { int R, C; stage_rc(tid * 16 + i * 8192, R, C); const int Rb = Epi::PERM ? ((R & ~31) + perm32(R & 31)) : R;
        voffA[i] = (unsigned)(R * g.lda + C) * 2u; voffB[i] = (unsigned)(Rb * g.ldb + C) * 2u; }
    const size_t kstep = (size_t)(BK * 2);
    const size_t hstepA = (size_t)HALF * g.lda * 2, hstepB = (size_t)HALF * g.ldb * 2;
    const size_t tstepA = 2 * hstepA, tstepB = 2 * hstepB;
    const unsigned ldsw = (unsigned)wid * 1024u;
    const int aoff = lds_byte(wr * 64 + fr, fq * 8), boff = lds_byte(wc * 32 + fr, fq * 8);
#define PG8_SA(b, h) (((b) * 2 + (h)) * HTB)
#define PG8_SB(b, h) ((4 + (b) * 2 + (h)) * HTB)
#define PG8_STAGE(bufoff, gbase, voff) do { _Pragma("unroll") for (int _i = 0; _i < 2; ++_i) \
        __builtin_amdgcn_global_load_lds((const unsigned*)((const char*)(gbase) + (voff)[_i]), (PG8_LAS unsigned*)(lds + (bufoff) + ldsw + _i * 8192), 16, 0, 0); } while (0)
#define PG8_LDA(dst, b, h) do { _Pragma("unroll") for (int m = 0; m < 4; ++m) _Pragma("unroll") for (int k = 0; k < 2; ++k) dst[m][k] = *(const PG8_LAS bf16x8*)(lds + PG8_SA(b, h) + aoff + m * 2048 + k * 1024); } while (0)
#define PG8_LDB(dst, b, h) do { _Pragma("unroll") for (int n = 0; n < 2; ++n) _Pragma("unroll") for (int k = 0; k < 2; ++k) dst[n][k] = *(const PG8_LAS bf16x8*)(lds + PG8_SB(b, h) + boff + n * 2048 + k * 1024); } while (0)
#define PG8_MMA(ai, bj, At, Bt) do { __builtin_amdgcn_s_setprio(1); _Pragma("unroll") for (int m = 0; m < 4; ++m) _Pragma("unroll") for (int n = 0; n < 2; ++n) _Pragma("unroll") for (int k = 0; k < 2; ++k) \
        acc[ai][bj][m][n] = __builtin_amdgcn_mfma_f32_16x16x32_bf16(Bt[n][k], At[m][k], acc[ai][bj][m][n], 0, 0, 0); __builtin_amdgcn_s_setprio(0); } while (0)
#define PG8_WAIT_V(n) asm volatile("s_waitcnt vmcnt(" #n ")" ::: "memory")
#define PG8_WAIT_L(n) asm volatile("s_waitcnt lgkmcnt(" #n ")" ::: "memory")
#define PG8_BAR __builtin_amdgcn_s_barrier()
#define PG8_SCHED __builtin_amdgcn_sched_barrier(0)
    Unit cur, nxt; int ui = 0;
    if (!S.next(0, cur)) return;
    f32x4 acc[2][2][4][2];
#pragma unroll
    for (int a = 0; a < 2; ++a)
#pragma unroll
        for (int b = 0; b < 2; ++b)
#pragma unroll
            for (int m = 0; m < 4; ++m)
#pragma unroll
                for (int n = 0; n < 2; ++n) acc[a][b][m][n] = (f32x4){0.f, 0.f, 0.f, 0.f};
    bf16x8 At[4][2], B0[2][2], B1[2][2];
    const char* cA = (const char*)g.A + (size_t)cur.pm * tstepA; const char* cB = (const char*)g.Bt + (size_t)cur.pn * tstepB;
    S.a_ready(cur);
    if constexpr (SP2) {
        PG8_STAGE(PG8_SB(0, 0), cB, voffB); PG8_STAGE(PG8_SB(0, 1), cB + hstepB, voffB); PG8_STAGE(PG8_SA(0, 0), cA, voffA); PG8_STAGE(PG8_SA(0, 1), cA + hstepA, voffA);
        if (wr == 1) PG8_BAR;
        PG8_WAIT_V(2); PG8_BAR;
        PG8_STAGE(PG8_SB(1, 0), cB + kstep, voffB); PG8_STAGE(PG8_SA(1, 0), cA + kstep, voffA); PG8_STAGE(PG8_SB(1, 1), cB + hstepB + kstep, voffB);
        PG8_WAIT_V(6); PG8_BAR;
    } else {
        PG8_STAGE(PG8_SB(0, 0), cB, voffB); PG8_STAGE(PG8_SA(0, 0), cA, voffA); PG8_STAGE(PG8_SB(0, 1), cB + hstepB, voffB); PG8_STAGE(PG8_SA(0, 1), cA + hstepA, voffA);
        if (wr == 1) PG8_BAR;
        PG8_WAIT_V(4); PG8_BAR;
        PG8_STAGE(PG8_SB(1, 0), cB + kstep, voffB); PG8_STAGE(PG8_SA(1, 0), cA + kstep, voffA); PG8_STAGE(PG8_SB(1, 1), cB + hstepB + kstep, voffB);
        PG8_WAIT_V(6); PG8_BAR;
    }
    for (;;) {
        const bool has_next = S.next(ui + 1, nxt);
        const char* nA = has_next ? (const char*)g.A + (size_t)nxt.pm * tstepA : cA; const char* nB = has_next ? (const char*)g.Bt + (size_t)nxt.pn * tstepB : cB;
        int t = 0;
        for (int seg = 0; seg < (Epi::HAS_MID ? 3 : 1); ++seg) {
        const int tend = Epi::HAS_MID ? (seg == 0 ? Epi::MID0 : (seg == 1 ? Epi::MID1 : nt)) : nt;
        for (; t < tend; t += 2) {
            const bool last = (t == nt - 2);
            const char* a1 = cA + (size_t)(t + 1) * kstep;
            const char* a2 = last ? nA : cA + (size_t)(t + 2) * kstep; const char* b2 = last ? nB : cB + (size_t)(t + 2) * kstep;
            const char* a3 = a2 + kstep; const char* b3 = b2 + kstep;
            if (last && has_next) S.a_ready(nxt);
            if constexpr (SP2) {
            PG8_LDB(B0, 0, 0); PG8_LDB(B1, 0, 1); PG8_SCHED; PG8_LDA(At, 0, 0); PG8_STAGE(PG8_SA(1, 1), a1 + hstepA, voffA);
            PG8_WAIT_V(8); PG8_WAIT_L(0); PG8_BAR; PG8_MMA(0, 0, At, B0); PG8_MMA(0, 1, At, B1); PG8_BAR; PG8_SCHED;
            PG8_LDA(At, 0, 1); PG8_STAGE(PG8_SB(0, 0), b2, voffB); PG8_STAGE(PG8_SB(0, 1), b2 + hstepB, voffB); PG8_STAGE(PG8_SA(0, 0), a2, voffA);
            PG8_WAIT_V(8); PG8_WAIT_L(0); PG8_BAR; PG8_MMA(1, 0, At, B0); PG8_MMA(1, 1, At, B1); PG8_BAR; PG8_SCHED;
            PG8_LDB(B0, 1, 0); PG8_LDB(B1, 1, 1); PG8_SCHED; PG8_LDA(At, 1, 0); PG8_STAGE(PG8_SA(0, 1), a2 + hstepA, voffA);
            PG8_WAIT_V(8); PG8_WAIT_L(0); PG8_BAR; PG8_MMA(0, 0, At, B0); PG8_MMA(0, 1, At, B1); PG8_BAR; PG8_SCHED;
            PG8_LDA(At, 1, 1); PG8_STAGE(PG8_SB(1, 0), b3, voffB); PG8_STAGE(PG8_SB(1, 1), b3 + hstepB, voffB); PG8_STAGE(PG8_SA(1, 0), a3, voffA);
            PG8_WAIT_V(8); PG8_WAIT_L(0); PG8_BAR; PG8_MMA(1, 0, At, B0); PG8_MMA(1, 1, At, B1); PG8_BAR; PG8_SCHED;
            } else {
            PG8_LDB(B0, 0, 0); PG8_SCHED; PG8_LDA(At, 0, 0); PG8_STAGE(PG8_SA(1, 1), a1 + hstepA, voffA);
            PG8_WAIT_L(8); PG8_BAR; PG8_WAIT_L(0); PG8_MMA(0, 0, At, B0); PG8_BAR; PG8_SCHED;
            PG8_LDB(B1, 0, 1); PG8_STAGE(PG8_SB(0, 0), b2, voffB);
            PG8_BAR; PG8_WAIT_L(0); PG8_MMA(0, 1, At, B1); PG8_BAR;
            PG8_LDA(At, 0, 1); PG8_STAGE(PG8_SA(0, 0), a2, voffA);
            PG8_BAR; PG8_WAIT_L(0); PG8_MMA(1, 0, At, B0); PG8_BAR; PG8_SCHED;
            PG8_STAGE(PG8_SB(0, 1), b2 + hstepB, voffB);
            PG8_WAIT_V(6); PG8_BAR; PG8_MMA(1, 1, At, B1); PG8_BAR;
            PG8_LDB(B0, 1, 0); PG8_SCHED; PG8_LDA(At, 1, 0); PG8_STAGE(PG8_SA(0, 1), a2 + hstepA, voffA);
            PG8_WAIT_L(8); PG8_BAR; PG8_WAIT_L(0); PG8_MMA(0, 0, At, B0); PG8_BAR; PG8_SCHED;
            PG8_LDB(B1, 1, 1); PG8_STAGE(PG8_SB(1, 0), b3, voffB);
            PG8_BAR; PG8_WAIT_L(0); PG8_MMA(0, 1, At, B1); PG8_BAR;
            PG8_LDA(At, 1, 1); PG8_STAGE(PG8_SA(1, 0), a3, voffA);
            PG8_BAR; PG8_WAIT_L(0); PG8_MMA(1, 0, At, B0); PG8_BAR; PG8_SCHED;
            PG8_STAGE(PG8_SB(1, 1), b3 + hstepB, voffB);
            PG8_WAIT_V(6); PG8_BAR; PG8_MMA(1, 1, At, B1); PG8_BAR;
            }
        }
        if constexpr (Epi::HAS_MID) { if (seg < 2) E.mid(acc, cur, wr, wc, fr, fq, seg); }
        }
        if constexpr (ALIGN_EPI) { if (wr == 0) PG8_BAR; }
        E(acc, cur, wr, wc, fr, fq); S.done(cur);
        if (!has_next) break;
#pragma unroll
        for (int a = 0; a < 2; ++a)
#pragma unroll
            for (int b = 0; b < 2; ++b)
#pragma unroll
                for (int m = 0; m < 4; ++m)
#pragma unroll
                    for (int n = 0; n < 2; ++n) acc[a][b][m][n] = (f32x4){0.f, 0.f, 0.f, 0.f};
        cur = nxt; cA = nA; cB = nB; ++ui;
        if constexpr (ALIGN_EPI) { if (wr == 1) PG8_BAR; }
    }
    PG8_WAIT_V(0);
    if constexpr (!ALIGN_EPI) { if (wr == 0) PG8_BAR; }
    PG8_BAR;
#undef PG8_SA
#undef PG8_SB
#undef PG8_STAGE
#undef PG8_LDA
#undef PG8_LDB
#undef PG8_MMA
#undef PG8_WAIT_V
#undef PG8_WAIT_L
#undef PG8_BAR
#undef PG8_SCHED
}
}
#define XB_TMO      128
#define XB_XCNT(j)  (256  + 64 * (j))
#define XB_XSUB(j)  (1280 + 64 * (j))
#define XB_XGEN(j)  (2304 + 64 * (j))
#define XB_TOP      3328
#define XB_TOPGEN   3392
#define XCD_BAR_WORDS 3456
#define XB_SPIN_CAP (1u << 18)

__device__ __forceinline__ unsigned xb_ld(unsigned* p)              { return __hip_atomic_load(p, __ATOMIC_RELAXED, __HIP_MEMORY_SCOPE_AGENT); }
__device__ __forceinline__ unsigned xb_add(unsigned* p, unsigned v) { return __hip_atomic_fetch_add(p, v, __ATOMIC_RELAXED, __HIP_MEMORY_SCOPE_AGENT); }
__device__ __forceinline__ unsigned xb_xcc_id() { return (unsigned)__builtin_amdgcn_s_getreg((3 << 11) | 20) & 0xFu; }
#define XB_SPIN(cond, bar) do { unsigned _sp = 0; while (cond) { __builtin_amdgcn_s_sleep(1); \
    if ((++_sp & 255u) == 0u) { if (xb_ld(&(bar)[XB_TMO])) break; if (_sp > XB_SPIN_CAP) { atomicAdd(&(bar)[XB_TMO], 1u); break; } } } } while (0)

struct XcdBarrier {
    unsigned* bar; unsigned x;
    volatile LAS unsigned* st;
};

__device__ __forceinline__ XcdBarrier xcd_barrier_post(unsigned* bar, volatile LAS unsigned* st) {
    XcdBarrier b; b.bar = bar; b.x = xb_xcc_id(); b.st = st;
    if (threadIdx.x == 0) (void)xb_add(&bar[XB_XCNT(b.x)], 1u);
    return b;
}
__device__ __forceinline__ void xcd_barrier_complete(unsigned* bar, unsigned x, unsigned& nloc, unsigned& nx) {
    const unsigned G = gridDim.x * gridDim.y * gridDim.z;
    unsigned sum, cnt, mine, sp = 0u;
    for (;;) {
        sum = 0u; cnt = 0u; mine = 0u;
#pragma unroll
        for (unsigned j = 0; j < 16; ++j) { const unsigned c = xb_ld(&bar[XB_XCNT(j)]); sum += c; cnt += (c > 0u) ? 1u : 0u; mine = (j == x) ? c : mine; }
        if (sum == G) break;
        __builtin_amdgcn_s_sleep(1);
        if ((++sp & 255u) == 0u) { if (xb_ld(&bar[XB_TMO])) break; if (sp > XB_SPIN_CAP) { atomicAdd(&bar[XB_TMO], 1u); break; } }
    }
    nloc = mine > 0u ? mine : 1u; nx = cnt > 0u ? cnt : 1u;
}

__device__ __forceinline__ void xcd_barrier(const XcdBarrier& b) {
    asm volatile("s_waitcnt vmcnt(0)" ::: "memory");
    __syncthreads();
    if (threadIdx.x == 0) {
        unsigned* bar = b.bar;
        __builtin_amdgcn_s_waitcnt(0);
        unsigned nloc = b.st[0], nx = b.st[1];
        if (nloc == 0u) { xcd_barrier_complete(bar, b.x, nloc, nx); b.st[0] = nloc; b.st[1] = nx; }
        const unsigned old = xb_add(&bar[XB_XSUB(b.x)], 1u);
        const unsigned gen = old / nloc;
        if (old + 1u == (gen + 1u) * nloc) {
            __builtin_amdgcn_fence(__ATOMIC_RELEASE, "agent");
            asm volatile("s_waitcnt vmcnt(0)" ::: "memory");
            const unsigned og = xb_add(&bar[XB_TOP], 1u);
            const unsigned tg = og / nx;
            if (og + 1u == (tg + 1u) * nx) xb_add(&bar[XB_TOPGEN], 1u);
            else XB_SPIN(xb_ld(&bar[XB_TOPGEN]) == tg, bar);
            __builtin_amdgcn_fence(__ATOMIC_ACQUIRE, "agent");
            xb_add(&bar[XB_XGEN(b.x)], 1u);
            asm volatile("s_waitcnt vmcnt(0)" ::: "memory");
        } else {
            XB_SPIN(xb_ld(&bar[XB_XGEN(b.x)]) == gen, bar);
            __builtin_amdgcn_fence(__ATOMIC_ACQUIRE, "agent");
            asm volatile("s_waitcnt vmcnt(0)" ::: "memory");
        }
    }
    __syncthreads();
}
namespace pg8 {
struct EpiProj {
    __device__ __forceinline__ void mid(f32x4 (&)[2][2][4][2], const Unit&, int, int, int, int, int) const {}
    static constexpr bool PERM = true, HAS_MID = false; static constexpr int MID0 = 0, MID1 = 0;
    bf16_t* proj; float* gsm; bf16_t* gd;
    __device__ __forceinline__ void operator()(const f32x4 (&acc)[2][2][4][2], const Unit& u, int wr, int wc, int fr, int fq) const {
        const int row0 = u.pm * BM + wr * 64 + fr;
        if (u.pn >= 22 && u.pn < 34) {
            const int gt = u.pn - 22; bf16_t* base = gd + ((size_t)((gt >> 2) * 128 + u.pm) * 4 + (gt & 3)) * 65536 + (size_t)((wr * 4 + wc) * 64 + fq * 16 + fr) * 8;
#pragma unroll
            for (int ai = 0; ai < 2; ++ai)
#pragma unroll
                for (int m = 0; m < 4; ++m)
#pragma unroll
                    for (int bj = 0; bj < 2; ++bj) { const f32x4 v0 = acc[ai][bj][m][0], v1 = acc[ai][bj][m][1];
                        u32x4 w; w.x = cvt_pk_bf16(v0[0], v0[1]); w.y = cvt_pk_bf16(v0[2], v0[3]); w.z = cvt_pk_bf16(v1[0], v1[1]); w.w = cvt_pk_bf16(v1[2], v1[3]);
                        *(u32x4*)(base + (size_t)((ai * 4 + m) * 2 + bj) * 4096) = w; }
        } else if (u.pn < 22) {
            const int col0 = u.pn * BM + wc * 32 + 8 * fq;
#pragma unroll
            for (int ai = 0; ai < 2; ++ai)
#pragma unroll
                for (int m = 0; m < 4; ++m) { bf16_t* rowp = proj + (size_t)(row0 + ai * HALF + m * 16) * NPROJ + col0;
#pragma unroll
                    for (int bj = 0; bj < 2; ++bj) { const f32x4 v0 = acc[ai][bj][m][0], v1 = acc[ai][bj][m][1];
                        u32x4 w; w.x = cvt_pk_bf16(v0[0], v0[1]); w.y = cvt_pk_bf16(v0[2], v0[3]); w.z = cvt_pk_bf16(v1[0], v1[1]); w.w = cvt_pk_bf16(v1[2], v1[3]);
                        *(u32x4*)(rowp + bj * HALF) = w; } }
        } else if (wc == 0 && fq < 3) {
#pragma unroll
            for (int ai = 0; ai < 2; ++ai)
#pragma unroll
                for (int m = 0; m < 4; ++m) { float* rowp = gsm + (size_t)(row0 + ai * HALF + m * 16) * 32 + 8 * fq;
                    *(f32x4*)(rowp) = acc[ai][0][m][0]; *(f32x4*)(rowp + 4) = acc[ai][0][m][1]; }
        }
    }
};
struct EpiMergeF {
    static constexpr bool PERM = true, HAS_MID = true; static constexpr int MID0 = 16, MID1 = 24;
    const bf16_t* gd; bf16_t* mb;
    static __device__ __forceinline__ float em(float x) { return __expf(fminf(-x, 40.0f)); }
    __device__ __forceinline__ void mid(f32x4 (&acc)[2][2][4][2], const Unit& u, int wr, int wc, int fr, int fq, int st) const {
        int toff = ((wr * 4 + wc) * 64 + fq * 16 + fr) * 8; asm volatile("" : "+v"(toff));
        const bf16_t* ga_ = gd + ((size_t)(st * 128 + u.pm) * 4 + u.pn) * 65536 + toff; const bf16_t* gb_ = ga_ + (size_t)128 * 4 * 65536;
#pragma unroll
        for (int ai = 0; ai < 2; ++ai)
#pragma unroll
            for (int m = 0; m < 4; ++m) {
#pragma unroll
                for (int bj = 0; bj < 2; ++bj) { const int o = ((ai * 4 + m) * 2 + bj) * 4096; const u32x4 ga = *(const u32x4*)(ga_ + o), gb = *(const u32x4*)(gb_ + o);
                    const unsigned xa[4] = {ga.x, ga.y, ga.z, ga.w}, xb[4] = {gb.x, gb.y, gb.z, gb.w};
#pragma unroll
                    for (int q = 0; q < 4; ++q) { const float r0 = (1.f + em(bflo(xb[q]))) * __builtin_amdgcn_rcpf(1.f + em(bflo(xa[q]))), r1 = (1.f + em(bfhi(xb[q]))) * __builtin_amdgcn_rcpf(1.f + em(bfhi(xa[q])));
                        acc[ai][bj][m][q >> 1][(q & 1) * 2] *= r0; acc[ai][bj][m][q >> 1][(q & 1) * 2 + 1] *= r1; } }
                asm volatile("" ::: "memory"); }
    }
    __device__ __forceinline__ void operator()(const f32x4 (&acc)[2][2][4][2], const Unit& u, int wr, int wc, int fr, int fq) const {
        const int row0 = u.pm * BM + wr * 64 + fr, col0 = u.pn * BM + wc * 32 + 8 * fq;
        const bf16_t* g2 = gd + ((size_t)(2 * 128 + u.pm) * 4 + u.pn) * 65536 + (size_t)((wr * 4 + wc) * 64 + fq * 16 + fr) * 8;
#pragma unroll
        for (int ai = 0; ai < 2; ++ai)
#pragma unroll
            for (int m = 0; m < 4; ++m) { const size_t row = (size_t)(row0 + ai * HALF + m * 16);
#pragma unroll
                for (int bj = 0; bj < 2; ++bj) { const int col = col0 + bj * HALF;
                    const u32x4 gw = *(const u32x4*)(g2 + ((ai * 4 + m) * 2 + bj) * 4096);
                    f32x4 g0, g1;
                    g0[0] = sigmoid_f(bflo(gw.x)); g0[1] = sigmoid_f(bfhi(gw.x)); g0[2] = sigmoid_f(bflo(gw.y)); g0[3] = sigmoid_f(bfhi(gw.y));
                    g1[0] = sigmoid_f(bflo(gw.z)); g1[1] = sigmoid_f(bfhi(gw.z)); g1[2] = sigmoid_f(bflo(gw.w)); g1[3] = sigmoid_f(bfhi(gw.w));
                    const f32x4 v0 = acc[ai][bj][m][0] * g0, v1 = acc[ai][bj][m][1] * g1;
                    u32x4 w; w.x = cvt_pk_bf16(v0[0], v0[1]); w.y = cvt_pk_bf16(v0[2], v0[3]); w.z = cvt_pk_bf16(v1[0], v1[1]); w.w = cvt_pk_bf16(v1[2], v1[3]);
                    *(u32x4*)(mb + row * 1024 + col) = w; }
                asm volatile("" ::: "memory"); }
    }
};
struct EpiWout {
    static constexpr bool PERM = true, HAS_MID = false; static constexpr int MID0 = 0, MID1 = 0;
    __device__ __forceinline__ void mid(f32x4 (&)[2][2][4][2], const Unit&, int, int, int, int, int) const {}
    const float* xf; const bf16_t* xh; bf16_t* v;
    __device__ __forceinline__ void operator()(const f32x4 (&acc)[2][2][4][2], const Unit& u, int wr, int wc, int fr, int fq) const {
        const int row0 = u.pm * BM + wr * 64 + fr, col0 = u.pn * BM + wc * 32 + 8 * fq;
#pragma unroll
        for (int ai = 0; ai < 2; ++ai)
#pragma unroll
            for (int m = 0; m < 4; ++m) { const size_t off = (size_t)(row0 + ai * HALF + m * 16) * 1024 + col0;
#pragma unroll
                for (int bj = 0; bj < 2; ++bj) { f32x4 x0, x1;
                    if (xf) { x0 = *(const f32x4*)(xf + off + bj * HALF); x1 = *(const f32x4*)(xf + off + bj * HALF + 4); }
                    else { const u32x4 w = *(const u32x4*)(xh + off + bj * HALF); x0 = (f32x4){bflo(w.x), bfhi(w.x), bflo(w.y), bfhi(w.y)}; x1 = (f32x4){bflo(w.z), bfhi(w.z), bflo(w.w), bfhi(w.w)}; }
                    const f32x4 v0 = x0 * DN_ALPHA + acc[ai][bj][m][0], v1 = x1 * DN_ALPHA + acc[ai][bj][m][1];
                    u32x4 w; w.x = cvt_pk_bf16(v0[0], v0[1]); w.y = cvt_pk_bf16(v0[2], v0[3]); w.z = cvt_pk_bf16(v1[0], v1[1]); w.w = cvt_pk_bf16(v1[2], v1[3]);
                    *(u32x4*)(v + off + bj * HALF) = w; }
                asm volatile("" ::: "memory"); }
    }
};
struct EpiMoe1 {
    __device__ __forceinline__ void mid(f32x4 (&)[2][2][4][2], const Unit&, int, int, int, int, int) const {}
    static constexpr bool PERM = true, HAS_MID = false; static constexpr int MID0 = 0, MID1 = 0;
    bf16_t* act; const float* b1;
    __device__ __forceinline__ void operator()(const f32x4 (&acc)[2][2][4][2], const Unit& u, int wr, int wc, int fr, int fq) const {
        const int e = u.pn >> 3, tl = u.pn & 7;
        const int row0 = u.pm * BM + wr * 64 + fr, col0 = tl * 128 + wc * 32 + 8 * fq;
        const float* bp = b1 + (size_t)e * 2048 + col0;
        const f32x4 bg0 = *(const f32x4*)(bp), bg1 = *(const f32x4*)(bp + 4), bl0 = *(const f32x4*)(bp + 1024), bl1 = *(const f32x4*)(bp + 1028);
#pragma unroll
        for (int ai = 0; ai < 2; ++ai)
#pragma unroll
            for (int m = 0; m < 4; ++m) { bf16_t* rowp = act + (size_t)(row0 + ai * HALF + m * 16) * 1024 + col0;
                f32x4 o[2];
#pragma unroll
                for (int n = 0; n < 2; ++n) { const f32x4 gg = acc[ai][0][m][n] + (n ? bg1 : bg0), ll = acc[ai][1][m][n] + (n ? bl1 : bl0);
#pragma unroll
                    for (int q = 0; q < 4; ++q) { const float gv = fminf(gg[q], 7.0f), lv = fminf(fmaxf(ll[q], -7.0f), 7.0f);
                        o[n][q] = gv * sigmoid_f(1.702f * gv) * (lv + 1.0f); } }
                u32x4 w; w.x = cvt_pk_bf16(o[0][0], o[0][1]); w.y = cvt_pk_bf16(o[0][2], o[0][3]); w.z = cvt_pk_bf16(o[1][0], o[1][1]); w.w = cvt_pk_bf16(o[1][2], o[1][3]);
                *(u32x4*)(rowp) = w; }
    }
};
struct EpiMoe2 {
    __device__ __forceinline__ void mid(f32x4 (&)[2][2][4][2], const Unit&, int, int, int, int, int) const {}
    static constexpr bool PERM = true, HAS_MID = false; static constexpr int MID0 = 0, MID1 = 0;
    bf16_t* ys; const float* b2; const float* wbuf;
    __device__ __forceinline__ void operator()(const f32x4 (&acc)[2][2][4][2], const Unit& u, int wr, int wc, int fr, int fq) const {
        const int e = u.pn >> 2, tl = u.pn & 3;
        const int row0 = u.pm * BM + wr * 64 + fr, col0 = tl * 256 + wc * 32 + 8 * fq;
        const float* bp = b2 + (size_t)e * 1024 + col0;
        f32x4 bv[2][2];
#pragma unroll
        for (int bj = 0; bj < 2; ++bj) { bv[bj][0] = *(const f32x4*)(bp + bj * HALF); bv[bj][1] = *(const f32x4*)(bp + bj * HALF + 4); }
#pragma unroll
        for (int ai = 0; ai < 2; ++ai)
#pragma unroll
            for (int m = 0; m < 4; ++m) { const int row = row0 + ai * HALF + m * 16; const float ww = wbuf[row]; bf16_t* rowp = ys + (size_t)row * 1024 + col0;
#pragma unroll
                for (int bj = 0; bj < 2; ++bj) { const f32x4 v0 = (acc[ai][bj][m][0] + bv[bj][0]) * ww, v1 = (acc[ai][bj][m][1] + bv[bj][1]) * ww;
                    u32x4 w; w.x = cvt_pk_bf16(v0[0], v0[1]); w.y = cvt_pk_bf16(v0[2], v0[3]); w.z = cvt_pk_bf16(v1[0], v1[1]); w.w = cvt_pk_bf16(v1[2], v1[3]);
                    *(u32x4*)(rowp + bj * HALF) = w; } }
    }
};
struct MoeOrder {
    int nN, G, c, total; const LAS int* blk_e;
    __device__ __forceinline__ bool next(int i, Unit& u) const {
        const long L = (long)i * G + c; if (L >= total) return false;
        const int rb = (int)(L / nN), tl = (int)(L % nN); u.pm = rb; u.pn = blk_e[rb] * nN + tl; return true;
    }
    __device__ __forceinline__ void a_ready(const Unit&) const {}
    __device__ __forceinline__ void done(const Unit&) const {}
};
}
struct Args { const float* in[30]; float* out; unsigned char* ws; int ph_lo, ph_hi, li, pad; };
typedef const __attribute__((address_space(4))) Args* ArgsP;
enum { I_X = 0, I_WIN, I_LCW, I_LCB, I_LWA, I_LBA, I_LWX, I_LBX, I_LLAM, I_MIB, I_MFB, I_MNG, I_GCW, I_GAL, I_GDT, I_GNG, I_WBA, I_WBB, I_WBC, I_WOUT, I_LN1G, I_LN1B, I_RW, I_RB, I_W1, I_B1, I_W2, I_B2, I_LN2G, I_LN2B };

template <int MODE> __device__ __forceinline__ int col_map(int n) {
    if (MODE == 1) {
        if (n < 3072) return n;
        if (n < 3076) return 8704 + (n - 3072);
        if (n < 3080) return 8708 + (n - 3076);
        if (n < 5128) return n - 8;
        if (n < 5136) return 8712 + (n - 5128);
        if (n < 5144) return 8720 + (n - 5136);
        return n - 24;
    } else if (MODE == 2) {
        if (n < 1024) return (n >> 7) * 256 + (n & 127);
        const int q = n - 1024; return (q >> 7) * 256 + 128 + (q & 127);
    }
    return n;
}
template <int MODE> __device__ __forceinline__ void transpose_item(const float* W, int N, bf16_t* WT, int ldk, int koff, LAS float* scr, int kb, int nb, int lane) {
    const int k0 = 64 * kb, n0 = 32 * nb; const int nsrc = n0 + (lane & 31);
#pragma unroll 8
    for (int i = 0; i < 32; ++i) { const int kk = 2 * i + (lane >> 5); scr[kk * 33 + (lane & 31)] = (nsrc < N) ? W[(size_t)(k0 + kk) * N + nsrc] : 0.f; }
    LDS_WAIT(); asm volatile("" ::: "memory");
    const int c = lane & 7;
#pragma unroll
    for (int j = 0; j < 4; ++j) { const int nl = (lane >> 3) + 8 * j, n = n0 + nl; const LAS float* s = scr + (8 * c) * 33 + nl;
        u32x4 o; o.x = pk2(s[0 * 33], s[1 * 33]); o.y = pk2(s[2 * 33], s[3 * 33]); o.z = pk2(s[4 * 33], s[5 * 33]); o.w = pk2(s[6 * 33], s[7 * 33]);
        if (n < N) *(u32x4*)(WT + (size_t)col_map<MODE>(n) * ldk + koff + k0 + 8 * c) = o; }
    LDS_WAIT(); asm volatile("" ::: "memory");
}
constexpr int IT_IN = 16 * 273, IT_BRA = 16 * 32, IT_BRB = 8 * 32, IT_BRC = 8 * 32, IT_OUT = 16 * 32, IT_W1 = 32 * 16 * 64, IT_W2 = 32 * 16 * 32;
constexpr int IT_G = 8 * 2 * 8;
constexpr int IT_LAYER = IT_IN + IT_BRA + IT_BRB + IT_BRC + IT_OUT + IT_W1 + IT_W2 + IT_G;
__device__ __forceinline__ void p0_convert(ArgsP a, LAS unsigned char* lds, int G) {
    int tid_ = threadIdx.x; asm volatile("" : "+v"(tid_)); const int tid = tid_, lane = tid & 63, wave = tid >> 6;
    LAS float* scr = (LAS float*)(lds + wave * 16384);
    const int gw = blockIdx.x * NWAVES + wave, NGW = G * NWAVES;
    for (int it = gw; it < 2 * IT_LAYER; it += NGW) {
        const int l = it / IT_LAYER; int r = it - l * IT_LAYER;
        unsigned char* wl = a->ws + WS_W + (size_t)l * WL_STRIDE;
        if (r < IT_IN) { transpose_item<1>(a->in[I_WIN] + (size_t)l * 1024 * DIN, DIN, (bf16_t*)(wl + WL_IN), 1024, 0, scr, r / 273, r % 273, lane); continue; } r -= IT_IN;
        if (r < IT_BRA) { transpose_item<0>(a->in[I_WBA] + (size_t)l * 1024 * 1024, 1024, (bf16_t*)(wl + WL_BR), 2048, 0, scr, r / 32, r % 32, lane); continue; } r -= IT_BRA;
        if (r < IT_BRB) { transpose_item<0>(a->in[I_WBB] + (size_t)l * 512 * 1024, 1024, (bf16_t*)(wl + WL_BR), 2048, 1024, scr, r / 32, r % 32, lane); continue; } r -= IT_BRB;
        if (r < IT_BRC) { transpose_item<0>(a->in[I_WBC] + (size_t)l * 512 * 1024, 1024, (bf16_t*)(wl + WL_BR), 2048, 1536, scr, r / 32, r % 32, lane); continue; } r -= IT_BRC;
        if (r < IT_OUT) { transpose_item<0>(a->in[I_WOUT] + (size_t)l * 1024 * 1024, 1024, (bf16_t*)(wl + WL_OUT), 1024, 0, scr, r / 32, r % 32, lane); continue; } r -= IT_OUT;
        if (r < IT_W1) { const int e = r / 1024, q = r % 1024;
            transpose_item<2>(a->in[I_W1] + ((size_t)l * NE + e) * 1024 * 2048, 2048, (bf16_t*)(wl + WL_W1) + (size_t)e * 2048 * 1024, 1024, 0, scr, q / 64, q % 64, lane); continue; } r -= IT_W1;
        if (r < IT_W2) { const int e = r / 512, q = r % 512;
            transpose_item<0>(a->in[I_W2] + ((size_t)l * NE + e) * 1024 * 1024, 1024, (bf16_t*)(wl + WL_W2) + (size_t)e * 1024 * 1024, 1024, 0, scr, q / 32, q % 32, lane); continue; } r -= IT_W2;
        { const int h = r >> 4, gate = (r >> 3) & 1, q = r & 7;
            transpose_item<0>(a->in[gate ? I_LWX : I_LWA] + ((size_t)l * 8 + h) * 128 * 128, 128, (bf16_t*)(wl + WL_G) + (size_t)(h * 256 + gate * 128) * 128, 128, 0, scr, q >> 2, q & 3, lane); }
    }
    const size_t gt = (size_t)blockIdx.x * 512 + tid, GT = (size_t)G * 512;
    for (size_t i = gt; i < (size_t)2 * 232 * 128; i += GT) { const int l = (int)(i / (232 * 128)); const size_t q = i % (232 * 128);
        *(u32x4*)(a->ws + WS_W + (size_t)l * WL_STRIDE + WL_IN + ((size_t)8728 * 1024) * 2 + q * 16) = (u32x4){0u, 0u, 0u, 0u}; }
    for (size_t i = gt; i < (size_t)2 * 32 * 1024; i += GT) { const int l = (int)(i >> 15), k = (int)((i >> 5) & 1023), e = (int)(i & 31); const float w = a->in[I_RW][i];
        const unsigned hb = f2bf(w); const float lo = w - bf2f((unsigned short)hb); bf16_t* dst = (bf16_t*)(a->ws + WS_RWB) + (size_t)l * 2 * 32 * 1024;
        dst[(size_t)e * 1024 + k] = (bf16_t)hb; dst[(size_t)(32 + e) * 1024 + k] = (bf16_t)f2bf(lo); }
    const float* x = a->in[I_X]; bf16_t* xb = (bf16_t*)(a->ws + WS_XB);
    for (size_t i = gt; i < (size_t)T_ * D_ / 8; i += GT) { const f32x4 v0 = *(const f32x4*)(x + i * 8), v1 = *(const f32x4*)(x + i * 8 + 4);
        u32x4 w; w.x = pk2(v0[0], v0[1]); w.y = pk2(v0[2], v0[3]); w.z = pk2(v1[0], v1[1]); w.w = pk2(v1[2], v1[3]); *(u32x4*)(xb + i * 8) = w; }
}

constexpr int TB = 32;
__device__ __forceinline__ void lru_naive(ArgsP a, int l, int u, LAS unsigned char* lds, const bf16_t* proj, bf16_t* H) {
    int tid_ = threadIdx.x; asm volatile("" : "+v"(tid_)); const int tid = tid_, b = u >> 3, h = u & 7, c = tid >> 2, p = tid & 3, chg = h * 128 + c;
    const float* wa = a->in[I_LWA] + ((size_t)l * 8 + h) * 128 * 128; const float* wx = a->in[I_LWX] + ((size_t)l * 8 + h) * 128 * 128;
    float wra[32], wrx[32];
#pragma unroll
    for (int i = 0; i < 32; ++i) { wra[i] = wa[(p * 32 + i) * 128 + c]; wrx[i] = wx[(p * 32 + i) * 128 + c]; }
    const float ba = a->in[I_LBA][l * 1024 + chg], bx = a->in[I_LBX][l * 1024 + chg];
    const float sp = softplus_f(-a->in[I_LLAM][l * 1024 + chg]);
    const float* cw = a->in[I_LCW] + (size_t)l * 4 * 1024 + chg; const float cw0 = cw[0], cw1 = cw[1024], cw2 = cw[2048], cw3 = cw[3072], cb = a->in[I_LCB][l * 1024 + chg];
    LAS bf16_t* xs = (LAS bf16_t*)(lds);
    LAS bf16_t* ys = (LAS bf16_t*)(lds + 8192);
    LAS float* xa_s = (LAS float*)(lds + 16384);
    const int srow = tid >> 4, scol = (tid & 15) * 8;
    const size_t tok0 = (size_t)b * SEQ_;
    u32x4 px = *(const u32x4*)(proj + (tok0 + srow) * NPROJ + PC_LRUX + h * 128 + scol);
    u32x4 py = *(const u32x4*)(proj + (tok0 + srow) * NPROJ + PC_LRUY + h * 128 + scol);
    float hs = 0.f, x1 = 0.f, x2 = 0.f, x3 = 0.f;
    for (int blk = 0; blk < SEQ_ / TB; ++blk) {
        __syncthreads();
        *(LAS u32x4*)(xs + srow * 128 + scol) = px; *(LAS u32x4*)(ys + srow * 128 + scol) = py;
        __syncthreads();
        if (blk + 1 < SEQ_ / TB) { const size_t tk = tok0 + (size_t)(blk + 1) * TB + srow;
            px = *(const u32x4*)(proj + tk * NPROJ + PC_LRUX + h * 128 + scol); py = *(const u32x4*)(proj + tk * NPROJ + PC_LRUY + h * 128 + scol); }
        for (int s = 0; s < TB; ++s) {
            const float xraw = bf2f(xs[s * 128 + c]);
            const float xa = cw0 * x3 + cw1 * x2 + cw2 * x1 + cw3 * xraw + cb;
            x3 = x2; x2 = x1; x1 = xraw;
            LAS float* xb_ = xa_s + (s & 1) * 128;
            if (p == 0) xb_[c] = xa;
            __syncthreads();
            float sa = 0.f, sx = 0.f;
#pragma unroll
            for (int i4 = 0; i4 < 8; ++i4) { const f32x4 xv = *(const LAS f32x4*)(xb_ + p * 32 + i4 * 4);
#pragma unroll
                for (int q = 0; q < 4; ++q) { sa += xv[q] * wra[i4 * 4 + q]; sx += xv[q] * wrx[i4 * 4 + q]; } }
            sa += __shfl_xor(sa, 1); sa += __shfl_xor(sa, 2); sx += __shfl_xor(sx, 1); sx += __shfl_xor(sx, 2);
            const float r = 1.f / (1.f + __expf(-(sa + ba))), ig = 1.f / (1.f + __expf(-(sx + bx)));
            const float log_a = -8.0f * r * sp, av = __expf(log_a), mult = sqrtf(-expm1f(2.0f * log_a));
            hs = av * hs + mult * (ig * xa);
            if (p == 0) { const float y = bf2f(ys[s * 128 + c]);
                H[(tok0 + (size_t)blk * TB + s) * 2048 + chg] = (bf16_t)f2bf(hs * gelu_tanh_f(y)); }
        }
    }
}
__device__ __forceinline__ void mlstm_naive(ArgsP a, int l, int u, LAS unsigned char* lds, const bf16_t* proj, const float* gsm, bf16_t* H) {
    int tid_ = threadIdx.x; asm volatile("" : "+v"(tid_)); const int tid = tid_, lane = tid & 63, wave = tid >> 6, b = u >> 2, hd = u & 3, j = tid & 127;
    LAS float* qs = (LAS float*)(lds);
    LAS float* ks = (LAS float*)(lds + 8192);
    LAS float* vs = (LAS float*)(lds + 16384);
    LAS float* os = (LAS float*)(lds + 32768);
    LAS float* gi = (LAS float*)(lds + 49152);
    LAS float* gf = (LAS float*)(lds + 49152 + 128);
    LAS float* red = (LAS float*)(lds + 49152 + 256);
    const float ib = a->in[I_MIB][l * 4 + hd], fb = a->in[I_MFB][l * 4 + hd], gn = a->in[I_MNG][(size_t)l * 512 + hd * 128 + j];
    const size_t tok0 = (size_t)b * SEQ_;
    const int qa_row = (tid & 255) >> 3, qa_c8 = (tid & 7) * 8; const int qa_col = (tid < 256 ? PC_MLQ : PC_MLK) + hd * 64 + qa_c8;
    const int vb_row = tid >> 4, vb_c8 = (tid & 15) * 8;
    u32x4 pa, pb, pc; float pg = 0.f;
#define ML_ISSUE(blk_) do { const size_t t0 = tok0 + (size_t)(blk_) * TB; \
        pa = *(const u32x4*)(proj + (t0 + qa_row) * NPROJ + qa_col); \
        pb = *(const u32x4*)(proj + (t0 + vb_row) * NPROJ + PC_MLV + hd * 128 + vb_c8); \
        pc = *(const u32x4*)(proj + (t0 + vb_row) * NPROJ + PC_MLO + hd * 128 + vb_c8); \
        if (tid < 64) pg = gsm[(t0 + (tid & 31)) * 32 + (tid < 32 ? 0 : 4) + hd]; } while (0)
    ML_ISSUE(0);
    float C[64], n[64];
#pragma unroll
    for (int r = 0; r < 64; ++r) { C[r] = 0.f; n[r] = 0.f; }
    for (int blk = 0; blk < SEQ_ / TB; ++blk) {
        __syncthreads();
        { LAS float* d = (tid < 256 ? qs : ks) + qa_row * 64 + qa_c8;
          *(LAS f32x4*)(d) = (f32x4){bflo(pa.x), bfhi(pa.x), bflo(pa.y), bfhi(pa.y)}; *(LAS f32x4*)(d + 4) = (f32x4){bflo(pa.z), bfhi(pa.z), bflo(pa.w), bfhi(pa.w)};
          LAS float* dv = vs + vb_row * 128 + vb_c8;
          *(LAS f32x4*)(dv) = (f32x4){bflo(pb.x), bfhi(pb.x), bflo(pb.y), bfhi(pb.y)}; *(LAS f32x4*)(dv + 4) = (f32x4){bflo(pb.z), bfhi(pb.z), bflo(pb.w), bfhi(pb.w)};
          LAS float* dz = os + vb_row * 128 + vb_c8;
          *(LAS f32x4*)(dz) = (f32x4){bflo(pc.x), bfhi(pc.x), bflo(pc.y), bfhi(pc.y)}; *(LAS f32x4*)(dz + 4) = (f32x4){bflo(pc.z), bfhi(pc.z), bflo(pc.w), bfhi(pc.w)};
          if (tid < 32) gi[tid] = pg; else if (tid < 64) gf[tid - 32] = pg; }
        __syncthreads();
        if (blk + 1 < SEQ_ / TB) ML_ISSUE(blk + 1);
        for (int s = 0; s < TB; ++s) {
            float hj = 0.f;
            if (tid < 128) {
                const float f = 1.f / (1.f + __expf(-(gf[s] + fb))), ie = __expf(gi[s] + ib);
                const float vj = vs[s * 128 + j];
                float num = 0.f, den = 0.f;
#pragma unroll
                for (int r4 = 0; r4 < 16; ++r4) { const f32x4 kk = *(const LAS f32x4*)(ks + s * 64 + r4 * 4), qq = *(const LAS f32x4*)(qs + s * 64 + r4 * 4);
#pragma unroll
                    for (int q = 0; q < 4; ++q) { const int r = r4 * 4 + q; const float ik = ie * kk[q];
                        C[r] = f * C[r] + ik * vj; n[r] = f * n[r] + ik; num += qq[q] * C[r]; den += qq[q] * n[r]; } }
                num *= 0.125f; den *= 0.125f;
                hj = num / fmaxf(fabsf(den), 1.0f);
                const float ss = wave_sum(hj * hj);
                if (lane == 0) red[(s & 1) * 2 + wave] = ss;
            }
            __syncthreads();
            if (tid < 128) {
                const float tot = red[(s & 1) * 2] + red[(s & 1) * 2 + 1];
                const float o = hj * rsqrtf(tot * (1.0f / 128.0f) + RMS_EPS) * gn * sigmoid_f(os[s * 128 + j]);
                H[(tok0 + (size_t)blk * TB + s) * 2048 + 1024 + hd * 128 + j] = (bf16_t)f2bf(o);
            }
        }
    }
}
__device__ __forceinline__ void gdn_naive(ArgsP a, int l, int u, LAS unsigned char* lds, const bf16_t* proj, const float* gsm, bf16_t* H) {
    int tid_ = threadIdx.x; asm volatile("" : "+v"(tid_)); const int tid = tid_, lane = tid & 63, b = u >> 3, hd = u & 7;
    LAS float* rq = (LAS float*)(lds);
    LAS float* rk = (LAS float*)(lds + 9216);
    LAS float* rv = (LAS float*)(lds + 18432);
    LAS float* zs = (LAS float*)(lds + 27648);
    LAS float* ga = (LAS float*)(lds + 27648 + 8192);
    LAS float* gb = ga + TB;
    const float* cw = a->in[I_GCW] + (size_t)l * 4 * 1536;
    float cq[4], ck[4], cv[4];
#pragma unroll
    for (int i = 0; i < 4; ++i) { cq[i] = cw[i * 1536 + hd * 64 + lane]; ck[i] = cw[i * 1536 + 512 + hd * 64 + lane]; cv[i] = cw[i * 1536 + 1024 + hd * 64 + lane]; }
    const float nexpA = -__expf(a->in[I_GAL][l * 8 + hd]), dtb = a->in[I_GDT][l * 8 + hd], gn = a->in[I_GNG][l * 64 + lane];
    const size_t tok0 = (size_t)b * SEQ_;
    u32x4 pp[3]; float pg = 0.f;
#define GD_ISSUE(blk_) do { const int tl0 = (blk_) * TB; \
        _Pragma("unroll") for (int i = 0; i < 3; ++i) { const int pid = tid + 512 * i; pp[i] = (u32x4){0u, 0u, 0u, 0u}; \
            if (pid < 840) { const int arr = pid / 280, rem = pid % 280, row = rem >> 3, c8 = (rem & 7) * 8; const int tl = tl0 - 3 + row; \
                if (tl >= 0) pp[i] = *(const u32x4*)(proj + (tok0 + tl) * NPROJ + (arr == 0 ? PC_GDQ : (arr == 1 ? PC_GDK : PC_GDV)) + hd * 64 + c8); } \
            else if (pid < 1096) { const int zp = pid - 840, row = zp >> 3, c8 = (zp & 7) * 8; \
                pp[i] = *(const u32x4*)(proj + (tok0 + tl0 + row) * NPROJ + PC_GDZ + hd * 64 + c8); } } \
        if (tid < 64) pg = gsm[(tok0 + tl0 + (tid & 31)) * 32 + (tid < 32 ? 8 : 16) + hd]; } while (0)
    GD_ISSUE(0);
    float S[64];
#pragma unroll
    for (int i = 0; i < 64; ++i) S[i] = 0.f;
    for (int blk = 0; blk < SEQ_ / TB; ++blk) {
        __syncthreads();
#pragma unroll
        for (int i = 0; i < 3; ++i) { const int pid = tid + 512 * i; LAS float* d = nullptr;
            if (pid < 840) { const int arr = pid / 280, rem = pid % 280, row = rem >> 3, c8 = (rem & 7) * 8; d = (arr == 0 ? rq : (arr == 1 ? rk : rv)) + row * 64 + c8; }
            else if (pid < 1096) { const int zp = pid - 840, row = zp >> 3, c8 = (zp & 7) * 8; d = zs + row * 64 + c8; }
            if (pid < 1096) { const u32x4 w = pp[i];
                *(LAS f32x4*)(d) = (f32x4){bflo(w.x), bfhi(w.x), bflo(w.y), bfhi(w.y)}; *(LAS f32x4*)(d + 4) = (f32x4){bflo(w.z), bfhi(w.z), bflo(w.w), bfhi(w.w)}; } }
        if (tid < 32) ga[tid] = pg; else if (tid < 64) gb[tid - 32] = pg;
        __syncthreads();
        if (blk + 1 < SEQ_ / TB) GD_ISSUE(blk + 1);
        if (tid < 64) {
            for (int s = 0; s < TB; ++s) {
                float qv = 0.f, kv = 0.f, vv = 0.f;
#pragma unroll
                for (int i = 0; i < 4; ++i) { qv += cq[i] * rq[(s + i) * 64 + lane]; kv += ck[i] * rk[(s + i) * 64 + lane]; vv += cv[i] * rv[(s + i) * 64 + lane]; }
                qv = silu_f(qv); kv = silu_f(kv); vv = silu_f(vv);
                const float qn = qv * rsqrtf(wave_sum(qv * qv) + RMS_EPS) * 0.125f;
                const float kn = kv * rsqrtf(wave_sum(kv * kv) + RMS_EPS);
                const float g = nexpA * softplus_f(ga[s] + dtb), alpha = __expf(g), beta = 1.f / (1.f + __expf(-gb[s]));
                float kS = 0.f;
#pragma unroll
                for (int i = 0; i < 64; ++i) kS += __builtin_bit_cast(float, __builtin_amdgcn_readlane(__builtin_bit_cast(int, kn), i)) * S[i];
                const float dl = beta * (vv - alpha * kS);
                float o = 0.f;
#pragma unroll
                for (int i = 0; i < 64; ++i) { const float ki = __builtin_bit_cast(float, __builtin_amdgcn_readlane(__builtin_bit_cast(int, kn), i));
                    const float qi = __builtin_bit_cast(float, __builtin_amdgcn_readlane(__builtin_bit_cast(int, qn), i));
                    S[i] = alpha * S[i] + ki * dl; o += qi * S[i]; }
                const float ms = wave_sum(o * o) * (1.0f / 64.0f);
                const float out = o * rsqrtf(ms + RMS_EPS) * gn * silu_f(zs[s * 64 + lane]);
                H[(tok0 + (size_t)blk * TB + s) * 2048 + 1536 + hd * 64 + lane] = (bf16_t)f2bf(out);
            }
        }
    }
}

constexpr int RW_PITCH = 1032;
__device__ __forceinline__ unsigned f2key(float v, int e) { unsigned u = __builtin_bit_cast(unsigned, v); u = (u & 0x80000000u) ? ~u : (u | 0x80000000u); return (u & ~31u) | (unsigned)(31 - e); }
__device__ __forceinline__ float key2f(unsigned k) { const unsigned u = k & ~31u; return __builtin_bit_cast(float, (u & 0x80000000u) ? (u ^ 0x80000000u) : ~u); }
__device__ __forceinline__ void p5_ln1_router(ArgsP a, int l, LAS unsigned char* lds, int G) {
    int tid_ = threadIdx.x; asm volatile("" : "+v"(tid_)); const int tid = tid_, lane = tid & 63, wave = tid >> 6, tk = lane & 15, g = lane >> 4;
    LAS bf16_t* whi = (LAS bf16_t*)lds;
    LAS bf16_t* wlo = (LAS bf16_t*)(lds + 32 * RW_PITCH * 2);
    LAS int* hist = (LAS int*)(lds + 2 * 32 * RW_PITCH * 2);
    { const bf16_t* src = (const bf16_t*)(a->ws + WS_RWB) + (size_t)l * 2 * 32 * 1024;
      for (int p = tid; p < 2 * 32 * 128; p += 512) { const int arr = p >> 12, e = (p >> 7) & 31, c8 = (p & 127) * 8;
          *(LAS u32x4*)((arr ? wlo : whi) + e * RW_PITCH + c8) = *(const u32x4*)(src + ((size_t)arr * 32 + e) * 1024 + c8); } }
    const bf16_t* v = (const bf16_t*)(a->ws + WS_V); bf16_t* x1b = (bf16_t*)(a->ws + WS_X1B);
    int* tke = (int*)(a->ws + WS_TKE); float* tkw = (float*)(a->ws + WS_TKW); int* ghist = (int*)(a->ws + WS_HIST);
    const float* lng = a->in[I_LN1G] + l * 1024; const float* lnb = a->in[I_LN1B] + l * 1024;
    const float rb0 = a->in[I_RB][l * 32 + tk], rb1 = a->in[I_RB][l * 32 + 16 + tk];
    for (int ch = blockIdx.x; ch < NCHUNK; ch += G) {
        __syncthreads();
        if (tid < 32) hist[tid] = 0;
        __syncthreads();
        const size_t t = (size_t)ch * CHTOK + wave * 16 + tk;
        const bf16_t* vr = v + t * 1024 + 8 * g;
        float s = 0.f, s2 = 0.f;
#pragma unroll 8
        for (int ks = 0; ks < 32; ++ks) { const u32x4 pw = *(const u32x4*)(vr + 32 * ks); const f32x4 p0 = (f32x4){bflo(pw.x), bfhi(pw.x), bflo(pw.y), bfhi(pw.y)}, p1 = (f32x4){bflo(pw.z), bfhi(pw.z), bflo(pw.w), bfhi(pw.w)};
            s += (p0[0] + p0[1]) + (p0[2] + p0[3]) + (p1[0] + p1[1]) + (p1[2] + p1[3]);
            s2 += (p0[0] * p0[0] + p0[1] * p0[1]) + (p0[2] * p0[2] + p0[3] * p0[3]) + (p1[0] * p1[0] + p1[1] * p1[1]) + (p1[2] * p1[2] + p1[3] * p1[3]); }
        s += __shfl_xor(s, 16); s += __shfl_xor(s, 32); s2 += __shfl_xor(s2, 16); s2 += __shfl_xor(s2, 32);
        const float mean = s * (1.0f / 1024.0f); const float rstd = rsqrtf(fmaxf(s2 * (1.0f / 1024.0f) - mean * mean, 0.f) + LN_EPS);
        f32x4 acc0 = (f32x4){0.f, 0.f, 0.f, 0.f}, acc1 = (f32x4){0.f, 0.f, 0.f, 0.f};
#pragma unroll 2
        for (int ks = 0; ks < 32; ++ks) { const int k0 = 32 * ks + 8 * g;
            const u32x4 pw = *(const u32x4*)(vr + 32 * ks); const f32x4 p0 = (f32x4){bflo(pw.x), bfhi(pw.x), bflo(pw.y), bfhi(pw.y)}, p1 = (f32x4){bflo(pw.z), bfhi(pw.z), bflo(pw.w), bfhi(pw.w)};
            const f32x4 g0 = *(const f32x4*)(lng + k0), g1 = *(const f32x4*)(lng + k0 + 4), b0 = *(const f32x4*)(lnb + k0), b1 = *(const f32x4*)(lnb + k0 + 4);
            const f32x4 y0 = (p0 - mean) * rstd * g0 + b0, y1 = (p1 - mean) * rstd * g1 + b1;
            u32x4 hw; hw.x = pg8::cvt_pk_bf16(y0[0], y0[1]); hw.y = pg8::cvt_pk_bf16(y0[2], y0[3]); hw.z = pg8::cvt_pk_bf16(y1[0], y1[1]); hw.w = pg8::cvt_pk_bf16(y1[2], y1[3]);
            *(u32x4*)(x1b + t * 1024 + k0) = hw;
            u32x4 lw; lw.x = pg8::cvt_pk_bf16(y0[0] - bflo(hw.x), y0[1] - bfhi(hw.x)); lw.y = pg8::cvt_pk_bf16(y0[2] - bflo(hw.y), y0[3] - bfhi(hw.y));
            lw.z = pg8::cvt_pk_bf16(y1[0] - bflo(hw.z), y1[1] - bfhi(hw.z)); lw.w = pg8::cvt_pk_bf16(y1[2] - bflo(hw.w), y1[3] - bfhi(hw.w));
            const bf16x8 ah = __builtin_bit_cast(bf16x8, hw), al = __builtin_bit_cast(bf16x8, lw);
            const bf16x8 wh0 = *(const LAS bf16x8*)(whi + tk * RW_PITCH + k0), wh1 = *(const LAS bf16x8*)(whi + (16 + tk) * RW_PITCH + k0);
            const bf16x8 wl0 = *(const LAS bf16x8*)(wlo + tk * RW_PITCH + k0), wl1 = *(const LAS bf16x8*)(wlo + (16 + tk) * RW_PITCH + k0);
            acc0 = __builtin_amdgcn_mfma_f32_16x16x32_bf16(ah, wh0, acc0, 0, 0, 0); acc1 = __builtin_amdgcn_mfma_f32_16x16x32_bf16(ah, wh1, acc1, 0, 0, 0);
            acc0 = __builtin_amdgcn_mfma_f32_16x16x32_bf16(ah, wl0, acc0, 0, 0, 0); acc1 = __builtin_amdgcn_mfma_f32_16x16x32_bf16(ah, wl1, acc1, 0, 0, 0);
            acc0 = __builtin_amdgcn_mfma_f32_16x16x32_bf16(al, wh0, acc0, 0, 0, 0); acc1 = __builtin_amdgcn_mfma_f32_16x16x32_bf16(al, wh1, acc1, 0, 0, 0); }
#pragma unroll
        for (int r = 0; r < 4; ++r) {
            unsigned k0 = f2key(acc0[r] + rb0, tk), k1 = f2key(acc1[r] + rb1, 16 + tk);
            float tv[4]; int te[4];
#pragma unroll
            for (int k = 0; k < 4; ++k) { unsigned m = k0 > k1 ? k0 : k1;
#pragma unroll
                for (int o = 1; o < 16; o <<= 1) { const unsigned q = (unsigned)__shfl_xor((int)m, o); m = q > m ? q : m; }
                const int e = 31 - (int)(m & 31u); tv[k] = key2f(m); te[k] = e;
                if (e == tk) k0 = 0u; if (e == 16 + tk) k1 = 0u; }
            const float e1 = __expf(tv[1] - tv[0]), e2 = __expf(tv[2] - tv[0]), e3 = __expf(tv[3] - tv[0]); const float inv = 1.0f / (1.0f + e1 + e2 + e3);
            if (tk < 4) { const size_t tt = (size_t)ch * CHTOK + wave * 16 + 4 * g + r;
                const int ei = tk == 0 ? te[0] : (tk == 1 ? te[1] : (tk == 2 ? te[2] : te[3]));
                const float wi = (tk == 0 ? 1.0f : (tk == 1 ? e1 : (tk == 2 ? e2 : e3))) * inv;
                tke[tt * 4 + tk] = ei; tkw[tt * 4 + tk] = wi; __hip_atomic_fetch_add(&hist[ei], 1, __ATOMIC_RELAXED, __HIP_MEMORY_SCOPE_WORKGROUP); }
        }
        __syncthreads();
        if (tid < 32) ghist[ch * 32 + tid] = hist[tid];
    }
}

__device__ __forceinline__ void p6_slots(ArgsP a, LAS unsigned char* lds, int G) {
    int tid_ = threadIdx.x; asm volatile("" : "+v"(tid_)); const int tid = tid_, lane = tid & 63, wave = tid >> 6;
    LAS int* hs = (LAS int*)lds;
    LAS int* cnt = (LAS int*)(lds + 32768);
    LAS int* bst = (LAS int*)(lds + 32768 + 256);
    LAS int* te = (LAS int*)(lds + 36864);
    LAS int* sl = (LAS int*)(lds + 36864 + 2048);
    const int* ghist = (const int*)(a->ws + WS_HIST);
    for (int i = tid; i < NCHUNK * 32; i += 512) hs[i] = ghist[i];
    __syncthreads();
    if (tid < 32) { int run = 0; for (int ch = 0; ch < NCHUNK; ++ch) { const int c = hs[ch * 32 + tid]; hs[ch * 32 + tid] = run; run += c; } cnt[tid] = run; }
    __syncthreads();
    if (tid == 0) { int bs = 0; for (int e = 0; e < 32; ++e) { bst[e] = bs; bs += (cnt[e] + 255) >> 8; } bst[32] = bs; }
    __syncthreads();
    if (blockIdx.x == 0 && tid <= 32) ((int*)(a->ws + WS_META))[tid] = bst[tid];
    const int* tke = (const int*)(a->ws + WS_TKE); const float* tkw = (const float*)(a->ws + WS_TKW);
    int* slot = (int*)(a->ws + WS_SLOT); float* wbuf = (float*)(a->ws + WS_WBUF);
    const bf16_t* x1b = (const bf16_t*)(a->ws + WS_X1B); bf16_t* xs = (bf16_t*)(a->ws + WS_OV + OV_XS);
    for (int ch = blockIdx.x; ch < NCHUNK; ch += G) {
        __syncthreads();
        te[tid] = tke[(size_t)ch * 512 + tid];
        __syncthreads();
        if (tid < 32) { int rank = bst[tid] * 256 + hs[ch * 32 + tid]; for (int p = 0; p < 512; ++p) if (te[p] == tid) sl[p] = rank++; }
        __syncthreads();
        { const size_t pi = (size_t)ch * 512 + tid; const int s_ = sl[tid]; slot[pi] = s_; wbuf[s_] = tkw[pi]; }
        for (int tt = 0; tt < 16; ++tt) { const int tl = wave * 16 + tt; const size_t t = (size_t)ch * CHTOK + tl;
            const u32x4 r0 = *(const u32x4*)(x1b + t * 1024 + lane * 8), r1 = *(const u32x4*)(x1b + t * 1024 + 512 + lane * 8);
#pragma unroll
            for (int k = 0; k < 4; ++k) { const size_t s_ = (size_t)sl[tl * 4 + k]; *(u32x4*)(xs + s_ * 1024 + lane * 8) = r0; *(u32x4*)(xs + s_ * 1024 + 512 + lane * 8) = r1; } }
    }
}
__device__ __forceinline__ int moe_table(ArgsP a, LAS unsigned char* lds) {
    int tid_ = threadIdx.x; asm volatile("" : "+v"(tid_)); const int tid = tid_;
    LAS int* bst = (LAS int*)(lds + MISC_OFF);
    LAS int* blk_e = (LAS int*)(lds + MISC_OFF + 256);
    __syncthreads();
    if (tid <= 32) bst[tid] = ((const int*)(a->ws + WS_META))[tid];
    __syncthreads();
    const int nb = bst[32];
    for (int rb = tid; rb < nb; rb += 512) { int e = 0; while (e < 31 && rb >= bst[e + 1]) ++e; blk_e[rb] = e; }
    __syncthreads();
    return nb;
}

__device__ __forceinline__ void p9_combine_ln2(ArgsP a, int l, float* xout, int G) {
    int tid_ = threadIdx.x; asm volatile("" : "+v"(tid_)); const int tid = tid_, lane = tid & 63, wave = tid >> 6;
    const bf16_t* x1b = (const bf16_t*)(a->ws + WS_X1B); const int* slot = (const int*)(a->ws + WS_SLOT);
    const bf16_t* ys = (const bf16_t*)(a->ws + WS_OV + OV_YS); bf16_t* xb = (bf16_t*)(a->ws + WS_XB);
    f32x4 gg[4], bb[4];
#pragma unroll
    for (int j = 0; j < 4; ++j) { gg[j] = *(const f32x4*)(a->in[I_LN2G] + l * 1024 + 4 * lane + 256 * j); bb[j] = *(const f32x4*)(a->in[I_LN2B] + l * 1024 + 4 * lane + 256 * j); }
    for (size_t t = (size_t)blockIdx.x * NWAVES + wave; t < (size_t)T_; t += (size_t)G * NWAVES) {
        int sk[4];
#pragma unroll
        for (int k = 0; k < 4; ++k) sk[k] = slot[t * 4 + k];
        f32x4 xv[4]; float s = 0.f;
#pragma unroll
        for (int j = 0; j < 4; ++j) { { const u32x2 xw = *(const u32x2*)(x1b + t * 1024 + 4 * lane + 256 * j); xv[j] = (f32x4){bflo(xw.x), bfhi(xw.x), bflo(xw.y), bfhi(xw.y)} * DN_ALPHA; }
            f32x4 ya = (f32x4){0.f, 0.f, 0.f, 0.f};
#pragma unroll
            for (int k = 0; k < 4; ++k) { const u32x2 w = *(const u32x2*)(ys + (size_t)sk[k] * 1024 + 4 * lane + 256 * j);
                ya[0] += bflo(w.x); ya[1] += bfhi(w.x); ya[2] += bflo(w.y); ya[3] += bfhi(w.y); }
            xv[j] += ya; s += (xv[j][0] + xv[j][1]) + (xv[j][2] + xv[j][3]); }
        const float mean = wave_sum(s) * (1.0f / 1024.0f); float s2 = 0.f;
#pragma unroll
        for (int j = 0; j < 4; ++j) { xv[j] = xv[j] - mean; s2 += (xv[j][0] * xv[j][0] + xv[j][1] * xv[j][1]) + (xv[j][2] * xv[j][2] + xv[j][3] * xv[j][3]); }
        const float rstd = rsqrtf(wave_sum(s2) * (1.0f / 1024.0f) + LN_EPS);
#pragma unroll
        for (int j = 0; j < 4; ++j) { xv[j] = xv[j] * rstd * gg[j] + bb[j];
            if (xout) *(f32x4*)(xout + t * 1024 + 4 * lane + 256 * j) = xv[j];
            u32x2 w; w.x = pk2(xv[j][0], xv[j][1]); w.y = pk2(xv[j][2], xv[j][3]); *(u32x2*)(xb + t * 1024 + 4 * lane + 256 * j) = w; }
    }
}
typedef float f32x4_t __attribute__((ext_vector_type(4)));
constexpr size_t MX_LRU_PH = 0, MX_LRU_CARRY = 4 * MiB;
template <int MODE> __device__ __forceinline__ void lru_fast(ArgsP a, int l, int b, int h, int c_lo, int c_hi, LAS unsigned char* lds, const bf16_t* proj, bf16_t* H, unsigned char* mxs) {
    int tid_ = threadIdx.x; asm volatile("" : "+v"(tid_)); const int tid = tid_, lane = tid & 63, wave = __builtin_amdgcn_readfirstlane(tid >> 6), fr = lane & 15, g = lane >> 4;
    LAS bf16_t* xa = (LAS bf16_t*)(lds);
    LAS bf16_t* ysb = (LAS bf16_t*)(lds + 17408);
    LAS bf16_t* outb = (LAS bf16_t*)(lds + 33792);
    LAS bf16_t* outc = (LAS bf16_t*)(lds + 50176);
    bf16_t* HL = (bf16_t*)(a->ws + WS_MB); bf16_t* CA = (bf16_t*)(a->ws + WS_X1B);
    float* PH = (float*)(mxs + MX_LRU_PH); const float* carry = (const float*)(mxs + MX_LRU_CARRY);
    const int ch = 16 * wave + fr, chg = h * 128 + ch;
    const bf16_t* wg = (const bf16_t*)(a->ws + WS_W + (size_t)l * WL_STRIDE + WL_G) + (size_t)h * 256 * 128;
    bf16x8 bra[4], brx[4];
#pragma unroll
    for (int ks = 0; ks < 4; ++ks) { bra[ks] = *(const bf16x8*)(wg + (size_t)(ch) * 128 + 32 * ks + 8 * g); brx[ks] = *(const bf16x8*)(wg + (size_t)(128 + ch) * 128 + 32 * ks + 8 * g); }
    const float ba = a->in[I_LBA][l * 1024 + chg], bx = a->in[I_LBX][l * 1024 + chg], sp = softplus_f(-a->in[I_LLAM][l * 1024 + chg]);
    const int cg = tid & 15, t0i = tid >> 4;
    float cwv[4][8], cbv[8];
    { const float* cw = a->in[I_LCW] + (size_t)l * 4 * 1024 + h * 128 + 8 * cg;
#pragma unroll
      for (int j = 0; j < 4; ++j) { const f32x4 w0 = *(const f32x4*)(cw + j * 1024), w1 = *(const f32x4*)(cw + j * 1024 + 4);
          cwv[j][0] = w0[0]; cwv[j][1] = w0[1]; cwv[j][2] = w0[2]; cwv[j][3] = w0[3]; cwv[j][4] = w1[0]; cwv[j][5] = w1[1]; cwv[j][6] = w1[2]; cwv[j][7] = w1[3]; }
      const float* cbp = a->in[I_LCB] + l * 1024 + h * 128 + 8 * cg; const f32x4 b0 = *(const f32x4*)(cbp), b1 = *(const f32x4*)(cbp + 4);
      cbv[0] = b0[0]; cbv[1] = b0[1]; cbv[2] = b0[2]; cbv[3] = b0[3]; cbv[4] = b1[0]; cbv[5] = b1[1]; cbv[6] = b1[2]; cbv[7] = b1[3]; }
    u32x4 pr[2][4], py[2];
#define LRU_ISSUE(c_) do { _Pragma("unroll") for (int i = 0; i < 2; ++i) { const int tl = (c_) * 64 + t0i + 32 * i; \
        _Pragma("unroll") for (int j = 0; j < 4; ++j) { const int tt_ = tl - 3 + j; pr[i][j] = (u32x4){0u, 0u, 0u, 0u}; \
            if (tt_ >= 0) pr[i][j] = *(const u32x4*)(proj + ((size_t)b * SEQ_ + tt_) * NPROJ + PC_LRUX + h * 128 + 8 * cg); } \
        if (MODE == 1) py[i] = *(const u32x4*)(proj + ((size_t)b * SEQ_ + tl) * NPROJ + PC_LRUY + h * 128 + 8 * cg); } } while (0)
    LRU_ISSUE(c_lo);
    for (int c = c_lo; c < c_hi; ++c) {
        const size_t tok0 = (size_t)b * SEQ_ + (size_t)c * 64;
        __syncthreads();
#pragma unroll
        for (int i = 0; i < 2; ++i) { float o[8];
#pragma unroll
            for (int q = 0; q < 8; ++q) o[q] = cbv[q];
#pragma unroll
            for (int j = 0; j < 4; ++j) { const unsigned x[4] = {pr[i][j].x, pr[i][j].y, pr[i][j].z, pr[i][j].w};
#pragma unroll
                for (int q = 0; q < 4; ++q) { o[2 * q] += cwv[j][2 * q] * bflo(x[q]); o[2 * q + 1] += cwv[j][2 * q + 1] * bfhi(x[q]); } }
            u32x4 w; w.x = pg8::cvt_pk_bf16(o[0], o[1]); w.y = pg8::cvt_pk_bf16(o[2], o[3]); w.z = pg8::cvt_pk_bf16(o[4], o[5]); w.w = pg8::cvt_pk_bf16(o[6], o[7]);
            *(LAS u32x4*)(xa + (t0i + 32 * i) * 136 + 8 * cg) = w;
            if (MODE == 1) *(LAS u32x4*)(ysb + (t0i + 32 * i) * 128 + 8 * cg) = py[i]; }
        if (c + 1 < c_hi) LRU_ISSUE(c + 1);
        __syncthreads();
        f32x4_t ar[4], ax[4];
#pragma unroll
        for (int tt = 0; tt < 4; ++tt) { ar[tt] = (f32x4_t){0.f, 0.f, 0.f, 0.f}; ax[tt] = (f32x4_t){0.f, 0.f, 0.f, 0.f}; }
#pragma unroll
        for (int tt = 0; tt < 4; ++tt)
#pragma unroll
            for (int ks = 0; ks < 4; ++ks) { const bf16x8 af = *(const LAS bf16x8*)(xa + (16 * tt + fr) * 136 + 32 * ks + 8 * g);
                ar[tt] = __builtin_amdgcn_mfma_f32_16x16x32_bf16(af, bra[ks], ar[tt], 0, 0, 0);
                ax[tt] = __builtin_amdgcn_mfma_f32_16x16x32_bf16(af, brx[ks], ax[tt], 0, 0, 0); }
        float av[4][4], uv[4][4], Ai[4], Bi[4];
#pragma unroll
        for (int tt = 0; tt < 4; ++tt) { float A = 1.f, B = 0.f;
#pragma unroll
            for (int r = 0; r < 4; ++r) { const int t = 16 * tt + 4 * g + r;
                const float rg = sigmoid_f(ar[tt][r] + ba), ig = sigmoid_f(ax[tt][r] + bx);
                const float log_a = -8.0f * rg * sp; av[tt][r] = __expf(log_a); uv[tt][r] = __builtin_amdgcn_sqrtf(neg_expm1_f(2.0f * log_a)) * (ig * bf2f(xa[t * 136 + ch]));
                B = av[tt][r] * B + uv[tt][r]; A *= av[tt][r]; }
            Ai[tt] = A; Bi[tt] = B; }
#pragma unroll
        for (int tt = 0; tt < 4; ++tt) { const float A1 = __shfl_up(Ai[tt], 16), B1 = __shfl_up(Bi[tt], 16); if (g >= 1) { Bi[tt] = Ai[tt] * B1 + Bi[tt]; Ai[tt] = Ai[tt] * A1; } }
#pragma unroll
        for (int tt = 0; tt < 4; ++tt) { const float A2 = __shfl_up(Ai[tt], 32), B2 = __shfl_up(Bi[tt], 32); if (g >= 2) { Bi[tt] = Ai[tt] * B2 + Bi[tt]; Ai[tt] = Ai[tt] * A2; } }
        float Ae[4], Be[4], At[4], Bt[4];
#pragma unroll
        for (int tt = 0; tt < 4; ++tt) { Ae[tt] = __shfl_up(Ai[tt], 16); Be[tt] = __shfl_up(Bi[tt], 16); if (g == 0) { Ae[tt] = 1.f; Be[tt] = 0.f; }
            At[tt] = __shfl(Ai[tt], fr + 48); Bt[tt] = __shfl(Bi[tt], fr + 48); }
        float hin = 0.f, ptot = 1.f;
        if (MODE == 1) hin = carry[((size_t)b * 64 + c) * 1024 + chg];
#pragma unroll
        for (int tt = 0; tt < 4; ++tt) {
            float hcur = Ae[tt] * hin + Be[tt], ccur = ptot * Ae[tt];
#pragma unroll
            for (int r = 0; r < 4; ++r) { const int t = 16 * tt + 4 * g + r; hcur = av[tt][r] * hcur + uv[tt][r]; ccur *= av[tt][r];
                if (MODE == 1) outb[t * 128 + ch] = (bf16_t)f2bf(hcur * gelu_tanh_f(bf2f(ysb[t * 128 + ch])));
                else { outb[t * 128 + ch] = (bf16_t)f2bf(hcur); outc[t * 128 + ch] = (bf16_t)f2bf(ccur); } }
            hin = At[tt] * hin + Bt[tt]; ptot *= At[tt]; }
        if (MODE == 0) { if (g == 0) { PH[(((size_t)b * 64 + c) * 2 + 0) * 1024 + chg] = ptot; PH[(((size_t)b * 64 + c) * 2 + 1) * 1024 + chg] = hin; } }
        __syncthreads();
#pragma unroll
        for (int i = 0; i < 2; ++i) { const int pid = tid + 512 * i; const int row = pid >> 4, c8 = (pid & 15) * 8;
            if (MODE == 1) *(u32x4*)(H + (tok0 + row) * 2048 + h * 128 + c8) = *(const LAS u32x4*)(outb + row * 128 + c8);
            else { *(u32x4*)(HL + (tok0 + row) * 1024 + h * 128 + c8) = *(const LAS u32x4*)(outb + row * 128 + c8); *(u32x4*)(CA + (tok0 + row) * 1024 + h * 128 + c8) = *(const LAS u32x4*)(outc + row * 128 + c8); } }
    }
#undef LRU_ISSUE
}
__device__ __forceinline__ void lru_carry(unsigned char* mxs, int G) {
    const float* PH = (const float*)(mxs + MX_LRU_PH); float* carry = (float*)(mxs + MX_LRU_CARRY);
    int tid_ = threadIdx.x; asm volatile("" : "+v"(tid_));
    for (int gid = blockIdx.x * 512 + tid_; gid < NBATCH * 1024; gid += G * 512) { const int b = gid >> 10, chg = gid & 1023; float hc = 0.f;
#pragma unroll 8
        for (int c = 0; c < 64; ++c) { const size_t o = ((size_t)b * 64 + c); carry[o * 1024 + chg] = hc; hc = PH[(o * 2) * 1024 + chg] * hc + PH[(o * 2 + 1) * 1024 + chg]; } }
}
__device__ __forceinline__ void lru_apply(ArgsP a, const bf16_t* proj, bf16_t* H, unsigned char* mxs, int first, int stride) {
    int tid_ = threadIdx.x; asm volatile("" : "+v"(tid_));
    const bf16_t* HL = (const bf16_t*)(a->ws + WS_MB); const bf16_t* CA = (const bf16_t*)(a->ws + WS_X1B); const float* carry = (const float*)(mxs + MX_LRU_CARRY);
    for (size_t p = (size_t)first * 512 + tid_; p < (size_t)T_ * 128; p += (size_t)stride * 512) { const size_t t = p >> 7; const int c8 = (int)(p & 127) * 8;
        const u32x4 hw = *(const u32x4*)(HL + t * 1024 + c8), cw = *(const u32x4*)(CA + t * 1024 + c8), yw = *(const u32x4*)(proj + t * NPROJ + PC_LRUY + c8);
        const float* cp = carry + (t >> 6) * 1024 + c8; const f32x4 c0 = *(const f32x4*)(cp), c1 = *(const f32x4*)(cp + 4);
        const unsigned hh[4] = {hw.x, hw.y, hw.z, hw.w}, cc[4] = {cw.x, cw.y, cw.z, cw.w}, yy[4] = {yw.x, yw.y, yw.z, yw.w}; const float cin[8] = {c0[0], c0[1], c0[2], c0[3], c1[0], c1[1], c1[2], c1[3]};
        unsigned o[4];
#pragma unroll
        for (int q = 0; q < 4; ++q) { const float h0 = bflo(hh[q]) + bflo(cc[q]) * cin[2 * q], h1 = bfhi(hh[q]) + bfhi(cc[q]) * cin[2 * q + 1];
            o[q] = pg8::cvt_pk_bf16(h0 * gelu_tanh_f(bflo(yy[q])), h1 * gelu_tanh_f(bfhi(yy[q]))); }
        *(u32x4*)(H + t * 2048 + c8) = (u32x4){o[0], o[1], o[2], o[3]}; }
}
typedef float f32x16 __attribute__((ext_vector_type(16)));
typedef short bf16x4 __attribute__((ext_vector_type(4)));
constexpr size_t MXB_ML_U = 0;
constexpr size_t MXB_ML_CP = 64 * MiB;
constexpr size_t MXS_ML_NU = 6 * MiB, MXS_ML_NP = 6 * MiB + 512 * 1024, MXS_ML_SC = 7 * MiB;

__device__ __forceinline__ float bperm_f(int src_lane, float v) { return __builtin_bit_cast(float, __builtin_amdgcn_ds_bpermute(src_lane << 2, __builtin_bit_cast(int, v))); }
__device__ __forceinline__ float wave_incl_sum(float v, int lane) {
#pragma unroll
    for (int o = 1; o < 64; o <<= 1) { const float t = bperm_f(lane >= o ? lane - o : lane, v); if (lane >= o) v += t; }
    return v;
}
__device__ __forceinline__ float wave_incl_max(float v, int lane) {
#pragma unroll
    for (int o = 1; o < 64; o <<= 1) { const float t = bperm_f(lane >= o ? lane - o : lane, v); if (lane >= o) v = fmaxf(v, t); }
    return v;
}
__device__ __forceinline__ bf16x8 pack8(float a0, float a1, float a2, float a3, float a4, float a5, float a6, float a7) {
    u32x4 w; w.x = pg8::cvt_pk_bf16(a0, a1); w.y = pg8::cvt_pk_bf16(a2, a3); w.z = pg8::cvt_pk_bf16(a4, a5); w.w = pg8::cvt_pk_bf16(a6, a7); return __builtin_bit_cast(bf16x8, w);
}
__device__ __forceinline__ bf16x8 ld_perm(const LAS bf16_t* p) {
    const u32x2 lo = *(const LAS u32x2*)(p), hi = *(const LAS u32x2*)(p + 8); u32x4 w; w.x = lo.x; w.y = lo.y; w.z = hi.x; w.w = hi.y; return __builtin_bit_cast(bf16x8, w);
}

__device__ __forceinline__ void mlstm_passA(ArgsP a, int l, LAS unsigned char* lds, const bf16_t* proj, const float* gsm, unsigned char* mxb, unsigned char* mxs, int G) {
    int tid_ = threadIdx.x; asm volatile("" : "+v"(tid_)); const int tid = tid_, lane = tid & 63, wave = __builtin_amdgcn_readfirstlane(tid >> 6), r = lane & 31, hh = lane >> 5;
    LAS bf16_t* kwT = (LAS bf16_t*)(lds);
    LAS bf16_t* vT = (LAS bf16_t*)(lds + 9216);
    LAS float* wts = (LAS float*)(lds + 27648);
    float* NU = (float*)(mxs + MXS_ML_NU); float* SC = (float*)(mxs + MXS_ML_SC);
    for (int uid = blockIdx.x; uid < 2048; uid += G) {
        const int c = uid & 63, hd = (uid >> 6) & 3, b = uid >> 8; const size_t tok0 = (size_t)b * SEQ_ + (size_t)c * 64;
        const float ib = a->in[I_MIB][l * 4 + hd], fb = a->in[I_MFB][l * 4 + hd];
        __syncthreads();
        if (wave == 0) {
            const float fpre = gsm[(tok0 + lane) * 32 + 4 + hd] + fb, ipre = gsm[(tok0 + lane) * 32 + hd] + ib;
            const float logf = -softplus_f(-fpre); const float bc = wave_incl_sum(logf, lane); const float bl = __shfl(bc, 63);
            const float ge = bl - bc + ipre; const float mloc = wave_max(ge);
            wts[lane] = __expf(ge - mloc);
            if (lane == 0) { SC[(size_t)uid * 4 + 0] = bl; SC[(size_t)uid * 4 + 1] = mloc; }
        }
        const u32x4 kp = *(const u32x4*)(proj + (tok0 + lane) * NPROJ + PC_MLK + hd * 64 + wave * 8);
        const u32x4 vp0 = *(const u32x4*)(proj + (tok0 + lane) * NPROJ + PC_MLV + hd * 128 + wave * 8);
        const u32x4 vp1 = *(const u32x4*)(proj + (tok0 + lane) * NPROJ + PC_MLV + hd * 128 + 64 + wave * 8);
        __syncthreads();
        { const float w = wts[lane]; const unsigned kw[4] = {kp.x, kp.y, kp.z, kp.w};
#pragma unroll
          for (int j = 0; j < 4; ++j) { kwT[(wave * 8 + 2 * j) * 72 + lane] = (bf16_t)f2bf(w * bflo(kw[j])); kwT[(wave * 8 + 2 * j + 1) * 72 + lane] = (bf16_t)f2bf(w * bfhi(kw[j])); }
          const unsigned v0[4] = {vp0.x, vp0.y, vp0.z, vp0.w}, v1[4] = {vp1.x, vp1.y, vp1.z, vp1.w};
#pragma unroll
          for (int j = 0; j < 4; ++j) { vT[(wave * 8 + 2 * j) * 72 + lane] = (bf16_t)(v0[j] & 0xffffu); vT[(wave * 8 + 2 * j + 1) * 72 + lane] = (bf16_t)(v0[j] >> 16);
              vT[(64 + wave * 8 + 2 * j) * 72 + lane] = (bf16_t)(v1[j] & 0xffffu); vT[(64 + wave * 8 + 2 * j + 1) * 72 + lane] = (bf16_t)(v1[j] >> 16); } }
        __syncthreads();
        const int dI = wave >> 2, eJ = wave & 3;
        f32x16 acc;
#pragma unroll
        for (int i = 0; i < 16; ++i) acc[i] = 0.f;
#pragma unroll
        for (int ks = 0; ks < 4; ++ks) { const bf16x8 af = *(const LAS bf16x8*)(kwT + (32 * dI + r) * 72 + 16 * ks + 8 * hh), bf = *(const LAS bf16x8*)(vT + (32 * eJ + r) * 72 + 16 * ks + 8 * hh);
            acc = __builtin_amdgcn_mfma_f32_32x32x16_bf16(af, bf, acc, 0, 0, 0); }
        float* ud = (float*)(mxb + MXB_ML_U) + ((size_t)uid * 8 + wave) * 1024;
#pragma unroll
        for (int q = 0; q < 4; ++q) *(f32x4*)(ud + (q * 64 + lane) * 4) = (f32x4){acc[4 * q], acc[4 * q + 1], acc[4 * q + 2], acc[4 * q + 3]};
        if (tid < 64) { float s = 0.f;
#pragma unroll 8
            for (int t = 0; t < 64; ++t) s += bf2f(kwT[tid * 72 + t]);
            NU[(size_t)uid * 64 + tid] = s; }
    }
}
__device__ __forceinline__ void mlstm_passB(unsigned char* mxb, unsigned char* mxs, int G) {
    int tid_ = threadIdx.x; asm volatile("" : "+v"(tid_)); const int tid = tid_;
    const float* NU = (const float*)(mxs + MXS_ML_NU); float* NP = (float*)(mxs + MXS_ML_NP); float* SC = (float*)(mxs + MXS_ML_SC);
    for (int wu = blockIdx.x; wu < 256; wu += G) {
        const int chain = wu >> 3, tile = wu & 7;
        if (tid < 128) {
            const int lane = tid & 63, s = tid >> 6;
            float st[8]; float m = 0.f;
#pragma unroll
            for (int i = 0; i < 8; ++i) st[i] = 0.f;
#pragma unroll 4
            for (int c = 0; c < 64; ++c) { const size_t uid = (size_t)chain * 64 + c;
                const float* ud = (const float*)(mxb + MXB_ML_U) + (uid * 8 + tile) * 1024;
                const f32x4 u0 = *(const f32x4*)(ud + ((2 * s) * 64 + lane) * 4), u1 = *(const f32x4*)(ud + ((2 * s + 1) * 64 + lane) * 4);
                const float bl = SC[uid * 4 + 0], mloc = SC[uid * 4 + 1];
                *(bf16x8*)((bf16_t*)(mxb + MXB_ML_CP) + (uid * 8 + tile) * 1024 + (s * 64 + lane) * 8) = pack8(st[0], st[1], st[2], st[3], st[4], st[5], st[6], st[7]);
                if (tile == 0 && tid == 0) SC[uid * 4 + 2] = m;
                const float mn = fmaxf(bl + m, mloc), dec = __expf(bl + m - mn), sc = __expf(mloc - mn); m = mn;
#pragma unroll
                for (int i = 0; i < 4; ++i) { st[i] = dec * st[i] + sc * u0[i]; st[4 + i] = dec * st[4 + i] + sc * u1[i]; } }
        } else if (tile == 0 && tid < 192) {
            const int d = tid - 128; float n = 0.f, m = 0.f;
#pragma unroll 4
            for (int c = 0; c < 64; ++c) { const size_t uid = (size_t)chain * 64 + c; const float bl = SC[uid * 4 + 0], mloc = SC[uid * 4 + 1]; const float nu = NU[uid * 64 + d];
                NP[uid * 64 + d] = n; const float mn = fmaxf(bl + m, mloc), dec = __expf(bl + m - mn), sc = __expf(mloc - mn); m = mn; n = dec * n + sc * nu; }
        }
    }
}
__device__ __forceinline__ void mlstm_passC(ArgsP a, int l, LAS unsigned char* lds, const bf16_t* proj, const float* gsm, bf16_t* H, unsigned char* mxb, unsigned char* mxs, int first, int stride) {
    int tid_ = threadIdx.x; asm volatile("" : "+v"(tid_)); const int tid = tid_, lane = tid & 63, wave = __builtin_amdgcn_readfirstlane(tid >> 6), r = lane & 31, hh = lane >> 5;
    LAS bf16_t* qb = (LAS bf16_t*)(lds);
    LAS bf16_t* kb = (LAS bf16_t*)(lds + 9216);
    LAS bf16_t* vT = (LAS bf16_t*)(lds + 18432);
    LAS bf16_t* ob = (LAS bf16_t*)(lds + 36864);
    LAS bf16_t* outb = (LAS bf16_t*)(lds + 54272);
    LAS float* tb_rt = (LAS float*)(lds + 70656);
    LAS float* tb_ct = tb_rt + 64;
    LAS float* tb_iw = tb_rt + 128;
    LAS float* tb_em = tb_rt + 192;
    LAS float* tb_np = tb_rt + 256;
    LAS float* ssq = tb_rt + 320;
    const float* NP = (const float*)(mxs + MXS_ML_NP); const float* SC = (const float*)(mxs + MXS_ML_SC);
    for (int uid = first; uid < 2048; uid += stride) {
        const int c = uid & 63, hd = (uid >> 6) & 3, b = uid >> 8; const size_t tok0 = (size_t)b * SEQ_ + (size_t)c * 64;
        __syncthreads();
        if (wave == 0) {
            const float ib = a->in[I_MIB][l * 4 + hd], fb = a->in[I_MFB][l * 4 + hd];
            const float fpre = gsm[(tok0 + lane) * 32 + 4 + hd] + fb, ipre = gsm[(tok0 + lane) * 32 + hd] + ib;
            const float logf = -softplus_f(-fpre); const float bc = wave_incl_sum(logf, lane);
            const float rt = ipre - bc; const float cmx = wave_incl_max(rt, lane); const float mprev = SC[(size_t)uid * 4 + 2];
            const float mt = bc + fmaxf(mprev, cmx);
            tb_rt[lane] = rt; tb_ct[lane] = bc - mt; tb_iw[lane] = __expf(bc + mprev - mt); tb_em[lane] = __expf(-mt); tb_np[lane] = NP[(size_t)uid * 64 + lane];
        }
        { const int row = tid >> 3, c8 = (tid & 7) * 8;
          *(LAS u32x4*)(qb + row * 72 + c8) = *(const u32x4*)(proj + (tok0 + row) * NPROJ + PC_MLQ + hd * 64 + c8);
          *(LAS u32x4*)(kb + row * 72 + c8) = *(const u32x4*)(proj + (tok0 + row) * NPROJ + PC_MLK + hd * 64 + c8);
#pragma unroll
          for (int i = 0; i < 2; ++i) { const int pid = tid + 512 * i; const int orow = pid >> 4, oc8 = (pid & 15) * 8;
              *(LAS u32x4*)(ob + orow * 136 + oc8) = *(const u32x4*)(proj + (tok0 + orow) * NPROJ + PC_MLO + hd * 128 + oc8); }
          const u32x4 vp0 = *(const u32x4*)(proj + (tok0 + lane) * NPROJ + PC_MLV + hd * 128 + wave * 8);
          const u32x4 vp1 = *(const u32x4*)(proj + (tok0 + lane) * NPROJ + PC_MLV + hd * 128 + 64 + wave * 8);
          const unsigned v0[4] = {vp0.x, vp0.y, vp0.z, vp0.w}, v1[4] = {vp1.x, vp1.y, vp1.z, vp1.w};
#pragma unroll
          for (int j = 0; j < 4; ++j) { vT[(wave * 8 + 2 * j) * 72 + lane] = (bf16_t)(v0[j] & 0xffffu); vT[(wave * 8 + 2 * j + 1) * 72 + lane] = (bf16_t)(v0[j] >> 16);
              vT[(64 + wave * 8 + 2 * j) * 72 + lane] = (bf16_t)(v1[j] & 0xffffu); vT[(64 + wave * 8 + 2 * j + 1) * 72 + lane] = (bf16_t)(v1[j] >> 16); } }
        __syncthreads();
        const int eI = wave >> 1, tJ = wave & 1; const int t = 32 * tJ + r;
        f32x16 as[2];
#pragma unroll
        for (int sI = 0; sI < 2; ++sI) {
#pragma unroll
            for (int i = 0; i < 16; ++i) as[sI][i] = 0.f;
#pragma unroll
            for (int ks = 0; ks < 4; ++ks) { const bf16x8 af = *(const LAS bf16x8*)(kb + (32 * sI + r) * 72 + 16 * ks + 8 * hh), bf = *(const LAS bf16x8*)(qb + t * 72 + 16 * ks + 8 * hh);
                as[sI] = __builtin_amdgcn_mfma_f32_32x32x16_bf16(af, bf, as[sI], 0, 0, 0); } }
        const float ctt = tb_ct[t], iwt = tb_iw[t] * 0.125f, emt = tb_em[t];
        float dsum = 0.f;
#pragma unroll
        for (int sI = 0; sI < 2; ++sI)
#pragma unroll
            for (int q = 0; q < 4; ++q) { const int s0 = 32 * sI + 8 * q + 4 * hh; const f32x4 rt4 = *(const LAS f32x4*)(tb_rt + s0);
#pragma unroll
                for (int i = 0; i < 4; ++i) { const float wv = (s0 + i <= t) ? as[sI][4 * q + i] * 0.125f * __expf(ctt + rt4[i]) : 0.f; as[sI][4 * q + i] = wv; dsum += wv; } }
        float qn = 0.f;
#pragma unroll
        for (int j = 0; j < 4; ++j) { const u32x4 qw = *(const LAS u32x4*)(qb + t * 72 + 32 * hh + 8 * j); const f32x4 n0 = *(const LAS f32x4*)(tb_np + 32 * hh + 8 * j), n1 = *(const LAS f32x4*)(tb_np + 32 * hh + 8 * j + 4);
            qn += bflo(qw.x) * n0[0] + bfhi(qw.x) * n0[1] + bflo(qw.y) * n0[2] + bfhi(qw.y) * n0[3] + bflo(qw.z) * n1[0] + bfhi(qw.z) * n1[1] + bflo(qw.w) * n1[2] + bfhi(qw.w) * n1[3]; }
        float den = dsum + iwt * qn; den += __shfl_xor(den, 32);
        f32x16 an;
#pragma unroll
        for (int i = 0; i < 16; ++i) an[i] = 0.f;
#pragma unroll
        for (int sI = 0; sI < 2; ++sI)
#pragma unroll
            for (int s2 = 0; s2 < 2; ++s2) { const bf16x8 af = ld_perm(vT + (32 * eI + r) * 72 + 32 * sI + 16 * s2 + 4 * hh);
                const bf16x8 bf = pack8(as[sI][8 * s2], as[sI][8 * s2 + 1], as[sI][8 * s2 + 2], as[sI][8 * s2 + 3], as[sI][8 * s2 + 4], as[sI][8 * s2 + 5], as[sI][8 * s2 + 6], as[sI][8 * s2 + 7]);
                an = __builtin_amdgcn_mfma_f32_32x32x16_bf16(af, bf, an, 0, 0, 0); }
        const bf16_t* cpd = (const bf16_t*)(mxb + MXB_ML_CP) + (size_t)uid * 8 * 1024;
#pragma unroll
        for (int dI = 0; dI < 2; ++dI)
#pragma unroll
            for (int s2 = 0; s2 < 2; ++s2) { const bf16x8 af = *(const bf16x8*)(cpd + (size_t)(dI * 4 + eI) * 1024 + (s2 * 64 + lane) * 8);
                const u32x4 qw = __builtin_bit_cast(u32x4, ld_perm(qb + t * 72 + 32 * dI + 16 * s2 + 4 * hh));
                const bf16x8 bf = pack8(bflo(qw.x) * iwt, bfhi(qw.x) * iwt, bflo(qw.y) * iwt, bfhi(qw.y) * iwt, bflo(qw.z) * iwt, bfhi(qw.z) * iwt, bflo(qw.w) * iwt, bfhi(qw.w) * iwt);
                an = __builtin_amdgcn_mfma_f32_32x32x16_bf16(af, bf, an, 0, 0, 0); }
        const float dinv = 1.0f / fmaxf(fabsf(den), emt);
        float sq = 0.f;
#pragma unroll
        for (int i = 0; i < 16; ++i) { an[i] *= dinv; sq += an[i] * an[i]; }
        sq += __shfl_xor(sq, 32);
        if (hh == 0) ssq[eI * 64 + t] = sq;
        __syncthreads();
        const float tot = ssq[t] + ssq[64 + t] + ssq[128 + t] + ssq[192 + t];
        const float rinv = rsqrtf(tot * (1.0f / 128.0f) + RMS_EPS);
        const float* gn = a->in[I_MNG] + (size_t)l * 512 + hd * 128;
#pragma unroll
        for (int q = 0; q < 4; ++q) { const int e0 = 32 * eI + 8 * q + 4 * hh; const f32x4 g4 = *(const f32x4*)(gn + e0); const u32x2 ow = *(const LAS u32x2*)(ob + t * 136 + e0);
            const float o0 = an[4 * q] * rinv * g4[0] * sigmoid_f(bflo(ow.x)), o1 = an[4 * q + 1] * rinv * g4[1] * sigmoid_f(bfhi(ow.x));
            const float o2 = an[4 * q + 2] * rinv * g4[2] * sigmoid_f(bflo(ow.y)), o3 = an[4 * q + 3] * rinv * g4[3] * sigmoid_f(bfhi(ow.y));
            u32x2 pw; pw.x = pg8::cvt_pk_bf16(o0, o1); pw.y = pg8::cvt_pk_bf16(o2, o3); *(LAS u32x2*)(outb + t * 128 + e0) = pw; }
        __syncthreads();
#pragma unroll
        for (int i = 0; i < 2; ++i) { const int pid = tid + 512 * i; const int row = pid >> 4, c8 = (pid & 15) * 8;
            *(u32x4*)(H + (tok0 + row) * 2048 + 1024 + hd * 128 + c8) = *(const LAS u32x4*)(outb + row * 128 + c8); }
    }
}
constexpr size_t MXB_GD_ND = 96 * MiB, MXB_GD_OD = 160 * MiB, MXB_GD_T = 224 * MiB;
constexpr size_t MXT_GD_XD = 8 * MiB, MXT_GD_QD = 40 * MiB, MXT_GD_SD = 72 * MiB;
constexpr size_t MXS_GD_GL = 7 * MiB + 64 * 1024;

__device__ __forceinline__ void conv_silu8(const u32x4 (&rw)[4], const float* cw, float (&o)[8]) {
#pragma unroll
    for (int j = 0; j < 8; ++j) o[j] = 0.f;
#pragma unroll
    for (int i = 0; i < 4; ++i) { const f32x4 w0 = *(const f32x4*)(cw + i * 1536), w1 = *(const f32x4*)(cw + i * 1536 + 4); const unsigned x[4] = {rw[i].x, rw[i].y, rw[i].z, rw[i].w};
        o[0] += w0[0] * bflo(x[0]); o[1] += w0[1] * bfhi(x[0]); o[2] += w0[2] * bflo(x[1]); o[3] += w0[3] * bfhi(x[1]);
        o[4] += w1[0] * bflo(x[2]); o[5] += w1[1] * bfhi(x[2]); o[6] += w1[2] * bflo(x[3]); o[7] += w1[3] * bfhi(x[3]); }
#pragma unroll
    for (int j = 0; j < 8; ++j) o[j] = silu_f(o[j]);
}
__device__ __forceinline__ void load_rows4(const bf16_t* proj, int b, int tl, int col, u32x4 (&rw)[4]) {
#pragma unroll
    for (int i = 0; i < 4; ++i) { const int tt = tl - 3 + i; rw[i] = (u32x4){0u, 0u, 0u, 0u}; if (tt >= 0) rw[i] = *(const u32x4*)(proj + ((size_t)b * SEQ_ + tt) * NPROJ + col); }
}

__device__ __forceinline__ void gdn_passA1(ArgsP a, int l, LAS unsigned char* lds, const bf16_t* proj, const float* gsm, unsigned char* mxb, int G) {
    int tid_ = threadIdx.x; asm volatile("" : "+v"(tid_)); const int tid = tid_, lane = tid & 63, wave = __builtin_amdgcn_readfirstlane(tid >> 6), r = lane & 31, hh = lane >> 5;
    LAS unsigned char* wl = lds + wave * 16384;
    LAS bf16_t* kb = (LAS bf16_t*)wl;
    LAS float* am = (LAS float*)wl;
    LAS float* tb = (LAS float*)(lds + MISC_OFF + 1024 + wave * 512);
    const float* cwk = a->in[I_GCW] + (size_t)l * 4 * 1536 + 512;
    for (int uid = blockIdx.x * NWAVES + wave; uid < 4096; uid += G * NWAVES) {
        const int c = uid & 63, hd = (uid >> 6) & 7, b = uid >> 9; const int tl = c * 64 + lane; const size_t tok = (size_t)b * SEQ_ + tl;
        float ss = 0.f;
#pragma unroll 2
        for (int p = 0; p < 8; ++p) { u32x4 rw[4]; load_rows4(proj, b, tl, PC_GDK + hd * 64 + 8 * p, rw); float o[8]; conv_silu8(rw, cwk + hd * 64 + 8 * p, o);
#pragma unroll
            for (int j = 0; j < 8; ++j) ss += o[j] * o[j];
            *(LAS bf16x8*)(kb + lane * 72 + 8 * p) = pack8(o[0], o[1], o[2], o[3], o[4], o[5], o[6], o[7]); }
        const float rn = rsqrtf(ss + RMS_EPS);
        const float gg = -__expf(a->in[I_GAL][l * 8 + hd]) * softplus_f(gsm[tok * 32 + 8 + hd] + a->in[I_GDT][l * 8 + hd]);
        const float gc = wave_incl_sum(gg, lane), beta = 1.f / (1.f + __expf(-gsm[tok * 32 + 16 + hd]));
        tb[lane] = gc; tb[64 + lane] = beta * rn;
        LDS_WAIT(); asm volatile("" ::: "memory");
        bf16x8 kf[2][4];
#pragma unroll
        for (int I = 0; I < 2; ++I)
#pragma unroll
            for (int ks = 0; ks < 4; ++ks) kf[I][ks] = *(const LAS bf16x8*)(kb + (32 * I + r) * 72 + 16 * ks + 8 * hh);
        LDS_WAIT(); asm volatile("" ::: "memory");
#pragma unroll
        for (int I = 0; I < 2; ++I)
#pragma unroll
            for (int J = 0; J < 2; ++J) { f32x16 acc;
#pragma unroll
                for (int i = 0; i < 16; ++i) acc[i] = 0.f;
#pragma unroll
                for (int ks = 0; ks < 4; ++ks) acc = __builtin_amdgcn_mfma_f32_32x32x16_bf16(kf[I][ks], kf[J][ks], acc, 0, 0, 0);
                const int s = 32 * J + r; const float gcs = __shfl(gc, s), rns = __shfl(rn, s);
#pragma unroll
                for (int q = 0; q < 4; ++q) { const int t0 = 32 * I + 8 * q + 4 * hh; const f32x4 gct = *(const LAS f32x4*)(tb + t0), brt = *(const LAS f32x4*)(tb + 64 + t0);
#pragma unroll
                    for (int i = 0; i < 4; ++i) { const float v = (s < t0 + i) ? acc[4 * q + i] * brt[i] * rns * __expf(gct[i] - gcs) : 0.f; am[(t0 + i) * 64 + s] = v; } } }
        LDS_WAIT(); asm volatile("" ::: "memory");
        float Tc[64];
#pragma unroll
        for (int i = 0; i < 64; ++i) { float acc = (i == lane) ? 1.f : 0.f;
#pragma unroll
            for (int j4 = 0; j4 < (i + 3) / 4; ++j4) { const f32x4 av = *(const LAS f32x4*)(am + i * 64 + 4 * j4);
#pragma unroll
                for (int jj = 0; jj < 4; ++jj) if (4 * j4 + jj < i) acc -= av[jj] * Tc[4 * j4 + jj]; }
            Tc[i] = acc; }
        bf16_t* Tg = (bf16_t*)(mxb + MXB_GD_T) + (size_t)uid * 4096;
#pragma unroll
        for (int i = 0; i < 64; ++i) Tg[i * 64 + lane] = (bf16_t)f2bf(Tc[i]);
    }
}

__device__ __forceinline__ void gdn_passA2(ArgsP a, int l, LAS unsigned char* lds, const bf16_t* proj, const float* gsm, unsigned char* mxb, unsigned char* mxt, unsigned char* mxs, int G) {
    int tid_ = threadIdx.x; asm volatile("" : "+v"(tid_)); const int tid = tid_, lane = tid & 63, wave = __builtin_amdgcn_readfirstlane(tid >> 6), r = lane & 31, hh = lane >> 5;
    LAS bf16_t* qb = (LAS bf16_t*)(lds);
    LAS bf16_t* kb = (LAS bf16_t*)(lds + 9216);
    LAS bf16_t* bvT = (LAS bf16_t*)(lds + 18432);
    LAS bf16_t* bkT = (LAS bf16_t*)(lds + 27648);
    LAS bf16_t* Tm = (LAS bf16_t*)(lds + 36864);
    LAS bf16_t* wT = (LAS bf16_t*)(lds + 46080);
    LAS bf16_t* uT = (LAS bf16_t*)(lds + 55296);
    LAS bf16_t* kdT = (LAS bf16_t*)(lds + 64512);
    LAS float* tb_gc = (LAS float*)(lds + 73728);
    LAS float* tb_beta = tb_gc + 64;
    LAS float* ssq = tb_gc + 128;
    const float* cw = a->in[I_GCW] + (size_t)l * 4 * 1536;
    float* GL = (float*)(mxs + MXS_GD_GL);
    u32x4 rq[4], rk[4], rv[4], tp; float pga = 0.f, pgb = 0.f;
#define GA2_ISSUE(u_) do { const int c_ = (u_) & 63, hd_ = ((u_) >> 6) & 7, b_ = (u_) >> 9; const int tl_ = c_ * 64 + lane; const size_t tok_ = (size_t)b_ * SEQ_ + tl_; \
        load_rows4(proj, b_, tl_, PC_GDQ + hd_ * 64 + 8 * wave, rq); load_rows4(proj, b_, tl_, PC_GDK + hd_ * 64 + 8 * wave, rk); load_rows4(proj, b_, tl_, PC_GDV + hd_ * 64 + 8 * wave, rv); \
        pga = gsm[tok_ * 32 + 8 + hd_]; pgb = gsm[tok_ * 32 + 16 + hd_]; \
        tp = *(const u32x4*)((const bf16_t*)(mxb + MXB_GD_T) + (size_t)(u_) * 4096 + (tid >> 3) * 64 + (tid & 7) * 8); } while (0)
    if ((int)blockIdx.x < 4096) GA2_ISSUE((int)blockIdx.x);
    for (int uid = blockIdx.x; uid < 4096; uid += G) {
        const int hd = (uid >> 6) & 7;
        __syncthreads();
        { const float gg = -__expf(a->in[I_GAL][l * 8 + hd]) * softplus_f(pga + a->in[I_GDT][l * 8 + hd]);
          const float gc = wave_incl_sum(gg, lane);
          if (wave == 0) { tb_gc[lane] = gc; tb_beta[lane] = 1.f / (1.f + __expf(-pgb)); if (lane == 63) GL[uid] = __expf(gc); } }
        float qo[8], ko[8], vo[8];
        conv_silu8(rq, cw + hd * 64 + 8 * wave, qo); conv_silu8(rk, cw + 512 + hd * 64 + 8 * wave, ko); conv_silu8(rv, cw + 1024 + hd * 64 + 8 * wave, vo);
        { float sq = 0.f, sk = 0.f;
#pragma unroll
          for (int j = 0; j < 8; ++j) { sq += qo[j] * qo[j]; sk += ko[j] * ko[j]; }
          ssq[wave * 64 + lane] = sq; ssq[512 + wave * 64 + lane] = sk; }
        *(LAS u32x4*)(Tm + (tid >> 3) * 72 + (tid & 7) * 8) = tp;
        if (uid + G < 4096) GA2_ISSUE(uid + G);
        __syncthreads();
        { float sq = 0.f, sk = 0.f;
#pragma unroll
          for (int w = 0; w < 8; ++w) { sq += ssq[w * 64 + lane]; sk += ssq[512 + w * 64 + lane]; }
          const float rq = rsqrtf(sq + RMS_EPS) * 0.125f, rk = rsqrtf(sk + RMS_EPS);
          const float gc = tb_gc[lane], beta = tb_beta[lane], gl_ = tb_gc[63];
          const float e1 = beta * __expf(gc), e2 = __expf(gl_ - gc);
#pragma unroll
          for (int j = 0; j < 8; ++j) { qo[j] *= rq; ko[j] *= rk; }
          *(LAS bf16x8*)(qb + lane * 72 + 8 * wave) = pack8(qo[0], qo[1], qo[2], qo[3], qo[4], qo[5], qo[6], qo[7]);
          *(LAS bf16x8*)(kb + lane * 72 + 8 * wave) = pack8(ko[0], ko[1], ko[2], ko[3], ko[4], ko[5], ko[6], ko[7]);
#pragma unroll
          for (int j = 0; j < 8; ++j) { const int d = 8 * wave + j;
              bvT[d * 72 + lane] = (bf16_t)f2bf(beta * vo[j]); bkT[d * 72 + lane] = (bf16_t)f2bf(e1 * ko[j]); kdT[d * 72 + lane] = (bf16_t)f2bf(e2 * ko[j]); } }
        __syncthreads();
        { const int mat = wave >> 2, I = (wave >> 1) & 1, J = wave & 1; const LAS bf16_t* Am = mat ? bkT : bvT; LAS bf16_t* Om = mat ? wT : uT;
          f32x16 acc;
#pragma unroll
          for (int i = 0; i < 16; ++i) acc[i] = 0.f;
#pragma unroll
          for (int ks = 0; ks < 4; ++ks) { const bf16x8 af = *(const LAS bf16x8*)(Am + (32 * I + r) * 72 + 16 * ks + 8 * hh), bf = *(const LAS bf16x8*)(Tm + (32 * J + r) * 72 + 16 * ks + 8 * hh);
              acc = __builtin_amdgcn_mfma_f32_32x32x16_bf16(af, bf, acc, 0, 0, 0); }
#pragma unroll
          for (int q = 0; q < 4; ++q)
#pragma unroll
              for (int i = 0; i < 4; ++i) Om[(32 * I + 8 * q + 4 * hh + i) * 72 + 32 * J + r] = (bf16_t)f2bf(acc[4 * q + i]); }
        __syncthreads();
        if (wave < 4) {
            const int I = (wave >> 1) & 1, J = wave & 1;
            f32x16 ax, an;
#pragma unroll
            for (int i = 0; i < 16; ++i) { ax[i] = 0.f; an[i] = 0.f; }
#pragma unroll
            for (int ks = 0; ks < 4; ++ks) { const bf16x8 wf = *(const LAS bf16x8*)(wT + (32 * I + r) * 72 + 16 * ks + 8 * hh), kdf_b = *(const LAS bf16x8*)(kdT + (32 * J + r) * 72 + 16 * ks + 8 * hh);
                ax = __builtin_amdgcn_mfma_f32_32x32x16_bf16(wf, kdf_b, ax, 0, 0, 0);
                const bf16x8 kdf_a = *(const LAS bf16x8*)(kdT + (32 * I + r) * 72 + 16 * ks + 8 * hh), uf = *(const LAS bf16x8*)(uT + (32 * J + r) * 72 + 16 * ks + 8 * hh);
                an = __builtin_amdgcn_mfma_f32_32x32x16_bf16(kdf_a, uf, an, 0, 0, 0); }
            bf16_t* xd = (bf16_t*)(mxt + MXT_GD_XD) + (size_t)uid * 4096 + (size_t)(I * 2 + J) * 1024;
#pragma unroll
            for (int s2 = 0; s2 < 2; ++s2) *(bf16x8*)(xd + (s2 * 64 + lane) * 8) = pack8(-ax[8 * s2], -ax[8 * s2 + 1], -ax[8 * s2 + 2], -ax[8 * s2 + 3], -ax[8 * s2 + 4], -ax[8 * s2 + 5], -ax[8 * s2 + 6], -ax[8 * s2 + 7]);
            float* nd = (float*)(mxb + MXB_GD_ND) + (size_t)uid * 4096 + (size_t)(I * 2 + J) * 1024;
#pragma unroll
            for (int q = 0; q < 4; ++q) *(f32x4*)(nd + (q * 64 + lane) * 4) = (f32x4){an[4 * q], an[4 * q + 1], an[4 * q + 2], an[4 * q + 3]};
        } else {
            const int I = (wave >> 1) & 1, tJ = wave & 1; const int t = 32 * tJ + r; const float gct = tb_gc[t];
            bf16x8 pf[2][2];
#pragma unroll
            for (int sI = 0; sI < 2; ++sI) { f32x16 ap;
#pragma unroll
                for (int i = 0; i < 16; ++i) ap[i] = 0.f;
#pragma unroll
                for (int ks = 0; ks < 4; ++ks) { const bf16x8 af = *(const LAS bf16x8*)(kb + (32 * sI + r) * 72 + 16 * ks + 8 * hh), bf = *(const LAS bf16x8*)(qb + t * 72 + 16 * ks + 8 * hh);
                    ap = __builtin_amdgcn_mfma_f32_32x32x16_bf16(af, bf, ap, 0, 0, 0); }
#pragma unroll
                for (int q = 0; q < 4; ++q) { const int s0 = 32 * sI + 8 * q + 4 * hh; const f32x4 gcs = *(const LAS f32x4*)(tb_gc + s0);
#pragma unroll
                    for (int i = 0; i < 4; ++i) ap[4 * q + i] = (s0 + i <= t) ? ap[4 * q + i] * __expf(gct - gcs[i]) : 0.f; }
#pragma unroll
                for (int s2 = 0; s2 < 2; ++s2) pf[sI][s2] = pack8(ap[8 * s2], ap[8 * s2 + 1], ap[8 * s2 + 2], ap[8 * s2 + 3], ap[8 * s2 + 4], ap[8 * s2 + 5], ap[8 * s2 + 6], ap[8 * s2 + 7]); }
            f32x16 aq, ao;
#pragma unroll
            for (int i = 0; i < 16; ++i) { aq[i] = 0.f; ao[i] = 0.f; }
#pragma unroll
            for (int sI = 0; sI < 2; ++sI)
#pragma unroll
                for (int s2 = 0; s2 < 2; ++s2) { const bf16x8 wf = ld_perm(wT + (32 * I + r) * 72 + 32 * sI + 16 * s2 + 4 * hh), uf = ld_perm(uT + (32 * I + r) * 72 + 32 * sI + 16 * s2 + 4 * hh);
                    aq = __builtin_amdgcn_mfma_f32_32x32x16_bf16(wf, pf[sI][s2], aq, 0, 0, 0); ao = __builtin_amdgcn_mfma_f32_32x32x16_bf16(uf, pf[sI][s2], ao, 0, 0, 0); }
            const float egt = __expf(gct);
#pragma unroll
            for (int q = 0; q < 4; ++q) { const int d0 = 32 * I + 8 * q + 4 * hh; const u32x2 qw = *(const LAS u32x2*)(qb + t * 72 + d0);
                aq[4 * q] = bflo(qw.x) * egt - aq[4 * q]; aq[4 * q + 1] = bfhi(qw.x) * egt - aq[4 * q + 1]; aq[4 * q + 2] = bflo(qw.y) * egt - aq[4 * q + 2]; aq[4 * q + 3] = bfhi(qw.y) * egt - aq[4 * q + 3]; }
            bf16_t* qd = (bf16_t*)(mxt + MXT_GD_QD) + (size_t)uid * 4096 + (size_t)(I * 2 + tJ) * 1024;
#pragma unroll
            for (int s2 = 0; s2 < 2; ++s2) *(bf16x8*)(qd + (s2 * 64 + lane) * 8) = pack8(aq[8 * s2], aq[8 * s2 + 1], aq[8 * s2 + 2], aq[8 * s2 + 3], aq[8 * s2 + 4], aq[8 * s2 + 5], aq[8 * s2 + 6], aq[8 * s2 + 7]);
            float* od = (float*)(mxb + MXB_GD_OD) + (size_t)uid * 4096 + (size_t)(I * 2 + tJ) * 1024;
#pragma unroll
            for (int q = 0; q < 4; ++q) *(f32x4*)(od + (q * 64 + lane) * 4) = (f32x4){ao[4 * q], ao[4 * q + 1], ao[4 * q + 2], ao[4 * q + 3]};
        }
    }
}

__device__ __forceinline__ void gdn_passB(unsigned char* mxb, unsigned char* mxt, unsigned char* mxs, int nB) {
    int tid_ = threadIdx.x; asm volatile("" : "+v"(tid_)); const int tid = tid_, lane = tid & 63, wave = __builtin_amdgcn_readfirstlane(tid >> 6);
    const float* GL = (const float*)(mxs + MXS_GD_GL);
    if (wave >= 2) return;
    const int eJ = wave;
    for (int chain = blockIdx.x; chain < 64; chain += nB) {
        f32x16 S[2];
#pragma unroll
        for (int i = 0; i < 16; ++i) { S[0][i] = 0.f; S[1][i] = 0.f; }
        bf16x8 xn[2][2][2]; f32x4 nq[2][4]; float gln;
#define GDB_LOAD(c_) do { const size_t u_ = (size_t)chain * 64 + (c_); const bf16_t* xd_ = (const bf16_t*)(mxt + MXT_GD_XD) + u_ * 4096; const float* nd_ = (const float*)(mxb + MXB_GD_ND) + u_ * 4096; \
        _Pragma("unroll") for (int I = 0; I < 2; ++I) _Pragma("unroll") for (int J = 0; J < 2; ++J) _Pragma("unroll") for (int s2 = 0; s2 < 2; ++s2) xn[I][J][s2] = *(const bf16x8*)(xd_ + (size_t)(I * 2 + J) * 1024 + (s2 * 64 + lane) * 8); \
        _Pragma("unroll") for (int J = 0; J < 2; ++J) _Pragma("unroll") for (int q = 0; q < 4; ++q) nq[J][q] = *(const f32x4*)(nd_ + (size_t)(J * 2 + eJ) * 1024 + (q * 64 + lane) * 4); \
        gln = GL[u_]; } while (0)
        GDB_LOAD(0);
        for (int c = 0; c < 64; ++c) { const size_t uid = (size_t)chain * 64 + c;
            bf16x8 xf[2][2][2]; f32x16 nn[2]; const float gl = gln;
#pragma unroll
            for (int I = 0; I < 2; ++I)
#pragma unroll
                for (int J = 0; J < 2; ++J)
#pragma unroll
                    for (int s2 = 0; s2 < 2; ++s2) xf[I][J][s2] = xn[I][J][s2];
#pragma unroll
            for (int J = 0; J < 2; ++J)
#pragma unroll
                for (int q = 0; q < 4; ++q) { nn[J][4 * q] = nq[J][q][0]; nn[J][4 * q + 1] = nq[J][q][1]; nn[J][4 * q + 2] = nq[J][q][2]; nn[J][4 * q + 3] = nq[J][q][3]; }
            if (c + 1 < 64) GDB_LOAD(c + 1);
            bf16x8 sh[2][2], sl[2][2];
            bf16_t* sd = (bf16_t*)(mxt + MXT_GD_SD) + uid * 4096;
#pragma unroll
            for (int I = 0; I < 2; ++I)
#pragma unroll
                for (int s2 = 0; s2 < 2; ++s2) { float hi[8], lo[8];
#pragma unroll
                    for (int j = 0; j < 8; ++j) { const float v = S[I][8 * s2 + j]; hi[j] = bf2f((unsigned short)f2bf(v)); lo[j] = v - hi[j]; }
                    sh[I][s2] = pack8(hi[0], hi[1], hi[2], hi[3], hi[4], hi[5], hi[6], hi[7]); sl[I][s2] = pack8(lo[0], lo[1], lo[2], lo[3], lo[4], lo[5], lo[6], lo[7]);
                    *(bf16x8*)(sd + (size_t)(I * 2 + eJ) * 1024 + (s2 * 64 + lane) * 8) = sh[I][s2]; }
#pragma unroll
            for (int J = 0; J < 2; ++J) { f32x16 acc = nn[J];
#pragma unroll
                for (int I = 0; I < 2; ++I)
#pragma unroll
                    for (int s2 = 0; s2 < 2; ++s2) { acc = __builtin_amdgcn_mfma_f32_32x32x16_bf16(xf[I][J][s2], sh[I][s2], acc, 0, 0, 0); acc = __builtin_amdgcn_mfma_f32_32x32x16_bf16(xf[I][J][s2], sl[I][s2], acc, 0, 0, 0); }
                nn[J] = acc; }
#pragma unroll
            for (int J = 0; J < 2; ++J)
#pragma unroll
                for (int i = 0; i < 16; ++i) S[J][i] = gl * S[J][i] + nn[J][i];
        }
    }
}

__device__ __forceinline__ void gdn_passC(ArgsP a, int l, LAS unsigned char* lds, const bf16_t* proj, bf16_t* H, unsigned char* mxb, unsigned char* mxt, int G) {
    int tid_ = threadIdx.x; asm volatile("" : "+v"(tid_)); const int tid = tid_, lane = tid & 63, wave = __builtin_amdgcn_readfirstlane(tid >> 6), r = lane & 31, hh = lane >> 5;
    LAS bf16_t* ob = (LAS bf16_t*)(lds + wave * 8192);
    const float* gn = a->in[I_GNG] + l * 64;
    for (int wu = blockIdx.x * NWAVES + wave; wu < 8192; wu += G * NWAVES) {
        const int uid = wu >> 1, tJ = wu & 1; const int c = uid & 63, hd = (uid >> 6) & 7, b = uid >> 9; const size_t tok0 = (size_t)b * SEQ_ + (size_t)c * 64;
        const bf16_t* sd = (const bf16_t*)(mxt + MXT_GD_SD) + (size_t)uid * 4096; const bf16_t* qd = (const bf16_t*)(mxt + MXT_GD_QD) + (size_t)uid * 4096; const float* od = (const float*)(mxb + MXB_GD_OD) + (size_t)uid * 4096;
        f32x16 ao[2];
#pragma unroll
        for (int eI = 0; eI < 2; ++eI)
#pragma unroll
            for (int q = 0; q < 4; ++q) { const f32x4 v = *(const f32x4*)(od + (size_t)(eI * 2 + tJ) * 1024 + (q * 64 + lane) * 4); ao[eI][4 * q] = v[0]; ao[eI][4 * q + 1] = v[1]; ao[eI][4 * q + 2] = v[2]; ao[eI][4 * q + 3] = v[3]; }
#pragma unroll
        for (int dI = 0; dI < 2; ++dI)
#pragma unroll
            for (int s2 = 0; s2 < 2; ++s2) { const bf16x8 qf = *(const bf16x8*)(qd + (size_t)(dI * 2 + tJ) * 1024 + (s2 * 64 + lane) * 8);
#pragma unroll
                for (int eI = 0; eI < 2; ++eI) { const bf16x8 sf = *(const bf16x8*)(sd + (size_t)(dI * 2 + eI) * 1024 + (s2 * 64 + lane) * 8);
                    ao[eI] = __builtin_amdgcn_mfma_f32_32x32x16_bf16(sf, qf, ao[eI], 0, 0, 0); } }
        float sq = 0.f;
#pragma unroll
        for (int eI = 0; eI < 2; ++eI)
#pragma unroll
            for (int i = 0; i < 16; ++i) sq += ao[eI][i] * ao[eI][i];
        sq += __shfl_xor(sq, 32);
        const float rinv = rsqrtf(sq * (1.0f / 64.0f) + RMS_EPS);
        const size_t tok = tok0 + 32 * tJ + r;
#pragma unroll
        for (int eI = 0; eI < 2; ++eI)
#pragma unroll
            for (int q = 0; q < 4; ++q) { const int e0 = 32 * eI + 8 * q + 4 * hh; const f32x4 g4 = *(const f32x4*)(gn + e0); const u32x2 zw = *(const u32x2*)(proj + tok * NPROJ + PC_GDZ + hd * 64 + e0);
                u32x2 pw; pw.x = pg8::cvt_pk_bf16(ao[eI][4 * q] * rinv * g4[0] * silu_f(bflo(zw.x)), ao[eI][4 * q + 1] * rinv * g4[1] * silu_f(bfhi(zw.x)));
                pw.y = pg8::cvt_pk_bf16(ao[eI][4 * q + 2] * rinv * g4[2] * silu_f(bflo(zw.y)), ao[eI][4 * q + 3] * rinv * g4[3] * silu_f(bfhi(zw.y)));
                *(LAS u32x2*)(ob + r * 64 + e0) = pw; }
        LDS_WAIT(); asm volatile("" ::: "memory");
#pragma unroll
        for (int it = 0; it < 4; ++it) { const int row = it * 8 + (lane >> 3), c8 = (lane & 7) * 8;
            *(u32x4*)(H + (tok0 + 32 * tJ + row) * 2048 + 1536 + hd * 64 + c8) = *(const LAS u32x4*)(ob + row * 64 + c8); }
        LDS_WAIT(); asm volatile("" ::: "memory");
    }
}
constexpr int PPL = 12;
constexpr int NPH = 1 + PPL * DEPTH_;
#ifndef MK_N_LAUNCHES
#define MK_N_LAUNCHES 1
#endif
#ifndef PROBE_PH
#define PROBE_PH -2
#endif
#define REPS(k) ((PROBE_PH) == (k) ? 2 : 1)
#ifndef PG8_SP2
#define PG8_SP2 true
#endif
#ifndef PG8_ALIGN
#define PG8_ALIGN true
#endif
__global__ void __launch_bounds__(NWAVES * 64, 2) fwd(Args a_unused) {
    ArgsP kargs = (ArgsP)__builtin_amdgcn_kernarg_segment_ptr();
#define FRESH(a) ArgsP a = kargs; asm volatile("" : "+s"(a))
    extern __shared__ __attribute__((aligned(16))) unsigned char lds_raw[];
    LAS unsigned char* lds = (LAS unsigned char*)lds_raw;
    const int tid = threadIdx.x, G = gridDim.x;
    const int vcu = (G % 8 == 0) ? ((int)blockIdx.x % 8) * (G / 8) + (int)blockIdx.x / 8 : (int)blockIdx.x;
    for (int u = tid; u < (LDS_BYTES - MISC_OFF) / 4; u += NWAVES * 64) ((LAS unsigned*)(lds + MISC_OFF))[u] = 0u;
    __syncthreads();
    const int lo = kargs->ph_lo, hi = kargs->ph_hi;
    unsigned* barw = (unsigned*)(kargs->ws + WS_CTL) + CW_BAR + kargs->li * XCD_BAR_WORDS;
    if (hi - lo > 1) (void)xcd_barrier_post(barw, (volatile LAS unsigned*)(lds + LDS_BYTES - 16));
#define IN(k) (lo <= (k) && (k) < hi)
#define SEAM(k) do { if (IN(k) && IN((k) + 1)) { FRESH(ab_); XcdBarrier bb_; bb_.bar = (unsigned*)(ab_->ws + WS_CTL) + CW_BAR + ab_->li * XCD_BAR_WORDS; bb_.x = xb_xcc_id(); bb_.st = (volatile LAS unsigned*)(lds + LDS_BYTES - 16); xcd_barrier(bb_); } } while (0)
    if (IN(0)) for (int rep = 0; rep < REPS(-1); ++rep) { FRESH(a); p0_convert(a, lds, G); }
    SEAM(0);

    for (int l = 0; l < DEPTH_; ++l) {
        const int pb = 1 + PPL * l;
#define WSP(T_, off) ((T_*)(a->ws + (off)))
#define WL_(off) (a->ws + WS_W + (size_t)l * WL_STRIDE + (off))
        if (IN(pb + 0)) for (int rep = 0; rep < REPS(0); ++rep) { FRESH(a);
            pg8::Gemm g{WSP(const bf16_t, WS_XB), (const bf16_t*)WL_(WL_IN), 1024, 1024, 1024}; pg8::StaticOrder S; S.init(T_, NINP, G, (int)blockIdx.x);
            pg8::EpiProj E{WSP(bf16_t, WS_OV + OV_PROJ), WSP(float, WS_GSM), WSP(bf16_t, WS_OV + OV_GD)};
            pg8::gemm_phase<pg8::EpiProj, pg8::StaticOrder, PG8_ALIGN, PG8_SP2>(lds, g, S, E);
        }
        SEAM(pb + 0);

        if (IN(pb + 1)) for (int rep = 0; rep < REPS(1); ++rep) { FRESH(a);
            const bf16_t* proj = WSP(const bf16_t, WS_OV + OV_PROJ); bf16_t* Hb = WSP(bf16_t, WS_OV + OV_H); const float* gsm = WSP(const float, WS_GSM);
            for (int r2 = 0; r2 < REPS(11); ++r2) for (int u = (int)blockIdx.x; u < 256; u += G) lru_fast<0>(a, l, u >> 5, (u >> 2) & 7, (u & 3) * 16, (u & 3) * 16 + 16, lds, proj, Hb, a->ws + WS_MXS);
            for (int r2 = 0; r2 < REPS(12); ++r2) mlstm_passA(a, l, lds, proj, gsm, a->ws + WS_V, a->ws + WS_MXS, G);
            __syncthreads();
            for (int r2 = 0; r2 < REPS(13); ++r2) gdn_passA1(a, l, lds, proj, gsm, a->ws + WS_V, G);
        }
        SEAM(pb + 1);
        if (IN(pb + 2)) for (int rep = 0; rep < REPS(2); ++rep) { FRESH(a);
            const bf16_t* proj = WSP(const bf16_t, WS_OV + OV_PROJ); const float* gsm = WSP(const float, WS_GSM);
            for (int r2 = 0; r2 < REPS(21); ++r2) lru_carry(a->ws + WS_MXS, G); for (int r2 = 0; r2 < REPS(22); ++r2) mlstm_passB(a->ws + WS_V, a->ws + WS_MXS, G); for (int r2 = 0; r2 < REPS(23); ++r2) gdn_passA2(a, l, lds, proj, gsm, a->ws + WS_V, a->ws + WS_MXS, a->ws + WS_MXS, G); }
        SEAM(pb + 2);
        if (IN(pb + 3)) for (int rep = 0; rep < REPS(3); ++rep) { FRESH(a);
            const bf16_t* proj = WSP(const bf16_t, WS_OV + OV_PROJ); bf16_t* Hb = WSP(bf16_t, WS_OV + OV_H); const float* gsm = WSP(const float, WS_GSM);
            const int nB = G >= 128 ? 64 : 0;
            if ((int)blockIdx.x < nB) { for (int r2 = 0; r2 < REPS(31); ++r2) gdn_passB(a->ws + WS_V, a->ws + WS_MXS, a->ws + WS_MXS, nB); }
            else {
                if (nB == 0) { gdn_passB(a->ws + WS_V, a->ws + WS_MXS, a->ws + WS_MXS, G); __syncthreads(); }
                for (int r2 = 0; r2 < REPS(32); ++r2) lru_apply(a, proj, Hb, a->ws + WS_MXS, (int)blockIdx.x - nB, G - nB);
                for (int r2 = 0; r2 < REPS(33); ++r2) mlstm_passC(a, l, lds, proj, gsm, Hb, a->ws + WS_V, a->ws + WS_MXS, (int)blockIdx.x - nB, G - nB);
            }
        }
        SEAM(pb + 3);
        if (IN(pb + 4)) for (int rep = 0; rep < REPS(4); ++rep) { FRESH(a); gdn_passC(a, l, lds, WSP(const bf16_t, WS_OV + OV_PROJ), WSP(bf16_t, WS_OV + OV_H), a->ws + WS_V, a->ws + WS_MXS, G); }
        SEAM(pb + 4);

        if (IN(pb + 5)) for (int rep = 0; rep < REPS(5); ++rep) { FRESH(a);
            pg8::StaticOrder S; S.init(T_, 1024, G, (int)blockIdx.x);
            pg8::Gemm g{WSP(const bf16_t, WS_OV + OV_H), (const bf16_t*)WL_(WL_BR), 2048, 2048, 2048}; pg8::EpiMergeF E{WSP(const bf16_t, WS_OV + OV_GD), WSP(bf16_t, WS_MB)};
            pg8::gemm_phase<pg8::EpiMergeF, pg8::StaticOrder, PG8_ALIGN, PG8_SP2>(lds, g, S, E);
        }
        SEAM(pb + 5);

        if (IN(pb + 6)) for (int rep = 0; rep < REPS(6); ++rep) { FRESH(a);
            pg8::Gemm g{WSP(const bf16_t, WS_MB), (const bf16_t*)WL_(WL_OUT), 1024, 1024, 1024}; pg8::StaticOrder S; S.init(T_, 1024, G, (int)blockIdx.x);
            pg8::EpiWout E{l == 0 ? a->in[I_X] : (const float*)nullptr, WSP(const bf16_t, WS_XB), WSP(bf16_t, WS_V)};
            pg8::gemm_phase<pg8::EpiWout, pg8::StaticOrder, PG8_ALIGN, PG8_SP2>(lds, g, S, E);
        }
        SEAM(pb + 6);

        if (IN(pb + 7)) for (int rep = 0; rep < REPS(7); ++rep) { FRESH(a); p5_ln1_router(a, l, lds, G); }
        SEAM(pb + 7);

        if (IN(pb + 8)) for (int rep = 0; rep < REPS(8); ++rep) { FRESH(a); p6_slots(a, lds, G); }
        SEAM(pb + 8);

        if (IN(pb + 9)) for (int rep = 0; rep < REPS(9); ++rep) { FRESH(a);
            const int nb = moe_table(a, lds);
            pg8::MoeOrder S{8, G, vcu, nb * 8, (const LAS int*)(lds + MISC_OFF + 256)};
            pg8::Gemm g{WSP(const bf16_t, WS_OV + OV_XS), (const bf16_t*)WL_(WL_W1), 1024, 1024, 1024};
            pg8::EpiMoe1 E{WSP(bf16_t, WS_OV + OV_ACT), a->in[I_B1] + (size_t)l * NE * 2048};
            pg8::gemm_phase<pg8::EpiMoe1, pg8::MoeOrder, PG8_ALIGN, PG8_SP2>(lds, g, S, E);
        }
        SEAM(pb + 9);

        if (IN(pb + 10)) for (int rep = 0; rep < REPS(10); ++rep) { FRESH(a);
            const int nb = moe_table(a, lds);
            pg8::MoeOrder S{4, G, vcu, nb * 4, (const LAS int*)(lds + MISC_OFF + 256)};
            pg8::Gemm g{WSP(const bf16_t, WS_OV + OV_ACT), (const bf16_t*)WL_(WL_W2), 1024, 1024, 1024};
            pg8::EpiMoe2 E{WSP(bf16_t, WS_OV + OV_YS), a->in[I_B2] + (size_t)l * NE * 1024, WSP(const float, WS_WBUF)};
            pg8::gemm_phase<pg8::EpiMoe2, pg8::MoeOrder, PG8_ALIGN, PG8_SP2>(lds, g, S, E);
        }
        SEAM(pb + 10);

        if (IN(pb + 11)) for (int rep = 0; rep < REPS(11); ++rep) { FRESH(a); p9_combine_ln2(a, l, (l == DEPTH_ - 1) ? a->out : (float*)nullptr, G); }
        SEAM(pb + 11);
    }
#undef WSP
#undef WL_
#undef IN
#undef SEAM
}

extern "C" void kernel_launch(void* const* d_in, const int* in_sizes, int n_in, void* d_out, int out_size, void* d_ws, size_t ws_size, hipStream_t stream) {
    static int grid = 0;
    if (grid == 0) {
        if (n_in != 30 || in_sizes[0] != T_ * D_ || out_size != T_ * D_ || ws_size < WS_END) {
            fprintf(stderr, "kernel_launch: unexpected shapes: n_in %d in0 %d out %d ws %zu (need %zu); nothing launched\n", n_in, n_in > 0 ? in_sizes[0] : -1, out_size, ws_size, (size_t)WS_END); grid = -1; return; }
        int dev = 0, cus = 0;
        if (hipGetDevice(&dev) != hipSuccess || hipDeviceGetAttribute(&cus, hipDeviceAttributeMultiprocessorCount, dev) != hipSuccess) { grid = -1; return; }
        if (hipFuncSetAttribute((const void*)fwd, hipFuncAttributeMaxDynamicSharedMemorySize, LDS_BYTES) != hipSuccess) { fprintf(stderr, "kernel_launch: hipFuncSetAttribute failed\n"); grid = -1; return; }
        int per_cu = 0; (void)hipOccupancyMaxActiveBlocksPerMultiprocessor(&per_cu, (const void*)fwd, NWAVES * 64, LDS_BYTES); (void)hipGetLastError();
        if (per_cu < 1) fprintf(stderr, "kernel_launch: occupancy query reports %d blocks per CU\n", per_cu);
        grid = cus;
    }
    if (grid < 0) return;
    (void)hipMemsetAsync((char*)d_ws + WS_CTL, 0, CTL_ZERO_BYTES, stream);
    Args a{};
    for (int i = 0; i < 30; ++i) a.in[i] = (const float*)d_in[i];
    a.out = (float*)d_out; a.ws = (unsigned char*)d_ws;
    constexpr int NL = MK_N_LAUNCHES; static_assert(NL == NPH || NL <= 4, "barrier regions");
    for (int li = 0; li < NL; ++li) {
        a.ph_lo = (int)((long)NPH * li / NL); a.ph_hi = (int)((long)NPH * (li + 1) / NL); a.li = (NL <= 4) ? li : 0;
        hipLaunchKernelGGL(fwd, dim3(grid), dim3(NWAVES * 64), LDS_BYTES, stream, a);
        const hipError_t le = hipPeekAtLastError();
        if (le != hipSuccess) { fprintf(stderr, "kernel_launch: launch %d failed: %s\n", li, hipGetErrorName(le)); break; }
    }
}
```

```cpp
#include <hip/hip_runtime.h>
#include <cstdio>
#include <cstdint>

#define LAS __attribute__((address_space(3)))
#define GAS __attribute__((address_space(1)))
typedef unsigned short bf16_t;
typedef short bf16x8 __attribute__((ext_vector_type(8)));
typedef float f32x4 __attribute__((ext_vector_type(4)));
typedef float f32x2 __attribute__((ext_vector_type(2)));
typedef unsigned u32x4 __attribute__((ext_vector_type(4)));
typedef unsigned u32x2 __attribute__((ext_vector_type(2)));

constexpr int T_ = 32768, D_ = 1024, SEQ_ = 4096, NBATCH = 8, DEPTH_ = 2;
constexpr int DIN = 8728, NPROJ = 5632, NINP = 8960;
constexpr int NE = 32, DFF = 1024;
constexpr int PMAX = 139264;
constexpr int NCHUNK = 256, CHTOK = 128;
constexpr float DN_ALPHA = 1.41421356237309515f;
constexpr float LN_EPS = 1e-5f, RMS_EPS = 1e-6f;
constexpr float F8_SX = 16.0f, F8_SW1 = 128.0f, F8_SA = 8.0f, F8_SW2 = 256.0f;
constexpr int PC_LRUX = 0, PC_LRUY = 1024, PC_MLQ = 2048, PC_MLK = 2304, PC_MLV = 2560, PC_MLO = 3072, PC_GDQ = 3584, PC_GDK = 4096, PC_GDV = 4608, PC_GDZ = 5120, PC_GATE = 5632;

constexpr size_t MiB = 1u << 20;
constexpr size_t WS_CTL = 0, CTL_ZERO_BYTES = 64 * 1024;
constexpr size_t WS_HIST = 256 * 1024;
constexpr size_t WS_META = 320 * 1024;
constexpr size_t WS_RWB = 384 * 1024;
constexpr size_t WS_W = 1 * MiB;
constexpr size_t WL_IN = 0, WL_BR = 18 * MiB, WL_OUT = 22 * MiB, WL_W1 = 24 * MiB, WL_W2 = 152 * MiB, WL_G = 216 * MiB, WL_STRIDE = 217 * MiB;
constexpr size_t WS_XB = 436 * MiB;
constexpr size_t WS_GSM = 501 * MiB;
constexpr size_t WS_MB = 505 * MiB;
constexpr size_t WS_V = 569 * MiB;
constexpr size_t WS_X1 = 697 * MiB;
constexpr size_t WS_X1B = 825 * MiB;
constexpr size_t WS_X2 = 890 * MiB;
constexpr size_t WS_TKE = 1018 * MiB;
constexpr size_t WS_TKW = WS_TKE + 512 * 1024;
constexpr size_t WS_SLOT = 1019 * MiB;
constexpr size_t WS_WBUF = 1020 * MiB;
constexpr size_t WS_TOKB = 1021 * MiB;
constexpr size_t WS_OV = 1024 * MiB;
constexpr size_t OV_PROJ = 0, OV_GD = 352 * MiB, OV_H = 544 * MiB;
constexpr size_t OV_XS = 0, OV_ACT = 272 * MiB, OV_YS = 544 * MiB;
constexpr size_t WS_MXS = WS_OV + 816 * MiB;
constexpr size_t WS_END = WS_MXS + 104 * MiB;

constexpr int CW_BAR = 1024;

constexpr int RING_BYTES = 131072;
constexpr int MISC_OFF = RING_BYTES;
constexpr int GTAB_OFF = MISC_OFF + 4096;
constexpr int LDS_BYTES = 163840;
constexpr int NWAVES = 8;

#define LDS_WAIT() asm volatile("s_waitcnt lgkmcnt(0)" ::: "memory")
#define VM_WAIT() asm volatile("s_waitcnt vmcnt(0)" ::: "memory")

__device__ __forceinline__ unsigned f2bf(float f) { unsigned u = __builtin_bit_cast(unsigned, f); return (u + 0x7fffu + ((u >> 16) & 1u)) >> 16; }
__device__ __forceinline__ unsigned pk2(float lo, float hi) { return f2bf(lo) | (f2bf(hi) << 16); }
__device__ __forceinline__ float bf2f(unsigned short b) { return __builtin_bit_cast(float, (unsigned)b << 16); }
__device__ __forceinline__ float bflo(unsigned w) { return __builtin_bit_cast(float, w << 16); }
__device__ __forceinline__ float bfhi(unsigned w) { return __builtin_bit_cast(float, w & 0xffff0000u); }
__device__ __forceinline__ unsigned pk_fp8x4(float a, float b, float c, float d) { int p = __builtin_amdgcn_cvt_pk_fp8_f32(a, b, 0, false); p = __builtin_amdgcn_cvt_pk_fp8_f32(c, d, p, true); return (unsigned)p; }
__device__ __forceinline__ float wave_sum(float v) {
#pragma unroll
    for (int o = 1; o < 64; o <<= 1) v += __shfl_xor(v, o);
    return v;
}
__device__ __forceinline__ float wave_max(float v) {
#pragma unroll
    for (int o = 1; o < 64; o <<= 1) v = fmaxf(v, __shfl_xor(v, o));
    return v;
}
__device__ __forceinline__ float sigmoid_f(float x) { return __builtin_amdgcn_rcpf(1.f + __expf(-x)); }
__device__ __forceinline__ float silu_f(float x) { return x * __builtin_amdgcn_rcpf(1.f + __expf(-x)); }
__device__ __forceinline__ float neg_expm1_f(float t) {
    const float p = -t * (1.f + t * 0.5f * (1.f + t * (1.f / 3.f) * (1.f + t * 0.25f * (1.f + t * 0.2f * (1.f + t * (1.f / 6.f) * (1.f + t * (1.f / 7.f)))))));
    return t > -0.3f ? p : 1.f - __expf(t);
}
__device__ __forceinline__ float log1p_f(float e) { return e < 0.01f ? e * (1.f - e * (0.5f - e * ((1.f / 3.f) - 0.25f * e))) : __logf(1.f + e); }
__device__ __forceinline__ float softplus_f(float x) { return fmaxf(x, 0.f) + log1p_f(__expf(-fabsf(x))); }
__device__ __forceinline__ float gelu_tanh_f(float x) { const float u = 0.7978845608028654f * (x + 0.044715f * x * x * x); return x * __builtin_amdgcn_rcpf(1.f + __expf(-2.f * u)); }
namespace pg8 {
#define PG8_LAS __attribute__((address_space(3)))
constexpr int BM = 256, BK = 64, HALF = 128, HTB = HALF * BK * 2  , STAGE_BYTES = 8 * HTB, NXCD = 8, WGM = 8;

__host__ __device__ __forceinline__ int lds_byte(int r, int c) { const int st = (r >> 4) * 2 + (c >> 5), rr = r & 15, cc = c & 31, ob = rr * 64 + cc * 2; return st * 1024 + (ob ^ (((ob >> 9) & 1) << 5)); }
__host__ __device__ __forceinline__ void stage_rc(int b, int& R, int& C) { const int st = b / 1024, sb = b % 1024, swz = sb ^ (((sb >> 9) & 1) << 5); R = (st >> 1) * 16 + swz / 64; C = (st & 1) * 32 + (swz % 64) / 2; }
__host__ __device__ __forceinline__ int perm32(int rho) { const int n = rho >> 4, i = rho & 15; return 8 * (i >> 2) + 4 * n + (i & 3); }

struct Unit { int pm, pn; };
struct Gemm { const bf16_t* A; const bf16_t* Bt; int lda, ldb, K; };

struct StaticOrder {
    int nM, nN, nwg, G, c;
    __host__ __device__ void init(int M, int N, int G_, int c_) { nM = M / BM; nN = N / BM; nwg = nM * nN; G = G_; c = c_; }
    __host__ __device__ bool next(int i, Unit& u) const {
        const long L = (long)i * G + c; if (L >= nwg) return false;
        int wgid = (int)L; { const int q = nwg / NXCD, r = nwg % NXCD, xcd = wgid % NXCD, off = wgid / NXCD; wgid = (xcd < r ? xcd * (q + 1) : r * (q + 1) + (xcd - r) * q) + off; }
        const int nig = WGM * nN, gid = wgid / nig, fm = gid * WGM, gsz = (nM - fm) < WGM ? (nM - fm) : WGM;
        u.pm = fm + ((wgid % nig) % gsz); u.pn = (wgid % nig) / gsz; return true;
    }
    __device__ __forceinline__ void a_ready(const Unit&) const {}
    __device__ __forceinline__ void done(const Unit&) const {}
};

__device__ __forceinline__ unsigned cvt_pk_bf16(float lo, float hi) { unsigned r; asm volatile("v_cvt_pk_bf16_f32 %0, %1, %2" : "=v"(r) : "v"(lo), "v"(hi)); return r; }

template <class Epi, class Sched, bool ALIGN_EPI = false, bool SP2 = false, bool GATHER = false>
__device__ __forceinline__ void gemm_phase(PG8_LAS unsigned char* lds, const Gemm g, const Sched& S, const Epi& E, const PG8_LAS int* gtab = nullptr) {
    int tid_ = threadIdx.x; asm volatile("" : "+v"(tid_));
    const int tid = tid_, wid = __builtin_amdgcn_readfirstlane(tid >> 6), lane = tid & 63, wr = wid >> 2, wc = wid & 3, fr = lane & 15, fq = lane >> 4;
    const int K = g.K, nt = K / BK;
    unsigned voffA[2], voffB[2];
#pragma unroll
    for (int i = 0; i < 2; ++i) { int R, C; stage_rc(tid * 16 + i * 8192, R, C); const int Rb = Epi::PERM ? ((R & ~31) + perm32(R & 31)) : R;
        voffA[i] = (unsigned)(R * g.lda + C) * 2u; voffB[i] = (unsigned)(Rb * g.ldb + C) * 2u; }
    const size_t kstep = (size_t)(BK * 2);
    const size_t hstepA = (size_t)HALF * g.lda * 2, hstepB = (size_t)HALF * g.ldb * 2;
    const size_t tstepA = 2 * hstepA, tstepB = 2 * hstepB;
    const unsigned ldsw = (unsigned)wid * 1024u;
    const int aoff = lds_byte(wr * 64 + fr, fq * 8), boff = lds_byte(wc * 32 + fr, fq * 8);
    int gR0 = 0, gC0 = 0; if constexpr (GATHER) { stage_rc(tid * 16, gR0, gC0); }
#define PG8_STAGE_A(bufoff, aptr, koff, slot, h) do { if constexpr (GATHER) { _Pragma("unroll") for (int _i = 0; _i < 2; ++_i) { const unsigned _o = ((slot) == ui) ? gvo[2 * (h) + _i] : nvo[2 * (h) + _i]; \
            __builtin_amdgcn_global_load_lds((const unsigned*)((const char*)g.A + _o + (koff)), (PG8_LAS unsigned*)(lds + (bufoff) + ldsw + _i * 8192), 16, 0, 0); } } \
        else { PG8_STAGE(bufoff, aptr, voffA); } } while (0)
#define PG8_GLOAD(dst, s_) do { _Pragma("unroll") for (int _j = 0; _j < 4; ++_j) dst[_j] = (unsigned)gtab[(s_) * 256 + gR0 + 64 * _j] * (unsigned)(g.lda * 2) + (unsigned)(gC0 * 2); } while (0)
#define PG8_SA(b, h) (((b) * 2 + (h)) * HTB)
#define PG8_SB(b, h) ((4 + (b) * 2 + (h)) * HTB)
#define PG8_STAGE(bufoff, gbase, voff) do { _Pragma("unroll") for (int _i = 0; _i < 2; ++_i) \
        __builtin_amdgcn_global_load_lds((const unsigned*)((const char*)(gbase) + (voff)[_i]), (PG8_LAS unsigned*)(lds + (bufoff) + ldsw + _i * 8192), 16, 0, 0); } while (0)
#define PG8_LDA(dst, b, h) do { _Pragma("unroll") for (int m = 0; m < 4; ++m) _Pragma("unroll") for (int k = 0; k < 2; ++k) dst[m][k] = *(const PG8_LAS bf16x8*)(lds + PG8_SA(b, h) + aoff + m * 2048 + k * 1024); } while (0)
#define PG8_LDB(dst, b, h) do { _Pragma("unroll") for (int n = 0; n < 2; ++n) _Pragma("unroll") for (int k = 0; k < 2; ++k) dst[n][k] = *(const PG8_LAS bf16x8*)(lds + PG8_SB(b, h) + boff + n * 2048 + k * 1024); } while (0)
#define PG8_MMA(ai, bj, At, Bt) do { __builtin_amdgcn_s_setprio(1); _Pragma("unroll") for (int m = 0; m < 4; ++m) _Pragma("unroll") for (int n = 0; n < 2; ++n) _Pragma("unroll") for (int k = 0; k < 2; ++k) \
        acc[ai][bj][m][n] = __builtin_amdgcn_mfma_f32_16x16x32_bf16(Bt[n][k], At[m][k], acc[ai][bj][m][n], 0, 0, 0); __builtin_amdgcn_s_setprio(0); } while (0)
#define PG8_WAIT_V(n) asm volatile("s_waitcnt vmcnt(" #n ")" ::: "memory")
#define PG8_WAIT_L(n) asm volatile("s_waitcnt lgkmcnt(" #n ")" ::: "memory")
#define PG8_BAR __builtin_amdgcn_s_barrier()
#define PG8_SCHED __builtin_amdgcn_sched_barrier(0)
    Unit cur, nxt; int ui = 0;
    if (!S.next(0, cur)) return;
    unsigned gvo[4] = {0u, 0u, 0u, 0u}, nvo[4] = {0u, 0u, 0u, 0u};
    if constexpr (GATHER) { PG8_GLOAD(gvo, 0); }
    f32x4 acc[2][2][4][2];
#pragma unroll
    for (int a = 0; a < 2; ++a)
#pragma unroll
        for (int b = 0; b < 2; ++b)
#pragma unroll
            for (int m = 0; m < 4; ++m)
#pragma unroll
                for (int n = 0; n < 2; ++n) acc[a][b][m][n] = (f32x4){0.f, 0.f, 0.f, 0.f};
    bf16x8 At[4][2], B0[2][2], B1[2][2];
    const char* cA = (const char*)g.A + (size_t)cur.pm * tstepA; const char* cB = (const char*)g.Bt + (size_t)cur.pn * tstepB;
    S.a_ready(cur);
    if constexpr (SP2) {
        PG8_STAGE(PG8_SB(0, 0), cB, voffB); PG8_STAGE(PG8_SB(0, 1), cB + hstepB, voffB); PG8_STAGE_A(PG8_SA(0, 0), cA, 0, 0, 0); PG8_STAGE_A(PG8_SA(0, 1), cA + hstepA, 0, 0, 1);
        if (wr == 1) PG8_BAR;
        PG8_WAIT_V(2); PG8_BAR;
        PG8_STAGE(PG8_SB(1, 0), cB + kstep, voffB); PG8_STAGE_A(PG8_SA(1, 0), cA + kstep, kstep, 0, 0); PG8_STAGE(PG8_SB(1, 1), cB + hstepB + kstep, voffB);
        PG8_WAIT_V(6); PG8_BAR;
    } else {
        PG8_STAGE(PG8_SB(0, 0), cB, voffB); PG8_STAGE_A(PG8_SA(0, 0), cA, 0, 0, 0); PG8_STAGE(PG8_SB(0, 1), cB + hstepB, voffB); PG8_STAGE_A(PG8_SA(0, 1), cA + hstepA, 0, 0, 1);
        if (wr == 1) PG8_BAR;
        PG8_WAIT_V(4); PG8_BAR;
        PG8_STAGE(PG8_SB(1, 0), cB + kstep, voffB); PG8_STAGE_A(PG8_SA(1, 0), cA + kstep, kstep, 0, 0); PG8_STAGE(PG8_SB(1, 1), cB + hstepB + kstep, voffB);
        PG8_WAIT_V(6); PG8_BAR;
    }
    for (;;) {
        const bool has_next = S.next(ui + 1, nxt);
        if constexpr (GATHER) { if (has_next) { PG8_GLOAD(nvo, ui + 1); } else { _Pragma("unroll") for (int _j = 0; _j < 4; ++_j) nvo[_j] = gvo[_j]; } }
        const char* nA = has_next ? (const char*)g.A + (size_t)nxt.pm * tstepA : cA; const char* nB = has_next ? (const char*)g.Bt + (size_t)nxt.pn * tstepB : cB;
        int t = 0;
        for (int seg = 0; seg < (Epi::HAS_MID ? 3 : 1); ++seg) {
        const int tend = Epi::HAS_MID ? (seg == 0 ? Epi::MID0 : (seg == 1 ? Epi::MID1 : nt)) : nt;
        for (; t < tend; t += 2) {
            const bool last = (t == nt - 2);
            const char* a1 = cA + (size_t)(t + 1) * kstep;
            const char* a2 = last ? nA : cA + (size_t)(t + 2) * kstep; const char* b2 = last ? nB : cB + (size_t)(t + 2) * kstep;
            const char* a3 = a2 + kstep; const char* b3 = b2 + kstep;
            const size_t ka1 = (size_t)(t + 1) * kstep, ka2 = last ? 0 : (size_t)(t + 2) * kstep, ka3 = ka2 + kstep; const int sl2 = (last && has_next) ? ui + 1 : ui;
            if (last && has_next) S.a_ready(nxt);
            if constexpr (SP2) {
            PG8_LDB(B0, 0, 0); PG8_LDB(B1, 0, 1); PG8_SCHED; PG8_LDA(At, 0, 0); PG8_STAGE_A(PG8_SA(1, 1), a1 + hstepA, ka1, ui, 1);
            PG8_WAIT_V(8); PG8_WAIT_L(0); PG8_BAR; PG8_MMA(0, 0, At, B0); PG8_MMA(0, 1, At, B1); PG8_BAR; PG8_SCHED;
            PG8_LDA(At, 0, 1); PG8_STAGE(PG8_SB(0, 0), b2, voffB); PG8_STAGE(PG8_SB(0, 1), b2 + hstepB, voffB); PG8_STAGE_A(PG8_SA(0, 0), a2, ka2, sl2, 0);
            PG8_WAIT_V(8); PG8_WAIT_L(0); PG8_BAR; PG8_MMA(1, 0, At, B0); PG8_MMA(1, 1, At, B1); PG8_BAR; PG8_SCHED;
            PG8_LDB(B0, 1, 0); PG8_LDB(B1, 1, 1); PG8_SCHED; PG8_LDA(At, 1, 0); PG8_STAGE_A(PG8_SA(0, 1), a2 + hstepA, ka2, sl2, 1);
            PG8_WAIT_V(8); PG8_WAIT_L(0); PG8_BAR; PG8_MMA(0, 0, At, B0); PG8_MMA(0, 1, At, B1); PG8_BAR; PG8_SCHED;
            PG8_LDA(At, 1, 1); PG8_STAGE(PG8_SB(1, 0), b3, voffB); PG8_STAGE(PG8_SB(1, 1), b3 + hstepB, voffB); PG8_STAGE_A(PG8_SA(1, 0), a3, ka3, sl2, 0);
            PG8_WAIT_V(8); PG8_WAIT_L(0); PG8_BAR; PG8_MMA(1, 0, At, B0); PG8_MMA(1, 1, At, B1); PG8_BAR; PG8_SCHED;
            } else {
            PG8_LDB(B0, 0, 0); PG8_SCHED; PG8_LDA(At, 0, 0); PG8_STAGE_A(PG8_SA(1, 1), a1 + hstepA, ka1, ui, 1);
            PG8_WAIT_L(8); PG8_BAR; PG8_WAIT_L(0); PG8_MMA(0, 0, At, B0); PG8_BAR; PG8_SCHED;
            PG8_LDB(B1, 0, 1); PG8_STAGE(PG8_SB(0, 0), b2, voffB);
            PG8_BAR; PG8_WAIT_L(0); PG8_MMA(0, 1, At, B1); PG8_BAR;
            PG8_LDA(At, 0, 1); PG8_STAGE_A(PG8_SA(0, 0), a2, ka2, sl2, 0);
            PG8_BAR; PG8_WAIT_L(0); PG8_MMA(1, 0, At, B0); PG8_BAR; PG8_SCHED;
            PG8_STAGE(PG8_SB(0, 1), b2 + hstepB, voffB);
            PG8_WAIT_V(6); PG8_BAR; PG8_MMA(1, 1, At, B1); PG8_BAR;
            PG8_LDB(B0, 1, 0); PG8_SCHED; PG8_LDA(At, 1, 0); PG8_STAGE_A(PG8_SA(0, 1), a2 + hstepA, ka2, sl2, 1);
            PG8_WAIT_L(8); PG8_BAR; PG8_WAIT_L(0); PG8_MMA(0, 0, At, B0); PG8_BAR; PG8_SCHED;
            PG8_LDB(B1, 1, 1); PG8_STAGE(PG8_SB(1, 0), b3, voffB);
            PG8_BAR; PG8_WAIT_L(0); PG8_MMA(0, 1, At, B1); PG8_BAR;
            PG8_LDA(At, 1, 1); PG8_STAGE_A(PG8_SA(1, 0), a3, ka3, sl2, 0);
            PG8_BAR; PG8_WAIT_L(0); PG8_MMA(1, 0, At, B0); PG8_BAR; PG8_SCHED;
            PG8_STAGE(PG8_SB(1, 1), b3 + hstepB, voffB);
            PG8_WAIT_V(6); PG8_BAR; PG8_MMA(1, 1, At, B1); PG8_BAR;
            }
        }
        if constexpr (Epi::HAS_MID) { if (seg < 2) E.mid(acc, cur, wr, wc, fr, fq, seg); }
        }
        if constexpr (ALIGN_EPI) { if (wr == 0) PG8_BAR; }
        E(acc, cur, wr, wc, fr, fq); S.done(cur);
        if (!has_next) break;
#pragma unroll
        for (int a = 0; a < 2; ++a)
#pragma unroll
            for (int b = 0; b < 2; ++b)
#pragma unroll
                for (int m = 0; m < 4; ++m)
#pragma unroll
                    for (int n = 0; n < 2; ++n) acc[a][b][m][n] = (f32x4){0.f, 0.f, 0.f, 0.f};
        cur = nxt; cA = nA; cB = nB; ++ui;
        if constexpr (GATHER) { _Pragma("unroll") for (int _j = 0; _j < 4; ++_j) gvo[_j] = nvo[_j]; }
        if constexpr (ALIGN_EPI) { if (wr == 1) PG8_BAR; }
    }
    PG8_WAIT_V(0);
    if constexpr (!ALIGN_EPI) { if (wr == 0) PG8_BAR; }
    PG8_BAR;
#undef PG8_SA
#undef PG8_SB
#undef PG8_STAGE
#undef PG8_STAGE_A
#undef PG8_GLOAD
#undef PG8_LDA
#undef PG8_LDB
#undef PG8_MMA
#undef PG8_WAIT_V
#undef PG8_WAIT_L
#undef PG8_BAR
#undef PG8_SCHED
}
}
namespace pg8 {
typedef int i32x4v __attribute__((ext_vector_type(4)));
typedef int i32x8 __attribute__((ext_vector_type(8)));
struct Gemm8 { const unsigned char* A; const unsigned char* Bt; int lda, ldb, K; };
template <class Epi, class Sched, bool GATHER = false>
__device__ __forceinline__ void gemm_phase_f8(PG8_LAS unsigned char* lds, const Gemm8 g, const Sched& S, const Epi& E, const PG8_LAS int* gtab = nullptr) {
    constexpr bool ALIGN_EPI = true, SP2 = true;
    int tid_ = threadIdx.x; asm volatile("" : "+v"(tid_));
    const int tid = tid_, wid = __builtin_amdgcn_readfirstlane(tid >> 6), lane = tid & 63, wr = wid >> 2, wc = wid & 3, fr = lane & 15, fq = lane >> 4;
    int K_ = g.K; asm volatile("" : "+s"(K_));
    const int K = K_, nt = K / 128;
    unsigned voffA[2], voffB[2];
#pragma unroll
    for (int i = 0; i < 2; ++i) { int R, C; stage_rc(tid * 16 + i * 8192, R, C); const int Rb = Epi::PERM ? ((R & ~31) + perm32(R & 31)) : R;
        voffA[i] = (unsigned)(R * g.lda + C * 2); voffB[i] = (unsigned)(Rb * g.ldb + C * 2); }
    const size_t kstep = (size_t)(BK * 2);
    const size_t hstepA = (size_t)HALF * g.lda, hstepB = (size_t)HALF * g.ldb;
    const size_t tstepA = 2 * hstepA, tstepB = 2 * hstepB;
    const unsigned ldsw = (unsigned)wid * 1024u;
    const int aoff = lds_byte(wr * 64 + fr, fq * 16), boff = lds_byte(wc * 32 + fr, fq * 16);
    int gR0 = 0, gC0 = 0; if constexpr (GATHER) { stage_rc(tid * 16, gR0, gC0); }
#define PG8_STAGE_A(bufoff, aptr, koff, slot, h) do { if constexpr (GATHER) { _Pragma("unroll") for (int _i = 0; _i < 2; ++_i) { const unsigned _o = ((slot) == ui) ? gvo[2 * (h) + _i] : nvo[2 * (h) + _i]; \
            __builtin_amdgcn_global_load_lds((const unsigned*)((const char*)g.A + _o + (koff)), (PG8_LAS unsigned*)(lds + (bufoff) + ldsw + _i * 8192), 16, 0, 0); } } \
        else { PG8_STAGE(bufoff, aptr, voffA); } } while (0)
#define PG8_GLOAD(dst, s_) do { _Pragma("unroll") for (int _j = 0; _j < 4; ++_j) dst[_j] = (unsigned)gtab[(s_) * 256 + gR0 + 64 * _j] * (unsigned)(g.lda) + (unsigned)(gC0 * 2); } while (0)
#define PG8_SA(b, h) (((b) * 2 + (h)) * HTB)
#define PG8_SB(b, h) ((4 + (b) * 2 + (h)) * HTB)
#define PG8_STAGE(bufoff, gbase, voff) do { _Pragma("unroll") for (int _i = 0; _i < 2; ++_i) \
        __builtin_amdgcn_global_load_lds((const unsigned*)((const char*)(gbase) + (voff)[_i]), (PG8_LAS unsigned*)(lds + (bufoff) + ldsw + _i * 8192), 16, 0, 0); } while (0)
#define PG8_LDA(dst, b, h) do { _Pragma("unroll") for (int m = 0; m < 4; ++m) { const i32x4v lo_ = *(const PG8_LAS i32x4v*)(lds + PG8_SA(b, h) + aoff + m * 2048), hi_ = *(const PG8_LAS i32x4v*)(lds + PG8_SA(b, h) + aoff + m * 2048 + 16); dst[m] = __builtin_shufflevector(lo_, hi_, 0, 1, 2, 3, 4, 5, 6, 7); } } while (0)
#define PG8_LDB(dst, b, h) do { _Pragma("unroll") for (int n = 0; n < 2; ++n) { const i32x4v lo_ = *(const PG8_LAS i32x4v*)(lds + PG8_SB(b, h) + boff + n * 2048), hi_ = *(const PG8_LAS i32x4v*)(lds + PG8_SB(b, h) + boff + n * 2048 + 16); dst[n] = __builtin_shufflevector(lo_, hi_, 0, 1, 2, 3, 4, 5, 6, 7); } } while (0)
#define PG8_MMA(ai, bj, At, Bt) do { __builtin_amdgcn_s_setprio(1); _Pragma("unroll") for (int m = 0; m < 4; ++m) _Pragma("unroll") for (int n = 0; n < 2; ++n) \
        asm volatile("v_mfma_scale_f32_16x16x128_f8f6f4 %0, %1, %2, %0, %3, %3 op_sel_hi:[0,0,0]" : "+v"(acc[ai][bj][m][n]) : "v"(Bt[n]), "v"(At[m]), "v"(sc1)); __builtin_amdgcn_s_setprio(0); } while (0)
#define PG8_WAIT_V(n) asm volatile("s_waitcnt vmcnt(" #n ")" ::: "memory")
#define PG8_WAIT_L(n) asm volatile("s_waitcnt lgkmcnt(" #n ")" ::: "memory")
#define PG8_BAR __builtin_amdgcn_s_barrier()
#define PG8_SCHED __builtin_amdgcn_sched_barrier(0)
    Unit cur, nxt; int ui = 0;
    if (!S.next(0, cur)) return;
    unsigned gvo[4] = {0u, 0u, 0u, 0u}, nvo[4] = {0u, 0u, 0u, 0u};
    if constexpr (GATHER) { PG8_GLOAD(gvo, 0); }
    f32x4 acc[2][2][4][2];
#pragma unroll
    for (int a = 0; a < 2; ++a)
#pragma unroll
        for (int b = 0; b < 2; ++b)
#pragma unroll
            for (int m = 0; m < 4; ++m)
#pragma unroll
                for (int n = 0; n < 2; ++n) acc[a][b][m][n] = (f32x4){0.f, 0.f, 0.f, 0.f};
    i32x8 At[4], B0[2], B1[2];
    int sc1 = 0x7f7f7f7f; asm volatile("" : "+v"(sc1));
    const char* cA = (const char*)g.A + (size_t)cur.pm * tstepA; const char* cB = (const char*)g.Bt + (size_t)cur.pn * tstepB;
    S.a_ready(cur);
    if constexpr (SP2) {
        PG8_STAGE(PG8_SB(0, 0), cB, voffB); PG8_STAGE(PG8_SB(0, 1), cB + hstepB, voffB); PG8_STAGE_A(PG8_SA(0, 0), cA, 0, 0, 0); PG8_STAGE_A(PG8_SA(0, 1), cA + hstepA, 0, 0, 1);
        if (wr == 1) PG8_BAR;
        PG8_WAIT_V(2); PG8_BAR;
        PG8_STAGE(PG8_SB(1, 0), cB + kstep, voffB); PG8_STAGE_A(PG8_SA(1, 0), cA + kstep, kstep, 0, 0); PG8_STAGE(PG8_SB(1, 1), cB + hstepB + kstep, voffB);
        PG8_WAIT_V(6); PG8_BAR;
    } else {
        PG8_STAGE(PG8_SB(0, 0), cB, voffB); PG8_STAGE_A(PG8_SA(0, 0), cA, 0, 0, 0); PG8_STAGE(PG8_SB(0, 1), cB + hstepB, voffB); PG8_STAGE_A(PG8_SA(0, 1), cA + hstepA, 0, 0, 1);
        if (wr == 1) PG8_BAR;
        PG8_WAIT_V(4); PG8_BAR;
        PG8_STAGE(PG8_SB(1, 0), cB + kstep, voffB); PG8_STAGE_A(PG8_SA(1, 0), cA + kstep, kstep, 0, 0); PG8_STAGE(PG8_SB(1, 1), cB + hstepB + kstep, voffB);
        PG8_WAIT_V(6); PG8_BAR;
    }
    for (;;) {
        const bool has_next = S.next(ui + 1, nxt);
        if constexpr (GATHER) { if (has_next) { PG8_GLOAD(nvo, ui + 1); } else { _Pragma("unroll") for (int _j = 0; _j < 4; ++_j) nvo[_j] = gvo[_j]; } }
        const char* nA = has_next ? (const char*)g.A + (size_t)nxt.pm * tstepA : cA; const char* nB = has_next ? (const char*)g.Bt + (size_t)nxt.pn * tstepB : cB;
        int t = 0;
        for (int seg = 0; seg < (Epi::HAS_MID ? 3 : 1); ++seg) {
        const int tend = Epi::HAS_MID ? (seg == 0 ? Epi::MID0 : (seg == 1 ? Epi::MID1 : nt)) : nt;
#pragma unroll 1
        for (; t < tend; t += 2) {
            const bool last = (t == nt - 2);
            const char* a1 = cA + (size_t)(t + 1) * kstep;
            const char* a2 = last ? nA : cA + (size_t)(t + 2) * kstep; const char* b2 = last ? nB : cB + (size_t)(t + 2) * kstep;
            const char* a3 = a2 + kstep; const char* b3 = b2 + kstep;
            const size_t ka1 = (size_t)(t + 1) * kstep, ka2 = last ? 0 : (size_t)(t + 2) * kstep, ka3 = ka2 + kstep; const int sl2 = (last && has_next) ? ui + 1 : ui;
            if (last && has_next) S.a_ready(nxt);
            if constexpr (SP2) {
            PG8_LDB(B0, 0, 0); PG8_LDB(B1, 0, 1); PG8_SCHED; PG8_LDA(At, 0, 0); PG8_STAGE_A(PG8_SA(1, 1), a1 + hstepA, ka1, ui, 1);
            PG8_WAIT_V(8); PG8_WAIT_L(0); PG8_BAR; PG8_MMA(0, 0, At, B0); PG8_MMA(0, 1, At, B1); PG8_BAR; PG8_SCHED;
            PG8_LDA(At, 0, 1); PG8_STAGE(PG8_SB(0, 0), b2, voffB); PG8_STAGE(PG8_SB(0, 1), b2 + hstepB, voffB); PG8_STAGE_A(PG8_SA(0, 0), a2, ka2, sl2, 0);
            PG8_WAIT_V(8); PG8_WAIT_L(0); PG8_BAR; PG8_MMA(1, 0, At, B0); PG8_MMA(1, 1, At, B1); PG8_BAR; PG8_SCHED;
            PG8_LDB(B0, 1, 0); PG8_LDB(B1, 1, 1); PG8_SCHED; PG8_LDA(At, 1, 0); PG8_STAGE_A(PG8_SA(0, 1), a2 + hstepA, ka2, sl2, 1);
            PG8_WAIT_V(8); PG8_WAIT_L(0); PG8_BAR; PG8_MMA(0, 0, At, B0); PG8_MMA(0, 1, At, B1); PG8_BAR; PG8_SCHED;
            PG8_LDA(At, 1, 1); PG8_STAGE(PG8_SB(1, 0), b3, voffB); PG8_STAGE(PG8_SB(1, 1), b3 + hstepB, voffB); PG8_STAGE_A(PG8_SA(1, 0), a3, ka3, sl2, 0);
            PG8_WAIT_V(8); PG8_WAIT_L(0); PG8_BAR; PG8_MMA(1, 0, At, B0); PG8_MMA(1, 1, At, B1); PG8_BAR; PG8_SCHED;
            } else {
            PG8_LDB(B0, 0, 0); PG8_SCHED; PG8_LDA(At, 0, 0); PG8_STAGE_A(PG8_SA(1, 1), a1 + hstepA, ka1, ui, 1);
            PG8_WAIT_L(8); PG8_BAR; PG8_WAIT_L(0); PG8_MMA(0, 0, At, B0); PG8_BAR; PG8_SCHED;
            PG8_LDB(B1, 0, 1); PG8_STAGE(PG8_SB(0, 0), b2, voffB);
            PG8_BAR; PG8_WAIT_L(0); PG8_MMA(0, 1, At, B1); PG8_BAR;
            PG8_LDA(At, 0, 1); PG8_STAGE_A(PG8_SA(0, 0), a2, ka2, sl2, 0);
            PG8_BAR; PG8_WAIT_L(0); PG8_MMA(1, 0, At, B0); PG8_BAR; PG8_SCHED;
            PG8_STAGE(PG8_SB(0, 1), b2 + hstepB, voffB);
            PG8_WAIT_V(6); PG8_BAR; PG8_MMA(1, 1, At, B1); PG8_BAR;
            PG8_LDB(B0, 1, 0); PG8_SCHED; PG8_LDA(At, 1, 0); PG8_STAGE_A(PG8_SA(0, 1), a2 + hstepA, ka2, sl2, 1);
            PG8_WAIT_L(8); PG8_BAR; PG8_WAIT_L(0); PG8_MMA(0, 0, At, B0); PG8_BAR; PG8_SCHED;
            PG8_LDB(B1, 1, 1); PG8_STAGE(PG8_SB(1, 0), b3, voffB);
            PG8_BAR; PG8_WAIT_L(0); PG8_MMA(0, 1, At, B1); PG8_BAR;
            PG8_LDA(At, 1, 1); PG8_STAGE_A(PG8_SA(1, 0), a3, ka3, sl2, 0);
            PG8_BAR; PG8_WAIT_L(0); PG8_MMA(1, 0, At, B0); PG8_BAR; PG8_SCHED;
            PG8_STAGE(PG8_SB(1, 1), b3 + hstepB, voffB);
            PG8_WAIT_V(6); PG8_BAR; PG8_MMA(1, 1, At, B1); PG8_BAR;
            }
        }
        if constexpr (Epi::HAS_MID) { if (seg < 2) E.mid(acc, cur, wr, wc, fr, fq, seg); }
        }
        if constexpr (ALIGN_EPI) { if (wr == 0) PG8_BAR; }
        asm volatile("s_nop 15\n\ts_nop 15" ::: "memory");
        E(acc, cur, wr, wc, fr, fq); S.done(cur);
        if (!has_next) break;
#pragma unroll
        for (int a = 0; a < 2; ++a)
#pragma unroll
            for (int b = 0; b < 2; ++b)
#pragma unroll
                for (int m = 0; m < 4; ++m)
#pragma unroll
                    for (int n = 0; n < 2; ++n) acc[a][b][m][n] = (f32x4){0.f, 0.f, 0.f, 0.f};
        cur = nxt; cA = nA; cB = nB; ++ui;
        if constexpr (GATHER) { _Pragma("unroll") for (int _j = 0; _j < 4; ++_j) gvo[_j] = nvo[_j]; }
        if constexpr (ALIGN_EPI) { if (wr == 1) PG8_BAR; }
    }
    PG8_WAIT_V(0);
    if constexpr (!ALIGN_EPI) { if (wr == 0) PG8_BAR; }
    PG8_BAR;
#undef PG8_SA
#undef PG8_SB
#undef PG8_STAGE
#undef PG8_STAGE_A
#undef PG8_GLOAD
#undef PG8_LDA
#undef PG8_LDB
#undef PG8_MMA
#undef PG8_WAIT_V
#undef PG8_WAIT_L
#undef PG8_BAR
#undef PG8_SCHED
}
}
#define XB_TMO      128
#define XB_XCNT(j)  (256  + 64 * (j))
#define XB_XSUB(j)  (1280 + 64 * (j))
#define XB_XGEN(j)  (2304 + 64 * (j))
#define XB_TOP      3328
#define XB_TOPGEN   3392
#define XCD_BAR_WORDS 3456
#define XB_SPIN_CAP (1u << 18)

__device__ __forceinline__ unsigned xb_ld(unsigned* p)              { return __hip_atomic_load(p, __ATOMIC_RELAXED, __HIP_MEMORY_SCOPE_AGENT); }
__device__ __forceinline__ unsigned xb_add(unsigned* p, unsigned v) { return __hip_atomic_fetch_add(p, v, __ATOMIC_RELAXED, __HIP_MEMORY_SCOPE_AGENT); }
__device__ __forceinline__ unsigned xb_xcc_id() { return (unsigned)__builtin_amdgcn_s_getreg((3 << 11) | 20) & 0xFu; }
#define XB_SPIN(cond, bar) do { unsigned _sp = 0; while (cond) { __builtin_amdgcn_s_sleep(1); \
    if ((++_sp & 255u) == 0u) { if (xb_ld(&(bar)[XB_TMO])) break; if (_sp > XB_SPIN_CAP) { atomicAdd(&(bar)[XB_TMO], 1u); break; } } } } while (0)

struct XcdBarrier {
    unsigned* bar; unsigned x;
    volatile LAS unsigned* st;
};

__device__ __forceinline__ XcdBarrier xcd_barrier_post(unsigned* bar, volatile LAS unsigned* st) {
    XcdBarrier b; b.bar = bar; b.x = xb_xcc_id(); b.st = st;
    if (threadIdx.x == 0) (void)xb_add(&bar[XB_XCNT(b.x)], 1u);
    return b;
}
__device__ __forceinline__ void xcd_barrier_complete(unsigned* bar, unsigned x, unsigned& nloc, unsigned& nx) {
    const unsigned G = gridDim.x * gridDim.y * gridDim.z;
    unsigned sum, cnt, mine, sp = 0u;
    for (;;) {
        sum = 0u; cnt = 0u; mine = 0u;
#pragma unroll
        for (unsigned j = 0; j < 16; ++j) { const unsigned c = xb_ld(&bar[XB_XCNT(j)]); sum += c; cnt += (c > 0u) ? 1u : 0u; mine = (j == x) ? c : mine; }
        if (sum == G) break;
        __builtin_amdgcn_s_sleep(1);
        if ((++sp & 255u) == 0u) { if (xb_ld(&bar[XB_TMO])) break; if (sp > XB_SPIN_CAP) { atomicAdd(&bar[XB_TMO], 1u); break; } }
    }
    nloc = mine > 0u ? mine : 1u; nx = cnt > 0u ? cnt : 1u;
}

__device__ __forceinline__ void xcd_barrier(const XcdBarrier& b) {
    asm volatile("s_waitcnt vmcnt(0)" ::: "memory");
    __syncthreads();
    if (threadIdx.x == 0) {
        unsigned* bar = b.bar;
        __builtin_amdgcn_s_waitcnt(0);
        unsigned nloc = b.st[0], nx = b.st[1];
        if (nloc == 0u) { xcd_barrier_complete(bar, b.x, nloc, nx); b.st[0] = nloc; b.st[1] = nx; }
        const unsigned old = xb_add(&bar[XB_XSUB(b.x)], 1u);
        const unsigned gen = old / nloc;
        if (old + 1u == (gen + 1u) * nloc) {
            __builtin_amdgcn_fence(__ATOMIC_RELEASE, "agent");
            asm volatile("s_waitcnt vmcnt(0)" ::: "memory");
            const unsigned og = xb_add(&bar[XB_TOP], 1u);
            const unsigned tg = og / nx;
            if (og + 1u == (tg + 1u) * nx) xb_add(&bar[XB_TOPGEN], 1u);
            else XB_SPIN(xb_ld(&bar[XB_TOPGEN]) == tg, bar);
            __builtin_amdgcn_fence(__ATOMIC_ACQUIRE, "agent");
            xb_add(&bar[XB_XGEN(b.x)], 1u);
            asm volatile("s_waitcnt vmcnt(0)" ::: "memory");
        } else {
            XB_SPIN(xb_ld(&bar[XB_XGEN(b.x)]) == gen, bar);
            __builtin_amdgcn_fence(__ATOMIC_ACQUIRE, "agent");
            asm volatile("s_waitcnt vmcnt(0)" ::: "memory");
        }
    }
    __syncthreads();
}
namespace pg8 {
struct EpiProj {
    __device__ __forceinline__ void mid(f32x4 (&)[2][2][4][2], const Unit&, int, int, int, int, int) const {}
    static constexpr bool PERM = true, HAS_MID = false; static constexpr int MID0 = 0, MID1 = 0;
    bf16_t* proj; float* gsm; bf16_t* gd;
    __device__ __forceinline__ void operator()(const f32x4 (&acc)[2][2][4][2], const Unit& u, int wr, int wc, int fr, int fq) const {
        const int row0 = u.pm * BM + wr * 64 + fr;
        if (u.pn >= 22 && u.pn < 34) {
            const int gt = u.pn - 22; bf16_t* base = gd + ((size_t)((gt >> 2) * 128 + u.pm) * 4 + (gt & 3)) * 65536 + (size_t)((wr * 4 + wc) * 64 + fq * 16 + fr) * 8;
#pragma unroll
            for (int ai = 0; ai < 2; ++ai)
#pragma unroll
                for (int m = 0; m < 4; ++m)
#pragma unroll
                    for (int bj = 0; bj < 2; ++bj) { const f32x4 v0 = acc[ai][bj][m][0], v1 = acc[ai][bj][m][1];
                        u32x4 w; w.x = cvt_pk_bf16(v0[0], v0[1]); w.y = cvt_pk_bf16(v0[2], v0[3]); w.z = cvt_pk_bf16(v1[0], v1[1]); w.w = cvt_pk_bf16(v1[2], v1[3]);
                        *(u32x4*)(base + (size_t)((ai * 4 + m) * 2 + bj) * 4096) = w; }
        } else if (u.pn < 22) {
            const int col0 = u.pn * BM + wc * 32 + 8 * fq;
#pragma unroll
            for (int ai = 0; ai < 2; ++ai)
#pragma unroll
                for (int m = 0; m < 4; ++m) { bf16_t* rowp = proj + (size_t)(row0 + ai * HALF + m * 16) * NPROJ + col0;
#pragma unroll
                    for (int bj = 0; bj < 2; ++bj) { const f32x4 v0 = acc[ai][bj][m][0], v1 = acc[ai][bj][m][1];
                        u32x4 w; w.x = cvt_pk_bf16(v0[0], v0[1]); w.y = cvt_pk_bf16(v0[2], v0[3]); w.z = cvt_pk_bf16(v1[0], v1[1]); w.w = cvt_pk_bf16(v1[2], v1[3]);
                        *(u32x4*)(rowp + bj * HALF) = w; } }
        } else if (wc == 0 && fq < 3) {
#pragma unroll
            for (int ai = 0; ai < 2; ++ai)
#pragma unroll
                for (int m = 0; m < 4; ++m) { float* rowp = gsm + (size_t)(row0 + ai * HALF + m * 16) * 32 + 8 * fq;
                    *(f32x4*)(rowp) = acc[ai][0][m][0]; *(f32x4*)(rowp + 4) = acc[ai][0][m][1]; }
        }
    }
};
struct EpiMergeF {
    static constexpr bool PERM = true, HAS_MID = true; static constexpr int MID0 = 16, MID1 = 24;
    const bf16_t* gd; bf16_t* mb;
    static __device__ __forceinline__ float em(float x) { return __expf(fminf(-x, 40.0f)); }
    __device__ __forceinline__ void mid(f32x4 (&acc)[2][2][4][2], const Unit& u, int wr, int wc, int fr, int fq, int st) const {
        int toff = ((wr * 4 + wc) * 64 + fq * 16 + fr) * 8; asm volatile("" : "+v"(toff));
        const bf16_t* ga_ = gd + ((size_t)(st * 128 + u.pm) * 4 + u.pn) * 65536 + toff; const bf16_t* gb_ = ga_ + (size_t)128 * 4 * 65536;
#pragma unroll
        for (int ai = 0; ai < 2; ++ai) {
            u32x4 ga[4][2], gb[4][2];
#pragma unroll
            for (int m = 0; m < 4; ++m)
#pragma unroll
                for (int bj = 0; bj < 2; ++bj) { const int o = ((ai * 4 + m) * 2 + bj) * 4096; ga[m][bj] = *(const u32x4*)(ga_ + o); gb[m][bj] = *(const u32x4*)(gb_ + o); }
#pragma unroll
            for (int m = 0; m < 4; ++m)
#pragma unroll
                for (int bj = 0; bj < 2; ++bj) { const unsigned xa[4] = {ga[m][bj].x, ga[m][bj].y, ga[m][bj].z, ga[m][bj].w}, xb[4] = {gb[m][bj].x, gb[m][bj].y, gb[m][bj].z, gb[m][bj].w};
#pragma unroll
                    for (int q = 0; q < 4; ++q) { const float r0 = (1.f + em(bflo(xb[q]))) * __builtin_amdgcn_rcpf(1.f + em(bflo(xa[q]))), r1 = (1.f + em(bfhi(xb[q]))) * __builtin_amdgcn_rcpf(1.f + em(bfhi(xa[q])));
                        acc[ai][bj][m][q >> 1][(q & 1) * 2] *= r0; acc[ai][bj][m][q >> 1][(q & 1) * 2 + 1] *= r1; } }
            asm volatile("" ::: "memory"); }
    }
    __device__ __forceinline__ void operator()(const f32x4 (&acc)[2][2][4][2], const Unit& u, int wr, int wc, int fr, int fq) const {
        const int row0 = u.pm * BM + wr * 64 + fr, col0 = u.pn * BM + wc * 32 + 8 * fq;
        const bf16_t* g2 = gd + ((size_t)(2 * 128 + u.pm) * 4 + u.pn) * 65536 + (size_t)((wr * 4 + wc) * 64 + fq * 16 + fr) * 8;
#pragma unroll
        for (int ai = 0; ai < 2; ++ai) {
            u32x4 gwv[4][2];
#pragma unroll
            for (int m = 0; m < 4; ++m)
#pragma unroll
                for (int bj = 0; bj < 2; ++bj) gwv[m][bj] = *(const u32x4*)(g2 + ((ai * 4 + m) * 2 + bj) * 4096);
#pragma unroll
            for (int m = 0; m < 4; ++m) { const size_t row = (size_t)(row0 + ai * HALF + m * 16);
#pragma unroll
                for (int bj = 0; bj < 2; ++bj) { const int col = col0 + bj * HALF; const u32x4 gw = gwv[m][bj];
                    f32x4 g0, g1;
                    g0[0] = sigmoid_f(bflo(gw.x)); g0[1] = sigmoid_f(bfhi(gw.x)); g0[2] = sigmoid_f(bflo(gw.y)); g0[3] = sigmoid_f(bfhi(gw.y));
                    g1[0] = sigmoid_f(bflo(gw.z)); g1[1] = sigmoid_f(bfhi(gw.z)); g1[2] = sigmoid_f(bflo(gw.w)); g1[3] = sigmoid_f(bfhi(gw.w));
                    const f32x4 v0 = acc[ai][bj][m][0] * g0, v1 = acc[ai][bj][m][1] * g1;
                    u32x4 w; w.x = cvt_pk_bf16(v0[0], v0[1]); w.y = cvt_pk_bf16(v0[2], v0[3]); w.z = cvt_pk_bf16(v1[0], v1[1]); w.w = cvt_pk_bf16(v1[2], v1[3]);
                    *(u32x4*)(mb + row * 1024 + col) = w; } }
            asm volatile("" ::: "memory"); }
    }
};
struct EpiWout {
    static constexpr bool PERM = true, HAS_MID = false; static constexpr int MID0 = 0, MID1 = 0;
    __device__ __forceinline__ void mid(f32x4 (&)[2][2][4][2], const Unit&, int, int, int, int, int) const {}
    const float* xf; const bf16_t* xh; bf16_t* v;
    __device__ __forceinline__ void operator()(const f32x4 (&acc)[2][2][4][2], const Unit& u, int wr, int wc, int fr, int fq) const {
        const int row0 = u.pm * BM + wr * 64 + fr, col0 = u.pn * BM + wc * 32 + 8 * fq;
#pragma unroll
        for (int ai = 0; ai < 2; ++ai) {
            f32x4 x0[4][2], x1[4][2];
#pragma unroll
            for (int m = 0; m < 4; ++m) { const size_t off = (size_t)(row0 + ai * HALF + m * 16) * 1024 + col0;
#pragma unroll
                for (int bj = 0; bj < 2; ++bj) {
                    if (xf) { x0[m][bj] = *(const f32x4*)(xf + off + bj * HALF); x1[m][bj] = *(const f32x4*)(xf + off + bj * HALF + 4); }
                    else { const u32x4 w = *(const u32x4*)(xh + off + bj * HALF); x0[m][bj] = (f32x4){bflo(w.x), bfhi(w.x), bflo(w.y), bfhi(w.y)}; x1[m][bj] = (f32x4){bflo(w.z), bfhi(w.z), bflo(w.w), bfhi(w.w)}; } } }
#pragma unroll
            for (int m = 0; m < 4; ++m) { const size_t off = (size_t)(row0 + ai * HALF + m * 16) * 1024 + col0;
#pragma unroll
                for (int bj = 0; bj < 2; ++bj) { const f32x4 v0 = x0[m][bj] * DN_ALPHA + acc[ai][bj][m][0], v1 = x1[m][bj] * DN_ALPHA + acc[ai][bj][m][1];
                    u32x4 w; w.x = cvt_pk_bf16(v0[0], v0[1]); w.y = cvt_pk_bf16(v0[2], v0[3]); w.z = cvt_pk_bf16(v1[0], v1[1]); w.w = cvt_pk_bf16(v1[2], v1[3]);
                    *(u32x4*)(v + off + bj * HALF) = w; } }
            asm volatile("" ::: "memory"); }
    }
};
struct EpiMoe1 {
    __device__ __forceinline__ void mid(f32x4 (&)[2][2][4][2], const Unit&, int, int, int, int, int) const {}
    static constexpr bool PERM = true, HAS_MID = false; static constexpr int MID0 = 0, MID1 = 0;
    bf16_t* act; const float* b1;
    __device__ __forceinline__ void operator()(const f32x4 (&acc)[2][2][4][2], const Unit& u, int wr, int wc, int fr, int fq) const {
        const int e = u.pn >> 3, tl = u.pn & 7;
        const int row0 = u.pm * BM + wr * 64 + fr, col0 = tl * 128 + wc * 32 + 8 * fq;
        const float* bp = b1 + (size_t)e * 2048 + col0;
        const f32x4 bg0 = *(const f32x4*)(bp), bg1 = *(const f32x4*)(bp + 4), bl0 = *(const f32x4*)(bp + 1024), bl1 = *(const f32x4*)(bp + 1028);
#pragma unroll
        for (int ai = 0; ai < 2; ++ai)
#pragma unroll
            for (int m = 0; m < 4; ++m) { bf16_t* rowp = act + (size_t)(row0 + ai * HALF + m * 16) * 1024 + col0;
                f32x4 o[2];
#pragma unroll
                for (int n = 0; n < 2; ++n) { const f32x4 gg = acc[ai][0][m][n] + (n ? bg1 : bg0), ll = acc[ai][1][m][n] + (n ? bl1 : bl0);
#pragma unroll
                    for (int q = 0; q < 4; ++q) { const float gv = fminf(gg[q], 7.0f), lv = fminf(fmaxf(ll[q], -7.0f), 7.0f);
                        o[n][q] = gv * sigmoid_f(1.702f * gv) * (lv + 1.0f); } }
                u32x4 w; w.x = cvt_pk_bf16(o[0][0], o[0][1]); w.y = cvt_pk_bf16(o[0][2], o[0][3]); w.z = cvt_pk_bf16(o[1][0], o[1][1]); w.w = cvt_pk_bf16(o[1][2], o[1][3]);
                *(u32x4*)(rowp) = w; }
    }
};
struct EpiMoe2 {
    __device__ __forceinline__ void mid(f32x4 (&)[2][2][4][2], const Unit&, int, int, int, int, int) const {}
    static constexpr bool PERM = true, HAS_MID = false; static constexpr int MID0 = 0, MID1 = 0;
    bf16_t* ys; const float* b2; const float* wbuf;
    __device__ __forceinline__ void operator()(const f32x4 (&acc)[2][2][4][2], const Unit& u, int wr, int wc, int fr, int fq) const {
        const int e = u.pn >> 2, tl = u.pn & 3;
        const int row0 = u.pm * BM + wr * 64 + fr, col0 = tl * 256 + wc * 32 + 8 * fq;
        const float* bp = b2 + (size_t)e * 1024 + col0;
        f32x4 bv[2][2];
#pragma unroll
        for (int bj = 0; bj < 2; ++bj) { bv[bj][0] = *(const f32x4*)(bp + bj * HALF); bv[bj][1] = *(const f32x4*)(bp + bj * HALF + 4); }
#pragma unroll
        for (int ai = 0; ai < 2; ++ai)
#pragma unroll
            for (int m = 0; m < 4; ++m) { const int row = row0 + ai * HALF + m * 16; const float ww = wbuf[row]; bf16_t* rowp = ys + (size_t)row * 1024 + col0;
#pragma unroll
                for (int bj = 0; bj < 2; ++bj) { const f32x4 v0 = (acc[ai][bj][m][0] + bv[bj][0]) * ww, v1 = (acc[ai][bj][m][1] + bv[bj][1]) * ww;
                    u32x4 w; w.x = cvt_pk_bf16(v0[0], v0[1]); w.y = cvt_pk_bf16(v0[2], v0[3]); w.z = cvt_pk_bf16(v1[0], v1[1]); w.w = cvt_pk_bf16(v1[2], v1[3]);
                    *(u32x4*)(rowp + bj * HALF) = w; } }
    }
};
struct EpiMoe1F8 {
    static constexpr bool PERM = true, HAS_MID = false; static constexpr int MID0 = 0, MID1 = 0;
    __device__ __forceinline__ void mid(f32x4 (&)[2][2][4][2], const Unit&, int, int, int, int, int) const {}
    unsigned char* act8; const float* b1;
    __device__ __forceinline__ void operator()(const f32x4 (&acc)[2][2][4][2], const Unit& u, int wr, int wc, int fr, int fq) const {
        const int e = u.pn >> 3, tl = u.pn & 7;
        const int row0 = u.pm * BM + wr * 64 + fr, col0 = tl * 128 + wc * 32 + 8 * fq;
        const float* bp = b1 + (size_t)e * 2048 + col0;
        const f32x4 bg0 = *(const f32x4*)(bp), bg1 = *(const f32x4*)(bp + 4), bl0 = *(const f32x4*)(bp + 1024), bl1 = *(const f32x4*)(bp + 1028);
        constexpr float sc = 1.0f / (F8_SX * F8_SW1);
#pragma unroll
        for (int ai = 0; ai < 2; ++ai)
#pragma unroll
            for (int m = 0; m < 4; ++m) { unsigned char* rowp = act8 + (size_t)(row0 + ai * HALF + m * 16) * 1024 + col0;
                f32x4 o[2];
#pragma unroll
                for (int n = 0; n < 2; ++n) { const f32x4 gg = acc[ai][0][m][n] * sc + (n ? bg1 : bg0), ll = acc[ai][1][m][n] * sc + (n ? bl1 : bl0);
#pragma unroll
                    for (int q = 0; q < 4; ++q) { const float gv = fminf(gg[q], 7.0f), lv = fminf(fmaxf(ll[q], -7.0f), 7.0f);
                        o[n][q] = gv * sigmoid_f(1.702f * gv) * (lv + 1.0f) * F8_SA; } }
                u32x2 w; w.x = pk_fp8x4(o[0][0], o[0][1], o[0][2], o[0][3]); w.y = pk_fp8x4(o[1][0], o[1][1], o[1][2], o[1][3]);
                *(u32x2*)(rowp) = w; }
    }
};
struct EpiMoe2F8 {
    static constexpr bool PERM = true, HAS_MID = false; static constexpr int MID0 = 0, MID1 = 0;
    __device__ __forceinline__ void mid(f32x4 (&)[2][2][4][2], const Unit&, int, int, int, int, int) const {}
    bf16_t* ys; const float* b2; const float* wbuf;
    __device__ __forceinline__ void operator()(const f32x4 (&acc)[2][2][4][2], const Unit& u, int wr, int wc, int fr, int fq) const {
        const int e = u.pn >> 2, tl = u.pn & 3;
        const int row0 = u.pm * BM + wr * 64 + fr, col0 = tl * 256 + wc * 32 + 8 * fq;
        const float* bp = b2 + (size_t)e * 1024 + col0;
        constexpr float sc = 1.0f / (F8_SA * F8_SW2);
        f32x4 bv[2][2];
#pragma unroll
        for (int bj = 0; bj < 2; ++bj) { bv[bj][0] = *(const f32x4*)(bp + bj * HALF); bv[bj][1] = *(const f32x4*)(bp + bj * HALF + 4); }
#pragma unroll
        for (int ai = 0; ai < 2; ++ai)
#pragma unroll
            for (int m = 0; m < 4; ++m) { const int row = row0 + ai * HALF + m * 16; const float ww = wbuf[row]; bf16_t* rowp = ys + (size_t)row * 1024 + col0;
#pragma unroll
                for (int bj = 0; bj < 2; ++bj) { const f32x4 v0 = (acc[ai][bj][m][0] * sc + bv[bj][0]) * ww, v1 = (acc[ai][bj][m][1] * sc + bv[bj][1]) * ww;
                    u32x4 w; w.x = cvt_pk_bf16(v0[0], v0[1]); w.y = cvt_pk_bf16(v0[2], v0[3]); w.z = cvt_pk_bf16(v1[0], v1[1]); w.w = cvt_pk_bf16(v1[2], v1[3]);
                    *(u32x4*)(rowp + bj * HALF) = w; } }
    }
};
struct MoeOrder {
    int nN, G, c, total; const LAS int* blk_e;
    __device__ __forceinline__ bool next(int i, Unit& u) const {
        const long L = (long)i * G + c; if (L >= total) return false;
        const int rb = (int)(L / nN), tl = (int)(L % nN); u.pm = rb; u.pn = blk_e[rb] * nN + tl; return true;
    }
    __device__ __forceinline__ void a_ready(const Unit&) const {}
    __device__ __forceinline__ void done(const Unit&) const {}
};
}
struct Args { const float* in[30]; float* out; unsigned char* ws; int ph_lo, ph_hi, li, pad; };
typedef const __attribute__((address_space(4))) Args* ArgsP;
enum { I_X = 0, I_WIN, I_LCW, I_LCB, I_LWA, I_LBA, I_LWX, I_LBX, I_LLAM, I_MIB, I_MFB, I_MNG, I_GCW, I_GAL, I_GDT, I_GNG, I_WBA, I_WBB, I_WBC, I_WOUT, I_LN1G, I_LN1B, I_RW, I_RB, I_W1, I_B1, I_W2, I_B2, I_LN2G, I_LN2B };

template <int MODE> __device__ __forceinline__ int col_map(int n) {
    if (MODE == 1) {
        if (n < 3072) return n;
        if (n < 3076) return 8704 + (n - 3072);
        if (n < 3080) return 8708 + (n - 3076);
        if (n < 5128) return n - 8;
        if (n < 5136) return 8712 + (n - 5128);
        if (n < 5144) return 8720 + (n - 5136);
        return n - 24;
    } else if (MODE == 2) {
        if (n < 1024) return (n >> 7) * 256 + (n & 127);
        const int q = n - 1024; return (q >> 7) * 256 + 128 + (q & 127);
    }
    return n;
}
struct TrItem { const float* W; bf16_t* WT; int N, ldk, koff, mode, k0, n0; float f8s; };
__device__ __forceinline__ int col_map_rt(int mode, int n) { return mode == 1 ? col_map<1>(n) : (mode == 2 ? col_map<2>(n) : n); }
constexpr int IT_IN = 16 * 273, IT_BRA = 16 * 32, IT_BRB = 8 * 32, IT_BRC = 8 * 32, IT_OUT = 16 * 32, IT_W1 = 32 * 16 * 64, IT_W2 = 32 * 16 * 32;
constexpr int IT_G = 8 * 2 * 8;
constexpr int IT_LAYER = IT_IN + IT_BRA + IT_BRB + IT_BRC + IT_OUT + IT_W1 + IT_W2 + IT_G;
__device__ __forceinline__ TrItem tr_decode(ArgsP a, int it) {
    const int l = it / IT_LAYER; int r = it - l * IT_LAYER; unsigned char* wl = a->ws + WS_W + (size_t)l * WL_STRIDE; TrItem t;
    if (r < IT_IN) { t = TrItem{a->in[I_WIN] + (size_t)l * 1024 * DIN, (bf16_t*)(wl + WL_IN), DIN, 1024, 0, 1, 64 * (r / 273), 32 * (r % 273), 0.f}; return t; } r -= IT_IN;
    if (r < IT_BRA) { t = TrItem{a->in[I_WBA] + (size_t)l * 1024 * 1024, (bf16_t*)(wl + WL_BR), 1024, 2048, 0, 0, 64 * (r / 32), 32 * (r % 32), 0.f}; return t; } r -= IT_BRA;
    if (r < IT_BRB) { t = TrItem{a->in[I_WBB] + (size_t)l * 512 * 1024, (bf16_t*)(wl + WL_BR), 1024, 2048, 1024, 0, 64 * (r / 32), 32 * (r % 32), 0.f}; return t; } r -= IT_BRB;
    if (r < IT_BRC) { t = TrItem{a->in[I_WBC] + (size_t)l * 512 * 1024, (bf16_t*)(wl + WL_BR), 1024, 2048, 1536, 0, 64 * (r / 32), 32 * (r % 32), 0.f}; return t; } r -= IT_BRC;
    if (r < IT_OUT) { t = TrItem{a->in[I_WOUT] + (size_t)l * 1024 * 1024, (bf16_t*)(wl + WL_OUT), 1024, 1024, 0, 0, 64 * (r / 32), 32 * (r % 32), 0.f}; return t; } r -= IT_OUT;
    if (r < IT_W1) { const int e = r / 1024, q = r % 1024; t = TrItem{a->in[I_W1] + ((size_t)l * NE + e) * 1024 * 2048, (bf16_t*)(wl + WL_W1 + (size_t)e * 2048 * 1024), 2048, 1024, 0, 2, 64 * (q / 64), 32 * (q % 64), F8_SW1}; return t; } r -= IT_W1;
    if (r < IT_W2) { const int e = r / 512, q = r % 512; t = TrItem{a->in[I_W2] + ((size_t)l * NE + e) * 1024 * 1024, (bf16_t*)(wl + WL_W2 + (size_t)e * 1024 * 1024), 1024, 1024, 0, 0, 64 * (q / 32), 32 * (q % 32), F8_SW2}; return t; } r -= IT_W2;
    { const int h = r >> 4, gate = (r >> 3) & 1, q = r & 7;
      t = TrItem{a->in[gate ? I_LWX : I_LWA] + ((size_t)l * 8 + h) * 128 * 128, (bf16_t*)(wl + WL_G) + (size_t)(h * 256 + gate * 128) * 128, 128, 128, 0, 0, 64 * (q >> 2), 32 * (q & 3), 0.f}; return t; }
}
__device__ __forceinline__ void p0_convert(ArgsP a, LAS unsigned char* lds, int G) {
    int tid_ = threadIdx.x; asm volatile("" : "+v"(tid_)); const int tid = tid_, lane = tid & 63, wave = tid >> 6;
    LAS float* scr = (LAS float*)(lds + wave * 16384);
    const int gw = blockIdx.x * NWAVES + wave, NGW = G * NWAVES;
    float v[32];
#define TR_LOAD(t_) do { const int nsrc_ = (t_).n0 + (lane & 31); const float* p_ = (t_).W + (size_t)((t_).k0 + (lane >> 5)) * (t_).N + nsrc_; \
        _Pragma("unroll") for (int i = 0; i < 32; ++i) v[i] = (nsrc_ < (t_).N) ? p_[(size_t)(2 * i) * (t_).N] : 0.f; } while (0)
    TrItem cur = tr_decode(a, gw < 2 * IT_LAYER ? gw : 0);
    if (gw < 2 * IT_LAYER) TR_LOAD(cur);
    for (int it = gw; it < 2 * IT_LAYER; it += NGW) {
#pragma unroll
        for (int i = 0; i < 32; ++i) scr[(2 * i + (lane >> 5)) * 33 + (lane & 31)] = v[i];
        const TrItem me = cur;
        if (it + NGW < 2 * IT_LAYER) { cur = tr_decode(a, it + NGW); TR_LOAD(cur); }
        LDS_WAIT(); asm volatile("" ::: "memory");
        const int c = lane & 7;
#pragma unroll
        for (int j = 0; j < 4; ++j) { const int nl = (lane >> 3) + 8 * j, n = me.n0 + nl; const LAS float* s = scr + (8 * c) * 33 + nl;
            if (me.f8s != 0.f) { const float f = me.f8s; u32x2 o8; o8.x = pk_fp8x4(s[0 * 33] * f, s[1 * 33] * f, s[2 * 33] * f, s[3 * 33] * f); o8.y = pk_fp8x4(s[4 * 33] * f, s[5 * 33] * f, s[6 * 33] * f, s[7 * 33] * f);
                if (n < me.N) *(u32x2*)((unsigned char*)me.WT + (size_t)col_map_rt(me.mode, n) * me.ldk + me.koff + me.k0 + 8 * c) = o8; }
            else { u32x4 o; o.x = pk2(s[0 * 33], s[1 * 33]); o.y = pk2(s[2 * 33], s[3 * 33]); o.z = pk2(s[4 * 33], s[5 * 33]); o.w = pk2(s[6 * 33], s[7 * 33]);
                if (n < me.N) *(u32x4*)(me.WT + (size_t)col_map_rt(me.mode, n) * me.ldk + me.koff + me.k0 + 8 * c) = o; } }
        LDS_WAIT(); asm volatile("" ::: "memory");
    }
#undef TR_LOAD
    const size_t gt = (size_t)blockIdx.x * 512 + tid, GT = (size_t)G * 512;
    for (size_t i = gt; i < (size_t)2 * 232 * 128; i += GT) { const int l = (int)(i / (232 * 128)); const size_t q = i % (232 * 128);
        *(u32x4*)(a->ws + WS_W + (size_t)l * WL_STRIDE + WL_IN + ((size_t)8728 * 1024) * 2 + q * 16) = (u32x4){0u, 0u, 0u, 0u}; }
    for (size_t i = gt; i < (size_t)2 * 32 * 1024; i += GT) { const int l = (int)(i >> 15), k = (int)((i >> 5) & 1023), e = (int)(i & 31); const float w = a->in[I_RW][i];
        const unsigned hb = f2bf(w); const float lo = w - bf2f((unsigned short)hb); bf16_t* dst = (bf16_t*)(a->ws + WS_RWB) + (size_t)l * 2 * 32 * 1024;
        dst[(size_t)e * 1024 + k] = (bf16_t)hb; dst[(size_t)(32 + e) * 1024 + k] = (bf16_t)f2bf(lo); }
    const float* x = a->in[I_X]; bf16_t* xb = (bf16_t*)(a->ws + WS_XB);
    for (size_t i = gt; i < (size_t)T_ * D_ / 8; i += GT) { const f32x4 v0 = *(const f32x4*)(x + i * 8), v1 = *(const f32x4*)(x + i * 8 + 4);
        u32x4 w; w.x = pk2(v0[0], v0[1]); w.y = pk2(v0[2], v0[3]); w.z = pk2(v1[0], v1[1]); w.w = pk2(v1[2], v1[3]); *(u32x4*)(xb + i * 8) = w; }
}

constexpr int TB = 32;
__device__ __forceinline__ void lru_naive(ArgsP a, int l, int u, LAS unsigned char* lds, const bf16_t* proj, bf16_t* H) {
    int tid_ = threadIdx.x; asm volatile("" : "+v"(tid_)); const int tid = tid_, b = u >> 3, h = u & 7, c = tid >> 2, p = tid & 3, chg = h * 128 + c;
    const float* wa = a->in[I_LWA] + ((size_t)l * 8 + h) * 128 * 128; const float* wx = a->in[I_LWX] + ((size_t)l * 8 + h) * 128 * 128;
    float wra[32], wrx[32];
#pragma unroll
    for (int i = 0; i < 32; ++i) { wra[i] = wa[(p * 32 + i) * 128 + c]; wrx[i] = wx[(p * 32 + i) * 128 + c]; }
    const float ba = a->in[I_LBA][l * 1024 + chg], bx = a->in[I_LBX][l * 1024 + chg];
    const float sp = softplus_f(-a->in[I_LLAM][l * 1024 + chg]);
    const float* cw = a->in[I_LCW] + (size_t)l * 4 * 1024 + chg; const float cw0 = cw[0], cw1 = cw[1024], cw2 = cw[2048], cw3 = cw[3072], cb = a->in[I_LCB][l * 1024 + chg];
    LAS bf16_t* xs = (LAS bf16_t*)(lds);
    LAS bf16_t* ys = (LAS bf16_t*)(lds + 8192);
    LAS float* xa_s = (LAS float*)(lds + 16384);
    const int srow = tid >> 4, scol = (tid & 15) * 8;
    const size_t tok0 = (size_t)b * SEQ_;
    u32x4 px = *(const u32x4*)(proj + (tok0 + srow) * NPROJ + PC_LRUX + h * 128 + scol);
    u32x4 py = *(const u32x4*)(proj + (tok0 + srow) * NPROJ + PC_LRUY + h * 128 + scol);
    float hs = 0.f, x1 = 0.f, x2 = 0.f, x3 = 0.f;
    for (int blk = 0; blk < SEQ_ / TB; ++blk) {
        __syncthreads();
        *(LAS u32x4*)(xs + srow * 128 + scol) = px; *(LAS u32x4*)(ys + srow * 128 + scol) = py;
        __syncthreads();
        if (blk + 1 < SEQ_ / TB) { const size_t tk = tok0 + (size_t)(blk + 1) * TB + srow;
            px = *(const u32x4*)(proj + tk * NPROJ + PC_LRUX + h * 128 + scol); py = *(const u32x4*)(proj + tk * NPROJ + PC_LRUY + h * 128 + scol); }
        for (int s = 0; s < TB; ++s) {
            const float xraw = bf2f(xs[s * 128 + c]);
            const float xa = cw0 * x3 + cw1 * x2 + cw2 * x1 + cw3 * xraw + cb;
            x3 = x2; x2 = x1; x1 = xraw;
            LAS float* xb_ = xa_s + (s & 1) * 128;
            if (p == 0) xb_[c] = xa;
            __syncthreads();
            float sa = 0.f, sx = 0.f;
#pragma unroll
            for (int i4 = 0; i4 < 8; ++i4) { const f32x4 xv = *(const LAS f32x4*)(xb_ + p * 32 + i4 * 4);
#pragma unroll
                for (int q = 0; q < 4; ++q) { sa += xv[q] * wra[i4 * 4 + q]; sx += xv[q] * wrx[i4 * 4 + q]; } }
            sa += __shfl_xor(sa, 1); sa += __shfl_xor(sa, 2); sx += __shfl_xor(sx, 1); sx += __shfl_xor(sx, 2);
            const float r = 1.f / (1.f + __expf(-(sa + ba))), ig = 1.f / (1.f + __expf(-(sx + bx)));
            const float log_a = -8.0f * r * sp, av = __expf(log_a), mult = sqrtf(-expm1f(2.0f * log_a));
            hs = av * hs + mult * (ig * xa);
            if (p == 0) { const float y = bf2f(ys[s * 128 + c]);
                H[(tok0 + (size_t)blk * TB + s) * 2048 + chg] = (bf16_t)f2bf(hs * gelu_tanh_f(y)); }
        }
    }
}
__device__ __forceinline__ void mlstm_naive(ArgsP a, int l, int u, LAS unsigned char* lds, const bf16_t* proj, const float* gsm, bf16_t* H) {
    int tid_ = threadIdx.x; asm volatile("" : "+v"(tid_)); const int tid = tid_, lane = tid & 63, wave = tid >> 6, b = u >> 2, hd = u & 3, j = tid & 127;
    LAS float* qs = (LAS float*)(lds);
    LAS float* ks = (LAS float*)(lds + 8192);
    LAS float* vs = (LAS float*)(lds + 16384);
    LAS float* os = (LAS float*)(lds + 32768);
    LAS float* gi = (LAS float*)(lds + 49152);
    LAS float* gf = (LAS float*)(lds + 49152 + 128);
    LAS float* red = (LAS float*)(lds + 49152 + 256);
    const float ib = a->in[I_MIB][l * 4 + hd], fb = a->in[I_MFB][l * 4 + hd], gn = a->in[I_MNG][(size_t)l * 512 + hd * 128 + j];
    const size_t tok0 = (size_t)b * SEQ_;
    const int qa_row = (tid & 255) >> 3, qa_c8 = (tid & 7) * 8; const int qa_col = (tid < 256 ? PC_MLQ : PC_MLK) + hd * 64 + qa_c8;
    const int vb_row = tid >> 4, vb_c8 = (tid & 15) * 8;
    u32x4 pa, pb, pc; float pg = 0.f;
#define ML_ISSUE(blk_) do { const size_t t0 = tok0 + (size_t)(blk_) * TB; \
        pa = *(const u32x4*)(proj + (t0 + qa_row) * NPROJ + qa_col); \
        pb = *(const u32x4*)(proj + (t0 + vb_row) * NPROJ + PC_MLV + hd * 128 + vb_c8); \
        pc = *(const u32x4*)(proj + (t0 + vb_row) * NPROJ + PC_MLO + hd * 128 + vb_c8); \
        if (tid < 64) pg = gsm[(t0 + (tid & 31)) * 32 + (tid < 32 ? 0 : 4) + hd]; } while (0)
    ML_ISSUE(0);
    float C[64], n[64];
#pragma unroll
    for (int r = 0; r < 64; ++r) { C[r] = 0.f; n[r] = 0.f; }
    for (int blk = 0; blk < SEQ_ / TB; ++blk) {
        __syncthreads();
        { LAS float* d = (tid < 256 ? qs : ks) + qa_row * 64 + qa_c8;
          *(LAS f32x4*)(d) = (f32x4){bflo(pa.x), bfhi(pa.x), bflo(pa.y), bfhi(pa.y)}; *(LAS f32x4*)(d + 4) = (f32x4){bflo(pa.z), bfhi(pa.z), bflo(pa.w), bfhi(pa.w)};
          LAS float* dv = vs + vb_row * 128 + vb_c8;
          *(LAS f32x4*)(dv) = (f32x4){bflo(pb.x), bfhi(pb.x), bflo(pb.y), bfhi(pb.y)}; *(LAS f32x4*)(dv + 4) = (f32x4){bflo(pb.z), bfhi(pb.z), bflo(pb.w), bfhi(pb.w)};
          LAS float* dz = os + vb_row * 128 + vb_c8;
          *(LAS f32x4*)(dz) = (f32x4){bflo(pc.x), bfhi(pc.x), bflo(pc.y), bfhi(pc.y)}; *(LAS f32x4*)(dz + 4) = (f32x4){bflo(pc.z), bfhi(pc.z), bflo(pc.w), bfhi(pc.w)};
          if (tid < 32) gi[tid] = pg; else if (tid < 64) gf[tid - 32] = pg; }
        __syncthreads();
        if (blk + 1 < SEQ_ / TB) ML_ISSUE(blk + 1);
        for (int s = 0; s < TB; ++s) {
            float hj = 0.f;
            if (tid < 128) {
                const float f = 1.f / (1.f + __expf(-(gf[s] + fb))), ie = __expf(gi[s] + ib);
                const float vj = vs[s * 128 + j];
                float num = 0.f, den = 0.f;
#pragma unroll
                for (int r4 = 0; r4 < 16; ++r4) { const f32x4 kk = *(const LAS f32x4*)(ks + s * 64 + r4 * 4), qq = *(const LAS f32x4*)(qs + s * 64 + r4 * 4);
#pragma unroll
                    for (int q = 0; q < 4; ++q) { const int r = r4 * 4 + q; const float ik = ie * kk[q];
                        C[r] = f * C[r] + ik * vj; n[r] = f * n[r] + ik; num += qq[q] * C[r]; den += qq[q] * n[r]; } }
                num *= 0.125f; den *= 0.125f;
                hj = num / fmaxf(fabsf(den), 1.0f);
                const float ss = wave_sum(hj * hj);
                if (lane == 0) red[(s & 1) * 2 + wave] = ss;
            }
            __syncthreads();
            if (tid < 128) {
                const float tot = red[(s & 1) * 2] + red[(s & 1) * 2 + 1];
                const float o = hj * rsqrtf(tot * (1.0f / 128.0f) + RMS_EPS) * gn * sigmoid_f(os[s * 128 + j]);
                H[(tok0 + (size_t)blk * TB + s) * 2048 + 1024 + hd * 128 + j] = (bf16_t)f2bf(o);
            }
        }
    }
}
__device__ __forceinline__ void gdn_naive(ArgsP a, int l, int u, LAS unsigned char* lds, const bf16_t* proj, const float* gsm, bf16_t* H) {
    int tid_ = threadIdx.x; asm volatile("" : "+v"(tid_)); const int tid = tid_, lane = tid & 63, b = u >> 3, hd = u & 7;
    LAS float* rq = (LAS float*)(lds);
    LAS float* rk = (LAS float*)(lds + 9216);
    LAS float* rv = (LAS float*)(lds + 18432);
    LAS float* zs = (LAS float*)(lds + 27648);
    LAS float* ga = (LAS float*)(lds + 27648 + 8192);
    LAS float* gb = ga + TB;
    const float* cw = a->in[I_GCW] + (size_t)l * 4 * 1536;
    float cq[4], ck[4], cv[4];
#pragma unroll
    for (int i = 0; i < 4; ++i) { cq[i] = cw[i * 1536 + hd * 64 + lane]; ck[i] = cw[i * 1536 + 512 + hd * 64 + lane]; cv[i] = cw[i * 1536 + 1024 + hd * 64 + lane]; }
    const float nexpA = -__expf(a->in[I_GAL][l * 8 + hd]), dtb = a->in[I_GDT][l * 8 + hd], gn = a->in[I_GNG][l * 64 + lane];
    const size_t tok0 = (size_t)b * SEQ_;
    u32x4 pp[3]; float pg = 0.f;
#define GD_ISSUE(blk_) do { const int tl0 = (blk_) * TB; \
        _Pragma("unroll") for (int i = 0; i < 3; ++i) { const int pid = tid + 512 * i; pp[i] = (u32x4){0u, 0u, 0u, 0u}; \
            if (pid < 840) { const int arr = pid / 280, rem = pid % 280, row = rem >> 3, c8 = (rem & 7) * 8; const int tl = tl0 - 3 + row; \
                if (tl >= 0) pp[i] = *(const u32x4*)(proj + (tok0 + tl) * NPROJ + (arr == 0 ? PC_GDQ : (arr == 1 ? PC_GDK : PC_GDV)) + hd * 64 + c8); } \
            else if (pid < 1096) { const int zp = pid - 840, row = zp >> 3, c8 = (zp & 7) * 8; \
                pp[i] = *(const u32x4*)(proj + (tok0 + tl0 + row) * NPROJ + PC_GDZ + hd * 64 + c8); } } \
        if (tid < 64) pg = gsm[(tok0 + tl0 + (tid & 31)) * 32 + (tid < 32 ? 8 : 16) + hd]; } while (0)
    GD_ISSUE(0);
    float S[64];
#pragma unroll
    for (int i = 0; i < 64; ++i) S[i] = 0.f;
    for (int blk = 0; blk < SEQ_ / TB; ++blk) {
        __syncthreads();
#pragma unroll
        for (int i = 0; i < 3; ++i) { const int pid = tid + 512 * i; LAS float* d = nullptr;
            if (pid < 840) { const int arr = pid / 280, rem = pid % 280, row = rem >> 3, c8 = (rem & 7) * 8; d = (arr == 0 ? rq : (arr == 1 ? rk : rv)) + row * 64 + c8; }
            else if (pid < 1096) { const int zp = pid - 840, row = zp >> 3, c8 = (zp & 7) * 8; d = zs + row * 64 + c8; }
            if (pid < 1096) { const u32x4 w = pp[i];
                *(LAS f32x4*)(d) = (f32x4){bflo(w.x), bfhi(w.x), bflo(w.y), bfhi(w.y)}; *(LAS f32x4*)(d + 4) = (f32x4){bflo(w.z), bfhi(w.z), bflo(w.w), bfhi(w.w)}; } }
        if (tid < 32) ga[tid] = pg; else if (tid < 64) gb[tid - 32] = pg;
        __syncthreads();
        if (blk + 1 < SEQ_ / TB) GD_ISSUE(blk + 1);
        if (tid < 64) {
            for (int s = 0; s < TB; ++s) {
                float qv = 0.f, kv = 0.f, vv = 0.f;
#pragma unroll
                for (int i = 0; i < 4; ++i) { qv += cq[i] * rq[(s + i) * 64 + lane]; kv += ck[i] * rk[(s + i) * 64 + lane]; vv += cv[i] * rv[(s + i) * 64 + lane]; }
                qv = silu_f(qv); kv = silu_f(kv); vv = silu_f(vv);
                const float qn = qv * rsqrtf(wave_sum(qv * qv) + RMS_EPS) * 0.125f;
                const float kn = kv * rsqrtf(wave_sum(kv * kv) + RMS_EPS);
                const float g = nexpA * softplus_f(ga[s] + dtb), alpha = __expf(g), beta = 1.f / (1.f + __expf(-gb[s]));
                float kS = 0.f;
#pragma unroll
                for (int i = 0; i < 64; ++i) kS += __builtin_bit_cast(float, __builtin_amdgcn_readlane(__builtin_bit_cast(int, kn), i)) * S[i];
                const float dl = beta * (vv - alpha * kS);
                float o = 0.f;
#pragma unroll
                for (int i = 0; i < 64; ++i) { const float ki = __builtin_bit_cast(float, __builtin_amdgcn_readlane(__builtin_bit_cast(int, kn), i));
                    const float qi = __builtin_bit_cast(float, __builtin_amdgcn_readlane(__builtin_bit_cast(int, qn), i));
                    S[i] = alpha * S[i] + ki * dl; o += qi * S[i]; }
                const float ms = wave_sum(o * o) * (1.0f / 64.0f);
                const float out = o * rsqrtf(ms + RMS_EPS) * gn * silu_f(zs[s * 64 + lane]);
                H[(tok0 + (size_t)blk * TB + s) * 2048 + 1536 + hd * 64 + lane] = (bf16_t)f2bf(out);
            }
        }
    }
}

constexpr int RW_PITCH = 1032;
__device__ __forceinline__ unsigned f2key(float v, int e) { unsigned u = __builtin_bit_cast(unsigned, v); u = (u & 0x80000000u) ? ~u : (u | 0x80000000u); return (u & ~31u) | (unsigned)(31 - e); }
__device__ __forceinline__ float key2f(unsigned k) { const unsigned u = k & ~31u; return __builtin_bit_cast(float, (u & 0x80000000u) ? (u ^ 0x80000000u) : ~u); }
__device__ __forceinline__ void p5_ln1_router(ArgsP a, int l, LAS unsigned char* lds, int G) {
    int tid_ = threadIdx.x; asm volatile("" : "+v"(tid_)); const int tid = tid_, lane = tid & 63, wave = tid >> 6, tk = lane & 15, g = lane >> 4;
    LAS bf16_t* whi = (LAS bf16_t*)lds;
    LAS bf16_t* wlo = (LAS bf16_t*)(lds + 32 * RW_PITCH * 2);
    LAS int* hist = (LAS int*)(lds + 2 * 32 * RW_PITCH * 2);
    { const bf16_t* src = (const bf16_t*)(a->ws + WS_RWB) + (size_t)l * 2 * 32 * 1024;
      for (int p = tid; p < 2 * 32 * 128; p += 512) { const int arr = p >> 12, e = (p >> 7) & 31, c8 = (p & 127) * 8;
          *(LAS u32x4*)((arr ? wlo : whi) + e * RW_PITCH + c8) = *(const u32x4*)(src + ((size_t)arr * 32 + e) * 1024 + c8); } }
    const bf16_t* v = (const bf16_t*)(a->ws + WS_V); bf16_t* x1b = (bf16_t*)(a->ws + WS_X1B); unsigned char* x18 = a->ws + WS_X1;
    int* tke = (int*)(a->ws + WS_TKE); float* tkw = (float*)(a->ws + WS_TKW); int* ghist = (int*)(a->ws + WS_HIST);
    const float* lng = a->in[I_LN1G] + l * 1024; const float* lnb = a->in[I_LN1B] + l * 1024;
    const float rb0 = a->in[I_RB][l * 32 + tk], rb1 = a->in[I_RB][l * 32 + 16 + tk];
    for (int ch = blockIdx.x; ch < NCHUNK; ch += G) {
        __syncthreads();
        if (tid < 32) hist[tid] = 0;
        __syncthreads();
        const size_t t = (size_t)ch * CHTOK + wave * 16 + tk;
        const bf16_t* vr = v + t * 1024 + 8 * g;
        float s = 0.f, s2 = 0.f;
#pragma unroll 8
        for (int ks = 0; ks < 32; ++ks) { const u32x4 pw = *(const u32x4*)(vr + 32 * ks); const f32x4 p0 = (f32x4){bflo(pw.x), bfhi(pw.x), bflo(pw.y), bfhi(pw.y)}, p1 = (f32x4){bflo(pw.z), bfhi(pw.z), bflo(pw.w), bfhi(pw.w)};
            s += (p0[0] + p0[1]) + (p0[2] + p0[3]) + (p1[0] + p1[1]) + (p1[2] + p1[3]);
            s2 += (p0[0] * p0[0] + p0[1] * p0[1]) + (p0[2] * p0[2] + p0[3] * p0[3]) + (p1[0] * p1[0] + p1[1] * p1[1]) + (p1[2] * p1[2] + p1[3] * p1[3]); }
        s += __shfl_xor(s, 16); s += __shfl_xor(s, 32); s2 += __shfl_xor(s2, 16); s2 += __shfl_xor(s2, 32);
        const float mean = s * (1.0f / 1024.0f); const float rstd = rsqrtf(fmaxf(s2 * (1.0f / 1024.0f) - mean * mean, 0.f) + LN_EPS);
        f32x4 acc0 = (f32x4){0.f, 0.f, 0.f, 0.f}, acc1 = (f32x4){0.f, 0.f, 0.f, 0.f};
#pragma unroll 2
        for (int ks = 0; ks < 32; ++ks) { const int k0 = 32 * ks + 8 * g;
            const u32x4 pw = *(const u32x4*)(vr + 32 * ks); const f32x4 p0 = (f32x4){bflo(pw.x), bfhi(pw.x), bflo(pw.y), bfhi(pw.y)}, p1 = (f32x4){bflo(pw.z), bfhi(pw.z), bflo(pw.w), bfhi(pw.w)};
            const f32x4 g0 = *(const f32x4*)(lng + k0), g1 = *(const f32x4*)(lng + k0 + 4), b0 = *(const f32x4*)(lnb + k0), b1 = *(const f32x4*)(lnb + k0 + 4);
            const f32x4 y0 = (p0 - mean) * rstd * g0 + b0, y1 = (p1 - mean) * rstd * g1 + b1;
            u32x4 hw; hw.x = pg8::cvt_pk_bf16(y0[0], y0[1]); hw.y = pg8::cvt_pk_bf16(y0[2], y0[3]); hw.z = pg8::cvt_pk_bf16(y1[0], y1[1]); hw.w = pg8::cvt_pk_bf16(y1[2], y1[3]);
            *(u32x4*)(x1b + t * 1024 + k0) = hw;
            { u32x2 q8; q8.x = pk_fp8x4(y0[0] * F8_SX, y0[1] * F8_SX, y0[2] * F8_SX, y0[3] * F8_SX); q8.y = pk_fp8x4(y1[0] * F8_SX, y1[1] * F8_SX, y1[2] * F8_SX, y1[3] * F8_SX); *(u32x2*)(x18 + t * 1024 + k0) = q8; }
            u32x4 lw; lw.x = pg8::cvt_pk_bf16(y0[0] - bflo(hw.x), y0[1] - bfhi(hw.x)); lw.y = pg8::cvt_pk_bf16(y0[2] - bflo(hw.y), y0[3] - bfhi(hw.y));
            lw.z = pg8::cvt_pk_bf16(y1[0] - bflo(hw.z), y1[1] - bfhi(hw.z)); lw.w = pg8::cvt_pk_bf16(y1[2] - bflo(hw.w), y1[3] - bfhi(hw.w));
            const bf16x8 ah = __builtin_bit_cast(bf16x8, hw), al = __builtin_bit_cast(bf16x8, lw);
            const bf16x8 wh0 = *(const LAS bf16x8*)(whi + tk * RW_PITCH + k0), wh1 = *(const LAS bf16x8*)(whi + (16 + tk) * RW_PITCH + k0);
            const bf16x8 wl0 = *(const LAS bf16x8*)(wlo + tk * RW_PITCH + k0), wl1 = *(const LAS bf16x8*)(wlo + (16 + tk) * RW_PITCH + k0);
            acc0 = __builtin_amdgcn_mfma_f32_16x16x32_bf16(ah, wh0, acc0, 0, 0, 0); acc1 = __builtin_amdgcn_mfma_f32_16x16x32_bf16(ah, wh1, acc1, 0, 0, 0);
            acc0 = __builtin_amdgcn_mfma_f32_16x16x32_bf16(ah, wl0, acc0, 0, 0, 0); acc1 = __builtin_amdgcn_mfma_f32_16x16x32_bf16(ah, wl1, acc1, 0, 0, 0);
            acc0 = __builtin_amdgcn_mfma_f32_16x16x32_bf16(al, wh0, acc0, 0, 0, 0); acc1 = __builtin_amdgcn_mfma_f32_16x16x32_bf16(al, wh1, acc1, 0, 0, 0); }
#pragma unroll
        for (int r = 0; r < 4; ++r) {
            unsigned k0 = f2key(acc0[r] + rb0, tk), k1 = f2key(acc1[r] + rb1, 16 + tk);
            float tv[4]; int te[4];
#pragma unroll
            for (int k = 0; k < 4; ++k) { unsigned m = k0 > k1 ? k0 : k1;
#pragma unroll
                for (int o = 1; o < 16; o <<= 1) { const unsigned q = (unsigned)__shfl_xor((int)m, o); m = q > m ? q : m; }
                const int e = 31 - (int)(m & 31u); tv[k] = key2f(m); te[k] = e;
                if (e == tk) k0 = 0u; if (e == 16 + tk) k1 = 0u; }
            const float e1 = __expf(tv[1] - tv[0]), e2 = __expf(tv[2] - tv[0]), e3 = __expf(tv[3] - tv[0]); const float inv = 1.0f / (1.0f + e1 + e2 + e3);
            if (tk < 4) { const size_t tt = (size_t)ch * CHTOK + wave * 16 + 4 * g + r;
                const int ei = tk == 0 ? te[0] : (tk == 1 ? te[1] : (tk == 2 ? te[2] : te[3]));
                const float wi = (tk == 0 ? 1.0f : (tk == 1 ? e1 : (tk == 2 ? e2 : e3))) * inv;
                tke[tt * 4 + tk] = ei; tkw[tt * 4 + tk] = wi; __hip_atomic_fetch_add(&hist[ei], 1, __ATOMIC_RELAXED, __HIP_MEMORY_SCOPE_WORKGROUP); }
        }
        __syncthreads();
        if (tid < 32) ghist[ch * 32 + tid] = hist[tid];
    }
}

__device__ __forceinline__ void p6_slots(ArgsP a, LAS unsigned char* lds, int G) {
    int tid_ = threadIdx.x; asm volatile("" : "+v"(tid_)); const int tid = tid_, lane = tid & 63, wave = tid >> 6;
    LAS int* hs = (LAS int*)lds;
    LAS int* cnt = (LAS int*)(lds + 32768);
    LAS int* bst = (LAS int*)(lds + 32768 + 256);
    LAS int* te = (LAS int*)(lds + 36864);
    LAS int* sl = (LAS int*)(lds + 36864 + 2048);
    const int* ghist = (const int*)(a->ws + WS_HIST);
    for (int i = tid; i < NCHUNK * 32; i += 512) hs[i] = ghist[i];
    __syncthreads();
    if (tid < 32) { int run = 0; for (int ch = 0; ch < NCHUNK; ++ch) { const int c = hs[ch * 32 + tid]; hs[ch * 32 + tid] = run; run += c; } cnt[tid] = run; }
    __syncthreads();
    if (tid == 0) { int bs = 0; for (int e = 0; e < 32; ++e) { bst[e] = bs; bs += (cnt[e] + 255) >> 8; } bst[32] = bs; }
    __syncthreads();
    if (blockIdx.x == 0 && tid <= 32) ((int*)(a->ws + WS_META))[tid] = bst[tid];
    const int* tke = (const int*)(a->ws + WS_TKE); const float* tkw = (const float*)(a->ws + WS_TKW);
    int* slot = (int*)(a->ws + WS_SLOT); float* wbuf = (float*)(a->ws + WS_WBUF);
    int* tokb = (int*)(a->ws + WS_TOKB);
    for (int ch = blockIdx.x; ch < NCHUNK; ch += G) {
        __syncthreads();
        te[tid] = tke[(size_t)ch * 512 + tid];
        __syncthreads();
        if (tid < 32) { int rank = bst[tid] * 256 + hs[ch * 32 + tid]; for (int p = 0; p < 512; ++p) if (te[p] == tid) sl[p] = rank++; }
        __syncthreads();
        { const size_t pi = (size_t)ch * 512 + tid; const int s_ = sl[tid]; slot[pi] = s_; wbuf[s_] = tkw[pi]; tokb[s_] = ch * CHTOK + (tid >> 2); }
    }
    for (int e = blockIdx.x; e < 32; e += G) for (int s_ = bst[e] * 256 + cnt[e] + tid; s_ < bst[e + 1] * 256; s_ += 512) tokb[s_] = T_;
}
__device__ __forceinline__ int moe_table(ArgsP a, LAS unsigned char* lds) {
    int tid_ = threadIdx.x; asm volatile("" : "+v"(tid_)); const int tid = tid_;
    LAS int* bst = (LAS int*)(lds + MISC_OFF);
    LAS int* blk_e = (LAS int*)(lds + MISC_OFF + 256);
    __syncthreads();
    if (tid <= 32) bst[tid] = ((const int*)(a->ws + WS_META))[tid];
    __syncthreads();
    const int nb = bst[32];
    for (int rb = tid; rb < nb; rb += 512) { int e = 0; while (e < 31 && rb >= bst[e + 1]) ++e; blk_e[rb] = e; }
    __syncthreads();
    return nb;
}

__device__ __forceinline__ void p9_combine_ln2(ArgsP a, int l, float* xout, int G) {
    int tid_ = threadIdx.x; asm volatile("" : "+v"(tid_)); const int tid = tid_, lane = tid & 63, wave = tid >> 6;
    const bf16_t* x1b = (const bf16_t*)(a->ws + WS_X1B); const int* slot = (const int*)(a->ws + WS_SLOT);
    const bf16_t* ys = (const bf16_t*)(a->ws + WS_OV + OV_YS); bf16_t* xb = (bf16_t*)(a->ws + WS_XB);
    f32x4 gg[4], bb[4];
#pragma unroll
    for (int j = 0; j < 4; ++j) { gg[j] = *(const f32x4*)(a->in[I_LN2G] + l * 1024 + 4 * lane + 256 * j); bb[j] = *(const f32x4*)(a->in[I_LN2B] + l * 1024 + 4 * lane + 256 * j); }
    for (int blk = blockIdx.x * NWAVES + wave; blk < T_ / 16; blk += G * NWAVES) {
        const int sv = slot[(size_t)blk * 64 + lane];
        for (int k = 0; k < 16; k += 2) {
            u32x2 xw[2][4], yw[2][4][4];
#pragma unroll
            for (int q = 0; q < 2; ++q) { const size_t t = (size_t)blk * 16 + k + q;
#pragma unroll
                for (int j = 0; j < 4; ++j) xw[q][j] = *(const u32x2*)(x1b + t * 1024 + 4 * lane + 256 * j);
#pragma unroll
                for (int kk = 0; kk < 4; ++kk) { const size_t sr = (size_t)__builtin_amdgcn_readfirstlane(__shfl(sv, (k + q) * 4 + kk));
#pragma unroll
                    for (int j = 0; j < 4; ++j) yw[q][kk][j] = *(const u32x2*)(ys + sr * 1024 + 4 * lane + 256 * j); } }
#pragma unroll
            for (int q = 0; q < 2; ++q) { const size_t t = (size_t)blk * 16 + k + q;
                f32x4 xv[4]; float s = 0.f;
#pragma unroll
                for (int j = 0; j < 4; ++j) { xv[j] = (f32x4){bflo(xw[q][j].x), bfhi(xw[q][j].x), bflo(xw[q][j].y), bfhi(xw[q][j].y)} * DN_ALPHA;
#pragma unroll
                    for (int kk = 0; kk < 4; ++kk) { const u32x2 w = yw[q][kk][j]; xv[j][0] += bflo(w.x); xv[j][1] += bfhi(w.x); xv[j][2] += bflo(w.y); xv[j][3] += bfhi(w.y); }
                    s += (xv[j][0] + xv[j][1]) + (xv[j][2] + xv[j][3]); }
                const float mean = wave_sum(s) * (1.0f / 1024.0f); float s2 = 0.f;
#pragma unroll
                for (int j = 0; j < 4; ++j) { xv[j] = xv[j] - mean; s2 += (xv[j][0] * xv[j][0] + xv[j][1] * xv[j][1]) + (xv[j][2] * xv[j][2] + xv[j][3] * xv[j][3]); }
                const float rstd = rsqrtf(wave_sum(s2) * (1.0f / 1024.0f) + LN_EPS);
#pragma unroll
                for (int j = 0; j < 4; ++j) { xv[j] = xv[j] * rstd * gg[j] + bb[j];
                    if (xout) *(f32x4*)(xout + t * 1024 + 4 * lane + 256 * j) = xv[j];
                    u32x2 w; w.x = pk2(xv[j][0], xv[j][1]); w.y = pk2(xv[j][2], xv[j][3]); *(u32x2*)(xb + t * 1024 + 4 * lane + 256 * j) = w; } }
        }
    }
}
typedef float f32x4_t __attribute__((ext_vector_type(4)));
constexpr size_t MX_LRU_PH = 0, MX_LRU_CARRY = 4 * MiB;
template <int MODE> __device__ __forceinline__ void lru_fast(ArgsP a, int l, int b, int h, int c_lo, int c_hi, LAS unsigned char* lds, const bf16_t* proj, bf16_t* H, unsigned char* mxs) {
    int tid_ = threadIdx.x; asm volatile("" : "+v"(tid_)); const int tid = tid_, lane = tid & 63, wave = __builtin_amdgcn_readfirstlane(tid >> 6), fr = lane & 15, g = lane >> 4;
    LAS bf16_t* xa = (LAS bf16_t*)(lds);
    LAS bf16_t* ysb = (LAS bf16_t*)(lds + 17408);
    LAS bf16_t* outb = (LAS bf16_t*)(lds + 33792);
    LAS bf16_t* outc = (LAS bf16_t*)(lds + 50176);
    bf16_t* HL = (bf16_t*)(a->ws + WS_MB); bf16_t* CA = (bf16_t*)(a->ws + WS_X1B);
    float* PH = (float*)(mxs + MX_LRU_PH); const float* carry = (const float*)(mxs + MX_LRU_CARRY);
    const int ch = 16 * wave + fr, chg = h * 128 + ch;
    const bf16_t* wg = (const bf16_t*)(a->ws + WS_W + (size_t)l * WL_STRIDE + WL_G) + (size_t)h * 256 * 128;
    bf16x8 bra[4], brx[4];
#pragma unroll
    for (int ks = 0; ks < 4; ++ks) { bra[ks] = *(const bf16x8*)(wg + (size_t)(ch) * 128 + 32 * ks + 8 * g); brx[ks] = *(const bf16x8*)(wg + (size_t)(128 + ch) * 128 + 32 * ks + 8 * g); }
    const float ba = a->in[I_LBA][l * 1024 + chg], bx = a->in[I_LBX][l * 1024 + chg], sp = softplus_f(-a->in[I_LLAM][l * 1024 + chg]);
    const int cg = tid & 15, t0i = tid >> 4;
    float cwv[4][8], cbv[8];
    { const float* cw = a->in[I_LCW] + (size_t)l * 4 * 1024 + h * 128 + 8 * cg;
#pragma unroll
      for (int j = 0; j < 4; ++j) { const f32x4 w0 = *(const f32x4*)(cw + j * 1024), w1 = *(const f32x4*)(cw + j * 1024 + 4);
          cwv[j][0] = w0[0]; cwv[j][1] = w0[1]; cwv[j][2] = w0[2]; cwv[j][3] = w0[3]; cwv[j][4] = w1[0]; cwv[j][5] = w1[1]; cwv[j][6] = w1[2]; cwv[j][7] = w1[3]; }
      const float* cbp = a->in[I_LCB] + l * 1024 + h * 128 + 8 * cg; const f32x4 b0 = *(const f32x4*)(cbp), b1 = *(const f32x4*)(cbp + 4);
      cbv[0] = b0[0]; cbv[1] = b0[1]; cbv[2] = b0[2]; cbv[3] = b0[3]; cbv[4] = b1[0]; cbv[5] = b1[1]; cbv[6] = b1[2]; cbv[7] = b1[3]; }
    u32x4 pr[2][4], py[2];
#define LRU_ISSUE(c_) do { _Pragma("unroll") for (int i = 0; i < 2; ++i) { const int tl = (c_) * 64 + t0i + 32 * i; \
        _Pragma("unroll") for (int j = 0; j < 4; ++j) { const int tt_ = tl - 3 + j; pr[i][j] = (u32x4){0u, 0u, 0u, 0u}; \
            if (tt_ >= 0) pr[i][j] = *(const u32x4*)(proj + ((size_t)b * SEQ_ + tt_) * NPROJ + PC_LRUX + h * 128 + 8 * cg); } \
        if (MODE == 1) py[i] = *(const u32x4*)(proj + ((size_t)b * SEQ_ + tl) * NPROJ + PC_LRUY + h * 128 + 8 * cg); } } while (0)
    LRU_ISSUE(c_lo);
    for (int c = c_lo; c < c_hi; ++c) {
        const size_t tok0 = (size_t)b * SEQ_ + (size_t)c * 64;
        __syncthreads();
#pragma unroll
        for (int i = 0; i < 2; ++i) { float o[8];
#pragma unroll
            for (int q = 0; q < 8; ++q) o[q] = cbv[q];
#pragma unroll
            for (int j = 0; j < 4; ++j) { const unsigned x[4] = {pr[i][j].x, pr[i][j].y, pr[i][j].z, pr[i][j].w};
#pragma unroll
                for (int q = 0; q < 4; ++q) { o[2 * q] += cwv[j][2 * q] * bflo(x[q]); o[2 * q + 1] += cwv[j][2 * q + 1] * bfhi(x[q]); } }
            u32x4 w; w.x = pg8::cvt_pk_bf16(o[0], o[1]); w.y = pg8::cvt_pk_bf16(o[2], o[3]); w.z = pg8::cvt_pk_bf16(o[4], o[5]); w.w = pg8::cvt_pk_bf16(o[6], o[7]);
            *(LAS u32x4*)(xa + (t0i + 32 * i) * 136 + 8 * cg) = w;
            if (MODE == 1) *(LAS u32x4*)(ysb + (t0i + 32 * i) * 128 + 8 * cg) = py[i]; }
        if (c + 1 < c_hi) LRU_ISSUE(c + 1);
        __syncthreads();
        f32x4_t ar[4], ax[4];
#pragma unroll
        for (int tt = 0; tt < 4; ++tt) { ar[tt] = (f32x4_t){0.f, 0.f, 0.f, 0.f}; ax[tt] = (f32x4_t){0.f, 0.f, 0.f, 0.f}; }
#pragma unroll
        for (int tt = 0; tt < 4; ++tt)
#pragma unroll
            for (int ks = 0; ks < 4; ++ks) { const bf16x8 af = *(const LAS bf16x8*)(xa + (16 * tt + fr) * 136 + 32 * ks + 8 * g);
                ar[tt] = __builtin_amdgcn_mfma_f32_16x16x32_bf16(af, bra[ks], ar[tt], 0, 0, 0);
                ax[tt] = __builtin_amdgcn_mfma_f32_16x16x32_bf16(af, brx[ks], ax[tt], 0, 0, 0); }
        float av[4][4], uv[4][4], Ai[4], Bi[4];
#pragma unroll
        for (int tt = 0; tt < 4; ++tt) { float A = 1.f, B = 0.f;
#pragma unroll
            for (int r = 0; r < 4; ++r) { const int t = 16 * tt + 4 * g + r;
                const float rg = sigmoid_f(ar[tt][r] + ba), ig = sigmoid_f(ax[tt][r] + bx);
                const float log_a = -8.0f * rg * sp; av[tt][r] = __expf(log_a); uv[tt][r] = __builtin_amdgcn_sqrtf(neg_expm1_f(2.0f * log_a)) * (ig * bf2f(xa[t * 136 + ch]));
                B = av[tt][r] * B + uv[tt][r]; A *= av[tt][r]; }
            Ai[tt] = A; Bi[tt] = B; }
#pragma unroll
        for (int tt = 0; tt < 4; ++tt) { const float A1 = __shfl_up(Ai[tt], 16), B1 = __shfl_up(Bi[tt], 16); if (g >= 1) { Bi[tt] = Ai[tt] * B1 + Bi[tt]; Ai[tt] = Ai[tt] * A1; } }
#pragma unroll
        for (int tt = 0; tt < 4; ++tt) { const float A2 = __shfl_up(Ai[tt], 32), B2 = __shfl_up(Bi[tt], 32); if (g >= 2) { Bi[tt] = Ai[tt] * B2 + Bi[tt]; Ai[tt] = Ai[tt] * A2; } }
        float Ae[4], Be[4], At[4], Bt[4];
#pragma unroll
        for (int tt = 0; tt < 4; ++tt) { Ae[tt] = __shfl_up(Ai[tt], 16); Be[tt] = __shfl_up(Bi[tt], 16); if (g == 0) { Ae[tt] = 1.f; Be[tt] = 0.f; }
            At[tt] = __shfl(Ai[tt], fr + 48); Bt[tt] = __shfl(Bi[tt], fr + 48); }
        float hin = 0.f, ptot = 1.f;
        if (MODE == 1) hin = carry[((size_t)b * 64 + c) * 1024 + chg];
#pragma unroll
        for (int tt = 0; tt < 4; ++tt) {
            float hcur = Ae[tt] * hin + Be[tt], ccur = ptot * Ae[tt];
#pragma unroll
            for (int r = 0; r < 4; ++r) { const int t = 16 * tt + 4 * g + r; hcur = av[tt][r] * hcur + uv[tt][r]; ccur *= av[tt][r];
                if (MODE == 1) outb[t * 128 + ch] = (bf16_t)f2bf(hcur * gelu_tanh_f(bf2f(ysb[t * 128 + ch])));
                else { outb[t * 128 + ch] = (bf16_t)f2bf(hcur); outc[t * 128 + ch] = (bf16_t)f2bf(ccur); } }
            hin = At[tt] * hin + Bt[tt]; ptot *= At[tt]; }
        if (MODE == 0) { if (g == 0) { PH[(((size_t)b * 64 + c) * 2 + 0) * 1024 + chg] = ptot; PH[(((size_t)b * 64 + c) * 2 + 1) * 1024 + chg] = hin; } }
        __syncthreads();
#pragma unroll
        for (int i = 0; i < 2; ++i) { const int pid = tid + 512 * i; const int row = pid >> 4, c8 = (pid & 15) * 8;
            if (MODE == 1) *(u32x4*)(H + (tok0 + row) * 2048 + h * 128 + c8) = *(const LAS u32x4*)(outb + row * 128 + c8);
            else { *(u32x4*)(HL + (tok0 + row) * 1024 + h * 128 + c8) = *(const LAS u32x4*)(outb + row * 128 + c8); *(u32x4*)(CA + (tok0 + row) * 1024 + h * 128 + c8) = *(const LAS u32x4*)(outc + row * 128 + c8); } }
    }
#undef LRU_ISSUE
}
__device__ __forceinline__ void lru_carry(unsigned char* mxs, int G) {
    const float* PH = (const float*)(mxs + MX_LRU_PH); float* carry = (float*)(mxs + MX_LRU_CARRY);
    int tid_ = threadIdx.x; asm volatile("" : "+v"(tid_));
    for (int gid = blockIdx.x * 512 + tid_; gid < NBATCH * 1024; gid += G * 512) { const int b = gid >> 10, chg = gid & 1023; float hc = 0.f;
#pragma unroll 8
        for (int c = 0; c < 64; ++c) { const size_t o = ((size_t)b * 64 + c); carry[o * 1024 + chg] = hc; hc = PH[(o * 2) * 1024 + chg] * hc + PH[(o * 2 + 1) * 1024 + chg]; } }
}
__device__ __forceinline__ void lru_apply(ArgsP a, const bf16_t* proj, bf16_t* H, unsigned char* mxs, int first, int stride) {
    int tid_ = threadIdx.x; asm volatile("" : "+v"(tid_));
    const bf16_t* HL = (const bf16_t*)(a->ws + WS_MB); const bf16_t* CA = (const bf16_t*)(a->ws + WS_X1B); const float* carry = (const float*)(mxs + MX_LRU_CARRY);
    for (size_t p = (size_t)first * 512 + tid_; p < (size_t)T_ * 128; p += (size_t)stride * 512) { const size_t t = p >> 7; const int c8 = (int)(p & 127) * 8;
        const u32x4 hw = *(const u32x4*)(HL + t * 1024 + c8), cw = *(const u32x4*)(CA + t * 1024 + c8), yw = *(const u32x4*)(proj + t * NPROJ + PC_LRUY + c8);
        const float* cp = carry + (t >> 6) * 1024 + c8; const f32x4 c0 = *(const f32x4*)(cp), c1 = *(const f32x4*)(cp + 4);
        const unsigned hh[4] = {hw.x, hw.y, hw.z, hw.w}, cc[4] = {cw.x, cw.y, cw.z, cw.w}, yy[4] = {yw.x, yw.y, yw.z, yw.w}; const float cin[8] = {c0[0], c0[1], c0[2], c0[3], c1[0], c1[1], c1[2], c1[3]};
        unsigned o[4];
#pragma unroll
        for (int q = 0; q < 4; ++q) { const float h0 = bflo(hh[q]) + bflo(cc[q]) * cin[2 * q], h1 = bfhi(hh[q]) + bfhi(cc[q]) * cin[2 * q + 1];
            o[q] = pg8::cvt_pk_bf16(h0 * gelu_tanh_f(bflo(yy[q])), h1 * gelu_tanh_f(bfhi(yy[q]))); }
        *(u32x4*)(H + t * 2048 + c8) = (u32x4){o[0], o[1], o[2], o[3]}; }
}
typedef float f32x16 __attribute__((ext_vector_type(16)));
typedef short bf16x4 __attribute__((ext_vector_type(4)));
constexpr size_t MXB_ML_U = 0;
constexpr size_t MXB_ML_CP = 64 * MiB;
constexpr size_t MXS_ML_NU = 6 * MiB, MXS_ML_NP = 6 * MiB + 512 * 1024, MXS_ML_SC = 7 * MiB;

__device__ __forceinline__ float bperm_f(int src_lane, float v) { return __builtin_bit_cast(float, __builtin_amdgcn_ds_bpermute(src_lane << 2, __builtin_bit_cast(int, v))); }
__device__ __forceinline__ float wave_incl_sum(float v, int lane) {
#pragma unroll
    for (int o = 1; o < 64; o <<= 1) { const float t = bperm_f(lane >= o ? lane - o : lane, v); if (lane >= o) v += t; }
    return v;
}
__device__ __forceinline__ float wave_incl_max(float v, int lane) {
#pragma unroll
    for (int o = 1; o < 64; o <<= 1) { const float t = bperm_f(lane >= o ? lane - o : lane, v); if (lane >= o) v = fmaxf(v, t); }
    return v;
}
__device__ __forceinline__ bf16x8 pack8(float a0, float a1, float a2, float a3, float a4, float a5, float a6, float a7) {
    u32x4 w; w.x = pg8::cvt_pk_bf16(a0, a1); w.y = pg8::cvt_pk_bf16(a2, a3); w.z = pg8::cvt_pk_bf16(a4, a5); w.w = pg8::cvt_pk_bf16(a6, a7); return __builtin_bit_cast(bf16x8, w);
}
__device__ __forceinline__ bf16x8 ld_perm(const LAS bf16_t* p) {
    const u32x2 lo = *(const LAS u32x2*)(p), hi = *(const LAS u32x2*)(p + 8); u32x4 w; w.x = lo.x; w.y = lo.y; w.z = hi.x; w.w = hi.y; return __builtin_bit_cast(bf16x8, w);
}

__device__ __forceinline__ void mlstm_passA(ArgsP a, int l, LAS unsigned char* lds, const bf16_t* proj, const float* gsm, unsigned char* mxb, unsigned char* mxs, int G) {
    int tid_ = threadIdx.x; asm volatile("" : "+v"(tid_)); const int tid = tid_, lane = tid & 63, wave = __builtin_amdgcn_readfirstlane(tid >> 6), r = lane & 31, hh = lane >> 5;
    LAS bf16_t* kwT = (LAS bf16_t*)(lds);
    LAS bf16_t* vT = (LAS bf16_t*)(lds + 9216);
    LAS float* wts = (LAS float*)(lds + 27648);
    float* NU = (float*)(mxs + MXS_ML_NU); float* SC = (float*)(mxs + MXS_ML_SC);
    for (int uid = blockIdx.x; uid < 2048; uid += G) {
        const int c = uid & 63, hd = (uid >> 6) & 3, b = uid >> 8; const size_t tok0 = (size_t)b * SEQ_ + (size_t)c * 64;
        const float ib = a->in[I_MIB][l * 4 + hd], fb = a->in[I_MFB][l * 4 + hd];
        __syncthreads();
        if (wave == 0) {
            const float fpre = gsm[(tok0 + lane) * 32 + 4 + hd] + fb, ipre = gsm[(tok0 + lane) * 32 + hd] + ib;
            const float logf = -softplus_f(-fpre); const float bc = wave_incl_sum(logf, lane); const float bl = __builtin_bit_cast(float, __builtin_amdgcn_readlane(__builtin_bit_cast(int, bc), 63));
            const float ge = bl - bc + ipre; const float mloc = wave_max(ge);
            wts[lane] = __expf(ge - mloc);
            if (lane == 0) { SC[(size_t)uid * 4 + 0] = bl; SC[(size_t)uid * 4 + 1] = mloc; }
        }
        const u32x4 kp = *(const u32x4*)(proj + (tok0 + lane) * NPROJ + PC_MLK + hd * 64 + wave * 8);
        const u32x4 vp0 = *(const u32x4*)(proj + (tok0 + lane) * NPROJ + PC_MLV + hd * 128 + wave * 8);
        const u32x4 vp1 = *(const u32x4*)(proj + (tok0 + lane) * NPROJ + PC_MLV + hd * 128 + 64 + wave * 8);
        __syncthreads();
        { const float w = wts[lane]; const unsigned kw[4] = {kp.x, kp.y, kp.z, kp.w};
#pragma unroll
          for (int j = 0; j < 4; ++j) { kwT[(wave * 8 + 2 * j) * 72 + lane] = (bf16_t)f2bf(w * bflo(kw[j])); kwT[(wave * 8 + 2 * j + 1) * 72 + lane] = (bf16_t)f2bf(w * bfhi(kw[j])); }
          const unsigned v0[4] = {vp0.x, vp0.y, vp0.z, vp0.w}, v1[4] = {vp1.x, vp1.y, vp1.z, vp1.w};
#pragma unroll
          for (int j = 0; j < 4; ++j) { vT[(wave * 8 + 2 * j) * 72 + lane] = (bf16_t)(v0[j] & 0xffffu); vT[(wave * 8 + 2 * j + 1) * 72 + lane] = (bf16_t)(v0[j] >> 16);
              vT[(64 + wave * 8 + 2 * j) * 72 + lane] = (bf16_t)(v1[j] & 0xffffu); vT[(64 + wave * 8 + 2 * j + 1) * 72 + lane] = (bf16_t)(v1[j] >> 16); } }
        __syncthreads();
        const int dI = wave >> 2, eJ = wave & 3;
        f32x16 acc;
#pragma unroll
        for (int i = 0; i < 16; ++i) acc[i] = 0.f;
#pragma unroll
        for (int ks = 0; ks < 4; ++ks) { const bf16x8 af = *(const LAS bf16x8*)(kwT + (32 * dI + r) * 72 + 16 * ks + 8 * hh), bf = *(const LAS bf16x8*)(vT + (32 * eJ + r) * 72 + 16 * ks + 8 * hh);
            acc = __builtin_amdgcn_mfma_f32_32x32x16_bf16(af, bf, acc, 0, 0, 0); }
        float* ud = (float*)(mxb + MXB_ML_U) + ((size_t)uid * 8 + wave) * 1024;
#pragma unroll
        for (int q = 0; q < 4; ++q) *(f32x4*)(ud + (q * 64 + lane) * 4) = (f32x4){acc[4 * q], acc[4 * q + 1], acc[4 * q + 2], acc[4 * q + 3]};
        if (tid < 64) { float s = 0.f;
#pragma unroll 8
            for (int t = 0; t < 64; ++t) s += bf2f(kwT[tid * 72 + t]);
            NU[(size_t)uid * 64 + tid] = s; }
    }
}
__device__ __forceinline__ void mlstm_passB(unsigned char* mxb, unsigned char* mxs, int G) {
    int tid_ = threadIdx.x; asm volatile("" : "+v"(tid_)); const int tid = tid_;
    const float* NU = (const float*)(mxs + MXS_ML_NU); float* NP = (float*)(mxs + MXS_ML_NP); float* SC = (float*)(mxs + MXS_ML_SC);
    for (int wu = blockIdx.x; wu < 256; wu += G) {
        const int chain = wu >> 3, tile = wu & 7;
        if (tid < 128) {
            const int lane = tid & 63, s = tid >> 6;
            float st[8]; float m = 0.f;
#pragma unroll
            for (int i = 0; i < 8; ++i) st[i] = 0.f;
#pragma unroll 4
            for (int c = 0; c < 64; ++c) { const size_t uid = (size_t)chain * 64 + c;
                const float* ud = (const float*)(mxb + MXB_ML_U) + (uid * 8 + tile) * 1024;
                const f32x4 u0 = *(const f32x4*)(ud + ((2 * s) * 64 + lane) * 4), u1 = *(const f32x4*)(ud + ((2 * s + 1) * 64 + lane) * 4);
                const float bl = SC[uid * 4 + 0], mloc = SC[uid * 4 + 1];
                *(bf16x8*)((bf16_t*)(mxb + MXB_ML_CP) + (uid * 8 + tile) * 1024 + (s * 64 + lane) * 8) = pack8(st[0], st[1], st[2], st[3], st[4], st[5], st[6], st[7]);
                if (tile == 0 && tid == 0) SC[uid * 4 + 2] = m;
                const float mn = fmaxf(bl + m, mloc), dec = __expf(bl + m - mn), sc = __expf(mloc - mn); m = mn;
#pragma unroll
                for (int i = 0; i < 4; ++i) { st[i] = dec * st[i] + sc * u0[i]; st[4 + i] = dec * st[4 + i] + sc * u1[i]; } }
        } else if (tile == 0 && tid < 192) {
            const int d = tid - 128; float n = 0.f, m = 0.f;
#pragma unroll 4
            for (int c = 0; c < 64; ++c) { const size_t uid = (size_t)chain * 64 + c; const float bl = SC[uid * 4 + 0], mloc = SC[uid * 4 + 1]; const float nu = NU[uid * 64 + d];
                NP[uid * 64 + d] = n; const float mn = fmaxf(bl + m, mloc), dec = __expf(bl + m - mn), sc = __expf(mloc - mn); m = mn; n = dec * n + sc * nu; }
        }
    }
}
__device__ __forceinline__ void mlstm_passC(ArgsP a, int l, LAS unsigned char* lds, const bf16_t* proj, const float* gsm, bf16_t* H, unsigned char* mxb, unsigned char* mxs, int first, int stride) {
    int tid_ = threadIdx.x; asm volatile("" : "+v"(tid_)); const int tid = tid_, lane = tid & 63, wave = __builtin_amdgcn_readfirstlane(tid >> 6), r = lane & 31, hh = lane >> 5;
    LAS bf16_t* qb = (LAS bf16_t*)(lds);
    LAS bf16_t* kb = (LAS bf16_t*)(lds + 9216);
    LAS bf16_t* vT = (LAS bf16_t*)(lds + 18432);
    LAS bf16_t* ob = (LAS bf16_t*)(lds + 36864);
    LAS bf16_t* outb = (LAS bf16_t*)(lds + 54272);
    LAS float* tb_rt = (LAS float*)(lds + 70656);
    LAS float* tb_ct = tb_rt + 64;
    LAS float* tb_iw = tb_rt + 128;
    LAS float* tb_em = tb_rt + 192;
    LAS float* tb_np = tb_rt + 256;
    LAS float* ssq = tb_rt + 320;
    const float* NP = (const float*)(mxs + MXS_ML_NP); const float* SC = (const float*)(mxs + MXS_ML_SC);
    for (int uid = first; uid < 2048; uid += stride) {
        const int c = uid & 63, hd = (uid >> 6) & 3, b = uid >> 8; const size_t tok0 = (size_t)b * SEQ_ + (size_t)c * 64;
        __syncthreads();
        if (wave == 0) {
            const float ib = a->in[I_MIB][l * 4 + hd], fb = a->in[I_MFB][l * 4 + hd];
            const float fpre = gsm[(tok0 + lane) * 32 + 4 + hd] + fb, ipre = gsm[(tok0 + lane) * 32 + hd] + ib;
            const float logf = -softplus_f(-fpre); const float bc = wave_incl_sum(logf, lane);
            const float rt = ipre - bc; const float cmx = wave_incl_max(rt, lane); const float mprev = SC[(size_t)uid * 4 + 2];
            const float mt = bc + fmaxf(mprev, cmx);
            tb_rt[lane] = rt; tb_ct[lane] = bc - mt; tb_iw[lane] = __expf(bc + mprev - mt); tb_em[lane] = __expf(-mt); tb_np[lane] = NP[(size_t)uid * 64 + lane];
        }
        { const int row = tid >> 3, c8 = (tid & 7) * 8;
          *(LAS u32x4*)(qb + row * 72 + c8) = *(const u32x4*)(proj + (tok0 + row) * NPROJ + PC_MLQ + hd * 64 + c8);
          *(LAS u32x4*)(kb + row * 72 + c8) = *(const u32x4*)(proj + (tok0 + row) * NPROJ + PC_MLK + hd * 64 + c8);
#pragma unroll
          for (int i = 0; i < 2; ++i) { const int pid = tid + 512 * i; const int orow = pid >> 4, oc8 = (pid & 15) * 8;
              *(LAS u32x4*)(ob + orow * 136 + oc8) = *(const u32x4*)(proj + (tok0 + orow) * NPROJ + PC_MLO + hd * 128 + oc8); }
          const u32x4 vp0 = *(const u32x4*)(proj + (tok0 + lane) * NPROJ + PC_MLV + hd * 128 + wave * 8);
          const u32x4 vp1 = *(const u32x4*)(proj + (tok0 + lane) * NPROJ + PC_MLV + hd * 128 + 64 + wave * 8);
          const unsigned v0[4] = {vp0.x, vp0.y, vp0.z, vp0.w}, v1[4] = {vp1.x, vp1.y, vp1.z, vp1.w};
#pragma unroll
          for (int j = 0; j < 4; ++j) { vT[(wave * 8 + 2 * j) * 72 + lane] = (bf16_t)(v0[j] & 0xffffu); vT[(wave * 8 + 2 * j + 1) * 72 + lane] = (bf16_t)(v0[j] >> 16);
              vT[(64 + wave * 8 + 2 * j) * 72 + lane] = (bf16_t)(v1[j] & 0xffffu); vT[(64 + wave * 8 + 2 * j + 1) * 72 + lane] = (bf16_t)(v1[j] >> 16); } }
        __syncthreads();
        const int eI = wave >> 1, tJ = wave & 1; const int t = 32 * tJ + r;
        f32x16 as[2];
#pragma unroll
        for (int sI = 0; sI < 2; ++sI) {
#pragma unroll
            for (int i = 0; i < 16; ++i) as[sI][i] = 0.f;
#pragma unroll
            for (int ks = 0; ks < 4; ++ks) { const bf16x8 af = *(const LAS bf16x8*)(kb + (32 * sI + r) * 72 + 16 * ks + 8 * hh), bf = *(const LAS bf16x8*)(qb + t * 72 + 16 * ks + 8 * hh);
                as[sI] = __builtin_amdgcn_mfma_f32_32x32x16_bf16(af, bf, as[sI], 0, 0, 0); } }
        const float ctt = tb_ct[t], iwt = tb_iw[t] * 0.125f, emt = tb_em[t];
        float dsum = 0.f;
#pragma unroll
        for (int sI = 0; sI < 2; ++sI)
#pragma unroll
            for (int q = 0; q < 4; ++q) { const int s0 = 32 * sI + 8 * q + 4 * hh; const f32x4 rt4 = *(const LAS f32x4*)(tb_rt + s0);
#pragma unroll
                for (int i = 0; i < 4; ++i) { const float wv = (s0 + i <= t) ? as[sI][4 * q + i] * 0.125f * __expf(ctt + rt4[i]) : 0.f; as[sI][4 * q + i] = wv; dsum += wv; } }
        float qn = 0.f;
#pragma unroll
        for (int j = 0; j < 4; ++j) { const u32x4 qw = *(const LAS u32x4*)(qb + t * 72 + 32 * hh + 8 * j); const f32x4 n0 = *(const LAS f32x4*)(tb_np + 32 * hh + 8 * j), n1 = *(const LAS f32x4*)(tb_np + 32 * hh + 8 * j + 4);
            qn += bflo(qw.x) * n0[0] + bfhi(qw.x) * n0[1] + bflo(qw.y) * n0[2] + bfhi(qw.y) * n0[3] + bflo(qw.z) * n1[0] + bfhi(qw.z) * n1[1] + bflo(qw.w) * n1[2] + bfhi(qw.w) * n1[3]; }
        float den = dsum + iwt * qn; den += __shfl_xor(den, 32);
        f32x16 an;
#pragma unroll
        for (int i = 0; i < 16; ++i) an[i] = 0.f;
#pragma unroll
        for (int sI = 0; sI < 2; ++sI)
#pragma unroll
            for (int s2 = 0; s2 < 2; ++s2) { const bf16x8 af = ld_perm(vT + (32 * eI + r) * 72 + 32 * sI + 16 * s2 + 4 * hh);
                const bf16x8 bf = pack8(as[sI][8 * s2], as[sI][8 * s2 + 1], as[sI][8 * s2 + 2], as[sI][8 * s2 + 3], as[sI][8 * s2 + 4], as[sI][8 * s2 + 5], as[sI][8 * s2 + 6], as[sI][8 * s2 + 7]);
                an = __builtin_amdgcn_mfma_f32_32x32x16_bf16(af, bf, an, 0, 0, 0); }
        const bf16_t* cpd = (const bf16_t*)(mxb + MXB_ML_CP) + (size_t)uid * 8 * 1024;
#pragma unroll
        for (int dI = 0; dI < 2; ++dI)
#pragma unroll
            for (int s2 = 0; s2 < 2; ++s2) { const bf16x8 af = *(const bf16x8*)(cpd + (size_t)(dI * 4 + eI) * 1024 + (s2 * 64 + lane) * 8);
                const u32x4 qw = __builtin_bit_cast(u32x4, ld_perm(qb + t * 72 + 32 * dI + 16 * s2 + 4 * hh));
                const bf16x8 bf = pack8(bflo(qw.x) * iwt, bfhi(qw.x) * iwt, bflo(qw.y) * iwt, bfhi(qw.y) * iwt, bflo(qw.z) * iwt, bfhi(qw.z) * iwt, bflo(qw.w) * iwt, bfhi(qw.w) * iwt);
                an = __builtin_amdgcn_mfma_f32_32x32x16_bf16(af, bf, an, 0, 0, 0); }
        const float dinv = 1.0f / fmaxf(fabsf(den), emt);
        float sq = 0.f;
#pragma unroll
        for (int i = 0; i < 16; ++i) { an[i] *= dinv; sq += an[i] * an[i]; }
        sq += __shfl_xor(sq, 32);
        if (hh == 0) ssq[eI * 64 + t] = sq;
        __syncthreads();
        const float tot = ssq[t] + ssq[64 + t] + ssq[128 + t] + ssq[192 + t];
        const float rinv = rsqrtf(tot * (1.0f / 128.0f) + RMS_EPS);
        const float* gn = a->in[I_MNG] + (size_t)l * 512 + hd * 128;
#pragma unroll
        for (int q = 0; q < 4; ++q) { const int e0 = 32 * eI + 8 * q + 4 * hh; const f32x4 g4 = *(const f32x4*)(gn + e0); const u32x2 ow = *(const LAS u32x2*)(ob + t * 136 + e0);
            const float o0 = an[4 * q] * rinv * g4[0] * sigmoid_f(bflo(ow.x)), o1 = an[4 * q + 1] * rinv * g4[1] * sigmoid_f(bfhi(ow.x));
            const float o2 = an[4 * q + 2] * rinv * g4[2] * sigmoid_f(bflo(ow.y)), o3 = an[4 * q + 3] * rinv * g4[3] * sigmoid_f(bfhi(ow.y));
            u32x2 pw; pw.x = pg8::cvt_pk_bf16(o0, o1); pw.y = pg8::cvt_pk_bf16(o2, o3); *(LAS u32x2*)(outb + t * 128 + e0) = pw; }
        __syncthreads();
#pragma unroll
        for (int i = 0; i < 2; ++i) { const int pid = tid + 512 * i; const int row = pid >> 4, c8 = (pid & 15) * 8;
            *(u32x4*)(H + (tok0 + row) * 2048 + 1024 + hd * 128 + c8) = *(const LAS u32x4*)(outb + row * 128 + c8); }
    }
}
constexpr size_t MXB_GD_ND = 96 * MiB, MXB_GD_OD = 160 * MiB, MXB_GD_T = 224 * MiB;
constexpr size_t MXT_GD_XD = 8 * MiB, MXT_GD_QD = 40 * MiB, MXT_GD_SD = 72 * MiB;
constexpr size_t MXS_GD_GL = 7 * MiB + 64 * 1024;

__device__ __forceinline__ void conv_silu8(const u32x4 (&rw)[4], const float* cw, float (&o)[8]) {
#pragma unroll
    for (int j = 0; j < 8; ++j) o[j] = 0.f;
#pragma unroll
    for (int i = 0; i < 4; ++i) { const f32x4 w0 = *(const f32x4*)(cw + i * 1536), w1 = *(const f32x4*)(cw + i * 1536 + 4); const unsigned x[4] = {rw[i].x, rw[i].y, rw[i].z, rw[i].w};
        o[0] += w0[0] * bflo(x[0]); o[1] += w0[1] * bfhi(x[0]); o[2] += w0[2] * bflo(x[1]); o[3] += w0[3] * bfhi(x[1]);
        o[4] += w1[0] * bflo(x[2]); o[5] += w1[1] * bfhi(x[2]); o[6] += w1[2] * bflo(x[3]); o[7] += w1[3] * bfhi(x[3]); }
#pragma unroll
    for (int j = 0; j < 8; ++j) o[j] = silu_f(o[j]);
}
__device__ __forceinline__ void load_rows4(const bf16_t* proj, int b, int tl, int col, u32x4 (&rw)[4]) {
#pragma unroll
    for (int i = 0; i < 4; ++i) { const int tt = tl - 3 + i; rw[i] = (u32x4){0u, 0u, 0u, 0u}; if (tt >= 0) rw[i] = *(const u32x4*)(proj + ((size_t)b * SEQ_ + tt) * NPROJ + col); }
}

__device__ __forceinline__ void gdn_passA1(ArgsP a, int l, LAS unsigned char* lds, const bf16_t* proj, const float* gsm, unsigned char* mxb, int G) {
    int tid_ = threadIdx.x; asm volatile("" : "+v"(tid_)); const int tid = tid_, lane = tid & 63, wave = __builtin_amdgcn_readfirstlane(tid >> 6), r = lane & 31, hh = lane >> 5;
    LAS unsigned char* wl = lds + wave * 16384;
    LAS bf16_t* kb = (LAS bf16_t*)wl;
    LAS float* am = (LAS float*)wl;
    LAS float* tb = (LAS float*)(lds + MISC_OFF + 1024 + wave * 512);
    const float* cwk = a->in[I_GCW] + (size_t)l * 4 * 1536 + 512;
    for (int uid = blockIdx.x * NWAVES + wave; uid < 4096; uid += G * NWAVES) {
        const int c = uid & 63, hd = (uid >> 6) & 7, b = uid >> 9; const int tl = c * 64 + lane; const size_t tok = (size_t)b * SEQ_ + tl;
        float ss = 0.f;
#pragma unroll 2
        for (int p = 0; p < 8; ++p) { u32x4 rw[4]; load_rows4(proj, b, tl, PC_GDK + hd * 64 + 8 * p, rw); float o[8]; conv_silu8(rw, cwk + hd * 64 + 8 * p, o);
#pragma unroll
            for (int j = 0; j < 8; ++j) ss += o[j] * o[j];
            *(LAS bf16x8*)(kb + lane * 72 + 8 * p) = pack8(o[0], o[1], o[2], o[3], o[4], o[5], o[6], o[7]); }
        const float rn = rsqrtf(ss + RMS_EPS);
        const float gg = -__expf(a->in[I_GAL][l * 8 + hd]) * softplus_f(gsm[tok * 32 + 8 + hd] + a->in[I_GDT][l * 8 + hd]);
        const float gc = wave_incl_sum(gg, lane), beta = 1.f / (1.f + __expf(-gsm[tok * 32 + 16 + hd]));
        tb[lane] = gc; tb[64 + lane] = beta * rn;
        LDS_WAIT(); asm volatile("" ::: "memory");
        bf16x8 kf[2][4];
#pragma unroll
        for (int I = 0; I < 2; ++I)
#pragma unroll
            for (int ks = 0; ks < 4; ++ks) kf[I][ks] = *(const LAS bf16x8*)(kb + (32 * I + r) * 72 + 16 * ks + 8 * hh);
        LDS_WAIT(); asm volatile("" ::: "memory");
#pragma unroll
        for (int I = 0; I < 2; ++I)
#pragma unroll
            for (int J = 0; J < 2; ++J) { f32x16 acc;
#pragma unroll
                for (int i = 0; i < 16; ++i) acc[i] = 0.f;
#pragma unroll
                for (int ks = 0; ks < 4; ++ks) acc = __builtin_amdgcn_mfma_f32_32x32x16_bf16(kf[I][ks], kf[J][ks], acc, 0, 0, 0);
                const int s = 32 * J + r; const float gcs = __shfl(gc, s), rns = __shfl(rn, s);
#pragma unroll
                for (int q = 0; q < 4; ++q) { const int t0 = 32 * I + 8 * q + 4 * hh; const f32x4 gct = *(const LAS f32x4*)(tb + t0), brt = *(const LAS f32x4*)(tb + 64 + t0);
#pragma unroll
                    for (int i = 0; i < 4; ++i) { const float v = (s < t0 + i) ? acc[4 * q + i] * brt[i] * rns * __expf(gct[i] - gcs) : 0.f; am[(t0 + i) * 64 + s] = v; } } }
        LDS_WAIT(); asm volatile("" ::: "memory");
        float Tc[64];
#pragma unroll
        for (int i = 0; i < 64; ++i) { float acc = (i == lane) ? 1.f : 0.f;
#pragma unroll
            for (int j4 = 0; j4 < (i + 3) / 4; ++j4) { const f32x4 av = *(const LAS f32x4*)(am + i * 64 + 4 * j4);
#pragma unroll
                for (int jj = 0; jj < 4; ++jj) if (4 * j4 + jj < i) acc -= av[jj] * Tc[4 * j4 + jj]; }
            Tc[i] = acc; }
        bf16_t* Tg = (bf16_t*)(mxb + MXB_GD_T) + (size_t)uid * 4096;
#pragma unroll
        for (int i = 0; i < 64; ++i) Tg[i * 64 + lane] = (bf16_t)f2bf(Tc[i]);
    }
}

__device__ __forceinline__ void gdn_passA2(ArgsP a, int l, LAS unsigned char* lds, const bf16_t* proj, const float* gsm, unsigned char* mxb, unsigned char* mxt, unsigned char* mxs, int G) {
    int tid_ = threadIdx.x; asm volatile("" : "+v"(tid_)); const int tid = tid_, lane = tid & 63, wave = __builtin_amdgcn_readfirstlane(tid >> 6), r = lane & 31, hh = lane >> 5;
    LAS bf16_t* qb = (LAS bf16_t*)(lds);
    LAS bf16_t* kb = (LAS bf16_t*)(lds + 9216);
    LAS bf16_t* bvT = (LAS bf16_t*)(lds + 18432);
    LAS bf16_t* bkT = (LAS bf16_t*)(lds + 27648);
    LAS bf16_t* Tm = (LAS bf16_t*)(lds + 36864);
    LAS bf16_t* wT = (LAS bf16_t*)(lds + 46080);
    LAS bf16_t* uT = (LAS bf16_t*)(lds + 55296);
    LAS bf16_t* kdT = (LAS bf16_t*)(lds + 64512);
    LAS float* tb_gc = (LAS float*)(lds + 73728);
    LAS float* tb_beta = tb_gc + 64;
    LAS float* ssq = tb_gc + 128;
    const float* cw = a->in[I_GCW] + (size_t)l * 4 * 1536;
    float* GL = (float*)(mxs + MXS_GD_GL);
    u32x4 rq[4], rk[4], rv[4], tp; float pga = 0.f, pgb = 0.f;
#define GA2_ISSUE(u_) do { const int c_ = (u_) & 63, hd_ = ((u_) >> 6) & 7, b_ = (u_) >> 9; const int tl_ = c_ * 64 + lane; const size_t tok_ = (size_t)b_ * SEQ_ + tl_; \
        load_rows4(proj, b_, tl_, PC_GDQ + hd_ * 64 + 8 * wave, rq); load_rows4(proj, b_, tl_, PC_GDK + hd_ * 64 + 8 * wave, rk); load_rows4(proj, b_, tl_, PC_GDV + hd_ * 64 + 8 * wave, rv); \
        pga = gsm[tok_ * 32 + 8 + hd_]; pgb = gsm[tok_ * 32 + 16 + hd_]; \
        tp = *(const u32x4*)((const bf16_t*)(mxb + MXB_GD_T) + (size_t)(u_) * 4096 + (tid >> 3) * 64 + (tid & 7) * 8); } while (0)
    if ((int)blockIdx.x < 4096) GA2_ISSUE((int)blockIdx.x);
    for (int uid = blockIdx.x; uid < 4096; uid += G) {
        const int hd = (uid >> 6) & 7;
        __syncthreads();
        { const float gg = -__expf(a->in[I_GAL][l * 8 + hd]) * softplus_f(pga + a->in[I_GDT][l * 8 + hd]);
          const float gc = wave_incl_sum(gg, lane);
          if (wave == 0) { tb_gc[lane] = gc; tb_beta[lane] = 1.f / (1.f + __expf(-pgb)); if (lane == 63) GL[uid] = __expf(gc); } }
        float qo[8], ko[8], vo[8];
        conv_silu8(rq, cw + hd * 64 + 8 * wave, qo); conv_silu8(rk, cw + 512 + hd * 64 + 8 * wave, ko); conv_silu8(rv, cw + 1024 + hd * 64 + 8 * wave, vo);
        { float sq = 0.f, sk = 0.f;
#pragma unroll
          for (int j = 0; j < 8; ++j) { sq += qo[j] * qo[j]; sk += ko[j] * ko[j]; }
          ssq[wave * 64 + lane] = sq; ssq[512 + wave * 64 + lane] = sk; }
        *(LAS u32x4*)(Tm + (tid >> 3) * 72 + (tid & 7) * 8) = tp;
        if (uid + G < 4096) GA2_ISSUE(uid + G);
        __syncthreads();
        { float sq = 0.f, sk = 0.f;
#pragma unroll
          for (int w = 0; w < 8; ++w) { sq += ssq[w * 64 + lane]; sk += ssq[512 + w * 64 + lane]; }
          const float rq = rsqrtf(sq + RMS_EPS) * 0.125f, rk = rsqrtf(sk + RMS_EPS);
          const float gc = tb_gc[lane], beta = tb_beta[lane], gl_ = tb_gc[63];
          const float e1 = beta * __expf(gc), e2 = __expf(gl_ - gc);
#pragma unroll
          for (int j = 0; j < 8; ++j) { qo[j] *= rq; ko[j] *= rk; }
          *(LAS bf16x8*)(qb + lane * 72 + 8 * wave) = pack8(qo[0], qo[1], qo[2], qo[3], qo[4], qo[5], qo[6], qo[7]);
          *(LAS bf16x8*)(kb + lane * 72 + 8 * wave) = pack8(ko[0], ko[1], ko[2], ko[3], ko[4], ko[5], ko[6], ko[7]);
#pragma unroll
          for (int j = 0; j < 8; ++j) { const int d = 8 * wave + j;
              bvT[d * 72 + lane] = (bf16_t)f2bf(beta * vo[j]); bkT[d * 72 + lane] = (bf16_t)f2bf(e1 * ko[j]); kdT[d * 72 + lane] = (bf16_t)f2bf(e2 * ko[j]); } }
        __syncthreads();
        { const int mat = wave >> 2, I = (wave >> 1) & 1, J = wave & 1; const LAS bf16_t* Am = mat ? bkT : bvT; LAS bf16_t* Om = mat ? wT : uT;
          f32x16 acc;
#pragma unroll
          for (int i = 0; i < 16; ++i) acc[i] = 0.f;
#pragma unroll
          for (int ks = 0; ks < 4; ++ks) { const bf16x8 af = *(const LAS bf16x8*)(Am + (32 * I + r) * 72 + 16 * ks + 8 * hh), bf = *(const LAS bf16x8*)(Tm + (32 * J + r) * 72 + 16 * ks + 8 * hh);
              acc = __builtin_amdgcn_mfma_f32_32x32x16_bf16(af, bf, acc, 0, 0, 0); }
#pragma unroll
          for (int q = 0; q < 4; ++q)
#pragma unroll
              for (int i = 0; i < 4; ++i) Om[(32 * I + 8 * q + 4 * hh + i) * 72 + 32 * J + r] = (bf16_t)f2bf(acc[4 * q + i]); }
        __syncthreads();
        if (wave < 4) {
            const int I = (wave >> 1) & 1, J = wave & 1;
            f32x16 ax, an;
#pragma unroll
            for (int i = 0; i < 16; ++i) { ax[i] = 0.f; an[i] = 0.f; }
#pragma unroll
            for (int ks = 0; ks < 4; ++ks) { const bf16x8 wf = *(const LAS bf16x8*)(wT + (32 * I + r) * 72 + 16 * ks + 8 * hh), kdf_b = *(const LAS bf16x8*)(kdT + (32 * J + r) * 72 + 16 * ks + 8 * hh);
                ax = __builtin_amdgcn_mfma_f32_32x32x16_bf16(wf, kdf_b, ax, 0, 0, 0);
                const bf16x8 kdf_a = *(const LAS bf16x8*)(kdT + (32 * I + r) * 72 + 16 * ks + 8 * hh), uf = *(const LAS bf16x8*)(uT + (32 * J + r) * 72 + 16 * ks + 8 * hh);
                an = __builtin_amdgcn_mfma_f32_32x32x16_bf16(kdf_a, uf, an, 0, 0, 0); }
            bf16_t* xd = (bf16_t*)(mxt + MXT_GD_XD) + (size_t)uid * 4096 + (size_t)(I * 2 + J) * 1024;
#pragma unroll
            for (int s2 = 0; s2 < 2; ++s2) *(bf16x8*)(xd + (s2 * 64 + lane) * 8) = pack8(-ax[8 * s2], -ax[8 * s2 + 1], -ax[8 * s2 + 2], -ax[8 * s2 + 3], -ax[8 * s2 + 4], -ax[8 * s2 + 5], -ax[8 * s2 + 6], -ax[8 * s2 + 7]);
            float* nd = (float*)(mxb + MXB_GD_ND) + (size_t)uid * 4096 + (size_t)(I * 2 + J) * 1024;
#pragma unroll
            for (int q = 0; q < 4; ++q) *(f32x4*)(nd + (q * 64 + lane) * 4) = (f32x4){an[4 * q], an[4 * q + 1], an[4 * q + 2], an[4 * q + 3]};
        } else {
            const int I = (wave >> 1) & 1, tJ = wave & 1; const int t = 32 * tJ + r; const float gct = tb_gc[t];
            bf16x8 pf[2][2];
#pragma unroll
            for (int sI = 0; sI < 2; ++sI) { f32x16 ap;
#pragma unroll
                for (int i = 0; i < 16; ++i) ap[i] = 0.f;
#pragma unroll
                for (int ks = 0; ks < 4; ++ks) { const bf16x8 af = *(const LAS bf16x8*)(kb + (32 * sI + r) * 72 + 16 * ks + 8 * hh), bf = *(const LAS bf16x8*)(qb + t * 72 + 16 * ks + 8 * hh);
                    ap = __builtin_amdgcn_mfma_f32_32x32x16_bf16(af, bf, ap, 0, 0, 0); }
#pragma unroll
                for (int q = 0; q < 4; ++q) { const int s0 = 32 * sI + 8 * q + 4 * hh; const f32x4 gcs = *(const LAS f32x4*)(tb_gc + s0);
#pragma unroll
                    for (int i = 0; i < 4; ++i) ap[4 * q + i] = (s0 + i <= t) ? ap[4 * q + i] * __expf(gct - gcs[i]) : 0.f; }
#pragma unroll
                for (int s2 = 0; s2 < 2; ++s2) pf[sI][s2] = pack8(ap[8 * s2], ap[8 * s2 + 1], ap[8 * s2 + 2], ap[8 * s2 + 3], ap[8 * s2 + 4], ap[8 * s2 + 5], ap[8 * s2 + 6], ap[8 * s2 + 7]); }
            f32x16 aq, ao;
#pragma unroll
            for (int i = 0; i < 16; ++i) { aq[i] = 0.f; ao[i] = 0.f; }
#pragma unroll
            for (int sI = 0; sI < 2; ++sI)
#pragma unroll
                for (int s2 = 0; s2 < 2; ++s2) { const bf16x8 wf = ld_perm(wT + (32 * I + r) * 72 + 32 * sI + 16 * s2 + 4 * hh), uf = ld_perm(uT + (32 * I + r) * 72 + 32 * sI + 16 * s2 + 4 * hh);
                    aq = __builtin_amdgcn_mfma_f32_32x32x16_bf16(wf, pf[sI][s2], aq, 0, 0, 0); ao = __builtin_amdgcn_mfma_f32_32x32x16_bf16(uf, pf[sI][s2], ao, 0, 0, 0); }
            const float egt = __expf(gct);
#pragma unroll
            for (int q = 0; q < 4; ++q) { const int d0 = 32 * I + 8 * q + 4 * hh; const u32x2 qw = *(const LAS u32x2*)(qb + t * 72 + d0);
                aq[4 * q] = bflo(qw.x) * egt - aq[4 * q]; aq[4 * q + 1] = bfhi(qw.x) * egt - aq[4 * q + 1]; aq[4 * q + 2] = bflo(qw.y) * egt - aq[4 * q + 2]; aq[4 * q + 3] = bfhi(qw.y) * egt - aq[4 * q + 3]; }
            bf16_t* qd = (bf16_t*)(mxt + MXT_GD_QD) + (size_t)uid * 4096 + (size_t)(I * 2 + tJ) * 1024;
#pragma unroll
            for (int s2 = 0; s2 < 2; ++s2) *(bf16x8*)(qd + (s2 * 64 + lane) * 8) = pack8(aq[8 * s2], aq[8 * s2 + 1], aq[8 * s2 + 2], aq[8 * s2 + 3], aq[8 * s2 + 4], aq[8 * s2 + 5], aq[8 * s2 + 6], aq[8 * s2 + 7]);
            float* od = (float*)(mxb + MXB_GD_OD) + (size_t)uid * 4096 + (size_t)(I * 2 + tJ) * 1024;
#pragma unroll
            for (int q = 0; q < 4; ++q) *(f32x4*)(od + (q * 64 + lane) * 4) = (f32x4){ao[4 * q], ao[4 * q + 1], ao[4 * q + 2], ao[4 * q + 3]};
        }
    }
}

__device__ __forceinline__ void gdn_passB(unsigned char* mxb, unsigned char* mxt, unsigned char* mxs, int nB) {
    int tid_ = threadIdx.x; asm volatile("" : "+v"(tid_)); const int tid = tid_, lane = tid & 63, wave = __builtin_amdgcn_readfirstlane(tid >> 6);
    const float* GL = (const float*)(mxs + MXS_GD_GL);
    if (wave >= 2) return;
    const int eJ = wave;
    for (int chain = blockIdx.x; chain < 64; chain += nB) {
        f32x16 S[2];
#pragma unroll
        for (int i = 0; i < 16; ++i) { S[0][i] = 0.f; S[1][i] = 0.f; }
        bf16x8 xn[2][2][2]; f32x4 nq[2][4]; float gln;
#define GDB_LOAD(c_) do { const size_t u_ = (size_t)chain * 64 + (c_); const bf16_t* xd_ = (const bf16_t*)(mxt + MXT_GD_XD) + u_ * 4096; const float* nd_ = (const float*)(mxb + MXB_GD_ND) + u_ * 4096; \
        _Pragma("unroll") for (int I = 0; I < 2; ++I) _Pragma("unroll") for (int J = 0; J < 2; ++J) _Pragma("unroll") for (int s2 = 0; s2 < 2; ++s2) xn[I][J][s2] = *(const bf16x8*)(xd_ + (size_t)(I * 2 + J) * 1024 + (s2 * 64 + lane) * 8); \
        _Pragma("unroll") for (int J = 0; J < 2; ++J) _Pragma("unroll") for (int q = 0; q < 4; ++q) nq[J][q] = *(const f32x4*)(nd_ + (size_t)(J * 2 + eJ) * 1024 + (q * 64 + lane) * 4); \
        gln = GL[u_]; } while (0)
        GDB_LOAD(0);
        for (int c = 0; c < 64; ++c) { const size_t uid = (size_t)chain * 64 + c;
            bf16x8 xf[2][2][2]; f32x16 nn[2]; const float gl = gln;
#pragma unroll
            for (int I = 0; I < 2; ++I)
#pragma unroll
                for (int J = 0; J < 2; ++J)
#pragma unroll
                    for (int s2 = 0; s2 < 2; ++s2) xf[I][J][s2] = xn[I][J][s2];
#pragma unroll
            for (int J = 0; J < 2; ++J)
#pragma unroll
                for (int q = 0; q < 4; ++q) { nn[J][4 * q] = nq[J][q][0]; nn[J][4 * q + 1] = nq[J][q][1]; nn[J][4 * q + 2] = nq[J][q][2]; nn[J][4 * q + 3] = nq[J][q][3]; }
            if (c + 1 < 64) GDB_LOAD(c + 1);
            bf16x8 sh[2][2], sl[2][2];
            bf16_t* sd = (bf16_t*)(mxt + MXT_GD_SD) + uid * 4096;
#pragma unroll
            for (int I = 0; I < 2; ++I)
#pragma unroll
                for (int s2 = 0; s2 < 2; ++s2) { float hi[8], lo[8];
#pragma unroll
                    for (int j = 0; j < 8; ++j) { const float v = S[I][8 * s2 + j]; hi[j] = bf2f((unsigned short)f2bf(v)); lo[j] = v - hi[j]; }
                    sh[I][s2] = pack8(hi[0], hi[1], hi[2], hi[3], hi[4], hi[5], hi[6], hi[7]); sl[I][s2] = pack8(lo[0], lo[1], lo[2], lo[3], lo[4], lo[5], lo[6], lo[7]);
                    *(bf16x8*)(sd + (size_t)(I * 2 + eJ) * 1024 + (s2 * 64 + lane) * 8) = sh[I][s2]; }
#pragma unroll
            for (int J = 0; J < 2; ++J) { f32x16 acc = nn[J];
#pragma unroll
                for (int I = 0; I < 2; ++I)
#pragma unroll
                    for (int s2 = 0; s2 < 2; ++s2) { acc = __builtin_amdgcn_mfma_f32_32x32x16_bf16(xf[I][J][s2], sh[I][s2], acc, 0, 0, 0); acc = __builtin_amdgcn_mfma_f32_32x32x16_bf16(xf[I][J][s2], sl[I][s2], acc, 0, 0, 0); }
                nn[J] = acc; }
#pragma unroll
            for (int J = 0; J < 2; ++J)
#pragma unroll
                for (int i = 0; i < 16; ++i) S[J][i] = gl * S[J][i] + nn[J][i];
        }
    }
}

__device__ __forceinline__ void gdn_passC(ArgsP a, int l, LAS unsigned char* lds, const bf16_t* proj, bf16_t* H, unsigned char* mxb, unsigned char* mxt, int G) {
    int tid_ = threadIdx.x; asm volatile("" : "+v"(tid_)); const int tid = tid_, lane = tid & 63, wave = __builtin_amdgcn_readfirstlane(tid >> 6), r = lane & 31, hh = lane >> 5;
    LAS bf16_t* ob = (LAS bf16_t*)(lds + wave * 8192);
    const float* gn = a->in[I_GNG] + l * 64;
    for (int wu = blockIdx.x * NWAVES + wave; wu < 8192; wu += G * NWAVES) {
        const int uid = wu >> 1, tJ = wu & 1; const int c = uid & 63, hd = (uid >> 6) & 7, b = uid >> 9; const size_t tok0 = (size_t)b * SEQ_ + (size_t)c * 64;
        const bf16_t* sd = (const bf16_t*)(mxt + MXT_GD_SD) + (size_t)uid * 4096; const bf16_t* qd = (const bf16_t*)(mxt + MXT_GD_QD) + (size_t)uid * 4096; const float* od = (const float*)(mxb + MXB_GD_OD) + (size_t)uid * 4096;
        f32x16 ao[2];
#pragma unroll
        for (int eI = 0; eI < 2; ++eI)
#pragma unroll
            for (int q = 0; q < 4; ++q) { const f32x4 v = *(const f32x4*)(od + (size_t)(eI * 2 + tJ) * 1024 + (q * 64 + lane) * 4); ao[eI][4 * q] = v[0]; ao[eI][4 * q + 1] = v[1]; ao[eI][4 * q + 2] = v[2]; ao[eI][4 * q + 3] = v[3]; }
#pragma unroll
        for (int dI = 0; dI < 2; ++dI)
#pragma unroll
            for (int s2 = 0; s2 < 2; ++s2) { const bf16x8 qf = *(const bf16x8*)(qd + (size_t)(dI * 2 + tJ) * 1024 + (s2 * 64 + lane) * 8);
#pragma unroll
                for (int eI = 0; eI < 2; ++eI) { const bf16x8 sf = *(const bf16x8*)(sd + (size_t)(dI * 2 + eI) * 1024 + (s2 * 64 + lane) * 8);
                    ao[eI] = __builtin_amdgcn_mfma_f32_32x32x16_bf16(sf, qf, ao[eI], 0, 0, 0); } }
        float sq = 0.f;
#pragma unroll
        for (int eI = 0; eI < 2; ++eI)
#pragma unroll
            for (int i = 0; i < 16; ++i) sq += ao[eI][i] * ao[eI][i];
        sq += __shfl_xor(sq, 32);
        const float rinv = rsqrtf(sq * (1.0f / 64.0f) + RMS_EPS);
        const size_t tok = tok0 + 32 * tJ + r;
#pragma unroll
        for (int eI = 0; eI < 2; ++eI)
#pragma unroll
            for (int q = 0; q < 4; ++q) { const int e0 = 32 * eI + 8 * q + 4 * hh; const f32x4 g4 = *(const f32x4*)(gn + e0); const u32x2 zw = *(const u32x2*)(proj + tok * NPROJ + PC_GDZ + hd * 64 + e0);
                u32x2 pw; pw.x = pg8::cvt_pk_bf16(ao[eI][4 * q] * rinv * g4[0] * silu_f(bflo(zw.x)), ao[eI][4 * q + 1] * rinv * g4[1] * silu_f(bfhi(zw.x)));
                pw.y = pg8::cvt_pk_bf16(ao[eI][4 * q + 2] * rinv * g4[2] * silu_f(bflo(zw.y)), ao[eI][4 * q + 3] * rinv * g4[3] * silu_f(bfhi(zw.y)));
                *(LAS u32x2*)(ob + r * 64 + e0) = pw; }
        LDS_WAIT(); asm volatile("" ::: "memory");
#pragma unroll
        for (int it = 0; it < 4; ++it) { const int row = it * 8 + (lane >> 3), c8 = (lane & 7) * 8;
            *(u32x4*)(H + (tok0 + 32 * tJ + row) * 2048 + 1536 + hd * 64 + c8) = *(const LAS u32x4*)(ob + row * 64 + c8); }
        LDS_WAIT(); asm volatile("" ::: "memory");
    }
}
constexpr int PPL = 12;
constexpr int NPH = 1 + PPL * DEPTH_;
#ifndef MK_N_LAUNCHES
#define MK_N_LAUNCHES 1
#endif
#ifndef PROBE_PH
#define PROBE_PH -2
#endif
#define REPS(k) ((PROBE_PH) == (k) ? 2 : 1)
#ifndef PG8_SP2
#define PG8_SP2 true
#endif
#ifndef PG8_ALIGN
#define PG8_ALIGN true
#endif
__global__ void __launch_bounds__(NWAVES * 64, 2) fwd(Args a_unused) {
    ArgsP kargs = (ArgsP)__builtin_amdgcn_kernarg_segment_ptr();
#define FRESH(a) ArgsP a = kargs; asm volatile("" : "+s"(a))
    extern __shared__ __attribute__((aligned(16))) unsigned char lds_raw[];
    LAS unsigned char* lds = (LAS unsigned char*)lds_raw;
    const int tid = threadIdx.x, G = gridDim.x;
    const int vcu = (G % 8 == 0) ? ((int)blockIdx.x % 8) * (G / 8) + (int)blockIdx.x / 8 : (int)blockIdx.x;
    for (int u = tid; u < (LDS_BYTES - MISC_OFF) / 4; u += NWAVES * 64) ((LAS unsigned*)(lds + MISC_OFF))[u] = 0u;
    __syncthreads();
    const int lo = kargs->ph_lo, hi = kargs->ph_hi;
    unsigned* barw = (unsigned*)(kargs->ws + WS_CTL) + CW_BAR + kargs->li * XCD_BAR_WORDS;
    if (hi - lo > 1) (void)xcd_barrier_post(barw, (volatile LAS unsigned*)(lds + LDS_BYTES - 16));
#define IN(k) (lo <= (k) && (k) < hi)
#define SEAM(k) do { if (IN(k) && IN((k) + 1)) { FRESH(ab_); XcdBarrier bb_; bb_.bar = (unsigned*)(ab_->ws + WS_CTL) + CW_BAR + ab_->li * XCD_BAR_WORDS; bb_.x = xb_xcc_id(); bb_.st = (volatile LAS unsigned*)(lds + LDS_BYTES - 16); xcd_barrier(bb_); } } while (0)
    if (IN(0)) for (int rep = 0; rep < REPS(-1); ++rep) { FRESH(a); p0_convert(a, lds, G); }
    SEAM(0);

    for (int l = 0; l < DEPTH_; ++l) {
        const int pb = 1 + PPL * l;
#define WSP(T_, off) ((T_*)(a->ws + (off)))
#define WL_(off) (a->ws + WS_W + (size_t)l * WL_STRIDE + (off))
        if (IN(pb + 0)) for (int rep = 0; rep < REPS(0); ++rep) { FRESH(a);
            pg8::Gemm g{WSP(const bf16_t, WS_XB), (const bf16_t*)WL_(WL_IN), 1024, 1024, 1024}; pg8::StaticOrder S; S.init(T_, NINP, G, (int)blockIdx.x);
            pg8::EpiProj E{WSP(bf16_t, WS_OV + OV_PROJ), WSP(float, WS_GSM), WSP(bf16_t, WS_OV + OV_GD)};
            pg8::gemm_phase<pg8::EpiProj, pg8::StaticOrder, PG8_ALIGN, PG8_SP2>(lds, g, S, E);
        }
        SEAM(pb + 0);

        if (IN(pb + 1)) for (int rep = 0; rep < REPS(1); ++rep) { FRESH(a);
            const bf16_t* proj = WSP(const bf16_t, WS_OV + OV_PROJ); bf16_t* Hb = WSP(bf16_t, WS_OV + OV_H); const float* gsm = WSP(const float, WS_GSM);
            for (int r2 = 0; r2 < REPS(11); ++r2) for (int u = (int)blockIdx.x; u < 256; u += G) lru_fast<0>(a, l, u >> 5, (u >> 2) & 7, (u & 3) * 16, (u & 3) * 16 + 16, lds, proj, Hb, a->ws + WS_MXS);
            for (int r2 = 0; r2 < REPS(12); ++r2) mlstm_passA(a, l, lds, proj, gsm, a->ws + WS_V, a->ws + WS_MXS, G);
            __syncthreads();
            for (int r2 = 0; r2 < REPS(13); ++r2) gdn_passA1(a, l, lds, proj, gsm, a->ws + WS_V, G);
        }
        SEAM(pb + 1);
        if (IN(pb + 2)) for (int rep = 0; rep < REPS(2); ++rep) { FRESH(a);
            const bf16_t* proj = WSP(const bf16_t, WS_OV + OV_PROJ); const float* gsm = WSP(const float, WS_GSM);
            for (int r2 = 0; r2 < REPS(21); ++r2) lru_carry(a->ws + WS_MXS, G); for (int r2 = 0; r2 < REPS(22); ++r2) mlstm_passB(a->ws + WS_V, a->ws + WS_MXS, G); for (int r2 = 0; r2 < REPS(23); ++r2) gdn_passA2(a, l, lds, proj, gsm, a->ws + WS_V, a->ws + WS_MXS, a->ws + WS_MXS, G); }
        SEAM(pb + 2);
        if (IN(pb + 3)) for (int rep = 0; rep < REPS(3); ++rep) { FRESH(a);
            const bf16_t* proj = WSP(const bf16_t, WS_OV + OV_PROJ); bf16_t* Hb = WSP(bf16_t, WS_OV + OV_H); const float* gsm = WSP(const float, WS_GSM);
            const int nB = G >= 128 ? 64 : 0;
            if ((int)blockIdx.x < nB) { for (int r2 = 0; r2 < REPS(31); ++r2) gdn_passB(a->ws + WS_V, a->ws + WS_MXS, a->ws + WS_MXS, nB); }
            else {
                if (nB == 0) { gdn_passB(a->ws + WS_V, a->ws + WS_MXS, a->ws + WS_MXS, G); __syncthreads(); }
                for (int r2 = 0; r2 < REPS(32); ++r2) lru_apply(a, proj, Hb, a->ws + WS_MXS, (int)blockIdx.x - nB, G - nB);
                for (int r2 = 0; r2 < REPS(33); ++r2) mlstm_passC(a, l, lds, proj, gsm, Hb, a->ws + WS_V, a->ws + WS_MXS, (int)blockIdx.x - nB, G - nB);
            }
        }
        SEAM(pb + 3);
        if (IN(pb + 4)) for (int rep = 0; rep < REPS(4); ++rep) { FRESH(a); gdn_passC(a, l, lds, WSP(const bf16_t, WS_OV + OV_PROJ), WSP(bf16_t, WS_OV + OV_H), a->ws + WS_V, a->ws + WS_MXS, G); }
        SEAM(pb + 4);

        if (IN(pb + 5)) for (int rep = 0; rep < REPS(5); ++rep) { FRESH(a);
            pg8::StaticOrder S; S.init(T_, 1024, G, (int)blockIdx.x);
            pg8::Gemm g{WSP(const bf16_t, WS_OV + OV_H), (const bf16_t*)WL_(WL_BR), 2048, 2048, 2048}; pg8::EpiMergeF E{WSP(const bf16_t, WS_OV + OV_GD), WSP(bf16_t, WS_MB)};
            pg8::gemm_phase<pg8::EpiMergeF, pg8::StaticOrder, PG8_ALIGN, PG8_SP2>(lds, g, S, E);
        }
        SEAM(pb + 5);

        if (IN(pb + 6)) for (int rep = 0; rep < REPS(6); ++rep) { FRESH(a);
            pg8::Gemm g{WSP(const bf16_t, WS_MB), (const bf16_t*)WL_(WL_OUT), 1024, 1024, 1024}; pg8::StaticOrder S; S.init(T_, 1024, G, (int)blockIdx.x);
            pg8::EpiWout E{l == 0 ? a->in[I_X] : (const float*)nullptr, WSP(const bf16_t, WS_XB), WSP(bf16_t, WS_V)};
            pg8::gemm_phase<pg8::EpiWout, pg8::StaticOrder, PG8_ALIGN, PG8_SP2>(lds, g, S, E);
        }
        SEAM(pb + 6);

        if (IN(pb + 7)) for (int rep = 0; rep < REPS(7); ++rep) { FRESH(a); p5_ln1_router(a, l, lds, G); }
        SEAM(pb + 7);

        if (IN(pb + 8)) for (int rep = 0; rep < REPS(8); ++rep) { FRESH(a); p6_slots(a, lds, G); }
        SEAM(pb + 8);

        if (IN(pb + 9)) for (int rep = 0; rep < REPS(9); ++rep) { FRESH(a);
            const int nb = moe_table(a, lds);
            pg8::MoeOrder S{8, G, vcu, nb * 8, (const LAS int*)(lds + MISC_OFF + 256)};
            { LAS int* gt = (LAS int*)(lds + GTAB_OFF); const int* tokb = WSP(const int, WS_TOKB);
              int tq_ = threadIdx.x; asm volatile("" : "+v"(tq_));
              for (int ui = 0; (long)ui * G + vcu < (long)nb * 8; ++ui) { const int pm = (int)(((long)ui * G + vcu) / 8); if (tq_ < 256) gt[ui * 256 + tq_] = tokb[(size_t)pm * 256 + tq_]; }
              __syncthreads(); }
            pg8::Gemm8 g{WSP(const unsigned char, WS_X1), (const unsigned char*)WL_(WL_W1), 1024, 1024, 1024};
            pg8::EpiMoe1F8 E{WSP(unsigned char, WS_OV + OV_ACT), a->in[I_B1] + (size_t)l * NE * 2048};
            pg8::gemm_phase_f8<pg8::EpiMoe1F8, pg8::MoeOrder, true>(lds, g, S, E, (const LAS int*)(lds + GTAB_OFF));
        }
        SEAM(pb + 9);

        if (IN(pb + 10)) for (int rep = 0; rep < REPS(10); ++rep) { FRESH(a);
            const int nb = moe_table(a, lds);
            pg8::MoeOrder S{4, G, vcu, nb * 4, (const LAS int*)(lds + MISC_OFF + 256)};
            pg8::Gemm8 g{WSP(const unsigned char, WS_OV + OV_ACT), (const unsigned char*)WL_(WL_W2), 1024, 1024, 1024};
            pg8::EpiMoe2F8 E{WSP(bf16_t, WS_OV + OV_YS), a->in[I_B2] + (size_t)l * NE * 1024, WSP(const float, WS_WBUF)};
            pg8::gemm_phase_f8<pg8::EpiMoe2F8, pg8::MoeOrder, false>(lds, g, S, E);
        }
        SEAM(pb + 10);

        if (IN(pb + 11)) for (int rep = 0; rep < REPS(11); ++rep) { FRESH(a); p9_combine_ln2(a, l, (l == DEPTH_ - 1) ? a->out : (float*)nullptr, G); }
        SEAM(pb + 11);
    }
#undef WSP
#undef WL_
#undef IN
#undef SEAM
}

extern "C" void kernel_launch(void* const* d_in, const int* in_sizes, int n_in, void* d_out, int out_size, void* d_ws, size_t ws_size, hipStream_t stream) {
    static int grid = 0;
    if (grid == 0) {
        if (n_in != 30 || in_sizes[0] != T_ * D_ || out_size != T_ * D_ || ws_size < WS_END) {
            fprintf(stderr, "kernel_launch: unexpected shapes: n_in %d in0 %d out %d ws %zu (need %zu); nothing launched\n", n_in, n_in > 0 ? in_sizes[0] : -1, out_size, ws_size, (size_t)WS_END); grid = -1; return; }
        int dev = 0, cus = 0;
        if (hipGetDevice(&dev) != hipSuccess || hipDeviceGetAttribute(&cus, hipDeviceAttributeMultiprocessorCount, dev) != hipSuccess) { grid = -1; return; }
        if (hipFuncSetAttribute((const void*)fwd, hipFuncAttributeMaxDynamicSharedMemorySize, LDS_BYTES) != hipSuccess) { fprintf(stderr, "kernel_launch: hipFuncSetAttribute failed\n"); grid = -1; return; }
        int per_cu = 0; (void)hipOccupancyMaxActiveBlocksPerMultiprocessor(&per_cu, (const void*)fwd, NWAVES * 64, LDS_BYTES); (void)hipGetLastError();
        if (per_cu < 1) fprintf(stderr, "kernel_launch: occupancy query reports %d blocks per CU\n", per_cu);
        grid = cus;
    }
    if (grid < 0) return;
    (void)hipMemsetAsync((char*)d_ws + WS_CTL, 0, CTL_ZERO_BYTES, stream);
    Args a{};
    for (int i = 0; i < 30; ++i) a.in[i] = (const float*)d_in[i];
    a.out = (float*)d_out; a.ws = (unsigned char*)d_ws;
    constexpr int NL = MK_N_LAUNCHES; static_assert(NL == NPH || NL <= 4, "barrier regions");
    for (int li = 0; li < NL; ++li) {
        a.ph_lo = (int)((long)NPH * li / NL); a.ph_hi = (int)((long)NPH * (li + 1) / NL); a.li = (NL <= 4) ? li : 0;
        hipLaunchKernelGGL(fwd, dim3(grid), dim3(NWAVES * 64), LDS_BYTES, stream, a);
        const hipError_t le = hipPeekAtLastError();
        if (le != hipSuccess) { fprintf(stderr, "kernel_launch: launch %d failed: %s\n", li, hipGetErrorName(le)); break; }
    }
}
```

```cpp
#include <hip/hip_runtime.h>
#include <cstdio>
#include <cstdint>

#define LAS __attribute__((address_space(3)))
#define GAS __attribute__((address_space(1)))
typedef unsigned short bf16_t;
typedef short bf16x8 __attribute__((ext_vector_type(8)));
typedef float f32x4 __attribute__((ext_vector_type(4)));
typedef float f32x2 __attribute__((ext_vector_type(2)));
typedef unsigned u32x4 __attribute__((ext_vector_type(4)));
typedef unsigned u32x2 __attribute__((ext_vector_type(2)));

constexpr int T_ = 32768, D_ = 1024, SEQ_ = 4096, NBATCH = 8, DEPTH_ = 2;
constexpr int DIN = 8728, NPROJ = 5632, NINP = 8960;
constexpr int NE = 32, DFF = 1024;
constexpr int PMAX = 139264;
constexpr int NCHUNK = 256, CHTOK = 128;
constexpr float DN_ALPHA = 1.41421356237309515f;
constexpr float LN_EPS = 1e-5f, RMS_EPS = 1e-6f;
constexpr float F8_SX = 16.0f, F8_SW1 = 128.0f, F8_SA = 8.0f, F8_SW2 = 256.0f, F8_SWI = 128.0f;
constexpr int PC_LRUX = 0, PC_MLQ = 1024, PC_MLK = 1280, PC_MLV = 1536, PC_GDQ = 2048, PC_GDK = 2560, PC_GDV = 3072, PC_LRUY = 3584, PC_MLO = 4608, PC_GDZ = 5120;
constexpr int NIN_BF = 3840, NIN_F8 = 5120;
constexpr size_t WL_IN8 = 8u << 20;

constexpr size_t MiB = 1u << 20;
constexpr size_t WS_CTL = 0, CTL_ZERO_BYTES = 64 * 1024;
constexpr size_t WS_HIST = 256 * 1024;
constexpr size_t WS_META = 320 * 1024;
constexpr size_t WS_RWB = 384 * 1024;
constexpr size_t WS_W = 1 * MiB;
constexpr size_t WL_IN = 0, WL_BR = 18 * MiB, WL_OUT = 22 * MiB, WL_W1 = 24 * MiB, WL_W2 = 152 * MiB, WL_G = 216 * MiB, WL_STRIDE = 217 * MiB;
constexpr size_t WS_XB = 436 * MiB;
constexpr size_t WS_GSM = 501 * MiB;
constexpr size_t WS_MB = 505 * MiB;
constexpr size_t WS_V = 569 * MiB;
constexpr size_t WS_X1 = 697 * MiB;
constexpr size_t WS_X1B = 825 * MiB;
constexpr size_t WS_X2 = 890 * MiB;
constexpr size_t WS_TKE = 1018 * MiB;
constexpr size_t WS_TKW = WS_TKE + 512 * 1024;
constexpr size_t WS_SLOT = 1019 * MiB;
constexpr size_t WS_WBUF = 1020 * MiB;
constexpr size_t WS_TOKB = 1021 * MiB;
constexpr size_t WS_OV = 1024 * MiB;
constexpr size_t OV_PROJ = 0, OV_GD = 352 * MiB, OV_H = 544 * MiB;
constexpr size_t OV_XS = 0, OV_ACT = 272 * MiB, OV_YS = 544 * MiB;
constexpr size_t WS_MXS = WS_OV + 816 * MiB;
constexpr size_t WS_END = WS_MXS + 104 * MiB;

constexpr int CW_BAR = 1024;

constexpr int RING_BYTES = 131072;
constexpr int MISC_OFF = RING_BYTES;
constexpr int GTAB_OFF = MISC_OFF + 4096;
constexpr int LDS_BYTES = 163840;
constexpr int NWAVES = 8;

#define LDS_WAIT() asm volatile("s_waitcnt lgkmcnt(0)" ::: "memory")
#define VM_WAIT() asm volatile("s_waitcnt vmcnt(0)" ::: "memory")

__device__ __forceinline__ unsigned f2bf(float f) { unsigned u = __builtin_bit_cast(unsigned, f); return (u + 0x7fffu + ((u >> 16) & 1u)) >> 16; }
__device__ __forceinline__ unsigned pk2(float lo, float hi) { return f2bf(lo) | (f2bf(hi) << 16); }
__device__ __forceinline__ float bf2f(unsigned short b) { return __builtin_bit_cast(float, (unsigned)b << 16); }
__device__ __forceinline__ float bflo(unsigned w) { return __builtin_bit_cast(float, w << 16); }
__device__ __forceinline__ float bfhi(unsigned w) { return __builtin_bit_cast(float, w & 0xffff0000u); }
__device__ __forceinline__ unsigned pk_fp8x4(float a, float b, float c, float d) { int p = __builtin_amdgcn_cvt_pk_fp8_f32(a, b, 0, false); p = __builtin_amdgcn_cvt_pk_fp8_f32(c, d, p, true); return (unsigned)p; }
__device__ __forceinline__ float wave_sum(float v) {
#pragma unroll
    for (int o = 1; o < 64; o <<= 1) v += __shfl_xor(v, o);
    return v;
}
__device__ __forceinline__ float wave_max(float v) {
#pragma unroll
    for (int o = 1; o < 64; o <<= 1) v = fmaxf(v, __shfl_xor(v, o));
    return v;
}
__device__ __forceinline__ float sigmoid_f(float x) { return __builtin_amdgcn_rcpf(1.f + __expf(-x)); }
__device__ __forceinline__ float silu_f(float x) { return x * __builtin_amdgcn_rcpf(1.f + __expf(-x)); }
__device__ __forceinline__ float neg_expm1_f(float t) {
    const float p = -t * (1.f + t * 0.5f * (1.f + t * (1.f / 3.f) * (1.f + t * 0.25f * (1.f + t * 0.2f * (1.f + t * (1.f / 6.f) * (1.f + t * (1.f / 7.f)))))));
    return t > -0.3f ? p : 1.f - __expf(t);
}
__device__ __forceinline__ float log1p_f(float e) { return e < 0.01f ? e * (1.f - e * (0.5f - e * ((1.f / 3.f) - 0.25f * e))) : __logf(1.f + e); }
__device__ __forceinline__ float softplus_f(float x) { return fmaxf(x, 0.f) + log1p_f(__expf(-fabsf(x))); }
__device__ __forceinline__ float gelu_tanh_f(float x) { const float u = 0.7978845608028654f * (x + 0.044715f * x * x * x); return x * __builtin_amdgcn_rcpf(1.f + __expf(-2.f * u)); }
namespace pg8 {
#define PG8_LAS __attribute__((address_space(3)))
constexpr int BM = 256, BK = 64, HALF = 128, HTB = HALF * BK * 2  , STAGE_BYTES = 8 * HTB, NXCD = 8, WGM = 8;

__host__ __device__ __forceinline__ int lds_byte(int r, int c) { const int st = (r >> 4) * 2 + (c >> 5), rr = r & 15, cc = c & 31, ob = rr * 64 + cc * 2; return st * 1024 + (ob ^ (((ob >> 9) & 1) << 5)); }
__host__ __device__ __forceinline__ void stage_rc(int b, int& R, int& C) { const int st = b / 1024, sb = b % 1024, swz = sb ^ (((sb >> 9) & 1) << 5); R = (st >> 1) * 16 + swz / 64; C = (st & 1) * 32 + (swz % 64) / 2; }
__host__ __device__ __forceinline__ int perm32(int rho) { const int n = rho >> 4, i = rho & 15; return 8 * (i >> 2) + 4 * n + (i & 3); }

struct Unit { int pm, pn; };
struct Gemm { const bf16_t* A; const bf16_t* Bt; int lda, ldb, K; };

struct StaticOrder {
    int nM, nN, nwg, G, c;
    __host__ __device__ void init(int M, int N, int G_, int c_) { nM = M / BM; nN = N / BM; nwg = nM * nN; G = G_; c = c_; }
    __host__ __device__ bool next(int i, Unit& u) const {
        const long L = (long)i * G + c; if (L >= nwg) return false;
        int wgid = (int)L; { const int q = nwg / NXCD, r = nwg % NXCD, xcd = wgid % NXCD, off = wgid / NXCD; wgid = (xcd < r ? xcd * (q + 1) : r * (q + 1) + (xcd - r) * q) + off; }
        const int nig = WGM * nN, gid = wgid / nig, fm = gid * WGM, gsz = (nM - fm) < WGM ? (nM - fm) : WGM;
        u.pm = fm + ((wgid % nig) % gsz); u.pn = (wgid % nig) / gsz; return true;
    }
    __device__ __forceinline__ void a_ready(const Unit&) const {}
    __device__ __forceinline__ void done(const Unit&) const {}
};

__device__ __forceinline__ unsigned cvt_pk_bf16(float lo, float hi) { unsigned r; asm volatile("v_cvt_pk_bf16_f32 %0, %1, %2" : "=v"(r) : "v"(lo), "v"(hi)); return r; }

template <class Epi, class Sched, bool ALIGN_EPI = false, bool SP2 = false, bool GATHER = false>
__device__ __forceinline__ void gemm_phase(PG8_LAS unsigned char* lds, const Gemm g, const Sched& S, const Epi& E, const PG8_LAS int* gtab = nullptr) {
    int tid_ = threadIdx.x; asm volatile("" : "+v"(tid_));
    const int tid = tid_, wid = __builtin_amdgcn_readfirstlane(tid >> 6), lane = tid & 63, wr = wid >> 2, wc = wid & 3, fr = lane & 15, fq = lane >> 4;
    const int K = g.K, nt = K / BK;
    unsigned voffA[2], voffB[2];
#pragma unroll
    for (int i = 0; i < 2; ++i) { int R, C; stage_rc(tid * 16 + i * 8192, R, C); const int Rb = Epi::PERM ? ((R & ~31) + perm32(R & 31)) : R;
        voffA[i] = (unsigned)(R * g.lda + C) * 2u; voffB[i] = (unsigned)(Rb * g.ldb + C) * 2u; }
    const size_t kstep = (size_t)(BK * 2);
    const size_t hstepA = (size_t)HALF * g.lda * 2, hstepB = (size_t)HALF * g.ldb * 2;
    const size_t tstepA = 2 * hstepA, tstepB = 2 * hstepB;
    const unsigned ldsw = (unsigned)wid * 1024u;
    const int aoff = lds_byte(wr * 64 + fr, fq * 8), boff = lds_byte(wc * 32 + fr, fq * 8);
    int gR0 = 0, gC0 = 0; if constexpr (GATHER) { stage_rc(tid * 16, gR0, gC0); }
#define PG8_STAGE_A(bufoff, aptr, koff, slot, h) do { if constexpr (GATHER) { _Pragma("unroll") for (int _i = 0; _i < 2; ++_i) { const unsigned _o = ((slot) == ui) ? gvo[2 * (h) + _i] : nvo[2 * (h) + _i]; \
            __builtin_amdgcn_global_load_lds((const unsigned*)((const char*)g.A + _o + (koff)), (PG8_LAS unsigned*)(lds + (bufoff) + ldsw + _i * 8192), 16, 0, 0); } } \
        else { PG8_STAGE(bufoff, aptr, voffA); } } while (0)
#define PG8_GLOAD(dst, s_) do { _Pragma("unroll") for (int _j = 0; _j < 4; ++_j) dst[_j] = (unsigned)gtab[(s_) * 256 + gR0 + 64 * _j] * (unsigned)(g.lda * 2) + (unsigned)(gC0 * 2); } while (0)
#define PG8_SA(b, h) (((b) * 2 + (h)) * HTB)
#define PG8_SB(b, h) ((4 + (b) * 2 + (h)) * HTB)
#define PG8_STAGE(bufoff, gbase, voff) do { _Pragma("unroll") for (int _i = 0; _i < 2; ++_i) \
        __builtin_amdgcn_global_load_lds((const unsigned*)((const char*)(gbase) + (voff)[_i]), (PG8_LAS unsigned*)(lds + (bufoff) + ldsw + _i * 8192), 16, 0, 0); } while (0)
#define PG8_LDA(dst, b, h) do { _Pragma("unroll") for (int m = 0; m < 4; ++m) _Pragma("unroll") for (int k = 0; k < 2; ++k) dst[m][k] = *(const PG8_LAS bf16x8*)(lds + PG8_SA(b, h) + aoff + m * 2048 + k * 1024); } while (0)
#define PG8_LDB(dst, b, h) do { _Pragma("unroll") for (int n = 0; n < 2; ++n) _Pragma("unroll") for (int k = 0; k < 2; ++k) dst[n][k] = *(const PG8_LAS bf16x8*)(lds + PG8_SB(b, h) + boff + n * 2048 + k * 1024); } while (0)
#define PG8_MMA(ai, bj, At, Bt) do { __builtin_amdgcn_s_setprio(1); _Pragma("unroll") for (int m = 0; m < 4; ++m) _Pragma("unroll") for (int n = 0; n < 2; ++n) _Pragma("unroll") for (int k = 0; k < 2; ++k) \
        acc[ai][bj][m][n] = __builtin_amdgcn_mfma_f32_16x16x32_bf16(Bt[n][k], At[m][k], acc[ai][bj][m][n], 0, 0, 0); __builtin_amdgcn_s_setprio(0); } while (0)
#define PG8_WAIT_V(n) asm volatile("s_waitcnt vmcnt(" #n ")" ::: "memory")
#define PG8_WAIT_L(n) asm volatile("s_waitcnt lgkmcnt(" #n ")" ::: "memory")
#define PG8_BAR __builtin_amdgcn_s_barrier()
#define PG8_SCHED __builtin_amdgcn_sched_barrier(0)
    Unit cur, nxt; int ui = 0;
    if (!S.next(0, cur)) return;
    unsigned gvo[4] = {0u, 0u, 0u, 0u}, nvo[4] = {0u, 0u, 0u, 0u};
    if constexpr (GATHER) { PG8_GLOAD(gvo, 0); }
    f32x4 acc[2][2][4][2];
#pragma unroll
    for (int a = 0; a < 2; ++a)
#pragma unroll
        for (int b = 0; b < 2; ++b)
#pragma unroll
            for (int m = 0; m < 4; ++m)
#pragma unroll
                for (int n = 0; n < 2; ++n) acc[a][b][m][n] = (f32x4){0.f, 0.f, 0.f, 0.f};
    bf16x8 At[4][2], B0[2][2], B1[2][2];
    const char* cA = (const char*)g.A + (size_t)cur.pm * tstepA; const char* cB = (const char*)g.Bt + (size_t)cur.pn * tstepB;
    S.a_ready(cur);
    if constexpr (SP2) {
        PG8_STAGE(PG8_SB(0, 0), cB, voffB); PG8_STAGE(PG8_SB(0, 1), cB + hstepB, voffB); PG8_STAGE_A(PG8_SA(0, 0), cA, 0, 0, 0); PG8_STAGE_A(PG8_SA(0, 1), cA + hstepA, 0, 0, 1);
        if (wr == 1) PG8_BAR;
        PG8_WAIT_V(2); PG8_BAR;
        PG8_STAGE(PG8_SB(1, 0), cB + kstep, voffB); PG8_STAGE_A(PG8_SA(1, 0), cA + kstep, kstep, 0, 0); PG8_STAGE(PG8_SB(1, 1), cB + hstepB + kstep, voffB);
        PG8_WAIT_V(6); PG8_BAR;
    } else {
        PG8_STAGE(PG8_SB(0, 0), cB, voffB); PG8_STAGE_A(PG8_SA(0, 0), cA, 0, 0, 0); PG8_STAGE(PG8_SB(0, 1), cB + hstepB, voffB); PG8_STAGE_A(PG8_SA(0, 1), cA + hstepA, 0, 0, 1);
        if (wr == 1) PG8_BAR;
        PG8_WAIT_V(4); PG8_BAR;
        PG8_STAGE(PG8_SB(1, 0), cB + kstep, voffB); PG8_STAGE_A(PG8_SA(1, 0), cA + kstep, kstep, 0, 0); PG8_STAGE(PG8_SB(1, 1), cB + hstepB + kstep, voffB);
        PG8_WAIT_V(6); PG8_BAR;
    }
    for (;;) {
        const bool has_next = S.next(ui + 1, nxt);
        if constexpr (GATHER) { if (has_next) { PG8_GLOAD(nvo, ui + 1); } else { _Pragma("unroll") for (int _j = 0; _j < 4; ++_j) nvo[_j] = gvo[_j]; } }
        const char* nA = has_next ? (const char*)g.A + (size_t)nxt.pm * tstepA : cA; const char* nB = has_next ? (const char*)g.Bt + (size_t)nxt.pn * tstepB : cB;
        int t = 0;
        for (int seg = 0; seg < (Epi::HAS_MID ? 3 : 1); ++seg) {
        const int tend = Epi::HAS_MID ? (seg == 0 ? Epi::MID0 : (seg == 1 ? Epi::MID1 : nt)) : nt;
        for (; t < tend; t += 2) {
            const bool last = (t == nt - 2);
            const char* a1 = cA + (size_t)(t + 1) * kstep;
            const char* a2 = last ? nA : cA + (size_t)(t + 2) * kstep; const char* b2 = last ? nB : cB + (size_t)(t + 2) * kstep;
            const char* a3 = a2 + kstep; const char* b3 = b2 + kstep;
            const size_t ka1 = (size_t)(t + 1) * kstep, ka2 = last ? 0 : (size_t)(t + 2) * kstep, ka3 = ka2 + kstep; const int sl2 = (last && has_next) ? ui + 1 : ui;
            if (last && has_next) S.a_ready(nxt);
            if constexpr (SP2) {
            PG8_LDB(B0, 0, 0); PG8_LDB(B1, 0, 1); PG8_SCHED; PG8_LDA(At, 0, 0); PG8_STAGE_A(PG8_SA(1, 1), a1 + hstepA, ka1, ui, 1);
            PG8_WAIT_V(8); PG8_WAIT_L(0); PG8_BAR; PG8_MMA(0, 0, At, B0); PG8_MMA(0, 1, At, B1); PG8_BAR; PG8_SCHED;
            PG8_LDA(At, 0, 1); PG8_STAGE(PG8_SB(0, 0), b2, voffB); PG8_STAGE(PG8_SB(0, 1), b2 + hstepB, voffB); PG8_STAGE_A(PG8_SA(0, 0), a2, ka2, sl2, 0);
            PG8_WAIT_V(8); PG8_WAIT_L(0); PG8_BAR; PG8_MMA(1, 0, At, B0); PG8_MMA(1, 1, At, B1); PG8_BAR; PG8_SCHED;
            PG8_LDB(B0, 1, 0); PG8_LDB(B1, 1, 1); PG8_SCHED; PG8_LDA(At, 1, 0); PG8_STAGE_A(PG8_SA(0, 1), a2 + hstepA, ka2, sl2, 1);
            PG8_WAIT_V(8); PG8_WAIT_L(0); PG8_BAR; PG8_MMA(0, 0, At, B0); PG8_MMA(0, 1, At, B1); PG8_BAR; PG8_SCHED;
            PG8_LDA(At, 1, 1); PG8_STAGE(PG8_SB(1, 0), b3, voffB); PG8_STAGE(PG8_SB(1, 1), b3 + hstepB, voffB); PG8_STAGE_A(PG8_SA(1, 0), a3, ka3, sl2, 0);
            PG8_WAIT_V(8); PG8_WAIT_L(0); PG8_BAR; PG8_MMA(1, 0, At, B0); PG8_MMA(1, 1, At, B1); PG8_BAR; PG8_SCHED;
            } else {
            PG8_LDB(B0, 0, 0); PG8_SCHED; PG8_LDA(At, 0, 0); PG8_STAGE_A(PG8_SA(1, 1), a1 + hstepA, ka1, ui, 1);
            PG8_WAIT_L(8); PG8_BAR; PG8_WAIT_L(0); PG8_MMA(0, 0, At, B0); PG8_BAR; PG8_SCHED;
            PG8_LDB(B1, 0, 1); PG8_STAGE(PG8_SB(0, 0), b2, voffB);
            PG8_BAR; PG8_WAIT_L(0); PG8_MMA(0, 1, At, B1); PG8_BAR;
            PG8_LDA(At, 0, 1); PG8_STAGE_A(PG8_SA(0, 0), a2, ka2, sl2, 0);
            PG8_BAR; PG8_WAIT_L(0); PG8_MMA(1, 0, At, B0); PG8_BAR; PG8_SCHED;
            PG8_STAGE(PG8_SB(0, 1), b2 + hstepB, voffB);
            PG8_WAIT_V(6); PG8_BAR; PG8_MMA(1, 1, At, B1); PG8_BAR;
            PG8_LDB(B0, 1, 0); PG8_SCHED; PG8_LDA(At, 1, 0); PG8_STAGE_A(PG8_SA(0, 1), a2 + hstepA, ka2, sl2, 1);
            PG8_WAIT_L(8); PG8_BAR; PG8_WAIT_L(0); PG8_MMA(0, 0, At, B0); PG8_BAR; PG8_SCHED;
            PG8_LDB(B1, 1, 1); PG8_STAGE(PG8_SB(1, 0), b3, voffB);
            PG8_BAR; PG8_WAIT_L(0); PG8_MMA(0, 1, At, B1); PG8_BAR;
            PG8_LDA(At, 1, 1); PG8_STAGE_A(PG8_SA(1, 0), a3, ka3, sl2, 0);
            PG8_BAR; PG8_WAIT_L(0); PG8_MMA(1, 0, At, B0); PG8_BAR; PG8_SCHED;
            PG8_STAGE(PG8_SB(1, 1), b3 + hstepB, voffB);
            PG8_WAIT_V(6); PG8_BAR; PG8_MMA(1, 1, At, B1); PG8_BAR;
            }
        }
        if constexpr (Epi::HAS_MID) { if (seg < 2) E.mid(acc, cur, wr, wc, fr, fq, seg); }
        }
        if constexpr (ALIGN_EPI) { if (wr == 0) PG8_BAR; }
        E(acc, cur, wr, wc, fr, fq); S.done(cur);
        if (!has_next) break;
#pragma unroll
        for (int a = 0; a < 2; ++a)
#pragma unroll
            for (int b = 0; b < 2; ++b)
#pragma unroll
                for (int m = 0; m < 4; ++m)
#pragma unroll
                    for (int n = 0; n < 2; ++n) acc[a][b][m][n] = (f32x4){0.f, 0.f, 0.f, 0.f};
        cur = nxt; cA = nA; cB = nB; ++ui;
        if constexpr (GATHER) { _Pragma("unroll") for (int _j = 0; _j < 4; ++_j) gvo[_j] = nvo[_j]; }
        if constexpr (ALIGN_EPI) { if (wr == 1) PG8_BAR; }
    }
    PG8_WAIT_V(0);
    if constexpr (!ALIGN_EPI) { if (wr == 0) PG8_BAR; }
    PG8_BAR;
#undef PG8_SA
#undef PG8_SB
#undef PG8_STAGE
#undef PG8_STAGE_A
#undef PG8_GLOAD
#undef PG8_LDA
#undef PG8_LDB
#undef PG8_MMA
#undef PG8_WAIT_V
#undef PG8_WAIT_L
#undef PG8_BAR
#undef PG8_SCHED
}
}
namespace pg8 {
typedef int i32x4v __attribute__((ext_vector_type(4)));
typedef int i32x8 __attribute__((ext_vector_type(8)));
struct Gemm8 { const unsigned char* A; const unsigned char* Bt; int lda, ldb, K; };
template <class Epi, class Sched, bool GATHER = false>
__device__ __forceinline__ void gemm_phase_f8(PG8_LAS unsigned char* lds, const Gemm8 g, const Sched& S, const Epi& E, const PG8_LAS int* gtab = nullptr) {
    constexpr bool ALIGN_EPI = true, SP2 = true;
    int tid_ = threadIdx.x; asm volatile("" : "+v"(tid_));
    const int tid = tid_, wid = __builtin_amdgcn_readfirstlane(tid >> 6), lane = tid & 63, wr = wid >> 2, wc = wid & 3, fr = lane & 15, fq = lane >> 4;
    int K_ = g.K; asm volatile("" : "+s"(K_));
    const int K = K_, nt = K / 128;
    unsigned voffA[2], voffB[2];
#pragma unroll
    for (int i = 0; i < 2; ++i) { int R, C; stage_rc(tid * 16 + i * 8192, R, C); const int Rb = Epi::PERM ? ((R & ~31) + perm32(R & 31)) : R;
        voffA[i] = (unsigned)(R * g.lda + C * 2); voffB[i] = (unsigned)(Rb * g.ldb + C * 2); }
    const size_t kstep = (size_t)(BK * 2);
    const size_t hstepA = (size_t)HALF * g.lda, hstepB = (size_t)HALF * g.ldb;
    const size_t tstepA = 2 * hstepA, tstepB = 2 * hstepB;
    const unsigned ldsw = (unsigned)wid * 1024u;
    const int aoff = lds_byte(wr * 64 + fr, fq * 16), boff = lds_byte(wc * 32 + fr, fq * 16);
    int gR0 = 0, gC0 = 0; if constexpr (GATHER) { stage_rc(tid * 16, gR0, gC0); }
#define PG8_STAGE_A(bufoff, aptr, koff, slot, h) do { if constexpr (GATHER) { _Pragma("unroll") for (int _i = 0; _i < 2; ++_i) { const unsigned _o = ((slot) == ui) ? gvo[2 * (h) + _i] : nvo[2 * (h) + _i]; \
            __builtin_amdgcn_global_load_lds((const unsigned*)((const char*)g.A + _o + (koff)), (PG8_LAS unsigned*)(lds + (bufoff) + ldsw + _i * 8192), 16, 0, 0); } } \
        else { PG8_STAGE(bufoff, aptr, voffA); } } while (0)
#define PG8_GLOAD(dst, s_) do { _Pragma("unroll") for (int _j = 0; _j < 4; ++_j) dst[_j] = (unsigned)gtab[(s_) * 256 + gR0 + 64 * _j] * (unsigned)(g.lda) + (unsigned)(gC0 * 2); } while (0)
#define PG8_SA(b, h) (((b) * 2 + (h)) * HTB)
#define PG8_SB(b, h) ((4 + (b) * 2 + (h)) * HTB)
#define PG8_STAGE(bufoff, gbase, voff) do { _Pragma("unroll") for (int _i = 0; _i < 2; ++_i) \
        __builtin_amdgcn_global_load_lds((const unsigned*)((const char*)(gbase) + (voff)[_i]), (PG8_LAS unsigned*)(lds + (bufoff) + ldsw + _i * 8192), 16, 0, 0); } while (0)
#define PG8_LDA(dst, b, h) do { _Pragma("unroll") for (int m = 0; m < 4; ++m) { const i32x4v lo_ = *(const PG8_LAS i32x4v*)(lds + PG8_SA(b, h) + aoff + m * 2048), hi_ = *(const PG8_LAS i32x4v*)(lds + PG8_SA(b, h) + aoff + m * 2048 + 16); dst[m] = __builtin_shufflevector(lo_, hi_, 0, 1, 2, 3, 4, 5, 6, 7); } } while (0)
#define PG8_LDB(dst, b, h) do { _Pragma("unroll") for (int n = 0; n < 2; ++n) { const i32x4v lo_ = *(const PG8_LAS i32x4v*)(lds + PG8_SB(b, h) + boff + n * 2048), hi_ = *(const PG8_LAS i32x4v*)(lds + PG8_SB(b, h) + boff + n * 2048 + 16); dst[n] = __builtin_shufflevector(lo_, hi_, 0, 1, 2, 3, 4, 5, 6, 7); } } while (0)
#define PG8_MMA(ai, bj, At, Bt) do { __builtin_amdgcn_s_setprio(1); _Pragma("unroll") for (int m = 0; m < 4; ++m) _Pragma("unroll") for (int n = 0; n < 2; ++n) \
        asm volatile("v_mfma_scale_f32_16x16x128_f8f6f4 %0, %1, %2, %0, %3, %3 op_sel_hi:[0,0,0]" : "+v"(acc[ai][bj][m][n]) : "v"(Bt[n]), "v"(At[m]), "v"(sc1)); __builtin_amdgcn_s_setprio(0); } while (0)
#define PG8_WAIT_V(n) asm volatile("s_waitcnt vmcnt(" #n ")" ::: "memory")
#define PG8_WAIT_L(n) asm volatile("s_waitcnt lgkmcnt(" #n ")" ::: "memory")
#define PG8_BAR __builtin_amdgcn_s_barrier()
#define PG8_SCHED __builtin_amdgcn_sched_barrier(0)
    Unit cur, nxt; int ui = 0;
    if (!S.next(0, cur)) return;
    unsigned gvo[4] = {0u, 0u, 0u, 0u}, nvo[4] = {0u, 0u, 0u, 0u};
    if constexpr (GATHER) { PG8_GLOAD(gvo, 0); }
    f32x4 acc[2][2][4][2];
#pragma unroll
    for (int a = 0; a < 2; ++a)
#pragma unroll
        for (int b = 0; b < 2; ++b)
#pragma unroll
            for (int m = 0; m < 4; ++m)
#pragma unroll
                for (int n = 0; n < 2; ++n) acc[a][b][m][n] = (f32x4){0.f, 0.f, 0.f, 0.f};
    i32x8 At[4], B0[2], B1[2];
    int sc1 = 0x7f7f7f7f; asm volatile("" : "+v"(sc1));
    const char* cA = (const char*)g.A + (size_t)cur.pm * tstepA; const char* cB = (const char*)g.Bt + (size_t)cur.pn * tstepB;
    S.a_ready(cur);
    if constexpr (SP2) {
        PG8_STAGE(PG8_SB(0, 0), cB, voffB); PG8_STAGE(PG8_SB(0, 1), cB + hstepB, voffB); PG8_STAGE_A(PG8_SA(0, 0), cA, 0, 0, 0); PG8_STAGE_A(PG8_SA(0, 1), cA + hstepA, 0, 0, 1);
        if (wr == 1) PG8_BAR;
        PG8_WAIT_V(2); PG8_BAR;
        PG8_STAGE(PG8_SB(1, 0), cB + kstep, voffB); PG8_STAGE_A(PG8_SA(1, 0), cA + kstep, kstep, 0, 0); PG8_STAGE(PG8_SB(1, 1), cB + hstepB + kstep, voffB);
        PG8_WAIT_V(6); PG8_BAR;
    } else {
        PG8_STAGE(PG8_SB(0, 0), cB, voffB); PG8_STAGE_A(PG8_SA(0, 0), cA, 0, 0, 0); PG8_STAGE(PG8_SB(0, 1), cB + hstepB, voffB); PG8_STAGE_A(PG8_SA(0, 1), cA + hstepA, 0, 0, 1);
        if (wr == 1) PG8_BAR;
        PG8_WAIT_V(4); PG8_BAR;
        PG8_STAGE(PG8_SB(1, 0), cB + kstep, voffB); PG8_STAGE_A(PG8_SA(1, 0), cA + kstep, kstep, 0, 0); PG8_STAGE(PG8_SB(1, 1), cB + hstepB + kstep, voffB);
        PG8_WAIT_V(6); PG8_BAR;
    }
    for (;;) {
        const bool has_next = S.next(ui + 1, nxt);
        if constexpr (GATHER) { if (has_next) { PG8_GLOAD(nvo, ui + 1); } else { _Pragma("unroll") for (int _j = 0; _j < 4; ++_j) nvo[_j] = gvo[_j]; } }
        const char* nA = has_next ? (const char*)g.A + (size_t)nxt.pm * tstepA : cA; const char* nB = has_next ? (const char*)g.Bt + (size_t)nxt.pn * tstepB : cB;
        int t = 0;
        for (int seg = 0; seg < (Epi::HAS_MID ? 3 : 1); ++seg) {
        const int tend = Epi::HAS_MID ? (seg == 0 ? Epi::MID0 : (seg == 1 ? Epi::MID1 : nt)) : nt;
#pragma unroll 1
        for (; t < tend; t += 2) {
            const bool last = (t == nt - 2);
            const char* a1 = cA + (size_t)(t + 1) * kstep;
            const char* a2 = last ? nA : cA + (size_t)(t + 2) * kstep; const char* b2 = last ? nB : cB + (size_t)(t + 2) * kstep;
            const char* a3 = a2 + kstep; const char* b3 = b2 + kstep;
            const size_t ka1 = (size_t)(t + 1) * kstep, ka2 = last ? 0 : (size_t)(t + 2) * kstep, ka3 = ka2 + kstep; const int sl2 = (last && has_next) ? ui + 1 : ui;
            if (last && has_next) S.a_ready(nxt);
            if constexpr (SP2) {
            PG8_LDB(B0, 0, 0); PG8_LDB(B1, 0, 1); PG8_SCHED; PG8_LDA(At, 0, 0); PG8_STAGE_A(PG8_SA(1, 1), a1 + hstepA, ka1, ui, 1);
            PG8_WAIT_V(8); PG8_WAIT_L(0); PG8_BAR; PG8_MMA(0, 0, At, B0); PG8_MMA(0, 1, At, B1); PG8_BAR; PG8_SCHED;
            PG8_LDA(At, 0, 1); PG8_STAGE(PG8_SB(0, 0), b2, voffB); PG8_STAGE(PG8_SB(0, 1), b2 + hstepB, voffB); PG8_STAGE_A(PG8_SA(0, 0), a2, ka2, sl2, 0);
            PG8_WAIT_V(8); PG8_WAIT_L(0); PG8_BAR; PG8_MMA(1, 0, At, B0); PG8_MMA(1, 1, At, B1); PG8_BAR; PG8_SCHED;
            PG8_LDB(B0, 1, 0); PG8_LDB(B1, 1, 1); PG8_SCHED; PG8_LDA(At, 1, 0); PG8_STAGE_A(PG8_SA(0, 1), a2 + hstepA, ka2, sl2, 1);
            PG8_WAIT_V(8); PG8_WAIT_L(0); PG8_BAR; PG8_MMA(0, 0, At, B0); PG8_MMA(0, 1, At, B1); PG8_BAR; PG8_SCHED;
            PG8_LDA(At, 1, 1); PG8_STAGE(PG8_SB(1, 0), b3, voffB); PG8_STAGE(PG8_SB(1, 1), b3 + hstepB, voffB); PG8_STAGE_A(PG8_SA(1, 0), a3, ka3, sl2, 0);
            PG8_WAIT_V(8); PG8_WAIT_L(0); PG8_BAR; PG8_MMA(1, 0, At, B0); PG8_MMA(1, 1, At, B1); PG8_BAR; PG8_SCHED;
            } else {
            PG8_LDB(B0, 0, 0); PG8_SCHED; PG8_LDA(At, 0, 0); PG8_STAGE_A(PG8_SA(1, 1), a1 + hstepA, ka1, ui, 1);
            PG8_WAIT_L(8); PG8_BAR; PG8_WAIT_L(0); PG8_MMA(0, 0, At, B0); PG8_BAR; PG8_SCHED;
            PG8_LDB(B1, 0, 1); PG8_STAGE(PG8_SB(0, 0), b2, voffB);
            PG8_BAR; PG8_WAIT_L(0); PG8_MMA(0, 1, At, B1); PG8_BAR;
            PG8_LDA(At, 0, 1); PG8_STAGE_A(PG8_SA(0, 0), a2, ka2, sl2, 0);
            PG8_BAR; PG8_WAIT_L(0); PG8_MMA(1, 0, At, B0); PG8_BAR; PG8_SCHED;
            PG8_STAGE(PG8_SB(0, 1), b2 + hstepB, voffB);
            PG8_WAIT_V(6); PG8_BAR; PG8_MMA(1, 1, At, B1); PG8_BAR;
            PG8_LDB(B0, 1, 0); PG8_SCHED; PG8_LDA(At, 1, 0); PG8_STAGE_A(PG8_SA(0, 1), a2 + hstepA, ka2, sl2, 1);
            PG8_WAIT_L(8); PG8_BAR; PG8_WAIT_L(0); PG8_MMA(0, 0, At, B0); PG8_BAR; PG8_SCHED;
            PG8_LDB(B1, 1, 1); PG8_STAGE(PG8_SB(1, 0), b3, voffB);
            PG8_BAR; PG8_WAIT_L(0); PG8_MMA(0, 1, At, B1); PG8_BAR;
            PG8_LDA(At, 1, 1); PG8_STAGE_A(PG8_SA(1, 0), a3, ka3, sl2, 0);
            PG8_BAR; PG8_WAIT_L(0); PG8_MMA(1, 0, At, B0); PG8_BAR; PG8_SCHED;
            PG8_STAGE(PG8_SB(1, 1), b3 + hstepB, voffB);
            PG8_WAIT_V(6); PG8_BAR; PG8_MMA(1, 1, At, B1); PG8_BAR;
            }
        }
        if constexpr (Epi::HAS_MID) { if (seg < 2) E.mid(acc, cur, wr, wc, fr, fq, seg); }
        }
        if constexpr (ALIGN_EPI) { if (wr == 0) PG8_BAR; }
        asm volatile("s_nop 15\n\ts_nop 15" ::: "memory");
        E(acc, cur, wr, wc, fr, fq); S.done(cur);
        if (!has_next) break;
#pragma unroll
        for (int a = 0; a < 2; ++a)
#pragma unroll
            for (int b = 0; b < 2; ++b)
#pragma unroll
                for (int m = 0; m < 4; ++m)
#pragma unroll
                    for (int n = 0; n < 2; ++n) acc[a][b][m][n] = (f32x4){0.f, 0.f, 0.f, 0.f};
        cur = nxt; cA = nA; cB = nB; ++ui;
        if constexpr (GATHER) { _Pragma("unroll") for (int _j = 0; _j < 4; ++_j) gvo[_j] = nvo[_j]; }
        if constexpr (ALIGN_EPI) { if (wr == 1) PG8_BAR; }
    }
    PG8_WAIT_V(0);
    if constexpr (!ALIGN_EPI) { if (wr == 0) PG8_BAR; }
    PG8_BAR;
#undef PG8_SA
#undef PG8_SB
#undef PG8_STAGE
#undef PG8_STAGE_A
#undef PG8_GLOAD
#undef PG8_LDA
#undef PG8_LDB
#undef PG8_MMA
#undef PG8_WAIT_V
#undef PG8_WAIT_L
#undef PG8_BAR
#undef PG8_SCHED
}
}
#define XB_TMO      128
#define XB_XCNT(j)  (256  + 64 * (j))
#define XB_XSUB(j)  (1280 + 64 * (j))
#define XB_XGEN(j)  (2304 + 64 * (j))
#define XB_TOP      3328
#define XB_TOPGEN   3392
#define XCD_BAR_WORDS 3456
#define XB_SPIN_CAP (1u << 18)

__device__ __forceinline__ unsigned xb_ld(unsigned* p)              { return __hip_atomic_load(p, __ATOMIC_RELAXED, __HIP_MEMORY_SCOPE_AGENT); }
__device__ __forceinline__ unsigned xb_add(unsigned* p, unsigned v) { return __hip_atomic_fetch_add(p, v, __ATOMIC_RELAXED, __HIP_MEMORY_SCOPE_AGENT); }
__device__ __forceinline__ unsigned xb_xcc_id() { return (unsigned)__builtin_amdgcn_s_getreg((3 << 11) | 20) & 0xFu; }
#define XB_SPIN(cond, bar) do { unsigned _sp = 0; while (cond) { __builtin_amdgcn_s_sleep(1); \
    if ((++_sp & 255u) == 0u) { if (xb_ld(&(bar)[XB_TMO])) break; if (_sp > XB_SPIN_CAP) { atomicAdd(&(bar)[XB_TMO], 1u); break; } } } } while (0)

struct XcdBarrier {
    unsigned* bar; unsigned x;
    volatile LAS unsigned* st;
};

__device__ __forceinline__ XcdBarrier xcd_barrier_post(unsigned* bar, volatile LAS unsigned* st) {
    XcdBarrier b; b.bar = bar; b.x = xb_xcc_id(); b.st = st;
    if (threadIdx.x == 0) (void)xb_add(&bar[XB_XCNT(b.x)], 1u);
    return b;
}
__device__ __forceinline__ void xcd_barrier_complete(unsigned* bar, unsigned x, unsigned& nloc, unsigned& nx) {
    const unsigned G = gridDim.x * gridDim.y * gridDim.z;
    unsigned sum, cnt, mine, sp = 0u;
    for (;;) {
        sum = 0u; cnt = 0u; mine = 0u;
#pragma unroll
        for (unsigned j = 0; j < 16; ++j) { const unsigned c = xb_ld(&bar[XB_XCNT(j)]); sum += c; cnt += (c > 0u) ? 1u : 0u; mine = (j == x) ? c : mine; }
        if (sum == G) break;
        __builtin_amdgcn_s_sleep(1);
        if ((++sp & 255u) == 0u) { if (xb_ld(&bar[XB_TMO])) break; if (sp > XB_SPIN_CAP) { atomicAdd(&bar[XB_TMO], 1u); break; } }
    }
    nloc = mine > 0u ? mine : 1u; nx = cnt > 0u ? cnt : 1u;
}

__device__ __forceinline__ void xcd_barrier(const XcdBarrier& b) {
    asm volatile("s_waitcnt vmcnt(0)" ::: "memory");
    __syncthreads();
    if (threadIdx.x == 0) {
        unsigned* bar = b.bar;
        __builtin_amdgcn_s_waitcnt(0);
        unsigned nloc = b.st[0], nx = b.st[1];
        if (nloc == 0u) { xcd_barrier_complete(bar, b.x, nloc, nx); b.st[0] = nloc; b.st[1] = nx; }
        const unsigned old = xb_add(&bar[XB_XSUB(b.x)], 1u);
        const unsigned gen = old / nloc;
        if (old + 1u == (gen + 1u) * nloc) {
            __builtin_amdgcn_fence(__ATOMIC_RELEASE, "agent");
            asm volatile("s_waitcnt vmcnt(0)" ::: "memory");
            const unsigned og = xb_add(&bar[XB_TOP], 1u);
            const unsigned tg = og / nx;
            if (og + 1u == (tg + 1u) * nx) xb_add(&bar[XB_TOPGEN], 1u);
            else XB_SPIN(xb_ld(&bar[XB_TOPGEN]) == tg, bar);
            __builtin_amdgcn_fence(__ATOMIC_ACQUIRE, "agent");
            xb_add(&bar[XB_XGEN(b.x)], 1u);
            asm volatile("s_waitcnt vmcnt(0)" ::: "memory");
        } else {
            XB_SPIN(xb_ld(&bar[XB_XGEN(b.x)]) == gen, bar);
            __builtin_amdgcn_fence(__ATOMIC_ACQUIRE, "agent");
            asm volatile("s_waitcnt vmcnt(0)" ::: "memory");
        }
    }
    __syncthreads();
}
namespace pg8 {
struct EpiProj {
    static constexpr bool PERM = true, HAS_MID = false; static constexpr int MID0 = 0, MID1 = 0;
    __device__ __forceinline__ void mid(f32x4 (&)[2][2][4][2], const Unit&, int, int, int, int, int) const {}
    bf16_t* proj; float* gsm;
    __device__ __forceinline__ void operator()(const f32x4 (&acc)[2][2][4][2], const Unit& u, int wr, int wc, int fr, int fq) const {
        const int row0 = u.pm * BM + wr * 64 + fr;
        if (u.pn < 14) {
            const int col0 = u.pn * BM + wc * 32 + 8 * fq;
#pragma unroll
            for (int ai = 0; ai < 2; ++ai)
#pragma unroll
                for (int m = 0; m < 4; ++m) { bf16_t* rowp = proj + (size_t)(row0 + ai * HALF + m * 16) * NPROJ + col0;
#pragma unroll
                    for (int bj = 0; bj < 2; ++bj) { const f32x4 v0 = acc[ai][bj][m][0], v1 = acc[ai][bj][m][1];
                        u32x4 w; w.x = cvt_pk_bf16(v0[0], v0[1]); w.y = cvt_pk_bf16(v0[2], v0[3]); w.z = cvt_pk_bf16(v1[0], v1[1]); w.w = cvt_pk_bf16(v1[2], v1[3]);
                        *(u32x4*)(rowp + bj * HALF) = w; } }
        } else if (wc == 0 && fq < 3) {
#pragma unroll
            for (int ai = 0; ai < 2; ++ai)
#pragma unroll
                for (int m = 0; m < 4; ++m) { float* rowp = gsm + (size_t)(row0 + ai * HALF + m * 16) * 32 + 8 * fq;
                    *(f32x4*)(rowp) = acc[ai][0][m][0]; *(f32x4*)(rowp + 4) = acc[ai][0][m][1]; }
        }
    }
};
struct EpiProj8 {
    static constexpr bool PERM = true, HAS_MID = false; static constexpr int MID0 = 0, MID1 = 0;
    __device__ __forceinline__ void mid(f32x4 (&)[2][2][4][2], const Unit&, int, int, int, int, int) const {}
    bf16_t* proj; bf16_t* gd;
    __device__ __forceinline__ void operator()(const f32x4 (&acc)[2][2][4][2], const Unit& u, int wr, int wc, int fr, int fq) const {
        constexpr float sc = 1.0f / (F8_SX * F8_SWI);
        const int row0 = u.pm * BM + wr * 64 + fr;
        if (u.pn >= 8) {
            const int gt = u.pn - 8; bf16_t* base = gd + ((size_t)((gt >> 2) * 128 + u.pm) * 4 + (gt & 3)) * 65536 + (size_t)((wr * 4 + wc) * 64 + fq * 16 + fr) * 8;
#pragma unroll
            for (int ai = 0; ai < 2; ++ai)
#pragma unroll
                for (int m = 0; m < 4; ++m)
#pragma unroll
                    for (int bj = 0; bj < 2; ++bj) { const f32x4 v0 = acc[ai][bj][m][0] * sc, v1 = acc[ai][bj][m][1] * sc;
                        u32x4 w; w.x = cvt_pk_bf16(v0[0], v0[1]); w.y = cvt_pk_bf16(v0[2], v0[3]); w.z = cvt_pk_bf16(v1[0], v1[1]); w.w = cvt_pk_bf16(v1[2], v1[3]);
                        *(u32x4*)(base + (size_t)((ai * 4 + m) * 2 + bj) * 4096) = w; }
        } else {
            const int col0 = PC_LRUY + u.pn * BM + wc * 32 + 8 * fq;
#pragma unroll
            for (int ai = 0; ai < 2; ++ai)
#pragma unroll
                for (int m = 0; m < 4; ++m) { bf16_t* rowp = proj + (size_t)(row0 + ai * HALF + m * 16) * NPROJ + col0;
#pragma unroll
                    for (int bj = 0; bj < 2; ++bj) { const f32x4 v0 = acc[ai][bj][m][0] * sc, v1 = acc[ai][bj][m][1] * sc;
                        u32x4 w; w.x = cvt_pk_bf16(v0[0], v0[1]); w.y = cvt_pk_bf16(v0[2], v0[3]); w.z = cvt_pk_bf16(v1[0], v1[1]); w.w = cvt_pk_bf16(v1[2], v1[3]);
                        *(u32x4*)(rowp + bj * HALF) = w; } }
        }
    }
};
struct P1F8Order {
    int G, c;
    __device__ __forceinline__ bool next(int i, Unit& u) const {
        int L;
        if (G == 256) { const int cnt = c < 128 ? 9 : 11; if (i >= cnt) return false; L = (c < 128 ? c * 9 : 1152 + (c - 128) * 11) + i; }
        else { L = i * G + c; if (L >= 128 * 20) return false; }
        u.pm = L / 20; u.pn = L % 20; return true;
    }
    __device__ __forceinline__ void a_ready(const Unit&) const {}
    __device__ __forceinline__ void done(const Unit&) const {}
};
struct EpiMergeF {
    static constexpr bool PERM = true, HAS_MID = true; static constexpr int MID0 = 16, MID1 = 24;
    const bf16_t* gd; bf16_t* mb;
    static __device__ __forceinline__ float em(float x) { return __expf(fminf(-x, 40.0f)); }
    __device__ __forceinline__ void mid(f32x4 (&acc)[2][2][4][2], const Unit& u, int wr, int wc, int fr, int fq, int st) const {
        int toff = ((wr * 4 + wc) * 64 + fq * 16 + fr) * 8; asm volatile("" : "+v"(toff));
        const bf16_t* ga_ = gd + ((size_t)(st * 128 + u.pm) * 4 + u.pn) * 65536 + toff; const bf16_t* gb_ = ga_ + (size_t)128 * 4 * 65536;
#pragma unroll
        for (int ai = 0; ai < 2; ++ai) {
            u32x4 ga[4][2], gb[4][2];
#pragma unroll
            for (int m = 0; m < 4; ++m)
#pragma unroll
                for (int bj = 0; bj < 2; ++bj) { const int o = ((ai * 4 + m) * 2 + bj) * 4096; ga[m][bj] = *(const u32x4*)(ga_ + o); gb[m][bj] = *(const u32x4*)(gb_ + o); }
#pragma unroll
            for (int m = 0; m < 4; ++m)
#pragma unroll
                for (int bj = 0; bj < 2; ++bj) { const unsigned xa[4] = {ga[m][bj].x, ga[m][bj].y, ga[m][bj].z, ga[m][bj].w}, xb[4] = {gb[m][bj].x, gb[m][bj].y, gb[m][bj].z, gb[m][bj].w};
#pragma unroll
                    for (int q = 0; q < 4; ++q) { const float r0 = (1.f + em(bflo(xb[q]))) * __builtin_amdgcn_rcpf(1.f + em(bflo(xa[q]))), r1 = (1.f + em(bfhi(xb[q]))) * __builtin_amdgcn_rcpf(1.f + em(bfhi(xa[q])));
                        acc[ai][bj][m][q >> 1][(q & 1) * 2] *= r0; acc[ai][bj][m][q >> 1][(q & 1) * 2 + 1] *= r1; } }
            asm volatile("" ::: "memory"); }
    }
    __device__ __forceinline__ void operator()(const f32x4 (&acc)[2][2][4][2], const Unit& u, int wr, int wc, int fr, int fq) const {
        const int row0 = u.pm * BM + wr * 64 + fr, col0 = u.pn * BM + wc * 32 + 8 * fq;
        const bf16_t* g2 = gd + ((size_t)(2 * 128 + u.pm) * 4 + u.pn) * 65536 + (size_t)((wr * 4 + wc) * 64 + fq * 16 + fr) * 8;
#pragma unroll
        for (int ai = 0; ai < 2; ++ai) {
            u32x4 gwv[4][2];
#pragma unroll
            for (int m = 0; m < 4; ++m)
#pragma unroll
                for (int bj = 0; bj < 2; ++bj) gwv[m][bj] = *(const u32x4*)(g2 + ((ai * 4 + m) * 2 + bj) * 4096);
#pragma unroll
            for (int m = 0; m < 4; ++m) { const size_t row = (size_t)(row0 + ai * HALF + m * 16);
#pragma unroll
                for (int bj = 0; bj < 2; ++bj) { const int col = col0 + bj * HALF; const u32x4 gw = gwv[m][bj];
                    f32x4 g0, g1;
                    g0[0] = sigmoid_f(bflo(gw.x)); g0[1] = sigmoid_f(bfhi(gw.x)); g0[2] = sigmoid_f(bflo(gw.y)); g0[3] = sigmoid_f(bfhi(gw.y));
                    g1[0] = sigmoid_f(bflo(gw.z)); g1[1] = sigmoid_f(bfhi(gw.z)); g1[2] = sigmoid_f(bflo(gw.w)); g1[3] = sigmoid_f(bfhi(gw.w));
                    const f32x4 v0 = acc[ai][bj][m][0] * g0, v1 = acc[ai][bj][m][1] * g1;
                    u32x4 w; w.x = cvt_pk_bf16(v0[0], v0[1]); w.y = cvt_pk_bf16(v0[2], v0[3]); w.z = cvt_pk_bf16(v1[0], v1[1]); w.w = cvt_pk_bf16(v1[2], v1[3]);
                    *(u32x4*)(mb + row * 1024 + col) = w; } }
            asm volatile("" ::: "memory"); }
    }
};
struct EpiWout {
    static constexpr bool PERM = true, HAS_MID = false; static constexpr int MID0 = 0, MID1 = 0;
    __device__ __forceinline__ void mid(f32x4 (&)[2][2][4][2], const Unit&, int, int, int, int, int) const {}
    const float* xf; const bf16_t* xh; bf16_t* v;
    __device__ __forceinline__ void operator()(const f32x4 (&acc)[2][2][4][2], const Unit& u, int wr, int wc, int fr, int fq) const {
        const int row0 = u.pm * BM + wr * 64 + fr, col0 = u.pn * BM + wc * 32 + 8 * fq;
#pragma unroll
        for (int ai = 0; ai < 2; ++ai) {
            f32x4 x0[4][2], x1[4][2];
#pragma unroll
            for (int m = 0; m < 4; ++m) { const size_t off = (size_t)(row0 + ai * HALF + m * 16) * 1024 + col0;
#pragma unroll
                for (int bj = 0; bj < 2; ++bj) {
                    if (xf) { x0[m][bj] = *(const f32x4*)(xf + off + bj * HALF); x1[m][bj] = *(const f32x4*)(xf + off + bj * HALF + 4); }
                    else { const u32x4 w = *(const u32x4*)(xh + off + bj * HALF); x0[m][bj] = (f32x4){bflo(w.x), bfhi(w.x), bflo(w.y), bfhi(w.y)}; x1[m][bj] = (f32x4){bflo(w.z), bfhi(w.z), bflo(w.w), bfhi(w.w)}; } } }
#pragma unroll
            for (int m = 0; m < 4; ++m) { const size_t off = (size_t)(row0 + ai * HALF + m * 16) * 1024 + col0;
#pragma unroll
                for (int bj = 0; bj < 2; ++bj) { const f32x4 v0 = x0[m][bj] * DN_ALPHA + acc[ai][bj][m][0], v1 = x1[m][bj] * DN_ALPHA + acc[ai][bj][m][1];
                    u32x4 w; w.x = cvt_pk_bf16(v0[0], v0[1]); w.y = cvt_pk_bf16(v0[2], v0[3]); w.z = cvt_pk_bf16(v1[0], v1[1]); w.w = cvt_pk_bf16(v1[2], v1[3]);
                    *(u32x4*)(v + off + bj * HALF) = w; } }
            asm volatile("" ::: "memory"); }
    }
};
struct EpiMoe1 {
    __device__ __forceinline__ void mid(f32x4 (&)[2][2][4][2], const Unit&, int, int, int, int, int) const {}
    static constexpr bool PERM = true, HAS_MID = false; static constexpr int MID0 = 0, MID1 = 0;
    bf16_t* act; const float* b1;
    __device__ __forceinline__ void operator()(const f32x4 (&acc)[2][2][4][2], const Unit& u, int wr, int wc, int fr, int fq) const {
        const int e = u.pn >> 3, tl = u.pn & 7;
        const int row0 = u.pm * BM + wr * 64 + fr, col0 = tl * 128 + wc * 32 + 8 * fq;
        const float* bp = b1 + (size_t)e * 2048 + col0;
        const f32x4 bg0 = *(const f32x4*)(bp), bg1 = *(const f32x4*)(bp + 4), bl0 = *(const f32x4*)(bp + 1024), bl1 = *(const f32x4*)(bp + 1028);
#pragma unroll
        for (int ai = 0; ai < 2; ++ai)
#pragma unroll
            for (int m = 0; m < 4; ++m) { bf16_t* rowp = act + (size_t)(row0 + ai * HALF + m * 16) * 1024 + col0;
                f32x4 o[2];
#pragma unroll
                for (int n = 0; n < 2; ++n) { const f32x4 gg = acc[ai][0][m][n] + (n ? bg1 : bg0), ll = acc[ai][1][m][n] + (n ? bl1 : bl0);
#pragma unroll
                    for (int q = 0; q < 4; ++q) { const float gv = fminf(gg[q], 7.0f), lv = fminf(fmaxf(ll[q], -7.0f), 7.0f);
                        o[n][q] = gv * sigmoid_f(1.702f * gv) * (lv + 1.0f); } }
                u32x4 w; w.x = cvt_pk_bf16(o[0][0], o[0][1]); w.y = cvt_pk_bf16(o[0][2], o[0][3]); w.z = cvt_pk_bf16(o[1][0], o[1][1]); w.w = cvt_pk_bf16(o[1][2], o[1][3]);
                *(u32x4*)(rowp) = w; }
    }
};
struct EpiMoe2 {
    __device__ __forceinline__ void mid(f32x4 (&)[2][2][4][2], const Unit&, int, int, int, int, int) const {}
    static constexpr bool PERM = true, HAS_MID = false; static constexpr int MID0 = 0, MID1 = 0;
    bf16_t* ys; const float* b2; const float* wbuf;
    __device__ __forceinline__ void operator()(const f32x4 (&acc)[2][2][4][2], const Unit& u, int wr, int wc, int fr, int fq) const {
        const int e = u.pn >> 2, tl = u.pn & 3;
        const int row0 = u.pm * BM + wr * 64 + fr, col0 = tl * 256 + wc * 32 + 8 * fq;
        const float* bp = b2 + (size_t)e * 1024 + col0;
        f32x4 bv[2][2];
#pragma unroll
        for (int bj = 0; bj < 2; ++bj) { bv[bj][0] = *(const f32x4*)(bp + bj * HALF); bv[bj][1] = *(const f32x4*)(bp + bj * HALF + 4); }
#pragma unroll
        for (int ai = 0; ai < 2; ++ai)
#pragma unroll
            for (int m = 0; m < 4; ++m) { const int row = row0 + ai * HALF + m * 16; const float ww = wbuf[row]; bf16_t* rowp = ys + (size_t)row * 1024 + col0;
#pragma unroll
                for (int bj = 0; bj < 2; ++bj) { const f32x4 v0 = (acc[ai][bj][m][0] + bv[bj][0]) * ww, v1 = (acc[ai][bj][m][1] + bv[bj][1]) * ww;
                    u32x4 w; w.x = cvt_pk_bf16(v0[0], v0[1]); w.y = cvt_pk_bf16(v0[2], v0[3]); w.z = cvt_pk_bf16(v1[0], v1[1]); w.w = cvt_pk_bf16(v1[2], v1[3]);
                    *(u32x4*)(rowp + bj * HALF) = w; } }
    }
};
struct EpiMoe1F8 {
    static constexpr bool PERM = true, HAS_MID = false; static constexpr int MID0 = 0, MID1 = 0;
    __device__ __forceinline__ void mid(f32x4 (&)[2][2][4][2], const Unit&, int, int, int, int, int) const {}
    unsigned char* act8; const float* b1;
    __device__ __forceinline__ void operator()(const f32x4 (&acc)[2][2][4][2], const Unit& u, int wr, int wc, int fr, int fq) const {
        const int e = u.pn >> 3, tl = u.pn & 7;
        const int row0 = u.pm * BM + wr * 64 + fr, col0 = tl * 128 + wc * 32 + 8 * fq;
        const float* bp = b1 + (size_t)e * 2048 + col0;
        const f32x4 bg0 = *(const f32x4*)(bp), bg1 = *(const f32x4*)(bp + 4), bl0 = *(const f32x4*)(bp + 1024), bl1 = *(const f32x4*)(bp + 1028);
        constexpr float sc = 1.0f / (F8_SX * F8_SW1);
#pragma unroll
        for (int ai = 0; ai < 2; ++ai)
#pragma unroll
            for (int m = 0; m < 4; ++m) { unsigned char* rowp = act8 + (size_t)(row0 + ai * HALF + m * 16) * 1024 + col0;
                f32x4 o[2];
#pragma unroll
                for (int n = 0; n < 2; ++n) { const f32x4 gg = acc[ai][0][m][n] * sc + (n ? bg1 : bg0), ll = acc[ai][1][m][n] * sc + (n ? bl1 : bl0);
#pragma unroll
                    for (int q = 0; q < 4; ++q) { const float gv = fminf(gg[q], 7.0f), lv = fminf(fmaxf(ll[q], -7.0f), 7.0f);
                        o[n][q] = gv * sigmoid_f(1.702f * gv) * (lv + 1.0f) * F8_SA; } }
                u32x2 w; w.x = pk_fp8x4(o[0][0], o[0][1], o[0][2], o[0][3]); w.y = pk_fp8x4(o[1][0], o[1][1], o[1][2], o[1][3]);
                *(u32x2*)(rowp) = w; }
    }
};
struct EpiMoe2F8 {
    static constexpr bool PERM = true, HAS_MID = false; static constexpr int MID0 = 0, MID1 = 0;
    __device__ __forceinline__ void mid(f32x4 (&)[2][2][4][2], const Unit&, int, int, int, int, int) const {}
    bf16_t* ys; const float* b2; const float* wbuf;
    __device__ __forceinline__ void operator()(const f32x4 (&acc)[2][2][4][2], const Unit& u, int wr, int wc, int fr, int fq) const {
        const int e = u.pn >> 2, tl = u.pn & 3;
        const int row0 = u.pm * BM + wr * 64 + fr, col0 = tl * 256 + wc * 32 + 8 * fq;
        const float* bp = b2 + (size_t)e * 1024 + col0;
        constexpr float sc = 1.0f / (F8_SA * F8_SW2);
        f32x4 bv[2][2];
#pragma unroll
        for (int bj = 0; bj < 2; ++bj) { bv[bj][0] = *(const f32x4*)(bp + bj * HALF); bv[bj][1] = *(const f32x4*)(bp + bj * HALF + 4); }
#pragma unroll
        for (int ai = 0; ai < 2; ++ai)
#pragma unroll
            for (int m = 0; m < 4; ++m) { const int row = row0 + ai * HALF + m * 16; const float ww = wbuf[row]; bf16_t* rowp = ys + (size_t)row * 1024 + col0;
#pragma unroll
                for (int bj = 0; bj < 2; ++bj) { const f32x4 v0 = (acc[ai][bj][m][0] * sc + bv[bj][0]) * ww, v1 = (acc[ai][bj][m][1] * sc + bv[bj][1]) * ww;
                    u32x4 w; w.x = cvt_pk_bf16(v0[0], v0[1]); w.y = cvt_pk_bf16(v0[2], v0[3]); w.z = cvt_pk_bf16(v1[0], v1[1]); w.w = cvt_pk_bf16(v1[2], v1[3]);
                    *(u32x4*)(rowp + bj * HALF) = w; } }
    }
};
struct MoeOrder {
    int nN, G, c, total; const LAS int* blk_e;
    __device__ __forceinline__ bool next(int i, Unit& u) const {
        const long L = (long)i * G + c; if (L >= total) return false;
        const int rb = (int)(L / nN), tl = (int)(L % nN); u.pm = rb; u.pn = blk_e[rb] * nN + tl; return true;
    }
    __device__ __forceinline__ void a_ready(const Unit&) const {}
    __device__ __forceinline__ void done(const Unit&) const {}
};
}
struct Args { const float* in[30]; float* out; unsigned char* ws; int ph_lo, ph_hi, li, pad; };
typedef const __attribute__((address_space(4))) Args* ArgsP;
enum { I_X = 0, I_WIN, I_LCW, I_LCB, I_LWA, I_LBA, I_LWX, I_LBX, I_LLAM, I_MIB, I_MFB, I_MNG, I_GCW, I_GAL, I_GDT, I_GNG, I_WBA, I_WBB, I_WBC, I_WOUT, I_LN1G, I_LN1B, I_RW, I_RB, I_W1, I_B1, I_W2, I_B2, I_LN2G, I_LN2B };

template <int MODE> __device__ __forceinline__ int col_map(int n) {
    if (MODE == 1) {
        if (n < 1024) return n;
        if (n < 2048) return 3840 + (n - 1024);
        if (n < 2304) return 1024 + (n - 2048);
        if (n < 2560) return 1280 + (n - 2304);
        if (n < 3072) return 1536 + (n - 2560);
        if (n < 3076) return 3584 + (n - 3072);
        if (n < 3080) return 3588 + (n - 3076);
        if (n < 3592) return 3840 + 1024 + (n - 3080);
        if (n < 4104) return 2048 + (n - 3592);
        if (n < 4616) return 2560 + (n - 4104);
        if (n < 5128) return 3072 + (n - 4616);
        if (n < 5136) return 3592 + (n - 5128);
        if (n < 5144) return 3600 + (n - 5136);
        if (n < 5656) return 3840 + 1536 + (n - 5144);
        return 3840 + 2048 + (n - 5656);
    } else if (MODE == 2) {
        if (n < 1024) return (n >> 7) * 256 + (n & 127);
        const int q = n - 1024; return (q >> 7) * 256 + 128 + (q & 127);
    }
    return n;
}
struct TrItem { const float* W; bf16_t* WT; int N, ldk, koff, mode, k0, n0; float f8s; };
__device__ __forceinline__ int col_map_rt(int mode, int n) { return mode == 1 ? col_map<1>(n) : (mode == 2 ? col_map<2>(n) : n); }
constexpr int IT_IN = 16 * 273, IT_BRA = 16 * 32, IT_BRB = 8 * 32, IT_BRC = 8 * 32, IT_OUT = 16 * 32, IT_W1 = 32 * 16 * 64, IT_W2 = 32 * 16 * 32;
constexpr int IT_G = 8 * 2 * 8;
constexpr int IT_LAYER = IT_IN + IT_BRA + IT_BRB + IT_BRC + IT_OUT + IT_W1 + IT_W2 + IT_G;
__device__ __forceinline__ TrItem tr_decode(ArgsP a, int it) {
    const int l = it / IT_LAYER; int r = it - l * IT_LAYER; unsigned char* wl = a->ws + WS_W + (size_t)l * WL_STRIDE; TrItem t;
    if (r < IT_IN) { t = TrItem{a->in[I_WIN] + (size_t)l * 1024 * DIN, (bf16_t*)(wl + WL_IN), DIN, 1024, 0, 1, 64 * (r / 273), 32 * (r % 273), 0.f}; return t; } r -= IT_IN;
    if (r < IT_BRA) { t = TrItem{a->in[I_WBA] + (size_t)l * 1024 * 1024, (bf16_t*)(wl + WL_BR), 1024, 2048, 0, 0, 64 * (r / 32), 32 * (r % 32), 0.f}; return t; } r -= IT_BRA;
    if (r < IT_BRB) { t = TrItem{a->in[I_WBB] + (size_t)l * 512 * 1024, (bf16_t*)(wl + WL_BR), 1024, 2048, 1024, 0, 64 * (r / 32), 32 * (r % 32), 0.f}; return t; } r -= IT_BRB;
    if (r < IT_BRC) { t = TrItem{a->in[I_WBC] + (size_t)l * 512 * 1024, (bf16_t*)(wl + WL_BR), 1024, 2048, 1536, 0, 64 * (r / 32), 32 * (r % 32), 0.f}; return t; } r -= IT_BRC;
    if (r < IT_OUT) { t = TrItem{a->in[I_WOUT] + (size_t)l * 1024 * 1024, (bf16_t*)(wl + WL_OUT), 1024, 1024, 0, 0, 64 * (r / 32), 32 * (r % 32), 0.f}; return t; } r -= IT_OUT;
    if (r < IT_W1) { const int e = r / 1024, q = r % 1024; t = TrItem{a->in[I_W1] + ((size_t)l * NE + e) * 1024 * 2048, (bf16_t*)(wl + WL_W1 + (size_t)e * 2048 * 1024), 2048, 1024, 0, 2, 64 * (q / 64), 32 * (q % 64), F8_SW1}; return t; } r -= IT_W1;
    if (r < IT_W2) { const int e = r / 512, q = r % 512; t = TrItem{a->in[I_W2] + ((size_t)l * NE + e) * 1024 * 1024, (bf16_t*)(wl + WL_W2 + (size_t)e * 1024 * 1024), 1024, 1024, 0, 0, 64 * (q / 32), 32 * (q % 32), F8_SW2}; return t; } r -= IT_W2;
    { const int h = r >> 4, gate = (r >> 3) & 1, q = r & 7;
      t = TrItem{a->in[gate ? I_LWX : I_LWA] + ((size_t)l * 8 + h) * 128 * 128, (bf16_t*)(wl + WL_G) + (size_t)(h * 256 + gate * 128) * 128, 128, 128, 0, 0, 64 * (q >> 2), 32 * (q & 3), 0.f}; return t; }
}
__device__ __forceinline__ void p0_convert(ArgsP a, LAS unsigned char* lds, int G) {
    int tid_ = threadIdx.x; asm volatile("" : "+v"(tid_)); const int tid = tid_, lane = tid & 63, wave = tid >> 6;
    LAS float* scr = (LAS float*)(lds + wave * 16384);
    const int gw = blockIdx.x * NWAVES + wave, NGW = G * NWAVES;
    float v[32];
#define TR_LOAD(t_) do { const int nsrc_ = (t_).n0 + (lane & 31); const float* p_ = (t_).W + (size_t)((t_).k0 + (lane >> 5)) * (t_).N + nsrc_; \
        _Pragma("unroll") for (int i = 0; i < 32; ++i) v[i] = (nsrc_ < (t_).N) ? p_[(size_t)(2 * i) * (t_).N] : 0.f; } while (0)
    TrItem cur = tr_decode(a, gw < 2 * IT_LAYER ? gw : 0);
    if (gw < 2 * IT_LAYER) TR_LOAD(cur);
    for (int it = gw; it < 2 * IT_LAYER; it += NGW) {
#pragma unroll
        for (int i = 0; i < 32; ++i) scr[(2 * i + (lane >> 5)) * 33 + (lane & 31)] = v[i];
        const TrItem me = cur;
        if (it + NGW < 2 * IT_LAYER) { cur = tr_decode(a, it + NGW); TR_LOAD(cur); }
        LDS_WAIT(); asm volatile("" ::: "memory");
        const int c = lane & 7;
#pragma unroll
        for (int j = 0; j < 4; ++j) { const int nl = (lane >> 3) + 8 * j, n = me.n0 + nl; const LAS float* s = scr + (8 * c) * 33 + nl;
            if (me.mode == 1) { const int vr_ = col_map<1>(n < me.N ? n : 0);
                if (n < me.N) { if (vr_ < NIN_BF) { u32x4 o; o.x = pk2(s[0 * 33], s[1 * 33]); o.y = pk2(s[2 * 33], s[3 * 33]); o.z = pk2(s[4 * 33], s[5 * 33]); o.w = pk2(s[6 * 33], s[7 * 33]);
                        *(u32x4*)(me.WT + (size_t)vr_ * 1024 + me.k0 + 8 * c) = o; }
                    else { const float f = F8_SWI; u32x2 o8; o8.x = pk_fp8x4(s[0 * 33] * f, s[1 * 33] * f, s[2 * 33] * f, s[3 * 33] * f); o8.y = pk_fp8x4(s[4 * 33] * f, s[5 * 33] * f, s[6 * 33] * f, s[7 * 33] * f);
                        *(u32x2*)((unsigned char*)me.WT + WL_IN8 + (size_t)(vr_ - NIN_BF) * 1024 + me.k0 + 8 * c) = o8; } } }
            else if (me.f8s != 0.f) { const float f = me.f8s; u32x2 o8; o8.x = pk_fp8x4(s[0 * 33] * f, s[1 * 33] * f, s[2 * 33] * f, s[3 * 33] * f); o8.y = pk_fp8x4(s[4 * 33] * f, s[5 * 33] * f, s[6 * 33] * f, s[7 * 33] * f);
                if (n < me.N) *(u32x2*)((unsigned char*)me.WT + (size_t)col_map_rt(me.mode, n) * me.ldk + me.koff + me.k0 + 8 * c) = o8; }
            else { u32x4 o; o.x = pk2(s[0 * 33], s[1 * 33]); o.y = pk2(s[2 * 33], s[3 * 33]); o.z = pk2(s[4 * 33], s[5 * 33]); o.w = pk2(s[6 * 33], s[7 * 33]);
                if (n < me.N) *(u32x4*)(me.WT + (size_t)col_map_rt(me.mode, n) * me.ldk + me.koff + me.k0 + 8 * c) = o; } }
        LDS_WAIT(); asm volatile("" ::: "memory");
    }
#undef TR_LOAD
    const size_t gt = (size_t)blockIdx.x * 512 + tid, GT = (size_t)G * 512;
    for (size_t i = gt; i < (size_t)2 * 232 * 128; i += GT) { const int l = (int)(i / (232 * 128)); const size_t q = i % (232 * 128);
        *(u32x4*)(a->ws + WS_W + (size_t)l * WL_STRIDE + WL_IN + ((size_t)3608 * 1024) * 2 + q * 16) = (u32x4){0u, 0u, 0u, 0u}; }
    for (size_t i = gt; i < (size_t)2 * 32 * 1024; i += GT) { const int l = (int)(i >> 15), k = (int)((i >> 5) & 1023), e = (int)(i & 31); const float w = a->in[I_RW][i];
        const unsigned hb = f2bf(w); const float lo = w - bf2f((unsigned short)hb); bf16_t* dst = (bf16_t*)(a->ws + WS_RWB) + (size_t)l * 2 * 32 * 1024;
        dst[(size_t)e * 1024 + k] = (bf16_t)hb; dst[(size_t)(32 + e) * 1024 + k] = (bf16_t)f2bf(lo); }
    const float* x = a->in[I_X]; bf16_t* xb = (bf16_t*)(a->ws + WS_XB);
    for (size_t i = gt; i < (size_t)T_ * D_ / 8; i += GT) { const f32x4 v0 = *(const f32x4*)(x + i * 8), v1 = *(const f32x4*)(x + i * 8 + 4);
        u32x4 w; w.x = pk2(v0[0], v0[1]); w.y = pk2(v0[2], v0[3]); w.z = pk2(v1[0], v1[1]); w.w = pk2(v1[2], v1[3]); *(u32x4*)(xb + i * 8) = w;
        u32x2 q8; q8.x = pk_fp8x4(v0[0] * F8_SX, v0[1] * F8_SX, v0[2] * F8_SX, v0[3] * F8_SX); q8.y = pk_fp8x4(v1[0] * F8_SX, v1[1] * F8_SX, v1[2] * F8_SX, v1[3] * F8_SX); *(u32x2*)(a->ws + WS_X2 + i * 8) = q8; }
}

constexpr int TB = 32;
__device__ __forceinline__ void lru_naive(ArgsP a, int l, int u, LAS unsigned char* lds, const bf16_t* proj, bf16_t* H) {
    int tid_ = threadIdx.x; asm volatile("" : "+v"(tid_)); const int tid = tid_, b = u >> 3, h = u & 7, c = tid >> 2, p = tid & 3, chg = h * 128 + c;
    const float* wa = a->in[I_LWA] + ((size_t)l * 8 + h) * 128 * 128; const float* wx = a->in[I_LWX] + ((size_t)l * 8 + h) * 128 * 128;
    float wra[32], wrx[32];
#pragma unroll
    for (int i = 0; i < 32; ++i) { wra[i] = wa[(p * 32 + i) * 128 + c]; wrx[i] = wx[(p * 32 + i) * 128 + c]; }
    const float ba = a->in[I_LBA][l * 1024 + chg], bx = a->in[I_LBX][l * 1024 + chg];
    const float sp = softplus_f(-a->in[I_LLAM][l * 1024 + chg]);
    const float* cw = a->in[I_LCW] + (size_t)l * 4 * 1024 + chg; const float cw0 = cw[0], cw1 = cw[1024], cw2 = cw[2048], cw3 = cw[3072], cb = a->in[I_LCB][l * 1024 + chg];
    LAS bf16_t* xs = (LAS bf16_t*)(lds);
    LAS bf16_t* ys = (LAS bf16_t*)(lds + 8192);
    LAS float* xa_s = (LAS float*)(lds + 16384);
    const int srow = tid >> 4, scol = (tid & 15) * 8;
    const size_t tok0 = (size_t)b * SEQ_;
    u32x4 px = *(const u32x4*)(proj + (tok0 + srow) * NPROJ + PC_LRUX + h * 128 + scol);
    u32x4 py = *(const u32x4*)(proj + (tok0 + srow) * NPROJ + PC_LRUY + h * 128 + scol);
    float hs = 0.f, x1 = 0.f, x2 = 0.f, x3 = 0.f;
    for (int blk = 0; blk < SEQ_ / TB; ++blk) {
        __syncthreads();
        *(LAS u32x4*)(xs + srow * 128 + scol) = px; *(LAS u32x4*)(ys + srow * 128 + scol) = py;
        __syncthreads();
        if (blk + 1 < SEQ_ / TB) { const size_t tk = tok0 + (size_t)(blk + 1) * TB + srow;
            px = *(const u32x4*)(proj + tk * NPROJ + PC_LRUX + h * 128 + scol); py = *(const u32x4*)(proj + tk * NPROJ + PC_LRUY + h * 128 + scol); }
        for (int s = 0; s < TB; ++s) {
            const float xraw = bf2f(xs[s * 128 + c]);
            const float xa = cw0 * x3 + cw1 * x2 + cw2 * x1 + cw3 * xraw + cb;
            x3 = x2; x2 = x1; x1 = xraw;
            LAS float* xb_ = xa_s + (s & 1) * 128;
            if (p == 0) xb_[c] = xa;
            __syncthreads();
            float sa = 0.f, sx = 0.f;
#pragma unroll
            for (int i4 = 0; i4 < 8; ++i4) { const f32x4 xv = *(const LAS f32x4*)(xb_ + p * 32 + i4 * 4);
#pragma unroll
                for (int q = 0; q < 4; ++q) { sa += xv[q] * wra[i4 * 4 + q]; sx += xv[q] * wrx[i4 * 4 + q]; } }
            sa += __shfl_xor(sa, 1); sa += __shfl_xor(sa, 2); sx += __shfl_xor(sx, 1); sx += __shfl_xor(sx, 2);
            const float r = 1.f / (1.f + __expf(-(sa + ba))), ig = 1.f / (1.f + __expf(-(sx + bx)));
            const float log_a = -8.0f * r * sp, av = __expf(log_a), mult = sqrtf(-expm1f(2.0f * log_a));
            hs = av * hs + mult * (ig * xa);
            if (p == 0) { const float y = bf2f(ys[s * 128 + c]);
                H[(tok0 + (size_t)blk * TB + s) * 2048 + chg] = (bf16_t)f2bf(hs * gelu_tanh_f(y)); }
        }
    }
}
__device__ __forceinline__ void mlstm_naive(ArgsP a, int l, int u, LAS unsigned char* lds, const bf16_t* proj, const float* gsm, bf16_t* H) {
    int tid_ = threadIdx.x; asm volatile("" : "+v"(tid_)); const int tid = tid_, lane = tid & 63, wave = tid >> 6, b = u >> 2, hd = u & 3, j = tid & 127;
    LAS float* qs = (LAS float*)(lds);
    LAS float* ks = (LAS float*)(lds + 8192);
    LAS float* vs = (LAS float*)(lds + 16384);
    LAS float* os = (LAS float*)(lds + 32768);
    LAS float* gi = (LAS float*)(lds + 49152);
    LAS float* gf = (LAS float*)(lds + 49152 + 128);
    LAS float* red = (LAS float*)(lds + 49152 + 256);
    const float ib = a->in[I_MIB][l * 4 + hd], fb = a->in[I_MFB][l * 4 + hd], gn = a->in[I_MNG][(size_t)l * 512 + hd * 128 + j];
    const size_t tok0 = (size_t)b * SEQ_;
    const int qa_row = (tid & 255) >> 3, qa_c8 = (tid & 7) * 8; const int qa_col = (tid < 256 ? PC_MLQ : PC_MLK) + hd * 64 + qa_c8;
    const int vb_row = tid >> 4, vb_c8 = (tid & 15) * 8;
    u32x4 pa, pb, pc; float pg = 0.f;
#define ML_ISSUE(blk_) do { const size_t t0 = tok0 + (size_t)(blk_) * TB; \
        pa = *(const u32x4*)(proj + (t0 + qa_row) * NPROJ + qa_col); \
        pb = *(const u32x4*)(proj + (t0 + vb_row) * NPROJ + PC_MLV + hd * 128 + vb_c8); \
        pc = *(const u32x4*)(proj + (t0 + vb_row) * NPROJ + PC_MLO + hd * 128 + vb_c8); \
        if (tid < 64) pg = gsm[(t0 + (tid & 31)) * 32 + (tid < 32 ? 0 : 4) + hd]; } while (0)
    ML_ISSUE(0);
    float C[64], n[64];
#pragma unroll
    for (int r = 0; r < 64; ++r) { C[r] = 0.f; n[r] = 0.f; }
    for (int blk = 0; blk < SEQ_ / TB; ++blk) {
        __syncthreads();
        { LAS float* d = (tid < 256 ? qs : ks) + qa_row * 64 + qa_c8;
          *(LAS f32x4*)(d) = (f32x4){bflo(pa.x), bfhi(pa.x), bflo(pa.y), bfhi(pa.y)}; *(LAS f32x4*)(d + 4) = (f32x4){bflo(pa.z), bfhi(pa.z), bflo(pa.w), bfhi(pa.w)};
          LAS float* dv = vs + vb_row * 128 + vb_c8;
          *(LAS f32x4*)(dv) = (f32x4){bflo(pb.x), bfhi(pb.x), bflo(pb.y), bfhi(pb.y)}; *(LAS f32x4*)(dv + 4) = (f32x4){bflo(pb.z), bfhi(pb.z), bflo(pb.w), bfhi(pb.w)};
          LAS float* dz = os + vb_row * 128 + vb_c8;
          *(LAS f32x4*)(dz) = (f32x4){bflo(pc.x), bfhi(pc.x), bflo(pc.y), bfhi(pc.y)}; *(LAS f32x4*)(dz + 4) = (f32x4){bflo(pc.z), bfhi(pc.z), bflo(pc.w), bfhi(pc.w)};
          if (tid < 32) gi[tid] = pg; else if (tid < 64) gf[tid - 32] = pg; }
        __syncthreads();
        if (blk + 1 < SEQ_ / TB) ML_ISSUE(blk + 1);
        for (int s = 0; s < TB; ++s) {
            float hj = 0.f;
            if (tid < 128) {
                const float f = 1.f / (1.f + __expf(-(gf[s] + fb))), ie = __expf(gi[s] + ib);
                const float vj = vs[s * 128 + j];
                float num = 0.f, den = 0.f;
#pragma unroll
                for (int r4 = 0; r4 < 16; ++r4) { const f32x4 kk = *(const LAS f32x4*)(ks + s * 64 + r4 * 4), qq = *(const LAS f32x4*)(qs + s * 64 + r4 * 4);
#pragma unroll
                    for (int q = 0; q < 4; ++q) { const int r = r4 * 4 + q; const float ik = ie * kk[q];
                        C[r] = f * C[r] + ik * vj; n[r] = f * n[r] + ik; num += qq[q] * C[r]; den += qq[q] * n[r]; } }
                num *= 0.125f; den *= 0.125f;
                hj = num / fmaxf(fabsf(den), 1.0f);
                const float ss = wave_sum(hj * hj);
                if (lane == 0) red[(s & 1) * 2 + wave] = ss;
            }
            __syncthreads();
            if (tid < 128) {
                const float tot = red[(s & 1) * 2] + red[(s & 1) * 2 + 1];
                const float o = hj * rsqrtf(tot * (1.0f / 128.0f) + RMS_EPS) * gn * sigmoid_f(os[s * 128 + j]);
                H[(tok0 + (size_t)blk * TB + s) * 2048 + 1024 + hd * 128 + j] = (bf16_t)f2bf(o);
            }
        }
    }
}
__device__ __forceinline__ void gdn_naive(ArgsP a, int l, int u, LAS unsigned char* lds, const bf16_t* proj, const float* gsm, bf16_t* H) {
    int tid_ = threadIdx.x; asm volatile("" : "+v"(tid_)); const int tid = tid_, lane = tid & 63, b = u >> 3, hd = u & 7;
    LAS float* rq = (LAS float*)(lds);
    LAS float* rk = (LAS float*)(lds + 9216);
    LAS float* rv = (LAS float*)(lds + 18432);
    LAS float* zs = (LAS float*)(lds + 27648);
    LAS float* ga = (LAS float*)(lds + 27648 + 8192);
    LAS float* gb = ga + TB;
    const float* cw = a->in[I_GCW] + (size_t)l * 4 * 1536;
    float cq[4], ck[4], cv[4];
#pragma unroll
    for (int i = 0; i < 4; ++i) { cq[i] = cw[i * 1536 + hd * 64 + lane]; ck[i] = cw[i * 1536 + 512 + hd * 64 + lane]; cv[i] = cw[i * 1536 + 1024 + hd * 64 + lane]; }
    const float nexpA = -__expf(a->in[I_GAL][l * 8 + hd]), dtb = a->in[I_GDT][l * 8 + hd], gn = a->in[I_GNG][l * 64 + lane];
    const size_t tok0 = (size_t)b * SEQ_;
    u32x4 pp[3]; float pg = 0.f;
#define GD_ISSUE(blk_) do { const int tl0 = (blk_) * TB; \
        _Pragma("unroll") for (int i = 0; i < 3; ++i) { const int pid = tid + 512 * i; pp[i] = (u32x4){0u, 0u, 0u, 0u}; \
            if (pid < 840) { const int arr = pid / 280, rem = pid % 280, row = rem >> 3, c8 = (rem & 7) * 8; const int tl = tl0 - 3 + row; \
                if (tl >= 0) pp[i] = *(const u32x4*)(proj + (tok0 + tl) * NPROJ + (arr == 0 ? PC_GDQ : (arr == 1 ? PC_GDK : PC_GDV)) + hd * 64 + c8); } \
            else if (pid < 1096) { const int zp = pid - 840, row = zp >> 3, c8 = (zp & 7) * 8; \
                pp[i] = *(const u32x4*)(proj + (tok0 + tl0 + row) * NPROJ + PC_GDZ + hd * 64 + c8); } } \
        if (tid < 64) pg = gsm[(tok0 + tl0 + (tid & 31)) * 32 + (tid < 32 ? 8 : 16) + hd]; } while (0)
    GD_ISSUE(0);
    float S[64];
#pragma unroll
    for (int i = 0; i < 64; ++i) S[i] = 0.f;
    for (int blk = 0; blk < SEQ_ / TB; ++blk) {
        __syncthreads();
#pragma unroll
        for (int i = 0; i < 3; ++i) { const int pid = tid + 512 * i; LAS float* d = nullptr;
            if (pid < 840) { const int arr = pid / 280, rem = pid % 280, row = rem >> 3, c8 = (rem & 7) * 8; d = (arr == 0 ? rq : (arr == 1 ? rk : rv)) + row * 64 + c8; }
            else if (pid < 1096) { const int zp = pid - 840, row = zp >> 3, c8 = (zp & 7) * 8; d = zs + row * 64 + c8; }
            if (pid < 1096) { const u32x4 w = pp[i];
                *(LAS f32x4*)(d) = (f32x4){bflo(w.x), bfhi(w.x), bflo(w.y), bfhi(w.y)}; *(LAS f32x4*)(d + 4) = (f32x4){bflo(w.z), bfhi(w.z), bflo(w.w), bfhi(w.w)}; } }
        if (tid < 32) ga[tid] = pg; else if (tid < 64) gb[tid - 32] = pg;
        __syncthreads();
        if (blk + 1 < SEQ_ / TB) GD_ISSUE(blk + 1);
        if (tid < 64) {
            for (int s = 0; s < TB; ++s) {
                float qv = 0.f, kv = 0.f, vv = 0.f;
#pragma unroll
                for (int i = 0; i < 4; ++i) { qv += cq[i] * rq[(s + i) * 64 + lane]; kv += ck[i] * rk[(s + i) * 64 + lane]; vv += cv[i] * rv[(s + i) * 64 + lane]; }
                qv = silu_f(qv); kv = silu_f(kv); vv = silu_f(vv);
                const float qn = qv * rsqrtf(wave_sum(qv * qv) + RMS_EPS) * 0.125f;
                const float kn = kv * rsqrtf(wave_sum(kv * kv) + RMS_EPS);
                const float g = nexpA * softplus_f(ga[s] + dtb), alpha = __expf(g), beta = 1.f / (1.f + __expf(-gb[s]));
                float kS = 0.f;
#pragma unroll
                for (int i = 0; i < 64; ++i) kS += __builtin_bit_cast(float, __builtin_amdgcn_readlane(__builtin_bit_cast(int, kn), i)) * S[i];
                const float dl = beta * (vv - alpha * kS);
                float o = 0.f;
#pragma unroll
                for (int i = 0; i < 64; ++i) { const float ki = __builtin_bit_cast(float, __builtin_amdgcn_readlane(__builtin_bit_cast(int, kn), i));
                    const float qi = __builtin_bit_cast(float, __builtin_amdgcn_readlane(__builtin_bit_cast(int, qn), i));
                    S[i] = alpha * S[i] + ki * dl; o += qi * S[i]; }
                const float ms = wave_sum(o * o) * (1.0f / 64.0f);
                const float out = o * rsqrtf(ms + RMS_EPS) * gn * silu_f(zs[s * 64 + lane]);
                H[(tok0 + (size_t)blk * TB + s) * 2048 + 1536 + hd * 64 + lane] = (bf16_t)f2bf(out);
            }
        }
    }
}

constexpr int RW_PITCH = 1032;
__device__ __forceinline__ unsigned f2key(float v, int e) { unsigned u = __builtin_bit_cast(unsigned, v); u = (u & 0x80000000u) ? ~u : (u | 0x80000000u); return (u & ~31u) | (unsigned)(31 - e); }
__device__ __forceinline__ float key2f(unsigned k) { const unsigned u = k & ~31u; return __builtin_bit_cast(float, (u & 0x80000000u) ? (u ^ 0x80000000u) : ~u); }
__device__ __forceinline__ void p5_ln1_router(ArgsP a, int l, LAS unsigned char* lds, int G) {
    int tid_ = threadIdx.x; asm volatile("" : "+v"(tid_)); const int tid = tid_, lane = tid & 63, wave = tid >> 6, tk = lane & 15, g = lane >> 4;
    LAS bf16_t* whi = (LAS bf16_t*)lds;
    LAS bf16_t* wlo = (LAS bf16_t*)(lds + 32 * RW_PITCH * 2);
    LAS int* hist = (LAS int*)(lds + 2 * 32 * RW_PITCH * 2);
    { const bf16_t* src = (const bf16_t*)(a->ws + WS_RWB) + (size_t)l * 2 * 32 * 1024;
      for (int p = tid; p < 2 * 32 * 128; p += 512) { const int arr = p >> 12, e = (p >> 7) & 31, c8 = (p & 127) * 8;
          *(LAS u32x4*)((arr ? wlo : whi) + e * RW_PITCH + c8) = *(const u32x4*)(src + ((size_t)arr * 32 + e) * 1024 + c8); } }
    const bf16_t* v = (const bf16_t*)(a->ws + WS_V); bf16_t* x1b = (bf16_t*)(a->ws + WS_X1B); unsigned char* x18 = a->ws + WS_X1;
    int* tke = (int*)(a->ws + WS_TKE); float* tkw = (float*)(a->ws + WS_TKW); int* ghist = (int*)(a->ws + WS_HIST);
    const float* lng = a->in[I_LN1G] + l * 1024; const float* lnb = a->in[I_LN1B] + l * 1024;
    const float rb0 = a->in[I_RB][l * 32 + tk], rb1 = a->in[I_RB][l * 32 + 16 + tk];
    for (int ch = blockIdx.x; ch < NCHUNK; ch += G) {
        __syncthreads();
        if (tid < 32) hist[tid] = 0;
        __syncthreads();
        const size_t t = (size_t)ch * CHTOK + wave * 16 + tk;
        const bf16_t* vr = v + t * 1024 + 8 * g;
        float s = 0.f, s2 = 0.f;
#pragma unroll 8
        for (int ks = 0; ks < 32; ++ks) { const u32x4 pw = *(const u32x4*)(vr + 32 * ks); const f32x4 p0 = (f32x4){bflo(pw.x), bfhi(pw.x), bflo(pw.y), bfhi(pw.y)}, p1 = (f32x4){bflo(pw.z), bfhi(pw.z), bflo(pw.w), bfhi(pw.w)};
            s += (p0[0] + p0[1]) + (p0[2] + p0[3]) + (p1[0] + p1[1]) + (p1[2] + p1[3]);
            s2 += (p0[0] * p0[0] + p0[1] * p0[1]) + (p0[2] * p0[2] + p0[3] * p0[3]) + (p1[0] * p1[0] + p1[1] * p1[1]) + (p1[2] * p1[2] + p1[3] * p1[3]); }
        s += __shfl_xor(s, 16); s += __shfl_xor(s, 32); s2 += __shfl_xor(s2, 16); s2 += __shfl_xor(s2, 32);
        const float mean = s * (1.0f / 1024.0f); const float rstd = rsqrtf(fmaxf(s2 * (1.0f / 1024.0f) - mean * mean, 0.f) + LN_EPS);
        f32x4 acc0 = (f32x4){0.f, 0.f, 0.f, 0.f}, acc1 = (f32x4){0.f, 0.f, 0.f, 0.f};
#pragma unroll 2
        for (int ks = 0; ks < 32; ++ks) { const int k0 = 32 * ks + 8 * g;
            const u32x4 pw = *(const u32x4*)(vr + 32 * ks); const f32x4 p0 = (f32x4){bflo(pw.x), bfhi(pw.x), bflo(pw.y), bfhi(pw.y)}, p1 = (f32x4){bflo(pw.z), bfhi(pw.z), bflo(pw.w), bfhi(pw.w)};
            const f32x4 g0 = *(const f32x4*)(lng + k0), g1 = *(const f32x4*)(lng + k0 + 4), b0 = *(const f32x4*)(lnb + k0), b1 = *(const f32x4*)(lnb + k0 + 4);
            const f32x4 y0 = (p0 - mean) * rstd * g0 + b0, y1 = (p1 - mean) * rstd * g1 + b1;
            u32x4 hw; hw.x = pg8::cvt_pk_bf16(y0[0], y0[1]); hw.y = pg8::cvt_pk_bf16(y0[2], y0[3]); hw.z = pg8::cvt_pk_bf16(y1[0], y1[1]); hw.w = pg8::cvt_pk_bf16(y1[2], y1[3]);
            *(u32x4*)(x1b + t * 1024 + k0) = hw;
            { u32x2 q8; q8.x = pk_fp8x4(y0[0] * F8_SX, y0[1] * F8_SX, y0[2] * F8_SX, y0[3] * F8_SX); q8.y = pk_fp8x4(y1[0] * F8_SX, y1[1] * F8_SX, y1[2] * F8_SX, y1[3] * F8_SX); *(u32x2*)(x18 + t * 1024 + k0) = q8; }
            u32x4 lw; lw.x = pg8::cvt_pk_bf16(y0[0] - bflo(hw.x), y0[1] - bfhi(hw.x)); lw.y = pg8::cvt_pk_bf16(y0[2] - bflo(hw.y), y0[3] - bfhi(hw.y));
            lw.z = pg8::cvt_pk_bf16(y1[0] - bflo(hw.z), y1[1] - bfhi(hw.z)); lw.w = pg8::cvt_pk_bf16(y1[2] - bflo(hw.w), y1[3] - bfhi(hw.w));
            const bf16x8 ah = __builtin_bit_cast(bf16x8, hw), al = __builtin_bit_cast(bf16x8, lw);
            const bf16x8 wh0 = *(const LAS bf16x8*)(whi + tk * RW_PITCH + k0), wh1 = *(const LAS bf16x8*)(whi + (16 + tk) * RW_PITCH + k0);
            const bf16x8 wl0 = *(const LAS bf16x8*)(wlo + tk * RW_PITCH + k0), wl1 = *(const LAS bf16x8*)(wlo + (16 + tk) * RW_PITCH + k0);
            acc0 = __builtin_amdgcn_mfma_f32_16x16x32_bf16(ah, wh0, acc0, 0, 0, 0); acc1 = __builtin_amdgcn_mfma_f32_16x16x32_bf16(ah, wh1, acc1, 0, 0, 0);
            acc0 = __builtin_amdgcn_mfma_f32_16x16x32_bf16(ah, wl0, acc0, 0, 0, 0); acc1 = __builtin_amdgcn_mfma_f32_16x16x32_bf16(ah, wl1, acc1, 0, 0, 0);
            acc0 = __builtin_amdgcn_mfma_f32_16x16x32_bf16(al, wh0, acc0, 0, 0, 0); acc1 = __builtin_amdgcn_mfma_f32_16x16x32_bf16(al, wh1, acc1, 0, 0, 0); }
#pragma unroll
        for (int r = 0; r < 4; ++r) {
            unsigned k0 = f2key(acc0[r] + rb0, tk), k1 = f2key(acc1[r] + rb1, 16 + tk);
            float tv[4]; int te[4];
#pragma unroll
            for (int k = 0; k < 4; ++k) { unsigned m = k0 > k1 ? k0 : k1;
#pragma unroll
                for (int o = 1; o < 16; o <<= 1) { const unsigned q = (unsigned)__shfl_xor((int)m, o); m = q > m ? q : m; }
                const int e = 31 - (int)(m & 31u); tv[k] = key2f(m); te[k] = e;
                if (e == tk) k0 = 0u; if (e == 16 + tk) k1 = 0u; }
            const float e1 = __expf(tv[1] - tv[0]), e2 = __expf(tv[2] - tv[0]), e3 = __expf(tv[3] - tv[0]); const float inv = 1.0f / (1.0f + e1 + e2 + e3);
            if (tk < 4) { const size_t tt = (size_t)ch * CHTOK + wave * 16 + 4 * g + r;
                const int ei = tk == 0 ? te[0] : (tk == 1 ? te[1] : (tk == 2 ? te[2] : te[3]));
                const float wi = (tk == 0 ? 1.0f : (tk == 1 ? e1 : (tk == 2 ? e2 : e3))) * inv;
                tke[tt * 4 + tk] = ei; tkw[tt * 4 + tk] = wi; __hip_atomic_fetch_add(&hist[ei], 1, __ATOMIC_RELAXED, __HIP_MEMORY_SCOPE_WORKGROUP); }
        }
        __syncthreads();
        if (tid < 32) ghist[ch * 32 + tid] = hist[tid];
    }
}

__device__ __forceinline__ void p6_slots(ArgsP a, LAS unsigned char* lds, int G) {
    int tid_ = threadIdx.x; asm volatile("" : "+v"(tid_)); const int tid = tid_, lane = tid & 63, wave = tid >> 6;
    LAS int* hs = (LAS int*)lds;
    LAS int* cnt = (LAS int*)(lds + 32768);
    LAS int* bst = (LAS int*)(lds + 32768 + 256);
    LAS int* te = (LAS int*)(lds + 36864);
    LAS int* sl = (LAS int*)(lds + 36864 + 2048);
    const int* ghist = (const int*)(a->ws + WS_HIST);
    for (int i = tid; i < NCHUNK * 32; i += 512) hs[i] = ghist[i];
    __syncthreads();
    if (tid < 32) { int run = 0; for (int ch = 0; ch < NCHUNK; ++ch) { const int c = hs[ch * 32 + tid]; hs[ch * 32 + tid] = run; run += c; } cnt[tid] = run; }
    __syncthreads();
    if (tid == 0) { int bs = 0; for (int e = 0; e < 32; ++e) { bst[e] = bs; bs += (cnt[e] + 255) >> 8; } bst[32] = bs; }
    __syncthreads();
    if (blockIdx.x == 0 && tid <= 32) ((int*)(a->ws + WS_META))[tid] = bst[tid];
    const int* tke = (const int*)(a->ws + WS_TKE); const float* tkw = (const float*)(a->ws + WS_TKW);
    int* slot = (int*)(a->ws + WS_SLOT); float* wbuf = (float*)(a->ws + WS_WBUF);
    int* tokb = (int*)(a->ws + WS_TOKB);
    for (int ch = blockIdx.x; ch < NCHUNK; ch += G) {
        __syncthreads();
        te[tid] = tke[(size_t)ch * 512 + tid];
        __syncthreads();
        if (tid < 32) { int rank = bst[tid] * 256 + hs[ch * 32 + tid]; for (int p = 0; p < 512; ++p) if (te[p] == tid) sl[p] = rank++; }
        __syncthreads();
        { const size_t pi = (size_t)ch * 512 + tid; const int s_ = sl[tid]; slot[pi] = s_; wbuf[s_] = tkw[pi]; tokb[s_] = ch * CHTOK + (tid >> 2); }
    }
    for (int e = blockIdx.x; e < 32; e += G) for (int s_ = bst[e] * 256 + cnt[e] + tid; s_ < bst[e + 1] * 256; s_ += 512) tokb[s_] = T_;
}
__device__ __forceinline__ int moe_table(ArgsP a, LAS unsigned char* lds) {
    int tid_ = threadIdx.x; asm volatile("" : "+v"(tid_)); const int tid = tid_;
    LAS int* bst = (LAS int*)(lds + MISC_OFF);
    LAS int* blk_e = (LAS int*)(lds + MISC_OFF + 256);
    __syncthreads();
    if (tid <= 32) bst[tid] = ((const int*)(a->ws + WS_META))[tid];
    __syncthreads();
    const int nb = bst[32];
    for (int rb = tid; rb < nb; rb += 512) { int e = 0; while (e < 31 && rb >= bst[e + 1]) ++e; blk_e[rb] = e; }
    __syncthreads();
    return nb;
}

__device__ __forceinline__ void p9_combine_ln2(ArgsP a, int l, float* xout, int G) {
    int tid_ = threadIdx.x; asm volatile("" : "+v"(tid_)); const int tid = tid_, lane = tid & 63, wave = tid >> 6;
    const bf16_t* x1b = (const bf16_t*)(a->ws + WS_X1B); const int* slot = (const int*)(a->ws + WS_SLOT);
    const bf16_t* ys = (const bf16_t*)(a->ws + WS_OV + OV_YS); bf16_t* xb = (bf16_t*)(a->ws + WS_XB);
    f32x4 gg[4], bb[4];
#pragma unroll
    for (int j = 0; j < 4; ++j) { gg[j] = *(const f32x4*)(a->in[I_LN2G] + l * 1024 + 4 * lane + 256 * j); bb[j] = *(const f32x4*)(a->in[I_LN2B] + l * 1024 + 4 * lane + 256 * j); }
    for (int blk = blockIdx.x * NWAVES + wave; blk < T_ / 16; blk += G * NWAVES) {
        const int sv = slot[(size_t)blk * 64 + lane];
        for (int k = 0; k < 16; k += 2) {
            u32x2 xw[2][4], yw[2][4][4];
#pragma unroll
            for (int q = 0; q < 2; ++q) { const size_t t = (size_t)blk * 16 + k + q;
#pragma unroll
                for (int j = 0; j < 4; ++j) xw[q][j] = *(const u32x2*)(x1b + t * 1024 + 4 * lane + 256 * j);
#pragma unroll
                for (int kk = 0; kk < 4; ++kk) { const size_t sr = (size_t)__builtin_amdgcn_readfirstlane(__shfl(sv, (k + q) * 4 + kk));
#pragma unroll
                    for (int j = 0; j < 4; ++j) yw[q][kk][j] = *(const u32x2*)(ys + sr * 1024 + 4 * lane + 256 * j); } }
#pragma unroll
            for (int q = 0; q < 2; ++q) { const size_t t = (size_t)blk * 16 + k + q;
                f32x4 xv[4]; float s = 0.f;
#pragma unroll
                for (int j = 0; j < 4; ++j) { xv[j] = (f32x4){bflo(xw[q][j].x), bfhi(xw[q][j].x), bflo(xw[q][j].y), bfhi(xw[q][j].y)} * DN_ALPHA;
#pragma unroll
                    for (int kk = 0; kk < 4; ++kk) { const u32x2 w = yw[q][kk][j]; xv[j][0] += bflo(w.x); xv[j][1] += bfhi(w.x); xv[j][2] += bflo(w.y); xv[j][3] += bfhi(w.y); }
                    s += (xv[j][0] + xv[j][1]) + (xv[j][2] + xv[j][3]); }
                const float mean = wave_sum(s) * (1.0f / 1024.0f); float s2 = 0.f;
#pragma unroll
                for (int j = 0; j < 4; ++j) { xv[j] = xv[j] - mean; s2 += (xv[j][0] * xv[j][0] + xv[j][1] * xv[j][1]) + (xv[j][2] * xv[j][2] + xv[j][3] * xv[j][3]); }
                const float rstd = rsqrtf(wave_sum(s2) * (1.0f / 1024.0f) + LN_EPS);
#pragma unroll
                for (int j = 0; j < 4; ++j) { xv[j] = xv[j] * rstd * gg[j] + bb[j];
                    if (xout) *(f32x4*)(xout + t * 1024 + 4 * lane + 256 * j) = xv[j];
                    u32x2 w; w.x = pk2(xv[j][0], xv[j][1]); w.y = pk2(xv[j][2], xv[j][3]); *(u32x2*)(xb + t * 1024 + 4 * lane + 256 * j) = w;
                    *(unsigned*)(a->ws + WS_X2 + t * 1024 + 4 * lane + 256 * j) = pk_fp8x4(xv[j][0] * F8_SX, xv[j][1] * F8_SX, xv[j][2] * F8_SX, xv[j][3] * F8_SX); } }
        }
    }
}
typedef float f32x4_t __attribute__((ext_vector_type(4)));
constexpr size_t MX_LRU_PH = 0, MX_LRU_CARRY = 4 * MiB;
template <int MODE> __device__ __forceinline__ void lru_fast(ArgsP a, int l, int b, int h, int c_lo, int c_hi, LAS unsigned char* lds, const bf16_t* proj, bf16_t* H, unsigned char* mxs) {
    int tid_ = threadIdx.x; asm volatile("" : "+v"(tid_)); const int tid = tid_, lane = tid & 63, wave = __builtin_amdgcn_readfirstlane(tid >> 6), fr = lane & 15, g = lane >> 4;
    LAS bf16_t* xa = (LAS bf16_t*)(lds);
    LAS bf16_t* ysb = (LAS bf16_t*)(lds + 17408);
    LAS bf16_t* outb = (LAS bf16_t*)(lds + 33792);
    LAS bf16_t* outc = (LAS bf16_t*)(lds + 50176);
    bf16_t* HL = (bf16_t*)(a->ws + WS_MB); bf16_t* CA = (bf16_t*)(a->ws + WS_X1B);
    float* PH = (float*)(mxs + MX_LRU_PH); const float* carry = (const float*)(mxs + MX_LRU_CARRY);
    const int ch = 16 * wave + fr, chg = h * 128 + ch;
    const bf16_t* wg = (const bf16_t*)(a->ws + WS_W + (size_t)l * WL_STRIDE + WL_G) + (size_t)h * 256 * 128;
    bf16x8 bra[4], brx[4];
#pragma unroll
    for (int ks = 0; ks < 4; ++ks) { bra[ks] = *(const bf16x8*)(wg + (size_t)(ch) * 128 + 32 * ks + 8 * g); brx[ks] = *(const bf16x8*)(wg + (size_t)(128 + ch) * 128 + 32 * ks + 8 * g); }
    const float ba = a->in[I_LBA][l * 1024 + chg], bx = a->in[I_LBX][l * 1024 + chg], sp = softplus_f(-a->in[I_LLAM][l * 1024 + chg]);
    const int cg = tid & 15, t0i = tid >> 4;
    float cwv[4][8], cbv[8];
    { const float* cw = a->in[I_LCW] + (size_t)l * 4 * 1024 + h * 128 + 8 * cg;
#pragma unroll
      for (int j = 0; j < 4; ++j) { const f32x4 w0 = *(const f32x4*)(cw + j * 1024), w1 = *(const f32x4*)(cw + j * 1024 + 4);
          cwv[j][0] = w0[0]; cwv[j][1] = w0[1]; cwv[j][2] = w0[2]; cwv[j][3] = w0[3]; cwv[j][4] = w1[0]; cwv[j][5] = w1[1]; cwv[j][6] = w1[2]; cwv[j][7] = w1[3]; }
      const float* cbp = a->in[I_LCB] + l * 1024 + h * 128 + 8 * cg; const f32x4 b0 = *(const f32x4*)(cbp), b1 = *(const f32x4*)(cbp + 4);
      cbv[0] = b0[0]; cbv[1] = b0[1]; cbv[2] = b0[2]; cbv[3] = b0[3]; cbv[4] = b1[0]; cbv[5] = b1[1]; cbv[6] = b1[2]; cbv[7] = b1[3]; }
    u32x4 pr[2][4], py[2];
#define LRU_ISSUE(c_) do { _Pragma("unroll") for (int i = 0; i < 2; ++i) { const int tl = (c_) * 64 + t0i + 32 * i; \
        _Pragma("unroll") for (int j = 0; j < 4; ++j) { const int tt_ = tl - 3 + j; pr[i][j] = (u32x4){0u, 0u, 0u, 0u}; \
            if (tt_ >= 0) pr[i][j] = *(const u32x4*)(proj + ((size_t)b * SEQ_ + tt_) * NPROJ + PC_LRUX + h * 128 + 8 * cg); } \
        if (MODE == 1) py[i] = *(const u32x4*)(proj + ((size_t)b * SEQ_ + tl) * NPROJ + PC_LRUY + h * 128 + 8 * cg); } } while (0)
    LRU_ISSUE(c_lo);
    for (int c = c_lo; c < c_hi; ++c) {
        const size_t tok0 = (size_t)b * SEQ_ + (size_t)c * 64;
        __syncthreads();
#pragma unroll
        for (int i = 0; i < 2; ++i) { float o[8];
#pragma unroll
            for (int q = 0; q < 8; ++q) o[q] = cbv[q];
#pragma unroll
            for (int j = 0; j < 4; ++j) { const unsigned x[4] = {pr[i][j].x, pr[i][j].y, pr[i][j].z, pr[i][j].w};
#pragma unroll
                for (int q = 0; q < 4; ++q) { o[2 * q] += cwv[j][2 * q] * bflo(x[q]); o[2 * q + 1] += cwv[j][2 * q + 1] * bfhi(x[q]); } }
            u32x4 w; w.x = pg8::cvt_pk_bf16(o[0], o[1]); w.y = pg8::cvt_pk_bf16(o[2], o[3]); w.z = pg8::cvt_pk_bf16(o[4], o[5]); w.w = pg8::cvt_pk_bf16(o[6], o[7]);
            *(LAS u32x4*)(xa + (t0i + 32 * i) * 136 + 8 * cg) = w;
            if (MODE == 1) *(LAS u32x4*)(ysb + (t0i + 32 * i) * 128 + 8 * cg) = py[i]; }
        if (c + 1 < c_hi) LRU_ISSUE(c + 1);
        __syncthreads();
        f32x4_t ar[4], ax[4];
#pragma unroll
        for (int tt = 0; tt < 4; ++tt) { ar[tt] = (f32x4_t){0.f, 0.f, 0.f, 0.f}; ax[tt] = (f32x4_t){0.f, 0.f, 0.f, 0.f}; }
#pragma unroll
        for (int tt = 0; tt < 4; ++tt)
#pragma unroll
            for (int ks = 0; ks < 4; ++ks) { const bf16x8 af = *(const LAS bf16x8*)(xa + (16 * tt + fr) * 136 + 32 * ks + 8 * g);
                ar[tt] = __builtin_amdgcn_mfma_f32_16x16x32_bf16(af, bra[ks], ar[tt], 0, 0, 0);
                ax[tt] = __builtin_amdgcn_mfma_f32_16x16x32_bf16(af, brx[ks], ax[tt], 0, 0, 0); }
        float av[4][4], uv[4][4], Ai[4], Bi[4];
#pragma unroll
        for (int tt = 0; tt < 4; ++tt) { float A = 1.f, B = 0.f;
#pragma unroll
            for (int r = 0; r < 4; ++r) { const int t = 16 * tt + 4 * g + r;
                const float rg = sigmoid_f(ar[tt][r] + ba), ig = sigmoid_f(ax[tt][r] + bx);
                const float log_a = -8.0f * rg * sp; av[tt][r] = __expf(log_a); uv[tt][r] = __builtin_amdgcn_sqrtf(neg_expm1_f(2.0f * log_a)) * (ig * bf2f(xa[t * 136 + ch]));
                B = av[tt][r] * B + uv[tt][r]; A *= av[tt][r]; }
            Ai[tt] = A; Bi[tt] = B; }
#pragma unroll
        for (int tt = 0; tt < 4; ++tt) { const float A1 = __shfl_up(Ai[tt], 16), B1 = __shfl_up(Bi[tt], 16); if (g >= 1) { Bi[tt] = Ai[tt] * B1 + Bi[tt]; Ai[tt] = Ai[tt] * A1; } }
#pragma unroll
        for (int tt = 0; tt < 4; ++tt) { const float A2 = __shfl_up(Ai[tt], 32), B2 = __shfl_up(Bi[tt], 32); if (g >= 2) { Bi[tt] = Ai[tt] * B2 + Bi[tt]; Ai[tt] = Ai[tt] * A2; } }
        float Ae[4], Be[4], At[4], Bt[4];
#pragma unroll
        for (int tt = 0; tt < 4; ++tt) { Ae[tt] = __shfl_up(Ai[tt], 16); Be[tt] = __shfl_up(Bi[tt], 16); if (g == 0) { Ae[tt] = 1.f; Be[tt] = 0.f; }
            At[tt] = __shfl(Ai[tt], fr + 48); Bt[tt] = __shfl(Bi[tt], fr + 48); }
        float hin = 0.f, ptot = 1.f;
        if (MODE == 1) hin = carry[((size_t)b * 64 + c) * 1024 + chg];
#pragma unroll
        for (int tt = 0; tt < 4; ++tt) {
            float hcur = Ae[tt] * hin + Be[tt], ccur = ptot * Ae[tt];
#pragma unroll
            for (int r = 0; r < 4; ++r) { const int t = 16 * tt + 4 * g + r; hcur = av[tt][r] * hcur + uv[tt][r]; ccur *= av[tt][r];
                if (MODE == 1) outb[t * 128 + ch] = (bf16_t)f2bf(hcur * gelu_tanh_f(bf2f(ysb[t * 128 + ch])));
                else { outb[t * 128 + ch] = (bf16_t)f2bf(hcur); outc[t * 128 + ch] = (bf16_t)f2bf(ccur); } }
            hin = At[tt] * hin + Bt[tt]; ptot *= At[tt]; }
        if (MODE == 0) { if (g == 0) { PH[(((size_t)b * 64 + c) * 2 + 0) * 1024 + chg] = ptot; PH[(((size_t)b * 64 + c) * 2 + 1) * 1024 + chg] = hin; } }
        __syncthreads();
#pragma unroll
        for (int i = 0; i < 2; ++i) { const int pid = tid + 512 * i; const int row = pid >> 4, c8 = (pid & 15) * 8;
            if (MODE == 1) *(u32x4*)(H + (tok0 + row) * 2048 + h * 128 + c8) = *(const LAS u32x4*)(outb + row * 128 + c8);
            else { *(u32x4*)(HL + (tok0 + row) * 1024 + h * 128 + c8) = *(const LAS u32x4*)(outb + row * 128 + c8); *(u32x4*)(CA + (tok0 + row) * 1024 + h * 128 + c8) = *(const LAS u32x4*)(outc + row * 128 + c8); } }
    }
#undef LRU_ISSUE
}
__device__ __forceinline__ void lru_carry(unsigned char* mxs, int G) {
    const float* PH = (const float*)(mxs + MX_LRU_PH); float* carry = (float*)(mxs + MX_LRU_CARRY);
    int tid_ = threadIdx.x; asm volatile("" : "+v"(tid_));
    for (int gid = blockIdx.x * 512 + tid_; gid < NBATCH * 1024; gid += G * 512) { const int b = gid >> 10, chg = gid & 1023; float hc = 0.f;
#pragma unroll 8
        for (int c = 0; c < 64; ++c) { const size_t o = ((size_t)b * 64 + c); carry[o * 1024 + chg] = hc; hc = PH[(o * 2) * 1024 + chg] * hc + PH[(o * 2 + 1) * 1024 + chg]; } }
}
__device__ __forceinline__ void lru_apply(ArgsP a, const bf16_t* proj, bf16_t* H, unsigned char* mxs, int first, int stride) {
    int tid_ = threadIdx.x; asm volatile("" : "+v"(tid_));
    const bf16_t* HL = (const bf16_t*)(a->ws + WS_MB); const bf16_t* CA = (const bf16_t*)(a->ws + WS_X1B); const float* carry = (const float*)(mxs + MX_LRU_CARRY);
    for (size_t p = (size_t)first * 512 + tid_; p < (size_t)T_ * 128; p += (size_t)stride * 512) { const size_t t = p >> 7; const int c8 = (int)(p & 127) * 8;
        const u32x4 hw = *(const u32x4*)(HL + t * 1024 + c8), cw = *(const u32x4*)(CA + t * 1024 + c8), yw = *(const u32x4*)(proj + t * NPROJ + PC_LRUY + c8);
        const float* cp = carry + (t >> 6) * 1024 + c8; const f32x4 c0 = *(const f32x4*)(cp), c1 = *(const f32x4*)(cp + 4);
        const unsigned hh[4] = {hw.x, hw.y, hw.z, hw.w}, cc[4] = {cw.x, cw.y, cw.z, cw.w}, yy[4] = {yw.x, yw.y, yw.z, yw.w}; const float cin[8] = {c0[0], c0[1], c0[2], c0[3], c1[0], c1[1], c1[2], c1[3]};
        unsigned o[4];
#pragma unroll
        for (int q = 0; q < 4; ++q) { const float h0 = bflo(hh[q]) + bflo(cc[q]) * cin[2 * q], h1 = bfhi(hh[q]) + bfhi(cc[q]) * cin[2 * q + 1];
            o[q] = pg8::cvt_pk_bf16(h0 * gelu_tanh_f(bflo(yy[q])), h1 * gelu_tanh_f(bfhi(yy[q]))); }
        *(u32x4*)(H + t * 2048 + c8) = (u32x4){o[0], o[1], o[2], o[3]}; }
}
typedef float f32x16 __attribute__((ext_vector_type(16)));
typedef short bf16x4 __attribute__((ext_vector_type(4)));
constexpr size_t MXB_ML_U = 0;
constexpr size_t MXB_ML_CP = 64 * MiB;
constexpr size_t MXS_ML_NU = 6 * MiB, MXS_ML_NP = 6 * MiB + 512 * 1024, MXS_ML_SC = 7 * MiB;

__device__ __forceinline__ float bperm_f(int src_lane, float v) { return __builtin_bit_cast(float, __builtin_amdgcn_ds_bpermute(src_lane << 2, __builtin_bit_cast(int, v))); }
__device__ __forceinline__ float wave_incl_sum(float v, int lane) {
#pragma unroll
    for (int o = 1; o < 64; o <<= 1) { const float t = bperm_f(lane >= o ? lane - o : lane, v); if (lane >= o) v += t; }
    return v;
}
__device__ __forceinline__ float wave_incl_max(float v, int lane) {
#pragma unroll
    for (int o = 1; o < 64; o <<= 1) { const float t = bperm_f(lane >= o ? lane - o : lane, v); if (lane >= o) v = fmaxf(v, t); }
    return v;
}
__device__ __forceinline__ bf16x8 pack8(float a0, float a1, float a2, float a3, float a4, float a5, float a6, float a7) {
    u32x4 w; w.x = pg8::cvt_pk_bf16(a0, a1); w.y = pg8::cvt_pk_bf16(a2, a3); w.z = pg8::cvt_pk_bf16(a4, a5); w.w = pg8::cvt_pk_bf16(a6, a7); return __builtin_bit_cast(bf16x8, w);
}
__device__ __forceinline__ bf16x8 ld_perm(const LAS bf16_t* p) {
    const u32x2 lo = *(const LAS u32x2*)(p), hi = *(const LAS u32x2*)(p + 8); u32x4 w; w.x = lo.x; w.y = lo.y; w.z = hi.x; w.w = hi.y; return __builtin_bit_cast(bf16x8, w);
}

__device__ __forceinline__ void mlstm_passA(ArgsP a, int l, LAS unsigned char* lds, const bf16_t* proj, const float* gsm, unsigned char* mxb, unsigned char* mxs, int G) {
    int tid_ = threadIdx.x; asm volatile("" : "+v"(tid_)); const int tid = tid_, lane = tid & 63, wave = __builtin_amdgcn_readfirstlane(tid >> 6), r = lane & 31, hh = lane >> 5;
    LAS bf16_t* kwT = (LAS bf16_t*)(lds);
    LAS bf16_t* vT = (LAS bf16_t*)(lds + 9216);
    LAS float* wts = (LAS float*)(lds + 27648);
    float* NU = (float*)(mxs + MXS_ML_NU); float* SC = (float*)(mxs + MXS_ML_SC);
    for (int uid = blockIdx.x; uid < 2048; uid += G) {
        const int c = uid & 63, hd = (uid >> 6) & 3, b = uid >> 8; const size_t tok0 = (size_t)b * SEQ_ + (size_t)c * 64;
        const float ib = a->in[I_MIB][l * 4 + hd], fb = a->in[I_MFB][l * 4 + hd];
        __syncthreads();
        if (wave == 0) {
            const float fpre = gsm[(tok0 + lane) * 32 + 4 + hd] + fb, ipre = gsm[(tok0 + lane) * 32 + hd] + ib;
            const float logf = -softplus_f(-fpre); const float bc = wave_incl_sum(logf, lane); const float bl = __builtin_bit_cast(float, __builtin_amdgcn_readlane(__builtin_bit_cast(int, bc), 63));
            const float ge = bl - bc + ipre; const float mloc = wave_max(ge);
            wts[lane] = __expf(ge - mloc);
            if (lane == 0) { SC[(size_t)uid * 4 + 0] = bl; SC[(size_t)uid * 4 + 1] = mloc; }
        }
        const u32x4 kp = *(const u32x4*)(proj + (tok0 + lane) * NPROJ + PC_MLK + hd * 64 + wave * 8);
        const u32x4 vp0 = *(const u32x4*)(proj + (tok0 + lane) * NPROJ + PC_MLV + hd * 128 + wave * 8);
        const u32x4 vp1 = *(const u32x4*)(proj + (tok0 + lane) * NPROJ + PC_MLV + hd * 128 + 64 + wave * 8);
        __syncthreads();
        { const float w = wts[lane]; const unsigned kw[4] = {kp.x, kp.y, kp.z, kp.w};
#pragma unroll
          for (int j = 0; j < 4; ++j) { kwT[(wave * 8 + 2 * j) * 72 + lane] = (bf16_t)f2bf(w * bflo(kw[j])); kwT[(wave * 8 + 2 * j + 1) * 72 + lane] = (bf16_t)f2bf(w * bfhi(kw[j])); }
          const unsigned v0[4] = {vp0.x, vp0.y, vp0.z, vp0.w}, v1[4] = {vp1.x, vp1.y, vp1.z, vp1.w};
#pragma unroll
          for (int j = 0; j < 4; ++j) { vT[(wave * 8 + 2 * j) * 72 + lane] = (bf16_t)(v0[j] & 0xffffu); vT[(wave * 8 + 2 * j + 1) * 72 + lane] = (bf16_t)(v0[j] >> 16);
              vT[(64 + wave * 8 + 2 * j) * 72 + lane] = (bf16_t)(v1[j] & 0xffffu); vT[(64 + wave * 8 + 2 * j + 1) * 72 + lane] = (bf16_t)(v1[j] >> 16); } }
        __syncthreads();
        const int dI = wave >> 2, eJ = wave & 3;
        f32x16 acc;
#pragma unroll
        for (int i = 0; i < 16; ++i) acc[i] = 0.f;
#pragma unroll
        for (int ks = 0; ks < 4; ++ks) { const bf16x8 af = *(const LAS bf16x8*)(kwT + (32 * dI + r) * 72 + 16 * ks + 8 * hh), bf = *(const LAS bf16x8*)(vT + (32 * eJ + r) * 72 + 16 * ks + 8 * hh);
            acc = __builtin_amdgcn_mfma_f32_32x32x16_bf16(af, bf, acc, 0, 0, 0); }
        float* ud = (float*)(mxb + MXB_ML_U) + ((size_t)uid * 8 + wave) * 1024;
#pragma unroll
        for (int q = 0; q < 4; ++q) *(f32x4*)(ud + (q * 64 + lane) * 4) = (f32x4){acc[4 * q], acc[4 * q + 1], acc[4 * q + 2], acc[4 * q + 3]};
        if (tid < 64) { float s = 0.f;
#pragma unroll 8
            for (int t = 0; t < 64; ++t) s += bf2f(kwT[tid * 72 + t]);
            NU[(size_t)uid * 64 + tid] = s; }
    }
}
__device__ __forceinline__ void mlstm_passB(unsigned char* mxb, unsigned char* mxs, int G) {
    int tid_ = threadIdx.x; asm volatile("" : "+v"(tid_)); const int tid = tid_;
    const float* NU = (const float*)(mxs + MXS_ML_NU); float* NP = (float*)(mxs + MXS_ML_NP); float* SC = (float*)(mxs + MXS_ML_SC);
    for (int wu = blockIdx.x; wu < 256; wu += G) {
        const int chain = wu >> 3, tile = wu & 7;
        if (tid < 128) {
            const int lane = tid & 63, s = tid >> 6;
            float st[8]; float m = 0.f;
#pragma unroll
            for (int i = 0; i < 8; ++i) st[i] = 0.f;
#pragma unroll 4
            for (int c = 0; c < 64; ++c) { const size_t uid = (size_t)chain * 64 + c;
                const float* ud = (const float*)(mxb + MXB_ML_U) + (uid * 8 + tile) * 1024;
                const f32x4 u0 = *(const f32x4*)(ud + ((2 * s) * 64 + lane) * 4), u1 = *(const f32x4*)(ud + ((2 * s + 1) * 64 + lane) * 4);
                const float bl = SC[uid * 4 + 0], mloc = SC[uid * 4 + 1];
                *(bf16x8*)((bf16_t*)(mxb + MXB_ML_CP) + (uid * 8 + tile) * 1024 + (s * 64 + lane) * 8) = pack8(st[0], st[1], st[2], st[3], st[4], st[5], st[6], st[7]);
                if (tile == 0 && tid == 0) SC[uid * 4 + 2] = m;
                const float mn = fmaxf(bl + m, mloc), dec = __expf(bl + m - mn), sc = __expf(mloc - mn); m = mn;
#pragma unroll
                for (int i = 0; i < 4; ++i) { st[i] = dec * st[i] + sc * u0[i]; st[4 + i] = dec * st[4 + i] + sc * u1[i]; } }
        } else if (tile == 0 && tid < 192) {
            const int d = tid - 128; float n = 0.f, m = 0.f;
#pragma unroll 4
            for (int c = 0; c < 64; ++c) { const size_t uid = (size_t)chain * 64 + c; const float bl = SC[uid * 4 + 0], mloc = SC[uid * 4 + 1]; const float nu = NU[uid * 64 + d];
                NP[uid * 64 + d] = n; const float mn = fmaxf(bl + m, mloc), dec = __expf(bl + m - mn), sc = __expf(mloc - mn); m = mn; n = dec * n + sc * nu; }
        }
    }
}
__device__ __forceinline__ void mlstm_passC(ArgsP a, int l, LAS unsigned char* lds, const bf16_t* proj, const float* gsm, bf16_t* H, unsigned char* mxb, unsigned char* mxs, int first, int stride) {
    int tid_ = threadIdx.x; asm volatile("" : "+v"(tid_)); const int tid = tid_, lane = tid & 63, wave = __builtin_amdgcn_readfirstlane(tid >> 6), r = lane & 31, hh = lane >> 5;
    LAS bf16_t* qb = (LAS bf16_t*)(lds);
    LAS bf16_t* kb = (LAS bf16_t*)(lds + 9216);
    LAS bf16_t* vT = (LAS bf16_t*)(lds + 18432);
    LAS bf16_t* ob = (LAS bf16_t*)(lds + 36864);
    LAS bf16_t* outb = (LAS bf16_t*)(lds + 54272);
    LAS float* tb_rt = (LAS float*)(lds + 70656);
    LAS float* tb_ct = tb_rt + 64;
    LAS float* tb_iw = tb_rt + 128;
    LAS float* tb_em = tb_rt + 192;
    LAS float* tb_np = tb_rt + 256;
    LAS float* ssq = tb_rt + 320;
    const float* NP = (const float*)(mxs + MXS_ML_NP); const float* SC = (const float*)(mxs + MXS_ML_SC);
    for (int uid = first; uid < 2048; uid += stride) {
        const int c = uid & 63, hd = (uid >> 6) & 3, b = uid >> 8; const size_t tok0 = (size_t)b * SEQ_ + (size_t)c * 64;
        __syncthreads();
        if (wave == 0) {
            const float ib = a->in[I_MIB][l * 4 + hd], fb = a->in[I_MFB][l * 4 + hd];
            const float fpre = gsm[(tok0 + lane) * 32 + 4 + hd] + fb, ipre = gsm[(tok0 + lane) * 32 + hd] + ib;
            const float logf = -softplus_f(-fpre); const float bc = wave_incl_sum(logf, lane);
            const float rt = ipre - bc; const float cmx = wave_incl_max(rt, lane); const float mprev = SC[(size_t)uid * 4 + 2];
            const float mt = bc + fmaxf(mprev, cmx);
            tb_rt[lane] = rt; tb_ct[lane] = bc - mt; tb_iw[lane] = __expf(bc + mprev - mt); tb_em[lane] = __expf(-mt); tb_np[lane] = NP[(size_t)uid * 64 + lane];
        }
        { const int row = tid >> 3, c8 = (tid & 7) * 8;
          *(LAS u32x4*)(qb + row * 72 + c8) = *(const u32x4*)(proj + (tok0 + row) * NPROJ + PC_MLQ + hd * 64 + c8);
          *(LAS u32x4*)(kb + row * 72 + c8) = *(const u32x4*)(proj + (tok0 + row) * NPROJ + PC_MLK + hd * 64 + c8);
#pragma unroll
          for (int i = 0; i < 2; ++i) { const int pid = tid + 512 * i; const int orow = pid >> 4, oc8 = (pid & 15) * 8;
              *(LAS u32x4*)(ob + orow * 136 + oc8) = *(const u32x4*)(proj + (tok0 + orow) * NPROJ + PC_MLO + hd * 128 + oc8); }
          const u32x4 vp0 = *(const u32x4*)(proj + (tok0 + lane) * NPROJ + PC_MLV + hd * 128 + wave * 8);
          const u32x4 vp1 = *(const u32x4*)(proj + (tok0 + lane) * NPROJ + PC_MLV + hd * 128 + 64 + wave * 8);
          const unsigned v0[4] = {vp0.x, vp0.y, vp0.z, vp0.w}, v1[4] = {vp1.x, vp1.y, vp1.z, vp1.w};
#pragma unroll
          for (int j = 0; j < 4; ++j) { vT[(wave * 8 + 2 * j) * 72 + lane] = (bf16_t)(v0[j] & 0xffffu); vT[(wave * 8 + 2 * j + 1) * 72 + lane] = (bf16_t)(v0[j] >> 16);
              vT[(64 + wave * 8 + 2 * j) * 72 + lane] = (bf16_t)(v1[j] & 0xffffu); vT[(64 + wave * 8 + 2 * j + 1) * 72 + lane] = (bf16_t)(v1[j] >> 16); } }
        __syncthreads();
        const int eI = wave >> 1, tJ = wave & 1; const int t = 32 * tJ + r;
        f32x16 as[2];
#pragma unroll
        for (int sI = 0; sI < 2; ++sI) {
#pragma unroll
            for (int i = 0; i < 16; ++i) as[sI][i] = 0.f;
#pragma unroll
            for (int ks = 0; ks < 4; ++ks) { const bf16x8 af = *(const LAS bf16x8*)(kb + (32 * sI + r) * 72 + 16 * ks + 8 * hh), bf = *(const LAS bf16x8*)(qb + t * 72 + 16 * ks + 8 * hh);
                as[sI] = __builtin_amdgcn_mfma_f32_32x32x16_bf16(af, bf, as[sI], 0, 0, 0); } }
        const float ctt = tb_ct[t], iwt = tb_iw[t] * 0.125f, emt = tb_em[t];
        float dsum = 0.f;
#pragma unroll
        for (int sI = 0; sI < 2; ++sI)
#pragma unroll
            for (int q = 0; q < 4; ++q) { const int s0 = 32 * sI + 8 * q + 4 * hh; const f32x4 rt4 = *(const LAS f32x4*)(tb_rt + s0);
#pragma unroll
                for (int i = 0; i < 4; ++i) { const float wv = (s0 + i <= t) ? as[sI][4 * q + i] * 0.125f * __expf(ctt + rt4[i]) : 0.f; as[sI][4 * q + i] = wv; dsum += wv; } }
        float qn = 0.f;
#pragma unroll
        for (int j = 0; j < 4; ++j) { const u32x4 qw = *(const LAS u32x4*)(qb + t * 72 + 32 * hh + 8 * j); const f32x4 n0 = *(const LAS f32x4*)(tb_np + 32 * hh + 8 * j), n1 = *(const LAS f32x4*)(tb_np + 32 * hh + 8 * j + 4);
            qn += bflo(qw.x) * n0[0] + bfhi(qw.x) * n0[1] + bflo(qw.y) * n0[2] + bfhi(qw.y) * n0[3] + bflo(qw.z) * n1[0] + bfhi(qw.z) * n1[1] + bflo(qw.w) * n1[2] + bfhi(qw.w) * n1[3]; }
        float den = dsum + iwt * qn; den += __shfl_xor(den, 32);
        f32x16 an;
#pragma unroll
        for (int i = 0; i < 16; ++i) an[i] = 0.f;
#pragma unroll
        for (int sI = 0; sI < 2; ++sI)
#pragma unroll
            for (int s2 = 0; s2 < 2; ++s2) { const bf16x8 af = ld_perm(vT + (32 * eI + r) * 72 + 32 * sI + 16 * s2 + 4 * hh);
                const bf16x8 bf = pack8(as[sI][8 * s2], as[sI][8 * s2 + 1], as[sI][8 * s2 + 2], as[sI][8 * s2 + 3], as[sI][8 * s2 + 4], as[sI][8 * s2 + 5], as[sI][8 * s2 + 6], as[sI][8 * s2 + 7]);
                an = __builtin_amdgcn_mfma_f32_32x32x16_bf16(af, bf, an, 0, 0, 0); }
        const bf16_t* cpd = (const bf16_t*)(mxb + MXB_ML_CP) + (size_t)uid * 8 * 1024;
#pragma unroll
        for (int dI = 0; dI < 2; ++dI)
#pragma unroll
            for (int s2 = 0; s2 < 2; ++s2) { const bf16x8 af = *(const bf16x8*)(cpd + (size_t)(dI * 4 + eI) * 1024 + (s2 * 64 + lane) * 8);
                const u32x4 qw = __builtin_bit_cast(u32x4, ld_perm(qb + t * 72 + 32 * dI + 16 * s2 + 4 * hh));
                const bf16x8 bf = pack8(bflo(qw.x) * iwt, bfhi(qw.x) * iwt, bflo(qw.y) * iwt, bfhi(qw.y) * iwt, bflo(qw.z) * iwt, bfhi(qw.z) * iwt, bflo(qw.w) * iwt, bfhi(qw.w) * iwt);
                an = __builtin_amdgcn_mfma_f32_32x32x16_bf16(af, bf, an, 0, 0, 0); }
        const float dinv = 1.0f / fmaxf(fabsf(den), emt);
        float sq = 0.f;
#pragma unroll
        for (int i = 0; i < 16; ++i) { an[i] *= dinv; sq += an[i] * an[i]; }
        sq += __shfl_xor(sq, 32);
        if (hh == 0) ssq[eI * 64 + t] = sq;
        __syncthreads();
        const float tot = ssq[t] + ssq[64 + t] + ssq[128 + t] + ssq[192 + t];
        const float rinv = rsqrtf(tot * (1.0f / 128.0f) + RMS_EPS);
        const float* gn = a->in[I_MNG] + (size_t)l * 512 + hd * 128;
#pragma unroll
        for (int q = 0; q < 4; ++q) { const int e0 = 32 * eI + 8 * q + 4 * hh; const f32x4 g4 = *(const f32x4*)(gn + e0); const u32x2 ow = *(const LAS u32x2*)(ob + t * 136 + e0);
            const float o0 = an[4 * q] * rinv * g4[0] * sigmoid_f(bflo(ow.x)), o1 = an[4 * q + 1] * rinv * g4[1] * sigmoid_f(bfhi(ow.x));
            const float o2 = an[4 * q + 2] * rinv * g4[2] * sigmoid_f(bflo(ow.y)), o3 = an[4 * q + 3] * rinv * g4[3] * sigmoid_f(bfhi(ow.y));
            u32x2 pw; pw.x = pg8::cvt_pk_bf16(o0, o1); pw.y = pg8::cvt_pk_bf16(o2, o3); *(LAS u32x2*)(outb + t * 128 + e0) = pw; }
        __syncthreads();
#pragma unroll
        for (int i = 0; i < 2; ++i) { const int pid = tid + 512 * i; const int row = pid >> 4, c8 = (pid & 15) * 8;
            *(u32x4*)(H + (tok0 + row) * 2048 + 1024 + hd * 128 + c8) = *(const LAS u32x4*)(outb + row * 128 + c8); }
    }
}
constexpr size_t MXB_GD_ND = 96 * MiB, MXB_GD_OD = 160 * MiB, MXB_GD_T = 224 * MiB;
constexpr size_t MXT_GD_XD = 8 * MiB, MXT_GD_QD = 40 * MiB, MXT_GD_SD = 72 * MiB;
constexpr size_t MXS_GD_GL = 7 * MiB + 64 * 1024;

__device__ __forceinline__ void conv_silu8(const u32x4 (&rw)[4], const float* cw, float (&o)[8]) {
#pragma unroll
    for (int j = 0; j < 8; ++j) o[j] = 0.f;
#pragma unroll
    for (int i = 0; i < 4; ++i) { const f32x4 w0 = *(const f32x4*)(cw + i * 1536), w1 = *(const f32x4*)(cw + i * 1536 + 4); const unsigned x[4] = {rw[i].x, rw[i].y, rw[i].z, rw[i].w};
        o[0] += w0[0] * bflo(x[0]); o[1] += w0[1] * bfhi(x[0]); o[2] += w0[2] * bflo(x[1]); o[3] += w0[3] * bfhi(x[1]);
        o[4] += w1[0] * bflo(x[2]); o[5] += w1[1] * bfhi(x[2]); o[6] += w1[2] * bflo(x[3]); o[7] += w1[3] * bfhi(x[3]); }
#pragma unroll
    for (int j = 0; j < 8; ++j) o[j] = silu_f(o[j]);
}
__device__ __forceinline__ void load_rows4(const bf16_t* proj, int b, int tl, int col, u32x4 (&rw)[4]) {
#pragma unroll
    for (int i = 0; i < 4; ++i) { const int tt = tl - 3 + i; rw[i] = (u32x4){0u, 0u, 0u, 0u}; if (tt >= 0) rw[i] = *(const u32x4*)(proj + ((size_t)b * SEQ_ + tt) * NPROJ + col); }
}

__device__ __forceinline__ void gdn_passA1(ArgsP a, int l, LAS unsigned char* lds, const bf16_t* proj, const float* gsm, unsigned char* mxb, int G) {
    int tid_ = threadIdx.x; asm volatile("" : "+v"(tid_)); const int tid = tid_, lane = tid & 63, wave = __builtin_amdgcn_readfirstlane(tid >> 6), r = lane & 31, hh = lane >> 5;
    LAS unsigned char* wl = lds + wave * 16384;
    LAS bf16_t* kb = (LAS bf16_t*)wl;
    LAS float* am = (LAS float*)wl;
    LAS float* tb = (LAS float*)(lds + MISC_OFF + 1024 + wave * 512);
    const float* cwk = a->in[I_GCW] + (size_t)l * 4 * 1536 + 512;
    for (int uid = blockIdx.x * NWAVES + wave; uid < 4096; uid += G * NWAVES) {
        const int c = uid & 63, hd = (uid >> 6) & 7, b = uid >> 9; const int tl = c * 64 + lane; const size_t tok = (size_t)b * SEQ_ + tl;
        float ss = 0.f;
#pragma unroll 2
        for (int p = 0; p < 8; ++p) { u32x4 rw[4]; load_rows4(proj, b, tl, PC_GDK + hd * 64 + 8 * p, rw); float o[8]; conv_silu8(rw, cwk + hd * 64 + 8 * p, o);
#pragma unroll
            for (int j = 0; j < 8; ++j) ss += o[j] * o[j];
            *(LAS bf16x8*)(kb + lane * 72 + 8 * p) = pack8(o[0], o[1], o[2], o[3], o[4], o[5], o[6], o[7]); }
        const float rn = rsqrtf(ss + RMS_EPS);
        const float gg = -__expf(a->in[I_GAL][l * 8 + hd]) * softplus_f(gsm[tok * 32 + 8 + hd] + a->in[I_GDT][l * 8 + hd]);
        const float gc = wave_incl_sum(gg, lane), beta = 1.f / (1.f + __expf(-gsm[tok * 32 + 16 + hd]));
        tb[lane] = gc; tb[64 + lane] = beta * rn;
        LDS_WAIT(); asm volatile("" ::: "memory");
        bf16x8 kf[2][4];
#pragma unroll
        for (int I = 0; I < 2; ++I)
#pragma unroll
            for (int ks = 0; ks < 4; ++ks) kf[I][ks] = *(const LAS bf16x8*)(kb + (32 * I + r) * 72 + 16 * ks + 8 * hh);
        LDS_WAIT(); asm volatile("" ::: "memory");
#pragma unroll
        for (int I = 0; I < 2; ++I)
#pragma unroll
            for (int J = 0; J < 2; ++J) { f32x16 acc;
#pragma unroll
                for (int i = 0; i < 16; ++i) acc[i] = 0.f;
#pragma unroll
                for (int ks = 0; ks < 4; ++ks) acc = __builtin_amdgcn_mfma_f32_32x32x16_bf16(kf[I][ks], kf[J][ks], acc, 0, 0, 0);
                const int s = 32 * J + r; const float gcs = __shfl(gc, s), rns = __shfl(rn, s);
#pragma unroll
                for (int q = 0; q < 4; ++q) { const int t0 = 32 * I + 8 * q + 4 * hh; const f32x4 gct = *(const LAS f32x4*)(tb + t0), brt = *(const LAS f32x4*)(tb + 64 + t0);
#pragma unroll
                    for (int i = 0; i < 4; ++i) { const float v = (s < t0 + i) ? acc[4 * q + i] * brt[i] * rns * __expf(gct[i] - gcs) : 0.f; am[(t0 + i) * 64 + s] = v; } } }
        LDS_WAIT(); asm volatile("" ::: "memory");
        float Tc[64];
#pragma unroll
        for (int i = 0; i < 64; ++i) { float acc = (i == lane) ? 1.f : 0.f;
#pragma unroll
            for (int j4 = 0; j4 < (i + 3) / 4; ++j4) { const f32x4 av = *(const LAS f32x4*)(am + i * 64 + 4 * j4);
#pragma unroll
                for (int jj = 0; jj < 4; ++jj) if (4 * j4 + jj < i) acc -= av[jj] * Tc[4 * j4 + jj]; }
            Tc[i] = acc; }
        bf16_t* Tg = (bf16_t*)(mxb + MXB_GD_T) + (size_t)uid * 4096;
#pragma unroll
        for (int i = 0; i < 64; ++i) Tg[i * 64 + lane] = (bf16_t)f2bf(Tc[i]);
    }
}

__device__ __forceinline__ void gdn_passA2(ArgsP a, int l, LAS unsigned char* lds, const bf16_t* proj, const float* gsm, unsigned char* mxb, unsigned char* mxt, unsigned char* mxs, int G) {
    int tid_ = threadIdx.x; asm volatile("" : "+v"(tid_)); const int tid = tid_, lane = tid & 63, wave = __builtin_amdgcn_readfirstlane(tid >> 6), r = lane & 31, hh = lane >> 5;
    LAS bf16_t* qb = (LAS bf16_t*)(lds);
    LAS bf16_t* kb = (LAS bf16_t*)(lds + 9216);
    LAS bf16_t* bvT = (LAS bf16_t*)(lds + 18432);
    LAS bf16_t* bkT = (LAS bf16_t*)(lds + 27648);
    LAS bf16_t* Tm = (LAS bf16_t*)(lds + 36864);
    LAS bf16_t* wT = (LAS bf16_t*)(lds + 46080);
    LAS bf16_t* uT = (LAS bf16_t*)(lds + 55296);
    LAS bf16_t* kdT = (LAS bf16_t*)(lds + 64512);
    LAS float* tb_gc = (LAS float*)(lds + 73728);
    LAS float* tb_beta = tb_gc + 64;
    LAS float* ssq = tb_gc + 128;
    const float* cw = a->in[I_GCW] + (size_t)l * 4 * 1536;
    float* GL = (float*)(mxs + MXS_GD_GL);
    u32x4 rq[4], rk[4], rv[4], tp; float pga = 0.f, pgb = 0.f;
#define GA2_ISSUE(u_) do { const int c_ = (u_) & 63, hd_ = ((u_) >> 6) & 7, b_ = (u_) >> 9; const int tl_ = c_ * 64 + lane; const size_t tok_ = (size_t)b_ * SEQ_ + tl_; \
        load_rows4(proj, b_, tl_, PC_GDQ + hd_ * 64 + 8 * wave, rq); load_rows4(proj, b_, tl_, PC_GDK + hd_ * 64 + 8 * wave, rk); load_rows4(proj, b_, tl_, PC_GDV + hd_ * 64 + 8 * wave, rv); \
        pga = gsm[tok_ * 32 + 8 + hd_]; pgb = gsm[tok_ * 32 + 16 + hd_]; \
        tp = *(const u32x4*)((const bf16_t*)(mxb + MXB_GD_T) + (size_t)(u_) * 4096 + (tid >> 3) * 64 + (tid & 7) * 8); } while (0)
    if ((int)blockIdx.x < 4096) GA2_ISSUE((int)blockIdx.x);
    for (int uid = blockIdx.x; uid < 4096; uid += G) {
        const int hd = (uid >> 6) & 7;
        __syncthreads();
        { const float gg = -__expf(a->in[I_GAL][l * 8 + hd]) * softplus_f(pga + a->in[I_GDT][l * 8 + hd]);
          const float gc = wave_incl_sum(gg, lane);
          if (wave == 0) { tb_gc[lane] = gc; tb_beta[lane] = 1.f / (1.f + __expf(-pgb)); if (lane == 63) GL[uid] = __expf(gc); } }
        float qo[8], ko[8], vo[8];
        conv_silu8(rq, cw + hd * 64 + 8 * wave, qo); conv_silu8(rk, cw + 512 + hd * 64 + 8 * wave, ko); conv_silu8(rv, cw + 1024 + hd * 64 + 8 * wave, vo);
        { float sq = 0.f, sk = 0.f;
#pragma unroll
          for (int j = 0; j < 8; ++j) { sq += qo[j] * qo[j]; sk += ko[j] * ko[j]; }
          ssq[wave * 64 + lane] = sq; ssq[512 + wave * 64 + lane] = sk; }
        *(LAS u32x4*)(Tm + (tid >> 3) * 72 + (tid & 7) * 8) = tp;
        if (uid + G < 4096) GA2_ISSUE(uid + G);
        __syncthreads();
        { float sq = 0.f, sk = 0.f;
#pragma unroll
          for (int w = 0; w < 8; ++w) { sq += ssq[w * 64 + lane]; sk += ssq[512 + w * 64 + lane]; }
          const float rq = rsqrtf(sq + RMS_EPS) * 0.125f, rk = rsqrtf(sk + RMS_EPS);
          const float gc = tb_gc[lane], beta = tb_beta[lane], gl_ = tb_gc[63];
          const float e1 = beta * __expf(gc), e2 = __expf(gl_ - gc);
#pragma unroll
          for (int j = 0; j < 8; ++j) { qo[j] *= rq; ko[j] *= rk; }
          *(LAS bf16x8*)(qb + lane * 72 + 8 * wave) = pack8(qo[0], qo[1], qo[2], qo[3], qo[4], qo[5], qo[6], qo[7]);
          *(LAS bf16x8*)(kb + lane * 72 + 8 * wave) = pack8(ko[0], ko[1], ko[2], ko[3], ko[4], ko[5], ko[6], ko[7]);
#pragma unroll
          for (int j = 0; j < 8; ++j) { const int d = 8 * wave + j;
              bvT[d * 72 + lane] = (bf16_t)f2bf(beta * vo[j]); bkT[d * 72 + lane] = (bf16_t)f2bf(e1 * ko[j]); kdT[d * 72 + lane] = (bf16_t)f2bf(e2 * ko[j]); } }
        __syncthreads();
        { const int mat = wave >> 2, I = (wave >> 1) & 1, J = wave & 1; const LAS bf16_t* Am = mat ? bkT : bvT; LAS bf16_t* Om = mat ? wT : uT;
          f32x16 acc;
#pragma unroll
          for (int i = 0; i < 16; ++i) acc[i] = 0.f;
#pragma unroll
          for (int ks = 0; ks < 4; ++ks) { const bf16x8 af = *(const LAS bf16x8*)(Am + (32 * I + r) * 72 + 16 * ks + 8 * hh), bf = *(const LAS bf16x8*)(Tm + (32 * J + r) * 72 + 16 * ks + 8 * hh);
              acc = __builtin_amdgcn_mfma_f32_32x32x16_bf16(af, bf, acc, 0, 0, 0); }
#pragma unroll
          for (int q = 0; q < 4; ++q)
#pragma unroll
              for (int i = 0; i < 4; ++i) Om[(32 * I + 8 * q + 4 * hh + i) * 72 + 32 * J + r] = (bf16_t)f2bf(acc[4 * q + i]); }
        __syncthreads();
        if (wave < 4) {
            const int I = (wave >> 1) & 1, J = wave & 1;
            f32x16 ax, an;
#pragma unroll
            for (int i = 0; i < 16; ++i) { ax[i] = 0.f; an[i] = 0.f; }
#pragma unroll
            for (int ks = 0; ks < 4; ++ks) { const bf16x8 wf = *(const LAS bf16x8*)(wT + (32 * I + r) * 72 + 16 * ks + 8 * hh), kdf_b = *(const LAS bf16x8*)(kdT + (32 * J + r) * 72 + 16 * ks + 8 * hh);
                ax = __builtin_amdgcn_mfma_f32_32x32x16_bf16(wf, kdf_b, ax, 0, 0, 0);
                const bf16x8 kdf_a = *(const LAS bf16x8*)(kdT + (32 * I + r) * 72 + 16 * ks + 8 * hh), uf = *(const LAS bf16x8*)(uT + (32 * J + r) * 72 + 16 * ks + 8 * hh);
                an = __builtin_amdgcn_mfma_f32_32x32x16_bf16(kdf_a, uf, an, 0, 0, 0); }
            bf16_t* xd = (bf16_t*)(mxt + MXT_GD_XD) + (size_t)uid * 4096 + (size_t)(I * 2 + J) * 1024;
#pragma unroll
            for (int s2 = 0; s2 < 2; ++s2) *(bf16x8*)(xd + (s2 * 64 + lane) * 8) = pack8(-ax[8 * s2], -ax[8 * s2 + 1], -ax[8 * s2 + 2], -ax[8 * s2 + 3], -ax[8 * s2 + 4], -ax[8 * s2 + 5], -ax[8 * s2 + 6], -ax[8 * s2 + 7]);
            float* nd = (float*)(mxb + MXB_GD_ND) + (size_t)uid * 4096 + (size_t)(I * 2 + J) * 1024;
#pragma unroll
            for (int q = 0; q < 4; ++q) *(f32x4*)(nd + (q * 64 + lane) * 4) = (f32x4){an[4 * q], an[4 * q + 1], an[4 * q + 2], an[4 * q + 3]};
        } else {
            const int I = (wave >> 1) & 1, tJ = wave & 1; const int t = 32 * tJ + r; const float gct = tb_gc[t];
            bf16x8 pf[2][2];
#pragma unroll
            for (int sI = 0; sI < 2; ++sI) { f32x16 ap;
#pragma unroll
                for (int i = 0; i < 16; ++i) ap[i] = 0.f;
#pragma unroll
                for (int ks = 0; ks < 4; ++ks) { const bf16x8 af = *(const LAS bf16x8*)(kb + (32 * sI + r) * 72 + 16 * ks + 8 * hh), bf = *(const LAS bf16x8*)(qb + t * 72 + 16 * ks + 8 * hh);
                    ap = __builtin_amdgcn_mfma_f32_32x32x16_bf16(af, bf, ap, 0, 0, 0); }
#pragma unroll
                for (int q = 0; q < 4; ++q) { const int s0 = 32 * sI + 8 * q + 4 * hh; const f32x4 gcs = *(const LAS f32x4*)(tb_gc + s0);
#pragma unroll
                    for (int i = 0; i < 4; ++i) ap[4 * q + i] = (s0 + i <= t) ? ap[4 * q + i] * __expf(gct - gcs[i]) : 0.f; }
#pragma unroll
                for (int s2 = 0; s2 < 2; ++s2) pf[sI][s2] = pack8(ap[8 * s2], ap[8 * s2 + 1], ap[8 * s2 + 2], ap[8 * s2 + 3], ap[8 * s2 + 4], ap[8 * s2 + 5], ap[8 * s2 + 6], ap[8 * s2 + 7]); }
            f32x16 aq, ao;
#pragma unroll
            for (int i = 0; i < 16; ++i) { aq[i] = 0.f; ao[i] = 0.f; }
#pragma unroll
            for (int sI = 0; sI < 2; ++sI)
#pragma unroll
                for (int s2 = 0; s2 < 2; ++s2) { const bf16x8 wf = ld_perm(wT + (32 * I + r) * 72 + 32 * sI + 16 * s2 + 4 * hh), uf = ld_perm(uT + (32 * I + r) * 72 + 32 * sI + 16 * s2 + 4 * hh);
                    aq = __builtin_amdgcn_mfma_f32_32x32x16_bf16(wf, pf[sI][s2], aq, 0, 0, 0); ao = __builtin_amdgcn_mfma_f32_32x32x16_bf16(uf, pf[sI][s2], ao, 0, 0, 0); }
            const float egt = __expf(gct);
#pragma unroll
            for (int q = 0; q < 4; ++q) { const int d0 = 32 * I + 8 * q + 4 * hh; const u32x2 qw = *(const LAS u32x2*)(qb + t * 72 + d0);
                aq[4 * q] = bflo(qw.x) * egt - aq[4 * q]; aq[4 * q + 1] = bfhi(qw.x) * egt - aq[4 * q + 1]; aq[4 * q + 2] = bflo(qw.y) * egt - aq[4 * q + 2]; aq[4 * q + 3] = bfhi(qw.y) * egt - aq[4 * q + 3]; }
            bf16_t* qd = (bf16_t*)(mxt + MXT_GD_QD) + (size_t)uid * 4096 + (size_t)(I * 2 + tJ) * 1024;
#pragma unroll
            for (int s2 = 0; s2 < 2; ++s2) *(bf16x8*)(qd + (s2 * 64 + lane) * 8) = pack8(aq[8 * s2], aq[8 * s2 + 1], aq[8 * s2 + 2], aq[8 * s2 + 3], aq[8 * s2 + 4], aq[8 * s2 + 5], aq[8 * s2 + 6], aq[8 * s2 + 7]);
            float* od = (float*)(mxb + MXB_GD_OD) + (size_t)uid * 4096 + (size_t)(I * 2 + tJ) * 1024;
#pragma unroll
            for (int q = 0; q < 4; ++q) *(f32x4*)(od + (q * 64 + lane) * 4) = (f32x4){ao[4 * q], ao[4 * q + 1], ao[4 * q + 2], ao[4 * q + 3]};
        }
    }
}

__device__ __forceinline__ void gdn_passB(unsigned char* mxb, unsigned char* mxt, unsigned char* mxs, int nB) {
    int tid_ = threadIdx.x; asm volatile("" : "+v"(tid_)); const int tid = tid_, lane = tid & 63, wave = __builtin_amdgcn_readfirstlane(tid >> 6);
    const float* GL = (const float*)(mxs + MXS_GD_GL);
    if (wave >= 2) return;
    const int eJ = wave;
    for (int chain = blockIdx.x; chain < 64; chain += nB) {
        f32x16 S[2];
#pragma unroll
        for (int i = 0; i < 16; ++i) { S[0][i] = 0.f; S[1][i] = 0.f; }
        bf16x8 xn[2][2][2]; f32x4 nq[2][4]; float gln;
#define GDB_LOAD(c_) do { const size_t u_ = (size_t)chain * 64 + (c_); const bf16_t* xd_ = (const bf16_t*)(mxt + MXT_GD_XD) + u_ * 4096; const float* nd_ = (const float*)(mxb + MXB_GD_ND) + u_ * 4096; \
        _Pragma("unroll") for (int I = 0; I < 2; ++I) _Pragma("unroll") for (int J = 0; J < 2; ++J) _Pragma("unroll") for (int s2 = 0; s2 < 2; ++s2) xn[I][J][s2] = *(const bf16x8*)(xd_ + (size_t)(I * 2 + J) * 1024 + (s2 * 64 + lane) * 8); \
        _Pragma("unroll") for (int J = 0; J < 2; ++J) _Pragma("unroll") for (int q = 0; q < 4; ++q) nq[J][q] = *(const f32x4*)(nd_ + (size_t)(J * 2 + eJ) * 1024 + (q * 64 + lane) * 4); \
        gln = GL[u_]; } while (0)
        GDB_LOAD(0);
        for (int c = 0; c < 64; ++c) { const size_t uid = (size_t)chain * 64 + c;
            bf16x8 xf[2][2][2]; f32x16 nn[2]; const float gl = gln;
#pragma unroll
            for (int I = 0; I < 2; ++I)
#pragma unroll
                for (int J = 0; J < 2; ++J)
#pragma unroll
                    for (int s2 = 0; s2 < 2; ++s2) xf[I][J][s2] = xn[I][J][s2];
#pragma unroll
            for (int J = 0; J < 2; ++J)
#pragma unroll
                for (int q = 0; q < 4; ++q) { nn[J][4 * q] = nq[J][q][0]; nn[J][4 * q + 1] = nq[J][q][1]; nn[J][4 * q + 2] = nq[J][q][2]; nn[J][4 * q + 3] = nq[J][q][3]; }
            if (c + 1 < 64) GDB_LOAD(c + 1);
            bf16x8 sh[2][2], sl[2][2];
            bf16_t* sd = (bf16_t*)(mxt + MXT_GD_SD) + uid * 4096;
#pragma unroll
            for (int I = 0; I < 2; ++I)
#pragma unroll
                for (int s2 = 0; s2 < 2; ++s2) { float hi[8], lo[8];
#pragma unroll
                    for (int j = 0; j < 8; ++j) { const float v = S[I][8 * s2 + j]; hi[j] = bf2f((unsigned short)f2bf(v)); lo[j] = v - hi[j]; }
                    sh[I][s2] = pack8(hi[0], hi[1], hi[2], hi[3], hi[4], hi[5], hi[6], hi[7]); sl[I][s2] = pack8(lo[0], lo[1], lo[2], lo[3], lo[4], lo[5], lo[6], lo[7]);
                    *(bf16x8*)(sd + (size_t)(I * 2 + eJ) * 1024 + (s2 * 64 + lane) * 8) = sh[I][s2]; }
#pragma unroll
            for (int J = 0; J < 2; ++J) { f32x16 acc = nn[J];
#pragma unroll
                for (int I = 0; I < 2; ++I)
#pragma unroll
                    for (int s2 = 0; s2 < 2; ++s2) { acc = __builtin_amdgcn_mfma_f32_32x32x16_bf16(xf[I][J][s2], sh[I][s2], acc, 0, 0, 0); acc = __builtin_amdgcn_mfma_f32_32x32x16_bf16(xf[I][J][s2], sl[I][s2], acc, 0, 0, 0); }
                nn[J] = acc; }
#pragma unroll
            for (int J = 0; J < 2; ++J)
#pragma unroll
                for (int i = 0; i < 16; ++i) S[J][i] = gl * S[J][i] + nn[J][i];
        }
    }
}

__device__ __forceinline__ void gdn_passC(ArgsP a, int l, LAS unsigned char* lds, const bf16_t* proj, bf16_t* H, unsigned char* mxb, unsigned char* mxt, int G) {
    int tid_ = threadIdx.x; asm volatile("" : "+v"(tid_)); const int tid = tid_, lane = tid & 63, wave = __builtin_amdgcn_readfirstlane(tid >> 6), r = lane & 31, hh = lane >> 5;
    LAS bf16_t* ob = (LAS bf16_t*)(lds + wave * 8192);
    const float* gn = a->in[I_GNG] + l * 64;
    for (int wu = blockIdx.x * NWAVES + wave; wu < 8192; wu += G * NWAVES) {
        const int uid = wu >> 1, tJ = wu & 1; const int c = uid & 63, hd = (uid >> 6) & 7, b = uid >> 9; const size_t tok0 = (size_t)b * SEQ_ + (size_t)c * 64;
        const bf16_t* sd = (const bf16_t*)(mxt + MXT_GD_SD) + (size_t)uid * 4096; const bf16_t* qd = (const bf16_t*)(mxt + MXT_GD_QD) + (size_t)uid * 4096; const float* od = (const float*)(mxb + MXB_GD_OD) + (size_t)uid * 4096;
        f32x16 ao[2];
#pragma unroll
        for (int eI = 0; eI < 2; ++eI)
#pragma unroll
            for (int q = 0; q < 4; ++q) { const f32x4 v = *(const f32x4*)(od + (size_t)(eI * 2 + tJ) * 1024 + (q * 64 + lane) * 4); ao[eI][4 * q] = v[0]; ao[eI][4 * q + 1] = v[1]; ao[eI][4 * q + 2] = v[2]; ao[eI][4 * q + 3] = v[3]; }
#pragma unroll
        for (int dI = 0; dI < 2; ++dI)
#pragma unroll
            for (int s2 = 0; s2 < 2; ++s2) { const bf16x8 qf = *(const bf16x8*)(qd + (size_t)(dI * 2 + tJ) * 1024 + (s2 * 64 + lane) * 8);
#pragma unroll
                for (int eI = 0; eI < 2; ++eI) { const bf16x8 sf = *(const bf16x8*)(sd + (size_t)(dI * 2 + eI) * 1024 + (s2 * 64 + lane) * 8);
                    ao[eI] = __builtin_amdgcn_mfma_f32_32x32x16_bf16(sf, qf, ao[eI], 0, 0, 0); } }
        float sq = 0.f;
#pragma unroll
        for (int eI = 0; eI < 2; ++eI)
#pragma unroll
            for (int i = 0; i < 16; ++i) sq += ao[eI][i] * ao[eI][i];
        sq += __shfl_xor(sq, 32);
        const float rinv = rsqrtf(sq * (1.0f / 64.0f) + RMS_EPS);
        const size_t tok = tok0 + 32 * tJ + r;
#pragma unroll
        for (int eI = 0; eI < 2; ++eI)
#pragma unroll
            for (int q = 0; q < 4; ++q) { const int e0 = 32 * eI + 8 * q + 4 * hh; const f32x4 g4 = *(const f32x4*)(gn + e0); const u32x2 zw = *(const u32x2*)(proj + tok * NPROJ + PC_GDZ + hd * 64 + e0);
                u32x2 pw; pw.x = pg8::cvt_pk_bf16(ao[eI][4 * q] * rinv * g4[0] * silu_f(bflo(zw.x)), ao[eI][4 * q + 1] * rinv * g4[1] * silu_f(bfhi(zw.x)));
                pw.y = pg8::cvt_pk_bf16(ao[eI][4 * q + 2] * rinv * g4[2] * silu_f(bflo(zw.y)), ao[eI][4 * q + 3] * rinv * g4[3] * silu_f(bfhi(zw.y)));
                *(LAS u32x2*)(ob + r * 64 + e0) = pw; }
        LDS_WAIT(); asm volatile("" ::: "memory");
#pragma unroll
        for (int it = 0; it < 4; ++it) { const int row = it * 8 + (lane >> 3), c8 = (lane & 7) * 8;
            *(u32x4*)(H + (tok0 + 32 * tJ + row) * 2048 + 1536 + hd * 64 + c8) = *(const LAS u32x4*)(ob + row * 64 + c8); }
        LDS_WAIT(); asm volatile("" ::: "memory");
    }
}
constexpr int PPL = 12;
constexpr int NPH = 1 + PPL * DEPTH_;
#ifndef MK_N_LAUNCHES
#define MK_N_LAUNCHES 1
#endif
#ifndef PROBE_PH
#define PROBE_PH -2
#endif
#define REPS(k) ((PROBE_PH) == (k) ? 2 : 1)
#ifndef PG8_SP2
#define PG8_SP2 true
#endif
#ifndef PG8_ALIGN
#define PG8_ALIGN true
#endif
__global__ void __launch_bounds__(NWAVES * 64, 2) fwd(Args a_unused) {
    ArgsP kargs = (ArgsP)__builtin_amdgcn_kernarg_segment_ptr();
#define FRESH(a) ArgsP a = kargs; asm volatile("" : "+s"(a))
    extern __shared__ __attribute__((aligned(16))) unsigned char lds_raw[];
    LAS unsigned char* lds = (LAS unsigned char*)lds_raw;
    const int tid = threadIdx.x, G = gridDim.x;
    const int vcu = (G % 8 == 0) ? ((int)blockIdx.x % 8) * (G / 8) + (int)blockIdx.x / 8 : (int)blockIdx.x;
    for (int u = tid; u < (LDS_BYTES - MISC_OFF) / 4; u += NWAVES * 64) ((LAS unsigned*)(lds + MISC_OFF))[u] = 0u;
    __syncthreads();
    const int lo = kargs->ph_lo, hi = kargs->ph_hi;
    unsigned* barw = (unsigned*)(kargs->ws + WS_CTL) + CW_BAR + kargs->li * XCD_BAR_WORDS;
    if (hi - lo > 1) (void)xcd_barrier_post(barw, (volatile LAS unsigned*)(lds + LDS_BYTES - 16));
#define IN(k) (lo <= (k) && (k) < hi)
#define SEAM(k) do { if (IN(k) && IN((k) + 1)) { FRESH(ab_); XcdBarrier bb_; bb_.bar = (unsigned*)(ab_->ws + WS_CTL) + CW_BAR + ab_->li * XCD_BAR_WORDS; bb_.x = xb_xcc_id(); bb_.st = (volatile LAS unsigned*)(lds + LDS_BYTES - 16); xcd_barrier(bb_); } } while (0)
    if (IN(0)) for (int rep = 0; rep < REPS(-1); ++rep) { FRESH(a); p0_convert(a, lds, G); }
    SEAM(0);

    for (int l = 0; l < DEPTH_; ++l) {
        const int pb = 1 + PPL * l;
#define WSP(T_, off) ((T_*)(a->ws + (off)))
#define WL_(off) (a->ws + WS_W + (size_t)l * WL_STRIDE + (off))
        if (IN(pb + 0)) for (int rep = 0; rep < REPS(0); ++rep) { FRESH(a);
            { pg8::Gemm g{WSP(const bf16_t, WS_XB), (const bf16_t*)WL_(WL_IN), 1024, 1024, 1024}; pg8::StaticOrder S; S.init(T_, NIN_BF, G, (int)blockIdx.x);
              pg8::EpiProj E{WSP(bf16_t, WS_OV + OV_PROJ), WSP(float, WS_GSM)};
              pg8::gemm_phase<pg8::EpiProj, pg8::StaticOrder, PG8_ALIGN, PG8_SP2>(lds, g, S, E); }
            { pg8::Gemm8 g{WSP(const unsigned char, WS_X2), (const unsigned char*)WL_(WL_IN + WL_IN8), 1024, 1024, 1024}; pg8::P1F8Order S{G, (int)blockIdx.x};
              pg8::EpiProj8 E{WSP(bf16_t, WS_OV + OV_PROJ), WSP(bf16_t, WS_OV + OV_GD)};
              pg8::gemm_phase_f8<pg8::EpiProj8, pg8::P1F8Order, false>(lds, g, S, E); }
        }
        SEAM(pb + 0);

        if (IN(pb + 1)) for (int rep = 0; rep < REPS(1); ++rep) { FRESH(a);
            const bf16_t* proj = WSP(const bf16_t, WS_OV + OV_PROJ); bf16_t* Hb = WSP(bf16_t, WS_OV + OV_H); const float* gsm = WSP(const float, WS_GSM);
            for (int r2 = 0; r2 < REPS(11); ++r2) for (int u = (int)blockIdx.x; u < 256; u += G) lru_fast<0>(a, l, u >> 5, (u >> 2) & 7, (u & 3) * 16, (u & 3) * 16 + 16, lds, proj, Hb, a->ws + WS_MXS);
            for (int r2 = 0; r2 < REPS(12); ++r2) mlstm_passA(a, l, lds, proj, gsm, a->ws + WS_V, a->ws + WS_MXS, G);
            __syncthreads();
            for (int r2 = 0; r2 < REPS(13); ++r2) gdn_passA1(a, l, lds, proj, gsm, a->ws + WS_V, G);
        }
        SEAM(pb + 1);
        if (IN(pb + 2)) for (int rep = 0; rep < REPS(2); ++rep) { FRESH(a);
            const bf16_t* proj = WSP(const bf16_t, WS_OV + OV_PROJ); const float* gsm = WSP(const float, WS_GSM);
            for (int r2 = 0; r2 < REPS(21); ++r2) lru_carry(a->ws + WS_MXS, G); for (int r2 = 0; r2 < REPS(22); ++r2) mlstm_passB(a->ws + WS_V, a->ws + WS_MXS, G); for (int r2 = 0; r2 < REPS(23); ++r2) gdn_passA2(a, l, lds, proj, gsm, a->ws + WS_V, a->ws + WS_MXS, a->ws + WS_MXS, G); }
        SEAM(pb + 2);
        if (IN(pb + 3)) for (int rep = 0; rep < REPS(3); ++rep) { FRESH(a);
            const bf16_t* proj = WSP(const bf16_t, WS_OV + OV_PROJ); bf16_t* Hb = WSP(bf16_t, WS_OV + OV_H); const float* gsm = WSP(const float, WS_GSM);
            const int nB = G >= 128 ? 64 : 0;
            if ((int)blockIdx.x < nB) { for (int r2 = 0; r2 < REPS(31); ++r2) gdn_passB(a->ws + WS_V, a->ws + WS_MXS, a->ws + WS_MXS, nB); }
            else {
                if (nB == 0) { gdn_passB(a->ws + WS_V, a->ws + WS_MXS, a->ws + WS_MXS, G); __syncthreads(); }
                for (int r2 = 0; r2 < REPS(32); ++r2) lru_apply(a, proj, Hb, a->ws + WS_MXS, (int)blockIdx.x - nB, G - nB);
                for (int r2 = 0; r2 < REPS(33); ++r2) mlstm_passC(a, l, lds, proj, gsm, Hb, a->ws + WS_V, a->ws + WS_MXS, (int)blockIdx.x - nB, G - nB);
            }
        }
        SEAM(pb + 3);
        if (IN(pb + 4)) for (int rep = 0; rep < REPS(4); ++rep) { FRESH(a); gdn_passC(a, l, lds, WSP(const bf16_t, WS_OV + OV_PROJ), WSP(bf16_t, WS_OV + OV_H), a->ws + WS_V, a->ws + WS_MXS, G); }
        SEAM(pb + 4);

        if (IN(pb + 5)) for (int rep = 0; rep < REPS(5); ++rep) { FRESH(a);
            pg8::StaticOrder S; S.init(T_, 1024, G, (int)blockIdx.x);
            pg8::Gemm g{WSP(const bf16_t, WS_OV + OV_H), (const bf16_t*)WL_(WL_BR), 2048, 2048, 2048}; pg8::EpiMergeF E{WSP(const bf16_t, WS_OV + OV_GD), WSP(bf16_t, WS_MB)};
            pg8::gemm_phase<pg8::EpiMergeF, pg8::StaticOrder, PG8_ALIGN, PG8_SP2>(lds, g, S, E);
        }
        SEAM(pb + 5);

        if (IN(pb + 6)) for (int rep = 0; rep < REPS(6); ++rep) { FRESH(a);
            pg8::Gemm g{WSP(const bf16_t, WS_MB), (const bf16_t*)WL_(WL_OUT), 1024, 1024, 1024}; pg8::StaticOrder S; S.init(T_, 1024, G, (int)blockIdx.x);
            pg8::EpiWout E{l == 0 ? a->in[I_X] : (const float*)nullptr, WSP(const bf16_t, WS_XB), WSP(bf16_t, WS_V)};
            pg8::gemm_phase<pg8::EpiWout, pg8::StaticOrder, PG8_ALIGN, PG8_SP2>(lds, g, S, E);
        }
        SEAM(pb + 6);

        if (IN(pb + 7)) for (int rep = 0; rep < REPS(7); ++rep) { FRESH(a); p5_ln1_router(a, l, lds, G); }
        SEAM(pb + 7);

        if (IN(pb + 8)) for (int rep = 0; rep < REPS(8); ++rep) { FRESH(a); p6_slots(a, lds, G); }
        SEAM(pb + 8);

        if (IN(pb + 9)) for (int rep = 0; rep < REPS(9); ++rep) { FRESH(a);
            const int nb = moe_table(a, lds);
            pg8::MoeOrder S{8, G, vcu, nb * 8, (const LAS int*)(lds + MISC_OFF + 256)};
            { LAS int* gt = (LAS int*)(lds + GTAB_OFF); const int* tokb = WSP(const int, WS_TOKB);
              int tq_ = threadIdx.x; asm volatile("" : "+v"(tq_));
              for (int ui = 0; (long)ui * G + vcu < (long)nb * 8; ++ui) { const int pm = (int)(((long)ui * G + vcu) / 8); if (tq_ < 256) gt[ui * 256 + tq_] = tokb[(size_t)pm * 256 + tq_]; }
              __syncthreads(); }
            pg8::Gemm8 g{WSP(const unsigned char, WS_X1), (const unsigned char*)WL_(WL_W1), 1024, 1024, 1024};
            pg8::EpiMoe1F8 E{WSP(unsigned char, WS_OV + OV_ACT), a->in[I_B1] + (size_t)l * NE * 2048};
            pg8::gemm_phase_f8<pg8::EpiMoe1F8, pg8::MoeOrder, true>(lds, g, S, E, (const LAS int*)(lds + GTAB_OFF));
        }
        SEAM(pb + 9);

        if (IN(pb + 10)) for (int rep = 0; rep < REPS(10); ++rep) { FRESH(a);
            const int nb = moe_table(a, lds);
            pg8::MoeOrder S{4, G, vcu, nb * 4, (const LAS int*)(lds + MISC_OFF + 256)};
            pg8::Gemm8 g{WSP(const unsigned char, WS_OV + OV_ACT), (const unsigned char*)WL_(WL_W2), 1024, 1024, 1024};
            pg8::EpiMoe2F8 E{WSP(bf16_t, WS_OV + OV_YS), a->in[I_B2] + (size_t)l * NE * 1024, WSP(const float, WS_WBUF)};
            pg8::gemm_phase_f8<pg8::EpiMoe2F8, pg8::MoeOrder, false>(lds, g, S, E);
        }
        SEAM(pb + 10);

        if (IN(pb + 11)) for (int rep = 0; rep < REPS(11); ++rep) { FRESH(a); p9_combine_ln2(a, l, (l == DEPTH_ - 1) ? a->out : (float*)nullptr, G); }
        SEAM(pb + 11);
    }
#undef WSP
#undef WL_
#undef IN
#undef SEAM
}

extern "C" void kernel_launch(void* const* d_in, const int* in_sizes, int n_in, void* d_out, int out_size, void* d_ws, size_t ws_size, hipStream_t stream) {
    static int grid = 0;
    if (grid == 0) {
        if (n_in != 30 || in_sizes[0] != T_ * D_ || out_size != T_ * D_ || ws_size < WS_END) {
            fprintf(stderr, "kernel_launch: unexpected shapes: n_in %d in0 %d out %d ws %zu (need %zu); nothing launched\n", n_in, n_in > 0 ? in_sizes[0] : -1, out_size, ws_size, (size_t)WS_END); grid = -1; return; }
        int dev = 0, cus = 0;
        if (hipGetDevice(&dev) != hipSuccess || hipDeviceGetAttribute(&cus, hipDeviceAttributeMultiprocessorCount, dev) != hipSuccess) { grid = -1; return; }
        if (hipFuncSetAttribute((const void*)fwd, hipFuncAttributeMaxDynamicSharedMemorySize, LDS_BYTES) != hipSuccess) { fprintf(stderr, "kernel_launch: hipFuncSetAttribute failed\n"); grid = -1; return; }
        int per_cu = 0; (void)hipOccupancyMaxActiveBlocksPerMultiprocessor(&per_cu, (const void*)fwd, NWAVES * 64, LDS_BYTES); (void)hipGetLastError();
        if (per_cu < 1) fprintf(stderr, "kernel_launch: occupancy query reports %d blocks per CU\n", per_cu);
        grid = cus;
    }
    if (grid < 0) return;
    (void)hipMemsetAsync((char*)d_ws + WS_CTL, 0, CTL_ZERO_BYTES, stream);
    Args a{};
    for (int i = 0; i < 30; ++i) a.in[i] = (const float*)d_in[i];
    a.out = (float*)d_out; a.ws = (unsigned char*)d_ws;
    constexpr int NL = MK_N_LAUNCHES; static_assert(NL == NPH || NL <= 4, "barrier regions");
    for (int li = 0; li < NL; ++li) {
        a.ph_lo = (int)((long)NPH * li / NL); a.ph_hi = (int)((long)NPH * (li + 1) / NL); a.li = (NL <= 4) ? li : 0;
        hipLaunchKernelGGL(fwd, dim3(grid), dim3(NWAVES * 64), LDS_BYTES, stream, a);
        const hipError_t le = hipPeekAtLastError();
        if (le != hipSuccess) { fprintf(stderr, "kernel_launch: launch %d failed: %s\n", li, hipGetErrorName(le)); break; }
    }
}
```

```cpp
#include <hip/hip_runtime.h>
#include <cstdio>
#include <cstdint>

#define LAS __attribute__((address_space(3)))
#define GAS __attribute__((address_space(1)))
typedef unsigned short bf16_t;
typedef short bf16x8 __attribute__((ext_vector_type(8)));
typedef float f32x4 __attribute__((ext_vector_type(4)));
typedef float f32x2 __attribute__((ext_vector_type(2)));
typedef unsigned u32x4 __attribute__((ext_vector_type(4)));
typedef unsigned u32x2 __attribute__((ext_vector_type(2)));

constexpr int T_ = 32768, D_ = 1024, SEQ_ = 4096, NBATCH = 8, DEPTH_ = 2;
constexpr int DIN = 8728, NPROJ = 5632, NINP = 8960;
constexpr int NE = 32, DFF = 1024;
constexpr int PMAX = 139264;
constexpr int NCHUNK = 256, CHTOK = 128;
constexpr float DN_ALPHA = 1.41421356237309515f;
constexpr float LN_EPS = 1e-5f, RMS_EPS = 1e-6f;
constexpr float F8_SX = 16.0f, F8_SW1 = 128.0f, F8_SA = 8.0f, F8_SW2 = 256.0f, F8_SWI = 128.0f;
constexpr int PC_LRUX = 0, PC_MLQ = 1024, PC_MLK = 1280, PC_MLV = 1536, PC_GDQ = 2048, PC_GDK = 2560, PC_GDV = 3072, PC_LRUY = 3584, PC_MLO = 4608, PC_GDZ = 5120;
constexpr int NIN_BF = 3840, NIN_F8 = 5120;
constexpr size_t WL_IN8 = 8u << 20;

constexpr size_t MiB = 1u << 20;
constexpr size_t WS_CTL = 0, CTL_ZERO_BYTES = 64 * 1024;
constexpr size_t WS_HIST = 256 * 1024;
constexpr size_t WS_META = 320 * 1024;
constexpr size_t WS_RWB = 384 * 1024;
constexpr size_t WS_W = 1 * MiB;
constexpr size_t WL_IN = 0, WL_BR = 18 * MiB, WL_OUT = 22 * MiB, WL_W1 = 24 * MiB, WL_W2 = 152 * MiB, WL_G = 216 * MiB, WL_STRIDE = 217 * MiB;
constexpr size_t WS_XB = 436 * MiB;
constexpr size_t WS_GSM = 501 * MiB;
constexpr size_t WS_MB = 505 * MiB;
constexpr size_t WS_V = 569 * MiB;
constexpr size_t WS_X1 = 697 * MiB;
constexpr size_t WS_X1B = 825 * MiB;
constexpr size_t WS_X2 = 890 * MiB;
constexpr size_t WS_TKE = 1018 * MiB;
constexpr size_t WS_TKW = WS_TKE + 512 * 1024;
constexpr size_t WS_SLOT = 1019 * MiB;
constexpr size_t WS_WBUF = 1020 * MiB;
constexpr size_t WS_TOKB = 1021 * MiB;
constexpr size_t WS_OV = 1024 * MiB;
constexpr size_t OV_PROJ = 0, OV_GD = 352 * MiB, OV_H = 544 * MiB;
constexpr size_t OV_XS = 0, OV_ACT = 272 * MiB, OV_YS = 544 * MiB;
constexpr size_t WS_MXS = WS_OV + 816 * MiB;
constexpr size_t WS_END = WS_MXS + 104 * MiB;

constexpr int CW_BAR = 1024;

constexpr int RING_BYTES = 131072;
constexpr int MISC_OFF = RING_BYTES;
constexpr int GTAB_OFF = MISC_OFF + 4096;
constexpr int LDS_BYTES = 163840;
constexpr int NWAVES = 8;

#define LDS_WAIT() asm volatile("s_waitcnt lgkmcnt(0)" ::: "memory")
#define VM_WAIT() asm volatile("s_waitcnt vmcnt(0)" ::: "memory")

__device__ __forceinline__ unsigned f2bf(float f) { unsigned u = __builtin_bit_cast(unsigned, f); return (u + 0x7fffu + ((u >> 16) & 1u)) >> 16; }
__device__ __forceinline__ unsigned pk2(float lo, float hi) { return f2bf(lo) | (f2bf(hi) << 16); }
__device__ __forceinline__ float bf2f(unsigned short b) { return __builtin_bit_cast(float, (unsigned)b << 16); }
__device__ __forceinline__ float bflo(unsigned w) { return __builtin_bit_cast(float, w << 16); }
__device__ __forceinline__ float bfhi(unsigned w) { return __builtin_bit_cast(float, w & 0xffff0000u); }
__device__ __forceinline__ unsigned pk_fp8x4(float a, float b, float c, float d) { int p = __builtin_amdgcn_cvt_pk_fp8_f32(a, b, 0, false); p = __builtin_amdgcn_cvt_pk_fp8_f32(c, d, p, true); return (unsigned)p; }
__device__ __forceinline__ float wave_sum(float v) {
#pragma unroll
    for (int o = 1; o < 64; o <<= 1) v += __shfl_xor(v, o);
    return v;
}
__device__ __forceinline__ float wave_max(float v) {
#pragma unroll
    for (int o = 1; o < 64; o <<= 1) v = fmaxf(v, __shfl_xor(v, o));
    return v;
}
__device__ __forceinline__ float sigmoid_f(float x) { return __builtin_amdgcn_rcpf(1.f + __expf(-x)); }
__device__ __forceinline__ float silu_f(float x) { return x * __builtin_amdgcn_rcpf(1.f + __expf(-x)); }
__device__ __forceinline__ float neg_expm1_f(float t) {
    const float p = -t * (1.f + t * 0.5f * (1.f + t * (1.f / 3.f) * (1.f + t * 0.25f * (1.f + t * 0.2f * (1.f + t * (1.f / 6.f) * (1.f + t * (1.f / 7.f)))))));
    return t > -0.3f ? p : 1.f - __expf(t);
}
__device__ __forceinline__ float log1p_f(float e) { return e < 0.01f ? e * (1.f - e * (0.5f - e * ((1.f / 3.f) - 0.25f * e))) : __logf(1.f + e); }
__device__ __forceinline__ float softplus_f(float x) { return fmaxf(x, 0.f) + log1p_f(__expf(-fabsf(x))); }
__device__ __forceinline__ float gelu_tanh_f(float x) { const float u = 0.7978845608028654f * (x + 0.044715f * x * x * x); return x * __builtin_amdgcn_rcpf(1.f + __expf(-2.f * u)); }
namespace pg8 {
#define PG8_LAS __attribute__((address_space(3)))
constexpr int BM = 256, BK = 64, HALF = 128, HTB = HALF * BK * 2  , STAGE_BYTES = 8 * HTB, NXCD = 8, WGM = 8;

__host__ __device__ __forceinline__ int lds_byte(int r, int c) { const int st = (r >> 4) * 2 + (c >> 5), rr = r & 15, cc = c & 31, ob = rr * 64 + cc * 2; return st * 1024 + (ob ^ (((ob >> 9) & 1) << 5)); }
__host__ __device__ __forceinline__ void stage_rc(int b, int& R, int& C) { const int st = b / 1024, sb = b % 1024, swz = sb ^ (((sb >> 9) & 1) << 5); R = (st >> 1) * 16 + swz / 64; C = (st & 1) * 32 + (swz % 64) / 2; }
__host__ __device__ __forceinline__ int perm32(int rho) { const int n = rho >> 4, i = rho & 15; return 8 * (i >> 2) + 4 * n + (i & 3); }

struct Unit { int pm, pn; };
struct Gemm { const bf16_t* A; const bf16_t* Bt; int lda, ldb, K; };

struct StaticOrder {
    int nM, nN, nwg, G, c;
    __host__ __device__ void init(int M, int N, int G_, int c_) { nM = M / BM; nN = N / BM; nwg = nM * nN; G = G_; c = c_; }
    __host__ __device__ bool next(int i, Unit& u) const {
        const long L = (long)i * G + c; if (L >= nwg) return false;
        int wgid = (int)L; { const int q = nwg / NXCD, r = nwg % NXCD, xcd = wgid % NXCD, off = wgid / NXCD; wgid = (xcd < r ? xcd * (q + 1) : r * (q + 1) + (xcd - r) * q) + off; }
        const int nig = WGM * nN, gid = wgid / nig, fm = gid * WGM, gsz = (nM - fm) < WGM ? (nM - fm) : WGM;
        u.pm = fm + ((wgid % nig) % gsz); u.pn = (wgid % nig) / gsz; return true;
    }
    __device__ __forceinline__ void a_ready(const Unit&) const {}
    __device__ __forceinline__ void done(const Unit&) const {}
};

__device__ __forceinline__ unsigned cvt_pk_bf16(float lo, float hi) { unsigned r; asm volatile("v_cvt_pk_bf16_f32 %0, %1, %2" : "=v"(r) : "v"(lo), "v"(hi)); return r; }

template <class Epi, class Sched, bool ALIGN_EPI = false, bool SP2 = false, bool GATHER = false>
__device__ __forceinline__ void gemm_phase(PG8_LAS unsigned char* lds, const Gemm g, const Sched& S, const Epi& E, const PG8_LAS int* gtab = nullptr) {
    int tid_ = threadIdx.x; asm volatile("" : "+v"(tid_));
    const int tid = tid_, wid = __builtin_amdgcn_readfirstlane(tid >> 6), lane = tid & 63, wr = wid >> 2, wc = wid & 3, fr = lane & 15, fq = lane >> 4;
    const int K = g.K, nt = K / BK;
    unsigned voffA[2], voffB[2];
#pragma unroll
    for (int i = 0; i < 2; ++i) { int R, C; stage_rc(tid * 16 + i * 8192, R, C); const int Rb = Epi::PERM ? ((R & ~31) + perm32(R & 31)) : R;
        voffA[i] = (unsigned)(R * g.lda + C) * 2u; voffB[i] = (unsigned)(Rb * g.ldb + C) * 2u; }
    const size_t kstep = (size_t)(BK * 2);
    const size_t hstepA = (size_t)HALF * g.lda * 2, hstepB = (size_t)HALF * g.ldb * 2;
    const size_t tstepA = 2 * hstepA, tstepB = 2 * hstepB;
    const unsigned ldsw = (unsigned)wid * 1024u;
    const int aoff = lds_byte(wr * 64 + fr, fq * 8), boff = lds_byte(wc * 32 + fr, fq * 8);
    int gR0 = 0, gC0 = 0; if constexpr (GATHER) { stage_rc(tid * 16, gR0, gC0); }
#define PG8_STAGE_A(bufoff, aptr, koff, slot, h) do { if constexpr (GATHER) { _Pragma("unroll") for (int _i = 0; _i < 2; ++_i) { const unsigned _o = ((slot) == ui) ? gvo[2 * (h) + _i] : nvo[2 * (h) + _i]; \
            __builtin_amdgcn_global_load_lds((const unsigned*)((const char*)g.A + _o + (koff)), (PG8_LAS unsigned*)(lds + (bufoff) + ldsw + _i * 8192), 16, 0, 0); } } \
        else { PG8_STAGE(bufoff, aptr, voffA); } } while (0)
#define PG8_GLOAD(dst, s_) do { _Pragma("unroll") for (int _j = 0; _j < 4; ++_j) dst[_j] = (unsigned)gtab[(s_) * 256 + gR0 + 64 * _j] * (unsigned)(g.lda * 2) + (unsigned)(gC0 * 2); } while (0)
#define PG8_SA(b, h) (((b) * 2 + (h)) * HTB)
#define PG8_SB(b, h) ((4 + (b) * 2 + (h)) * HTB)
#define PG8_STAGE(bufoff, gbase, voff) do { _Pragma("unroll") for (int _i = 0; _i < 2; ++_i) \
        __builtin_amdgcn_global_load_lds((const unsigned*)((const char*)(gbase) + (voff)[_i]), (PG8_LAS unsigned*)(lds + (bufoff) + ldsw + _i * 8192), 16, 0, 0); } while (0)
#define PG8_LDA(dst, b, h) do { _Pragma("unroll") for (int m = 0; m < 4; ++m) _Pragma("unroll") for (int k = 0; k < 2; ++k) dst[m][k] = *(const PG8_LAS bf16x8*)(lds + PG8_SA(b, h) + aoff + m * 2048 + k * 1024); } while (0)
#define PG8_LDB(dst, b, h) do { _Pragma("unroll") for (int n = 0; n < 2; ++n) _Pragma("unroll") for (int k = 0; k < 2; ++k) dst[n][k] = *(const PG8_LAS bf16x8*)(lds + PG8_SB(b, h) + boff + n * 2048 + k * 1024); } while (0)
#define PG8_MMA(ai, bj, At, Bt) do { __builtin_amdgcn_s_setprio(1); _Pragma("unroll") for (int m = 0; m < 4; ++m) _Pragma("unroll") for (int n = 0; n < 2; ++n) _Pragma("unroll") for (int k = 0; k < 2; ++k) \
        acc[ai][bj][m][n] = __builtin_amdgcn_mfma_f32_16x16x32_bf16(Bt[n][k], At[m][k], acc[ai][bj][m][n], 0, 0, 0); __builtin_amdgcn_s_setprio(0); } while (0)
#define PG8_WAIT_V(n) asm volatile("s_waitcnt vmcnt(" #n ")" ::: "memory")
#define PG8_WAIT_L(n) asm volatile("s_waitcnt lgkmcnt(" #n ")" ::: "memory")
#define PG8_BAR __builtin_amdgcn_s_barrier()
#define PG8_SCHED __builtin_amdgcn_sched_barrier(0)
    Unit cur, nxt; int ui = 0;
    if (!S.next(0, cur)) return;
    unsigned gvo[4] = {0u, 0u, 0u, 0u}, nvo[4] = {0u, 0u, 0u, 0u};
    if constexpr (GATHER) { PG8_GLOAD(gvo, 0); }
    f32x4 acc[2][2][4][2];
#pragma unroll
    for (int a = 0; a < 2; ++a)
#pragma unroll
        for (int b = 0; b < 2; ++b)
#pragma unroll
            for (int m = 0; m < 4; ++m)
#pragma unroll
                for (int n = 0; n < 2; ++n) acc[a][b][m][n] = (f32x4){0.f, 0.f, 0.f, 0.f};
    bf16x8 At[4][2], B0[2][2], B1[2][2];
    const char* cA = (const char*)g.A + (size_t)cur.pm * tstepA; const char* cB = (const char*)g.Bt + (size_t)cur.pn * tstepB;
    S.a_ready(cur);
    if constexpr (SP2) {
        PG8_STAGE(PG8_SB(0, 0), cB, voffB); PG8_STAGE(PG8_SB(0, 1), cB + hstepB, voffB); PG8_STAGE_A(PG8_SA(0, 0), cA, 0, 0, 0); PG8_STAGE_A(PG8_SA(0, 1), cA + hstepA, 0, 0, 1);
        if (wr == 1) PG8_BAR;
        PG8_WAIT_V(2); PG8_BAR;
        PG8_STAGE(PG8_SB(1, 0), cB + kstep, voffB); PG8_STAGE_A(PG8_SA(1, 0), cA + kstep, kstep, 0, 0); PG8_STAGE(PG8_SB(1, 1), cB + hstepB + kstep, voffB);
        PG8_WAIT_V(6); PG8_BAR;
    } else {
        PG8_STAGE(PG8_SB(0, 0), cB, voffB); PG8_STAGE_A(PG8_SA(0, 0), cA, 0, 0, 0); PG8_STAGE(PG8_SB(0, 1), cB + hstepB, voffB); PG8_STAGE_A(PG8_SA(0, 1), cA + hstepA, 0, 0, 1);
        if (wr == 1) PG8_BAR;
        PG8_WAIT_V(4); PG8_BAR;
        PG8_STAGE(PG8_SB(1, 0), cB + kstep, voffB); PG8_STAGE_A(PG8_SA(1, 0), cA + kstep, kstep, 0, 0); PG8_STAGE(PG8_SB(1, 1), cB + hstepB + kstep, voffB);
        PG8_WAIT_V(6); PG8_BAR;
    }
    for (;;) {
        const bool has_next = S.next(ui + 1, nxt);
        if constexpr (GATHER) { if (has_next) { PG8_GLOAD(nvo, ui + 1); } else { _Pragma("unroll") for (int _j = 0; _j < 4; ++_j) nvo[_j] = gvo[_j]; } }
        const char* nA = has_next ? (const char*)g.A + (size_t)nxt.pm * tstepA : cA; const char* nB = has_next ? (const char*)g.Bt + (size_t)nxt.pn * tstepB : cB;
        int t = 0;
        for (int seg = 0; seg < (Epi::HAS_MID ? 3 : 1); ++seg) {
        const int tend = Epi::HAS_MID ? (seg == 0 ? Epi::MID0 : (seg == 1 ? Epi::MID1 : nt)) : nt;
        for (; t < tend; t += 2) {
            const bool last = (t == nt - 2);
            const char* a1 = cA + (size_t)(t + 1) * kstep;
            const char* a2 = last ? nA : cA + (size_t)(t + 2) * kstep; const char* b2 = last ? nB : cB + (size_t)(t + 2) * kstep;
            const char* a3 = a2 + kstep; const char* b3 = b2 + kstep;
            const size_t ka1 = (size_t)(t + 1) * kstep, ka2 = last ? 0 : (size_t)(t + 2) * kstep, ka3 = ka2 + kstep; const int sl2 = (last && has_next) ? ui + 1 : ui;
            if (last && has_next) S.a_ready(nxt);
            if constexpr (SP2) {
            PG8_LDB(B0, 0, 0); PG8_LDB(B1, 0, 1); PG8_SCHED; PG8_LDA(At, 0, 0); PG8_STAGE_A(PG8_SA(1, 1), a1 + hstepA, ka1, ui, 1);
            PG8_WAIT_V(8); PG8_WAIT_L(0); PG8_BAR; PG8_MMA(0, 0, At, B0); PG8_MMA(0, 1, At, B1); PG8_BAR; PG8_SCHED;
            PG8_LDA(At, 0, 1); PG8_STAGE(PG8_SB(0, 0), b2, voffB); PG8_STAGE(PG8_SB(0, 1), b2 + hstepB, voffB); PG8_STAGE_A(PG8_SA(0, 0), a2, ka2, sl2, 0);
            PG8_WAIT_V(8); PG8_WAIT_L(0); PG8_BAR; PG8_MMA(1, 0, At, B0); PG8_MMA(1, 1, At, B1); PG8_BAR; PG8_SCHED;
            PG8_LDB(B0, 1, 0); PG8_LDB(B1, 1, 1); PG8_SCHED; PG8_LDA(At, 1, 0); PG8_STAGE_A(PG8_SA(0, 1), a2 + hstepA, ka2, sl2, 1);
            PG8_WAIT_V(8); PG8_WAIT_L(0); PG8_BAR; PG8_MMA(0, 0, At, B0); PG8_MMA(0, 1, At, B1); PG8_BAR; PG8_SCHED;
            PG8_LDA(At, 1, 1); PG8_STAGE(PG8_SB(1, 0), b3, voffB); PG8_STAGE(PG8_SB(1, 1), b3 + hstepB, voffB); PG8_STAGE_A(PG8_SA(1, 0), a3, ka3, sl2, 0);
            PG8_WAIT_V(8); PG8_WAIT_L(0); PG8_BAR; PG8_MMA(1, 0, At, B0); PG8_MMA(1, 1, At, B1); PG8_BAR; PG8_SCHED;
            } else {
            PG8_LDB(B0, 0, 0); PG8_SCHED; PG8_LDA(At, 0, 0); PG8_STAGE_A(PG8_SA(1, 1), a1 + hstepA, ka1, ui, 1);
            PG8_WAIT_L(8); PG8_BAR; PG8_WAIT_L(0); PG8_MMA(0, 0, At, B0); PG8_BAR; PG8_SCHED;
            PG8_LDB(B1, 0, 1); PG8_STAGE(PG8_SB(0, 0), b2, voffB);
            PG8_BAR; PG8_WAIT_L(0); PG8_MMA(0, 1, At, B1); PG8_BAR;
            PG8_LDA(At, 0, 1); PG8_STAGE_A(PG8_SA(0, 0), a2, ka2, sl2, 0);
            PG8_BAR; PG8_WAIT_L(0); PG8_MMA(1, 0, At, B0); PG8_BAR; PG8_SCHED;
            PG8_STAGE(PG8_SB(0, 1), b2 + hstepB, voffB);
            PG8_WAIT_V(6); PG8_BAR; PG8_MMA(1, 1, At, B1); PG8_BAR;
            PG8_LDB(B0, 1, 0); PG8_SCHED; PG8_LDA(At, 1, 0); PG8_STAGE_A(PG8_SA(0, 1), a2 + hstepA, ka2, sl2, 1);
            PG8_WAIT_L(8); PG8_BAR; PG8_WAIT_L(0); PG8_MMA(0, 0, At, B0); PG8_BAR; PG8_SCHED;
            PG8_LDB(B1, 1, 1); PG8_STAGE(PG8_SB(1, 0), b3, voffB);
            PG8_BAR; PG8_WAIT_L(0); PG8_MMA(0, 1, At, B1); PG8_BAR;
            PG8_LDA(At, 1, 1); PG8_STAGE_A(PG8_SA(1, 0), a3, ka3, sl2, 0);
            PG8_BAR; PG8_WAIT_L(0); PG8_MMA(1, 0, At, B0); PG8_BAR; PG8_SCHED;
            PG8_STAGE(PG8_SB(1, 1), b3 + hstepB, voffB);
            PG8_WAIT_V(6); PG8_BAR; PG8_MMA(1, 1, At, B1); PG8_BAR;
            }
        }
        if constexpr (Epi::HAS_MID) { if (seg < 2) E.mid(acc, cur, wr, wc, fr, fq, seg); }
        }
        if constexpr (ALIGN_EPI) { if (wr == 0) PG8_BAR; }
        E(acc, cur, wr, wc, fr, fq); S.done(cur);
        if (!has_next) break;
#pragma unroll
        for (int a = 0; a < 2; ++a)
#pragma unroll
            for (int b = 0; b < 2; ++b)
#pragma unroll
                for (int m = 0; m < 4; ++m)
#pragma unroll
                    for (int n = 0; n < 2; ++n) acc[a][b][m][n] = (f32x4){0.f, 0.f, 0.f, 0.f};
        cur = nxt; cA = nA; cB = nB; ++ui;
        if constexpr (GATHER) { _Pragma("unroll") for (int _j = 0; _j < 4; ++_j) gvo[_j] = nvo[_j]; }
        if constexpr (ALIGN_EPI) { if (wr == 1) PG8_BAR; }
    }
    PG8_WAIT_V(0);
    if constexpr (!ALIGN_EPI) { if (wr == 0) PG8_BAR; }
    PG8_BAR;
#undef PG8_SA
#undef PG8_SB
#undef PG8_STAGE
#undef PG8_STAGE_A
#undef PG8_GLOAD
#undef PG8_LDA
#undef PG8_LDB
#undef PG8_MMA
#undef PG8_WAIT_V
#undef PG8_WAIT_L
#undef PG8_BAR
#undef PG8_SCHED
}
}
namespace pg8 {
typedef int i32x4v __attribute__((ext_vector_type(4)));
typedef int i32x8 __attribute__((ext_vector_type(8)));
struct Gemm8 { const unsigned char* A; const unsigned char* Bt; int lda, ldb, K; };
template <class Epi, class Sched, bool GATHER = false>
__device__ __forceinline__ void gemm_phase_f8(PG8_LAS unsigned char* lds, const Gemm8 g, const Sched& S, const Epi& E, const PG8_LAS int* gtab = nullptr) {
    constexpr bool ALIGN_EPI = true, SP2 = true;
    int tid_ = threadIdx.x; asm volatile("" : "+v"(tid_));
    const int tid = tid_, wid = __builtin_amdgcn_readfirstlane(tid >> 6), lane = tid & 63, wr = wid >> 2, wc = wid & 3, fr = lane & 15, fq = lane >> 4;
    int K_ = g.K; asm volatile("" : "+s"(K_));
    const int K = K_, nt = K / 128;
    unsigned voffA[2], voffB[2];
#pragma unroll
    for (int i = 0; i < 2; ++i) { int R, C; stage_rc(tid * 16 + i * 8192, R, C); const int Rb = Epi::PERM ? ((R & ~31) + perm32(R & 31)) : R;
        voffA[i] = (unsigned)(R * g.lda + C * 2); voffB[i] = (unsigned)(Rb * g.ldb + C * 2); }
    const size_t kstep = (size_t)(BK * 2);
    const size_t hstepA = (size_t)HALF * g.lda, hstepB = (size_t)HALF * g.ldb;
    const size_t tstepA = 2 * hstepA, tstepB = 2 * hstepB;
    const unsigned ldsw = (unsigned)wid * 1024u;
    const int aoff = lds_byte(wr * 64 + fr, fq * 16), boff = lds_byte(wc * 32 + fr, fq * 16);
    int gR0 = 0, gC0 = 0; if constexpr (GATHER) { stage_rc(tid * 16, gR0, gC0); }
#define PG8_STAGE_A(bufoff, aptr, koff, slot, h) do { if constexpr (GATHER) { _Pragma("unroll") for (int _i = 0; _i < 2; ++_i) { const unsigned _o = ((slot) == ui) ? gvo[2 * (h) + _i] : nvo[2 * (h) + _i]; \
            __builtin_amdgcn_global_load_lds((const unsigned*)((const char*)g.A + _o + (koff)), (PG8_LAS unsigned*)(lds + (bufoff) + ldsw + _i * 8192), 16, 0, 0); } } \
        else { PG8_STAGE(bufoff, aptr, voffA); } } while (0)
#define PG8_GLOAD(dst, s_) do { _Pragma("unroll") for (int _j = 0; _j < 4; ++_j) dst[_j] = (unsigned)gtab[(s_) * 256 + gR0 + 64 * _j] * (unsigned)(g.lda) + (unsigned)(gC0 * 2); } while (0)
#define PG8_SA(b, h) (((b) * 2 + (h)) * HTB)
#define PG8_SB(b, h) ((4 + (b) * 2 + (h)) * HTB)
#define PG8_STAGE(bufoff, gbase, voff) do { _Pragma("unroll") for (int _i = 0; _i < 2; ++_i) \
        __builtin_amdgcn_global_load_lds((const unsigned*)((const char*)(gbase) + (voff)[_i]), (PG8_LAS unsigned*)(lds + (bufoff) + ldsw + _i * 8192), 16, 0, 0); } while (0)
#define PG8_LDA(dst, b, h) do { _Pragma("unroll") for (int m = 0; m < 4; ++m) { const i32x4v lo_ = *(const PG8_LAS i32x4v*)(lds + PG8_SA(b, h) + aoff + m * 2048), hi_ = *(const PG8_LAS i32x4v*)(lds + PG8_SA(b, h) + aoff + m * 2048 + 16); dst[m] = __builtin_shufflevector(lo_, hi_, 0, 1, 2, 3, 4, 5, 6, 7); } } while (0)
#define PG8_LDB(dst, b, h) do { _Pragma("unroll") for (int n = 0; n < 2; ++n) { const i32x4v lo_ = *(const PG8_LAS i32x4v*)(lds + PG8_SB(b, h) + boff + n * 2048), hi_ = *(const PG8_LAS i32x4v*)(lds + PG8_SB(b, h) + boff + n * 2048 + 16); dst[n] = __builtin_shufflevector(lo_, hi_, 0, 1, 2, 3, 4, 5, 6, 7); } } while (0)
#define PG8_MMA(ai, bj, At, Bt) do { __builtin_amdgcn_s_setprio(1); _Pragma("unroll") for (int m = 0; m < 4; ++m) _Pragma("unroll") for (int n = 0; n < 2; ++n) \
        asm volatile("v_mfma_scale_f32_16x16x128_f8f6f4 %0, %1, %2, %0, %3, %3 op_sel_hi:[0,0,0]" : "+v"(acc[ai][bj][m][n]) : "v"(Bt[n]), "v"(At[m]), "v"(sc1)); __builtin_amdgcn_s_setprio(0); } while (0)
#define PG8_WAIT_V(n) asm volatile("s_waitcnt vmcnt(" #n ")" ::: "memory")
#define PG8_WAIT_L(n) asm volatile("s_waitcnt lgkmcnt(" #n ")" ::: "memory")
#define PG8_BAR __builtin_amdgcn_s_barrier()
#define PG8_SCHED __builtin_amdgcn_sched_barrier(0)
    Unit cur, nxt; int ui = 0;
    if (!S.next(0, cur)) return;
    unsigned gvo[4] = {0u, 0u, 0u, 0u}, nvo[4] = {0u, 0u, 0u, 0u};
    if constexpr (GATHER) { PG8_GLOAD(gvo, 0); }
    f32x4 acc[2][2][4][2];
#pragma unroll
    for (int a = 0; a < 2; ++a)
#pragma unroll
        for (int b = 0; b < 2; ++b)
#pragma unroll
            for (int m = 0; m < 4; ++m)
#pragma unroll
                for (int n = 0; n < 2; ++n) acc[a][b][m][n] = (f32x4){0.f, 0.f, 0.f, 0.f};
    i32x8 At[4], B0[2], B1[2];
    int sc1 = 0x7f7f7f7f; asm volatile("" : "+v"(sc1));
    const char* cA = (const char*)g.A + (size_t)cur.pm * tstepA; const char* cB = (const char*)g.Bt + (size_t)cur.pn * tstepB;
    S.a_ready(cur);
    if constexpr (SP2) {
        PG8_STAGE(PG8_SB(0, 0), cB, voffB); PG8_STAGE(PG8_SB(0, 1), cB + hstepB, voffB); PG8_STAGE_A(PG8_SA(0, 0), cA, 0, 0, 0); PG8_STAGE_A(PG8_SA(0, 1), cA + hstepA, 0, 0, 1);
        if (wr == 1) PG8_BAR;
        PG8_WAIT_V(2); PG8_BAR;
        PG8_STAGE(PG8_SB(1, 0), cB + kstep, voffB); PG8_STAGE_A(PG8_SA(1, 0), cA + kstep, kstep, 0, 0); PG8_STAGE(PG8_SB(1, 1), cB + hstepB + kstep, voffB);
        PG8_WAIT_V(6); PG8_BAR;
    } else {
        PG8_STAGE(PG8_SB(0, 0), cB, voffB); PG8_STAGE_A(PG8_SA(0, 0), cA, 0, 0, 0); PG8_STAGE(PG8_SB(0, 1), cB + hstepB, voffB); PG8_STAGE_A(PG8_SA(0, 1), cA + hstepA, 0, 0, 1);
        if (wr == 1) PG8_BAR;
        PG8_WAIT_V(4); PG8_BAR;
        PG8_STAGE(PG8_SB(1, 0), cB + kstep, voffB); PG8_STAGE_A(PG8_SA(1, 0), cA + kstep, kstep, 0, 0); PG8_STAGE(PG8_SB(1, 1), cB + hstepB + kstep, voffB);
        PG8_WAIT_V(6); PG8_BAR;
    }
    for (;;) {
        const bool has_next = S.next(ui + 1, nxt);
        if constexpr (GATHER) { if (has_next) { PG8_GLOAD(nvo, ui + 1); } else { _Pragma("unroll") for (int _j = 0; _j < 4; ++_j) nvo[_j] = gvo[_j]; } }
        const char* nA = has_next ? (const char*)g.A + (size_t)nxt.pm * tstepA : cA; const char* nB = has_next ? (const char*)g.Bt + (size_t)nxt.pn * tstepB : cB;
        int t = 0;
        for (int seg = 0; seg < (Epi::HAS_MID ? 3 : 1); ++seg) {
        const int tend = Epi::HAS_MID ? (seg == 0 ? Epi::MID0 : (seg == 1 ? Epi::MID1 : nt)) : nt;
#pragma unroll 1
        for (; t < tend; t += 2) {
            const bool last = (t == nt - 2);
            const char* a1 = cA + (size_t)(t + 1) * kstep;
            const char* a2 = last ? nA : cA + (size_t)(t + 2) * kstep; const char* b2 = last ? nB : cB + (size_t)(t + 2) * kstep;
            const char* a3 = a2 + kstep; const char* b3 = b2 + kstep;
            const size_t ka1 = (size_t)(t + 1) * kstep, ka2 = last ? 0 : (size_t)(t + 2) * kstep, ka3 = ka2 + kstep; const int sl2 = (last && has_next) ? ui + 1 : ui;
            if (last && has_next) S.a_ready(nxt);
            if constexpr (SP2) {
            PG8_LDB(B0, 0, 0); PG8_LDB(B1, 0, 1); PG8_SCHED; PG8_LDA(At, 0, 0); PG8_STAGE_A(PG8_SA(1, 1), a1 + hstepA, ka1, ui, 1);
            PG8_WAIT_V(8); PG8_WAIT_L(0); PG8_BAR; PG8_MMA(0, 0, At, B0); PG8_MMA(0, 1, At, B1); PG8_BAR; PG8_SCHED;
            PG8_LDA(At, 0, 1); PG8_STAGE(PG8_SB(0, 0), b2, voffB); PG8_STAGE(PG8_SB(0, 1), b2 + hstepB, voffB); PG8_STAGE_A(PG8_SA(0, 0), a2, ka2, sl2, 0);
            PG8_WAIT_V(8); PG8_WAIT_L(0); PG8_BAR; PG8_MMA(1, 0, At, B0); PG8_MMA(1, 1, At, B1); PG8_BAR; PG8_SCHED;
            PG8_LDB(B0, 1, 0); PG8_LDB(B1, 1, 1); PG8_SCHED; PG8_LDA(At, 1, 0); PG8_STAGE_A(PG8_SA(0, 1), a2 + hstepA, ka2, sl2, 1);
            PG8_WAIT_V(8); PG8_WAIT_L(0); PG8_BAR; PG8_MMA(0, 0, At, B0); PG8_MMA(0, 1, At, B1); PG8_BAR; PG8_SCHED;
            PG8_LDA(At, 1, 1); PG8_STAGE(PG8_SB(1, 0), b3, voffB); PG8_STAGE(PG8_SB(1, 1), b3 + hstepB, voffB); PG8_STAGE_A(PG8_SA(1, 0), a3, ka3, sl2, 0);
            PG8_WAIT_V(8); PG8_WAIT_L(0); PG8_BAR; PG8_MMA(1, 0, At, B0); PG8_MMA(1, 1, At, B1); PG8_BAR; PG8_SCHED;
            } else {
            PG8_LDB(B0, 0, 0); PG8_SCHED; PG8_LDA(At, 0, 0); PG8_STAGE_A(PG8_SA(1, 1), a1 + hstepA, ka1, ui, 1);
            PG8_WAIT_L(8); PG8_BAR; PG8_WAIT_L(0); PG8_MMA(0, 0, At, B0); PG8_BAR; PG8_SCHED;
            PG8_LDB(B1, 0, 1); PG8_STAGE(PG8_SB(0, 0), b2, voffB);
            PG8_BAR; PG8_WAIT_L(0); PG8_MMA(0, 1, At, B1); PG8_BAR;
            PG8_LDA(At, 0, 1); PG8_STAGE_A(PG8_SA(0, 0), a2, ka2, sl2, 0);
            PG8_BAR; PG8_WAIT_L(0); PG8_MMA(1, 0, At, B0); PG8_BAR; PG8_SCHED;
            PG8_STAGE(PG8_SB(0, 1), b2 + hstepB, voffB);
            PG8_WAIT_V(6); PG8_BAR; PG8_MMA(1, 1, At, B1); PG8_BAR;
            PG8_LDB(B0, 1, 0); PG8_SCHED; PG8_LDA(At, 1, 0); PG8_STAGE_A(PG8_SA(0, 1), a2 + hstepA, ka2, sl2, 1);
            PG8_WAIT_L(8); PG8_BAR; PG8_WAIT_L(0); PG8_MMA(0, 0, At, B0); PG8_BAR; PG8_SCHED;
            PG8_LDB(B1, 1, 1); PG8_STAGE(PG8_SB(1, 0), b3, voffB);
            PG8_BAR; PG8_WAIT_L(0); PG8_MMA(0, 1, At, B1); PG8_BAR;
            PG8_LDA(At, 1, 1); PG8_STAGE_A(PG8_SA(1, 0), a3, ka3, sl2, 0);
            PG8_BAR; PG8_WAIT_L(0); PG8_MMA(1, 0, At, B0); PG8_BAR; PG8_SCHED;
            PG8_STAGE(PG8_SB(1, 1), b3 + hstepB, voffB);
            PG8_WAIT_V(6); PG8_BAR; PG8_MMA(1, 1, At, B1); PG8_BAR;
            }
        }
        if constexpr (Epi::HAS_MID) { if (seg < 2) E.mid(acc, cur, wr, wc, fr, fq, seg); }
        }
        if constexpr (ALIGN_EPI) { if (wr == 0) PG8_BAR; }
        asm volatile("s_nop 15\n\ts_nop 15" ::: "memory");
        E(acc, cur, wr, wc, fr, fq); S.done(cur);
        if (!has_next) break;
#pragma unroll
        for (int a = 0; a < 2; ++a)
#pragma unroll
            for (int b = 0; b < 2; ++b)
#pragma unroll
                for (int m = 0; m < 4; ++m)
#pragma unroll
                    for (int n = 0; n < 2; ++n) acc[a][b][m][n] = (f32x4){0.f, 0.f, 0.f, 0.f};
        cur = nxt; cA = nA; cB = nB; ++ui;
        if constexpr (GATHER) { _Pragma("unroll") for (int _j = 0; _j < 4; ++_j) gvo[_j] = nvo[_j]; }
        if constexpr (ALIGN_EPI) { if (wr == 1) PG8_BAR; }
    }
    PG8_WAIT_V(0);
    if constexpr (!ALIGN_EPI) { if (wr == 0) PG8_BAR; }
    PG8_BAR;
#undef PG8_SA
#undef PG8_SB
#undef PG8_STAGE
#undef PG8_STAGE_A
#undef PG8_GLOAD
#undef PG8_LDA
#undef PG8_LDB
#undef PG8_MMA
#undef PG8_WAIT_V
#undef PG8_WAIT_L
#undef PG8_BAR
#undef PG8_SCHED
}
}
#define XB_TMO      128
#define XB_XCNT(j)  (256  + 64 * (j))
#define XB_XSUB(j)  (1280 + 64 * (j))
#define XB_XGEN(j)  (2304 + 64 * (j))
#define XB_TOP      3328
#define XB_TOPGEN   3392
#define XCD_BAR_WORDS 3456
#define XB_SPIN_CAP (1u << 18)

__device__ __forceinline__ unsigned xb_ld(unsigned* p)              { return __hip_atomic_load(p, __ATOMIC_RELAXED, __HIP_MEMORY_SCOPE_AGENT); }
__device__ __forceinline__ unsigned xb_add(unsigned* p, unsigned v) { return __hip_atomic_fetch_add(p, v, __ATOMIC_RELAXED, __HIP_MEMORY_SCOPE_AGENT); }
__device__ __forceinline__ unsigned xb_xcc_id() { return (unsigned)__builtin_amdgcn_s_getreg((3 << 11) | 20) & 0xFu; }
#define XB_SPIN(cond, bar) do { unsigned _sp = 0; while (cond) { __builtin_amdgcn_s_sleep(1); \
    if ((++_sp & 255u) == 0u) { if (xb_ld(&(bar)[XB_TMO])) break; if (_sp > XB_SPIN_CAP) { atomicAdd(&(bar)[XB_TMO], 1u); break; } } } } while (0)

struct XcdBarrier {
    unsigned* bar; unsigned x;
    volatile LAS unsigned* st;
};

__device__ __forceinline__ XcdBarrier xcd_barrier_post(unsigned* bar, volatile LAS unsigned* st) {
    XcdBarrier b; b.bar = bar; b.x = xb_xcc_id(); b.st = st;
    if (threadIdx.x == 0) (void)xb_add(&bar[XB_XCNT(b.x)], 1u);
    return b;
}
__device__ __forceinline__ void xcd_barrier_complete(unsigned* bar, unsigned x, unsigned& nloc, unsigned& nx) {
    const unsigned G = gridDim.x * gridDim.y * gridDim.z;
    unsigned sum, cnt, mine, sp = 0u;
    for (;;) {
        sum = 0u; cnt = 0u; mine = 0u;
#pragma unroll
        for (unsigned j = 0; j < 16; ++j) { const unsigned c = xb_ld(&bar[XB_XCNT(j)]); sum += c; cnt += (c > 0u) ? 1u : 0u; mine = (j == x) ? c : mine; }
        if (sum == G) break;
        __builtin_amdgcn_s_sleep(1);
        if ((++sp & 255u) == 0u) { if (xb_ld(&bar[XB_TMO])) break; if (sp > XB_SPIN_CAP) { atomicAdd(&bar[XB_TMO], 1u); break; } }
    }
    nloc = mine > 0u ? mine : 1u; nx = cnt > 0u ? cnt : 1u;
}

__device__ __forceinline__ void xcd_barrier(const XcdBarrier& b) {
    asm volatile("s_waitcnt vmcnt(0)" ::: "memory");
    __syncthreads();
    if (threadIdx.x == 0) {
        unsigned* bar = b.bar;
        __builtin_amdgcn_s_waitcnt(0);
        unsigned nloc = b.st[0], nx = b.st[1];
        if (nloc == 0u) { xcd_barrier_complete(bar, b.x, nloc, nx); b.st[0] = nloc; b.st[1] = nx; }
        const unsigned old = xb_add(&bar[XB_XSUB(b.x)], 1u);
        const unsigned gen = old / nloc;
        if (old + 1u == (gen + 1u) * nloc) {
            __builtin_amdgcn_fence(__ATOMIC_RELEASE, "agent");
            asm volatile("s_waitcnt vmcnt(0)" ::: "memory");
            const unsigned og = xb_add(&bar[XB_TOP], 1u);
            const unsigned tg = og / nx;
            if (og + 1u == (tg + 1u) * nx) xb_add(&bar[XB_TOPGEN], 1u);
            else XB_SPIN(xb_ld(&bar[XB_TOPGEN]) == tg, bar);
            __builtin_amdgcn_fence(__ATOMIC_ACQUIRE, "agent");
            xb_add(&bar[XB_XGEN(b.x)], 1u);
            asm volatile("s_waitcnt vmcnt(0)" ::: "memory");
        } else {
            XB_SPIN(xb_ld(&bar[XB_XGEN(b.x)]) == gen, bar);
            __builtin_amdgcn_fence(__ATOMIC_ACQUIRE, "agent");
            asm volatile("s_waitcnt vmcnt(0)" ::: "memory");
        }
    }
    __syncthreads();
}
namespace pg8 {
struct EpiProj {
    static constexpr bool PERM = true, HAS_MID = false; static constexpr int MID0 = 0, MID1 = 0;
    __device__ __forceinline__ void mid(f32x4 (&)[2][2][4][2], const Unit&, int, int, int, int, int) const {}
    bf16_t* proj; float* gsm;
    __device__ __forceinline__ void operator()(const f32x4 (&acc)[2][2][4][2], const Unit& u, int wr, int wc, int fr, int fq) const {
        const int row0 = u.pm * BM + wr * 64 + fr;
        if (u.pn < 14) {
            const int col0 = u.pn * BM + wc * 32 + 8 * fq;
#pragma unroll
            for (int ai = 0; ai < 2; ++ai)
#pragma unroll
                for (int m = 0; m < 4; ++m) { bf16_t* rowp = proj + (size_t)(row0 + ai * HALF + m * 16) * NPROJ + col0;
#pragma unroll
                    for (int bj = 0; bj < 2; ++bj) { const f32x4 v0 = acc[ai][bj][m][0], v1 = acc[ai][bj][m][1];
                        u32x4 w; w.x = cvt_pk_bf16(v0[0], v0[1]); w.y = cvt_pk_bf16(v0[2], v0[3]); w.z = cvt_pk_bf16(v1[0], v1[1]); w.w = cvt_pk_bf16(v1[2], v1[3]);
                        *(u32x4*)(rowp + bj * HALF) = w; } }
        } else if (wc == 0 && fq < 3) {
#pragma unroll
            for (int ai = 0; ai < 2; ++ai)
#pragma unroll
                for (int m = 0; m < 4; ++m) { float* rowp = gsm + (size_t)(row0 + ai * HALF + m * 16) * 32 + 8 * fq;
                    *(f32x4*)(rowp) = acc[ai][0][m][0]; *(f32x4*)(rowp + 4) = acc[ai][0][m][1]; }
        }
    }
};
struct EpiProj8 {
    static constexpr bool PERM = true, HAS_MID = false; static constexpr int MID0 = 0, MID1 = 0;
    __device__ __forceinline__ void mid(f32x4 (&)[2][2][4][2], const Unit&, int, int, int, int, int) const {}
    bf16_t* proj; bf16_t* gd;
    __device__ __forceinline__ void operator()(const f32x4 (&acc)[2][2][4][2], const Unit& u, int wr, int wc, int fr, int fq) const {
        constexpr float sc = 1.0f / (F8_SX * F8_SWI);
        const int row0 = u.pm * BM + wr * 64 + fr;
        if (u.pn >= 8) {
            const int gt = u.pn - 8; bf16_t* base = gd + ((size_t)((gt >> 2) * 128 + u.pm) * 4 + (gt & 3)) * 65536 + (size_t)((wr * 4 + wc) * 64 + fq * 16 + fr) * 8;
#pragma unroll
            for (int ai = 0; ai < 2; ++ai)
#pragma unroll
                for (int m = 0; m < 4; ++m)
#pragma unroll
                    for (int bj = 0; bj < 2; ++bj) { const f32x4 v0 = acc[ai][bj][m][0] * sc, v1 = acc[ai][bj][m][1] * sc;
                        u32x4 w; w.x = cvt_pk_bf16(v0[0], v0[1]); w.y = cvt_pk_bf16(v0[2], v0[3]); w.z = cvt_pk_bf16(v1[0], v1[1]); w.w = cvt_pk_bf16(v1[2], v1[3]);
                        *(u32x4*)(base + (size_t)((ai * 4 + m) * 2 + bj) * 4096) = w; }
        } else {
            const int col0 = PC_LRUY + u.pn * BM + wc * 32 + 8 * fq;
#pragma unroll
            for (int ai = 0; ai < 2; ++ai)
#pragma unroll
                for (int m = 0; m < 4; ++m) { bf16_t* rowp = proj + (size_t)(row0 + ai * HALF + m * 16) * NPROJ + col0;
#pragma unroll
                    for (int bj = 0; bj < 2; ++bj) { const f32x4 v0 = acc[ai][bj][m][0] * sc, v1 = acc[ai][bj][m][1] * sc;
                        u32x4 w; w.x = cvt_pk_bf16(v0[0], v0[1]); w.y = cvt_pk_bf16(v0[2], v0[3]); w.z = cvt_pk_bf16(v1[0], v1[1]); w.w = cvt_pk_bf16(v1[2], v1[3]);
                        *(u32x4*)(rowp + bj * HALF) = w; } }
        }
    }
};
struct P1F8Order {
    int G, c;
    __device__ __forceinline__ bool next(int i, Unit& u) const {
        int L;
        if (G == 256) { const int cnt = c < 128 ? 9 : 11; if (i >= cnt) return false; L = (c < 128 ? c * 9 : 1152 + (c - 128) * 11) + i; }
        else { L = i * G + c; if (L >= 128 * 20) return false; }
        u.pm = L / 20; u.pn = L % 20; return true;
    }
    __device__ __forceinline__ void a_ready(const Unit&) const {}
    __device__ __forceinline__ void done(const Unit&) const {}
};
struct EpiMergeF {
    static constexpr bool PERM = true, HAS_MID = true; static constexpr int MID0 = 16, MID1 = 24;
    const bf16_t* gd; bf16_t* mb;
    static __device__ __forceinline__ float em(float x) { return __expf(fminf(-x, 40.0f)); }
    __device__ __forceinline__ void mid(f32x4 (&acc)[2][2][4][2], const Unit& u, int wr, int wc, int fr, int fq, int st) const {
        int toff = ((wr * 4 + wc) * 64 + fq * 16 + fr) * 8; asm volatile("" : "+v"(toff));
        const bf16_t* ga_ = gd + ((size_t)(st * 128 + u.pm) * 4 + u.pn) * 65536 + toff; const bf16_t* gb_ = ga_ + (size_t)128 * 4 * 65536;
#pragma unroll
        for (int ai = 0; ai < 2; ++ai) {
            u32x4 ga[4][2], gb[4][2];
#pragma unroll
            for (int m = 0; m < 4; ++m)
#pragma unroll
                for (int bj = 0; bj < 2; ++bj) { const int o = ((ai * 4 + m) * 2 + bj) * 4096; ga[m][bj] = *(const u32x4*)(ga_ + o); gb[m][bj] = *(const u32x4*)(gb_ + o); }
#pragma unroll
            for (int m = 0; m < 4; ++m)
#pragma unroll
                for (int bj = 0; bj < 2; ++bj) { const unsigned xa[4] = {ga[m][bj].x, ga[m][bj].y, ga[m][bj].z, ga[m][bj].w}, xb[4] = {gb[m][bj].x, gb[m][bj].y, gb[m][bj].z, gb[m][bj].w};
#pragma unroll
                    for (int q = 0; q < 4; ++q) { const float r0 = (1.f + em(bflo(xb[q]))) * __builtin_amdgcn_rcpf(1.f + em(bflo(xa[q]))), r1 = (1.f + em(bfhi(xb[q]))) * __builtin_amdgcn_rcpf(1.f + em(bfhi(xa[q])));
                        acc[ai][bj][m][q >> 1][(q & 1) * 2] *= r0; acc[ai][bj][m][q >> 1][(q & 1) * 2 + 1] *= r1; } }
            asm volatile("" ::: "memory"); }
    }
    __device__ __forceinline__ void operator()(const f32x4 (&acc)[2][2][4][2], const Unit& u, int wr, int wc, int fr, int fq) const {
        const int row0 = u.pm * BM + wr * 64 + fr, col0 = u.pn * BM + wc * 32 + 8 * fq;
        const bf16_t* g2 = gd + ((size_t)(2 * 128 + u.pm) * 4 + u.pn) * 65536 + (size_t)((wr * 4 + wc) * 64 + fq * 16 + fr) * 8;
#pragma unroll
        for (int ai = 0; ai < 2; ++ai) {
            u32x4 gwv[4][2];
#pragma unroll
            for (int m = 0; m < 4; ++m)
#pragma unroll
                for (int bj = 0; bj < 2; ++bj) gwv[m][bj] = *(const u32x4*)(g2 + ((ai * 4 + m) * 2 + bj) * 4096);
#pragma unroll
            for (int m = 0; m < 4; ++m) { const size_t row = (size_t)(row0 + ai * HALF + m * 16);
#pragma unroll
                for (int bj = 0; bj < 2; ++bj) { const int col = col0 + bj * HALF; const u32x4 gw = gwv[m][bj];
                    f32x4 g0, g1;
                    g0[0] = sigmoid_f(bflo(gw.x)); g0[1] = sigmoid_f(bfhi(gw.x)); g0[2] = sigmoid_f(bflo(gw.y)); g0[3] = sigmoid_f(bfhi(gw.y));
                    g1[0] = sigmoid_f(bflo(gw.z)); g1[1] = sigmoid_f(bfhi(gw.z)); g1[2] = sigmoid_f(bflo(gw.w)); g1[3] = sigmoid_f(bfhi(gw.w));
                    const f32x4 v0 = acc[ai][bj][m][0] * g0, v1 = acc[ai][bj][m][1] * g1;
                    u32x4 w; w.x = cvt_pk_bf16(v0[0], v0[1]); w.y = cvt_pk_bf16(v0[2], v0[3]); w.z = cvt_pk_bf16(v1[0], v1[1]); w.w = cvt_pk_bf16(v1[2], v1[3]);
                    *(u32x4*)(mb + row * 1024 + col) = w; } }
            asm volatile("" ::: "memory"); }
    }
};
struct EpiWout {
    static constexpr bool PERM = true, HAS_MID = false; static constexpr int MID0 = 0, MID1 = 0;
    __device__ __forceinline__ void mid(f32x4 (&)[2][2][4][2], const Unit&, int, int, int, int, int) const {}
    const float* xf; const bf16_t* xh; bf16_t* v;
    __device__ __forceinline__ void operator()(const f32x4 (&acc)[2][2][4][2], const Unit& u, int wr, int wc, int fr, int fq) const {
        const int row0 = u.pm * BM + wr * 64 + fr, col0 = u.pn * BM + wc * 32 + 8 * fq;
#pragma unroll
        for (int ai = 0; ai < 2; ++ai) {
            f32x4 x0[4][2], x1[4][2];
#pragma unroll
            for (int m = 0; m < 4; ++m) { const size_t off = (size_t)(row0 + ai * HALF + m * 16) * 1024 + col0;
#pragma unroll
                for (int bj = 0; bj < 2; ++bj) {
                    if (xf) { x0[m][bj] = *(const f32x4*)(xf + off + bj * HALF); x1[m][bj] = *(const f32x4*)(xf + off + bj * HALF + 4); }
                    else { const u32x4 w = *(const u32x4*)(xh + off + bj * HALF); x0[m][bj] = (f32x4){bflo(w.x), bfhi(w.x), bflo(w.y), bfhi(w.y)}; x1[m][bj] = (f32x4){bflo(w.z), bfhi(w.z), bflo(w.w), bfhi(w.w)}; } } }
#pragma unroll
            for (int m = 0; m < 4; ++m) { const size_t off = (size_t)(row0 + ai * HALF + m * 16) * 1024 + col0;
#pragma unroll
                for (int bj = 0; bj < 2; ++bj) { const f32x4 v0 = x0[m][bj] * DN_ALPHA + acc[ai][bj][m][0], v1 = x1[m][bj] * DN_ALPHA + acc[ai][bj][m][1];
                    u32x4 w; w.x = cvt_pk_bf16(v0[0], v0[1]); w.y = cvt_pk_bf16(v0[2], v0[3]); w.z = cvt_pk_bf16(v1[0], v1[1]); w.w = cvt_pk_bf16(v1[2], v1[3]);
                    *(u32x4*)(v + off + bj * HALF) = w; } }
            asm volatile("" ::: "memory"); }
    }
};
struct EpiMoe1 {
    __device__ __forceinline__ void mid(f32x4 (&)[2][2][4][2], const Unit&, int, int, int, int, int) const {}
    static constexpr bool PERM = true, HAS_MID = false; static constexpr int MID0 = 0, MID1 = 0;
    bf16_t* act; const float* b1;
    __device__ __forceinline__ void operator()(const f32x4 (&acc)[2][2][4][2], const Unit& u, int wr, int wc, int fr, int fq) const {
        const int e = u.pn >> 3, tl = u.pn & 7;
        const int row0 = u.pm * BM + wr * 64 + fr, col0 = tl * 128 + wc * 32 + 8 * fq;
        const float* bp = b1 + (size_t)e * 2048 + col0;
        const f32x4 bg0 = *(const f32x4*)(bp), bg1 = *(const f32x4*)(bp + 4), bl0 = *(const f32x4*)(bp + 1024), bl1 = *(const f32x4*)(bp + 1028);
#pragma unroll
        for (int ai = 0; ai < 2; ++ai)
#pragma unroll
            for (int m = 0; m < 4; ++m) { bf16_t* rowp = act + (size_t)(row0 + ai * HALF + m * 16) * 1024 + col0;
                f32x4 o[2];
#pragma unroll
                for (int n = 0; n < 2; ++n) { const f32x4 gg = acc[ai][0][m][n] + (n ? bg1 : bg0), ll = acc[ai][1][m][n] + (n ? bl1 : bl0);
#pragma unroll
                    for (int q = 0; q < 4; ++q) { const float gv = fminf(gg[q], 7.0f), lv = fminf(fmaxf(ll[q], -7.0f), 7.0f);
                        o[n][q] = gv * sigmoid_f(1.702f * gv) * (lv + 1.0f); } }
                u32x4 w; w.x = cvt_pk_bf16(o[0][0], o[0][1]); w.y = cvt_pk_bf16(o[0][2], o[0][3]); w.z = cvt_pk_bf16(o[1][0], o[1][1]); w.w = cvt_pk_bf16(o[1][2], o[1][3]);
                *(u32x4*)(rowp) = w; }
    }
};
struct EpiMoe2 {
    __device__ __forceinline__ void mid(f32x4 (&)[2][2][4][2], const Unit&, int, int, int, int, int) const {}
    static constexpr bool PERM = true, HAS_MID = false; static constexpr int MID0 = 0, MID1 = 0;
    bf16_t* ys; const float* b2; const float* wbuf;
    __device__ __forceinline__ void operator()(const f32x4 (&acc)[2][2][4][2], const Unit& u, int wr, int wc, int fr, int fq) const {
        const int e = u.pn >> 2, tl = u.pn & 3;
        const int row0 = u.pm * BM + wr * 64 + fr, col0 = tl * 256 + wc * 32 + 8 * fq;
        const float* bp = b2 + (size_t)e * 1024 + col0;
        f32x4 bv[2][2];
#pragma unroll
        for (int bj = 0; bj < 2; ++bj) { bv[bj][0] = *(const f32x4*)(bp + bj * HALF); bv[bj][1] = *(const f32x4*)(bp + bj * HALF + 4); }
#pragma unroll
        for (int ai = 0; ai < 2; ++ai)
#pragma unroll
            for (int m = 0; m < 4; ++m) { const int row = row0 + ai * HALF + m * 16; const float ww = wbuf[row]; bf16_t* rowp = ys + (size_t)row * 1024 + col0;
#pragma unroll
                for (int bj = 0; bj < 2; ++bj) { const f32x4 v0 = (acc[ai][bj][m][0] + bv[bj][0]) * ww, v1 = (acc[ai][bj][m][1] + bv[bj][1]) * ww;
                    u32x4 w; w.x = cvt_pk_bf16(v0[0], v0[1]); w.y = cvt_pk_bf16(v0[2], v0[3]); w.z = cvt_pk_bf16(v1[0], v1[1]); w.w = cvt_pk_bf16(v1[2], v1[3]);
                    *(u32x4*)(rowp + bj * HALF) = w; } }
    }
};
struct EpiMoe1F8 {
    static constexpr bool PERM = true, HAS_MID = false; static constexpr int MID0 = 0, MID1 = 0;
    __device__ __forceinline__ void mid(f32x4 (&)[2][2][4][2], const Unit&, int, int, int, int, int) const {}
    unsigned char* act8; const float* b1;
    __device__ __forceinline__ void operator()(const f32x4 (&acc)[2][2][4][2], const Unit& u, int wr, int wc, int fr, int fq) const {
        const int e = u.pn >> 3, tl = u.pn & 7;
        const int row0 = u.pm * BM + wr * 64 + fr, col0 = tl * 128 + wc * 32 + 8 * fq;
        const float* bp = b1 + (size_t)e * 2048 + col0;
        const f32x4 bg0 = *(const f32x4*)(bp), bg1 = *(const f32x4*)(bp + 4), bl0 = *(const f32x4*)(bp + 1024), bl1 = *(const f32x4*)(bp + 1028);
        constexpr float sc = 1.0f / (F8_SX * F8_SW1);
#pragma unroll
        for (int ai = 0; ai < 2; ++ai)
#pragma unroll
            for (int m = 0; m < 4; ++m) { unsigned char* rowp = act8 + (size_t)(row0 + ai * HALF + m * 16) * 1024 + col0;
                f32x4 o[2];
#pragma unroll
                for (int n = 0; n < 2; ++n) { const f32x4 gg = acc[ai][0][m][n] * sc + (n ? bg1 : bg0), ll = acc[ai][1][m][n] * sc + (n ? bl1 : bl0);
#pragma unroll
                    for (int q = 0; q < 4; ++q) { const float gv = fminf(gg[q], 7.0f), lv = fminf(fmaxf(ll[q], -7.0f), 7.0f);
                        o[n][q] = gv * sigmoid_f(1.702f * gv) * (lv + 1.0f) * F8_SA; } }
                u32x2 w; w.x = pk_fp8x4(o[0][0], o[0][1], o[0][2], o[0][3]); w.y = pk_fp8x4(o[1][0], o[1][1], o[1][2], o[1][3]);
                *(u32x2*)(rowp) = w; }
    }
};
struct EpiMoe2F8 {
    static constexpr bool PERM = true, HAS_MID = false; static constexpr int MID0 = 0, MID1 = 0;
    __device__ __forceinline__ void mid(f32x4 (&)[2][2][4][2], const Unit&, int, int, int, int, int) const {}
    bf16_t* ys; const float* b2; const float* wbuf;
    __device__ __forceinline__ void operator()(const f32x4 (&acc)[2][2][4][2], const Unit& u, int wr, int wc, int fr, int fq) const {
        const int e = u.pn >> 2, tl = u.pn & 3;
        const int row0 = u.pm * BM + wr * 64 + fr, col0 = tl * 256 + wc * 32 + 8 * fq;
        const float* bp = b2 + (size_t)e * 1024 + col0;
        constexpr float sc = 1.0f / (F8_SA * F8_SW2);
        f32x4 bv[2][2]; float ww[2][4];
#pragma unroll
        for (int bj = 0; bj < 2; ++bj) { bv[bj][0] = *(const f32x4*)(bp + bj * HALF); bv[bj][1] = *(const f32x4*)(bp + bj * HALF + 4); }
#pragma unroll
        for (int ai = 0; ai < 2; ++ai)
#pragma unroll
            for (int m = 0; m < 4; ++m) ww[ai][m] = wbuf[row0 + ai * HALF + m * 16];
#pragma unroll
        for (int ai = 0; ai < 2; ++ai)
#pragma unroll
            for (int m = 0; m < 4; ++m) { const int row = row0 + ai * HALF + m * 16; const float w_ = ww[ai][m]; bf16_t* rowp = ys + (size_t)row * 1024 + col0;
#pragma unroll
                for (int bj = 0; bj < 2; ++bj) { const f32x4 v0 = (acc[ai][bj][m][0] * sc + bv[bj][0]) * w_, v1 = (acc[ai][bj][m][1] * sc + bv[bj][1]) * w_;
                    u32x4 w; w.x = cvt_pk_bf16(v0[0], v0[1]); w.y = cvt_pk_bf16(v0[2], v0[3]); w.z = cvt_pk_bf16(v1[0], v1[1]); w.w = cvt_pk_bf16(v1[2], v1[3]);
                    *(u32x4*)(rowp + bj * HALF) = w; } }
    }
};
struct MoeOrder {
    int nN, G, c, total; const LAS int* blk_e;
    __device__ __forceinline__ bool next(int i, Unit& u) const {
        const long L = (long)i * G + c; if (L >= total) return false;
        const int rb = (int)(L / nN), tl = (int)(L % nN); u.pm = rb; u.pn = blk_e[rb] * nN + tl; return true;
    }
    __device__ __forceinline__ void a_ready(const Unit&) const {}
    __device__ __forceinline__ void done(const Unit&) const {}
};
}
struct Args { const float* in[30]; float* out; unsigned char* ws; int ph_lo, ph_hi, li, pad; };
typedef const __attribute__((address_space(4))) Args* ArgsP;
enum { I_X = 0, I_WIN, I_LCW, I_LCB, I_LWA, I_LBA, I_LWX, I_LBX, I_LLAM, I_MIB, I_MFB, I_MNG, I_GCW, I_GAL, I_GDT, I_GNG, I_WBA, I_WBB, I_WBC, I_WOUT, I_LN1G, I_LN1B, I_RW, I_RB, I_W1, I_B1, I_W2, I_B2, I_LN2G, I_LN2B };

template <int MODE> __device__ __forceinline__ int col_map(int n) {
    if (MODE == 1) {
        if (n < 1024) return n;
        if (n < 2048) return 3840 + (n - 1024);
        if (n < 2304) return 1024 + (n - 2048);
        if (n < 2560) return 1280 + (n - 2304);
        if (n < 3072) return 1536 + (n - 2560);
        if (n < 3076) return 3584 + (n - 3072);
        if (n < 3080) return 3588 + (n - 3076);
        if (n < 3592) return 3840 + 1024 + (n - 3080);
        if (n < 4104) return 2048 + (n - 3592);
        if (n < 4616) return 2560 + (n - 4104);
        if (n < 5128) return 3072 + (n - 4616);
        if (n < 5136) return 3592 + (n - 5128);
        if (n < 5144) return 3600 + (n - 5136);
        if (n < 5656) return 3840 + 1536 + (n - 5144);
        return 3840 + 2048 + (n - 5656);
    } else if (MODE == 2) {
        if (n < 1024) return (n >> 7) * 256 + (n & 127);
        const int q = n - 1024; return (q >> 7) * 256 + 128 + (q & 127);
    }
    return n;
}
struct TrItem { const float* W; bf16_t* WT; int N, ldk, koff, mode, k0, n0; float f8s; };
__device__ __forceinline__ int col_map_rt(int mode, int n) { return mode == 1 ? col_map<1>(n) : (mode == 2 ? col_map<2>(n) : n); }
constexpr int IT_IN = 16 * 273, IT_BRA = 16 * 32, IT_BRB = 8 * 32, IT_BRC = 8 * 32, IT_OUT = 16 * 32, IT_W1 = 32 * 16 * 64, IT_W2 = 32 * 16 * 32;
constexpr int IT_G = 8 * 2 * 8;
constexpr int IT_LAYER = IT_IN + IT_BRA + IT_BRB + IT_BRC + IT_OUT + IT_W1 + IT_W2 + IT_G;
__device__ __forceinline__ TrItem tr_decode(ArgsP a, int it) {
    const int l = it / IT_LAYER; int r = it - l * IT_LAYER; unsigned char* wl = a->ws + WS_W + (size_t)l * WL_STRIDE; TrItem t;
    if (r < IT_IN) { t = TrItem{a->in[I_WIN] + (size_t)l * 1024 * DIN, (bf16_t*)(wl + WL_IN), DIN, 1024, 0, 1, 64 * (r / 273), 32 * (r % 273), 0.f}; return t; } r -= IT_IN;
    if (r < IT_BRA) { t = TrItem{a->in[I_WBA] + (size_t)l * 1024 * 1024, (bf16_t*)(wl + WL_BR), 1024, 2048, 0, 0, 64 * (r / 32), 32 * (r % 32), 0.f}; return t; } r -= IT_BRA;
    if (r < IT_BRB) { t = TrItem{a->in[I_WBB] + (size_t)l * 512 * 1024, (bf16_t*)(wl + WL_BR), 1024, 2048, 1024, 0, 64 * (r / 32), 32 * (r % 32), 0.f}; return t; } r -= IT_BRB;
    if (r < IT_BRC) { t = TrItem{a->in[I_WBC] + (size_t)l * 512 * 1024, (bf16_t*)(wl + WL_BR), 1024, 2048, 1536, 0, 64 * (r / 32), 32 * (r % 32), 0.f}; return t; } r -= IT_BRC;
    if (r < IT_OUT) { t = TrItem{a->in[I_WOUT] + (size_t)l * 1024 * 1024, (bf16_t*)(wl + WL_OUT), 1024, 1024, 0, 0, 64 * (r / 32), 32 * (r % 32), 0.f}; return t; } r -= IT_OUT;
    if (r < IT_W1) { const int e = r / 1024, q = r % 1024; t = TrItem{a->in[I_W1] + ((size_t)l * NE + e) * 1024 * 2048, (bf16_t*)(wl + WL_W1 + (size_t)e * 2048 * 1024), 2048, 1024, 0, 2, 64 * (q / 64), 32 * (q % 64), F8_SW1}; return t; } r -= IT_W1;
    if (r < IT_W2) { const int e = r / 512, q = r % 512; t = TrItem{a->in[I_W2] + ((size_t)l * NE + e) * 1024 * 1024, (bf16_t*)(wl + WL_W2 + (size_t)e * 1024 * 1024), 1024, 1024, 0, 0, 64 * (q / 32), 32 * (q % 32), F8_SW2}; return t; } r -= IT_W2;
    { const int h = r >> 4, gate = (r >> 3) & 1, q = r & 7;
      t = TrItem{a->in[gate ? I_LWX : I_LWA] + ((size_t)l * 8 + h) * 128 * 128, (bf16_t*)(wl + WL_G) + (size_t)(h * 256 + gate * 128) * 128, 128, 128, 0, 0, 64 * (q >> 2), 32 * (q & 3), 0.f}; return t; }
}
__device__ __forceinline__ void p0_convert(ArgsP a, LAS unsigned char* lds, int G) {
    int tid_ = threadIdx.x; asm volatile("" : "+v"(tid_)); const int tid = tid_, lane = tid & 63, wave = tid >> 6;
    LAS float* scr = (LAS float*)(lds + wave * 16384);
    const int gw = blockIdx.x * NWAVES + wave, NGW = G * NWAVES;
    float v[32];
#define TR_LOAD(t_) do { const int nsrc_ = (t_).n0 + (lane & 31); const float* p_ = (t_).W + (size_t)((t_).k0 + (lane >> 5)) * (t_).N + nsrc_; \
        _Pragma("unroll") for (int i = 0; i < 32; ++i) v[i] = (nsrc_ < (t_).N) ? p_[(size_t)(2 * i) * (t_).N] : 0.f; } while (0)
    TrItem cur = tr_decode(a, gw < 2 * IT_LAYER ? gw : 0);
    if (gw < 2 * IT_LAYER) TR_LOAD(cur);
    for (int it = gw; it < 2 * IT_LAYER; it += NGW) {
#pragma unroll
        for (int i = 0; i < 32; ++i) scr[(2 * i + (lane >> 5)) * 33 + (lane & 31)] = v[i];
        const TrItem me = cur;
        if (it + NGW < 2 * IT_LAYER) { cur = tr_decode(a, it + NGW); TR_LOAD(cur); }
        LDS_WAIT(); asm volatile("" ::: "memory");
        const int c = lane & 7;
#pragma unroll
        for (int j = 0; j < 4; ++j) { const int nl = (lane >> 3) + 8 * j, n = me.n0 + nl; const LAS float* s = scr + (8 * c) * 33 + nl;
            if (me.mode == 1) { const int vr_ = col_map<1>(n < me.N ? n : 0);
                if (n < me.N) { if (vr_ < NIN_BF) { u32x4 o; o.x = pk2(s[0 * 33], s[1 * 33]); o.y = pk2(s[2 * 33], s[3 * 33]); o.z = pk2(s[4 * 33], s[5 * 33]); o.w = pk2(s[6 * 33], s[7 * 33]);
                        *(u32x4*)(me.WT + (size_t)vr_ * 1024 + me.k0 + 8 * c) = o; }
                    else { const float f = F8_SWI; u32x2 o8; o8.x = pk_fp8x4(s[0 * 33] * f, s[1 * 33] * f, s[2 * 33] * f, s[3 * 33] * f); o8.y = pk_fp8x4(s[4 * 33] * f, s[5 * 33] * f, s[6 * 33] * f, s[7 * 33] * f);
                        *(u32x2*)((unsigned char*)me.WT + WL_IN8 + (size_t)(vr_ - NIN_BF) * 1024 + me.k0 + 8 * c) = o8; } } }
            else if (me.f8s != 0.f) { const float f = me.f8s; u32x2 o8; o8.x = pk_fp8x4(s[0 * 33] * f, s[1 * 33] * f, s[2 * 33] * f, s[3 * 33] * f); o8.y = pk_fp8x4(s[4 * 33] * f, s[5 * 33] * f, s[6 * 33] * f, s[7 * 33] * f);
                if (n < me.N) *(u32x2*)((unsigned char*)me.WT + (size_t)col_map_rt(me.mode, n) * me.ldk + me.koff + me.k0 + 8 * c) = o8; }
            else { u32x4 o; o.x = pk2(s[0 * 33], s[1 * 33]); o.y = pk2(s[2 * 33], s[3 * 33]); o.z = pk2(s[4 * 33], s[5 * 33]); o.w = pk2(s[6 * 33], s[7 * 33]);
                if (n < me.N) *(u32x4*)(me.WT + (size_t)col_map_rt(me.mode, n) * me.ldk + me.koff + me.k0 + 8 * c) = o; } }
        LDS_WAIT(); asm volatile("" ::: "memory");
    }
#undef TR_LOAD
    const size_t gt = (size_t)blockIdx.x * 512 + tid, GT = (size_t)G * 512;
    for (size_t i = gt; i < (size_t)2 * 232 * 128; i += GT) { const int l = (int)(i / (232 * 128)); const size_t q = i % (232 * 128);
        *(u32x4*)(a->ws + WS_W + (size_t)l * WL_STRIDE + WL_IN + ((size_t)3608 * 1024) * 2 + q * 16) = (u32x4){0u, 0u, 0u, 0u}; }
    for (size_t i = gt; i < (size_t)2 * 32 * 1024; i += GT) { const int l = (int)(i >> 15), k = (int)((i >> 5) & 1023), e = (int)(i & 31); const float w = a->in[I_RW][i];
        const unsigned hb = f2bf(w); const float lo = w - bf2f((unsigned short)hb); bf16_t* dst = (bf16_t*)(a->ws + WS_RWB) + (size_t)l * 2 * 32 * 1024;
        dst[(size_t)e * 1024 + k] = (bf16_t)hb; dst[(size_t)(32 + e) * 1024 + k] = (bf16_t)f2bf(lo); }
    const float* x = a->in[I_X]; bf16_t* xb = (bf16_t*)(a->ws + WS_XB);
    for (size_t i = gt; i < (size_t)T_ * D_ / 8; i += GT) { const f32x4 v0 = *(const f32x4*)(x + i * 8), v1 = *(const f32x4*)(x + i * 8 + 4);
        u32x4 w; w.x = pk2(v0[0], v0[1]); w.y = pk2(v0[2], v0[3]); w.z = pk2(v1[0], v1[1]); w.w = pk2(v1[2], v1[3]); *(u32x4*)(xb + i * 8) = w;
        u32x2 q8; q8.x = pk_fp8x4(v0[0] * F8_SX, v0[1] * F8_SX, v0[2] * F8_SX, v0[3] * F8_SX); q8.y = pk_fp8x4(v1[0] * F8_SX, v1[1] * F8_SX, v1[2] * F8_SX, v1[3] * F8_SX); *(u32x2*)(a->ws + WS_X2 + i * 8) = q8; }
}

constexpr int TB = 32;
__device__ __forceinline__ void lru_naive(ArgsP a, int l, int u, LAS unsigned char* lds, const bf16_t* proj, bf16_t* H) {
    int tid_ = threadIdx.x; asm volatile("" : "+v"(tid_)); const int tid = tid_, b = u >> 3, h = u & 7, c = tid >> 2, p = tid & 3, chg = h * 128 + c;
    const float* wa = a->in[I_LWA] + ((size_t)l * 8 + h) * 128 * 128; const float* wx = a->in[I_LWX] + ((size_t)l * 8 + h) * 128 * 128;
    float wra[32], wrx[32];
#pragma unroll
    for (int i = 0; i < 32; ++i) { wra[i] = wa[(p * 32 + i) * 128 + c]; wrx[i] = wx[(p * 32 + i) * 128 + c]; }
    const float ba = a->in[I_LBA][l * 1024 + chg], bx = a->in[I_LBX][l * 1024 + chg];
    const float sp = softplus_f(-a->in[I_LLAM][l * 1024 + chg]);
    const float* cw = a->in[I_LCW] + (size_t)l * 4 * 1024 + chg; const float cw0 = cw[0], cw1 = cw[1024], cw2 = cw[2048], cw3 = cw[3072], cb = a->in[I_LCB][l * 1024 + chg];
    LAS bf16_t* xs = (LAS bf16_t*)(lds);
    LAS bf16_t* ys = (LAS bf16_t*)(lds + 8192);
    LAS float* xa_s = (LAS float*)(lds + 16384);
    const int srow = tid >> 4, scol = (tid & 15) * 8;
    const size_t tok0 = (size_t)b * SEQ_;
    u32x4 px = *(const u32x4*)(proj + (tok0 + srow) * NPROJ + PC_LRUX + h * 128 + scol);
    u32x4 py = *(const u32x4*)(proj + (tok0 + srow) * NPROJ + PC_LRUY + h * 128 + scol);
    float hs = 0.f, x1 = 0.f, x2 = 0.f, x3 = 0.f;
    for (int blk = 0; blk < SEQ_ / TB; ++blk) {
        __syncthreads();
        *(LAS u32x4*)(xs + srow * 128 + scol) = px; *(LAS u32x4*)(ys + srow * 128 + scol) = py;
        __syncthreads();
        if (blk + 1 < SEQ_ / TB) { const size_t tk = tok0 + (size_t)(blk + 1) * TB + srow;
            px = *(const u32x4*)(proj + tk * NPROJ + PC_LRUX + h * 128 + scol); py = *(const u32x4*)(proj + tk * NPROJ + PC_LRUY + h * 128 + scol); }
        for (int s = 0; s < TB; ++s) {
            const float xraw = bf2f(xs[s * 128 + c]);
            const float xa = cw0 * x3 + cw1 * x2 + cw2 * x1 + cw3 * xraw + cb;
            x3 = x2; x2 = x1; x1 = xraw;
            LAS float* xb_ = xa_s + (s & 1) * 128;
            if (p == 0) xb_[c] = xa;
            __syncthreads();
            float sa = 0.f, sx = 0.f;
#pragma unroll
            for (int i4 = 0; i4 < 8; ++i4) { const f32x4 xv = *(const LAS f32x4*)(xb_ + p * 32 + i4 * 4);
#pragma unroll
                for (int q = 0; q < 4; ++q) { sa += xv[q] * wra[i4 * 4 + q]; sx += xv[q] * wrx[i4 * 4 + q]; } }
            sa += __shfl_xor(sa, 1); sa += __shfl_xor(sa, 2); sx += __shfl_xor(sx, 1); sx += __shfl_xor(sx, 2);
            const float r = 1.f / (1.f + __expf(-(sa + ba))), ig = 1.f / (1.f + __expf(-(sx + bx)));
            const float log_a = -8.0f * r * sp, av = __expf(log_a), mult = sqrtf(-expm1f(2.0f * log_a));
            hs = av * hs + mult * (ig * xa);
            if (p == 0) { const float y = bf2f(ys[s * 128 + c]);
                H[(tok0 + (size_t)blk * TB + s) * 2048 + chg] = (bf16_t)f2bf(hs * gelu_tanh_f(y)); }
        }
    }
}
__device__ __forceinline__ void mlstm_naive(ArgsP a, int l, int u, LAS unsigned char* lds, const bf16_t* proj, const float* gsm, bf16_t* H) {
    int tid_ = threadIdx.x; asm volatile("" : "+v"(tid_)); const int tid = tid_, lane = tid & 63, wave = tid >> 6, b = u >> 2, hd = u & 3, j = tid & 127;
    LAS float* qs = (LAS float*)(lds);
    LAS float* ks = (LAS float*)(lds + 8192);
    LAS float* vs = (LAS float*)(lds + 16384);
    LAS float* os = (LAS float*)(lds + 32768);
    LAS float* gi = (LAS float*)(lds + 49152);
    LAS float* gf = (LAS float*)(lds + 49152 + 128);
    LAS float* red = (LAS float*)(lds + 49152 + 256);
    const float ib = a->in[I_MIB][l * 4 + hd], fb = a->in[I_MFB][l * 4 + hd], gn = a->in[I_MNG][(size_t)l * 512 + hd * 128 + j];
    const size_t tok0 = (size_t)b * SEQ_;
    const int qa_row = (tid & 255) >> 3, qa_c8 = (tid & 7) * 8; const int qa_col = (tid < 256 ? PC_MLQ : PC_MLK) + hd * 64 + qa_c8;
    const int vb_row = tid >> 4, vb_c8 = (tid & 15) * 8;
    u32x4 pa, pb, pc; float pg = 0.f;
#define ML_ISSUE(blk_) do { const size_t t0 = tok0 + (size_t)(blk_) * TB; \
        pa = *(const u32x4*)(proj + (t0 + qa_row) * NPROJ + qa_col); \
        pb = *(const u32x4*)(proj + (t0 + vb_row) * NPROJ + PC_MLV + hd * 128 + vb_c8); \
        pc = *(const u32x4*)(proj + (t0 + vb_row) * NPROJ + PC_MLO + hd * 128 + vb_c8); \
        if (tid < 64) pg = gsm[(t0 + (tid & 31)) * 32 + (tid < 32 ? 0 : 4) + hd]; } while (0)
    ML_ISSUE(0);
    float C[64], n[64];
#pragma unroll
    for (int r = 0; r < 64; ++r) { C[r] = 0.f; n[r] = 0.f; }
    for (int blk = 0; blk < SEQ_ / TB; ++blk) {
        __syncthreads();
        { LAS float* d = (tid < 256 ? qs : ks) + qa_row * 64 + qa_c8;
          *(LAS f32x4*)(d) = (f32x4){bflo(pa.x), bfhi(pa.x), bflo(pa.y), bfhi(pa.y)}; *(LAS f32x4*)(d + 4) = (f32x4){bflo(pa.z), bfhi(pa.z), bflo(pa.w), bfhi(pa.w)};
          LAS float* dv = vs + vb_row * 128 + vb_c8;
          *(LAS f32x4*)(dv) = (f32x4){bflo(pb.x), bfhi(pb.x), bflo(pb.y), bfhi(pb.y)}; *(LAS f32x4*)(dv + 4) = (f32x4){bflo(pb.z), bfhi(pb.z), bflo(pb.w), bfhi(pb.w)};
          LAS float* dz = os + vb_row * 128 + vb_c8;
          *(LAS f32x4*)(dz) = (f32x4){bflo(pc.x), bfhi(pc.x), bflo(pc.y), bfhi(pc.y)}; *(LAS f32x4*)(dz + 4) = (f32x4){bflo(pc.z), bfhi(pc.z), bflo(pc.w), bfhi(pc.w)};
          if (tid < 32) gi[tid] = pg; else if (tid < 64) gf[tid - 32] = pg; }
        __syncthreads();
        if (blk + 1 < SEQ_ / TB) ML_ISSUE(blk + 1);
        for (int s = 0; s < TB; ++s) {
            float hj = 0.f;
            if (tid < 128) {
                const float f = 1.f / (1.f + __expf(-(gf[s] + fb))), ie = __expf(gi[s] + ib);
                const float vj = vs[s * 128 + j];
                float num = 0.f, den = 0.f;
#pragma unroll
                for (int r4 = 0; r4 < 16; ++r4) { const f32x4 kk = *(const LAS f32x4*)(ks + s * 64 + r4 * 4), qq = *(const LAS f32x4*)(qs + s * 64 + r4 * 4);
#pragma unroll
                    for (int q = 0; q < 4; ++q) { const int r = r4 * 4 + q; const float ik = ie * kk[q];
                        C[r] = f * C[r] + ik * vj; n[r] = f * n[r] + ik; num += qq[q] * C[r]; den += qq[q] * n[r]; } }
                num *= 0.125f; den *= 0.125f;
                hj = num / fmaxf(fabsf(den), 1.0f);
                const float ss = wave_sum(hj * hj);
                if (lane == 0) red[(s & 1) * 2 + wave] = ss;
            }
            __syncthreads();
            if (tid < 128) {
                const float tot = red[(s & 1) * 2] + red[(s & 1) * 2 + 1];
                const float o = hj * rsqrtf(tot * (1.0f / 128.0f) + RMS_EPS) * gn * sigmoid_f(os[s * 128 + j]);
                H[(tok0 + (size_t)blk * TB + s) * 2048 + 1024 + hd * 128 + j] = (bf16_t)f2bf(o);
            }
        }
    }
}
__device__ __forceinline__ void gdn_naive(ArgsP a, int l, int u, LAS unsigned char* lds, const bf16_t* proj, const float* gsm, bf16_t* H) {
    int tid_ = threadIdx.x; asm volatile("" : "+v"(tid_)); const int tid = tid_, lane = tid & 63, b = u >> 3, hd = u & 7;
    LAS float* rq = (LAS float*)(lds);
    LAS float* rk = (LAS float*)(lds + 9216);
    LAS float* rv = (LAS float*)(lds + 18432);
    LAS float* zs = (LAS float*)(lds + 27648);
    LAS float* ga = (LAS float*)(lds + 27648 + 8192);
    LAS float* gb = ga + TB;
    const float* cw = a->in[I_GCW] + (size_t)l * 4 * 1536;
    float cq[4], ck[4], cv[4];
#pragma unroll
    for (int i = 0; i < 4; ++i) { cq[i] = cw[i * 1536 + hd * 64 + lane]; ck[i] = cw[i * 1536 + 512 + hd * 64 + lane]; cv[i] = cw[i * 1536 + 1024 + hd * 64 + lane]; }
    const float nexpA = -__expf(a->in[I_GAL][l * 8 + hd]), dtb = a->in[I_GDT][l * 8 + hd], gn = a->in[I_GNG][l * 64 + lane];
    const size_t tok0 = (size_t)b * SEQ_;
    u32x4 pp[3]; float pg = 0.f;
#define GD_ISSUE(blk_) do { const int tl0 = (blk_) * TB; \
        _Pragma("unroll") for (int i = 0; i < 3; ++i) { const int pid = tid + 512 * i; pp[i] = (u32x4){0u, 0u, 0u, 0u}; \
            if (pid < 840) { const int arr = pid / 280, rem = pid % 280, row = rem >> 3, c8 = (rem & 7) * 8; const int tl = tl0 - 3 + row; \
                if (tl >= 0) pp[i] = *(const u32x4*)(proj + (tok0 + tl) * NPROJ + (arr == 0 ? PC_GDQ : (arr == 1 ? PC_GDK : PC_GDV)) + hd * 64 + c8); } \
            else if (pid < 1096) { const int zp = pid - 840, row = zp >> 3, c8 = (zp & 7) * 8; \
                pp[i] = *(const u32x4*)(proj + (tok0 + tl0 + row) * NPROJ + PC_GDZ + hd * 64 + c8); } } \
        if (tid < 64) pg = gsm[(tok0 + tl0 + (tid & 31)) * 32 + (tid < 32 ? 8 : 16) + hd]; } while (0)
    GD_ISSUE(0);
    float S[64];
#pragma unroll
    for (int i = 0; i < 64; ++i) S[i] = 0.f;
    for (int blk = 0; blk < SEQ_ / TB; ++blk) {
        __syncthreads();
#pragma unroll
        for (int i = 0; i < 3; ++i) { const int pid = tid + 512 * i; LAS float* d = nullptr;
            if (pid < 840) { const int arr = pid / 280, rem = pid % 280, row = rem >> 3, c8 = (rem & 7) * 8; d = (arr == 0 ? rq : (arr == 1 ? rk : rv)) + row * 64 + c8; }
            else if (pid < 1096) { const int zp = pid - 840, row = zp >> 3, c8 = (zp & 7) * 8; d = zs + row * 64 + c8; }
            if (pid < 1096) { const u32x4 w = pp[i];
                *(LAS f32x4*)(d) = (f32x4){bflo(w.x), bfhi(w.x), bflo(w.y), bfhi(w.y)}; *(LAS f32x4*)(d + 4) = (f32x4){bflo(w.z), bfhi(w.z), bflo(w.w), bfhi(w.w)}; } }
        if (tid < 32) ga[tid] = pg; else if (tid < 64) gb[tid - 32] = pg;
        __syncthreads();
        if (blk + 1 < SEQ_ / TB) GD_ISSUE(blk + 1);
        if (tid < 64) {
            for (int s = 0; s < TB; ++s) {
                float qv = 0.f, kv = 0.f, vv = 0.f;
#pragma unroll
                for (int i = 0; i < 4; ++i) { qv += cq[i] * rq[(s + i) * 64 + lane]; kv += ck[i] * rk[(s + i) * 64 + lane]; vv += cv[i] * rv[(s + i) * 64 + lane]; }
                qv = silu_f(qv); kv = silu_f(kv); vv = silu_f(vv);
                const float qn = qv * rsqrtf(wave_sum(qv * qv) + RMS_EPS) * 0.125f;
                const float kn = kv * rsqrtf(wave_sum(kv * kv) + RMS_EPS);
                const float g = nexpA * softplus_f(ga[s] + dtb), alpha = __expf(g), beta = 1.f / (1.f + __expf(-gb[s]));
                float kS = 0.f;
#pragma unroll
                for (int i = 0; i < 64; ++i) kS += __builtin_bit_cast(float, __builtin_amdgcn_readlane(__builtin_bit_cast(int, kn), i)) * S[i];
                const float dl = beta * (vv - alpha * kS);
                float o = 0.f;
#pragma unroll
                for (int i = 0; i < 64; ++i) { const float ki = __builtin_bit_cast(float, __builtin_amdgcn_readlane(__builtin_bit_cast(int, kn), i));
                    const float qi = __builtin_bit_cast(float, __builtin_amdgcn_readlane(__builtin_bit_cast(int, qn), i));
                    S[i] = alpha * S[i] + ki * dl; o += qi * S[i]; }
                const float ms = wave_sum(o * o) * (1.0f / 64.0f);
                const float out = o * rsqrtf(ms + RMS_EPS) * gn * silu_f(zs[s * 64 + lane]);
                H[(tok0 + (size_t)blk * TB + s) * 2048 + 1536 + hd * 64 + lane] = (bf16_t)f2bf(out);
            }
        }
    }
}

constexpr int RW_PITCH = 1032;
__device__ __forceinline__ unsigned f2key(float v, int e) { unsigned u = __builtin_bit_cast(unsigned, v); u = (u & 0x80000000u) ? ~u : (u | 0x80000000u); return (u & ~31u) | (unsigned)(31 - e); }
__device__ __forceinline__ float key2f(unsigned k) { const unsigned u = k & ~31u; return __builtin_bit_cast(float, (u & 0x80000000u) ? (u ^ 0x80000000u) : ~u); }
__device__ __forceinline__ void p5_ln1_router(ArgsP a, int l, LAS unsigned char* lds, int G) {
    int tid_ = threadIdx.x; asm volatile("" : "+v"(tid_)); const int tid = tid_, lane = tid & 63, wave = tid >> 6, tk = lane & 15, g = lane >> 4;
    LAS bf16_t* whi = (LAS bf16_t*)lds;
    LAS bf16_t* wlo = (LAS bf16_t*)(lds + 32 * RW_PITCH * 2);
    LAS int* hist = (LAS int*)(lds + 2 * 32 * RW_PITCH * 2);
    { const bf16_t* src = (const bf16_t*)(a->ws + WS_RWB) + (size_t)l * 2 * 32 * 1024;
      for (int p = tid; p < 2 * 32 * 128; p += 512) { const int arr = p >> 12, e = (p >> 7) & 31, c8 = (p & 127) * 8;
          *(LAS u32x4*)((arr ? wlo : whi) + e * RW_PITCH + c8) = *(const u32x4*)(src + ((size_t)arr * 32 + e) * 1024 + c8); } }
    const bf16_t* v = (const bf16_t*)(a->ws + WS_V); bf16_t* x1b = (bf16_t*)(a->ws + WS_X1B); unsigned char* x18 = a->ws + WS_X1;
    int* tke = (int*)(a->ws + WS_TKE); float* tkw = (float*)(a->ws + WS_TKW); int* ghist = (int*)(a->ws + WS_HIST);
    const float* lng = a->in[I_LN1G] + l * 1024; const float* lnb = a->in[I_LN1B] + l * 1024;
    const float rb0 = a->in[I_RB][l * 32 + tk], rb1 = a->in[I_RB][l * 32 + 16 + tk];
    for (int ch = blockIdx.x; ch < NCHUNK; ch += G) {
        __syncthreads();
        if (tid < 32) hist[tid] = 0;
        __syncthreads();
        const size_t t = (size_t)ch * CHTOK + wave * 16 + tk;
        const bf16_t* vr = v + t * 1024 + 8 * g;
        float s = 0.f, s2 = 0.f;
#pragma unroll 8
        for (int ks = 0; ks < 32; ++ks) { const u32x4 pw = *(const u32x4*)(vr + 32 * ks); const f32x4 p0 = (f32x4){bflo(pw.x), bfhi(pw.x), bflo(pw.y), bfhi(pw.y)}, p1 = (f32x4){bflo(pw.z), bfhi(pw.z), bflo(pw.w), bfhi(pw.w)};
            s += (p0[0] + p0[1]) + (p0[2] + p0[3]) + (p1[0] + p1[1]) + (p1[2] + p1[3]);
            s2 += (p0[0] * p0[0] + p0[1] * p0[1]) + (p0[2] * p0[2] + p0[3] * p0[3]) + (p1[0] * p1[0] + p1[1] * p1[1]) + (p1[2] * p1[2] + p1[3] * p1[3]); }
        s += __shfl_xor(s, 16); s += __shfl_xor(s, 32); s2 += __shfl_xor(s2, 16); s2 += __shfl_xor(s2, 32);
        const float mean = s * (1.0f / 1024.0f); const float rstd = rsqrtf(fmaxf(s2 * (1.0f / 1024.0f) - mean * mean, 0.f) + LN_EPS);
        f32x4 acc0 = (f32x4){0.f, 0.f, 0.f, 0.f}, acc1 = (f32x4){0.f, 0.f, 0.f, 0.f};
#pragma unroll 2
        for (int ks = 0; ks < 32; ++ks) { const int k0 = 32 * ks + 8 * g;
            const u32x4 pw = *(const u32x4*)(vr + 32 * ks); const f32x4 p0 = (f32x4){bflo(pw.x), bfhi(pw.x), bflo(pw.y), bfhi(pw.y)}, p1 = (f32x4){bflo(pw.z), bfhi(pw.z), bflo(pw.w), bfhi(pw.w)};
            const f32x4 g0 = *(const f32x4*)(lng + k0), g1 = *(const f32x4*)(lng + k0 + 4), b0 = *(const f32x4*)(lnb + k0), b1 = *(const f32x4*)(lnb + k0 + 4);
            const f32x4 y0 = (p0 - mean) * rstd * g0 + b0, y1 = (p1 - mean) * rstd * g1 + b1;
            u32x4 hw; hw.x = pg8::cvt_pk_bf16(y0[0], y0[1]); hw.y = pg8::cvt_pk_bf16(y0[2], y0[3]); hw.z = pg8::cvt_pk_bf16(y1[0], y1[1]); hw.w = pg8::cvt_pk_bf16(y1[2], y1[3]);
            *(u32x4*)(x1b + t * 1024 + k0) = hw;
            { u32x2 q8; q8.x = pk_fp8x4(y0[0] * F8_SX, y0[1] * F8_SX, y0[2] * F8_SX, y0[3] * F8_SX); q8.y = pk_fp8x4(y1[0] * F8_SX, y1[1] * F8_SX, y1[2] * F8_SX, y1[3] * F8_SX); *(u32x2*)(x18 + t * 1024 + k0) = q8; }
            u32x4 lw; lw.x = pg8::cvt_pk_bf16(y0[0] - bflo(hw.x), y0[1] - bfhi(hw.x)); lw.y = pg8::cvt_pk_bf16(y0[2] - bflo(hw.y), y0[3] - bfhi(hw.y));
            lw.z = pg8::cvt_pk_bf16(y1[0] - bflo(hw.z), y1[1] - bfhi(hw.z)); lw.w = pg8::cvt_pk_bf16(y1[2] - bflo(hw.w), y1[3] - bfhi(hw.w));
            const bf16x8 ah = __builtin_bit_cast(bf16x8, hw), al = __builtin_bit_cast(bf16x8, lw);
            const bf16x8 wh0 = *(const LAS bf16x8*)(whi + tk * RW_PITCH + k0), wh1 = *(const LAS bf16x8*)(whi + (16 + tk) * RW_PITCH + k0);
            const bf16x8 wl0 = *(const LAS bf16x8*)(wlo + tk * RW_PITCH + k0), wl1 = *(const LAS bf16x8*)(wlo + (16 + tk) * RW_PITCH + k0);
            acc0 = __builtin_amdgcn_mfma_f32_16x16x32_bf16(ah, wh0, acc0, 0, 0, 0); acc1 = __builtin_amdgcn_mfma_f32_16x16x32_bf16(ah, wh1, acc1, 0, 0, 0);
            acc0 = __builtin_amdgcn_mfma_f32_16x16x32_bf16(ah, wl0, acc0, 0, 0, 0); acc1 = __builtin_amdgcn_mfma_f32_16x16x32_bf16(ah, wl1, acc1, 0, 0, 0);
            acc0 = __builtin_amdgcn_mfma_f32_16x16x32_bf16(al, wh0, acc0, 0, 0, 0); acc1 = __builtin_amdgcn_mfma_f32_16x16x32_bf16(al, wh1, acc1, 0, 0, 0); }
#pragma unroll
        for (int r = 0; r < 4; ++r) {
            unsigned k0 = f2key(acc0[r] + rb0, tk), k1 = f2key(acc1[r] + rb1, 16 + tk);
            float tv[4]; int te[4];
#pragma unroll
            for (int k = 0; k < 4; ++k) { unsigned m = k0 > k1 ? k0 : k1;
#pragma unroll
                for (int o = 1; o < 16; o <<= 1) { const unsigned q = (unsigned)__shfl_xor((int)m, o); m = q > m ? q : m; }
                const int e = 31 - (int)(m & 31u); tv[k] = key2f(m); te[k] = e;
                if (e == tk) k0 = 0u; if (e == 16 + tk) k1 = 0u; }
            const float e1 = __expf(tv[1] - tv[0]), e2 = __expf(tv[2] - tv[0]), e3 = __expf(tv[3] - tv[0]); const float inv = 1.0f / (1.0f + e1 + e2 + e3);
            if (tk < 4) { const size_t tt = (size_t)ch * CHTOK + wave * 16 + 4 * g + r;
                const int ei = tk == 0 ? te[0] : (tk == 1 ? te[1] : (tk == 2 ? te[2] : te[3]));
                const float wi = (tk == 0 ? 1.0f : (tk == 1 ? e1 : (tk == 2 ? e2 : e3))) * inv;
                tke[tt * 4 + tk] = ei; tkw[tt * 4 + tk] = wi; __hip_atomic_fetch_add(&hist[ei], 1, __ATOMIC_RELAXED, __HIP_MEMORY_SCOPE_WORKGROUP); }
        }
        __syncthreads();
        if (tid < 32) ghist[ch * 32 + tid] = hist[tid];
    }
}

__device__ __forceinline__ void p6_slots(ArgsP a, LAS unsigned char* lds, int G) {
    int tid_ = threadIdx.x; asm volatile("" : "+v"(tid_)); const int tid = tid_, lane = tid & 63, wave = tid >> 6;
    LAS int* hs = (LAS int*)lds;
    LAS int* cnt = (LAS int*)(lds + 32768);
    LAS int* bst = (LAS int*)(lds + 32768 + 256);
    LAS int* te = (LAS int*)(lds + 36864);
    LAS int* sl = (LAS int*)(lds + 36864 + 2048);
    const int* ghist = (const int*)(a->ws + WS_HIST);
    for (int i = tid; i < NCHUNK * 32; i += 512) hs[i] = ghist[i];
    __syncthreads();
    if (tid < 32) { int run = 0; for (int ch = 0; ch < NCHUNK; ++ch) { const int c = hs[ch * 32 + tid]; hs[ch * 32 + tid] = run; run += c; } cnt[tid] = run; }
    __syncthreads();
    if (tid == 0) { int bs = 0; for (int e = 0; e < 32; ++e) { bst[e] = bs; bs += (cnt[e] + 255) >> 8; } bst[32] = bs; }
    __syncthreads();
    if (blockIdx.x == 0 && tid <= 32) ((int*)(a->ws + WS_META))[tid] = bst[tid];
    const int* tke = (const int*)(a->ws + WS_TKE); const float* tkw = (const float*)(a->ws + WS_TKW);
    int* slot = (int*)(a->ws + WS_SLOT); float* wbuf = (float*)(a->ws + WS_WBUF);
    int* tokb = (int*)(a->ws + WS_TOKB);
    for (int ch = blockIdx.x; ch < NCHUNK; ch += G) {
        __syncthreads();
        te[tid] = tke[(size_t)ch * 512 + tid];
        __syncthreads();
        if (tid < 32) { int rank = bst[tid] * 256 + hs[ch * 32 + tid]; for (int p = 0; p < 512; ++p) if (te[p] == tid) sl[p] = rank++; }
        __syncthreads();
        { const size_t pi = (size_t)ch * 512 + tid; const int s_ = sl[tid]; slot[pi] = s_; wbuf[s_] = tkw[pi]; tokb[s_] = ch * CHTOK + (tid >> 2); }
    }
    for (int e = blockIdx.x; e < 32; e += G) for (int s_ = bst[e] * 256 + cnt[e] + tid; s_ < bst[e + 1] * 256; s_ += 512) tokb[s_] = T_;
}
__device__ __forceinline__ int moe_table(ArgsP a, LAS unsigned char* lds) {
    int tid_ = threadIdx.x; asm volatile("" : "+v"(tid_)); const int tid = tid_;
    LAS int* bst = (LAS int*)(lds + MISC_OFF);
    LAS int* blk_e = (LAS int*)(lds + MISC_OFF + 256);
    __syncthreads();
    if (tid <= 32) bst[tid] = ((const int*)(a->ws + WS_META))[tid];
    __syncthreads();
    const int nb = bst[32];
    for (int rb = tid; rb < nb; rb += 512) { int e = 0; while (e < 31 && rb >= bst[e + 1]) ++e; blk_e[rb] = e; }
    __syncthreads();
    return nb;
}

__device__ __forceinline__ void p9_combine_ln2(ArgsP a, int l, float* xout, int G) {
    int tid_ = threadIdx.x; asm volatile("" : "+v"(tid_)); const int tid = tid_, lane = tid & 63, wave = tid >> 6;
    const bf16_t* x1b = (const bf16_t*)(a->ws + WS_X1B); const int* slot = (const int*)(a->ws + WS_SLOT);
    const bf16_t* ys = (const bf16_t*)(a->ws + WS_OV + OV_YS); bf16_t* xb = (bf16_t*)(a->ws + WS_XB); unsigned char* x8 = a->ws + WS_X2;
    float gg[2][8], bb[2][8];
#pragma unroll
    for (int j = 0; j < 2; ++j) { const float* gp = a->in[I_LN2G] + l * 1024 + 8 * lane + 512 * j; const float* bp = a->in[I_LN2B] + l * 1024 + 8 * lane + 512 * j;
        const f32x4 g0 = *(const f32x4*)gp, g1 = *(const f32x4*)(gp + 4), b0 = *(const f32x4*)bp, b1 = *(const f32x4*)(bp + 4);
#pragma unroll
        for (int q = 0; q < 4; ++q) { gg[j][q] = g0[q]; gg[j][4 + q] = g1[q]; bb[j][q] = b0[q]; bb[j][4 + q] = b1[q]; } }
    for (int blk = blockIdx.x * NWAVES + wave; blk < T_ / 16; blk += G * NWAVES) {
        const int sv = slot[(size_t)blk * 64 + lane];
        for (int k = 0; k < 16; k += 4) {
            u32x4 xw[4][2], yw[4][4][2];
#pragma unroll
            for (int q = 0; q < 4; ++q) { const size_t t = (size_t)blk * 16 + k + q;
#pragma unroll
                for (int j = 0; j < 2; ++j) xw[q][j] = *(const u32x4*)(x1b + t * 1024 + 8 * lane + 512 * j);
#pragma unroll
                for (int kk = 0; kk < 4; ++kk) { const size_t sr = (size_t)__builtin_amdgcn_readfirstlane(__shfl(sv, (k + q) * 4 + kk));
#pragma unroll
                    for (int j = 0; j < 2; ++j) yw[q][kk][j] = *(const u32x4*)(ys + sr * 1024 + 8 * lane + 512 * j); } }
#pragma unroll
            for (int q = 0; q < 4; ++q) { const size_t t = (size_t)blk * 16 + k + q;
                float xv[2][8]; float s = 0.f;
#pragma unroll
                for (int j = 0; j < 2; ++j) { const unsigned xx[4] = {xw[q][j].x, xw[q][j].y, xw[q][j].z, xw[q][j].w};
#pragma unroll
                    for (int p2 = 0; p2 < 4; ++p2) { xv[j][2 * p2] = bflo(xx[p2]) * DN_ALPHA; xv[j][2 * p2 + 1] = bfhi(xx[p2]) * DN_ALPHA; }
#pragma unroll
                    for (int kk = 0; kk < 4; ++kk) { const unsigned yy[4] = {yw[q][kk][j].x, yw[q][kk][j].y, yw[q][kk][j].z, yw[q][kk][j].w};
#pragma unroll
                        for (int p2 = 0; p2 < 4; ++p2) { xv[j][2 * p2] += bflo(yy[p2]); xv[j][2 * p2 + 1] += bfhi(yy[p2]); } }
#pragma unroll
                    for (int e = 0; e < 8; ++e) s += xv[j][e]; }
                const float mean = wave_sum(s) * (1.0f / 1024.0f); float s2 = 0.f;
#pragma unroll
                for (int j = 0; j < 2; ++j)
#pragma unroll
                    for (int e = 0; e < 8; ++e) { xv[j][e] -= mean; s2 += xv[j][e] * xv[j][e]; }
                const float rstd = rsqrtf(wave_sum(s2) * (1.0f / 1024.0f) + LN_EPS);
#pragma unroll
                for (int j = 0; j < 2; ++j) {
#pragma unroll
                    for (int e = 0; e < 8; ++e) xv[j][e] = xv[j][e] * rstd * gg[j][e] + bb[j][e];
                    const size_t o = t * 1024 + 8 * lane + 512 * j;
                    if (xout) { *(f32x4*)(xout + o) = (f32x4){xv[j][0], xv[j][1], xv[j][2], xv[j][3]}; *(f32x4*)(xout + o + 4) = (f32x4){xv[j][4], xv[j][5], xv[j][6], xv[j][7]}; }
                    u32x4 w; w.x = pk2(xv[j][0], xv[j][1]); w.y = pk2(xv[j][2], xv[j][3]); w.z = pk2(xv[j][4], xv[j][5]); w.w = pk2(xv[j][6], xv[j][7]); *(u32x4*)(xb + o) = w;
                    u32x2 q8; q8.x = pk_fp8x4(xv[j][0] * F8_SX, xv[j][1] * F8_SX, xv[j][2] * F8_SX, xv[j][3] * F8_SX); q8.y = pk_fp8x4(xv[j][4] * F8_SX, xv[j][5] * F8_SX, xv[j][6] * F8_SX, xv[j][7] * F8_SX);
                    *(u32x2*)(x8 + o) = q8; } }
        }
    }
}
typedef float f32x4_t __attribute__((ext_vector_type(4)));
constexpr size_t MX_LRU_PH = 0, MX_LRU_CARRY = 4 * MiB;
template <int MODE> __device__ __forceinline__ void lru_fast(ArgsP a, int l, int b, int h, int c_lo, int c_hi, LAS unsigned char* lds, const bf16_t* proj, bf16_t* H, unsigned char* mxs) {
    int tid_ = threadIdx.x; asm volatile("" : "+v"(tid_)); const int tid = tid_, lane = tid & 63, wave = __builtin_amdgcn_readfirstlane(tid >> 6), fr = lane & 15, g = lane >> 4;
    LAS bf16_t* xa = (LAS bf16_t*)(lds);
    LAS bf16_t* ysb = (LAS bf16_t*)(lds + 17408);
    LAS bf16_t* outb = (LAS bf16_t*)(lds + 33792);
    LAS bf16_t* outc = (LAS bf16_t*)(lds + 50176);
    bf16_t* HL = (bf16_t*)(a->ws + WS_MB); bf16_t* CA = (bf16_t*)(a->ws + WS_X1B);
    float* PH = (float*)(mxs + MX_LRU_PH); const float* carry = (const float*)(mxs + MX_LRU_CARRY);
    const int ch = 16 * wave + fr, chg = h * 128 + ch;
    const bf16_t* wg = (const bf16_t*)(a->ws + WS_W + (size_t)l * WL_STRIDE + WL_G) + (size_t)h * 256 * 128;
    bf16x8 bra[4], brx[4];
#pragma unroll
    for (int ks = 0; ks < 4; ++ks) { bra[ks] = *(const bf16x8*)(wg + (size_t)(ch) * 128 + 32 * ks + 8 * g); brx[ks] = *(const bf16x8*)(wg + (size_t)(128 + ch) * 128 + 32 * ks + 8 * g); }
    const float ba = a->in[I_LBA][l * 1024 + chg], bx = a->in[I_LBX][l * 1024 + chg], sp = softplus_f(-a->in[I_LLAM][l * 1024 + chg]);
    const int cg = tid & 15, t0i = tid >> 4;
    float cwv[4][8], cbv[8];
    { const float* cw = a->in[I_LCW] + (size_t)l * 4 * 1024 + h * 128 + 8 * cg;
#pragma unroll
      for (int j = 0; j < 4; ++j) { const f32x4 w0 = *(const f32x4*)(cw + j * 1024), w1 = *(const f32x4*)(cw + j * 1024 + 4);
          cwv[j][0] = w0[0]; cwv[j][1] = w0[1]; cwv[j][2] = w0[2]; cwv[j][3] = w0[3]; cwv[j][4] = w1[0]; cwv[j][5] = w1[1]; cwv[j][6] = w1[2]; cwv[j][7] = w1[3]; }
      const float* cbp = a->in[I_LCB] + l * 1024 + h * 128 + 8 * cg; const f32x4 b0 = *(const f32x4*)(cbp), b1 = *(const f32x4*)(cbp + 4);
      cbv[0] = b0[0]; cbv[1] = b0[1]; cbv[2] = b0[2]; cbv[3] = b0[3]; cbv[4] = b1[0]; cbv[5] = b1[1]; cbv[6] = b1[2]; cbv[7] = b1[3]; }
    u32x4 pr[2][4], py[2];
#define LRU_ISSUE(c_) do { _Pragma("unroll") for (int i = 0; i < 2; ++i) { const int tl = (c_) * 64 + t0i + 32 * i; \
        _Pragma("unroll") for (int j = 0; j < 4; ++j) { const int tt_ = tl - 3 + j; pr[i][j] = (u32x4){0u, 0u, 0u, 0u}; \
            if (tt_ >= 0) pr[i][j] = *(const u32x4*)(proj + ((size_t)b * SEQ_ + tt_) * NPROJ + PC_LRUX + h * 128 + 8 * cg); } \
        if (MODE == 1) py[i] = *(const u32x4*)(proj + ((size_t)b * SEQ_ + tl) * NPROJ + PC_LRUY + h * 128 + 8 * cg); } } while (0)
    LRU_ISSUE(c_lo);
    for (int c = c_lo; c < c_hi; ++c) {
        const size_t tok0 = (size_t)b * SEQ_ + (size_t)c * 64;
        __syncthreads();
#pragma unroll
        for (int i = 0; i < 2; ++i) { float o[8];
#pragma unroll
            for (int q = 0; q < 8; ++q) o[q] = cbv[q];
#pragma unroll
            for (int j = 0; j < 4; ++j) { const unsigned x[4] = {pr[i][j].x, pr[i][j].y, pr[i][j].z, pr[i][j].w};
#pragma unroll
                for (int q = 0; q < 4; ++q) { o[2 * q] += cwv[j][2 * q] * bflo(x[q]); o[2 * q + 1] += cwv[j][2 * q + 1] * bfhi(x[q]); } }
            u32x4 w; w.x = pg8::cvt_pk_bf16(o[0], o[1]); w.y = pg8::cvt_pk_bf16(o[2], o[3]); w.z = pg8::cvt_pk_bf16(o[4], o[5]); w.w = pg8::cvt_pk_bf16(o[6], o[7]);
            *(LAS u32x4*)(xa + (t0i + 32 * i) * 136 + 8 * cg) = w;
            if (MODE == 1) *(LAS u32x4*)(ysb + (t0i + 32 * i) * 128 + 8 * cg) = py[i]; }
        if (c + 1 < c_hi) LRU_ISSUE(c + 1);
        __syncthreads();
        f32x4_t ar[4], ax[4];
#pragma unroll
        for (int tt = 0; tt < 4; ++tt) { ar[tt] = (f32x4_t){0.f, 0.f, 0.f, 0.f}; ax[tt] = (f32x4_t){0.f, 0.f, 0.f, 0.f}; }
#pragma unroll
        for (int tt = 0; tt < 4; ++tt)
#pragma unroll
            for (int ks = 0; ks < 4; ++ks) { const bf16x8 af = *(const LAS bf16x8*)(xa + (16 * tt + fr) * 136 + 32 * ks + 8 * g);
                ar[tt] = __builtin_amdgcn_mfma_f32_16x16x32_bf16(af, bra[ks], ar[tt], 0, 0, 0);
                ax[tt] = __builtin_amdgcn_mfma_f32_16x16x32_bf16(af, brx[ks], ax[tt], 0, 0, 0); }
        float av[4][4], uv[4][4], Ai[4], Bi[4];
#pragma unroll
        for (int tt = 0; tt < 4; ++tt) { float A = 1.f, B = 0.f;
#pragma unroll
            for (int r = 0; r < 4; ++r) { const int t = 16 * tt + 4 * g + r;
                const float rg = sigmoid_f(ar[tt][r] + ba), ig = sigmoid_f(ax[tt][r] + bx);
                const float log_a = -8.0f * rg * sp; av[tt][r] = __expf(log_a); uv[tt][r] = __builtin_amdgcn_sqrtf(neg_expm1_f(2.0f * log_a)) * (ig * bf2f(xa[t * 136 + ch]));
                B = av[tt][r] * B + uv[tt][r]; A *= av[tt][r]; }
            Ai[tt] = A; Bi[tt] = B; }
#pragma unroll
        for (int tt = 0; tt < 4; ++tt) { const float A1 = __shfl_up(Ai[tt], 16), B1 = __shfl_up(Bi[tt], 16); if (g >= 1) { Bi[tt] = Ai[tt] * B1 + Bi[tt]; Ai[tt] = Ai[tt] * A1; } }
#pragma unroll
        for (int tt = 0; tt < 4; ++tt) { const float A2 = __shfl_up(Ai[tt], 32), B2 = __shfl_up(Bi[tt], 32); if (g >= 2) { Bi[tt] = Ai[tt] * B2 + Bi[tt]; Ai[tt] = Ai[tt] * A2; } }
        float Ae[4], Be[4], At[4], Bt[4];
#pragma unroll
        for (int tt = 0; tt < 4; ++tt) { Ae[tt] = __shfl_up(Ai[tt], 16); Be[tt] = __shfl_up(Bi[tt], 16); if (g == 0) { Ae[tt] = 1.f; Be[tt] = 0.f; }
            At[tt] = __shfl(Ai[tt], fr + 48); Bt[tt] = __shfl(Bi[tt], fr + 48); }
        float hin = 0.f, ptot = 1.f;
        if (MODE == 1) hin = carry[((size_t)b * 64 + c) * 1024 + chg];
#pragma unroll
        for (int tt = 0; tt < 4; ++tt) {
            float hcur = Ae[tt] * hin + Be[tt], ccur = ptot * Ae[tt];
#pragma unroll
            for (int r = 0; r < 4; ++r) { const int t = 16 * tt + 4 * g + r; hcur = av[tt][r] * hcur + uv[tt][r]; ccur *= av[tt][r];
                if (MODE == 1) outb[t * 128 + ch] = (bf16_t)f2bf(hcur * gelu_tanh_f(bf2f(ysb[t * 128 + ch])));
                else { outb[t * 128 + ch] = (bf16_t)f2bf(hcur); outc[t * 128 + ch] = (bf16_t)f2bf(ccur); } }
            hin = At[tt] * hin + Bt[tt]; ptot *= At[tt]; }
        if (MODE == 0) { if (g == 0) { PH[(((size_t)b * 64 + c) * 2 + 0) * 1024 + chg] = ptot; PH[(((size_t)b * 64 + c) * 2 + 1) * 1024 + chg] = hin; } }
        __syncthreads();
#pragma unroll
        for (int i = 0; i < 2; ++i) { const int pid = tid + 512 * i; const int row = pid >> 4, c8 = (pid & 15) * 8;
            if (MODE == 1) *(u32x4*)(H + (tok0 + row) * 2048 + h * 128 + c8) = *(const LAS u32x4*)(outb + row * 128 + c8);
            else { *(u32x4*)(HL + (tok0 + row) * 1024 + h * 128 + c8) = *(const LAS u32x4*)(outb + row * 128 + c8); *(u32x4*)(CA + (tok0 + row) * 1024 + h * 128 + c8) = *(const LAS u32x4*)(outc + row * 128 + c8); } }
    }
#undef LRU_ISSUE
}
__device__ __forceinline__ void lru_carry(unsigned char* mxs, int gid0, int gstride) {
    const float* PH = (const float*)(mxs + MX_LRU_PH); float* carry = (float*)(mxs + MX_LRU_CARRY);
    for (int gid = gid0; gid < NBATCH * 1024; gid += gstride) { const int b = gid >> 10, chg = gid & 1023; float hc = 0.f;
#pragma unroll 8
        for (int c = 0; c < 64; ++c) { const size_t o = ((size_t)b * 64 + c); carry[o * 1024 + chg] = hc; hc = PH[(o * 2) * 1024 + chg] * hc + PH[(o * 2 + 1) * 1024 + chg]; } }
}
__device__ __forceinline__ void lru_apply(ArgsP a, const bf16_t* proj, bf16_t* H, unsigned char* mxs, int first, int stride) {
    int tid_ = threadIdx.x; asm volatile("" : "+v"(tid_));
    const bf16_t* HL = (const bf16_t*)(a->ws + WS_MB); const bf16_t* CA = (const bf16_t*)(a->ws + WS_X1B); const float* carry = (const float*)(mxs + MX_LRU_CARRY);
    for (size_t p = (size_t)first * 512 + tid_; p < (size_t)T_ * 128; p += (size_t)stride * 512) { const size_t t = p >> 7; const int c8 = (int)(p & 127) * 8;
        const u32x4 hw = *(const u32x4*)(HL + t * 1024 + c8), cw = *(const u32x4*)(CA + t * 1024 + c8), yw = *(const u32x4*)(proj + t * NPROJ + PC_LRUY + c8);
        const float* cp = carry + (t >> 6) * 1024 + c8; const f32x4 c0 = *(const f32x4*)(cp), c1 = *(const f32x4*)(cp + 4);
        const unsigned hh[4] = {hw.x, hw.y, hw.z, hw.w}, cc[4] = {cw.x, cw.y, cw.z, cw.w}, yy[4] = {yw.x, yw.y, yw.z, yw.w}; const float cin[8] = {c0[0], c0[1], c0[2], c0[3], c1[0], c1[1], c1[2], c1[3]};
        unsigned o[4];
#pragma unroll
        for (int q = 0; q < 4; ++q) { const float h0 = bflo(hh[q]) + bflo(cc[q]) * cin[2 * q], h1 = bfhi(hh[q]) + bfhi(cc[q]) * cin[2 * q + 1];
            o[q] = pg8::cvt_pk_bf16(h0 * gelu_tanh_f(bflo(yy[q])), h1 * gelu_tanh_f(bfhi(yy[q]))); }
        *(u32x4*)(H + t * 2048 + c8) = (u32x4){o[0], o[1], o[2], o[3]}; }
}
typedef float f32x16 __attribute__((ext_vector_type(16)));
typedef short bf16x4 __attribute__((ext_vector_type(4)));
constexpr size_t MXB_ML_U = 0;
constexpr size_t MXB_ML_CP = 64 * MiB;
constexpr size_t MXS_ML_NU = 6 * MiB, MXS_ML_NP = 6 * MiB + 512 * 1024, MXS_ML_SC = 7 * MiB;

__device__ __forceinline__ float bperm_f(int src_lane, float v) { return __builtin_bit_cast(float, __builtin_amdgcn_ds_bpermute(src_lane << 2, __builtin_bit_cast(int, v))); }
__device__ __forceinline__ float wave_incl_sum(float v, int lane) {
#pragma unroll
    for (int o = 1; o < 64; o <<= 1) { const float t = bperm_f(lane >= o ? lane - o : lane, v); if (lane >= o) v += t; }
    return v;
}
__device__ __forceinline__ float wave_incl_max(float v, int lane) {
#pragma unroll
    for (int o = 1; o < 64; o <<= 1) { const float t = bperm_f(lane >= o ? lane - o : lane, v); if (lane >= o) v = fmaxf(v, t); }
    return v;
}
__device__ __forceinline__ bf16x8 pack8(float a0, float a1, float a2, float a3, float a4, float a5, float a6, float a7) {
    u32x4 w; w.x = pg8::cvt_pk_bf16(a0, a1); w.y = pg8::cvt_pk_bf16(a2, a3); w.z = pg8::cvt_pk_bf16(a4, a5); w.w = pg8::cvt_pk_bf16(a6, a7); return __builtin_bit_cast(bf16x8, w);
}
__device__ __forceinline__ bf16x8 ld_perm(const LAS bf16_t* p) {
    const u32x2 lo = *(const LAS u32x2*)(p), hi = *(const LAS u32x2*)(p + 8); u32x4 w; w.x = lo.x; w.y = lo.y; w.z = hi.x; w.w = hi.y; return __builtin_bit_cast(bf16x8, w);
}

__device__ __forceinline__ void mlstm_passA(ArgsP a, int l, LAS unsigned char* lds, const bf16_t* proj, const float* gsm, unsigned char* mxb, unsigned char* mxs, int G) {
    int tid_ = threadIdx.x; asm volatile("" : "+v"(tid_)); const int tid = tid_, lane = tid & 63, wave = __builtin_amdgcn_readfirstlane(tid >> 6), r = lane & 31, hh = lane >> 5;
    LAS bf16_t* kwT = (LAS bf16_t*)(lds);
    LAS bf16_t* vT = (LAS bf16_t*)(lds + 9216);
    LAS float* wts = (LAS float*)(lds + 27648);
    float* NU = (float*)(mxs + MXS_ML_NU); float* SC = (float*)(mxs + MXS_ML_SC);
    const f32x4 ib4 = *(const f32x4*)(a->in[I_MIB] + l * 4), fb4 = *(const f32x4*)(a->in[I_MFB] + l * 4);
    for (int uid = blockIdx.x; uid < 2048; uid += G) {
        const int c = uid & 63, hd = (uid >> 6) & 3, b = uid >> 8; const size_t tok0 = (size_t)b * SEQ_ + (size_t)c * 64;
        const float ib = hd == 0 ? ib4[0] : (hd == 1 ? ib4[1] : (hd == 2 ? ib4[2] : ib4[3])), fb = hd == 0 ? fb4[0] : (hd == 1 ? fb4[1] : (hd == 2 ? fb4[2] : fb4[3]));
        __syncthreads();
        if (wave == 0) {
            const float fpre = gsm[(tok0 + lane) * 32 + 4 + hd] + fb, ipre = gsm[(tok0 + lane) * 32 + hd] + ib;
            const float logf = -softplus_f(-fpre); const float bc = wave_incl_sum(logf, lane); const float bl = __builtin_bit_cast(float, __builtin_amdgcn_readlane(__builtin_bit_cast(int, bc), 63));
            const float ge = bl - bc + ipre; const float mloc = wave_max(ge);
            wts[lane] = __expf(ge - mloc);
            if (lane == 0) { SC[(size_t)uid * 4 + 0] = bl; SC[(size_t)uid * 4 + 1] = mloc; }
        }
        const u32x4 kp = *(const u32x4*)(proj + (tok0 + lane) * NPROJ + PC_MLK + hd * 64 + wave * 8);
        const u32x4 vp0 = *(const u32x4*)(proj + (tok0 + lane) * NPROJ + PC_MLV + hd * 128 + wave * 8);
        const u32x4 vp1 = *(const u32x4*)(proj + (tok0 + lane) * NPROJ + PC_MLV + hd * 128 + 64 + wave * 8);
        __syncthreads();
        { const float w = wts[lane]; const unsigned kw[4] = {kp.x, kp.y, kp.z, kp.w};
#pragma unroll
          for (int j = 0; j < 4; ++j) { kwT[(wave * 8 + 2 * j) * 72 + lane] = (bf16_t)f2bf(w * bflo(kw[j])); kwT[(wave * 8 + 2 * j + 1) * 72 + lane] = (bf16_t)f2bf(w * bfhi(kw[j])); }
          const unsigned v0[4] = {vp0.x, vp0.y, vp0.z, vp0.w}, v1[4] = {vp1.x, vp1.y, vp1.z, vp1.w};
#pragma unroll
          for (int j = 0; j < 4; ++j) { vT[(wave * 8 + 2 * j) * 72 + lane] = (bf16_t)(v0[j] & 0xffffu); vT[(wave * 8 + 2 * j + 1) * 72 + lane] = (bf16_t)(v0[j] >> 16);
              vT[(64 + wave * 8 + 2 * j) * 72 + lane] = (bf16_t)(v1[j] & 0xffffu); vT[(64 + wave * 8 + 2 * j + 1) * 72 + lane] = (bf16_t)(v1[j] >> 16); } }
        __syncthreads();
        const int dI = wave >> 2, eJ = wave & 3;
        f32x16 acc;
#pragma unroll
        for (int i = 0; i < 16; ++i) acc[i] = 0.f;
#pragma unroll
        for (int ks = 0; ks < 4; ++ks) { const bf16x8 af = *(const LAS bf16x8*)(kwT + (32 * dI + r) * 72 + 16 * ks + 8 * hh), bf = *(const LAS bf16x8*)(vT + (32 * eJ + r) * 72 + 16 * ks + 8 * hh);
            acc = __builtin_amdgcn_mfma_f32_32x32x16_bf16(af, bf, acc, 0, 0, 0); }
        float* ud = (float*)(mxb + MXB_ML_U) + ((size_t)uid * 8 + wave) * 1024;
#pragma unroll
        for (int q = 0; q < 4; ++q) *(f32x4*)(ud + (q * 64 + lane) * 4) = (f32x4){acc[4 * q], acc[4 * q + 1], acc[4 * q + 2], acc[4 * q + 3]};
        if (tid < 64) { float s = 0.f;
#pragma unroll 8
            for (int t = 0; t < 64; ++t) s += bf2f(kwT[tid * 72 + t]);
            NU[(size_t)uid * 64 + tid] = s; }
    }
}
__device__ __forceinline__ void mlstm_passB(unsigned char* mxb, unsigned char* mxs, int G) {
    int tid_ = threadIdx.x; asm volatile("" : "+v"(tid_)); const int tid = tid_;
    const float* NU = (const float*)(mxs + MXS_ML_NU); float* NP = (float*)(mxs + MXS_ML_NP); float* SC = (float*)(mxs + MXS_ML_SC);
    for (int wu = blockIdx.x; wu < 256; wu += G) {
        const int chain = wu >> 3, tile = wu & 7;
        if (tid < 128) {
            const int lane = tid & 63, s = tid >> 6;
            float st[8]; float m = 0.f;
#pragma unroll
            for (int i = 0; i < 8; ++i) st[i] = 0.f;
#pragma unroll 4
            for (int c = 0; c < 64; ++c) { const size_t uid = (size_t)chain * 64 + c;
                const float* ud = (const float*)(mxb + MXB_ML_U) + (uid * 8 + tile) * 1024;
                const f32x4 u0 = *(const f32x4*)(ud + ((2 * s) * 64 + lane) * 4), u1 = *(const f32x4*)(ud + ((2 * s + 1) * 64 + lane) * 4);
                const float bl = SC[uid * 4 + 0], mloc = SC[uid * 4 + 1];
                *(bf16x8*)((bf16_t*)(mxb + MXB_ML_CP) + (uid * 8 + tile) * 1024 + (s * 64 + lane) * 8) = pack8(st[0], st[1], st[2], st[3], st[4], st[5], st[6], st[7]);
                if (tile == 0 && tid == 0) SC[uid * 4 + 2] = m;
                const float mn = fmaxf(bl + m, mloc), dec = __expf(bl + m - mn), sc = __expf(mloc - mn); m = mn;
#pragma unroll
                for (int i = 0; i < 4; ++i) { st[i] = dec * st[i] + sc * u0[i]; st[4 + i] = dec * st[4 + i] + sc * u1[i]; } }
        } else if (tile == 0 && tid < 192) {
            const int d = tid - 128; float n = 0.f, m = 0.f;
#pragma unroll 4
            for (int c = 0; c < 64; ++c) { const size_t uid = (size_t)chain * 64 + c; const float bl = SC[uid * 4 + 0], mloc = SC[uid * 4 + 1]; const float nu = NU[uid * 64 + d];
                NP[uid * 64 + d] = n; const float mn = fmaxf(bl + m, mloc), dec = __expf(bl + m - mn), sc = __expf(mloc - mn); m = mn; n = dec * n + sc * nu; }
        }
    }
}
__device__ __forceinline__ void mlstm_passC(ArgsP a, int l, LAS unsigned char* lds, const bf16_t* proj, const float* gsm, bf16_t* H, unsigned char* mxb, unsigned char* mxs, int first, int stride) {
    int tid_ = threadIdx.x; asm volatile("" : "+v"(tid_)); const int tid = tid_, lane = tid & 63, wave = __builtin_amdgcn_readfirstlane(tid >> 6), r = lane & 31, hh = lane >> 5;
    LAS bf16_t* qb = (LAS bf16_t*)(lds);
    LAS bf16_t* kb = (LAS bf16_t*)(lds + 9216);
    LAS bf16_t* vT = (LAS bf16_t*)(lds + 18432);
    LAS bf16_t* ob = (LAS bf16_t*)(lds + 36864);
    LAS bf16_t* outb = (LAS bf16_t*)(lds + 54272);
    LAS float* tb_rt = (LAS float*)(lds + 70656);
    LAS float* tb_ct = tb_rt + 64;
    LAS float* tb_iw = tb_rt + 128;
    LAS float* tb_em = tb_rt + 192;
    LAS float* tb_np = tb_rt + 256;
    LAS float* ssq = tb_rt + 320;
    const float* NP = (const float*)(mxs + MXS_ML_NP); const float* SC = (const float*)(mxs + MXS_ML_SC);
    const f32x4 ib4 = *(const f32x4*)(a->in[I_MIB] + l * 4), fb4 = *(const f32x4*)(a->in[I_MFB] + l * 4);
    LAS float* gnl = tb_rt + 640;
    gnl[tid] = a->in[I_MNG][(size_t)l * 512 + tid];
    for (int uid = first; uid < 2048; uid += stride) {
        const int c = uid & 63, hd = (uid >> 6) & 3, b = uid >> 8; const size_t tok0 = (size_t)b * SEQ_ + (size_t)c * 64;
        __syncthreads();
        if (wave == 0) {
            const float ib = hd == 0 ? ib4[0] : (hd == 1 ? ib4[1] : (hd == 2 ? ib4[2] : ib4[3])), fb = hd == 0 ? fb4[0] : (hd == 1 ? fb4[1] : (hd == 2 ? fb4[2] : fb4[3]));
            const float fpre = gsm[(tok0 + lane) * 32 + 4 + hd] + fb, ipre = gsm[(tok0 + lane) * 32 + hd] + ib;
            const float logf = -softplus_f(-fpre); const float bc = wave_incl_sum(logf, lane);
            const float rt = ipre - bc; const float cmx = wave_incl_max(rt, lane); const float mprev = SC[(size_t)uid * 4 + 2];
            const float mt = bc + fmaxf(mprev, cmx);
            tb_rt[lane] = rt; tb_ct[lane] = bc - mt; tb_iw[lane] = __expf(bc + mprev - mt); tb_em[lane] = __expf(-mt); tb_np[lane] = NP[(size_t)uid * 64 + lane];
        }
        { const int row = tid >> 3, c8 = (tid & 7) * 8;
          *(LAS u32x4*)(qb + row * 72 + c8) = *(const u32x4*)(proj + (tok0 + row) * NPROJ + PC_MLQ + hd * 64 + c8);
          *(LAS u32x4*)(kb + row * 72 + c8) = *(const u32x4*)(proj + (tok0 + row) * NPROJ + PC_MLK + hd * 64 + c8);
#pragma unroll
          for (int i = 0; i < 2; ++i) { const int pid = tid + 512 * i; const int orow = pid >> 4, oc8 = (pid & 15) * 8;
              *(LAS u32x4*)(ob + orow * 136 + oc8) = *(const u32x4*)(proj + (tok0 + orow) * NPROJ + PC_MLO + hd * 128 + oc8); }
          const u32x4 vp0 = *(const u32x4*)(proj + (tok0 + lane) * NPROJ + PC_MLV + hd * 128 + wave * 8);
          const u32x4 vp1 = *(const u32x4*)(proj + (tok0 + lane) * NPROJ + PC_MLV + hd * 128 + 64 + wave * 8);
          const unsigned v0[4] = {vp0.x, vp0.y, vp0.z, vp0.w}, v1[4] = {vp1.x, vp1.y, vp1.z, vp1.w};
#pragma unroll
          for (int j = 0; j < 4; ++j) { vT[(wave * 8 + 2 * j) * 72 + lane] = (bf16_t)(v0[j] & 0xffffu); vT[(wave * 8 + 2 * j + 1) * 72 + lane] = (bf16_t)(v0[j] >> 16);
              vT[(64 + wave * 8 + 2 * j) * 72 + lane] = (bf16_t)(v1[j] & 0xffffu); vT[(64 + wave * 8 + 2 * j + 1) * 72 + lane] = (bf16_t)(v1[j] >> 16); } }
        __syncthreads();
        const int eI = wave >> 1, tJ = wave & 1; const int t = 32 * tJ + r;
        f32x16 as[2];
#pragma unroll
        for (int sI = 0; sI < 2; ++sI) {
#pragma unroll
            for (int i = 0; i < 16; ++i) as[sI][i] = 0.f;
#pragma unroll
            for (int ks = 0; ks < 4; ++ks) { const bf16x8 af = *(const LAS bf16x8*)(kb + (32 * sI + r) * 72 + 16 * ks + 8 * hh), bf = *(const LAS bf16x8*)(qb + t * 72 + 16 * ks + 8 * hh);
                as[sI] = __builtin_amdgcn_mfma_f32_32x32x16_bf16(af, bf, as[sI], 0, 0, 0); } }
        const float ctt = tb_ct[t], iwt = tb_iw[t] * 0.125f, emt = tb_em[t];
        float dsum = 0.f;
#pragma unroll
        for (int sI = 0; sI < 2; ++sI)
#pragma unroll
            for (int q = 0; q < 4; ++q) { const int s0 = 32 * sI + 8 * q + 4 * hh; const f32x4 rt4 = *(const LAS f32x4*)(tb_rt + s0);
#pragma unroll
                for (int i = 0; i < 4; ++i) { const float wv = (s0 + i <= t) ? as[sI][4 * q + i] * 0.125f * __expf(ctt + rt4[i]) : 0.f; as[sI][4 * q + i] = wv; dsum += wv; } }
        float qn = 0.f;
#pragma unroll
        for (int j = 0; j < 4; ++j) { const u32x4 qw = *(const LAS u32x4*)(qb + t * 72 + 32 * hh + 8 * j); const f32x4 n0 = *(const LAS f32x4*)(tb_np + 32 * hh + 8 * j), n1 = *(const LAS f32x4*)(tb_np + 32 * hh + 8 * j + 4);
            qn += bflo(qw.x) * n0[0] + bfhi(qw.x) * n0[1] + bflo(qw.y) * n0[2] + bfhi(qw.y) * n0[3] + bflo(qw.z) * n1[0] + bfhi(qw.z) * n1[1] + bflo(qw.w) * n1[2] + bfhi(qw.w) * n1[3]; }
        float den = dsum + iwt * qn; den += __shfl_xor(den, 32);
        f32x16 an;
#pragma unroll
        for (int i = 0; i < 16; ++i) an[i] = 0.f;
#pragma unroll
        for (int sI = 0; sI < 2; ++sI)
#pragma unroll
            for (int s2 = 0; s2 < 2; ++s2) { const bf16x8 af = ld_perm(vT + (32 * eI + r) * 72 + 32 * sI + 16 * s2 + 4 * hh);
                const bf16x8 bf = pack8(as[sI][8 * s2], as[sI][8 * s2 + 1], as[sI][8 * s2 + 2], as[sI][8 * s2 + 3], as[sI][8 * s2 + 4], as[sI][8 * s2 + 5], as[sI][8 * s2 + 6], as[sI][8 * s2 + 7]);
                an = __builtin_amdgcn_mfma_f32_32x32x16_bf16(af, bf, an, 0, 0, 0); }
        const bf16_t* cpd = (const bf16_t*)(mxb + MXB_ML_CP) + (size_t)uid * 8 * 1024;
#pragma unroll
        for (int dI = 0; dI < 2; ++dI)
#pragma unroll
            for (int s2 = 0; s2 < 2; ++s2) { const bf16x8 af = *(const bf16x8*)(cpd + (size_t)(dI * 4 + eI) * 1024 + (s2 * 64 + lane) * 8);
                const u32x4 qw = __builtin_bit_cast(u32x4, ld_perm(qb + t * 72 + 32 * dI + 16 * s2 + 4 * hh));
                const bf16x8 bf = pack8(bflo(qw.x) * iwt, bfhi(qw.x) * iwt, bflo(qw.y) * iwt, bfhi(qw.y) * iwt, bflo(qw.z) * iwt, bfhi(qw.z) * iwt, bflo(qw.w) * iwt, bfhi(qw.w) * iwt);
                an = __builtin_amdgcn_mfma_f32_32x32x16_bf16(af, bf, an, 0, 0, 0); }
        const float dinv = 1.0f / fmaxf(fabsf(den), emt);
        float sq = 0.f;
#pragma unroll
        for (int i = 0; i < 16; ++i) { an[i] *= dinv; sq += an[i] * an[i]; }
        sq += __shfl_xor(sq, 32);
        if (hh == 0) ssq[eI * 64 + t] = sq;
        __syncthreads();
        const float tot = ssq[t] + ssq[64 + t] + ssq[128 + t] + ssq[192 + t];
        const float rinv = rsqrtf(tot * (1.0f / 128.0f) + RMS_EPS);
        const LAS float* gn = gnl + hd * 128;
#pragma unroll
        for (int q = 0; q < 4; ++q) { const int e0 = 32 * eI + 8 * q + 4 * hh; const f32x4 g4 = *(const LAS f32x4*)(gn + e0); const u32x2 ow = *(const LAS u32x2*)(ob + t * 136 + e0);
            const float o0 = an[4 * q] * rinv * g4[0] * sigmoid_f(bflo(ow.x)), o1 = an[4 * q + 1] * rinv * g4[1] * sigmoid_f(bfhi(ow.x));
            const float o2 = an[4 * q + 2] * rinv * g4[2] * sigmoid_f(bflo(ow.y)), o3 = an[4 * q + 3] * rinv * g4[3] * sigmoid_f(bfhi(ow.y));
            u32x2 pw; pw.x = pg8::cvt_pk_bf16(o0, o1); pw.y = pg8::cvt_pk_bf16(o2, o3); *(LAS u32x2*)(outb + t * 128 + e0) = pw; }
        __syncthreads();
#pragma unroll
        for (int i = 0; i < 2; ++i) { const int pid = tid + 512 * i; const int row = pid >> 4, c8 = (pid & 15) * 8;
            *(u32x4*)(H + (tok0 + row) * 2048 + 1024 + hd * 128 + c8) = *(const LAS u32x4*)(outb + row * 128 + c8); }
    }
}
constexpr size_t MXB_GD_ND = 96 * MiB, MXB_GD_OD = 160 * MiB, MXB_GD_T = 224 * MiB;
constexpr size_t MXT_GD_XD = 8 * MiB, MXT_GD_QD = 40 * MiB, MXT_GD_SD = 72 * MiB;
constexpr size_t MXS_GD_GL = 7 * MiB + 64 * 1024;

__device__ __forceinline__ void conv_silu8(const u32x4 (&rw)[4], const float* cw, float (&o)[8]) {
#pragma unroll
    for (int j = 0; j < 8; ++j) o[j] = 0.f;
#pragma unroll
    for (int i = 0; i < 4; ++i) { const f32x4 w0 = *(const f32x4*)(cw + i * 1536), w1 = *(const f32x4*)(cw + i * 1536 + 4); const unsigned x[4] = {rw[i].x, rw[i].y, rw[i].z, rw[i].w};
        o[0] += w0[0] * bflo(x[0]); o[1] += w0[1] * bfhi(x[0]); o[2] += w0[2] * bflo(x[1]); o[3] += w0[3] * bfhi(x[1]);
        o[4] += w1[0] * bflo(x[2]); o[5] += w1[1] * bfhi(x[2]); o[6] += w1[2] * bflo(x[3]); o[7] += w1[3] * bfhi(x[3]); }
#pragma unroll
    for (int j = 0; j < 8; ++j) o[j] = silu_f(o[j]);
}
__device__ __forceinline__ void conv_silu8_l(const u32x4 (&rw)[4], const LAS float* cw, int stride, float (&o)[8]) {
#pragma unroll
    for (int j = 0; j < 8; ++j) o[j] = 0.f;
#pragma unroll
    for (int i = 0; i < 4; ++i) { const f32x4 w0 = *(const LAS f32x4*)(cw + i * stride), w1 = *(const LAS f32x4*)(cw + i * stride + 4); const unsigned x[4] = {rw[i].x, rw[i].y, rw[i].z, rw[i].w};
        o[0] += w0[0] * bflo(x[0]); o[1] += w0[1] * bfhi(x[0]); o[2] += w0[2] * bflo(x[1]); o[3] += w0[3] * bfhi(x[1]);
        o[4] += w1[0] * bflo(x[2]); o[5] += w1[1] * bfhi(x[2]); o[6] += w1[2] * bflo(x[3]); o[7] += w1[3] * bfhi(x[3]); }
#pragma unroll
    for (int j = 0; j < 8; ++j) o[j] = silu_f(o[j]);
}
__device__ __forceinline__ void load_rows4(const bf16_t* proj, int b, int tl, int col, u32x4 (&rw)[4]) {
#pragma unroll
    for (int i = 0; i < 4; ++i) { const int tt = tl - 3 + i; rw[i] = (u32x4){0u, 0u, 0u, 0u}; if (tt >= 0) rw[i] = *(const u32x4*)(proj + ((size_t)b * SEQ_ + tt) * NPROJ + col); }
}

__device__ __forceinline__ void gdn_passA1(ArgsP a, int l, LAS unsigned char* lds, const bf16_t* proj, const float* gsm, unsigned char* mxb, int G) {
    int tid_ = threadIdx.x; asm volatile("" : "+v"(tid_)); const int tid = tid_, lane = tid & 63, wave = __builtin_amdgcn_readfirstlane(tid >> 6), r = lane & 31, hh = lane >> 5;
    LAS unsigned char* wl = lds + wave * 16384;
    LAS bf16_t* kb = (LAS bf16_t*)wl;
    LAS float* am = (LAS float*)wl;
    LAS float* tb = (LAS float*)(lds + MISC_OFF + 1024 + wave * 512);
    LAS float* cwl = (LAS float*)(lds + MISC_OFF + 8192);
    { const float* cwk = a->in[I_GCW] + (size_t)l * 4 * 1536 + 512; for (int i = tid; i < 2048; i += 512) cwl[i] = cwk[(i >> 9) * 1536 + (i & 511)]; }
    LAS float* gpl = (LAS float*)(lds + MISC_OFF + 8192 + 8192);
    if (tid < 8) { gpl[tid] = -__expf(a->in[I_GAL][l * 8 + tid]); gpl[8 + tid] = a->in[I_GDT][l * 8 + tid]; }
    __syncthreads();
    for (int uid = blockIdx.x * NWAVES + wave; uid < 4096; uid += G * NWAVES) {
        const int c = uid & 63, hd = (uid >> 6) & 7, b = uid >> 9; const int tl = c * 64 + lane; const size_t tok = (size_t)b * SEQ_ + tl;
        float ss = 0.f;
#pragma unroll 2
        for (int p = 0; p < 8; ++p) { u32x4 rw[4]; load_rows4(proj, b, tl, PC_GDK + hd * 64 + 8 * p, rw); float o[8]; conv_silu8_l(rw, cwl + hd * 64 + 8 * p, 512, o);
#pragma unroll
            for (int j = 0; j < 8; ++j) ss += o[j] * o[j];
            *(LAS bf16x8*)(kb + lane * 72 + 8 * p) = pack8(o[0], o[1], o[2], o[3], o[4], o[5], o[6], o[7]); }
        const float rn = rsqrtf(ss + RMS_EPS);
        const float gg = gpl[hd] * softplus_f(gsm[tok * 32 + 8 + hd] + gpl[8 + hd]);
        const float gc = wave_incl_sum(gg, lane), beta = 1.f / (1.f + __expf(-gsm[tok * 32 + 16 + hd]));
        tb[lane] = gc; tb[64 + lane] = beta * rn;
        LDS_WAIT(); asm volatile("" ::: "memory");
        bf16x8 kf[2][4];
#pragma unroll
        for (int I = 0; I < 2; ++I)
#pragma unroll
            for (int ks = 0; ks < 4; ++ks) kf[I][ks] = *(const LAS bf16x8*)(kb + (32 * I + r) * 72 + 16 * ks + 8 * hh);
        LDS_WAIT(); asm volatile("" ::: "memory");
#pragma unroll
        for (int I = 0; I < 2; ++I)
#pragma unroll
            for (int J = 0; J < 2; ++J) { f32x16 acc;
#pragma unroll
                for (int i = 0; i < 16; ++i) acc[i] = 0.f;
#pragma unroll
                for (int ks = 0; ks < 4; ++ks) acc = __builtin_amdgcn_mfma_f32_32x32x16_bf16(kf[I][ks], kf[J][ks], acc, 0, 0, 0);
                const int s = 32 * J + r; const float gcs = __shfl(gc, s), rns = __shfl(rn, s);
#pragma unroll
                for (int q = 0; q < 4; ++q) { const int t0 = 32 * I + 8 * q + 4 * hh; const f32x4 gct = *(const LAS f32x4*)(tb + t0), brt = *(const LAS f32x4*)(tb + 64 + t0);
#pragma unroll
                    for (int i = 0; i < 4; ++i) { const float v = (s < t0 + i) ? acc[4 * q + i] * brt[i] * rns * __expf(gct[i] - gcs) : 0.f; am[(t0 + i) * 64 + s] = v; } } }
        LDS_WAIT(); asm volatile("" ::: "memory");
        float Tc[64];
#pragma unroll
        for (int i = 0; i < 64; ++i) { float acc = (i == lane) ? 1.f : 0.f;
#pragma unroll
            for (int j4 = 0; j4 < (i + 3) / 4; ++j4) { const f32x4 av = *(const LAS f32x4*)(am + i * 64 + 4 * j4);
#pragma unroll
                for (int jj = 0; jj < 4; ++jj) if (4 * j4 + jj < i) acc -= av[jj] * Tc[4 * j4 + jj]; }
            Tc[i] = acc; }
        bf16_t* Tg = (bf16_t*)(mxb + MXB_GD_T) + (size_t)uid * 4096;
#pragma unroll
        for (int i = 0; i < 64; ++i) Tg[i * 64 + lane] = (bf16_t)f2bf(Tc[i]);
    }
}

__device__ __forceinline__ void gdn_passA2(ArgsP a, int l, LAS unsigned char* lds, const bf16_t* proj, const float* gsm, unsigned char* mxb, unsigned char* mxt, unsigned char* mxs, int G) {
    int tid_ = threadIdx.x; asm volatile("" : "+v"(tid_)); const int tid = tid_, lane = tid & 63, wave = __builtin_amdgcn_readfirstlane(tid >> 6), r = lane & 31, hh = lane >> 5;
    LAS bf16_t* qb = (LAS bf16_t*)(lds);
    LAS bf16_t* kb = (LAS bf16_t*)(lds + 9216);
    LAS bf16_t* bvT = (LAS bf16_t*)(lds + 18432);
    LAS bf16_t* bkT = (LAS bf16_t*)(lds + 27648);
    LAS bf16_t* Tm = (LAS bf16_t*)(lds + 36864);
    LAS bf16_t* wT = (LAS bf16_t*)(lds + 46080);
    LAS bf16_t* uT = (LAS bf16_t*)(lds + 55296);
    LAS bf16_t* kdT = (LAS bf16_t*)(lds + 64512);
    LAS float* tb_gc = (LAS float*)(lds + 73728);
    LAS float* tb_beta = tb_gc + 64;
    LAS float* ssq = tb_gc + 128;
    LAS float* cw = (LAS float*)(lds + 81920);
    { const float* cwg = a->in[I_GCW] + (size_t)l * 4 * 1536; for (int i = tid; i < 6144; i += 512) cw[i] = cwg[i]; }
    LAS float* gpl = cw + 6144;
    if (tid < 8) { gpl[tid] = -__expf(a->in[I_GAL][l * 8 + tid]); gpl[8 + tid] = a->in[I_GDT][l * 8 + tid]; }
    float* GL = (float*)(mxs + MXS_GD_GL);
    u32x4 rq[4], rk[4], rv[4], tp; float pga = 0.f, pgb = 0.f;
#define GA2_ISSUE(u_) do { const int c_ = (u_) & 63, hd_ = ((u_) >> 6) & 7, b_ = (u_) >> 9; const int tl_ = c_ * 64 + lane; const size_t tok_ = (size_t)b_ * SEQ_ + tl_; \
        load_rows4(proj, b_, tl_, PC_GDQ + hd_ * 64 + 8 * wave, rq); load_rows4(proj, b_, tl_, PC_GDK + hd_ * 64 + 8 * wave, rk); load_rows4(proj, b_, tl_, PC_GDV + hd_ * 64 + 8 * wave, rv); \
        pga = gsm[tok_ * 32 + 8 + hd_]; pgb = gsm[tok_ * 32 + 16 + hd_]; \
        tp = *(const u32x4*)((const bf16_t*)(mxb + MXB_GD_T) + (size_t)(u_) * 4096 + (tid >> 3) * 64 + (tid & 7) * 8); } while (0)
    if ((int)blockIdx.x < 4096) GA2_ISSUE((int)blockIdx.x);
    for (int uid = blockIdx.x; uid < 4096; uid += G) {
        const int hd = (uid >> 6) & 7;
        __syncthreads();
        { const float gg = gpl[hd] * softplus_f(pga + gpl[8 + hd]);
          const float gc = wave_incl_sum(gg, lane);
          if (wave == 0) { tb_gc[lane] = gc; tb_beta[lane] = 1.f / (1.f + __expf(-pgb)); if (lane == 63) GL[uid] = __expf(gc); } }
        float qo[8], ko[8], vo[8];
        conv_silu8_l(rq, cw + hd * 64 + 8 * wave, 1536, qo); conv_silu8_l(rk, cw + 512 + hd * 64 + 8 * wave, 1536, ko); conv_silu8_l(rv, cw + 1024 + hd * 64 + 8 * wave, 1536, vo);
        { float sq = 0.f, sk = 0.f;
#pragma unroll
          for (int j = 0; j < 8; ++j) { sq += qo[j] * qo[j]; sk += ko[j] * ko[j]; }
          ssq[wave * 64 + lane] = sq; ssq[512 + wave * 64 + lane] = sk; }
        *(LAS u32x4*)(Tm + (tid >> 3) * 72 + (tid & 7) * 8) = tp;
        if (uid + G < 4096) GA2_ISSUE(uid + G);
        __syncthreads();
        { float sq = 0.f, sk = 0.f;
#pragma unroll
          for (int w = 0; w < 8; ++w) { sq += ssq[w * 64 + lane]; sk += ssq[512 + w * 64 + lane]; }
          const float rq = rsqrtf(sq + RMS_EPS) * 0.125f, rk = rsqrtf(sk + RMS_EPS);
          const float gc = tb_gc[lane], beta = tb_beta[lane], gl_ = tb_gc[63];
          const float e1 = beta * __expf(gc), e2 = __expf(gl_ - gc);
#pragma unroll
          for (int j = 0; j < 8; ++j) { qo[j] *= rq; ko[j] *= rk; }
          *(LAS bf16x8*)(qb + lane * 72 + 8 * wave) = pack8(qo[0], qo[1], qo[2], qo[3], qo[4], qo[5], qo[6], qo[7]);
          *(LAS bf16x8*)(kb + lane * 72 + 8 * wave) = pack8(ko[0], ko[1], ko[2], ko[3], ko[4], ko[5], ko[6], ko[7]);
#pragma unroll
          for (int j = 0; j < 8; ++j) { const int d = 8 * wave + j;
              bvT[d * 72 + lane] = (bf16_t)f2bf(beta * vo[j]); bkT[d * 72 + lane] = (bf16_t)f2bf(e1 * ko[j]); kdT[d * 72 + lane] = (bf16_t)f2bf(e2 * ko[j]); } }
        __syncthreads();
        { const int mat = wave >> 2, I = (wave >> 1) & 1, J = wave & 1; const LAS bf16_t* Am = mat ? bkT : bvT; LAS bf16_t* Om = mat ? wT : uT;
          f32x16 acc;
#pragma unroll
          for (int i = 0; i < 16; ++i) acc[i] = 0.f;
#pragma unroll
          for (int ks = 0; ks < 4; ++ks) { const bf16x8 af = *(const LAS bf16x8*)(Am + (32 * I + r) * 72 + 16 * ks + 8 * hh), bf = *(const LAS bf16x8*)(Tm + (32 * J + r) * 72 + 16 * ks + 8 * hh);
              acc = __builtin_amdgcn_mfma_f32_32x32x16_bf16(af, bf, acc, 0, 0, 0); }
#pragma unroll
          for (int q = 0; q < 4; ++q)
#pragma unroll
              for (int i = 0; i < 4; ++i) Om[(32 * I + 8 * q + 4 * hh + i) * 72 + 32 * J + r] = (bf16_t)f2bf(acc[4 * q + i]); }
        __syncthreads();
        if (wave < 4) {
            const int I = (wave >> 1) & 1, J = wave & 1;
            f32x16 ax, an;
#pragma unroll
            for (int i = 0; i < 16; ++i) { ax[i] = 0.f; an[i] = 0.f; }
#pragma unroll
            for (int ks = 0; ks < 4; ++ks) { const bf16x8 wf = *(const LAS bf16x8*)(wT + (32 * I + r) * 72 + 16 * ks + 8 * hh), kdf_b = *(const LAS bf16x8*)(kdT + (32 * J + r) * 72 + 16 * ks + 8 * hh);
                ax = __builtin_amdgcn_mfma_f32_32x32x16_bf16(wf, kdf_b, ax, 0, 0, 0);
                const bf16x8 kdf_a = *(const LAS bf16x8*)(kdT + (32 * I + r) * 72 + 16 * ks + 8 * hh), uf = *(const LAS bf16x8*)(uT + (32 * J + r) * 72 + 16 * ks + 8 * hh);
                an = __builtin_amdgcn_mfma_f32_32x32x16_bf16(kdf_a, uf, an, 0, 0, 0); }
            bf16_t* xd = (bf16_t*)(mxt + MXT_GD_XD) + (size_t)uid * 4096 + (size_t)(I * 2 + J) * 1024;
#pragma unroll
            for (int s2 = 0; s2 < 2; ++s2) *(bf16x8*)(xd + (s2 * 64 + lane) * 8) = pack8(-ax[8 * s2], -ax[8 * s2 + 1], -ax[8 * s2 + 2], -ax[8 * s2 + 3], -ax[8 * s2 + 4], -ax[8 * s2 + 5], -ax[8 * s2 + 6], -ax[8 * s2 + 7]);
            float* nd = (float*)(mxb + MXB_GD_ND) + (size_t)uid * 4096 + (size_t)(I * 2 + J) * 1024;
#pragma unroll
            for (int q = 0; q < 4; ++q) *(f32x4*)(nd + (q * 64 + lane) * 4) = (f32x4){an[4 * q], an[4 * q + 1], an[4 * q + 2], an[4 * q + 3]};
        } else {
            const int I = (wave >> 1) & 1, tJ = wave & 1; const int t = 32 * tJ + r; const float gct = tb_gc[t];
            bf16x8 pf[2][2];
#pragma unroll
            for (int sI = 0; sI < 2; ++sI) { f32x16 ap;
#pragma unroll
                for (int i = 0; i < 16; ++i) ap[i] = 0.f;
#pragma unroll
                for (int ks = 0; ks < 4; ++ks) { const bf16x8 af = *(const LAS bf16x8*)(kb + (32 * sI + r) * 72 + 16 * ks + 8 * hh), bf = *(const LAS bf16x8*)(qb + t * 72 + 16 * ks + 8 * hh);
                    ap = __builtin_amdgcn_mfma_f32_32x32x16_bf16(af, bf, ap, 0, 0, 0); }
#pragma unroll
                for (int q = 0; q < 4; ++q) { const int s0 = 32 * sI + 8 * q + 4 * hh; const f32x4 gcs = *(const LAS f32x4*)(tb_gc + s0);
#pragma unroll
                    for (int i = 0; i < 4; ++i) ap[4 * q + i] = (s0 + i <= t) ? ap[4 * q + i] * __expf(gct - gcs[i]) : 0.f; }
#pragma unroll
                for (int s2 = 0; s2 < 2; ++s2) pf[sI][s2] = pack8(ap[8 * s2], ap[8 * s2 + 1], ap[8 * s2 + 2], ap[8 * s2 + 3], ap[8 * s2 + 4], ap[8 * s2 + 5], ap[8 * s2 + 6], ap[8 * s2 + 7]); }
            f32x16 aq, ao;
#pragma unroll
            for (int i = 0; i < 16; ++i) { aq[i] = 0.f; ao[i] = 0.f; }
#pragma unroll
            for (int sI = 0; sI < 2; ++sI)
#pragma unroll
                for (int s2 = 0; s2 < 2; ++s2) { const bf16x8 wf = ld_perm(wT + (32 * I + r) * 72 + 32 * sI + 16 * s2 + 4 * hh), uf = ld_perm(uT + (32 * I + r) * 72 + 32 * sI + 16 * s2 + 4 * hh);
                    aq = __builtin_amdgcn_mfma_f32_32x32x16_bf16(wf, pf[sI][s2], aq, 0, 0, 0); ao = __builtin_amdgcn_mfma_f32_32x32x16_bf16(uf, pf[sI][s2], ao, 0, 0, 0); }
            const float egt = __expf(gct);
#pragma unroll
            for (int q = 0; q < 4; ++q) { const int d0 = 32 * I + 8 * q + 4 * hh; const u32x2 qw = *(const LAS u32x2*)(qb + t * 72 + d0);
                aq[4 * q] = bflo(qw.x) * egt - aq[4 * q]; aq[4 * q + 1] = bfhi(qw.x) * egt - aq[4 * q + 1]; aq[4 * q + 2] = bflo(qw.y) * egt - aq[4 * q + 2]; aq[4 * q + 3] = bfhi(qw.y) * egt - aq[4 * q + 3]; }
            bf16_t* qd = (bf16_t*)(mxt + MXT_GD_QD) + (size_t)uid * 4096 + (size_t)(I * 2 + tJ) * 1024;
#pragma unroll
            for (int s2 = 0; s2 < 2; ++s2) *(bf16x8*)(qd + (s2 * 64 + lane) * 8) = pack8(aq[8 * s2], aq[8 * s2 + 1], aq[8 * s2 + 2], aq[8 * s2 + 3], aq[8 * s2 + 4], aq[8 * s2 + 5], aq[8 * s2 + 6], aq[8 * s2 + 7]);
            float* od = (float*)(mxb + MXB_GD_OD) + (size_t)uid * 4096 + (size_t)(I * 2 + tJ) * 1024;
#pragma unroll
            for (int q = 0; q < 4; ++q) *(f32x4*)(od + (q * 64 + lane) * 4) = (f32x4){ao[4 * q], ao[4 * q + 1], ao[4 * q + 2], ao[4 * q + 3]};
        }
    }
}

__device__ __forceinline__ void gdn_passB(unsigned char* mxb, unsigned char* mxt, unsigned char* mxs, int nB) {
    int tid_ = threadIdx.x; asm volatile("" : "+v"(tid_)); const int tid = tid_, lane = tid & 63, wave = __builtin_amdgcn_readfirstlane(tid >> 6);
    const float* GL = (const float*)(mxs + MXS_GD_GL);
    if (wave >= 2) { lru_carry(mxs, ((int)blockIdx.x * 6 + (wave - 2)) * 64 + lane, nB * 6 * 64); return; }
    const int eJ = wave;
    for (int chain = blockIdx.x; chain < 64; chain += nB) {
        f32x16 S[2];
#pragma unroll
        for (int i = 0; i < 16; ++i) { S[0][i] = 0.f; S[1][i] = 0.f; }
        bf16x8 xn[2][2][2]; f32x4 nq[2][4]; float gln;
#define GDB_LOAD(c_) do { const size_t u_ = (size_t)chain * 64 + (c_); const bf16_t* xd_ = (const bf16_t*)(mxt + MXT_GD_XD) + u_ * 4096; const float* nd_ = (const float*)(mxb + MXB_GD_ND) + u_ * 4096; \
        _Pragma("unroll") for (int I = 0; I < 2; ++I) _Pragma("unroll") for (int J = 0; J < 2; ++J) _Pragma("unroll") for (int s2 = 0; s2 < 2; ++s2) xn[I][J][s2] = *(const bf16x8*)(xd_ + (size_t)(I * 2 + J) * 1024 + (s2 * 64 + lane) * 8); \
        _Pragma("unroll") for (int J = 0; J < 2; ++J) _Pragma("unroll") for (int q = 0; q < 4; ++q) nq[J][q] = *(const f32x4*)(nd_ + (size_t)(J * 2 + eJ) * 1024 + (q * 64 + lane) * 4); \
        gln = GL[u_]; } while (0)
        GDB_LOAD(0);
        for (int c = 0; c < 64; ++c) { const size_t uid = (size_t)chain * 64 + c;
            bf16x8 xf[2][2][2]; f32x16 nn[2]; const float gl = gln;
#pragma unroll
            for (int I = 0; I < 2; ++I)
#pragma unroll
                for (int J = 0; J < 2; ++J)
#pragma unroll
                    for (int s2 = 0; s2 < 2; ++s2) xf[I][J][s2] = xn[I][J][s2];
#pragma unroll
            for (int J = 0; J < 2; ++J)
#pragma unroll
                for (int q = 0; q < 4; ++q) { nn[J][4 * q] = nq[J][q][0]; nn[J][4 * q + 1] = nq[J][q][1]; nn[J][4 * q + 2] = nq[J][q][2]; nn[J][4 * q + 3] = nq[J][q][3]; }
            if (c + 1 < 64) GDB_LOAD(c + 1);
            bf16x8 sh[2][2];
            bf16_t* sd = (bf16_t*)(mxt + MXT_GD_SD) + uid * 4096;
#pragma unroll
            for (int I = 0; I < 2; ++I)
#pragma unroll
                for (int s2 = 0; s2 < 2; ++s2) { sh[I][s2] = pack8(S[I][8 * s2], S[I][8 * s2 + 1], S[I][8 * s2 + 2], S[I][8 * s2 + 3], S[I][8 * s2 + 4], S[I][8 * s2 + 5], S[I][8 * s2 + 6], S[I][8 * s2 + 7]);
                    *(bf16x8*)(sd + (size_t)(I * 2 + eJ) * 1024 + (s2 * 64 + lane) * 8) = sh[I][s2]; }
#pragma unroll
            for (int J = 0; J < 2; ++J) { f32x16 acc = nn[J];
#pragma unroll
                for (int I = 0; I < 2; ++I)
#pragma unroll
                    for (int s2 = 0; s2 < 2; ++s2) acc = __builtin_amdgcn_mfma_f32_32x32x16_bf16(xf[I][J][s2], sh[I][s2], acc, 0, 0, 0);
                nn[J] = acc; }
#pragma unroll
            for (int J = 0; J < 2; ++J)
#pragma unroll
                for (int i = 0; i < 16; ++i) S[J][i] = gl * S[J][i] + nn[J][i];
        }
    }
}

__device__ __forceinline__ void gdn_passC(ArgsP a, int l, LAS unsigned char* lds, const bf16_t* proj, bf16_t* H, unsigned char* mxb, unsigned char* mxt, int G) {
    int tid_ = threadIdx.x; asm volatile("" : "+v"(tid_)); const int tid = tid_, lane = tid & 63, wave = __builtin_amdgcn_readfirstlane(tid >> 6), r = lane & 31, hh = lane >> 5;
    LAS bf16_t* ob = (LAS bf16_t*)(lds + wave * 8192);
    f32x4 gnr[2][4];
#pragma unroll
    for (int eI = 0; eI < 2; ++eI)
#pragma unroll
        for (int q = 0; q < 4; ++q) gnr[eI][q] = *(const f32x4*)(a->in[I_GNG] + l * 64 + 32 * eI + 8 * q + 4 * hh);
    for (int wu = blockIdx.x * NWAVES + wave; wu < 8192; wu += G * NWAVES) {
        const int uid = wu >> 1, tJ = wu & 1; const int c = uid & 63, hd = (uid >> 6) & 7, b = uid >> 9; const size_t tok0 = (size_t)b * SEQ_ + (size_t)c * 64;
        const bf16_t* sd = (const bf16_t*)(mxt + MXT_GD_SD) + (size_t)uid * 4096; const bf16_t* qd = (const bf16_t*)(mxt + MXT_GD_QD) + (size_t)uid * 4096; const float* od = (const float*)(mxb + MXB_GD_OD) + (size_t)uid * 4096;
        f32x16 ao[2];
#pragma unroll
        for (int eI = 0; eI < 2; ++eI)
#pragma unroll
            for (int q = 0; q < 4; ++q) { const f32x4 v = *(const f32x4*)(od + (size_t)(eI * 2 + tJ) * 1024 + (q * 64 + lane) * 4); ao[eI][4 * q] = v[0]; ao[eI][4 * q + 1] = v[1]; ao[eI][4 * q + 2] = v[2]; ao[eI][4 * q + 3] = v[3]; }
#pragma unroll
        for (int dI = 0; dI < 2; ++dI)
#pragma unroll
            for (int s2 = 0; s2 < 2; ++s2) { const bf16x8 qf = *(const bf16x8*)(qd + (size_t)(dI * 2 + tJ) * 1024 + (s2 * 64 + lane) * 8);
#pragma unroll
                for (int eI = 0; eI < 2; ++eI) { const bf16x8 sf = *(const bf16x8*)(sd + (size_t)(dI * 2 + eI) * 1024 + (s2 * 64 + lane) * 8);
                    ao[eI] = __builtin_amdgcn_mfma_f32_32x32x16_bf16(sf, qf, ao[eI], 0, 0, 0); } }
        float sq = 0.f;
#pragma unroll
        for (int eI = 0; eI < 2; ++eI)
#pragma unroll
            for (int i = 0; i < 16; ++i) sq += ao[eI][i] * ao[eI][i];
        sq += __shfl_xor(sq, 32);
        const float rinv = rsqrtf(sq * (1.0f / 64.0f) + RMS_EPS);
        const size_t tok = tok0 + 32 * tJ + r;
#pragma unroll
        for (int eI = 0; eI < 2; ++eI)
#pragma unroll
            for (int q = 0; q < 4; ++q) { const int e0 = 32 * eI + 8 * q + 4 * hh; const f32x4 g4 = gnr[eI][q]; const u32x2 zw = *(const u32x2*)(proj + tok * NPROJ + PC_GDZ + hd * 64 + e0);
                u32x2 pw; pw.x = pg8::cvt_pk_bf16(ao[eI][4 * q] * rinv * g4[0] * silu_f(bflo(zw.x)), ao[eI][4 * q + 1] * rinv * g4[1] * silu_f(bfhi(zw.x)));
                pw.y = pg8::cvt_pk_bf16(ao[eI][4 * q + 2] * rinv * g4[2] * silu_f(bflo(zw.y)), ao[eI][4 * q + 3] * rinv * g4[3] * silu_f(bfhi(zw.y)));
                *(LAS u32x2*)(ob + r * 64 + e0) = pw; }
        LDS_WAIT(); asm volatile("" ::: "memory");
#pragma unroll
        for (int it = 0; it < 4; ++it) { const int row = it * 8 + (lane >> 3), c8 = (lane & 7) * 8;
            *(u32x4*)(H + (tok0 + 32 * tJ + row) * 2048 + 1536 + hd * 64 + c8) = *(const LAS u32x4*)(ob + row * 64 + c8); }
        LDS_WAIT(); asm volatile("" ::: "memory");
    }
}
constexpr int PPL = 12;
constexpr int NPH = 1 + PPL * DEPTH_;
#ifndef MK_N_LAUNCHES
#define MK_N_LAUNCHES 1
#endif
#ifndef PROBE_PH
#define PROBE_PH -2
#endif
#define REPS(k) ((PROBE_PH) == (k) ? 2 : 1)
#ifndef PG8_SP2
#define PG8_SP2 true
#endif
#ifndef PG8_ALIGN
#define PG8_ALIGN true
#endif
__global__ void __launch_bounds__(NWAVES * 64, 2) fwd(Args a_unused) {
    ArgsP kargs = (ArgsP)__builtin_amdgcn_kernarg_segment_ptr();
#define FRESH(a) ArgsP a = kargs; asm volatile("" : "+s"(a))
    extern __shared__ __attribute__((aligned(16))) unsigned char lds_raw[];
    LAS unsigned char* lds = (LAS unsigned char*)lds_raw;
    const int tid = threadIdx.x, G = gridDim.x;
    const int vcu = (G % 8 == 0) ? ((int)blockIdx.x % 8) * (G / 8) + (int)blockIdx.x / 8 : (int)blockIdx.x;
    for (int u = tid; u < (LDS_BYTES - MISC_OFF) / 4; u += NWAVES * 64) ((LAS unsigned*)(lds + MISC_OFF))[u] = 0u;
    __syncthreads();
    const int lo = kargs->ph_lo, hi = kargs->ph_hi;
    unsigned* barw = (unsigned*)(kargs->ws + WS_CTL) + CW_BAR + kargs->li * XCD_BAR_WORDS;
    if (hi - lo > 1) (void)xcd_barrier_post(barw, (volatile LAS unsigned*)(lds + LDS_BYTES - 16));
#define IN(k) (lo <= (k) && (k) < hi)
#define SEAM(k) do { if (IN(k) && IN((k) + 1)) { FRESH(ab_); XcdBarrier bb_; bb_.bar = (unsigned*)(ab_->ws + WS_CTL) + CW_BAR + ab_->li * XCD_BAR_WORDS; bb_.x = xb_xcc_id(); bb_.st = (volatile LAS unsigned*)(lds + LDS_BYTES - 16); xcd_barrier(bb_); } } while (0)
    if (IN(0)) for (int rep = 0; rep < REPS(-1); ++rep) { FRESH(a); p0_convert(a, lds, G); }
    SEAM(0);

    for (int l = 0; l < DEPTH_; ++l) {
        const int pb = 1 + PPL * l;
#define WSP(T_, off) ((T_*)(a->ws + (off)))
#define WL_(off) (a->ws + WS_W + (size_t)l * WL_STRIDE + (off))
        if (IN(pb + 0)) for (int rep = 0; rep < REPS(0); ++rep) { FRESH(a);
            { pg8::Gemm g{WSP(const bf16_t, WS_XB), (const bf16_t*)WL_(WL_IN), 1024, 1024, 1024}; pg8::StaticOrder S; S.init(T_, NIN_BF, G, (int)blockIdx.x);
              pg8::EpiProj E{WSP(bf16_t, WS_OV + OV_PROJ), WSP(float, WS_GSM)};
              pg8::gemm_phase<pg8::EpiProj, pg8::StaticOrder, PG8_ALIGN, PG8_SP2>(lds, g, S, E); }
            { pg8::Gemm8 g{WSP(const unsigned char, WS_X2), (const unsigned char*)WL_(WL_IN + WL_IN8), 1024, 1024, 1024}; pg8::P1F8Order S{G, (int)blockIdx.x};
              pg8::EpiProj8 E{WSP(bf16_t, WS_OV + OV_PROJ), WSP(bf16_t, WS_OV + OV_GD)};
              pg8::gemm_phase_f8<pg8::EpiProj8, pg8::P1F8Order, false>(lds, g, S, E); }
        }
        SEAM(pb + 0);

        if (IN(pb + 1)) for (int rep = 0; rep < REPS(1); ++rep) { FRESH(a);
            const bf16_t* proj = WSP(const bf16_t, WS_OV + OV_PROJ); bf16_t* Hb = WSP(bf16_t, WS_OV + OV_H); const float* gsm = WSP(const float, WS_GSM);
            for (int r2 = 0; r2 < REPS(11); ++r2) for (int u = (int)blockIdx.x; u < 256; u += G) lru_fast<0>(a, l, u >> 5, (u >> 2) & 7, (u & 3) * 16, (u & 3) * 16 + 16, lds, proj, Hb, a->ws + WS_MXS);
            for (int r2 = 0; r2 < REPS(12); ++r2) mlstm_passA(a, l, lds, proj, gsm, a->ws + WS_V, a->ws + WS_MXS, G);
            __syncthreads();
            for (int r2 = 0; r2 < REPS(13); ++r2) gdn_passA1(a, l, lds, proj, gsm, a->ws + WS_V, G);
        }
        SEAM(pb + 1);
        if (IN(pb + 2)) for (int rep = 0; rep < REPS(2); ++rep) { FRESH(a);
            const bf16_t* proj = WSP(const bf16_t, WS_OV + OV_PROJ); const float* gsm = WSP(const float, WS_GSM);
            for (int r2 = 0; r2 < REPS(22); ++r2) mlstm_passB(a->ws + WS_V, a->ws + WS_MXS, G); for (int r2 = 0; r2 < REPS(23); ++r2) gdn_passA2(a, l, lds, proj, gsm, a->ws + WS_V, a->ws + WS_MXS, a->ws + WS_MXS, G); }
        SEAM(pb + 2);
        if (IN(pb + 3)) for (int rep = 0; rep < REPS(3); ++rep) { FRESH(a);
            const bf16_t* proj = WSP(const bf16_t, WS_OV + OV_PROJ); bf16_t* Hb = WSP(bf16_t, WS_OV + OV_H); const float* gsm = WSP(const float, WS_GSM);
            const int nB = G >= 128 ? 64 : 0;
            if ((int)blockIdx.x < nB) { for (int r2 = 0; r2 < REPS(31); ++r2) gdn_passB(a->ws + WS_V, a->ws + WS_MXS, a->ws + WS_MXS, nB); }
            else {
                if (nB == 0) { gdn_passB(a->ws + WS_V, a->ws + WS_MXS, a->ws + WS_MXS, G); __syncthreads(); }
                for (int r2 = 0; r2 < REPS(33); ++r2) mlstm_passC(a, l, lds, proj, gsm, Hb, a->ws + WS_V, a->ws + WS_MXS, (int)blockIdx.x - nB, G - nB);
            }
        }
        SEAM(pb + 3);
        if (IN(pb + 4)) for (int rep = 0; rep < REPS(4); ++rep) { FRESH(a); gdn_passC(a, l, lds, WSP(const bf16_t, WS_OV + OV_PROJ), WSP(bf16_t, WS_OV + OV_H), a->ws + WS_V, a->ws + WS_MXS, G);
            for (int r2 = 0; r2 < REPS(32); ++r2) lru_apply(a, WSP(const bf16_t, WS_OV + OV_PROJ), WSP(bf16_t, WS_OV + OV_H), a->ws + WS_MXS, (int)blockIdx.x, G); }
        SEAM(pb + 4);

        if (IN(pb + 5)) for (int rep = 0; rep < REPS(5); ++rep) { FRESH(a);
            pg8::StaticOrder S; S.init(T_, 1024, G, (int)blockIdx.x);
            pg8::Gemm g{WSP(const bf16_t, WS_OV + OV_H), (const bf16_t*)WL_(WL_BR), 2048, 2048, 2048}; pg8::EpiMergeF E{WSP(const bf16_t, WS_OV + OV_GD), WSP(bf16_t, WS_MB)};
            pg8::gemm_phase<pg8::EpiMergeF, pg8::StaticOrder, PG8_ALIGN, PG8_SP2>(lds, g, S, E);
        }
        SEAM(pb + 5);

        if (IN(pb + 6)) for (int rep = 0; rep < REPS(6); ++rep) { FRESH(a);
            pg8::Gemm g{WSP(const bf16_t, WS_MB), (const bf16_t*)WL_(WL_OUT), 1024, 1024, 1024}; pg8::StaticOrder S; S.init(T_, 1024, G, (int)blockIdx.x);
            pg8::EpiWout E{l == 0 ? a->in[I_X] : (const float*)nullptr, WSP(const bf16_t, WS_XB), WSP(bf16_t, WS_V)};
            pg8::gemm_phase<pg8::EpiWout, pg8::StaticOrder, PG8_ALIGN, PG8_SP2>(lds, g, S, E);
        }
        SEAM(pb + 6);

        if (IN(pb + 7)) for (int rep = 0; rep < REPS(7); ++rep) { FRESH(a); p5_ln1_router(a, l, lds, G); }
        SEAM(pb + 7);

        if (IN(pb + 8)) for (int rep = 0; rep < REPS(8); ++rep) { FRESH(a); p6_slots(a, lds, G); }
        SEAM(pb + 8);

        if (IN(pb + 9)) for (int rep = 0; rep < REPS(9); ++rep) { FRESH(a);
            const int nb = moe_table(a, lds);
            pg8::MoeOrder S{8, G, vcu, nb * 8, (const LAS int*)(lds + MISC_OFF + 256)};
            { LAS int* gt = (LAS int*)(lds + GTAB_OFF); const int* tokb = WSP(const int, WS_TOKB);
              int tq_ = threadIdx.x; asm volatile("" : "+v"(tq_));
              for (int ui = 0; (long)ui * G + vcu < (long)nb * 8; ++ui) { const int pm = (int)(((long)ui * G + vcu) / 8); if (tq_ < 256) gt[ui * 256 + tq_] = tokb[(size_t)pm * 256 + tq_]; }
              __syncthreads(); }
            pg8::Gemm8 g{WSP(const unsigned char, WS_X1), (const unsigned char*)WL_(WL_W1), 1024, 1024, 1024};
            pg8::EpiMoe1F8 E{WSP(unsigned char, WS_OV + OV_ACT), a->in[I_B1] + (size_t)l * NE * 2048};
            pg8::gemm_phase_f8<pg8::EpiMoe1F8, pg8::MoeOrder, true>(lds, g, S, E, (const LAS int*)(lds + GTAB_OFF));
        }
        SEAM(pb + 9);

        if (IN(pb + 10)) for (int rep = 0; rep < REPS(10); ++rep) { FRESH(a);
            const int nb = moe_table(a, lds);
            pg8::MoeOrder S{4, G, vcu, nb * 4, (const LAS int*)(lds + MISC_OFF + 256)};
            pg8::Gemm8 g{WSP(const unsigned char, WS_OV + OV_ACT), (const unsigned char*)WL_(WL_W2), 1024, 1024, 1024};
            pg8::EpiMoe2F8 E{WSP(bf16_t, WS_OV + OV_YS), a->in[I_B2] + (size_t)l * NE * 1024, WSP(const float, WS_WBUF)};
            pg8::gemm_phase_f8<pg8::EpiMoe2F8, pg8::MoeOrder, false>(lds, g, S, E);
        }
        SEAM(pb + 10);

        if (IN(pb + 11)) for (int rep = 0; rep < REPS(11); ++rep) { FRESH(a); p9_combine_ln2(a, l, (l == DEPTH_ - 1) ? a->out : (float*)nullptr, G); }
        SEAM(pb + 11);
    }
#undef WSP
#undef WL_
#undef IN
#undef SEAM
}

extern "C" void kernel_launch(void* const* d_in, const int* in_sizes, int n_in, void* d_out, int out_size, void* d_ws, size_t ws_size, hipStream_t stream) {
    static int grid = 0;
    if (grid == 0) {
        if (n_in != 30 || in_sizes[0] != T_ * D_ || out_size != T_ * D_ || ws_size < WS_END) {
            fprintf(stderr, "kernel_launch: unexpected shapes: n_in %d in0 %d out %d ws %zu (need %zu); nothing launched\n", n_in, n_in > 0 ? in_sizes[0] : -1, out_size, ws_size, (size_t)WS_END); grid = -1; return; }
        int dev = 0, cus = 0;
        if (hipGetDevice(&dev) != hipSuccess || hipDeviceGetAttribute(&cus, hipDeviceAttributeMultiprocessorCount, dev) != hipSuccess) { grid = -1; return; }
        if (hipFuncSetAttribute((const void*)fwd, hipFuncAttributeMaxDynamicSharedMemorySize, LDS_BYTES) != hipSuccess) { fprintf(stderr, "kernel_launch: hipFuncSetAttribute failed\n"); grid = -1; return; }
        int per_cu = 0; (void)hipOccupancyMaxActiveBlocksPerMultiprocessor(&per_cu, (const void*)fwd, NWAVES * 64, LDS_BYTES); (void)hipGetLastError();
        if (per_cu < 1) fprintf(stderr, "kernel_launch: occupancy query reports %d blocks per CU\n", per_cu);
        grid = cus;
    }
    if (grid < 0) return;
    (void)hipMemsetAsync((char*)d_ws + WS_CTL, 0, CTL_ZERO_BYTES, stream);
    Args a{};
    for (int i = 0; i < 30; ++i) a.in[i] = (const float*)d_in[i];
    a.out = (float*)d_out; a.ws = (unsigned char*)d_ws;
    constexpr int NL = MK_N_LAUNCHES; static_assert(NL == NPH || NL <= 4, "barrier regions");
    for (int li = 0; li < NL; ++li) {
        a.ph_lo = (int)((long)NPH * li / NL); a.ph_hi = (int)((long)NPH * (li + 1) / NL); a.li = (NL <= 4) ? li : 0;
        hipLaunchKernelGGL(fwd, dim3(grid), dim3(NWAVES * 64), LDS_BYTES, stream, a);
        const hipError_t le = hipPeekAtLastError();
        if (le != hipSuccess) { fprintf(stderr, "kernel_launch: launch %d failed: %s\n", li, hipGetErrorName(le)); break; }
    }
}
```

```cpp
#include <hip/hip_runtime.h>
#include <cstdio>
#include <cstdint>

#define LAS __attribute__((address_space(3)))
#define GAS __attribute__((address_space(1)))
typedef unsigned short bf16_t;
typedef short bf16x8 __attribute__((ext_vector_type(8)));
typedef float f32x4 __attribute__((ext_vector_type(4)));
typedef float f32x2 __attribute__((ext_vector_type(2)));
typedef unsigned u32x4 __attribute__((ext_vector_type(4)));
typedef unsigned u32x2 __attribute__((ext_vector_type(2)));

constexpr int T_ = 32768, D_ = 1024, SEQ_ = 4096, NBATCH = 8, DEPTH_ = 2;
constexpr int DIN = 8728, NPROJ = 5632, NINP = 8960;
constexpr int NE = 32, DFF = 1024;
constexpr int PMAX = 139264;
constexpr int NCHUNK = 256, CHTOK = 128;
constexpr float DN_ALPHA = 1.41421356237309515f;
constexpr float LN_EPS = 1e-5f, RMS_EPS = 1e-6f;
constexpr float F8_SX = 16.0f, F8_SW1 = 128.0f, F8_SA = 8.0f, F8_SW2 = 256.0f, F8_SWI = 128.0f;
constexpr int PC_LRUX = 0, PC_MLQ = 1024, PC_MLK = 1280, PC_MLV = 1536, PC_GDQ = 2048, PC_GDK = 2560, PC_GDV = 3072, PC_LRUY = 3584, PC_MLO = 4608, PC_GDZ = 5120;
constexpr int NIN_BF = 3840, NIN_F8 = 5120;
constexpr size_t WL_IN8 = 8u << 20;

constexpr size_t MiB = 1u << 20;
constexpr size_t WS_CTL = 0, CTL_ZERO_BYTES = 64 * 1024;
constexpr size_t WS_HIST = 256 * 1024;
constexpr size_t WS_META = 320 * 1024;
constexpr size_t WS_RWB = 384 * 1024;
constexpr size_t WS_W = 1 * MiB;
constexpr size_t WL_IN = 0, WL_BR = 18 * MiB, WL_OUT = 22 * MiB, WL_W1 = 24 * MiB, WL_W2 = 152 * MiB, WL_G = 216 * MiB, WL_STRIDE = 217 * MiB;
constexpr size_t WS_XB = 436 * MiB;
constexpr size_t WS_GSM = 501 * MiB;
constexpr size_t WS_MB = 505 * MiB;
constexpr size_t WS_V = 569 * MiB;
constexpr size_t WS_X1 = 697 * MiB;
constexpr size_t WS_X1B = 825 * MiB;
constexpr size_t WS_X2 = 890 * MiB;
constexpr size_t WS_TKE = 1018 * MiB;
constexpr size_t WS_TKW = WS_TKE + 512 * 1024;
constexpr size_t WS_SLOT = 1019 * MiB;
constexpr size_t WS_WBUF = 1020 * MiB;
constexpr size_t WS_TOKB = 1021 * MiB;
constexpr size_t WS_OV = 1024 * MiB;
constexpr size_t OV_PROJ = 0, OV_GD = 352 * MiB, OV_H = 544 * MiB;
constexpr size_t OV_XS = 0, OV_ACT = 272 * MiB, OV_YS = 544 * MiB;
constexpr size_t WS_MXS = WS_OV + 816 * MiB;
constexpr size_t WS_END = WS_MXS + 104 * MiB;

constexpr int CW_BAR = 1024;

constexpr int RING_BYTES = 131072;
constexpr int MISC_OFF = RING_BYTES;
constexpr int GTAB_OFF = MISC_OFF + 4096;
constexpr int LDS_BYTES = 163840;
constexpr int NWAVES = 8;

#define LDS_WAIT() asm volatile("s_waitcnt lgkmcnt(0)" ::: "memory")
#define VM_WAIT() asm volatile("s_waitcnt vmcnt(0)" ::: "memory")

__device__ __forceinline__ unsigned f2bf(float f) { unsigned u = __builtin_bit_cast(unsigned, f); return (u + 0x7fffu + ((u >> 16) & 1u)) >> 16; }
__device__ __forceinline__ unsigned pk2(float lo, float hi) { return f2bf(lo) | (f2bf(hi) << 16); }
__device__ __forceinline__ float bf2f(unsigned short b) { return __builtin_bit_cast(float, (unsigned)b << 16); }
__device__ __forceinline__ float bflo(unsigned w) { return __builtin_bit_cast(float, w << 16); }
__device__ __forceinline__ float bfhi(unsigned w) { return __builtin_bit_cast(float, w & 0xffff0000u); }
__device__ __forceinline__ unsigned pk_fp8x4(float a, float b, float c, float d) { int p = __builtin_amdgcn_cvt_pk_fp8_f32(a, b, 0, false); p = __builtin_amdgcn_cvt_pk_fp8_f32(c, d, p, true); return (unsigned)p; }
__device__ __forceinline__ float wave_sum(float v) {
#pragma unroll
    for (int o = 1; o < 64; o <<= 1) v += __shfl_xor(v, o);
    return v;
}
__device__ __forceinline__ float wave_max(float v) {
#pragma unroll
    for (int o = 1; o < 64; o <<= 1) v = fmaxf(v, __shfl_xor(v, o));
    return v;
}
__device__ __forceinline__ float sigmoid_f(float x) { return __builtin_amdgcn_rcpf(1.f + __expf(-x)); }
__device__ __forceinline__ float silu_f(float x) { return x * __builtin_amdgcn_rcpf(1.f + __expf(-x)); }
__device__ __forceinline__ float neg_expm1_f(float t) {
    const float p = -t * (1.f + t * 0.5f * (1.f + t * (1.f / 3.f) * (1.f + t * 0.25f * (1.f + t * 0.2f * (1.f + t * (1.f / 6.f) * (1.f + t * (1.f / 7.f)))))));
    return t > -0.3f ? p : 1.f - __expf(t);
}
__device__ __forceinline__ float log1p_f(float e) { return e < 0.01f ? e * (1.f - e * (0.5f - e * ((1.f / 3.f) - 0.25f * e))) : __logf(1.f + e); }
__device__ __forceinline__ float softplus_f(float x) { return fmaxf(x, 0.f) + log1p_f(__expf(-fabsf(x))); }
__device__ __forceinline__ float gelu_tanh_f(float x) { const float u = 0.7978845608028654f * (x + 0.044715f * x * x * x); return x * __builtin_amdgcn_rcpf(1.f + __expf(-2.f * u)); }
namespace pg8 {
#define PG8_LAS __attribute__((address_space(3)))
constexpr int BM = 256, BK = 64, HALF = 128, HTB = HALF * BK * 2  , STAGE_BYTES = 8 * HTB, NXCD = 8, WGM = 8;

__host__ __device__ __forceinline__ int lds_byte(int r, int c) { const int st = (r >> 4) * 2 + (c >> 5), rr = r & 15, cc = c & 31, ob = rr * 64 + cc * 2; return st * 1024 + (ob ^ (((ob >> 9) & 1) << 5)); }
__host__ __device__ __forceinline__ void stage_rc(int b, int& R, int& C) { const int st = b / 1024, sb = b % 1024, swz = sb ^ (((sb >> 9) & 1) << 5); R = (st >> 1) * 16 + swz / 64; C = (st & 1) * 32 + (swz % 64) / 2; }
__host__ __device__ __forceinline__ int perm32(int rho) { const int n = rho >> 4, i = rho & 15; return 8 * (i >> 2) + 4 * n + (i & 3); }

struct Unit { int pm, pn; };
struct Gemm { const bf16_t* A; const bf16_t* Bt; int lda, ldb, K; };

struct StaticOrder {
    int nM, nN, nwg, G, c;
    __host__ __device__ void init(int M, int N, int G_, int c_) { nM = M / BM; nN = N / BM; nwg = nM * nN; G = G_; c = c_; }
    __host__ __device__ bool next(int i, Unit& u) const {
        const long L = (long)i * G + c; if (L >= nwg) return false;
        int wgid = (int)L; { const int q = nwg / NXCD, r = nwg % NXCD, xcd = wgid % NXCD, off = wgid / NXCD; wgid = (xcd < r ? xcd * (q + 1) : r * (q + 1) + (xcd - r) * q) + off; }
        const int nig = WGM * nN, gid = wgid / nig, fm = gid * WGM, gsz = (nM - fm) < WGM ? (nM - fm) : WGM;
        u.pm = fm + ((wgid % nig) % gsz); u.pn = (wgid % nig) / gsz; return true;
    }
    __device__ __forceinline__ void a_ready(const Unit&) const {}
    __device__ __forceinline__ void done(const Unit&) const {}
};

__device__ __forceinline__ unsigned cvt_pk_bf16(float lo, float hi) { unsigned r; asm volatile("v_cvt_pk_bf16_f32 %0, %1, %2" : "=v"(r) : "v"(lo), "v"(hi)); return r; }

template <class Epi, class Sched, bool ALIGN_EPI = false, bool SP2 = false, bool GATHER = false>
__device__ __forceinline__ void gemm_phase(PG8_LAS unsigned char* lds, const Gemm g, const Sched& S, const Epi& E, const PG8_LAS int* gtab = nullptr) {
    int tid_ = threadIdx.x; asm volatile("" : "+v"(tid_));
    const int tid = tid_, wid = __builtin_amdgcn_readfirstlane(tid >> 6), lane = tid & 63, wr = wid >> 2, wc = wid & 3, fr = lane & 15, fq = lane >> 4;
    const int K = g.K, nt = K / BK;
    unsigned voffA[2], voffB[2];
#pragma unroll
    for (int i = 0; i < 2; ++i) { int R, C; stage_rc(tid * 16 + i * 8192, R, C); const int Rb = Epi::PERM ? ((R & ~31) + perm32(R & 31)) : R;
        voffA[i] = (unsigned)(R * g.lda + C) * 2u; voffB[i] = (unsigned)(Rb * g.ldb + C) * 2u; }
    const size_t kstep = (size_t)(BK * 2);
    const size_t hstepA = (size_t)HALF * g.lda * 2, hstepB = (size_t)HALF * g.ldb * 2;
    const size_t tstepA = 2 * hstepA, tstepB = 2 * hstepB;
    const unsigned ldsw = (unsigned)wid * 1024u;
    const int aoff = lds_byte(wr * 64 + fr, fq * 8), boff = lds_byte(wc * 32 + fr, fq * 8);
    int gR0 = 0, gC0 = 0; if constexpr (GATHER) { stage_rc(tid * 16, gR0, gC0); }
#define PG8_STAGE_A(bufoff, aptr, koff, slot, h) do { if constexpr (GATHER) { _Pragma("unroll") for (int _i = 0; _i < 2; ++_i) { const unsigned _o = ((slot) == ui) ? gvo[2 * (h) + _i] : nvo[2 * (h) + _i]; \
            __builtin_amdgcn_global_load_lds((const unsigned*)((const char*)g.A + _o + (koff)), (PG8_LAS unsigned*)(lds + (bufoff) + ldsw + _i * 8192), 16, 0, 0); } } \
        else { PG8_STAGE(bufoff, aptr, voffA); } } while (0)
#define PG8_GLOAD(dst, s_) do { _Pragma("unroll") for (int _j = 0; _j < 4; ++_j) dst[_j] = (unsigned)gtab[(s_) * 256 + gR0 + 64 * _j] * (unsigned)(g.lda * 2) + (unsigned)(gC0 * 2); } while (0)
#define PG8_SA(b, h) (((b) * 2 + (h)) * HTB)
#define PG8_SB(b, h) ((4 + (b) * 2 + (h)) * HTB)
#define PG8_STAGE(bufoff, gbase, voff) do { _Pragma("unroll") for (int _i = 0; _i < 2; ++_i) \
        __builtin_amdgcn_global_load_lds((const unsigned*)((const char*)(gbase) + (voff)[_i]), (PG8_LAS unsigned*)(lds + (bufoff) + ldsw + _i * 8192), 16, 0, 0); } while (0)
#define PG8_LDA(dst, b, h) do { _Pragma("unroll") for (int m = 0; m < 4; ++m) _Pragma("unroll") for (int k = 0; k < 2; ++k) dst[m][k] = *(const PG8_LAS bf16x8*)(lds + PG8_SA(b, h) + aoff + m * 2048 + k * 1024); } while (0)
#define PG8_LDB(dst, b, h) do { _Pragma("unroll") for (int n = 0; n < 2; ++n) _Pragma("unroll") for (int k = 0; k < 2; ++k) dst[n][k] = *(const PG8_LAS bf16x8*)(lds + PG8_SB(b, h) + boff + n * 2048 + k * 1024); } while (0)
#define PG8_MMA(ai, bj, At, Bt) do { __builtin_amdgcn_s_setprio(1); _Pragma("unroll") for (int m = 0; m < 4; ++m) _Pragma("unroll") for (int n = 0; n < 2; ++n) _Pragma("unroll") for (int k = 0; k < 2; ++k) \
        acc[ai][bj][m][n] = __builtin_amdgcn_mfma_f32_16x16x32_bf16(Bt[n][k], At[m][k], acc[ai][bj][m][n], 0, 0, 0); __builtin_amdgcn_s_setprio(0); } while (0)
#define PG8_WAIT_V(n) asm volatile("s_waitcnt vmcnt(" #n ")" ::: "memory")
#define PG8_WAIT_L(n) asm volatile("s_waitcnt lgkmcnt(" #n ")" ::: "memory")
#define PG8_BAR __builtin_amdgcn_s_barrier()
#define PG8_SCHED __builtin_amdgcn_sched_barrier(0)
    Unit cur, nxt; int ui = 0;
    if (!S.next(0, cur)) return;
    unsigned gvo[4] = {0u, 0u, 0u, 0u}, nvo[4] = {0u, 0u, 0u, 0u};
    if constexpr (GATHER) { PG8_GLOAD(gvo, 0); }
    f32x4 acc[2][2][4][2];
#pragma unroll
    for (int a = 0; a < 2; ++a)
#pragma unroll
        for (int b = 0; b < 2; ++b)
#pragma unroll
            for (int m = 0; m < 4; ++m)
#pragma unroll
                for (int n = 0; n < 2; ++n) acc[a][b][m][n] = (f32x4){0.f, 0.f, 0.f, 0.f};
    bf16x8 At[4][2], B0[2][2], B1[2][2];
    const char* cA = (const char*)g.A + (size_t)cur.pm * tstepA; const char* cB = (const char*)g.Bt + (size_t)cur.pn * tstepB;
    S.a_ready(cur);
    if constexpr (SP2) {
        PG8_STAGE(PG8_SB(0, 0), cB, voffB); PG8_STAGE(PG8_SB(0, 1), cB + hstepB, voffB); PG8_STAGE_A(PG8_SA(0, 0), cA, 0, 0, 0); PG8_STAGE_A(PG8_SA(0, 1), cA + hstepA, 0, 0, 1);
        if (wr == 1) PG8_BAR;
        PG8_WAIT_V(2); PG8_BAR;
        PG8_STAGE(PG8_SB(1, 0), cB + kstep, voffB); PG8_STAGE_A(PG8_SA(1, 0), cA + kstep, kstep, 0, 0); PG8_STAGE(PG8_SB(1, 1), cB + hstepB + kstep, voffB);
        PG8_WAIT_V(6); PG8_BAR;
    } else {
        PG8_STAGE(PG8_SB(0, 0), cB, voffB); PG8_STAGE_A(PG8_SA(0, 0), cA, 0, 0, 0); PG8_STAGE(PG8_SB(0, 1), cB + hstepB, voffB); PG8_STAGE_A(PG8_SA(0, 1), cA + hstepA, 0, 0, 1);
        if (wr == 1) PG8_BAR;
        PG8_WAIT_V(4); PG8_BAR;
        PG8_STAGE(PG8_SB(1, 0), cB + kstep, voffB); PG8_STAGE_A(PG8_SA(1, 0), cA + kstep, kstep, 0, 0); PG8_STAGE(PG8_SB(1, 1), cB + hstepB + kstep, voffB);
        PG8_WAIT_V(6); PG8_BAR;
    }
    for (;;) {
        const bool has_next = S.next(ui + 1, nxt);
        if constexpr (GATHER) { if (has_next) { PG8_GLOAD(nvo, ui + 1); } else { _Pragma("unroll") for (int _j = 0; _j < 4; ++_j) nvo[_j] = gvo[_j]; } }
        const char* nA = has_next ? (const char*)g.A + (size_t)nxt.pm * tstepA : cA; const char* nB = has_next ? (const char*)g.Bt + (size_t)nxt.pn * tstepB : cB;
        int t = 0;
        for (int seg = 0; seg < (Epi::HAS_MID ? 3 : 1); ++seg) {
        const int tend = Epi::HAS_MID ? (seg == 0 ? Epi::MID0 : (seg == 1 ? Epi::MID1 : nt)) : nt;
        for (; t < tend; t += 2) {
            const bool last = (t == nt - 2);
            const char* a1 = cA + (size_t)(t + 1) * kstep;
            const char* a2 = last ? nA : cA + (size_t)(t + 2) * kstep; const char* b2 = last ? nB : cB + (size_t)(t + 2) * kstep;
            const char* a3 = a2 + kstep; const char* b3 = b2 + kstep;
            const size_t ka1 = (size_t)(t + 1) * kstep, ka2 = last ? 0 : (size_t)(t + 2) * kstep, ka3 = ka2 + kstep; const int sl2 = (last && has_next) ? ui + 1 : ui;
            if (last && has_next) S.a_ready(nxt);
            if constexpr (SP2) {
            PG8_LDB(B0, 0, 0); PG8_LDB(B1, 0, 1); PG8_SCHED; PG8_LDA(At, 0, 0); PG8_STAGE_A(PG8_SA(1, 1), a1 + hstepA, ka1, ui, 1);
            PG8_WAIT_V(8); PG8_WAIT_L(0); PG8_BAR; PG8_MMA(0, 0, At, B0); PG8_MMA(0, 1, At, B1); PG8_BAR; PG8_SCHED;
            PG8_LDA(At, 0, 1); PG8_STAGE(PG8_SB(0, 0), b2, voffB); PG8_STAGE(PG8_SB(0, 1), b2 + hstepB, voffB); PG8_STAGE_A(PG8_SA(0, 0), a2, ka2, sl2, 0);
            PG8_WAIT_V(8); PG8_WAIT_L(0); PG8_BAR; PG8_MMA(1, 0, At, B0); PG8_MMA(1, 1, At, B1); PG8_BAR; PG8_SCHED;
            PG8_LDB(B0, 1, 0); PG8_LDB(B1, 1, 1); PG8_SCHED; PG8_LDA(At, 1, 0); PG8_STAGE_A(PG8_SA(0, 1), a2 + hstepA, ka2, sl2, 1);
            PG8_WAIT_V(8); PG8_WAIT_L(0); PG8_BAR; PG8_MMA(0, 0, At, B0); PG8_MMA(0, 1, At, B1); PG8_BAR; PG8_SCHED;
            PG8_LDA(At, 1, 1); PG8_STAGE(PG8_SB(1, 0), b3, voffB); PG8_STAGE(PG8_SB(1, 1), b3 + hstepB, voffB); PG8_STAGE_A(PG8_SA(1, 0), a3, ka3, sl2, 0);
            PG8_WAIT_V(8); PG8_WAIT_L(0); PG8_BAR; PG8_MMA(1, 0, At, B0); PG8_MMA(1, 1, At, B1); PG8_BAR; PG8_SCHED;
            } else {
            PG8_LDB(B0, 0, 0); PG8_SCHED; PG8_LDA(At, 0, 0); PG8_STAGE_A(PG8_SA(1, 1), a1 + hstepA, ka1, ui, 1);
            PG8_WAIT_L(8); PG8_BAR; PG8_WAIT_L(0); PG8_MMA(0, 0, At, B0); PG8_BAR; PG8_SCHED;
            PG8_LDB(B1, 0, 1); PG8_STAGE(PG8_SB(0, 0), b2, voffB);
            PG8_BAR; PG8_WAIT_L(0); PG8_MMA(0, 1, At, B1); PG8_BAR;
            PG8_LDA(At, 0, 1); PG8_STAGE_A(PG8_SA(0, 0), a2, ka2, sl2, 0);
            PG8_BAR; PG8_WAIT_L(0); PG8_MMA(1, 0, At, B0); PG8_BAR; PG8_SCHED;
            PG8_STAGE(PG8_SB(0, 1), b2 + hstepB, voffB);
            PG8_WAIT_V(6); PG8_BAR; PG8_MMA(1, 1, At, B1); PG8_BAR;
            PG8_LDB(B0, 1, 0); PG8_SCHED; PG8_LDA(At, 1, 0); PG8_STAGE_A(PG8_SA(0, 1), a2 + hstepA, ka2, sl2, 1);
            PG8_WAIT_L(8); PG8_BAR; PG8_WAIT_L(0); PG8_MMA(0, 0, At, B0); PG8_BAR; PG8_SCHED;
            PG8_LDB(B1, 1, 1); PG8_STAGE(PG8_SB(1, 0), b3, voffB);
            PG8_BAR; PG8_WAIT_L(0); PG8_MMA(0, 1, At, B1); PG8_BAR;
            PG8_LDA(At, 1, 1); PG8_STAGE_A(PG8_SA(1, 0), a3, ka3, sl2, 0);
            PG8_BAR; PG8_WAIT_L(0); PG8_MMA(1, 0, At, B0); PG8_BAR; PG8_SCHED;
            PG8_STAGE(PG8_SB(1, 1), b3 + hstepB, voffB);
            PG8_WAIT_V(6); PG8_BAR; PG8_MMA(1, 1, At, B1); PG8_BAR;
            }
        }
        if constexpr (Epi::HAS_MID) { if (seg < 2) E.mid(acc, cur, wr, wc, fr, fq, seg); }
        }
        if constexpr (ALIGN_EPI) { if (wr == 0) PG8_BAR; }
        E(acc, cur, wr, wc, fr, fq); S.done(cur);
        if (!has_next) break;
#pragma unroll
        for (int a = 0; a < 2; ++a)
#pragma unroll
            for (int b = 0; b < 2; ++b)
#pragma unroll
                for (int m = 0; m < 4; ++m)
#pragma unroll
                    for (int n = 0; n < 2; ++n) acc[a][b][m][n] = (f32x4){0.f, 0.f, 0.f, 0.f};
        cur = nxt; cA = nA; cB = nB; ++ui;
        if constexpr (GATHER) { _Pragma("unroll") for (int _j = 0; _j < 4; ++_j) gvo[_j] = nvo[_j]; }
        if constexpr (ALIGN_EPI) { if (wr == 1) PG8_BAR; }
    }
    PG8_WAIT_V(0);
    if constexpr (!ALIGN_EPI) { if (wr == 0) PG8_BAR; }
    PG8_BAR;
#undef PG8_SA
#undef PG8_SB
#undef PG8_STAGE
#undef PG8_STAGE_A
#undef PG8_GLOAD
#undef PG8_LDA
#undef PG8_LDB
#undef PG8_MMA
#undef PG8_WAIT_V
#undef PG8_WAIT_L
#undef PG8_BAR
#undef PG8_SCHED
}
}
namespace pg8 {
typedef int i32x4v __attribute__((ext_vector_type(4)));
typedef int i32x8 __attribute__((ext_vector_type(8)));
struct Gemm8 { const unsigned char* A; const unsigned char* Bt; int lda, ldb, K; };
template <class Epi, class Sched, bool GATHER = false>
__device__ __forceinline__ void gemm_phase_f8(PG8_LAS unsigned char* lds, const Gemm8 g, const Sched& S, const Epi& E, const PG8_LAS int* gtab = nullptr) {
    constexpr bool ALIGN_EPI = true, SP2 = true;
    int tid_ = threadIdx.x; asm volatile("" : "+v"(tid_));
    const int tid = tid_, wid = __builtin_amdgcn_readfirstlane(tid >> 6), lane = tid & 63, wr = wid >> 2, wc = wid & 3, fr = lane & 15, fq = lane >> 4;
    int K_ = g.K; asm volatile("" : "+s"(K_));
    const int K = K_, nt = K / 128;
    unsigned voffA[2], voffB[2];
#pragma unroll
    for (int i = 0; i < 2; ++i) { int R, C; stage_rc(tid * 16 + i * 8192, R, C); const int Rb = Epi::PERM ? ((R & ~31) + perm32(R & 31)) : R;
        voffA[i] = (unsigned)(R * g.lda + C * 2); voffB[i] = (unsigned)(Rb * g.ldb + C * 2); }
    const size_t kstep = (size_t)(BK * 2);
    const size_t hstepA = (size_t)HALF * g.lda, hstepB = (size_t)HALF * g.ldb;
    const size_t tstepA = 2 * hstepA, tstepB = 2 * hstepB;
    const unsigned ldsw = (unsigned)wid * 1024u;
    const int aoff = lds_byte(wr * 64 + fr, fq * 16), boff = lds_byte(wc * 32 + fr, fq * 16);
    int gR0 = 0, gC0 = 0; if constexpr (GATHER) { stage_rc(tid * 16, gR0, gC0); }
#define PG8_STAGE_A(bufoff, aptr, koff, slot, h) do { if constexpr (GATHER) { _Pragma("unroll") for (int _i = 0; _i < 2; ++_i) { const unsigned _o = ((slot) == ui) ? gvo[2 * (h) + _i] : nvo[2 * (h) + _i]; \
            __builtin_amdgcn_global_load_lds((const unsigned*)((const char*)g.A + _o + (koff)), (PG8_LAS unsigned*)(lds + (bufoff) + ldsw + _i * 8192), 16, 0, 0); } } \
        else { PG8_STAGE(bufoff, aptr, voffA); } } while (0)
#define PG8_GLOAD(dst, s_) do { _Pragma("unroll") for (int _j = 0; _j < 4; ++_j) dst[_j] = (unsigned)gtab[(s_) * 256 + gR0 + 64 * _j] * (unsigned)(g.lda) + (unsigned)(gC0 * 2); } while (0)
#define PG8_SA(b, h) (((b) * 2 + (h)) * HTB)
#define PG8_SB(b, h) ((4 + (b) * 2 + (h)) * HTB)
#define PG8_STAGE(bufoff, gbase, voff) do { _Pragma("unroll") for (int _i = 0; _i < 2; ++_i) \
        __builtin_amdgcn_global_load_lds((const unsigned*)((const char*)(gbase) + (voff)[_i]), (PG8_LAS unsigned*)(lds + (bufoff) + ldsw + _i * 8192), 16, 0, 0); } while (0)
#define PG8_LDA(dst, b, h) do { _Pragma("unroll") for (int m = 0; m < 4; ++m) { const i32x4v lo_ = *(const PG8_LAS i32x4v*)(lds + PG8_SA(b, h) + aoff + m * 2048), hi_ = *(const PG8_LAS i32x4v*)(lds + PG8_SA(b, h) + aoff + m * 2048 + 16); dst[m] = __builtin_shufflevector(lo_, hi_, 0, 1, 2, 3, 4, 5, 6, 7); } } while (0)
#define PG8_LDB(dst, b, h) do { _Pragma("unroll") for (int n = 0; n < 2; ++n) { const i32x4v lo_ = *(const PG8_LAS i32x4v*)(lds + PG8_SB(b, h) + boff + n * 2048), hi_ = *(const PG8_LAS i32x4v*)(lds + PG8_SB(b, h) + boff + n * 2048 + 16); dst[n] = __builtin_shufflevector(lo_, hi_, 0, 1, 2, 3, 4, 5, 6, 7); } } while (0)
#define PG8_MMA(ai, bj, At, Bt) do { __builtin_amdgcn_s_setprio(1); _Pragma("unroll") for (int m = 0; m < 4; ++m) _Pragma("unroll") for (int n = 0; n < 2; ++n) \
        asm volatile("v_mfma_scale_f32_16x16x128_f8f6f4 %0, %1, %2, %0, %3, %3 op_sel_hi:[0,0,0]" : "+v"(acc[ai][bj][m][n]) : "v"(Bt[n]), "v"(At[m]), "v"(sc1)); __builtin_amdgcn_s_setprio(0); } while (0)
#define PG8_WAIT_V(n) asm volatile("s_waitcnt vmcnt(" #n ")" ::: "memory")
#define PG8_WAIT_L(n) asm volatile("s_waitcnt lgkmcnt(" #n ")" ::: "memory")
#define PG8_BAR __builtin_amdgcn_s_barrier()
#define PG8_SCHED __builtin_amdgcn_sched_barrier(0)
    Unit cur, nxt; int ui = 0;
    if (!S.next(0, cur)) return;
    unsigned gvo[4] = {0u, 0u, 0u, 0u}, nvo[4] = {0u, 0u, 0u, 0u};
    if constexpr (GATHER) { PG8_GLOAD(gvo, 0); }
    f32x4 acc[2][2][4][2];
#pragma unroll
    for (int a = 0; a < 2; ++a)
#pragma unroll
        for (int b = 0; b < 2; ++b)
#pragma unroll
            for (int m = 0; m < 4; ++m)
#pragma unroll
                for (int n = 0; n < 2; ++n) acc[a][b][m][n] = (f32x4){0.f, 0.f, 0.f, 0.f};
    i32x8 At[4], B0[2], B1[2];
    int sc1 = 0x7f7f7f7f; asm volatile("" : "+v"(sc1));
    const char* cA = (const char*)g.A + (size_t)cur.pm * tstepA; const char* cB = (const char*)g.Bt + (size_t)cur.pn * tstepB;
    S.a_ready(cur);
    if constexpr (SP2) {
        PG8_STAGE(PG8_SB(0, 0), cB, voffB); PG8_STAGE(PG8_SB(0, 1), cB + hstepB, voffB); PG8_STAGE_A(PG8_SA(0, 0), cA, 0, 0, 0); PG8_STAGE_A(PG8_SA(0, 1), cA + hstepA, 0, 0, 1);
        if (wr == 1) PG8_BAR;
        PG8_WAIT_V(2); PG8_BAR;
        PG8_STAGE(PG8_SB(1, 0), cB + kstep, voffB); PG8_STAGE_A(PG8_SA(1, 0), cA + kstep, kstep, 0, 0); PG8_STAGE(PG8_SB(1, 1), cB + hstepB + kstep, voffB);
        PG8_WAIT_V(6); PG8_BAR;
    } else {
        PG8_STAGE(PG8_SB(0, 0), cB, voffB); PG8_STAGE_A(PG8_SA(0, 0), cA, 0, 0, 0); PG8_STAGE(PG8_SB(0, 1), cB + hstepB, voffB); PG8_STAGE_A(PG8_SA(0, 1), cA + hstepA, 0, 0, 1);
        if (wr == 1) PG8_BAR;
        PG8_WAIT_V(4); PG8_BAR;
        PG8_STAGE(PG8_SB(1, 0), cB + kstep, voffB); PG8_STAGE_A(PG8_SA(1, 0), cA + kstep, kstep, 0, 0); PG8_STAGE(PG8_SB(1, 1), cB + hstepB + kstep, voffB);
        PG8_WAIT_V(6); PG8_BAR;
    }
    for (;;) {
        const bool has_next = S.next(ui + 1, nxt);
        if constexpr (GATHER) { if (has_next) { PG8_GLOAD(nvo, ui + 1); } else { _Pragma("unroll") for (int _j = 0; _j < 4; ++_j) nvo[_j] = gvo[_j]; } }
        const char* nA = has_next ? (const char*)g.A + (size_t)nxt.pm * tstepA : cA; const char* nB = has_next ? (const char*)g.Bt + (size_t)nxt.pn * tstepB : cB;
        int t = 0;
        for (int seg = 0; seg < (Epi::HAS_MID ? 3 : 1); ++seg) {
        const int tend = Epi::HAS_MID ? (seg == 0 ? Epi::MID0 : (seg == 1 ? Epi::MID1 : nt)) : nt;
#pragma unroll 1
        for (; t < tend; t += 2) {
            const bool last = (t == nt - 2);
            const char* a1 = cA + (size_t)(t + 1) * kstep;
            const char* a2 = last ? nA : cA + (size_t)(t + 2) * kstep; const char* b2 = last ? nB : cB + (size_t)(t + 2) * kstep;
            const char* a3 = a2 + kstep; const char* b3 = b2 + kstep;
            const size_t ka1 = (size_t)(t + 1) * kstep, ka2 = last ? 0 : (size_t)(t + 2) * kstep, ka3 = ka2 + kstep; const int sl2 = (last && has_next) ? ui + 1 : ui;
            if (last && has_next) S.a_ready(nxt);
            if constexpr (SP2) {
            PG8_LDB(B0, 0, 0); PG8_LDB(B1, 0, 1); PG8_SCHED; PG8_LDA(At, 0, 0); PG8_STAGE_A(PG8_SA(1, 1), a1 + hstepA, ka1, ui, 1);
            PG8_WAIT_V(8); PG8_WAIT_L(0); PG8_BAR; PG8_MMA(0, 0, At, B0); PG8_MMA(0, 1, At, B1); PG8_BAR; PG8_SCHED;
            PG8_LDA(At, 0, 1); PG8_STAGE(PG8_SB(0, 0), b2, voffB); PG8_STAGE(PG8_SB(0, 1), b2 + hstepB, voffB); PG8_STAGE_A(PG8_SA(0, 0), a2, ka2, sl2, 0);
            PG8_WAIT_V(8); PG8_WAIT_L(0); PG8_BAR; PG8_MMA(1, 0, At, B0); PG8_MMA(1, 1, At, B1); PG8_BAR; PG8_SCHED;
            PG8_LDB(B0, 1, 0); PG8_LDB(B1, 1, 1); PG8_SCHED; PG8_LDA(At, 1, 0); PG8_STAGE_A(PG8_SA(0, 1), a2 + hstepA, ka2, sl2, 1);
            PG8_WAIT_V(8); PG8_WAIT_L(0); PG8_BAR; PG8_MMA(0, 0, At, B0); PG8_MMA(0, 1, At, B1); PG8_BAR; PG8_SCHED;
            PG8_LDA(At, 1, 1); PG8_STAGE(PG8_SB(1, 0), b3, voffB); PG8_STAGE(PG8_SB(1, 1), b3 + hstepB, voffB); PG8_STAGE_A(PG8_SA(1, 0), a3, ka3, sl2, 0);
            PG8_WAIT_V(8); PG8_WAIT_L(0); PG8_BAR; PG8_MMA(1, 0, At, B0); PG8_MMA(1, 1, At, B1); PG8_BAR; PG8_SCHED;
            } else {
            PG8_LDB(B0, 0, 0); PG8_SCHED; PG8_LDA(At, 0, 0); PG8_STAGE_A(PG8_SA(1, 1), a1 + hstepA, ka1, ui, 1);
            PG8_WAIT_L(8); PG8_BAR; PG8_WAIT_L(0); PG8_MMA(0, 0, At, B0); PG8_BAR; PG8_SCHED;
            PG8_LDB(B1, 0, 1); PG8_STAGE(PG8_SB(0, 0), b2, voffB);
            PG8_BAR; PG8_WAIT_L(0); PG8_MMA(0, 1, At, B1); PG8_BAR;
            PG8_LDA(At, 0, 1); PG8_STAGE_A(PG8_SA(0, 0), a2, ka2, sl2, 0);
            PG8_BAR; PG8_WAIT_L(0); PG8_MMA(1, 0, At, B0); PG8_BAR; PG8_SCHED;
            PG8_STAGE(PG8_SB(0, 1), b2 + hstepB, voffB);
            PG8_WAIT_V(6); PG8_BAR; PG8_MMA(1, 1, At, B1); PG8_BAR;
            PG8_LDB(B0, 1, 0); PG8_SCHED; PG8_LDA(At, 1, 0); PG8_STAGE_A(PG8_SA(0, 1), a2 + hstepA, ka2, sl2, 1);
            PG8_WAIT_L(8); PG8_BAR; PG8_WAIT_L(0); PG8_MMA(0, 0, At, B0); PG8_BAR; PG8_SCHED;
            PG8_LDB(B1, 1, 1); PG8_STAGE(PG8_SB(1, 0), b3, voffB);
            PG8_BAR; PG8_WAIT_L(0); PG8_MMA(0, 1, At, B1); PG8_BAR;
            PG8_LDA(At, 1, 1); PG8_STAGE_A(PG8_SA(1, 0), a3, ka3, sl2, 0);
            PG8_BAR; PG8_WAIT_L(0); PG8_MMA(1, 0, At, B0); PG8_BAR; PG8_SCHED;
            PG8_STAGE(PG8_SB(1, 1), b3 + hstepB, voffB);
            PG8_WAIT_V(6); PG8_BAR; PG8_MMA(1, 1, At, B1); PG8_BAR;
            }
        }
        if constexpr (Epi::HAS_MID) { if (seg < 2) E.mid(acc, cur, wr, wc, fr, fq, seg); }
        }
        if constexpr (ALIGN_EPI) { if (wr == 0) PG8_BAR; }
        asm volatile("s_nop 15\n\ts_nop 15" ::: "memory");
        E(acc, cur, wr, wc, fr, fq); S.done(cur);
        if (!has_next) break;
#pragma unroll
        for (int a = 0; a < 2; ++a)
#pragma unroll
            for (int b = 0; b < 2; ++b)
#pragma unroll
                for (int m = 0; m < 4; ++m)
#pragma unroll
                    for (int n = 0; n < 2; ++n) acc[a][b][m][n] = (f32x4){0.f, 0.f, 0.f, 0.f};
        cur = nxt; cA = nA; cB = nB; ++ui;
        if constexpr (GATHER) { _Pragma("unroll") for (int _j = 0; _j < 4; ++_j) gvo[_j] = nvo[_j]; }
        if constexpr (ALIGN_EPI) { if (wr == 1) PG8_BAR; }
    }
    PG8_WAIT_V(0);
    if constexpr (!ALIGN_EPI) { if (wr == 0) PG8_BAR; }
    PG8_BAR;
#undef PG8_SA
#undef PG8_SB
#undef PG8_STAGE
#undef PG8_STAGE_A
#undef PG8_GLOAD
#undef PG8_LDA
#undef PG8_LDB
#undef PG8_MMA
#undef PG8_WAIT_V
#undef PG8_WAIT_L
#undef PG8_BAR
#undef PG8_SCHED
}
}
#define XB_TMO      128
#define XB_XCNT(j)  (256  + 64 * (j))
#define XB_XSUB(j)  (1280 + 64 * (j))
#define XB_XGEN(j)  (2304 + 64 * (j))
#define XB_TOP      3328
#define XB_TOPGEN   3392
#define XCD_BAR_WORDS 3456
#define XB_SPIN_CAP (1u << 18)

__device__ __forceinline__ unsigned xb_ld(unsigned* p)              { return __hip_atomic_load(p, __ATOMIC_RELAXED, __HIP_MEMORY_SCOPE_AGENT); }
__device__ __forceinline__ unsigned xb_add(unsigned* p, unsigned v) { return __hip_atomic_fetch_add(p, v, __ATOMIC_RELAXED, __HIP_MEMORY_SCOPE_AGENT); }
__device__ __forceinline__ unsigned xb_xcc_id() { return (unsigned)__builtin_amdgcn_s_getreg((3 << 11) | 20) & 0xFu; }
#define XB_SPIN(cond, bar) do { unsigned _sp = 0; while (cond) { __builtin_amdgcn_s_sleep(1); \
    if ((++_sp & 255u) == 0u) { if (xb_ld(&(bar)[XB_TMO])) break; if (_sp > XB_SPIN_CAP) { atomicAdd(&(bar)[XB_TMO], 1u); break; } } } } while (0)

struct XcdBarrier {
    unsigned* bar; unsigned x;
    volatile LAS unsigned* st;
};

__device__ __forceinline__ XcdBarrier xcd_barrier_post(unsigned* bar, volatile LAS unsigned* st) {
    XcdBarrier b; b.bar = bar; b.x = xb_xcc_id(); b.st = st;
    if (threadIdx.x == 0) (void)xb_add(&bar[XB_XCNT(b.x)], 1u);
    return b;
}
__device__ __forceinline__ void xcd_barrier_complete(unsigned* bar, unsigned x, unsigned& nloc, unsigned& nx) {
    const unsigned G = gridDim.x * gridDim.y * gridDim.z;
    unsigned sum, cnt, mine, sp = 0u;
    for (;;) {
        sum = 0u; cnt = 0u; mine = 0u;
#pragma unroll
        for (unsigned j = 0; j < 16; ++j) { const unsigned c = xb_ld(&bar[XB_XCNT(j)]); sum += c; cnt += (c > 0u) ? 1u : 0u; mine = (j == x) ? c : mine; }
        if (sum == G) break;
        __builtin_amdgcn_s_sleep(1);
        if ((++sp & 255u) == 0u) { if (xb_ld(&bar[XB_TMO])) break; if (sp > XB_SPIN_CAP) { atomicAdd(&bar[XB_TMO], 1u); break; } }
    }
    nloc = mine > 0u ? mine : 1u; nx = cnt > 0u ? cnt : 1u;
}

__device__ __forceinline__ void xcd_barrier(const XcdBarrier& b) {
    asm volatile("s_waitcnt vmcnt(0)" ::: "memory");
    __syncthreads();
    if (threadIdx.x == 0) {
        unsigned* bar = b.bar;
        __builtin_amdgcn_s_waitcnt(0);
        unsigned nloc = b.st[0], nx = b.st[1];
        if (nloc == 0u) { xcd_barrier_complete(bar, b.x, nloc, nx); b.st[0] = nloc; b.st[1] = nx; }
        const unsigned old = xb_add(&bar[XB_XSUB(b.x)], 1u);
        const unsigned gen = old / nloc;
        if (old + 1u == (gen + 1u) * nloc) {
            __builtin_amdgcn_fence(__ATOMIC_RELEASE, "agent");
            asm volatile("s_waitcnt vmcnt(0)" ::: "memory");
            const unsigned og = xb_add(&bar[XB_TOP], 1u);
            const unsigned tg = og / nx;
            if (og + 1u == (tg + 1u) * nx) xb_add(&bar[XB_TOPGEN], 1u);
            else XB_SPIN(xb_ld(&bar[XB_TOPGEN]) == tg, bar);
            __builtin_amdgcn_fence(__ATOMIC_ACQUIRE, "agent");
            xb_add(&bar[XB_XGEN(b.x)], 1u);
            asm volatile("s_waitcnt vmcnt(0)" ::: "memory");
        } else {
            XB_SPIN(xb_ld(&bar[XB_XGEN(b.x)]) == gen, bar);
            __builtin_amdgcn_fence(__ATOMIC_ACQUIRE, "agent");
            asm volatile("s_waitcnt vmcnt(0)" ::: "memory");
        }
    }
    __syncthreads();
}
namespace pg8 {
struct EpiProj {
    static constexpr bool PERM = true, HAS_MID = false; static constexpr int MID0 = 0, MID1 = 0;
    __device__ __forceinline__ void mid(f32x4 (&)[2][2][4][2], const Unit&, int, int, int, int, int) const {}
    bf16_t* proj; float* gsm;
    __device__ __forceinline__ void operator()(const f32x4 (&acc)[2][2][4][2], const Unit& u, int wr, int wc, int fr, int fq) const {
        const int row0 = u.pm * BM + wr * 64 + fr;
        if (u.pn < 14) {
            const int col0 = u.pn * BM + wc * 32 + 8 * fq;
#pragma unroll
            for (int ai = 0; ai < 2; ++ai)
#pragma unroll
                for (int m = 0; m < 4; ++m) { bf16_t* rowp = proj + (size_t)(row0 + ai * HALF + m * 16) * NPROJ + col0;
#pragma unroll
                    for (int bj = 0; bj < 2; ++bj) { const f32x4 v0 = acc[ai][bj][m][0], v1 = acc[ai][bj][m][1];
                        u32x4 w; w.x = cvt_pk_bf16(v0[0], v0[1]); w.y = cvt_pk_bf16(v0[2], v0[3]); w.z = cvt_pk_bf16(v1[0], v1[1]); w.w = cvt_pk_bf16(v1[2], v1[3]);
                        *(u32x4*)(rowp + bj * HALF) = w; } }
        } else if (wc == 0 && fq < 3) {
#pragma unroll
            for (int ai = 0; ai < 2; ++ai)
#pragma unroll
                for (int m = 0; m < 4; ++m) { float* rowp = gsm + (size_t)(row0 + ai * HALF + m * 16) * 32 + 8 * fq;
                    *(f32x4*)(rowp) = acc[ai][0][m][0]; *(f32x4*)(rowp + 4) = acc[ai][0][m][1]; }
        }
    }
};
struct EpiProj8 {
    static constexpr bool PERM = true, HAS_MID = false; static constexpr int MID0 = 0, MID1 = 0;
    __device__ __forceinline__ void mid(f32x4 (&)[2][2][4][2], const Unit&, int, int, int, int, int) const {}
    bf16_t* proj; bf16_t* gd;
    __device__ __forceinline__ void operator()(const f32x4 (&acc)[2][2][4][2], const Unit& u, int wr, int wc, int fr, int fq) const {
        constexpr float sc = 1.0f / (F8_SX * F8_SWI);
        const int row0 = u.pm * BM + wr * 64 + fr;
        if (u.pn >= 8) {
            const int gt = u.pn - 8; bf16_t* base = gd + ((size_t)((gt >> 2) * 128 + u.pm) * 4 + (gt & 3)) * 65536 + (size_t)((wr * 4 + wc) * 64 + fq * 16 + fr) * 8;
#pragma unroll
            for (int ai = 0; ai < 2; ++ai)
#pragma unroll
                for (int m = 0; m < 4; ++m)
#pragma unroll
                    for (int bj = 0; bj < 2; ++bj) { constexpr float sg = -sc * 1.4426950408889634f;
                        f32x4 v0 = acc[ai][bj][m][0] * sg, v1 = acc[ai][bj][m][1] * sg;
#pragma unroll
                        for (int q = 0; q < 4; ++q) { v0[q] = fminf(v0[q], 57.0f); v1[q] = fminf(v1[q], 57.0f); }
                        u32x4 w; w.x = cvt_pk_bf16(v0[0], v0[1]); w.y = cvt_pk_bf16(v0[2], v0[3]); w.z = cvt_pk_bf16(v1[0], v1[1]); w.w = cvt_pk_bf16(v1[2], v1[3]);
                        *(u32x4*)(base + (size_t)((ai * 4 + m) * 2 + bj) * 4096) = w; }
        } else {
            const int col0 = PC_LRUY + u.pn * BM + wc * 32 + 8 * fq;
#pragma unroll
            for (int ai = 0; ai < 2; ++ai)
#pragma unroll
                for (int m = 0; m < 4; ++m) { bf16_t* rowp = proj + (size_t)(row0 + ai * HALF + m * 16) * NPROJ + col0;
#pragma unroll
                    for (int bj = 0; bj < 2; ++bj) { const f32x4 v0 = acc[ai][bj][m][0] * sc, v1 = acc[ai][bj][m][1] * sc;
                        u32x4 w; w.x = cvt_pk_bf16(v0[0], v0[1]); w.y = cvt_pk_bf16(v0[2], v0[3]); w.z = cvt_pk_bf16(v1[0], v1[1]); w.w = cvt_pk_bf16(v1[2], v1[3]);
                        *(u32x4*)(rowp + bj * HALF) = w; } }
        }
    }
};
struct P1F8Order {
    int G, c;
    __device__ __forceinline__ bool next(int i, Unit& u) const {
        int L;
        if (G == 256) { const int cnt = c < 128 ? 9 : 11; if (i >= cnt) return false; L = (c < 128 ? c * 9 : 1152 + (c - 128) * 11) + i; }
        else { L = i * G + c; if (L >= 128 * 20) return false; }
        u.pm = L / 20; u.pn = L % 20; return true;
    }
    __device__ __forceinline__ void a_ready(const Unit&) const {}
    __device__ __forceinline__ void done(const Unit&) const {}
};
struct EpiMergeF {
    static constexpr bool PERM = true, HAS_MID = true; static constexpr int MID0 = 16, MID1 = 24;
    const bf16_t* gd; bf16_t* mb;
    static __device__ __forceinline__ float em(float x) { return __builtin_amdgcn_exp2f(x); }
    __device__ __forceinline__ void mid(f32x4 (&acc)[2][2][4][2], const Unit& u, int wr, int wc, int fr, int fq, int st) const {
        int toff = ((wr * 4 + wc) * 64 + fq * 16 + fr) * 8; asm volatile("" : "+v"(toff));
        const bf16_t* ga_ = gd + ((size_t)(st * 128 + u.pm) * 4 + u.pn) * 65536 + toff; const bf16_t* gb_ = ga_ + (size_t)128 * 4 * 65536;
#pragma unroll
        for (int ai = 0; ai < 2; ++ai) {
            u32x4 ga[4][2], gb[4][2];
#pragma unroll
            for (int m = 0; m < 4; ++m)
#pragma unroll
                for (int bj = 0; bj < 2; ++bj) { const int o = ((ai * 4 + m) * 2 + bj) * 4096; ga[m][bj] = *(const u32x4*)(ga_ + o); gb[m][bj] = *(const u32x4*)(gb_ + o); }
#pragma unroll
            for (int m = 0; m < 4; ++m)
#pragma unroll
                for (int bj = 0; bj < 2; ++bj) { const unsigned xa[4] = {ga[m][bj].x, ga[m][bj].y, ga[m][bj].z, ga[m][bj].w}, xb[4] = {gb[m][bj].x, gb[m][bj].y, gb[m][bj].z, gb[m][bj].w};
#pragma unroll
                    for (int q = 0; q < 4; ++q) { const float r0 = (1.f + em(bflo(xb[q]))) * __builtin_amdgcn_rcpf(1.f + em(bflo(xa[q]))), r1 = (1.f + em(bfhi(xb[q]))) * __builtin_amdgcn_rcpf(1.f + em(bfhi(xa[q])));
                        acc[ai][bj][m][q >> 1][(q & 1) * 2] *= r0; acc[ai][bj][m][q >> 1][(q & 1) * 2 + 1] *= r1; } }
            asm volatile("" ::: "memory"); }
    }
    __device__ __forceinline__ void operator()(const f32x4 (&acc)[2][2][4][2], const Unit& u, int wr, int wc, int fr, int fq) const {
        const int row0 = u.pm * BM + wr * 64 + fr, col0 = u.pn * BM + wc * 32 + 8 * fq;
        const bf16_t* g2 = gd + ((size_t)(2 * 128 + u.pm) * 4 + u.pn) * 65536 + (size_t)((wr * 4 + wc) * 64 + fq * 16 + fr) * 8;
#pragma unroll
        for (int ai = 0; ai < 2; ++ai) {
            u32x4 gwv[4][2];
#pragma unroll
            for (int m = 0; m < 4; ++m)
#pragma unroll
                for (int bj = 0; bj < 2; ++bj) gwv[m][bj] = *(const u32x4*)(g2 + ((ai * 4 + m) * 2 + bj) * 4096);
#pragma unroll
            for (int m = 0; m < 4; ++m) { const size_t row = (size_t)(row0 + ai * HALF + m * 16);
#pragma unroll
                for (int bj = 0; bj < 2; ++bj) { const int col = col0 + bj * HALF; const u32x4 gw = gwv[m][bj];
                    f32x4 g0, g1;
                    g0[0] = __builtin_amdgcn_rcpf(1.f + em(bflo(gw.x))); g0[1] = __builtin_amdgcn_rcpf(1.f + em(bfhi(gw.x))); g0[2] = __builtin_amdgcn_rcpf(1.f + em(bflo(gw.y))); g0[3] = __builtin_amdgcn_rcpf(1.f + em(bfhi(gw.y)));
                    g1[0] = __builtin_amdgcn_rcpf(1.f + em(bflo(gw.z))); g1[1] = __builtin_amdgcn_rcpf(1.f + em(bfhi(gw.z))); g1[2] = __builtin_amdgcn_rcpf(1.f + em(bflo(gw.w))); g1[3] = __builtin_amdgcn_rcpf(1.f + em(bfhi(gw.w)));
                    const f32x4 v0 = acc[ai][bj][m][0] * g0, v1 = acc[ai][bj][m][1] * g1;
                    u32x4 w; w.x = cvt_pk_bf16(v0[0], v0[1]); w.y = cvt_pk_bf16(v0[2], v0[3]); w.z = cvt_pk_bf16(v1[0], v1[1]); w.w = cvt_pk_bf16(v1[2], v1[3]);
                    *(u32x4*)(mb + row * 1024 + col) = w; } }
            asm volatile("" ::: "memory"); }
    }
};
struct EpiWout {
    static constexpr bool PERM = true, HAS_MID = false; static constexpr int MID0 = 0, MID1 = 0;
    __device__ __forceinline__ void mid(f32x4 (&)[2][2][4][2], const Unit&, int, int, int, int, int) const {}
    const float* xf; const bf16_t* xh; bf16_t* v;
    __device__ __forceinline__ void operator()(const f32x4 (&acc)[2][2][4][2], const Unit& u, int wr, int wc, int fr, int fq) const {
        const int row0 = u.pm * BM + wr * 64 + fr, col0 = u.pn * BM + wc * 32 + 8 * fq;
#pragma unroll
        for (int ai = 0; ai < 2; ++ai) {
            f32x4 x0[4][2], x1[4][2];
#pragma unroll
            for (int m = 0; m < 4; ++m) { const size_t off = (size_t)(row0 + ai * HALF + m * 16) * 1024 + col0;
#pragma unroll
                for (int bj = 0; bj < 2; ++bj) {
                    if (xf) { x0[m][bj] = *(const f32x4*)(xf + off + bj * HALF); x1[m][bj] = *(const f32x4*)(xf + off + bj * HALF + 4); }
                    else { const u32x4 w = *(const u32x4*)(xh + off + bj * HALF); x0[m][bj] = (f32x4){bflo(w.x), bfhi(w.x), bflo(w.y), bfhi(w.y)}; x1[m][bj] = (f32x4){bflo(w.z), bfhi(w.z), bflo(w.w), bfhi(w.w)}; } } }
#pragma unroll
            for (int m = 0; m < 4; ++m) { const size_t off = (size_t)(row0 + ai * HALF + m * 16) * 1024 + col0;
#pragma unroll
                for (int bj = 0; bj < 2; ++bj) { const f32x4 v0 = x0[m][bj] * DN_ALPHA + acc[ai][bj][m][0], v1 = x1[m][bj] * DN_ALPHA + acc[ai][bj][m][1];
                    u32x4 w; w.x = cvt_pk_bf16(v0[0], v0[1]); w.y = cvt_pk_bf16(v0[2], v0[3]); w.z = cvt_pk_bf16(v1[0], v1[1]); w.w = cvt_pk_bf16(v1[2], v1[3]);
                    *(u32x4*)(v + off + bj * HALF) = w; } }
            asm volatile("" ::: "memory"); }
    }
};
struct EpiMoe1 {
    __device__ __forceinline__ void mid(f32x4 (&)[2][2][4][2], const Unit&, int, int, int, int, int) const {}
    static constexpr bool PERM = true, HAS_MID = false; static constexpr int MID0 = 0, MID1 = 0;
    bf16_t* act; const float* b1;
    __device__ __forceinline__ void operator()(const f32x4 (&acc)[2][2][4][2], const Unit& u, int wr, int wc, int fr, int fq) const {
        const int e = u.pn >> 3, tl = u.pn & 7;
        const int row0 = u.pm * BM + wr * 64 + fr, col0 = tl * 128 + wc * 32 + 8 * fq;
        const float* bp = b1 + (size_t)e * 2048 + col0;
        const f32x4 bg0 = *(const f32x4*)(bp), bg1 = *(const f32x4*)(bp + 4), bl0 = *(const f32x4*)(bp + 1024), bl1 = *(const f32x4*)(bp + 1028);
#pragma unroll
        for (int ai = 0; ai < 2; ++ai)
#pragma unroll
            for (int m = 0; m < 4; ++m) { bf16_t* rowp = act + (size_t)(row0 + ai * HALF + m * 16) * 1024 + col0;
                f32x4 o[2];
#pragma unroll
                for (int n = 0; n < 2; ++n) { const f32x4 gg = acc[ai][0][m][n] + (n ? bg1 : bg0), ll = acc[ai][1][m][n] + (n ? bl1 : bl0);
#pragma unroll
                    for (int q = 0; q < 4; ++q) { const float gv = fminf(gg[q], 7.0f), lv = fminf(fmaxf(ll[q], -7.0f), 7.0f);
                        o[n][q] = gv * sigmoid_f(1.702f * gv) * (lv + 1.0f); } }
                u32x4 w; w.x = cvt_pk_bf16(o[0][0], o[0][1]); w.y = cvt_pk_bf16(o[0][2], o[0][3]); w.z = cvt_pk_bf16(o[1][0], o[1][1]); w.w = cvt_pk_bf16(o[1][2], o[1][3]);
                *(u32x4*)(rowp) = w; }
    }
};
struct EpiMoe2 {
    __device__ __forceinline__ void mid(f32x4 (&)[2][2][4][2], const Unit&, int, int, int, int, int) const {}
    static constexpr bool PERM = true, HAS_MID = false; static constexpr int MID0 = 0, MID1 = 0;
    bf16_t* ys; const float* b2; const float* wbuf;
    __device__ __forceinline__ void operator()(const f32x4 (&acc)[2][2][4][2], const Unit& u, int wr, int wc, int fr, int fq) const {
        const int e = u.pn >> 2, tl = u.pn & 3;
        const int row0 = u.pm * BM + wr * 64 + fr, col0 = tl * 256 + wc * 32 + 8 * fq;
        const float* bp = b2 + (size_t)e * 1024 + col0;
        f32x4 bv[2][2];
#pragma unroll
        for (int bj = 0; bj < 2; ++bj) { bv[bj][0] = *(const f32x4*)(bp + bj * HALF); bv[bj][1] = *(const f32x4*)(bp + bj * HALF + 4); }
#pragma unroll
        for (int ai = 0; ai < 2; ++ai)
#pragma unroll
            for (int m = 0; m < 4; ++m) { const int row = row0 + ai * HALF + m * 16; const float ww = wbuf[row]; bf16_t* rowp = ys + (size_t)row * 1024 + col0;
#pragma unroll
                for (int bj = 0; bj < 2; ++bj) { const f32x4 v0 = (acc[ai][bj][m][0] + bv[bj][0]) * ww, v1 = (acc[ai][bj][m][1] + bv[bj][1]) * ww;
                    u32x4 w; w.x = cvt_pk_bf16(v0[0], v0[1]); w.y = cvt_pk_bf16(v0[2], v0[3]); w.z = cvt_pk_bf16(v1[0], v1[1]); w.w = cvt_pk_bf16(v1[2], v1[3]);
                    *(u32x4*)(rowp + bj * HALF) = w; } }
    }
};
struct EpiMoe1F8 {
    static constexpr bool PERM = true, HAS_MID = false; static constexpr int MID0 = 0, MID1 = 0;
    __device__ __forceinline__ void mid(f32x4 (&)[2][2][4][2], const Unit&, int, int, int, int, int) const {}
    unsigned char* act8; const float* b1;
    __device__ __forceinline__ void operator()(const f32x4 (&acc)[2][2][4][2], const Unit& u, int wr, int wc, int fr, int fq) const {
        const int e = u.pn >> 3, tl = u.pn & 7;
        const int row0 = u.pm * BM + wr * 64 + fr, col0 = tl * 128 + wc * 32 + 8 * fq;
        const float* bp = b1 + (size_t)e * 2048 + col0;
        const f32x4 bg0 = *(const f32x4*)(bp), bg1 = *(const f32x4*)(bp + 4), bl0 = *(const f32x4*)(bp + 1024), bl1 = *(const f32x4*)(bp + 1028);
        constexpr float sc = 1.0f / (F8_SX * F8_SW1);
#pragma unroll
        for (int ai = 0; ai < 2; ++ai)
#pragma unroll
            for (int m = 0; m < 4; ++m) { unsigned char* rowp = act8 + (size_t)(row0 + ai * HALF + m * 16) * 1024 + col0;
                f32x4 o[2];
#pragma unroll
                for (int n = 0; n < 2; ++n) { const f32x4 gg = acc[ai][0][m][n] * sc + (n ? bg1 : bg0), ll = acc[ai][1][m][n] * sc + (n ? bl1 : bl0);
#pragma unroll
                    for (int q = 0; q < 4; ++q) { const float gv = fminf(gg[q], 7.0f), lv = fminf(fmaxf(ll[q], -7.0f), 7.0f);
                        o[n][q] = gv * sigmoid_f(1.702f * gv) * (lv + 1.0f) * F8_SA; } }
                u32x2 w; w.x = pk_fp8x4(o[0][0], o[0][1], o[0][2], o[0][3]); w.y = pk_fp8x4(o[1][0], o[1][1], o[1][2], o[1][3]);
                *(u32x2*)(rowp) = w; }
    }
};
struct EpiMoe2F8 {
    static constexpr bool PERM = true, HAS_MID = false; static constexpr int MID0 = 0, MID1 = 0;
    __device__ __forceinline__ void mid(f32x4 (&)[2][2][4][2], const Unit&, int, int, int, int, int) const {}
    bf16_t* ys; const float* b2; const float* wbuf;
    __device__ __forceinline__ void operator()(const f32x4 (&acc)[2][2][4][2], const Unit& u, int wr, int wc, int fr, int fq) const {
        const int e = u.pn >> 2, tl = u.pn & 3;
        const int row0 = u.pm * BM + wr * 64 + fr, col0 = tl * 256 + wc * 32 + 8 * fq;
        const float* bp = b2 + (size_t)e * 1024 + col0;
        constexpr float sc = 1.0f / (F8_SA * F8_SW2);
        f32x4 bv[2][2]; float ww[2][4];
#pragma unroll
        for (int bj = 0; bj < 2; ++bj) { bv[bj][0] = *(const f32x4*)(bp + bj * HALF); bv[bj][1] = *(const f32x4*)(bp + bj * HALF + 4); }
#pragma unroll
        for (int ai = 0; ai < 2; ++ai)
#pragma unroll
            for (int m = 0; m < 4; ++m) ww[ai][m] = wbuf[row0 + ai * HALF + m * 16];
#pragma unroll
        for (int ai = 0; ai < 2; ++ai)
#pragma unroll
            for (int m = 0; m < 4; ++m) { const int row = row0 + ai * HALF + m * 16; const float w_ = ww[ai][m]; bf16_t* rowp = ys + (size_t)row * 1024 + col0;
#pragma unroll
                for (int bj = 0; bj < 2; ++bj) { const f32x4 v0 = (acc[ai][bj][m][0] * sc + bv[bj][0]) * w_, v1 = (acc[ai][bj][m][1] * sc + bv[bj][1]) * w_;
                    u32x4 w; w.x = cvt_pk_bf16(v0[0], v0[1]); w.y = cvt_pk_bf16(v0[2], v0[3]); w.z = cvt_pk_bf16(v1[0], v1[1]); w.w = cvt_pk_bf16(v1[2], v1[3]);
                    *(u32x4*)(rowp + bj * HALF) = w; } }
    }
};
struct MoeOrder {
    int nN, G, c, total; const LAS int* blk_e;
    __device__ __forceinline__ bool next(int i, Unit& u) const {
        const long L = (long)i * G + c; if (L >= total) return false;
        const int rb = (int)(L / nN), tl = (int)(L % nN); u.pm = rb; u.pn = blk_e[rb] * nN + tl; return true;
    }
    __device__ __forceinline__ void a_ready(const Unit&) const {}
    __device__ __forceinline__ void done(const Unit&) const {}
};
}
struct Args { const float* in[30]; float* out; unsigned char* ws; int ph_lo, ph_hi, li, pad; };
typedef const __attribute__((address_space(4))) Args* ArgsP;
enum { I_X = 0, I_WIN, I_LCW, I_LCB, I_LWA, I_LBA, I_LWX, I_LBX, I_LLAM, I_MIB, I_MFB, I_MNG, I_GCW, I_GAL, I_GDT, I_GNG, I_WBA, I_WBB, I_WBC, I_WOUT, I_LN1G, I_LN1B, I_RW, I_RB, I_W1, I_B1, I_W2, I_B2, I_LN2G, I_LN2B };

template <int MODE> __device__ __forceinline__ int col_map(int n) {
    if (MODE == 1) {
        if (n < 1024) return n;
        if (n < 2048) return 3840 + (n - 1024);
        if (n < 2304) return 1024 + (n - 2048);
        if (n < 2560) return 1280 + (n - 2304);
        if (n < 3072) return 1536 + (n - 2560);
        if (n < 3076) return 3584 + (n - 3072);
        if (n < 3080) return 3588 + (n - 3076);
        if (n < 3592) return 3840 + 1024 + (n - 3080);
        if (n < 4104) return 2048 + (n - 3592);
        if (n < 4616) return 2560 + (n - 4104);
        if (n < 5128) return 3072 + (n - 4616);
        if (n < 5136) return 3592 + (n - 5128);
        if (n < 5144) return 3600 + (n - 5136);
        if (n < 5656) return 3840 + 1536 + (n - 5144);
        return 3840 + 2048 + (n - 5656);
    } else if (MODE == 2) {
        if (n < 1024) return (n >> 7) * 256 + (n & 127);
        const int q = n - 1024; return (q >> 7) * 256 + 128 + (q & 127);
    }
    return n;
}
struct TrItem { const float* W; bf16_t* WT; int N, ldk, koff, mode, k0, n0; float f8s; };
__device__ __forceinline__ int col_map_rt(int mode, int n) { return mode == 1 ? col_map<1>(n) : (mode == 2 ? col_map<2>(n) : n); }
constexpr int IT_IN = 16 * 273, IT_BRA = 16 * 32, IT_BRB = 8 * 32, IT_BRC = 8 * 32, IT_OUT = 16 * 32, IT_W1 = 32 * 16 * 64, IT_W2 = 32 * 16 * 32;
constexpr int IT_G = 8 * 2 * 8;
constexpr int IT_LAYER = IT_IN + IT_BRA + IT_BRB + IT_BRC + IT_OUT + IT_W1 + IT_W2 + IT_G;
__device__ __forceinline__ TrItem tr_decode(ArgsP a, int it) {
    const int l = it / IT_LAYER; int r = it - l * IT_LAYER; unsigned char* wl = a->ws + WS_W + (size_t)l * WL_STRIDE; TrItem t;
    if (r < IT_IN) { t = TrItem{a->in[I_WIN] + (size_t)l * 1024 * DIN, (bf16_t*)(wl + WL_IN), DIN, 1024, 0, 1, 64 * (r / 273), 32 * (r % 273), 0.f}; return t; } r -= IT_IN;
    if (r < IT_BRA) { t = TrItem{a->in[I_WBA] + (size_t)l * 1024 * 1024, (bf16_t*)(wl + WL_BR), 1024, 2048, 0, 0, 64 * (r / 32), 32 * (r % 32), 0.f}; return t; } r -= IT_BRA;
    if (r < IT_BRB) { t = TrItem{a->in[I_WBB] + (size_t)l * 512 * 1024, (bf16_t*)(wl + WL_BR), 1024, 2048, 1024, 0, 64 * (r / 32), 32 * (r % 32), 0.f}; return t; } r -= IT_BRB;
    if (r < IT_BRC) { t = TrItem{a->in[I_WBC] + (size_t)l * 512 * 1024, (bf16_t*)(wl + WL_BR), 1024, 2048, 1536, 0, 64 * (r / 32), 32 * (r % 32), 0.f}; return t; } r -= IT_BRC;
    if (r < IT_OUT) { t = TrItem{a->in[I_WOUT] + (size_t)l * 1024 * 1024, (bf16_t*)(wl + WL_OUT), 1024, 1024, 0, 0, 64 * (r / 32), 32 * (r % 32), 0.f}; return t; } r -= IT_OUT;
    if (r < IT_W1) { const int e = r / 1024, q = r % 1024; t = TrItem{a->in[I_W1] + ((size_t)l * NE + e) * 1024 * 2048, (bf16_t*)(wl + WL_W1 + (size_t)e * 2048 * 1024), 2048, 1024, 0, 2, 64 * (q / 64), 32 * (q % 64), F8_SW1}; return t; } r -= IT_W1;
    if (r < IT_W2) { const int e = r / 512, q = r % 512; t = TrItem{a->in[I_W2] + ((size_t)l * NE + e) * 1024 * 1024, (bf16_t*)(wl + WL_W2 + (size_t)e * 1024 * 1024), 1024, 1024, 0, 0, 64 * (q / 32), 32 * (q % 32), F8_SW2}; return t; } r -= IT_W2;
    { const int h = r >> 4, gate = (r >> 3) & 1, q = r & 7;
      t = TrItem{a->in[gate ? I_LWX : I_LWA] + ((size_t)l * 8 + h) * 128 * 128, (bf16_t*)(wl + WL_G) + (size_t)(h * 256 + gate * 128) * 128, 128, 128, 0, 0, 64 * (q >> 2), 32 * (q & 3), 0.f}; return t; }
}
__device__ __forceinline__ void p0_convert(ArgsP a, LAS unsigned char* lds, int G) {
    int tid_ = threadIdx.x; asm volatile("" : "+v"(tid_)); const int tid = tid_, lane = tid & 63, wave = tid >> 6;
    LAS float* scr = (LAS float*)(lds + wave * 16384);
    const int gw = blockIdx.x * NWAVES + wave, NGW = G * NWAVES;
    f32x4 v[8];
#define TR_LOAD(t_) do { const int nsrc_ = (t_).n0 + 4 * (lane & 7); const float* p_ = (t_).W + (size_t)((t_).k0 + (lane >> 3)) * (t_).N + nsrc_; \
        _Pragma("unroll") for (int i = 0; i < 8; ++i) { if (nsrc_ + 3 < (t_).N) v[i] = *(const f32x4*)(p_ + (size_t)(8 * i) * (t_).N); \
            else { const float* q_ = p_ + (size_t)(8 * i) * (t_).N; v[i] = (f32x4){nsrc_ < (t_).N ? q_[0] : 0.f, nsrc_ + 1 < (t_).N ? q_[1] : 0.f, nsrc_ + 2 < (t_).N ? q_[2] : 0.f, 0.f}; } } } while (0)
    TrItem cur = tr_decode(a, gw < 2 * IT_LAYER ? gw : 0);
    if (gw < 2 * IT_LAYER) TR_LOAD(cur);
    for (int it = gw; it < 2 * IT_LAYER; it += NGW) {
#pragma unroll
        for (int i = 0; i < 8; ++i) { LAS float* d_ = scr + (8 * i + (lane >> 3)) * 33 + 4 * (lane & 7); d_[0] = v[i][0]; d_[1] = v[i][1]; d_[2] = v[i][2]; d_[3] = v[i][3]; }
        const TrItem me = cur;
        if (it + NGW < 2 * IT_LAYER) { cur = tr_decode(a, it + NGW); TR_LOAD(cur); }
        LDS_WAIT(); asm volatile("" ::: "memory");
        const int c = lane & 7;
#pragma unroll
        for (int j = 0; j < 4; ++j) { const int nl = (lane >> 3) + 8 * j, n = me.n0 + nl; const LAS float* s = scr + (8 * c) * 33 + nl;
            if (me.mode == 1) { const int vr_ = col_map<1>(n < me.N ? n : 0);
                if (n < me.N) { if (vr_ < NIN_BF) { u32x4 o; o.x = pk2(s[0 * 33], s[1 * 33]); o.y = pk2(s[2 * 33], s[3 * 33]); o.z = pk2(s[4 * 33], s[5 * 33]); o.w = pk2(s[6 * 33], s[7 * 33]);
                        *(u32x4*)(me.WT + (size_t)vr_ * 1024 + me.k0 + 8 * c) = o; }
                    else { const float f = F8_SWI; u32x2 o8; o8.x = pk_fp8x4(s[0 * 33] * f, s[1 * 33] * f, s[2 * 33] * f, s[3 * 33] * f); o8.y = pk_fp8x4(s[4 * 33] * f, s[5 * 33] * f, s[6 * 33] * f, s[7 * 33] * f);
                        *(u32x2*)((unsigned char*)me.WT + WL_IN8 + (size_t)(vr_ - NIN_BF) * 1024 + me.k0 + 8 * c) = o8; } } }
            else if (me.f8s != 0.f) { const float f = me.f8s; u32x2 o8; o8.x = pk_fp8x4(s[0 * 33] * f, s[1 * 33] * f, s[2 * 33] * f, s[3 * 33] * f); o8.y = pk_fp8x4(s[4 * 33] * f, s[5 * 33] * f, s[6 * 33] * f, s[7 * 33] * f);
                if (n < me.N) *(u32x2*)((unsigned char*)me.WT + (size_t)col_map_rt(me.mode, n) * me.ldk + me.koff + me.k0 + 8 * c) = o8; }
            else { u32x4 o; o.x = pk2(s[0 * 33], s[1 * 33]); o.y = pk2(s[2 * 33], s[3 * 33]); o.z = pk2(s[4 * 33], s[5 * 33]); o.w = pk2(s[6 * 33], s[7 * 33]);
                if (n < me.N) *(u32x4*)(me.WT + (size_t)col_map_rt(me.mode, n) * me.ldk + me.koff + me.k0 + 8 * c) = o; } }
        LDS_WAIT(); asm volatile("" ::: "memory");
    }
#undef TR_LOAD
    const size_t gt = (size_t)blockIdx.x * 512 + tid, GT = (size_t)G * 512;
    for (size_t i = gt; i < (size_t)2 * 232 * 128; i += GT) { const int l = (int)(i / (232 * 128)); const size_t q = i % (232 * 128);
        *(u32x4*)(a->ws + WS_W + (size_t)l * WL_STRIDE + WL_IN + ((size_t)3608 * 1024) * 2 + q * 16) = (u32x4){0u, 0u, 0u, 0u}; }
    for (size_t i = gt; i < (size_t)2 * 32 * 1024; i += GT) { const int l = (int)(i >> 15), k = (int)((i >> 5) & 1023), e = (int)(i & 31); const float w = a->in[I_RW][i];
        const unsigned hb = f2bf(w); const float lo = w - bf2f((unsigned short)hb); bf16_t* dst = (bf16_t*)(a->ws + WS_RWB) + (size_t)l * 2 * 32 * 1024;
        dst[(size_t)e * 1024 + k] = (bf16_t)hb; dst[(size_t)(32 + e) * 1024 + k] = (bf16_t)f2bf(lo); }
    const float* x = a->in[I_X]; bf16_t* xb = (bf16_t*)(a->ws + WS_XB);
    for (size_t i = gt; i < (size_t)T_ * D_ / 8; i += GT) { const f32x4 v0 = *(const f32x4*)(x + i * 8), v1 = *(const f32x4*)(x + i * 8 + 4);
        u32x4 w; w.x = pk2(v0[0], v0[1]); w.y = pk2(v0[2], v0[3]); w.z = pk2(v1[0], v1[1]); w.w = pk2(v1[2], v1[3]); *(u32x4*)(xb + i * 8) = w;
        u32x2 q8; q8.x = pk_fp8x4(v0[0] * F8_SX, v0[1] * F8_SX, v0[2] * F8_SX, v0[3] * F8_SX); q8.y = pk_fp8x4(v1[0] * F8_SX, v1[1] * F8_SX, v1[2] * F8_SX, v1[3] * F8_SX); *(u32x2*)(a->ws + WS_X2 + i * 8) = q8; }
}

constexpr int TB = 32;
__device__ __forceinline__ void lru_naive(ArgsP a, int l, int u, LAS unsigned char* lds, const bf16_t* proj, bf16_t* H) {
    int tid_ = threadIdx.x; asm volatile("" : "+v"(tid_)); const int tid = tid_, b = u >> 3, h = u & 7, c = tid >> 2, p = tid & 3, chg = h * 128 + c;
    const float* wa = a->in[I_LWA] + ((size_t)l * 8 + h) * 128 * 128; const float* wx = a->in[I_LWX] + ((size_t)l * 8 + h) * 128 * 128;
    float wra[32], wrx[32];
#pragma unroll
    for (int i = 0; i < 32; ++i) { wra[i] = wa[(p * 32 + i) * 128 + c]; wrx[i] = wx[(p * 32 + i) * 128 + c]; }
    const float ba = a->in[I_LBA][l * 1024 + chg], bx = a->in[I_LBX][l * 1024 + chg];
    const float sp = softplus_f(-a->in[I_LLAM][l * 1024 + chg]);
    const float* cw = a->in[I_LCW] + (size_t)l * 4 * 1024 + chg; const float cw0 = cw[0], cw1 = cw[1024], cw2 = cw[2048], cw3 = cw[3072], cb = a->in[I_LCB][l * 1024 + chg];
    LAS bf16_t* xs = (LAS bf16_t*)(lds);
    LAS bf16_t* ys = (LAS bf16_t*)(lds + 8192);
    LAS float* xa_s = (LAS float*)(lds + 16384);
    const int srow = tid >> 4, scol = (tid & 15) * 8;
    const size_t tok0 = (size_t)b * SEQ_;
    u32x4 px = *(const u32x4*)(proj + (tok0 + srow) * NPROJ + PC_LRUX + h * 128 + scol);
    u32x4 py = *(const u32x4*)(proj + (tok0 + srow) * NPROJ + PC_LRUY + h * 128 + scol);
    float hs = 0.f, x1 = 0.f, x2 = 0.f, x3 = 0.f;
    for (int blk = 0; blk < SEQ_ / TB; ++blk) {
        __syncthreads();
        *(LAS u32x4*)(xs + srow * 128 + scol) = px; *(LAS u32x4*)(ys + srow * 128 + scol) = py;
        __syncthreads();
        if (blk + 1 < SEQ_ / TB) { const size_t tk = tok0 + (size_t)(blk + 1) * TB + srow;
            px = *(const u32x4*)(proj + tk * NPROJ + PC_LRUX + h * 128 + scol); py = *(const u32x4*)(proj + tk * NPROJ + PC_LRUY + h * 128 + scol); }
        for (int s = 0; s < TB; ++s) {
            const float xraw = bf2f(xs[s * 128 + c]);
            const float xa = cw0 * x3 + cw1 * x2 + cw2 * x1 + cw3 * xraw + cb;
            x3 = x2; x2 = x1; x1 = xraw;
            LAS float* xb_ = xa_s + (s & 1) * 128;
            if (p == 0) xb_[c] = xa;
            __syncthreads();
            float sa = 0.f, sx = 0.f;
#pragma unroll
            for (int i4 = 0; i4 < 8; ++i4) { const f32x4 xv = *(const LAS f32x4*)(xb_ + p * 32 + i4 * 4);
#pragma unroll
                for (int q = 0; q < 4; ++q) { sa += xv[q] * wra[i4 * 4 + q]; sx += xv[q] * wrx[i4 * 4 + q]; } }
            sa += __shfl_xor(sa, 1); sa += __shfl_xor(sa, 2); sx += __shfl_xor(sx, 1); sx += __shfl_xor(sx, 2);
            const float r = 1.f / (1.f + __expf(-(sa + ba))), ig = 1.f / (1.f + __expf(-(sx + bx)));
            const float log_a = -8.0f * r * sp, av = __expf(log_a), mult = sqrtf(-expm1f(2.0f * log_a));
            hs = av * hs + mult * (ig * xa);
            if (p == 0) { const float y = bf2f(ys[s * 128 + c]);
                H[(tok0 + (size_t)blk * TB + s) * 2048 + chg] = (bf16_t)f2bf(hs * gelu_tanh_f(y)); }
        }
    }
}
__device__ __forceinline__ void mlstm_naive(ArgsP a, int l, int u, LAS unsigned char* lds, const bf16_t* proj, const float* gsm, bf16_t* H) {
    int tid_ = threadIdx.x; asm volatile("" : "+v"(tid_)); const int tid = tid_, lane = tid & 63, wave = tid >> 6, b = u >> 2, hd = u & 3, j = tid & 127;
    LAS float* qs = (LAS float*)(lds);
    LAS float* ks = (LAS float*)(lds + 8192);
    LAS float* vs = (LAS float*)(lds + 16384);
    LAS float* os = (LAS float*)(lds + 32768);
    LAS float* gi = (LAS float*)(lds + 49152);
    LAS float* gf = (LAS float*)(lds + 49152 + 128);
    LAS float* red = (LAS float*)(lds + 49152 + 256);
    const float ib = a->in[I_MIB][l * 4 + hd], fb = a->in[I_MFB][l * 4 + hd], gn = a->in[I_MNG][(size_t)l * 512 + hd * 128 + j];
    const size_t tok0 = (size_t)b * SEQ_;
    const int qa_row = (tid & 255) >> 3, qa_c8 = (tid & 7) * 8; const int qa_col = (tid < 256 ? PC_MLQ : PC_MLK) + hd * 64 + qa_c8;
    const int vb_row = tid >> 4, vb_c8 = (tid & 15) * 8;
    u32x4 pa, pb, pc; float pg = 0.f;
#define ML_ISSUE(blk_) do { const size_t t0 = tok0 + (size_t)(blk_) * TB; \
        pa = *(const u32x4*)(proj + (t0 + qa_row) * NPROJ + qa_col); \
        pb = *(const u32x4*)(proj + (t0 + vb_row) * NPROJ + PC_MLV + hd * 128 + vb_c8); \
        pc = *(const u32x4*)(proj + (t0 + vb_row) * NPROJ + PC_MLO + hd * 128 + vb_c8); \
        if (tid < 64) pg = gsm[(t0 + (tid & 31)) * 32 + (tid < 32 ? 0 : 4) + hd]; } while (0)
    ML_ISSUE(0);
    float C[64], n[64];
#pragma unroll
    for (int r = 0; r < 64; ++r) { C[r] = 0.f; n[r] = 0.f; }
    for (int blk = 0; blk < SEQ_ / TB; ++blk) {
        __syncthreads();
        { LAS float* d = (tid < 256 ? qs : ks) + qa_row * 64 + qa_c8;
          *(LAS f32x4*)(d) = (f32x4){bflo(pa.x), bfhi(pa.x), bflo(pa.y), bfhi(pa.y)}; *(LAS f32x4*)(d + 4) = (f32x4){bflo(pa.z), bfhi(pa.z), bflo(pa.w), bfhi(pa.w)};
          LAS float* dv = vs + vb_row * 128 + vb_c8;
          *(LAS f32x4*)(dv) = (f32x4){bflo(pb.x), bfhi(pb.x), bflo(pb.y), bfhi(pb.y)}; *(LAS f32x4*)(dv + 4) = (f32x4){bflo(pb.z), bfhi(pb.z), bflo(pb.w), bfhi(pb.w)};
          LAS float* dz = os + vb_row * 128 + vb_c8;
          *(LAS f32x4*)(dz) = (f32x4){bflo(pc.x), bfhi(pc.x), bflo(pc.y), bfhi(pc.y)}; *(LAS f32x4*)(dz + 4) = (f32x4){bflo(pc.z), bfhi(pc.z), bflo(pc.w), bfhi(pc.w)};
          if (tid < 32) gi[tid] = pg; else if (tid < 64) gf[tid - 32] = pg; }
        __syncthreads();
        if (blk + 1 < SEQ_ / TB) ML_ISSUE(blk + 1);
        for (int s = 0; s < TB; ++s) {
            float hj = 0.f;
            if (tid < 128) {
                const float f = 1.f / (1.f + __expf(-(gf[s] + fb))), ie = __expf(gi[s] + ib);
                const float vj = vs[s * 128 + j];
                float num = 0.f, den = 0.f;
#pragma unroll
                for (int r4 = 0; r4 < 16; ++r4) { const f32x4 kk = *(const LAS f32x4*)(ks + s * 64 + r4 * 4), qq = *(const LAS f32x4*)(qs + s * 64 + r4 * 4);
#pragma unroll
                    for (int q = 0; q < 4; ++q) { const int r = r4 * 4 + q; const float ik = ie * kk[q];
                        C[r] = f * C[r] + ik * vj; n[r] = f * n[r] + ik; num += qq[q] * C[r]; den += qq[q] * n[r]; } }
                num *= 0.125f; den *= 0.125f;
                hj = num / fmaxf(fabsf(den), 1.0f);
                const float ss = wave_sum(hj * hj);
                if (lane == 0) red[(s & 1) * 2 + wave] = ss;
            }
            __syncthreads();
            if (tid < 128) {
                const float tot = red[(s & 1) * 2] + red[(s & 1) * 2 + 1];
                const float o = hj * rsqrtf(tot * (1.0f / 128.0f) + RMS_EPS) * gn * sigmoid_f(os[s * 128 + j]);
                H[(tok0 + (size_t)blk * TB + s) * 2048 + 1024 + hd * 128 + j] = (bf16_t)f2bf(o);
            }
        }
    }
}
__device__ __forceinline__ void gdn_naive(ArgsP a, int l, int u, LAS unsigned char* lds, const bf16_t* proj, const float* gsm, bf16_t* H) {
    int tid_ = threadIdx.x; asm volatile("" : "+v"(tid_)); const int tid = tid_, lane = tid & 63, b = u >> 3, hd = u & 7;
    LAS float* rq = (LAS float*)(lds);
    LAS float* rk = (LAS float*)(lds + 9216);
    LAS float* rv = (LAS float*)(lds + 18432);
    LAS float* zs = (LAS float*)(lds + 27648);
    LAS float* ga = (LAS float*)(lds + 27648 + 8192);
    LAS float* gb = ga + TB;
    const float* cw = a->in[I_GCW] + (size_t)l * 4 * 1536;
    float cq[4], ck[4], cv[4];
#pragma unroll
    for (int i = 0; i < 4; ++i) { cq[i] = cw[i * 1536 + hd * 64 + lane]; ck[i] = cw[i * 1536 + 512 + hd * 64 + lane]; cv[i] = cw[i * 1536 + 1024 + hd * 64 + lane]; }
    const float nexpA = -__expf(a->in[I_GAL][l * 8 + hd]), dtb = a->in[I_GDT][l * 8 + hd], gn = a->in[I_GNG][l * 64 + lane];
    const size_t tok0 = (size_t)b * SEQ_;
    u32x4 pp[3]; float pg = 0.f;
#define GD_ISSUE(blk_) do { const int tl0 = (blk_) * TB; \
        _Pragma("unroll") for (int i = 0; i < 3; ++i) { const int pid = tid + 512 * i; pp[i] = (u32x4){0u, 0u, 0u, 0u}; \
            if (pid < 840) { const int arr = pid / 280, rem = pid % 280, row = rem >> 3, c8 = (rem & 7) * 8; const int tl = tl0 - 3 + row; \
                if (tl >= 0) pp[i] = *(const u32x4*)(proj + (tok0 + tl) * NPROJ + (arr == 0 ? PC_GDQ : (arr == 1 ? PC_GDK : PC_GDV)) + hd * 64 + c8); } \
            else if (pid < 1096) { const int zp = pid - 840, row = zp >> 3, c8 = (zp & 7) * 8; \
                pp[i] = *(const u32x4*)(proj + (tok0 + tl0 + row) * NPROJ + PC_GDZ + hd * 64 + c8); } } \
        if (tid < 64) pg = gsm[(tok0 + tl0 + (tid & 31)) * 32 + (tid < 32 ? 8 : 16) + hd]; } while (0)
    GD_ISSUE(0);
    float S[64];
#pragma unroll
    for (int i = 0; i < 64; ++i) S[i] = 0.f;
    for (int blk = 0; blk < SEQ_ / TB; ++blk) {
        __syncthreads();
#pragma unroll
        for (int i = 0; i < 3; ++i) { const int pid = tid + 512 * i; LAS float* d = nullptr;
            if (pid < 840) { const int arr = pid / 280, rem = pid % 280, row = rem >> 3, c8 = (rem & 7) * 8; d = (arr == 0 ? rq : (arr == 1 ? rk : rv)) + row * 64 + c8; }
            else if (pid < 1096) { const int zp = pid - 840, row = zp >> 3, c8 = (zp & 7) * 8; d = zs + row * 64 + c8; }
            if (pid < 1096) { const u32x4 w = pp[i];
                *(LAS f32x4*)(d) = (f32x4){bflo(w.x), bfhi(w.x), bflo(w.y), bfhi(w.y)}; *(LAS f32x4*)(d + 4) = (f32x4){bflo(w.z), bfhi(w.z), bflo(w.w), bfhi(w.w)}; } }
        if (tid < 32) ga[tid] = pg; else if (tid < 64) gb[tid - 32] = pg;
        __syncthreads();
        if (blk + 1 < SEQ_ / TB) GD_ISSUE(blk + 1);
        if (tid < 64) {
            for (int s = 0; s < TB; ++s) {
                float qv = 0.f, kv = 0.f, vv = 0.f;
#pragma unroll
                for (int i = 0; i < 4; ++i) { qv += cq[i] * rq[(s + i) * 64 + lane]; kv += ck[i] * rk[(s + i) * 64 + lane]; vv += cv[i] * rv[(s + i) * 64 + lane]; }
                qv = silu_f(qv); kv = silu_f(kv); vv = silu_f(vv);
                const float qn = qv * rsqrtf(wave_sum(qv * qv) + RMS_EPS) * 0.125f;
                const float kn = kv * rsqrtf(wave_sum(kv * kv) + RMS_EPS);
                const float g = nexpA * softplus_f(ga[s] + dtb), alpha = __expf(g), beta = 1.f / (1.f + __expf(-gb[s]));
                float kS = 0.f;
#pragma unroll
                for (int i = 0; i < 64; ++i) kS += __builtin_bit_cast(float, __builtin_amdgcn_readlane(__builtin_bit_cast(int, kn), i)) * S[i];
                const float dl = beta * (vv - alpha * kS);
                float o = 0.f;
#pragma unroll
                for (int i = 0; i < 64; ++i) { const float ki = __builtin_bit_cast(float, __builtin_amdgcn_readlane(__builtin_bit_cast(int, kn), i));
                    const float qi = __builtin_bit_cast(float, __builtin_amdgcn_readlane(__builtin_bit_cast(int, qn), i));
                    S[i] = alpha * S[i] + ki * dl; o += qi * S[i]; }
                const float ms = wave_sum(o * o) * (1.0f / 64.0f);
                const float out = o * rsqrtf(ms + RMS_EPS) * gn * silu_f(zs[s * 64 + lane]);
                H[(tok0 + (size_t)blk * TB + s) * 2048 + 1536 + hd * 64 + lane] = (bf16_t)f2bf(out);
            }
        }
    }
}

constexpr int RW_PITCH = 1032;
__device__ __forceinline__ unsigned f2key(float v, int e) { unsigned u = __builtin_bit_cast(unsigned, v); u = (u & 0x80000000u) ? ~u : (u | 0x80000000u); return (u & ~31u) | (unsigned)(31 - e); }
__device__ __forceinline__ float key2f(unsigned k) { const unsigned u = k & ~31u; return __builtin_bit_cast(float, (u & 0x80000000u) ? (u ^ 0x80000000u) : ~u); }
__device__ __forceinline__ void p5_ln1_router(ArgsP a, int l, LAS unsigned char* lds, int G) {
    int tid_ = threadIdx.x; asm volatile("" : "+v"(tid_)); const int tid = tid_, lane = tid & 63, wave = tid >> 6, tk = lane & 15, g = lane >> 4;
    LAS bf16_t* whi = (LAS bf16_t*)lds;
    LAS bf16_t* wlo = (LAS bf16_t*)(lds + 32 * RW_PITCH * 2);
    LAS int* hist = (LAS int*)(lds + 2 * 32 * RW_PITCH * 2);
    { const bf16_t* src = (const bf16_t*)(a->ws + WS_RWB) + (size_t)l * 2 * 32 * 1024;
      for (int p = tid; p < 2 * 32 * 128; p += 512) { const int arr = p >> 12, e = (p >> 7) & 31, c8 = (p & 127) * 8;
          *(LAS u32x4*)((arr ? wlo : whi) + e * RW_PITCH + c8) = *(const u32x4*)(src + ((size_t)arr * 32 + e) * 1024 + c8); } }
    const bf16_t* v = (const bf16_t*)(a->ws + WS_V); bf16_t* x1b = (bf16_t*)(a->ws + WS_X1B); unsigned char* x18 = a->ws + WS_X1;
    int* tke = (int*)(a->ws + WS_TKE); float* tkw = (float*)(a->ws + WS_TKW); int* ghist = (int*)(a->ws + WS_HIST);
    const float* lng = a->in[I_LN1G] + l * 1024; const float* lnb = a->in[I_LN1B] + l * 1024;
    const float rb0 = a->in[I_RB][l * 32 + tk], rb1 = a->in[I_RB][l * 32 + 16 + tk];
    for (int ch = blockIdx.x; ch < NCHUNK; ch += G) {
        __syncthreads();
        if (tid < 32) hist[tid] = 0;
        __syncthreads();
        const size_t t = (size_t)ch * CHTOK + wave * 16 + tk;
        const bf16_t* vr = v + t * 1024 + 8 * g;
        float s = 0.f, s2 = 0.f;
#pragma unroll 8
        for (int ks = 0; ks < 32; ++ks) { const u32x4 pw = *(const u32x4*)(vr + 32 * ks); const f32x4 p0 = (f32x4){bflo(pw.x), bfhi(pw.x), bflo(pw.y), bfhi(pw.y)}, p1 = (f32x4){bflo(pw.z), bfhi(pw.z), bflo(pw.w), bfhi(pw.w)};
            s += (p0[0] + p0[1]) + (p0[2] + p0[3]) + (p1[0] + p1[1]) + (p1[2] + p1[3]);
            s2 += (p0[0] * p0[0] + p0[1] * p0[1]) + (p0[2] * p0[2] + p0[3] * p0[3]) + (p1[0] * p1[0] + p1[1] * p1[1]) + (p1[2] * p1[2] + p1[3] * p1[3]); }
        s += __shfl_xor(s, 16); s += __shfl_xor(s, 32); s2 += __shfl_xor(s2, 16); s2 += __shfl_xor(s2, 32);
        const float mean = s * (1.0f / 1024.0f); const float rstd = rsqrtf(fmaxf(s2 * (1.0f / 1024.0f) - mean * mean, 0.f) + LN_EPS);
        f32x4 acc0 = (f32x4){0.f, 0.f, 0.f, 0.f}, acc1 = (f32x4){0.f, 0.f, 0.f, 0.f};
#pragma unroll 2
        for (int ks = 0; ks < 32; ++ks) { const int k0 = 32 * ks + 8 * g;
            const u32x4 pw = *(const u32x4*)(vr + 32 * ks); const f32x4 p0 = (f32x4){bflo(pw.x), bfhi(pw.x), bflo(pw.y), bfhi(pw.y)}, p1 = (f32x4){bflo(pw.z), bfhi(pw.z), bflo(pw.w), bfhi(pw.w)};
            const f32x4 g0 = *(const f32x4*)(lng + k0), g1 = *(const f32x4*)(lng + k0 + 4), b0 = *(const f32x4*)(lnb + k0), b1 = *(const f32x4*)(lnb + k0 + 4);
            const f32x4 y0 = (p0 - mean) * rstd * g0 + b0, y1 = (p1 - mean) * rstd * g1 + b1;
            u32x4 hw; hw.x = pg8::cvt_pk_bf16(y0[0], y0[1]); hw.y = pg8::cvt_pk_bf16(y0[2], y0[3]); hw.z = pg8::cvt_pk_bf16(y1[0], y1[1]); hw.w = pg8::cvt_pk_bf16(y1[2], y1[3]);
            *(u32x4*)(x1b + t * 1024 + k0) = hw;
            { u32x2 q8; q8.x = pk_fp8x4(y0[0] * F8_SX, y0[1] * F8_SX, y0[2] * F8_SX, y0[3] * F8_SX); q8.y = pk_fp8x4(y1[0] * F8_SX, y1[1] * F8_SX, y1[2] * F8_SX, y1[3] * F8_SX); *(u32x2*)(x18 + t * 1024 + k0) = q8; }
            u32x4 lw; lw.x = pg8::cvt_pk_bf16(y0[0] - bflo(hw.x), y0[1] - bfhi(hw.x)); lw.y = pg8::cvt_pk_bf16(y0[2] - bflo(hw.y), y0[3] - bfhi(hw.y));
            lw.z = pg8::cvt_pk_bf16(y1[0] - bflo(hw.z), y1[1] - bfhi(hw.z)); lw.w = pg8::cvt_pk_bf16(y1[2] - bflo(hw.w), y1[3] - bfhi(hw.w));
            const bf16x8 ah = __builtin_bit_cast(bf16x8, hw), al = __builtin_bit_cast(bf16x8, lw);
            const bf16x8 wh0 = *(const LAS bf16x8*)(whi + tk * RW_PITCH + k0), wh1 = *(const LAS bf16x8*)(whi + (16 + tk) * RW_PITCH + k0);
            const bf16x8 wl0 = *(const LAS bf16x8*)(wlo + tk * RW_PITCH + k0), wl1 = *(const LAS bf16x8*)(wlo + (16 + tk) * RW_PITCH + k0);
            acc0 = __builtin_amdgcn_mfma_f32_16x16x32_bf16(ah, wh0, acc0, 0, 0, 0); acc1 = __builtin_amdgcn_mfma_f32_16x16x32_bf16(ah, wh1, acc1, 0, 0, 0);
            acc0 = __builtin_amdgcn_mfma_f32_16x16x32_bf16(ah, wl0, acc0, 0, 0, 0); acc1 = __builtin_amdgcn_mfma_f32_16x16x32_bf16(ah, wl1, acc1, 0, 0, 0);
            acc0 = __builtin_amdgcn_mfma_f32_16x16x32_bf16(al, wh0, acc0, 0, 0, 0); acc1 = __builtin_amdgcn_mfma_f32_16x16x32_bf16(al, wh1, acc1, 0, 0, 0); }
#pragma unroll
        for (int r = 0; r < 4; ++r) {
            unsigned k0 = f2key(acc0[r] + rb0, tk), k1 = f2key(acc1[r] + rb1, 16 + tk);
            float tv[4]; int te[4];
#pragma unroll
            for (int k = 0; k < 4; ++k) { unsigned m = k0 > k1 ? k0 : k1;
#pragma unroll
                for (int o = 1; o < 16; o <<= 1) { const unsigned q = (unsigned)__shfl_xor((int)m, o); m = q > m ? q : m; }
                const int e = 31 - (int)(m & 31u); tv[k] = key2f(m); te[k] = e;
                if (e == tk) k0 = 0u; if (e == 16 + tk) k1 = 0u; }
            const float e1 = __expf(tv[1] - tv[0]), e2 = __expf(tv[2] - tv[0]), e3 = __expf(tv[3] - tv[0]); const float inv = 1.0f / (1.0f + e1 + e2 + e3);
            if (tk < 4) { const size_t tt = (size_t)ch * CHTOK + wave * 16 + 4 * g + r;
                const int ei = tk == 0 ? te[0] : (tk == 1 ? te[1] : (tk == 2 ? te[2] : te[3]));
                const float wi = (tk == 0 ? 1.0f : (tk == 1 ? e1 : (tk == 2 ? e2 : e3))) * inv;
                tke[tt * 4 + tk] = ei; tkw[tt * 4 + tk] = wi; __hip_atomic_fetch_add(&hist[ei], 1, __ATOMIC_RELAXED, __HIP_MEMORY_SCOPE_WORKGROUP); }
        }
        __syncthreads();
        if (tid < 32) ghist[ch * 32 + tid] = hist[tid];
    }
}

__device__ __forceinline__ void p6_slots(ArgsP a, LAS unsigned char* lds, int G) {
    int tid_ = threadIdx.x; asm volatile("" : "+v"(tid_)); const int tid = tid_, lane = tid & 63, wave = tid >> 6;
    LAS int* hs = (LAS int*)lds;
    LAS int* cnt = (LAS int*)(lds + 32768);
    LAS int* bst = (LAS int*)(lds + 32768 + 256);
    LAS int* seg = (LAS int*)(lds + 32768 + 512);
    LAS int* wcnt = (LAS int*)(lds + 36864);
    const int* ghist = (const int*)(a->ws + WS_HIST);
    for (int i = tid; i < NCHUNK * 32; i += 512) hs[i] = ghist[i];
    __syncthreads();
    { const int e = tid & 31, sg = tid >> 5;
      int run = 0; for (int c = sg * 16; c < sg * 16 + 16; ++c) { const int v = hs[c * 32 + e]; hs[c * 32 + e] = run; run += v; } seg[sg * 32 + e] = run; }
    __syncthreads();
    if (tid < 32) { int run = 0; for (int sg = 0; sg < 16; ++sg) { const int v = seg[sg * 32 + tid]; seg[sg * 32 + tid] = run; run += v; } cnt[tid] = run; }
    __syncthreads();
    if (tid == 0) { int bs = 0; for (int e = 0; e < 32; ++e) { bst[e] = bs; bs += (cnt[e] + 255) >> 8; } bst[32] = bs; }
    __syncthreads();
    if (blockIdx.x == 0 && tid <= 32) ((int*)(a->ws + WS_META))[tid] = bst[tid];
    const int* tke = (const int*)(a->ws + WS_TKE); const float* tkw = (const float*)(a->ws + WS_TKW);
    int* slot = (int*)(a->ws + WS_SLOT); float* wbuf = (float*)(a->ws + WS_WBUF); int* tokb = (int*)(a->ws + WS_TOKB);
    for (int ch = blockIdx.x; ch < NCHUNK; ch += G) {
        const size_t pi = (size_t)ch * 512 + tid; const int me = tke[pi]; const float mw = tkw[pi];
        int rk = 0;
#pragma unroll 4
        for (int e = 0; e < 32; ++e) { const unsigned long long m = __ballot(me == e); if (me == e) rk = __popcll(m & ((1ull << lane) - 1ull)); if (lane == 0) wcnt[wave * 32 + e] = __popcll(m); }
        __syncthreads();
        int before = 0;
        for (int w = 0; w < wave; ++w) before += wcnt[w * 32 + me];
        const int s_ = bst[me] * 256 + seg[(ch >> 4) * 32 + me] + hs[ch * 32 + me] + before + rk;
        slot[pi] = s_; wbuf[s_] = mw; tokb[s_] = ch * CHTOK + (tid >> 2);
        __syncthreads();
    }
    for (int e = blockIdx.x; e < 32; e += G) for (int s_ = bst[e] * 256 + cnt[e] + tid; s_ < bst[e + 1] * 256; s_ += 512) tokb[s_] = T_;
}
__device__ __forceinline__ int moe_table(ArgsP a, LAS unsigned char* lds) {
    int tid_ = threadIdx.x; asm volatile("" : "+v"(tid_)); const int tid = tid_;
    LAS int* bst = (LAS int*)(lds + MISC_OFF);
    LAS int* blk_e = (LAS int*)(lds + MISC_OFF + 256);
    __syncthreads();
    if (tid <= 32) bst[tid] = ((const int*)(a->ws + WS_META))[tid];
    __syncthreads();
    const int nb = bst[32];
    for (int rb = tid; rb < nb; rb += 512) { int e = 0; while (e < 31 && rb >= bst[e + 1]) ++e; blk_e[rb] = e; }
    __syncthreads();
    return nb;
}

__device__ __forceinline__ void p9_combine_ln2(ArgsP a, int l, float* xout, int G) {
    int tid_ = threadIdx.x; asm volatile("" : "+v"(tid_)); const int tid = tid_, lane = tid & 63, wave = tid >> 6;
    const bf16_t* x1b = (const bf16_t*)(a->ws + WS_X1B); const int* slot = (const int*)(a->ws + WS_SLOT);
    const bf16_t* ys = (const bf16_t*)(a->ws + WS_OV + OV_YS); bf16_t* xb = (bf16_t*)(a->ws + WS_XB); unsigned char* x8 = a->ws + WS_X2;
    float gg[2][8], bb[2][8];
#pragma unroll
    for (int j = 0; j < 2; ++j) { const float* gp = a->in[I_LN2G] + l * 1024 + 8 * lane + 512 * j; const float* bp = a->in[I_LN2B] + l * 1024 + 8 * lane + 512 * j;
        const f32x4 g0 = *(const f32x4*)gp, g1 = *(const f32x4*)(gp + 4), b0 = *(const f32x4*)bp, b1 = *(const f32x4*)(bp + 4);
#pragma unroll
        for (int q = 0; q < 4; ++q) { gg[j][q] = g0[q]; gg[j][4 + q] = g1[q]; bb[j][q] = b0[q]; bb[j][4 + q] = b1[q]; } }
    for (int blk = blockIdx.x * NWAVES + wave; blk < T_ / 16; blk += G * NWAVES) {
        const int sv = slot[(size_t)blk * 64 + lane];
        for (int k = 0; k < 16; k += 4) {
            u32x4 xw[4][2], yw[4][4][2];
#pragma unroll
            for (int q = 0; q < 4; ++q) { const size_t t = (size_t)blk * 16 + k + q;
#pragma unroll
                for (int j = 0; j < 2; ++j) xw[q][j] = *(const u32x4*)(x1b + t * 1024 + 8 * lane + 512 * j);
#pragma unroll
                for (int kk = 0; kk < 4; ++kk) { const size_t sr = (size_t)__builtin_amdgcn_readfirstlane(__shfl(sv, (k + q) * 4 + kk));
#pragma unroll
                    for (int j = 0; j < 2; ++j) yw[q][kk][j] = *(const u32x4*)(ys + sr * 1024 + 8 * lane + 512 * j); } }
#pragma unroll
            for (int q = 0; q < 4; ++q) { const size_t t = (size_t)blk * 16 + k + q;
                float xv[2][8]; float s = 0.f;
#pragma unroll
                for (int j = 0; j < 2; ++j) { const unsigned xx[4] = {xw[q][j].x, xw[q][j].y, xw[q][j].z, xw[q][j].w};
#pragma unroll
                    for (int p2 = 0; p2 < 4; ++p2) { xv[j][2 * p2] = bflo(xx[p2]) * DN_ALPHA; xv[j][2 * p2 + 1] = bfhi(xx[p2]) * DN_ALPHA; }
#pragma unroll
                    for (int kk = 0; kk < 4; ++kk) { const unsigned yy[4] = {yw[q][kk][j].x, yw[q][kk][j].y, yw[q][kk][j].z, yw[q][kk][j].w};
#pragma unroll
                        for (int p2 = 0; p2 < 4; ++p2) { xv[j][2 * p2] += bflo(yy[p2]); xv[j][2 * p2 + 1] += bfhi(yy[p2]); } }
#pragma unroll
                    for (int e = 0; e < 8; ++e) s += xv[j][e]; }
                const float mean = wave_sum(s) * (1.0f / 1024.0f); float s2 = 0.f;
#pragma unroll
                for (int j = 0; j < 2; ++j)
#pragma unroll
                    for (int e = 0; e < 8; ++e) { xv[j][e] -= mean; s2 += xv[j][e] * xv[j][e]; }
                const float rstd = rsqrtf(wave_sum(s2) * (1.0f / 1024.0f) + LN_EPS);
#pragma unroll
                for (int j = 0; j < 2; ++j) {
#pragma unroll
                    for (int e = 0; e < 8; ++e) xv[j][e] = xv[j][e] * rstd * gg[j][e] + bb[j][e];
                    const size_t o = t * 1024 + 8 * lane + 512 * j;
                    if (xout) { *(f32x4*)(xout + o) = (f32x4){xv[j][0], xv[j][1], xv[j][2], xv[j][3]}; *(f32x4*)(xout + o + 4) = (f32x4){xv[j][4], xv[j][5], xv[j][6], xv[j][7]}; }
                    u32x4 w; w.x = pk2(xv[j][0], xv[j][1]); w.y = pk2(xv[j][2], xv[j][3]); w.z = pk2(xv[j][4], xv[j][5]); w.w = pk2(xv[j][6], xv[j][7]); *(u32x4*)(xb + o) = w;
                    u32x2 q8; q8.x = pk_fp8x4(xv[j][0] * F8_SX, xv[j][1] * F8_SX, xv[j][2] * F8_SX, xv[j][3] * F8_SX); q8.y = pk_fp8x4(xv[j][4] * F8_SX, xv[j][5] * F8_SX, xv[j][6] * F8_SX, xv[j][7] * F8_SX);
                    *(u32x2*)(x8 + o) = q8; } }
        }
    }
}
typedef float f32x4_t __attribute__((ext_vector_type(4)));
constexpr size_t MX_LRU_PH = 0, MX_LRU_CARRY = 4 * MiB;
template <int MODE> __device__ __forceinline__ void lru_fast(ArgsP a, int l, int b, int h, int c_lo, int c_hi, LAS unsigned char* lds, const bf16_t* proj, bf16_t* H, unsigned char* mxs) {
    int tid_ = threadIdx.x; asm volatile("" : "+v"(tid_)); const int tid = tid_, lane = tid & 63, wave = __builtin_amdgcn_readfirstlane(tid >> 6), fr = lane & 15, g = lane >> 4;
    LAS bf16_t* xa = (LAS bf16_t*)(lds);
    LAS bf16_t* ysb = (LAS bf16_t*)(lds + 17408);
    LAS bf16_t* outb = (LAS bf16_t*)(lds + 33792);
    LAS bf16_t* outc = (LAS bf16_t*)(lds + 50176);
    bf16_t* HL = (bf16_t*)(a->ws + WS_MB); bf16_t* CA = (bf16_t*)(a->ws + WS_X1B);
    float* PH = (float*)(mxs + MX_LRU_PH); const float* carry = (const float*)(mxs + MX_LRU_CARRY);
    const int ch = 16 * wave + fr, chg = h * 128 + ch;
    const bf16_t* wg = (const bf16_t*)(a->ws + WS_W + (size_t)l * WL_STRIDE + WL_G) + (size_t)h * 256 * 128;
    bf16x8 bra[4], brx[4];
#pragma unroll
    for (int ks = 0; ks < 4; ++ks) { bra[ks] = *(const bf16x8*)(wg + (size_t)(ch) * 128 + 32 * ks + 8 * g); brx[ks] = *(const bf16x8*)(wg + (size_t)(128 + ch) * 128 + 32 * ks + 8 * g); }
    const float ba = a->in[I_LBA][l * 1024 + chg], bx = a->in[I_LBX][l * 1024 + chg], sp = softplus_f(-a->in[I_LLAM][l * 1024 + chg]);
    const int cg = tid & 15, t0i = tid >> 4;
    float cwv[4][8], cbv[8];
    { const float* cw = a->in[I_LCW] + (size_t)l * 4 * 1024 + h * 128 + 8 * cg;
#pragma unroll
      for (int j = 0; j < 4; ++j) { const f32x4 w0 = *(const f32x4*)(cw + j * 1024), w1 = *(const f32x4*)(cw + j * 1024 + 4);
          cwv[j][0] = w0[0]; cwv[j][1] = w0[1]; cwv[j][2] = w0[2]; cwv[j][3] = w0[3]; cwv[j][4] = w1[0]; cwv[j][5] = w1[1]; cwv[j][6] = w1[2]; cwv[j][7] = w1[3]; }
      const float* cbp = a->in[I_LCB] + l * 1024 + h * 128 + 8 * cg; const f32x4 b0 = *(const f32x4*)(cbp), b1 = *(const f32x4*)(cbp + 4);
      cbv[0] = b0[0]; cbv[1] = b0[1]; cbv[2] = b0[2]; cbv[3] = b0[3]; cbv[4] = b1[0]; cbv[5] = b1[1]; cbv[6] = b1[2]; cbv[7] = b1[3]; }
    u32x4 pr[2][4], py[2];
#define LRU_ISSUE(c_) do { _Pragma("unroll") for (int i = 0; i < 2; ++i) { const int tl = (c_) * 64 + t0i + 32 * i; \
        _Pragma("unroll") for (int j = 0; j < 4; ++j) { const int tt_ = tl - 3 + j; pr[i][j] = (u32x4){0u, 0u, 0u, 0u}; \
            if (tt_ >= 0) pr[i][j] = *(const u32x4*)(proj + ((size_t)b * SEQ_ + tt_) * NPROJ + PC_LRUX + h * 128 + 8 * cg); } \
        if (MODE == 1) py[i] = *(const u32x4*)(proj + ((size_t)b * SEQ_ + tl) * NPROJ + PC_LRUY + h * 128 + 8 * cg); } } while (0)
    LRU_ISSUE(c_lo);
    for (int c = c_lo; c < c_hi; ++c) {
        const size_t tok0 = (size_t)b * SEQ_ + (size_t)c * 64;
        __syncthreads();
#pragma unroll
        for (int i = 0; i < 2; ++i) { float o[8];
#pragma unroll
            for (int q = 0; q < 8; ++q) o[q] = cbv[q];
#pragma unroll
            for (int j = 0; j < 4; ++j) { const unsigned x[4] = {pr[i][j].x, pr[i][j].y, pr[i][j].z, pr[i][j].w};
#pragma unroll
                for (int q = 0; q < 4; ++q) { o[2 * q] += cwv[j][2 * q] * bflo(x[q]); o[2 * q + 1] += cwv[j][2 * q + 1] * bfhi(x[q]); } }
            u32x4 w; w.x = pg8::cvt_pk_bf16(o[0], o[1]); w.y = pg8::cvt_pk_bf16(o[2], o[3]); w.z = pg8::cvt_pk_bf16(o[4], o[5]); w.w = pg8::cvt_pk_bf16(o[6], o[7]);
            *(LAS u32x4*)(xa + (t0i + 32 * i) * 136 + 8 * cg) = w;
            if (MODE == 1) *(LAS u32x4*)(ysb + (t0i + 32 * i) * 128 + 8 * cg) = py[i]; }
        if (c + 1 < c_hi) LRU_ISSUE(c + 1);
        __syncthreads();
        f32x4_t ar[4], ax[4];
#pragma unroll
        for (int tt = 0; tt < 4; ++tt) { ar[tt] = (f32x4_t){0.f, 0.f, 0.f, 0.f}; ax[tt] = (f32x4_t){0.f, 0.f, 0.f, 0.f}; }
#pragma unroll
        for (int tt = 0; tt < 4; ++tt)
#pragma unroll
            for (int ks = 0; ks < 4; ++ks) { const bf16x8 af = *(const LAS bf16x8*)(xa + (16 * tt + fr) * 136 + 32 * ks + 8 * g);
                ar[tt] = __builtin_amdgcn_mfma_f32_16x16x32_bf16(af, bra[ks], ar[tt], 0, 0, 0);
                ax[tt] = __builtin_amdgcn_mfma_f32_16x16x32_bf16(af, brx[ks], ax[tt], 0, 0, 0); }
        float av[4][4], uv[4][4], Ai[4], Bi[4];
#pragma unroll
        for (int tt = 0; tt < 4; ++tt) { float A = 1.f, B = 0.f;
#pragma unroll
            for (int r = 0; r < 4; ++r) { const int t = 16 * tt + 4 * g + r;
                const float rg = sigmoid_f(ar[tt][r] + ba), ig = sigmoid_f(ax[tt][r] + bx);
                const float log_a = -8.0f * rg * sp; av[tt][r] = __expf(log_a); uv[tt][r] = __builtin_amdgcn_sqrtf(neg_expm1_f(2.0f * log_a)) * (ig * bf2f(xa[t * 136 + ch]));
                B = av[tt][r] * B + uv[tt][r]; A *= av[tt][r]; }
            Ai[tt] = A; Bi[tt] = B; }
#pragma unroll
        for (int tt = 0; tt < 4; ++tt) { const float A1 = __shfl_up(Ai[tt], 16), B1 = __shfl_up(Bi[tt], 16); if (g >= 1) { Bi[tt] = Ai[tt] * B1 + Bi[tt]; Ai[tt] = Ai[tt] * A1; } }
#pragma unroll
        for (int tt = 0; tt < 4; ++tt) { const float A2 = __shfl_up(Ai[tt], 32), B2 = __shfl_up(Bi[tt], 32); if (g >= 2) { Bi[tt] = Ai[tt] * B2 + Bi[tt]; Ai[tt] = Ai[tt] * A2; } }
        float Ae[4], Be[4], At[4], Bt[4];
#pragma unroll
        for (int tt = 0; tt < 4; ++tt) { Ae[tt] = __shfl_up(Ai[tt], 16); Be[tt] = __shfl_up(Bi[tt], 16); if (g == 0) { Ae[tt] = 1.f; Be[tt] = 0.f; }
            At[tt] = __shfl(Ai[tt], fr + 48); Bt[tt] = __shfl(Bi[tt], fr + 48); }
        float hin = 0.f, ptot = 1.f;
        if (MODE == 1) hin = carry[((size_t)b * 64 + c) * 1024 + chg];
#pragma unroll
        for (int tt = 0; tt < 4; ++tt) {
            float hcur = Ae[tt] * hin + Be[tt], ccur = ptot * Ae[tt];
#pragma unroll
            for (int r = 0; r < 4; ++r) { const int t = 16 * tt + 4 * g + r; hcur = av[tt][r] * hcur + uv[tt][r]; ccur *= av[tt][r];
                if (MODE == 1) outb[t * 128 + ch] = (bf16_t)f2bf(hcur * gelu_tanh_f(bf2f(ysb[t * 128 + ch])));
                else { outb[t * 128 + ch] = (bf16_t)f2bf(hcur); outc[t * 128 + ch] = (bf16_t)f2bf(ccur); } }
            hin = At[tt] * hin + Bt[tt]; ptot *= At[tt]; }
        if (MODE == 0) { if (g == 0) { PH[(((size_t)b * 64 + c) * 2 + 0) * 1024 + chg] = ptot; PH[(((size_t)b * 64 + c) * 2 + 1) * 1024 + chg] = hin; } }
        __syncthreads();
#pragma unroll
        for (int i = 0; i < 2; ++i) { const int pid = tid + 512 * i; const int row = pid >> 4, c8 = (pid & 15) * 8;
            if (MODE == 1) *(u32x4*)(H + (tok0 + row) * 2048 + h * 128 + c8) = *(const LAS u32x4*)(outb + row * 128 + c8);
            else { *(u32x4*)(HL + (tok0 + row) * 1024 + h * 128 + c8) = *(const LAS u32x4*)(outb + row * 128 + c8); *(u32x4*)(CA + (tok0 + row) * 1024 + h * 128 + c8) = *(const LAS u32x4*)(outc + row * 128 + c8); } }
    }
#undef LRU_ISSUE
}
__device__ __forceinline__ void lru_carry(unsigned char* mxs, int gid0, int gstride) {
    const float* PH = (const float*)(mxs + MX_LRU_PH); float* carry = (float*)(mxs + MX_LRU_CARRY);
    for (int gid = gid0; gid < NBATCH * 1024; gid += gstride) { const int b = gid >> 10, chg = gid & 1023; float hc = 0.f;
#pragma unroll 8
        for (int c = 0; c < 64; ++c) { const size_t o = ((size_t)b * 64 + c); carry[o * 1024 + chg] = hc; hc = PH[(o * 2) * 1024 + chg] * hc + PH[(o * 2 + 1) * 1024 + chg]; } }
}
__device__ __forceinline__ void lru_apply(ArgsP a, const bf16_t* proj, bf16_t* H, unsigned char* mxs, int first, int stride) {
    int tid_ = threadIdx.x; asm volatile("" : "+v"(tid_));
    const bf16_t* HL = (const bf16_t*)(a->ws + WS_MB); const bf16_t* CA = (const bf16_t*)(a->ws + WS_X1B); const float* carry = (const float*)(mxs + MX_LRU_CARRY);
    for (size_t p = (size_t)first * 512 + tid_; p < (size_t)T_ * 128; p += (size_t)stride * 512) { const size_t t = p >> 7; const int c8 = (int)(p & 127) * 8;
        const u32x4 hw = *(const u32x4*)(HL + t * 1024 + c8), cw = *(const u32x4*)(CA + t * 1024 + c8), yw = *(const u32x4*)(proj + t * NPROJ + PC_LRUY + c8);
        const float* cp = carry + (t >> 6) * 1024 + c8; const f32x4 c0 = *(const f32x4*)(cp), c1 = *(const f32x4*)(cp + 4);
        const unsigned hh[4] = {hw.x, hw.y, hw.z, hw.w}, cc[4] = {cw.x, cw.y, cw.z, cw.w}, yy[4] = {yw.x, yw.y, yw.z, yw.w}; const float cin[8] = {c0[0], c0[1], c0[2], c0[3], c1[0], c1[1], c1[2], c1[3]};
        unsigned o[4];
#pragma unroll
        for (int q = 0; q < 4; ++q) { const float h0 = bflo(hh[q]) + bflo(cc[q]) * cin[2 * q], h1 = bfhi(hh[q]) + bfhi(cc[q]) * cin[2 * q + 1];
            o[q] = pg8::cvt_pk_bf16(h0 * gelu_tanh_f(bflo(yy[q])), h1 * gelu_tanh_f(bfhi(yy[q]))); }
        *(u32x4*)(H + t * 2048 + c8) = (u32x4){o[0], o[1], o[2], o[3]}; }
}
typedef float f32x16 __attribute__((ext_vector_type(16)));
typedef short bf16x4 __attribute__((ext_vector_type(4)));
constexpr size_t MXB_ML_U = 0;
constexpr size_t MXB_ML_CP = 64 * MiB;
constexpr size_t MXS_ML_NU = 6 * MiB, MXS_ML_NP = 6 * MiB + 512 * 1024, MXS_ML_SC = 7 * MiB;

__device__ __forceinline__ float bperm_f(int src_lane, float v) { return __builtin_bit_cast(float, __builtin_amdgcn_ds_bpermute(src_lane << 2, __builtin_bit_cast(int, v))); }
__device__ __forceinline__ float wave_incl_sum(float v, int lane) {
#pragma unroll
    for (int o = 1; o < 64; o <<= 1) { const float t = bperm_f(lane >= o ? lane - o : lane, v); if (lane >= o) v += t; }
    return v;
}
__device__ __forceinline__ float wave_incl_max(float v, int lane) {
#pragma unroll
    for (int o = 1; o < 64; o <<= 1) { const float t = bperm_f(lane >= o ? lane - o : lane, v); if (lane >= o) v = fmaxf(v, t); }
    return v;
}
__device__ __forceinline__ bf16x8 pack8(float a0, float a1, float a2, float a3, float a4, float a5, float a6, float a7) {
    u32x4 w; w.x = pg8::cvt_pk_bf16(a0, a1); w.y = pg8::cvt_pk_bf16(a2, a3); w.z = pg8::cvt_pk_bf16(a4, a5); w.w = pg8::cvt_pk_bf16(a6, a7); return __builtin_bit_cast(bf16x8, w);
}
__device__ __forceinline__ bf16x8 ld_perm(const LAS bf16_t* p) {
    const u32x2 lo = *(const LAS u32x2*)(p), hi = *(const LAS u32x2*)(p + 8); u32x4 w; w.x = lo.x; w.y = lo.y; w.z = hi.x; w.w = hi.y; return __builtin_bit_cast(bf16x8, w);
}

__device__ __forceinline__ void mlstm_passA(ArgsP a, int l, LAS unsigned char* lds, const bf16_t* proj, const float* gsm, unsigned char* mxb, unsigned char* mxs, int G) {
    int tid_ = threadIdx.x; asm volatile("" : "+v"(tid_)); const int tid = tid_, lane = tid & 63, wave = __builtin_amdgcn_readfirstlane(tid >> 6), r = lane & 31, hh = lane >> 5;
    LAS bf16_t* kwT = (LAS bf16_t*)(lds);
    LAS bf16_t* vT = (LAS bf16_t*)(lds + 9216);
    LAS float* wts = (LAS float*)(lds + 27648);
    float* NU = (float*)(mxs + MXS_ML_NU); float* SC = (float*)(mxs + MXS_ML_SC);
    const f32x4 ib4 = *(const f32x4*)(a->in[I_MIB] + l * 4), fb4 = *(const f32x4*)(a->in[I_MFB] + l * 4);
    u32x4 kp, vp0, vp1; float pgf = 0.f, pgi = 0.f;
#define MLA_ISSUE(u_) do { const int c_ = (u_) & 63, hd_ = ((u_) >> 6) & 3, b_ = (u_) >> 8; const size_t t0_ = (size_t)b_ * SEQ_ + (size_t)c_ * 64 + lane; \
        kp = *(const u32x4*)(proj + t0_ * NPROJ + PC_MLK + hd_ * 64 + wave * 8); vp0 = *(const u32x4*)(proj + t0_ * NPROJ + PC_MLV + hd_ * 128 + wave * 8); \
        vp1 = *(const u32x4*)(proj + t0_ * NPROJ + PC_MLV + hd_ * 128 + 64 + wave * 8); pgf = gsm[t0_ * 32 + 4 + hd_]; pgi = gsm[t0_ * 32 + hd_]; } while (0)
    if ((int)blockIdx.x < 2048) MLA_ISSUE((int)blockIdx.x);
    for (int uid = blockIdx.x; uid < 2048; uid += G) {
        const int hd = (uid >> 6) & 3;
        const float ib = hd == 0 ? ib4[0] : (hd == 1 ? ib4[1] : (hd == 2 ? ib4[2] : ib4[3])), fb = hd == 0 ? fb4[0] : (hd == 1 ? fb4[1] : (hd == 2 ? fb4[2] : fb4[3]));
        float w;
        { const float fpre = pgf + fb, ipre = pgi + ib;
          const float logf = -softplus_f(-fpre); const float bc = wave_incl_sum(logf, lane); const float bl = __builtin_bit_cast(float, __builtin_amdgcn_readlane(__builtin_bit_cast(int, bc), 63));
          const float ge = bl - bc + ipre; const float mloc = wave_max(ge);
          w = __expf(ge - mloc);
          if (tid == 0) { SC[(size_t)uid * 4 + 0] = bl; SC[(size_t)uid * 4 + 1] = mloc; } }
        __syncthreads();
        { const unsigned kw[4] = {kp.x, kp.y, kp.z, kp.w};
#pragma unroll
          for (int j = 0; j < 4; ++j) { kwT[(wave * 8 + 2 * j) * 72 + lane] = (bf16_t)f2bf(w * bflo(kw[j])); kwT[(wave * 8 + 2 * j + 1) * 72 + lane] = (bf16_t)f2bf(w * bfhi(kw[j])); }
          const unsigned v0[4] = {vp0.x, vp0.y, vp0.z, vp0.w}, v1[4] = {vp1.x, vp1.y, vp1.z, vp1.w};
#pragma unroll
          for (int j = 0; j < 4; ++j) { vT[(wave * 8 + 2 * j) * 72 + lane] = (bf16_t)(v0[j] & 0xffffu); vT[(wave * 8 + 2 * j + 1) * 72 + lane] = (bf16_t)(v0[j] >> 16);
              vT[(64 + wave * 8 + 2 * j) * 72 + lane] = (bf16_t)(v1[j] & 0xffffu); vT[(64 + wave * 8 + 2 * j + 1) * 72 + lane] = (bf16_t)(v1[j] >> 16); } }
        if (uid + G < 2048) MLA_ISSUE(uid + G);
        __syncthreads();
        const int dI = wave >> 2, eJ = wave & 3;
        f32x16 acc;
#pragma unroll
        for (int i = 0; i < 16; ++i) acc[i] = 0.f;
#pragma unroll
        for (int ks = 0; ks < 4; ++ks) { const bf16x8 af = *(const LAS bf16x8*)(kwT + (32 * dI + r) * 72 + 16 * ks + 8 * hh), bf = *(const LAS bf16x8*)(vT + (32 * eJ + r) * 72 + 16 * ks + 8 * hh);
            acc = __builtin_amdgcn_mfma_f32_32x32x16_bf16(af, bf, acc, 0, 0, 0); }
        float* ud = (float*)(mxb + MXB_ML_U) + ((size_t)uid * 8 + wave) * 1024;
#pragma unroll
        for (int q = 0; q < 4; ++q) *(f32x4*)(ud + (q * 64 + lane) * 4) = (f32x4){acc[4 * q], acc[4 * q + 1], acc[4 * q + 2], acc[4 * q + 3]};
        if (tid < 64) { float s = 0.f;
#pragma unroll 8
            for (int t = 0; t < 64; ++t) s += bf2f(kwT[tid * 72 + t]);
            NU[(size_t)uid * 64 + tid] = s; }
    }
#undef MLA_ISSUE
}
__device__ __forceinline__ void mlstm_passB(unsigned char* mxb, unsigned char* mxs, int G) {
    int tid_ = threadIdx.x; asm volatile("" : "+v"(tid_)); const int tid = tid_;
    const float* NU = (const float*)(mxs + MXS_ML_NU); float* NP = (float*)(mxs + MXS_ML_NP); float* SC = (float*)(mxs + MXS_ML_SC);
    for (int wu = blockIdx.x; wu < 256; wu += G) {
        const int chain = wu >> 3, tile = wu & 7;
        if (tid < 128) {
            const int lane = tid & 63, s = tid >> 6;
            float st[8]; float m = 0.f;
#pragma unroll
            for (int i = 0; i < 8; ++i) st[i] = 0.f;
#pragma unroll 4
            for (int c = 0; c < 64; ++c) { const size_t uid = (size_t)chain * 64 + c;
                const float* ud = (const float*)(mxb + MXB_ML_U) + (uid * 8 + tile) * 1024;
                const f32x4 u0 = *(const f32x4*)(ud + ((2 * s) * 64 + lane) * 4), u1 = *(const f32x4*)(ud + ((2 * s + 1) * 64 + lane) * 4);
                const float bl = SC[uid * 4 + 0], mloc = SC[uid * 4 + 1];
                *(bf16x8*)((bf16_t*)(mxb + MXB_ML_CP) + (uid * 8 + tile) * 1024 + (s * 64 + lane) * 8) = pack8(st[0], st[1], st[2], st[3], st[4], st[5], st[6], st[7]);
                if (tile == 0 && tid == 0) SC[uid * 4 + 2] = m;
                const float mn = fmaxf(bl + m, mloc), dec = __expf(bl + m - mn), sc = __expf(mloc - mn); m = mn;
#pragma unroll
                for (int i = 0; i < 4; ++i) { st[i] = dec * st[i] + sc * u0[i]; st[4 + i] = dec * st[4 + i] + sc * u1[i]; } }
        } else if (tile == 0 && tid < 192) {
            const int d = tid - 128; float n = 0.f, m = 0.f;
#pragma unroll 4
            for (int c = 0; c < 64; ++c) { const size_t uid = (size_t)chain * 64 + c; const float bl = SC[uid * 4 + 0], mloc = SC[uid * 4 + 1]; const float nu = NU[uid * 64 + d];
                NP[uid * 64 + d] = n; const float mn = fmaxf(bl + m, mloc), dec = __expf(bl + m - mn), sc = __expf(mloc - mn); m = mn; n = dec * n + sc * nu; }
        }
    }
}
__device__ __forceinline__ void mlstm_passC(ArgsP a, int l, LAS unsigned char* lds, const bf16_t* proj, const float* gsm, bf16_t* H, unsigned char* mxb, unsigned char* mxs, int first, int stride) {
    int tid_ = threadIdx.x; asm volatile("" : "+v"(tid_)); const int tid = tid_, lane = tid & 63, wave = __builtin_amdgcn_readfirstlane(tid >> 6), r = lane & 31, hh = lane >> 5;
    LAS bf16_t* qb = (LAS bf16_t*)(lds);
    LAS bf16_t* kb = (LAS bf16_t*)(lds + 9216);
    LAS bf16_t* vT = (LAS bf16_t*)(lds + 18432);
    LAS bf16_t* ob = (LAS bf16_t*)(lds + 36864);
    LAS bf16_t* outb = (LAS bf16_t*)(lds + 54272);
    LAS float* tb_rt = (LAS float*)(lds + 70656);
    LAS float* tb_ct = tb_rt + 64;
    LAS float* tb_iw = tb_rt + 128;
    LAS float* tb_em = tb_rt + 192;
    LAS float* tb_np = tb_rt + 256;
    LAS float* ssq = tb_rt + 320;
    const float* NP = (const float*)(mxs + MXS_ML_NP); const float* SC = (const float*)(mxs + MXS_ML_SC);
    const f32x4 ib4 = *(const f32x4*)(a->in[I_MIB] + l * 4), fb4 = *(const f32x4*)(a->in[I_MFB] + l * 4);
    LAS float* gnl = tb_rt + 640;
    gnl[tid] = a->in[I_MNG][(size_t)l * 512 + tid];
    u32x4 pq, pk, po[2], pv0, pv1; float pgf = 0.f, pgi = 0.f, pmp = 0.f, pnp = 0.f;
#define MLC_ISSUE(u_) do { const int c_ = (u_) & 63, hd_ = ((u_) >> 6) & 3, b_ = (u_) >> 8; const size_t k0_ = (size_t)b_ * SEQ_ + (size_t)c_ * 64; const int row_ = tid >> 3, c8_ = (tid & 7) * 8; \
        pq = *(const u32x4*)(proj + (k0_ + row_) * NPROJ + PC_MLQ + hd_ * 64 + c8_); pk = *(const u32x4*)(proj + (k0_ + row_) * NPROJ + PC_MLK + hd_ * 64 + c8_); \
        _Pragma("unroll") for (int i = 0; i < 2; ++i) { const int pid = tid + 512 * i; po[i] = *(const u32x4*)(proj + (k0_ + (pid >> 4)) * NPROJ + PC_MLO + hd_ * 128 + (pid & 15) * 8); } \
        pv0 = *(const u32x4*)(proj + (k0_ + lane) * NPROJ + PC_MLV + hd_ * 128 + wave * 8); pv1 = *(const u32x4*)(proj + (k0_ + lane) * NPROJ + PC_MLV + hd_ * 128 + 64 + wave * 8); \
        if (wave == 0) { pgf = gsm[(k0_ + lane) * 32 + 4 + hd_]; pgi = gsm[(k0_ + lane) * 32 + hd_]; pmp = SC[(size_t)(u_) * 4 + 2]; pnp = NP[(size_t)(u_) * 64 + lane]; } } while (0)
    if (first < 2048) MLC_ISSUE(first);
    for (int uid = first; uid < 2048; uid += stride) {
        const int c = uid & 63, hd = (uid >> 6) & 3, b = uid >> 8; const size_t tok0 = (size_t)b * SEQ_ + (size_t)c * 64;
        __syncthreads();
        if (wave == 0) {
            const float ib = hd == 0 ? ib4[0] : (hd == 1 ? ib4[1] : (hd == 2 ? ib4[2] : ib4[3])), fb = hd == 0 ? fb4[0] : (hd == 1 ? fb4[1] : (hd == 2 ? fb4[2] : fb4[3]));
            const float fpre = pgf + fb, ipre = pgi + ib;
            const float logf = -softplus_f(-fpre); const float bc = wave_incl_sum(logf, lane);
            const float rt = ipre - bc; const float cmx = wave_incl_max(rt, lane); const float mprev = pmp;
            const float mt = bc + fmaxf(mprev, cmx);
            tb_rt[lane] = rt; tb_ct[lane] = bc - mt; tb_iw[lane] = __expf(bc + mprev - mt); tb_em[lane] = __expf(-mt); tb_np[lane] = pnp;
        }
        { const int row = tid >> 3, c8 = (tid & 7) * 8;
          *(LAS u32x4*)(qb + row * 72 + c8) = pq; *(LAS u32x4*)(kb + row * 72 + c8) = pk;
#pragma unroll
          for (int i = 0; i < 2; ++i) { const int pid = tid + 512 * i; *(LAS u32x4*)(ob + (pid >> 4) * 136 + (pid & 15) * 8) = po[i]; }
          const unsigned v0[4] = {pv0.x, pv0.y, pv0.z, pv0.w}, v1[4] = {pv1.x, pv1.y, pv1.z, pv1.w};
#pragma unroll
          for (int j = 0; j < 4; ++j) { vT[(wave * 8 + 2 * j) * 72 + lane] = (bf16_t)(v0[j] & 0xffffu); vT[(wave * 8 + 2 * j + 1) * 72 + lane] = (bf16_t)(v0[j] >> 16);
              vT[(64 + wave * 8 + 2 * j) * 72 + lane] = (bf16_t)(v1[j] & 0xffffu); vT[(64 + wave * 8 + 2 * j + 1) * 72 + lane] = (bf16_t)(v1[j] >> 16); } }
        if (uid + stride < 2048) MLC_ISSUE(uid + stride);
        __syncthreads();
        const int eI = wave >> 1, tJ = wave & 1; const int t = 32 * tJ + r;
        f32x16 as[2];
#pragma unroll
        for (int sI = 0; sI < 2; ++sI) {
#pragma unroll
            for (int i = 0; i < 16; ++i) as[sI][i] = 0.f;
#pragma unroll
            for (int ks = 0; ks < 4; ++ks) { const bf16x8 af = *(const LAS bf16x8*)(kb + (32 * sI + r) * 72 + 16 * ks + 8 * hh), bf = *(const LAS bf16x8*)(qb + t * 72 + 16 * ks + 8 * hh);
                as[sI] = __builtin_amdgcn_mfma_f32_32x32x16_bf16(af, bf, as[sI], 0, 0, 0); } }
        const float ctt = tb_ct[t], iwt = tb_iw[t] * 0.125f, emt = tb_em[t];
        float dsum = 0.f;
#pragma unroll
        for (int sI = 0; sI < 2; ++sI)
#pragma unroll
            for (int q = 0; q < 4; ++q) { const int s0 = 32 * sI + 8 * q + 4 * hh; const f32x4 rt4 = *(const LAS f32x4*)(tb_rt + s0);
#pragma unroll
                for (int i = 0; i < 4; ++i) { const float wv = (s0 + i <= t) ? as[sI][4 * q + i] * 0.125f * __expf(ctt + rt4[i]) : 0.f; as[sI][4 * q + i] = wv; dsum += wv; } }
        float qn = 0.f;
#pragma unroll
        for (int j = 0; j < 4; ++j) { const u32x4 qw = *(const LAS u32x4*)(qb + t * 72 + 32 * hh + 8 * j); const f32x4 n0 = *(const LAS f32x4*)(tb_np + 32 * hh + 8 * j), n1 = *(const LAS f32x4*)(tb_np + 32 * hh + 8 * j + 4);
            qn += bflo(qw.x) * n0[0] + bfhi(qw.x) * n0[1] + bflo(qw.y) * n0[2] + bfhi(qw.y) * n0[3] + bflo(qw.z) * n1[0] + bfhi(qw.z) * n1[1] + bflo(qw.w) * n1[2] + bfhi(qw.w) * n1[3]; }
        float den = dsum + iwt * qn; den += __shfl_xor(den, 32);
        f32x16 an;
#pragma unroll
        for (int i = 0; i < 16; ++i) an[i] = 0.f;
#pragma unroll
        for (int sI = 0; sI < 2; ++sI)
#pragma unroll
            for (int s2 = 0; s2 < 2; ++s2) { const bf16x8 af = ld_perm(vT + (32 * eI + r) * 72 + 32 * sI + 16 * s2 + 4 * hh);
                const bf16x8 bf = pack8(as[sI][8 * s2], as[sI][8 * s2 + 1], as[sI][8 * s2 + 2], as[sI][8 * s2 + 3], as[sI][8 * s2 + 4], as[sI][8 * s2 + 5], as[sI][8 * s2 + 6], as[sI][8 * s2 + 7]);
                an = __builtin_amdgcn_mfma_f32_32x32x16_bf16(af, bf, an, 0, 0, 0); }
        const bf16_t* cpd = (const bf16_t*)(mxb + MXB_ML_CP) + (size_t)uid * 8 * 1024;
#pragma unroll
        for (int dI = 0; dI < 2; ++dI)
#pragma unroll
            for (int s2 = 0; s2 < 2; ++s2) { const bf16x8 af = *(const bf16x8*)(cpd + (size_t)(dI * 4 + eI) * 1024 + (s2 * 64 + lane) * 8);
                const u32x4 qw = __builtin_bit_cast(u32x4, ld_perm(qb + t * 72 + 32 * dI + 16 * s2 + 4 * hh));
                const bf16x8 bf = pack8(bflo(qw.x) * iwt, bfhi(qw.x) * iwt, bflo(qw.y) * iwt, bfhi(qw.y) * iwt, bflo(qw.z) * iwt, bfhi(qw.z) * iwt, bflo(qw.w) * iwt, bfhi(qw.w) * iwt);
                an = __builtin_amdgcn_mfma_f32_32x32x16_bf16(af, bf, an, 0, 0, 0); }
        const float dinv = 1.0f / fmaxf(fabsf(den), emt);
        float sq = 0.f;
#pragma unroll
        for (int i = 0; i < 16; ++i) { an[i] *= dinv; sq += an[i] * an[i]; }
        sq += __shfl_xor(sq, 32);
        if (hh == 0) ssq[eI * 64 + t] = sq;
        __syncthreads();
        const float tot = ssq[t] + ssq[64 + t] + ssq[128 + t] + ssq[192 + t];
        const float rinv = rsqrtf(tot * (1.0f / 128.0f) + RMS_EPS);
        const LAS float* gn = gnl + hd * 128;
#pragma unroll
        for (int q = 0; q < 4; ++q) { const int e0 = 32 * eI + 8 * q + 4 * hh; const f32x4 g4 = *(const LAS f32x4*)(gn + e0); const u32x2 ow = *(const LAS u32x2*)(ob + t * 136 + e0);
            const float o0 = an[4 * q] * rinv * g4[0] * sigmoid_f(bflo(ow.x)), o1 = an[4 * q + 1] * rinv * g4[1] * sigmoid_f(bfhi(ow.x));
            const float o2 = an[4 * q + 2] * rinv * g4[2] * sigmoid_f(bflo(ow.y)), o3 = an[4 * q + 3] * rinv * g4[3] * sigmoid_f(bfhi(ow.y));
            u32x2 pw; pw.x = pg8::cvt_pk_bf16(o0, o1); pw.y = pg8::cvt_pk_bf16(o2, o3); *(LAS u32x2*)(outb + t * 128 + e0) = pw; }
        __syncthreads();
#pragma unroll
        for (int i = 0; i < 2; ++i) { const int pid = tid + 512 * i; const int row = pid >> 4, c8 = (pid & 15) * 8;
            *(u32x4*)(H + (tok0 + row) * 2048 + 1024 + hd * 128 + c8) = *(const LAS u32x4*)(outb + row * 128 + c8); }
    }
#undef MLC_ISSUE
}
constexpr size_t MXB_GD_ND = 96 * MiB, MXB_GD_OD = 160 * MiB, MXB_GD_T = 224 * MiB;
constexpr size_t MXT_GD_XD = 8 * MiB, MXT_GD_QD = 40 * MiB, MXT_GD_SD = 72 * MiB;
constexpr size_t MXS_GD_GL = 7 * MiB + 64 * 1024;

__device__ __forceinline__ void conv_silu8(const u32x4 (&rw)[4], const float* cw, float (&o)[8]) {
#pragma unroll
    for (int j = 0; j < 8; ++j) o[j] = 0.f;
#pragma unroll
    for (int i = 0; i < 4; ++i) { const f32x4 w0 = *(const f32x4*)(cw + i * 1536), w1 = *(const f32x4*)(cw + i * 1536 + 4); const unsigned x[4] = {rw[i].x, rw[i].y, rw[i].z, rw[i].w};
        o[0] += w0[0] * bflo(x[0]); o[1] += w0[1] * bfhi(x[0]); o[2] += w0[2] * bflo(x[1]); o[3] += w0[3] * bfhi(x[1]);
        o[4] += w1[0] * bflo(x[2]); o[5] += w1[1] * bfhi(x[2]); o[6] += w1[2] * bflo(x[3]); o[7] += w1[3] * bfhi(x[3]); }
#pragma unroll
    for (int j = 0; j < 8; ++j) o[j] = silu_f(o[j]);
}
__device__ __forceinline__ void conv_silu8_l(const u32x4 (&rw)[4], const LAS float* cw, int stride, float (&o)[8]) {
#pragma unroll
    for (int j = 0; j < 8; ++j) o[j] = 0.f;
#pragma unroll
    for (int i = 0; i < 4; ++i) { const f32x4 w0 = *(const LAS f32x4*)(cw + i * stride), w1 = *(const LAS f32x4*)(cw + i * stride + 4); const unsigned x[4] = {rw[i].x, rw[i].y, rw[i].z, rw[i].w};
        o[0] += w0[0] * bflo(x[0]); o[1] += w0[1] * bfhi(x[0]); o[2] += w0[2] * bflo(x[1]); o[3] += w0[3] * bfhi(x[1]);
        o[4] += w1[0] * bflo(x[2]); o[5] += w1[1] * bfhi(x[2]); o[6] += w1[2] * bflo(x[3]); o[7] += w1[3] * bfhi(x[3]); }
#pragma unroll
    for (int j = 0; j < 8; ++j) o[j] = silu_f(o[j]);
}
__device__ __forceinline__ void load_rows4(const bf16_t* proj, int b, int tl, int col, u32x4 (&rw)[4]) {
#pragma unroll
    for (int i = 0; i < 4; ++i) { const int tt = tl - 3 + i; rw[i] = (u32x4){0u, 0u, 0u, 0u}; if (tt >= 0) rw[i] = *(const u32x4*)(proj + ((size_t)b * SEQ_ + tt) * NPROJ + col); }
}

__device__ __forceinline__ void gdn_passA1(ArgsP a, int l, LAS unsigned char* lds, const bf16_t* proj, const float* gsm, unsigned char* mxb, int G) {
    int tid_ = threadIdx.x; asm volatile("" : "+v"(tid_)); const int tid = tid_, lane = tid & 63, wave = __builtin_amdgcn_readfirstlane(tid >> 6), r = lane & 31, hh = lane >> 5;
    LAS unsigned char* wl = lds + wave * 16384;
    LAS bf16_t* kb = (LAS bf16_t*)wl;
    LAS float* am = (LAS float*)wl;
    LAS float* tb = (LAS float*)(lds + MISC_OFF + 1024 + wave * 512);
    LAS float* cwl = (LAS float*)(lds + MISC_OFF + 8192);
    { const float* cwk = a->in[I_GCW] + (size_t)l * 4 * 1536 + 512; for (int i = tid; i < 2048; i += 512) cwl[i] = cwk[(i >> 9) * 1536 + (i & 511)]; }
    LAS float* gpl = (LAS float*)(lds + MISC_OFF + 8192 + 8192);
    if (tid < 8) { gpl[tid] = -__expf(a->in[I_GAL][l * 8 + tid]); gpl[8 + tid] = a->in[I_GDT][l * 8 + tid]; }
    __syncthreads();
    for (int uid = blockIdx.x * NWAVES + wave; uid < 4096; uid += G * NWAVES) {
        const int c = uid & 63, hd = (uid >> 6) & 7, b = uid >> 9; const int tl = c * 64 + lane; const size_t tok = (size_t)b * SEQ_ + tl;
        float ss = 0.f;
        const float ga_ = gsm[tok * 32 + 8 + hd], gb_ = gsm[tok * 32 + 16 + hd];
#pragma unroll
        for (int ph = 0; ph < 2; ++ph) {
            u32x4 rw[4][4];
#pragma unroll
            for (int p = 0; p < 4; ++p) load_rows4(proj, b, tl, PC_GDK + hd * 64 + 8 * (4 * ph + p), rw[p]);
#pragma unroll
            for (int p = 0; p < 4; ++p) { float o[8]; conv_silu8_l(rw[p], cwl + hd * 64 + 8 * (4 * ph + p), 512, o);
#pragma unroll
                for (int j = 0; j < 8; ++j) ss += o[j] * o[j];
                *(LAS bf16x8*)(kb + lane * 72 + 8 * (4 * ph + p)) = pack8(o[0], o[1], o[2], o[3], o[4], o[5], o[6], o[7]); } }
        const float rn = rsqrtf(ss + RMS_EPS);
        const float gg = gpl[hd] * softplus_f(ga_ + gpl[8 + hd]);
        const float gc = wave_incl_sum(gg, lane), beta = 1.f / (1.f + __expf(-gb_));
        tb[lane] = gc; tb[64 + lane] = beta * rn;
        LDS_WAIT(); asm volatile("" ::: "memory");
        bf16x8 kf[2][4];
#pragma unroll
        for (int I = 0; I < 2; ++I)
#pragma unroll
            for (int ks = 0; ks < 4; ++ks) kf[I][ks] = *(const LAS bf16x8*)(kb + (32 * I + r) * 72 + 16 * ks + 8 * hh);
        LDS_WAIT(); asm volatile("" ::: "memory");
#pragma unroll
        for (int I = 0; I < 2; ++I)
#pragma unroll
            for (int J = 0; J < 2; ++J) { f32x16 acc;
#pragma unroll
                for (int i = 0; i < 16; ++i) acc[i] = 0.f;
#pragma unroll
                for (int ks = 0; ks < 4; ++ks) acc = __builtin_amdgcn_mfma_f32_32x32x16_bf16(kf[I][ks], kf[J][ks], acc, 0, 0, 0);
                const int s = 32 * J + r; const float gcs = __shfl(gc, s), rns = __shfl(rn, s);
#pragma unroll
                for (int q = 0; q < 4; ++q) { const int t0 = 32 * I + 8 * q + 4 * hh; const f32x4 gct = *(const LAS f32x4*)(tb + t0), brt = *(const LAS f32x4*)(tb + 64 + t0);
#pragma unroll
                    for (int i = 0; i < 4; ++i) { const float v = (s < t0 + i) ? acc[4 * q + i] * brt[i] * rns * __expf(gct[i] - gcs) : 0.f; am[(t0 + i) * 64 + s] = v; } } }
        LDS_WAIT(); asm volatile("" ::: "memory");
        float Tc[64];
#pragma unroll
        for (int i = 0; i < 64; ++i) { float acc = (i == lane) ? 1.f : 0.f;
#pragma unroll
            for (int j4 = 0; j4 < (i + 3) / 4; ++j4) { const f32x4 av = *(const LAS f32x4*)(am + i * 64 + 4 * j4);
#pragma unroll
                for (int jj = 0; jj < 4; ++jj) if (4 * j4 + jj < i) acc -= av[jj] * Tc[4 * j4 + jj]; }
            Tc[i] = acc; }
        bf16_t* Tg = (bf16_t*)(mxb + MXB_GD_T) + (size_t)uid * 4096;
#pragma unroll
        for (int i = 0; i < 64; ++i) Tg[i * 64 + lane] = (bf16_t)f2bf(Tc[i]);
    }
}

__device__ __forceinline__ void gdn_passA2(ArgsP a, int l, LAS unsigned char* lds, const bf16_t* proj, const float* gsm, unsigned char* mxb, unsigned char* mxt, unsigned char* mxs, int G) {
    int tid_ = threadIdx.x; asm volatile("" : "+v"(tid_)); const int tid = tid_, lane = tid & 63, wave = __builtin_amdgcn_readfirstlane(tid >> 6), r = lane & 31, hh = lane >> 5;
    LAS bf16_t* qb = (LAS bf16_t*)(lds);
    LAS bf16_t* kb = (LAS bf16_t*)(lds + 9216);
    LAS bf16_t* bvT = (LAS bf16_t*)(lds + 18432);
    LAS bf16_t* bkT = (LAS bf16_t*)(lds + 27648);
    LAS bf16_t* Tm = (LAS bf16_t*)(lds + 36864);
    LAS bf16_t* wT = (LAS bf16_t*)(lds + 46080);
    LAS bf16_t* uT = (LAS bf16_t*)(lds + 55296);
    LAS bf16_t* kdT = (LAS bf16_t*)(lds + 64512);
    LAS float* tb_gc = (LAS float*)(lds + 73728);
    LAS float* tb_beta = tb_gc + 64;
    LAS float* ssq = tb_gc + 128;
    LAS float* cw = (LAS float*)(lds + 81920);
    { const float* cwg = a->in[I_GCW] + (size_t)l * 4 * 1536; for (int i = tid; i < 6144; i += 512) cw[i] = cwg[i]; }
    LAS float* gpl = cw + 6144;
    if (tid < 8) { gpl[tid] = -__expf(a->in[I_GAL][l * 8 + tid]); gpl[8 + tid] = a->in[I_GDT][l * 8 + tid]; }
    float* GL = (float*)(mxs + MXS_GD_GL);
    u32x4 rq[4], rk[4], rv[4], tp; float pga = 0.f, pgb = 0.f;
#define GA2_ISSUE(u_) do { const int c_ = (u_) & 63, hd_ = ((u_) >> 6) & 7, b_ = (u_) >> 9; const int tl_ = c_ * 64 + lane; const size_t tok_ = (size_t)b_ * SEQ_ + tl_; \
        load_rows4(proj, b_, tl_, PC_GDQ + hd_ * 64 + 8 * wave, rq); load_rows4(proj, b_, tl_, PC_GDK + hd_ * 64 + 8 * wave, rk); load_rows4(proj, b_, tl_, PC_GDV + hd_ * 64 + 8 * wave, rv); \
        pga = gsm[tok_ * 32 + 8 + hd_]; pgb = gsm[tok_ * 32 + 16 + hd_]; \
        tp = *(const u32x4*)((const bf16_t*)(mxb + MXB_GD_T) + (size_t)(u_) * 4096 + (tid >> 3) * 64 + (tid & 7) * 8); } while (0)
    if ((int)blockIdx.x < 4096) GA2_ISSUE((int)blockIdx.x);
    for (int uid = blockIdx.x; uid < 4096; uid += G) {
        const int hd = (uid >> 6) & 7;
        __syncthreads();
        { const float gg = gpl[hd] * softplus_f(pga + gpl[8 + hd]);
          const float gc = wave_incl_sum(gg, lane);
          if (wave == 0) { tb_gc[lane] = gc; tb_beta[lane] = 1.f / (1.f + __expf(-pgb)); if (lane == 63) GL[uid] = __expf(gc); } }
        float qo[8], ko[8], vo[8];
        conv_silu8_l(rq, cw + hd * 64 + 8 * wave, 1536, qo); conv_silu8_l(rk, cw + 512 + hd * 64 + 8 * wave, 1536, ko); conv_silu8_l(rv, cw + 1024 + hd * 64 + 8 * wave, 1536, vo);
        { float sq = 0.f, sk = 0.f;
#pragma unroll
          for (int j = 0; j < 8; ++j) { sq += qo[j] * qo[j]; sk += ko[j] * ko[j]; }
          ssq[wave * 64 + lane] = sq; ssq[512 + wave * 64 + lane] = sk; }
        *(LAS u32x4*)(Tm + (tid >> 3) * 72 + (tid & 7) * 8) = tp;
        if (uid + G < 4096) GA2_ISSUE(uid + G);
        __syncthreads();
        { float sq = 0.f, sk = 0.f;
#pragma unroll
          for (int w = 0; w < 8; ++w) { sq += ssq[w * 64 + lane]; sk += ssq[512 + w * 64 + lane]; }
          const float rq = rsqrtf(sq + RMS_EPS) * 0.125f, rk = rsqrtf(sk + RMS_EPS);
          const float gc = tb_gc[lane], beta = tb_beta[lane], gl_ = tb_gc[63];
          const float e1 = beta * __expf(gc), e2 = __expf(gl_ - gc);
#pragma unroll
          for (int j = 0; j < 8; ++j) { qo[j] *= rq; ko[j] *= rk; }
          *(LAS bf16x8*)(qb + lane * 72 + 8 * wave) = pack8(qo[0], qo[1], qo[2], qo[3], qo[4], qo[5], qo[6], qo[7]);
          *(LAS bf16x8*)(kb + lane * 72 + 8 * wave) = pack8(ko[0], ko[1], ko[2], ko[3], ko[4], ko[5], ko[6], ko[7]);
#pragma unroll
          for (int j = 0; j < 8; ++j) { const int d = 8 * wave + j;
              bvT[d * 72 + lane] = (bf16_t)f2bf(beta * vo[j]); bkT[d * 72 + lane] = (bf16_t)f2bf(e1 * ko[j]); kdT[d * 72 + lane] = (bf16_t)f2bf(e2 * ko[j]); } }
        __syncthreads();
        { const int mat = wave >> 2, I = (wave >> 1) & 1, J = wave & 1; const LAS bf16_t* Am = mat ? bkT : bvT; LAS bf16_t* Om = mat ? wT : uT;
          f32x16 acc;
#pragma unroll
          for (int i = 0; i < 16; ++i) acc[i] = 0.f;
#pragma unroll
          for (int ks = 0; ks < 4; ++ks) { const bf16x8 af = *(const LAS bf16x8*)(Am + (32 * I + r) * 72 + 16 * ks + 8 * hh), bf = *(const LAS bf16x8*)(Tm + (32 * J + r) * 72 + 16 * ks + 8 * hh);
              acc = __builtin_amdgcn_mfma_f32_32x32x16_bf16(af, bf, acc, 0, 0, 0); }
#pragma unroll
          for (int q = 0; q < 4; ++q)
#pragma unroll
              for (int i = 0; i < 4; ++i) Om[(32 * I + 8 * q + 4 * hh + i) * 72 + 32 * J + r] = (bf16_t)f2bf(acc[4 * q + i]); }
        __syncthreads();
        if (wave < 4) {
            const int I = (wave >> 1) & 1, J = wave & 1;
            f32x16 ax, an;
#pragma unroll
            for (int i = 0; i < 16; ++i) { ax[i] = 0.f; an[i] = 0.f; }
#pragma unroll
            for (int ks = 0; ks < 4; ++ks) { const bf16x8 wf = *(const LAS bf16x8*)(wT + (32 * I + r) * 72 + 16 * ks + 8 * hh), kdf_b = *(const LAS bf16x8*)(kdT + (32 * J + r) * 72 + 16 * ks + 8 * hh);
                ax = __builtin_amdgcn_mfma_f32_32x32x16_bf16(wf, kdf_b, ax, 0, 0, 0);
                const bf16x8 kdf_a = *(const LAS bf16x8*)(kdT + (32 * I + r) * 72 + 16 * ks + 8 * hh), uf = *(const LAS bf16x8*)(uT + (32 * J + r) * 72 + 16 * ks + 8 * hh);
                an = __builtin_amdgcn_mfma_f32_32x32x16_bf16(kdf_a, uf, an, 0, 0, 0); }
            bf16_t* xd = (bf16_t*)(mxt + MXT_GD_XD) + (size_t)uid * 4096 + (size_t)(I * 2 + J) * 1024;
#pragma unroll
            for (int s2 = 0; s2 < 2; ++s2) *(bf16x8*)(xd + (s2 * 64 + lane) * 8) = pack8(-ax[8 * s2], -ax[8 * s2 + 1], -ax[8 * s2 + 2], -ax[8 * s2 + 3], -ax[8 * s2 + 4], -ax[8 * s2 + 5], -ax[8 * s2 + 6], -ax[8 * s2 + 7]);
            float* nd = (float*)(mxb + MXB_GD_ND) + (size_t)uid * 4096 + (size_t)(I * 2 + J) * 1024;
#pragma unroll
            for (int q = 0; q < 4; ++q) *(f32x4*)(nd + (q * 64 + lane) * 4) = (f32x4){an[4 * q], an[4 * q + 1], an[4 * q + 2], an[4 * q + 3]};
        } else {
            const int I = (wave >> 1) & 1, tJ = wave & 1; const int t = 32 * tJ + r; const float gct = tb_gc[t];
            bf16x8 pf[2][2];
#pragma unroll
            for (int sI = 0; sI < 2; ++sI) { f32x16 ap;
#pragma unroll
                for (int i = 0; i < 16; ++i) ap[i] = 0.f;
#pragma unroll
                for (int ks = 0; ks < 4; ++ks) { const bf16x8 af = *(const LAS bf16x8*)(kb + (32 * sI + r) * 72 + 16 * ks + 8 * hh), bf = *(const LAS bf16x8*)(qb + t * 72 + 16 * ks + 8 * hh);
                    ap = __builtin_amdgcn_mfma_f32_32x32x16_bf16(af, bf, ap, 0, 0, 0); }
#pragma unroll
                for (int q = 0; q < 4; ++q) { const int s0 = 32 * sI + 8 * q + 4 * hh; const f32x4 gcs = *(const LAS f32x4*)(tb_gc + s0);
#pragma unroll
                    for (int i = 0; i < 4; ++i) ap[4 * q + i] = (s0 + i <= t) ? ap[4 * q + i] * __expf(gct - gcs[i]) : 0.f; }
#pragma unroll
                for (int s2 = 0; s2 < 2; ++s2) pf[sI][s2] = pack8(ap[8 * s2], ap[8 * s2 + 1], ap[8 * s2 + 2], ap[8 * s2 + 3], ap[8 * s2 + 4], ap[8 * s2 + 5], ap[8 * s2 + 6], ap[8 * s2 + 7]); }
            f32x16 aq, ao;
#pragma unroll
            for (int i = 0; i < 16; ++i) { aq[i] = 0.f; ao[i] = 0.f; }
#pragma unroll
            for (int sI = 0; sI < 2; ++sI)
#pragma unroll
                for (int s2 = 0; s2 < 2; ++s2) { const bf16x8 wf = ld_perm(wT + (32 * I + r) * 72 + 32 * sI + 16 * s2 + 4 * hh), uf = ld_perm(uT + (32 * I + r) * 72 + 32 * sI + 16 * s2 + 4 * hh);
                    aq = __builtin_amdgcn_mfma_f32_32x32x16_bf16(wf, pf[sI][s2], aq, 0, 0, 0); ao = __builtin_amdgcn_mfma_f32_32x32x16_bf16(uf, pf[sI][s2], ao, 0, 0, 0); }
            const float egt = __expf(gct);
#pragma unroll
            for (int q = 0; q < 4; ++q) { const int d0 = 32 * I + 8 * q + 4 * hh; const u32x2 qw = *(const LAS u32x2*)(qb + t * 72 + d0);
                aq[4 * q] = bflo(qw.x) * egt - aq[4 * q]; aq[4 * q + 1] = bfhi(qw.x) * egt - aq[4 * q + 1]; aq[4 * q + 2] = bflo(qw.y) * egt - aq[4 * q + 2]; aq[4 * q + 3] = bfhi(qw.y) * egt - aq[4 * q + 3]; }
            bf16_t* qd = (bf16_t*)(mxt + MXT_GD_QD) + (size_t)uid * 4096 + (size_t)(I * 2 + tJ) * 1024;
#pragma unroll
            for (int s2 = 0; s2 < 2; ++s2) *(bf16x8*)(qd + (s2 * 64 + lane) * 8) = pack8(aq[8 * s2], aq[8 * s2 + 1], aq[8 * s2 + 2], aq[8 * s2 + 3], aq[8 * s2 + 4], aq[8 * s2 + 5], aq[8 * s2 + 6], aq[8 * s2 + 7]);
            float* od = (float*)(mxb + MXB_GD_OD) + (size_t)uid * 4096 + (size_t)(I * 2 + tJ) * 1024;
#pragma unroll
            for (int q = 0; q < 4; ++q) *(f32x4*)(od + (q * 64 + lane) * 4) = (f32x4){ao[4 * q], ao[4 * q + 1], ao[4 * q + 2], ao[4 * q + 3]};
        }
    }
}

__device__ __forceinline__ void gdn_passB(unsigned char* mxb, unsigned char* mxt, unsigned char* mxs, int nB) {
    int tid_ = threadIdx.x; asm volatile("" : "+v"(tid_)); const int tid = tid_, lane = tid & 63, wave = __builtin_amdgcn_readfirstlane(tid >> 6);
    const float* GL = (const float*)(mxs + MXS_GD_GL);
    if (wave >= 2) { lru_carry(mxs, ((int)blockIdx.x * 6 + (wave - 2)) * 64 + lane, nB * 6 * 64); return; }
    const int eJ = wave;
    for (int chain = blockIdx.x; chain < 64; chain += nB) {
        f32x16 S[2];
#pragma unroll
        for (int i = 0; i < 16; ++i) { S[0][i] = 0.f; S[1][i] = 0.f; }
        bf16x8 xn[2][2][2]; f32x4 nq[2][4]; float gln;
#define GDB_LOAD(c_) do { const size_t u_ = (size_t)chain * 64 + (c_); const bf16_t* xd_ = (const bf16_t*)(mxt + MXT_GD_XD) + u_ * 4096; const float* nd_ = (const float*)(mxb + MXB_GD_ND) + u_ * 4096; \
        _Pragma("unroll") for (int I = 0; I < 2; ++I) _Pragma("unroll") for (int J = 0; J < 2; ++J) _Pragma("unroll") for (int s2 = 0; s2 < 2; ++s2) xn[I][J][s2] = *(const bf16x8*)(xd_ + (size_t)(I * 2 + J) * 1024 + (s2 * 64 + lane) * 8); \
        _Pragma("unroll") for (int J = 0; J < 2; ++J) _Pragma("unroll") for (int q = 0; q < 4; ++q) nq[J][q] = *(const f32x4*)(nd_ + (size_t)(J * 2 + eJ) * 1024 + (q * 64 + lane) * 4); \
        gln = GL[u_]; } while (0)
        GDB_LOAD(0);
        for (int c = 0; c < 64; ++c) { const size_t uid = (size_t)chain * 64 + c;
            bf16x8 xf[2][2][2]; f32x16 nn[2]; const float gl = gln;
#pragma unroll
            for (int I = 0; I < 2; ++I)
#pragma unroll
                for (int J = 0; J < 2; ++J)
#pragma unroll
                    for (int s2 = 0; s2 < 2; ++s2) xf[I][J][s2] = xn[I][J][s2];
#pragma unroll
            for (int J = 0; J < 2; ++J)
#pragma unroll
                for (int q = 0; q < 4; ++q) { nn[J][4 * q] = nq[J][q][0]; nn[J][4 * q + 1] = nq[J][q][1]; nn[J][4 * q + 2] = nq[J][q][2]; nn[J][4 * q + 3] = nq[J][q][3]; }
            if (c + 1 < 64) GDB_LOAD(c + 1);
            bf16x8 sh[2][2];
            bf16_t* sd = (bf16_t*)(mxt + MXT_GD_SD) + uid * 4096;
#pragma unroll
            for (int I = 0; I < 2; ++I)
#pragma unroll
                for (int s2 = 0; s2 < 2; ++s2) { sh[I][s2] = pack8(S[I][8 * s2], S[I][8 * s2 + 1], S[I][8 * s2 + 2], S[I][8 * s2 + 3], S[I][8 * s2 + 4], S[I][8 * s2 + 5], S[I][8 * s2 + 6], S[I][8 * s2 + 7]);
                    *(bf16x8*)(sd + (size_t)(I * 2 + eJ) * 1024 + (s2 * 64 + lane) * 8) = sh[I][s2]; }
#pragma unroll
            for (int J = 0; J < 2; ++J) { f32x16 acc = nn[J];
#pragma unroll
                for (int I = 0; I < 2; ++I)
#pragma unroll
                    for (int s2 = 0; s2 < 2; ++s2) acc = __builtin_amdgcn_mfma_f32_32x32x16_bf16(xf[I][J][s2], sh[I][s2], acc, 0, 0, 0);
                nn[J] = acc; }
#pragma unroll
            for (int J = 0; J < 2; ++J)
#pragma unroll
                for (int i = 0; i < 16; ++i) S[J][i] = gl * S[J][i] + nn[J][i];
        }
    }
}

__device__ __forceinline__ void gdn_passC(ArgsP a, int l, LAS unsigned char* lds, const bf16_t* proj, bf16_t* H, unsigned char* mxb, unsigned char* mxt, int G) {
    int tid_ = threadIdx.x; asm volatile("" : "+v"(tid_)); const int tid = tid_, lane = tid & 63, wave = __builtin_amdgcn_readfirstlane(tid >> 6), r = lane & 31, hh = lane >> 5;
    LAS bf16_t* ob = (LAS bf16_t*)(lds + wave * 8192);
    f32x4 gnr[2][4];
#pragma unroll
    for (int eI = 0; eI < 2; ++eI)
#pragma unroll
        for (int q = 0; q < 4; ++q) gnr[eI][q] = *(const f32x4*)(a->in[I_GNG] + l * 64 + 32 * eI + 8 * q + 4 * hh);
    for (int wu = blockIdx.x * NWAVES + wave; wu < 8192; wu += G * NWAVES) {
        const int uid = wu >> 1, tJ = wu & 1; const int c = uid & 63, hd = (uid >> 6) & 7, b = uid >> 9; const size_t tok0 = (size_t)b * SEQ_ + (size_t)c * 64;
        const bf16_t* sd = (const bf16_t*)(mxt + MXT_GD_SD) + (size_t)uid * 4096; const bf16_t* qd = (const bf16_t*)(mxt + MXT_GD_QD) + (size_t)uid * 4096; const float* od = (const float*)(mxb + MXB_GD_OD) + (size_t)uid * 4096;
        f32x16 ao[2];
#pragma unroll
        for (int eI = 0; eI < 2; ++eI)
#pragma unroll
            for (int q = 0; q < 4; ++q) { const f32x4 v = *(const f32x4*)(od + (size_t)(eI * 2 + tJ) * 1024 + (q * 64 + lane) * 4); ao[eI][4 * q] = v[0]; ao[eI][4 * q + 1] = v[1]; ao[eI][4 * q + 2] = v[2]; ao[eI][4 * q + 3] = v[3]; }
#pragma unroll
        for (int dI = 0; dI < 2; ++dI)
#pragma unroll
            for (int s2 = 0; s2 < 2; ++s2) { const bf16x8 qf = *(const bf16x8*)(qd + (size_t)(dI * 2 + tJ) * 1024 + (s2 * 64 + lane) * 8);
#pragma unroll
                for (int eI = 0; eI < 2; ++eI) { const bf16x8 sf = *(const bf16x8*)(sd + (size_t)(dI * 2 + eI) * 1024 + (s2 * 64 + lane) * 8);
                    ao[eI] = __builtin_amdgcn_mfma_f32_32x32x16_bf16(sf, qf, ao[eI], 0, 0, 0); } }
        float sq = 0.f;
#pragma unroll
        for (int eI = 0; eI < 2; ++eI)
#pragma unroll
            for (int i = 0; i < 16; ++i) sq += ao[eI][i] * ao[eI][i];
        sq += __shfl_xor(sq, 32);
        const float rinv = rsqrtf(sq * (1.0f / 64.0f) + RMS_EPS);
        const size_t tok = tok0 + 32 * tJ + r;
#pragma unroll
        for (int eI = 0; eI < 2; ++eI)
#pragma unroll
            for (int q = 0; q < 4; ++q) { const int e0 = 32 * eI + 8 * q + 4 * hh; const f32x4 g4 = gnr[eI][q]; const u32x2 zw = *(const u32x2*)(proj + tok * NPROJ + PC_GDZ + hd * 64 + e0);
                u32x2 pw; pw.x = pg8::cvt_pk_bf16(ao[eI][4 * q] * rinv * g4[0] * silu_f(bflo(zw.x)), ao[eI][4 * q + 1] * rinv * g4[1] * silu_f(bfhi(zw.x)));
                pw.y = pg8::cvt_pk_bf16(ao[eI][4 * q + 2] * rinv * g4[2] * silu_f(bflo(zw.y)), ao[eI][4 * q + 3] * rinv * g4[3] * silu_f(bfhi(zw.y)));
                *(LAS u32x2*)(ob + r * 64 + e0) = pw; }
        LDS_WAIT(); asm volatile("" ::: "memory");
#pragma unroll
        for (int it = 0; it < 4; ++it) { const int row = it * 8 + (lane >> 3), c8 = (lane & 7) * 8;
            *(u32x4*)(H + (tok0 + 32 * tJ + row) * 2048 + 1536 + hd * 64 + c8) = *(const LAS u32x4*)(ob + row * 64 + c8); }
        LDS_WAIT(); asm volatile("" ::: "memory");
    }
}
constexpr int PPL = 12;
constexpr int NPH = 1 + PPL * DEPTH_;
#ifndef MK_N_LAUNCHES
#define MK_N_LAUNCHES 1
#endif
#ifndef PROBE_PH
#define PROBE_PH -2
#endif
#define REPS(k) ((PROBE_PH) == (k) ? 2 : 1)
#ifndef PG8_SP2
#define PG8_SP2 true
#endif
#ifndef PG8_ALIGN
#define PG8_ALIGN true
#endif
__global__ void __launch_bounds__(NWAVES * 64, 2) fwd(Args a_unused) {
    ArgsP kargs = (ArgsP)__builtin_amdgcn_kernarg_segment_ptr();
#define FRESH(a) ArgsP a = kargs; asm volatile("" : "+s"(a))
    extern __shared__ __attribute__((aligned(16))) unsigned char lds_raw[];
    LAS unsigned char* lds = (LAS unsigned char*)lds_raw;
    const int tid = threadIdx.x, G = gridDim.x;
    const int vcu = (G % 8 == 0) ? ((int)blockIdx.x % 8) * (G / 8) + (int)blockIdx.x / 8 : (int)blockIdx.x;
    for (int u = tid; u < (LDS_BYTES - MISC_OFF) / 4; u += NWAVES * 64) ((LAS unsigned*)(lds + MISC_OFF))[u] = 0u;
    __syncthreads();
    const int lo = kargs->ph_lo, hi = kargs->ph_hi;
    unsigned* barw = (unsigned*)(kargs->ws + WS_CTL) + CW_BAR + kargs->li * XCD_BAR_WORDS;
    if (hi - lo > 1) (void)xcd_barrier_post(barw, (volatile LAS unsigned*)(lds + LDS_BYTES - 16));
#define IN(k) (lo <= (k) && (k) < hi)
#define SEAM(k) do { if (IN(k) && IN((k) + 1)) { FRESH(ab_); XcdBarrier bb_; bb_.bar = (unsigned*)(ab_->ws + WS_CTL) + CW_BAR + ab_->li * XCD_BAR_WORDS; bb_.x = xb_xcc_id(); bb_.st = (volatile LAS unsigned*)(lds + LDS_BYTES - 16); xcd_barrier(bb_); } } while (0)
    if (IN(0)) for (int rep = 0; rep < REPS(-1); ++rep) { FRESH(a); p0_convert(a, lds, G); }
    SEAM(0);

    for (int l = 0; l < DEPTH_; ++l) {
        const int pb = 1 + PPL * l;
#define WSP(T_, off) ((T_*)(a->ws + (off)))
#define WL_(off) (a->ws + WS_W + (size_t)l * WL_STRIDE + (off))
        if (IN(pb + 0)) for (int rep = 0; rep < REPS(0); ++rep) { FRESH(a);
            { pg8::Gemm g{WSP(const bf16_t, WS_XB), (const bf16_t*)WL_(WL_IN), 1024, 1024, 1024}; pg8::StaticOrder S; S.init(T_, NIN_BF, G, (int)blockIdx.x);
              pg8::EpiProj E{WSP(bf16_t, WS_OV + OV_PROJ), WSP(float, WS_GSM)};
              pg8::gemm_phase<pg8::EpiProj, pg8::StaticOrder, PG8_ALIGN, PG8_SP2>(lds, g, S, E); }
            { pg8::Gemm8 g{WSP(const unsigned char, WS_X2), (const unsigned char*)WL_(WL_IN + WL_IN8), 1024, 1024, 1024}; pg8::P1F8Order S{G, (int)blockIdx.x};
              pg8::EpiProj8 E{WSP(bf16_t, WS_OV + OV_PROJ), WSP(bf16_t, WS_OV + OV_GD)};
              pg8::gemm_phase_f8<pg8::EpiProj8, pg8::P1F8Order, false>(lds, g, S, E); }
        }
        SEAM(pb + 0);

        if (IN(pb + 1)) for (int rep = 0; rep < REPS(1); ++rep) { FRESH(a);
            const bf16_t* proj = WSP(const bf16_t, WS_OV + OV_PROJ); bf16_t* Hb = WSP(bf16_t, WS_OV + OV_H); const float* gsm = WSP(const float, WS_GSM);
            for (int r2 = 0; r2 < REPS(11); ++r2) for (int u = (int)blockIdx.x; u < 256; u += G) lru_fast<0>(a, l, u >> 5, (u >> 2) & 7, (u & 3) * 16, (u & 3) * 16 + 16, lds, proj, Hb, a->ws + WS_MXS);
            for (int r2 = 0; r2 < REPS(12); ++r2) mlstm_passA(a, l, lds, proj, gsm, a->ws + WS_V, a->ws + WS_MXS, G);
            __syncthreads();
            for (int r2 = 0; r2 < REPS(13); ++r2) gdn_passA1(a, l, lds, proj, gsm, a->ws + WS_V, G);
        }
        SEAM(pb + 1);
        if (IN(pb + 2)) for (int rep = 0; rep < REPS(2); ++rep) { FRESH(a);
            const bf16_t* proj = WSP(const bf16_t, WS_OV + OV_PROJ); const float* gsm = WSP(const float, WS_GSM);
            for (int r2 = 0; r2 < REPS(22); ++r2) mlstm_passB(a->ws + WS_V, a->ws + WS_MXS, G); for (int r2 = 0; r2 < REPS(23); ++r2) gdn_passA2(a, l, lds, proj, gsm, a->ws + WS_V, a->ws + WS_MXS, a->ws + WS_MXS, G); }
        SEAM(pb + 2);
        if (IN(pb + 3)) for (int rep = 0; rep < REPS(3); ++rep) { FRESH(a);
            const bf16_t* proj = WSP(const bf16_t, WS_OV + OV_PROJ); bf16_t* Hb = WSP(bf16_t, WS_OV + OV_H); const float* gsm = WSP(const float, WS_GSM);
            const int nB = G >= 128 ? 64 : 0;
            if ((int)blockIdx.x < nB) { for (int r2 = 0; r2 < REPS(31); ++r2) gdn_passB(a->ws + WS_V, a->ws + WS_MXS, a->ws + WS_MXS, nB); }
            else {
                if (nB == 0) { gdn_passB(a->ws + WS_V, a->ws + WS_MXS, a->ws + WS_MXS, G); __syncthreads(); }
                for (int r2 = 0; r2 < REPS(33); ++r2) mlstm_passC(a, l, lds, proj, gsm, Hb, a->ws + WS_V, a->ws + WS_MXS, (int)blockIdx.x - nB, G - nB);
            }
        }
        SEAM(pb + 3);
        if (IN(pb + 4)) for (int rep = 0; rep < REPS(4); ++rep) { FRESH(a); gdn_passC(a, l, lds, WSP(const bf16_t, WS_OV + OV_PROJ), WSP(bf16_t, WS_OV + OV_H), a->ws + WS_V, a->ws + WS_MXS, G);
            for (int r2 = 0; r2 < REPS(32); ++r2) lru_apply(a, WSP(const bf16_t, WS_OV + OV_PROJ), WSP(bf16_t, WS_OV + OV_H), a->ws + WS_MXS, (int)blockIdx.x, G); }
        SEAM(pb + 4);

        if (IN(pb + 5)) for (int rep = 0; rep < REPS(5); ++rep) { FRESH(a);
            pg8::StaticOrder S; S.init(T_, 1024, G, (int)blockIdx.x);
            pg8::Gemm g{WSP(const bf16_t, WS_OV + OV_H), (const bf16_t*)WL_(WL_BR), 2048, 2048, 2048}; pg8::EpiMergeF E{WSP(const bf16_t, WS_OV + OV_GD), WSP(bf16_t, WS_MB)};
            pg8::gemm_phase<pg8::EpiMergeF, pg8::StaticOrder, PG8_ALIGN, PG8_SP2>(lds, g, S, E);
        }
        SEAM(pb + 5);

        if (IN(pb + 6)) for (int rep = 0; rep < REPS(6); ++rep) { FRESH(a);
            pg8::Gemm g{WSP(const bf16_t, WS_MB), (const bf16_t*)WL_(WL_OUT), 1024, 1024, 1024}; pg8::StaticOrder S; S.init(T_, 1024, G, (int)blockIdx.x);
            pg8::EpiWout E{l == 0 ? a->in[I_X] : (const float*)nullptr, WSP(const bf16_t, WS_XB), WSP(bf16_t, WS_V)};
            pg8::gemm_phase<pg8::EpiWout, pg8::StaticOrder, PG8_ALIGN, PG8_SP2>(lds, g, S, E);
        }
        SEAM(pb + 6);

        if (IN(pb + 7)) for (int rep = 0; rep < REPS(7); ++rep) { FRESH(a); p5_ln1_router(a, l, lds, G); }
        SEAM(pb + 7);

        if (IN(pb + 8)) for (int rep = 0; rep < REPS(8); ++rep) { FRESH(a); p6_slots(a, lds, G); }
        SEAM(pb + 8);

        if (IN(pb + 9)) for (int rep = 0; rep < REPS(9); ++rep) { FRESH(a);
            const int nb = moe_table(a, lds);
            pg8::MoeOrder S{8, G, vcu, nb * 8, (const LAS int*)(lds + MISC_OFF + 256)};
            { LAS int* gt = (LAS int*)(lds + GTAB_OFF); const int* tokb = WSP(const int, WS_TOKB);
              int tq_ = threadIdx.x; asm volatile("" : "+v"(tq_));
              for (int ui = 0; (long)ui * G + vcu < (long)nb * 8; ++ui) { const int pm = (int)(((long)ui * G + vcu) / 8); if (tq_ < 256) gt[ui * 256 + tq_] = tokb[(size_t)pm * 256 + tq_]; }
              __syncthreads(); }
            pg8::Gemm8 g{WSP(const unsigned char, WS_X1), (const unsigned char*)WL_(WL_W1), 1024, 1024, 1024};
            pg8::EpiMoe1F8 E{WSP(unsigned char, WS_OV + OV_ACT), a->in[I_B1] + (size_t)l * NE * 2048};
            pg8::gemm_phase_f8<pg8::EpiMoe1F8, pg8::MoeOrder, true>(lds, g, S, E, (const LAS int*)(lds + GTAB_OFF));
        }
        SEAM(pb + 9);

        if (IN(pb + 10)) for (int rep = 0; rep < REPS(10); ++rep) { FRESH(a);
            const int nb = moe_table(a, lds);
            pg8::MoeOrder S{4, G, vcu, nb * 4, (const LAS int*)(lds + MISC_OFF + 256)};
            pg8::Gemm8 g{WSP(const unsigned char, WS_OV + OV_ACT), (const unsigned char*)WL_(WL_W2), 1024, 1024, 1024};
            pg8::EpiMoe2F8 E{WSP(bf16_t, WS_OV + OV_YS), a->in[I_B2] + (size_t)l * NE * 1024, WSP(const float, WS_WBUF)};
            pg8::gemm_phase_f8<pg8::EpiMoe2F8, pg8::MoeOrder, false>(lds, g, S, E);
        }
        SEAM(pb + 10);

        if (IN(pb + 11)) for (int rep = 0; rep < REPS(11); ++rep) { FRESH(a); p9_combine_ln2(a, l, (l == DEPTH_ - 1) ? a->out : (float*)nullptr, G); }
        SEAM(pb + 11);
    }
#undef WSP
#undef WL_
#undef IN
#undef SEAM
}

extern "C" void kernel_launch(void* const* d_in, const int* in_sizes, int n_in, void* d_out, int out_size, void* d_ws, size_t ws_size, hipStream_t stream) {
    static int grid = 0;
    if (grid == 0) {
        if (n_in != 30 || in_sizes[0] != T_ * D_ || out_size != T_ * D_ || ws_size < WS_END) {
            fprintf(stderr, "kernel_launch: unexpected shapes: n_in %d in0 %d out %d ws %zu (need %zu); nothing launched\n", n_in, n_in > 0 ? in_sizes[0] : -1, out_size, ws_size, (size_t)WS_END); grid = -1; return; }
        int dev = 0, cus = 0;
        if (hipGetDevice(&dev) != hipSuccess || hipDeviceGetAttribute(&cus, hipDeviceAttributeMultiprocessorCount, dev) != hipSuccess) { grid = -1; return; }
        if (hipFuncSetAttribute((const void*)fwd, hipFuncAttributeMaxDynamicSharedMemorySize, LDS_BYTES) != hipSuccess) { fprintf(stderr, "kernel_launch: hipFuncSetAttribute failed\n"); grid = -1; return; }
        int per_cu = 0; (void)hipOccupancyMaxActiveBlocksPerMultiprocessor(&per_cu, (const void*)fwd, NWAVES * 64, LDS_BYTES); (void)hipGetLastError();
        if (per_cu < 1) fprintf(stderr, "kernel_launch: occupancy query reports %d blocks per CU\n", per_cu);
        grid = cus;
    }
    if (grid < 0) return;
    (void)hipMemsetAsync((char*)d_ws + WS_CTL, 0, CTL_ZERO_BYTES, stream);
    Args a{};
    for (int i = 0; i < 30; ++i) a.in[i] = (const float*)d_in[i];
    a.out = (float*)d_out; a.ws = (unsigned char*)d_ws;
    constexpr int NL = MK_N_LAUNCHES; static_assert(NL == NPH || NL <= 4, "barrier regions");
    for (int li = 0; li < NL; ++li) {
        a.ph_lo = (int)((long)NPH * li / NL); a.ph_hi = (int)((long)NPH * (li + 1) / NL); a.li = (NL <= 4) ? li : 0;
        hipLaunchKernelGGL(fwd, dim3(grid), dim3(NWAVES * 64), LDS_BYTES, stream, a);
        const hipError_t le = hipPeekAtLastError();
        if (le != hipSuccess) { fprintf(stderr, "kernel_launch: launch %d failed: %s\n", li, hipGetErrorName(le)); break; }
    }
}
```

```cpp
#include <hip/hip_runtime.h>
#include <cstdio>
#include <cstdint>

#define LAS __attribute__((address_space(3)))
#define GAS __attribute__((address_space(1)))
typedef unsigned short bf16_t;
typedef short bf16x8 __attribute__((ext_vector_type(8)));
typedef float f32x4 __attribute__((ext_vector_type(4)));
typedef float f32x2 __attribute__((ext_vector_type(2)));
typedef unsigned u32x4 __attribute__((ext_vector_type(4)));
typedef unsigned u32x2 __attribute__((ext_vector_type(2)));

constexpr int T_ = 32768, D_ = 1024, SEQ_ = 4096, NBATCH = 8, DEPTH_ = 2;
constexpr int DIN = 8728, NPROJ = 5632, NINP = 8960;
constexpr int NE = 32, DFF = 1024;
constexpr int PMAX = 139264;
constexpr int NCHUNK = 256, CHTOK = 128;
constexpr float DN_ALPHA = 1.41421356237309515f;
constexpr float LN_EPS = 1e-5f, RMS_EPS = 1e-6f;
constexpr float F8_SX = 16.0f, F8_SW1 = 128.0f, F8_SA = 8.0f, F8_SW2 = 256.0f, F8_SWI = 128.0f, F8_SY = 64.0f;
constexpr int PC_LRUX = 0, PC_MLQ = 1024, PC_MLK = 1280, PC_MLV = 1536, PC_GDQ = 2048, PC_GDK = 2560, PC_GDV = 3072, PC_LRUY = 3584, PC_MLO = 4608, PC_GDZ = 5120;
constexpr int NIN_BF = 3840, NIN_F8 = 5120;
constexpr size_t WL_IN8 = 8u << 20;

constexpr size_t MiB = 1u << 20;
constexpr size_t WS_CTL = 0, CTL_ZERO_BYTES = 64 * 1024;
constexpr size_t WS_HIST = 256 * 1024;
constexpr size_t WS_META = 320 * 1024;
constexpr size_t WS_RWB = 384 * 1024;
constexpr size_t WS_W = 1 * MiB;
constexpr size_t WL_IN = 0, WL_BR = 18 * MiB, WL_OUT = 22 * MiB, WL_W1 = 24 * MiB, WL_W2 = 152 * MiB, WL_G = 216 * MiB, WL_STRIDE = 217 * MiB;
constexpr size_t WS_XB = 436 * MiB;
constexpr size_t WS_GSM = 501 * MiB;
constexpr size_t WS_MB = 505 * MiB;
constexpr size_t WS_V = 569 * MiB;
constexpr size_t WS_X1 = 697 * MiB;
constexpr size_t WS_X1B = 825 * MiB;
constexpr size_t WS_X2 = 890 * MiB;
constexpr size_t WS_TKE = 1018 * MiB;
constexpr size_t WS_TKW = WS_TKE + 512 * 1024;
constexpr size_t WS_SLOT = 1019 * MiB;
constexpr size_t WS_WBUF = 1020 * MiB;
constexpr size_t WS_TOKB = 1021 * MiB;
constexpr size_t WS_OV = 1024 * MiB;
constexpr size_t OV_PROJ = 0, OV_GD = 352 * MiB, OV_H = 544 * MiB;
constexpr size_t OV_XS = 0, OV_ACT = 272 * MiB, OV_YS = 544 * MiB;
constexpr size_t WS_MXS = WS_OV + 816 * MiB;
constexpr size_t WS_END = WS_MXS + 104 * MiB;

constexpr int CW_BAR = 1024;

constexpr int RING_BYTES = 131072;
constexpr int MISC_OFF = RING_BYTES;
constexpr int GTAB_OFF = MISC_OFF + 4096;
constexpr int LDS_BYTES = 163840;
constexpr int NWAVES = 8;

#define LDS_WAIT() asm volatile("s_waitcnt lgkmcnt(0)" ::: "memory")
#define VM_WAIT() asm volatile("s_waitcnt vmcnt(0)" ::: "memory")

__device__ __forceinline__ unsigned f2bf(float f) { unsigned u = __builtin_bit_cast(unsigned, f); return (u + 0x7fffu + ((u >> 16) & 1u)) >> 16; }
__device__ __forceinline__ unsigned pk2(float lo, float hi) { return f2bf(lo) | (f2bf(hi) << 16); }
__device__ __forceinline__ float bf2f(unsigned short b) { return __builtin_bit_cast(float, (unsigned)b << 16); }
__device__ __forceinline__ float bflo(unsigned w) { return __builtin_bit_cast(float, w << 16); }
__device__ __forceinline__ float bfhi(unsigned w) { return __builtin_bit_cast(float, w & 0xffff0000u); }
__device__ __forceinline__ unsigned pk_fp8x4(float a, float b, float c, float d) { int p = __builtin_amdgcn_cvt_pk_fp8_f32(a, b, 0, false); p = __builtin_amdgcn_cvt_pk_fp8_f32(c, d, p, true); return (unsigned)p; }
__device__ __forceinline__ float wave_sum(float v) {
#pragma unroll
    for (int o = 1; o < 64; o <<= 1) v += __shfl_xor(v, o);
    return v;
}
__device__ __forceinline__ float wave_max(float v) {
#pragma unroll
    for (int o = 1; o < 64; o <<= 1) v = fmaxf(v, __shfl_xor(v, o));
    return v;
}
__device__ __forceinline__ float sigmoid_f(float x) { return __builtin_amdgcn_rcpf(1.f + __expf(-x)); }
__device__ __forceinline__ float silu_f(float x) { return x * __builtin_amdgcn_rcpf(1.f + __expf(-x)); }
__device__ __forceinline__ float neg_expm1_f(float t) {
    const float p = -t * (1.f + t * 0.5f * (1.f + t * (1.f / 3.f) * (1.f + t * 0.25f * (1.f + t * 0.2f * (1.f + t * (1.f / 6.f) * (1.f + t * (1.f / 7.f)))))));
    return t > -0.3f ? p : 1.f - __expf(t);
}
__device__ __forceinline__ float log1p_f(float e) { return e < 0.01f ? e * (1.f - e * (0.5f - e * ((1.f / 3.f) - 0.25f * e))) : __logf(1.f + e); }
__device__ __forceinline__ float softplus_f(float x) { return fmaxf(x, 0.f) + log1p_f(__expf(-fabsf(x))); }
__device__ __forceinline__ float gelu_tanh_f(float x) { const float u = 0.7978845608028654f * (x + 0.044715f * x * x * x); return x * __builtin_amdgcn_rcpf(1.f + __expf(-2.f * u)); }
namespace pg8 {
#define PG8_LAS __attribute__((address_space(3)))
constexpr int BM = 256, BK = 64, HALF = 128, HTB = HALF * BK * 2  , STAGE_BYTES = 8 * HTB, NXCD = 8, WGM = 8;

__host__ __device__ __forceinline__ int lds_byte(int r, int c) { const int st = (r >> 4) * 2 + (c >> 5), rr = r & 15, cc = c & 31, ob = rr * 64 + cc * 2; return st * 1024 + (ob ^ (((ob >> 9) & 1) << 5)); }
__host__ __device__ __forceinline__ void stage_rc(int b, int& R, int& C) { const int st = b / 1024, sb = b % 1024, swz = sb ^ (((sb >> 9) & 1) << 5); R = (st >> 1) * 16 + swz / 64; C = (st & 1) * 32 + (swz % 64) / 2; }
__host__ __device__ __forceinline__ int perm32(int rho) { const int n = rho >> 4, i = rho & 15; return 8 * (i >> 2) + 4 * n + (i & 3); }

struct Unit { int pm, pn; };
struct Gemm { const bf16_t* A; const bf16_t* Bt; int lda, ldb, K; };

struct StaticOrder {
    int nM, nN, nwg, G, c;
    __host__ __device__ void init(int M, int N, int G_, int c_) { nM = M / BM; nN = N / BM; nwg = nM * nN; G = G_; c = c_; }
    __host__ __device__ bool next(int i, Unit& u) const {
        const long L = (long)i * G + c; if (L >= nwg) return false;
        int wgid = (int)L; { const int q = nwg / NXCD, r = nwg % NXCD, xcd = wgid % NXCD, off = wgid / NXCD; wgid = (xcd < r ? xcd * (q + 1) : r * (q + 1) + (xcd - r) * q) + off; }
        const int nig = WGM * nN, gid = wgid / nig, fm = gid * WGM, gsz = (nM - fm) < WGM ? (nM - fm) : WGM;
        u.pm = fm + ((wgid % nig) % gsz); u.pn = (wgid % nig) / gsz; return true;
    }
    __device__ __forceinline__ void a_ready(const Unit&) const {}
    __device__ __forceinline__ void done(const Unit&) const {}
};

__device__ __forceinline__ unsigned cvt_pk_bf16(float lo, float hi) { unsigned r; asm volatile("v_cvt_pk_bf16_f32 %0, %1, %2" : "=v"(r) : "v"(lo), "v"(hi)); return r; }

template <class Epi, class Sched, bool ALIGN_EPI = false, bool SP2 = false, bool GATHER = false>
__device__ __forceinline__ void gemm_phase(PG8_LAS unsigned char* lds, const Gemm g, const Sched& S, const Epi& E, const PG8_LAS int* gtab = nullptr) {
    int tid_ = threadIdx.x; asm volatile("" : "+v"(tid_));
    const int tid = tid_, wid = __builtin_amdgcn_readfirstlane(tid >> 6), lane = tid & 63, wr = wid >> 2, wc = wid & 3, fr = lane & 15, fq = lane >> 4;
    const int K = g.K, nt = K / BK;
    unsigned voffA[2], voffB[2];
#pragma unroll
    for (int i = 0; i < 2; ++i) { int R, C; stage_rc(tid * 16 + i * 8192, R, C); const int Rb = Epi::PERM ? ((R & ~31) + perm32(R & 31)) : R;
        voffA[i] = (unsigned)(R * g.lda + C) * 2u; voffB[i] = (unsigned)(Rb * g.ldb + C) * 2u; }
    const size_t kstep = (size_t)(BK * 2);
    const size_t hstepA = (size_t)HALF * g.lda * 2, hstepB = (size_t)HALF * g.ldb * 2;
    const size_t tstepA = 2 * hstepA, tstepB = 2 * hstepB;
    const unsigned ldsw = (unsigned)wid * 1024u;
    const int aoff = lds_byte(wr * 64 + fr, fq * 8), boff = lds_byte(wc * 32 + fr, fq * 8);
    int gR0 = 0, gC0 = 0; if constexpr (GATHER) { stage_rc(tid * 16, gR0, gC0); }
#define PG8_STAGE_A(bufoff, aptr, koff, slot, h) do { if constexpr (GATHER) { _Pragma("unroll") for (int _i = 0; _i < 2; ++_i) { const unsigned _o = ((slot) == ui) ? gvo[2 * (h) + _i] : nvo[2 * (h) + _i]; \
            __builtin_amdgcn_global_load_lds((const unsigned*)((const char*)g.A + _o + (koff)), (PG8_LAS unsigned*)(lds + (bufoff) + ldsw + _i * 8192), 16, 0, 0); } } \
        else { PG8_STAGE(bufoff, aptr, voffA); } } while (0)
#define PG8_GLOAD(dst, s_) do { _Pragma("unroll") for (int _j = 0; _j < 4; ++_j) dst[_j] = (unsigned)gtab[(s_) * 256 + gR0 + 64 * _j] * (unsigned)(g.lda * 2) + (unsigned)(gC0 * 2); } while (0)
#define PG8_SA(b, h) (((b) * 2 + (h)) * HTB)
#define PG8_SB(b, h) ((4 + (b) * 2 + (h)) * HTB)
#define PG8_STAGE(bufoff, gbase, voff) do { _Pragma("unroll") for (int _i = 0; _i < 2; ++_i) \
        __builtin_amdgcn_global_load_lds((const unsigned*)((const char*)(gbase) + (voff)[_i]), (PG8_LAS unsigned*)(lds + (bufoff) + ldsw + _i * 8192), 16, 0, 0); } while (0)
#define PG8_LDA(dst, b, h) do { _Pragma("unroll") for (int m = 0; m < 4; ++m) _Pragma("unroll") for (int k = 0; k < 2; ++k) dst[m][k] = *(const PG8_LAS bf16x8*)(lds + PG8_SA(b, h) + aoff + m * 2048 + k * 1024); } while (0)
#define PG8_LDB(dst, b, h) do { _Pragma("unroll") for (int n = 0; n < 2; ++n) _Pragma("unroll") for (int k = 0; k < 2; ++k) dst[n][k] = *(const PG8_LAS bf16x8*)(lds + PG8_SB(b, h) + boff + n * 2048 + k * 1024); } while (0)
#define PG8_MMA(ai, bj, At, Bt) do { __builtin_amdgcn_s_setprio(1); _Pragma("unroll") for (int m = 0; m < 4; ++m) _Pragma("unroll") for (int n = 0; n < 2; ++n) _Pragma("unroll") for (int k = 0; k < 2; ++k) \
        acc[ai][bj][m][n] = __builtin_amdgcn_mfma_f32_16x16x32_bf16(Bt[n][k], At[m][k], acc[ai][bj][m][n], 0, 0, 0); __builtin_amdgcn_s_setprio(0); } while (0)
#define PG8_WAIT_V(n) asm volatile("s_waitcnt vmcnt(" #n ")" ::: "memory")
#define PG8_WAIT_L(n) asm volatile("s_waitcnt lgkmcnt(" #n ")" ::: "memory")
#define PG8_BAR __builtin_amdgcn_s_barrier()
#define PG8_SCHED __builtin_amdgcn_sched_barrier(0)
    Unit cur, nxt; int ui = 0;
    if (!S.next(0, cur)) return;
    unsigned gvo[4] = {0u, 0u, 0u, 0u}, nvo[4] = {0u, 0u, 0u, 0u};
    if constexpr (GATHER) { PG8_GLOAD(gvo, 0); }
    f32x4 acc[2][2][4][2];
#pragma unroll
    for (int a = 0; a < 2; ++a)
#pragma unroll
        for (int b = 0; b < 2; ++b)
#pragma unroll
            for (int m = 0; m < 4; ++m)
#pragma unroll
                for (int n = 0; n < 2; ++n) acc[a][b][m][n] = (f32x4){0.f, 0.f, 0.f, 0.f};
    bf16x8 At[4][2], B0[2][2], B1[2][2];
    const char* cA = (const char*)g.A + (size_t)cur.pm * tstepA; const char* cB = (const char*)g.Bt + (size_t)cur.pn * tstepB;
    S.a_ready(cur);
    if constexpr (SP2) {
        PG8_STAGE(PG8_SB(0, 0), cB, voffB); PG8_STAGE(PG8_SB(0, 1), cB + hstepB, voffB); PG8_STAGE_A(PG8_SA(0, 0), cA, 0, 0, 0); PG8_STAGE_A(PG8_SA(0, 1), cA + hstepA, 0, 0, 1);
        if (wr == 1) PG8_BAR;
        PG8_WAIT_V(2); PG8_BAR;
        PG8_STAGE(PG8_SB(1, 0), cB + kstep, voffB); PG8_STAGE_A(PG8_SA(1, 0), cA + kstep, kstep, 0, 0); PG8_STAGE(PG8_SB(1, 1), cB + hstepB + kstep, voffB);
        PG8_WAIT_V(6); PG8_BAR;
    } else {
        PG8_STAGE(PG8_SB(0, 0), cB, voffB); PG8_STAGE_A(PG8_SA(0, 0), cA, 0, 0, 0); PG8_STAGE(PG8_SB(0, 1), cB + hstepB, voffB); PG8_STAGE_A(PG8_SA(0, 1), cA + hstepA, 0, 0, 1);
        if (wr == 1) PG8_BAR;
        PG8_WAIT_V(4); PG8_BAR;
        PG8_STAGE(PG8_SB(1, 0), cB + kstep, voffB); PG8_STAGE_A(PG8_SA(1, 0), cA + kstep, kstep, 0, 0); PG8_STAGE(PG8_SB(1, 1), cB + hstepB + kstep, voffB);
        PG8_WAIT_V(6); PG8_BAR;
    }
    for (;;) {
        const bool has_next = S.next(ui + 1, nxt);
        if constexpr (GATHER) { if (has_next) { PG8_GLOAD(nvo, ui + 1); } else { _Pragma("unroll") for (int _j = 0; _j < 4; ++_j) nvo[_j] = gvo[_j]; } }
        const char* nA = has_next ? (const char*)g.A + (size_t)nxt.pm * tstepA : cA; const char* nB = has_next ? (const char*)g.Bt + (size_t)nxt.pn * tstepB : cB;
        int t = 0;
        for (int seg = 0; seg < (Epi::HAS_MID ? 3 : 1); ++seg) {
        const int tend = Epi::HAS_MID ? (seg == 0 ? Epi::MID0 : (seg == 1 ? Epi::MID1 : nt)) : nt;
        for (; t < tend; t += 2) {
            const bool last = (t == nt - 2);
            const char* a1 = cA + (size_t)(t + 1) * kstep;
            const char* a2 = last ? nA : cA + (size_t)(t + 2) * kstep; const char* b2 = last ? nB : cB + (size_t)(t + 2) * kstep;
            const char* a3 = a2 + kstep; const char* b3 = b2 + kstep;
            const size_t ka1 = (size_t)(t + 1) * kstep, ka2 = last ? 0 : (size_t)(t + 2) * kstep, ka3 = ka2 + kstep; const int sl2 = (last && has_next) ? ui + 1 : ui;
            if (last && has_next) S.a_ready(nxt);
            if constexpr (SP2) {
            PG8_LDB(B0, 0, 0); PG8_LDB(B1, 0, 1); PG8_SCHED; PG8_LDA(At, 0, 0); PG8_STAGE_A(PG8_SA(1, 1), a1 + hstepA, ka1, ui, 1);
            PG8_WAIT_V(8); PG8_WAIT_L(0); PG8_BAR; PG8_MMA(0, 0, At, B0); PG8_MMA(0, 1, At, B1); PG8_BAR; PG8_SCHED;
            PG8_LDA(At, 0, 1); PG8_STAGE(PG8_SB(0, 0), b2, voffB); PG8_STAGE(PG8_SB(0, 1), b2 + hstepB, voffB); PG8_STAGE_A(PG8_SA(0, 0), a2, ka2, sl2, 0);
            PG8_WAIT_V(8); PG8_WAIT_L(0); PG8_BAR; PG8_MMA(1, 0, At, B0); PG8_MMA(1, 1, At, B1); PG8_BAR; PG8_SCHED;
            PG8_LDB(B0, 1, 0); PG8_LDB(B1, 1, 1); PG8_SCHED; PG8_LDA(At, 1, 0); PG8_STAGE_A(PG8_SA(0, 1), a2 + hstepA, ka2, sl2, 1);
            PG8_WAIT_V(8); PG8_WAIT_L(0); PG8_BAR; PG8_MMA(0, 0, At, B0); PG8_MMA(0, 1, At, B1); PG8_BAR; PG8_SCHED;
            PG8_LDA(At, 1, 1); PG8_STAGE(PG8_SB(1, 0), b3, voffB); PG8_STAGE(PG8_SB(1, 1), b3 + hstepB, voffB); PG8_STAGE_A(PG8_SA(1, 0), a3, ka3, sl2, 0);
            PG8_WAIT_V(8); PG8_WAIT_L(0); PG8_BAR; PG8_MMA(1, 0, At, B0); PG8_MMA(1, 1, At, B1); PG8_BAR; PG8_SCHED;
            } else {
            PG8_LDB(B0, 0, 0); PG8_SCHED; PG8_LDA(At, 0, 0); PG8_STAGE_A(PG8_SA(1, 1), a1 + hstepA, ka1, ui, 1);
            PG8_WAIT_L(8); PG8_BAR; PG8_WAIT_L(0); PG8_MMA(0, 0, At, B0); PG8_BAR; PG8_SCHED;
            PG8_LDB(B1, 0, 1); PG8_STAGE(PG8_SB(0, 0), b2, voffB);
            PG8_BAR; PG8_WAIT_L(0); PG8_MMA(0, 1, At, B1); PG8_BAR;
            PG8_LDA(At, 0, 1); PG8_STAGE_A(PG8_SA(0, 0), a2, ka2, sl2, 0);
            PG8_BAR; PG8_WAIT_L(0); PG8_MMA(1, 0, At, B0); PG8_BAR; PG8_SCHED;
            PG8_STAGE(PG8_SB(0, 1), b2 + hstepB, voffB);
            PG8_WAIT_V(6); PG8_BAR; PG8_MMA(1, 1, At, B1); PG8_BAR;
            PG8_LDB(B0, 1, 0); PG8_SCHED; PG8_LDA(At, 1, 0); PG8_STAGE_A(PG8_SA(0, 1), a2 + hstepA, ka2, sl2, 1);
            PG8_WAIT_L(8); PG8_BAR; PG8_WAIT_L(0); PG8_MMA(0, 0, At, B0); PG8_BAR; PG8_SCHED;
            PG8_LDB(B1, 1, 1); PG8_STAGE(PG8_SB(1, 0), b3, voffB);
            PG8_BAR; PG8_WAIT_L(0); PG8_MMA(0, 1, At, B1); PG8_BAR;
            PG8_LDA(At, 1, 1); PG8_STAGE_A(PG8_SA(1, 0), a3, ka3, sl2, 0);
            PG8_BAR; PG8_WAIT_L(0); PG8_MMA(1, 0, At, B0); PG8_BAR; PG8_SCHED;
            PG8_STAGE(PG8_SB(1, 1), b3 + hstepB, voffB);
            PG8_WAIT_V(6); PG8_BAR; PG8_MMA(1, 1, At, B1); PG8_BAR;
            }
        }
        if constexpr (Epi::HAS_MID) { if (seg < 2) E.mid(acc, cur, wr, wc, fr, fq, seg); }
        }
        if constexpr (ALIGN_EPI) { if (wr == 0) PG8_BAR; }
        E(acc, cur, wr, wc, fr, fq); S.done(cur);
        if (!has_next) break;
#pragma unroll
        for (int a = 0; a < 2; ++a)
#pragma unroll
            for (int b = 0; b < 2; ++b)
#pragma unroll
                for (int m = 0; m < 4; ++m)
#pragma unroll
                    for (int n = 0; n < 2; ++n) acc[a][b][m][n] = (f32x4){0.f, 0.f, 0.f, 0.f};
        cur = nxt; cA = nA; cB = nB; ++ui;
        if constexpr (GATHER) { _Pragma("unroll") for (int _j = 0; _j < 4; ++_j) gvo[_j] = nvo[_j]; }
        if constexpr (ALIGN_EPI) { if (wr == 1) PG8_BAR; }
    }
    PG8_WAIT_V(0);
    if constexpr (!ALIGN_EPI) { if (wr == 0) PG8_BAR; }
    PG8_BAR;
#undef PG8_SA
#undef PG8_SB
#undef PG8_STAGE
#undef PG8_STAGE_A
#undef PG8_GLOAD
#undef PG8_LDA
#undef PG8_LDB
#undef PG8_MMA
#undef PG8_WAIT_V
#undef PG8_WAIT_L
#undef PG8_BAR
#undef PG8_SCHED
}
}
namespace pg8 {
typedef int i32x4v __attribute__((ext_vector_type(4)));
typedef int i32x8 __attribute__((ext_vector_type(8)));
struct Gemm8 { const unsigned char* A; const unsigned char* Bt; int lda, ldb, K; };
template <class Epi, class Sched, bool GATHER = false>
__device__ __forceinline__ void gemm_phase_f8(PG8_LAS unsigned char* lds, const Gemm8 g, const Sched& S, const Epi& E, const PG8_LAS int* gtab = nullptr) {
    constexpr bool ALIGN_EPI = true, SP2 = true;
    int tid_ = threadIdx.x; asm volatile("" : "+v"(tid_));
    const int tid = tid_, wid = __builtin_amdgcn_readfirstlane(tid >> 6), lane = tid & 63, wr = wid >> 2, wc = wid & 3, fr = lane & 15, fq = lane >> 4;
    int K_ = g.K; asm volatile("" : "+s"(K_));
    const int K = K_, nt = K / 128;
    unsigned voffA[2], voffB[2];
#pragma unroll
    for (int i = 0; i < 2; ++i) { int R, C; stage_rc(tid * 16 + i * 8192, R, C); const int Rb = Epi::PERM ? ((R & ~31) + perm32(R & 31)) : R;
        voffA[i] = (unsigned)(R * g.lda + C * 2); voffB[i] = (unsigned)(Rb * g.ldb + C * 2); }
    const size_t kstep = (size_t)(BK * 2);
    const size_t hstepA = (size_t)HALF * g.lda, hstepB = (size_t)HALF * g.ldb;
    const size_t tstepA = 2 * hstepA, tstepB = 2 * hstepB;
    const unsigned ldsw = (unsigned)wid * 1024u;
    const int aoff = lds_byte(wr * 64 + fr, fq * 16), boff = lds_byte(wc * 32 + fr, fq * 16);
    int gR0 = 0, gC0 = 0; if constexpr (GATHER) { stage_rc(tid * 16, gR0, gC0); }
#define PG8_STAGE_A(bufoff, aptr, koff, slot, h) do { if constexpr (GATHER) { _Pragma("unroll") for (int _i = 0; _i < 2; ++_i) { const unsigned _o = ((slot) == ui) ? gvo[2 * (h) + _i] : nvo[2 * (h) + _i]; \
            __builtin_amdgcn_global_load_lds((const unsigned*)((const char*)g.A + _o + (koff)), (PG8_LAS unsigned*)(lds + (bufoff) + ldsw + _i * 8192), 16, 0, 0); } } \
        else { PG8_STAGE(bufoff, aptr, voffA); } } while (0)
#define PG8_GLOAD(dst, s_) do { _Pragma("unroll") for (int _j = 0; _j < 4; ++_j) dst[_j] = (unsigned)gtab[(s_) * 256 + gR0 + 64 * _j] * (unsigned)(g.lda) + (unsigned)(gC0 * 2); } while (0)
#define PG8_SA(b, h) (((b) * 2 + (h)) * HTB)
#define PG8_SB(b, h) ((4 + (b) * 2 + (h)) * HTB)
#define PG8_STAGE(bufoff, gbase, voff) do { _Pragma("unroll") for (int _i = 0; _i < 2; ++_i) \
        __builtin_amdgcn_global_load_lds((const unsigned*)((const char*)(gbase) + (voff)[_i]), (PG8_LAS unsigned*)(lds + (bufoff) + ldsw + _i * 8192), 16, 0, 0); } while (0)
#define PG8_LDA(dst, b, h) do { _Pragma("unroll") for (int m = 0; m < 4; ++m) { const i32x4v lo_ = *(const PG8_LAS i32x4v*)(lds + PG8_SA(b, h) + aoff + m * 2048), hi_ = *(const PG8_LAS i32x4v*)(lds + PG8_SA(b, h) + aoff + m * 2048 + 16); dst[m] = __builtin_shufflevector(lo_, hi_, 0, 1, 2, 3, 4, 5, 6, 7); } } while (0)
#define PG8_LDB(dst, b, h) do { _Pragma("unroll") for (int n = 0; n < 2; ++n) { const i32x4v lo_ = *(const PG8_LAS i32x4v*)(lds + PG8_SB(b, h) + boff + n * 2048), hi_ = *(const PG8_LAS i32x4v*)(lds + PG8_SB(b, h) + boff + n * 2048 + 16); dst[n] = __builtin_shufflevector(lo_, hi_, 0, 1, 2, 3, 4, 5, 6, 7); } } while (0)
#define PG8_MMA(ai, bj, At, Bt) do { __builtin_amdgcn_s_setprio(1); _Pragma("unroll") for (int m = 0; m < 4; ++m) _Pragma("unroll") for (int n = 0; n < 2; ++n) \
        asm volatile("v_mfma_scale_f32_16x16x128_f8f6f4 %0, %1, %2, %0, %3, %3 op_sel_hi:[0,0,0]" : "+v"(acc[ai][bj][m][n]) : "v"(Bt[n]), "v"(At[m]), "v"(sc1)); __builtin_amdgcn_s_setprio(0); } while (0)
#define PG8_WAIT_V(n) asm volatile("s_waitcnt vmcnt(" #n ")" ::: "memory")
#define PG8_WAIT_L(n) asm volatile("s_waitcnt lgkmcnt(" #n ")" ::: "memory")
#define PG8_BAR __builtin_amdgcn_s_barrier()
#define PG8_SCHED __builtin_amdgcn_sched_barrier(0)
    Unit cur, nxt; int ui = 0;
    if (!S.next(0, cur)) return;
    unsigned gvo[4] = {0u, 0u, 0u, 0u}, nvo[4] = {0u, 0u, 0u, 0u};
    if constexpr (GATHER) { PG8_GLOAD(gvo, 0); }
    f32x4 acc[2][2][4][2];
#pragma unroll
    for (int a = 0; a < 2; ++a)
#pragma unroll
        for (int b = 0; b < 2; ++b)
#pragma unroll
            for (int m = 0; m < 4; ++m)
#pragma unroll
                for (int n = 0; n < 2; ++n) acc[a][b][m][n] = (f32x4){0.f, 0.f, 0.f, 0.f};
    i32x8 At[4], B0[2], B1[2];
    int sc1 = 0x7f7f7f7f; asm volatile("" : "+v"(sc1));
    const char* cA = (const char*)g.A + (size_t)cur.pm * tstepA; const char* cB = (const char*)g.Bt + (size_t)cur.pn * tstepB;
    S.a_ready(cur);
    if constexpr (SP2) {
        PG8_STAGE(PG8_SB(0, 0), cB, voffB); PG8_STAGE(PG8_SB(0, 1), cB + hstepB, voffB); PG8_STAGE_A(PG8_SA(0, 0), cA, 0, 0, 0); PG8_STAGE_A(PG8_SA(0, 1), cA + hstepA, 0, 0, 1);
        if (wr == 1) PG8_BAR;
        PG8_WAIT_V(2); PG8_BAR;
        PG8_STAGE(PG8_SB(1, 0), cB + kstep, voffB); PG8_STAGE_A(PG8_SA(1, 0), cA + kstep, kstep, 0, 0); PG8_STAGE(PG8_SB(1, 1), cB + hstepB + kstep, voffB);
        PG8_WAIT_V(6); PG8_BAR;
    } else {
        PG8_STAGE(PG8_SB(0, 0), cB, voffB); PG8_STAGE_A(PG8_SA(0, 0), cA, 0, 0, 0); PG8_STAGE(PG8_SB(0, 1), cB + hstepB, voffB); PG8_STAGE_A(PG8_SA(0, 1), cA + hstepA, 0, 0, 1);
        if (wr == 1) PG8_BAR;
        PG8_WAIT_V(4); PG8_BAR;
        PG8_STAGE(PG8_SB(1, 0), cB + kstep, voffB); PG8_STAGE_A(PG8_SA(1, 0), cA + kstep, kstep, 0, 0); PG8_STAGE(PG8_SB(1, 1), cB + hstepB + kstep, voffB);
        PG8_WAIT_V(6); PG8_BAR;
    }
    for (;;) {
        const bool has_next = S.next(ui + 1, nxt);
        if constexpr (GATHER) { if (has_next) { PG8_GLOAD(nvo, ui + 1); } else { _Pragma("unroll") for (int _j = 0; _j < 4; ++_j) nvo[_j] = gvo[_j]; } }
        const char* nA = has_next ? (const char*)g.A + (size_t)nxt.pm * tstepA : cA; const char* nB = has_next ? (const char*)g.Bt + (size_t)nxt.pn * tstepB : cB;
        int t = 0;
        for (int seg = 0; seg < (Epi::HAS_MID ? 3 : 1); ++seg) {
        const int tend = Epi::HAS_MID ? (seg == 0 ? Epi::MID0 : (seg == 1 ? Epi::MID1 : nt)) : nt;
#pragma unroll 1
        for (; t < tend; t += 2) {
            const bool last = (t == nt - 2);
            const char* a1 = cA + (size_t)(t + 1) * kstep;
            const char* a2 = last ? nA : cA + (size_t)(t + 2) * kstep; const char* b2 = last ? nB : cB + (size_t)(t + 2) * kstep;
            const char* a3 = a2 + kstep; const char* b3 = b2 + kstep;
            const size_t ka1 = (size_t)(t + 1) * kstep, ka2 = last ? 0 : (size_t)(t + 2) * kstep, ka3 = ka2 + kstep; const int sl2 = (last && has_next) ? ui + 1 : ui;
            if (last && has_next) S.a_ready(nxt);
            if constexpr (SP2) {
            PG8_LDB(B0, 0, 0); PG8_LDB(B1, 0, 1); PG8_SCHED; PG8_LDA(At, 0, 0); PG8_STAGE_A(PG8_SA(1, 1), a1 + hstepA, ka1, ui, 1);
            PG8_WAIT_V(8); PG8_WAIT_L(0); PG8_BAR; PG8_MMA(0, 0, At, B0); PG8_MMA(0, 1, At, B1); PG8_BAR; PG8_SCHED;
            PG8_LDA(At, 0, 1); PG8_STAGE(PG8_SB(0, 0), b2, voffB); PG8_STAGE(PG8_SB(0, 1), b2 + hstepB, voffB); PG8_STAGE_A(PG8_SA(0, 0), a2, ka2, sl2, 0);
            PG8_WAIT_V(8); PG8_WAIT_L(0); PG8_BAR; PG8_MMA(1, 0, At, B0); PG8_MMA(1, 1, At, B1); PG8_BAR; PG8_SCHED;
            PG8_LDB(B0, 1, 0); PG8_LDB(B1, 1, 1); PG8_SCHED; PG8_LDA(At, 1, 0); PG8_STAGE_A(PG8_SA(0, 1), a2 + hstepA, ka2, sl2, 1);
            PG8_WAIT_V(8); PG8_WAIT_L(0); PG8_BAR; PG8_MMA(0, 0, At, B0); PG8_MMA(0, 1, At, B1); PG8_BAR; PG8_SCHED;
            PG8_LDA(At, 1, 1); PG8_STAGE(PG8_SB(1, 0), b3, voffB); PG8_STAGE(PG8_SB(1, 1), b3 + hstepB, voffB); PG8_STAGE_A(PG8_SA(1, 0), a3, ka3, sl2, 0);
            PG8_WAIT_V(8); PG8_WAIT_L(0); PG8_BAR; PG8_MMA(1, 0, At, B0); PG8_MMA(1, 1, At, B1); PG8_BAR; PG8_SCHED;
            } else {
            PG8_LDB(B0, 0, 0); PG8_SCHED; PG8_LDA(At, 0, 0); PG8_STAGE_A(PG8_SA(1, 1), a1 + hstepA, ka1, ui, 1);
            PG8_WAIT_L(8); PG8_BAR; PG8_WAIT_L(0); PG8_MMA(0, 0, At, B0); PG8_BAR; PG8_SCHED;
            PG8_LDB(B1, 0, 1); PG8_STAGE(PG8_SB(0, 0), b2, voffB);
            PG8_BAR; PG8_WAIT_L(0); PG8_MMA(0, 1, At, B1); PG8_BAR;
            PG8_LDA(At, 0, 1); PG8_STAGE_A(PG8_SA(0, 0), a2, ka2, sl2, 0);
            PG8_BAR; PG8_WAIT_L(0); PG8_MMA(1, 0, At, B0); PG8_BAR; PG8_SCHED;
            PG8_STAGE(PG8_SB(0, 1), b2 + hstepB, voffB);
            PG8_WAIT_V(6); PG8_BAR; PG8_MMA(1, 1, At, B1); PG8_BAR;
            PG8_LDB(B0, 1, 0); PG8_SCHED; PG8_LDA(At, 1, 0); PG8_STAGE_A(PG8_SA(0, 1), a2 + hstepA, ka2, sl2, 1);
            PG8_WAIT_L(8); PG8_BAR; PG8_WAIT_L(0); PG8_MMA(0, 0, At, B0); PG8_BAR; PG8_SCHED;
            PG8_LDB(B1, 1, 1); PG8_STAGE(PG8_SB(1, 0), b3, voffB);
            PG8_BAR; PG8_WAIT_L(0); PG8_MMA(0, 1, At, B1); PG8_BAR;
            PG8_LDA(At, 1, 1); PG8_STAGE_A(PG8_SA(1, 0), a3, ka3, sl2, 0);
            PG8_BAR; PG8_WAIT_L(0); PG8_MMA(1, 0, At, B0); PG8_BAR; PG8_SCHED;
            PG8_STAGE(PG8_SB(1, 1), b3 + hstepB, voffB);
            PG8_WAIT_V(6); PG8_BAR; PG8_MMA(1, 1, At, B1); PG8_BAR;
            }
        }
        if constexpr (Epi::HAS_MID) { if (seg < 2) E.mid(acc, cur, wr, wc, fr, fq, seg); }
        }
        if constexpr (ALIGN_EPI) { if (wr == 0) PG8_BAR; }
        asm volatile("s_nop 15\n\ts_nop 15" ::: "memory");
        E(acc, cur, wr, wc, fr, fq); S.done(cur);
        if (!has_next) break;
#pragma unroll
        for (int a = 0; a < 2; ++a)
#pragma unroll
            for (int b = 0; b < 2; ++b)
#pragma unroll
                for (int m = 0; m < 4; ++m)
#pragma unroll
                    for (int n = 0; n < 2; ++n) acc[a][b][m][n] = (f32x4){0.f, 0.f, 0.f, 0.f};
        cur = nxt; cA = nA; cB = nB; ++ui;
        if constexpr (GATHER) { _Pragma("unroll") for (int _j = 0; _j < 4; ++_j) gvo[_j] = nvo[_j]; }
        if constexpr (ALIGN_EPI) { if (wr == 1) PG8_BAR; }
    }
    PG8_WAIT_V(0);
    if constexpr (!ALIGN_EPI) { if (wr == 0) PG8_BAR; }
    PG8_BAR;
#undef PG8_SA
#undef PG8_SB
#undef PG8_STAGE
#undef PG8_STAGE_A
#undef PG8_GLOAD
#undef PG8_LDA
#undef PG8_LDB
#undef PG8_MMA
#undef PG8_WAIT_V
#undef PG8_WAIT_L
#undef PG8_BAR
#undef PG8_SCHED
}
}
#define XB_TMO      128
#define XB_XCNT(j)  (256  + 64 * (j))
#define XB_XSUB(j)  (1280 + 64 * (j))
#define XB_XGEN(j)  (2304 + 64 * (j))
#define XB_TOP      3328
#define XB_TOPGEN   3392
#define XCD_BAR_WORDS 3456
#define XB_SPIN_CAP (1u << 18)

__device__ __forceinline__ unsigned xb_ld(unsigned* p)              { return __hip_atomic_load(p, __ATOMIC_RELAXED, __HIP_MEMORY_SCOPE_AGENT); }
__device__ __forceinline__ unsigned xb_add(unsigned* p, unsigned v) { return __hip_atomic_fetch_add(p, v, __ATOMIC_RELAXED, __HIP_MEMORY_SCOPE_AGENT); }
__device__ __forceinline__ unsigned xb_xcc_id() { return (unsigned)__builtin_amdgcn_s_getreg((3 << 11) | 20) & 0xFu; }
#define XB_SPIN(cond, bar) do { unsigned _sp = 0; while (cond) { __builtin_amdgcn_s_sleep(1); \
    if ((++_sp & 255u) == 0u) { if (xb_ld(&(bar)[XB_TMO])) break; if (_sp > XB_SPIN_CAP) { atomicAdd(&(bar)[XB_TMO], 1u); break; } } } } while (0)

struct XcdBarrier {
    unsigned* bar; unsigned x;
    volatile LAS unsigned* st;
};

__device__ __forceinline__ XcdBarrier xcd_barrier_post(unsigned* bar, volatile LAS unsigned* st) {
    XcdBarrier b; b.bar = bar; b.x = xb_xcc_id(); b.st = st;
    if (threadIdx.x == 0) (void)xb_add(&bar[XB_XCNT(b.x)], 1u);
    return b;
}
__device__ __forceinline__ void xcd_barrier_complete(unsigned* bar, unsigned x, unsigned& nloc, unsigned& nx) {
    const unsigned G = gridDim.x * gridDim.y * gridDim.z;
    unsigned sum, cnt, mine, sp = 0u;
    for (;;) {
        sum = 0u; cnt = 0u; mine = 0u;
#pragma unroll
        for (unsigned j = 0; j < 16; ++j) { const unsigned c = xb_ld(&bar[XB_XCNT(j)]); sum += c; cnt += (c > 0u) ? 1u : 0u; mine = (j == x) ? c : mine; }
        if (sum == G) break;
        __builtin_amdgcn_s_sleep(1);
        if ((++sp & 255u) == 0u) { if (xb_ld(&bar[XB_TMO])) break; if (sp > XB_SPIN_CAP) { atomicAdd(&bar[XB_TMO], 1u); break; } }
    }
    nloc = mine > 0u ? mine : 1u; nx = cnt > 0u ? cnt : 1u;
}

__device__ __forceinline__ void xcd_barrier(const XcdBarrier& b) {
    asm volatile("s_waitcnt vmcnt(0)" ::: "memory");
    __syncthreads();
    if (threadIdx.x == 0) {
        unsigned* bar = b.bar;
        __builtin_amdgcn_s_waitcnt(0);
        unsigned nloc = b.st[0], nx = b.st[1];
        if (nloc == 0u) { xcd_barrier_complete(bar, b.x, nloc, nx); b.st[0] = nloc; b.st[1] = nx; }
        const unsigned old = xb_add(&bar[XB_XSUB(b.x)], 1u);
        const unsigned gen = old / nloc;
        if (old + 1u == (gen + 1u) * nloc) {
            __builtin_amdgcn_fence(__ATOMIC_RELEASE, "agent");
            asm volatile("s_waitcnt vmcnt(0)" ::: "memory");
            const unsigned og = xb_add(&bar[XB_TOP], 1u);
            const unsigned tg = og / nx;
            if (og + 1u == (tg + 1u) * nx) xb_add(&bar[XB_TOPGEN], 1u);
            else XB_SPIN(xb_ld(&bar[XB_TOPGEN]) == tg, bar);
            __builtin_amdgcn_fence(__ATOMIC_ACQUIRE, "agent");
            xb_add(&bar[XB_XGEN(b.x)], 1u);
            asm volatile("s_waitcnt vmcnt(0)" ::: "memory");
        } else {
            XB_SPIN(xb_ld(&bar[XB_XGEN(b.x)]) == gen, bar);
            __builtin_amdgcn_fence(__ATOMIC_ACQUIRE, "agent");
            asm volatile("s_waitcnt vmcnt(0)" ::: "memory");
        }
    }
    __syncthreads();
}
namespace pg8 {
struct EpiProj {
    static constexpr bool PERM = true, HAS_MID = false; static constexpr int MID0 = 0, MID1 = 0;
    __device__ __forceinline__ void mid(f32x4 (&)[2][2][4][2], const Unit&, int, int, int, int, int) const {}
    bf16_t* proj; float* gsm;
    __device__ __forceinline__ void operator()(const f32x4 (&acc)[2][2][4][2], const Unit& u, int wr, int wc, int fr, int fq) const {
        const int row0 = u.pm * BM + wr * 64 + fr;
        if (u.pn < 14) {
            const int col0 = u.pn * BM + wc * 32 + 8 * fq;
#pragma unroll
            for (int ai = 0; ai < 2; ++ai)
#pragma unroll
                for (int m = 0; m < 4; ++m) { bf16_t* rowp = proj + (size_t)(row0 + ai * HALF + m * 16) * NPROJ + col0;
#pragma unroll
                    for (int bj = 0; bj < 2; ++bj) { const f32x4 v0 = acc[ai][bj][m][0], v1 = acc[ai][bj][m][1];
                        u32x4 w; w.x = cvt_pk_bf16(v0[0], v0[1]); w.y = cvt_pk_bf16(v0[2], v0[3]); w.z = cvt_pk_bf16(v1[0], v1[1]); w.w = cvt_pk_bf16(v1[2], v1[3]);
                        *(u32x4*)(rowp + bj * HALF) = w; } }
        } else if (wc == 0 && fq < 3) {
#pragma unroll
            for (int ai = 0; ai < 2; ++ai)
#pragma unroll
                for (int m = 0; m < 4; ++m) { float* rowp = gsm + (size_t)(row0 + ai * HALF + m * 16) * 32 + 8 * fq;
                    *(f32x4*)(rowp) = acc[ai][0][m][0]; *(f32x4*)(rowp + 4) = acc[ai][0][m][1]; }
        }
    }
};
struct EpiProj8 {
    static constexpr bool PERM = true, HAS_MID = false; static constexpr int MID0 = 0, MID1 = 0;
    __device__ __forceinline__ void mid(f32x4 (&)[2][2][4][2], const Unit&, int, int, int, int, int) const {}
    bf16_t* proj; bf16_t* gd;
    __device__ __forceinline__ void operator()(const f32x4 (&acc)[2][2][4][2], const Unit& u, int wr, int wc, int fr, int fq) const {
        constexpr float sc = 1.0f / (F8_SX * F8_SWI);
        const int row0 = u.pm * BM + wr * 64 + fr;
        if (u.pn >= 8) {
            const int gt = u.pn - 8; bf16_t* base = gd + ((size_t)((gt >> 2) * 128 + u.pm) * 4 + (gt & 3)) * 65536 + (size_t)((wr * 4 + wc) * 64 + fq * 16 + fr) * 8;
#pragma unroll
            for (int ai = 0; ai < 2; ++ai)
#pragma unroll
                for (int m = 0; m < 4; ++m)
#pragma unroll
                    for (int bj = 0; bj < 2; ++bj) { constexpr float sg = -sc * 1.4426950408889634f;
                        f32x4 v0 = acc[ai][bj][m][0] * sg, v1 = acc[ai][bj][m][1] * sg;
#pragma unroll
                        for (int q = 0; q < 4; ++q) { v0[q] = fminf(v0[q], 57.0f); v1[q] = fminf(v1[q], 57.0f); }
                        u32x4 w; w.x = cvt_pk_bf16(v0[0], v0[1]); w.y = cvt_pk_bf16(v0[2], v0[3]); w.z = cvt_pk_bf16(v1[0], v1[1]); w.w = cvt_pk_bf16(v1[2], v1[3]);
                        *(u32x4*)(base + (size_t)((ai * 4 + m) * 2 + bj) * 4096) = w; }
        } else {
            const int col0 = PC_LRUY + u.pn * BM + wc * 32 + 8 * fq;
#pragma unroll
            for (int ai = 0; ai < 2; ++ai)
#pragma unroll
                for (int m = 0; m < 4; ++m) { bf16_t* rowp = proj + (size_t)(row0 + ai * HALF + m * 16) * NPROJ + col0;
#pragma unroll
                    for (int bj = 0; bj < 2; ++bj) { const f32x4 v0 = acc[ai][bj][m][0] * sc, v1 = acc[ai][bj][m][1] * sc;
                        u32x4 w; w.x = cvt_pk_bf16(v0[0], v0[1]); w.y = cvt_pk_bf16(v0[2], v0[3]); w.z = cvt_pk_bf16(v1[0], v1[1]); w.w = cvt_pk_bf16(v1[2], v1[3]);
                        *(u32x4*)(rowp + bj * HALF) = w; } }
        }
    }
};
struct P1F8Order {
    int G, c;
    __device__ __forceinline__ bool next(int i, Unit& u) const {
        int L;
        if (G == 256) { const int cnt = c < 128 ? 9 : 11; if (i >= cnt) return false; L = (c < 128 ? c * 9 : 1152 + (c - 128) * 11) + i; }
        else { L = i * G + c; if (L >= 128 * 20) return false; }
        u.pm = L / 20; u.pn = L % 20; return true;
    }
    __device__ __forceinline__ void a_ready(const Unit&) const {}
    __device__ __forceinline__ void done(const Unit&) const {}
};
struct EpiMergeF {
    static constexpr bool PERM = true, HAS_MID = true; static constexpr int MID0 = 16, MID1 = 24;
    const bf16_t* gd; bf16_t* mb;
    static __device__ __forceinline__ float em(float x) { return __builtin_amdgcn_exp2f(x); }
    __device__ __forceinline__ void mid(f32x4 (&acc)[2][2][4][2], const Unit& u, int wr, int wc, int fr, int fq, int st) const {
        int toff = ((wr * 4 + wc) * 64 + fq * 16 + fr) * 8; asm volatile("" : "+v"(toff));
        const bf16_t* ga_ = gd + ((size_t)(st * 128 + u.pm) * 4 + u.pn) * 65536 + toff; const bf16_t* gb_ = ga_ + (size_t)128 * 4 * 65536;
#pragma unroll
        for (int ai = 0; ai < 2; ++ai) {
            u32x4 ga[4][2], gb[4][2];
#pragma unroll
            for (int m = 0; m < 4; ++m)
#pragma unroll
                for (int bj = 0; bj < 2; ++bj) { const int o = ((ai * 4 + m) * 2 + bj) * 4096; ga[m][bj] = *(const u32x4*)(ga_ + o); gb[m][bj] = *(const u32x4*)(gb_ + o); }
#pragma unroll
            for (int m = 0; m < 4; ++m)
#pragma unroll
                for (int bj = 0; bj < 2; ++bj) { const unsigned xa[4] = {ga[m][bj].x, ga[m][bj].y, ga[m][bj].z, ga[m][bj].w}, xb[4] = {gb[m][bj].x, gb[m][bj].y, gb[m][bj].z, gb[m][bj].w};
#pragma unroll
                    for (int q = 0; q < 4; ++q) { const float r0 = (1.f + em(bflo(xb[q]))) * __builtin_amdgcn_rcpf(1.f + em(bflo(xa[q]))), r1 = (1.f + em(bfhi(xb[q]))) * __builtin_amdgcn_rcpf(1.f + em(bfhi(xa[q])));
                        acc[ai][bj][m][q >> 1][(q & 1) * 2] *= r0; acc[ai][bj][m][q >> 1][(q & 1) * 2 + 1] *= r1; } }
            asm volatile("" ::: "memory"); }
    }
    __device__ __forceinline__ void operator()(const f32x4 (&acc)[2][2][4][2], const Unit& u, int wr, int wc, int fr, int fq) const {
        const int row0 = u.pm * BM + wr * 64 + fr, col0 = u.pn * BM + wc * 32 + 8 * fq;
        const bf16_t* g2 = gd + ((size_t)(2 * 128 + u.pm) * 4 + u.pn) * 65536 + (size_t)((wr * 4 + wc) * 64 + fq * 16 + fr) * 8;
#pragma unroll
        for (int ai = 0; ai < 2; ++ai) {
            u32x4 gwv[4][2];
#pragma unroll
            for (int m = 0; m < 4; ++m)
#pragma unroll
                for (int bj = 0; bj < 2; ++bj) gwv[m][bj] = *(const u32x4*)(g2 + ((ai * 4 + m) * 2 + bj) * 4096);
#pragma unroll
            for (int m = 0; m < 4; ++m) { const size_t row = (size_t)(row0 + ai * HALF + m * 16);
#pragma unroll
                for (int bj = 0; bj < 2; ++bj) { const int col = col0 + bj * HALF; const u32x4 gw = gwv[m][bj];
                    f32x4 g0, g1;
                    g0[0] = __builtin_amdgcn_rcpf(1.f + em(bflo(gw.x))); g0[1] = __builtin_amdgcn_rcpf(1.f + em(bfhi(gw.x))); g0[2] = __builtin_amdgcn_rcpf(1.f + em(bflo(gw.y))); g0[3] = __builtin_amdgcn_rcpf(1.f + em(bfhi(gw.y)));
                    g1[0] = __builtin_amdgcn_rcpf(1.f + em(bflo(gw.z))); g1[1] = __builtin_amdgcn_rcpf(1.f + em(bfhi(gw.z))); g1[2] = __builtin_amdgcn_rcpf(1.f + em(bflo(gw.w))); g1[3] = __builtin_amdgcn_rcpf(1.f + em(bfhi(gw.w)));
                    const f32x4 v0 = acc[ai][bj][m][0] * g0, v1 = acc[ai][bj][m][1] * g1;
                    u32x4 w; w.x = cvt_pk_bf16(v0[0], v0[1]); w.y = cvt_pk_bf16(v0[2], v0[3]); w.z = cvt_pk_bf16(v1[0], v1[1]); w.w = cvt_pk_bf16(v1[2], v1[3]);
                    *(u32x4*)(mb + row * 1024 + col) = w; } }
            asm volatile("" ::: "memory"); }
    }
};
struct EpiWout {
    static constexpr bool PERM = true, HAS_MID = false; static constexpr int MID0 = 0, MID1 = 0;
    __device__ __forceinline__ void mid(f32x4 (&)[2][2][4][2], const Unit&, int, int, int, int, int) const {}
    const float* xf; const bf16_t* xh; bf16_t* v;
    __device__ __forceinline__ void operator()(const f32x4 (&acc)[2][2][4][2], const Unit& u, int wr, int wc, int fr, int fq) const {
        const int row0 = u.pm * BM + wr * 64 + fr, col0 = u.pn * BM + wc * 32 + 8 * fq;
#pragma unroll
        for (int ai = 0; ai < 2; ++ai) {
            f32x4 x0[4][2], x1[4][2];
#pragma unroll
            for (int m = 0; m < 4; ++m) { const size_t off = (size_t)(row0 + ai * HALF + m * 16) * 1024 + col0;
#pragma unroll
                for (int bj = 0; bj < 2; ++bj) {
                    if (xf) { x0[m][bj] = *(const f32x4*)(xf + off + bj * HALF); x1[m][bj] = *(const f32x4*)(xf + off + bj * HALF + 4); }
                    else { const u32x4 w = *(const u32x4*)(xh + off + bj * HALF); x0[m][bj] = (f32x4){bflo(w.x), bfhi(w.x), bflo(w.y), bfhi(w.y)}; x1[m][bj] = (f32x4){bflo(w.z), bfhi(w.z), bflo(w.w), bfhi(w.w)}; } } }
#pragma unroll
            for (int m = 0; m < 4; ++m) { const size_t off = (size_t)(row0 + ai * HALF + m * 16) * 1024 + col0;
#pragma unroll
                for (int bj = 0; bj < 2; ++bj) { const f32x4 v0 = x0[m][bj] * DN_ALPHA + acc[ai][bj][m][0], v1 = x1[m][bj] * DN_ALPHA + acc[ai][bj][m][1];
                    u32x4 w; w.x = cvt_pk_bf16(v0[0], v0[1]); w.y = cvt_pk_bf16(v0[2], v0[3]); w.z = cvt_pk_bf16(v1[0], v1[1]); w.w = cvt_pk_bf16(v1[2], v1[3]);
                    *(u32x4*)(v + off + bj * HALF) = w; } }
            asm volatile("" ::: "memory"); }
    }
};
struct EpiMoe1 {
    __device__ __forceinline__ void mid(f32x4 (&)[2][2][4][2], const Unit&, int, int, int, int, int) const {}
    static constexpr bool PERM = true, HAS_MID = false; static constexpr int MID0 = 0, MID1 = 0;
    bf16_t* act; const float* b1;
    __device__ __forceinline__ void operator()(const f32x4 (&acc)[2][2][4][2], const Unit& u, int wr, int wc, int fr, int fq) const {
        const int e = u.pn >> 3, tl = u.pn & 7;
        const int row0 = u.pm * BM + wr * 64 + fr, col0 = tl * 128 + wc * 32 + 8 * fq;
        const float* bp = b1 + (size_t)e * 2048 + col0;
        const f32x4 bg0 = *(const f32x4*)(bp), bg1 = *(const f32x4*)(bp + 4), bl0 = *(const f32x4*)(bp + 1024), bl1 = *(const f32x4*)(bp + 1028);
#pragma unroll
        for (int ai = 0; ai < 2; ++ai)
#pragma unroll
            for (int m = 0; m < 4; ++m) { bf16_t* rowp = act + (size_t)(row0 + ai * HALF + m * 16) * 1024 + col0;
                f32x4 o[2];
#pragma unroll
                for (int n = 0; n < 2; ++n) { const f32x4 gg = acc[ai][0][m][n] + (n ? bg1 : bg0), ll = acc[ai][1][m][n] + (n ? bl1 : bl0);
#pragma unroll
                    for (int q = 0; q < 4; ++q) { const float gv = fminf(gg[q], 7.0f), lv = fminf(fmaxf(ll[q], -7.0f), 7.0f);
                        o[n][q] = gv * sigmoid_f(1.702f * gv) * (lv + 1.0f); } }
                u32x4 w; w.x = cvt_pk_bf16(o[0][0], o[0][1]); w.y = cvt_pk_bf16(o[0][2], o[0][3]); w.z = cvt_pk_bf16(o[1][0], o[1][1]); w.w = cvt_pk_bf16(o[1][2], o[1][3]);
                *(u32x4*)(rowp) = w; }
    }
};
struct EpiMoe2 {
    __device__ __forceinline__ void mid(f32x4 (&)[2][2][4][2], const Unit&, int, int, int, int, int) const {}
    static constexpr bool PERM = true, HAS_MID = false; static constexpr int MID0 = 0, MID1 = 0;
    bf16_t* ys; const float* b2; const float* wbuf;
    __device__ __forceinline__ void operator()(const f32x4 (&acc)[2][2][4][2], const Unit& u, int wr, int wc, int fr, int fq) const {
        const int e = u.pn >> 2, tl = u.pn & 3;
        const int row0 = u.pm * BM + wr * 64 + fr, col0 = tl * 256 + wc * 32 + 8 * fq;
        const float* bp = b2 + (size_t)e * 1024 + col0;
        f32x4 bv[2][2];
#pragma unroll
        for (int bj = 0; bj < 2; ++bj) { bv[bj][0] = *(const f32x4*)(bp + bj * HALF); bv[bj][1] = *(const f32x4*)(bp + bj * HALF + 4); }
#pragma unroll
        for (int ai = 0; ai < 2; ++ai)
#pragma unroll
            for (int m = 0; m < 4; ++m) { const int row = row0 + ai * HALF + m * 16; const float ww = wbuf[row]; bf16_t* rowp = ys + (size_t)row * 1024 + col0;
#pragma unroll
                for (int bj = 0; bj < 2; ++bj) { const f32x4 v0 = (acc[ai][bj][m][0] + bv[bj][0]) * ww, v1 = (acc[ai][bj][m][1] + bv[bj][1]) * ww;
                    u32x4 w; w.x = cvt_pk_bf16(v0[0], v0[1]); w.y = cvt_pk_bf16(v0[2], v0[3]); w.z = cvt_pk_bf16(v1[0], v1[1]); w.w = cvt_pk_bf16(v1[2], v1[3]);
                    *(u32x4*)(rowp + bj * HALF) = w; } }
    }
};
struct EpiMoe1F8 {
    static constexpr bool PERM = true, HAS_MID = false; static constexpr int MID0 = 0, MID1 = 0;
    __device__ __forceinline__ void mid(f32x4 (&)[2][2][4][2], const Unit&, int, int, int, int, int) const {}
    unsigned char* act8; const float* b1;
    __device__ __forceinline__ void operator()(const f32x4 (&acc)[2][2][4][2], const Unit& u, int wr, int wc, int fr, int fq) const {
        const int e = u.pn >> 3, tl = u.pn & 7;
        const int row0 = u.pm * BM + wr * 64 + fr, col0 = tl * 128 + wc * 32 + 8 * fq;
        const float* bp = b1 + (size_t)e * 2048 + col0;
        const f32x4 bg0 = *(const f32x4*)(bp), bg1 = *(const f32x4*)(bp + 4), bl0 = *(const f32x4*)(bp + 1024), bl1 = *(const f32x4*)(bp + 1028);
        constexpr float sc = 1.0f / (F8_SX * F8_SW1);
#pragma unroll
        for (int ai = 0; ai < 2; ++ai)
#pragma unroll
            for (int m = 0; m < 4; ++m) { unsigned char* rowp = act8 + (size_t)(row0 + ai * HALF + m * 16) * 1024 + col0;
                f32x4 o[2];
#pragma unroll
                for (int n = 0; n < 2; ++n) { const f32x4 gg = acc[ai][0][m][n] * sc + (n ? bg1 : bg0), ll = acc[ai][1][m][n] * sc + (n ? bl1 : bl0);
#pragma unroll
                    for (int q = 0; q < 4; ++q) { const float gv = fminf(gg[q], 7.0f), lv = fminf(fmaxf(ll[q], -7.0f), 7.0f);
                        o[n][q] = gv * sigmoid_f(1.702f * gv) * (lv + 1.0f) * F8_SA; } }
                u32x2 w; w.x = pk_fp8x4(o[0][0], o[0][1], o[0][2], o[0][3]); w.y = pk_fp8x4(o[1][0], o[1][1], o[1][2], o[1][3]);
                *(u32x2*)(rowp) = w; }
    }
};
struct EpiMoe2F8 {
    static constexpr bool PERM = true, HAS_MID = false; static constexpr int MID0 = 0, MID1 = 0;
    __device__ __forceinline__ void mid(f32x4 (&)[2][2][4][2], const Unit&, int, int, int, int, int) const {}
    unsigned char* ys8; const float* b2; const float* wbuf;
    __device__ __forceinline__ void operator()(const f32x4 (&acc)[2][2][4][2], const Unit& u, int wr, int wc, int fr, int fq) const {
        const int e = u.pn >> 2, tl = u.pn & 3;
        const int row0 = u.pm * BM + wr * 64 + fr, col0 = tl * 256 + wc * 32 + 8 * fq;
        const float* bp = b2 + (size_t)e * 1024 + col0;
        constexpr float sc = 1.0f / (F8_SA * F8_SW2);
        f32x4 bv[2][2]; float ww[2][4];
#pragma unroll
        for (int bj = 0; bj < 2; ++bj) { bv[bj][0] = *(const f32x4*)(bp + bj * HALF); bv[bj][1] = *(const f32x4*)(bp + bj * HALF + 4); }
#pragma unroll
        for (int ai = 0; ai < 2; ++ai)
#pragma unroll
            for (int m = 0; m < 4; ++m) ww[ai][m] = wbuf[row0 + ai * HALF + m * 16] * F8_SY;
#pragma unroll
        for (int ai = 0; ai < 2; ++ai)
#pragma unroll
            for (int m = 0; m < 4; ++m) { const int row = row0 + ai * HALF + m * 16; const float w_ = ww[ai][m]; unsigned char* rowp = ys8 + (size_t)row * 1024 + col0;
#pragma unroll
                for (int bj = 0; bj < 2; ++bj) { const f32x4 v0 = (acc[ai][bj][m][0] * sc + bv[bj][0]) * w_, v1 = (acc[ai][bj][m][1] * sc + bv[bj][1]) * w_;
                    u32x2 w; w.x = pk_fp8x4(v0[0], v0[1], v0[2], v0[3]); w.y = pk_fp8x4(v1[0], v1[1], v1[2], v1[3]);
                    *(u32x2*)(rowp + bj * HALF) = w; } }
    }
};
struct MoeOrder {
    int nN, G, c, total; const LAS int* blk_e;
    __device__ __forceinline__ bool next(int i, Unit& u) const {
        const long L = (long)i * G + c; if (L >= total) return false;
        const int rb = (int)(L / nN), tl = (int)(L % nN); u.pm = rb; u.pn = blk_e[rb] * nN + tl; return true;
    }
    __device__ __forceinline__ void a_ready(const Unit&) const {}
    __device__ __forceinline__ void done(const Unit&) const {}
};
}
struct Args { const float* in[30]; float* out; unsigned char* ws; int ph_lo, ph_hi, li, pad; };
typedef const __attribute__((address_space(4))) Args* ArgsP;
enum { I_X = 0, I_WIN, I_LCW, I_LCB, I_LWA, I_LBA, I_LWX, I_LBX, I_LLAM, I_MIB, I_MFB, I_MNG, I_GCW, I_GAL, I_GDT, I_GNG, I_WBA, I_WBB, I_WBC, I_WOUT, I_LN1G, I_LN1B, I_RW, I_RB, I_W1, I_B1, I_W2, I_B2, I_LN2G, I_LN2B };

template <int MODE> __device__ __forceinline__ int col_map(int n) {
    if (MODE == 1) {
        if (n < 1024) return n;
        if (n < 2048) return 3840 + (n - 1024);
        if (n < 2304) return 1024 + (n - 2048);
        if (n < 2560) return 1280 + (n - 2304);
        if (n < 3072) return 1536 + (n - 2560);
        if (n < 3076) return 3584 + (n - 3072);
        if (n < 3080) return 3588 + (n - 3076);
        if (n < 3592) return 3840 + 1024 + (n - 3080);
        if (n < 4104) return 2048 + (n - 3592);
        if (n < 4616) return 2560 + (n - 4104);
        if (n < 5128) return 3072 + (n - 4616);
        if (n < 5136) return 3592 + (n - 5128);
        if (n < 5144) return 3600 + (n - 5136);
        if (n < 5656) return 3840 + 1536 + (n - 5144);
        return 3840 + 2048 + (n - 5656);
    } else if (MODE == 2) {
        if (n < 1024) return (n >> 7) * 256 + (n & 127);
        const int q = n - 1024; return (q >> 7) * 256 + 128 + (q & 127);
    }
    return n;
}
struct TrItem { const float* W; bf16_t* WT; int N, ldk, koff, mode, k0, n0; float f8s; };
__device__ __forceinline__ int col_map_rt(int mode, int n) { return mode == 1 ? col_map<1>(n) : (mode == 2 ? col_map<2>(n) : n); }
constexpr int IT_IN = 16 * 273, IT_BRA = 16 * 32, IT_BRB = 8 * 32, IT_BRC = 8 * 32, IT_OUT = 16 * 32, IT_W1 = 32 * 16 * 64, IT_W2 = 32 * 16 * 32;
constexpr int IT_G = 8 * 2 * 8;
constexpr int IT_LAYER = IT_IN + IT_BRA + IT_BRB + IT_BRC + IT_OUT + IT_W1 + IT_W2 + IT_G;
__device__ __forceinline__ TrItem tr_decode(ArgsP a, int it) {
    const int l = it / IT_LAYER; int r = it - l * IT_LAYER; unsigned char* wl = a->ws + WS_W + (size_t)l * WL_STRIDE; TrItem t;
    if (r < IT_IN) { t = TrItem{a->in[I_WIN] + (size_t)l * 1024 * DIN, (bf16_t*)(wl + WL_IN), DIN, 1024, 0, 1, 64 * (r / 273), 32 * (r % 273), 0.f}; return t; } r -= IT_IN;
    if (r < IT_BRA) { t = TrItem{a->in[I_WBA] + (size_t)l * 1024 * 1024, (bf16_t*)(wl + WL_BR), 1024, 2048, 0, 0, 64 * (r / 32), 32 * (r % 32), 0.f}; return t; } r -= IT_BRA;
    if (r < IT_BRB) { t = TrItem{a->in[I_WBB] + (size_t)l * 512 * 1024, (bf16_t*)(wl + WL_BR), 1024, 2048, 1024, 0, 64 * (r / 32), 32 * (r % 32), 0.f}; return t; } r -= IT_BRB;
    if (r < IT_BRC) { t = TrItem{a->in[I_WBC] + (size_t)l * 512 * 1024, (bf16_t*)(wl + WL_BR), 1024, 2048, 1536, 0, 64 * (r / 32), 32 * (r % 32), 0.f}; return t; } r -= IT_BRC;
    if (r < IT_OUT) { t = TrItem{a->in[I_WOUT] + (size_t)l * 1024 * 1024, (bf16_t*)(wl + WL_OUT), 1024, 1024, 0, 0, 64 * (r / 32), 32 * (r % 32), 0.f}; return t; } r -= IT_OUT;
    if (r < IT_W1) { const int e = r / 1024, q = r % 1024; t = TrItem{a->in[I_W1] + ((size_t)l * NE + e) * 1024 * 2048, (bf16_t*)(wl + WL_W1 + (size_t)e * 2048 * 1024), 2048, 1024, 0, 2, 64 * (q / 64), 32 * (q % 64), F8_SW1}; return t; } r -= IT_W1;
    if (r < IT_W2) { const int e = r / 512, q = r % 512; t = TrItem{a->in[I_W2] + ((size_t)l * NE + e) * 1024 * 1024, (bf16_t*)(wl + WL_W2 + (size_t)e * 1024 * 1024), 1024, 1024, 0, 0, 64 * (q / 32), 32 * (q % 32), F8_SW2}; return t; } r -= IT_W2;
    { const int h = r >> 4, gate = (r >> 3) & 1, q = r & 7;
      t = TrItem{a->in[gate ? I_LWX : I_LWA] + ((size_t)l * 8 + h) * 128 * 128, (bf16_t*)(wl + WL_G) + (size_t)(h * 256 + gate * 128) * 128, 128, 128, 0, 0, 64 * (q >> 2), 32 * (q & 3), 0.f}; return t; }
}
__device__ __forceinline__ void p0_convert(ArgsP a, LAS unsigned char* lds, int G) {
    int tid_ = threadIdx.x; asm volatile("" : "+v"(tid_)); const int tid = tid_, lane = tid & 63, wave = tid >> 6;
    LAS float* scr = (LAS float*)(lds + wave * 16384);
    const int gw = blockIdx.x * NWAVES + wave, NGW = G * NWAVES;
    f32x4 v[8];
#define TR_LOAD(t_) do { const int nsrc_ = (t_).n0 + 4 * (lane & 7); const float* p_ = (t_).W + (size_t)((t_).k0 + (lane >> 3)) * (t_).N + nsrc_; \
        _Pragma("unroll") for (int i = 0; i < 8; ++i) { if (nsrc_ + 3 < (t_).N) v[i] = *(const f32x4*)(p_ + (size_t)(8 * i) * (t_).N); \
            else { const float* q_ = p_ + (size_t)(8 * i) * (t_).N; v[i] = (f32x4){nsrc_ < (t_).N ? q_[0] : 0.f, nsrc_ + 1 < (t_).N ? q_[1] : 0.f, nsrc_ + 2 < (t_).N ? q_[2] : 0.f, 0.f}; } } } while (0)
    TrItem cur = tr_decode(a, gw < 2 * IT_LAYER ? gw : 0);
    if (gw < 2 * IT_LAYER) TR_LOAD(cur);
    for (int it = gw; it < 2 * IT_LAYER; it += NGW) {
#pragma unroll
        for (int i = 0; i < 8; ++i) { LAS float* d_ = scr + (8 * i + (lane >> 3)) * 33 + 4 * (lane & 7); d_[0] = v[i][0]; d_[1] = v[i][1]; d_[2] = v[i][2]; d_[3] = v[i][3]; }
        const TrItem me = cur;
        if (it + NGW < 2 * IT_LAYER) { cur = tr_decode(a, it + NGW); TR_LOAD(cur); }
        LDS_WAIT(); asm volatile("" ::: "memory");
        const int c = lane & 7;
#pragma unroll
        for (int j = 0; j < 4; ++j) { const int nl = (lane >> 3) + 8 * j, n = me.n0 + nl; const LAS float* s = scr + (8 * c) * 33 + nl;
            if (me.mode == 1) { const int vr_ = col_map<1>(n < me.N ? n : 0);
                if (n < me.N) { if (vr_ < NIN_BF) { u32x4 o; o.x = pk2(s[0 * 33], s[1 * 33]); o.y = pk2(s[2 * 33], s[3 * 33]); o.z = pk2(s[4 * 33], s[5 * 33]); o.w = pk2(s[6 * 33], s[7 * 33]);
                        *(u32x4*)(me.WT + (size_t)vr_ * 1024 + me.k0 + 8 * c) = o; }
                    else { const float f = F8_SWI; u32x2 o8; o8.x = pk_fp8x4(s[0 * 33] * f, s[1 * 33] * f, s[2 * 33] * f, s[3 * 33] * f); o8.y = pk_fp8x4(s[4 * 33] * f, s[5 * 33] * f, s[6 * 33] * f, s[7 * 33] * f);
                        *(u32x2*)((unsigned char*)me.WT + WL_IN8 + (size_t)(vr_ - NIN_BF) * 1024 + me.k0 + 8 * c) = o8; } } }
            else if (me.f8s != 0.f) { const float f = me.f8s; u32x2 o8; o8.x = pk_fp8x4(s[0 * 33] * f, s[1 * 33] * f, s[2 * 33] * f, s[3 * 33] * f); o8.y = pk_fp8x4(s[4 * 33] * f, s[5 * 33] * f, s[6 * 33] * f, s[7 * 33] * f);
                if (n < me.N) *(u32x2*)((unsigned char*)me.WT + (size_t)col_map_rt(me.mode, n) * me.ldk + me.koff + me.k0 + 8 * c) = o8; }
            else { u32x4 o; o.x = pk2(s[0 * 33], s[1 * 33]); o.y = pk2(s[2 * 33], s[3 * 33]); o.z = pk2(s[4 * 33], s[5 * 33]); o.w = pk2(s[6 * 33], s[7 * 33]);
                if (n < me.N) *(u32x4*)(me.WT + (size_t)col_map_rt(me.mode, n) * me.ldk + me.koff + me.k0 + 8 * c) = o; } }
        LDS_WAIT(); asm volatile("" ::: "memory");
    }
#undef TR_LOAD
    const size_t gt = (size_t)blockIdx.x * 512 + tid, GT = (size_t)G * 512;
    for (size_t i = gt; i < (size_t)2 * 232 * 128; i += GT) { const int l = (int)(i / (232 * 128)); const size_t q = i % (232 * 128);
        *(u32x4*)(a->ws + WS_W + (size_t)l * WL_STRIDE + WL_IN + ((size_t)3608 * 1024) * 2 + q * 16) = (u32x4){0u, 0u, 0u, 0u}; }
    for (size_t i = gt; i < (size_t)2 * 32 * 1024; i += GT) { const int l = (int)(i >> 15), k = (int)((i >> 5) & 1023), e = (int)(i & 31); const float w = a->in[I_RW][i];
        const unsigned hb = f2bf(w); const float lo = w - bf2f((unsigned short)hb); bf16_t* dst = (bf16_t*)(a->ws + WS_RWB) + (size_t)l * 2 * 32 * 1024;
        dst[(size_t)e * 1024 + k] = (bf16_t)hb; dst[(size_t)(32 + e) * 1024 + k] = (bf16_t)f2bf(lo); }
    const float* x = a->in[I_X]; bf16_t* xb = (bf16_t*)(a->ws + WS_XB);
    for (size_t i = gt; i < (size_t)T_ * D_ / 8; i += GT) { const f32x4 v0 = *(const f32x4*)(x + i * 8), v1 = *(const f32x4*)(x + i * 8 + 4);
        u32x4 w; w.x = pk2(v0[0], v0[1]); w.y = pk2(v0[2], v0[3]); w.z = pk2(v1[0], v1[1]); w.w = pk2(v1[2], v1[3]); *(u32x4*)(xb + i * 8) = w;
        u32x2 q8; q8.x = pk_fp8x4(v0[0] * F8_SX, v0[1] * F8_SX, v0[2] * F8_SX, v0[3] * F8_SX); q8.y = pk_fp8x4(v1[0] * F8_SX, v1[1] * F8_SX, v1[2] * F8_SX, v1[3] * F8_SX); *(u32x2*)(a->ws + WS_X2 + i * 8) = q8; }
}

constexpr int TB = 32;
__device__ __forceinline__ void lru_naive(ArgsP a, int l, int u, LAS unsigned char* lds, const bf16_t* proj, bf16_t* H) {
    int tid_ = threadIdx.x; asm volatile("" : "+v"(tid_)); const int tid = tid_, b = u >> 3, h = u & 7, c = tid >> 2, p = tid & 3, chg = h * 128 + c;
    const float* wa = a->in[I_LWA] + ((size_t)l * 8 + h) * 128 * 128; const float* wx = a->in[I_LWX] + ((size_t)l * 8 + h) * 128 * 128;
    float wra[32], wrx[32];
#pragma unroll
    for (int i = 0; i < 32; ++i) { wra[i] = wa[(p * 32 + i) * 128 + c]; wrx[i] = wx[(p * 32 + i) * 128 + c]; }
    const float ba = a->in[I_LBA][l * 1024 + chg], bx = a->in[I_LBX][l * 1024 + chg];
    const float sp = softplus_f(-a->in[I_LLAM][l * 1024 + chg]);
    const float* cw = a->in[I_LCW] + (size_t)l * 4 * 1024 + chg; const float cw0 = cw[0], cw1 = cw[1024], cw2 = cw[2048], cw3 = cw[3072], cb = a->in[I_LCB][l * 1024 + chg];
    LAS bf16_t* xs = (LAS bf16_t*)(lds);
    LAS bf16_t* ys = (LAS bf16_t*)(lds + 8192);
    LAS float* xa_s = (LAS float*)(lds + 16384);
    const int srow = tid >> 4, scol = (tid & 15) * 8;
    const size_t tok0 = (size_t)b * SEQ_;
    u32x4 px = *(const u32x4*)(proj + (tok0 + srow) * NPROJ + PC_LRUX + h * 128 + scol);
    u32x4 py = *(const u32x4*)(proj + (tok0 + srow) * NPROJ + PC_LRUY + h * 128 + scol);
    float hs = 0.f, x1 = 0.f, x2 = 0.f, x3 = 0.f;
    for (int blk = 0; blk < SEQ_ / TB; ++blk) {
        __syncthreads();
        *(LAS u32x4*)(xs + srow * 128 + scol) = px; *(LAS u32x4*)(ys + srow * 128 + scol) = py;
        __syncthreads();
        if (blk + 1 < SEQ_ / TB) { const size_t tk = tok0 + (size_t)(blk + 1) * TB + srow;
            px = *(const u32x4*)(proj + tk * NPROJ + PC_LRUX + h * 128 + scol); py = *(const u32x4*)(proj + tk * NPROJ + PC_LRUY + h * 128 + scol); }
        for (int s = 0; s < TB; ++s) {
            const float xraw = bf2f(xs[s * 128 + c]);
            const float xa = cw0 * x3 + cw1 * x2 + cw2 * x1 + cw3 * xraw + cb;
            x3 = x2; x2 = x1; x1 = xraw;
            LAS float* xb_ = xa_s + (s & 1) * 128;
            if (p == 0) xb_[c] = xa;
            __syncthreads();
            float sa = 0.f, sx = 0.f;
#pragma unroll
            for (int i4 = 0; i4 < 8; ++i4) { const f32x4 xv = *(const LAS f32x4*)(xb_ + p * 32 + i4 * 4);
#pragma unroll
                for (int q = 0; q < 4; ++q) { sa += xv[q] * wra[i4 * 4 + q]; sx += xv[q] * wrx[i4 * 4 + q]; } }
            sa += __shfl_xor(sa, 1); sa += __shfl_xor(sa, 2); sx += __shfl_xor(sx, 1); sx += __shfl_xor(sx, 2);
            const float r = 1.f / (1.f + __expf(-(sa + ba))), ig = 1.f / (1.f + __expf(-(sx + bx)));
            const float log_a = -8.0f * r * sp, av = __expf(log_a), mult = sqrtf(-expm1f(2.0f * log_a));
            hs = av * hs + mult * (ig * xa);
            if (p == 0) { const float y = bf2f(ys[s * 128 + c]);
                H[(tok0 + (size_t)blk * TB + s) * 2048 + chg] = (bf16_t)f2bf(hs * gelu_tanh_f(y)); }
        }
    }
}
__device__ __forceinline__ void mlstm_naive(ArgsP a, int l, int u, LAS unsigned char* lds, const bf16_t* proj, const float* gsm, bf16_t* H) {
    int tid_ = threadIdx.x; asm volatile("" : "+v"(tid_)); const int tid = tid_, lane = tid & 63, wave = tid >> 6, b = u >> 2, hd = u & 3, j = tid & 127;
    LAS float* qs = (LAS float*)(lds);
    LAS float* ks = (LAS float*)(lds + 8192);
    LAS float* vs = (LAS float*)(lds + 16384);
    LAS float* os = (LAS float*)(lds + 32768);
    LAS float* gi = (LAS float*)(lds + 49152);
    LAS float* gf = (LAS float*)(lds + 49152 + 128);
    LAS float* red = (LAS float*)(lds + 49152 + 256);
    const float ib = a->in[I_MIB][l * 4 + hd], fb = a->in[I_MFB][l * 4 + hd], gn = a->in[I_MNG][(size_t)l * 512 + hd * 128 + j];
    const size_t tok0 = (size_t)b * SEQ_;
    const int qa_row = (tid & 255) >> 3, qa_c8 = (tid & 7) * 8; const int qa_col = (tid < 256 ? PC_MLQ : PC_MLK) + hd * 64 + qa_c8;
    const int vb_row = tid >> 4, vb_c8 = (tid & 15) * 8;
    u32x4 pa, pb, pc; float pg = 0.f;
#define ML_ISSUE(blk_) do { const size_t t0 = tok0 + (size_t)(blk_) * TB; \
        pa = *(const u32x4*)(proj + (t0 + qa_row) * NPROJ + qa_col); \
        pb = *(const u32x4*)(proj + (t0 + vb_row) * NPROJ + PC_MLV + hd * 128 + vb_c8); \
        pc = *(const u32x4*)(proj + (t0 + vb_row) * NPROJ + PC_MLO + hd * 128 + vb_c8); \
        if (tid < 64) pg = gsm[(t0 + (tid & 31)) * 32 + (tid < 32 ? 0 : 4) + hd]; } while (0)
    ML_ISSUE(0);
    float C[64], n[64];
#pragma unroll
    for (int r = 0; r < 64; ++r) { C[r] = 0.f; n[r] = 0.f; }
    for (int blk = 0; blk < SEQ_ / TB; ++blk) {
        __syncthreads();
        { LAS float* d = (tid < 256 ? qs : ks) + qa_row * 64 + qa_c8;
          *(LAS f32x4*)(d) = (f32x4){bflo(pa.x), bfhi(pa.x), bflo(pa.y), bfhi(pa.y)}; *(LAS f32x4*)(d + 4) = (f32x4){bflo(pa.z), bfhi(pa.z), bflo(pa.w), bfhi(pa.w)};
          LAS float* dv = vs + vb_row * 128 + vb_c8;
          *(LAS f32x4*)(dv) = (f32x4){bflo(pb.x), bfhi(pb.x), bflo(pb.y), bfhi(pb.y)}; *(LAS f32x4*)(dv + 4) = (f32x4){bflo(pb.z), bfhi(pb.z), bflo(pb.w), bfhi(pb.w)};
          LAS float* dz = os + vb_row * 128 + vb_c8;
          *(LAS f32x4*)(dz) = (f32x4){bflo(pc.x), bfhi(pc.x), bflo(pc.y), bfhi(pc.y)}; *(LAS f32x4*)(dz + 4) = (f32x4){bflo(pc.z), bfhi(pc.z), bflo(pc.w), bfhi(pc.w)};
          if (tid < 32) gi[tid] = pg; else if (tid < 64) gf[tid - 32] = pg; }
        __syncthreads();
        if (blk + 1 < SEQ_ / TB) ML_ISSUE(blk + 1);
        for (int s = 0; s < TB; ++s) {
            float hj = 0.f;
            if (tid < 128) {
                const float f = 1.f / (1.f + __expf(-(gf[s] + fb))), ie = __expf(gi[s] + ib);
                const float vj = vs[s * 128 + j];
                float num = 0.f, den = 0.f;
#pragma unroll
                for (int r4 = 0; r4 < 16; ++r4) { const f32x4 kk = *(const LAS f32x4*)(ks + s * 64 + r4 * 4), qq = *(const LAS f32x4*)(qs + s * 64 + r4 * 4);
#pragma unroll
                    for (int q = 0; q < 4; ++q) { const int r = r4 * 4 + q; const float ik = ie * kk[q];
                        C[r] = f * C[r] + ik * vj; n[r] = f * n[r] + ik; num += qq[q] * C[r]; den += qq[q] * n[r]; } }
                num *= 0.125f; den *= 0.125f;
                hj = num / fmaxf(fabsf(den), 1.0f);
                const float ss = wave_sum(hj * hj);
                if (lane == 0) red[(s & 1) * 2 + wave] = ss;
            }
            __syncthreads();
            if (tid < 128) {
                const float tot = red[(s & 1) * 2] + red[(s & 1) * 2 + 1];
                const float o = hj * rsqrtf(tot * (1.0f / 128.0f) + RMS_EPS) * gn * sigmoid_f(os[s * 128 + j]);
                H[(tok0 + (size_t)blk * TB + s) * 2048 + 1024 + hd * 128 + j] = (bf16_t)f2bf(o);
            }
        }
    }
}
__device__ __forceinline__ void gdn_naive(ArgsP a, int l, int u, LAS unsigned char* lds, const bf16_t* proj, const float* gsm, bf16_t* H) {
    int tid_ = threadIdx.x; asm volatile("" : "+v"(tid_)); const int tid = tid_, lane = tid & 63, b = u >> 3, hd = u & 7;
    LAS float* rq = (LAS float*)(lds);
    LAS float* rk = (LAS float*)(lds + 9216);
    LAS float* rv = (LAS float*)(lds + 18432);
    LAS float* zs = (LAS float*)(lds + 27648);
    LAS float* ga = (LAS float*)(lds + 27648 + 8192);
    LAS float* gb = ga + TB;
    const float* cw = a->in[I_GCW] + (size_t)l * 4 * 1536;
    float cq[4], ck[4], cv[4];
#pragma unroll
    for (int i = 0; i < 4; ++i) { cq[i] = cw[i * 1536 + hd * 64 + lane]; ck[i] = cw[i * 1536 + 512 + hd * 64 + lane]; cv[i] = cw[i * 1536 + 1024 + hd * 64 + lane]; }
    const float nexpA = -__expf(a->in[I_GAL][l * 8 + hd]), dtb = a->in[I_GDT][l * 8 + hd], gn = a->in[I_GNG][l * 64 + lane];
    const size_t tok0 = (size_t)b * SEQ_;
    u32x4 pp[3]; float pg = 0.f;
#define GD_ISSUE(blk_) do { const int tl0 = (blk_) * TB; \
        _Pragma("unroll") for (int i = 0; i < 3; ++i) { const int pid = tid + 512 * i; pp[i] = (u32x4){0u, 0u, 0u, 0u}; \
            if (pid < 840) { const int arr = pid / 280, rem = pid % 280, row = rem >> 3, c8 = (rem & 7) * 8; const int tl = tl0 - 3 + row; \
                if (tl >= 0) pp[i] = *(const u32x4*)(proj + (tok0 + tl) * NPROJ + (arr == 0 ? PC_GDQ : (arr == 1 ? PC_GDK : PC_GDV)) + hd * 64 + c8); } \
            else if (pid < 1096) { const int zp = pid - 840, row = zp >> 3, c8 = (zp & 7) * 8; \
                pp[i] = *(const u32x4*)(proj + (tok0 + tl0 + row) * NPROJ + PC_GDZ + hd * 64 + c8); } } \
        if (tid < 64) pg = gsm[(tok0 + tl0 + (tid & 31)) * 32 + (tid < 32 ? 8 : 16) + hd]; } while (0)
    GD_ISSUE(0);
    float S[64];
#pragma unroll
    for (int i = 0; i < 64; ++i) S[i] = 0.f;
    for (int blk = 0; blk < SEQ_ / TB; ++blk) {
        __syncthreads();
#pragma unroll
        for (int i = 0; i < 3; ++i) { const int pid = tid + 512 * i; LAS float* d = nullptr;
            if (pid < 840) { const int arr = pid / 280, rem = pid % 280, row = rem >> 3, c8 = (rem & 7) * 8; d = (arr == 0 ? rq : (arr == 1 ? rk : rv)) + row * 64 + c8; }
            else if (pid < 1096) { const int zp = pid - 840, row = zp >> 3, c8 = (zp & 7) * 8; d = zs + row * 64 + c8; }
            if (pid < 1096) { const u32x4 w = pp[i];
                *(LAS f32x4*)(d) = (f32x4){bflo(w.x), bfhi(w.x), bflo(w.y), bfhi(w.y)}; *(LAS f32x4*)(d + 4) = (f32x4){bflo(w.z), bfhi(w.z), bflo(w.w), bfhi(w.w)}; } }
        if (tid < 32) ga[tid] = pg; else if (tid < 64) gb[tid - 32] = pg;
        __syncthreads();
        if (blk + 1 < SEQ_ / TB) GD_ISSUE(blk + 1);
        if (tid < 64) {
            for (int s = 0; s < TB; ++s) {
                float qv = 0.f, kv = 0.f, vv = 0.f;
#pragma unroll
                for (int i = 0; i < 4; ++i) { qv += cq[i] * rq[(s + i) * 64 + lane]; kv += ck[i] * rk[(s + i) * 64 + lane]; vv += cv[i] * rv[(s + i) * 64 + lane]; }
                qv = silu_f(qv); kv = silu_f(kv); vv = silu_f(vv);
                const float qn = qv * rsqrtf(wave_sum(qv * qv) + RMS_EPS) * 0.125f;
                const float kn = kv * rsqrtf(wave_sum(kv * kv) + RMS_EPS);
                const float g = nexpA * softplus_f(ga[s] + dtb), alpha = __expf(g), beta = 1.f / (1.f + __expf(-gb[s]));
                float kS = 0.f;
#pragma unroll
                for (int i = 0; i < 64; ++i) kS += __builtin_bit_cast(float, __builtin_amdgcn_readlane(__builtin_bit_cast(int, kn), i)) * S[i];
                const float dl = beta * (vv - alpha * kS);
                float o = 0.f;
#pragma unroll
                for (int i = 0; i < 64; ++i) { const float ki = __builtin_bit_cast(float, __builtin_amdgcn_readlane(__builtin_bit_cast(int, kn), i));
                    const float qi = __builtin_bit_cast(float, __builtin_amdgcn_readlane(__builtin_bit_cast(int, qn), i));
                    S[i] = alpha * S[i] + ki * dl; o += qi * S[i]; }
                const float ms = wave_sum(o * o) * (1.0f / 64.0f);
                const float out = o * rsqrtf(ms + RMS_EPS) * gn * silu_f(zs[s * 64 + lane]);
                H[(tok0 + (size_t)blk * TB + s) * 2048 + 1536 + hd * 64 + lane] = (bf16_t)f2bf(out);
            }
        }
    }
}

constexpr int RW_PITCH = 1032;
__device__ __forceinline__ unsigned f2key(float v, int e) { unsigned u = __builtin_bit_cast(unsigned, v); u = (u & 0x80000000u) ? ~u : (u | 0x80000000u); return (u & ~31u) | (unsigned)(31 - e); }
__device__ __forceinline__ float key2f(unsigned k) { const unsigned u = k & ~31u; return __builtin_bit_cast(float, (u & 0x80000000u) ? (u ^ 0x80000000u) : ~u); }
__device__ __forceinline__ void p5_ln1_router(ArgsP a, int l, LAS unsigned char* lds, int G) {
    int tid_ = threadIdx.x; asm volatile("" : "+v"(tid_)); const int tid = tid_, lane = tid & 63, wave = tid >> 6, tk = lane & 15, g = lane >> 4;
    LAS bf16_t* whi = (LAS bf16_t*)lds;
    LAS bf16_t* wlo = (LAS bf16_t*)(lds + 32 * RW_PITCH * 2);
    LAS int* hist = (LAS int*)(lds + 2 * 32 * RW_PITCH * 2);
    { const bf16_t* src = (const bf16_t*)(a->ws + WS_RWB) + (size_t)l * 2 * 32 * 1024;
      for (int p = tid; p < 2 * 32 * 128; p += 512) { const int arr = p >> 12, e = (p >> 7) & 31, c8 = (p & 127) * 8;
          *(LAS u32x4*)((arr ? wlo : whi) + e * RW_PITCH + c8) = *(const u32x4*)(src + ((size_t)arr * 32 + e) * 1024 + c8); } }
    const bf16_t* v = (const bf16_t*)(a->ws + WS_V); bf16_t* x1b = (bf16_t*)(a->ws + WS_X1B); unsigned char* x18 = a->ws + WS_X1;
    int* tke = (int*)(a->ws + WS_TKE); float* tkw = (float*)(a->ws + WS_TKW); int* ghist = (int*)(a->ws + WS_HIST);
    const float* lng = a->in[I_LN1G] + l * 1024; const float* lnb = a->in[I_LN1B] + l * 1024;
    const float rb0 = a->in[I_RB][l * 32 + tk], rb1 = a->in[I_RB][l * 32 + 16 + tk];
    for (int ch = blockIdx.x; ch < NCHUNK; ch += G) {
        __syncthreads();
        if (tid < 32) hist[tid] = 0;
        __syncthreads();
        const size_t t = (size_t)ch * CHTOK + wave * 16 + tk;
        const bf16_t* vr = v + t * 1024 + 8 * g;
        float s = 0.f, s2 = 0.f;
#pragma unroll 8
        for (int ks = 0; ks < 32; ++ks) { const u32x4 pw = *(const u32x4*)(vr + 32 * ks); const f32x4 p0 = (f32x4){bflo(pw.x), bfhi(pw.x), bflo(pw.y), bfhi(pw.y)}, p1 = (f32x4){bflo(pw.z), bfhi(pw.z), bflo(pw.w), bfhi(pw.w)};
            s += (p0[0] + p0[1]) + (p0[2] + p0[3]) + (p1[0] + p1[1]) + (p1[2] + p1[3]);
            s2 += (p0[0] * p0[0] + p0[1] * p0[1]) + (p0[2] * p0[2] + p0[3] * p0[3]) + (p1[0] * p1[0] + p1[1] * p1[1]) + (p1[2] * p1[2] + p1[3] * p1[3]); }
        s += __shfl_xor(s, 16); s += __shfl_xor(s, 32); s2 += __shfl_xor(s2, 16); s2 += __shfl_xor(s2, 32);
        const float mean = s * (1.0f / 1024.0f); const float rstd = rsqrtf(fmaxf(s2 * (1.0f / 1024.0f) - mean * mean, 0.f) + LN_EPS);
        f32x4 acc0 = (f32x4){0.f, 0.f, 0.f, 0.f}, acc1 = (f32x4){0.f, 0.f, 0.f, 0.f};
#pragma unroll 2
        for (int ks = 0; ks < 32; ++ks) { const int k0 = 32 * ks + 8 * g;
            const u32x4 pw = *(const u32x4*)(vr + 32 * ks); const f32x4 p0 = (f32x4){bflo(pw.x), bfhi(pw.x), bflo(pw.y), bfhi(pw.y)}, p1 = (f32x4){bflo(pw.z), bfhi(pw.z), bflo(pw.w), bfhi(pw.w)};
            const f32x4 g0 = *(const f32x4*)(lng + k0), g1 = *(const f32x4*)(lng + k0 + 4), b0 = *(const f32x4*)(lnb + k0), b1 = *(const f32x4*)(lnb + k0 + 4);
            const f32x4 y0 = (p0 - mean) * rstd * g0 + b0, y1 = (p1 - mean) * rstd * g1 + b1;
            u32x4 hw; hw.x = pg8::cvt_pk_bf16(y0[0], y0[1]); hw.y = pg8::cvt_pk_bf16(y0[2], y0[3]); hw.z = pg8::cvt_pk_bf16(y1[0], y1[1]); hw.w = pg8::cvt_pk_bf16(y1[2], y1[3]);
            *(u32x4*)(x1b + t * 1024 + k0) = hw;
            { u32x2 q8; q8.x = pk_fp8x4(y0[0] * F8_SX, y0[1] * F8_SX, y0[2] * F8_SX, y0[3] * F8_SX); q8.y = pk_fp8x4(y1[0] * F8_SX, y1[1] * F8_SX, y1[2] * F8_SX, y1[3] * F8_SX); *(u32x2*)(x18 + t * 1024 + k0) = q8; }
            u32x4 lw; lw.x = pg8::cvt_pk_bf16(y0[0] - bflo(hw.x), y0[1] - bfhi(hw.x)); lw.y = pg8::cvt_pk_bf16(y0[2] - bflo(hw.y), y0[3] - bfhi(hw.y));
            lw.z = pg8::cvt_pk_bf16(y1[0] - bflo(hw.z), y1[1] - bfhi(hw.z)); lw.w = pg8::cvt_pk_bf16(y1[2] - bflo(hw.w), y1[3] - bfhi(hw.w));
            const bf16x8 ah = __builtin_bit_cast(bf16x8, hw), al = __builtin_bit_cast(bf16x8, lw);
            const bf16x8 wh0 = *(const LAS bf16x8*)(whi + tk * RW_PITCH + k0), wh1 = *(const LAS bf16x8*)(whi + (16 + tk) * RW_PITCH + k0);
            const bf16x8 wl0 = *(const LAS bf16x8*)(wlo + tk * RW_PITCH + k0), wl1 = *(const LAS bf16x8*)(wlo + (16 + tk) * RW_PITCH + k0);
            acc0 = __builtin_amdgcn_mfma_f32_16x16x32_bf16(ah, wh0, acc0, 0, 0, 0); acc1 = __builtin_amdgcn_mfma_f32_16x16x32_bf16(ah, wh1, acc1, 0, 0, 0);
            acc0 = __builtin_amdgcn_mfma_f32_16x16x32_bf16(ah, wl0, acc0, 0, 0, 0); acc1 = __builtin_amdgcn_mfma_f32_16x16x32_bf16(ah, wl1, acc1, 0, 0, 0);
            acc0 = __builtin_amdgcn_mfma_f32_16x16x32_bf16(al, wh0, acc0, 0, 0, 0); acc1 = __builtin_amdgcn_mfma_f32_16x16x32_bf16(al, wh1, acc1, 0, 0, 0); }
#pragma unroll
        for (int r = 0; r < 4; ++r) {
            unsigned k0 = f2key(acc0[r] + rb0, tk), k1 = f2key(acc1[r] + rb1, 16 + tk);
            float tv[4]; int te[4];
#pragma unroll
            for (int k = 0; k < 4; ++k) { unsigned m = k0 > k1 ? k0 : k1;
#pragma unroll
                for (int o = 1; o < 16; o <<= 1) { const unsigned q = (unsigned)__shfl_xor((int)m, o); m = q > m ? q : m; }
                const int e = 31 - (int)(m & 31u); tv[k] = key2f(m); te[k] = e;
                if (e == tk) k0 = 0u; if (e == 16 + tk) k1 = 0u; }
            const float e1 = __expf(tv[1] - tv[0]), e2 = __expf(tv[2] - tv[0]), e3 = __expf(tv[3] - tv[0]); const float inv = 1.0f / (1.0f + e1 + e2 + e3);
            if (tk < 4) { const size_t tt = (size_t)ch * CHTOK + wave * 16 + 4 * g + r;
                const int ei = tk == 0 ? te[0] : (tk == 1 ? te[1] : (tk == 2 ? te[2] : te[3]));
                const float wi = (tk == 0 ? 1.0f : (tk == 1 ? e1 : (tk == 2 ? e2 : e3))) * inv;
                tke[tt * 4 + tk] = ei; tkw[tt * 4 + tk] = wi; __hip_atomic_fetch_add(&hist[ei], 1, __ATOMIC_RELAXED, __HIP_MEMORY_SCOPE_WORKGROUP); }
        }
        __syncthreads();
        if (tid < 32) ghist[ch * 32 + tid] = hist[tid];
    }
}

__device__ __forceinline__ void p6_slots(ArgsP a, LAS unsigned char* lds, int G) {
    int tid_ = threadIdx.x; asm volatile("" : "+v"(tid_)); const int tid = tid_, lane = tid & 63, wave = tid >> 6;
    LAS int* hs = (LAS int*)lds;
    LAS int* cnt = (LAS int*)(lds + 32768);
    LAS int* bst = (LAS int*)(lds + 32768 + 256);
    LAS int* seg = (LAS int*)(lds + 32768 + 512);
    LAS int* wcnt = (LAS int*)(lds + 36864);
    const int* ghist = (const int*)(a->ws + WS_HIST);
    for (int i = tid; i < NCHUNK * 32; i += 512) hs[i] = ghist[i];
    __syncthreads();
    { const int e = tid & 31, sg = tid >> 5;
      int run = 0; for (int c = sg * 16; c < sg * 16 + 16; ++c) { const int v = hs[c * 32 + e]; hs[c * 32 + e] = run; run += v; } seg[sg * 32 + e] = run; }
    __syncthreads();
    if (tid < 32) { int run = 0; for (int sg = 0; sg < 16; ++sg) { const int v = seg[sg * 32 + tid]; seg[sg * 32 + tid] = run; run += v; } cnt[tid] = run; }
    __syncthreads();
    if (tid == 0) { int bs = 0; for (int e = 0; e < 32; ++e) { bst[e] = bs; bs += (cnt[e] + 255) >> 8; } bst[32] = bs; }
    __syncthreads();
    if (blockIdx.x == 0 && tid <= 32) ((int*)(a->ws + WS_META))[tid] = bst[tid];
    const int* tke = (const int*)(a->ws + WS_TKE); const float* tkw = (const float*)(a->ws + WS_TKW);
    int* slot = (int*)(a->ws + WS_SLOT); float* wbuf = (float*)(a->ws + WS_WBUF); int* tokb = (int*)(a->ws + WS_TOKB);
    for (int ch = blockIdx.x; ch < NCHUNK; ch += G) {
        const size_t pi = (size_t)ch * 512 + tid; const int me = tke[pi]; const float mw = tkw[pi];
        int rk = 0;
#pragma unroll 4
        for (int e = 0; e < 32; ++e) { const unsigned long long m = __ballot(me == e); if (me == e) rk = __popcll(m & ((1ull << lane) - 1ull)); if (lane == 0) wcnt[wave * 32 + e] = __popcll(m); }
        __syncthreads();
        int before = 0;
        for (int w = 0; w < wave; ++w) before += wcnt[w * 32 + me];
        const int s_ = bst[me] * 256 + seg[(ch >> 4) * 32 + me] + hs[ch * 32 + me] + before + rk;
        slot[pi] = s_; wbuf[s_] = mw; tokb[s_] = ch * CHTOK + (tid >> 2);
        __syncthreads();
    }
    for (int e = blockIdx.x; e < 32; e += G) for (int s_ = bst[e] * 256 + cnt[e] + tid; s_ < bst[e + 1] * 256; s_ += 512) tokb[s_] = T_;
}
__device__ __forceinline__ int moe_table(ArgsP a, LAS unsigned char* lds) {
    int tid_ = threadIdx.x; asm volatile("" : "+v"(tid_)); const int tid = tid_;
    LAS int* bst = (LAS int*)(lds + MISC_OFF);
    LAS int* blk_e = (LAS int*)(lds + MISC_OFF + 256);
    __syncthreads();
    if (tid <= 32) bst[tid] = ((const int*)(a->ws + WS_META))[tid];
    __syncthreads();
    const int nb = bst[32];
    for (int rb = tid; rb < nb; rb += 512) { int e = 0; while (e < 31 && rb >= bst[e + 1]) ++e; blk_e[rb] = e; }
    __syncthreads();
    return nb;
}

__device__ __forceinline__ void p9_combine_ln2(ArgsP a, int l, float* xout, int G) {
    int tid_ = threadIdx.x; asm volatile("" : "+v"(tid_)); const int tid = tid_, lane = tid & 63, wave = tid >> 6;
    const bf16_t* x1b = (const bf16_t*)(a->ws + WS_X1B); const int* slot = (const int*)(a->ws + WS_SLOT);
    const unsigned char* ys = a->ws + WS_OV + OV_YS; bf16_t* xb = (bf16_t*)(a->ws + WS_XB); unsigned char* x8 = a->ws + WS_X2;
    float gg[2][8], bb[2][8];
#pragma unroll
    for (int j = 0; j < 2; ++j) { const float* gp = a->in[I_LN2G] + l * 1024 + 8 * lane + 512 * j; const float* bp = a->in[I_LN2B] + l * 1024 + 8 * lane + 512 * j;
        const f32x4 g0 = *(const f32x4*)gp, g1 = *(const f32x4*)(gp + 4), b0 = *(const f32x4*)bp, b1 = *(const f32x4*)(bp + 4);
#pragma unroll
        for (int q = 0; q < 4; ++q) { gg[j][q] = g0[q]; gg[j][4 + q] = g1[q]; bb[j][q] = b0[q]; bb[j][4 + q] = b1[q]; } }
    for (int blk = blockIdx.x * NWAVES + wave; blk < T_ / 16; blk += G * NWAVES) {
        const int sv = slot[(size_t)blk * 64 + lane];
        for (int k = 0; k < 16; k += 4) {
            u32x4 xw[4][2]; u32x2 yw[4][4][2];
#pragma unroll
            for (int q = 0; q < 4; ++q) { const size_t t = (size_t)blk * 16 + k + q;
#pragma unroll
                for (int j = 0; j < 2; ++j) xw[q][j] = *(const u32x4*)(x1b + t * 1024 + 8 * lane + 512 * j);
#pragma unroll
                for (int kk = 0; kk < 4; ++kk) { const size_t sr = (size_t)__builtin_amdgcn_readfirstlane(__shfl(sv, (k + q) * 4 + kk));
#pragma unroll
                    for (int j = 0; j < 2; ++j) yw[q][kk][j] = *(const u32x2*)(ys + sr * 1024 + 8 * lane + 512 * j); } }
#pragma unroll
            for (int q = 0; q < 4; ++q) { const size_t t = (size_t)blk * 16 + k + q;
                float xv[2][8]; float s = 0.f;
#pragma unroll
                for (int j = 0; j < 2; ++j) { const unsigned xx[4] = {xw[q][j].x, xw[q][j].y, xw[q][j].z, xw[q][j].w};
#pragma unroll
                    for (int p2 = 0; p2 < 4; ++p2) { xv[j][2 * p2] = bflo(xx[p2]) * DN_ALPHA; xv[j][2 * p2 + 1] = bfhi(xx[p2]) * DN_ALPHA; }
#pragma unroll
                    for (int kk = 0; kk < 4; ++kk) { const int y0 = (int)yw[q][kk][j].x, y1 = (int)yw[q][kk][j].y; constexpr float isy = 1.0f / F8_SY;
                        xv[j][0] += __builtin_amdgcn_cvt_f32_fp8(y0, 0) * isy; xv[j][1] += __builtin_amdgcn_cvt_f32_fp8(y0, 1) * isy; xv[j][2] += __builtin_amdgcn_cvt_f32_fp8(y0, 2) * isy; xv[j][3] += __builtin_amdgcn_cvt_f32_fp8(y0, 3) * isy;
                        xv[j][4] += __builtin_amdgcn_cvt_f32_fp8(y1, 0) * isy; xv[j][5] += __builtin_amdgcn_cvt_f32_fp8(y1, 1) * isy; xv[j][6] += __builtin_amdgcn_cvt_f32_fp8(y1, 2) * isy; xv[j][7] += __builtin_amdgcn_cvt_f32_fp8(y1, 3) * isy; }
#pragma unroll
                    for (int e = 0; e < 8; ++e) s += xv[j][e]; }
                const float mean = wave_sum(s) * (1.0f / 1024.0f); float s2 = 0.f;
#pragma unroll
                for (int j = 0; j < 2; ++j)
#pragma unroll
                    for (int e = 0; e < 8; ++e) { xv[j][e] -= mean; s2 += xv[j][e] * xv[j][e]; }
                const float rstd = rsqrtf(wave_sum(s2) * (1.0f / 1024.0f) + LN_EPS);
#pragma unroll
                for (int j = 0; j < 2; ++j) {
#pragma unroll
                    for (int e = 0; e < 8; ++e) xv[j][e] = xv[j][e] * rstd * gg[j][e] + bb[j][e];
                    const size_t o = t * 1024 + 8 * lane + 512 * j;
                    if (xout) { *(f32x4*)(xout + o) = (f32x4){xv[j][0], xv[j][1], xv[j][2], xv[j][3]}; *(f32x4*)(xout + o + 4) = (f32x4){xv[j][4], xv[j][5], xv[j][6], xv[j][7]}; }
                    u32x4 w; w.x = pk2(xv[j][0], xv[j][1]); w.y = pk2(xv[j][2], xv[j][3]); w.z = pk2(xv[j][4], xv[j][5]); w.w = pk2(xv[j][6], xv[j][7]); *(u32x4*)(xb + o) = w;
                    u32x2 q8; q8.x = pk_fp8x4(xv[j][0] * F8_SX, xv[j][1] * F8_SX, xv[j][2] * F8_SX, xv[j][3] * F8_SX); q8.y = pk_fp8x4(xv[j][4] * F8_SX, xv[j][5] * F8_SX, xv[j][6] * F8_SX, xv[j][7] * F8_SX);
                    *(u32x2*)(x8 + o) = q8; } }
        }
    }
}
typedef float f32x4_t __attribute__((ext_vector_type(4)));
constexpr size_t MX_LRU_PH = 0, MX_LRU_CARRY = 4 * MiB;
template <int MODE> __device__ __forceinline__ void lru_fast(ArgsP a, int l, int b, int h, int c_lo, int c_hi, LAS unsigned char* lds, const bf16_t* proj, bf16_t* H, unsigned char* mxs) {
    int tid_ = threadIdx.x; asm volatile("" : "+v"(tid_)); const int tid = tid_, lane = tid & 63, wave = __builtin_amdgcn_readfirstlane(tid >> 6), fr = lane & 15, g = lane >> 4;
    LAS bf16_t* xa = (LAS bf16_t*)(lds);
    LAS bf16_t* ysb = (LAS bf16_t*)(lds + 17408);
    LAS bf16_t* outb = (LAS bf16_t*)(lds + 33792);
    LAS bf16_t* outc = (LAS bf16_t*)(lds + 50176);
    bf16_t* HL = (bf16_t*)(a->ws + WS_MB); bf16_t* CA = (bf16_t*)(a->ws + WS_X1B);
    float* PH = (float*)(mxs + MX_LRU_PH); const float* carry = (const float*)(mxs + MX_LRU_CARRY);
    const int ch = 16 * wave + fr, chg = h * 128 + ch;
    const bf16_t* wg = (const bf16_t*)(a->ws + WS_W + (size_t)l * WL_STRIDE + WL_G) + (size_t)h * 256 * 128;
    bf16x8 bra[4], brx[4];
#pragma unroll
    for (int ks = 0; ks < 4; ++ks) { bra[ks] = *(const bf16x8*)(wg + (size_t)(ch) * 128 + 32 * ks + 8 * g); brx[ks] = *(const bf16x8*)(wg + (size_t)(128 + ch) * 128 + 32 * ks + 8 * g); }
    const float ba = a->in[I_LBA][l * 1024 + chg], bx = a->in[I_LBX][l * 1024 + chg], sp = softplus_f(-a->in[I_LLAM][l * 1024 + chg]);
    const int cg = tid & 15, t0i = tid >> 4;
    float cwv[4][8], cbv[8];
    { const float* cw = a->in[I_LCW] + (size_t)l * 4 * 1024 + h * 128 + 8 * cg;
#pragma unroll
      for (int j = 0; j < 4; ++j) { const f32x4 w0 = *(const f32x4*)(cw + j * 1024), w1 = *(const f32x4*)(cw + j * 1024 + 4);
          cwv[j][0] = w0[0]; cwv[j][1] = w0[1]; cwv[j][2] = w0[2]; cwv[j][3] = w0[3]; cwv[j][4] = w1[0]; cwv[j][5] = w1[1]; cwv[j][6] = w1[2]; cwv[j][7] = w1[3]; }
      const float* cbp = a->in[I_LCB] + l * 1024 + h * 128 + 8 * cg; const f32x4 b0 = *(const f32x4*)(cbp), b1 = *(const f32x4*)(cbp + 4);
      cbv[0] = b0[0]; cbv[1] = b0[1]; cbv[2] = b0[2]; cbv[3] = b0[3]; cbv[4] = b1[0]; cbv[5] = b1[1]; cbv[6] = b1[2]; cbv[7] = b1[3]; }
    u32x4 pr[2][4], py[2];
#define LRU_ISSUE(c_) do { _Pragma("unroll") for (int i = 0; i < 2; ++i) { const int tl = (c_) * 64 + t0i + 32 * i; \
        _Pragma("unroll") for (int j = 0; j < 4; ++j) { const int tt_ = tl - 3 + j; pr[i][j] = (u32x4){0u, 0u, 0u, 0u}; \
            if (tt_ >= 0) pr[i][j] = *(const u32x4*)(proj + ((size_t)b * SEQ_ + tt_) * NPROJ + PC_LRUX + h * 128 + 8 * cg); } \
        if (MODE == 1) py[i] = *(const u32x4*)(proj + ((size_t)b * SEQ_ + tl) * NPROJ + PC_LRUY + h * 128 + 8 * cg); } } while (0)
    LRU_ISSUE(c_lo);
    for (int c = c_lo; c < c_hi; ++c) {
        const size_t tok0 = (size_t)b * SEQ_ + (size_t)c * 64;
        __syncthreads();
#pragma unroll
        for (int i = 0; i < 2; ++i) { float o[8];
#pragma unroll
            for (int q = 0; q < 8; ++q) o[q] = cbv[q];
#pragma unroll
            for (int j = 0; j < 4; ++j) { const unsigned x[4] = {pr[i][j].x, pr[i][j].y, pr[i][j].z, pr[i][j].w};
#pragma unroll
                for (int q = 0; q < 4; ++q) { o[2 * q] += cwv[j][2 * q] * bflo(x[q]); o[2 * q + 1] += cwv[j][2 * q + 1] * bfhi(x[q]); } }
            u32x4 w; w.x = pg8::cvt_pk_bf16(o[0], o[1]); w.y = pg8::cvt_pk_bf16(o[2], o[3]); w.z = pg8::cvt_pk_bf16(o[4], o[5]); w.w = pg8::cvt_pk_bf16(o[6], o[7]);
            *(LAS u32x4*)(xa + (t0i + 32 * i) * 136 + 8 * cg) = w;
            if (MODE == 1) *(LAS u32x4*)(ysb + (t0i + 32 * i) * 128 + 8 * cg) = py[i]; }
        if (c + 1 < c_hi) LRU_ISSUE(c + 1);
        __syncthreads();
        f32x4_t ar[4], ax[4];
#pragma unroll
        for (int tt = 0; tt < 4; ++tt) { ar[tt] = (f32x4_t){0.f, 0.f, 0.f, 0.f}; ax[tt] = (f32x4_t){0.f, 0.f, 0.f, 0.f}; }
#pragma unroll
        for (int tt = 0; tt < 4; ++tt)
#pragma unroll
            for (int ks = 0; ks < 4; ++ks) { const bf16x8 af = *(const LAS bf16x8*)(xa + (16 * tt + fr) * 136 + 32 * ks + 8 * g);
                ar[tt] = __builtin_amdgcn_mfma_f32_16x16x32_bf16(af, bra[ks], ar[tt], 0, 0, 0);
                ax[tt] = __builtin_amdgcn_mfma_f32_16x16x32_bf16(af, brx[ks], ax[tt], 0, 0, 0); }
        float av[4][4], uv[4][4], Ai[4], Bi[4];
#pragma unroll
        for (int tt = 0; tt < 4; ++tt) { float A = 1.f, B = 0.f;
#pragma unroll
            for (int r = 0; r < 4; ++r) { const int t = 16 * tt + 4 * g + r;
                const float rg = sigmoid_f(ar[tt][r] + ba), ig = sigmoid_f(ax[tt][r] + bx);
                const float log_a = -8.0f * rg * sp; av[tt][r] = __expf(log_a); uv[tt][r] = __builtin_amdgcn_sqrtf(neg_expm1_f(2.0f * log_a)) * (ig * bf2f(xa[t * 136 + ch]));
                B = av[tt][r] * B + uv[tt][r]; A *= av[tt][r]; }
            Ai[tt] = A; Bi[tt] = B; }
#pragma unroll
        for (int tt = 0; tt < 4; ++tt) { const float A1 = __shfl_up(Ai[tt], 16), B1 = __shfl_up(Bi[tt], 16); if (g >= 1) { Bi[tt] = Ai[tt] * B1 + Bi[tt]; Ai[tt] = Ai[tt] * A1; } }
#pragma unroll
        for (int tt = 0; tt < 4; ++tt) { const float A2 = __shfl_up(Ai[tt], 32), B2 = __shfl_up(Bi[tt], 32); if (g >= 2) { Bi[tt] = Ai[tt] * B2 + Bi[tt]; Ai[tt] = Ai[tt] * A2; } }
        float Ae[4], Be[4], At[4], Bt[4];
#pragma unroll
        for (int tt = 0; tt < 4; ++tt) { Ae[tt] = __shfl_up(Ai[tt], 16); Be[tt] = __shfl_up(Bi[tt], 16); if (g == 0) { Ae[tt] = 1.f; Be[tt] = 0.f; }
            At[tt] = __shfl(Ai[tt], fr + 48); Bt[tt] = __shfl(Bi[tt], fr + 48); }
        float hin = 0.f, ptot = 1.f;
        if (MODE == 1) hin = carry[((size_t)b * 64 + c) * 1024 + chg];
#pragma unroll
        for (int tt = 0; tt < 4; ++tt) {
            float hcur = Ae[tt] * hin + Be[tt], ccur = ptot * Ae[tt];
#pragma unroll
            for (int r = 0; r < 4; ++r) { const int t = 16 * tt + 4 * g + r; hcur = av[tt][r] * hcur + uv[tt][r]; ccur *= av[tt][r];
                if (MODE == 1) outb[t * 128 + ch] = (bf16_t)f2bf(hcur * gelu_tanh_f(bf2f(ysb[t * 128 + ch])));
                else { outb[t * 128 + ch] = (bf16_t)f2bf(hcur); outc[t * 128 + ch] = (bf16_t)f2bf(ccur); } }
            hin = At[tt] * hin + Bt[tt]; ptot *= At[tt]; }
        if (MODE == 0) { if (g == 0) { PH[(((size_t)b * 64 + c) * 2 + 0) * 1024 + chg] = ptot; PH[(((size_t)b * 64 + c) * 2 + 1) * 1024 + chg] = hin; } }
        __syncthreads();
#pragma unroll
        for (int i = 0; i < 2; ++i) { const int pid = tid + 512 * i; const int row = pid >> 4, c8 = (pid & 15) * 8;
            if (MODE == 1) *(u32x4*)(H + (tok0 + row) * 2048 + h * 128 + c8) = *(const LAS u32x4*)(outb + row * 128 + c8);
            else { *(u32x4*)(HL + (tok0 + row) * 1024 + h * 128 + c8) = *(const LAS u32x4*)(outb + row * 128 + c8); *(u32x4*)(CA + (tok0 + row) * 1024 + h * 128 + c8) = *(const LAS u32x4*)(outc + row * 128 + c8); } }
    }
#undef LRU_ISSUE
}
__device__ __forceinline__ void lru_carry(unsigned char* mxs, int gid0, int gstride) {
    const float* PH = (const float*)(mxs + MX_LRU_PH); float* carry = (float*)(mxs + MX_LRU_CARRY);
    for (int gid = gid0; gid < NBATCH * 1024; gid += gstride) { const int b = gid >> 10, chg = gid & 1023; float hc = 0.f;
#pragma unroll 8
        for (int c = 0; c < 64; ++c) { const size_t o = ((size_t)b * 64 + c); carry[o * 1024 + chg] = hc; hc = PH[(o * 2) * 1024 + chg] * hc + PH[(o * 2 + 1) * 1024 + chg]; } }
}
__device__ __forceinline__ void lru_apply(ArgsP a, const bf16_t* proj, bf16_t* H, unsigned char* mxs, int first, int stride) {
    int tid_ = threadIdx.x; asm volatile("" : "+v"(tid_));
    const bf16_t* HL = (const bf16_t*)(a->ws + WS_MB); const bf16_t* CA = (const bf16_t*)(a->ws + WS_X1B); const float* carry = (const float*)(mxs + MX_LRU_CARRY);
    for (size_t p = (size_t)first * 512 + tid_; p < (size_t)T_ * 128; p += (size_t)stride * 512) { const size_t t = p >> 7; const int c8 = (int)(p & 127) * 8;
        const u32x4 hw = *(const u32x4*)(HL + t * 1024 + c8), cw = *(const u32x4*)(CA + t * 1024 + c8), yw = *(const u32x4*)(proj + t * NPROJ + PC_LRUY + c8);
        const float* cp = carry + (t >> 6) * 1024 + c8; const f32x4 c0 = *(const f32x4*)(cp), c1 = *(const f32x4*)(cp + 4);
        const unsigned hh[4] = {hw.x, hw.y, hw.z, hw.w}, cc[4] = {cw.x, cw.y, cw.z, cw.w}, yy[4] = {yw.x, yw.y, yw.z, yw.w}; const float cin[8] = {c0[0], c0[1], c0[2], c0[3], c1[0], c1[1], c1[2], c1[3]};
        unsigned o[4];
#pragma unroll
        for (int q = 0; q < 4; ++q) { const float h0 = bflo(hh[q]) + bflo(cc[q]) * cin[2 * q], h1 = bfhi(hh[q]) + bfhi(cc[q]) * cin[2 * q + 1];
            o[q] = pg8::cvt_pk_bf16(h0 * gelu_tanh_f(bflo(yy[q])), h1 * gelu_tanh_f(bfhi(yy[q]))); }
        *(u32x4*)(H + t * 2048 + c8) = (u32x4){o[0], o[1], o[2], o[3]}; }
}
typedef float f32x16 __attribute__((ext_vector_type(16)));
typedef short bf16x4 __attribute__((ext_vector_type(4)));
constexpr size_t MXB_ML_U = 0;
constexpr size_t MXB_ML_CP = 64 * MiB;
constexpr size_t MXS_ML_NU = 6 * MiB, MXS_ML_NP = 6 * MiB + 512 * 1024, MXS_ML_SC = 7 * MiB;

__device__ __forceinline__ float bperm_f(int src_lane, float v) { return __builtin_bit_cast(float, __builtin_amdgcn_ds_bpermute(src_lane << 2, __builtin_bit_cast(int, v))); }
__device__ __forceinline__ float wave_incl_sum(float v, int lane) {
#pragma unroll
    for (int o = 1; o < 64; o <<= 1) { const float t = bperm_f(lane >= o ? lane - o : lane, v); if (lane >= o) v += t; }
    return v;
}
__device__ __forceinline__ float wave_incl_max(float v, int lane) {
#pragma unroll
    for (int o = 1; o < 64; o <<= 1) { const float t = bperm_f(lane >= o ? lane - o : lane, v); if (lane >= o) v = fmaxf(v, t); }
    return v;
}
__device__ __forceinline__ bf16x8 pack8(float a0, float a1, float a2, float a3, float a4, float a5, float a6, float a7) {
    u32x4 w; w.x = pg8::cvt_pk_bf16(a0, a1); w.y = pg8::cvt_pk_bf16(a2, a3); w.z = pg8::cvt_pk_bf16(a4, a5); w.w = pg8::cvt_pk_bf16(a6, a7); return __builtin_bit_cast(bf16x8, w);
}
__device__ __forceinline__ bf16x8 ld_perm(const LAS bf16_t* p) {
    const u32x2 lo = *(const LAS u32x2*)(p), hi = *(const LAS u32x2*)(p + 8); u32x4 w; w.x = lo.x; w.y = lo.y; w.z = hi.x; w.w = hi.y; return __builtin_bit_cast(bf16x8, w);
}

__device__ __forceinline__ void mlstm_passA(ArgsP a, int l, LAS unsigned char* lds, const bf16_t* proj, const float* gsm, unsigned char* mxb, unsigned char* mxs, int G) {
    int tid_ = threadIdx.x; asm volatile("" : "+v"(tid_)); const int tid = tid_, lane = tid & 63, wave = __builtin_amdgcn_readfirstlane(tid >> 6), r = lane & 31, hh = lane >> 5;
    LAS bf16_t* kwT = (LAS bf16_t*)(lds);
    LAS bf16_t* vT = (LAS bf16_t*)(lds + 9216);
    LAS float* wts = (LAS float*)(lds + 27648);
    float* NU = (float*)(mxs + MXS_ML_NU); float* SC = (float*)(mxs + MXS_ML_SC);
    const f32x4 ib4 = *(const f32x4*)(a->in[I_MIB] + l * 4), fb4 = *(const f32x4*)(a->in[I_MFB] + l * 4);
    u32x4 kp, vp0, vp1; float pgf = 0.f, pgi = 0.f;
#define MLA_ISSUE(u_) do { const int c_ = (u_) & 63, hd_ = ((u_) >> 6) & 3, b_ = (u_) >> 8; const size_t t0_ = (size_t)b_ * SEQ_ + (size_t)c_ * 64 + lane; \
        kp = *(const u32x4*)(proj + t0_ * NPROJ + PC_MLK + hd_ * 64 + wave * 8); vp0 = *(const u32x4*)(proj + t0_ * NPROJ + PC_MLV + hd_ * 128 + wave * 8); \
        vp1 = *(const u32x4*)(proj + t0_ * NPROJ + PC_MLV + hd_ * 128 + 64 + wave * 8); pgf = gsm[t0_ * 32 + 4 + hd_]; pgi = gsm[t0_ * 32 + hd_]; } while (0)
    if ((int)blockIdx.x < 2048) MLA_ISSUE((int)blockIdx.x);
    for (int uid = blockIdx.x; uid < 2048; uid += G) {
        const int hd = (uid >> 6) & 3;
        const float ib = hd == 0 ? ib4[0] : (hd == 1 ? ib4[1] : (hd == 2 ? ib4[2] : ib4[3])), fb = hd == 0 ? fb4[0] : (hd == 1 ? fb4[1] : (hd == 2 ? fb4[2] : fb4[3]));
        float w;
        { const float fpre = pgf + fb, ipre = pgi + ib;
          const float logf = -softplus_f(-fpre); const float bc = wave_incl_sum(logf, lane); const float bl = __builtin_bit_cast(float, __builtin_amdgcn_readlane(__builtin_bit_cast(int, bc), 63));
          const float ge = bl - bc + ipre; const float mloc = wave_max(ge);
          w = __expf(ge - mloc);
          if (tid == 0) { SC[(size_t)uid * 4 + 0] = bl; SC[(size_t)uid * 4 + 1] = mloc; } }
        __syncthreads();
        { const unsigned kw[4] = {kp.x, kp.y, kp.z, kp.w};
#pragma unroll
          for (int j = 0; j < 4; ++j) { kwT[(wave * 8 + 2 * j) * 72 + lane] = (bf16_t)f2bf(w * bflo(kw[j])); kwT[(wave * 8 + 2 * j + 1) * 72 + lane] = (bf16_t)f2bf(w * bfhi(kw[j])); }
          const unsigned v0[4] = {vp0.x, vp0.y, vp0.z, vp0.w}, v1[4] = {vp1.x, vp1.y, vp1.z, vp1.w};
#pragma unroll
          for (int j = 0; j < 4; ++j) { vT[(wave * 8 + 2 * j) * 72 + lane] = (bf16_t)(v0[j] & 0xffffu); vT[(wave * 8 + 2 * j + 1) * 72 + lane] = (bf16_t)(v0[j] >> 16);
              vT[(64 + wave * 8 + 2 * j) * 72 + lane] = (bf16_t)(v1[j] & 0xffffu); vT[(64 + wave * 8 + 2 * j + 1) * 72 + lane] = (bf16_t)(v1[j] >> 16); } }
        if (uid + G < 2048) MLA_ISSUE(uid + G);
        __syncthreads();
        const int dI = wave >> 2, eJ = wave & 3;
        f32x16 acc;
#pragma unroll
        for (int i = 0; i < 16; ++i) acc[i] = 0.f;
#pragma unroll
        for (int ks = 0; ks < 4; ++ks) { const bf16x8 af = *(const LAS bf16x8*)(kwT + (32 * dI + r) * 72 + 16 * ks + 8 * hh), bf = *(const LAS bf16x8*)(vT + (32 * eJ + r) * 72 + 16 * ks + 8 * hh);
            acc = __builtin_amdgcn_mfma_f32_32x32x16_bf16(af, bf, acc, 0, 0, 0); }
        float* ud = (float*)(mxb + MXB_ML_U) + ((size_t)uid * 8 + wave) * 1024;
#pragma unroll
        for (int q = 0; q < 4; ++q) *(f32x4*)(ud + (q * 64 + lane) * 4) = (f32x4){acc[4 * q], acc[4 * q + 1], acc[4 * q + 2], acc[4 * q + 3]};
        if (tid < 64) { float s = 0.f;
#pragma unroll 8
            for (int t = 0; t < 64; ++t) s += bf2f(kwT[tid * 72 + t]);
            NU[(size_t)uid * 64 + tid] = s; }
    }
#undef MLA_ISSUE
}
__device__ __forceinline__ void mlstm_passB(unsigned char* mxb, unsigned char* mxs, int G) {
    int tid_ = threadIdx.x; asm volatile("" : "+v"(tid_)); const int tid = tid_;
    const float* NU = (const float*)(mxs + MXS_ML_NU); float* NP = (float*)(mxs + MXS_ML_NP); float* SC = (float*)(mxs + MXS_ML_SC);
    for (int wu = blockIdx.x; wu < 256; wu += G) {
        const int chain = wu >> 3, tile = wu & 7;
        if (tid < 128) {
            const int lane = tid & 63, s = tid >> 6;
            float st[8]; float m = 0.f;
#pragma unroll
            for (int i = 0; i < 8; ++i) st[i] = 0.f;
#pragma unroll 4
            for (int c = 0; c < 64; ++c) { const size_t uid = (size_t)chain * 64 + c;
                const float* ud = (const float*)(mxb + MXB_ML_U) + (uid * 8 + tile) * 1024;
                const f32x4 u0 = *(const f32x4*)(ud + ((2 * s) * 64 + lane) * 4), u1 = *(const f32x4*)(ud + ((2 * s + 1) * 64 + lane) * 4);
                const float bl = SC[uid * 4 + 0], mloc = SC[uid * 4 + 1];
                *(bf16x8*)((bf16_t*)(mxb + MXB_ML_CP) + (uid * 8 + tile) * 1024 + (s * 64 + lane) * 8) = pack8(st[0], st[1], st[2], st[3], st[4], st[5], st[6], st[7]);
                if (tile == 0 && tid == 0) SC[uid * 4 + 2] = m;
                const float mn = fmaxf(bl + m, mloc), dec = __expf(bl + m - mn), sc = __expf(mloc - mn); m = mn;
#pragma unroll
                for (int i = 0; i < 4; ++i) { st[i] = dec * st[i] + sc * u0[i]; st[4 + i] = dec * st[4 + i] + sc * u1[i]; } }
        } else if (tile == 0 && tid < 192) {
            const int d = tid - 128; float n = 0.f, m = 0.f;
#pragma unroll 4
            for (int c = 0; c < 64; ++c) { const size_t uid = (size_t)chain * 64 + c; const float bl = SC[uid * 4 + 0], mloc = SC[uid * 4 + 1]; const float nu = NU[uid * 64 + d];
                NP[uid * 64 + d] = n; const float mn = fmaxf(bl + m, mloc), dec = __expf(bl + m - mn), sc = __expf(mloc - mn); m = mn; n = dec * n + sc * nu; }
        }
    }
}
__device__ __forceinline__ void mlstm_passC(ArgsP a, int l, LAS unsigned char* lds, const bf16_t* proj, const float* gsm, bf16_t* H, unsigned char* mxb, unsigned char* mxs, int first, int stride) {
    int tid_ = threadIdx.x; asm volatile("" : "+v"(tid_)); const int tid = tid_, lane = tid & 63, wave = __builtin_amdgcn_readfirstlane(tid >> 6), r = lane & 31, hh = lane >> 5;
    LAS bf16_t* qb = (LAS bf16_t*)(lds);
    LAS bf16_t* kb = (LAS bf16_t*)(lds + 9216);
    LAS bf16_t* vT = (LAS bf16_t*)(lds + 18432);
    LAS bf16_t* ob = (LAS bf16_t*)(lds + 36864);
    LAS bf16_t* outb = (LAS bf16_t*)(lds + 54272);
    LAS float* tb_rt = (LAS float*)(lds + 70656);
    LAS float* tb_ct = tb_rt + 64;
    LAS float* tb_iw = tb_rt + 128;
    LAS float* tb_em = tb_rt + 192;
    LAS float* tb_np = tb_rt + 256;
    LAS float* ssq = tb_rt + 320;
    const float* NP = (const float*)(mxs + MXS_ML_NP); const float* SC = (const float*)(mxs + MXS_ML_SC);
    const f32x4 ib4 = *(const f32x4*)(a->in[I_MIB] + l * 4), fb4 = *(const f32x4*)(a->in[I_MFB] + l * 4);
    LAS float* gnl = tb_rt + 640;
    gnl[tid] = a->in[I_MNG][(size_t)l * 512 + tid];
    u32x4 pq, pk, po[2], pv0, pv1; float pgf = 0.f, pgi = 0.f, pmp = 0.f, pnp = 0.f;
#define MLC_ISSUE(u_) do { const int c_ = (u_) & 63, hd_ = ((u_) >> 6) & 3, b_ = (u_) >> 8; const size_t k0_ = (size_t)b_ * SEQ_ + (size_t)c_ * 64; const int row_ = tid >> 3, c8_ = (tid & 7) * 8; \
        pq = *(const u32x4*)(proj + (k0_ + row_) * NPROJ + PC_MLQ + hd_ * 64 + c8_); pk = *(const u32x4*)(proj + (k0_ + row_) * NPROJ + PC_MLK + hd_ * 64 + c8_); \
        _Pragma("unroll") for (int i = 0; i < 2; ++i) { const int pid = tid + 512 * i; po[i] = *(const u32x4*)(proj + (k0_ + (pid >> 4)) * NPROJ + PC_MLO + hd_ * 128 + (pid & 15) * 8); } \
        pv0 = *(const u32x4*)(proj + (k0_ + lane) * NPROJ + PC_MLV + hd_ * 128 + wave * 8); pv1 = *(const u32x4*)(proj + (k0_ + lane) * NPROJ + PC_MLV + hd_ * 128 + 64 + wave * 8); \
        if (wave == 0) { pgf = gsm[(k0_ + lane) * 32 + 4 + hd_]; pgi = gsm[(k0_ + lane) * 32 + hd_]; pmp = SC[(size_t)(u_) * 4 + 2]; pnp = NP[(size_t)(u_) * 64 + lane]; } } while (0)
    if (first < 2048) MLC_ISSUE(first);
    for (int uid = first; uid < 2048; uid += stride) {
        const int c = uid & 63, hd = (uid >> 6) & 3, b = uid >> 8; const size_t tok0 = (size_t)b * SEQ_ + (size_t)c * 64;
        __syncthreads();
        if (wave == 0) {
            const float ib = hd == 0 ? ib4[0] : (hd == 1 ? ib4[1] : (hd == 2 ? ib4[2] : ib4[3])), fb = hd == 0 ? fb4[0] : (hd == 1 ? fb4[1] : (hd == 2 ? fb4[2] : fb4[3]));
            const float fpre = pgf + fb, ipre = pgi + ib;
            const float logf = -softplus_f(-fpre); const float bc = wave_incl_sum(logf, lane);
            const float rt = ipre - bc; const float cmx = wave_incl_max(rt, lane); const float mprev = pmp;
            const float mt = bc + fmaxf(mprev, cmx);
            tb_rt[lane] = rt; tb_ct[lane] = bc - mt; tb_iw[lane] = __expf(bc + mprev - mt); tb_em[lane] = __expf(-mt); tb_np[lane] = pnp;
        }
        { const int row = tid >> 3, c8 = (tid & 7) * 8;
          *(LAS u32x4*)(qb + row * 72 + c8) = pq; *(LAS u32x4*)(kb + row * 72 + c8) = pk;
#pragma unroll
          for (int i = 0; i < 2; ++i) { const int pid = tid + 512 * i; *(LAS u32x4*)(ob + (pid >> 4) * 136 + (pid & 15) * 8) = po[i]; }
          const unsigned v0[4] = {pv0.x, pv0.y, pv0.z, pv0.w}, v1[4] = {pv1.x, pv1.y, pv1.z, pv1.w};
#pragma unroll
          for (int j = 0; j < 4; ++j) { vT[(wave * 8 + 2 * j) * 72 + lane] = (bf16_t)(v0[j] & 0xffffu); vT[(wave * 8 + 2 * j + 1) * 72 + lane] = (bf16_t)(v0[j] >> 16);
              vT[(64 + wave * 8 + 2 * j) * 72 + lane] = (bf16_t)(v1[j] & 0xffffu); vT[(64 + wave * 8 + 2 * j + 1) * 72 + lane] = (bf16_t)(v1[j] >> 16); } }
        if (uid + stride < 2048) MLC_ISSUE(uid + stride);
        __syncthreads();
        const int eI = wave >> 1, tJ = wave & 1; const int t = 32 * tJ + r;
        f32x16 as[2];
#pragma unroll
        for (int sI = 0; sI < 2; ++sI) {
#pragma unroll
            for (int i = 0; i < 16; ++i) as[sI][i] = 0.f;
#pragma unroll
            for (int ks = 0; ks < 4; ++ks) { const bf16x8 af = *(const LAS bf16x8*)(kb + (32 * sI + r) * 72 + 16 * ks + 8 * hh), bf = *(const LAS bf16x8*)(qb + t * 72 + 16 * ks + 8 * hh);
                as[sI] = __builtin_amdgcn_mfma_f32_32x32x16_bf16(af, bf, as[sI], 0, 0, 0); } }
        const float ctt = tb_ct[t], iwt = tb_iw[t] * 0.125f, emt = tb_em[t];
        float dsum = 0.f;
#pragma unroll
        for (int sI = 0; sI < 2; ++sI)
#pragma unroll
            for (int q = 0; q < 4; ++q) { const int s0 = 32 * sI + 8 * q + 4 * hh; const f32x4 rt4 = *(const LAS f32x4*)(tb_rt + s0);
#pragma unroll
                for (int i = 0; i < 4; ++i) { const float wv = (s0 + i <= t) ? as[sI][4 * q + i] * 0.125f * __expf(ctt + rt4[i]) : 0.f; as[sI][4 * q + i] = wv; dsum += wv; } }
        float qn = 0.f;
#pragma unroll
        for (int j = 0; j < 4; ++j) { const u32x4 qw = *(const LAS u32x4*)(qb + t * 72 + 32 * hh + 8 * j); const f32x4 n0 = *(const LAS f32x4*)(tb_np + 32 * hh + 8 * j), n1 = *(const LAS f32x4*)(tb_np + 32 * hh + 8 * j + 4);
            qn += bflo(qw.x) * n0[0] + bfhi(qw.x) * n0[1] + bflo(qw.y) * n0[2] + bfhi(qw.y) * n0[3] + bflo(qw.z) * n1[0] + bfhi(qw.z) * n1[1] + bflo(qw.w) * n1[2] + bfhi(qw.w) * n1[3]; }
        float den = dsum + iwt * qn; den += __shfl_xor(den, 32);
        f32x16 an;
#pragma unroll
        for (int i = 0; i < 16; ++i) an[i] = 0.f;
#pragma unroll
        for (int sI = 0; sI < 2; ++sI)
#pragma unroll
            for (int s2 = 0; s2 < 2; ++s2) { const bf16x8 af = ld_perm(vT + (32 * eI + r) * 72 + 32 * sI + 16 * s2 + 4 * hh);
                const bf16x8 bf = pack8(as[sI][8 * s2], as[sI][8 * s2 + 1], as[sI][8 * s2 + 2], as[sI][8 * s2 + 3], as[sI][8 * s2 + 4], as[sI][8 * s2 + 5], as[sI][8 * s2 + 6], as[sI][8 * s2 + 7]);
                an = __builtin_amdgcn_mfma_f32_32x32x16_bf16(af, bf, an, 0, 0, 0); }
        const bf16_t* cpd = (const bf16_t*)(mxb + MXB_ML_CP) + (size_t)uid * 8 * 1024;
#pragma unroll
        for (int dI = 0; dI < 2; ++dI)
#pragma unroll
            for (int s2 = 0; s2 < 2; ++s2) { const bf16x8 af = *(const bf16x8*)(cpd + (size_t)(dI * 4 + eI) * 1024 + (s2 * 64 + lane) * 8);
                const u32x4 qw = __builtin_bit_cast(u32x4, ld_perm(qb + t * 72 + 32 * dI + 16 * s2 + 4 * hh));
                const bf16x8 bf = pack8(bflo(qw.x) * iwt, bfhi(qw.x) * iwt, bflo(qw.y) * iwt, bfhi(qw.y) * iwt, bflo(qw.z) * iwt, bfhi(qw.z) * iwt, bflo(qw.w) * iwt, bfhi(qw.w) * iwt);
                an = __builtin_amdgcn_mfma_f32_32x32x16_bf16(af, bf, an, 0, 0, 0); }
        const float dinv = 1.0f / fmaxf(fabsf(den), emt);
        float sq = 0.f;
#pragma unroll
        for (int i = 0; i < 16; ++i) { an[i] *= dinv; sq += an[i] * an[i]; }
        sq += __shfl_xor(sq, 32);
        if (hh == 0) ssq[eI * 64 + t] = sq;
        __syncthreads();
        const float tot = ssq[t] + ssq[64 + t] + ssq[128 + t] + ssq[192 + t];
        const float rinv = rsqrtf(tot * (1.0f / 128.0f) + RMS_EPS);
        const LAS float* gn = gnl + hd * 128;
#pragma unroll
        for (int q = 0; q < 4; ++q) { const int e0 = 32 * eI + 8 * q + 4 * hh; const f32x4 g4 = *(const LAS f32x4*)(gn + e0); const u32x2 ow = *(const LAS u32x2*)(ob + t * 136 + e0);
            const float o0 = an[4 * q] * rinv * g4[0] * sigmoid_f(bflo(ow.x)), o1 = an[4 * q + 1] * rinv * g4[1] * sigmoid_f(bfhi(ow.x));
            const float o2 = an[4 * q + 2] * rinv * g4[2] * sigmoid_f(bflo(ow.y)), o3 = an[4 * q + 3] * rinv * g4[3] * sigmoid_f(bfhi(ow.y));
            u32x2 pw; pw.x = pg8::cvt_pk_bf16(o0, o1); pw.y = pg8::cvt_pk_bf16(o2, o3); *(LAS u32x2*)(outb + t * 128 + e0) = pw; }
        __syncthreads();
#pragma unroll
        for (int i = 0; i < 2; ++i) { const int pid = tid + 512 * i; const int row = pid >> 4, c8 = (pid & 15) * 8;
            *(u32x4*)(H + (tok0 + row) * 2048 + 1024 + hd * 128 + c8) = *(const LAS u32x4*)(outb + row * 128 + c8); }
    }
#undef MLC_ISSUE
}
constexpr size_t MXB_GD_ND = 96 * MiB, MXB_GD_OD = 160 * MiB, MXB_GD_T = 224 * MiB;
constexpr size_t MXT_GD_XD = 8 * MiB, MXT_GD_QD = 40 * MiB, MXT_GD_SD = 72 * MiB;
constexpr size_t MXS_GD_GL = 7 * MiB + 64 * 1024;

__device__ __forceinline__ void conv_silu8(const u32x4 (&rw)[4], const float* cw, float (&o)[8]) {
#pragma unroll
    for (int j = 0; j < 8; ++j) o[j] = 0.f;
#pragma unroll
    for (int i = 0; i < 4; ++i) { const f32x4 w0 = *(const f32x4*)(cw + i * 1536), w1 = *(const f32x4*)(cw + i * 1536 + 4); const unsigned x[4] = {rw[i].x, rw[i].y, rw[i].z, rw[i].w};
        o[0] += w0[0] * bflo(x[0]); o[1] += w0[1] * bfhi(x[0]); o[2] += w0[2] * bflo(x[1]); o[3] += w0[3] * bfhi(x[1]);
        o[4] += w1[0] * bflo(x[2]); o[5] += w1[1] * bfhi(x[2]); o[6] += w1[2] * bflo(x[3]); o[7] += w1[3] * bfhi(x[3]); }
#pragma unroll
    for (int j = 0; j < 8; ++j) o[j] = silu_f(o[j]);
}
__device__ __forceinline__ void conv_silu8_l(const u32x4 (&rw)[4], const LAS float* cw, int stride, float (&o)[8]) {
#pragma unroll
    for (int j = 0; j < 8; ++j) o[j] = 0.f;
#pragma unroll
    for (int i = 0; i < 4; ++i) { const f32x4 w0 = *(const LAS f32x4*)(cw + i * stride), w1 = *(const LAS f32x4*)(cw + i * stride + 4); const unsigned x[4] = {rw[i].x, rw[i].y, rw[i].z, rw[i].w};
        o[0] += w0[0] * bflo(x[0]); o[1] += w0[1] * bfhi(x[0]); o[2] += w0[2] * bflo(x[1]); o[3] += w0[3] * bfhi(x[1]);
        o[4] += w1[0] * bflo(x[2]); o[5] += w1[1] * bfhi(x[2]); o[6] += w1[2] * bflo(x[3]); o[7] += w1[3] * bfhi(x[3]); }
#pragma unroll
    for (int j = 0; j < 8; ++j) o[j] = silu_f(o[j]);
}
__device__ __forceinline__ void load_rows4(const bf16_t* proj, int b, int tl, int col, u32x4 (&rw)[4]) {
#pragma unroll
    for (int i = 0; i < 4; ++i) { const int tt = tl - 3 + i; rw[i] = (u32x4){0u, 0u, 0u, 0u}; if (tt >= 0) rw[i] = *(const u32x4*)(proj + ((size_t)b * SEQ_ + tt) * NPROJ + col); }
}

__device__ __forceinline__ void gdn_passA1(ArgsP a, int l, LAS unsigned char* lds, const bf16_t* proj, const float* gsm, unsigned char* mxb, int G) {
    int tid_ = threadIdx.x; asm volatile("" : "+v"(tid_)); const int tid = tid_, lane = tid & 63, wave = __builtin_amdgcn_readfirstlane(tid >> 6), r = lane & 31, hh = lane >> 5;
    LAS unsigned char* wl = lds + wave * 16384;
    LAS bf16_t* kb = (LAS bf16_t*)wl;
    LAS float* am = (LAS float*)wl;
    LAS float* tb = (LAS float*)(lds + MISC_OFF + 1024 + wave * 512);
    LAS float* cwl = (LAS float*)(lds + MISC_OFF + 8192);
    { const float* cwk = a->in[I_GCW] + (size_t)l * 4 * 1536 + 512; for (int i = tid; i < 2048; i += 512) cwl[i] = cwk[(i >> 9) * 1536 + (i & 511)]; }
    LAS float* gpl = (LAS float*)(lds + MISC_OFF + 8192 + 8192);
    if (tid < 8) { gpl[tid] = -__expf(a->in[I_GAL][l * 8 + tid]); gpl[8 + tid] = a->in[I_GDT][l * 8 + tid]; }
    __syncthreads();
    for (int uid = blockIdx.x * NWAVES + wave; uid < 4096; uid += G * NWAVES) {
        const int c = uid & 63, hd = (uid >> 6) & 7, b = uid >> 9; const int tl = c * 64 + lane; const size_t tok = (size_t)b * SEQ_ + tl;
        float ss = 0.f;
        const float ga_ = gsm[tok * 32 + 8 + hd], gb_ = gsm[tok * 32 + 16 + hd];
#pragma unroll
        for (int ph = 0; ph < 2; ++ph) {
            u32x4 rw[4][4];
#pragma unroll
            for (int p = 0; p < 4; ++p) load_rows4(proj, b, tl, PC_GDK + hd * 64 + 8 * (4 * ph + p), rw[p]);
#pragma unroll
            for (int p = 0; p < 4; ++p) { float o[8]; conv_silu8_l(rw[p], cwl + hd * 64 + 8 * (4 * ph + p), 512, o);
#pragma unroll
                for (int j = 0; j < 8; ++j) ss += o[j] * o[j];
                *(LAS bf16x8*)(kb + lane * 72 + 8 * (4 * ph + p)) = pack8(o[0], o[1], o[2], o[3], o[4], o[5], o[6], o[7]); } }
        const float rn = rsqrtf(ss + RMS_EPS);
        const float gg = gpl[hd] * softplus_f(ga_ + gpl[8 + hd]);
        const float gc = wave_incl_sum(gg, lane), beta = 1.f / (1.f + __expf(-gb_));
        tb[lane] = gc; tb[64 + lane] = beta * rn;
        LDS_WAIT(); asm volatile("" ::: "memory");
        bf16x8 kf[2][4];
#pragma unroll
        for (int I = 0; I < 2; ++I)
#pragma unroll
            for (int ks = 0; ks < 4; ++ks) kf[I][ks] = *(const LAS bf16x8*)(kb + (32 * I + r) * 72 + 16 * ks + 8 * hh);
        LDS_WAIT(); asm volatile("" ::: "memory");
#pragma unroll
        for (int I = 0; I < 2; ++I)
#pragma unroll
            for (int J = 0; J < 2; ++J) { f32x16 acc;
#pragma unroll
                for (int i = 0; i < 16; ++i) acc[i] = 0.f;
#pragma unroll
                for (int ks = 0; ks < 4; ++ks) acc = __builtin_amdgcn_mfma_f32_32x32x16_bf16(kf[I][ks], kf[J][ks], acc, 0, 0, 0);
                const int s = 32 * J + r; const float gcs = __shfl(gc, s), rns = __shfl(rn, s);
#pragma unroll
                for (int q = 0; q < 4; ++q) { const int t0 = 32 * I + 8 * q + 4 * hh; const f32x4 gct = *(const LAS f32x4*)(tb + t0), brt = *(const LAS f32x4*)(tb + 64 + t0);
#pragma unroll
                    for (int i = 0; i < 4; ++i) { const float v = (s < t0 + i) ? acc[4 * q + i] * brt[i] * rns * __expf(gct[i] - gcs) : 0.f; am[(t0 + i) * 64 + s] = v; } } }
        LDS_WAIT(); asm volatile("" ::: "memory");
        float Tc[64];
#pragma unroll
        for (int i = 0; i < 64; ++i) { float acc = (i == lane) ? 1.f : 0.f;
#pragma unroll
            for (int j4 = 0; j4 < (i + 3) / 4; ++j4) { const f32x4 av = *(const LAS f32x4*)(am + i * 64 + 4 * j4);
#pragma unroll
                for (int jj = 0; jj < 4; ++jj) if (4 * j4 + jj < i) acc -= av[jj] * Tc[4 * j4 + jj]; }
            Tc[i] = acc; }
        bf16_t* Tg = (bf16_t*)(mxb + MXB_GD_T) + (size_t)uid * 4096;
#pragma unroll
        for (int i = 0; i < 64; ++i) Tg[i * 64 + lane] = (bf16_t)f2bf(Tc[i]);
    }
}

__device__ __forceinline__ void gdn_passA2(ArgsP a, int l, LAS unsigned char* lds, const bf16_t* proj, const float* gsm, unsigned char* mxb, unsigned char* mxt, unsigned char* mxs, int G) {
    int tid_ = threadIdx.x; asm volatile("" : "+v"(tid_)); const int tid = tid_, lane = tid & 63, wave = __builtin_amdgcn_readfirstlane(tid >> 6), r = lane & 31, hh = lane >> 5;
    LAS bf16_t* qb = (LAS bf16_t*)(lds);
    LAS bf16_t* kb = (LAS bf16_t*)(lds + 9216);
    LAS bf16_t* bvT = (LAS bf16_t*)(lds + 18432);
    LAS bf16_t* bkT = (LAS bf16_t*)(lds + 27648);
    LAS bf16_t* Tm = (LAS bf16_t*)(lds + 36864);
    LAS bf16_t* wT = (LAS bf16_t*)(lds + 46080);
    LAS bf16_t* uT = (LAS bf16_t*)(lds + 55296);
    LAS bf16_t* kdT = (LAS bf16_t*)(lds + 64512);
    LAS float* tb_gc = (LAS float*)(lds + 73728);
    LAS float* tb_beta = tb_gc + 64;
    LAS float* ssq = tb_gc + 128;
    LAS float* cw = (LAS float*)(lds + 81920);
    { const float* cwg = a->in[I_GCW] + (size_t)l * 4 * 1536; for (int i = tid; i < 6144; i += 512) cw[i] = cwg[i]; }
    LAS float* gpl = cw + 6144;
    if (tid < 8) { gpl[tid] = -__expf(a->in[I_GAL][l * 8 + tid]); gpl[8 + tid] = a->in[I_GDT][l * 8 + tid]; }
    float* GL = (float*)(mxs + MXS_GD_GL);
    u32x4 rq[4], rk[4], rv[4], tp; float pga = 0.f, pgb = 0.f;
#define GA2_ISSUE(u_) do { const int c_ = (u_) & 63, hd_ = ((u_) >> 6) & 7, b_ = (u_) >> 9; const int tl_ = c_ * 64 + lane; const size_t tok_ = (size_t)b_ * SEQ_ + tl_; \
        load_rows4(proj, b_, tl_, PC_GDQ + hd_ * 64 + 8 * wave, rq); load_rows4(proj, b_, tl_, PC_GDK + hd_ * 64 + 8 * wave, rk); load_rows4(proj, b_, tl_, PC_GDV + hd_ * 64 + 8 * wave, rv); \
        pga = gsm[tok_ * 32 + 8 + hd_]; pgb = gsm[tok_ * 32 + 16 + hd_]; \
        tp = *(const u32x4*)((const bf16_t*)(mxb + MXB_GD_T) + (size_t)(u_) * 4096 + (tid >> 3) * 64 + (tid & 7) * 8); } while (0)
    if ((int)blockIdx.x < 4096) GA2_ISSUE((int)blockIdx.x);
    for (int uid = blockIdx.x; uid < 4096; uid += G) {
        const int hd = (uid >> 6) & 7;
        __syncthreads();
        { const float gg = gpl[hd] * softplus_f(pga + gpl[8 + hd]);
          const float gc = wave_incl_sum(gg, lane);
          if (wave == 0) { tb_gc[lane] = gc; tb_beta[lane] = 1.f / (1.f + __expf(-pgb)); if (lane == 63) GL[uid] = __expf(gc); } }
        float qo[8], ko[8], vo[8];
        conv_silu8_l(rq, cw + hd * 64 + 8 * wave, 1536, qo); conv_silu8_l(rk, cw + 512 + hd * 64 + 8 * wave, 1536, ko); conv_silu8_l(rv, cw + 1024 + hd * 64 + 8 * wave, 1536, vo);
        { float sq = 0.f, sk = 0.f;
#pragma unroll
          for (int j = 0; j < 8; ++j) { sq += qo[j] * qo[j]; sk += ko[j] * ko[j]; }
          ssq[wave * 64 + lane] = sq; ssq[512 + wave * 64 + lane] = sk; }
        *(LAS u32x4*)(Tm + (tid >> 3) * 72 + (tid & 7) * 8) = tp;
        if (uid + G < 4096) GA2_ISSUE(uid + G);
        __syncthreads();
        { float sq = 0.f, sk = 0.f;
#pragma unroll
          for (int w = 0; w < 8; ++w) { sq += ssq[w * 64 + lane]; sk += ssq[512 + w * 64 + lane]; }
          const float rq = rsqrtf(sq + RMS_EPS) * 0.125f, rk = rsqrtf(sk + RMS_EPS);
          const float gc = tb_gc[lane], beta = tb_beta[lane], gl_ = tb_gc[63];
          const float e1 = beta * __expf(gc), e2 = __expf(gl_ - gc);
#pragma unroll
          for (int j = 0; j < 8; ++j) { qo[j] *= rq; ko[j] *= rk; }
          *(LAS bf16x8*)(qb + lane * 72 + 8 * wave) = pack8(qo[0], qo[1], qo[2], qo[3], qo[4], qo[5], qo[6], qo[7]);
          *(LAS bf16x8*)(kb + lane * 72 + 8 * wave) = pack8(ko[0], ko[1], ko[2], ko[3], ko[4], ko[5], ko[6], ko[7]);
#pragma unroll
          for (int j = 0; j < 8; ++j) { const int d = 8 * wave + j;
              bvT[d * 72 + lane] = (bf16_t)f2bf(beta * vo[j]); bkT[d * 72 + lane] = (bf16_t)f2bf(e1 * ko[j]); kdT[d * 72 + lane] = (bf16_t)f2bf(e2 * ko[j]); } }
        __syncthreads();
        { const int mat = wave >> 2, I = (wave >> 1) & 1, J = wave & 1; const LAS bf16_t* Am = mat ? bkT : bvT; LAS bf16_t* Om = mat ? wT : uT;
          f32x16 acc;
#pragma unroll
          for (int i = 0; i < 16; ++i) acc[i] = 0.f;
#pragma unroll
          for (int ks = 0; ks < 4; ++ks) { const bf16x8 af = *(const LAS bf16x8*)(Am + (32 * I + r) * 72 + 16 * ks + 8 * hh), bf = *(const LAS bf16x8*)(Tm + (32 * J + r) * 72 + 16 * ks + 8 * hh);
              acc = __builtin_amdgcn_mfma_f32_32x32x16_bf16(af, bf, acc, 0, 0, 0); }
#pragma unroll
          for (int q = 0; q < 4; ++q)
#pragma unroll
              for (int i = 0; i < 4; ++i) Om[(32 * I + 8 * q + 4 * hh + i) * 72 + 32 * J + r] = (bf16_t)f2bf(acc[4 * q + i]); }
        __syncthreads();
        if (wave < 4) {
            const int I = (wave >> 1) & 1, J = wave & 1;
            f32x16 ax, an;
#pragma unroll
            for (int i = 0; i < 16; ++i) { ax[i] = 0.f; an[i] = 0.f; }
#pragma unroll
            for (int ks = 0; ks < 4; ++ks) { const bf16x8 wf = *(const LAS bf16x8*)(wT + (32 * I + r) * 72 + 16 * ks + 8 * hh), kdf_b = *(const LAS bf16x8*)(kdT + (32 * J + r) * 72 + 16 * ks + 8 * hh);
                ax = __builtin_amdgcn_mfma_f32_32x32x16_bf16(wf, kdf_b, ax, 0, 0, 0);
                const bf16x8 kdf_a = *(const LAS bf16x8*)(kdT + (32 * I + r) * 72 + 16 * ks + 8 * hh), uf = *(const LAS bf16x8*)(uT + (32 * J + r) * 72 + 16 * ks + 8 * hh);
                an = __builtin_amdgcn_mfma_f32_32x32x16_bf16(kdf_a, uf, an, 0, 0, 0); }
            bf16_t* xd = (bf16_t*)(mxt + MXT_GD_XD) + (size_t)uid * 4096 + (size_t)(I * 2 + J) * 1024;
#pragma unroll
            for (int s2 = 0; s2 < 2; ++s2) *(bf16x8*)(xd + (s2 * 64 + lane) * 8) = pack8(-ax[8 * s2], -ax[8 * s2 + 1], -ax[8 * s2 + 2], -ax[8 * s2 + 3], -ax[8 * s2 + 4], -ax[8 * s2 + 5], -ax[8 * s2 + 6], -ax[8 * s2 + 7]);
            float* nd = (float*)(mxb + MXB_GD_ND) + (size_t)uid * 4096 + (size_t)(I * 2 + J) * 1024;
#pragma unroll
            for (int q = 0; q < 4; ++q) *(f32x4*)(nd + (q * 64 + lane) * 4) = (f32x4){an[4 * q], an[4 * q + 1], an[4 * q + 2], an[4 * q + 3]};
        } else {
            const int I = (wave >> 1) & 1, tJ = wave & 1; const int t = 32 * tJ + r; const float gct = tb_gc[t];
            bf16x8 pf[2][2];
#pragma unroll
            for (int sI = 0; sI < 2; ++sI) { f32x16 ap;
#pragma unroll
                for (int i = 0; i < 16; ++i) ap[i] = 0.f;
#pragma unroll
                for (int ks = 0; ks < 4; ++ks) { const bf16x8 af = *(const LAS bf16x8*)(kb + (32 * sI + r) * 72 + 16 * ks + 8 * hh), bf = *(const LAS bf16x8*)(qb + t * 72 + 16 * ks + 8 * hh);
                    ap = __builtin_amdgcn_mfma_f32_32x32x16_bf16(af, bf, ap, 0, 0, 0); }
#pragma unroll
                for (int q = 0; q < 4; ++q) { const int s0 = 32 * sI + 8 * q + 4 * hh; const f32x4 gcs = *(const LAS f32x4*)(tb_gc + s0);
#pragma unroll
                    for (int i = 0; i < 4; ++i) ap[4 * q + i] = (s0 + i <= t) ? ap[4 * q + i] * __expf(gct - gcs[i]) : 0.f; }
#pragma unroll
                for (int s2 = 0; s2 < 2; ++s2) pf[sI][s2] = pack8(ap[8 * s2], ap[8 * s2 + 1], ap[8 * s2 + 2], ap[8 * s2 + 3], ap[8 * s2 + 4], ap[8 * s2 + 5], ap[8 * s2 + 6], ap[8 * s2 + 7]); }
            f32x16 aq, ao;
#pragma unroll
            for (int i = 0; i < 16; ++i) { aq[i] = 0.f; ao[i] = 0.f; }
#pragma unroll
            for (int sI = 0; sI < 2; ++sI)
#pragma unroll
                for (int s2 = 0; s2 < 2; ++s2) { const bf16x8 wf = ld_perm(wT + (32 * I + r) * 72 + 32 * sI + 16 * s2 + 4 * hh), uf = ld_perm(uT + (32 * I + r) * 72 + 32 * sI + 16 * s2 + 4 * hh);
                    aq = __builtin_amdgcn_mfma_f32_32x32x16_bf16(wf, pf[sI][s2], aq, 0, 0, 0); ao = __builtin_amdgcn_mfma_f32_32x32x16_bf16(uf, pf[sI][s2], ao, 0, 0, 0); }
            const float egt = __expf(gct);
#pragma unroll
            for (int q = 0; q < 4; ++q) { const int d0 = 32 * I + 8 * q + 4 * hh; const u32x2 qw = *(const LAS u32x2*)(qb + t * 72 + d0);
                aq[4 * q] = bflo(qw.x) * egt - aq[4 * q]; aq[4 * q + 1] = bfhi(qw.x) * egt - aq[4 * q + 1]; aq[4 * q + 2] = bflo(qw.y) * egt - aq[4 * q + 2]; aq[4 * q + 3] = bfhi(qw.y) * egt - aq[4 * q + 3]; }
            bf16_t* qd = (bf16_t*)(mxt + MXT_GD_QD) + (size_t)uid * 4096 + (size_t)(I * 2 + tJ) * 1024;
#pragma unroll
            for (int s2 = 0; s2 < 2; ++s2) *(bf16x8*)(qd + (s2 * 64 + lane) * 8) = pack8(aq[8 * s2], aq[8 * s2 + 1], aq[8 * s2 + 2], aq[8 * s2 + 3], aq[8 * s2 + 4], aq[8 * s2 + 5], aq[8 * s2 + 6], aq[8 * s2 + 7]);
            float* od = (float*)(mxb + MXB_GD_OD) + (size_t)uid * 4096 + (size_t)(I * 2 + tJ) * 1024;
#pragma unroll
            for (int q = 0; q < 4; ++q) *(f32x4*)(od + (q * 64 + lane) * 4) = (f32x4){ao[4 * q], ao[4 * q + 1], ao[4 * q + 2], ao[4 * q + 3]};
        }
    }
}

__device__ __forceinline__ void gdn_passB(unsigned char* mxb, unsigned char* mxt, unsigned char* mxs, int nB) {
    int tid_ = threadIdx.x; asm volatile("" : "+v"(tid_)); const int tid = tid_, lane = tid & 63, wave = __builtin_amdgcn_readfirstlane(tid >> 6);
    const float* GL = (const float*)(mxs + MXS_GD_GL);
    if (wave >= 2) { lru_carry(mxs, ((int)blockIdx.x * 6 + (wave - 2)) * 64 + lane, nB * 6 * 64); return; }
    const int eJ = wave;
    for (int chain = blockIdx.x; chain < 64; chain += nB) {
        f32x16 S[2];
#pragma unroll
        for (int i = 0; i < 16; ++i) { S[0][i] = 0.f; S[1][i] = 0.f; }
        bf16x8 xn[2][2][2]; f32x4 nq[2][4]; float gln;
#define GDB_LOAD(c_) do { const size_t u_ = (size_t)chain * 64 + (c_); const bf16_t* xd_ = (const bf16_t*)(mxt + MXT_GD_XD) + u_ * 4096; const float* nd_ = (const float*)(mxb + MXB_GD_ND) + u_ * 4096; \
        _Pragma("unroll") for (int I = 0; I < 2; ++I) _Pragma("unroll") for (int J = 0; J < 2; ++J) _Pragma("unroll") for (int s2 = 0; s2 < 2; ++s2) xn[I][J][s2] = *(const bf16x8*)(xd_ + (size_t)(I * 2 + J) * 1024 + (s2 * 64 + lane) * 8); \
        _Pragma("unroll") for (int J = 0; J < 2; ++J) _Pragma("unroll") for (int q = 0; q < 4; ++q) nq[J][q] = *(const f32x4*)(nd_ + (size_t)(J * 2 + eJ) * 1024 + (q * 64 + lane) * 4); \
        gln = GL[u_]; } while (0)
        GDB_LOAD(0);
        for (int c = 0; c < 64; ++c) { const size_t uid = (size_t)chain * 64 + c;
            bf16x8 xf[2][2][2]; f32x16 nn[2]; const float gl = gln;
#pragma unroll
            for (int I = 0; I < 2; ++I)
#pragma unroll
                for (int J = 0; J < 2; ++J)
#pragma unroll
                    for (int s2 = 0; s2 < 2; ++s2) xf[I][J][s2] = xn[I][J][s2];
#pragma unroll
            for (int J = 0; J < 2; ++J)
#pragma unroll
                for (int q = 0; q < 4; ++q) { nn[J][4 * q] = nq[J][q][0]; nn[J][4 * q + 1] = nq[J][q][1]; nn[J][4 * q + 2] = nq[J][q][2]; nn[J][4 * q + 3] = nq[J][q][3]; }
            if (c + 1 < 64) GDB_LOAD(c + 1);
            bf16x8 sh[2][2];
            bf16_t* sd = (bf16_t*)(mxt + MXT_GD_SD) + uid * 4096;
#pragma unroll
            for (int I = 0; I < 2; ++I)
#pragma unroll
                for (int s2 = 0; s2 < 2; ++s2) { sh[I][s2] = pack8(S[I][8 * s2], S[I][8 * s2 + 1], S[I][8 * s2 + 2], S[I][8 * s2 + 3], S[I][8 * s2 + 4], S[I][8 * s2 + 5], S[I][8 * s2 + 6], S[I][8 * s2 + 7]);
                    *(bf16x8*)(sd + (size_t)(I * 2 + eJ) * 1024 + (s2 * 64 + lane) * 8) = sh[I][s2]; }
#pragma unroll
            for (int J = 0; J < 2; ++J) { f32x16 acc = nn[J];
#pragma unroll
                for (int I = 0; I < 2; ++I)
#pragma unroll
                    for (int s2 = 0; s2 < 2; ++s2) acc = __builtin_amdgcn_mfma_f32_32x32x16_bf16(xf[I][J][s2], sh[I][s2], acc, 0, 0, 0);
                nn[J] = acc; }
#pragma unroll
            for (int J = 0; J < 2; ++J)
#pragma unroll
                for (int i = 0; i < 16; ++i) S[J][i] = gl * S[J][i] + nn[J][i];
        }
    }
}

__device__ __forceinline__ void gdn_passC(ArgsP a, int l, LAS unsigned char* lds, const bf16_t* proj, bf16_t* H, unsigned char* mxb, unsigned char* mxt, int G) {
    int tid_ = threadIdx.x; asm volatile("" : "+v"(tid_)); const int tid = tid_, lane = tid & 63, wave = __builtin_amdgcn_readfirstlane(tid >> 6), r = lane & 31, hh = lane >> 5;
    LAS bf16_t* ob = (LAS bf16_t*)(lds + wave * 8192);
    f32x4 gnr[2][4];
#pragma unroll
    for (int eI = 0; eI < 2; ++eI)
#pragma unroll
        for (int q = 0; q < 4; ++q) gnr[eI][q] = *(const f32x4*)(a->in[I_GNG] + l * 64 + 32 * eI + 8 * q + 4 * hh);
    for (int wu = blockIdx.x * NWAVES + wave; wu < 8192; wu += G * NWAVES) {
        const int uid = wu >> 1, tJ = wu & 1; const int c = uid & 63, hd = (uid >> 6) & 7, b = uid >> 9; const size_t tok0 = (size_t)b * SEQ_ + (size_t)c * 64;
        const bf16_t* sd = (const bf16_t*)(mxt + MXT_GD_SD) + (size_t)uid * 4096; const bf16_t* qd = (const bf16_t*)(mxt + MXT_GD_QD) + (size_t)uid * 4096; const float* od = (const float*)(mxb + MXB_GD_OD) + (size_t)uid * 4096;
        f32x16 ao[2];
#pragma unroll
        for (int eI = 0; eI < 2; ++eI)
#pragma unroll
            for (int q = 0; q < 4; ++q) { const f32x4 v = *(const f32x4*)(od + (size_t)(eI * 2 + tJ) * 1024 + (q * 64 + lane) * 4); ao[eI][4 * q] = v[0]; ao[eI][4 * q + 1] = v[1]; ao[eI][4 * q + 2] = v[2]; ao[eI][4 * q + 3] = v[3]; }
#pragma unroll
        for (int dI = 0; dI < 2; ++dI)
#pragma unroll
            for (int s2 = 0; s2 < 2; ++s2) { const bf16x8 qf = *(const bf16x8*)(qd + (size_t)(dI * 2 + tJ) * 1024 + (s2 * 64 + lane) * 8);
#pragma unroll
                for (int eI = 0; eI < 2; ++eI) { const bf16x8 sf = *(const bf16x8*)(sd + (size_t)(dI * 2 + eI) * 1024 + (s2 * 64 + lane) * 8);
                    ao[eI] = __builtin_amdgcn_mfma_f32_32x32x16_bf16(sf, qf, ao[eI], 0, 0, 0); } }
        float sq = 0.f;
#pragma unroll
        for (int eI = 0; eI < 2; ++eI)
#pragma unroll
            for (int i = 0; i < 16; ++i) sq += ao[eI][i] * ao[eI][i];
        sq += __shfl_xor(sq, 32);
        const float rinv = rsqrtf(sq * (1.0f / 64.0f) + RMS_EPS);
        const size_t tok = tok0 + 32 * tJ + r;
#pragma unroll
        for (int eI = 0; eI < 2; ++eI)
#pragma unroll
            for (int q = 0; q < 4; ++q) { const int e0 = 32 * eI + 8 * q + 4 * hh; const f32x4 g4 = gnr[eI][q]; const u32x2 zw = *(const u32x2*)(proj + tok * NPROJ + PC_GDZ + hd * 64 + e0);
                u32x2 pw; pw.x = pg8::cvt_pk_bf16(ao[eI][4 * q] * rinv * g4[0] * silu_f(bflo(zw.x)), ao[eI][4 * q + 1] * rinv * g4[1] * silu_f(bfhi(zw.x)));
                pw.y = pg8::cvt_pk_bf16(ao[eI][4 * q + 2] * rinv * g4[2] * silu_f(bflo(zw.y)), ao[eI][4 * q + 3] * rinv * g4[3] * silu_f(bfhi(zw.y)));
                *(LAS u32x2*)(ob + r * 64 + e0) = pw; }
        LDS_WAIT(); asm volatile("" ::: "memory");
#pragma unroll
        for (int it = 0; it < 4; ++it) { const int row = it * 8 + (lane >> 3), c8 = (lane & 7) * 8;
            *(u32x4*)(H + (tok0 + 32 * tJ + row) * 2048 + 1536 + hd * 64 + c8) = *(const LAS u32x4*)(ob + row * 64 + c8); }
        LDS_WAIT(); asm volatile("" ::: "memory");
    }
}
constexpr int PPL = 12;
constexpr int NPH = 1 + PPL * DEPTH_;
#ifndef MK_N_LAUNCHES
#define MK_N_LAUNCHES 1
#endif
#ifndef PROBE_PH
#define PROBE_PH -2
#endif
#define REPS(k) ((PROBE_PH) == (k) ? 2 : 1)
#ifndef PG8_SP2
#define PG8_SP2 true
#endif
#ifndef PG8_ALIGN
#define PG8_ALIGN true
#endif
__global__ void __launch_bounds__(NWAVES * 64, 2) fwd(Args a_unused) {
    ArgsP kargs = (ArgsP)__builtin_amdgcn_kernarg_segment_ptr();
#define FRESH(a) ArgsP a = kargs; asm volatile("" : "+s"(a))
    extern __shared__ __attribute__((aligned(16))) unsigned char lds_raw[];
    LAS unsigned char* lds = (LAS unsigned char*)lds_raw;
    const int tid = threadIdx.x, G = gridDim.x;
    const int vcu = (G % 8 == 0) ? ((int)blockIdx.x % 8) * (G / 8) + (int)blockIdx.x / 8 : (int)blockIdx.x;
    for (int u = tid; u < (LDS_BYTES - MISC_OFF) / 4; u += NWAVES * 64) ((LAS unsigned*)(lds + MISC_OFF))[u] = 0u;
    __syncthreads();
    const int lo = kargs->ph_lo, hi = kargs->ph_hi;
    unsigned* barw = (unsigned*)(kargs->ws + WS_CTL) + CW_BAR + kargs->li * XCD_BAR_WORDS;
    if (hi - lo > 1) (void)xcd_barrier_post(barw, (volatile LAS unsigned*)(lds + LDS_BYTES - 16));
#define IN(k) (lo <= (k) && (k) < hi)
#define SEAM(k) do { if (IN(k) && IN((k) + 1)) { FRESH(ab_); XcdBarrier bb_; bb_.bar = (unsigned*)(ab_->ws + WS_CTL) + CW_BAR + ab_->li * XCD_BAR_WORDS; bb_.x = xb_xcc_id(); bb_.st = (volatile LAS unsigned*)(lds + LDS_BYTES - 16); xcd_barrier(bb_); } } while (0)
    if (IN(0)) for (int rep = 0; rep < REPS(-1); ++rep) { FRESH(a); p0_convert(a, lds, G); }
    SEAM(0);

    for (int l = 0; l < DEPTH_; ++l) {
        const int pb = 1 + PPL * l;
#define WSP(T_, off) ((T_*)(a->ws + (off)))
#define WL_(off) (a->ws + WS_W + (size_t)l * WL_STRIDE + (off))
        if (IN(pb + 0)) for (int rep = 0; rep < REPS(0); ++rep) { FRESH(a);
            { pg8::Gemm g{WSP(const bf16_t, WS_XB), (const bf16_t*)WL_(WL_IN), 1024, 1024, 1024}; pg8::StaticOrder S; S.init(T_, NIN_BF, G, (int)blockIdx.x);
              pg8::EpiProj E{WSP(bf16_t, WS_OV + OV_PROJ), WSP(float, WS_GSM)};
              pg8::gemm_phase<pg8::EpiProj, pg8::StaticOrder, PG8_ALIGN, PG8_SP2>(lds, g, S, E); }
            { pg8::Gemm8 g{WSP(const unsigned char, WS_X2), (const unsigned char*)WL_(WL_IN + WL_IN8), 1024, 1024, 1024}; pg8::P1F8Order S{G, (int)blockIdx.x};
              pg8::EpiProj8 E{WSP(bf16_t, WS_OV + OV_PROJ), WSP(bf16_t, WS_OV + OV_GD)};
              pg8::gemm_phase_f8<pg8::EpiProj8, pg8::P1F8Order, false>(lds, g, S, E); }
        }
        SEAM(pb + 0);

        if (IN(pb + 1)) for (int rep = 0; rep < REPS(1); ++rep) { FRESH(a);
            const bf16_t* proj = WSP(const bf16_t, WS_OV + OV_PROJ); bf16_t* Hb = WSP(bf16_t, WS_OV + OV_H); const float* gsm = WSP(const float, WS_GSM);
            for (int r2 = 0; r2 < REPS(11); ++r2) for (int u = (int)blockIdx.x; u < 256; u += G) lru_fast<0>(a, l, u >> 5, (u >> 2) & 7, (u & 3) * 16, (u & 3) * 16 + 16, lds, proj, Hb, a->ws + WS_MXS);
            for (int r2 = 0; r2 < REPS(12); ++r2) mlstm_passA(a, l, lds, proj, gsm, a->ws + WS_V, a->ws + WS_MXS, G);
            __syncthreads();
            for (int r2 = 0; r2 < REPS(13); ++r2) gdn_passA1(a, l, lds, proj, gsm, a->ws + WS_V, G);
        }
        SEAM(pb + 1);
        if (IN(pb + 2)) for (int rep = 0; rep < REPS(2); ++rep) { FRESH(a);
            const bf16_t* proj = WSP(const bf16_t, WS_OV + OV_PROJ); const float* gsm = WSP(const float, WS_GSM);
            for (int r2 = 0; r2 < REPS(22); ++r2) mlstm_passB(a->ws + WS_V, a->ws + WS_MXS, G); for (int r2 = 0; r2 < REPS(23); ++r2) gdn_passA2(a, l, lds, proj, gsm, a->ws + WS_V, a->ws + WS_MXS, a->ws + WS_MXS, G); }
        SEAM(pb + 2);
        if (IN(pb + 3)) for (int rep = 0; rep < REPS(3); ++rep) { FRESH(a);
            const bf16_t* proj = WSP(const bf16_t, WS_OV + OV_PROJ); bf16_t* Hb = WSP(bf16_t, WS_OV + OV_H); const float* gsm = WSP(const float, WS_GSM);
            const int nB = G >= 128 ? 64 : 0;
            if ((int)blockIdx.x < nB) { for (int r2 = 0; r2 < REPS(31); ++r2) gdn_passB(a->ws + WS_V, a->ws + WS_MXS, a->ws + WS_MXS, nB); }
            else {
                if (nB == 0) { gdn_passB(a->ws + WS_V, a->ws + WS_MXS, a->ws + WS_MXS, G); __syncthreads(); }
                for (int r2 = 0; r2 < REPS(33); ++r2) mlstm_passC(a, l, lds, proj, gsm, Hb, a->ws + WS_V, a->ws + WS_MXS, (int)blockIdx.x - nB, G - nB);
            }
        }
        SEAM(pb + 3);
        if (IN(pb + 4)) for (int rep = 0; rep < REPS(4); ++rep) { FRESH(a); gdn_passC(a, l, lds, WSP(const bf16_t, WS_OV + OV_PROJ), WSP(bf16_t, WS_OV + OV_H), a->ws + WS_V, a->ws + WS_MXS, G);
            for (int r2 = 0; r2 < REPS(32); ++r2) lru_apply(a, WSP(const bf16_t, WS_OV + OV_PROJ), WSP(bf16_t, WS_OV + OV_H), a->ws + WS_MXS, (int)blockIdx.x, G); }
        SEAM(pb + 4);

        if (IN(pb + 5)) for (int rep = 0; rep < REPS(5); ++rep) { FRESH(a);
            pg8::StaticOrder S; S.init(T_, 1024, G, (int)blockIdx.x);
            pg8::Gemm g{WSP(const bf16_t, WS_OV + OV_H), (const bf16_t*)WL_(WL_BR), 2048, 2048, 2048}; pg8::EpiMergeF E{WSP(const bf16_t, WS_OV + OV_GD), WSP(bf16_t, WS_MB)};
            pg8::gemm_phase<pg8::EpiMergeF, pg8::StaticOrder, PG8_ALIGN, PG8_SP2>(lds, g, S, E);
        }
        SEAM(pb + 5);

        if (IN(pb + 6)) for (int rep = 0; rep < REPS(6); ++rep) { FRESH(a);
            pg8::Gemm g{WSP(const bf16_t, WS_MB), (const bf16_t*)WL_(WL_OUT), 1024, 1024, 1024}; pg8::StaticOrder S; S.init(T_, 1024, G, (int)blockIdx.x);
            pg8::EpiWout E{l == 0 ? a->in[I_X] : (const float*)nullptr, WSP(const bf16_t, WS_XB), WSP(bf16_t, WS_V)};
            pg8::gemm_phase<pg8::EpiWout, pg8::StaticOrder, PG8_ALIGN, PG8_SP2>(lds, g, S, E);
        }
        SEAM(pb + 6);

        if (IN(pb + 7)) for (int rep = 0; rep < REPS(7); ++rep) { FRESH(a); p5_ln1_router(a, l, lds, G); }
        SEAM(pb + 7);

        if (IN(pb + 8)) for (int rep = 0; rep < REPS(8); ++rep) { FRESH(a); p6_slots(a, lds, G); }
        SEAM(pb + 8);

        if (IN(pb + 9)) for (int rep = 0; rep < REPS(9); ++rep) { FRESH(a);
            const int nb = moe_table(a, lds);
            pg8::MoeOrder S{8, G, vcu, nb * 8, (const LAS int*)(lds + MISC_OFF + 256)};
            { LAS int* gt = (LAS int*)(lds + GTAB_OFF); const int* tokb = WSP(const int, WS_TOKB);
              int tq_ = threadIdx.x; asm volatile("" : "+v"(tq_));
              for (int ui = 0; (long)ui * G + vcu < (long)nb * 8; ++ui) { const int pm = (int)(((long)ui * G + vcu) / 8); if (tq_ < 256) gt[ui * 256 + tq_] = tokb[(size_t)pm * 256 + tq_]; }
              __syncthreads(); }
            pg8::Gemm8 g{WSP(const unsigned char, WS_X1), (const unsigned char*)WL_(WL_W1), 1024, 1024, 1024};
            pg8::EpiMoe1F8 E{WSP(unsigned char, WS_OV + OV_ACT), a->in[I_B1] + (size_t)l * NE * 2048};
            pg8::gemm_phase_f8<pg8::EpiMoe1F8, pg8::MoeOrder, true>(lds, g, S, E, (const LAS int*)(lds + GTAB_OFF));
        }
        SEAM(pb + 9);

        if (IN(pb + 10)) for (int rep = 0; rep < REPS(10); ++rep) { FRESH(a);
            const int nb = moe_table(a, lds);
            pg8::MoeOrder S{4, G, vcu, nb * 4, (const LAS int*)(lds + MISC_OFF + 256)};
            pg8::Gemm8 g{WSP(const unsigned char, WS_OV + OV_ACT), (const unsigned char*)WL_(WL_W2), 1024, 1024, 1024};
            pg8::EpiMoe2F8 E{WSP(unsigned char, WS_OV + OV_YS), a->in[I_B2] + (size_t)l * NE * 1024, WSP(const float, WS_WBUF)};
            pg8::gemm_phase_f8<pg8::EpiMoe2F8, pg8::MoeOrder, false>(lds, g, S, E);
        }
        SEAM(pb + 10);

        if (IN(pb + 11)) for (int rep = 0; rep < REPS(11); ++rep) { FRESH(a); p9_combine_ln2(a, l, (l == DEPTH_ - 1) ? a->out : (float*)nullptr, G); }
        SEAM(pb + 11);
    }
#undef WSP
#undef WL_
#undef IN
#undef SEAM
}

extern "C" void kernel_launch(void* const* d_in, const int* in_sizes, int n_in, void* d_out, int out_size, void* d_ws, size_t ws_size, hipStream_t stream) {
    static int grid = 0;
    if (grid == 0) {
        if (n_in != 30 || in_sizes[0] != T_ * D_ || out_size != T_ * D_ || ws_size < WS_END) {
            fprintf(stderr, "kernel_launch: unexpected shapes: n_in %d in0 %d out %d ws %zu (need %zu); nothing launched\n", n_in, n_in > 0 ? in_sizes[0] : -1, out_size, ws_size, (size_t)WS_END); grid = -1; return; }
        int dev = 0, cus = 0;
        if (hipGetDevice(&dev) != hipSuccess || hipDeviceGetAttribute(&cus, hipDeviceAttributeMultiprocessorCount, dev) != hipSuccess) { grid = -1; return; }
        if (hipFuncSetAttribute((const void*)fwd, hipFuncAttributeMaxDynamicSharedMemorySize, LDS_BYTES) != hipSuccess) { fprintf(stderr, "kernel_launch: hipFuncSetAttribute failed\n"); grid = -1; return; }
        int per_cu = 0; (void)hipOccupancyMaxActiveBlocksPerMultiprocessor(&per_cu, (const void*)fwd, NWAVES * 64, LDS_BYTES); (void)hipGetLastError();
        if (per_cu < 1) fprintf(stderr, "kernel_launch: occupancy query reports %d blocks per CU\n", per_cu);
        grid = cus;
    }
    if (grid < 0) return;
    (void)hipMemsetAsync((char*)d_ws + WS_CTL, 0, CTL_ZERO_BYTES, stream);
    Args a{};
    for (int i = 0; i < 30; ++i) a.in[i] = (const float*)d_in[i];
    a.out = (float*)d_out; a.ws = (unsigned char*)d_ws;
    constexpr int NL = MK_N_LAUNCHES; static_assert(NL == NPH || NL <= 4, "barrier regions");
    for (int li = 0; li < NL; ++li) {
        a.ph_lo = (int)((long)NPH * li / NL); a.ph_hi = (int)((long)NPH * (li + 1) / NL); a.li = (NL <= 4) ? li : 0;
        hipLaunchKernelGGL(fwd, dim3(grid), dim3(NWAVES * 64), LDS_BYTES, stream, a);
        const hipError_t le = hipPeekAtLastError();
        if (le != hipSuccess) { fprintf(stderr, "kernel_launch: launch %d failed: %s\n", li, hipGetErrorName(le)); break; }
    }
}
```

```cpp
#include <hip/hip_runtime.h>
#include <cstdio>
#include <cstdint>

#define LAS __attribute__((address_space(3)))
#define GAS __attribute__((address_space(1)))
typedef unsigned short bf16_t;
typedef short bf16x8 __attribute__((ext_vector_type(8)));
typedef float f32x4 __attribute__((ext_vector_type(4)));
#ifndef PROBE_PH
#define PROBE_PH -2
#endif
typedef float f32x2 __attribute__((ext_vector_type(2)));
typedef unsigned u32x4 __attribute__((ext_vector_type(4)));
typedef unsigned u32x2 __attribute__((ext_vector_type(2)));

constexpr int T_ = 32768, D_ = 1024, SEQ_ = 4096, NBATCH = 8, DEPTH_ = 2;
constexpr int DIN = 8728, NPROJ = 5632, NINP = 8960;
constexpr int NE = 32, DFF = 1024;
constexpr int PMAX = 139264;
constexpr int NCHUNK = 256, CHTOK = 128;
constexpr float DN_ALPHA = 1.41421356237309515f;
constexpr float LN_EPS = 1e-5f, RMS_EPS = 1e-6f;
constexpr float F8_SX = 16.0f, F8_SW1 = 128.0f, F8_SA = 8.0f, F8_SW2 = 256.0f, F8_SWI = 128.0f, F8_SY = 64.0f;
constexpr int PC_LRUX = 0, PC_MLQ = 1024, PC_MLK = 1280, PC_MLV = 1536, PC_GDQ = 2048, PC_GDK = 2560, PC_GDV = 3072, PC_LRUY = 3584, PC_MLO = 4608, PC_GDZ = 5120;
constexpr int NIN_BF = 3840, NIN_F8 = 5120;
#ifndef P1_ALL_F8
#define P1_ALL_F8 1
#endif
constexpr size_t WL_IN8 = 8u << 20;

constexpr size_t MiB = 1u << 20;
constexpr size_t WS_CTL = 0, CTL_ZERO_BYTES = 64 * 1024;
constexpr size_t WS_HIST = 256 * 1024;
constexpr size_t WS_META = 320 * 1024;
constexpr size_t WS_RWB = 384 * 1024;
constexpr size_t WS_W = 1 * MiB;
constexpr size_t WL_IN = 0, WL_BR = 18 * MiB, WL_OUT = 22 * MiB, WL_W1 = 24 * MiB, WL_W2 = 152 * MiB, WL_G = 216 * MiB, WL_STRIDE = 217 * MiB;
constexpr size_t WS_XB = 436 * MiB;
constexpr size_t WS_GSM = 501 * MiB;
constexpr size_t WS_MB = 505 * MiB;
constexpr size_t WS_V = 569 * MiB;
constexpr size_t WS_X1 = 697 * MiB;
constexpr size_t WS_X1B = 825 * MiB;
constexpr size_t WS_X2 = 890 * MiB;
constexpr size_t WS_TKE = 1018 * MiB;
constexpr size_t WS_TKW = WS_TKE + 512 * 1024;
constexpr size_t WS_SLOT = 1019 * MiB;
constexpr size_t WS_WBUF = 1020 * MiB;
constexpr size_t WS_TOKB = 1021 * MiB;
constexpr size_t WS_OV = 1024 * MiB;
constexpr size_t OV_PROJ = 0, OV_GD = 352 * MiB, OV_H = 544 * MiB;
constexpr size_t OV_XS = 0, OV_ACT = 272 * MiB, OV_YS = 544 * MiB;
constexpr size_t WS_MXS = WS_OV + 816 * MiB;
constexpr size_t WS_END = WS_MXS + 104 * MiB;

constexpr int CW_BAR = 1024;

constexpr int RING_BYTES = 131072;
constexpr int MISC_OFF = RING_BYTES;
constexpr int GTAB_OFF = MISC_OFF + 4096;
constexpr int LDS_BYTES = 163840;
constexpr int NWAVES = 8;

#define LDS_WAIT() asm volatile("s_waitcnt lgkmcnt(0)" ::: "memory")
#define VM_WAIT() asm volatile("s_waitcnt vmcnt(0)" ::: "memory")

__device__ __forceinline__ unsigned f2bf(float f) { unsigned u = __builtin_bit_cast(unsigned, f); return (u + 0x7fffu + ((u >> 16) & 1u)) >> 16; }
typedef __bf16 bf16x2h __attribute__((ext_vector_type(2)));
__device__ __forceinline__ unsigned pk2(float lo, float hi) { const f32x2 v = {lo, hi}; return __builtin_bit_cast(unsigned, __builtin_convertvector(v, bf16x2h)); }
__device__ __forceinline__ float bf2f(unsigned short b) { return __builtin_bit_cast(float, (unsigned)b << 16); }
__device__ __forceinline__ float bflo(unsigned w) { return __builtin_bit_cast(float, w << 16); }
__device__ __forceinline__ float bfhi(unsigned w) { return __builtin_bit_cast(float, w & 0xffff0000u); }
__device__ __forceinline__ unsigned pk_fp8x4(float a, float b, float c, float d) { int p = __builtin_amdgcn_cvt_pk_fp8_f32(a, b, 0, false); p = __builtin_amdgcn_cvt_pk_fp8_f32(c, d, p, true); return (unsigned)p; }
__device__ __forceinline__ float wave_sum(float v) {
#pragma unroll
    for (int o = 1; o < 64; o <<= 1) v += __shfl_xor(v, o);
    return v;
}
__device__ __forceinline__ float wave_max(float v) {
#pragma unroll
    for (int o = 1; o < 64; o <<= 1) v = fmaxf(v, __shfl_xor(v, o));
    return v;
}
__device__ __forceinline__ float sigmoid_f(float x) { return __builtin_amdgcn_rcpf(1.f + __expf(-x)); }
__device__ __forceinline__ float silu_f(float x) { return x * __builtin_amdgcn_rcpf(1.f + __expf(-x)); }
__device__ __forceinline__ float neg_expm1_f(float t) {
    const float p = -t * (1.f + t * 0.5f * (1.f + t * (1.f / 3.f) * (1.f + t * 0.25f * (1.f + t * 0.2f * (1.f + t * (1.f / 6.f) * (1.f + t * (1.f / 7.f)))))));
    return t > -0.3f ? p : 1.f - __expf(t);
}
__device__ __forceinline__ float log1p_f(float e) { return e < 0.01f ? e * (1.f - e * (0.5f - e * ((1.f / 3.f) - 0.25f * e))) : __logf(1.f + e); }
__device__ __forceinline__ float softplus_f(float x) { return fmaxf(x, 0.f) + log1p_f(__expf(-fabsf(x))); }
__device__ __forceinline__ float gelu_tanh_f(float x) { const float u = 0.7978845608028654f * (x + 0.044715f * x * x * x); return x * __builtin_amdgcn_rcpf(1.f + __expf(-2.f * u)); }
namespace pg8 {
#define PG8_LAS __attribute__((address_space(3)))
constexpr int BM = 256, BK = 64, HALF = 128, HTB = HALF * BK * 2  , STAGE_BYTES = 8 * HTB, NXCD = 8, WGM = 8;

__host__ __device__ __forceinline__ int lds_byte(int r, int c) { const int st = (r >> 4) * 2 + (c >> 5), rr = r & 15, cc = c & 31, ob = rr * 64 + cc * 2; return st * 1024 + (ob ^ (((ob >> 9) & 1) << 5)); }
__host__ __device__ __forceinline__ void stage_rc(int b, int& R, int& C) { const int st = b / 1024, sb = b % 1024, swz = sb ^ (((sb >> 9) & 1) << 5); R = (st >> 1) * 16 + swz / 64; C = (st & 1) * 32 + (swz % 64) / 2; }
__host__ __device__ __forceinline__ int perm32(int rho) { const int n = rho >> 4, i = rho & 15; return 8 * (i >> 2) + 4 * n + (i & 3); }

struct Unit { int pm, pn; };
struct Gemm { const bf16_t* A; const bf16_t* Bt; int lda, ldb, K, wrap; };

struct StaticOrder {
    int nM, nN, nwg, G, c;
    __host__ __device__ void init(int M, int N, int G_, int c_) { nM = M / BM; nN = N / BM; nwg = nM * nN; G = G_; c = c_; }
    __host__ __device__ bool next(int i, Unit& u) const {
        const long L = (long)i * G + c; if (L >= nwg) return false;
        int wgid = (int)L; { const int q = nwg / NXCD, r = nwg % NXCD, xcd = wgid % NXCD, off = wgid / NXCD; wgid = (xcd < r ? xcd * (q + 1) : r * (q + 1) + (xcd - r) * q) + off; }
        const int nig = WGM * nN, gid = wgid / nig, fm = gid * WGM, gsz = (nM - fm) < WGM ? (nM - fm) : WGM;
        u.pm = fm + ((wgid % nig) % gsz); u.pn = (wgid % nig) / gsz; return true;
    }
    __device__ __forceinline__ void a_ready(const Unit&) const {}
    __device__ __forceinline__ void done(const Unit&) const {}
};

typedef float f32x2c __attribute__((ext_vector_type(2))); typedef __bf16 bf16x2c __attribute__((ext_vector_type(2)));
__device__ __forceinline__ unsigned cvt_pk_bf16(float lo, float hi) { const f32x2c v = {lo, hi}; const bf16x2c b = __builtin_convertvector(v, bf16x2c); return __builtin_bit_cast(unsigned, b); }

template <class Epi, class Sched, bool ALIGN_EPI = false, bool SP2 = false, bool GATHER = false>
__device__ __forceinline__ void gemm_phase(PG8_LAS unsigned char* lds, const Gemm g, const Sched& S, const Epi& E, const PG8_LAS int* gtab = nullptr) {
    int tid_ = threadIdx.x; asm volatile("" : "+v"(tid_));
    const int tid = tid_, wid = __builtin_amdgcn_readfirstlane(tid >> 6), lane = tid & 63, wr = wid >> 2, wc = wid & 3, fr = lane & 15, fq = lane >> 4;
    const int K = g.K, nt = K / BK;
    const int wm = g.wrap ? (nt / 2 - 1) : 0x7fffffff;
    unsigned voffA[2], voffB[2];
#pragma unroll
    for (int i = 0; i < 2; ++i) { int R, C; stage_rc(tid * 16 + i * 8192, R, C); const int Rb = Epi::PERM ? ((R & ~31) + perm32(R & 31)) : R;
        voffA[i] = (unsigned)(R * g.lda + C) * 2u; voffB[i] = (unsigned)(Rb * g.ldb + C) * 2u; }
    const size_t kstep = (size_t)(BK * 2);
    const size_t hstepA = (size_t)HALF * g.lda * 2, hstepB = (size_t)HALF * g.ldb * 2;
    const size_t tstepA = 2 * hstepA, tstepB = 2 * hstepB;
    const unsigned ldsw = (unsigned)wid * 1024u;
    const int aoff = lds_byte(wr * 64 + fr, fq * 8), boff = lds_byte(wc * 32 + fr, fq * 8);
    int gR0 = 0, gC0 = 0; if constexpr (GATHER) { stage_rc(tid * 16, gR0, gC0); }
#define PG8_STAGE_A(bufoff, aptr, koff, slot, h) do { if constexpr (GATHER) { _Pragma("unroll") for (int _i = 0; _i < 2; ++_i) { const unsigned _o = ((slot) == ui) ? gvo[2 * (h) + _i] : nvo[2 * (h) + _i]; \
            __builtin_amdgcn_global_load_lds((const unsigned*)((const char*)g.A + _o + (koff)), (PG8_LAS unsigned*)(lds + (bufoff) + ldsw + _i * 8192), 16, 0, 0); } } \
        else { PG8_STAGE(bufoff, aptr, voffA); } } while (0)
#define PG8_GLOAD(dst, s_) do { _Pragma("unroll") for (int _j = 0; _j < 4; ++_j) dst[_j] = (unsigned)gtab[(s_) * 256 + gR0 + 64 * _j] * (unsigned)(g.lda * 2) + (unsigned)(gC0 * 2); } while (0)
#define PG8_SA(b, h) (((b) * 2 + (h)) * HTB)
#define PG8_SB(b, h) ((4 + (b) * 2 + (h)) * HTB)
#define PG8_STAGE(bufoff, gbase, voff) do { _Pragma("unroll") for (int _i = 0; _i < 2; ++_i) \
        __builtin_amdgcn_global_load_lds((const unsigned*)((const char*)(gbase) + (voff)[_i]), (PG8_LAS unsigned*)(lds + (bufoff) + ldsw + _i * 8192), 16, 0, 0); } while (0)
#define PG8_LDA(dst, b, h) do { _Pragma("unroll") for (int m = 0; m < 4; ++m) _Pragma("unroll") for (int k = 0; k < 2; ++k) dst[m][k] = *(const PG8_LAS bf16x8*)(lds + PG8_SA(b, h) + aoff + m * 2048 + k * 1024); } while (0)
#define PG8_LDB(dst, b, h) do { _Pragma("unroll") for (int n = 0; n < 2; ++n) _Pragma("unroll") for (int k = 0; k < 2; ++k) dst[n][k] = *(const PG8_LAS bf16x8*)(lds + PG8_SB(b, h) + boff + n * 2048 + k * 1024); } while (0)
#define PG8_MMA(ai, bj, At, Bt) do { __builtin_amdgcn_s_setprio(1); _Pragma("unroll") for (int m = 0; m < 4; ++m) _Pragma("unroll") for (int n = 0; n < 2; ++n) _Pragma("unroll") for (int k = 0; k < 2; ++k) \
        acc[ai][bj][m][n] = __builtin_amdgcn_mfma_f32_16x16x32_bf16(Bt[n][k], At[m][k], acc[ai][bj][m][n], 0, 0, 0); __builtin_amdgcn_s_setprio(0); } while (0)
#define PG8_WAIT_V(n) asm volatile("s_waitcnt vmcnt(" #n ")" ::: "memory")
#define PG8_WAIT_L(n) asm volatile("s_waitcnt lgkmcnt(" #n ")" ::: "memory")
#define PG8_BAR __builtin_amdgcn_s_barrier()
#define PG8_SCHED __builtin_amdgcn_sched_barrier(0)
    Unit cur, nxt; int ui = 0;
    if (!S.next(0, cur)) return;
    unsigned gvo[4] = {0u, 0u, 0u, 0u}, nvo[4] = {0u, 0u, 0u, 0u};
    if constexpr (GATHER) { PG8_GLOAD(gvo, 0); }
    f32x4 acc[2][2][4][2];
#pragma unroll
    for (int a = 0; a < 2; ++a)
#pragma unroll
        for (int b = 0; b < 2; ++b)
#pragma unroll
            for (int m = 0; m < 4; ++m)
#pragma unroll
                for (int n = 0; n < 2; ++n) acc[a][b][m][n] = (f32x4){0.f, 0.f, 0.f, 0.f};
    bf16x8 At[4][2], B0[2][2], B1[2][2];
    const char* cA = (const char*)g.A + (size_t)cur.pm * tstepA; const char* cB = (const char*)g.Bt + (size_t)cur.pn * tstepB;
    S.a_ready(cur);
    if constexpr (SP2) {
        PG8_STAGE(PG8_SB(0, 0), cB, voffB); PG8_STAGE(PG8_SB(0, 1), cB + hstepB, voffB); PG8_STAGE_A(PG8_SA(0, 0), cA, 0, 0, 0); PG8_STAGE_A(PG8_SA(0, 1), cA + hstepA, 0, 0, 1);
        if (wr == 1) PG8_BAR;
        PG8_WAIT_V(2); PG8_BAR;
        PG8_STAGE(PG8_SB(1, 0), cB + kstep, voffB); PG8_STAGE_A(PG8_SA(1, 0), cA + kstep, kstep, 0, 0); PG8_STAGE(PG8_SB(1, 1), cB + hstepB + kstep, voffB);
        PG8_WAIT_V(6); PG8_BAR;
    } else {
        PG8_STAGE(PG8_SB(0, 0), cB, voffB); PG8_STAGE_A(PG8_SA(0, 0), cA, 0, 0, 0); PG8_STAGE(PG8_SB(0, 1), cB + hstepB, voffB); PG8_STAGE_A(PG8_SA(0, 1), cA + hstepA, 0, 0, 1);
        if (wr == 1) PG8_BAR;
        PG8_WAIT_V(4); PG8_BAR;
        PG8_STAGE(PG8_SB(1, 0), cB + kstep, voffB); PG8_STAGE_A(PG8_SA(1, 0), cA + kstep, kstep, 0, 0); PG8_STAGE(PG8_SB(1, 1), cB + hstepB + kstep, voffB);
        PG8_WAIT_V(6); PG8_BAR;
    }
    for (;;) {
        const bool has_next = S.next(ui + 1, nxt);
        if constexpr (GATHER) { if (has_next) { PG8_GLOAD(nvo, ui + 1); } else { _Pragma("unroll") for (int _j = 0; _j < 4; ++_j) nvo[_j] = gvo[_j]; } }
        const char* nA = has_next ? (const char*)g.A + (size_t)nxt.pm * tstepA : cA; const char* nB = has_next ? (const char*)g.Bt + (size_t)nxt.pn * tstepB : cB;
        int t = 0;
        for (int seg = 0; seg < (Epi::HAS_MID ? 3 : 1); ++seg) {
        const int tend = Epi::HAS_MID ? (seg == 0 ? Epi::MID0 : (seg == 1 ? Epi::MID1 : nt)) : nt;
        for (; t < tend; t += 2) {
            const bool last = (t == nt - 2);
            const char* a1 = cA + (size_t)((t + 1) & wm) * kstep;
            const char* a2 = last ? nA : cA + (size_t)((t + 2) & wm) * kstep; const char* b2 = last ? nB : cB + (size_t)((t + 2) & wm) * kstep;
            const char* a3 = a2 + kstep; const char* b3 = b2 + kstep;
            const size_t ka1 = (size_t)((t + 1) & wm) * kstep, ka2 = last ? 0 : (size_t)((t + 2) & wm) * kstep, ka3 = ka2 + kstep; const int sl2 = (last && has_next) ? ui + 1 : ui;
            if (last && has_next) S.a_ready(nxt);
            if constexpr (SP2) {
            PG8_LDB(B0, 0, 0); PG8_LDB(B1, 0, 1); PG8_SCHED; PG8_LDA(At, 0, 0); PG8_STAGE_A(PG8_SA(1, 1), a1 + hstepA, ka1, ui, 1);
            PG8_WAIT_V(8); PG8_WAIT_L(0); PG8_BAR; PG8_MMA(0, 0, At, B0); PG8_MMA(0, 1, At, B1); PG8_BAR; PG8_SCHED;
            PG8_LDA(At, 0, 1); PG8_STAGE(PG8_SB(0, 0), b2, voffB); PG8_STAGE(PG8_SB(0, 1), b2 + hstepB, voffB); PG8_STAGE_A(PG8_SA(0, 0), a2, ka2, sl2, 0);
            PG8_WAIT_V(8); PG8_WAIT_L(0); PG8_BAR; PG8_MMA(1, 0, At, B0); PG8_MMA(1, 1, At, B1); PG8_BAR; PG8_SCHED;
            PG8_LDB(B0, 1, 0); PG8_LDB(B1, 1, 1); PG8_SCHED; PG8_LDA(At, 1, 0); PG8_STAGE_A(PG8_SA(0, 1), a2 + hstepA, ka2, sl2, 1);
            PG8_WAIT_V(8); PG8_WAIT_L(0); PG8_BAR; PG8_MMA(0, 0, At, B0); PG8_MMA(0, 1, At, B1); PG8_BAR; PG8_SCHED;
            PG8_LDA(At, 1, 1); PG8_STAGE(PG8_SB(1, 0), b3, voffB); PG8_STAGE(PG8_SB(1, 1), b3 + hstepB, voffB); PG8_STAGE_A(PG8_SA(1, 0), a3, ka3, sl2, 0);
            PG8_WAIT_V(8); PG8_WAIT_L(0); PG8_BAR; PG8_MMA(1, 0, At, B0); PG8_MMA(1, 1, At, B1); PG8_BAR; PG8_SCHED;
            } else {
            PG8_LDB(B0, 0, 0); PG8_SCHED; PG8_LDA(At, 0, 0); PG8_STAGE_A(PG8_SA(1, 1), a1 + hstepA, ka1, ui, 1);
            PG8_WAIT_L(8); PG8_BAR; PG8_WAIT_L(0); PG8_MMA(0, 0, At, B0); PG8_BAR; PG8_SCHED;
            PG8_LDB(B1, 0, 1); PG8_STAGE(PG8_SB(0, 0), b2, voffB);
            PG8_BAR; PG8_WAIT_L(0); PG8_MMA(0, 1, At, B1); PG8_BAR;
            PG8_LDA(At, 0, 1); PG8_STAGE_A(PG8_SA(0, 0), a2, ka2, sl2, 0);
            PG8_BAR; PG8_WAIT_L(0); PG8_MMA(1, 0, At, B0); PG8_BAR; PG8_SCHED;
            PG8_STAGE(PG8_SB(0, 1), b2 + hstepB, voffB);
            PG8_WAIT_V(6); PG8_BAR; PG8_MMA(1, 1, At, B1); PG8_BAR;
            PG8_LDB(B0, 1, 0); PG8_SCHED; PG8_LDA(At, 1, 0); PG8_STAGE_A(PG8_SA(0, 1), a2 + hstepA, ka2, sl2, 1);
            PG8_WAIT_L(8); PG8_BAR; PG8_WAIT_L(0); PG8_MMA(0, 0, At, B0); PG8_BAR; PG8_SCHED;
            PG8_LDB(B1, 1, 1); PG8_STAGE(PG8_SB(1, 0), b3, voffB);
            PG8_BAR; PG8_WAIT_L(0); PG8_MMA(0, 1, At, B1); PG8_BAR;
            PG8_LDA(At, 1, 1); PG8_STAGE_A(PG8_SA(1, 0), a3, ka3, sl2, 0);
            PG8_BAR; PG8_WAIT_L(0); PG8_MMA(1, 0, At, B0); PG8_BAR; PG8_SCHED;
            PG8_STAGE(PG8_SB(1, 1), b3 + hstepB, voffB);
            PG8_WAIT_V(6); PG8_BAR; PG8_MMA(1, 1, At, B1); PG8_BAR;
            }
        }
        if constexpr (Epi::HAS_MID) { if (seg < 2) E.mid(acc, cur, wr, wc, fr, fq, seg); }
        }
        if constexpr (ALIGN_EPI) { if (wr == 0) PG8_BAR; }
        E(acc, cur, wr, wc, fr, fq); S.done(cur);
        if (!has_next) break;
#pragma unroll
        for (int a = 0; a < 2; ++a)
#pragma unroll
            for (int b = 0; b < 2; ++b)
#pragma unroll
                for (int m = 0; m < 4; ++m)
#pragma unroll
                    for (int n = 0; n < 2; ++n) acc[a][b][m][n] = (f32x4){0.f, 0.f, 0.f, 0.f};
        cur = nxt; cA = nA; cB = nB; ++ui;
        if constexpr (GATHER) { _Pragma("unroll") for (int _j = 0; _j < 4; ++_j) gvo[_j] = nvo[_j]; }
        if constexpr (ALIGN_EPI) { if (wr == 1) PG8_BAR; }
    }
    PG8_WAIT_V(0);
    if constexpr (!ALIGN_EPI) { if (wr == 0) PG8_BAR; }
    PG8_BAR;
#undef PG8_SA
#undef PG8_SB
#undef PG8_STAGE
#undef PG8_STAGE_A
#undef PG8_GLOAD
#undef PG8_LDA
#undef PG8_LDB
#undef PG8_MMA
#undef PG8_WAIT_V
#undef PG8_WAIT_L
#undef PG8_BAR
#undef PG8_SCHED
}
}
namespace pg8 {
typedef int i32x4v __attribute__((ext_vector_type(4)));
typedef int i32x8 __attribute__((ext_vector_type(8)));
struct Gemm8 { const unsigned char* A; const unsigned char* Bt; int lda, ldb, K, wrap; };
template <class Epi, class Sched, bool GATHER = false>
__device__ __forceinline__ void gemm_phase_f8(PG8_LAS unsigned char* lds, const Gemm8 g, const Sched& S, const Epi& E, const PG8_LAS int* gtab = nullptr) {
    constexpr bool ALIGN_EPI = true, SP2 = true;
    int tid_ = threadIdx.x; asm volatile("" : "+v"(tid_));
    const int tid = tid_, wid = __builtin_amdgcn_readfirstlane(tid >> 6), lane = tid & 63, wr = wid >> 2, wc = wid & 3, fr = lane & 15, fq = lane >> 4;
    int K_ = g.K; asm volatile("" : "+s"(K_));
    const int K = K_, nt = K / 128;
    unsigned voffA[2], voffB[2];
#pragma unroll
    for (int i = 0; i < 2; ++i) { int R, C; stage_rc(tid * 16 + i * 8192, R, C); const int Rb = Epi::PERM ? ((R & ~31) + perm32(R & 31)) : R;
        voffA[i] = (unsigned)(R * g.lda + C * 2); voffB[i] = (unsigned)(Rb * g.ldb + C * 2); }
    const size_t kstep = (size_t)(BK * 2);
    const size_t hstepA = (size_t)HALF * g.lda, hstepB = (size_t)HALF * g.ldb;
    const size_t tstepA = 2 * hstepA, tstepB = 2 * hstepB;
    const unsigned ldsw = (unsigned)wid * 1024u;
    const int aoff = lds_byte(wr * 64 + fr, fq * 8), boff = lds_byte(wc * 32 + fr, fq * 8);
    int gR0 = 0, gC0 = 0; if constexpr (GATHER) { stage_rc(tid * 16, gR0, gC0); }
#define PG8_STAGE_A(bufoff, aptr, koff, slot, h) do { if constexpr (GATHER) { _Pragma("unroll") for (int _i = 0; _i < 2; ++_i) { const unsigned _o = ((slot) == ui) ? gvo[2 * (h) + _i] : nvo[2 * (h) + _i]; \
            __builtin_amdgcn_global_load_lds((const unsigned*)((const char*)g.A + _o + (koff)), (PG8_LAS unsigned*)(lds + (bufoff) + ldsw + _i * 8192), 16, 0, 0); } } \
        else { PG8_STAGE(bufoff, aptr, voffA); } } while (0)
#define PG8_GLOAD(dst, s_) do { _Pragma("unroll") for (int _j = 0; _j < 4; ++_j) dst[_j] = (unsigned)gtab[(s_) * 256 + gR0 + 64 * _j] * (unsigned)(g.lda) + (unsigned)(gC0 * 2); } while (0)
#define PG8_SA(b, h) (((b) * 2 + (h)) * HTB)
#define PG8_SB(b, h) ((4 + (b) * 2 + (h)) * HTB)
#define PG8_STAGE(bufoff, gbase, voff) do { _Pragma("unroll") for (int _i = 0; _i < 2; ++_i) \
        __builtin_amdgcn_global_load_lds((const unsigned*)((const char*)(gbase) + (voff)[_i]), (PG8_LAS unsigned*)(lds + (bufoff) + ldsw + _i * 8192), 16, 0, 0); } while (0)
#define PG8_LDA(dst, b, h) do { _Pragma("unroll") for (int m = 0; m < 4; ++m) { const i32x4v lo_ = *(const PG8_LAS i32x4v*)(lds + PG8_SA(b, h) + aoff + m * 2048), hi_ = *(const PG8_LAS i32x4v*)(lds + PG8_SA(b, h) + aoff + m * 2048 + 1024); dst[m] = __builtin_shufflevector(lo_, hi_, 0, 1, 2, 3, 4, 5, 6, 7); } } while (0)
#define PG8_LDB(dst, b, h) do { _Pragma("unroll") for (int n = 0; n < 2; ++n) { const i32x4v lo_ = *(const PG8_LAS i32x4v*)(lds + PG8_SB(b, h) + boff + n * 2048), hi_ = *(const PG8_LAS i32x4v*)(lds + PG8_SB(b, h) + boff + n * 2048 + 1024); dst[n] = __builtin_shufflevector(lo_, hi_, 0, 1, 2, 3, 4, 5, 6, 7); } } while (0)
#define PG8_MMA(ai, bj, At, Bt) do { __builtin_amdgcn_s_setprio(1); _Pragma("unroll") for (int m = 0; m < 4; ++m) _Pragma("unroll") for (int n = 0; n < 2; ++n) \
        asm volatile("v_mfma_f32_16x16x128_f8f6f4 %0, %1, %2, %0" : "+v"(acc[ai][bj][m][n]) : "v"(Bt[n]), "v"(At[m])); __builtin_amdgcn_s_setprio(0); } while (0)
#define PG8_WAIT_V(n) asm volatile("s_waitcnt vmcnt(" #n ")" ::: "memory")
#define PG8_WAIT_L(n) asm volatile("s_waitcnt lgkmcnt(" #n ")" ::: "memory")
#define PG8_BAR __builtin_amdgcn_s_barrier()
#define PG8_SCHED __builtin_amdgcn_sched_barrier(0)
    Unit cur, nxt; int ui = 0;
    if (!S.next(0, cur)) return;
    if constexpr (Epi::HAS_PRE) E.pre(cur, ui, wid, lane);
    unsigned gvo[4] = {0u, 0u, 0u, 0u}, nvo[4] = {0u, 0u, 0u, 0u};
    if constexpr (GATHER) { PG8_GLOAD(gvo, 0); }
    f32x4 acc[2][2][4][2];
#pragma unroll
    for (int a = 0; a < 2; ++a)
#pragma unroll
        for (int b = 0; b < 2; ++b)
#pragma unroll
            for (int m = 0; m < 4; ++m)
#pragma unroll
                for (int n = 0; n < 2; ++n) acc[a][b][m][n] = (f32x4){0.f, 0.f, 0.f, 0.f};
    i32x8 At[4], B0[2], B1[2];
    const int wm = g.wrap ? (nt / 2 - 1) : 0x7fffffff;
    int sc1 = 0x7f7f7f7f; asm volatile("" : "+v"(sc1));
    const char* cA = (const char*)g.A + (size_t)cur.pm * tstepA; const char* cB = (const char*)g.Bt + (size_t)cur.pn * tstepB;
    S.a_ready(cur);
    if constexpr (SP2) {
        PG8_STAGE(PG8_SB(0, 0), cB, voffB); PG8_STAGE(PG8_SB(0, 1), cB + hstepB, voffB); PG8_STAGE_A(PG8_SA(0, 0), cA, 0, 0, 0); PG8_STAGE_A(PG8_SA(0, 1), cA + hstepA, 0, 0, 1);
        if (wr == 1) PG8_BAR;
        PG8_WAIT_V(2); PG8_BAR;
        PG8_STAGE(PG8_SB(1, 0), cB + kstep, voffB); PG8_STAGE_A(PG8_SA(1, 0), cA + kstep, kstep, 0, 0); PG8_STAGE(PG8_SB(1, 1), cB + hstepB + kstep, voffB);
        PG8_WAIT_V(6); PG8_BAR;
    } else {
        PG8_STAGE(PG8_SB(0, 0), cB, voffB); PG8_STAGE_A(PG8_SA(0, 0), cA, 0, 0, 0); PG8_STAGE(PG8_SB(0, 1), cB + hstepB, voffB); PG8_STAGE_A(PG8_SA(0, 1), cA + hstepA, 0, 0, 1);
        if (wr == 1) PG8_BAR;
        PG8_WAIT_V(4); PG8_BAR;
        PG8_STAGE(PG8_SB(1, 0), cB + kstep, voffB); PG8_STAGE_A(PG8_SA(1, 0), cA + kstep, kstep, 0, 0); PG8_STAGE(PG8_SB(1, 1), cB + hstepB + kstep, voffB);
        PG8_WAIT_V(6); PG8_BAR;
    }
    for (;;) {
        const bool has_next = S.next(ui + 1, nxt);
        if constexpr (GATHER) { if (has_next) { PG8_GLOAD(nvo, ui + 1); } else { _Pragma("unroll") for (int _j = 0; _j < 4; ++_j) nvo[_j] = gvo[_j]; } }
        const char* nA = has_next ? (const char*)g.A + (size_t)nxt.pm * tstepA : cA; const char* nB = has_next ? (const char*)g.Bt + (size_t)nxt.pn * tstepB : cB;
        int t = 0;
        for (int seg = 0; seg < (Epi::HAS_MID ? 3 : 1); ++seg) {
        const int tend = Epi::HAS_MID ? (seg == 0 ? Epi::MID0 : (seg == 1 ? Epi::MID1 : nt)) : nt;
#pragma unroll 1
        for (; t < tend; t += 2) {
            const bool last = (t == nt - 2);
            const char* a1 = cA + (size_t)((t + 1) & wm) * kstep;
            const char* a2 = last ? nA : cA + (size_t)((t + 2) & wm) * kstep; const char* b2 = last ? nB : cB + (size_t)((t + 2) & wm) * kstep;
            const char* a3 = a2 + kstep; const char* b3 = b2 + kstep;
            const size_t ka1 = (size_t)((t + 1) & wm) * kstep, ka2 = last ? 0 : (size_t)((t + 2) & wm) * kstep, ka3 = ka2 + kstep; const int sl2 = (last && has_next) ? ui + 1 : ui;
            if (last && has_next) S.a_ready(nxt);
            if constexpr (SP2) {
            PG8_LDB(B0, 0, 0); PG8_LDB(B1, 0, 1); PG8_SCHED; PG8_LDA(At, 0, 0); PG8_STAGE_A(PG8_SA(1, 1), a1 + hstepA, ka1, ui, 1);
            PG8_WAIT_V(8); PG8_WAIT_L(0); PG8_BAR; PG8_MMA(0, 0, At, B0); PG8_MMA(0, 1, At, B1); PG8_BAR; PG8_SCHED;
            PG8_LDA(At, 0, 1); PG8_STAGE(PG8_SB(0, 0), b2, voffB); PG8_STAGE(PG8_SB(0, 1), b2 + hstepB, voffB); PG8_STAGE_A(PG8_SA(0, 0), a2, ka2, sl2, 0);
            PG8_WAIT_V(8); PG8_WAIT_L(0); PG8_BAR; PG8_MMA(1, 0, At, B0); PG8_MMA(1, 1, At, B1); PG8_BAR; PG8_SCHED;
            PG8_LDB(B0, 1, 0); PG8_LDB(B1, 1, 1); PG8_SCHED; PG8_LDA(At, 1, 0); PG8_STAGE_A(PG8_SA(0, 1), a2 + hstepA, ka2, sl2, 1);
            PG8_WAIT_V(8); PG8_WAIT_L(0); PG8_BAR; PG8_MMA(0, 0, At, B0); PG8_MMA(0, 1, At, B1); PG8_BAR; PG8_SCHED;
            PG8_LDA(At, 1, 1); PG8_STAGE(PG8_SB(1, 0), b3, voffB); PG8_STAGE(PG8_SB(1, 1), b3 + hstepB, voffB); PG8_STAGE_A(PG8_SA(1, 0), a3, ka3, sl2, 0);
            PG8_WAIT_V(8); PG8_WAIT_L(0); PG8_BAR; PG8_MMA(1, 0, At, B0); PG8_MMA(1, 1, At, B1); PG8_BAR; PG8_SCHED;
            } else {
            PG8_LDB(B0, 0, 0); PG8_SCHED; PG8_LDA(At, 0, 0); PG8_STAGE_A(PG8_SA(1, 1), a1 + hstepA, ka1, ui, 1);
            PG8_WAIT_L(8); PG8_BAR; PG8_WAIT_L(0); PG8_MMA(0, 0, At, B0); PG8_BAR; PG8_SCHED;
            PG8_LDB(B1, 0, 1); PG8_STAGE(PG8_SB(0, 0), b2, voffB);
            PG8_BAR; PG8_WAIT_L(0); PG8_MMA(0, 1, At, B1); PG8_BAR;
            PG8_LDA(At, 0, 1); PG8_STAGE_A(PG8_SA(0, 0), a2, ka2, sl2, 0);
            PG8_BAR; PG8_WAIT_L(0); PG8_MMA(1, 0, At, B0); PG8_BAR; PG8_SCHED;
            PG8_STAGE(PG8_SB(0, 1), b2 + hstepB, voffB);
            PG8_WAIT_V(6); PG8_BAR; PG8_MMA(1, 1, At, B1); PG8_BAR;
            PG8_LDB(B0, 1, 0); PG8_SCHED; PG8_LDA(At, 1, 0); PG8_STAGE_A(PG8_SA(0, 1), a2 + hstepA, ka2, sl2, 1);
            PG8_WAIT_L(8); PG8_BAR; PG8_WAIT_L(0); PG8_MMA(0, 0, At, B0); PG8_BAR; PG8_SCHED;
            PG8_LDB(B1, 1, 1); PG8_STAGE(PG8_SB(1, 0), b3, voffB);
            PG8_BAR; PG8_WAIT_L(0); PG8_MMA(0, 1, At, B1); PG8_BAR;
            PG8_LDA(At, 1, 1); PG8_STAGE_A(PG8_SA(1, 0), a3, ka3, sl2, 0);
            PG8_BAR; PG8_WAIT_L(0); PG8_MMA(1, 0, At, B0); PG8_BAR; PG8_SCHED;
            PG8_STAGE(PG8_SB(1, 1), b3 + hstepB, voffB);
            PG8_WAIT_V(6); PG8_BAR; PG8_MMA(1, 1, At, B1); PG8_BAR;
            }
        }
        if constexpr (Epi::HAS_MID) { if (seg < 2) E.mid(acc, cur, wr, wc, fr, fq, seg); }
        }
        if constexpr (ALIGN_EPI) { if (wr == 0) PG8_BAR; }
        asm volatile("s_nop 15\n\ts_nop 15" ::: "memory");
        if constexpr (Epi::HAS_PRE) E(acc, cur, wr, wc, fr, fq, ui); else E(acc, cur, wr, wc, fr, fq);
        S.done(cur);
        if (!has_next) break;
#pragma unroll
        for (int a = 0; a < 2; ++a)
#pragma unroll
            for (int b = 0; b < 2; ++b)
#pragma unroll
                for (int m = 0; m < 4; ++m)
#pragma unroll
                    for (int n = 0; n < 2; ++n) acc[a][b][m][n] = (f32x4){0.f, 0.f, 0.f, 0.f};
        cur = nxt; cA = nA; cB = nB; ++ui;
        if constexpr (Epi::HAS_PRE) E.pre(cur, ui, wid, lane);
        if constexpr (GATHER) { _Pragma("unroll") for (int _j = 0; _j < 4; ++_j) gvo[_j] = nvo[_j]; }
        if constexpr (ALIGN_EPI) { if (wr == 1) PG8_BAR; }
    }
    PG8_WAIT_V(0);
    if constexpr (!ALIGN_EPI) { if (wr == 0) PG8_BAR; }
    PG8_BAR;
#undef PG8_SA
#undef PG8_SB
#undef PG8_STAGE
#undef PG8_STAGE_A
#undef PG8_GLOAD
#undef PG8_LDA
#undef PG8_LDB
#undef PG8_MMA
#undef PG8_WAIT_V
#undef PG8_WAIT_L
#undef PG8_BAR
#undef PG8_SCHED
}
}
#define XB_TMO      128
#define XB_XCNT(j)  (256  + 64 * (j))
#define XB_XSUB(j)  (1280 + 64 * (j))
#define XB_XGEN(j)  (2304 + 64 * (j))
#define XB_TOP      3328
#define XB_TOPGEN   3392
#define XCD_BAR_WORDS 3456
#define XB_SPIN_CAP (1u << 18)

__device__ __forceinline__ unsigned xb_ld(unsigned* p)              { return __hip_atomic_load(p, __ATOMIC_RELAXED, __HIP_MEMORY_SCOPE_AGENT); }
__device__ __forceinline__ unsigned xb_add(unsigned* p, unsigned v) { return __hip_atomic_fetch_add(p, v, __ATOMIC_RELAXED, __HIP_MEMORY_SCOPE_AGENT); }
__device__ __forceinline__ unsigned xb_xcc_id() { return (unsigned)__builtin_amdgcn_s_getreg((3 << 11) | 20) & 0xFu; }
#define XB_SPIN(cond, bar) do { unsigned _sp = 0; while (cond) { __builtin_amdgcn_s_sleep(1); \
    if ((++_sp & 255u) == 0u) { if (xb_ld(&(bar)[XB_TMO])) break; if (_sp > XB_SPIN_CAP) { atomicAdd(&(bar)[XB_TMO], 1u); break; } } } } while (0)

struct XcdBarrier {
    unsigned* bar; unsigned x;
    volatile LAS unsigned* st;
};

__device__ __forceinline__ XcdBarrier xcd_barrier_post(unsigned* bar, volatile LAS unsigned* st) {
    XcdBarrier b; b.bar = bar; b.x = xb_xcc_id(); b.st = st;
    if (threadIdx.x == 0) (void)xb_add(&bar[XB_XCNT(b.x)], 1u);
    return b;
}
__device__ __forceinline__ void xcd_barrier_complete(unsigned* bar, unsigned x, unsigned& nloc, unsigned& nx) {
    const unsigned G = gridDim.x * gridDim.y * gridDim.z;
    unsigned sum, cnt, mine, sp = 0u;
    for (;;) {
        sum = 0u; cnt = 0u; mine = 0u;
#pragma unroll
        for (unsigned j = 0; j < 16; ++j) { const unsigned c = xb_ld(&bar[XB_XCNT(j)]); sum += c; cnt += (c > 0u) ? 1u : 0u; mine = (j == x) ? c : mine; }
        if (sum == G) break;
        __builtin_amdgcn_s_sleep(1);
        if ((++sp & 255u) == 0u) { if (xb_ld(&bar[XB_TMO])) break; if (sp > XB_SPIN_CAP) { atomicAdd(&bar[XB_TMO], 1u); break; } }
    }
    nloc = mine > 0u ? mine : 1u; nx = cnt > 0u ? cnt : 1u;
}

__device__ __forceinline__ void xcd_barrier(const XcdBarrier& b) {
    asm volatile("s_waitcnt vmcnt(0)" ::: "memory");
    __syncthreads();
    if (threadIdx.x == 0) {
        unsigned* bar = b.bar;
        __builtin_amdgcn_s_waitcnt(0);
        unsigned nloc = b.st[0], nx = b.st[1];
        if (nloc == 0u) { xcd_barrier_complete(bar, b.x, nloc, nx); b.st[0] = nloc; b.st[1] = nx; }
        const unsigned old = xb_add(&bar[XB_XSUB(b.x)], 1u);
        const unsigned gen = old / nloc;
        if (old + 1u == (gen + 1u) * nloc) {
            __builtin_amdgcn_fence(__ATOMIC_RELEASE, "agent");
            asm volatile("s_waitcnt vmcnt(0)" ::: "memory");
            const unsigned og = xb_add(&bar[XB_TOP], 1u);
            const unsigned tg = og / nx;
            if (og + 1u == (tg + 1u) * nx) xb_add(&bar[XB_TOPGEN], 1u);
            else XB_SPIN(xb_ld(&bar[XB_TOPGEN]) == tg, bar);
            __builtin_amdgcn_fence(__ATOMIC_ACQUIRE, "agent");
            xb_add(&bar[XB_XGEN(b.x)], 1u);
            asm volatile("s_waitcnt vmcnt(0)" ::: "memory");
        } else {
            XB_SPIN(xb_ld(&bar[XB_XGEN(b.x)]) == gen, bar);
            __builtin_amdgcn_fence(__ATOMIC_ACQUIRE, "agent");
            asm volatile("s_waitcnt vmcnt(0)" ::: "memory");
        }
    }
    __syncthreads();
}
namespace pg8 {
struct EpiProj {
    static constexpr bool PERM = true, HAS_MID = false; static constexpr int MID0 = 0, MID1 = 0;
    __device__ __forceinline__ void mid(f32x4 (&)[2][2][4][2], const Unit&, int, int, int, int, int) const {}
    bf16_t* proj; float* gsm; int pn0;
    __device__ __forceinline__ void operator()(const f32x4 (&acc)[2][2][4][2], const Unit& u, int wr, int wc, int fr, int fq) const {
        const int row0 = u.pm * BM + wr * 64 + fr; const int pn = u.pn + pn0;
        if (pn < 14) {
            const int col0 = pn * BM + wc * 32 + 8 * fq;
#pragma unroll
            for (int ai = 0; ai < 2; ++ai)
#pragma unroll
                for (int m = 0; m < 4; ++m) { bf16_t* rowp = proj + (size_t)(row0 + ai * HALF + m * 16) * NPROJ + col0;
#pragma unroll
                    for (int bj = 0; bj < 2; ++bj) { constexpr float ps = PROBE_PH == 100 ? 0.5f : 1.0f; const f32x4 v0 = acc[ai][bj][m][0] * ps, v1 = acc[ai][bj][m][1] * ps;
                        u32x4 w; w.x = cvt_pk_bf16(v0[0], v0[1]); w.y = cvt_pk_bf16(v0[2], v0[3]); w.z = cvt_pk_bf16(v1[0], v1[1]); w.w = cvt_pk_bf16(v1[2], v1[3]);
                        *(u32x4*)(rowp + bj * HALF) = w; } }
        } else if (wc == 0 && fq < 3) {
#pragma unroll
            for (int ai = 0; ai < 2; ++ai)
#pragma unroll
                for (int m = 0; m < 4; ++m) { float* rowp = gsm + (size_t)(row0 + ai * HALF + m * 16) * 32 + 8 * fq;
                    constexpr float ps = PROBE_PH == 100 ? 0.5f : 1.0f; *(f32x4*)(rowp) = acc[ai][0][m][0] * ps; *(f32x4*)(rowp + 4) = acc[ai][0][m][1] * ps; }
        }
    }
};
__device__ __forceinline__ void stage_store16(PG8_LAS unsigned char* buf, const u32x4 w, int wr, int wc, int fr, int fq, int orow, int oc, unsigned char* gdst) {
    *(PG8_LAS u32x4*)(buf + (wr * 16 + fr) * 272 + wc * 64 + 16 * fq) = w;
    asm volatile("s_waitcnt lgkmcnt(0)" ::: "memory"); __builtin_amdgcn_s_barrier();
    const u32x4 o = *(const PG8_LAS u32x4*)(buf + orow * 272 + oc);
    __builtin_nontemporal_store(o, (u32x4*)gdst);
}
struct EpiProj8 {
    static constexpr bool HAS_PRE = false;
    static constexpr bool PERM = true, HAS_MID = false; static constexpr int MID0 = 0, MID1 = 0;
    __device__ __forceinline__ void mid(f32x4 (&)[2][2][4][2], const Unit&, int, int, int, int, int) const {}
    bf16_t* proj; unsigned char* gd; PG8_LAS unsigned char* tb;
    __device__ __forceinline__ void operator()(const f32x4 (&acc)[2][2][4][2], const Unit& u, int wr, int wc, int fr, int fq) const {
        constexpr float sc = 1.0f / (F8_SX * F8_SWI);
        const int row0 = u.pm * BM + wr * 64 + fr;
        constexpr int GT0 = P1_ALL_F8 ? 22 : 8;
        if (u.pn >= GT0) {
            const int gt = u.pn - GT0; unsigned char* base = gd + ((size_t)((gt >> 2) * 128 + u.pm) * 4 + (gt & 3)) * 65536 + (size_t)((wr * 4 + wc) * 64 + fq * 16 + fr) * 16;
#pragma unroll
            for (int ai = 0; ai < 2; ++ai)
#pragma unroll
                for (int m = 0; m < 4; ++m) { u32x4 w;
#pragma unroll
                    for (int bj = 0; bj < 2; ++bj)
#pragma unroll
                        for (int h = 0; h < 2; ++h) { constexpr float sg = -sc * 1.4426950408889634f; unsigned pk = 0;
#pragma unroll
                            for (int q = 0; q < 4; ++q) { const float sgm = __builtin_amdgcn_rcpf(1.f + __builtin_amdgcn_exp2f(acc[ai][bj][m][h][q] * sg));
                                pk = __builtin_amdgcn_cvt_pk_u8_f32(fmaxf(__builtin_floorf(sgm * 255.f + 0.5f), 1.0f), q, pk); }
                            w[bj * 2 + h] = pk; }
                    __builtin_nontemporal_store(w, (u32x4*)(base + (size_t)(ai * 4 + m) * 8192)); }
        } else {
            const int t_ = (wr * 4 + wc) * 64 + fq * 16 + fr, orow = t_ >> 4, oc = (t_ & 15) * 16;
            unsigned char* obase = (unsigned char*)(proj + (size_t)(u.pm * BM + (orow >> 4) * 64 + (orow & 15)) * NPROJ + (P1_ALL_F8 ? 0 : PC_LRUY) + u.pn * BM) + oc;
#pragma unroll
            for (int ai = 0; ai < 2; ++ai)
#pragma unroll
                for (int m = 0; m < 4; ++m)
#pragma unroll
                    for (int bj = 0; bj < 2; ++bj) { PG8_LAS unsigned char* buf = tb + (bj & 1) * 8704;
                        const f32x4 v0 = acc[ai][bj][m][0] * sc, v1 = acc[ai][bj][m][1] * sc;
                        u32x4 w; w.x = cvt_pk_bf16(v0[0], v0[1]); w.y = cvt_pk_bf16(v0[2], v0[3]); w.z = cvt_pk_bf16(v1[0], v1[1]); w.w = cvt_pk_bf16(v1[2], v1[3]);
                        *(PG8_LAS u32x4*)(buf + (wr * 16 + fr) * 272 + wc * 64 + 16 * fq) = w;
                        asm volatile("s_waitcnt lgkmcnt(0)" ::: "memory"); __builtin_amdgcn_s_barrier();
                        const u32x4 o = *(const PG8_LAS u32x4*)(buf + orow * 272 + oc);
                        __builtin_nontemporal_store(o, (u32x4*)(obase + ((size_t)(ai * HALF + m * 16) * NPROJ + bj * HALF) * 2)); }
        }
    }
};
struct P1F8Order {
    int G, c;
    __device__ __forceinline__ bool next(int i, Unit& u) const {
        constexpr int NT = P1_ALL_F8 ? 34 : 20;
        if (P1_ALL_F8 && G == 256) {
            const int x = c & 7, j = c >> 3; int U;
            if (j < 16) { if (i >= 16) return false; U = i * 32 + j; }
            else { if (i >= 18) return false; U = i < 16 ? i * 32 + j : 512 + (i - 16) * 16 + (j - 16); }
            const int h = U >= 272 ? 1 : 0, rest = U - 272 * h;
            const int v = rest >> 3, grp = v / 3, pos = v - 3 * grp;
            u.pm = 16 * x + 8 * h + (rest & 7); u.pn = v == 33 ? 33 : (pos == 1 ? 22 + grp : 2 * grp + (pos >> 1)); return true;
        }
        int L;
        if (!P1_ALL_F8 && G == 256) { const int cnt = c < 128 ? 9 : 11; if (i >= cnt) return false; L = (c < 128 ? c * 9 : 1152 + (c - 128) * 11) + i; }
        else { L = i * G + c; if (L >= 128 * NT) return false; }
        u.pm = L / NT; u.pn = L % NT; return true;
    }
    __device__ __forceinline__ void a_ready(const Unit&) const {}
    __device__ __forceinline__ void done(const Unit&) const {}
};
struct EpiMergeF {
    static constexpr bool PERM = true, HAS_MID = true; static constexpr int MID0 = 16, MID1 = 24;
    const unsigned char* gd; bf16_t* mb; PG8_LAS unsigned char* tb;
    static __device__ __forceinline__ float ub(unsigned w, int q) { return (float)((w >> (8 * q)) & 0xffu); }
    __device__ __forceinline__ void mid(f32x4 (&acc)[2][2][4][2], const Unit& u, int wr, int wc, int fr, int fq, int st) const {
        int toff = ((wr * 4 + wc) * 64 + fq * 16 + fr) * 16; asm volatile("" : "+v"(toff));
        const unsigned char* ga_ = gd + ((size_t)(st * 128 + u.pm) * 4 + u.pn) * 65536 + toff; const unsigned char* gb_ = ga_ + (size_t)128 * 4 * 65536;
        u32x4 ga[8], gb[8];
#pragma unroll
        for (int i = 0; i < 8; ++i) { ga[i] = __builtin_nontemporal_load((const u32x4*)(ga_ + i * 8192)); gb[i] = __builtin_nontemporal_load((const u32x4*)(gb_ + i * 8192)); }
#pragma unroll
        for (int ai = 0; ai < 2; ++ai)
#pragma unroll
            for (int m = 0; m < 4; ++m)
#pragma unroll
                for (int bj = 0; bj < 2; ++bj)
#pragma unroll
                    for (int h = 0; h < 2; ++h) { const unsigned wa = ga[ai * 4 + m][bj * 2 + h], wb = gb[ai * 4 + m][bj * 2 + h];
#pragma unroll
                        for (int q = 0; q < 4; ++q) acc[ai][bj][m][h][q] *= ub(wa, q) * __builtin_amdgcn_rcpf(ub(wb, q)); }
        asm volatile("" ::: "memory");
    }
    __device__ __forceinline__ void operator()(const f32x4 (&acc)[2][2][4][2], const Unit& u, int wr, int wc, int fr, int fq) const {
        const int t_ = (wr * 4 + wc) * 64 + fq * 16 + fr, orow = t_ >> 4, oc = (t_ & 15) * 16;
        const unsigned char* g2 = gd + ((size_t)(2 * 128 + u.pm) * 4 + u.pn) * 65536 + (size_t)((wr * 4 + wc) * 64 + fq * 16 + fr) * 16;
        u32x4 gw[8];
#pragma unroll
        for (int i = 0; i < 8; ++i) gw[i] = __builtin_nontemporal_load((const u32x4*)(g2 + i * 8192));
#pragma unroll
        for (int ai = 0; ai < 2; ++ai)
#pragma unroll
            for (int m = 0; m < 4; ++m) {
#pragma unroll
                for (int bj = 0; bj < 2; ++bj) { const unsigned w0 = gw[ai * 4 + m][bj * 2], w1 = gw[ai * 4 + m][bj * 2 + 1];
                    constexpr float k = 1.0f / 255.f; f32x4 g0, g1;
#pragma unroll
                    for (int q = 0; q < 4; ++q) { g0[q] = ub(w0, q) * k; g1[q] = ub(w1, q) * k; }
                    const f32x4 v0 = acc[ai][bj][m][0] * g0, v1 = acc[ai][bj][m][1] * g1;
                    u32x4 w; w.x = cvt_pk_bf16(v0[0], v0[1]); w.y = cvt_pk_bf16(v0[2], v0[3]); w.z = cvt_pk_bf16(v1[0], v1[1]); w.w = cvt_pk_bf16(v1[2], v1[3]);
                    stage_store16(tb + bj * 8704, w, wr, wc, fr, fq, orow, oc, (unsigned char*)(mb + (size_t)(u.pm * BM + (orow >> 4) * 64 + (orow & 15) + ai * HALF + m * 16) * 1024 + u.pn * BM + bj * HALF) + oc); } }
    }
};
struct EpiWout {
    static constexpr bool PERM = true, HAS_MID = false; static constexpr int MID0 = 0, MID1 = 0;
    __device__ __forceinline__ void mid(f32x4 (&)[2][2][4][2], const Unit&, int, int, int, int, int) const {}
    const bf16_t* xh; bf16_t* v; PG8_LAS unsigned char* tb;
    __device__ __forceinline__ void operator()(const f32x4 (&acc)[2][2][4][2], const Unit& u, int wr, int wc, int fr, int fq) const {
        const int row0 = u.pm * BM + wr * 64 + fr, col0 = u.pn * BM + wc * 32 + 8 * fq;
        const int t_ = (wr * 4 + wc) * 64 + fq * 16 + fr, orow = t_ >> 4, oc = (t_ & 15) * 16;
        u32x4 xw[2][4][2];
#pragma unroll
        for (int ai = 0; ai < 2; ++ai)
#pragma unroll
            for (int m = 0; m < 4; ++m) { const size_t off = (size_t)(row0 + ai * HALF + m * 16) * 1024 + col0;
#pragma unroll
                for (int bj = 0; bj < 2; ++bj) xw[ai][m][bj] = *(const u32x4*)(xh + off + bj * HALF); }
#pragma unroll
        for (int ai = 0; ai < 2; ++ai)
#pragma unroll
            for (int m = 0; m < 4; ++m) { const size_t off = (size_t)(row0 + ai * HALF + m * 16) * 1024 + col0;
#pragma unroll
                for (int bj = 0; bj < 2; ++bj) { const u32x4 w_ = xw[ai][m][bj];
                    const f32x4 x0 = (f32x4){bflo(w_.x), bfhi(w_.x), bflo(w_.y), bfhi(w_.y)}, x1 = (f32x4){bflo(w_.z), bfhi(w_.z), bflo(w_.w), bfhi(w_.w)};
                    const f32x4 v0 = x0 * DN_ALPHA + acc[ai][bj][m][0], v1 = x1 * DN_ALPHA + acc[ai][bj][m][1];
                    u32x4 w; w.x = cvt_pk_bf16(v0[0], v0[1]); w.y = cvt_pk_bf16(v0[2], v0[3]); w.z = cvt_pk_bf16(v1[0], v1[1]); w.w = cvt_pk_bf16(v1[2], v1[3]);
                    stage_store16(tb + bj * 8704, w, wr, wc, fr, fq, orow, oc, (unsigned char*)(v + (size_t)(u.pm * BM + (orow >> 4) * 64 + (orow & 15) + ai * HALF + m * 16) * 1024 + u.pn * BM + bj * HALF) + oc); } }
    }
};
struct EpiMoe1 {
    __device__ __forceinline__ void mid(f32x4 (&)[2][2][4][2], const Unit&, int, int, int, int, int) const {}
    static constexpr bool PERM = true, HAS_MID = false; static constexpr int MID0 = 0, MID1 = 0;
    bf16_t* act; const float* b1;
    __device__ __forceinline__ void operator()(const f32x4 (&acc)[2][2][4][2], const Unit& u, int wr, int wc, int fr, int fq) const {
        const int e = u.pn >> 3, tl = u.pn & 7;
        const int row0 = u.pm * BM + wr * 64 + fr, col0 = tl * 128 + wc * 32 + 8 * fq;
        const float* bp = b1 + (size_t)e * 2048 + col0;
        const f32x4 bg0 = *(const f32x4*)(bp), bg1 = *(const f32x4*)(bp + 4), bl0 = *(const f32x4*)(bp + 1024), bl1 = *(const f32x4*)(bp + 1028);
#pragma unroll
        for (int ai = 0; ai < 2; ++ai)
#pragma unroll
            for (int m = 0; m < 4; ++m) { bf16_t* rowp = act + (size_t)(row0 + ai * HALF + m * 16) * 1024 + col0;
                f32x4 o[2];
#pragma unroll
                for (int n = 0; n < 2; ++n) { const f32x4 gg = acc[ai][0][m][n] + (n ? bg1 : bg0), ll = acc[ai][1][m][n] + (n ? bl1 : bl0);
#pragma unroll
                    for (int q = 0; q < 4; ++q) { const float gv = fminf(gg[q], 7.0f), lv = fminf(fmaxf(ll[q], -7.0f), 7.0f);
                        o[n][q] = gv * sigmoid_f(1.702f * gv) * (lv + 1.0f); } }
                u32x4 w; w.x = cvt_pk_bf16(o[0][0], o[0][1]); w.y = cvt_pk_bf16(o[0][2], o[0][3]); w.z = cvt_pk_bf16(o[1][0], o[1][1]); w.w = cvt_pk_bf16(o[1][2], o[1][3]);
                *(u32x4*)(rowp) = w; }
    }
};
struct EpiMoe2 {
    __device__ __forceinline__ void mid(f32x4 (&)[2][2][4][2], const Unit&, int, int, int, int, int) const {}
    static constexpr bool PERM = true, HAS_MID = false; static constexpr int MID0 = 0, MID1 = 0;
    bf16_t* ys; const float* b2; const float* wbuf;
    __device__ __forceinline__ void operator()(const f32x4 (&acc)[2][2][4][2], const Unit& u, int wr, int wc, int fr, int fq) const {
        const int e = u.pn >> 2, tl = u.pn & 3;
        const int row0 = u.pm * BM + wr * 64 + fr, col0 = tl * 256 + wc * 32 + 8 * fq;
        const float* bp = b2 + (size_t)e * 1024 + col0;
        f32x4 bv[2][2];
#pragma unroll
        for (int bj = 0; bj < 2; ++bj) { bv[bj][0] = *(const f32x4*)(bp + bj * HALF); bv[bj][1] = *(const f32x4*)(bp + bj * HALF + 4); }
#pragma unroll
        for (int ai = 0; ai < 2; ++ai)
#pragma unroll
            for (int m = 0; m < 4; ++m) { const int row = row0 + ai * HALF + m * 16; const float ww = wbuf[row]; bf16_t* rowp = ys + (size_t)row * 1024 + col0;
#pragma unroll
                for (int bj = 0; bj < 2; ++bj) { const f32x4 v0 = (acc[ai][bj][m][0] + bv[bj][0]) * ww, v1 = (acc[ai][bj][m][1] + bv[bj][1]) * ww;
                    u32x4 w; w.x = cvt_pk_bf16(v0[0], v0[1]); w.y = cvt_pk_bf16(v0[2], v0[3]); w.z = cvt_pk_bf16(v1[0], v1[1]); w.w = cvt_pk_bf16(v1[2], v1[3]);
                    *(u32x4*)(rowp + bj * HALF) = w; } }
    }
};
struct EpiMoe1F8 {
    static constexpr bool PERM = true, HAS_MID = false; static constexpr int MID0 = 0, MID1 = 0;
    __device__ __forceinline__ void mid(f32x4 (&)[2][2][4][2], const Unit&, int, int, int, int, int) const {}
    static constexpr bool HAS_PRE = true;
    unsigned char* act8; const float* b1; PG8_LAS unsigned char* pl;
    __device__ __forceinline__ void pre(const Unit& u, int ui, int wid, int lane) const {
        if (wid < 4) { const float* src = b1 + (size_t)(u.pn >> 3) * 2048 + (u.pn & 7) * 128 + (wid >> 1) * 1024 + (wid & 1) * 64 + lane;
            __builtin_amdgcn_global_load_lds((const unsigned*)src, (PG8_LAS unsigned*)(pl + (ui & 1) * 1024 + wid * 256), 4, 0, 0); }
    }
    __device__ __forceinline__ void operator()(const f32x4 (&acc)[2][2][4][2], const Unit& u, int wr, int wc, int fr, int fq, int ui) const {
        const int tl = u.pn & 7;
        const int row0 = u.pm * BM + wr * 64 + fr, col0 = tl * 128 + wc * 32 + 8 * fq;
        const PG8_LAS float* bp = (const PG8_LAS float*)(pl + (ui & 1) * 1024) + wc * 32 + 8 * fq;
        const f32x4 bg0 = *(const PG8_LAS f32x4*)(bp), bg1 = *(const PG8_LAS f32x4*)(bp + 4), bl0 = *(const PG8_LAS f32x4*)(bp + 128), bl1 = *(const PG8_LAS f32x4*)(bp + 132);
        constexpr float sc = (PROBE_PH == 70 ? 0.5f : 1.0f) / (F8_SX * F8_SW1), scl = sc * F8_SA, kk = -1.702f * 1.4426950408889634f;
        f32x2 bgp[4], blp[4];
#pragma unroll
        for (int q = 0; q < 2; ++q) { bgp[q] = (f32x2){bg0[2 * q], bg0[2 * q + 1]}; bgp[2 + q] = (f32x2){bg1[2 * q], bg1[2 * q + 1]};
            blp[q] = ((f32x2){bl0[2 * q], bl0[2 * q + 1]} + 1.0f) * F8_SA; blp[2 + q] = ((f32x2){bl1[2 * q], bl1[2 * q + 1]} + 1.0f) * F8_SA; }
#pragma unroll
        for (int ai = 0; ai < 2; ++ai)
#pragma unroll
            for (int m = 0; m < 4; ++m) { unsigned char* rowp = act8 + (size_t)(row0 + ai * HALF + m * 16) * 1024 + col0;
                f32x2 o[4];
#pragma unroll
                for (int n = 0; n < 2; ++n)
#pragma unroll
                    for (int q = 0; q < 2; ++q) { const f32x2 ag = {acc[ai][0][m][n][2 * q], acc[ai][0][m][n][2 * q + 1]}, al = {acc[ai][1][m][n][2 * q], acc[ai][1][m][n][2 * q + 1]};
                        f32x2 gv = ag * sc + bgp[2 * n + q], lv = al * scl + blp[2 * n + q];
                        gv.x = fminf(gv.x, 7.0f); gv.y = fminf(gv.y, 7.0f);
                        lv.x = __builtin_amdgcn_fmed3f(lv.x, -6.0f * F8_SA, 8.0f * F8_SA); lv.y = __builtin_amdgcn_fmed3f(lv.y, -6.0f * F8_SA, 8.0f * F8_SA);
                        const f32x2 ex = gv * kk; f32x2 d; d.x = __builtin_amdgcn_exp2f(ex.x); d.y = __builtin_amdgcn_exp2f(ex.y); d = d + 1.0f;
                        f32x2 r; r.x = __builtin_amdgcn_rcpf(d.x); r.y = __builtin_amdgcn_rcpf(d.y);
                        o[2 * n + q] = gv * r * lv; }
                u32x2 w; w.x = pk_fp8x4(o[0].x, o[0].y, o[1].x, o[1].y); w.y = pk_fp8x4(o[2].x, o[2].y, o[3].x, o[3].y);
                *(u32x2*)(rowp) = w; }
    }
};
struct EpiMoe2F8 {
    static constexpr bool PERM = true, HAS_MID = false; static constexpr int MID0 = 0, MID1 = 0;
    __device__ __forceinline__ void mid(f32x4 (&)[2][2][4][2], const Unit&, int, int, int, int, int) const {}
    static constexpr bool HAS_PRE = true;
    unsigned char* ys8; const float* b2; const float* wbuf; PG8_LAS unsigned char* pl;
    __device__ __forceinline__ void pre(const Unit& u, int ui, int wid, int lane) const {
        if (wid < 4) __builtin_amdgcn_global_load_lds((const unsigned*)(b2 + (size_t)(u.pn >> 2) * 1024 + (u.pn & 3) * 256 + wid * 64 + lane), (PG8_LAS unsigned*)(pl + (ui & 1) * 2048 + wid * 256), 4, 0, 0);
        else __builtin_amdgcn_global_load_lds((const unsigned*)(wbuf + (size_t)u.pm * 256 + (wid - 4) * 64 + lane), (PG8_LAS unsigned*)(pl + (ui & 1) * 2048 + 1024 + (wid - 4) * 256), 4, 0, 0);
    }
    __device__ __forceinline__ void operator()(const f32x4 (&acc)[2][2][4][2], const Unit& u, int wr, int wc, int fr, int fq, int ui) const {
        const int tl = u.pn & 3;
        const int row0 = u.pm * BM + wr * 64 + fr, col0 = tl * 256 + wc * 32 + 8 * fq;
        const PG8_LAS float* bp = (const PG8_LAS float*)(pl + (ui & 1) * 2048) + wc * 32 + 8 * fq; const PG8_LAS float* wb = (const PG8_LAS float*)(pl + (ui & 1) * 2048 + 1024) + wr * 64 + fr;
        constexpr float sc = (PROBE_PH == 80 ? 0.5f : 1.0f) / (F8_SA * F8_SW2);
        f32x4 bv[2][2]; float ww[2][4];
#pragma unroll
        for (int bj = 0; bj < 2; ++bj) { bv[bj][0] = *(const PG8_LAS f32x4*)(bp + bj * HALF); bv[bj][1] = *(const PG8_LAS f32x4*)(bp + bj * HALF + 4); }
#pragma unroll
        for (int ai = 0; ai < 2; ++ai)
#pragma unroll
            for (int m = 0; m < 4; ++m) ww[ai][m] = wb[ai * HALF + m * 16] * F8_SY;
        PG8_LAS unsigned char* tb = pl - 20480;
        const int t_ = (wr * 4 + wc) * 64 + fq * 16 + fr, orow = t_ >> 4, oc = (t_ & 15) * 16;
        unsigned char* obase = ys8 + (size_t)(u.pm * BM + (orow >> 4) * 64 + (orow & 15)) * 1024 + tl * 256 + oc;
#pragma unroll
        for (int ai = 0; ai < 2; ++ai)
#pragma unroll
            for (int m = 0; m < 4; ++m) { const float w_ = ww[ai][m]; PG8_LAS unsigned char* buf = tb + ((ai * 4 + m) & 1) * 8704;
#pragma unroll
                for (int bj = 0; bj < 2; ++bj) { const f32x4 v0 = (acc[ai][bj][m][0] * sc + bv[bj][0]) * w_, v1 = (acc[ai][bj][m][1] * sc + bv[bj][1]) * w_;
                    u32x2 w; w.x = pk_fp8x4(v0[0], v0[1], v0[2], v0[3]); w.y = pk_fp8x4(v1[0], v1[1], v1[2], v1[3]);
                    *(PG8_LAS u32x2*)(buf + (wr * 16 + fr) * 272 + wc * 32 + 8 * fq + bj * HALF) = w; }
                asm volatile("s_waitcnt lgkmcnt(0)" ::: "memory"); __builtin_amdgcn_s_barrier();
                const u32x4 o = *(const PG8_LAS u32x4*)(buf + orow * 272 + oc);
                __builtin_nontemporal_store(o, (u32x4*)(obase + (size_t)(ai * HALF + m * 16) * 1024)); }
    }
};
struct EpiNull8 {
    static constexpr bool PERM = true, HAS_MID = false, HAS_PRE = false; static constexpr int MID0 = 0, MID1 = 0;
    __device__ __forceinline__ void mid(f32x4 (&)[2][2][4][2], const Unit&, int, int, int, int, int) const {}
    __device__ __forceinline__ void operator()(const f32x4 (&)[2][2][4][2], const Unit&, int, int, int, int) const {}
};
__device__ __forceinline__ long moe_L(int i, int c, int G, int total, int nN) {
    if (G == 256) { const int x = c >> 5, j = c & 31, per = ((total / nN + 7) >> 3) * nN, Ul = i * 32 + j;
        if (Ul >= per) return -1; const long L = (long)x * per + Ul; return L < total ? L : -1; }
    const long L = (long)i * G + c; return L < total ? L : -1;
}
struct MoeOrder {
    int nN, G, c, total; const LAS int* blk_e;
    __device__ __forceinline__ bool next(int i, Unit& u) const {
        const long L = moe_L(i, c, G, total, nN); if (L < 0) return false;
        const int rb = (int)(L / nN), tl = (int)(L % nN); u.pm = rb; u.pn = blk_e[rb] * nN + tl; return true;
    }
    __device__ __forceinline__ void a_ready(const Unit&) const {}
    __device__ __forceinline__ void done(const Unit&) const {}
};
}
struct Args { const float* in[30]; float* out; unsigned char* ws; int ph_lo, ph_hi, li, pad; };
typedef const __attribute__((address_space(4))) Args* ArgsP;
enum { I_X = 0, I_WIN, I_LCW, I_LCB, I_LWA, I_LBA, I_LWX, I_LBX, I_LLAM, I_MIB, I_MFB, I_MNG, I_GCW, I_GAL, I_GDT, I_GNG, I_WBA, I_WBB, I_WBC, I_WOUT, I_LN1G, I_LN1B, I_RW, I_RB, I_W1, I_B1, I_W2, I_B2, I_LN2G, I_LN2B };

template <int MODE> __device__ __forceinline__ int col_map(int n) {
    if (MODE == 1) {
        if (n < 1024) return n;
        if (n < 2048) return 3840 + (n - 1024);
        if (n < 2304) return 1024 + (n - 2048);
        if (n < 2560) return 1280 + (n - 2304);
        if (n < 3072) return 1536 + (n - 2560);
        if (n < 3076) return 3584 + (n - 3072);
        if (n < 3080) return 3588 + (n - 3076);
        if (n < 3592) return 3840 + 1024 + (n - 3080);
        if (n < 4104) return 2048 + (n - 3592);
        if (n < 4616) return 2560 + (n - 4104);
        if (n < 5128) return 3072 + (n - 4616);
        if (n < 5136) return 3592 + (n - 5128);
        if (n < 5144) return 3600 + (n - 5136);
        if (n < 5656) return 3840 + 1536 + (n - 5144);
        return 3840 + 2048 + (n - 5656);
    } else if (MODE == 2) {
        if (n < 1024) return (n >> 7) * 256 + (n & 127);
        const int q = n - 1024; return (q >> 7) * 256 + 128 + (q & 127);
    }
    return n;
}
struct TrItem { const float* W; bf16_t* WT; int N, ldk, koff, mode, k0, n0; float f8s; };
__device__ __forceinline__ int col_map_rt(int mode, int n) { return mode == 1 ? col_map<1>(n) : (mode == 2 ? col_map<2>(n) : n); }
constexpr int IT_IN = 16 * 273, IT_BRA = 16 * 32, IT_BRB = 8 * 32, IT_BRC = 8 * 32, IT_OUT = 16 * 32, IT_W1 = 32 * 16 * 64, IT_W2 = 32 * 16 * 32;
constexpr int IT_G = 8 * 2 * 8;
constexpr int IT_LAYER = IT_IN + IT_BRA + IT_BRB + IT_BRC + IT_OUT + IT_W1 + IT_W2 + IT_G;
__device__ __forceinline__ TrItem tr_decode(ArgsP a, int it) {
    const int l = it / IT_LAYER; int r = it - l * IT_LAYER; unsigned char* wl = a->ws + WS_W + (size_t)l * WL_STRIDE; TrItem t;
    if (r < IT_IN) { t = TrItem{a->in[I_WIN] + (size_t)l * 1024 * DIN, (bf16_t*)(wl + WL_IN), DIN, 1024, 0, 1, 64 * (r / 273), 32 * (r % 273), 0.f}; return t; } r -= IT_IN;
    if (r < IT_BRA) { t = TrItem{a->in[I_WBA] + (size_t)l * 1024 * 1024, (bf16_t*)(wl + WL_BR), 1024, 2048, 0, 0, 64 * (r / 32), 32 * (r % 32), 0.f}; return t; } r -= IT_BRA;
    if (r < IT_BRB) { t = TrItem{a->in[I_WBB] + (size_t)l * 512 * 1024, (bf16_t*)(wl + WL_BR), 1024, 2048, 1024, 0, 64 * (r / 32), 32 * (r % 32), 0.f}; return t; } r -= IT_BRB;
    if (r < IT_BRC) { t = TrItem{a->in[I_WBC] + (size_t)l * 512 * 1024, (bf16_t*)(wl + WL_BR), 1024, 2048, 1536, 0, 64 * (r / 32), 32 * (r % 32), 0.f}; return t; } r -= IT_BRC;
    if (r < IT_OUT) { t = TrItem{a->in[I_WOUT] + (size_t)l * 1024 * 1024, (bf16_t*)(wl + WL_OUT), 1024, 1024, 0, 0, 64 * (r / 32), 32 * (r % 32), 0.f}; return t; } r -= IT_OUT;
    if (r < IT_W1) { const int e = r / 1024, q = r % 1024; t = TrItem{a->in[I_W1] + ((size_t)l * NE + e) * 1024 * 2048, (bf16_t*)(wl + WL_W1 + (size_t)e * 2048 * 1024), 2048, 1024, 0, 2, 64 * (q / 64), 32 * (q % 64), F8_SW1}; return t; } r -= IT_W1;
    if (r < IT_W2) { const int e = r / 512, q = r % 512; t = TrItem{a->in[I_W2] + ((size_t)l * NE + e) * 1024 * 1024, (bf16_t*)(wl + WL_W2 + (size_t)e * 1024 * 1024), 1024, 1024, 0, 0, 64 * (q / 32), 32 * (q % 32), F8_SW2}; return t; } r -= IT_W2;
    { const int h = r >> 4, gate = (r >> 3) & 1, q = r & 7;
      t = TrItem{a->in[gate ? I_LWX : I_LWA] + ((size_t)l * 8 + h) * 128 * 128, (bf16_t*)(wl + WL_G) + (size_t)(h * 256 + gate * 128) * 128, 128, 128, 0, 0, 64 * (q >> 2), 32 * (q & 3), 0.f}; return t; }
}
__device__ __forceinline__ void p0_convert(ArgsP a, LAS unsigned char* lds, int G) {
    int tid_ = threadIdx.x; asm volatile("" : "+v"(tid_)); const int tid = tid_, lane = tid & 63, wave = tid >> 6;
    LAS float* scr = (LAS float*)(lds + wave * 16384);
    const int gw = blockIdx.x * NWAVES + wave, NGW = G * NWAVES;
    f32x4 v[8];
#define TR_LOAD(t_) do { const int nsrc_ = (t_).n0 + 4 * (lane & 7); const float* p_ = (t_).W + (size_t)((t_).k0 + (lane >> 3)) * (t_).N + nsrc_; \
        _Pragma("unroll") for (int i = 0; i < 8; ++i) { if (nsrc_ + 3 < (t_).N) v[i] = *(const f32x4*)(p_ + (size_t)(8 * i) * (t_).N); \
            else { const float* q_ = p_ + (size_t)(8 * i) * (t_).N; v[i] = (f32x4){nsrc_ < (t_).N ? q_[0] : 0.f, nsrc_ + 1 < (t_).N ? q_[1] : 0.f, nsrc_ + 2 < (t_).N ? q_[2] : 0.f, 0.f}; } } } while (0)
    TrItem cur = tr_decode(a, gw < 2 * IT_LAYER ? gw : 0);
    if (gw < 2 * IT_LAYER) TR_LOAD(cur);
    for (int it = gw; it < 2 * IT_LAYER; it += NGW) {
#pragma unroll
        for (int i = 0; i < 8; ++i) { LAS float* d_ = scr + (8 * i + (lane >> 3)) * 33 + 4 * (lane & 7); d_[0] = v[i][0]; d_[1] = v[i][1]; d_[2] = v[i][2]; d_[3] = v[i][3]; }
        const TrItem me = cur;
        if (it + NGW < 2 * IT_LAYER) { cur = tr_decode(a, it + NGW); TR_LOAD(cur); }
        LDS_WAIT(); asm volatile("" ::: "memory");
        const int c = lane & 7;
#pragma unroll
        for (int j = 0; j < 4; ++j) { const int nl = (lane >> 3) + 8 * j, n = me.n0 + nl; const LAS float* s = scr + (8 * c) * 33 + nl;
            if (me.mode == 1) { const int vr_ = col_map<1>(n < me.N ? n : 0);
                if (n < me.N) { if (vr_ < NIN_BF && (!P1_ALL_F8 || vr_ >= 3584)) { u32x4 o; o.x = pk2(s[0 * 33], s[1 * 33]); o.y = pk2(s[2 * 33], s[3 * 33]); o.z = pk2(s[4 * 33], s[5 * 33]); o.w = pk2(s[6 * 33], s[7 * 33]);
                        *(u32x4*)(me.WT + (size_t)vr_ * 1024 + me.k0 + 8 * c) = o; }
                    else { const float f = F8_SWI; u32x2 o8; o8.x = pk_fp8x4(s[0 * 33] * f, s[1 * 33] * f, s[2 * 33] * f, s[3 * 33] * f); o8.y = pk_fp8x4(s[4 * 33] * f, s[5 * 33] * f, s[6 * 33] * f, s[7 * 33] * f);
                        *(u32x2*)((unsigned char*)me.WT + WL_IN8 + (size_t)(P1_ALL_F8 ? (vr_ < NIN_BF ? vr_ : vr_ - 256) : vr_ - NIN_BF) * 1024 + me.k0 + 8 * c) = o8; } } }
            else if (me.f8s != 0.f) { const float f = me.f8s; u32x2 o8; o8.x = pk_fp8x4(s[0 * 33] * f, s[1 * 33] * f, s[2 * 33] * f, s[3 * 33] * f); o8.y = pk_fp8x4(s[4 * 33] * f, s[5 * 33] * f, s[6 * 33] * f, s[7 * 33] * f);
                if (n < me.N) *(u32x2*)((unsigned char*)me.WT + (size_t)col_map_rt(me.mode, n) * me.ldk + me.koff + me.k0 + 8 * c) = o8; }
            else { u32x4 o; o.x = pk2(s[0 * 33], s[1 * 33]); o.y = pk2(s[2 * 33], s[3 * 33]); o.z = pk2(s[4 * 33], s[5 * 33]); o.w = pk2(s[6 * 33], s[7 * 33]);
                if (n < me.N) *(u32x4*)(me.WT + (size_t)col_map_rt(me.mode, n) * me.ldk + me.koff + me.k0 + 8 * c) = o; } }
        LDS_WAIT(); asm volatile("" ::: "memory");
    }
#undef TR_LOAD
    const size_t gt = (size_t)blockIdx.x * 512 + tid, GT = (size_t)G * 512;
    for (size_t i = gt; i < (size_t)2 * 232 * 128; i += GT) { const int l = (int)(i / (232 * 128)); const size_t q = i % (232 * 128);
        *(u32x4*)(a->ws + WS_W + (size_t)l * WL_STRIDE + WL_IN + ((size_t)3608 * 1024) * 2 + q * 16) = (u32x4){0u, 0u, 0u, 0u}; }
    for (size_t i = gt; i < (size_t)2 * 32 * 1024; i += GT) { const int l = (int)(i >> 15), k = (int)((i >> 5) & 1023), e = (int)(i & 31); const float w = a->in[I_RW][i];
        const unsigned hb = f2bf(w); const float lo = w - bf2f((unsigned short)hb); bf16_t* dst = (bf16_t*)(a->ws + WS_RWB) + (size_t)l * 2 * 32 * 1024;
        dst[(size_t)e * 1024 + k] = (bf16_t)hb; dst[(size_t)(32 + e) * 1024 + k] = (bf16_t)f2bf(lo); }
    const float* x = a->in[I_X]; bf16_t* xb = (bf16_t*)(a->ws + WS_XB);
    for (size_t i = gt; i < (size_t)T_ * D_ / 8; i += GT) { const f32x4 v0 = *(const f32x4*)(x + i * 8), v1 = *(const f32x4*)(x + i * 8 + 4);
        u32x4 w; w.x = pk2(v0[0], v0[1]); w.y = pk2(v0[2], v0[3]); w.z = pk2(v1[0], v1[1]); w.w = pk2(v1[2], v1[3]); *(u32x4*)(xb + i * 8) = w;
        u32x2 q8; q8.x = pk_fp8x4(v0[0] * F8_SX, v0[1] * F8_SX, v0[2] * F8_SX, v0[3] * F8_SX); q8.y = pk_fp8x4(v1[0] * F8_SX, v1[1] * F8_SX, v1[2] * F8_SX, v1[3] * F8_SX); *(u32x2*)(a->ws + WS_X2 + i * 8) = q8; }
}

constexpr int TB = 32;
__device__ __forceinline__ void lru_naive(ArgsP a, int l, int u, LAS unsigned char* lds, const bf16_t* proj, bf16_t* H) {
    int tid_ = threadIdx.x; asm volatile("" : "+v"(tid_)); const int tid = tid_, b = u >> 3, h = u & 7, c = tid >> 2, p = tid & 3, chg = h * 128 + c;
    const float* wa = a->in[I_LWA] + ((size_t)l * 8 + h) * 128 * 128; const float* wx = a->in[I_LWX] + ((size_t)l * 8 + h) * 128 * 128;
    float wra[32], wrx[32];
#pragma unroll
    for (int i = 0; i < 32; ++i) { wra[i] = wa[(p * 32 + i) * 128 + c]; wrx[i] = wx[(p * 32 + i) * 128 + c]; }
    const float ba = a->in[I_LBA][l * 1024 + chg], bx = a->in[I_LBX][l * 1024 + chg];
    const float sp = softplus_f(-a->in[I_LLAM][l * 1024 + chg]);
    const float* cw = a->in[I_LCW] + (size_t)l * 4 * 1024 + chg; const float cw0 = cw[0], cw1 = cw[1024], cw2 = cw[2048], cw3 = cw[3072], cb = a->in[I_LCB][l * 1024 + chg];
    LAS bf16_t* xs = (LAS bf16_t*)(lds);
    LAS bf16_t* ys = (LAS bf16_t*)(lds + 8192);
    LAS float* xa_s = (LAS float*)(lds + 16384);
    const int srow = tid >> 4, scol = (tid & 15) * 8;
    const size_t tok0 = (size_t)b * SEQ_;
    u32x4 px = *(const u32x4*)(proj + (tok0 + srow) * NPROJ + PC_LRUX + h * 128 + scol);
    u32x4 py = *(const u32x4*)(proj + (tok0 + srow) * NPROJ + PC_LRUY + h * 128 + scol);
    float hs = 0.f, x1 = 0.f, x2 = 0.f, x3 = 0.f;
    for (int blk = 0; blk < SEQ_ / TB; ++blk) {
        __syncthreads();
        *(LAS u32x4*)(xs + srow * 128 + scol) = px; *(LAS u32x4*)(ys + srow * 128 + scol) = py;
        __syncthreads();
        if (blk + 1 < SEQ_ / TB) { const size_t tk = tok0 + (size_t)(blk + 1) * TB + srow;
            px = *(const u32x4*)(proj + tk * NPROJ + PC_LRUX + h * 128 + scol); py = *(const u32x4*)(proj + tk * NPROJ + PC_LRUY + h * 128 + scol); }
        for (int s = 0; s < TB; ++s) {
            const float xraw = bf2f(xs[s * 128 + c]);
            const float xa = cw0 * x3 + cw1 * x2 + cw2 * x1 + cw3 * xraw + cb;
            x3 = x2; x2 = x1; x1 = xraw;
            LAS float* xb_ = xa_s + (s & 1) * 128;
            if (p == 0) xb_[c] = xa;
            __syncthreads();
            float sa = 0.f, sx = 0.f;
#pragma unroll
            for (int i4 = 0; i4 < 8; ++i4) { const f32x4 xv = *(const LAS f32x4*)(xb_ + p * 32 + i4 * 4);
#pragma unroll
                for (int q = 0; q < 4; ++q) { sa += xv[q] * wra[i4 * 4 + q]; sx += xv[q] * wrx[i4 * 4 + q]; } }
            sa += __shfl_xor(sa, 1); sa += __shfl_xor(sa, 2); sx += __shfl_xor(sx, 1); sx += __shfl_xor(sx, 2);
            const float r = 1.f / (1.f + __expf(-(sa + ba))), ig = 1.f / (1.f + __expf(-(sx + bx)));
            const float log_a = -8.0f * r * sp, av = __expf(log_a), mult = sqrtf(-expm1f(2.0f * log_a));
            hs = av * hs + mult * (ig * xa);
            if (p == 0) { const float y = bf2f(ys[s * 128 + c]);
                H[(tok0 + (size_t)blk * TB + s) * 2048 + chg] = (bf16_t)f2bf(hs * gelu_tanh_f(y)); }
        }
    }
}
__device__ __forceinline__ void mlstm_naive(ArgsP a, int l, int u, LAS unsigned char* lds, const bf16_t* proj, const float* gsm, bf16_t* H) {
    int tid_ = threadIdx.x; asm volatile("" : "+v"(tid_)); const int tid = tid_, lane = tid & 63, wave = tid >> 6, b = u >> 2, hd = u & 3, j = tid & 127;
    LAS float* qs = (LAS float*)(lds);
    LAS float* ks = (LAS float*)(lds + 8192);
    LAS float* vs = (LAS float*)(lds + 16384);
    LAS float* os = (LAS float*)(lds + 32768);
    LAS float* gi = (LAS float*)(lds + 49152);
    LAS float* gf = (LAS float*)(lds + 49152 + 128);
    LAS float* red = (LAS float*)(lds + 49152 + 256);
    const float ib = a->in[I_MIB][l * 4 + hd], fb = a->in[I_MFB][l * 4 + hd], gn = a->in[I_MNG][(size_t)l * 512 + hd * 128 + j];
    const size_t tok0 = (size_t)b * SEQ_;
    const int qa_row = (tid & 255) >> 3, qa_c8 = (tid & 7) * 8; const int qa_col = (tid < 256 ? PC_MLQ : PC_MLK) + hd * 64 + qa_c8;
    const int vb_row = tid >> 4, vb_c8 = (tid & 15) * 8;
    u32x4 pa, pb, pc; float pg = 0.f;
#define ML_ISSUE(blk_) do { const size_t t0 = tok0 + (size_t)(blk_) * TB; \
        pa = *(const u32x4*)(proj + (t0 + qa_row) * NPROJ + qa_col); \
        pb = *(const u32x4*)(proj + (t0 + vb_row) * NPROJ + PC_MLV + hd * 128 + vb_c8); \
        pc = *(const u32x4*)(proj + (t0 + vb_row) * NPROJ + PC_MLO + hd * 128 + vb_c8); \
        if (tid < 64) pg = gsm[(t0 + (tid & 31)) * 32 + (tid < 32 ? 0 : 4) + hd]; } while (0)
    ML_ISSUE(0);
    float C[64], n[64];
#pragma unroll
    for (int r = 0; r < 64; ++r) { C[r] = 0.f; n[r] = 0.f; }
    for (int blk = 0; blk < SEQ_ / TB; ++blk) {
        __syncthreads();
        { LAS float* d = (tid < 256 ? qs : ks) + qa_row * 64 + qa_c8;
          *(LAS f32x4*)(d) = (f32x4){bflo(pa.x), bfhi(pa.x), bflo(pa.y), bfhi(pa.y)}; *(LAS f32x4*)(d + 4) = (f32x4){bflo(pa.z), bfhi(pa.z), bflo(pa.w), bfhi(pa.w)};
          LAS float* dv = vs + vb_row * 128 + vb_c8;
          *(LAS f32x4*)(dv) = (f32x4){bflo(pb.x), bfhi(pb.x), bflo(pb.y), bfhi(pb.y)}; *(LAS f32x4*)(dv + 4) = (f32x4){bflo(pb.z), bfhi(pb.z), bflo(pb.w), bfhi(pb.w)};
          LAS float* dz = os + vb_row * 128 + vb_c8;
          *(LAS f32x4*)(dz) = (f32x4){bflo(pc.x), bfhi(pc.x), bflo(pc.y), bfhi(pc.y)}; *(LAS f32x4*)(dz + 4) = (f32x4){bflo(pc.z), bfhi(pc.z), bflo(pc.w), bfhi(pc.w)};
          if (tid < 32) gi[tid] = pg; else if (tid < 64) gf[tid - 32] = pg; }
        __syncthreads();
        if (blk + 1 < SEQ_ / TB) ML_ISSUE(blk + 1);
        for (int s = 0; s < TB; ++s) {
            float hj = 0.f;
            if (tid < 128) {
                const float f = 1.f / (1.f + __expf(-(gf[s] + fb))), ie = __expf(gi[s] + ib);
                const float vj = vs[s * 128 + j];
                float num = 0.f, den = 0.f;
#pragma unroll
                for (int r4 = 0; r4 < 16; ++r4) { const f32x4 kk = *(const LAS f32x4*)(ks + s * 64 + r4 * 4), qq = *(const LAS f32x4*)(qs + s * 64 + r4 * 4);
#pragma unroll
                    for (int q = 0; q < 4; ++q) { const int r = r4 * 4 + q; const float ik = ie * kk[q];
                        C[r] = f * C[r] + ik * vj; n[r] = f * n[r] + ik; num += qq[q] * C[r]; den += qq[q] * n[r]; } }
                num *= 0.125f; den *= 0.125f;
                hj = num / fmaxf(fabsf(den), 1.0f);
                const float ss = wave_sum(hj * hj);
                if (lane == 0) red[(s & 1) * 2 + wave] = ss;
            }
            __syncthreads();
            if (tid < 128) {
                const float tot = red[(s & 1) * 2] + red[(s & 1) * 2 + 1];
                const float o = hj * rsqrtf(tot * (1.0f / 128.0f) + RMS_EPS) * gn * sigmoid_f(os[s * 128 + j]);
                H[(tok0 + (size_t)blk * TB + s) * 2048 + 1024 + hd * 128 + j] = (bf16_t)f2bf(o);
            }
        }
    }
}
__device__ __forceinline__ void gdn_naive(ArgsP a, int l, int u, LAS unsigned char* lds, const bf16_t* proj, const float* gsm, bf16_t* H) {
    int tid_ = threadIdx.x; asm volatile("" : "+v"(tid_)); const int tid = tid_, lane = tid & 63, b = u >> 3, hd = u & 7;
    LAS float* rq = (LAS float*)(lds);
    LAS float* rk = (LAS float*)(lds + 9216);
    LAS float* rv = (LAS float*)(lds + 18432);
    LAS float* zs = (LAS float*)(lds + 27648);
    LAS float* ga = (LAS float*)(lds + 27648 + 8192);
    LAS float* gb = ga + TB;
    const float* cw = a->in[I_GCW] + (size_t)l * 4 * 1536;
    float cq[4], ck[4], cv[4];
#pragma unroll
    for (int i = 0; i < 4; ++i) { cq[i] = cw[i * 1536 + hd * 64 + lane]; ck[i] = cw[i * 1536 + 512 + hd * 64 + lane]; cv[i] = cw[i * 1536 + 1024 + hd * 64 + lane]; }
    const float nexpA = -__expf(a->in[I_GAL][l * 8 + hd]), dtb = a->in[I_GDT][l * 8 + hd], gn = a->in[I_GNG][l * 64 + lane];
    const size_t tok0 = (size_t)b * SEQ_;
    u32x4 pp[3]; float pg = 0.f;
#define GD_ISSUE(blk_) do { const int tl0 = (blk_) * TB; \
        _Pragma("unroll") for (int i = 0; i < 3; ++i) { const int pid = tid + 512 * i; pp[i] = (u32x4){0u, 0u, 0u, 0u}; \
            if (pid < 840) { const int arr = pid / 280, rem = pid % 280, row = rem >> 3, c8 = (rem & 7) * 8; const int tl = tl0 - 3 + row; \
                if (tl >= 0) pp[i] = *(const u32x4*)(proj + (tok0 + tl) * NPROJ + (arr == 0 ? PC_GDQ : (arr == 1 ? PC_GDK : PC_GDV)) + hd * 64 + c8); } \
            else if (pid < 1096) { const int zp = pid - 840, row = zp >> 3, c8 = (zp & 7) * 8; \
                pp[i] = *(const u32x4*)(proj + (tok0 + tl0 + row) * NPROJ + PC_GDZ + hd * 64 + c8); } } \
        if (tid < 64) pg = gsm[(tok0 + tl0 + (tid & 31)) * 32 + (tid < 32 ? 8 : 16) + hd]; } while (0)
    GD_ISSUE(0);
    float S[64];
#pragma unroll
    for (int i = 0; i < 64; ++i) S[i] = 0.f;
    for (int blk = 0; blk < SEQ_ / TB; ++blk) {
        __syncthreads();
#pragma unroll
        for (int i = 0; i < 3; ++i) { const int pid = tid + 512 * i; LAS float* d = nullptr;
            if (pid < 840) { const int arr = pid / 280, rem = pid % 280, row = rem >> 3, c8 = (rem & 7) * 8; d = (arr == 0 ? rq : (arr == 1 ? rk : rv)) + row * 64 + c8; }
            else if (pid < 1096) { const int zp = pid - 840, row = zp >> 3, c8 = (zp & 7) * 8; d = zs + row * 64 + c8; }
            if (pid < 1096) { const u32x4 w = pp[i];
                *(LAS f32x4*)(d) = (f32x4){bflo(w.x), bfhi(w.x), bflo(w.y), bfhi(w.y)}; *(LAS f32x4*)(d + 4) = (f32x4){bflo(w.z), bfhi(w.z), bflo(w.w), bfhi(w.w)}; } }
        if (tid < 32) ga[tid] = pg; else if (tid < 64) gb[tid - 32] = pg;
        __syncthreads();
        if (blk + 1 < SEQ_ / TB) GD_ISSUE(blk + 1);
        if (tid < 64) {
            for (int s = 0; s < TB; ++s) {
                float qv = 0.f, kv = 0.f, vv = 0.f;
#pragma unroll
                for (int i = 0; i < 4; ++i) { qv += cq[i] * rq[(s + i) * 64 + lane]; kv += ck[i] * rk[(s + i) * 64 + lane]; vv += cv[i] * rv[(s + i) * 64 + lane]; }
                qv = silu_f(qv); kv = silu_f(kv); vv = silu_f(vv);
                const float qn = qv * rsqrtf(wave_sum(qv * qv) + RMS_EPS) * 0.125f;
                const float kn = kv * rsqrtf(wave_sum(kv * kv) + RMS_EPS);
                const float g = nexpA * softplus_f(ga[s] + dtb), alpha = __expf(g), beta = 1.f / (1.f + __expf(-gb[s]));
                float kS = 0.f;
#pragma unroll
                for (int i = 0; i < 64; ++i) kS += __builtin_bit_cast(float, __builtin_amdgcn_readlane(__builtin_bit_cast(int, kn), i)) * S[i];
                const float dl = beta * (vv - alpha * kS);
                float o = 0.f;
#pragma unroll
                for (int i = 0; i < 64; ++i) { const float ki = __builtin_bit_cast(float, __builtin_amdgcn_readlane(__builtin_bit_cast(int, kn), i));
                    const float qi = __builtin_bit_cast(float, __builtin_amdgcn_readlane(__builtin_bit_cast(int, qn), i));
                    S[i] = alpha * S[i] + ki * dl; o += qi * S[i]; }
                const float ms = wave_sum(o * o) * (1.0f / 64.0f);
                const float out = o * rsqrtf(ms + RMS_EPS) * gn * silu_f(zs[s * 64 + lane]);
                H[(tok0 + (size_t)blk * TB + s) * 2048 + 1536 + hd * 64 + lane] = (bf16_t)f2bf(out);
            }
        }
    }
}

constexpr int RW_PITCH = 1032;
__device__ __forceinline__ unsigned f2key(float v, int e) { unsigned u = __builtin_bit_cast(unsigned, v); u = (u & 0x80000000u) ? ~u : (u | 0x80000000u); return (u & ~31u) | (unsigned)(31 - e); }
__device__ __forceinline__ float key2f(unsigned k) { const unsigned u = k & ~31u; return __builtin_bit_cast(float, (u & 0x80000000u) ? (u ^ 0x80000000u) : ~u); }
__device__ __forceinline__ void p5_ln1_router(ArgsP a, int l, LAS unsigned char* lds, int G) {
    int tid_ = threadIdx.x; asm volatile("" : "+v"(tid_)); const int tid = tid_, lane = tid & 63, wave = tid >> 6, tk = lane & 15, g = lane >> 4;
    LAS bf16_t* whi = (LAS bf16_t*)lds;
    LAS bf16_t* wlo = (LAS bf16_t*)(lds + 32 * RW_PITCH * 2);
    LAS int* hist = (LAS int*)(lds + 2 * 32 * RW_PITCH * 2);
    { const bf16_t* src = (const bf16_t*)(a->ws + WS_RWB) + (size_t)l * 2 * 32 * 1024;
      for (int p = tid; p < 2 * 32 * 128; p += 512) { const int arr = p >> 12, e = (p >> 7) & 31, c8 = (p & 127) * 8;
          *(LAS u32x4*)((arr ? wlo : whi) + e * RW_PITCH + c8) = *(const u32x4*)(src + ((size_t)arr * 32 + e) * 1024 + c8); } }
    const bf16_t* v = (const bf16_t*)(a->ws + WS_V); bf16_t* x1b = (bf16_t*)(a->ws + WS_X1B); unsigned char* x18 = a->ws + WS_X1;
    int* tke = (int*)(a->ws + WS_TKE); float* tkw = (float*)(a->ws + WS_TKW); int* ghist = (int*)(a->ws + WS_HIST);
    LAS float* lng = (LAS float*)(lds + 2 * 32 * RW_PITCH * 2 + 1024);
    LAS float* lnb = lng + 1024;
    { const float* gsrc = a->in[I_LN1G] + l * 1024; const float* bsrc = a->in[I_LN1B] + l * 1024; for (int p = tid; p < 1024; p += 512) { lng[p] = gsrc[p]; lnb[p] = bsrc[p]; } }
    const float rb0 = a->in[I_RB][l * 32 + tk], rb1 = a->in[I_RB][l * 32 + 16 + tk];
    for (int ch = blockIdx.x; ch < NCHUNK; ch += G) {
        __syncthreads();
        if (tid < 32) hist[tid] = 0;
        __syncthreads();
        const size_t t = (size_t)ch * CHTOK + wave * 16 + tk;
        const bf16_t* vr = v + t * 1024 + 8 * g;
        float s = 0.f, s2 = 0.f;
#pragma unroll 16
        for (int ks = 0; ks < 32; ++ks) { const u32x4 pw = *(const u32x4*)(vr + 32 * ks); const f32x4 p0 = (f32x4){bflo(pw.x), bfhi(pw.x), bflo(pw.y), bfhi(pw.y)}, p1 = (f32x4){bflo(pw.z), bfhi(pw.z), bflo(pw.w), bfhi(pw.w)};
            s += (p0[0] + p0[1]) + (p0[2] + p0[3]) + (p1[0] + p1[1]) + (p1[2] + p1[3]);
            s2 += (p0[0] * p0[0] + p0[1] * p0[1]) + (p0[2] * p0[2] + p0[3] * p0[3]) + (p1[0] * p1[0] + p1[1] * p1[1]) + (p1[2] * p1[2] + p1[3] * p1[3]); }
        s += __shfl_xor(s, 16); s += __shfl_xor(s, 32); s2 += __shfl_xor(s2, 16); s2 += __shfl_xor(s2, 32);
        const float mean = s * (1.0f / 1024.0f); const float rstd = rsqrtf(fmaxf(s2 * (1.0f / 1024.0f) - mean * mean, 0.f) + LN_EPS);
        f32x4 acc0 = (f32x4){0.f, 0.f, 0.f, 0.f}, acc1 = (f32x4){0.f, 0.f, 0.f, 0.f};
        for (int kg = 0; kg < 32; kg += 8) { u32x4 pv[8];
#pragma unroll
          for (int j = 0; j < 8; ++j) pv[j] = *(const u32x4*)(vr + 32 * (kg + j));
#pragma unroll
          for (int j = 0; j < 8; ++j) { const int ks = kg + j; const int k0 = 32 * ks + 8 * g;
            const u32x4 pw = pv[j]; const f32x4 p0 = (f32x4){bflo(pw.x), bfhi(pw.x), bflo(pw.y), bfhi(pw.y)}, p1 = (f32x4){bflo(pw.z), bfhi(pw.z), bflo(pw.w), bfhi(pw.w)};
            const f32x4 g0 = *(const LAS f32x4*)(lng + k0), g1 = *(const LAS f32x4*)(lng + k0 + 4), b0 = *(const LAS f32x4*)(lnb + k0), b1 = *(const LAS f32x4*)(lnb + k0 + 4);
            const f32x4 y0 = (p0 - mean) * rstd * g0 + b0, y1 = (p1 - mean) * rstd * g1 + b1;
            u32x4 hw; hw.x = pg8::cvt_pk_bf16(y0[0], y0[1]); hw.y = pg8::cvt_pk_bf16(y0[2], y0[3]); hw.z = pg8::cvt_pk_bf16(y1[0], y1[1]); hw.w = pg8::cvt_pk_bf16(y1[2], y1[3]);
            *(u32x4*)(x1b + t * 1024 + k0) = hw;
            { u32x2 q8; q8.x = pk_fp8x4(y0[0] * F8_SX, y0[1] * F8_SX, y0[2] * F8_SX, y0[3] * F8_SX); q8.y = pk_fp8x4(y1[0] * F8_SX, y1[1] * F8_SX, y1[2] * F8_SX, y1[3] * F8_SX); *(u32x2*)(x18 + t * 1024 + k0) = q8; }
            u32x4 lw; lw.x = pg8::cvt_pk_bf16(y0[0] - bflo(hw.x), y0[1] - bfhi(hw.x)); lw.y = pg8::cvt_pk_bf16(y0[2] - bflo(hw.y), y0[3] - bfhi(hw.y));
            lw.z = pg8::cvt_pk_bf16(y1[0] - bflo(hw.z), y1[1] - bfhi(hw.z)); lw.w = pg8::cvt_pk_bf16(y1[2] - bflo(hw.w), y1[3] - bfhi(hw.w));
            const bf16x8 ah = __builtin_bit_cast(bf16x8, hw), al = __builtin_bit_cast(bf16x8, lw);
            const bf16x8 wh0 = *(const LAS bf16x8*)(whi + tk * RW_PITCH + k0), wh1 = *(const LAS bf16x8*)(whi + (16 + tk) * RW_PITCH + k0);
            const bf16x8 wl0 = *(const LAS bf16x8*)(wlo + tk * RW_PITCH + k0), wl1 = *(const LAS bf16x8*)(wlo + (16 + tk) * RW_PITCH + k0);
            acc0 = __builtin_amdgcn_mfma_f32_16x16x32_bf16(ah, wh0, acc0, 0, 0, 0); acc1 = __builtin_amdgcn_mfma_f32_16x16x32_bf16(ah, wh1, acc1, 0, 0, 0);
            acc0 = __builtin_amdgcn_mfma_f32_16x16x32_bf16(ah, wl0, acc0, 0, 0, 0); acc1 = __builtin_amdgcn_mfma_f32_16x16x32_bf16(ah, wl1, acc1, 0, 0, 0);
            acc0 = __builtin_amdgcn_mfma_f32_16x16x32_bf16(al, wh0, acc0, 0, 0, 0); acc1 = __builtin_amdgcn_mfma_f32_16x16x32_bf16(al, wh1, acc1, 0, 0, 0);
            asm volatile("" ::: "memory"); } }
#pragma unroll
        for (int r = 0; r < 4; ++r) {
            unsigned k0 = f2key(acc0[r] + rb0, tk), k1 = f2key(acc1[r] + rb1, 16 + tk);
            float tv[4]; int te[4];
#pragma unroll
            for (int k = 0; k < 4; ++k) { unsigned m = k0 > k1 ? k0 : k1;
#pragma unroll
                for (int o = 1; o < 16; o <<= 1) { const unsigned q = (unsigned)__shfl_xor((int)m, o); m = q > m ? q : m; }
                const int e = 31 - (int)(m & 31u); tv[k] = key2f(m); te[k] = e;
                if (e == tk) k0 = 0u; if (e == 16 + tk) k1 = 0u; }
            const float e1 = __expf(tv[1] - tv[0]), e2 = __expf(tv[2] - tv[0]), e3 = __expf(tv[3] - tv[0]); const float inv = 1.0f / (1.0f + e1 + e2 + e3);
            if (tk < 4) { const size_t tt = (size_t)ch * CHTOK + wave * 16 + 4 * g + r;
                const int ei = tk == 0 ? te[0] : (tk == 1 ? te[1] : (tk == 2 ? te[2] : te[3]));
                const float wi = (tk == 0 ? 1.0f : (tk == 1 ? e1 : (tk == 2 ? e2 : e3))) * inv;
                tke[tt * 4 + tk] = ei; tkw[tt * 4 + tk] = wi; __hip_atomic_fetch_add(&hist[ei], 1, __ATOMIC_RELAXED, __HIP_MEMORY_SCOPE_WORKGROUP); }
        }
        __syncthreads();
        if (tid < 32) ghist[ch * 32 + tid] = hist[tid];
    }
}

__device__ __forceinline__ void p6_slots(ArgsP a, LAS unsigned char* lds, int G) {
    int tid_ = threadIdx.x; asm volatile("" : "+v"(tid_)); const int tid = tid_, lane = tid & 63, wave = tid >> 6;
    LAS int* hs = (LAS int*)lds;
    LAS int* cnt = (LAS int*)(lds + 32768);
    LAS int* bst = (LAS int*)(lds + 32768 + 256);
    LAS int* seg = (LAS int*)(lds + 32768 + 512);
    LAS int* wcnt = (LAS int*)(lds + 36864);
    const int* ghist = (const int*)(a->ws + WS_HIST);
    for (int i = tid; i < NCHUNK * 32; i += 512) hs[i] = ghist[i];
    __syncthreads();
    { const int e = tid & 31, sg = tid >> 5;
      int run = 0; for (int c = sg * 16; c < sg * 16 + 16; ++c) { const int v = hs[c * 32 + e]; hs[c * 32 + e] = run; run += v; } seg[sg * 32 + e] = run; }
    __syncthreads();
    if (tid < 32) { int run = 0; for (int sg = 0; sg < 16; ++sg) { const int v = seg[sg * 32 + tid]; seg[sg * 32 + tid] = run; run += v; } cnt[tid] = run; }
    __syncthreads();
    if (tid == 0) { int bs = 0; for (int e = 0; e < 32; ++e) { bst[e] = bs; bs += (cnt[e] + 255) >> 8; } bst[32] = bs; }
    __syncthreads();
    if (blockIdx.x == 0 && tid <= 32) ((int*)(a->ws + WS_META))[tid] = bst[tid];
    const int* tke = (const int*)(a->ws + WS_TKE); const float* tkw = (const float*)(a->ws + WS_TKW);
    int* slot = (int*)(a->ws + WS_SLOT); float* wbuf = (float*)(a->ws + WS_WBUF); int* tokb = (int*)(a->ws + WS_TOKB);
    for (int ch = blockIdx.x; ch < NCHUNK; ch += G) {
        const size_t pi = (size_t)ch * 512 + tid; const int me = tke[pi]; const float mw = tkw[pi];
        int rk = 0;
#pragma unroll 4
        for (int e = 0; e < 32; ++e) { const unsigned long long m = __ballot(me == e); if (me == e) rk = __popcll(m & ((1ull << lane) - 1ull)); if (lane == 0) wcnt[wave * 32 + e] = __popcll(m); }
        __syncthreads();
        int before = 0;
        for (int w = 0; w < wave; ++w) before += wcnt[w * 32 + me];
        const int s_ = bst[me] * 256 + seg[(ch >> 4) * 32 + me] + hs[ch * 32 + me] + before + rk;
        slot[pi] = s_; wbuf[s_] = mw; tokb[s_] = ch * CHTOK + (tid >> 2);
        __syncthreads();
    }
    for (int e = blockIdx.x; e < 32; e += G) for (int s_ = bst[e] * 256 + cnt[e] + tid; s_ < bst[e + 1] * 256; s_ += 512) tokb[s_] = T_;
}
__device__ __forceinline__ int moe_table(ArgsP a, LAS unsigned char* lds) {
    int tid_ = threadIdx.x; asm volatile("" : "+v"(tid_)); const int tid = tid_;
    LAS int* bst = (LAS int*)(lds + MISC_OFF);
    LAS int* blk_e = (LAS int*)(lds + MISC_OFF + 256);
    __syncthreads();
    if (tid <= 32) bst[tid] = ((const int*)(a->ws + WS_META))[tid];
    __syncthreads();
    const int nb = bst[32];
    for (int rb = tid; rb < nb; rb += 512) { int e = 0; while (e < 31 && rb >= bst[e + 1]) ++e; blk_e[rb] = e; }
    __syncthreads();
    return nb;
}

__device__ __forceinline__ void p9_combine_ln2(ArgsP a, int l, float* xout, int G, LAS unsigned char* lds) {
    int tid_ = threadIdx.x; asm volatile("" : "+v"(tid_)); const int tid = tid_, lane = tid & 63, wave = tid >> 6;
    LAS unsigned char* wl = lds + wave * 2048;
    const bf16_t* x1b = (const bf16_t*)(a->ws + WS_X1B); const int* slot = (const int*)(a->ws + WS_SLOT);
    const unsigned char* ys = a->ws + WS_OV + OV_YS; bf16_t* xb = (bf16_t*)(a->ws + WS_XB); unsigned char* x8 = a->ws + WS_X2;
    float gg[2][8], bb[2][8];
#pragma unroll
    for (int j = 0; j < 2; ++j) { const float* gp = a->in[I_LN2G] + l * 1024 + 8 * lane + 512 * j; const float* bp = a->in[I_LN2B] + l * 1024 + 8 * lane + 512 * j;
        const f32x4 g0 = *(const f32x4*)gp, g1 = *(const f32x4*)(gp + 4), b0 = *(const f32x4*)bp, b1 = *(const f32x4*)(bp + 4);
#pragma unroll
        for (int q = 0; q < 4; ++q) { gg[j][q] = g0[q]; gg[j][4 + q] = g1[q]; bb[j][q] = b0[q]; bb[j][4 + q] = b1[q]; } }
    for (int blk = blockIdx.x * NWAVES + wave; blk < T_ / 16; blk += G * NWAVES) {
        const int sv = slot[(size_t)blk * 64 + lane];
        for (int k = 0; k < 16; k += 4) {
            u32x4 xw[4][2]; u32x2 yw[4][4][2];
#pragma unroll
            for (int q = 0; q < 4; ++q) { const size_t t = (size_t)blk * 16 + k + q;
#pragma unroll
                for (int j = 0; j < 2; ++j) xw[q][j] = *(const u32x4*)(x1b + t * 1024 + 8 * lane + 512 * j);
#pragma unroll
                for (int kk = 0; kk < 4; ++kk) { const size_t sr = (size_t)__builtin_amdgcn_readfirstlane(__shfl(sv, (k + q) * 4 + kk));
#pragma unroll
                    for (int j = 0; j < 2; ++j) yw[q][kk][j] = *(const u32x2*)(ys + sr * 1024 + 8 * lane + 512 * j); } }
#pragma unroll
            for (int q = 0; q < 4; ++q) { const size_t t = (size_t)blk * 16 + k + q;
                float xv[2][8]; float s = 0.f;
#pragma unroll
                for (int j = 0; j < 2; ++j) { const unsigned xx[4] = {xw[q][j].x, xw[q][j].y, xw[q][j].z, xw[q][j].w};
#pragma unroll
                    for (int p2 = 0; p2 < 4; ++p2) { xv[j][2 * p2] = bflo(xx[p2]) * DN_ALPHA; xv[j][2 * p2 + 1] = bfhi(xx[p2]) * DN_ALPHA; }
#pragma unroll
                    for (int kk = 0; kk < 4; ++kk) { const int y0 = (int)yw[q][kk][j].x, y1 = (int)yw[q][kk][j].y; constexpr float isy = 1.0f / F8_SY;
                        xv[j][0] += __builtin_amdgcn_cvt_f32_fp8(y0, 0) * isy; xv[j][1] += __builtin_amdgcn_cvt_f32_fp8(y0, 1) * isy; xv[j][2] += __builtin_amdgcn_cvt_f32_fp8(y0, 2) * isy; xv[j][3] += __builtin_amdgcn_cvt_f32_fp8(y0, 3) * isy;
                        xv[j][4] += __builtin_amdgcn_cvt_f32_fp8(y1, 0) * isy; xv[j][5] += __builtin_amdgcn_cvt_f32_fp8(y1, 1) * isy; xv[j][6] += __builtin_amdgcn_cvt_f32_fp8(y1, 2) * isy; xv[j][7] += __builtin_amdgcn_cvt_f32_fp8(y1, 3) * isy; }
#pragma unroll
                    for (int e = 0; e < 8; ++e) s += xv[j][e]; }
                const float mean = wave_sum(s) * (1.0f / 1024.0f); float s2 = 0.f;
#pragma unroll
                for (int j = 0; j < 2; ++j)
#pragma unroll
                    for (int e = 0; e < 8; ++e) { xv[j][e] -= mean; s2 += xv[j][e] * xv[j][e]; }
                const float rstd = rsqrtf(wave_sum(s2) * (1.0f / 1024.0f) + LN_EPS);
#pragma unroll
                for (int j = 0; j < 2; ++j) {
#pragma unroll
                    for (int e = 0; e < 8; ++e) xv[j][e] = xv[j][e] * rstd * gg[j][e] + bb[j][e];
                    const size_t o = t * 1024 + 8 * lane + 512 * j;
                    if (xout) {
                        *(LAS f32x4*)(wl + lane * 32) = (f32x4){xv[j][0], xv[j][1], xv[j][2], xv[j][3]}; *(LAS f32x4*)(wl + lane * 32 + 16) = (f32x4){xv[j][4], xv[j][5], xv[j][6], xv[j][7]};
                        const f32x4 oa = *(const LAS f32x4*)(wl + lane * 16), ob_ = *(const LAS f32x4*)(wl + 1024 + lane * 16);
                        float* orow_ = xout + t * 1024 + 512 * j + 4 * lane; *(f32x4*)(orow_) = oa; *(f32x4*)(orow_ + 256) = ob_; }
                    else {
                    u32x4 w; w.x = pk2(xv[j][0], xv[j][1]); w.y = pk2(xv[j][2], xv[j][3]); w.z = pk2(xv[j][4], xv[j][5]); w.w = pk2(xv[j][6], xv[j][7]); *(u32x4*)(xb + o) = w;
                    u32x2 q8; q8.x = pk_fp8x4(xv[j][0] * F8_SX, xv[j][1] * F8_SX, xv[j][2] * F8_SX, xv[j][3] * F8_SX); q8.y = pk_fp8x4(xv[j][4] * F8_SX, xv[j][5] * F8_SX, xv[j][6] * F8_SX, xv[j][7] * F8_SX);
                    *(u32x2*)(x8 + o) = q8; } } }
        }
    }
}
typedef float f32x2_t_ __attribute__((ext_vector_type(2))); typedef __bf16 bf16x2_t_ __attribute__((ext_vector_type(2)));
__device__ __forceinline__ unsigned cvtpk_c(float lo, float hi) { const f32x2_t_ v = {lo, hi}; const bf16x2_t_ b = __builtin_convertvector(v, bf16x2_t_); return __builtin_bit_cast(unsigned, b); }
__device__ __forceinline__ unsigned pair_pack(float x0, float x1, bool odd) {
    const unsigned p = cvtpk_c(x0, x1);
    const unsigned q = (unsigned)__builtin_amdgcn_update_dpp(0, (int)p, 0xB1  , 0xF, 0xF, true);
    return odd ? ((q >> 16) | (p & 0xffff0000u)) : ((p & 0xffffu) | (q << 16));
}
__device__ __forceinline__ unsigned pair_pack_u(unsigned p, bool odd) {
    const unsigned q = (unsigned)__builtin_amdgcn_update_dpp(0, (int)p, 0xB1, 0xF, 0xF, true);
    return odd ? ((q >> 16) | (p & 0xffff0000u)) : ((p & 0xffffu) | (q << 16));
}
typedef float f32x4_t __attribute__((ext_vector_type(4)));
constexpr size_t MX_LRU_PH = 0, MX_LRU_CARRY = 4 * MiB;
template <int MODE> __device__ __forceinline__ void lru_fast(ArgsP a, int l, int b, int h, int c_lo, int c_hi, LAS unsigned char* lds, const bf16_t* proj, bf16_t* H, unsigned char* mxs) {
    int tid_ = threadIdx.x; asm volatile("" : "+v"(tid_)); const int tid = tid_, lane = tid & 63, wave = __builtin_amdgcn_readfirstlane(tid >> 6), fr = lane & 15, g = lane >> 4;
    LAS bf16_t* xa = (LAS bf16_t*)(lds);
    LAS bf16_t* ysb = (LAS bf16_t*)(lds + 17408);
    LAS bf16_t* outb = (LAS bf16_t*)(lds + 33792);
    LAS bf16_t* outc = (LAS bf16_t*)(lds + 50176);
    bf16_t* HL = (bf16_t*)(a->ws + WS_MB); bf16_t* CA = (bf16_t*)(a->ws + WS_X1B);
    float* PH = (float*)(mxs + MX_LRU_PH); const float* carry = (const float*)(mxs + MX_LRU_CARRY);
    const int ch = 16 * wave + fr, chg = h * 128 + ch;
    const bf16_t* wg = (const bf16_t*)(a->ws + WS_W + (size_t)l * WL_STRIDE + WL_G) + (size_t)h * 256 * 128;
    bf16x8 bra[4], brx[4];
#pragma unroll
    for (int ks = 0; ks < 4; ++ks) { bra[ks] = *(const bf16x8*)(wg + (size_t)(ch) * 128 + 32 * ks + 8 * g); brx[ks] = *(const bf16x8*)(wg + (size_t)(128 + ch) * 128 + 32 * ks + 8 * g); }
    const float ba = a->in[I_LBA][l * 1024 + chg], bx = a->in[I_LBX][l * 1024 + chg], sp = softplus_f(-a->in[I_LLAM][l * 1024 + chg]);
    constexpr float L2E = 1.4426950408889634f; const float ba2 = -L2E * ba, bx2 = -L2E * bx, ksp = -8.0f * L2E * sp;
    const int cg = tid & 15, t0i = tid >> 4;
    float cwv[4][8], cbv[8];
    { const float* cw = a->in[I_LCW] + (size_t)l * 4 * 1024 + h * 128 + 8 * cg;
#pragma unroll
      for (int j = 0; j < 4; ++j) { const f32x4 w0 = *(const f32x4*)(cw + j * 1024), w1 = *(const f32x4*)(cw + j * 1024 + 4);
          cwv[j][0] = w0[0]; cwv[j][1] = w0[1]; cwv[j][2] = w0[2]; cwv[j][3] = w0[3]; cwv[j][4] = w1[0]; cwv[j][5] = w1[1]; cwv[j][6] = w1[2]; cwv[j][7] = w1[3]; }
      const float* cbp = a->in[I_LCB] + l * 1024 + h * 128 + 8 * cg; const f32x4 b0 = *(const f32x4*)(cbp), b1 = *(const f32x4*)(cbp + 4);
      cbv[0] = b0[0]; cbv[1] = b0[1]; cbv[2] = b0[2]; cbv[3] = b0[3]; cbv[4] = b1[0]; cbv[5] = b1[1]; cbv[6] = b1[2]; cbv[7] = b1[3]; }
    u32x4 pr[2][4], py[2];
#define LRU_ISSUE(c_) do { _Pragma("unroll") for (int i = 0; i < 2; ++i) { const int tl = (c_) * 64 + t0i + 32 * i; \
        _Pragma("unroll") for (int j = 0; j < 4; ++j) { const int tt_ = tl - 3 + j; pr[i][j] = (u32x4){0u, 0u, 0u, 0u}; \
            if (tt_ >= 0) pr[i][j] = *(const u32x4*)(proj + ((size_t)b * SEQ_ + tt_) * NPROJ + PC_LRUX + h * 128 + 8 * cg); } \
        if (MODE == 1) py[i] = *(const u32x4*)(proj + ((size_t)b * SEQ_ + tl) * NPROJ + PC_LRUY + h * 128 + 8 * cg); } } while (0)
    LRU_ISSUE(c_lo);
    for (int c = c_lo; c < c_hi; ++c) {
        const size_t tok0 = (size_t)b * SEQ_ + (size_t)c * 64;
        __syncthreads();
#pragma unroll
        for (int i = 0; i < 2; ++i) { float o[8];
#pragma unroll
            for (int q = 0; q < 8; ++q) o[q] = cbv[q];
#pragma unroll
            for (int j = 0; j < 4; ++j) { const unsigned x[4] = {pr[i][j].x, pr[i][j].y, pr[i][j].z, pr[i][j].w};
#pragma unroll
                for (int q = 0; q < 4; ++q) { o[2 * q] += cwv[j][2 * q] * bflo(x[q]); o[2 * q + 1] += cwv[j][2 * q + 1] * bfhi(x[q]); } }
            u32x4 w; w.x = pg8::cvt_pk_bf16(o[0], o[1]); w.y = pg8::cvt_pk_bf16(o[2], o[3]); w.z = pg8::cvt_pk_bf16(o[4], o[5]); w.w = pg8::cvt_pk_bf16(o[6], o[7]);
            *(LAS u32x4*)(xa + (t0i + 32 * i) * 136 + 8 * cg) = w;
            if (MODE == 1) *(LAS u32x4*)(ysb + (t0i + 32 * i) * 128 + 8 * cg) = py[i]; }
        if (c + 1 < c_hi) LRU_ISSUE(c + 1);
        __syncthreads();
        f32x4_t ar[4], ax[4];
#pragma unroll
        for (int tt = 0; tt < 4; ++tt) { ar[tt] = (f32x4_t){0.f, 0.f, 0.f, 0.f}; ax[tt] = (f32x4_t){0.f, 0.f, 0.f, 0.f}; }
#pragma unroll
        for (int tt = 0; tt < 4; ++tt)
#pragma unroll
            for (int ks = 0; ks < 4; ++ks) { const bf16x8 af = *(const LAS bf16x8*)(xa + (16 * tt + fr) * 136 + 32 * ks + 8 * g);
                ar[tt] = __builtin_amdgcn_mfma_f32_16x16x32_bf16(af, bra[ks], ar[tt], 0, 0, 0);
                ax[tt] = __builtin_amdgcn_mfma_f32_16x16x32_bf16(af, brx[ks], ax[tt], 0, 0, 0); }
        float av[4][4], uv[4][4], Ai[4], Bi[4];
#pragma unroll
        for (int tt = 0; tt < 4; ++tt) { float A = 1.f, B = 0.f;
#pragma unroll
            for (int r = 0; r < 4; ++r) { const int t = 16 * tt + 4 * g + r;
                const float rg = __builtin_amdgcn_rcpf(1.f + __builtin_amdgcn_exp2f(__builtin_fmaf(ar[tt][r], -L2E, ba2))), ig = __builtin_amdgcn_rcpf(1.f + __builtin_amdgcn_exp2f(__builtin_fmaf(ax[tt][r], -L2E, bx2)));
                const float a_ = __builtin_amdgcn_exp2f(rg * ksp); av[tt][r] = a_; uv[tt][r] = __builtin_amdgcn_sqrtf(__builtin_fmaf(-a_, a_, 1.f)) * (ig * bf2f(xa[t * 136 + ch]));
                B = av[tt][r] * B + uv[tt][r]; A *= av[tt][r]; }
            Ai[tt] = A; Bi[tt] = B; }
#pragma unroll
        for (int tt = 0; tt < 4; ++tt) { const float A1 = __shfl_up(Ai[tt], 16), B1 = __shfl_up(Bi[tt], 16); if (g >= 1) { Bi[tt] = Ai[tt] * B1 + Bi[tt]; Ai[tt] = Ai[tt] * A1; } }
#pragma unroll
        for (int tt = 0; tt < 4; ++tt) { const float A2 = __shfl_up(Ai[tt], 32), B2 = __shfl_up(Bi[tt], 32); if (g >= 2) { Bi[tt] = Ai[tt] * B2 + Bi[tt]; Ai[tt] = Ai[tt] * A2; } }
        float Ae[4], Be[4], At[4], Bt[4];
#pragma unroll
        for (int tt = 0; tt < 4; ++tt) { Ae[tt] = __shfl_up(Ai[tt], 16); Be[tt] = __shfl_up(Bi[tt], 16); if (g == 0) { Ae[tt] = 1.f; Be[tt] = 0.f; }
            At[tt] = __shfl(Ai[tt], fr + 48); Bt[tt] = __shfl(Bi[tt], fr + 48); }
        float hin = 0.f, ptot = 1.f;
        if (MODE == 1) hin = carry[((size_t)b * 64 + c) * 1024 + chg];
#pragma unroll
        for (int tt = 0; tt < 4; ++tt) {
            float hcur = Ae[tt] * hin + Be[tt], ccur = ptot * Ae[tt];
            float hv[4], cv[4];
#pragma unroll
            for (int r = 0; r < 4; ++r) { const int t = 16 * tt + 4 * g + r; hcur = av[tt][r] * hcur + uv[tt][r]; ccur *= av[tt][r];
                if (MODE == 1) hv[r] = hcur * gelu_tanh_f(bf2f(ysb[t * 128 + ch])); else { hv[r] = hcur; cv[r] = ccur; } }
            { const bool odd = lane & 1; const int che = ch & ~1;
#pragma unroll
              for (int r = 0; r < 4; r += 2) { const int t = 16 * tt + 4 * g + r + (odd ? 1 : 0);
                  *(LAS unsigned*)(outb + t * 128 + che) = pair_pack(hv[r], hv[r + 1], odd);
                  if (MODE == 0) *(LAS unsigned*)(outc + t * 128 + che) = pair_pack(cv[r], cv[r + 1], odd); } }
            hin = At[tt] * hin + Bt[tt]; ptot *= At[tt]; }
        if (MODE == 0) { if (g == 0) { PH[(((size_t)b * 64 + c) * 2 + 0) * 1024 + chg] = ptot; PH[(((size_t)b * 64 + c) * 2 + 1) * 1024 + chg] = hin; } }
        __syncthreads();
#pragma unroll
        for (int i = 0; i < 2; ++i) { const int pid = tid + 512 * i; const int row = pid >> 4, c8 = (pid & 15) * 8;
            if (MODE == 1) *(u32x4*)(H + (tok0 + row) * 2048 + h * 128 + c8) = *(const LAS u32x4*)(outb + row * 128 + c8);
            else { *(u32x4*)(HL + (tok0 + row) * 1024 + h * 128 + c8) = *(const LAS u32x4*)(outb + row * 128 + c8); *(u32x4*)(CA + (tok0 + row) * 1024 + h * 128 + c8) = *(const LAS u32x4*)(outc + row * 128 + c8); } }
    }
#undef LRU_ISSUE
}
__device__ __forceinline__ void lru_carry(unsigned char* mxs, int gid0, int gstride) {
    const float* PH = (const float*)(mxs + MX_LRU_PH); float* carry = (float*)(mxs + MX_LRU_CARRY);
    for (int gid = gid0; gid < NBATCH * 1024; gid += gstride) { const int b = gid >> 10, chg = gid & 1023; float hc = 0.f;
#pragma unroll 8
        for (int c = 0; c < 64; ++c) { const size_t o = ((size_t)b * 64 + c); carry[o * 1024 + chg] = hc; hc = PH[(o * 2) * 1024 + chg] * hc + PH[(o * 2 + 1) * 1024 + chg]; } }
}
__device__ __forceinline__ void lru_apply(ArgsP a, const bf16_t* proj, bf16_t* H, unsigned char* mxs, int first, int stride) {
    int tid_ = threadIdx.x; asm volatile("" : "+v"(tid_));
    const bf16_t* HL = (const bf16_t*)(a->ws + WS_MB); const bf16_t* CA = (const bf16_t*)(a->ws + WS_X1B); const float* carry = (const float*)(mxs + MX_LRU_CARRY);
    const size_t step = (size_t)stride * 512, lim = (size_t)T_ * 128;
    for (size_t p0 = (size_t)first * 512 + tid_; p0 < lim; p0 += 2 * step) {
        u32x4 hw[2], cw[2], yw[2]; f32x4 c0[2], c1[2]; bool ok[2];
#pragma unroll
        for (int u = 0; u < 2; ++u) { const size_t p = p0 + u * step; ok[u] = p < lim; const size_t pp = ok[u] ? p : p0; const size_t t = pp >> 7; const int c8 = (int)(pp & 127) * 8;
            hw[u] = *(const u32x4*)(HL + t * 1024 + c8); cw[u] = *(const u32x4*)(CA + t * 1024 + c8); yw[u] = *(const u32x4*)(proj + t * NPROJ + PC_LRUY + c8);
            const float* cp = carry + (t >> 6) * 1024 + c8; c0[u] = *(const f32x4*)(cp); c1[u] = *(const f32x4*)(cp + 4); }
#pragma unroll
        for (int u = 0; u < 2; ++u) { if (!ok[u]) continue; const size_t p = p0 + u * step; const size_t t = p >> 7; const int c8 = (int)(p & 127) * 8;
            const unsigned hh[4] = {hw[u].x, hw[u].y, hw[u].z, hw[u].w}, cc[4] = {cw[u].x, cw[u].y, cw[u].z, cw[u].w}, yy[4] = {yw[u].x, yw[u].y, yw[u].z, yw[u].w};
            const float cin[8] = {c0[u][0], c0[u][1], c0[u][2], c0[u][3], c1[u][0], c1[u][1], c1[u][2], c1[u][3]};
            unsigned o[4];
#pragma unroll
            for (int q = 0; q < 4; ++q) { const float h0 = bflo(hh[q]) + bflo(cc[q]) * cin[2 * q], h1 = bfhi(hh[q]) + bfhi(cc[q]) * cin[2 * q + 1];
                o[q] = pg8::cvt_pk_bf16(h0 * gelu_tanh_f(bflo(yy[q])), h1 * gelu_tanh_f(bfhi(yy[q]))); }
            *(u32x4*)(H + t * 2048 + c8) = (u32x4){o[0], o[1], o[2], o[3]}; } }
}
typedef float f32x16 __attribute__((ext_vector_type(16)));
typedef short bf16x4 __attribute__((ext_vector_type(4)));
constexpr size_t MXB_ML_U = 0;
constexpr size_t MXB_ML_CP = 64 * MiB;
constexpr size_t MXS_ML_NU = 6 * MiB, MXS_ML_NP = 6 * MiB + 512 * 1024, MXS_ML_SC = 7 * MiB;

__device__ __forceinline__ float bperm_f(int src_lane, float v) { return __builtin_bit_cast(float, __builtin_amdgcn_ds_bpermute(src_lane << 2, __builtin_bit_cast(int, v))); }
__device__ __forceinline__ float wave_incl_sum(float v, int lane) {
#pragma unroll
    for (int o = 1; o < 64; o <<= 1) { const float t = bperm_f(lane >= o ? lane - o : lane, v); if (lane >= o) v += t; }
    return v;
}
__device__ __forceinline__ float wave_incl_max(float v, int lane) {
#pragma unroll
    for (int o = 1; o < 64; o <<= 1) { const float t = bperm_f(lane >= o ? lane - o : lane, v); if (lane >= o) v = fmaxf(v, t); }
    return v;
}
__device__ __forceinline__ bf16x8 pack8(float a0, float a1, float a2, float a3, float a4, float a5, float a6, float a7) {
    u32x4 w; w.x = pg8::cvt_pk_bf16(a0, a1); w.y = pg8::cvt_pk_bf16(a2, a3); w.z = pg8::cvt_pk_bf16(a4, a5); w.w = pg8::cvt_pk_bf16(a6, a7); return __builtin_bit_cast(bf16x8, w);
}
__device__ __forceinline__ bf16x8 ld_perm(const LAS bf16_t* p) {
    const u32x2 lo = *(const LAS u32x2*)(p), hi = *(const LAS u32x2*)(p + 8); u32x4 w; w.x = lo.x; w.y = lo.y; w.z = hi.x; w.w = hi.y; return __builtin_bit_cast(bf16x8, w);
}

__device__ __forceinline__ void mlstm_passA(ArgsP a, int l, LAS unsigned char* lds, const bf16_t* proj, const float* gsm, unsigned char* mxb, unsigned char* mxs, int G) {
    int tid_ = threadIdx.x; asm volatile("" : "+v"(tid_)); const int tid = tid_, lane = tid & 63, wave = __builtin_amdgcn_readfirstlane(tid >> 6), r = lane & 31, hh = lane >> 5;
    LAS bf16_t* kwT = (LAS bf16_t*)(lds);
    LAS bf16_t* vT = (LAS bf16_t*)(lds + 9216);
    LAS float* wts = (LAS float*)(lds + 27648);
    float* NU = (float*)(mxs + MXS_ML_NU); float* SC = (float*)(mxs + MXS_ML_SC);
    const f32x4 ib4 = *(const f32x4*)(a->in[I_MIB] + l * 4), fb4 = *(const f32x4*)(a->in[I_MFB] + l * 4);
    u32x4 kp, vp0, vp1; float pgf = 0.f, pgi = 0.f;
#define MLA_ISSUE(u_) do { const int c_ = (u_) & 63, hd_ = ((u_) >> 6) & 3, b_ = (u_) >> 8; const size_t t0_ = (size_t)b_ * SEQ_ + (size_t)c_ * 64 + lane; \
        kp = *(const u32x4*)(proj + t0_ * NPROJ + PC_MLK + hd_ * 64 + wave * 8); vp0 = *(const u32x4*)(proj + t0_ * NPROJ + PC_MLV + hd_ * 128 + wave * 8); \
        vp1 = *(const u32x4*)(proj + t0_ * NPROJ + PC_MLV + hd_ * 128 + 64 + wave * 8); pgf = gsm[t0_ * 32 + 4 + hd_]; pgi = gsm[t0_ * 32 + hd_]; } while (0)
    if ((int)blockIdx.x < 2048) MLA_ISSUE((int)blockIdx.x);
    for (int uid = blockIdx.x; uid < 2048; uid += G) {
        const int hd = (uid >> 6) & 3;
        const float ib = hd == 0 ? ib4[0] : (hd == 1 ? ib4[1] : (hd == 2 ? ib4[2] : ib4[3])), fb = hd == 0 ? fb4[0] : (hd == 1 ? fb4[1] : (hd == 2 ? fb4[2] : fb4[3]));
        float w;
        { const float fpre = pgf + fb, ipre = pgi + ib;
          const float logf = -softplus_f(-fpre); const float bc = wave_incl_sum(logf, lane); const float bl = __builtin_bit_cast(float, __builtin_amdgcn_readlane(__builtin_bit_cast(int, bc), 63));
          const float ge = bl - bc + ipre; const float mloc = wave_max(ge);
          w = __expf(ge - mloc);
          if (tid == 0) { SC[(size_t)uid * 4 + 0] = bl; SC[(size_t)uid * 4 + 1] = mloc; } }
        __syncthreads();
        { const bool odd = lane & 1; const int te = lane & ~1;
          const unsigned kw[4] = {kp.x, kp.y, kp.z, kp.w};
#pragma unroll
          for (int j = 0; j < 4; ++j) *(LAS unsigned*)(kwT + (wave * 8 + 2 * j + (odd ? 1 : 0)) * 72 + te) = pair_pack(w * bflo(kw[j]), w * bfhi(kw[j]), odd);
          const unsigned v0[4] = {vp0.x, vp0.y, vp0.z, vp0.w}, v1[4] = {vp1.x, vp1.y, vp1.z, vp1.w};
#pragma unroll
          for (int j = 0; j < 4; ++j) { *(LAS unsigned*)(vT + (wave * 8 + 2 * j + (odd ? 1 : 0)) * 72 + te) = pair_pack_u(v0[j], odd);
              *(LAS unsigned*)(vT + (64 + wave * 8 + 2 * j + (odd ? 1 : 0)) * 72 + te) = pair_pack_u(v1[j], odd); } }
        if (uid + G < 2048) MLA_ISSUE(uid + G);
        __syncthreads();
        const int dI = wave >> 2, eJ = wave & 3;
        f32x16 acc;
#pragma unroll
        for (int i = 0; i < 16; ++i) acc[i] = 0.f;
#pragma unroll
        for (int ks = 0; ks < 4; ++ks) { const bf16x8 af = *(const LAS bf16x8*)(kwT + (32 * dI + r) * 72 + 16 * ks + 8 * hh), bf = *(const LAS bf16x8*)(vT + (32 * eJ + r) * 72 + 16 * ks + 8 * hh);
            acc = __builtin_amdgcn_mfma_f32_32x32x16_bf16(af, bf, acc, 0, 0, 0); }
        bf16_t* ud = (bf16_t*)(mxb + MXB_ML_U) + ((size_t)uid * 8 + wave) * 1024;
#pragma unroll
        for (int q = 0; q < 4; ++q) *(u32x2*)(ud + (q * 64 + lane) * 4) = (u32x2){pg8::cvt_pk_bf16(acc[4 * q], acc[4 * q + 1]), pg8::cvt_pk_bf16(acc[4 * q + 2], acc[4 * q + 3])};
        if (tid < 64) { float s = 0.f;
#pragma unroll 8
            for (int t = 0; t < 64; ++t) s += bf2f(kwT[tid * 72 + t]);
            NU[(size_t)uid * 64 + tid] = s; }
    }
#undef MLA_ISSUE
}
__device__ __forceinline__ void mlstm_passB(unsigned char* mxb, unsigned char* mxs, int G) {
    int tid_ = threadIdx.x; asm volatile("" : "+v"(tid_)); const int tid = tid_;
    const float* NU = (const float*)(mxs + MXS_ML_NU); float* NP = (float*)(mxs + MXS_ML_NP); float* SC = (float*)(mxs + MXS_ML_SC);
    for (int wu = blockIdx.x; wu < 256; wu += G) {
        const int chain = wu >> 3, tile = wu & 7;
        if (tid < 128) {
            const int lane = tid & 63, s = tid >> 6;
            float st[8]; float m = 0.f;
#pragma unroll
            for (int i = 0; i < 8; ++i) st[i] = 0.f;
#pragma unroll 4
            for (int c = 0; c < 64; ++c) { const size_t uid = (size_t)chain * 64 + c;
                const bf16_t* ud = (const bf16_t*)(mxb + MXB_ML_U) + (uid * 8 + tile) * 1024;
                const u32x2 w0 = *(const u32x2*)(ud + ((2 * s) * 64 + lane) * 4), w1 = *(const u32x2*)(ud + ((2 * s + 1) * 64 + lane) * 4);
                const float u0[4] = {bflo(w0.x), bfhi(w0.x), bflo(w0.y), bfhi(w0.y)}, u1[4] = {bflo(w1.x), bfhi(w1.x), bflo(w1.y), bfhi(w1.y)};
                const float bl = SC[uid * 4 + 0], mloc = SC[uid * 4 + 1];
                *(bf16x8*)((bf16_t*)(mxb + MXB_ML_CP) + (uid * 8 + tile) * 1024 + (s * 64 + lane) * 8) = pack8(st[0], st[1], st[2], st[3], st[4], st[5], st[6], st[7]);
                if (tile == 0 && tid == 0) SC[uid * 4 + 2] = m;
                const float mn = fmaxf(bl + m, mloc), dec = __expf(bl + m - mn), sc = __expf(mloc - mn); m = mn;
#pragma unroll
                for (int i = 0; i < 4; ++i) { st[i] = dec * st[i] + sc * u0[i]; st[4 + i] = dec * st[4 + i] + sc * u1[i]; } }
        } else if (tile == 0 && tid < 192) {
            const int d = tid - 128; float n = 0.f, m = 0.f;
#pragma unroll 4
            for (int c = 0; c < 64; ++c) { const size_t uid = (size_t)chain * 64 + c; const float bl = SC[uid * 4 + 0], mloc = SC[uid * 4 + 1]; const float nu = NU[uid * 64 + d];
                NP[uid * 64 + d] = n; const float mn = fmaxf(bl + m, mloc), dec = __expf(bl + m - mn), sc = __expf(mloc - mn); m = mn; n = dec * n + sc * nu; }
        }
    }
}
__device__ __forceinline__ void mlstm_passC(ArgsP a, int l, LAS unsigned char* lds, const bf16_t* proj, const float* gsm, bf16_t* H, unsigned char* mxb, unsigned char* mxs, int first, int stride) {
    int tid_ = threadIdx.x; asm volatile("" : "+v"(tid_)); const int tid = tid_, lane = tid & 63, wave = __builtin_amdgcn_readfirstlane(tid >> 6), r = lane & 31, hh = lane >> 5;
    LAS bf16_t* qb = (LAS bf16_t*)(lds);
    LAS bf16_t* kb = (LAS bf16_t*)(lds + 9216);
    LAS bf16_t* vT = (LAS bf16_t*)(lds + 18432);
    LAS bf16_t* ob = (LAS bf16_t*)(lds + 36864);
    LAS bf16_t* outb = (LAS bf16_t*)(lds + 54272);
    LAS float* tb_rt = (LAS float*)(lds + 70656);
    LAS float* tb_ct = tb_rt + 64;
    LAS float* tb_iw = tb_rt + 128;
    LAS float* tb_em = tb_rt + 192;
    LAS float* tb_np = tb_rt + 256;
    LAS float* ssq = tb_rt + 320;
    const float* NP = (const float*)(mxs + MXS_ML_NP); const float* SC = (const float*)(mxs + MXS_ML_SC);
    const f32x4 ib4 = *(const f32x4*)(a->in[I_MIB] + l * 4), fb4 = *(const f32x4*)(a->in[I_MFB] + l * 4);
    LAS float* gnl = tb_rt + 640;
    gnl[tid] = a->in[I_MNG][(size_t)l * 512 + tid];
    u32x4 pq, pk, po[2], pv0, pv1; float pgf = 0.f, pgi = 0.f, pmp = 0.f, pnp = 0.f;
#define MLC_ISSUE(u_) do { const int c_ = (u_) & 63, hd_ = ((u_) >> 6) & 3, b_ = (u_) >> 8; const size_t k0_ = (size_t)b_ * SEQ_ + (size_t)c_ * 64; const int row_ = tid >> 3, c8_ = (tid & 7) * 8; \
        pq = *(const u32x4*)(proj + (k0_ + row_) * NPROJ + PC_MLQ + hd_ * 64 + c8_); pk = *(const u32x4*)(proj + (k0_ + row_) * NPROJ + PC_MLK + hd_ * 64 + c8_); \
        _Pragma("unroll") for (int i = 0; i < 2; ++i) { const int pid = tid + 512 * i; po[i] = *(const u32x4*)(proj + (k0_ + (pid >> 4)) * NPROJ + PC_MLO + hd_ * 128 + (pid & 15) * 8); } \
        pv0 = *(const u32x4*)(proj + (k0_ + lane) * NPROJ + PC_MLV + hd_ * 128 + wave * 8); pv1 = *(const u32x4*)(proj + (k0_ + lane) * NPROJ + PC_MLV + hd_ * 128 + 64 + wave * 8); \
        if (wave == 0) { pgf = gsm[(k0_ + lane) * 32 + 4 + hd_]; pgi = gsm[(k0_ + lane) * 32 + hd_]; pmp = SC[(size_t)(u_) * 4 + 2]; pnp = NP[(size_t)(u_) * 64 + lane]; } } while (0)
    if (first < 2048) MLC_ISSUE(first);
    for (int uid = first; uid < 2048; uid += stride) {
        const int c = uid & 63, hd = (uid >> 6) & 3, b = uid >> 8; const size_t tok0 = (size_t)b * SEQ_ + (size_t)c * 64;
        __syncthreads();
        if (wave == 0) {
            const float ib = hd == 0 ? ib4[0] : (hd == 1 ? ib4[1] : (hd == 2 ? ib4[2] : ib4[3])), fb = hd == 0 ? fb4[0] : (hd == 1 ? fb4[1] : (hd == 2 ? fb4[2] : fb4[3]));
            const float fpre = pgf + fb, ipre = pgi + ib;
            const float logf = -softplus_f(-fpre); const float bc = wave_incl_sum(logf, lane);
            const float rt = ipre - bc; const float cmx = wave_incl_max(rt, lane); const float mprev = pmp;
            const float mt = bc + fmaxf(mprev, cmx);
            tb_rt[lane] = rt; tb_ct[lane] = bc - mt; tb_iw[lane] = __expf(bc + mprev - mt); tb_em[lane] = __expf(-mt); tb_np[lane] = pnp;
        }
        { const int row = tid >> 3, c8 = (tid & 7) * 8;
          *(LAS u32x4*)(qb + row * 72 + c8) = pq; *(LAS u32x4*)(kb + row * 72 + c8) = pk;
#pragma unroll
          for (int i = 0; i < 2; ++i) { const int pid = tid + 512 * i; *(LAS u32x4*)(ob + (pid >> 4) * 136 + (pid & 15) * 8) = po[i]; }
          const unsigned v0[4] = {pv0.x, pv0.y, pv0.z, pv0.w}, v1[4] = {pv1.x, pv1.y, pv1.z, pv1.w}; const bool odd = lane & 1; const int te = lane & ~1;
#pragma unroll
          for (int j = 0; j < 4; ++j) { *(LAS unsigned*)(vT + (wave * 8 + 2 * j + (odd ? 1 : 0)) * 72 + te) = pair_pack_u(v0[j], odd);
              *(LAS unsigned*)(vT + (64 + wave * 8 + 2 * j + (odd ? 1 : 0)) * 72 + te) = pair_pack_u(v1[j], odd); } }
        if (uid + stride < 2048) MLC_ISSUE(uid + stride);
        __syncthreads();
        const int eI = wave >> 1, tJ = wave & 1; const int t = 32 * tJ + r;
        f32x16 as[2];
#pragma unroll
        for (int sI = 0; sI < 2; ++sI) {
#pragma unroll
            for (int i = 0; i < 16; ++i) as[sI][i] = 0.f;
#pragma unroll
            for (int ks = 0; ks < 4; ++ks) { const bf16x8 af = *(const LAS bf16x8*)(kb + (32 * sI + r) * 72 + 16 * ks + 8 * hh), bf = *(const LAS bf16x8*)(qb + t * 72 + 16 * ks + 8 * hh);
                as[sI] = __builtin_amdgcn_mfma_f32_32x32x16_bf16(af, bf, as[sI], 0, 0, 0); } }
        const float ctt = tb_ct[t], iwt = tb_iw[t] * 0.125f, emt = tb_em[t];
        float dsum = 0.f;
#pragma unroll
        for (int sI = 0; sI < 2; ++sI)
#pragma unroll
            for (int q = 0; q < 4; ++q) { const int s0 = 32 * sI + 8 * q + 4 * hh; const f32x4 rt4 = *(const LAS f32x4*)(tb_rt + s0);
#pragma unroll
                for (int i = 0; i < 4; ++i) { const float wv = (s0 + i <= t) ? as[sI][4 * q + i] * 0.125f * __expf(ctt + rt4[i]) : 0.f; as[sI][4 * q + i] = wv; dsum += wv; } }
        float qn = 0.f;
#pragma unroll
        for (int j = 0; j < 4; ++j) { const u32x4 qw = *(const LAS u32x4*)(qb + t * 72 + 32 * hh + 8 * j); const f32x4 n0 = *(const LAS f32x4*)(tb_np + 32 * hh + 8 * j), n1 = *(const LAS f32x4*)(tb_np + 32 * hh + 8 * j + 4);
            qn += bflo(qw.x) * n0[0] + bfhi(qw.x) * n0[1] + bflo(qw.y) * n0[2] + bfhi(qw.y) * n0[3] + bflo(qw.z) * n1[0] + bfhi(qw.z) * n1[1] + bflo(qw.w) * n1[2] + bfhi(qw.w) * n1[3]; }
        float den = dsum + iwt * qn; den += __shfl_xor(den, 32);
        f32x16 an;
#pragma unroll
        for (int i = 0; i < 16; ++i) an[i] = 0.f;
#pragma unroll
        for (int sI = 0; sI < 2; ++sI)
#pragma unroll
            for (int s2 = 0; s2 < 2; ++s2) { const bf16x8 af = ld_perm(vT + (32 * eI + r) * 72 + 32 * sI + 16 * s2 + 4 * hh);
                const bf16x8 bf = pack8(as[sI][8 * s2], as[sI][8 * s2 + 1], as[sI][8 * s2 + 2], as[sI][8 * s2 + 3], as[sI][8 * s2 + 4], as[sI][8 * s2 + 5], as[sI][8 * s2 + 6], as[sI][8 * s2 + 7]);
                an = __builtin_amdgcn_mfma_f32_32x32x16_bf16(af, bf, an, 0, 0, 0); }
        const bf16_t* cpd = (const bf16_t*)(mxb + MXB_ML_CP) + (size_t)uid * 8 * 1024;
#pragma unroll
        for (int dI = 0; dI < 2; ++dI)
#pragma unroll
            for (int s2 = 0; s2 < 2; ++s2) { const bf16x8 af = *(const bf16x8*)(cpd + (size_t)(dI * 4 + eI) * 1024 + (s2 * 64 + lane) * 8);
                const u32x4 qw = __builtin_bit_cast(u32x4, ld_perm(qb + t * 72 + 32 * dI + 16 * s2 + 4 * hh));
                const bf16x8 bf = pack8(bflo(qw.x) * iwt, bfhi(qw.x) * iwt, bflo(qw.y) * iwt, bfhi(qw.y) * iwt, bflo(qw.z) * iwt, bfhi(qw.z) * iwt, bflo(qw.w) * iwt, bfhi(qw.w) * iwt);
                an = __builtin_amdgcn_mfma_f32_32x32x16_bf16(af, bf, an, 0, 0, 0); }
        const float dinv = 1.0f / fmaxf(fabsf(den), emt);
        float sq = 0.f;
#pragma unroll
        for (int i = 0; i < 16; ++i) { an[i] *= dinv; sq += an[i] * an[i]; }
        sq += __shfl_xor(sq, 32);
        if (hh == 0) ssq[eI * 64 + t] = sq;
        __syncthreads();
        const float tot = ssq[t] + ssq[64 + t] + ssq[128 + t] + ssq[192 + t];
        const float rinv = rsqrtf(tot * (1.0f / 128.0f) + RMS_EPS);
        const LAS float* gn = gnl + hd * 128;
#pragma unroll
        for (int q = 0; q < 4; ++q) { const int e0 = 32 * eI + 8 * q + 4 * hh; const f32x4 g4 = *(const LAS f32x4*)(gn + e0); const u32x2 ow = *(const LAS u32x2*)(ob + t * 136 + e0);
            const float o0 = an[4 * q] * rinv * g4[0] * sigmoid_f(bflo(ow.x)), o1 = an[4 * q + 1] * rinv * g4[1] * sigmoid_f(bfhi(ow.x));
            const float o2 = an[4 * q + 2] * rinv * g4[2] * sigmoid_f(bflo(ow.y)), o3 = an[4 * q + 3] * rinv * g4[3] * sigmoid_f(bfhi(ow.y));
            u32x2 pw; pw.x = pg8::cvt_pk_bf16(o0, o1); pw.y = pg8::cvt_pk_bf16(o2, o3); *(LAS u32x2*)(outb + t * 128 + e0) = pw; }
        __syncthreads();
#pragma unroll
        for (int i = 0; i < 2; ++i) { const int pid = tid + 512 * i; const int row = pid >> 4, c8 = (pid & 15) * 8;
            *(u32x4*)(H + (tok0 + row) * 2048 + 1024 + hd * 128 + c8) = *(const LAS u32x4*)(outb + row * 128 + c8); }
    }
#undef MLC_ISSUE
}
constexpr size_t MXB_GD_ND = 96 * MiB, MXB_GD_OD = 160 * MiB, MXB_GD_T = 224 * MiB;
constexpr size_t MXT_GD_XD = 8 * MiB, MXT_GD_QD = 40 * MiB, MXT_GD_SD = 72 * MiB;
constexpr size_t MXS_GD_GL = 7 * MiB + 64 * 1024;

__device__ __forceinline__ void conv_silu8(const u32x4 (&rw)[4], const float* cw, float (&o)[8]) {
#pragma unroll
    for (int j = 0; j < 8; ++j) o[j] = 0.f;
#pragma unroll
    for (int i = 0; i < 4; ++i) { const f32x4 w0 = *(const f32x4*)(cw + i * 1536), w1 = *(const f32x4*)(cw + i * 1536 + 4); const unsigned x[4] = {rw[i].x, rw[i].y, rw[i].z, rw[i].w};
        o[0] += w0[0] * bflo(x[0]); o[1] += w0[1] * bfhi(x[0]); o[2] += w0[2] * bflo(x[1]); o[3] += w0[3] * bfhi(x[1]);
        o[4] += w1[0] * bflo(x[2]); o[5] += w1[1] * bfhi(x[2]); o[6] += w1[2] * bflo(x[3]); o[7] += w1[3] * bfhi(x[3]); }
#pragma unroll
    for (int j = 0; j < 8; ++j) o[j] = silu_f(o[j]);
}
__device__ __forceinline__ void conv_silu8_l(const u32x4 (&rw)[4], const LAS float* cw, int stride, float (&o)[8]) {
#pragma unroll
    for (int j = 0; j < 8; ++j) o[j] = 0.f;
#pragma unroll
    for (int i = 0; i < 4; ++i) { const f32x4 w0 = *(const LAS f32x4*)(cw + i * stride), w1 = *(const LAS f32x4*)(cw + i * stride + 4); const unsigned x[4] = {rw[i].x, rw[i].y, rw[i].z, rw[i].w};
        o[0] += w0[0] * bflo(x[0]); o[1] += w0[1] * bfhi(x[0]); o[2] += w0[2] * bflo(x[1]); o[3] += w0[3] * bfhi(x[1]);
        o[4] += w1[0] * bflo(x[2]); o[5] += w1[1] * bfhi(x[2]); o[6] += w1[2] * bflo(x[3]); o[7] += w1[3] * bfhi(x[3]); }
#pragma unroll
    for (int j = 0; j < 8; ++j) o[j] = silu_f(o[j]);
}
__device__ __forceinline__ void load_rows4(const bf16_t* proj, int b, int tl, int col, u32x4 (&rw)[4]) {
#pragma unroll
    for (int i = 0; i < 4; ++i) { const int tt = tl - 3 + i; rw[i] = (u32x4){0u, 0u, 0u, 0u}; if (tt >= 0) rw[i] = *(const u32x4*)(proj + ((size_t)b * SEQ_ + tt) * NPROJ + col); }
}

__device__ __forceinline__ void gdn_passA1(ArgsP a, int l, LAS unsigned char* lds, const bf16_t* proj, const float* gsm, unsigned char* mxb, int G) {
    int tid_ = threadIdx.x; asm volatile("" : "+v"(tid_)); const int tid = tid_, lane = tid & 63, wave = __builtin_amdgcn_readfirstlane(tid >> 6), r = lane & 31, hh = lane >> 5;
    LAS unsigned char* wl = lds + wave * 16384;
    LAS bf16_t* kb = (LAS bf16_t*)wl;
    LAS float* am = (LAS float*)wl;
    LAS float* tb = (LAS float*)(lds + MISC_OFF + 1024 + wave * 512);
    LAS float* cwl = (LAS float*)(lds + MISC_OFF + 8192);
    { const float* cwk = a->in[I_GCW] + (size_t)l * 4 * 1536 + 512; for (int i = tid; i < 2048; i += 512) cwl[i] = cwk[(i >> 9) * 1536 + (i & 511)]; }
    LAS float* gpl = (LAS float*)(lds + MISC_OFF + 8192 + 8192);
    if (tid < 8) { gpl[tid] = -__expf(a->in[I_GAL][l * 8 + tid]); gpl[8 + tid] = a->in[I_GDT][l * 8 + tid]; }
    __syncthreads();
    for (int uid = blockIdx.x * NWAVES + wave; uid < 4096; uid += G * NWAVES) {
        const int c = uid & 63, hd = (uid >> 6) & 7, b = uid >> 9; const int tl = c * 64 + lane; const size_t tok = (size_t)b * SEQ_ + tl;
        float ss = 0.f;
        const float ga_ = gsm[tok * 32 + 8 + hd], gb_ = gsm[tok * 32 + 16 + hd];
#pragma unroll
        for (int ph = 0; ph < 2; ++ph) {
            u32x4 rw[4][4];
#pragma unroll
            for (int p = 0; p < 4; ++p) load_rows4(proj, b, tl, PC_GDK + hd * 64 + 8 * (4 * ph + p), rw[p]);
#pragma unroll
            for (int p = 0; p < 4; ++p) { float o[8]; conv_silu8_l(rw[p], cwl + hd * 64 + 8 * (4 * ph + p), 512, o);
#pragma unroll
                for (int j = 0; j < 8; ++j) ss += o[j] * o[j];
                *(LAS bf16x8*)(kb + lane * 72 + 8 * (4 * ph + p)) = pack8(o[0], o[1], o[2], o[3], o[4], o[5], o[6], o[7]); } }
        const float rn = rsqrtf(ss + RMS_EPS);
        const float gg = gpl[hd] * softplus_f(ga_ + gpl[8 + hd]);
        const float gc = wave_incl_sum(gg, lane), beta = 1.f / (1.f + __expf(-gb_));
        tb[lane] = gc; tb[64 + lane] = beta * rn;
        LDS_WAIT(); asm volatile("" ::: "memory");
        bf16x8 kf[2][4];
#pragma unroll
        for (int I = 0; I < 2; ++I)
#pragma unroll
            for (int ks = 0; ks < 4; ++ks) kf[I][ks] = *(const LAS bf16x8*)(kb + (32 * I + r) * 72 + 16 * ks + 8 * hh);
        LDS_WAIT(); asm volatile("" ::: "memory");
#pragma unroll
        for (int I = 0; I < 2; ++I)
#pragma unroll
            for (int J = 0; J < 2; ++J) { f32x16 acc;
#pragma unroll
                for (int i = 0; i < 16; ++i) acc[i] = 0.f;
#pragma unroll
                for (int ks = 0; ks < 4; ++ks) acc = __builtin_amdgcn_mfma_f32_32x32x16_bf16(kf[I][ks], kf[J][ks], acc, 0, 0, 0);
                const int s = 32 * J + r; const float gcs = __shfl(gc, s), rns = __shfl(rn, s);
#pragma unroll
                for (int q = 0; q < 4; ++q) { const int t0 = 32 * I + 8 * q + 4 * hh; const f32x4 gct = *(const LAS f32x4*)(tb + t0), brt = *(const LAS f32x4*)(tb + 64 + t0);
#pragma unroll
                    for (int i = 0; i < 4; ++i) { const float v = (s < t0 + i) ? acc[4 * q + i] * brt[i] * rns * __expf(gct[i] - gcs) : 0.f; am[(t0 + i) * 64 + s] = v; } } }
        LDS_WAIT(); asm volatile("" ::: "memory");
        float Tc[64];
#pragma unroll
        for (int i = 0; i < 64; ++i) { float acc = (i == lane) ? 1.f : 0.f;
#pragma unroll
            for (int j4 = 0; j4 < (i + 3) / 4; ++j4) { const f32x4 av = *(const LAS f32x4*)(am + i * 64 + 4 * j4);
#pragma unroll
                for (int jj = 0; jj < 4; ++jj) if (4 * j4 + jj < i) acc -= av[jj] * Tc[4 * j4 + jj]; }
            asm volatile("" : "+v"(acc) :: "memory");
            Tc[i] = acc; }
        bf16_t* Tg = (bf16_t*)(mxb + MXB_GD_T) + (size_t)uid * 4096;
        { const bool odd = lane & 1; const int se = lane & ~1;
#pragma unroll
          for (int i = 0; i < 64; i += 2) *(unsigned*)(Tg + (i + (odd ? 1 : 0)) * 64 + se) = pair_pack(Tc[i], Tc[i + 1], odd); }
    }
}

__device__ __forceinline__ void gdn_passA2(ArgsP a, int l, LAS unsigned char* lds, const bf16_t* proj, const float* gsm, unsigned char* mxb, unsigned char* mxt, unsigned char* mxs, int G) {
    int tid_ = threadIdx.x; asm volatile("" : "+v"(tid_)); const int tid = tid_, lane = tid & 63, wave = __builtin_amdgcn_readfirstlane(tid >> 6), r = lane & 31, hh = lane >> 5;
    LAS bf16_t* qb = (LAS bf16_t*)(lds);
    LAS bf16_t* kb = (LAS bf16_t*)(lds + 9216);
    LAS bf16_t* bvT = (LAS bf16_t*)(lds + 18432);
    LAS bf16_t* bkT = (LAS bf16_t*)(lds + 27648);
    LAS bf16_t* Tm = (LAS bf16_t*)(lds + 36864);
    LAS bf16_t* wT = (LAS bf16_t*)(lds + 46080);
    LAS bf16_t* uT = (LAS bf16_t*)(lds + 55296);
    LAS bf16_t* kdT = (LAS bf16_t*)(lds + 64512);
    LAS float* tb_gc = (LAS float*)(lds + 73728);
    LAS float* tb_beta = tb_gc + 64;
    LAS float* ssq = tb_gc + 128;
    LAS float* cw = (LAS float*)(lds + 81920);
    { const float* cwg = a->in[I_GCW] + (size_t)l * 4 * 1536; for (int i = tid; i < 6144; i += 512) cw[i] = cwg[i]; }
    LAS float* gpl = cw + 6144;
    if (tid < 8) { gpl[tid] = -__expf(a->in[I_GAL][l * 8 + tid]); gpl[8 + tid] = a->in[I_GDT][l * 8 + tid]; }
    float* GL = (float*)(mxs + MXS_GD_GL);
    LAS bf16_t* raw = (LAS bf16_t*)(lds + 110592);
    u32x4 pr[4], tp; float pga = 0.f, pgb = 0.f;
#define GA2_ISSUE(u_) do { const int c_ = (u_) & 63, hd_ = ((u_) >> 6) & 7, b_ = (u_) >> 9; const size_t tok_ = (size_t)b_ * SEQ_ + c_ * 64 + lane; \
        _Pragma("unroll") for (int i = 0; i < 4; ++i) { const int pid = tid + 512 * i; pr[i] = (u32x4){0u, 0u, 0u, 0u}; \
            if (pid < 1608) { const int arr = pid / 536, rem = pid % 536, row = rem >> 3, c8 = (rem & 7) * 8; const int tt_ = c_ * 64 - 3 + row; \
                if (tt_ >= 0) pr[i] = *(const u32x4*)(proj + ((size_t)b_ * SEQ_ + tt_) * NPROJ + (arr == 0 ? PC_GDQ : (arr == 1 ? PC_GDK : PC_GDV)) + hd_ * 64 + c8); } } \
        pga = gsm[tok_ * 32 + 8 + hd_]; pgb = gsm[tok_ * 32 + 16 + hd_]; \
        tp = *(const u32x4*)((const bf16_t*)(mxb + MXB_GD_T) + (size_t)(u_) * 4096 + (tid >> 3) * 64 + (tid & 7) * 8); } while (0)
    if ((int)blockIdx.x < 4096) GA2_ISSUE((int)blockIdx.x);
    for (int uid = blockIdx.x; uid < 4096; uid += G) {
        const int hd = (uid >> 6) & 7;
        __syncthreads();
#pragma unroll
        for (int i = 0; i < 4; ++i) { const int pid = tid + 512 * i; if (pid < 1608) { const int arr = pid / 536, rem = pid % 536; *(LAS u32x4*)(raw + (arr * 67 + (rem >> 3)) * 72 + (rem & 7) * 8) = pr[i]; } }
        { const float gg = gpl[hd] * softplus_f(pga + gpl[8 + hd]);
          const float gc = wave_incl_sum(gg, lane);
          if (wave == 0) { tb_gc[lane] = gc; tb_beta[lane] = 1.f / (1.f + __expf(-pgb)); if (lane == 63) GL[uid] = __expf(gc); } }
        *(LAS u32x4*)(Tm + (tid >> 3) * 72 + (tid & 7) * 8) = tp;
        if (uid + G < 4096) GA2_ISSUE(uid + G);
        __syncthreads();
        float qo[8], ko[8], vo[8];
        { u32x4 rw[4];
#pragma unroll
          for (int i = 0; i < 4; ++i) rw[i] = *(const LAS u32x4*)(raw + (0 * 67 + lane + i) * 72 + 8 * wave);
          conv_silu8_l(rw, cw + hd * 64 + 8 * wave, 1536, qo);
#pragma unroll
          for (int i = 0; i < 4; ++i) rw[i] = *(const LAS u32x4*)(raw + (1 * 67 + lane + i) * 72 + 8 * wave);
          conv_silu8_l(rw, cw + 512 + hd * 64 + 8 * wave, 1536, ko);
#pragma unroll
          for (int i = 0; i < 4; ++i) rw[i] = *(const LAS u32x4*)(raw + (2 * 67 + lane + i) * 72 + 8 * wave);
          conv_silu8_l(rw, cw + 1024 + hd * 64 + 8 * wave, 1536, vo); }
        { float sq = 0.f, sk = 0.f;
#pragma unroll
          for (int j = 0; j < 8; ++j) { sq += qo[j] * qo[j]; sk += ko[j] * ko[j]; }
          ssq[wave * 64 + lane] = sq; ssq[512 + wave * 64 + lane] = sk; }
        __syncthreads();
        { float sq = 0.f, sk = 0.f;
#pragma unroll
          for (int w = 0; w < 8; ++w) { sq += ssq[w * 64 + lane]; sk += ssq[512 + w * 64 + lane]; }
          const float rq = rsqrtf(sq + RMS_EPS) * 0.125f, rk = rsqrtf(sk + RMS_EPS);
          const float gc = tb_gc[lane], beta = tb_beta[lane], gl_ = tb_gc[63];
          const float e1 = beta * __expf(gc), e2 = __expf(gl_ - gc);
#pragma unroll
          for (int j = 0; j < 8; ++j) { qo[j] *= rq; ko[j] *= rk; }
          *(LAS bf16x8*)(qb + lane * 72 + 8 * wave) = pack8(qo[0], qo[1], qo[2], qo[3], qo[4], qo[5], qo[6], qo[7]);
          *(LAS bf16x8*)(kb + lane * 72 + 8 * wave) = pack8(ko[0], ko[1], ko[2], ko[3], ko[4], ko[5], ko[6], ko[7]);
          { const bool odd = lane & 1; const int te = lane & ~1;
#pragma unroll
            for (int j = 0; j < 8; j += 2) { const int d = 8 * wave + j + (odd ? 1 : 0);
                *(LAS unsigned*)(bvT + d * 72 + te) = pair_pack(beta * vo[j], beta * vo[j + 1], odd); *(LAS unsigned*)(bkT + d * 72 + te) = pair_pack(e1 * ko[j], e1 * ko[j + 1], odd);
                *(LAS unsigned*)(kdT + d * 72 + te) = pair_pack(e2 * ko[j], e2 * ko[j + 1], odd); } } }
        __syncthreads();
        { const int mat = wave >> 2, I = (wave >> 1) & 1, J = wave & 1; const LAS bf16_t* Am = mat ? bkT : bvT; LAS bf16_t* Om = mat ? wT : uT;
          f32x16 acc;
#pragma unroll
          for (int i = 0; i < 16; ++i) acc[i] = 0.f;
#pragma unroll
          for (int ks = 0; ks < 4; ++ks) { const bf16x8 af = *(const LAS bf16x8*)(Am + (32 * I + r) * 72 + 16 * ks + 8 * hh), bf = *(const LAS bf16x8*)(Tm + (32 * J + r) * 72 + 16 * ks + 8 * hh);
              acc = __builtin_amdgcn_mfma_f32_32x32x16_bf16(af, bf, acc, 0, 0, 0); }
          { const bool odd = lane & 1; const int te = 32 * J + (r & ~1);
#pragma unroll
            for (int q = 0; q < 4; ++q)
#pragma unroll
                for (int i = 0; i < 4; i += 2) *(LAS unsigned*)(Om + (32 * I + 8 * q + 4 * hh + i + (odd ? 1 : 0)) * 72 + te) = pair_pack(acc[4 * q + i], acc[4 * q + i + 1], odd); } }
        __syncthreads();
        if (wave < 4) {
            const int I = (wave >> 1) & 1, J = wave & 1;
            f32x16 ax, an;
#pragma unroll
            for (int i = 0; i < 16; ++i) { ax[i] = 0.f; an[i] = 0.f; }
#pragma unroll
            for (int ks = 0; ks < 4; ++ks) { const bf16x8 wf = *(const LAS bf16x8*)(wT + (32 * I + r) * 72 + 16 * ks + 8 * hh), kdf_b = *(const LAS bf16x8*)(kdT + (32 * J + r) * 72 + 16 * ks + 8 * hh);
                ax = __builtin_amdgcn_mfma_f32_32x32x16_bf16(wf, kdf_b, ax, 0, 0, 0);
                const bf16x8 kdf_a = *(const LAS bf16x8*)(kdT + (32 * I + r) * 72 + 16 * ks + 8 * hh), uf = *(const LAS bf16x8*)(uT + (32 * J + r) * 72 + 16 * ks + 8 * hh);
                an = __builtin_amdgcn_mfma_f32_32x32x16_bf16(kdf_a, uf, an, 0, 0, 0); }
            bf16_t* xd = (bf16_t*)(mxt + MXT_GD_XD) + (size_t)uid * 4096 + (size_t)(I * 2 + J) * 1024;
#pragma unroll
            for (int s2 = 0; s2 < 2; ++s2) *(bf16x8*)(xd + (s2 * 64 + lane) * 8) = pack8(-ax[8 * s2], -ax[8 * s2 + 1], -ax[8 * s2 + 2], -ax[8 * s2 + 3], -ax[8 * s2 + 4], -ax[8 * s2 + 5], -ax[8 * s2 + 6], -ax[8 * s2 + 7]);
            bf16_t* nd = (bf16_t*)(mxb + MXB_GD_ND) + (size_t)uid * 4096 + (size_t)(I * 2 + J) * 1024;
#pragma unroll
            for (int q = 0; q < 4; ++q) *(u32x2*)(nd + (q * 64 + lane) * 4) = (u32x2){pg8::cvt_pk_bf16(an[4 * q], an[4 * q + 1]), pg8::cvt_pk_bf16(an[4 * q + 2], an[4 * q + 3])};
        } else {
            const int I = (wave >> 1) & 1, tJ = wave & 1; const int t = 32 * tJ + r; const float gct = tb_gc[t];
            bf16x8 pf[2][2];
#pragma unroll
            for (int sI = 0; sI < 2; ++sI) { f32x16 ap;
#pragma unroll
                for (int i = 0; i < 16; ++i) ap[i] = 0.f;
#pragma unroll
                for (int ks = 0; ks < 4; ++ks) { const bf16x8 af = *(const LAS bf16x8*)(kb + (32 * sI + r) * 72 + 16 * ks + 8 * hh), bf = *(const LAS bf16x8*)(qb + t * 72 + 16 * ks + 8 * hh);
                    ap = __builtin_amdgcn_mfma_f32_32x32x16_bf16(af, bf, ap, 0, 0, 0); }
#pragma unroll
                for (int q = 0; q < 4; ++q) { const int s0 = 32 * sI + 8 * q + 4 * hh; const f32x4 gcs = *(const LAS f32x4*)(tb_gc + s0);
#pragma unroll
                    for (int i = 0; i < 4; ++i) ap[4 * q + i] = (s0 + i <= t) ? ap[4 * q + i] * __expf(gct - gcs[i]) : 0.f; }
#pragma unroll
                for (int s2 = 0; s2 < 2; ++s2) pf[sI][s2] = pack8(ap[8 * s2], ap[8 * s2 + 1], ap[8 * s2 + 2], ap[8 * s2 + 3], ap[8 * s2 + 4], ap[8 * s2 + 5], ap[8 * s2 + 6], ap[8 * s2 + 7]); }
            f32x16 aq, ao;
#pragma unroll
            for (int i = 0; i < 16; ++i) { aq[i] = 0.f; ao[i] = 0.f; }
#pragma unroll
            for (int sI = 0; sI < 2; ++sI)
#pragma unroll
                for (int s2 = 0; s2 < 2; ++s2) { const bf16x8 wf = ld_perm(wT + (32 * I + r) * 72 + 32 * sI + 16 * s2 + 4 * hh), uf = ld_perm(uT + (32 * I + r) * 72 + 32 * sI + 16 * s2 + 4 * hh);
                    aq = __builtin_amdgcn_mfma_f32_32x32x16_bf16(wf, pf[sI][s2], aq, 0, 0, 0); ao = __builtin_amdgcn_mfma_f32_32x32x16_bf16(uf, pf[sI][s2], ao, 0, 0, 0); }
            const float egt = __expf(gct);
#pragma unroll
            for (int q = 0; q < 4; ++q) { const int d0 = 32 * I + 8 * q + 4 * hh; const u32x2 qw = *(const LAS u32x2*)(qb + t * 72 + d0);
                aq[4 * q] = bflo(qw.x) * egt - aq[4 * q]; aq[4 * q + 1] = bfhi(qw.x) * egt - aq[4 * q + 1]; aq[4 * q + 2] = bflo(qw.y) * egt - aq[4 * q + 2]; aq[4 * q + 3] = bfhi(qw.y) * egt - aq[4 * q + 3]; }
            bf16_t* qd = (bf16_t*)(mxt + MXT_GD_QD) + (size_t)uid * 4096 + (size_t)(I * 2 + tJ) * 1024;
#pragma unroll
            for (int s2 = 0; s2 < 2; ++s2) *(bf16x8*)(qd + (s2 * 64 + lane) * 8) = pack8(aq[8 * s2], aq[8 * s2 + 1], aq[8 * s2 + 2], aq[8 * s2 + 3], aq[8 * s2 + 4], aq[8 * s2 + 5], aq[8 * s2 + 6], aq[8 * s2 + 7]);
            bf16_t* od = (bf16_t*)(mxb + MXB_GD_OD) + (size_t)uid * 4096 + (size_t)(I * 2 + tJ) * 1024;
#pragma unroll
            for (int q = 0; q < 4; ++q) *(u32x2*)(od + (q * 64 + lane) * 4) = (u32x2){pg8::cvt_pk_bf16(ao[4 * q], ao[4 * q + 1]), pg8::cvt_pk_bf16(ao[4 * q + 2], ao[4 * q + 3])};
        }
    }
}

__device__ __forceinline__ void gdn_passB(unsigned char* mxb, unsigned char* mxt, unsigned char* mxs, int nB) {
    int tid_ = threadIdx.x; asm volatile("" : "+v"(tid_)); const int tid = tid_, lane = tid & 63, wave = __builtin_amdgcn_readfirstlane(tid >> 6);
    const float* GL = (const float*)(mxs + MXS_GD_GL);
    if (wave >= 2) { lru_carry(mxs, ((int)blockIdx.x * 6 + (wave - 2)) * 64 + lane, nB * 6 * 64); return; }
    const int eJ = wave;
    for (int chain = blockIdx.x; chain < 64; chain += nB) {
        f32x16 S[2];
#pragma unroll
        for (int i = 0; i < 16; ++i) { S[0][i] = 0.f; S[1][i] = 0.f; }
        bf16x8 xn[2][2][2]; u32x2 nq[2][4]; float gln;
#define GDB_LOAD(c_) do { const size_t u_ = (size_t)chain * 64 + (c_); const bf16_t* xd_ = (const bf16_t*)(mxt + MXT_GD_XD) + u_ * 4096; const bf16_t* nd_ = (const bf16_t*)(mxb + MXB_GD_ND) + u_ * 4096; \
        _Pragma("unroll") for (int I = 0; I < 2; ++I) _Pragma("unroll") for (int J = 0; J < 2; ++J) _Pragma("unroll") for (int s2 = 0; s2 < 2; ++s2) xn[I][J][s2] = *(const bf16x8*)(xd_ + (size_t)(I * 2 + J) * 1024 + (s2 * 64 + lane) * 8); \
        _Pragma("unroll") for (int J = 0; J < 2; ++J) _Pragma("unroll") for (int q = 0; q < 4; ++q) nq[J][q] = *(const u32x2*)(nd_ + (size_t)(J * 2 + eJ) * 1024 + (q * 64 + lane) * 4); \
        gln = GL[u_]; } while (0)
        GDB_LOAD(0);
        for (int c = 0; c < 64; ++c) { const size_t uid = (size_t)chain * 64 + c;
            bf16x8 xf[2][2][2]; f32x16 nn[2]; const float gl = gln;
#pragma unroll
            for (int I = 0; I < 2; ++I)
#pragma unroll
                for (int J = 0; J < 2; ++J)
#pragma unroll
                    for (int s2 = 0; s2 < 2; ++s2) xf[I][J][s2] = xn[I][J][s2];
#pragma unroll
            for (int J = 0; J < 2; ++J)
#pragma unroll
                for (int q = 0; q < 4; ++q) { nn[J][4 * q] = bflo(nq[J][q].x); nn[J][4 * q + 1] = bfhi(nq[J][q].x); nn[J][4 * q + 2] = bflo(nq[J][q].y); nn[J][4 * q + 3] = bfhi(nq[J][q].y); }
            if (c + 1 < 64) GDB_LOAD(c + 1);
            bf16x8 sh[2][2];
            bf16_t* sd = (bf16_t*)(mxt + MXT_GD_SD) + uid * 4096;
#pragma unroll
            for (int I = 0; I < 2; ++I)
#pragma unroll
                for (int s2 = 0; s2 < 2; ++s2) { sh[I][s2] = pack8(S[I][8 * s2], S[I][8 * s2 + 1], S[I][8 * s2 + 2], S[I][8 * s2 + 3], S[I][8 * s2 + 4], S[I][8 * s2 + 5], S[I][8 * s2 + 6], S[I][8 * s2 + 7]);
                    *(bf16x8*)(sd + (size_t)(I * 2 + eJ) * 1024 + (s2 * 64 + lane) * 8) = sh[I][s2]; }
#pragma unroll
            for (int J = 0; J < 2; ++J) { f32x16 acc = nn[J];
#pragma unroll
                for (int I = 0; I < 2; ++I)
#pragma unroll
                    for (int s2 = 0; s2 < 2; ++s2) acc = __builtin_amdgcn_mfma_f32_32x32x16_bf16(xf[I][J][s2], sh[I][s2], acc, 0, 0, 0);
                nn[J] = acc; }
#pragma unroll
            for (int J = 0; J < 2; ++J)
#pragma unroll
                for (int i = 0; i < 16; ++i) S[J][i] = gl * S[J][i] + nn[J][i];
        }
    }
}

__device__ __forceinline__ void gdn_passC(ArgsP a, int l, LAS unsigned char* lds, const bf16_t* proj, bf16_t* H, unsigned char* mxb, unsigned char* mxt, int G) {
    int tid_ = threadIdx.x; asm volatile("" : "+v"(tid_)); const int tid = tid_, lane = tid & 63, wave = __builtin_amdgcn_readfirstlane(tid >> 6), r = lane & 31, hh = lane >> 5;
    LAS bf16_t* ob = (LAS bf16_t*)(lds + wave * 8192);
    f32x4 gnr[2][4];
#pragma unroll
    for (int eI = 0; eI < 2; ++eI)
#pragma unroll
        for (int q = 0; q < 4; ++q) gnr[eI][q] = *(const f32x4*)(a->in[I_GNG] + l * 64 + 32 * eI + 8 * q + 4 * hh);
    for (int wu = blockIdx.x * NWAVES + wave; wu < 8192; wu += G * NWAVES) {
        const int uid = wu >> 1, tJ = wu & 1; const int c = uid & 63, hd = (uid >> 6) & 7, b = uid >> 9; const size_t tok0 = (size_t)b * SEQ_ + (size_t)c * 64;
        const bf16_t* sd = (const bf16_t*)(mxt + MXT_GD_SD) + (size_t)uid * 4096; const bf16_t* qd = (const bf16_t*)(mxt + MXT_GD_QD) + (size_t)uid * 4096; const bf16_t* od = (const bf16_t*)(mxb + MXB_GD_OD) + (size_t)uid * 4096;
        const size_t tok = tok0 + 32 * tJ + r;
        u32x2 ov[2][4]; bf16x8 qf[2][2], sf[2][2][2]; u32x2 zw[2][4];
#pragma unroll
        for (int eI = 0; eI < 2; ++eI)
#pragma unroll
            for (int q = 0; q < 4; ++q) ov[eI][q] = *(const u32x2*)(od + (size_t)(eI * 2 + tJ) * 1024 + (q * 64 + lane) * 4);
#pragma unroll
        for (int dI = 0; dI < 2; ++dI)
#pragma unroll
            for (int s2 = 0; s2 < 2; ++s2) { qf[dI][s2] = *(const bf16x8*)(qd + (size_t)(dI * 2 + tJ) * 1024 + (s2 * 64 + lane) * 8);
#pragma unroll
                for (int eI = 0; eI < 2; ++eI) sf[dI][s2][eI] = *(const bf16x8*)(sd + (size_t)(dI * 2 + eI) * 1024 + (s2 * 64 + lane) * 8); }
#pragma unroll
        for (int eI = 0; eI < 2; ++eI)
#pragma unroll
            for (int q = 0; q < 4; ++q) zw[eI][q] = *(const u32x2*)(proj + tok * NPROJ + PC_GDZ + hd * 64 + 32 * eI + 8 * q + 4 * hh);
        asm volatile("" ::: "memory");
        f32x16 ao[2];
#pragma unroll
        for (int eI = 0; eI < 2; ++eI)
#pragma unroll
            for (int q = 0; q < 4; ++q) { const u32x2 v = ov[eI][q]; ao[eI][4 * q] = bflo(v.x); ao[eI][4 * q + 1] = bfhi(v.x); ao[eI][4 * q + 2] = bflo(v.y); ao[eI][4 * q + 3] = bfhi(v.y); }
#pragma unroll
        for (int dI = 0; dI < 2; ++dI)
#pragma unroll
            for (int s2 = 0; s2 < 2; ++s2)
#pragma unroll
                for (int eI = 0; eI < 2; ++eI) ao[eI] = __builtin_amdgcn_mfma_f32_32x32x16_bf16(sf[dI][s2][eI], qf[dI][s2], ao[eI], 0, 0, 0);
        float sq = 0.f;
#pragma unroll
        for (int eI = 0; eI < 2; ++eI)
#pragma unroll
            for (int i = 0; i < 16; ++i) sq += ao[eI][i] * ao[eI][i];
        sq += __shfl_xor(sq, 32);
        const float rinv = rsqrtf(sq * (1.0f / 64.0f) + RMS_EPS);
#pragma unroll
        for (int eI = 0; eI < 2; ++eI)
#pragma unroll
            for (int q = 0; q < 4; ++q) { const int e0 = 32 * eI + 8 * q + 4 * hh; const f32x4 g4 = gnr[eI][q]; const u32x2 z_ = zw[eI][q];
                u32x2 pw; pw.x = pg8::cvt_pk_bf16(ao[eI][4 * q] * rinv * g4[0] * silu_f(bflo(z_.x)), ao[eI][4 * q + 1] * rinv * g4[1] * silu_f(bfhi(z_.x)));
                pw.y = pg8::cvt_pk_bf16(ao[eI][4 * q + 2] * rinv * g4[2] * silu_f(bflo(z_.y)), ao[eI][4 * q + 3] * rinv * g4[3] * silu_f(bfhi(z_.y)));
                *(LAS u32x2*)(ob + r * 64 + e0) = pw; }
        LDS_WAIT(); asm volatile("" ::: "memory");
#pragma unroll
        for (int it = 0; it < 4; ++it) { const int row = it * 8 + (lane >> 3), c8 = (lane & 7) * 8;
            *(u32x4*)(H + (tok0 + 32 * tJ + row) * 2048 + 1536 + hd * 64 + c8) = *(const LAS u32x4*)(ob + row * 64 + c8); }
        LDS_WAIT(); asm volatile("" ::: "memory");
    }
}
constexpr int PPL = 12;
constexpr int NPH = 1 + PPL * DEPTH_;
#ifndef MK_N_LAUNCHES
#define MK_N_LAUNCHES 1
#endif
#define REPS(k) ((PROBE_PH) == (k) ? 2 : 1)
#ifndef PG8_SP2
#define PG8_SP2 true
#endif
#ifndef PG8_ALIGN
#define PG8_ALIGN true
#endif
__global__ void __launch_bounds__(NWAVES * 64, 2) fwd(Args a_unused) {
    ArgsP kargs = (ArgsP)__builtin_amdgcn_kernarg_segment_ptr();
#define FRESH(a) ArgsP a = kargs; asm volatile("" : "+s"(a))
    extern __shared__ __attribute__((aligned(16))) unsigned char lds_raw[];
    LAS unsigned char* lds = (LAS unsigned char*)lds_raw;
    const int tid = threadIdx.x, G = gridDim.x;
    const int vcu = (G % 8 == 0) ? ((int)blockIdx.x % 8) * (G / 8) + (int)blockIdx.x / 8 : (int)blockIdx.x;
    for (int u = tid; u < (LDS_BYTES - MISC_OFF) / 4; u += NWAVES * 64) ((LAS unsigned*)(lds + MISC_OFF))[u] = 0u;
    __syncthreads();
    const int lo = kargs->ph_lo, hi = kargs->ph_hi;
    unsigned* barw = (unsigned*)(kargs->ws + WS_CTL) + CW_BAR + kargs->li * XCD_BAR_WORDS;
    if (hi - lo > 1) (void)xcd_barrier_post(barw, (volatile LAS unsigned*)(lds + LDS_BYTES - 16));
#define IN(k) (lo <= (k) && (k) < hi)
#define SEAM(k) do { if (IN(k) && IN((k) + 1)) { FRESH(ab_); XcdBarrier bb_; bb_.bar = (unsigned*)(ab_->ws + WS_CTL) + CW_BAR + ab_->li * XCD_BAR_WORDS; bb_.x = xb_xcc_id(); bb_.st = (volatile LAS unsigned*)(lds + LDS_BYTES - 16); xcd_barrier(bb_); } } while (0)
    if (IN(0)) for (int rep = 0; rep < REPS(-1); ++rep) { FRESH(a); p0_convert(a, lds, G); }
    SEAM(0);

    for (int l = 0; l < DEPTH_; ++l) {
        const int pb = 1 + PPL * l;
#define WSP(T_, off) ((T_*)(a->ws + (off)))
#define WL_(off) (a->ws + WS_W + (size_t)l * WL_STRIDE + (off))
        if (IN(pb + 0)) for (int rep = 0; rep < REPS(0); ++rep) { FRESH(a);
            { pg8::Gemm8 g{WSP(const unsigned char, WS_X2), (const unsigned char*)WL_(WL_IN + WL_IN8), 1024, 1024, 1024}; int Gp_ = G, cp_ = (int)blockIdx.x; asm volatile("" : "+s"(Gp_), "+s"(cp_)); pg8::P1F8Order S{Gp_, cp_};
              pg8::EpiProj8 E{WSP(bf16_t, WS_OV + OV_PROJ), WSP(unsigned char, WS_OV + OV_GD), lds + GTAB_OFF};
              pg8::gemm_phase_f8<pg8::EpiProj8, pg8::P1F8Order, false>(lds, g, S, E); }
            { pg8::Gemm g{WSP(const bf16_t, WS_XB), (const bf16_t*)WL_(WL_IN) + (P1_ALL_F8 ? (size_t)3584 * 1024 : 0), 1024, 1024, PROBE_PH == 100 ? 2048 : 1024, PROBE_PH == 100 ? 1 : 0}; pg8::StaticOrder S; S.init(T_, P1_ALL_F8 ? 256 : NIN_BF, G, (int)blockIdx.x);
              pg8::EpiProj E{WSP(bf16_t, WS_OV + OV_PROJ), WSP(float, WS_GSM), P1_ALL_F8 ? 14 : 0};
              pg8::gemm_phase<pg8::EpiProj, pg8::StaticOrder, PG8_ALIGN, PG8_SP2>(lds, g, S, E); }
        }
        SEAM(pb + 0);

        if (IN(pb + 1)) for (int rep = 0; rep < REPS(1); ++rep) { FRESH(a);
            const bf16_t* proj = WSP(const bf16_t, WS_OV + OV_PROJ); bf16_t* Hb = WSP(bf16_t, WS_OV + OV_H); const float* gsm = WSP(const float, WS_GSM);
            for (int r2 = 0; r2 < REPS(11); ++r2) for (int u = (int)blockIdx.x; u < 256; u += G) lru_fast<0>(a, l, u >> 5, (u >> 2) & 7, (u & 3) * 16, (u & 3) * 16 + 16, lds, proj, Hb, a->ws + WS_MXS);
            for (int r2 = 0; r2 < REPS(12); ++r2) mlstm_passA(a, l, lds, proj, gsm, a->ws + WS_V, a->ws + WS_MXS, G);
            __syncthreads();
            for (int r2 = 0; r2 < REPS(13); ++r2) gdn_passA1(a, l, lds, proj, gsm, a->ws + WS_V, G);
        }
        SEAM(pb + 1);
        if (IN(pb + 2)) for (int rep = 0; rep < REPS(2); ++rep) { FRESH(a);
            const bf16_t* proj = WSP(const bf16_t, WS_OV + OV_PROJ); const float* gsm = WSP(const float, WS_GSM);
            for (int r2 = 0; r2 < REPS(22); ++r2) mlstm_passB(a->ws + WS_V, a->ws + WS_MXS, G); for (int r2 = 0; r2 < REPS(23); ++r2) gdn_passA2(a, l, lds, proj, gsm, a->ws + WS_V, a->ws + WS_MXS, a->ws + WS_MXS, G); }
        SEAM(pb + 2);
        if (IN(pb + 3)) for (int rep = 0; rep < REPS(3); ++rep) { FRESH(a);
            const bf16_t* proj = WSP(const bf16_t, WS_OV + OV_PROJ); bf16_t* Hb = WSP(bf16_t, WS_OV + OV_H); const float* gsm = WSP(const float, WS_GSM);
            const int nB = G >= 128 ? 64 : 0;
            if ((int)blockIdx.x < nB) { for (int r2 = 0; r2 < REPS(31); ++r2) gdn_passB(a->ws + WS_V, a->ws + WS_MXS, a->ws + WS_MXS, nB); }
            else {
                if (nB == 0) { gdn_passB(a->ws + WS_V, a->ws + WS_MXS, a->ws + WS_MXS, G); __syncthreads(); }
                for (int r2 = 0; r2 < REPS(33); ++r2) mlstm_passC(a, l, lds, proj, gsm, Hb, a->ws + WS_V, a->ws + WS_MXS, (int)blockIdx.x - nB, G - nB);
            }
        }
        SEAM(pb + 3);
        if (IN(pb + 4)) for (int rep = 0; rep < REPS(4); ++rep) { FRESH(a); gdn_passC(a, l, lds, WSP(const bf16_t, WS_OV + OV_PROJ), WSP(bf16_t, WS_OV + OV_H), a->ws + WS_V, a->ws + WS_MXS, G);
            for (int r2 = 0; r2 < REPS(32); ++r2) lru_apply(a, WSP(const bf16_t, WS_OV + OV_PROJ), WSP(bf16_t, WS_OV + OV_H), a->ws + WS_MXS, (int)blockIdx.x, G); }
        SEAM(pb + 4);

        if (IN(pb + 5)) for (int rep = 0; rep < REPS(5); ++rep) { FRESH(a);
            pg8::StaticOrder S; S.init(T_, 1024, G, (int)blockIdx.x);
            pg8::Gemm g{WSP(const bf16_t, WS_OV + OV_H), (const bf16_t*)WL_(WL_BR), 2048, 2048, 2048}; pg8::EpiMergeF E{WSP(const unsigned char, WS_OV + OV_GD), WSP(bf16_t, WS_MB), lds + GTAB_OFF};
            pg8::gemm_phase<pg8::EpiMergeF, pg8::StaticOrder, PG8_ALIGN, PG8_SP2>(lds, g, S, E);
        }
        SEAM(pb + 5);

        if (IN(pb + 6)) for (int rep = 0; rep < REPS(6); ++rep) { FRESH(a);
            pg8::Gemm g{WSP(const bf16_t, WS_MB), (const bf16_t*)WL_(WL_OUT), 1024, 1024, 1024}; pg8::StaticOrder S; S.init(T_, 1024, G, (int)blockIdx.x);
            pg8::EpiWout E{WSP(const bf16_t, WS_XB), WSP(bf16_t, WS_V), lds + GTAB_OFF};
            pg8::gemm_phase<pg8::EpiWout, pg8::StaticOrder, PG8_ALIGN, PG8_SP2>(lds, g, S, E);
        }
        SEAM(pb + 6);

        if (IN(pb + 7)) for (int rep = 0; rep < REPS(7); ++rep) { FRESH(a); p5_ln1_router(a, l, lds, G); }
        SEAM(pb + 7);

        if (IN(pb + 8)) for (int rep = 0; rep < REPS(8); ++rep) { FRESH(a); p6_slots(a, lds, G); }
        SEAM(pb + 8);

        if (IN(pb + 9)) for (int rep = 0; rep < REPS(9); ++rep) { FRESH(a);
            const int nb = moe_table(a, lds);
            pg8::MoeOrder S{8, G, vcu, nb * 8, (const LAS int*)(lds + MISC_OFF + 256)};
            { LAS int* gt = (LAS int*)(lds + GTAB_OFF); const int* tokb = WSP(const int, WS_TOKB);
              int tq_ = threadIdx.x; asm volatile("" : "+v"(tq_));
              for (int ui = 0; ; ++ui) { const long L_ = pg8::moe_L(ui, vcu, G, nb * 8, 8); if (L_ < 0) break; const int pm = (int)(L_ / 8); if (tq_ < 256) gt[ui * 256 + tq_] = tokb[(size_t)pm * 256 + tq_]; }
              __syncthreads(); }
            pg8::Gemm8 g{WSP(const unsigned char, WS_X1), (const unsigned char*)WL_(WL_W1), 1024, 1024, PROBE_PH == 70 ? 2048 : 1024, PROBE_PH == 70 ? 1 : 0};
            pg8::EpiMoe1F8 E{WSP(unsigned char, WS_OV + OV_ACT), a->in[I_B1] + (size_t)l * NE * 2048, lds + MISC_OFF + 24576};
            pg8::gemm_phase_f8<pg8::EpiMoe1F8, pg8::MoeOrder, true>(lds, g, S, E, (const LAS int*)(lds + GTAB_OFF));
        }
        SEAM(pb + 9);

        if (IN(pb + 10)) for (int rep = 0; rep < REPS(10); ++rep) { FRESH(a);
            const int nb = moe_table(a, lds);
            pg8::MoeOrder S{4, G, vcu, nb * 4, (const LAS int*)(lds + MISC_OFF + 256)};
            pg8::Gemm8 g{WSP(const unsigned char, WS_OV + OV_ACT), (const unsigned char*)WL_(WL_W2), 1024, 1024, PROBE_PH == 80 ? 2048 : 1024, PROBE_PH == 80 ? 1 : 0};
            pg8::EpiMoe2F8 E{WSP(unsigned char, WS_OV + OV_YS), a->in[I_B2] + (size_t)l * NE * 1024, WSP(const float, WS_WBUF), lds + MISC_OFF + 24576};
            if (PROBE_PH == 81) { pg8::EpiNull8 E0; pg8::gemm_phase_f8<pg8::EpiNull8, pg8::MoeOrder, false>(lds, g, S, E0); __syncthreads(); }
            pg8::gemm_phase_f8<pg8::EpiMoe2F8, pg8::MoeOrder, false>(lds, g, S, E);
        }
        SEAM(pb + 10);

        if (IN(pb + 11)) for (int rep = 0; rep < REPS(14); ++rep) { FRESH(a); p9_combine_ln2(a, l, (l == DEPTH_ - 1) ? a->out : (float*)nullptr, G, lds); }
        SEAM(pb + 11);
    }
#undef WSP
#undef WL_
#undef IN
#undef SEAM
}

extern "C" void kernel_launch(void* const* d_in, const int* in_sizes, int n_in, void* d_out, int out_size, void* d_ws, size_t ws_size, hipStream_t stream) {
    static int grid = 0;
    if (grid == 0) {
        if (n_in != 30 || in_sizes[0] != T_ * D_ || out_size != T_ * D_ || ws_size < WS_END) {
            fprintf(stderr, "kernel_launch: unexpected shapes: n_in %d in0 %d out %d ws %zu (need %zu); nothing launched\n", n_in, n_in > 0 ? in_sizes[0] : -1, out_size, ws_size, (size_t)WS_END); grid = -1; return; }
        int dev = 0, cus = 0;
        if (hipGetDevice(&dev) != hipSuccess || hipDeviceGetAttribute(&cus, hipDeviceAttributeMultiprocessorCount, dev) != hipSuccess) { grid = -1; return; }
        if (hipFuncSetAttribute((const void*)fwd, hipFuncAttributeMaxDynamicSharedMemorySize, LDS_BYTES) != hipSuccess) { fprintf(stderr, "kernel_launch: hipFuncSetAttribute failed\n"); grid = -1; return; }
        int per_cu = 0; (void)hipOccupancyMaxActiveBlocksPerMultiprocessor(&per_cu, (const void*)fwd, NWAVES * 64, LDS_BYTES); (void)hipGetLastError();
        if (per_cu < 1) fprintf(stderr, "kernel_launch: occupancy query reports %d blocks per CU\n", per_cu);
        grid = cus;
    }
    if (grid < 0) return;
    (void)hipMemsetAsync((char*)d_ws + WS_CTL, 0, CTL_ZERO_BYTES, stream);
    Args a{};
    for (int i = 0; i < 30; ++i) a.in[i] = (const float*)d_in[i];
    a.out = (float*)d_out; a.ws = (unsigned char*)d_ws;
    constexpr int NL = MK_N_LAUNCHES; static_assert(NL == NPH || NL <= 4, "barrier regions");
    for (int li = 0; li < NL; ++li) {
        a.ph_lo = (int)((long)NPH * li / NL); a.ph_hi = (int)((long)NPH * (li + 1) / NL); a.li = (NL <= 4) ? li : 0;
        hipLaunchKernelGGL(fwd, dim3(grid), dim3(NWAVES * 64), LDS_BYTES, stream, a);
        const hipError_t le = hipPeekAtLastError();
        if (le != hipSuccess) { fprintf(stderr, "kernel_launch: launch %d failed: %s\n", li, hipGetErrorName(le)); break; }
    }
}
```
